# Optimizing an MI355X kernel written in HIP

```python
import math
import jax
import jax.numpy as jnp
from jax import lax
import numpy as np

D_MODEL = 1024
BATCH = 16
SEQ = 2048
DEPTH = 1

MIX_WIDTH = 2 * D_MODEL
SSD_WIDTH = MIX_WIDTH // 2
SSD_HEAD_DIM = 64
SSD_HEADS = SSD_WIDTH // SSD_HEAD_DIM
SSD_GROUPS = 4
SSD_HPG = SSD_HEADS // SSD_GROUPS
SSD_STATE = 128
SSD_CONV = 4
SSD_CHUNK = 128
CONV_CH = SSD_WIDTH + 2 * SSD_GROUPS * SSD_STATE
S5_WIDTH = MIX_WIDTH - SSD_WIDTH
S5_GROUP_CH = 16
S5_GROUPS = S5_WIDTH // S5_GROUP_CH
S5_STATE = 64
DT_MIN = 1e-3
DT_MAX = 1e-1
IN_WIDTH = SSD_WIDTH + CONV_CH + SSD_HEADS + S5_WIDTH
PEER_HEADS = 8
PEER_NKEYS = 128
PEER_EXPERTS = PEER_NKEYS * PEER_NKEYS
PEER_TOPK = 16
PEER_KEY_DIM = 256
PEER_HALF = PEER_KEY_DIM // 2
PEER_TOK_BLOCK = 128
EPS = 1e-6

kernel_name = 'hybrid_ssd_s5_peer_adaln_block'


def rms_norm(x, g):
    xf = x.astype(jnp.float32)
    y = xf * lax.rsqrt(jnp.mean(xf * xf, axis=-1, keepdims=True) + EPS)
    return (y * g.astype(jnp.float32)).astype(x.dtype)


def ssd_mixer(z, xbc, dt_raw, conv_w, conv_b, dt_bias, a_log, d_ssd, norm_ssd_g):
    b, s, _ = xbc.shape
    nc = s // SSD_CHUNK
    f32 = jnp.float32
    xpad = jnp.pad(xbc, ((0, 0), (SSD_CONV - 1, 0), (0, 0)))
    conv = conv_b
    for k in range(SSD_CONV):
        conv = conv + xpad[:, k:k + s, :] * conv_w[k]
    xbc = jax.nn.silu(conv.astype(f32))
    xs, bm, cm = jnp.split(xbc, [SSD_WIDTH, SSD_WIDTH + SSD_GROUPS * SSD_STATE], axis=-1)
    dt = jax.nn.softplus(dt_raw.astype(f32) + dt_bias.astype(f32))
    a = -jnp.exp(a_log.astype(f32))
    xc = xs.reshape(b, nc, SSD_CHUNK, SSD_GROUPS, SSD_HPG, SSD_HEAD_DIM)
    bc = bm.reshape(b, nc, SSD_CHUNK, SSD_GROUPS, SSD_STATE)
    cc = cm.reshape(b, nc, SSD_CHUNK, SSD_GROUPS, SSD_STATE)
    dtc = dt.reshape(b, nc, SSD_CHUNK, SSD_GROUPS, SSD_HPG)
    xdt = xc * dtc[..., None]
    da_cs = jnp.cumsum(dtc * a.reshape(SSD_GROUPS, SSD_HPG), axis=2)
    seg = jnp.moveaxis(da_cs, 2, -1)
    diff = seg[..., :, None] - seg[..., None, :]
    causal = jnp.tril(jnp.ones((SSD_CHUNK, SSD_CHUNK), dtype=bool))
    lmat = jnp.where(causal, jnp.exp(jnp.where(causal, diff, 0.0)), 0.0)
    cb = jnp.einsum('bclgn,bcsgn->bcgls', cc, bc)
    y_diag = jnp.einsum('bcgls,bcgrls,bcsgrp->bclgrp', cb, lmat, xdt)
    decay_states = jnp.exp(da_cs[:, :, -1:] - da_cs)
    states = jnp.einsum('bclgn,bclgr,bclgrp->bcgrpn', bc, decay_states, xdt)
    chunk_decay = jnp.exp(da_cs[:, :, -1])

    def step(carry, inp):
        st, dec = inp
        return carry * dec[..., None, None] + st, carry

    init = jnp.zeros((b, SSD_GROUPS, SSD_HPG, SSD_HEAD_DIM, SSD_STATE), f32)
    _, prev = lax.scan(step, init, (jnp.moveaxis(states, 1, 0), jnp.moveaxis(chunk_decay, 1, 0)))
    prev = jnp.moveaxis(prev, 0, 1)
    y_off = jnp.einsum('bclgn,bcgrpn,bclgr->bclgrp', cc, prev, jnp.exp(da_cs))
    y = y_diag + y_off + d_ssd.astype(f32).reshape(SSD_GROUPS, SSD_HPG, 1) * xc
    y = y.reshape(b, s, SSD_WIDTH) * jax.nn.silu(z.astype(f32))
    yg = y.reshape(b, s, SSD_GROUPS, SSD_WIDTH // SSD_GROUPS)
    yg = yg * lax.rsqrt(jnp.mean(yg * yg, axis=-1, keepdims=True) + EPS)
    return (yg.reshape(b, s, SSD_WIDTH) * norm_ssd_g.astype(f32)).astype(z.dtype)


def s5_mixer(u, a_re, a_im, log_dt, b_re, b_im, c_re, c_im, d_s5, glu_w, glu_b, norm_s5_g):
    b, s, _ = u.shape
    f32 = jnp.float32
    uf = u.astype(f32).reshape(b, s, S5_GROUPS, S5_GROUP_CH)
    lr = a_re.astype(f32)
    li = a_im.astype(f32)
    dt = jnp.exp(log_dt.astype(f32))[:, None]
    mag = jnp.exp(lr * dt)
    lb_re = mag * jnp.cos(li * dt)
    lb_im = mag * jnp.sin(li * dt)
    den = lr * lr + li * li
    coef_re = ((lb_re - 1.0) * lr + lb_im * li) / den
    coef_im = (lb_im * lr - (lb_re - 1.0) * li) / den
    br = b_re.astype(f32)
    bi = b_im.astype(f32)
    bb_re = coef_re[..., None] * br - coef_im[..., None] * bi
    bb_im = coef_re[..., None] * bi + coef_im[..., None] * br
    bu_re = jnp.einsum('bsgh,gph->sbgp', uf, bb_re)
    bu_im = jnp.einsum('bsgh,gph->sbgp', uf, bb_im)
    a_re_t = jnp.broadcast_to(lb_re, (s, 1, S5_GROUPS, S5_STATE))
    a_im_t = jnp.broadcast_to(lb_im, (s, 1, S5_GROUPS, S5_STATE))

    def combine(e1, e2):
        a1r, a1i, b1r, b1i = e1
        a2r, a2i, b2r, b2i = e2
        return (a2r * a1r - a2i * a1i,
                a2r * a1i + a2i * a1r,
                a2r * b1r - a2i * b1i + b2r,
                a2r * b1i + a2i * b1r + b2i)

    _, _, xr, xi = lax.associative_scan(combine, (a_re_t, a_im_t, bu_re, bu_im), axis=0)
    y = (jnp.einsum('sbgp,ghp->bsgh', xr, c_re.astype(f32))
         - jnp.einsum('sbgp,ghp->bsgh', xi, c_im.astype(f32))
         + d_s5.astype(f32) * uf)
    v = jax.nn.gelu(y, approximate=False)
    out = v * jax.nn.sigmoid(jnp.einsum('bsgh,ghk->bsgk', v, glu_w.astype(f32)) + glu_b.astype(f32))
    out = out.reshape(b, s, S5_WIDTH)
    return rms_norm(out, norm_s5_g).astype(u.dtype)


def peer_ffn(h, w_query, sub_keys, expert_u, expert_v):
    b, s, d = h.shape
    f32 = jnp.float32
    q = (h @ w_query).reshape(b, s, PEER_HEADS, 2, PEER_HALF)
    scores = jnp.einsum('bshcd,hckd->bshck', q, sub_keys).astype(f32)
    s1, i1 = lax.top_k(scores[..., 0, :], PEER_TOPK)
    s2, i2 = lax.top_k(scores[..., 1, :], PEER_TOPK)
    cand = (s1[..., :, None] + s2[..., None, :]).reshape(b, s, PEER_HEADS, PEER_TOPK * PEER_TOPK)
    cand_id = (i1[..., :, None] * PEER_NKEYS + i2[..., None, :]).reshape(b, s, PEER_HEADS, PEER_TOPK * PEER_TOPK)
    top_s, pos = lax.top_k(cand, PEER_TOPK)
    eid = jnp.take_along_axis(cand_id, pos, axis=-1)
    gates = jax.nn.softmax(top_s, axis=-1)
    n_blocks = (b * s) // PEER_TOK_BLOCK
    hb = h.reshape(n_blocks, PEER_TOK_BLOCK, d)
    eb = eid.reshape(n_blocks, PEER_TOK_BLOCK, PEER_HEADS * PEER_TOPK)
    gb = gates.reshape(n_blocks, PEER_TOK_BLOCK, PEER_HEADS * PEER_TOPK)

    def block(args):
        hx, ex, gx = args
        u = jnp.take(expert_u, ex, axis=0)
        v = jnp.take(expert_v, ex, axis=0)
        act = jax.nn.gelu(jnp.einsum('td,ted->te', hx, u).astype(f32), approximate=False)
        return jnp.einsum('te,ted->td', (gx * act).astype(h.dtype), v).astype(h.dtype)

    out = lax.map(block, (hb, eb, gb))
    return out.reshape(b, s, d)


def setup_inputs(seed: int = 0) -> dict:
    key = jax.random.key(seed)
    ks = jax.random.split(key, 32)
    L = DEPTH
    f32 = jnp.float32

    def nrm(k, shape, scale):
        return jax.random.normal(k, shape, f32) * scale

    x = nrm(ks[0], (BATCH, SEQ, D_MODEL), 1.0)
    c = nrm(ks[1], (BATCH, D_MODEL), 1.0)
    w_ada = nrm(ks[2], (L, D_MODEL, 6 * D_MODEL), D_MODEL ** -0.5)
    b_ada = nrm(ks[3], (L, 6 * D_MODEL), 0.02)
    norm1_g = 1.0 + nrm(ks[4], (L, D_MODEL), 0.02)
    w_in = nrm(ks[5], (L, D_MODEL, IN_WIDTH), D_MODEL ** -0.5)
    conv_w = nrm(ks[6], (L, SSD_CONV, CONV_CH), SSD_CONV ** -0.5)
    conv_b = nrm(ks[7], (L, CONV_CH), 0.02)
    dt0 = jnp.exp(jax.random.uniform(ks[8], (L, SSD_HEADS), f32, math.log(DT_MIN), math.log(DT_MAX)))
    dt_bias = dt0 + jnp.log(-jnp.expm1(-dt0))
    a_log = jnp.log(jax.random.uniform(ks[9], (L, SSD_HEADS), f32, 1.0, 16.0))
    d_ssd = 1.0 + nrm(ks[10], (L, SSD_HEADS), 0.02)
    norm_ssd_g = 1.0 + nrm(ks[11], (L, SSD_WIDTH), 0.02)
    s5_a_re = -0.5 + nrm(ks[12], (L, S5_GROUPS, S5_STATE), 0.01)
    s5_a_im = jnp.pi * jnp.arange(S5_STATE, dtype=f32) + nrm(ks[13], (L, S5_GROUPS, S5_STATE), 0.01)
    s5_log_dt = jax.random.uniform(ks[14], (L, S5_GROUPS), f32, math.log(DT_MIN), math.log(DT_MAX))
    s5_b_re = nrm(ks[15], (L, S5_GROUPS, S5_STATE, S5_GROUP_CH), (2 * S5_GROUP_CH) ** -0.5)
    s5_b_im = nrm(ks[16], (L, S5_GROUPS, S5_STATE, S5_GROUP_CH), (2 * S5_GROUP_CH) ** -0.5)
    s5_c_re = nrm(ks[17], (L, S5_GROUPS, S5_GROUP_CH, S5_STATE), (2 * S5_STATE) ** -0.5)
    s5_c_im = nrm(ks[18], (L, S5_GROUPS, S5_GROUP_CH, S5_STATE), (2 * S5_STATE) ** -0.5)
    s5_d = nrm(ks[19], (L, S5_GROUPS, S5_GROUP_CH), 1.0)
    glu_w = nrm(ks[20], (L, S5_GROUPS, S5_GROUP_CH, S5_GROUP_CH), S5_GROUP_CH ** -0.5)
    glu_b = nrm(ks[21], (L, S5_GROUPS, S5_GROUP_CH), 0.02)
    norm_s5_g = 1.0 + nrm(ks[22], (L, S5_WIDTH), 0.02)
    w_out = nrm(ks[23], (L, MIX_WIDTH, D_MODEL), MIX_WIDTH ** -0.5)
    norm2_g = 1.0 + nrm(ks[24], (L, D_MODEL), 0.02)
    w_query = nrm(ks[25], (L, D_MODEL, PEER_HEADS * PEER_KEY_DIM), D_MODEL ** -0.5)
    sub_keys = nrm(ks[26], (L, PEER_HEADS, 2, PEER_NKEYS, PEER_HALF), PEER_HALF ** -0.5)
    expert_u = nrm(ks[27], (L, PEER_EXPERTS, D_MODEL), D_MODEL ** -0.5)
    expert_v = nrm(ks[28], (L, PEER_EXPERTS, D_MODEL), PEER_HEADS ** -0.5)
    norm_f_g = 1.0 + nrm(ks[29], (D_MODEL,), 0.02)
    return {'x': x, 'c': c, 'w_ada': w_ada, 'b_ada': b_ada, 'norm1_g': norm1_g, 'w_in': w_in,
            'conv_w': conv_w, 'conv_b': conv_b, 'dt_bias': dt_bias, 'a_log': a_log, 'd_ssd': d_ssd,
            'norm_ssd_g': norm_ssd_g, 's5_a_re': s5_a_re, 's5_a_im': s5_a_im, 's5_log_dt': s5_log_dt,
            's5_b_re': s5_b_re, 's5_b_im': s5_b_im, 's5_c_re': s5_c_re, 's5_c_im': s5_c_im, 's5_d': s5_d,
            'glu_w': glu_w, 'glu_b': glu_b, 'norm_s5_g': norm_s5_g, 'w_out': w_out, 'norm2_g': norm2_g,
            'w_query': w_query, 'sub_keys': sub_keys, 'expert_u': expert_u, 'expert_v': expert_v,
            'norm_f_g': norm_f_g}


def reference(x, c, w_ada, b_ada, norm1_g, w_in, conv_w, conv_b, dt_bias, a_log, d_ssd, norm_ssd_g,
              s5_a_re, s5_a_im, s5_log_dt, s5_b_re, s5_b_im, s5_c_re, s5_c_im, s5_d, glu_w, glu_b,
              norm_s5_g, w_out, norm2_g, w_query, sub_keys, expert_u, expert_v, norm_f_g):
    for l in range(DEPTH):
        mod = jax.nn.silu(c) @ w_ada[l] + b_ada[l]
        shift1, scale1, gate1, shift2, scale2, gate2 = jnp.split(mod[:, None, :], 6, axis=-1)
        h = rms_norm(x, norm1_g[l]) * (1.0 + scale1) + shift1
        proj = h @ w_in[l]
        z, xbc, dt_raw, u = jnp.split(
            proj, [SSD_WIDTH, SSD_WIDTH + CONV_CH, SSD_WIDTH + CONV_CH + SSD_HEADS], axis=-1)
        y_ssd = ssd_mixer(z, xbc, dt_raw, conv_w[l], conv_b[l], dt_bias[l], a_log[l], d_ssd[l], norm_ssd_g[l])
        y_s5 = s5_mixer(u, s5_a_re[l], s5_a_im[l], s5_log_dt[l], s5_b_re[l], s5_b_im[l], s5_c_re[l],
                        s5_c_im[l], s5_d[l], glu_w[l], glu_b[l], norm_s5_g[l])
        mix = jnp.concatenate([y_ssd, y_s5], axis=-1) @ w_out[l]
        x = x + gate1 * mix
        h = rms_norm(x, norm2_g[l]) * (1.0 + scale2) + shift2
        x = x + gate2 * peer_ffn(h, w_query[l], sub_keys[l], expert_u[l], expert_v[l])
    return rms_norm(x, norm_f_g)
```

```cpp
#include <hip/hip_runtime.h>
#include <cstdio>
#include <cstdint>
namespace pg8 {
#define PG8_LAS __attribute__((address_space(3)))
typedef unsigned short bf16_t;
typedef short bf16x8 __attribute__((ext_vector_type(8)));
typedef float f32x4 __attribute__((ext_vector_type(4)));
typedef unsigned u32x4 __attribute__((ext_vector_type(4)));
constexpr int BM = 256, BK = 64, HALF = 128, HTB = HALF * BK * 2  , STAGE_BYTES = 8 * HTB, NXCD = 8, WGM = 8;

__host__ __device__ __forceinline__ int lds_byte(int r, int c) { const int st = (r >> 4) * 2 + (c >> 5), rr = r & 15, cc = c & 31, ob = rr * 64 + cc * 2; return st * 1024 + (ob ^ (((ob >> 9) & 1) << 5)); }
__host__ __device__ __forceinline__ void stage_rc(int b, int& R, int& C) { const int st = b / 1024, sb = b % 1024, swz = sb ^ (((sb >> 9) & 1) << 5); R = (st >> 1) * 16 + swz / 64; C = (st & 1) * 32 + (swz % 64) / 2; }
__host__ __device__ __forceinline__ int perm32(int rho) { const int n = rho >> 4, i = rho & 15; return 8 * (i >> 2) + 4 * n + (i & 3); }

struct Unit { int pm, pn; };
struct Gemm { const bf16_t* A; const bf16_t* Bt; int M, N, K; };

struct StaticOrder {
    int nM, nN, nwg, G, c;
    __host__ __device__ void init(int M, int N, int G_, int c_) { nM = M / BM; nN = N / BM; nwg = nM * nN; G = G_; c = c_; }
    __host__ __device__ bool next(int i, Unit& u) const {
        const long L = (long)i * G + c; if (L >= nwg) return false;
        int wgid = (int)L; { const int q = nwg / NXCD, r = nwg % NXCD, xcd = wgid % NXCD, off = wgid / NXCD; wgid = (xcd < r ? xcd * (q + 1) : r * (q + 1) + (xcd - r) * q) + off; }
        const int nig = WGM * nN, gid = wgid / nig, fm = gid * WGM, gsz = (nM - fm) < WGM ? (nM - fm) : WGM;
        u.pm = fm + ((wgid % nig) % gsz); u.pn = (wgid % nig) / gsz; return true;
    }
    __device__ __forceinline__ void a_ready(const Unit&) const {}
    __device__ __forceinline__ void done(const Unit&) const {}
};

__device__ __forceinline__ unsigned cvt_pk_bf16(float lo, float hi) { unsigned r; asm volatile("v_cvt_pk_bf16_f32 %0, %1, %2" : "=v"(r) : "v"(lo), "v"(hi)); return r; }
typedef float f32x2 __attribute__((ext_vector_type(2)));
template <class Epi, class Sched, bool ALIGN_EPI = false, bool SP2 = false>
__device__ __forceinline__ void gemm_phase(PG8_LAS unsigned char* lds, const Gemm g, const Sched& S, const Epi& E) {
    const int tid = threadIdx.x, wid = __builtin_amdgcn_readfirstlane(tid >> 6), lane = tid & 63, wr = wid >> 2, wc = wid & 3, fr = lane & 15, fq = lane >> 4;
    const int K = g.K, nt = K / BK;
    unsigned voffA[2], voffB[2];
#pragma unroll
    for (int i = 0; i < 2; ++i) { int R, C; stage_rc(tid * 16 + i * 8192, R, C); const int Rb = Epi::PERM ? ((R & ~31) + perm32(R & 31)) : R;
        voffA[i] = (unsigned)(R * K + C) * 2u; voffB[i] = (unsigned)(Rb * K + C) * 2u; }
    const size_t kstep = (size_t)(BK * 2);
    const size_t hstep = (size_t)HALF * K * 2;
    const size_t tstep = 2 * hstep;
    const unsigned ldsw = (unsigned)wid * 1024u;
    const int aoff = lds_byte(wr * 64 + fr, fq * 8), boff = lds_byte(wc * 32 + fr, fq * 8);
#define PG8_SA(b, h) (((b) * 2 + (h)) * HTB)
#define PG8_SB(b, h) ((4 + (b) * 2 + (h)) * HTB)
#define PG8_STAGE(bufoff, gbase, voff) do { _Pragma("unroll") for (int _i = 0; _i < 2; ++_i) \
        __builtin_amdgcn_global_load_lds((const unsigned*)((const char*)(gbase) + (voff)[_i]), (PG8_LAS unsigned*)(lds + (bufoff) + ldsw + _i * 8192), 16, 0, 0); } while (0)
#define PG8_LDA(dst, b, h) do { _Pragma("unroll") for (int m = 0; m < 4; ++m) _Pragma("unroll") for (int k = 0; k < 2; ++k) dst[m][k] = *(const PG8_LAS bf16x8*)(lds + PG8_SA(b, h) + aoff + m * 2048 + k * 1024); } while (0)
#define PG8_LDB(dst, b, h) do { _Pragma("unroll") for (int n = 0; n < 2; ++n) _Pragma("unroll") for (int k = 0; k < 2; ++k) dst[n][k] = *(const PG8_LAS bf16x8*)(lds + PG8_SB(b, h) + boff + n * 2048 + k * 1024); } while (0)
#define PG8_MMA(ai, bj, At, Bt) do { __builtin_amdgcn_s_setprio(1); _Pragma("unroll") for (int m = 0; m < 4; ++m) _Pragma("unroll") for (int n = 0; n < 2; ++n) _Pragma("unroll") for (int k = 0; k < 2; ++k) \
        acc[ai][bj][m][n] = __builtin_amdgcn_mfma_f32_16x16x32_bf16(Bt[n][k], At[m][k], acc[ai][bj][m][n], 0, 0, 0); __builtin_amdgcn_s_setprio(0); } while (0)
#define PG8_WAIT_V(n) asm volatile("s_waitcnt vmcnt(" #n ")" ::: "memory")
#define PG8_WAIT_L(n) asm volatile("s_waitcnt lgkmcnt(" #n ")" ::: "memory")
#define PG8_BAR __builtin_amdgcn_s_barrier()
#define PG8_SCHED __builtin_amdgcn_sched_barrier(0)
    Unit cur, nxt; int ui = 0;
    if (!S.next(0, cur)) return;
    f32x4 acc[2][2][4][2];
#pragma unroll
    for (int a = 0; a < 2; ++a)
#pragma unroll
        for (int b = 0; b < 2; ++b)
#pragma unroll
            for (int m = 0; m < 4; ++m)
#pragma unroll
                for (int n = 0; n < 2; ++n) acc[a][b][m][n] = (f32x4){0.f, 0.f, 0.f, 0.f};
    bf16x8 At[4][2], B0[2][2], B1[2][2];
    const char* cA = (const char*)g.A + (size_t)cur.pm * tstep; const char* cB = (const char*)g.Bt + (size_t)cur.pn * tstep;
    S.a_ready(cur);
    if constexpr (SP2) {
        PG8_STAGE(PG8_SB(0, 0), cB, voffB); PG8_STAGE(PG8_SB(0, 1), cB + hstep, voffB); PG8_STAGE(PG8_SA(0, 0), cA, voffA); PG8_STAGE(PG8_SA(0, 1), cA + hstep, voffA);
        if (wr == 1) PG8_BAR;
        PG8_WAIT_V(2); PG8_BAR;
        PG8_STAGE(PG8_SB(1, 0), cB + kstep, voffB); PG8_STAGE(PG8_SA(1, 0), cA + kstep, voffA); PG8_STAGE(PG8_SB(1, 1), cB + hstep + kstep, voffB);
        PG8_WAIT_V(6); PG8_BAR;
    } else {
        PG8_STAGE(PG8_SB(0, 0), cB, voffB); PG8_STAGE(PG8_SA(0, 0), cA, voffA); PG8_STAGE(PG8_SB(0, 1), cB + hstep, voffB); PG8_STAGE(PG8_SA(0, 1), cA + hstep, voffA);
        if (wr == 1) PG8_BAR;
        PG8_WAIT_V(4); PG8_BAR;
        PG8_STAGE(PG8_SB(1, 0), cB + kstep, voffB); PG8_STAGE(PG8_SA(1, 0), cA + kstep, voffA); PG8_STAGE(PG8_SB(1, 1), cB + hstep + kstep, voffB);
        PG8_WAIT_V(6); PG8_BAR;
    }
    for (;;) {
        const bool has_next = S.next(ui + 1, nxt);
        const char* nA = has_next ? (const char*)g.A + (size_t)nxt.pm * tstep : cA; const char* nB = has_next ? (const char*)g.Bt + (size_t)nxt.pn * tstep : cB;
        for (int t = 0; t < nt; t += 2) {
            const bool last = (t == nt - 2);
            const char* a1 = cA + (size_t)(t + 1) * kstep;
            const char* a2 = last ? nA : cA + (size_t)(t + 2) * kstep; const char* b2 = last ? nB : cB + (size_t)(t + 2) * kstep;
            const char* a3 = a2 + kstep; const char* b3 = b2 + kstep;
            if (last && has_next) S.a_ready(nxt);
            if constexpr (SP2) {
            PG8_LDB(B0, 0, 0); PG8_LDB(B1, 0, 1); PG8_SCHED; PG8_LDA(At, 0, 0); PG8_STAGE(PG8_SA(1, 1), a1 + hstep, voffA);
            PG8_WAIT_V(8); PG8_WAIT_L(0); PG8_BAR; PG8_MMA(0, 0, At, B0); PG8_MMA(0, 1, At, B1); PG8_BAR; PG8_SCHED;
            PG8_LDA(At, 0, 1); PG8_STAGE(PG8_SB(0, 0), b2, voffB); PG8_STAGE(PG8_SB(0, 1), b2 + hstep, voffB); PG8_STAGE(PG8_SA(0, 0), a2, voffA);
            PG8_WAIT_V(8); PG8_WAIT_L(0); PG8_BAR; PG8_MMA(1, 0, At, B0); PG8_MMA(1, 1, At, B1); PG8_BAR; PG8_SCHED;
            PG8_LDB(B0, 1, 0); PG8_LDB(B1, 1, 1); PG8_SCHED; PG8_LDA(At, 1, 0); PG8_STAGE(PG8_SA(0, 1), a2 + hstep, voffA);
            PG8_WAIT_V(8); PG8_WAIT_L(0); PG8_BAR; PG8_MMA(0, 0, At, B0); PG8_MMA(0, 1, At, B1); PG8_BAR; PG8_SCHED;
            PG8_LDA(At, 1, 1); PG8_STAGE(PG8_SB(1, 0), b3, voffB); PG8_STAGE(PG8_SB(1, 1), b3 + hstep, voffB); PG8_STAGE(PG8_SA(1, 0), a3, voffA);
            PG8_WAIT_V(8); PG8_WAIT_L(0); PG8_BAR; PG8_MMA(1, 0, At, B0); PG8_MMA(1, 1, At, B1); PG8_BAR; PG8_SCHED;
            } else {
            PG8_LDB(B0, 0, 0); PG8_SCHED; PG8_LDA(At, 0, 0); PG8_STAGE(PG8_SA(1, 1), a1 + hstep, voffA);
            PG8_WAIT_L(8); PG8_BAR; PG8_WAIT_L(0); PG8_MMA(0, 0, At, B0); PG8_BAR; PG8_SCHED;
            PG8_LDB(B1, 0, 1); PG8_STAGE(PG8_SB(0, 0), b2, voffB);
            PG8_BAR; PG8_WAIT_L(0); PG8_MMA(0, 1, At, B1); PG8_BAR;
            PG8_LDA(At, 0, 1); PG8_STAGE(PG8_SA(0, 0), a2, voffA);
            PG8_BAR; PG8_WAIT_L(0); PG8_MMA(1, 0, At, B0); PG8_BAR; PG8_SCHED;
            PG8_STAGE(PG8_SB(0, 1), b2 + hstep, voffB);
            PG8_WAIT_V(6); PG8_BAR; PG8_MMA(1, 1, At, B1); PG8_BAR;
            PG8_LDB(B0, 1, 0); PG8_SCHED; PG8_LDA(At, 1, 0); PG8_STAGE(PG8_SA(0, 1), a2 + hstep, voffA);
            PG8_WAIT_L(8); PG8_BAR; PG8_WAIT_L(0); PG8_MMA(0, 0, At, B0); PG8_BAR; PG8_SCHED;
            PG8_LDB(B1, 1, 1); PG8_STAGE(PG8_SB(1, 0), b3, voffB);
            PG8_BAR; PG8_WAIT_L(0); PG8_MMA(0, 1, At, B1); PG8_BAR;
            PG8_LDA(At, 1, 1); PG8_STAGE(PG8_SA(1, 0), a3, voffA);
            PG8_BAR; PG8_WAIT_L(0); PG8_MMA(1, 0, At, B0); PG8_BAR; PG8_SCHED;
            PG8_STAGE(PG8_SB(1, 1), b3 + hstep, voffB);
            PG8_WAIT_V(6); PG8_BAR; PG8_MMA(1, 1, At, B1); PG8_BAR;
            }
        }
        if constexpr (ALIGN_EPI) { if (wr == 0) PG8_BAR; }
        if constexpr (!Epi::AFTER_DRAIN) { E(acc, cur, wr, wc, fr, fq); S.done(cur); }
        if (!has_next) break;
#pragma unroll
        for (int a = 0; a < 2; ++a)
#pragma unroll
            for (int b = 0; b < 2; ++b)
#pragma unroll
                for (int m = 0; m < 4; ++m)
#pragma unroll
                    for (int n = 0; n < 2; ++n) acc[a][b][m][n] = (f32x4){0.f, 0.f, 0.f, 0.f};
        cur = nxt; cA = nA; cB = nB; ++ui;
        if constexpr (ALIGN_EPI) { if (wr == 1) PG8_BAR; }
    }
    PG8_WAIT_V(0);
    if constexpr (!ALIGN_EPI) { if (wr == 0) PG8_BAR; }
    PG8_BAR;
    if constexpr (Epi::AFTER_DRAIN) { E.fused(acc, cur, wr, wc, fr, fq, lds, wid, lane); S.done(cur); }
#undef PG8_SA
#undef PG8_SB
#undef PG8_STAGE
#undef PG8_LDA
#undef PG8_LDB
#undef PG8_MMA
#undef PG8_WAIT_V
#undef PG8_WAIT_L
#undef PG8_BAR
#undef PG8_SCHED
}
}
namespace pg8 {
struct EpiProj {
    static constexpr bool PERM = true, AFTER_DRAIN = false;
    bf16_t* O; int ldc;
    __device__ __forceinline__ void operator()(const f32x4 (&acc)[2][2][4][2], const Unit& u, int wr, int wc, int fr, int fq) const {
        const int row0 = u.pm * BM + wr * 64 + fr; const int col0 = u.pn * BM + wc * 32 + 8 * fq;
#pragma unroll
        for (int ai = 0; ai < 2; ++ai)
#pragma unroll
            for (int m = 0; m < 4; ++m) { bf16_t* rowp = O + (size_t)(row0 + ai * HALF + m * 16) * ldc + col0;
#pragma unroll
                for (int bj = 0; bj < 2; ++bj) { const f32x4 v0 = acc[ai][bj][m][0], v1 = acc[ai][bj][m][1];
                    u32x4 w; w.x = cvt_pk_bf16(v0[0], v0[1]); w.y = cvt_pk_bf16(v0[2], v0[3]); w.z = cvt_pk_bf16(v1[0], v1[1]); w.w = cvt_pk_bf16(v1[2], v1[3]);
                    *(u32x4*)(rowp + bj * HALF) = w; } }
    }
};
struct EpiX1 {
    static constexpr bool PERM = true, AFTER_DRAIN = false;
    const float* x; float* x1; bf16_t* x1s; const float* mod; const float* norm2_g; float* rowstat;
    __device__ __forceinline__ void operator()(const f32x4 (&acc)[2][2][4][2], const Unit& u, int wr, int wc, int fr, int fq) const {
        const int row0 = u.pm * BM + wr * 64 + fr; const int col0 = u.pn * BM + wc * 32 + 8 * fq; const int b = (u.pm * BM) >> 11;
        const float* mb = mod + (size_t)b * 6144;
        f32x4 g1[2][2], g2[2][2];
#pragma unroll
        for (int bj = 0; bj < 2; ++bj)
#pragma unroll
            for (int n = 0; n < 2; ++n) { const int c = col0 + bj * HALF + 4 * n; g1[bj][n] = *(const f32x4*)(mb + 2048 + c);
                const f32x4 sc = *(const f32x4*)(mb + 4096 + c), ng = *(const f32x4*)(norm2_g + c); g2[bj][n] = ng * (sc + 1.0f); }
#pragma unroll
        for (int ai = 0; ai < 2; ++ai)
#pragma unroll
            for (int m = 0; m < 4; ++m) { const size_t row = (size_t)(row0 + ai * HALF + m * 16); const size_t off = row * 1024 + col0; float ss = 0.f;
#pragma unroll
                for (int bj = 0; bj < 2; ++bj) {
                    const f32x4 xa = *(const f32x4*)(x + off + bj * HALF), xb = *(const f32x4*)(x + off + bj * HALF + 4);
                    const f32x4 v0 = xa + g1[bj][0] * acc[ai][bj][m][0], v1 = xb + g1[bj][1] * acc[ai][bj][m][1];
                    *(f32x4*)(x1 + off + bj * HALF) = v0; *(f32x4*)(x1 + off + bj * HALF + 4) = v1;
                    ss += (v0[0] * v0[0] + v0[1] * v0[1]) + (v0[2] * v0[2] + v0[3] * v0[3]) + (v1[0] * v1[0] + v1[1] * v1[1]) + (v1[2] * v1[2] + v1[3] * v1[3]);
                    const f32x4 s0 = v0 * g2[bj][0], s1 = v1 * g2[bj][1];
                    u32x4 w; w.x = cvt_pk_bf16(s0[0], s0[1]); w.y = cvt_pk_bf16(s0[2], s0[3]); w.z = cvt_pk_bf16(s1[0], s1[1]); w.w = cvt_pk_bf16(s1[2], s1[3]);
                    *(u32x4*)(x1s + off + bj * HALF) = w; }
                ss += __shfl_xor(ss, 16); ss += __shfl_xor(ss, 32);
                if (fq == 0) atomicAdd(rowstat + row, ss); }
    }
};
struct EpiScores {
    static constexpr bool PERM = true, AFTER_DRAIN = false;
    float* S; const float* sb; const float* rowstat;
    __device__ __forceinline__ void operator()(const f32x4 (&acc)[2][2][4][2], const Unit& u, int wr, int wc, int fr, int fq) const {
        const int row0 = u.pm * BM + wr * 64 + fr; const int col0 = u.pn * BM + wc * 32 + 8 * fq; const int b = (u.pm * BM) >> 11;
        f32x4 bv[2][2];
#pragma unroll
        for (int bj = 0; bj < 2; ++bj)
#pragma unroll
            for (int n = 0; n < 2; ++n) bv[bj][n] = *(const f32x4*)(sb + (size_t)b * 2048 + col0 + bj * HALF + 4 * n);
#pragma unroll
        for (int ai = 0; ai < 2; ++ai)
#pragma unroll
            for (int m = 0; m < 4; ++m) { const size_t row = (size_t)(row0 + ai * HALF + m * 16); const float rs = 1.0f / sqrtf(rowstat[row] * (1.0f / 1024.0f) + 1e-6f);
                float* rowp = S + row * 2048 + col0;
#pragma unroll
                for (int bj = 0; bj < 2; ++bj) { *(f32x4*)(rowp + bj * HALF) = acc[ai][bj][m][0] * rs + bv[bj][0]; *(f32x4*)(rowp + bj * HALF + 4) = acc[ai][bj][m][1] * rs + bv[bj][1]; } }
    }
};
}
constexpr int NWAVES = 8, NTHR = 512;
constexpr int DM = 1024, NB = 16, SEQ = 2048, MTOK = NB * SEQ;
constexpr int NPROJ = 4096;
constexpr int INW = 4112;
constexpr int NHEADS = 16, HDIM = 64, NGRP = 4, NST = 128, CHUNK = 128;
constexpr int S5G = 64, S5CH = 16, S5P = 64;
constexpr int PH = 8, PK = 16, PNK = 128;
constexpr float EPSF = 1e-6f;
constexpr int NS5PART = 64;

constexpr size_t MiB = 1u << 20;
constexpr size_t WS_CTL = 0, CTL_ZERO_BYTES = 64 * 1024;
constexpr size_t WS_MOD = 1 * MiB;
constexpr size_t WS_WDT = WS_MOD + 0x60000;
constexpr size_t WS_SB = WS_MOD + 0x70000;
constexpr size_t WS_ROWSTAT = WS_MOD + 0x90000;
constexpr size_t WS_S5LB = WS_MOD + 0xB0000;
constexpr size_t WS_S5BB = WS_MOD + 0xC0000;
constexpr size_t WS_DTRAW = 3 * MiB;
constexpr size_t WS_STSSD = 5 * MiB;
constexpr size_t WS_STS5 = 7 * MiB;
constexpr size_t WS_WINT = 15 * MiB;
constexpr size_t WS_WOUTT = 23 * MiB;
constexpr size_t WS_WQKT = 27 * MiB;
constexpr size_t WS_EU = 31 * MiB, WS_EV = 63 * MiB;
constexpr size_t WS_A = 95 * MiB;
constexpr size_t WS_B = 223 * MiB;
constexpr size_t WS_H1 = WS_A, WS_Y = WS_A, WS_PROJ = WS_B, WS_SCORES = WS_A;
constexpr size_t WS_X1S = WS_B + 192 * MiB;
constexpr size_t WS_EID = 479 * MiB, WS_GATE = 495 * MiB;
constexpr size_t WS_END = 511 * MiB;
static_assert(WS_SCORES + (size_t)MTOK * 2048 * 4 <= WS_X1S && WS_X1S + (size_t)MTOK * 1024 * 2 <= WS_EID && WS_GATE + (size_t)MTOK * 128 * 4 <= WS_END, "ws map");

constexpr int LDS_MAIN = 159744;
constexpr int MISC_OFF = LDS_MAIN;
constexpr int LDS_BYTES = LDS_MAIN + 128;

#define GAS __attribute__((address_space(1)))
#define LAS __attribute__((address_space(3)))
typedef unsigned short bf16;
typedef unsigned v4u __attribute__((ext_vector_type(4)));
typedef unsigned v2u __attribute__((ext_vector_type(2)));
typedef float f32x4 __attribute__((ext_vector_type(4)));
typedef float f32x2 __attribute__((ext_vector_type(2)));
typedef short bf16x8 __attribute__((ext_vector_type(8)));
#define LDS_WAIT() asm volatile("s_waitcnt lgkmcnt(0)" ::: "memory")
#define VM_WAIT() asm volatile("s_waitcnt vmcnt(0)" ::: "memory")
__device__ __forceinline__ unsigned f2bf(float f) { unsigned u = __builtin_bit_cast(unsigned, f); return (u + 0x7fffu + ((u >> 16) & 1u)) >> 16; }
__device__ __forceinline__ unsigned pk2(float lo, float hi) { return f2bf(lo) | (f2bf(hi) << 16); }
__device__ __forceinline__ float bflo(unsigned w) { return __builtin_bit_cast(float, w << 16); }
__device__ __forceinline__ float bfhi(unsigned w) { return __builtin_bit_cast(float, w & 0xffff0000u); }
__device__ __forceinline__ float bf2f(bf16 v) { return __builtin_bit_cast(float, (unsigned)v << 16); }
__device__ __forceinline__ float wave_sum(float v) {
#pragma unroll
    for (int o = 1; o < 64; o <<= 1) v += __shfl_xor(v, o);
    return v;
}
__device__ __forceinline__ float silu_f(float v) { return v / (1.0f + __expf(-v)); }
__device__ __forceinline__ float gelu_erf(float v) { return 0.5f * v * (1.0f + erff(v * 0.70710678118654752f)); }
__device__ __forceinline__ float softplus_f(float v) { return v > 20.f ? v : log1pf(__expf(v)); }
#define XB_TMO      128
#define XB_XCNT(j)  (256  + 64 * (j))
#define XB_XSUB(j)  (1280 + 64 * (j))
#define XB_XGEN(j)  (2304 + 64 * (j))
#define XB_TOP      3328
#define XB_TOPGEN   3392
#define XCD_BAR_WORDS 3456
#define XB_SPIN_CAP (1u << 18)

__device__ __forceinline__ unsigned xb_ld(unsigned* p)              { return __hip_atomic_load(p, __ATOMIC_RELAXED, __HIP_MEMORY_SCOPE_AGENT); }
__device__ __forceinline__ unsigned xb_add(unsigned* p, unsigned v) { return __hip_atomic_fetch_add(p, v, __ATOMIC_RELAXED, __HIP_MEMORY_SCOPE_AGENT); }
__device__ __forceinline__ unsigned xb_xcc_id() { return (unsigned)__builtin_amdgcn_s_getreg((3 << 11) | 20) & 0xFu; }
#define XB_SPIN(cond, bar) do { unsigned _sp = 0; while (cond) { __builtin_amdgcn_s_sleep(1); \
    if ((++_sp & 255u) == 0u) { if (xb_ld(&(bar)[XB_TMO])) break; if (_sp > XB_SPIN_CAP) { atomicAdd(&(bar)[XB_TMO], 1u); break; } } } } while (0)

struct XcdBarrier {
    unsigned* bar; unsigned x;
    volatile LAS unsigned* st;
};

__device__ __forceinline__ XcdBarrier xcd_barrier_post(unsigned* bar, volatile LAS unsigned* st) {
    XcdBarrier b; b.bar = bar; b.x = xb_xcc_id(); b.st = st;
    if (threadIdx.x == 0) (void)xb_add(&bar[XB_XCNT(b.x)], 1u);
    return b;
}
__device__ __forceinline__ void xcd_barrier_complete(unsigned* bar, unsigned x, unsigned& nloc, unsigned& nx) {
    const unsigned G = gridDim.x * gridDim.y * gridDim.z;
    unsigned sum, cnt, mine, sp = 0u;
    for (;;) {
        sum = 0u; cnt = 0u; mine = 0u;
#pragma unroll
        for (unsigned j = 0; j < 16; ++j) { const unsigned c = xb_ld(&bar[XB_XCNT(j)]); sum += c; cnt += (c > 0u) ? 1u : 0u; mine = (j == x) ? c : mine; }
        if (sum == G) break;
        __builtin_amdgcn_s_sleep(1);
        if ((++sp & 255u) == 0u) { if (xb_ld(&bar[XB_TMO])) break; if (sp > XB_SPIN_CAP) { atomicAdd(&bar[XB_TMO], 1u); break; } }
    }
    nloc = mine > 0u ? mine : 1u; nx = cnt > 0u ? cnt : 1u;
}

__device__ __forceinline__ void xcd_barrier(const XcdBarrier& b) {
    asm volatile("s_waitcnt vmcnt(0)" ::: "memory");
    __syncthreads();
    if (threadIdx.x == 0) {
        unsigned* bar = b.bar;
        __builtin_amdgcn_s_waitcnt(0);
        unsigned nloc = b.st[0], nx = b.st[1];
        if (nloc == 0u) { xcd_barrier_complete(bar, b.x, nloc, nx); b.st[0] = nloc; b.st[1] = nx; }
        const unsigned old = xb_add(&bar[XB_XSUB(b.x)], 1u);
        const unsigned gen = old / nloc;
        if (old + 1u == (gen + 1u) * nloc) {
            __builtin_amdgcn_fence(__ATOMIC_RELEASE, "agent");
            asm volatile("s_waitcnt vmcnt(0)" ::: "memory");
            const unsigned og = xb_add(&bar[XB_TOP], 1u);
            const unsigned tg = og / nx;
            if (og + 1u == (tg + 1u) * nx) xb_add(&bar[XB_TOPGEN], 1u);
            else XB_SPIN(xb_ld(&bar[XB_TOPGEN]) == tg, bar);
            __builtin_amdgcn_fence(__ATOMIC_ACQUIRE, "agent");
            xb_add(&bar[XB_XGEN(b.x)], 1u);
            asm volatile("s_waitcnt vmcnt(0)" ::: "memory");
        } else {
            XB_SPIN(xb_ld(&bar[XB_XGEN(b.x)]) == gen, bar);
            __builtin_amdgcn_fence(__ATOMIC_ACQUIRE, "agent");
            asm volatile("s_waitcnt vmcnt(0)" ::: "memory");
        }
    }
    __syncthreads();
}
struct Args { const float* in[30]; float* out; unsigned char* ws; int ph_lo, ph_hi; };
struct Frame {
    LAS unsigned char* lds;
    volatile LAS unsigned* MISC;
    int vcu, G;
    unsigned char* ws;
    const Args* a;
    float* out;
};
#define WSP(T, off) ((T*)(F.ws + (off)))

__device__ __forceinline__ void transpose_tile(const float* W, int ldw, int k0, int src_n0, bf16* WT, int K, int dst_n0, LAS float* scr, int lane, const float* kscale) {
#pragma unroll 8
    for (int i = 0; i < 32; ++i) { const int kk = 2 * i + (lane >> 5); float v = W[(size_t)(k0 + kk) * ldw + src_n0 + (lane & 31)]; if (kscale) v *= kscale[k0 + kk]; scr[kk * 33 + (lane & 31)] = v; }
    LDS_WAIT(); asm volatile("" ::: "memory");
    const int c = lane & 7;
#pragma unroll
    for (int j = 0; j < 4; ++j) { const int n = (lane >> 3) + 8 * j; const LAS float* s = scr + (8 * c) * 33 + n;
        v4u o; o.x = pk2(s[0 * 33], s[1 * 33]); o.y = pk2(s[2 * 33], s[3 * 33]); o.z = pk2(s[4 * 33], s[5 * 33]); o.w = pk2(s[6 * 33], s[7 * 33]);
        *(v4u*)(WT + (size_t)(dst_n0 + n) * K + k0 + 8 * c) = o; }
    LDS_WAIT(); asm volatile("" ::: "memory");
}
__device__ __forceinline__ void p0_phase(Frame& F) {
    const int f_tid = threadIdx.x, f_lane = f_tid & 63, f_wave = __builtin_amdgcn_readfirstlane(f_tid >> 6);
    const int gw = F.vcu * NWAVES + f_wave, NGW = F.G * NWAVES, gt = F.vcu * NTHR + f_tid, NGT = F.G * NTHR;
    if (F.vcu < 96) {
        LAS float* sc = (LAS float*)F.lds;
        LAS float* red = (LAS float*)(F.lds + 65536);
        for (int i = f_tid; i < 16 * 1024; i += NTHR) { const int b = i >> 10, k = i & 1023; sc[k * 16 + b] = silu_f((F.a->in[1])[i]); }
        __syncthreads();
        const int ks = f_tid >> 6, col = f_tid & 63, j = F.vcu * 64 + col;
        float acc[16];
#pragma unroll
        for (int b = 0; b < 16; ++b) acc[b] = 0.f;
        const float* wp = (F.a->in[2]) + (size_t)(ks * 128) * 6144 + j;
#pragma unroll 4
        for (int k = 0; k < 128; ++k) { const float w = wp[(size_t)k * 6144]; const LAS f32x4* s4 = (const LAS f32x4*)(sc + (ks * 128 + k) * 16);
#pragma unroll
            for (int q = 0; q < 4; ++q) { const f32x4 s = s4[q]; acc[4 * q] += s[0] * w; acc[4 * q + 1] += s[1] * w; acc[4 * q + 2] += s[2] * w; acc[4 * q + 3] += s[3] * w; } }
#pragma unroll
        for (int b = 0; b < 16; ++b) red[(ks * 16 + b) * 64 + col] = acc[b];
        __syncthreads();
        for (int i = f_tid; i < 16 * 64; i += NTHR) { const int b = i >> 6, cc = i & 63; float s = 0.f;
#pragma unroll
            for (int q = 0; q < 8; ++q) s += red[(q * 16 + b) * 64 + cc];
            WSP(float, WS_MOD)[b * 6144 + F.vcu * 64 + cc] = s + (F.a->in[3])[F.vcu * 64 + cc]; }
        __syncthreads();
    }
    {
        LAS float* scr = (LAS float*)(F.lds + f_wave * 16384);
        constexpr int I_IN = (1024 / 64) * (NPROJ / 32), I_OUT = (2048 / 64) * (1024 / 32);
        for (int it = gw; it < I_IN + I_OUT; it += NGW) {
            if (it < I_IN) { const int kb = it / (NPROJ / 32), nb = it % (NPROJ / 32); const int dn = 32 * nb, sn = dn < 3072 ? dn : dn + 16;
                transpose_tile((F.a->in[5]), INW, 64 * kb, sn, WSP(bf16, WS_WINT), 1024, dn, scr, f_lane, nullptr); }
            else { const int r = it - I_IN, kb = r / 32, nb = r % 32; const int k0 = 64 * kb;
                transpose_tile((F.a->in[23]), 1024, k0, 32 * nb, WSP(bf16, WS_WOUTT), 2048, 32 * nb, scr, f_lane, k0 < 1024 ? (F.a->in[11]) : (F.a->in[22]) - 1024); }
        }
    }
    for (int i = gt; i < 16 * 1024; i += NGT) { const int h = i >> 10, k = i & 1023; WSP(float, WS_WDT)[i] = (F.a->in[5])[(size_t)k * INW + 3072 + h]; }
    for (int task = gw; task < 2048; task += NGW) {
        const int nt = task >> 4, ks = task & 15, n0 = 16 * nt, hc = n0 >> 7, k0 = 64 * ks;
        const int li = f_lane & 15, lq = f_lane >> 4;
        f32x4 acc[4];
#pragma unroll
        for (int s = 0; s < 4; ++s) acc[s] = (f32x4){0.f, 0.f, 0.f, 0.f};
        const float* ap = (F.a->in[26]) + (size_t)(n0 + li) * 128 + 4 * lq;
        const float* bp = (F.a->in[25]) + (size_t)(k0 + li) * 2048 + hc * 128 + 4 * lq;
#pragma unroll
        for (int q = 0; q < 8; ++q) { const f32x4 a = *(const f32x4*)(ap + 16 * q);
#pragma unroll
            for (int s = 0; s < 4; ++s) { const f32x4 b = *(const f32x4*)(bp + (size_t)(16 * s) * 2048 + 16 * q);
#pragma unroll
                for (int jj = 0; jj < 4; ++jj) acc[s] = __builtin_amdgcn_mfma_f32_16x16x4f32(a[jj], b[jj], acc[s], 0, 0, 0); } }
        bf16* o = WSP(bf16, WS_WQKT);
#pragma unroll
        for (int s = 0; s < 4; ++s)
#pragma unroll
            for (int r = 0; r < 4; ++r) o[(size_t)(n0 + 4 * lq + r) * 1024 + k0 + 16 * s + li] = (bf16)f2bf(acc[s][r]);
    }
    for (int i = gt; i < 2 * 2097152; i += NGT) {
        const int tb = i >= 2097152; const int o = tb ? i - 2097152 : i; const float* src = (tb ? (F.a->in[28]) : (F.a->in[27])) + (size_t)o * 8;
        const f32x4 a = *(const f32x4*)src, b = *(const f32x4*)(src + 4);
        v4u w; w.x = pk2(a[0], a[1]); w.y = pk2(a[2], a[3]); w.z = pk2(b[0], b[1]); w.w = pk2(b[2], b[3]);
        *(v4u*)(WSP(bf16, tb ? WS_EV : WS_EU) + (size_t)o * 8) = w; }
    for (int i = gt; i < S5G * S5P; i += NGT) {
        const float lr = (F.a->in[12])[i], li = (F.a->in[13])[i], dt = expf((F.a->in[14])[i >> 6]);
        const float mag = expf(lr * dt); float sn, cs; sincosf(li * dt, &sn, &cs);
        const float lbr = mag * cs, lbi = mag * sn, den = lr * lr + li * li;
        const float cfr = ((lbr - 1.0f) * lr + lbi * li) / den, cfi = (lbi * lr - (lbr - 1.0f) * li) / den;
        WSP(float, WS_S5LB)[2 * i] = lbr; WSP(float, WS_S5LB)[2 * i + 1] = lbi;
        for (int hh = 0; hh < 16; ++hh) { const float br = (F.a->in[15])[i * 16 + hh], bi = (F.a->in[16])[i * 16 + hh];
            WSP(float, WS_S5BB)[i * 32 + hh] = cfr * br - cfi * bi; WSP(float, WS_S5BB)[i * 32 + 16 + hh] = cfr * bi + cfi * br; }
    }
    for (int i = gt; i < MTOK; i += NGT) WSP(float, WS_ROWSTAT)[i] = 0.f;
}

__device__ __forceinline__ void p1_phase(Frame& F) {
    const int f_tid = threadIdx.x, f_lane = f_tid & 63, f_wave = __builtin_amdgcn_readfirstlane(f_tid >> 6);
    const int gw = F.vcu * NWAVES + f_wave;
    LAS float* wdt = (LAS float*)F.lds;
    for (int i = f_tid; i < 16 * 1024 / 4; i += NTHR) ((LAS f32x4*)wdt)[i] = ((const f32x4*)WSP(float, WS_WDT))[i];
    __syncthreads();
    const int lane = f_lane;
    for (int wq = gw; wq < MTOK / 16; wq += F.G * NWAVES) {
        const int b = wq >> 7; const float* mb = WSP(float, WS_MOD) + (size_t)b * 6144;
        f32x4 Gv[4], Sv[4];
#pragma unroll
        for (int j = 0; j < 4; ++j) { const int k = 4 * lane + 256 * j; const f32x4 g = *(const f32x4*)((F.a->in[4]) + k), sc = *(const f32x4*)(mb + 1024 + k); Gv[j] = g * (sc + 1.0f); Sv[j] = *(const f32x4*)(mb + k); }
        for (int tt = 0; tt < 16; ++tt) {
            asm volatile("" ::: "memory");
            const size_t t = (size_t)wq * 16 + tt; const float* xr = (F.a->in[0]) + t * 1024;
            f32x4 v[4]; float ss = 0.f;
#pragma unroll
            for (int j = 0; j < 4; ++j) { v[j] = *(const f32x4*)(xr + 4 * lane + 256 * j); ss += (v[j][0] * v[j][0] + v[j][1] * v[j][1]) + (v[j][2] * v[j][2] + v[j][3] * v[j][3]); }
            const float rstd = 1.0f / sqrtf(wave_sum(ss) * (1.0f / 1024.0f) + EPSF);
            bf16* hr = WSP(bf16, WS_H1) + t * 1024;
#pragma unroll
            for (int j = 0; j < 4; ++j) { v[j] = v[j] * rstd * Gv[j] + Sv[j]; v2u w; w.x = pk2(v[j][0], v[j][1]); w.y = pk2(v[j][2], v[j][3]); *(v2u*)(hr + 4 * lane + 256 * j) = w; }
            float d[16];
#pragma unroll
            for (int h = 0; h < 16; ++h) { float a = 0.f;
#pragma unroll
                for (int j = 0; j < 4; ++j) { const f32x4 w = *(const LAS f32x4*)(wdt + h * 1024 + 4 * lane + 256 * j); a += (v[j][0] * w[0] + v[j][1] * w[1]) + (v[j][2] * w[2] + v[j][3] * w[3]); }
                d[h] = a; }
            float e8[8], e4[4], e2[2], e1;
#pragma unroll
            for (int i = 0; i < 8; ++i) { const bool up = lane & 32; const float snd = up ? d[i] : d[i + 8]; const float rcv = __shfl_xor(snd, 32); e8[i] = (up ? d[i + 8] : d[i]) + rcv; }
#pragma unroll
            for (int i = 0; i < 4; ++i) { const bool up = lane & 16; const float snd = up ? e8[i] : e8[i + 4]; const float rcv = __shfl_xor(snd, 16); e4[i] = (up ? e8[i + 4] : e8[i]) + rcv; }
#pragma unroll
            for (int i = 0; i < 2; ++i) { const bool up = lane & 8; const float snd = up ? e4[i] : e4[i + 2]; const float rcv = __shfl_xor(snd, 8); e2[i] = (up ? e4[i + 2] : e4[i]) + rcv; }
            { const bool up = lane & 4; const float snd = up ? e2[0] : e2[1]; const float rcv = __shfl_xor(snd, 4); e1 = (up ? e2[1] : e2[0]) + rcv; }
            e1 += __shfl_xor(e1, 2); e1 += __shfl_xor(e1, 1);
            const int head = ((lane >> 5) & 1) * 8 + ((lane >> 4) & 1) * 4 + ((lane >> 3) & 1) * 2 + ((lane >> 2) & 1);
            if ((lane & 3) == 0) WSP(float, WS_DTRAW)[t * 16 + head] = e1;
        }
    }
    for (int n = gw; n < 2048; n += F.G * NWAVES) {
        const bf16* wr = WSP(bf16, WS_WQKT) + (size_t)n * 1024 + 16 * lane;
        const v4u w0 = *(const v4u*)wr, w1 = *(const v4u*)(wr + 8);
        float wv[16]; wv[0] = bflo(w0.x); wv[1] = bfhi(w0.x); wv[2] = bflo(w0.y); wv[3] = bfhi(w0.y); wv[4] = bflo(w0.z); wv[5] = bfhi(w0.z); wv[6] = bflo(w0.w); wv[7] = bfhi(w0.w);
        wv[8] = bflo(w1.x); wv[9] = bfhi(w1.x); wv[10] = bflo(w1.y); wv[11] = bfhi(w1.y); wv[12] = bflo(w1.z); wv[13] = bfhi(w1.z); wv[14] = bflo(w1.w); wv[15] = bfhi(w1.w);
        for (int b = 0; b < 16; ++b) { const float* sp = WSP(float, WS_MOD) + (size_t)b * 6144 + 3072 + 16 * lane; float a = 0.f;
#pragma unroll
            for (int q = 0; q < 4; ++q) { const f32x4 s = *(const f32x4*)(sp + 4 * q); a += (s[0] * wv[4 * q] + s[1] * wv[4 * q + 1]) + (s[2] * wv[4 * q + 2] + s[3] * wv[4 * q + 3]); }
            a = wave_sum(a); if (lane == 0) WSP(float, WS_SB)[b * 2048 + n] = a; }
    }
}
__device__ __forceinline__ void p3_ssd_naive(Frame& F) {
    const int f_tid = threadIdx.x;
    const bf16* proj = WSP(bf16, WS_PROJ);
    LAS float* buf = (LAS float*)F.lds;
    LAS float* yl = (LAS float*)(F.lds + 4096);
    for (int item = F.vcu; item < NB * NGRP; item += F.G) {
        const int b = item >> 2, g = item & 3, tid = f_tid;
        const int ch = tid < 256 ? g * 256 + tid : (tid < 384 ? 1024 + g * 128 + (tid - 256) : 1536 + g * 128 + (tid - 384));
        const float w0 = (F.a->in[6])[0 * 2048 + ch], w1 = (F.a->in[6])[1 * 2048 + ch], w2 = (F.a->in[6])[2 * 2048 + ch], w3 = (F.a->in[6])[3 * 2048 + ch], cb = (F.a->in[7])[ch];
        float r0 = 0.f, r1 = 0.f, r2 = 0.f;
        const int r = tid >> 7, nh = (tid >> 6) & 1, p = tid & 63, h = g * 4 + r;
        float st[64];
#pragma unroll
        for (int n = 0; n < 64; ++n) st[n] = 0.f;
        const float A = -__expf((F.a->in[9])[h]), Dh = (F.a->in[10])[h], dtb = (F.a->in[8])[h];
        for (int t = 0; t < SEQ; ++t) {
            const size_t row = (size_t)b * SEQ + t;
            const float r3 = bf2f(proj[row * NPROJ + 1024 + ch]);
            const float cv = silu_f(cb + r0 * w0 + r1 * w1 + r2 * w2 + r3 * w3);
            r0 = r1; r1 = r2; r2 = r3;
            LAS float* cur = buf + (t & 1) * 512; LAS float* ycur = yl + (t & 1) * 512;
            cur[tid] = cv;
            __syncthreads();
            const float dt = softplus_f(WSP(float, WS_DTRAW)[row * 16 + h] + dtb);
            const float dA = __expf(dt * A), xv = cur[r * 64 + p], xd = xv * dt;
            float y = 0.f;
#pragma unroll
            for (int n4 = 0; n4 < 16; ++n4) { const f32x4 Bv = *(const LAS f32x4*)(cur + 256 + 64 * nh + 4 * n4), Cv = *(const LAS f32x4*)(cur + 384 + 64 * nh + 4 * n4);
#pragma unroll
                for (int q = 0; q < 4; ++q) { st[4 * n4 + q] = st[4 * n4 + q] * dA + xd * Bv[q]; y += Cv[q] * st[4 * n4 + q]; } }
            ycur[tid] = y;
            __syncthreads();
            if (nh == 0) {
                y = ycur[tid] + ycur[tid + 64] + Dh * xv;
                const float zv = bf2f(proj[row * NPROJ + h * 64 + p]);
                y *= silu_f(zv);
                WSP(bf16, WS_Y)[row * 2048 + h * 64 + p] = (bf16)f2bf(y);
                const float ss = wave_sum(y * y);
                if (p == 0) WSP(float, WS_STSSD)[row * 16 + h] = ss;
            }
        }
        __syncthreads();
    }
}
__device__ __forceinline__ void p3_s5_naive(Frame& F) {
    const int f_tid = threadIdx.x, f_lane = f_tid & 63, f_wave = __builtin_amdgcn_readfirstlane(f_tid >> 6);
    const bf16* proj = WSP(bf16, WS_PROJ);
    LAS float* xt = (LAS float*)(F.lds + 4096 + f_wave * 19200);
    LAS float* vt = (LAS float*)(F.lds + 4096 + f_wave * 19200 + 16896) + (f_lane & 31) * 17;
    const int lane = f_lane;
    for (int item = F.vcu * NWAVES + f_wave; item < NB * S5G; item += F.G * NWAVES) {
        const int b = item >> 6, g = item & 63, p = lane;
        const float lbr = WSP(float, WS_S5LB)[(g * 64 + p) * 2], lbi = WSP(float, WS_S5LB)[(g * 64 + p) * 2 + 1];
        float bbr[16], bbi[16];
#pragma unroll
        for (int q = 0; q < 4; ++q) { const f32x4 a = *(const f32x4*)(WSP(float, WS_S5BB) + (g * 64 + p) * 32 + 4 * q), c = *(const f32x4*)(WSP(float, WS_S5BB) + (g * 64 + p) * 32 + 16 + 4 * q);
#pragma unroll
            for (int e = 0; e < 4; ++e) { bbr[4 * q + e] = a[e]; bbi[4 * q + e] = c[e]; } }
        float xr = 0.f, xi = 0.f;
        for (int t0 = 0; t0 < SEQ; t0 += 32) {
            for (int tt = 0; tt < 32; ++tt) {
                const bf16* up = proj + ((size_t)b * SEQ + t0 + tt) * NPROJ + 3072 + g * 16;
                const v4u u0 = *(const v4u*)up, u1 = *(const v4u*)(up + 8);
                float uv[16]; uv[0] = bflo(u0.x); uv[1] = bfhi(u0.x); uv[2] = bflo(u0.y); uv[3] = bfhi(u0.y); uv[4] = bflo(u0.z); uv[5] = bfhi(u0.z); uv[6] = bflo(u0.w); uv[7] = bfhi(u0.w);
                uv[8] = bflo(u1.x); uv[9] = bfhi(u1.x); uv[10] = bflo(u1.y); uv[11] = bfhi(u1.y); uv[12] = bflo(u1.z); uv[13] = bfhi(u1.z); uv[14] = bflo(u1.w); uv[15] = bfhi(u1.w);
                float br = 0.f, bi = 0.f;
#pragma unroll
                for (int hh = 0; hh < 16; ++hh) { br += uv[hh] * bbr[hh]; bi += uv[hh] * bbi[hh]; }
                const float nr = lbr * xr - lbi * xi + br, ni = lbr * xi + lbi * xr + bi; xr = nr; xi = ni;
                xt[(tt * 66 + p) * 2] = xr; xt[(tt * 66 + p) * 2 + 1] = xi;
            }
            LDS_WAIT(); asm volatile("" ::: "memory");
            if (lane < 32) {
                const int tt = lane; const size_t row = (size_t)b * SEQ + t0 + tt;
                const bf16* up = proj + row * NPROJ + 3072 + g * 16;
#pragma unroll 1
                for (int hh = 0; hh < 16; ++hh) { float y = 0.f; const float* cr = (F.a->in[17]) + (g * 16 + hh) * 64; const float* ci = (F.a->in[18]) + (g * 16 + hh) * 64;
#pragma unroll 8
                    for (int pp = 0; pp < 64; ++pp) y += xt[(tt * 66 + pp) * 2] * cr[pp] - xt[(tt * 66 + pp) * 2 + 1] * ci[pp];
                    vt[hh] = gelu_erf(y + (F.a->in[19])[g * 16 + hh] * bf2f(up[hh])); }
                float ss = 0.f; unsigned ow[8];
#pragma unroll 1
                for (int k2 = 0; k2 < 8; ++k2) { float o2[2];
#pragma unroll
                    for (int e = 0; e < 2; ++e) { const int k = 2 * k2 + e; float gt = (F.a->in[21])[g * 16 + k];
#pragma unroll
                        for (int hh = 0; hh < 16; ++hh) gt += vt[hh] * (F.a->in[20])[(g * 16 + hh) * 16 + k];
                        o2[e] = vt[k] / (1.0f + __expf(-gt)); ss += o2[e] * o2[e]; }
                    const unsigned pw = pk2(o2[0], o2[1]);
#pragma unroll
                    for (int q = 0; q < 8; ++q) ow[q] = (q == k2) ? pw : ow[q]; }
                bf16* yo = WSP(bf16, WS_Y) + row * 2048 + 1024 + g * 16;
                *(v4u*)yo = (v4u){ow[0], ow[1], ow[2], ow[3]}; *(v4u*)(yo + 8) = (v4u){ow[4], ow[5], ow[6], ow[7]};
                WSP(float, WS_STS5)[row * NS5PART + g] = ss;
            }
            LDS_WAIT(); asm volatile("" ::: "memory");
        }
    }
}
__device__ __forceinline__ void p3c_normalize(Frame& F) {
    const int f_tid = threadIdx.x, f_lane = f_tid & 63, f_wave = __builtin_amdgcn_readfirstlane(f_tid >> 6);
    const int lane = f_lane;
    for (int t = F.vcu * NWAVES + f_wave; t < MTOK; t += F.G * NWAVES) {
        const float* sg = WSP(float, WS_STSSD) + (size_t)t * 16; const float* s5 = WSP(float, WS_STS5) + (size_t)t * NS5PART;
        float rg[4];
#pragma unroll
        for (int g = 0; g < 4; ++g) rg[g] = 1.0f / sqrtf((sg[4 * g] + sg[4 * g + 1] + sg[4 * g + 2] + sg[4 * g + 3]) * (1.0f / 256.0f) + EPSF);
        float s5s = (NS5PART == 64) ? s5[lane] : (lane < NS5PART ? s5[lane] : 0.f); s5s = wave_sum(s5s);
        const float r5 = 1.0f / sqrtf(s5s * (1.0f / 1024.0f) + EPSF);
        bf16* yr = WSP(bf16, WS_Y) + (size_t)t * 2048;
#pragma unroll
        for (int j = 0; j < 4; ++j) { const int e0 = 512 * j + 8 * lane; const float sc = j >= 2 ? r5 : (j == 0 ? (lane < 32 ? rg[0] : rg[1]) : (lane < 32 ? rg[2] : rg[3]));
            v4u w = *(v4u*)(yr + e0);
            w.x = pk2(bflo(w.x) * sc, bfhi(w.x) * sc); w.y = pk2(bflo(w.y) * sc, bfhi(w.y) * sc); w.z = pk2(bflo(w.z) * sc, bfhi(w.z) * sc); w.w = pk2(bflo(w.w) * sc, bfhi(w.w) * sc);
            *(v4u*)(yr + e0) = w; }
    }
}
__device__ __forceinline__ unsigned med3u(unsigned a, unsigned b, unsigned c) { unsigned r; asm("v_med3_u32 %0, %1, %2, %3" : "=v"(r) : "v"(a), "v"(b), "v"(c)); return r; }
__device__ __forceinline__ unsigned fkey(float v) { const unsigned u = __builtin_bit_cast(unsigned, v); return (u & 0x80000000u) ? ~u : (u | 0x80000000u); }
__device__ __forceinline__ float fkey_inv(unsigned k) { const unsigned u = (k & 0x80000000u) ? (k & 0x7fffffffu) : ~k; return __builtin_bit_cast(float, u); }
#define TOPK_INSERT(a, x) do { _Pragma("unroll") for (int _i = 15; _i >= 1; --_i) a[_i] = med3u(a[_i - 1], a[_i], (x)); a[0] = a[0] > (x) ? a[0] : (x); } while (0)
__device__ __forceinline__ void p5b_topk(Frame& F) {
    const int f_tid = threadIdx.x, f_lane = f_tid & 63, f_wave = __builtin_amdgcn_readfirstlane(f_tid >> 6);
    const float* scores = WSP(float, WS_SCORES);
    LAS unsigned char* ix = (LAS unsigned char*)F.lds + f_tid * 36;
    for (int item = F.vcu * NTHR + f_tid; item < MTOK * PH; item += F.G * NTHR) {
        const int t = item >> 3, hd = item & 7;
        unsigned a1[16], a2[16];
#pragma unroll
        for (int i = 0; i < 16; ++i) { a1[i] = 0u; a2[i] = 0u; }
        const float* sp = scores + (size_t)t * 2048 + hd * 256;
#pragma unroll 2
        for (int q = 0; q < 32; ++q) { const f32x4 s = *(const f32x4*)(sp + 4 * q);
#pragma unroll
            for (int e = 0; e < 4; ++e) { const unsigned k = (fkey(s[e]) & ~127u) | (unsigned)(127 - (4 * q + e)); TOPK_INSERT(a1, k); } }
#pragma unroll 2
        for (int q = 0; q < 32; ++q) { const f32x4 s = *(const f32x4*)(sp + 128 + 4 * q);
#pragma unroll
            for (int e = 0; e < 4; ++e) { const unsigned k = (fkey(s[e]) & ~127u) | (unsigned)(127 - (4 * q + e)); TOPK_INSERT(a2, k); } }
        float v1[16], v2[16];
#pragma unroll
        for (int i = 0; i < 16; ++i) { ix[i] = (unsigned char)(127u - (a1[i] & 127u)); ix[16 + i] = (unsigned char)(127u - (a2[i] & 127u)); v1[i] = fkey_inv(a1[i] & ~127u); v2[i] = fkey_inv(a2[i] & ~127u); }
        unsigned cb[16];
#pragma unroll
        for (int i = 0; i < 16; ++i) cb[i] = 0u;
#pragma unroll
        for (int i = 0; i < 16; ++i)
#pragma unroll
            for (int j = 0; j < 16; ++j) if ((i + 1) * (j + 1) <= 16) { const unsigned k = (fkey(v1[i] + v2[j]) & ~255u) | (unsigned)(255 - (i * 16 + j)); TOPK_INSERT(cb, k); }
        float tv[16]; float mx = -3.0e38f;
#pragma unroll
        for (int k = 0; k < 16; ++k) { tv[k] = fkey_inv(cb[k] & ~255u); mx = fmaxf(mx, tv[k]); }
        float sum = 0.f;
#pragma unroll
        for (int k = 0; k < 16; ++k) { tv[k] = __expf(tv[k] - mx); sum += tv[k]; }
        const float inv = 1.0f / sum;
        LDS_WAIT(); asm volatile("" ::: "memory");
        int* eo = WSP(int, WS_EID) + (size_t)t * 128 + hd * 16; float* go = WSP(float, WS_GATE) + (size_t)t * 128 + hd * 16;
#pragma unroll
        for (int k4 = 0; k4 < 4; ++k4) { int ev[4]; f32x4 gv;
#pragma unroll
            for (int e = 0; e < 4; ++e) { const int k = 4 * k4 + e; const unsigned code = 255u - (cb[k] & 255u); const int i = code >> 4, j = code & 15;
                ev[e] = (int)ix[i] * 128 + (int)ix[16 + j]; gv[e] = tv[k] * inv; }
            *(int4*)(eo + 4 * k4) = make_int4(ev[0], ev[1], ev[2], ev[3]); *(f32x4*)(go + 4 * k4) = gv; }
        LDS_WAIT(); asm volatile("" ::: "memory");
    }
}
__device__ __forceinline__ void unpack8(const v4u w, float* f) { f[0] = bflo(w.x); f[1] = bfhi(w.x); f[2] = bflo(w.y); f[3] = bfhi(w.y); f[4] = bflo(w.z); f[5] = bfhi(w.z); f[6] = bflo(w.w); f[7] = bfhi(w.w); }
__device__ __forceinline__ void p6_gather(Frame& F) {
    const int f_tid = threadIdx.x, f_lane = f_tid & 63, f_wave = __builtin_amdgcn_readfirstlane(f_tid >> 6);
    const int lane = f_lane;
    const bf16* EU = WSP(bf16, WS_EU); const bf16* EV = WSP(bf16, WS_EV);
    for (int wq = F.vcu * NWAVES + f_wave; wq < MTOK / 16; wq += F.G * NWAVES) {
        const int b = wq >> 7; const float* mb = WSP(float, WS_MOD) + (size_t)b * 6144;
        float G2[16], S2[16], GT[16], NF[16];
#pragma unroll
        for (int c = 0; c < 2; ++c)
#pragma unroll
            for (int q = 0; q < 2; ++q) { const int k = 512 * c + 8 * lane + 4 * q; const f32x4 g = *(const f32x4*)((F.a->in[24]) + k), sc = *(const f32x4*)(mb + 4096 + k), sh = *(const f32x4*)(mb + 3072 + k), gt = *(const f32x4*)(mb + 5120 + k), nf = *(const f32x4*)((F.a->in[29]) + k);
#pragma unroll
                for (int e = 0; e < 4; ++e) { G2[8 * c + 4 * q + e] = g[e] * (1.0f + sc[e]); S2[8 * c + 4 * q + e] = sh[e]; GT[8 * c + 4 * q + e] = gt[e]; NF[8 * c + 4 * q + e] = nf[e]; } }
        for (int tt = 0; tt < 16; ++tt) {
            const size_t t = (size_t)wq * 16 + tt; float* xr = F.out + t * 1024;
            float x1[16], h2[16], o[16];
#pragma unroll
            for (int c = 0; c < 2; ++c)
#pragma unroll
                for (int q = 0; q < 2; ++q) { const f32x4 v = *(const f32x4*)(xr + 512 * c + 8 * lane + 4 * q);
#pragma unroll
                    for (int e = 0; e < 4; ++e) x1[8 * c + 4 * q + e] = v[e]; }
            const float rs = 1.0f / sqrtf(WSP(float, WS_ROWSTAT)[t] * (1.0f / 1024.0f) + EPSF);
#pragma unroll
            for (int i = 0; i < 16; ++i) { h2[i] = x1[i] * rs * G2[i] + S2[i]; o[i] = 0.f; }
            const int e_lo = WSP(int, WS_EID)[t * 128 + lane], e_hi = WSP(int, WS_EID)[t * 128 + 64 + lane];
            const float g_lo = WSP(float, WS_GATE)[t * 128 + lane], g_hi = WSP(float, WS_GATE)[t * 128 + 64 + lane];
            for (int grp = 0; grp < 16; ++grp) {
                const int esel = grp < 8 ? e_lo : e_hi; const float gsel = grp < 8 ? g_lo : g_hi; const int base = (grp & 7) * 8;
                int eid[8]; float d[8];
#pragma unroll
                for (int j = 0; j < 8; ++j) { eid[j] = __shfl(esel, base + j);
                    const bf16* ur = EU + (size_t)eid[j] * 1024 + 8 * lane; const v4u w0 = *(const v4u*)ur, w1 = *(const v4u*)(ur + 512);
                    float f[16]; unpack8(w0, f); unpack8(w1, f + 8); float a = 0.f;
#pragma unroll
                    for (int i = 0; i < 16; ++i) a += h2[i] * f[i];
                    d[j] = a; }
                float e4[4], e2[2], e1;
#pragma unroll
                for (int i = 0; i < 4; ++i) { const bool up = lane & 32; const float snd = up ? d[i] : d[i + 4]; const float rcv = __shfl_xor(snd, 32); e4[i] = (up ? d[i + 4] : d[i]) + rcv; }
#pragma unroll
                for (int i = 0; i < 2; ++i) { const bool up = lane & 16; const float snd = up ? e4[i] : e4[i + 2]; const float rcv = __shfl_xor(snd, 16); e2[i] = (up ? e4[i + 2] : e4[i]) + rcv; }
                { const bool up = lane & 8; const float snd = up ? e2[0] : e2[1]; const float rcv = __shfl_xor(snd, 8); e1 = (up ? e2[1] : e2[0]) + rcv; }
                e1 += __shfl_xor(e1, 4); e1 += __shfl_xor(e1, 2); e1 += __shfl_xor(e1, 1);
                const int myj = ((lane >> 5) & 1) * 4 + ((lane >> 4) & 1) * 2 + ((lane >> 3) & 1);
                const float wmine = __shfl(gsel, base + myj) * gelu_erf(e1);
#pragma unroll
                for (int j = 0; j < 8; ++j) { const int src = ((j >> 2) & 1) * 32 + ((j >> 1) & 1) * 16 + (j & 1) * 8; const float wj = __shfl(wmine, src);
                    const bf16* vr = EV + (size_t)eid[j] * 1024 + 8 * lane; const v4u w0 = *(const v4u*)vr, w1 = *(const v4u*)(vr + 512);
                    float f[16]; unpack8(w0, f); unpack8(w1, f + 8);
#pragma unroll
                    for (int i = 0; i < 16; ++i) o[i] += wj * f[i]; }
            }
            float ss = 0.f;
#pragma unroll
            for (int i = 0; i < 16; ++i) { x1[i] += GT[i] * o[i]; ss += x1[i] * x1[i]; }
            const float rf = 1.0f / sqrtf(wave_sum(ss) * (1.0f / 1024.0f) + EPSF);
#pragma unroll
            for (int c = 0; c < 2; ++c)
#pragma unroll
                for (int q = 0; q < 2; ++q) { f32x4 v;
#pragma unroll
                    for (int e = 0; e < 4; ++e) v[e] = x1[8 * c + 4 * q + e] * rf * NF[8 * c + 4 * q + e];
                    *(f32x4*)(xr + 512 * c + 8 * lane + 4 * q) = v; }
        }
    }
}
constexpr int NPHASE = 9;
__global__ void __launch_bounds__(NTHR, 2) fwd_mega(Args args) {
    extern __shared__ __attribute__((aligned(16))) unsigned char lds[];
    Frame F;
    F.lds = (LAS unsigned char*)lds;
    F.MISC = (volatile LAS unsigned*)(F.lds + MISC_OFF);
    F.G = gridDim.x; { const int bx = blockIdx.x; F.vcu = (F.G % 8 == 0) ? (bx % 8) * (F.G / 8) + bx / 8 : bx; }
    F.ws = args.ws; F.out = args.out;
    F.a = &args;
    for (int u = threadIdx.x; u < 32; u += NTHR) F.MISC[u] = 0u;
    __syncthreads();
    const int lo = args.ph_lo, hi = args.ph_hi;
    const bool use_bar = (hi - lo) > 1;
    XcdBarrier bar; bar.bar = (unsigned*)(F.ws + WS_CTL); bar.x = 0; bar.st = nullptr;
    if (use_bar) bar = xcd_barrier_post((unsigned*)(F.ws + WS_CTL), F.MISC + 8);
#define IN(k) (lo <= (k) && (k) < hi)
#define SEAM(k) do { if (IN(k) && IN((k) + 1)) xcd_barrier(bar); } while (0)
    if (IN(0)) {
#ifndef SKIP_P0
 p0_phase(F);
#endif
 } SEAM(0);
    if (IN(1)) {
#ifndef SKIP_P1
 p1_phase(F);
#endif
 } SEAM(1);
    if (IN(2)) {
        pg8::Gemm g{WSP(bf16, WS_H1), WSP(bf16, WS_WINT), MTOK, NPROJ, 1024}; pg8::StaticOrder S; S.init(MTOK, NPROJ, F.G, (int)blockIdx.x);
        pg8::EpiProj E{WSP(bf16, WS_PROJ), NPROJ};
        pg8::gemm_phase<pg8::EpiProj, pg8::StaticOrder, true, true>(F.lds, g, S, E);
    } SEAM(2);
    if (IN(3)) {
#ifndef SKIP_SSD
 p3_ssd_naive(F);
#endif
#ifndef SKIP_S5
 p3_s5_naive(F);
#endif
 } SEAM(3);
    if (IN(4)) {
#ifndef SKIP_P3C
 p3c_normalize(F);
#endif
 } SEAM(4);
    if (IN(5)) {
        pg8::Gemm g{WSP(bf16, WS_Y), WSP(bf16, WS_WOUTT), MTOK, 1024, 2048}; pg8::StaticOrder S; S.init(MTOK, 1024, F.G, (int)blockIdx.x);
        pg8::EpiX1 E{(F.a->in[0]), F.out, WSP(bf16, WS_X1S), WSP(float, WS_MOD), (F.a->in[24]), WSP(float, WS_ROWSTAT)};
        pg8::gemm_phase<pg8::EpiX1, pg8::StaticOrder, true, true>(F.lds, g, S, E);
    } SEAM(5);
    if (IN(6)) {
        pg8::Gemm g{WSP(bf16, WS_X1S), WSP(bf16, WS_WQKT), MTOK, 2048, 1024}; pg8::StaticOrder S; S.init(MTOK, 2048, F.G, (int)blockIdx.x);
        pg8::EpiScores E{WSP(float, WS_SCORES), WSP(float, WS_SB), WSP(float, WS_ROWSTAT)};
        pg8::gemm_phase<pg8::EpiScores, pg8::StaticOrder, true, true>(F.lds, g, S, E);
    } SEAM(6);
    if (IN(7)) {
#ifndef SKIP_TOPK
 p5b_topk(F);
#endif
 } SEAM(7);
    if (IN(8)) {
#ifndef SKIP_GATHER
 p6_gather(F);
#endif
 }
#undef IN
#undef SEAM
}

#ifndef N_LAUNCHES
#define N_LAUNCHES 1
#endif
extern "C" void kernel_launch(void* const* d_in, const int* in_sizes, int n_in, void* d_out, int out_size, void* d_ws, size_t ws_size, hipStream_t stream) {
    static int grid = 0;
    if (grid == 0) {
        if (n_in != 30 || in_sizes[0] != MTOK * DM || out_size != MTOK * DM || ws_size < WS_END) { fprintf(stderr, "kernel_launch: unexpected shapes (n_in %d, in0 %d, out %d, ws %zu)\n", n_in, n_in > 0 ? in_sizes[0] : -1, out_size, ws_size); grid = -1; return; }
        int dev = 0, cus = 0, per_cu = 0;
        if (hipGetDevice(&dev) != hipSuccess || hipDeviceGetAttribute(&cus, hipDeviceAttributeMultiprocessorCount, dev) != hipSuccess) { grid = -1; return; }
        if (hipFuncSetAttribute((const void*)fwd_mega, hipFuncAttributeMaxDynamicSharedMemorySize, LDS_BYTES) != hipSuccess) { fprintf(stderr, "kernel_launch: hipFuncSetAttribute failed\n"); grid = -1; return; }
        if (hipOccupancyMaxActiveBlocksPerMultiprocessor(&per_cu, (const void*)fwd_mega, NTHR, LDS_BYTES) != hipSuccess || per_cu < 1) { fprintf(stderr, "kernel_launch: occupancy query says %d\n", per_cu); (void)hipGetLastError(); grid = -1; return; }
        grid = cus;
    }
    if (grid < 0) return;
    (void)hipMemsetAsync((char*)d_ws + WS_CTL, 0, CTL_ZERO_BYTES, stream);
    Args a{};
    for (int i = 0; i < 30; ++i) a.in[i] = (const float*)d_in[i];
    a.out = (float*)d_out; a.ws = (unsigned char*)d_ws;
    if (N_LAUNCHES == 1) {
        a.ph_lo = 0; a.ph_hi = NPHASE;
        void* kargs[] = {&a};
        hipError_t e = hipLaunchCooperativeKernel((const void*)fwd_mega, dim3(grid), dim3(NTHR), kargs, LDS_BYTES, stream);
        if (e != hipSuccess) fprintf(stderr, "kernel_launch: cooperative launch failed: %s (grid %d)\n", hipGetErrorString(e), grid);
    } else {
        for (int p = 0; p < NPHASE; ++p) { a.ph_lo = p; a.ph_hi = p + 1; hipLaunchKernelGGL(fwd_mega, dim3(grid), dim3(NTHR), LDS_BYTES, stream, a); }
    }
}
```

```cpp
#include <hip/hip_runtime.h>
#include <cstdio>
#include <cstdint>
namespace pg8 {
#define PG8_LAS __attribute__((address_space(3)))
typedef unsigned short bf16_t;
typedef short bf16x8 __attribute__((ext_vector_type(8)));
typedef float f32x4 __attribute__((ext_vector_type(4)));
typedef unsigned u32x4 __attribute__((ext_vector_type(4)));
constexpr int BM = 256, BK = 64, HALF = 128, HTB = HALF * BK * 2  , STAGE_BYTES = 8 * HTB, NXCD = 8, WGM = 8;

__host__ __device__ __forceinline__ int lds_byte(int r, int c) { const int st = (r >> 4) * 2 + (c >> 5), rr = r & 15, cc = c & 31, ob = rr * 64 + cc * 2; return st * 1024 + (ob ^ (((ob >> 9) & 1) << 5)); }
__host__ __device__ __forceinline__ void stage_rc(int b, int& R, int& C) { const int st = b / 1024, sb = b % 1024, swz = sb ^ (((sb >> 9) & 1) << 5); R = (st >> 1) * 16 + swz / 64; C = (st & 1) * 32 + (swz % 64) / 2; }
__host__ __device__ __forceinline__ int perm32(int rho) { const int n = rho >> 4, i = rho & 15; return 8 * (i >> 2) + 4 * n + (i & 3); }

struct Unit { int pm, pn; };
struct Gemm { const bf16_t* A; const bf16_t* Bt; int M, N, K; };

struct StaticOrder {
    int nM, nN, nwg, G, c;
    __host__ __device__ void init(int M, int N, int G_, int c_) { nM = M / BM; nN = N / BM; nwg = nM * nN; G = G_; c = c_; }
    __host__ __device__ bool next(int i, Unit& u) const {
        const long L = (long)i * G + c; if (L >= nwg) return false;
        int wgid = (int)L; { const int q = nwg / NXCD, r = nwg % NXCD, xcd = wgid % NXCD, off = wgid / NXCD; wgid = (xcd < r ? xcd * (q + 1) : r * (q + 1) + (xcd - r) * q) + off; }
        const int nig = WGM * nN, gid = wgid / nig, fm = gid * WGM, gsz = (nM - fm) < WGM ? (nM - fm) : WGM;
        u.pm = fm + ((wgid % nig) % gsz); u.pn = (wgid % nig) / gsz; return true;
    }
    __device__ __forceinline__ void a_ready(const Unit&) const {}
    __device__ __forceinline__ void done(const Unit&) const {}
};

__device__ __forceinline__ unsigned cvt_pk_bf16(float lo, float hi) { unsigned r; asm volatile("v_cvt_pk_bf16_f32 %0, %1, %2" : "=v"(r) : "v"(lo), "v"(hi)); return r; }
typedef float f32x2 __attribute__((ext_vector_type(2)));
template <class Epi, class Sched, bool ALIGN_EPI = false, bool SP2 = false>
__device__ __forceinline__ void gemm_phase(PG8_LAS unsigned char* lds, const Gemm g, const Sched& S, const Epi& E) {
    const int tid = threadIdx.x, wid = __builtin_amdgcn_readfirstlane(tid >> 6), lane = tid & 63, wr = wid >> 2, wc = wid & 3, fr = lane & 15, fq = lane >> 4;
    const int K = g.K, nt = K / BK;
    unsigned voffA[2], voffB[2];
#pragma unroll
    for (int i = 0; i < 2; ++i) { int R, C; stage_rc(tid * 16 + i * 8192, R, C); const int Rb = Epi::PERM ? ((R & ~31) + perm32(R & 31)) : R;
        voffA[i] = (unsigned)(R * K + C) * 2u; voffB[i] = (unsigned)(Rb * K + C) * 2u; }
    const size_t kstep = (size_t)(BK * 2);
    const size_t hstep = (size_t)HALF * K * 2;
    const size_t tstep = 2 * hstep;
    const unsigned ldsw = (unsigned)wid * 1024u;
    const int aoff = lds_byte(wr * 64 + fr, fq * 8), boff = lds_byte(wc * 32 + fr, fq * 8);
#define PG8_SA(b, h) (((b) * 2 + (h)) * HTB)
#define PG8_SB(b, h) ((4 + (b) * 2 + (h)) * HTB)
#define PG8_STAGE(bufoff, gbase, voff) do { _Pragma("unroll") for (int _i = 0; _i < 2; ++_i) \
        __builtin_amdgcn_global_load_lds((const unsigned*)((const char*)(gbase) + (voff)[_i]), (PG8_LAS unsigned*)(lds + (bufoff) + ldsw + _i * 8192), 16, 0, 0); } while (0)
#define PG8_LDA(dst, b, h) do { _Pragma("unroll") for (int m = 0; m < 4; ++m) _Pragma("unroll") for (int k = 0; k < 2; ++k) dst[m][k] = *(const PG8_LAS bf16x8*)(lds + PG8_SA(b, h) + aoff + m * 2048 + k * 1024); } while (0)
#define PG8_LDB(dst, b, h) do { _Pragma("unroll") for (int n = 0; n < 2; ++n) _Pragma("unroll") for (int k = 0; k < 2; ++k) dst[n][k] = *(const PG8_LAS bf16x8*)(lds + PG8_SB(b, h) + boff + n * 2048 + k * 1024); } while (0)
#define PG8_MMA(ai, bj, At, Bt) do { __builtin_amdgcn_s_setprio(1); _Pragma("unroll") for (int m = 0; m < 4; ++m) _Pragma("unroll") for (int n = 0; n < 2; ++n) _Pragma("unroll") for (int k = 0; k < 2; ++k) \
        acc[ai][bj][m][n] = __builtin_amdgcn_mfma_f32_16x16x32_bf16(Bt[n][k], At[m][k], acc[ai][bj][m][n], 0, 0, 0); __builtin_amdgcn_s_setprio(0); } while (0)
#define PG8_WAIT_V(n) asm volatile("s_waitcnt vmcnt(" #n ")" ::: "memory")
#define PG8_WAIT_L(n) asm volatile("s_waitcnt lgkmcnt(" #n ")" ::: "memory")
#define PG8_BAR __builtin_amdgcn_s_barrier()
#define PG8_SCHED __builtin_amdgcn_sched_barrier(0)
    Unit cur, nxt; int ui = 0;
    if (!S.next(0, cur)) return;
    f32x4 acc[2][2][4][2];
#pragma unroll
    for (int a = 0; a < 2; ++a)
#pragma unroll
        for (int b = 0; b < 2; ++b)
#pragma unroll
            for (int m = 0; m < 4; ++m)
#pragma unroll
                for (int n = 0; n < 2; ++n) acc[a][b][m][n] = (f32x4){0.f, 0.f, 0.f, 0.f};
    bf16x8 At[4][2], B0[2][2], B1[2][2];
    const char* cA = (const char*)g.A + (size_t)cur.pm * tstep; const char* cB = (const char*)g.Bt + (size_t)cur.pn * tstep;
    S.a_ready(cur);
    if constexpr (SP2) {
        PG8_STAGE(PG8_SB(0, 0), cB, voffB); PG8_STAGE(PG8_SB(0, 1), cB + hstep, voffB); PG8_STAGE(PG8_SA(0, 0), cA, voffA); PG8_STAGE(PG8_SA(0, 1), cA + hstep, voffA);
        if (wr == 1) PG8_BAR;
        PG8_WAIT_V(2); PG8_BAR;
        PG8_STAGE(PG8_SB(1, 0), cB + kstep, voffB); PG8_STAGE(PG8_SA(1, 0), cA + kstep, voffA); PG8_STAGE(PG8_SB(1, 1), cB + hstep + kstep, voffB);
        PG8_WAIT_V(6); PG8_BAR;
    } else {
        PG8_STAGE(PG8_SB(0, 0), cB, voffB); PG8_STAGE(PG8_SA(0, 0), cA, voffA); PG8_STAGE(PG8_SB(0, 1), cB + hstep, voffB); PG8_STAGE(PG8_SA(0, 1), cA + hstep, voffA);
        if (wr == 1) PG8_BAR;
        PG8_WAIT_V(4); PG8_BAR;
        PG8_STAGE(PG8_SB(1, 0), cB + kstep, voffB); PG8_STAGE(PG8_SA(1, 0), cA + kstep, voffA); PG8_STAGE(PG8_SB(1, 1), cB + hstep + kstep, voffB);
        PG8_WAIT_V(6); PG8_BAR;
    }
    for (;;) {
        const bool has_next = S.next(ui + 1, nxt);
        const char* nA = has_next ? (const char*)g.A + (size_t)nxt.pm * tstep : cA; const char* nB = has_next ? (const char*)g.Bt + (size_t)nxt.pn * tstep : cB;
        for (int t = 0; t < nt; t += 2) {
            const bool last = (t == nt - 2);
            const char* a1 = cA + (size_t)(t + 1) * kstep;
            const char* a2 = last ? nA : cA + (size_t)(t + 2) * kstep; const char* b2 = last ? nB : cB + (size_t)(t + 2) * kstep;
            const char* a3 = a2 + kstep; const char* b3 = b2 + kstep;
            if (last && has_next) S.a_ready(nxt);
            if constexpr (SP2) {
            PG8_LDB(B0, 0, 0); PG8_LDB(B1, 0, 1); PG8_SCHED; PG8_LDA(At, 0, 0); PG8_STAGE(PG8_SA(1, 1), a1 + hstep, voffA);
            PG8_WAIT_V(8); PG8_WAIT_L(0); PG8_BAR; PG8_MMA(0, 0, At, B0); PG8_MMA(0, 1, At, B1); PG8_BAR; PG8_SCHED;
            PG8_LDA(At, 0, 1); PG8_STAGE(PG8_SB(0, 0), b2, voffB); PG8_STAGE(PG8_SB(0, 1), b2 + hstep, voffB); PG8_STAGE(PG8_SA(0, 0), a2, voffA);
            PG8_WAIT_V(8); PG8_WAIT_L(0); PG8_BAR; PG8_MMA(1, 0, At, B0); PG8_MMA(1, 1, At, B1); PG8_BAR; PG8_SCHED;
            PG8_LDB(B0, 1, 0); PG8_LDB(B1, 1, 1); PG8_SCHED; PG8_LDA(At, 1, 0); PG8_STAGE(PG8_SA(0, 1), a2 + hstep, voffA);
            PG8_WAIT_V(8); PG8_WAIT_L(0); PG8_BAR; PG8_MMA(0, 0, At, B0); PG8_MMA(0, 1, At, B1); PG8_BAR; PG8_SCHED;
            PG8_LDA(At, 1, 1); PG8_STAGE(PG8_SB(1, 0), b3, voffB); PG8_STAGE(PG8_SB(1, 1), b3 + hstep, voffB); PG8_STAGE(PG8_SA(1, 0), a3, voffA);
            PG8_WAIT_V(8); PG8_WAIT_L(0); PG8_BAR; PG8_MMA(1, 0, At, B0); PG8_MMA(1, 1, At, B1); PG8_BAR; PG8_SCHED;
            } else {
            PG8_LDB(B0, 0, 0); PG8_SCHED; PG8_LDA(At, 0, 0); PG8_STAGE(PG8_SA(1, 1), a1 + hstep, voffA);
            PG8_WAIT_L(8); PG8_BAR; PG8_WAIT_L(0); PG8_MMA(0, 0, At, B0); PG8_BAR; PG8_SCHED;
            PG8_LDB(B1, 0, 1); PG8_STAGE(PG8_SB(0, 0), b2, voffB);
            PG8_BAR; PG8_WAIT_L(0); PG8_MMA(0, 1, At, B1); PG8_BAR;
            PG8_LDA(At, 0, 1); PG8_STAGE(PG8_SA(0, 0), a2, voffA);
            PG8_BAR; PG8_WAIT_L(0); PG8_MMA(1, 0, At, B0); PG8_BAR; PG8_SCHED;
            PG8_STAGE(PG8_SB(0, 1), b2 + hstep, voffB);
            PG8_WAIT_V(6); PG8_BAR; PG8_MMA(1, 1, At, B1); PG8_BAR;
            PG8_LDB(B0, 1, 0); PG8_SCHED; PG8_LDA(At, 1, 0); PG8_STAGE(PG8_SA(0, 1), a2 + hstep, voffA);
            PG8_WAIT_L(8); PG8_BAR; PG8_WAIT_L(0); PG8_MMA(0, 0, At, B0); PG8_BAR; PG8_SCHED;
            PG8_LDB(B1, 1, 1); PG8_STAGE(PG8_SB(1, 0), b3, voffB);
            PG8_BAR; PG8_WAIT_L(0); PG8_MMA(0, 1, At, B1); PG8_BAR;
            PG8_LDA(At, 1, 1); PG8_STAGE(PG8_SA(1, 0), a3, voffA);
            PG8_BAR; PG8_WAIT_L(0); PG8_MMA(1, 0, At, B0); PG8_BAR; PG8_SCHED;
            PG8_STAGE(PG8_SB(1, 1), b3 + hstep, voffB);
            PG8_WAIT_V(6); PG8_BAR; PG8_MMA(1, 1, At, B1); PG8_BAR;
            }
        }
        if constexpr (ALIGN_EPI) { if (wr == 0) PG8_BAR; }
        if constexpr (!Epi::AFTER_DRAIN) { E(acc, cur, wr, wc, fr, fq); S.done(cur); }
        if (!has_next) break;
#pragma unroll
        for (int a = 0; a < 2; ++a)
#pragma unroll
            for (int b = 0; b < 2; ++b)
#pragma unroll
                for (int m = 0; m < 4; ++m)
#pragma unroll
                    for (int n = 0; n < 2; ++n) acc[a][b][m][n] = (f32x4){0.f, 0.f, 0.f, 0.f};
        cur = nxt; cA = nA; cB = nB; ++ui;
        if constexpr (ALIGN_EPI) { if (wr == 1) PG8_BAR; }
    }
    PG8_WAIT_V(0);
    if constexpr (!ALIGN_EPI) { if (wr == 0) PG8_BAR; }
    PG8_BAR;
    if constexpr (Epi::AFTER_DRAIN) { E.fused(acc, cur, wr, wc, fr, fq, lds, wid, lane); S.done(cur); }
#undef PG8_SA
#undef PG8_SB
#undef PG8_STAGE
#undef PG8_LDA
#undef PG8_LDB
#undef PG8_MMA
#undef PG8_WAIT_V
#undef PG8_WAIT_L
#undef PG8_BAR
#undef PG8_SCHED
}
}
namespace pg8 {
struct EpiProj {
    static constexpr bool PERM = true, AFTER_DRAIN = false;
    bf16_t* O; int ldc;
    __device__ __forceinline__ void operator()(const f32x4 (&acc)[2][2][4][2], const Unit& u, int wr, int wc, int fr, int fq) const {
        const int row0 = u.pm * BM + wr * 64 + fr; const int col0 = u.pn * BM + wc * 32 + 8 * fq;
#pragma unroll
        for (int ai = 0; ai < 2; ++ai)
#pragma unroll
            for (int m = 0; m < 4; ++m) { bf16_t* rowp = O + (size_t)(row0 + ai * HALF + m * 16) * ldc + col0;
#pragma unroll
                for (int bj = 0; bj < 2; ++bj) { const f32x4 v0 = acc[ai][bj][m][0], v1 = acc[ai][bj][m][1];
                    u32x4 w; w.x = cvt_pk_bf16(v0[0], v0[1]); w.y = cvt_pk_bf16(v0[2], v0[3]); w.z = cvt_pk_bf16(v1[0], v1[1]); w.w = cvt_pk_bf16(v1[2], v1[3]);
                    *(u32x4*)(rowp + bj * HALF) = w; } }
    }
};
struct EpiX1 {
    static constexpr bool PERM = true, AFTER_DRAIN = false;
    const float* x; float* x1; bf16_t* x1s; const float* mod; const float* norm2_g; float* rowstat;
    __device__ __forceinline__ void operator()(const f32x4 (&acc)[2][2][4][2], const Unit& u, int wr, int wc, int fr, int fq) const {
        const int row0 = u.pm * BM + wr * 64 + fr; const int col0 = u.pn * BM + wc * 32 + 8 * fq; const int b = (u.pm * BM) >> 11;
        const float* mb = mod + (size_t)b * 6144;
        f32x4 g1[2][2], g2[2][2];
#pragma unroll
        for (int bj = 0; bj < 2; ++bj)
#pragma unroll
            for (int n = 0; n < 2; ++n) { const int c = col0 + bj * HALF + 4 * n; g1[bj][n] = *(const f32x4*)(mb + 2048 + c);
                const f32x4 sc = *(const f32x4*)(mb + 4096 + c), ng = *(const f32x4*)(norm2_g + c); g2[bj][n] = ng * (sc + 1.0f); }
#pragma unroll
        for (int ai = 0; ai < 2; ++ai)
#pragma unroll
            for (int m = 0; m < 4; ++m) { const size_t row = (size_t)(row0 + ai * HALF + m * 16); const size_t off = row * 1024 + col0; float ss = 0.f;
#pragma unroll
                for (int bj = 0; bj < 2; ++bj) {
                    const f32x4 xa = *(const f32x4*)(x + off + bj * HALF), xb = *(const f32x4*)(x + off + bj * HALF + 4);
                    const f32x4 v0 = xa + g1[bj][0] * acc[ai][bj][m][0], v1 = xb + g1[bj][1] * acc[ai][bj][m][1];
                    *(f32x4*)(x1 + off + bj * HALF) = v0; *(f32x4*)(x1 + off + bj * HALF + 4) = v1;
                    ss += (v0[0] * v0[0] + v0[1] * v0[1]) + (v0[2] * v0[2] + v0[3] * v0[3]) + (v1[0] * v1[0] + v1[1] * v1[1]) + (v1[2] * v1[2] + v1[3] * v1[3]);
                    const f32x4 s0 = v0 * g2[bj][0], s1 = v1 * g2[bj][1];
                    u32x4 w; w.x = cvt_pk_bf16(s0[0], s0[1]); w.y = cvt_pk_bf16(s0[2], s0[3]); w.z = cvt_pk_bf16(s1[0], s1[1]); w.w = cvt_pk_bf16(s1[2], s1[3]);
                    *(u32x4*)(x1s + off + bj * HALF) = w; }
                ss += __shfl_xor(ss, 16); ss += __shfl_xor(ss, 32);
                if (fq == 0) atomicAdd(rowstat + row, ss); }
    }
};
struct EpiScores {
    static constexpr bool PERM = true, AFTER_DRAIN = false;
    float* S; const float* sb; const float* rowstat;
    __device__ __forceinline__ void operator()(const f32x4 (&acc)[2][2][4][2], const Unit& u, int wr, int wc, int fr, int fq) const {
        const int row0 = u.pm * BM + wr * 64 + fr; const int col0 = u.pn * BM + wc * 32 + 8 * fq; const int b = (u.pm * BM) >> 11;
        f32x4 bv[2][2];
#pragma unroll
        for (int bj = 0; bj < 2; ++bj)
#pragma unroll
            for (int n = 0; n < 2; ++n) bv[bj][n] = *(const f32x4*)(sb + (size_t)b * 2048 + col0 + bj * HALF + 4 * n);
#pragma unroll
        for (int ai = 0; ai < 2; ++ai)
#pragma unroll
            for (int m = 0; m < 4; ++m) { const size_t row = (size_t)(row0 + ai * HALF + m * 16); const float rs = 1.0f / sqrtf(rowstat[row] * (1.0f / 1024.0f) + 1e-6f);
                float* rowp = S + row * 2048 + col0;
#pragma unroll
                for (int bj = 0; bj < 2; ++bj) { *(f32x4*)(rowp + bj * HALF) = acc[ai][bj][m][0] * rs + bv[bj][0]; *(f32x4*)(rowp + bj * HALF + 4) = acc[ai][bj][m][1] * rs + bv[bj][1]; } }
    }
};
}
constexpr int NWAVES = 8, NTHR = 512;
constexpr int DM = 1024, NB = 16, SEQ = 2048, MTOK = NB * SEQ;
constexpr int NPROJ = 4096;
constexpr int INW = 4112;
constexpr int NHEADS = 16, HDIM = 64, NGRP = 4, NST = 128, CHUNK = 128;
constexpr int S5G = 64, S5CH = 16, S5P = 64;
constexpr int PH = 8, PK = 16, PNK = 128;
constexpr float EPSF = 1e-6f;
constexpr int NS5PART = 64;

constexpr size_t MiB = 1u << 20;
constexpr size_t WS_CTL = 0, CTL_ZERO_BYTES = 64 * 1024;
constexpr size_t WS_MOD = 1 * MiB;
constexpr size_t WS_WDT = WS_MOD + 0x60000;
constexpr size_t WS_SB = WS_MOD + 0x70000;
constexpr size_t WS_ROWSTAT = WS_MOD + 0x90000;
constexpr size_t WS_S5LB = WS_MOD + 0xB0000;
constexpr size_t WS_S5BB = WS_MOD + 0xC0000;
constexpr size_t WS_DTRAW = 3 * MiB;
constexpr size_t WS_STSSD = 5 * MiB;
constexpr size_t WS_STS5 = 7 * MiB;
constexpr size_t WS_WINT = 15 * MiB;
constexpr size_t WS_WOUTT = 23 * MiB;
constexpr size_t WS_WQKT = 27 * MiB;
constexpr size_t WS_EU = 31 * MiB, WS_EV = 63 * MiB;
constexpr size_t WS_A = 95 * MiB;
constexpr size_t WS_B = 223 * MiB;
constexpr size_t WS_H1 = WS_A, WS_Y = WS_A, WS_PROJ = WS_B, WS_SCORES = WS_A;
constexpr size_t WS_X1S = WS_B + 192 * MiB;
constexpr size_t WS_EID = 479 * MiB, WS_GATE = 495 * MiB;
constexpr size_t WS_END = 511 * MiB;
static_assert(WS_SCORES + (size_t)MTOK * 2048 * 4 <= WS_X1S && WS_X1S + (size_t)MTOK * 1024 * 2 <= WS_EID && WS_GATE + (size_t)MTOK * 128 * 4 <= WS_END, "ws map");

constexpr int LDS_MAIN = 159744;
constexpr int MISC_OFF = LDS_MAIN;
constexpr int LDS_BYTES = LDS_MAIN + 128;

#define GAS __attribute__((address_space(1)))
#define LAS __attribute__((address_space(3)))
typedef unsigned short bf16;
typedef unsigned v4u __attribute__((ext_vector_type(4)));
typedef unsigned v2u __attribute__((ext_vector_type(2)));
typedef float f32x4 __attribute__((ext_vector_type(4)));
typedef float f32x2 __attribute__((ext_vector_type(2)));
typedef short bf16x8 __attribute__((ext_vector_type(8)));
#define LDS_WAIT() asm volatile("s_waitcnt lgkmcnt(0)" ::: "memory")
#define VM_WAIT() asm volatile("s_waitcnt vmcnt(0)" ::: "memory")
__device__ __forceinline__ unsigned f2bf(float f) { unsigned u = __builtin_bit_cast(unsigned, f); return (u + 0x7fffu + ((u >> 16) & 1u)) >> 16; }
__device__ __forceinline__ unsigned pk2(float lo, float hi) { return f2bf(lo) | (f2bf(hi) << 16); }
__device__ __forceinline__ float bflo(unsigned w) { return __builtin_bit_cast(float, w << 16); }
__device__ __forceinline__ float bfhi(unsigned w) { return __builtin_bit_cast(float, w & 0xffff0000u); }
__device__ __forceinline__ float bf2f(bf16 v) { return __builtin_bit_cast(float, (unsigned)v << 16); }
__device__ __forceinline__ float wave_sum(float v) {
#pragma unroll
    for (int o = 1; o < 64; o <<= 1) v += __shfl_xor(v, o);
    return v;
}
__device__ __forceinline__ float silu_f(float v) { return v / (1.0f + __expf(-v)); }
__device__ __forceinline__ float gelu_erf(float v) { return 0.5f * v * (1.0f + erff(v * 0.70710678118654752f)); }
__device__ __forceinline__ float softplus_f(float v) { return v > 20.f ? v : log1pf(__expf(v)); }
__device__ __forceinline__ void unpack8(const v4u w, float* f) { f[0] = bflo(w.x); f[1] = bfhi(w.x); f[2] = bflo(w.y); f[3] = bfhi(w.y); f[4] = bflo(w.z); f[5] = bfhi(w.z); f[6] = bflo(w.w); f[7] = bfhi(w.w); }
#define XB_TMO      128
#define XB_XCNT(j)  (256  + 64 * (j))
#define XB_XSUB(j)  (1280 + 64 * (j))
#define XB_XGEN(j)  (2304 + 64 * (j))
#define XB_TOP      3328
#define XB_TOPGEN   3392
#define XCD_BAR_WORDS 3456
#define XB_SPIN_CAP (1u << 18)

__device__ __forceinline__ unsigned xb_ld(unsigned* p)              { return __hip_atomic_load(p, __ATOMIC_RELAXED, __HIP_MEMORY_SCOPE_AGENT); }
__device__ __forceinline__ unsigned xb_add(unsigned* p, unsigned v) { return __hip_atomic_fetch_add(p, v, __ATOMIC_RELAXED, __HIP_MEMORY_SCOPE_AGENT); }
__device__ __forceinline__ unsigned xb_xcc_id() { return (unsigned)__builtin_amdgcn_s_getreg((3 << 11) | 20) & 0xFu; }
#define XB_SPIN(cond, bar) do { unsigned _sp = 0; while (cond) { __builtin_amdgcn_s_sleep(1); \
    if ((++_sp & 255u) == 0u) { if (xb_ld(&(bar)[XB_TMO])) break; if (_sp > XB_SPIN_CAP) { atomicAdd(&(bar)[XB_TMO], 1u); break; } } } } while (0)

struct XcdBarrier {
    unsigned* bar; unsigned x;
    volatile LAS unsigned* st;
};

__device__ __forceinline__ XcdBarrier xcd_barrier_post(unsigned* bar, volatile LAS unsigned* st) {
    XcdBarrier b; b.bar = bar; b.x = xb_xcc_id(); b.st = st;
    if (threadIdx.x == 0) (void)xb_add(&bar[XB_XCNT(b.x)], 1u);
    return b;
}
__device__ __forceinline__ void xcd_barrier_complete(unsigned* bar, unsigned x, unsigned& nloc, unsigned& nx) {
    const unsigned G = gridDim.x * gridDim.y * gridDim.z;
    unsigned sum, cnt, mine, sp = 0u;
    for (;;) {
        sum = 0u; cnt = 0u; mine = 0u;
#pragma unroll
        for (unsigned j = 0; j < 16; ++j) { const unsigned c = xb_ld(&bar[XB_XCNT(j)]); sum += c; cnt += (c > 0u) ? 1u : 0u; mine = (j == x) ? c : mine; }
        if (sum == G) break;
        __builtin_amdgcn_s_sleep(1);
        if ((++sp & 255u) == 0u) { if (xb_ld(&bar[XB_TMO])) break; if (sp > XB_SPIN_CAP) { atomicAdd(&bar[XB_TMO], 1u); break; } }
    }
    nloc = mine > 0u ? mine : 1u; nx = cnt > 0u ? cnt : 1u;
}

__device__ __forceinline__ void xcd_barrier(const XcdBarrier& b) {
    asm volatile("s_waitcnt vmcnt(0)" ::: "memory");
    __syncthreads();
    if (threadIdx.x == 0) {
        unsigned* bar = b.bar;
        __builtin_amdgcn_s_waitcnt(0);
        unsigned nloc = b.st[0], nx = b.st[1];
        if (nloc == 0u) { xcd_barrier_complete(bar, b.x, nloc, nx); b.st[0] = nloc; b.st[1] = nx; }
        const unsigned old = xb_add(&bar[XB_XSUB(b.x)], 1u);
        const unsigned gen = old / nloc;
        if (old + 1u == (gen + 1u) * nloc) {
            __builtin_amdgcn_fence(__ATOMIC_RELEASE, "agent");
            asm volatile("s_waitcnt vmcnt(0)" ::: "memory");
            const unsigned og = xb_add(&bar[XB_TOP], 1u);
            const unsigned tg = og / nx;
            if (og + 1u == (tg + 1u) * nx) xb_add(&bar[XB_TOPGEN], 1u);
            else XB_SPIN(xb_ld(&bar[XB_TOPGEN]) == tg, bar);
            __builtin_amdgcn_fence(__ATOMIC_ACQUIRE, "agent");
            xb_add(&bar[XB_XGEN(b.x)], 1u);
            asm volatile("s_waitcnt vmcnt(0)" ::: "memory");
        } else {
            XB_SPIN(xb_ld(&bar[XB_XGEN(b.x)]) == gen, bar);
            __builtin_amdgcn_fence(__ATOMIC_ACQUIRE, "agent");
            asm volatile("s_waitcnt vmcnt(0)" ::: "memory");
        }
    }
    __syncthreads();
}
struct Args { const float* in[30]; float* out; unsigned char* ws; int ph_lo, ph_hi; };
struct Frame {
    LAS unsigned char* lds;
    volatile LAS unsigned* MISC;
    int vcu, G;
    unsigned char* ws;
    const Args* a;
    float* out;
};
#define WSP(T, off) ((T*)(F.ws + (off)))

__device__ __forceinline__ void transpose_tile(const float* W, int ldw, int k0, int src_n0, bf16* WT, int K, int dst_n0, LAS float* scr, int lane, const float* kscale) {
#pragma unroll 8
    for (int i = 0; i < 32; ++i) { const int kk = 2 * i + (lane >> 5); float v = W[(size_t)(k0 + kk) * ldw + src_n0 + (lane & 31)]; if (kscale) v *= kscale[k0 + kk]; scr[kk * 33 + (lane & 31)] = v; }
    LDS_WAIT(); asm volatile("" ::: "memory");
    const int c = lane & 7;
#pragma unroll
    for (int j = 0; j < 4; ++j) { const int n = (lane >> 3) + 8 * j; const LAS float* s = scr + (8 * c) * 33 + n;
        v4u o; o.x = pk2(s[0 * 33], s[1 * 33]); o.y = pk2(s[2 * 33], s[3 * 33]); o.z = pk2(s[4 * 33], s[5 * 33]); o.w = pk2(s[6 * 33], s[7 * 33]);
        *(v4u*)(WT + (size_t)(dst_n0 + n) * K + k0 + 8 * c) = o; }
    LDS_WAIT(); asm volatile("" ::: "memory");
}
__device__ __forceinline__ void p0_phase(Frame& F) {
    const int f_tid = threadIdx.x, f_lane = f_tid & 63, f_wave = __builtin_amdgcn_readfirstlane(f_tid >> 6);
    const int gw = F.vcu * NWAVES + f_wave, NGW = F.G * NWAVES, gt = F.vcu * NTHR + f_tid, NGT = F.G * NTHR;
    if (F.vcu < 96) {
        LAS float* sc = (LAS float*)F.lds;
        LAS float* red = (LAS float*)(F.lds + 65536);
        for (int i = f_tid; i < 16 * 1024; i += NTHR) { const int b = i >> 10, k = i & 1023; sc[k * 16 + b] = silu_f((F.a->in[1])[i]); }
        __syncthreads();
        const int ks = f_tid >> 6, col = f_tid & 63, j = F.vcu * 64 + col;
        float acc[16];
#pragma unroll
        for (int b = 0; b < 16; ++b) acc[b] = 0.f;
        const float* wp = (F.a->in[2]) + (size_t)(ks * 128) * 6144 + j;
#pragma unroll 4
        for (int k = 0; k < 128; ++k) { const float w = wp[(size_t)k * 6144]; const LAS f32x4* s4 = (const LAS f32x4*)(sc + (ks * 128 + k) * 16);
#pragma unroll
            for (int q = 0; q < 4; ++q) { const f32x4 s = s4[q]; acc[4 * q] += s[0] * w; acc[4 * q + 1] += s[1] * w; acc[4 * q + 2] += s[2] * w; acc[4 * q + 3] += s[3] * w; } }
#pragma unroll
        for (int b = 0; b < 16; ++b) red[(ks * 16 + b) * 64 + col] = acc[b];
        __syncthreads();
        for (int i = f_tid; i < 16 * 64; i += NTHR) { const int b = i >> 6, cc = i & 63; float s = 0.f;
#pragma unroll
            for (int q = 0; q < 8; ++q) s += red[(q * 16 + b) * 64 + cc];
            WSP(float, WS_MOD)[b * 6144 + F.vcu * 64 + cc] = s + (F.a->in[3])[F.vcu * 64 + cc]; }
        __syncthreads();
    }
    {
        LAS float* scr = (LAS float*)(F.lds + f_wave * 16384);
        constexpr int I_IN = (1024 / 64) * (NPROJ / 32), I_OUT = (2048 / 64) * (1024 / 32);
        for (int it = gw; it < I_IN + I_OUT; it += NGW) {
            if (it < I_IN) { const int kb = it / (NPROJ / 32), nb = it % (NPROJ / 32); const int dn = 32 * nb, sn = dn < 3072 ? dn : dn + 16;
                transpose_tile((F.a->in[5]), INW, 64 * kb, sn, WSP(bf16, WS_WINT), 1024, dn, scr, f_lane, nullptr); }
            else { const int r = it - I_IN, kb = r / 32, nb = r % 32; const int k0 = 64 * kb;
                transpose_tile((F.a->in[23]), 1024, k0, 32 * nb, WSP(bf16, WS_WOUTT), 2048, 32 * nb, scr, f_lane, k0 < 1024 ? (F.a->in[11]) : (F.a->in[22]) - 1024); }
        }
    }
    for (int i = gt; i < 16 * 1024; i += NGT) { const int h = i >> 10, k = i & 1023; WSP(float, WS_WDT)[i] = (F.a->in[5])[(size_t)k * INW + 3072 + h]; }
    for (int task = gw; task < 2048; task += NGW) {
        const int nt = task >> 4, ks = task & 15, n0 = 16 * nt, hc = n0 >> 7, k0 = 64 * ks;
        const int li = f_lane & 15, lq = f_lane >> 4;
        f32x4 acc[4];
#pragma unroll
        for (int s = 0; s < 4; ++s) acc[s] = (f32x4){0.f, 0.f, 0.f, 0.f};
        const float* ap = (F.a->in[26]) + (size_t)(n0 + li) * 128 + 4 * lq;
        const float* bp = (F.a->in[25]) + (size_t)(k0 + li) * 2048 + hc * 128 + 4 * lq;
#pragma unroll
        for (int q = 0; q < 8; ++q) { const f32x4 a = *(const f32x4*)(ap + 16 * q);
#pragma unroll
            for (int s = 0; s < 4; ++s) { const f32x4 b = *(const f32x4*)(bp + (size_t)(16 * s) * 2048 + 16 * q);
#pragma unroll
                for (int jj = 0; jj < 4; ++jj) acc[s] = __builtin_amdgcn_mfma_f32_16x16x4f32(a[jj], b[jj], acc[s], 0, 0, 0); } }
        bf16* o = WSP(bf16, WS_WQKT);
#pragma unroll
        for (int s = 0; s < 4; ++s)
#pragma unroll
            for (int r = 0; r < 4; ++r) o[(size_t)(n0 + 4 * lq + r) * 1024 + k0 + 16 * s + li] = (bf16)f2bf(acc[s][r]);
    }
    for (int i = gt; i < 2 * 2097152; i += NGT) {
        const int tb = i >= 2097152; const int o = tb ? i - 2097152 : i; const float* src = (tb ? (F.a->in[28]) : (F.a->in[27])) + (size_t)o * 8;
        const f32x4 a = *(const f32x4*)src, b = *(const f32x4*)(src + 4);
        v4u w; w.x = pk2(a[0], a[1]); w.y = pk2(a[2], a[3]); w.z = pk2(b[0], b[1]); w.w = pk2(b[2], b[3]);
        *(v4u*)(WSP(bf16, tb ? WS_EV : WS_EU) + (size_t)o * 8) = w; }
    for (int i = gt; i < S5G * S5P; i += NGT) {
        const float lr = (F.a->in[12])[i], li = (F.a->in[13])[i], dt = expf((F.a->in[14])[i >> 6]);
        const float mag = expf(lr * dt); float sn, cs; sincosf(li * dt, &sn, &cs);
        const float lbr = mag * cs, lbi = mag * sn, den = lr * lr + li * li;
        const float cfr = ((lbr - 1.0f) * lr + lbi * li) / den, cfi = (lbi * lr - (lbr - 1.0f) * li) / den;
        WSP(float, WS_S5LB)[2 * i] = lbr; WSP(float, WS_S5LB)[2 * i + 1] = lbi;
        for (int hh = 0; hh < 16; ++hh) { const float br = (F.a->in[15])[i * 16 + hh], bi = (F.a->in[16])[i * 16 + hh];
            WSP(float, WS_S5BB)[i * 32 + hh] = cfr * br - cfi * bi; WSP(float, WS_S5BB)[i * 32 + 16 + hh] = cfr * bi + cfi * br; }
    }
    for (int i = gt; i < MTOK; i += NGT) WSP(float, WS_ROWSTAT)[i] = 0.f;
}

__device__ __forceinline__ void p1_phase(Frame& F) {
    const int f_tid = threadIdx.x, f_lane = f_tid & 63, f_wave = __builtin_amdgcn_readfirstlane(f_tid >> 6);
    const int gw = F.vcu * NWAVES + f_wave;
    LAS float* wdt = (LAS float*)F.lds;
    for (int i = f_tid; i < 16 * 1024 / 4; i += NTHR) ((LAS f32x4*)wdt)[i] = ((const f32x4*)WSP(float, WS_WDT))[i];
    __syncthreads();
    const int lane = f_lane;
    for (int wq = gw; wq < MTOK / 16; wq += F.G * NWAVES) {
        const int b = wq >> 7; const float* mb = WSP(float, WS_MOD) + (size_t)b * 6144;
        f32x4 Gv[4], Sv[4];
#pragma unroll
        for (int j = 0; j < 4; ++j) { const int k = 4 * lane + 256 * j; const f32x4 g = *(const f32x4*)((F.a->in[4]) + k), sc = *(const f32x4*)(mb + 1024 + k); Gv[j] = g * (sc + 1.0f); Sv[j] = *(const f32x4*)(mb + k); }
        for (int tt = 0; tt < 16; ++tt) {
            asm volatile("" ::: "memory");
            const size_t t = (size_t)wq * 16 + tt; const float* xr = (F.a->in[0]) + t * 1024;
            f32x4 v[4]; float ss = 0.f;
#pragma unroll
            for (int j = 0; j < 4; ++j) { v[j] = *(const f32x4*)(xr + 4 * lane + 256 * j); ss += (v[j][0] * v[j][0] + v[j][1] * v[j][1]) + (v[j][2] * v[j][2] + v[j][3] * v[j][3]); }
            const float rstd = 1.0f / sqrtf(wave_sum(ss) * (1.0f / 1024.0f) + EPSF);
            bf16* hr = WSP(bf16, WS_H1) + t * 1024;
#pragma unroll
            for (int j = 0; j < 4; ++j) { v[j] = v[j] * rstd * Gv[j] + Sv[j]; v2u w; w.x = pk2(v[j][0], v[j][1]); w.y = pk2(v[j][2], v[j][3]); *(v2u*)(hr + 4 * lane + 256 * j) = w; }
            float d[16];
#pragma unroll
            for (int h = 0; h < 16; ++h) { float a = 0.f;
#pragma unroll
                for (int j = 0; j < 4; ++j) { const f32x4 w = *(const LAS f32x4*)(wdt + h * 1024 + 4 * lane + 256 * j); a += (v[j][0] * w[0] + v[j][1] * w[1]) + (v[j][2] * w[2] + v[j][3] * w[3]); }
                d[h] = a; }
            float e8[8], e4[4], e2[2], e1;
#pragma unroll
            for (int i = 0; i < 8; ++i) { const bool up = lane & 32; const float snd = up ? d[i] : d[i + 8]; const float rcv = __shfl_xor(snd, 32); e8[i] = (up ? d[i + 8] : d[i]) + rcv; }
#pragma unroll
            for (int i = 0; i < 4; ++i) { const bool up = lane & 16; const float snd = up ? e8[i] : e8[i + 4]; const float rcv = __shfl_xor(snd, 16); e4[i] = (up ? e8[i + 4] : e8[i]) + rcv; }
#pragma unroll
            for (int i = 0; i < 2; ++i) { const bool up = lane & 8; const float snd = up ? e4[i] : e4[i + 2]; const float rcv = __shfl_xor(snd, 8); e2[i] = (up ? e4[i + 2] : e4[i]) + rcv; }
            { const bool up = lane & 4; const float snd = up ? e2[0] : e2[1]; const float rcv = __shfl_xor(snd, 4); e1 = (up ? e2[1] : e2[0]) + rcv; }
            e1 += __shfl_xor(e1, 2); e1 += __shfl_xor(e1, 1);
            const int head = ((lane >> 5) & 1) * 8 + ((lane >> 4) & 1) * 4 + ((lane >> 3) & 1) * 2 + ((lane >> 2) & 1);
            if ((lane & 3) == 0) WSP(float, WS_DTRAW)[t * 16 + head] = e1;
        }
    }
    for (int n = gw; n < 2048; n += F.G * NWAVES) {
        const bf16* wr = WSP(bf16, WS_WQKT) + (size_t)n * 1024 + 16 * lane;
        const v4u w0 = *(const v4u*)wr, w1 = *(const v4u*)(wr + 8);
        float wv[16]; wv[0] = bflo(w0.x); wv[1] = bfhi(w0.x); wv[2] = bflo(w0.y); wv[3] = bfhi(w0.y); wv[4] = bflo(w0.z); wv[5] = bfhi(w0.z); wv[6] = bflo(w0.w); wv[7] = bfhi(w0.w);
        wv[8] = bflo(w1.x); wv[9] = bfhi(w1.x); wv[10] = bflo(w1.y); wv[11] = bfhi(w1.y); wv[12] = bflo(w1.z); wv[13] = bfhi(w1.z); wv[14] = bflo(w1.w); wv[15] = bfhi(w1.w);
        for (int b = 0; b < 16; ++b) { const float* sp = WSP(float, WS_MOD) + (size_t)b * 6144 + 3072 + 16 * lane; float a = 0.f;
#pragma unroll
            for (int q = 0; q < 4; ++q) { const f32x4 s = *(const f32x4*)(sp + 4 * q); a += (s[0] * wv[4 * q] + s[1] * wv[4 * q + 1]) + (s[2] * wv[4 * q + 2] + s[3] * wv[4 * q + 3]); }
            a = wave_sum(a); if (lane == 0) WSP(float, WS_SB)[b * 2048 + n] = a; }
    }
}
__device__ __forceinline__ void p3_ssd_naive(Frame& F) {
    const int f_tid = threadIdx.x;
    const bf16* proj = WSP(bf16, WS_PROJ);
    LAS float* buf = (LAS float*)F.lds;
    LAS float* yl = (LAS float*)(F.lds + 4096);
    for (int item = F.vcu; item < NB * NGRP; item += F.G) {
        const int b = item >> 2, g = item & 3, tid = f_tid;
        const int ch = tid < 256 ? g * 256 + tid : (tid < 384 ? 1024 + g * 128 + (tid - 256) : 1536 + g * 128 + (tid - 384));
        const float w0 = (F.a->in[6])[0 * 2048 + ch], w1 = (F.a->in[6])[1 * 2048 + ch], w2 = (F.a->in[6])[2 * 2048 + ch], w3 = (F.a->in[6])[3 * 2048 + ch], cb = (F.a->in[7])[ch];
        float r0 = 0.f, r1 = 0.f, r2 = 0.f;
        const int r = tid >> 7, nh = (tid >> 6) & 1, p = tid & 63, h = g * 4 + r;
        float st[64];
#pragma unroll
        for (int n = 0; n < 64; ++n) st[n] = 0.f;
        const float A = -__expf((F.a->in[9])[h]), Dh = (F.a->in[10])[h], dtb = (F.a->in[8])[h];
        for (int t = 0; t < SEQ; ++t) {
            const size_t row = (size_t)b * SEQ + t;
            const float r3 = bf2f(proj[row * NPROJ + 1024 + ch]);
            const float cv = silu_f(cb + r0 * w0 + r1 * w1 + r2 * w2 + r3 * w3);
            r0 = r1; r1 = r2; r2 = r3;
            LAS float* cur = buf + (t & 1) * 512; LAS float* ycur = yl + (t & 1) * 512;
            cur[tid] = cv;
            __syncthreads();
            const float dt = softplus_f(WSP(float, WS_DTRAW)[row * 16 + h] + dtb);
            const float dA = __expf(dt * A), xv = cur[r * 64 + p], xd = xv * dt;
            float y = 0.f;
#pragma unroll
            for (int n4 = 0; n4 < 16; ++n4) { const f32x4 Bv = *(const LAS f32x4*)(cur + 256 + 64 * nh + 4 * n4), Cv = *(const LAS f32x4*)(cur + 384 + 64 * nh + 4 * n4);
#pragma unroll
                for (int q = 0; q < 4; ++q) { st[4 * n4 + q] = st[4 * n4 + q] * dA + xd * Bv[q]; y += Cv[q] * st[4 * n4 + q]; } }
            ycur[tid] = y;
            __syncthreads();
            if (nh == 0) {
                y = ycur[tid] + ycur[tid + 64] + Dh * xv;
                const float zv = bf2f(proj[row * NPROJ + h * 64 + p]);
                y *= silu_f(zv);
                WSP(bf16, WS_Y)[row * 2048 + h * 64 + p] = (bf16)f2bf(y);
                const float ss = wave_sum(y * y);
                if (p == 0) WSP(float, WS_STSSD)[row * 16 + h] = ss;
            }
        }
        __syncthreads();
    }
}
__device__ __forceinline__ void p3_s5_naive(Frame& F) {
    const int f_tid = threadIdx.x, f_lane = f_tid & 63, f_wave = __builtin_amdgcn_readfirstlane(f_tid >> 6);
    const bf16* proj = WSP(bf16, WS_PROJ);
    LAS float* xt = (LAS float*)(F.lds + 4096 + f_wave * 19200);
    LAS float* vt = (LAS float*)(F.lds + 4096 + f_wave * 19200 + 16896) + (f_lane & 31) * 17;
    const int lane = f_lane;
    for (int item = F.vcu * NWAVES + f_wave; item < NB * S5G; item += F.G * NWAVES) {
        const int b = item >> 6, g = item & 63, p = lane;
        const float lbr = WSP(float, WS_S5LB)[(g * 64 + p) * 2], lbi = WSP(float, WS_S5LB)[(g * 64 + p) * 2 + 1];
        float bbr[16], bbi[16];
#pragma unroll
        for (int q = 0; q < 4; ++q) { const f32x4 a = *(const f32x4*)(WSP(float, WS_S5BB) + (g * 64 + p) * 32 + 4 * q), c = *(const f32x4*)(WSP(float, WS_S5BB) + (g * 64 + p) * 32 + 16 + 4 * q);
#pragma unroll
            for (int e = 0; e < 4; ++e) { bbr[4 * q + e] = a[e]; bbi[4 * q + e] = c[e]; } }
        float xr = 0.f, xi = 0.f;
        for (int t0 = 0; t0 < SEQ; t0 += 32) {
            for (int tt = 0; tt < 32; ++tt) {
                const bf16* up = proj + ((size_t)b * SEQ + t0 + tt) * NPROJ + 3072 + g * 16;
                const v4u u0 = *(const v4u*)up, u1 = *(const v4u*)(up + 8);
                float uv[16]; uv[0] = bflo(u0.x); uv[1] = bfhi(u0.x); uv[2] = bflo(u0.y); uv[3] = bfhi(u0.y); uv[4] = bflo(u0.z); uv[5] = bfhi(u0.z); uv[6] = bflo(u0.w); uv[7] = bfhi(u0.w);
                uv[8] = bflo(u1.x); uv[9] = bfhi(u1.x); uv[10] = bflo(u1.y); uv[11] = bfhi(u1.y); uv[12] = bflo(u1.z); uv[13] = bfhi(u1.z); uv[14] = bflo(u1.w); uv[15] = bfhi(u1.w);
                float br = 0.f, bi = 0.f;
#pragma unroll
                for (int hh = 0; hh < 16; ++hh) { br += uv[hh] * bbr[hh]; bi += uv[hh] * bbi[hh]; }
                const float nr = lbr * xr - lbi * xi + br, ni = lbr * xi + lbi * xr + bi; xr = nr; xi = ni;
                xt[(tt * 66 + p) * 2] = xr; xt[(tt * 66 + p) * 2 + 1] = xi;
            }
            LDS_WAIT(); asm volatile("" ::: "memory");
            if (lane < 32) {
                const int tt = lane; const size_t row = (size_t)b * SEQ + t0 + tt;
                const bf16* up = proj + row * NPROJ + 3072 + g * 16;
#pragma unroll 1
                for (int hh = 0; hh < 16; ++hh) { float y = 0.f; const float* cr = (F.a->in[17]) + (g * 16 + hh) * 64; const float* ci = (F.a->in[18]) + (g * 16 + hh) * 64;
#pragma unroll 8
                    for (int pp = 0; pp < 64; ++pp) y += xt[(tt * 66 + pp) * 2] * cr[pp] - xt[(tt * 66 + pp) * 2 + 1] * ci[pp];
                    vt[hh] = gelu_erf(y + (F.a->in[19])[g * 16 + hh] * bf2f(up[hh])); }
                float ss = 0.f; unsigned ow[8];
#pragma unroll 1
                for (int k2 = 0; k2 < 8; ++k2) { float o2[2];
#pragma unroll
                    for (int e = 0; e < 2; ++e) { const int k = 2 * k2 + e; float gt = (F.a->in[21])[g * 16 + k];
#pragma unroll
                        for (int hh = 0; hh < 16; ++hh) gt += vt[hh] * (F.a->in[20])[(g * 16 + hh) * 16 + k];
                        o2[e] = vt[k] / (1.0f + __expf(-gt)); ss += o2[e] * o2[e]; }
                    const unsigned pw = pk2(o2[0], o2[1]);
#pragma unroll
                    for (int q = 0; q < 8; ++q) ow[q] = (q == k2) ? pw : ow[q]; }
                bf16* yo = WSP(bf16, WS_Y) + row * 2048 + 1024 + g * 16;
                *(v4u*)yo = (v4u){ow[0], ow[1], ow[2], ow[3]}; *(v4u*)(yo + 8) = (v4u){ow[4], ow[5], ow[6], ow[7]};
                WSP(float, WS_STS5)[row * NS5PART + g] = ss;
            }
            LDS_WAIT(); asm volatile("" ::: "memory");
        }
    }
}
__device__ __forceinline__ void p3c_normalize(Frame& F) {
    const int f_tid = threadIdx.x, f_lane = f_tid & 63, f_wave = __builtin_amdgcn_readfirstlane(f_tid >> 6);
    const int lane = f_lane;
    for (int t = F.vcu * NWAVES + f_wave; t < MTOK; t += F.G * NWAVES) {
        const float* sg = WSP(float, WS_STSSD) + (size_t)t * 16; const float* s5 = WSP(float, WS_STS5) + (size_t)t * NS5PART;
        float rg[4];
#pragma unroll
        for (int g = 0; g < 4; ++g) rg[g] = 1.0f / sqrtf((sg[4 * g] + sg[4 * g + 1] + sg[4 * g + 2] + sg[4 * g + 3]) * (1.0f / 256.0f) + EPSF);
        float s5s = (NS5PART == 64) ? s5[lane] : (lane < NS5PART ? s5[lane] : 0.f); s5s = wave_sum(s5s);
        const float r5 = 1.0f / sqrtf(s5s * (1.0f / 1024.0f) + EPSF);
        bf16* yr = WSP(bf16, WS_Y) + (size_t)t * 2048;
#pragma unroll
        for (int j = 0; j < 4; ++j) { const int e0 = 512 * j + 8 * lane; const float sc = j >= 2 ? r5 : (j == 0 ? (lane < 32 ? rg[0] : rg[1]) : (lane < 32 ? rg[2] : rg[3]));
            v4u w = *(v4u*)(yr + e0);
            w.x = pk2(bflo(w.x) * sc, bfhi(w.x) * sc); w.y = pk2(bflo(w.y) * sc, bfhi(w.y) * sc); w.z = pk2(bflo(w.z) * sc, bfhi(w.z) * sc); w.w = pk2(bflo(w.w) * sc, bfhi(w.w) * sc);
            *(v4u*)(yr + e0) = w; }
    }
}
constexpr int SSD_CS = 0, SSD_BS = 34816, SSD_BWT = 69632, SSD_XDT = 104448, SSD_PREV = 121856, SSD_XS = 139264, SSD_CSF = 157696, SSD_DTF = 158208, SSD_PITCH = 272, SSD_XPITCH = 144;
static_assert(SSD_DTF + 512 <= LDS_MAIN, "SSD LDS map");
__device__ __forceinline__ bf16x8 lds_frag(LAS unsigned char* base, int row, int kbyte) { return *(const LAS bf16x8*)(base + row * SSD_PITCH + kbyte); }
__device__ __forceinline__ void p3_ssd(Frame& F) {
    const int tid = threadIdx.x, lane = tid & 63, w = __builtin_amdgcn_readfirstlane(tid >> 6);
    const int li = lane & 15, lq = lane >> 4;
    LAS unsigned char* L = F.lds;
    LAS float* csf = (LAS float*)(L + SSD_CSF); LAS float* dtf = (LAS float*)(L + SSD_DTF);
    const bf16* proj = WSP(bf16, WS_PROJ);
    for (int item = F.vcu; item < NB * NHEADS; item += F.G) {
        const int b = item >> 4, h = item & 15, g = h >> 2;
        const float A = -__expf((F.a->in[9])[h]), Dh = (F.a->in[10])[h], dtb = (F.a->in[8])[h];
        const int pbs = w >> 1, nb0 = 4 * (w & 1);
        f32x4 st[4];
#pragma unroll
        for (int j = 0; j < 4; ++j) st[j] = (f32x4){0.f, 0.f, 0.f, 0.f};
        for (int i = tid; i < 17408 / 16; i += NTHR) ((LAS v4u*)(L + SSD_PREV))[i] = (v4u){0u, 0u, 0u, 0u};
        for (int c = 0; c < SEQ / CHUNK; ++c) {
            const size_t row0 = (size_t)b * SEQ + (size_t)c * CHUNK;
            if (w == 0) {
                const float d0 = softplus_f(WSP(float, WS_DTRAW)[(row0 + 2 * lane) * 16 + h] + dtb), d1 = softplus_f(WSP(float, WS_DTRAW)[(row0 + 2 * lane + 1) * 16 + h] + dtb);
                const float a0 = d0 * A, a1 = d1 * A; float s = a0 + a1;
#pragma unroll
                for (int o = 1; o < 64; o <<= 1) { const float t = __shfl_up(s, o); if (lane >= o) s += t; }
                dtf[2 * lane] = d0; dtf[2 * lane + 1] = d1; csf[2 * lane] = s - a1; csf[2 * lane + 1] = s;
            }
            __syncthreads();
            const float cs_end = csf[127];
            for (int it = tid; it < 1280; it += NTHR) {
                const int o = it % 40, rg = it / 40, l0 = 4 * rg;
                const int xcol = o < 8 ? h * 64 + 8 * o : (o < 24 ? 1024 + g * 128 + 8 * (o - 8) : 1536 + g * 128 + 8 * (o - 24));
                float raw[7][8];
#pragma unroll
                for (int k = 0; k < 7; ++k) { const int l = l0 - 3 + k; const bool ok = (c > 0) || (l >= 0);
                    v4u wv = (v4u){0u, 0u, 0u, 0u}; if (ok) wv = *(const v4u*)(proj + (size_t)((long)row0 + l) * NPROJ + 1024 + xcol);
                    raw[k][0] = bflo(wv.x); raw[k][1] = bfhi(wv.x); raw[k][2] = bflo(wv.y); raw[k][3] = bfhi(wv.y); raw[k][4] = bflo(wv.z); raw[k][5] = bfhi(wv.z); raw[k][6] = bflo(wv.w); raw[k][7] = bfhi(wv.w); }
                float cw[4][8], cbv[8];
#pragma unroll
                for (int k = 0; k < 4; ++k) { const f32x4 w0 = *(const f32x4*)((F.a->in[6]) + k * 2048 + xcol), w1 = *(const f32x4*)((F.a->in[6]) + k * 2048 + xcol + 4);
#pragma unroll
                    for (int e = 0; e < 4; ++e) { cw[k][e] = w0[e]; cw[k][4 + e] = w1[e]; } }
                { const f32x4 b0 = *(const f32x4*)((F.a->in[7]) + xcol), b1 = *(const f32x4*)((F.a->in[7]) + xcol + 4);
#pragma unroll
                    for (int e = 0; e < 4; ++e) { cbv[e] = b0[e]; cbv[4 + e] = b1[e]; } }
                float v[4][8];
#pragma unroll
                for (int r = 0; r < 4; ++r)
#pragma unroll
                    for (int i = 0; i < 8; ++i) v[r][i] = silu_f(cbv[i] + raw[r][i] * cw[0][i] + raw[r + 1][i] * cw[1][i] + raw[r + 2][i] * cw[2][i] + raw[r + 3][i] * cw[3][i]);
                if (o < 8) {
                    const int p0 = 8 * o;
#pragma unroll
                    for (int r = 0; r < 4; ++r) *(LAS v4u*)(L + SSD_XS + (l0 + r) * SSD_XPITCH + p0 * 2) = (v4u){pk2(v[r][0], v[r][1]), pk2(v[r][2], v[r][3]), pk2(v[r][4], v[r][5]), pk2(v[r][6], v[r][7])};
                    const float t0 = dtf[l0], t1 = dtf[l0 + 1], t2 = dtf[l0 + 2], t3 = dtf[l0 + 3];
#pragma unroll
                    for (int i = 0; i < 8; ++i) *(LAS v2u*)(L + SSD_XDT + (p0 + i) * SSD_PITCH + l0 * 2) = (v2u){pk2(v[0][i] * t0, v[1][i] * t1), pk2(v[2][i] * t2, v[3][i] * t3)};
                } else if (o < 24) {
                    const int n0 = 8 * (o - 8);
#pragma unroll
                    for (int r = 0; r < 4; ++r) *(LAS v4u*)(L + SSD_BS + (l0 + r) * SSD_PITCH + n0 * 2) = (v4u){pk2(v[r][0], v[r][1]), pk2(v[r][2], v[r][3]), pk2(v[r][4], v[r][5]), pk2(v[r][6], v[r][7])};
                    const float t0 = __expf(cs_end - csf[l0]), t1 = __expf(cs_end - csf[l0 + 1]), t2 = __expf(cs_end - csf[l0 + 2]), t3 = __expf(cs_end - csf[l0 + 3]);
#pragma unroll
                    for (int i = 0; i < 8; ++i) *(LAS v2u*)(L + SSD_BWT + (n0 + i) * SSD_PITCH + l0 * 2) = (v2u){pk2(v[0][i] * t0, v[1][i] * t1), pk2(v[2][i] * t2, v[3][i] * t3)};
                } else {
                    const int n0 = 8 * (o - 24);
#pragma unroll
                    for (int r = 0; r < 4; ++r) *(LAS v4u*)(L + SSD_CS + (l0 + r) * SSD_PITCH + n0 * 2) = (v4u){pk2(v[r][0], v[r][1]), pk2(v[r][2], v[r][3]), pk2(v[r][4], v[r][5]), pk2(v[r][6], v[r][7])};
                }
            }
            __syncthreads();
            bf16x8 ca[4];
#pragma unroll
            for (int ks = 0; ks < 4; ++ks) ca[ks] = lds_frag(L + SSD_CS, 16 * w + li, 64 * ks + 16 * lq);
            f32x4 cb[8];
#pragma unroll
            for (int sb = 0; sb < 8; ++sb) { cb[sb] = (f32x4){0.f, 0.f, 0.f, 0.f};
                if (sb <= w) {
#pragma unroll
                    for (int ks = 0; ks < 4; ++ks) cb[sb] = __builtin_amdgcn_mfma_f32_16x16x32_bf16(ca[ks], lds_frag(L + SSD_BS, 16 * sb + li, 64 * ks + 16 * lq), cb[sb], 0, 0, 0); } }
            float csl[4];
#pragma unroll
            for (int r = 0; r < 4; ++r) csl[r] = csf[16 * w + 4 * lq + r];
#pragma unroll
            for (int sb = 0; sb < 8; ++sb) if (sb <= w) { const int s = 16 * sb + li; const float css = csf[s];
#pragma unroll
                for (int r = 0; r < 4; ++r) { const int l = 16 * w + 4 * lq + r; cb[sb][r] = (s <= l) ? cb[sb][r] * __expf(csl[r] - css) : 0.f; } }
            __syncthreads();
#pragma unroll
            for (int sb = 0; sb < 8; ++sb) if (sb <= (w | 1)) {
#pragma unroll
                for (int r = 0; r < 4; ++r) *(LAS unsigned short*)(L + SSD_BS + (16 * w + 4 * lq + r) * SSD_PITCH + (16 * sb + li) * 2) = (unsigned short)f2bf(cb[sb][r]); }
            LDS_WAIT(); asm volatile("" ::: "memory");
            f32x4 yd[4], yo[4];
#pragma unroll
            for (int pb = 0; pb < 4; ++pb) { yd[pb] = (f32x4){0.f, 0.f, 0.f, 0.f}; yo[pb] = (f32x4){0.f, 0.f, 0.f, 0.f}; }
#pragma unroll
            for (int ks = 0; ks < 4; ++ks) if (ks <= (w >> 1)) { const bf16x8 gf = lds_frag(L + SSD_BS, 16 * w + li, 64 * ks + 16 * lq);
#pragma unroll
                for (int pb = 0; pb < 4; ++pb) yd[pb] = __builtin_amdgcn_mfma_f32_16x16x32_bf16(gf, lds_frag(L + SSD_XDT, 16 * pb + li, 64 * ks + 16 * lq), yd[pb], 0, 0, 0); }
#pragma unroll
            for (int ks = 0; ks < 4; ++ks)
#pragma unroll
                for (int pb = 0; pb < 4; ++pb) yo[pb] = __builtin_amdgcn_mfma_f32_16x16x32_bf16(ca[ks], lds_frag(L + SSD_PREV, 16 * pb + li, 64 * ks + 16 * lq), yo[pb], 0, 0, 0);
#pragma unroll
            for (int r = 0; r < 4; ++r) { const float e = __expf(csl[r]);
#pragma unroll
                for (int pb = 0; pb < 4; ++pb) *(LAS float*)(L + SSD_BS + (16 * w + 4 * lq + r) * SSD_PITCH + (16 * pb + li) * 4) = yd[pb][r] + e * yo[pb][r]; }
            __syncthreads();
            { const float dec = __expf(cs_end);
#pragma unroll
              for (int j = 0; j < 4; ++j) st[j] = st[j] * dec;
#pragma unroll
              for (int ks = 0; ks < 4; ++ks) { const bf16x8 xf = lds_frag(L + SSD_XDT, 16 * pbs + li, 64 * ks + 16 * lq);
#pragma unroll
                  for (int j = 0; j < 4; ++j) st[j] = __builtin_amdgcn_mfma_f32_16x16x32_bf16(xf, lds_frag(L + SSD_BWT, 16 * (nb0 + j) + li, 64 * ks + 16 * lq), st[j], 0, 0, 0); }
#pragma unroll
              for (int j = 0; j < 4; ++j)
#pragma unroll
                  for (int r = 0; r < 4; ++r) *(LAS unsigned short*)(L + SSD_PREV + (16 * pbs + 4 * lq + r) * SSD_PITCH + (16 * (nb0 + j) + li) * 2) = (unsigned short)f2bf(st[j][r]); }
#pragma unroll
            for (int k = 0; k < 2; ++k) { const int it = tid + 512 * k, l = it >> 3, o = it & 7; const size_t row = row0 + l;
                const f32x4 y0 = *(const LAS f32x4*)(L + SSD_BS + l * SSD_PITCH + 32 * o), y1 = *(const LAS f32x4*)(L + SSD_BS + l * SSD_PITCH + 32 * o + 16);
                const v4u xw = *(const LAS v4u*)(L + SSD_XS + l * SSD_XPITCH + 16 * o); const v4u zw = *(const v4u*)(proj + row * NPROJ + h * 64 + 8 * o);
                float xv[8], zv[8], yv[8]; unpack8(xw, xv); unpack8(zw, zv);
                float ss = 0.f;
#pragma unroll
                for (int e = 0; e < 8; ++e) { const float yy = (e < 4 ? y0[e] : y1[e - 4]) + Dh * xv[e]; yv[e] = yy * silu_f(zv[e]); ss += yv[e] * yv[e]; }
                ss += __shfl_xor(ss, 1); ss += __shfl_xor(ss, 2); ss += __shfl_xor(ss, 4);
                if (o == 0) WSP(float, WS_STSSD)[row * 16 + h] = ss;
                *(v4u*)(WSP(bf16, WS_Y) + row * 2048 + h * 64 + 8 * o) = (v4u){pk2(yv[0], yv[1]), pk2(yv[2], yv[3]), pk2(yv[4], yv[5]), pk2(yv[6], yv[7])}; }
            __syncthreads();
        }
    }
}
constexpr int S5_XT = 0, S5_XPITCH = 2056, S5_BBT = 65792, S5_CC = S5_BBT + 16384, S5_CCPITCH = 272, S5_GLU = S5_CC + 64 * S5_CCPITCH, S5_VS = S5_GLU + 2048, S5_OT = S5_VS + 8 * 512, S5_OPITCH = 144, S5_END = S5_OT + 32 * S5_OPITCH;
static_assert(S5_END <= LDS_MAIN, "S5 LDS map");
typedef float f32x16 __attribute__((ext_vector_type(16)));
__device__ __forceinline__ void p3_s5(Frame& F) {
    const int tid = threadIdx.x, lane = tid & 63, w = __builtin_amdgcn_readfirstlane(tid >> 6);
    const int li = lane & 15, lq = lane >> 4;
    LAS unsigned char* L = F.lds;
    const bf16* proj = WSP(bf16, WS_PROJ);
    for (int item = F.vcu; item < NB * 16; item += F.G) {
        const int b = item >> 4, gs = item & 15;
        __syncthreads();
        { const int gl = tid >> 7, col = tid & 127, p = col >> 1, ri = col & 1; const float* src = WSP(float, WS_S5BB) + ((gs * 4 + gl) * 64 + p) * 32 + ri * 16;
          const f32x4 a0 = *(const f32x4*)src, a1 = *(const f32x4*)(src + 4), a2 = *(const f32x4*)(src + 8), a3 = *(const f32x4*)(src + 12);
          LAS v4u* d = (LAS v4u*)(L + S5_BBT + (gl * 128 + col) * 32);
          d[0] = (v4u){pk2(a0[0], a0[1]), pk2(a0[2], a0[3]), pk2(a1[0], a1[1]), pk2(a1[2], a1[3])}; d[1] = (v4u){pk2(a2[0], a2[1]), pk2(a2[2], a2[3]), pk2(a3[0], a3[1]), pk2(a3[2], a3[3])}; }
        { const int gl = tid >> 7, hh = (tid >> 3) & 15, kq = tid & 7; const int g = gs * 4 + gl; const float* cr = (F.a->in[17]) + (g * 16 + hh) * 64 + 8 * kq; const float* ci = (F.a->in[18]) + (g * 16 + hh) * 64 + 8 * kq;
          const f32x4 r0 = *(const f32x4*)cr, r1 = *(const f32x4*)(cr + 4), i0 = *(const f32x4*)ci, i1 = *(const f32x4*)(ci + 4);
          LAS v4u* d = (LAS v4u*)(L + S5_CC + (gl * 16 + hh) * S5_CCPITCH + kq * 32);
          d[0] = (v4u){pk2(r0[0], -i0[0]), pk2(r0[1], -i0[1]), pk2(r0[2], -i0[2]), pk2(r0[3], -i0[3])}; d[1] = (v4u){pk2(r1[0], -i1[0]), pk2(r1[1], -i1[1]), pk2(r1[2], -i1[2]), pk2(r1[3], -i1[3])}; }
        for (int i = tid; i < 1024; i += NTHR) { const int gl = i >> 8, k = (i >> 4) & 15, hh = i & 15; ((LAS unsigned short*)(L + S5_GLU))[i] = (unsigned short)f2bf((F.a->in[20])[((gs * 4 + gl) * 16 + hh) * 16 + k]); }
        const int gsc = gs * 4 + (w & 3);
        const float lbr = WSP(float, WS_S5LB)[(gsc * 64 + lane) * 2], lbi = WSP(float, WS_S5LB)[(gsc * 64 + lane) * 2 + 1];
        const int glo = w >> 1, mb = w & 1, go = gs * 4 + glo;
        const float dsk = (F.a->in[19])[go * 16 + li], gbias = (F.a->in[21])[go * 16 + li];
        float xr = 0.f, xi = 0.f;
        __syncthreads();
        const bf16* ubase = proj + (size_t)b * SEQ * NPROJ + 3072 + gs * 64;
        v4u ua = *(const v4u*)(ubase + (size_t)(lane & 31) * NPROJ + glo * 16 + 8 * (lane >> 5));
        for (int t0 = 0; t0 < SEQ; t0 += 32) {
            const bf16x8 af = __builtin_bit_cast(bf16x8, ua);
            if (t0 + 32 < SEQ) ua = *(const v4u*)(ubase + (size_t)(t0 + 32 + (lane & 31)) * NPROJ + glo * 16 + 8 * (lane >> 5));
            float uo[4];
#pragma unroll
            for (int r = 0; r < 4; ++r) uo[r] = bf2f(ubase[(size_t)(t0 + 16 * mb + 4 * lq + r) * NPROJ + glo * 16 + li]);
#pragma unroll
            for (int q = 0; q < 2; ++q) { const int cb = 2 * (w & 1) + q;
                const bf16x8 bfrag = *(const LAS bf16x8*)(L + S5_BBT + (glo * 128 + 32 * cb + (lane & 31)) * 32 + 16 * (lane >> 5));
                f32x16 acc;
#pragma unroll
                for (int r = 0; r < 16; ++r) acc[r] = 0.f;
                acc = __builtin_amdgcn_mfma_f32_32x32x16_bf16(af, bfrag, acc, 0, 0, 0);
#pragma unroll
                for (int r = 0; r < 16; ++r) { const int t = (r & 3) + 8 * (r >> 2) + 4 * (lane >> 5); *(LAS float*)(L + S5_XT + t * S5_XPITCH + (glo * 128 + 32 * cb + (lane & 31)) * 4) = acc[r]; } }
            __syncthreads();
            if (w < 4) { LAS f32x2* xp = (LAS f32x2*)(L + S5_XT + (w * 128 + 2 * lane) * 4);
#pragma unroll 8
                for (int t = 0; t < 32; ++t) { const f32x2 bu = xp[t * (S5_XPITCH / 8)]; const float nr = lbr * xr - lbi * xi + bu[0], ni = lbr * xi + lbi * xr + bu[1]; xr = nr; xi = ni; xp[t * (S5_XPITCH / 8)] = (f32x2){xr, xi}; } }
            __syncthreads();
            f32x4 yacc = (f32x4){0.f, 0.f, 0.f, 0.f};
#pragma unroll
            for (int ks = 0; ks < 4; ++ks) { const LAS float* xs = (const LAS float*)(L + S5_XT + (16 * mb + li) * S5_XPITCH + (glo * 128 + 32 * ks + 8 * lq) * 4);
                const f32x4 x0 = *(const LAS f32x4*)xs, x1 = *(const LAS f32x4*)(xs + 4);
                const v4u xa = (v4u){pk2(x0[0], x0[1]), pk2(x0[2], x0[3]), pk2(x1[0], x1[1]), pk2(x1[2], x1[3])};
                const bf16x8 cf = *(const LAS bf16x8*)(L + S5_CC + (glo * 16 + li) * S5_CCPITCH + 64 * ks + 16 * lq);
                yacc = __builtin_amdgcn_mfma_f32_16x16x32_bf16(__builtin_bit_cast(bf16x8, xa), cf, yacc, 0, 0, 0); }
            float v[4];
#pragma unroll
            for (int r = 0; r < 4; ++r) v[r] = gelu_erf(yacc[r] + dsk * uo[r]);
            LAS unsigned char* vs = L + S5_VS + w * 512;
#pragma unroll
            for (int r = 0; r < 4; ++r) *(LAS unsigned short*)(vs + (4 * lq + r) * 32 + li * 2) = (unsigned short)f2bf(v[r]);
            LDS_WAIT(); asm volatile("" ::: "memory");
            v4u va = (v4u){0u, 0u, 0u, 0u}, gw = (v4u){0u, 0u, 0u, 0u};
            if (lq < 2) { va = *(const LAS v4u*)(vs + li * 32 + 16 * lq); gw = *(const LAS v4u*)(L + S5_GLU + ((glo * 16 + li) * 16 + 8 * lq) * 2); }
            f32x4 gacc = (f32x4){0.f, 0.f, 0.f, 0.f};
            gacc = __builtin_amdgcn_mfma_f32_16x16x32_bf16(__builtin_bit_cast(bf16x8, va), __builtin_bit_cast(bf16x8, gw), gacc, 0, 0, 0);
            float o[4], ss[4];
#pragma unroll
            for (int r = 0; r < 4; ++r) { o[r] = v[r] / (1.0f + __expf(-(gacc[r] + gbias))); ss[r] = o[r] * o[r]; }
#pragma unroll
            for (int r = 0; r < 4; ++r) { ss[r] += __shfl_xor(ss[r], 1); ss[r] += __shfl_xor(ss[r], 2); ss[r] += __shfl_xor(ss[r], 4); ss[r] += __shfl_xor(ss[r], 8); }
            if (li == 0) {
#pragma unroll
                for (int r = 0; r < 4; ++r) WSP(float, WS_STS5)[((size_t)b * SEQ + t0 + 16 * mb + 4 * lq + r) * NS5PART + go] = ss[r]; }
#pragma unroll
            for (int r = 0; r < 4; ++r) *(LAS unsigned short*)(L + S5_OT + (16 * mb + 4 * lq + r) * S5_OPITCH + (glo * 16 + li) * 2) = (unsigned short)f2bf(o[r]);
            __syncthreads();
            if (tid < 256) { const int t = tid >> 3, oc = tid & 7; const v4u ov = *(const LAS v4u*)(L + S5_OT + t * S5_OPITCH + 16 * oc);
                *(v4u*)(WSP(bf16, WS_Y) + ((size_t)b * SEQ + t0 + t) * 2048 + 1024 + gs * 64 + 8 * oc) = ov; }
        }
    }
}
__device__ __forceinline__ unsigned med3u(unsigned a, unsigned b, unsigned c) { unsigned r; asm("v_med3_u32 %0, %1, %2, %3" : "=v"(r) : "v"(a), "v"(b), "v"(c)); return r; }
__device__ __forceinline__ unsigned fkey(float v) { const unsigned u = __builtin_bit_cast(unsigned, v); return (u & 0x80000000u) ? ~u : (u | 0x80000000u); }
__device__ __forceinline__ float fkey_inv(unsigned k) { const unsigned u = (k & 0x80000000u) ? (k & 0x7fffffffu) : ~k; return __builtin_bit_cast(float, u); }
#define TOPK_INSERT(a, x) do { _Pragma("unroll") for (int _i = 15; _i >= 1; --_i) a[_i] = med3u(a[_i - 1], a[_i], (x)); a[0] = a[0] > (x) ? a[0] : (x); } while (0)
__device__ __forceinline__ void p5b_topk(Frame& F) {
    const int f_tid = threadIdx.x, f_lane = f_tid & 63, f_wave = __builtin_amdgcn_readfirstlane(f_tid >> 6);
    const float* scores = WSP(float, WS_SCORES);
    LAS unsigned char* ix = (LAS unsigned char*)F.lds + f_tid * 36;
    for (int item = F.vcu * NTHR + f_tid; item < MTOK * PH; item += F.G * NTHR) {
        const int t = item >> 3, hd = item & 7;
        unsigned a1[16], a2[16];
#pragma unroll
        for (int i = 0; i < 16; ++i) { a1[i] = 0u; a2[i] = 0u; }
        const float* sp = scores + (size_t)t * 2048 + hd * 256;
#pragma unroll 2
        for (int q = 0; q < 32; ++q) { const f32x4 s = *(const f32x4*)(sp + 4 * q);
#pragma unroll
            for (int e = 0; e < 4; ++e) { const unsigned k = (fkey(s[e]) & ~127u) | (unsigned)(127 - (4 * q + e)); TOPK_INSERT(a1, k); } }
#pragma unroll 2
        for (int q = 0; q < 32; ++q) { const f32x4 s = *(const f32x4*)(sp + 128 + 4 * q);
#pragma unroll
            for (int e = 0; e < 4; ++e) { const unsigned k = (fkey(s[e]) & ~127u) | (unsigned)(127 - (4 * q + e)); TOPK_INSERT(a2, k); } }
        float v1[16], v2[16];
#pragma unroll
        for (int i = 0; i < 16; ++i) { ix[i] = (unsigned char)(127u - (a1[i] & 127u)); ix[16 + i] = (unsigned char)(127u - (a2[i] & 127u)); v1[i] = fkey_inv(a1[i] & ~127u); v2[i] = fkey_inv(a2[i] & ~127u); }
        unsigned cb[16];
#pragma unroll
        for (int i = 0; i < 16; ++i) cb[i] = 0u;
#pragma unroll
        for (int i = 0; i < 16; ++i)
#pragma unroll
            for (int j = 0; j < 16; ++j) if ((i + 1) * (j + 1) <= 16) { const unsigned k = (fkey(v1[i] + v2[j]) & ~255u) | (unsigned)(255 - (i * 16 + j)); TOPK_INSERT(cb, k); }
        float tv[16]; float mx = -3.0e38f;
#pragma unroll
        for (int k = 0; k < 16; ++k) { tv[k] = fkey_inv(cb[k] & ~255u); mx = fmaxf(mx, tv[k]); }
        float sum = 0.f;
#pragma unroll
        for (int k = 0; k < 16; ++k) { tv[k] = __expf(tv[k] - mx); sum += tv[k]; }
        const float inv = 1.0f / sum;
        LDS_WAIT(); asm volatile("" ::: "memory");
        int* eo = WSP(int, WS_EID) + (size_t)t * 128 + hd * 16; float* go = WSP(float, WS_GATE) + (size_t)t * 128 + hd * 16;
#pragma unroll
        for (int k4 = 0; k4 < 4; ++k4) { int ev[4]; f32x4 gv;
#pragma unroll
            for (int e = 0; e < 4; ++e) { const int k = 4 * k4 + e; const unsigned code = 255u - (cb[k] & 255u); const int i = code >> 4, j = code & 15;
                ev[e] = (int)ix[i] * 128 + (int)ix[16 + j]; gv[e] = tv[k] * inv; }
            *(int4*)(eo + 4 * k4) = make_int4(ev[0], ev[1], ev[2], ev[3]); *(f32x4*)(go + 4 * k4) = gv; }
        LDS_WAIT(); asm volatile("" ::: "memory");
    }
}
__device__ __forceinline__ void p6_gather(Frame& F) {
    const int f_tid = threadIdx.x, f_lane = f_tid & 63, f_wave = __builtin_amdgcn_readfirstlane(f_tid >> 6);
    const int lane = f_lane;
    const bf16* EU = WSP(bf16, WS_EU); const bf16* EV = WSP(bf16, WS_EV);
    for (int wq = F.vcu * NWAVES + f_wave; wq < MTOK / 16; wq += F.G * NWAVES) {
        const int b = wq >> 7; const float* mb = WSP(float, WS_MOD) + (size_t)b * 6144;
        float G2[16], S2[16], GT[16], NF[16];
#pragma unroll
        for (int c = 0; c < 2; ++c)
#pragma unroll
            for (int q = 0; q < 2; ++q) { const int k = 512 * c + 8 * lane + 4 * q; const f32x4 g = *(const f32x4*)((F.a->in[24]) + k), sc = *(const f32x4*)(mb + 4096 + k), sh = *(const f32x4*)(mb + 3072 + k), gt = *(const f32x4*)(mb + 5120 + k), nf = *(const f32x4*)((F.a->in[29]) + k);
#pragma unroll
                for (int e = 0; e < 4; ++e) { G2[8 * c + 4 * q + e] = g[e] * (1.0f + sc[e]); S2[8 * c + 4 * q + e] = sh[e]; GT[8 * c + 4 * q + e] = gt[e]; NF[8 * c + 4 * q + e] = nf[e]; } }
        for (int tt = 0; tt < 16; ++tt) {
            const size_t t = (size_t)wq * 16 + tt; float* xr = F.out + t * 1024;
            float x1[16], h2[16], o[16];
#pragma unroll
            for (int c = 0; c < 2; ++c)
#pragma unroll
                for (int q = 0; q < 2; ++q) { const f32x4 v = *(const f32x4*)(xr + 512 * c + 8 * lane + 4 * q);
#pragma unroll
                    for (int e = 0; e < 4; ++e) x1[8 * c + 4 * q + e] = v[e]; }
            const float rs = 1.0f / sqrtf(WSP(float, WS_ROWSTAT)[t] * (1.0f / 1024.0f) + EPSF);
#pragma unroll
            for (int i = 0; i < 16; ++i) { h2[i] = x1[i] * rs * G2[i] + S2[i]; o[i] = 0.f; }
            const int e_lo = WSP(int, WS_EID)[t * 128 + lane], e_hi = WSP(int, WS_EID)[t * 128 + 64 + lane];
            const float g_lo = WSP(float, WS_GATE)[t * 128 + lane], g_hi = WSP(float, WS_GATE)[t * 128 + 64 + lane];
            for (int grp = 0; grp < 16; ++grp) {
                const int esel = grp < 8 ? e_lo : e_hi; const float gsel = grp < 8 ? g_lo : g_hi; const int base = (grp & 7) * 8;
                int eid[8]; float d[8];
#pragma unroll
                for (int j = 0; j < 8; ++j) { eid[j] = __shfl(esel, base + j);
                    const bf16* ur = EU + (size_t)eid[j] * 1024 + 8 * lane; const v4u w0 = *(const v4u*)ur, w1 = *(const v4u*)(ur + 512);
                    float f[16]; unpack8(w0, f); unpack8(w1, f + 8); float a = 0.f;
#pragma unroll
                    for (int i = 0; i < 16; ++i) a += h2[i] * f[i];
                    d[j] = a; }
                float e4[4], e2[2], e1;
#pragma unroll
                for (int i = 0; i < 4; ++i) { const bool up = lane & 32; const float snd = up ? d[i] : d[i + 4]; const float rcv = __shfl_xor(snd, 32); e4[i] = (up ? d[i + 4] : d[i]) + rcv; }
#pragma unroll
                for (int i = 0; i < 2; ++i) { const bool up = lane & 16; const float snd = up ? e4[i] : e4[i + 2]; const float rcv = __shfl_xor(snd, 16); e2[i] = (up ? e4[i + 2] : e4[i]) + rcv; }
                { const bool up = lane & 8; const float snd = up ? e2[0] : e2[1]; const float rcv = __shfl_xor(snd, 8); e1 = (up ? e2[1] : e2[0]) + rcv; }
                e1 += __shfl_xor(e1, 4); e1 += __shfl_xor(e1, 2); e1 += __shfl_xor(e1, 1);
                const int myj = ((lane >> 5) & 1) * 4 + ((lane >> 4) & 1) * 2 + ((lane >> 3) & 1);
                const float wmine = __shfl(gsel, base + myj) * gelu_erf(e1);
#pragma unroll
                for (int j = 0; j < 8; ++j) { const int src = ((j >> 2) & 1) * 32 + ((j >> 1) & 1) * 16 + (j & 1) * 8; const float wj = __shfl(wmine, src);
                    const bf16* vr = EV + (size_t)eid[j] * 1024 + 8 * lane; const v4u w0 = *(const v4u*)vr, w1 = *(const v4u*)(vr + 512);
                    float f[16]; unpack8(w0, f); unpack8(w1, f + 8);
#pragma unroll
                    for (int i = 0; i < 16; ++i) o[i] += wj * f[i]; }
            }
            float ss = 0.f;
#pragma unroll
            for (int i = 0; i < 16; ++i) { x1[i] += GT[i] * o[i]; ss += x1[i] * x1[i]; }
            const float rf = 1.0f / sqrtf(wave_sum(ss) * (1.0f / 1024.0f) + EPSF);
#pragma unroll
            for (int c = 0; c < 2; ++c)
#pragma unroll
                for (int q = 0; q < 2; ++q) { f32x4 v;
#pragma unroll
                    for (int e = 0; e < 4; ++e) v[e] = x1[8 * c + 4 * q + e] * rf * NF[8 * c + 4 * q + e];
                    *(f32x4*)(xr + 512 * c + 8 * lane + 4 * q) = v; }
        }
    }
}
constexpr int NPHASE = 9;
__global__ void __launch_bounds__(NTHR, 2) fwd_mega(Args args) {
    extern __shared__ __attribute__((aligned(16))) unsigned char lds[];
    Frame F;
    F.lds = (LAS unsigned char*)lds;
    F.MISC = (volatile LAS unsigned*)(F.lds + MISC_OFF);
    F.G = gridDim.x; { const int bx = blockIdx.x; F.vcu = (F.G % 8 == 0) ? (bx % 8) * (F.G / 8) + bx / 8 : bx; }
    F.ws = args.ws; F.out = args.out;
    F.a = &args;
    for (int u = threadIdx.x; u < 32; u += NTHR) F.MISC[u] = 0u;
    __syncthreads();
    const int lo = args.ph_lo, hi = args.ph_hi;
    const bool use_bar = (hi - lo) > 1;
    XcdBarrier bar; bar.bar = (unsigned*)(F.ws + WS_CTL); bar.x = 0; bar.st = nullptr;
    if (use_bar) bar = xcd_barrier_post((unsigned*)(F.ws + WS_CTL), F.MISC + 8);
#define IN(k) (lo <= (k) && (k) < hi)
#define SEAM(k) do { if (IN(k) && IN((k) + 1)) xcd_barrier(bar); } while (0)
    if (IN(0)) {
#ifndef SKIP_P0
 p0_phase(F);
#endif
 } SEAM(0);
    if (IN(1)) {
#ifndef SKIP_P1
 p1_phase(F);
#endif
 } SEAM(1);
    if (IN(2)) {
        pg8::Gemm g{WSP(bf16, WS_H1), WSP(bf16, WS_WINT), MTOK, NPROJ, 1024}; pg8::StaticOrder S; S.init(MTOK, NPROJ, F.G, (int)blockIdx.x);
        pg8::EpiProj E{WSP(bf16, WS_PROJ), NPROJ};
        pg8::gemm_phase<pg8::EpiProj, pg8::StaticOrder, true, true>(F.lds, g, S, E);
    } SEAM(2);
    if (IN(3)) {
#ifndef SKIP_SSD
#ifdef SSD_NAIVE
 p3_ssd_naive(F);
#else
 p3_ssd(F);
#endif
#endif
#ifndef SKIP_S5
#ifdef S5_NAIVE
 p3_s5_naive(F);
#else
 p3_s5(F);
#endif
#endif
 } SEAM(3);
    if (IN(4)) {
#ifndef SKIP_P3C
 p3c_normalize(F);
#endif
 } SEAM(4);
    if (IN(5)) {
        pg8::Gemm g{WSP(bf16, WS_Y), WSP(bf16, WS_WOUTT), MTOK, 1024, 2048}; pg8::StaticOrder S; S.init(MTOK, 1024, F.G, (int)blockIdx.x);
        pg8::EpiX1 E{(F.a->in[0]), F.out, WSP(bf16, WS_X1S), WSP(float, WS_MOD), (F.a->in[24]), WSP(float, WS_ROWSTAT)};
        pg8::gemm_phase<pg8::EpiX1, pg8::StaticOrder, true, true>(F.lds, g, S, E);
    } SEAM(5);
    if (IN(6)) {
        pg8::Gemm g{WSP(bf16, WS_X1S), WSP(bf16, WS_WQKT), MTOK, 2048, 1024}; pg8::StaticOrder S; S.init(MTOK, 2048, F.G, (int)blockIdx.x);
        pg8::EpiScores E{WSP(float, WS_SCORES), WSP(float, WS_SB), WSP(float, WS_ROWSTAT)};
        pg8::gemm_phase<pg8::EpiScores, pg8::StaticOrder, true, true>(F.lds, g, S, E);
    } SEAM(6);
    if (IN(7)) {
#ifndef SKIP_TOPK
 p5b_topk(F);
#endif
 } SEAM(7);
    if (IN(8)) {
#ifndef SKIP_GATHER
 p6_gather(F);
#endif
 }
#undef IN
#undef SEAM
}

#ifndef N_LAUNCHES
#define N_LAUNCHES 1
#endif
extern "C" void kernel_launch(void* const* d_in, const int* in_sizes, int n_in, void* d_out, int out_size, void* d_ws, size_t ws_size, hipStream_t stream) {
    static int grid = 0;
    if (grid == 0) {
        if (n_in != 30 || in_sizes[0] != MTOK * DM || out_size != MTOK * DM || ws_size < WS_END) { fprintf(stderr, "kernel_launch: unexpected shapes (n_in %d, in0 %d, out %d, ws %zu)\n", n_in, n_in > 0 ? in_sizes[0] : -1, out_size, ws_size); grid = -1; return; }
        int dev = 0, cus = 0, per_cu = 0;
        if (hipGetDevice(&dev) != hipSuccess || hipDeviceGetAttribute(&cus, hipDeviceAttributeMultiprocessorCount, dev) != hipSuccess) { grid = -1; return; }
        if (hipFuncSetAttribute((const void*)fwd_mega, hipFuncAttributeMaxDynamicSharedMemorySize, LDS_BYTES) != hipSuccess) { fprintf(stderr, "kernel_launch: hipFuncSetAttribute failed\n"); grid = -1; return; }
        if (hipOccupancyMaxActiveBlocksPerMultiprocessor(&per_cu, (const void*)fwd_mega, NTHR, LDS_BYTES) != hipSuccess || per_cu < 1) { fprintf(stderr, "kernel_launch: occupancy query says %d\n", per_cu); (void)hipGetLastError(); grid = -1; return; }
        grid = cus;
    }
    if (grid < 0) return;
    (void)hipMemsetAsync((char*)d_ws + WS_CTL, 0, CTL_ZERO_BYTES, stream);
    Args a{};
    for (int i = 0; i < 30; ++i) a.in[i] = (const float*)d_in[i];
    a.out = (float*)d_out; a.ws = (unsigned char*)d_ws;
    if (N_LAUNCHES == 1) {
        a.ph_lo = 0; a.ph_hi = NPHASE;
        void* kargs[] = {&a};
        hipError_t e = hipLaunchCooperativeKernel((const void*)fwd_mega, dim3(grid), dim3(NTHR), kargs, LDS_BYTES, stream);
        if (e != hipSuccess) fprintf(stderr, "kernel_launch: cooperative launch failed: %s (grid %d)\n", hipGetErrorString(e), grid);
    } else {
        for (int p = 0; p < NPHASE; ++p) { a.ph_lo = p; a.ph_hi = p + 1; hipLaunchKernelGGL(fwd_mega, dim3(grid), dim3(NTHR), LDS_BYTES, stream, a); }
    }
}
```

```cpp
#include <hip/hip_runtime.h>
#include <cstdio>
#include <cstdint>
namespace pg8 {
#define PG8_LAS __attribute__((address_space(3)))
typedef unsigned short bf16_t;
typedef short bf16x8 __attribute__((ext_vector_type(8)));
typedef float f32x4 __attribute__((ext_vector_type(4)));
typedef unsigned u32x4 __attribute__((ext_vector_type(4)));
constexpr int BM = 256, BK = 64, HALF = 128, HTB = HALF * BK * 2  , STAGE_BYTES = 8 * HTB, NXCD = 8, WGM = 8;

__host__ __device__ __forceinline__ int lds_byte(int r, int c) { const int st = (r >> 4) * 2 + (c >> 5), rr = r & 15, cc = c & 31, ob = rr * 64 + cc * 2; return st * 1024 + (ob ^ (((ob >> 9) & 1) << 5)); }
__host__ __device__ __forceinline__ void stage_rc(int b, int& R, int& C) { const int st = b / 1024, sb = b % 1024, swz = sb ^ (((sb >> 9) & 1) << 5); R = (st >> 1) * 16 + swz / 64; C = (st & 1) * 32 + (swz % 64) / 2; }
__host__ __device__ __forceinline__ int perm32(int rho) { const int n = rho >> 4, i = rho & 15; return 8 * (i >> 2) + 4 * n + (i & 3); }

struct Unit { int pm, pn; };
struct Gemm { const bf16_t* A; const bf16_t* Bt; int M, N, K; };

struct StaticOrder {
    int nM, nN, nwg, G, c;
    __host__ __device__ void init(int M, int N, int G_, int c_) { nM = M / BM; nN = N / BM; nwg = nM * nN; G = G_; c = c_; }
    __host__ __device__ bool next(int i, Unit& u) const {
        const long L = (long)i * G + c; if (L >= nwg) return false;
        int wgid = (int)L; { const int q = nwg / NXCD, r = nwg % NXCD, xcd = wgid % NXCD, off = wgid / NXCD; wgid = (xcd < r ? xcd * (q + 1) : r * (q + 1) + (xcd - r) * q) + off; }
        const int nig = WGM * nN, gid = wgid / nig, fm = gid * WGM, gsz = (nM - fm) < WGM ? (nM - fm) : WGM;
        u.pm = fm + ((wgid % nig) % gsz); u.pn = (wgid % nig) / gsz; return true;
    }
    __device__ __forceinline__ void a_ready(const Unit&) const {}
    __device__ __forceinline__ void done(const Unit&) const {}
};

__device__ __forceinline__ unsigned cvt_pk_bf16(float lo, float hi) { unsigned r; asm volatile("v_cvt_pk_bf16_f32 %0, %1, %2" : "=v"(r) : "v"(lo), "v"(hi)); return r; }
typedef float f32x2 __attribute__((ext_vector_type(2)));
template <class Epi, class Sched, bool ALIGN_EPI = false, bool SP2 = false>
__device__ __forceinline__ void gemm_phase(PG8_LAS unsigned char* lds, const Gemm g, const Sched& S, const Epi& E) {
    const int tid = threadIdx.x, wid = __builtin_amdgcn_readfirstlane(tid >> 6), lane = tid & 63, wr = wid >> 2, wc = wid & 3, fr = lane & 15, fq = lane >> 4;
    const int K = g.K, nt = K / BK;
    unsigned voffA[2], voffB[2];
#pragma unroll
    for (int i = 0; i < 2; ++i) { int R, C; stage_rc(tid * 16 + i * 8192, R, C); const int Rb = Epi::PERM ? ((R & ~31) + perm32(R & 31)) : R;
        voffA[i] = (unsigned)(R * K + C) * 2u; voffB[i] = (unsigned)(Rb * K + C) * 2u; }
    const size_t kstep = (size_t)(BK * 2);
    const size_t hstep = (size_t)HALF * K * 2;
    const size_t tstep = 2 * hstep;
    const unsigned ldsw = (unsigned)wid * 1024u;
    const int aoff = lds_byte(wr * 64 + fr, fq * 8), boff = lds_byte(wc * 32 + fr, fq * 8);
#define PG8_SA(b, h) (((b) * 2 + (h)) * HTB)
#define PG8_SB(b, h) ((4 + (b) * 2 + (h)) * HTB)
#define PG8_STAGE(bufoff, gbase, voff) do { _Pragma("unroll") for (int _i = 0; _i < 2; ++_i) \
        __builtin_amdgcn_global_load_lds((const unsigned*)((const char*)(gbase) + (voff)[_i]), (PG8_LAS unsigned*)(lds + (bufoff) + ldsw + _i * 8192), 16, 0, 0); } while (0)
#define PG8_LDA(dst, b, h) do { _Pragma("unroll") for (int m = 0; m < 4; ++m) _Pragma("unroll") for (int k = 0; k < 2; ++k) dst[m][k] = *(const PG8_LAS bf16x8*)(lds + PG8_SA(b, h) + aoff + m * 2048 + k * 1024); } while (0)
#define PG8_LDB(dst, b, h) do { _Pragma("unroll") for (int n = 0; n < 2; ++n) _Pragma("unroll") for (int k = 0; k < 2; ++k) dst[n][k] = *(const PG8_LAS bf16x8*)(lds + PG8_SB(b, h) + boff + n * 2048 + k * 1024); } while (0)
#define PG8_MMA(ai, bj, At, Bt) do { __builtin_amdgcn_s_setprio(1); _Pragma("unroll") for (int m = 0; m < 4; ++m) _Pragma("unroll") for (int n = 0; n < 2; ++n) _Pragma("unroll") for (int k = 0; k < 2; ++k) \
        acc[ai][bj][m][n] = __builtin_amdgcn_mfma_f32_16x16x32_bf16(Bt[n][k], At[m][k], acc[ai][bj][m][n], 0, 0, 0); __builtin_amdgcn_s_setprio(0); } while (0)
#define PG8_WAIT_V(n) asm volatile("s_waitcnt vmcnt(" #n ")" ::: "memory")
#define PG8_WAIT_L(n) asm volatile("s_waitcnt lgkmcnt(" #n ")" ::: "memory")
#define PG8_BAR __builtin_amdgcn_s_barrier()
#define PG8_SCHED __builtin_amdgcn_sched_barrier(0)
    Unit cur, nxt; int ui = 0;
    if (!S.next(0, cur)) return;
    f32x4 acc[2][2][4][2];
#pragma unroll
    for (int a = 0; a < 2; ++a)
#pragma unroll
        for (int b = 0; b < 2; ++b)
#pragma unroll
            for (int m = 0; m < 4; ++m)
#pragma unroll
                for (int n = 0; n < 2; ++n) acc[a][b][m][n] = (f32x4){0.f, 0.f, 0.f, 0.f};
    bf16x8 At[4][2], B0[2][2], B1[2][2];
    const char* cA = (const char*)g.A + (size_t)cur.pm * tstep; const char* cB = (const char*)g.Bt + (size_t)cur.pn * tstep;
    S.a_ready(cur);
    if constexpr (SP2) {
        PG8_STAGE(PG8_SB(0, 0), cB, voffB); PG8_STAGE(PG8_SB(0, 1), cB + hstep, voffB); PG8_STAGE(PG8_SA(0, 0), cA, voffA); PG8_STAGE(PG8_SA(0, 1), cA + hstep, voffA);
        if (wr == 1) PG8_BAR;
        PG8_WAIT_V(2); PG8_BAR;
        PG8_STAGE(PG8_SB(1, 0), cB + kstep, voffB); PG8_STAGE(PG8_SA(1, 0), cA + kstep, voffA); PG8_STAGE(PG8_SB(1, 1), cB + hstep + kstep, voffB);
        PG8_WAIT_V(6); PG8_BAR;
    } else {
        PG8_STAGE(PG8_SB(0, 0), cB, voffB); PG8_STAGE(PG8_SA(0, 0), cA, voffA); PG8_STAGE(PG8_SB(0, 1), cB + hstep, voffB); PG8_STAGE(PG8_SA(0, 1), cA + hstep, voffA);
        if (wr == 1) PG8_BAR;
        PG8_WAIT_V(4); PG8_BAR;
        PG8_STAGE(PG8_SB(1, 0), cB + kstep, voffB); PG8_STAGE(PG8_SA(1, 0), cA + kstep, voffA); PG8_STAGE(PG8_SB(1, 1), cB + hstep + kstep, voffB);
        PG8_WAIT_V(6); PG8_BAR;
    }
    for (;;) {
        const bool has_next = S.next(ui + 1, nxt);
        const char* nA = has_next ? (const char*)g.A + (size_t)nxt.pm * tstep : cA; const char* nB = has_next ? (const char*)g.Bt + (size_t)nxt.pn * tstep : cB;
        for (int t = 0; t < nt; t += 2) {
            const bool last = (t == nt - 2);
            const char* a1 = cA + (size_t)(t + 1) * kstep;
            const char* a2 = last ? nA : cA + (size_t)(t + 2) * kstep; const char* b2 = last ? nB : cB + (size_t)(t + 2) * kstep;
            const char* a3 = a2 + kstep; const char* b3 = b2 + kstep;
            if (last && has_next) S.a_ready(nxt);
            if constexpr (SP2) {
            PG8_LDB(B0, 0, 0); PG8_LDB(B1, 0, 1); PG8_SCHED; PG8_LDA(At, 0, 0); PG8_STAGE(PG8_SA(1, 1), a1 + hstep, voffA);
            PG8_WAIT_V(8); PG8_WAIT_L(0); PG8_BAR; PG8_MMA(0, 0, At, B0); PG8_MMA(0, 1, At, B1); PG8_BAR; PG8_SCHED;
            PG8_LDA(At, 0, 1); PG8_STAGE(PG8_SB(0, 0), b2, voffB); PG8_STAGE(PG8_SB(0, 1), b2 + hstep, voffB); PG8_STAGE(PG8_SA(0, 0), a2, voffA);
            PG8_WAIT_V(8); PG8_WAIT_L(0); PG8_BAR; PG8_MMA(1, 0, At, B0); PG8_MMA(1, 1, At, B1); PG8_BAR; PG8_SCHED;
            PG8_LDB(B0, 1, 0); PG8_LDB(B1, 1, 1); PG8_SCHED; PG8_LDA(At, 1, 0); PG8_STAGE(PG8_SA(0, 1), a2 + hstep, voffA);
            PG8_WAIT_V(8); PG8_WAIT_L(0); PG8_BAR; PG8_MMA(0, 0, At, B0); PG8_MMA(0, 1, At, B1); PG8_BAR; PG8_SCHED;
            PG8_LDA(At, 1, 1); PG8_STAGE(PG8_SB(1, 0), b3, voffB); PG8_STAGE(PG8_SB(1, 1), b3 + hstep, voffB); PG8_STAGE(PG8_SA(1, 0), a3, voffA);
            PG8_WAIT_V(8); PG8_WAIT_L(0); PG8_BAR; PG8_MMA(1, 0, At, B0); PG8_MMA(1, 1, At, B1); PG8_BAR; PG8_SCHED;
            } else {
            PG8_LDB(B0, 0, 0); PG8_SCHED; PG8_LDA(At, 0, 0); PG8_STAGE(PG8_SA(1, 1), a1 + hstep, voffA);
            PG8_WAIT_L(8); PG8_BAR; PG8_WAIT_L(0); PG8_MMA(0, 0, At, B0); PG8_BAR; PG8_SCHED;
            PG8_LDB(B1, 0, 1); PG8_STAGE(PG8_SB(0, 0), b2, voffB);
            PG8_BAR; PG8_WAIT_L(0); PG8_MMA(0, 1, At, B1); PG8_BAR;
            PG8_LDA(At, 0, 1); PG8_STAGE(PG8_SA(0, 0), a2, voffA);
            PG8_BAR; PG8_WAIT_L(0); PG8_MMA(1, 0, At, B0); PG8_BAR; PG8_SCHED;
            PG8_STAGE(PG8_SB(0, 1), b2 + hstep, voffB);
            PG8_WAIT_V(6); PG8_BAR; PG8_MMA(1, 1, At, B1); PG8_BAR;
            PG8_LDB(B0, 1, 0); PG8_SCHED; PG8_LDA(At, 1, 0); PG8_STAGE(PG8_SA(0, 1), a2 + hstep, voffA);
            PG8_WAIT_L(8); PG8_BAR; PG8_WAIT_L(0); PG8_MMA(0, 0, At, B0); PG8_BAR; PG8_SCHED;
            PG8_LDB(B1, 1, 1); PG8_STAGE(PG8_SB(1, 0), b3, voffB);
            PG8_BAR; PG8_WAIT_L(0); PG8_MMA(0, 1, At, B1); PG8_BAR;
            PG8_LDA(At, 1, 1); PG8_STAGE(PG8_SA(1, 0), a3, voffA);
            PG8_BAR; PG8_WAIT_L(0); PG8_MMA(1, 0, At, B0); PG8_BAR; PG8_SCHED;
            PG8_STAGE(PG8_SB(1, 1), b3 + hstep, voffB);
            PG8_WAIT_V(6); PG8_BAR; PG8_MMA(1, 1, At, B1); PG8_BAR;
            }
        }
        if constexpr (ALIGN_EPI) { if (wr == 0) PG8_BAR; }
        if constexpr (!Epi::AFTER_DRAIN) { E(acc, cur, wr, wc, fr, fq); S.done(cur); }
        if (!has_next) break;
#pragma unroll
        for (int a = 0; a < 2; ++a)
#pragma unroll
            for (int b = 0; b < 2; ++b)
#pragma unroll
                for (int m = 0; m < 4; ++m)
#pragma unroll
                    for (int n = 0; n < 2; ++n) acc[a][b][m][n] = (f32x4){0.f, 0.f, 0.f, 0.f};
        cur = nxt; cA = nA; cB = nB; ++ui;
        if constexpr (ALIGN_EPI) { if (wr == 1) PG8_BAR; }
    }
    PG8_WAIT_V(0);
    if constexpr (!ALIGN_EPI) { if (wr == 0) PG8_BAR; }
    PG8_BAR;
    if constexpr (Epi::AFTER_DRAIN) { E.fused(acc, cur, wr, wc, fr, fq, lds, wid, lane); S.done(cur); }
#undef PG8_SA
#undef PG8_SB
#undef PG8_STAGE
#undef PG8_LDA
#undef PG8_LDB
#undef PG8_MMA
#undef PG8_WAIT_V
#undef PG8_WAIT_L
#undef PG8_BAR
#undef PG8_SCHED
}
}
namespace pg8 {
struct EpiProj {
    static constexpr bool PERM = true, AFTER_DRAIN = false;
    bf16_t* O; int ldc;
    __device__ __forceinline__ void operator()(const f32x4 (&acc)[2][2][4][2], const Unit& u, int wr, int wc, int fr, int fq) const {
        const int row0 = u.pm * BM + wr * 64 + fr; const int col0 = u.pn * BM + wc * 32 + 8 * fq;
#pragma unroll
        for (int ai = 0; ai < 2; ++ai)
#pragma unroll
            for (int m = 0; m < 4; ++m) { bf16_t* rowp = O + (size_t)(row0 + ai * HALF + m * 16) * ldc + col0;
#pragma unroll
                for (int bj = 0; bj < 2; ++bj) { const f32x4 v0 = acc[ai][bj][m][0], v1 = acc[ai][bj][m][1];
                    u32x4 w; w.x = cvt_pk_bf16(v0[0], v0[1]); w.y = cvt_pk_bf16(v0[2], v0[3]); w.z = cvt_pk_bf16(v1[0], v1[1]); w.w = cvt_pk_bf16(v1[2], v1[3]);
                    *(u32x4*)(rowp + bj * HALF) = w; } }
    }
};
struct EpiX1 {
    static constexpr bool PERM = true, AFTER_DRAIN = false;
    const float* x; float* x1; bf16_t* x1s; const float* mod; const float* norm2_g; float* rowstat;
    __device__ __forceinline__ void operator()(const f32x4 (&acc)[2][2][4][2], const Unit& u, int wr, int wc, int fr, int fq) const {
        const int row0 = u.pm * BM + wr * 64 + fr; const int col0 = u.pn * BM + wc * 32 + 8 * fq; const int b = (u.pm * BM) >> 11;
        const float* mb = mod + (size_t)b * 6144;
        f32x4 g1[2][2], g2[2][2];
#pragma unroll
        for (int bj = 0; bj < 2; ++bj)
#pragma unroll
            for (int n = 0; n < 2; ++n) { const int c = col0 + bj * HALF + 4 * n; g1[bj][n] = *(const f32x4*)(mb + 2048 + c);
                const f32x4 sc = *(const f32x4*)(mb + 4096 + c), ng = *(const f32x4*)(norm2_g + c); g2[bj][n] = ng * (sc + 1.0f); }
#pragma unroll
        for (int ai = 0; ai < 2; ++ai)
#pragma unroll
            for (int m = 0; m < 4; ++m) { const size_t row = (size_t)(row0 + ai * HALF + m * 16); const size_t off = row * 1024 + col0; float ss = 0.f;
#pragma unroll
                for (int bj = 0; bj < 2; ++bj) {
                    const f32x4 xa = *(const f32x4*)(x + off + bj * HALF), xb = *(const f32x4*)(x + off + bj * HALF + 4);
                    const f32x4 v0 = xa + g1[bj][0] * acc[ai][bj][m][0], v1 = xb + g1[bj][1] * acc[ai][bj][m][1];
                    *(f32x4*)(x1 + off + bj * HALF) = v0; *(f32x4*)(x1 + off + bj * HALF + 4) = v1;
                    ss += (v0[0] * v0[0] + v0[1] * v0[1]) + (v0[2] * v0[2] + v0[3] * v0[3]) + (v1[0] * v1[0] + v1[1] * v1[1]) + (v1[2] * v1[2] + v1[3] * v1[3]);
                    const f32x4 s0 = v0 * g2[bj][0], s1 = v1 * g2[bj][1];
                    u32x4 w; w.x = cvt_pk_bf16(s0[0], s0[1]); w.y = cvt_pk_bf16(s0[2], s0[3]); w.z = cvt_pk_bf16(s1[0], s1[1]); w.w = cvt_pk_bf16(s1[2], s1[3]);
                    *(u32x4*)(x1s + off + bj * HALF) = w; }
                ss += __shfl_xor(ss, 16); ss += __shfl_xor(ss, 32);
                if (fq == 0) atomicAdd(rowstat + row, ss); }
    }
};
struct EpiScores {
    static constexpr bool PERM = true, AFTER_DRAIN = false;
    float* S; const float* sb; const float* rowstat;
    __device__ __forceinline__ void operator()(const f32x4 (&acc)[2][2][4][2], const Unit& u, int wr, int wc, int fr, int fq) const {
        const int row0 = u.pm * BM + wr * 64 + fr; const int col0 = u.pn * BM + wc * 32 + 8 * fq; const int b = (u.pm * BM) >> 11;
        f32x4 bv[2][2];
#pragma unroll
        for (int bj = 0; bj < 2; ++bj)
#pragma unroll
            for (int n = 0; n < 2; ++n) bv[bj][n] = *(const f32x4*)(sb + (size_t)b * 2048 + col0 + bj * HALF + 4 * n);
#pragma unroll
        for (int ai = 0; ai < 2; ++ai)
#pragma unroll
            for (int m = 0; m < 4; ++m) { const size_t row = (size_t)(row0 + ai * HALF + m * 16); const float rs = 1.0f / sqrtf(rowstat[row] * (1.0f / 1024.0f) + 1e-6f);
                float* rowp = S + row * 2048 + col0;
#pragma unroll
                for (int bj = 0; bj < 2; ++bj) { *(f32x4*)(rowp + bj * HALF) = acc[ai][bj][m][0] * rs + bv[bj][0]; *(f32x4*)(rowp + bj * HALF + 4) = acc[ai][bj][m][1] * rs + bv[bj][1]; } }
    }
};
}
constexpr int NWAVES = 8, NTHR = 512;
constexpr int DM = 1024, NB = 16, SEQ = 2048, MTOK = NB * SEQ;
constexpr int NPROJ = 4096;
constexpr int INW = 4112;
constexpr int NHEADS = 16, HDIM = 64, NGRP = 4, NST = 128, CHUNK = 128;
constexpr int S5G = 64, S5CH = 16, S5P = 64;
constexpr int PH = 8, PK = 16, PNK = 128;
constexpr float EPSF = 1e-6f;
constexpr int NS5PART = 64;

constexpr size_t MiB = 1u << 20;
constexpr size_t WS_CTL = 0, CTL_ZERO_BYTES = 64 * 1024;
constexpr size_t WS_MOD = 1 * MiB;
constexpr size_t WS_WDT = WS_MOD + 0x60000;
constexpr size_t WS_SB = WS_MOD + 0x70000;
constexpr size_t WS_ROWSTAT = WS_MOD + 0x90000;
constexpr size_t WS_S5LB = WS_MOD + 0xB0000;
constexpr size_t WS_S5BB = WS_MOD + 0xC0000;
constexpr size_t WS_DTRAW = 3 * MiB;
constexpr size_t WS_STSSD = 5 * MiB;
constexpr size_t WS_STS5 = 7 * MiB;
constexpr size_t WS_WINT = 15 * MiB;
constexpr size_t WS_WOUTT = 23 * MiB;
constexpr size_t WS_WQKT = 27 * MiB;
constexpr size_t WS_EU = 31 * MiB, WS_EV = 47 * MiB;
constexpr size_t WS_EUS = 63 * MiB, WS_EVS = 63 * MiB + 65536;
constexpr size_t WS_START = 64 * MiB;
constexpr size_t WS_A = 95 * MiB;
constexpr size_t WS_B = 223 * MiB;
constexpr size_t WS_H1 = WS_A, WS_Y = WS_A, WS_PROJ = WS_B, WS_SCORES = WS_A;
constexpr size_t WS_X1S = WS_B + 192 * MiB;
constexpr size_t WS_EID = 479 * MiB, WS_GATE = 495 * MiB;
constexpr size_t WS_END = 511 * MiB;
static_assert(WS_SCORES + (size_t)MTOK * 2048 * 4 <= WS_X1S && WS_X1S + (size_t)MTOK * 1024 * 2 <= WS_EID && WS_GATE + (size_t)MTOK * 128 * 4 <= WS_END, "ws map");

constexpr int LDS_MAIN = 159744;
constexpr int MISC_OFF = LDS_MAIN;
constexpr int LDS_BYTES = LDS_MAIN + 128;

#define GAS __attribute__((address_space(1)))
#define LAS __attribute__((address_space(3)))
typedef unsigned short bf16;
typedef unsigned v4u __attribute__((ext_vector_type(4)));
typedef unsigned v2u __attribute__((ext_vector_type(2)));
typedef float f32x4 __attribute__((ext_vector_type(4)));
typedef float f32x2 __attribute__((ext_vector_type(2)));
typedef short bf16x8 __attribute__((ext_vector_type(8)));
#define LDS_WAIT() asm volatile("s_waitcnt lgkmcnt(0)" ::: "memory")
#define VM_WAIT() asm volatile("s_waitcnt vmcnt(0)" ::: "memory")
__device__ __forceinline__ unsigned f2bf(float f) { unsigned u = __builtin_bit_cast(unsigned, f); return (u + 0x7fffu + ((u >> 16) & 1u)) >> 16; }
__device__ __forceinline__ unsigned pk2(float lo, float hi) { return f2bf(lo) | (f2bf(hi) << 16); }
__device__ __forceinline__ float bflo(unsigned w) { return __builtin_bit_cast(float, w << 16); }
__device__ __forceinline__ float bfhi(unsigned w) { return __builtin_bit_cast(float, w & 0xffff0000u); }
__device__ __forceinline__ float bf2f(bf16 v) { return __builtin_bit_cast(float, (unsigned)v << 16); }
__device__ __forceinline__ float wave_sum(float v) {
#pragma unroll
    for (int o = 1; o < 64; o <<= 1) v += __shfl_xor(v, o);
    return v;
}
__device__ __forceinline__ float silu_f(float v) { return v / (1.0f + __expf(-v)); }
__device__ __forceinline__ float gelu_erf(float v) { return 0.5f * v * (1.0f + erff(v * 0.70710678118654752f)); }
__device__ __forceinline__ float softplus_f(float v) { return v > 20.f ? v : log1pf(__expf(v)); }
__device__ __forceinline__ void unpack8(const v4u w, float* f) { f[0] = bflo(w.x); f[1] = bfhi(w.x); f[2] = bflo(w.y); f[3] = bfhi(w.y); f[4] = bflo(w.z); f[5] = bfhi(w.z); f[6] = bflo(w.w); f[7] = bfhi(w.w); }
#define XB_TMO      128
#define XB_XCNT(j)  (256  + 64 * (j))
#define XB_XSUB(j)  (1280 + 64 * (j))
#define XB_XGEN(j)  (2304 + 64 * (j))
#define XB_TOP      3328
#define XB_TOPGEN   3392
#define XCD_BAR_WORDS 3456
#define XB_SPIN_CAP (1u << 18)

__device__ __forceinline__ unsigned xb_ld(unsigned* p)              { return __hip_atomic_load(p, __ATOMIC_RELAXED, __HIP_MEMORY_SCOPE_AGENT); }
__device__ __forceinline__ unsigned xb_add(unsigned* p, unsigned v) { return __hip_atomic_fetch_add(p, v, __ATOMIC_RELAXED, __HIP_MEMORY_SCOPE_AGENT); }
__device__ __forceinline__ unsigned xb_xcc_id() { return (unsigned)__builtin_amdgcn_s_getreg((3 << 11) | 20) & 0xFu; }
#define XB_SPIN(cond, bar) do { unsigned _sp = 0; while (cond) { __builtin_amdgcn_s_sleep(1); \
    if ((++_sp & 255u) == 0u) { if (xb_ld(&(bar)[XB_TMO])) break; if (_sp > XB_SPIN_CAP) { atomicAdd(&(bar)[XB_TMO], 1u); break; } } } } while (0)

struct XcdBarrier {
    unsigned* bar; unsigned x;
    volatile LAS unsigned* st;
};

__device__ __forceinline__ XcdBarrier xcd_barrier_post(unsigned* bar, volatile LAS unsigned* st) {
    XcdBarrier b; b.bar = bar; b.x = xb_xcc_id(); b.st = st;
    if (threadIdx.x == 0) (void)xb_add(&bar[XB_XCNT(b.x)], 1u);
    return b;
}
__device__ __forceinline__ void xcd_barrier_complete(unsigned* bar, unsigned x, unsigned& nloc, unsigned& nx) {
    const unsigned G = gridDim.x * gridDim.y * gridDim.z;
    unsigned sum, cnt, mine, sp = 0u;
    for (;;) {
        sum = 0u; cnt = 0u; mine = 0u;
#pragma unroll
        for (unsigned j = 0; j < 16; ++j) { const unsigned c = xb_ld(&bar[XB_XCNT(j)]); sum += c; cnt += (c > 0u) ? 1u : 0u; mine = (j == x) ? c : mine; }
        if (sum == G) break;
        __builtin_amdgcn_s_sleep(1);
        if ((++sp & 255u) == 0u) { if (xb_ld(&bar[XB_TMO])) break; if (sp > XB_SPIN_CAP) { atomicAdd(&bar[XB_TMO], 1u); break; } }
    }
    nloc = mine > 0u ? mine : 1u; nx = cnt > 0u ? cnt : 1u;
}

__device__ __forceinline__ void xcd_barrier(const XcdBarrier& b) {
    asm volatile("s_waitcnt vmcnt(0)" ::: "memory");
    __syncthreads();
    if (threadIdx.x == 0) {
        unsigned* bar = b.bar;
        __builtin_amdgcn_s_waitcnt(0);
        unsigned nloc = b.st[0], nx = b.st[1];
        if (nloc == 0u) { xcd_barrier_complete(bar, b.x, nloc, nx); b.st[0] = nloc; b.st[1] = nx; }
        const unsigned old = xb_add(&bar[XB_XSUB(b.x)], 1u);
        const unsigned gen = old / nloc;
        if (old + 1u == (gen + 1u) * nloc) {
            __builtin_amdgcn_fence(__ATOMIC_RELEASE, "agent");
            asm volatile("s_waitcnt vmcnt(0)" ::: "memory");
            const unsigned og = xb_add(&bar[XB_TOP], 1u);
            const unsigned tg = og / nx;
            if (og + 1u == (tg + 1u) * nx) xb_add(&bar[XB_TOPGEN], 1u);
            else XB_SPIN(xb_ld(&bar[XB_TOPGEN]) == tg, bar);
            __builtin_amdgcn_fence(__ATOMIC_ACQUIRE, "agent");
            xb_add(&bar[XB_XGEN(b.x)], 1u);
            asm volatile("s_waitcnt vmcnt(0)" ::: "memory");
        } else {
            XB_SPIN(xb_ld(&bar[XB_XGEN(b.x)]) == gen, bar);
            __builtin_amdgcn_fence(__ATOMIC_ACQUIRE, "agent");
            asm volatile("s_waitcnt vmcnt(0)" ::: "memory");
        }
    }
    __syncthreads();
}
struct Args { const float* in[30]; float* out; unsigned char* ws; int ph_lo, ph_hi; };
struct Frame {
    LAS unsigned char* lds;
    volatile LAS unsigned* MISC;
    int vcu, G;
    unsigned char* ws;
    const Args* a;
    float* out;
};
#define WSP(T, off) ((T*)(F.ws + (off)))

__device__ __forceinline__ void transpose_tile(const float* W, int ldw, int k0, int src_n0, bf16* WT, int K, int dst_n0, LAS float* scr, int lane, const float* kscale) {
#pragma unroll 8
    for (int i = 0; i < 32; ++i) { const int kk = 2 * i + (lane >> 5); float v = W[(size_t)(k0 + kk) * ldw + src_n0 + (lane & 31)]; if (kscale) v *= kscale[k0 + kk]; scr[kk * 33 + (lane & 31)] = v; }
    LDS_WAIT(); asm volatile("" ::: "memory");
    const int c = lane & 7;
#pragma unroll
    for (int j = 0; j < 4; ++j) { const int n = (lane >> 3) + 8 * j; const LAS float* s = scr + (8 * c) * 33 + n;
        v4u o; o.x = pk2(s[0 * 33], s[1 * 33]); o.y = pk2(s[2 * 33], s[3 * 33]); o.z = pk2(s[4 * 33], s[5 * 33]); o.w = pk2(s[6 * 33], s[7 * 33]);
        *(v4u*)(WT + (size_t)(dst_n0 + n) * K + k0 + 8 * c) = o; }
    LDS_WAIT(); asm volatile("" ::: "memory");
}
__device__ __forceinline__ void p0_phase(Frame& F) {
    const int f_tid = threadIdx.x, f_lane = f_tid & 63, f_wave = __builtin_amdgcn_readfirstlane(f_tid >> 6);
    const int gw = F.vcu * NWAVES + f_wave, NGW = F.G * NWAVES, gt = F.vcu * NTHR + f_tid, NGT = F.G * NTHR;
    if (F.vcu < 96) {
        LAS float* sc = (LAS float*)F.lds;
        LAS float* red = (LAS float*)(F.lds + 65536);
        for (int i = f_tid; i < 16 * 1024; i += NTHR) { const int b = i >> 10, k = i & 1023; sc[k * 16 + b] = silu_f((F.a->in[1])[i]); }
        __syncthreads();
        const int ks = f_tid >> 6, col = f_tid & 63, j = F.vcu * 64 + col;
        float acc[16];
#pragma unroll
        for (int b = 0; b < 16; ++b) acc[b] = 0.f;
        const float* wp = (F.a->in[2]) + (size_t)(ks * 128) * 6144 + j;
#pragma unroll 4
        for (int k = 0; k < 128; ++k) { const float w = wp[(size_t)k * 6144]; const LAS f32x4* s4 = (const LAS f32x4*)(sc + (ks * 128 + k) * 16);
#pragma unroll
            for (int q = 0; q < 4; ++q) { const f32x4 s = s4[q]; acc[4 * q] += s[0] * w; acc[4 * q + 1] += s[1] * w; acc[4 * q + 2] += s[2] * w; acc[4 * q + 3] += s[3] * w; } }
#pragma unroll
        for (int b = 0; b < 16; ++b) red[(ks * 16 + b) * 64 + col] = acc[b];
        __syncthreads();
        for (int i = f_tid; i < 16 * 64; i += NTHR) { const int b = i >> 6, cc = i & 63; float s = 0.f;
#pragma unroll
            for (int q = 0; q < 8; ++q) s += red[(q * 16 + b) * 64 + cc];
            WSP(float, WS_MOD)[b * 6144 + F.vcu * 64 + cc] = s + (F.a->in[3])[F.vcu * 64 + cc]; }
        __syncthreads();
    }
    {
        LAS float* scr = (LAS float*)(F.lds + f_wave * 16384);
        constexpr int I_IN = (1024 / 64) * (NPROJ / 32), I_OUT = (2048 / 64) * (1024 / 32);
        for (int it = gw; it < I_IN + I_OUT; it += NGW) {
            if (it < I_IN) { const int kb = it / (NPROJ / 32), nb = it % (NPROJ / 32); const int dn = 32 * nb, sn = dn < 3072 ? dn : dn + 16;
                transpose_tile((F.a->in[5]), INW, 64 * kb, sn, WSP(bf16, WS_WINT), 1024, dn, scr, f_lane, nullptr); }
            else { const int r = it - I_IN, kb = r / 32, nb = r % 32; const int k0 = 64 * kb;
                transpose_tile((F.a->in[23]), 1024, k0, 32 * nb, WSP(bf16, WS_WOUTT), 2048, 32 * nb, scr, f_lane, k0 < 1024 ? (F.a->in[11]) : (F.a->in[22]) - 1024); }
        }
    }
    for (int i = gt; i < 16 * 1024; i += NGT) { const int h = i >> 10, k = i & 1023; WSP(float, WS_WDT)[i] = (F.a->in[5])[(size_t)k * INW + 3072 + h]; }
    for (int task = gw; task < 2048; task += NGW) {
        const int nt = task >> 4, ks = task & 15, n0 = 16 * nt, hc = n0 >> 7, k0 = 64 * ks;
        const int li = f_lane & 15, lq = f_lane >> 4;
        f32x4 acc[4];
#pragma unroll
        for (int s = 0; s < 4; ++s) acc[s] = (f32x4){0.f, 0.f, 0.f, 0.f};
        const float* ap = (F.a->in[26]) + (size_t)(n0 + li) * 128 + 4 * lq;
        const float* bp = (F.a->in[25]) + (size_t)(k0 + li) * 2048 + hc * 128 + 4 * lq;
#pragma unroll
        for (int q = 0; q < 8; ++q) { const f32x4 a = *(const f32x4*)(ap + 16 * q);
#pragma unroll
            for (int s = 0; s < 4; ++s) { const f32x4 b = *(const f32x4*)(bp + (size_t)(16 * s) * 2048 + 16 * q);
#pragma unroll
                for (int jj = 0; jj < 4; ++jj) acc[s] = __builtin_amdgcn_mfma_f32_16x16x4f32(a[jj], b[jj], acc[s], 0, 0, 0); } }
        bf16* o = WSP(bf16, WS_WQKT);
#pragma unroll
        for (int s = 0; s < 4; ++s)
#pragma unroll
            for (int r = 0; r < 4; ++r) o[(size_t)(n0 + 4 * lq + r) * 1024 + k0 + 16 * s + li] = (bf16)f2bf(acc[s][r]);
    }
    for (int rw = gw; rw < 2 * 16384; rw += NGW) {
        const int tb = rw >= 16384, e = tb ? rw - 16384 : rw; const float* src = (tb ? (F.a->in[28]) : (F.a->in[27])) + (size_t)e * 1024 + 16 * f_lane;
        f32x4 v[4]; float mx = 0.f;
#pragma unroll
        for (int q = 0; q < 4; ++q) { v[q] = *(const f32x4*)(src + 4 * q); mx = fmaxf(mx, fmaxf(fmaxf(fabsf(v[q][0]), fabsf(v[q][1])), fmaxf(fabsf(v[q][2]), fabsf(v[q][3])))); }
#pragma unroll
        for (int o = 1; o < 64; o <<= 1) mx = fmaxf(mx, __shfl_xor(mx, o));
        mx = fmaxf(mx, 1e-30f); const float sc = 224.0f / mx;
        v4u w;
#pragma unroll
        for (int q = 0; q < 4; ++q) { int pk = 0; pk = __builtin_amdgcn_cvt_pk_fp8_f32(v[q][0] * sc, v[q][1] * sc, pk, false); pk = __builtin_amdgcn_cvt_pk_fp8_f32(v[q][2] * sc, v[q][3] * sc, pk, true); w[q] = (unsigned)pk; }
        *(v4u*)(F.ws + (tb ? WS_EV : WS_EU) + (size_t)e * 1024 + 16 * f_lane) = w;
        if (f_lane == 0) WSP(float, tb ? WS_EVS : WS_EUS)[e] = mx * (1.0f / 224.0f);
    }
    for (int i = gt; i < S5G * S5P; i += NGT) {
        const float lr = (F.a->in[12])[i], li = (F.a->in[13])[i], dt = expf((F.a->in[14])[i >> 6]);
        const float mag = expf(lr * dt); float sn, cs; sincosf(li * dt, &sn, &cs);
        const float lbr = mag * cs, lbi = mag * sn, den = lr * lr + li * li;
        const float cfr = ((lbr - 1.0f) * lr + lbi * li) / den, cfi = (lbi * lr - (lbr - 1.0f) * li) / den;
        WSP(float, WS_S5LB)[2 * i] = lbr; WSP(float, WS_S5LB)[2 * i + 1] = lbi;
        for (int hh = 0; hh < 16; ++hh) { const float br = (F.a->in[15])[i * 16 + hh], bi = (F.a->in[16])[i * 16 + hh];
            WSP(float, WS_S5BB)[i * 32 + hh] = cfr * br - cfi * bi; WSP(float, WS_S5BB)[i * 32 + 16 + hh] = cfr * bi + cfi * br; }
    }
    for (int i = gt; i < MTOK; i += NGT) WSP(float, WS_ROWSTAT)[i] = 0.f;
}

__device__ __forceinline__ void p1_phase(Frame& F) {
    const int f_tid = threadIdx.x, f_lane = f_tid & 63, f_wave = __builtin_amdgcn_readfirstlane(f_tid >> 6);
    const int gw = F.vcu * NWAVES + f_wave;
    LAS float* wdt = (LAS float*)F.lds;
    for (int i = f_tid; i < 16 * 1024 / 4; i += NTHR) ((LAS f32x4*)wdt)[i] = ((const f32x4*)WSP(float, WS_WDT))[i];
    __syncthreads();
    const int lane = f_lane;
    for (int wq = gw; wq < MTOK / 16; wq += F.G * NWAVES) {
        const int b = wq >> 7; const float* mb = WSP(float, WS_MOD) + (size_t)b * 6144;
        f32x4 Gv[4], Sv[4];
#pragma unroll
        for (int j = 0; j < 4; ++j) { const int k = 4 * lane + 256 * j; const f32x4 g = *(const f32x4*)((F.a->in[4]) + k), sc = *(const f32x4*)(mb + 1024 + k); Gv[j] = g * (sc + 1.0f); Sv[j] = *(const f32x4*)(mb + k); }
        for (int tt = 0; tt < 16; ++tt) {
            asm volatile("" ::: "memory");
            const size_t t = (size_t)wq * 16 + tt; const float* xr = (F.a->in[0]) + t * 1024;
            f32x4 v[4]; float ss = 0.f;
#pragma unroll
            for (int j = 0; j < 4; ++j) { v[j] = *(const f32x4*)(xr + 4 * lane + 256 * j); ss += (v[j][0] * v[j][0] + v[j][1] * v[j][1]) + (v[j][2] * v[j][2] + v[j][3] * v[j][3]); }
            const float rstd = 1.0f / sqrtf(wave_sum(ss) * (1.0f / 1024.0f) + EPSF);
            bf16* hr = WSP(bf16, WS_H1) + t * 1024;
#pragma unroll
            for (int j = 0; j < 4; ++j) { v[j] = v[j] * rstd * Gv[j] + Sv[j]; v2u w; w.x = pk2(v[j][0], v[j][1]); w.y = pk2(v[j][2], v[j][3]); *(v2u*)(hr + 4 * lane + 256 * j) = w; }
            float d[16];
#pragma unroll
            for (int h = 0; h < 16; ++h) { float a = 0.f;
#pragma unroll
                for (int j = 0; j < 4; ++j) { const f32x4 w = *(const LAS f32x4*)(wdt + h * 1024 + 4 * lane + 256 * j); a += (v[j][0] * w[0] + v[j][1] * w[1]) + (v[j][2] * w[2] + v[j][3] * w[3]); }
                d[h] = a; }
            float e8[8], e4[4], e2[2], e1;
#pragma unroll
            for (int i = 0; i < 8; ++i) { const bool up = lane & 32; const float snd = up ? d[i] : d[i + 8]; const float rcv = __shfl_xor(snd, 32); e8[i] = (up ? d[i + 8] : d[i]) + rcv; }
#pragma unroll
            for (int i = 0; i < 4; ++i) { const bool up = lane & 16; const float snd = up ? e8[i] : e8[i + 4]; const float rcv = __shfl_xor(snd, 16); e4[i] = (up ? e8[i + 4] : e8[i]) + rcv; }
#pragma unroll
            for (int i = 0; i < 2; ++i) { const bool up = lane & 8; const float snd = up ? e4[i] : e4[i + 2]; const float rcv = __shfl_xor(snd, 8); e2[i] = (up ? e4[i + 2] : e4[i]) + rcv; }
            { const bool up = lane & 4; const float snd = up ? e2[0] : e2[1]; const float rcv = __shfl_xor(snd, 4); e1 = (up ? e2[1] : e2[0]) + rcv; }
            e1 += __shfl_xor(e1, 2); e1 += __shfl_xor(e1, 1);
            const int head = ((lane >> 5) & 1) * 8 + ((lane >> 4) & 1) * 4 + ((lane >> 3) & 1) * 2 + ((lane >> 2) & 1);
            if ((lane & 3) == 0) WSP(float, WS_DTRAW)[t * 16 + head] = e1;
        }
    }
    for (int n = gw; n < 2048; n += F.G * NWAVES) {
        const bf16* wr = WSP(bf16, WS_WQKT) + (size_t)n * 1024 + 16 * lane;
        const v4u w0 = *(const v4u*)wr, w1 = *(const v4u*)(wr + 8);
        float wv[16]; wv[0] = bflo(w0.x); wv[1] = bfhi(w0.x); wv[2] = bflo(w0.y); wv[3] = bfhi(w0.y); wv[4] = bflo(w0.z); wv[5] = bfhi(w0.z); wv[6] = bflo(w0.w); wv[7] = bfhi(w0.w);
        wv[8] = bflo(w1.x); wv[9] = bfhi(w1.x); wv[10] = bflo(w1.y); wv[11] = bfhi(w1.y); wv[12] = bflo(w1.z); wv[13] = bfhi(w1.z); wv[14] = bflo(w1.w); wv[15] = bfhi(w1.w);
        for (int b = 0; b < 16; ++b) { const float* sp = WSP(float, WS_MOD) + (size_t)b * 6144 + 3072 + 16 * lane; float a = 0.f;
#pragma unroll
            for (int q = 0; q < 4; ++q) { const f32x4 s = *(const f32x4*)(sp + 4 * q); a += (s[0] * wv[4 * q] + s[1] * wv[4 * q + 1]) + (s[2] * wv[4 * q + 2] + s[3] * wv[4 * q + 3]); }
            a = wave_sum(a); if (lane == 0) WSP(float, WS_SB)[b * 2048 + n] = a; }
    }
}
__device__ __forceinline__ void p3_ssd_naive(Frame& F) {
    const int f_tid = threadIdx.x;
    const bf16* proj = WSP(bf16, WS_PROJ);
    LAS float* buf = (LAS float*)F.lds;
    LAS float* yl = (LAS float*)(F.lds + 4096);
    for (int item = F.vcu; item < NB * NGRP; item += F.G) {
        const int b = item >> 2, g = item & 3, tid = f_tid;
        const int ch = tid < 256 ? g * 256 + tid : (tid < 384 ? 1024 + g * 128 + (tid - 256) : 1536 + g * 128 + (tid - 384));
        const float w0 = (F.a->in[6])[0 * 2048 + ch], w1 = (F.a->in[6])[1 * 2048 + ch], w2 = (F.a->in[6])[2 * 2048 + ch], w3 = (F.a->in[6])[3 * 2048 + ch], cb = (F.a->in[7])[ch];
        float r0 = 0.f, r1 = 0.f, r2 = 0.f;
        const int r = tid >> 7, nh = (tid >> 6) & 1, p = tid & 63, h = g * 4 + r;
        float st[64];
#pragma unroll
        for (int n = 0; n < 64; ++n) st[n] = 0.f;
        const float A = -__expf((F.a->in[9])[h]), Dh = (F.a->in[10])[h], dtb = (F.a->in[8])[h];
        for (int t = 0; t < SEQ; ++t) {
            const size_t row = (size_t)b * SEQ + t;
            const float r3 = bf2f(proj[row * NPROJ + 1024 + ch]);
            const float cv = silu_f(cb + r0 * w0 + r1 * w1 + r2 * w2 + r3 * w3);
            r0 = r1; r1 = r2; r2 = r3;
            LAS float* cur = buf + (t & 1) * 512; LAS float* ycur = yl + (t & 1) * 512;
            cur[tid] = cv;
            __syncthreads();
            const float dt = softplus_f(WSP(float, WS_DTRAW)[row * 16 + h] + dtb);
            const float dA = __expf(dt * A), xv = cur[r * 64 + p], xd = xv * dt;
            float y = 0.f;
#pragma unroll
            for (int n4 = 0; n4 < 16; ++n4) { const f32x4 Bv = *(const LAS f32x4*)(cur + 256 + 64 * nh + 4 * n4), Cv = *(const LAS f32x4*)(cur + 384 + 64 * nh + 4 * n4);
#pragma unroll
                for (int q = 0; q < 4; ++q) { st[4 * n4 + q] = st[4 * n4 + q] * dA + xd * Bv[q]; y += Cv[q] * st[4 * n4 + q]; } }
            ycur[tid] = y;
            __syncthreads();
            if (nh == 0) {
                y = ycur[tid] + ycur[tid + 64] + Dh * xv;
                const float zv = bf2f(proj[row * NPROJ + h * 64 + p]);
                y *= silu_f(zv);
                WSP(bf16, WS_Y)[row * 2048 + h * 64 + p] = (bf16)f2bf(y);
                const float ss = wave_sum(y * y);
                if (p == 0) WSP(float, WS_STSSD)[row * 16 + h] = ss;
            }
        }
        __syncthreads();
    }
}
__device__ __forceinline__ void p3_s5_naive(Frame& F) {
    const int f_tid = threadIdx.x, f_lane = f_tid & 63, f_wave = __builtin_amdgcn_readfirstlane(f_tid >> 6);
    const bf16* proj = WSP(bf16, WS_PROJ);
    LAS float* xt = (LAS float*)(F.lds + 4096 + f_wave * 19200);
    LAS float* vt = (LAS float*)(F.lds + 4096 + f_wave * 19200 + 16896) + (f_lane & 31) * 17;
    const int lane = f_lane;
    for (int item = F.vcu * NWAVES + f_wave; item < NB * S5G; item += F.G * NWAVES) {
        const int b = item >> 6, g = item & 63, p = lane;
        const float lbr = WSP(float, WS_S5LB)[(g * 64 + p) * 2], lbi = WSP(float, WS_S5LB)[(g * 64 + p) * 2 + 1];
        float bbr[16], bbi[16];
#pragma unroll
        for (int q = 0; q < 4; ++q) { const f32x4 a = *(const f32x4*)(WSP(float, WS_S5BB) + (g * 64 + p) * 32 + 4 * q), c = *(const f32x4*)(WSP(float, WS_S5BB) + (g * 64 + p) * 32 + 16 + 4 * q);
#pragma unroll
            for (int e = 0; e < 4; ++e) { bbr[4 * q + e] = a[e]; bbi[4 * q + e] = c[e]; } }
        float xr = 0.f, xi = 0.f;
        for (int t0 = 0; t0 < SEQ; t0 += 32) {
            for (int tt = 0; tt < 32; ++tt) {
                const bf16* up = proj + ((size_t)b * SEQ + t0 + tt) * NPROJ + 3072 + g * 16;
                const v4u u0 = *(const v4u*)up, u1 = *(const v4u*)(up + 8);
                float uv[16]; uv[0] = bflo(u0.x); uv[1] = bfhi(u0.x); uv[2] = bflo(u0.y); uv[3] = bfhi(u0.y); uv[4] = bflo(u0.z); uv[5] = bfhi(u0.z); uv[6] = bflo(u0.w); uv[7] = bfhi(u0.w);
                uv[8] = bflo(u1.x); uv[9] = bfhi(u1.x); uv[10] = bflo(u1.y); uv[11] = bfhi(u1.y); uv[12] = bflo(u1.z); uv[13] = bfhi(u1.z); uv[14] = bflo(u1.w); uv[15] = bfhi(u1.w);
                float br = 0.f, bi = 0.f;
#pragma unroll
                for (int hh = 0; hh < 16; ++hh) { br += uv[hh] * bbr[hh]; bi += uv[hh] * bbi[hh]; }
                const float nr = lbr * xr - lbi * xi + br, ni = lbr * xi + lbi * xr + bi; xr = nr; xi = ni;
                xt[(tt * 66 + p) * 2] = xr; xt[(tt * 66 + p) * 2 + 1] = xi;
            }
            LDS_WAIT(); asm volatile("" ::: "memory");
            if (lane < 32) {
                const int tt = lane; const size_t row = (size_t)b * SEQ + t0 + tt;
                const bf16* up = proj + row * NPROJ + 3072 + g * 16;
#pragma unroll 1
                for (int hh = 0; hh < 16; ++hh) { float y = 0.f; const float* cr = (F.a->in[17]) + (g * 16 + hh) * 64; const float* ci = (F.a->in[18]) + (g * 16 + hh) * 64;
#pragma unroll 8
                    for (int pp = 0; pp < 64; ++pp) y += xt[(tt * 66 + pp) * 2] * cr[pp] - xt[(tt * 66 + pp) * 2 + 1] * ci[pp];
                    vt[hh] = gelu_erf(y + (F.a->in[19])[g * 16 + hh] * bf2f(up[hh])); }
                float ss = 0.f; unsigned ow[8];
#pragma unroll 1
                for (int k2 = 0; k2 < 8; ++k2) { float o2[2];
#pragma unroll
                    for (int e = 0; e < 2; ++e) { const int k = 2 * k2 + e; float gt = (F.a->in[21])[g * 16 + k];
#pragma unroll
                        for (int hh = 0; hh < 16; ++hh) gt += vt[hh] * (F.a->in[20])[(g * 16 + hh) * 16 + k];
                        o2[e] = vt[k] / (1.0f + __expf(-gt)); ss += o2[e] * o2[e]; }
                    const unsigned pw = pk2(o2[0], o2[1]);
#pragma unroll
                    for (int q = 0; q < 8; ++q) ow[q] = (q == k2) ? pw : ow[q]; }
                bf16* yo = WSP(bf16, WS_Y) + row * 2048 + 1024 + g * 16;
                *(v4u*)yo = (v4u){ow[0], ow[1], ow[2], ow[3]}; *(v4u*)(yo + 8) = (v4u){ow[4], ow[5], ow[6], ow[7]};
                WSP(float, WS_STS5)[row * NS5PART + g] = ss;
            }
            LDS_WAIT(); asm volatile("" ::: "memory");
        }
    }
}
__device__ __forceinline__ void p3c_normalize(Frame& F) {
    const int f_tid = threadIdx.x, f_lane = f_tid & 63, f_wave = __builtin_amdgcn_readfirstlane(f_tid >> 6);
    const int lane = f_lane;
    for (int t = F.vcu * NWAVES + f_wave; t < MTOK; t += F.G * NWAVES) {
        const float* sg = WSP(float, WS_STSSD) + (size_t)t * 16; const float* s5 = WSP(float, WS_STS5) + (size_t)t * NS5PART;
        float rg[4];
#pragma unroll
        for (int g = 0; g < 4; ++g) rg[g] = 1.0f / sqrtf((sg[4 * g] + sg[4 * g + 1] + sg[4 * g + 2] + sg[4 * g + 3]) * (1.0f / 256.0f) + EPSF);
        float s5s = (NS5PART == 64) ? s5[lane] : (lane < NS5PART ? s5[lane] : 0.f); s5s = wave_sum(s5s);
        const float r5 = 1.0f / sqrtf(s5s * (1.0f / 1024.0f) + EPSF);
        bf16* yr = WSP(bf16, WS_Y) + (size_t)t * 2048;
#pragma unroll
        for (int j = 0; j < 4; ++j) { const int e0 = 512 * j + 8 * lane; const float sc = j >= 2 ? r5 : (j == 0 ? (lane < 32 ? rg[0] : rg[1]) : (lane < 32 ? rg[2] : rg[3]));
            v4u w = *(v4u*)(yr + e0);
            w.x = pk2(bflo(w.x) * sc, bfhi(w.x) * sc); w.y = pk2(bflo(w.y) * sc, bfhi(w.y) * sc); w.z = pk2(bflo(w.z) * sc, bfhi(w.z) * sc); w.w = pk2(bflo(w.w) * sc, bfhi(w.w) * sc);
            *(v4u*)(yr + e0) = w; }
    }
}
constexpr int SSD_CS = 0, SSD_BS = 34816, SSD_BWT = 69632, SSD_XDT = 104448, SSD_PREV = 121856, SSD_XS = 139264, SSD_CSF = 157696, SSD_DTF = 158208, SSD_PITCH = 272, SSD_XPITCH = 144;
static_assert(SSD_DTF + 512 <= LDS_MAIN, "SSD LDS map");
__device__ __forceinline__ bf16x8 lds_frag(LAS unsigned char* base, int row, int kbyte) { return *(const LAS bf16x8*)(base + row * SSD_PITCH + kbyte); }
__device__ __forceinline__ void p3_ssd(Frame& F) {
    const int tid = threadIdx.x, lane = tid & 63, w = __builtin_amdgcn_readfirstlane(tid >> 6);
    const int li = lane & 15, lq = lane >> 4;
    LAS unsigned char* L = F.lds;
    LAS float* csf = (LAS float*)(L + SSD_CSF); LAS float* dtf = (LAS float*)(L + SSD_DTF);
    const bf16* proj = WSP(bf16, WS_PROJ);
    for (int item = F.vcu; item < NB * NHEADS; item += F.G) {
        const int b = item >> 4, h = item & 15, g = h >> 2;
        const float A = -__expf((F.a->in[9])[h]), Dh = (F.a->in[10])[h], dtb = (F.a->in[8])[h];
        const int pbs = w >> 1, nb0 = 4 * (w & 1);
        f32x4 st[4];
#pragma unroll
        for (int j = 0; j < 4; ++j) st[j] = (f32x4){0.f, 0.f, 0.f, 0.f};
        for (int i = tid; i < 17408 / 16; i += NTHR) ((LAS v4u*)(L + SSD_PREV))[i] = (v4u){0u, 0u, 0u, 0u};
        for (int c = 0; c < SEQ / CHUNK; ++c) {
            const size_t row0 = (size_t)b * SEQ + (size_t)c * CHUNK;
            if (w == 0) {
                const float d0 = softplus_f(WSP(float, WS_DTRAW)[(row0 + 2 * lane) * 16 + h] + dtb), d1 = softplus_f(WSP(float, WS_DTRAW)[(row0 + 2 * lane + 1) * 16 + h] + dtb);
                const float a0 = d0 * A, a1 = d1 * A; float s = a0 + a1;
#pragma unroll
                for (int o = 1; o < 64; o <<= 1) { const float t = __shfl_up(s, o); if (lane >= o) s += t; }
                dtf[2 * lane] = d0; dtf[2 * lane + 1] = d1; csf[2 * lane] = s - a1; csf[2 * lane + 1] = s;
            }
            __syncthreads();
            const float cs_end = csf[127];
            for (int it = tid; it < 1280; it += NTHR) {
                const int o = it % 40, rg = it / 40, l0 = 4 * rg;
                const int xcol = o < 8 ? h * 64 + 8 * o : (o < 24 ? 1024 + g * 128 + 8 * (o - 8) : 1536 + g * 128 + 8 * (o - 24));
                float raw[7][8];
#pragma unroll
                for (int k = 0; k < 7; ++k) { const int l = l0 - 3 + k; const bool ok = (c > 0) || (l >= 0);
                    v4u wv = (v4u){0u, 0u, 0u, 0u}; if (ok) wv = *(const v4u*)(proj + (size_t)((long)row0 + l) * NPROJ + 1024 + xcol);
                    raw[k][0] = bflo(wv.x); raw[k][1] = bfhi(wv.x); raw[k][2] = bflo(wv.y); raw[k][3] = bfhi(wv.y); raw[k][4] = bflo(wv.z); raw[k][5] = bfhi(wv.z); raw[k][6] = bflo(wv.w); raw[k][7] = bfhi(wv.w); }
                float cw[4][8], cbv[8];
#pragma unroll
                for (int k = 0; k < 4; ++k) { const f32x4 w0 = *(const f32x4*)((F.a->in[6]) + k * 2048 + xcol), w1 = *(const f32x4*)((F.a->in[6]) + k * 2048 + xcol + 4);
#pragma unroll
                    for (int e = 0; e < 4; ++e) { cw[k][e] = w0[e]; cw[k][4 + e] = w1[e]; } }
                { const f32x4 b0 = *(const f32x4*)((F.a->in[7]) + xcol), b1 = *(const f32x4*)((F.a->in[7]) + xcol + 4);
#pragma unroll
                    for (int e = 0; e < 4; ++e) { cbv[e] = b0[e]; cbv[4 + e] = b1[e]; } }
                float v[4][8];
#pragma unroll
                for (int r = 0; r < 4; ++r)
#pragma unroll
                    for (int i = 0; i < 8; ++i) v[r][i] = silu_f(cbv[i] + raw[r][i] * cw[0][i] + raw[r + 1][i] * cw[1][i] + raw[r + 2][i] * cw[2][i] + raw[r + 3][i] * cw[3][i]);
                if (o < 8) {
                    const int p0 = 8 * o;
#pragma unroll
                    for (int r = 0; r < 4; ++r) *(LAS v4u*)(L + SSD_XS + (l0 + r) * SSD_XPITCH + p0 * 2) = (v4u){pk2(v[r][0], v[r][1]), pk2(v[r][2], v[r][3]), pk2(v[r][4], v[r][5]), pk2(v[r][6], v[r][7])};
                    const float t0 = dtf[l0], t1 = dtf[l0 + 1], t2 = dtf[l0 + 2], t3 = dtf[l0 + 3];
#pragma unroll
                    for (int i = 0; i < 8; ++i) *(LAS v2u*)(L + SSD_XDT + (p0 + i) * SSD_PITCH + l0 * 2) = (v2u){pk2(v[0][i] * t0, v[1][i] * t1), pk2(v[2][i] * t2, v[3][i] * t3)};
                } else if (o < 24) {
                    const int n0 = 8 * (o - 8);
#pragma unroll
                    for (int r = 0; r < 4; ++r) *(LAS v4u*)(L + SSD_BS + (l0 + r) * SSD_PITCH + n0 * 2) = (v4u){pk2(v[r][0], v[r][1]), pk2(v[r][2], v[r][3]), pk2(v[r][4], v[r][5]), pk2(v[r][6], v[r][7])};
                    const float t0 = __expf(cs_end - csf[l0]), t1 = __expf(cs_end - csf[l0 + 1]), t2 = __expf(cs_end - csf[l0 + 2]), t3 = __expf(cs_end - csf[l0 + 3]);
#pragma unroll
                    for (int i = 0; i < 8; ++i) *(LAS v2u*)(L + SSD_BWT + (n0 + i) * SSD_PITCH + l0 * 2) = (v2u){pk2(v[0][i] * t0, v[1][i] * t1), pk2(v[2][i] * t2, v[3][i] * t3)};
                } else {
                    const int n0 = 8 * (o - 24);
#pragma unroll
                    for (int r = 0; r < 4; ++r) *(LAS v4u*)(L + SSD_CS + (l0 + r) * SSD_PITCH + n0 * 2) = (v4u){pk2(v[r][0], v[r][1]), pk2(v[r][2], v[r][3]), pk2(v[r][4], v[r][5]), pk2(v[r][6], v[r][7])};
                }
            }
            __syncthreads();
            bf16x8 ca[4];
#pragma unroll
            for (int ks = 0; ks < 4; ++ks) ca[ks] = lds_frag(L + SSD_CS, 16 * w + li, 64 * ks + 16 * lq);
            f32x4 cb[8];
#pragma unroll
            for (int sb = 0; sb < 8; ++sb) { cb[sb] = (f32x4){0.f, 0.f, 0.f, 0.f};
                if (sb <= w) {
#pragma unroll
                    for (int ks = 0; ks < 4; ++ks) cb[sb] = __builtin_amdgcn_mfma_f32_16x16x32_bf16(ca[ks], lds_frag(L + SSD_BS, 16 * sb + li, 64 * ks + 16 * lq), cb[sb], 0, 0, 0); } }
            float csl[4];
#pragma unroll
            for (int r = 0; r < 4; ++r) csl[r] = csf[16 * w + 4 * lq + r];
#pragma unroll
            for (int sb = 0; sb < 8; ++sb) if (sb <= w) { const int s = 16 * sb + li; const float css = csf[s];
#pragma unroll
                for (int r = 0; r < 4; ++r) { const int l = 16 * w + 4 * lq + r; cb[sb][r] = (s <= l) ? cb[sb][r] * __expf(csl[r] - css) : 0.f; } }
            __syncthreads();
#pragma unroll
            for (int sb = 0; sb < 8; ++sb) if (sb <= (w | 1)) {
#pragma unroll
                for (int r = 0; r < 4; ++r) *(LAS unsigned short*)(L + SSD_BS + (16 * w + 4 * lq + r) * SSD_PITCH + (16 * sb + li) * 2) = (unsigned short)f2bf(cb[sb][r]); }
            LDS_WAIT(); asm volatile("" ::: "memory");
            f32x4 yd[4], yo[4];
#pragma unroll
            for (int pb = 0; pb < 4; ++pb) { yd[pb] = (f32x4){0.f, 0.f, 0.f, 0.f}; yo[pb] = (f32x4){0.f, 0.f, 0.f, 0.f}; }
#pragma unroll
            for (int ks = 0; ks < 4; ++ks) if (ks <= (w >> 1)) { const bf16x8 gf = lds_frag(L + SSD_BS, 16 * w + li, 64 * ks + 16 * lq);
#pragma unroll
                for (int pb = 0; pb < 4; ++pb) yd[pb] = __builtin_amdgcn_mfma_f32_16x16x32_bf16(gf, lds_frag(L + SSD_XDT, 16 * pb + li, 64 * ks + 16 * lq), yd[pb], 0, 0, 0); }
#pragma unroll
            for (int ks = 0; ks < 4; ++ks)
#pragma unroll
                for (int pb = 0; pb < 4; ++pb) yo[pb] = __builtin_amdgcn_mfma_f32_16x16x32_bf16(ca[ks], lds_frag(L + SSD_PREV, 16 * pb + li, 64 * ks + 16 * lq), yo[pb], 0, 0, 0);
#pragma unroll
            for (int r = 0; r < 4; ++r) { const float e = __expf(csl[r]);
#pragma unroll
                for (int pb = 0; pb < 4; ++pb) *(LAS float*)(L + SSD_BS + (16 * w + 4 * lq + r) * SSD_PITCH + (16 * pb + li) * 4) = yd[pb][r] + e * yo[pb][r]; }
            __syncthreads();
            { const float dec = __expf(cs_end);
#pragma unroll
              for (int j = 0; j < 4; ++j) st[j] = st[j] * dec;
#pragma unroll
              for (int ks = 0; ks < 4; ++ks) { const bf16x8 xf = lds_frag(L + SSD_XDT, 16 * pbs + li, 64 * ks + 16 * lq);
#pragma unroll
                  for (int j = 0; j < 4; ++j) st[j] = __builtin_amdgcn_mfma_f32_16x16x32_bf16(xf, lds_frag(L + SSD_BWT, 16 * (nb0 + j) + li, 64 * ks + 16 * lq), st[j], 0, 0, 0); }
#pragma unroll
              for (int j = 0; j < 4; ++j)
#pragma unroll
                  for (int r = 0; r < 4; ++r) *(LAS unsigned short*)(L + SSD_PREV + (16 * pbs + 4 * lq + r) * SSD_PITCH + (16 * (nb0 + j) + li) * 2) = (unsigned short)f2bf(st[j][r]); }
#pragma unroll
            for (int k = 0; k < 2; ++k) { const int it = tid + 512 * k, l = it >> 3, o = it & 7; const size_t row = row0 + l;
                const f32x4 y0 = *(const LAS f32x4*)(L + SSD_BS + l * SSD_PITCH + 32 * o), y1 = *(const LAS f32x4*)(L + SSD_BS + l * SSD_PITCH + 32 * o + 16);
                const v4u xw = *(const LAS v4u*)(L + SSD_XS + l * SSD_XPITCH + 16 * o); const v4u zw = *(const v4u*)(proj + row * NPROJ + h * 64 + 8 * o);
                float xv[8], zv[8], yv[8]; unpack8(xw, xv); unpack8(zw, zv);
                float ss = 0.f;
#pragma unroll
                for (int e = 0; e < 8; ++e) { const float yy = (e < 4 ? y0[e] : y1[e - 4]) + Dh * xv[e]; yv[e] = yy * silu_f(zv[e]); ss += yv[e] * yv[e]; }
                ss += __shfl_xor(ss, 1); ss += __shfl_xor(ss, 2); ss += __shfl_xor(ss, 4);
                if (o == 0) WSP(float, WS_STSSD)[row * 16 + h] = ss;
                *(v4u*)(WSP(bf16, WS_Y) + row * 2048 + h * 64 + 8 * o) = (v4u){pk2(yv[0], yv[1]), pk2(yv[2], yv[3]), pk2(yv[4], yv[5]), pk2(yv[6], yv[7])}; }
            __syncthreads();
        }
    }
}
constexpr int S5_XT = 0, S5_XPITCH = 2056, S5_BBT = 65792, S5_CC = S5_BBT + 16384, S5_CCPITCH = 272, S5_GLU = S5_CC + 64 * S5_CCPITCH, S5_VS = S5_GLU + 2048, S5_OT = S5_VS + 8 * 512, S5_OPITCH = 144, S5_END = S5_OT + 32 * S5_OPITCH;
static_assert(S5_END <= LDS_MAIN, "S5 LDS map");
typedef float f32x16 __attribute__((ext_vector_type(16)));
__device__ __forceinline__ void p3_s5(Frame& F) {
    const int tid = threadIdx.x, lane = tid & 63, w = __builtin_amdgcn_readfirstlane(tid >> 6);
    const int li = lane & 15, lq = lane >> 4;
    LAS unsigned char* L = F.lds;
    const bf16* proj = WSP(bf16, WS_PROJ);
    for (int item = F.vcu; item < NB * 16; item += F.G) {
        const int b = item >> 4, gs = item & 15;
        __syncthreads();
        { const int gl = tid >> 7, col = tid & 127, p = col >> 1, ri = col & 1; const float* src = WSP(float, WS_S5BB) + ((gs * 4 + gl) * 64 + p) * 32 + ri * 16;
          const f32x4 a0 = *(const f32x4*)src, a1 = *(const f32x4*)(src + 4), a2 = *(const f32x4*)(src + 8), a3 = *(const f32x4*)(src + 12);
          LAS v4u* d = (LAS v4u*)(L + S5_BBT + (gl * 128 + col) * 32);
          d[0] = (v4u){pk2(a0[0], a0[1]), pk2(a0[2], a0[3]), pk2(a1[0], a1[1]), pk2(a1[2], a1[3])}; d[1] = (v4u){pk2(a2[0], a2[1]), pk2(a2[2], a2[3]), pk2(a3[0], a3[1]), pk2(a3[2], a3[3])}; }
        { const int gl = tid >> 7, hh = (tid >> 3) & 15, kq = tid & 7; const int g = gs * 4 + gl; const float* cr = (F.a->in[17]) + (g * 16 + hh) * 64 + 8 * kq; const float* ci = (F.a->in[18]) + (g * 16 + hh) * 64 + 8 * kq;
          const f32x4 r0 = *(const f32x4*)cr, r1 = *(const f32x4*)(cr + 4), i0 = *(const f32x4*)ci, i1 = *(const f32x4*)(ci + 4);
          LAS v4u* d = (LAS v4u*)(L + S5_CC + (gl * 16 + hh) * S5_CCPITCH + kq * 32);
          d[0] = (v4u){pk2(r0[0], -i0[0]), pk2(r0[1], -i0[1]), pk2(r0[2], -i0[2]), pk2(r0[3], -i0[3])}; d[1] = (v4u){pk2(r1[0], -i1[0]), pk2(r1[1], -i1[1]), pk2(r1[2], -i1[2]), pk2(r1[3], -i1[3])}; }
        for (int i = tid; i < 1024; i += NTHR) { const int gl = i >> 8, k = (i >> 4) & 15, hh = i & 15; ((LAS unsigned short*)(L + S5_GLU))[i] = (unsigned short)f2bf((F.a->in[20])[((gs * 4 + gl) * 16 + hh) * 16 + k]); }
        const int gsc = gs * 4 + (w & 3);
        const float lbr = WSP(float, WS_S5LB)[(gsc * 64 + lane) * 2], lbi = WSP(float, WS_S5LB)[(gsc * 64 + lane) * 2 + 1];
        const int glo = w >> 1, mb = w & 1, go = gs * 4 + glo;
        const float dsk = (F.a->in[19])[go * 16 + li], gbias = (F.a->in[21])[go * 16 + li];
        float xr = 0.f, xi = 0.f;
        __syncthreads();
        const bf16* ubase = proj + (size_t)b * SEQ * NPROJ + 3072 + gs * 64;
        v4u ua = *(const v4u*)(ubase + (size_t)(lane & 31) * NPROJ + glo * 16 + 8 * (lane >> 5));
        for (int t0 = 0; t0 < SEQ; t0 += 32) {
            const bf16x8 af = __builtin_bit_cast(bf16x8, ua);
            if (t0 + 32 < SEQ) ua = *(const v4u*)(ubase + (size_t)(t0 + 32 + (lane & 31)) * NPROJ + glo * 16 + 8 * (lane >> 5));
            float uo[4];
#pragma unroll
            for (int r = 0; r < 4; ++r) uo[r] = bf2f(ubase[(size_t)(t0 + 16 * mb + 4 * lq + r) * NPROJ + glo * 16 + li]);
#pragma unroll
            for (int q = 0; q < 2; ++q) { const int cb = 2 * (w & 1) + q;
                const bf16x8 bfrag = *(const LAS bf16x8*)(L + S5_BBT + (glo * 128 + 32 * cb + (lane & 31)) * 32 + 16 * (lane >> 5));
                f32x16 acc;
#pragma unroll
                for (int r = 0; r < 16; ++r) acc[r] = 0.f;
                acc = __builtin_amdgcn_mfma_f32_32x32x16_bf16(af, bfrag, acc, 0, 0, 0);
#pragma unroll
                for (int r = 0; r < 16; ++r) { const int t = (r & 3) + 8 * (r >> 2) + 4 * (lane >> 5); *(LAS float*)(L + S5_XT + t * S5_XPITCH + (glo * 128 + 32 * cb + (lane & 31)) * 4) = acc[r]; } }
            __syncthreads();
            if (w < 4) { LAS f32x2* xp = (LAS f32x2*)(L + S5_XT + (w * 128 + 2 * lane) * 4);
#pragma unroll 8
                for (int t = 0; t < 32; ++t) { const f32x2 bu = xp[t * (S5_XPITCH / 8)]; const float nr = lbr * xr - lbi * xi + bu[0], ni = lbr * xi + lbi * xr + bu[1]; xr = nr; xi = ni; xp[t * (S5_XPITCH / 8)] = (f32x2){xr, xi}; } }
            __syncthreads();
            f32x4 yacc = (f32x4){0.f, 0.f, 0.f, 0.f};
#pragma unroll
            for (int ks = 0; ks < 4; ++ks) { const LAS float* xs = (const LAS float*)(L + S5_XT + (16 * mb + li) * S5_XPITCH + (glo * 128 + 32 * ks + 8 * lq) * 4);
                const f32x4 x0 = *(const LAS f32x4*)xs, x1 = *(const LAS f32x4*)(xs + 4);
                const v4u xa = (v4u){pk2(x0[0], x0[1]), pk2(x0[2], x0[3]), pk2(x1[0], x1[1]), pk2(x1[2], x1[3])};
                const bf16x8 cf = *(const LAS bf16x8*)(L + S5_CC + (glo * 16 + li) * S5_CCPITCH + 64 * ks + 16 * lq);
                yacc = __builtin_amdgcn_mfma_f32_16x16x32_bf16(__builtin_bit_cast(bf16x8, xa), cf, yacc, 0, 0, 0); }
            float v[4];
#pragma unroll
            for (int r = 0; r < 4; ++r) v[r] = gelu_erf(yacc[r] + dsk * uo[r]);
            LAS unsigned char* vs = L + S5_VS + w * 512;
#pragma unroll
            for (int r = 0; r < 4; ++r) *(LAS unsigned short*)(vs + (4 * lq + r) * 32 + li * 2) = (unsigned short)f2bf(v[r]);
            LDS_WAIT(); asm volatile("" ::: "memory");
            v4u va = (v4u){0u, 0u, 0u, 0u}, gw = (v4u){0u, 0u, 0u, 0u};
            if (lq < 2) { va = *(const LAS v4u*)(vs + li * 32 + 16 * lq); gw = *(const LAS v4u*)(L + S5_GLU + ((glo * 16 + li) * 16 + 8 * lq) * 2); }
            f32x4 gacc = (f32x4){0.f, 0.f, 0.f, 0.f};
            gacc = __builtin_amdgcn_mfma_f32_16x16x32_bf16(__builtin_bit_cast(bf16x8, va), __builtin_bit_cast(bf16x8, gw), gacc, 0, 0, 0);
            float o[4], ss[4];
#pragma unroll
            for (int r = 0; r < 4; ++r) { o[r] = v[r] / (1.0f + __expf(-(gacc[r] + gbias))); ss[r] = o[r] * o[r]; }
#pragma unroll
            for (int r = 0; r < 4; ++r) { ss[r] += __shfl_xor(ss[r], 1); ss[r] += __shfl_xor(ss[r], 2); ss[r] += __shfl_xor(ss[r], 4); ss[r] += __shfl_xor(ss[r], 8); }
            if (li == 0) {
#pragma unroll
                for (int r = 0; r < 4; ++r) WSP(float, WS_STS5)[((size_t)b * SEQ + t0 + 16 * mb + 4 * lq + r) * NS5PART + go] = ss[r]; }
#pragma unroll
            for (int r = 0; r < 4; ++r) *(LAS unsigned short*)(L + S5_OT + (16 * mb + 4 * lq + r) * S5_OPITCH + (glo * 16 + li) * 2) = (unsigned short)f2bf(o[r]);
            __syncthreads();
            if (tid < 256) { const int t = tid >> 3, oc = tid & 7; const v4u ov = *(const LAS v4u*)(L + S5_OT + t * S5_OPITCH + 16 * oc);
                *(v4u*)(WSP(bf16, WS_Y) + ((size_t)b * SEQ + t0 + t) * 2048 + 1024 + gs * 64 + 8 * oc) = ov; }
        }
    }
}
__device__ __forceinline__ unsigned med3u(unsigned a, unsigned b, unsigned c) { unsigned r; asm("v_med3_u32 %0, %1, %2, %3" : "=v"(r) : "v"(a), "v"(b), "v"(c)); return r; }
__device__ __forceinline__ unsigned fkey(float v) { const unsigned u = __builtin_bit_cast(unsigned, v); return (u & 0x80000000u) ? ~u : (u | 0x80000000u); }
__device__ __forceinline__ float fkey_inv(unsigned k) { const unsigned u = (k & 0x80000000u) ? (k & 0x7fffffffu) : ~k; return __builtin_bit_cast(float, u); }
#define TOPK_INSERT(a, x) do { _Pragma("unroll") for (int _i = 15; _i >= 1; --_i) a[_i] = med3u(a[_i - 1], a[_i], (x)); a[0] = a[0] > (x) ? a[0] : (x); } while (0)
__device__ __forceinline__ void p5b_topk(Frame& F) {
    const int f_tid = threadIdx.x, f_lane = f_tid & 63, f_wave = __builtin_amdgcn_readfirstlane(f_tid >> 6);
    const float* scores = WSP(float, WS_SCORES);
    LAS unsigned char* ix = (LAS unsigned char*)F.lds + f_tid * 36;
    for (int item = F.vcu * NTHR + f_tid; item < MTOK * PH; item += F.G * NTHR) {
        const int t = item >> 3, hd = item & 7;
        unsigned a1[16], a2[16];
#pragma unroll
        for (int i = 0; i < 16; ++i) { a1[i] = 0u; a2[i] = 0u; }
        const float* sp = scores + (size_t)t * 2048 + hd * 256;
#pragma unroll 2
        for (int q = 0; q < 32; ++q) { const f32x4 s = *(const f32x4*)(sp + 4 * q);
#pragma unroll
            for (int e = 0; e < 4; ++e) { const unsigned k = (fkey(s[e]) & ~127u) | (unsigned)(127 - (4 * q + e)); TOPK_INSERT(a1, k); } }
#pragma unroll 2
        for (int q = 0; q < 32; ++q) { const f32x4 s = *(const f32x4*)(sp + 128 + 4 * q);
#pragma unroll
            for (int e = 0; e < 4; ++e) { const unsigned k = (fkey(s[e]) & ~127u) | (unsigned)(127 - (4 * q + e)); TOPK_INSERT(a2, k); } }
        float v1[16], v2[16];
#pragma unroll
        for (int i = 0; i < 16; ++i) { ix[i] = (unsigned char)(127u - (a1[i] & 127u)); ix[16 + i] = (unsigned char)(127u - (a2[i] & 127u)); v1[i] = fkey_inv(a1[i] & ~127u); v2[i] = fkey_inv(a2[i] & ~127u); }
        unsigned cb[16];
#pragma unroll
        for (int i = 0; i < 16; ++i) cb[i] = 0u;
#pragma unroll
        for (int i = 0; i < 16; ++i)
#pragma unroll
            for (int j = 0; j < 16; ++j) if ((i + 1) * (j + 1) <= 16) { const unsigned k = (fkey(v1[i] + v2[j]) & ~255u) | (unsigned)(255 - (i * 16 + j)); TOPK_INSERT(cb, k); }
        float tv[16]; float mx = -3.0e38f;
#pragma unroll
        for (int k = 0; k < 16; ++k) { tv[k] = fkey_inv(cb[k] & ~255u); mx = fmaxf(mx, tv[k]); }
        float sum = 0.f;
#pragma unroll
        for (int k = 0; k < 16; ++k) { tv[k] = __expf(tv[k] - mx); sum += tv[k]; }
        const float inv = 1.0f / sum;
        LDS_WAIT(); asm volatile("" ::: "memory");
        int ev[16]; unsigned long long c64 = 0ull;
#pragma unroll
        for (int k = 0; k < 16; ++k) { const unsigned code = 255u - (cb[k] & 255u); const int i = code >> 4, j = code & 15; ev[k] = (int)ix[i] * 128 + (int)ix[16 + j]; c64 += 1ull << (8 * (ev[k] >> 11)); }
        unsigned long long s64 = c64;
#pragma unroll
        for (int o = 1; o < 8; o <<= 1) { const unsigned lo = __shfl_up((unsigned)s64, o, 8), hi = __shfl_up((unsigned)(s64 >> 32), o, 8); if ((f_lane & 7) >= o) s64 += ((unsigned long long)hi << 32) | lo; }
        const unsigned long long e64 = s64 - c64;
        const unsigned long long t64 = ((unsigned long long)__shfl((unsigned)(s64 >> 32), 7, 8) << 32) | __shfl((unsigned)s64, 7, 8);
        const unsigned long long st64 = (t64 * 0x0101010101010101ull) << 8;
        unsigned long long base64 = st64 + e64;
        int* eo = WSP(int, WS_EID) + (size_t)t * 128; float* go = WSP(float, WS_GATE) + (size_t)t * 128;
#pragma unroll
        for (int k = 0; k < 16; ++k) { const int r8 = 8 * (ev[k] >> 11); const int slot = (int)((base64 >> r8) & 255ull); base64 += 1ull << r8; eo[slot] = ev[k]; go[slot] = tv[k] * inv; }
        if (hd == 0) WSP(unsigned long long, WS_START)[t] = st64;
        LDS_WAIT(); asm volatile("" ::: "memory");
    }
}
__device__ __forceinline__ void dec16(const v4u q, float* f) {
#pragma unroll
    for (int i = 0; i < 4; ++i) { const f32x2 lo = __builtin_amdgcn_cvt_pk_f32_fp8((int)q[i], false), hi = __builtin_amdgcn_cvt_pk_f32_fp8((int)q[i], true); f[4 * i] = lo[0]; f[4 * i + 1] = lo[1]; f[4 * i + 2] = hi[0]; f[4 * i + 3] = hi[1]; }
}
__device__ __forceinline__ void p8_peer_up(Frame& F) {
    const int f_tid = threadIdx.x, lane = f_tid & 63, f_wave = __builtin_amdgcn_readfirstlane(f_tid >> 6);
    const int rr = blockIdx.x & 7, wk = (blockIdx.x >> 3) * NWAVES + f_wave, nwk = (F.G >> 3) * NWAVES;
    const unsigned char* EU = F.ws + WS_EU;
    for (int blk = wk; blk < MTOK / 128; blk += nwk) {
        const int b = blk >> 4; const float* mb = WSP(float, WS_MOD) + (size_t)b * 6144;
        float S2[16];
#pragma unroll
        for (int q = 0; q < 4; ++q) { const f32x4 sh = *(const f32x4*)(mb + 3072 + 16 * lane + 4 * q); S2[4 * q] = sh[0]; S2[4 * q + 1] = sh[1]; S2[4 * q + 2] = sh[2]; S2[4 * q + 3] = sh[3]; }
        for (int tt = 0; tt < 128; ++tt) {
            const size_t t = (size_t)blk * 128 + tt;
            const unsigned long long st64 = WSP(unsigned long long, WS_START)[t];
            const int s0 = (int)((st64 >> (8 * rr)) & 255ull), s1 = rr == 7 ? 128 : (int)((st64 >> (8 * rr + 8)) & 255ull), cnt = s1 - s0;
            if (cnt <= 0) continue;
            const float rs = 1.0f / sqrtf(WSP(float, WS_ROWSTAT)[t] * (1.0f / 1024.0f) + EPSF);
            const bf16* xr = WSP(bf16, WS_X1S) + t * 1024 + 16 * lane; const v4u xa = *(const v4u*)xr, xb = *(const v4u*)(xr + 8);
            float h2[16]; unpack8(xa, h2); unpack8(xb, h2 + 8);
#pragma unroll
            for (int i = 0; i < 16; ++i) h2[i] = h2[i] * rs + S2[i];
            int* ep = WSP(int, WS_EID) + t * 128 + s0; float* gp = WSP(float, WS_GATE) + t * 128 + s0;
            for (int j0 = 0; j0 < cnt; j0 += 8) {
                const int myi = j0 + (lane & 7) < cnt ? j0 + (lane & 7) : cnt - 1;
                const int emine = ep[myi]; const float gmine = gp[myi];
                v4u q[8];
#pragma unroll
                for (int j = 0; j < 8; ++j) { const int e = __shfl(emine, j); q[j] = *(const v4u*)(EU + (size_t)e * 1024 + 16 * lane); }
                float d[8];
#pragma unroll
                for (int j = 0; j < 8; ++j) { float f[16]; dec16(q[j], f); float a = 0.f;
#pragma unroll
                    for (int i = 0; i < 16; ++i) a += h2[i] * f[i];
                    d[j] = a; }
                float e4[4], e2[2], e1;
#pragma unroll
                for (int i = 0; i < 4; ++i) { const bool up = lane & 32; const float snd = up ? d[i] : d[i + 4]; const float rcv = __shfl_xor(snd, 32); e4[i] = (up ? d[i + 4] : d[i]) + rcv; }
#pragma unroll
                for (int i = 0; i < 2; ++i) { const bool up = lane & 16; const float snd = up ? e4[i] : e4[i + 2]; const float rcv = __shfl_xor(snd, 16); e2[i] = (up ? e4[i + 2] : e4[i]) + rcv; }
                { const bool up = lane & 8; const float snd = up ? e2[0] : e2[1]; const float rcv = __shfl_xor(snd, 8); e1 = (up ? e2[1] : e2[0]) + rcv; }
                e1 += __shfl_xor(e1, 4); e1 += __shfl_xor(e1, 2); e1 += __shfl_xor(e1, 1);
                const int myj = ((lane >> 5) & 1) * 4 + ((lane >> 4) & 1) * 2 + ((lane >> 3) & 1);
                const int ej = __shfl(emine, myj); const float gj = __shfl(gmine, myj);
                const float wv = gj * gelu_erf(e1 * WSP(float, WS_EUS)[ej]) * WSP(float, WS_EVS)[ej];
                if ((lane & 7) == 0 && j0 + myj < cnt) gp[j0 + myj] = wv;
            }
        }
    }
}
__device__ __forceinline__ void p9_peer_down(Frame& F) {
    const int f_tid = threadIdx.x, lane = f_tid & 63, f_wave = __builtin_amdgcn_readfirstlane(f_tid >> 6);
    const unsigned char* EV = F.ws + WS_EV;
    for (int wq = F.vcu * NWAVES + f_wave; wq < MTOK / 16; wq += F.G * NWAVES) {
        const int b = wq >> 7; const float* mb = WSP(float, WS_MOD) + (size_t)b * 6144;
        float GT[16], NF[16];
#pragma unroll
        for (int q = 0; q < 4; ++q) { const f32x4 gt = *(const f32x4*)(mb + 5120 + 16 * lane + 4 * q), nf = *(const f32x4*)((F.a->in[29]) + 16 * lane + 4 * q);
#pragma unroll
            for (int e = 0; e < 4; ++e) { GT[4 * q + e] = gt[e]; NF[4 * q + e] = nf[e]; } }
        for (int tt = 0; tt < 16; ++tt) {
            const size_t t = (size_t)wq * 16 + tt; float* xr = F.out + t * 1024 + 16 * lane;
            const int e_lo = WSP(int, WS_EID)[t * 128 + lane], e_hi = WSP(int, WS_EID)[t * 128 + 64 + lane];
            const float w_lo = WSP(float, WS_GATE)[t * 128 + lane], w_hi = WSP(float, WS_GATE)[t * 128 + 64 + lane];
            f32x2 o[8];
#pragma unroll
            for (int i = 0; i < 8; ++i) o[i] = (f32x2){0.f, 0.f};
            for (int grp = 0; grp < 16; ++grp) {
                const int esel = grp < 8 ? e_lo : e_hi; const float wsel = grp < 8 ? w_lo : w_hi; const int base = (grp & 7) * 8;
                v4u q[8];
#pragma unroll
                for (int j = 0; j < 8; ++j) { const int e = __shfl(esel, base + j); q[j] = *(const v4u*)(EV + (size_t)e * 1024 + 16 * lane); }
#pragma unroll
                for (int j = 0; j < 8; ++j) { const float wj = __shfl(wsel, base + j); const f32x2 w2 = (f32x2){wj, wj};
#pragma unroll
                    for (int i = 0; i < 4; ++i) { const f32x2 lo = __builtin_amdgcn_cvt_pk_f32_fp8((int)q[j][i], false), hi = __builtin_amdgcn_cvt_pk_f32_fp8((int)q[j][i], true); o[2 * i] += w2 * lo; o[2 * i + 1] += w2 * hi; } }
            }
            float x1[16]; float ss = 0.f;
#pragma unroll
            for (int q = 0; q < 4; ++q) { const f32x4 v = *(const f32x4*)(xr + 4 * q); x1[4 * q] = v[0]; x1[4 * q + 1] = v[1]; x1[4 * q + 2] = v[2]; x1[4 * q + 3] = v[3]; }
#pragma unroll
            for (int i = 0; i < 16; ++i) { x1[i] += GT[i] * o[i >> 1][i & 1]; ss += x1[i] * x1[i]; }
            const float rf = 1.0f / sqrtf(wave_sum(ss) * (1.0f / 1024.0f) + EPSF);
#pragma unroll
            for (int q = 0; q < 4; ++q) { f32x4 v;
#pragma unroll
                for (int e = 0; e < 4; ++e) v[e] = x1[4 * q + e] * rf * NF[4 * q + e];
                *(f32x4*)(xr + 4 * q) = v; }
        }
    }
}
constexpr int NPHASE = 10;
__global__ void __launch_bounds__(NTHR, 2) fwd_mega(Args args) {
    extern __shared__ __attribute__((aligned(16))) unsigned char lds[];
    Frame F;
    F.lds = (LAS unsigned char*)lds;
    F.MISC = (volatile LAS unsigned*)(F.lds + MISC_OFF);
    F.G = gridDim.x; { const int bx = blockIdx.x; F.vcu = (F.G % 8 == 0) ? (bx % 8) * (F.G / 8) + bx / 8 : bx; }
    F.ws = args.ws; F.out = args.out;
    F.a = &args;
    for (int u = threadIdx.x; u < 32; u += NTHR) F.MISC[u] = 0u;
    __syncthreads();
    const int lo = args.ph_lo, hi = args.ph_hi;
    const bool use_bar = (hi - lo) > 1;
    XcdBarrier bar; bar.bar = (unsigned*)(F.ws + WS_CTL); bar.x = 0; bar.st = nullptr;
    if (use_bar) bar = xcd_barrier_post((unsigned*)(F.ws + WS_CTL), F.MISC + 8);
#define IN(k) (lo <= (k) && (k) < hi)
#define SEAM(k) do { if (IN(k) && IN((k) + 1)) xcd_barrier(bar); } while (0)
    if (IN(0)) {
#ifndef SKIP_P0
 p0_phase(F);
#endif
 } SEAM(0);
    if (IN(1)) {
#ifndef SKIP_P1
 p1_phase(F);
#endif
 } SEAM(1);
    if (IN(2)) {
        pg8::Gemm g{WSP(bf16, WS_H1), WSP(bf16, WS_WINT), MTOK, NPROJ, 1024}; pg8::StaticOrder S; S.init(MTOK, NPROJ, F.G, (int)blockIdx.x);
        pg8::EpiProj E{WSP(bf16, WS_PROJ), NPROJ};
        pg8::gemm_phase<pg8::EpiProj, pg8::StaticOrder, true, true>(F.lds, g, S, E);
    } SEAM(2);
    if (IN(3)) {
#ifndef SKIP_SSD
#ifdef SSD_NAIVE
 p3_ssd_naive(F);
#else
 p3_ssd(F);
#endif
#endif
#ifndef SKIP_S5
#ifdef S5_NAIVE
 p3_s5_naive(F);
#else
 p3_s5(F);
#endif
#endif
 } SEAM(3);
    if (IN(4)) {
#ifndef SKIP_P3C
 p3c_normalize(F);
#endif
 } SEAM(4);
    if (IN(5)) {
        pg8::Gemm g{WSP(bf16, WS_Y), WSP(bf16, WS_WOUTT), MTOK, 1024, 2048}; pg8::StaticOrder S; S.init(MTOK, 1024, F.G, (int)blockIdx.x);
        pg8::EpiX1 E{(F.a->in[0]), F.out, WSP(bf16, WS_X1S), WSP(float, WS_MOD), (F.a->in[24]), WSP(float, WS_ROWSTAT)};
        pg8::gemm_phase<pg8::EpiX1, pg8::StaticOrder, true, true>(F.lds, g, S, E);
    } SEAM(5);
    if (IN(6)) {
        pg8::Gemm g{WSP(bf16, WS_X1S), WSP(bf16, WS_WQKT), MTOK, 2048, 1024}; pg8::StaticOrder S; S.init(MTOK, 2048, F.G, (int)blockIdx.x);
        pg8::EpiScores E{WSP(float, WS_SCORES), WSP(float, WS_SB), WSP(float, WS_ROWSTAT)};
        pg8::gemm_phase<pg8::EpiScores, pg8::StaticOrder, true, true>(F.lds, g, S, E);
    } SEAM(6);
    if (IN(7)) {
#ifndef SKIP_TOPK
 p5b_topk(F);
#endif
 } SEAM(7);
    if (IN(8)) { p8_peer_up(F); } SEAM(8);
    if (IN(9)) { p9_peer_down(F); }
#undef IN
#undef SEAM
}

#ifndef N_LAUNCHES
#define N_LAUNCHES 1
#endif
extern "C" void kernel_launch(void* const* d_in, const int* in_sizes, int n_in, void* d_out, int out_size, void* d_ws, size_t ws_size, hipStream_t stream) {
    static int grid = 0;
    if (grid == 0) {
        if (n_in != 30 || in_sizes[0] != MTOK * DM || out_size != MTOK * DM || ws_size < WS_END) { fprintf(stderr, "kernel_launch: unexpected shapes (n_in %d, in0 %d, out %d, ws %zu)\n", n_in, n_in > 0 ? in_sizes[0] : -1, out_size, ws_size); grid = -1; return; }
        int dev = 0, cus = 0, per_cu = 0;
        if (hipGetDevice(&dev) != hipSuccess || hipDeviceGetAttribute(&cus, hipDeviceAttributeMultiprocessorCount, dev) != hipSuccess) { grid = -1; return; }
        if (hipFuncSetAttribute((const void*)fwd_mega, hipFuncAttributeMaxDynamicSharedMemorySize, LDS_BYTES) != hipSuccess) { fprintf(stderr, "kernel_launch: hipFuncSetAttribute failed\n"); grid = -1; return; }
        if (hipOccupancyMaxActiveBlocksPerMultiprocessor(&per_cu, (const void*)fwd_mega, NTHR, LDS_BYTES) != hipSuccess || per_cu < 1) { fprintf(stderr, "kernel_launch: occupancy query says %d\n", per_cu); (void)hipGetLastError(); grid = -1; return; }
        grid = cus;
    }
    if (grid < 0) return;
    (void)hipMemsetAsync((char*)d_ws + WS_CTL, 0, CTL_ZERO_BYTES, stream);
    Args a{};
    for (int i = 0; i < 30; ++i) a.in[i] = (const float*)d_in[i];
    a.out = (float*)d_out; a.ws = (unsigned char*)d_ws;
    if (N_LAUNCHES == 1) {
        a.ph_lo = 0; a.ph_hi = NPHASE;
        void* kargs[] = {&a};
        hipError_t e = hipLaunchCooperativeKernel((const void*)fwd_mega, dim3(grid), dim3(NTHR), kargs, LDS_BYTES, stream);
        if (e != hipSuccess) fprintf(stderr, "kernel_launch: cooperative launch failed: %s (grid %d)\n", hipGetErrorString(e), grid);
    } else {
        for (int p = 0; p < NPHASE; ++p) { a.ph_lo = p; a.ph_hi = p + 1; hipLaunchKernelGGL(fwd_mega, dim3(grid), dim3(NTHR), LDS_BYTES, stream, a); }
    }
}
```

```cpp
#include <hip/hip_runtime.h>
#include <cstdio>
#include <cstdint>

namespace pg8 {
#define PG8_LAS __attribute__((address_space(3)))
typedef unsigned short bf16_t;
typedef short bf16x8 __attribute__((ext_vector_type(8)));
typedef float f32x4 __attribute__((ext_vector_type(4)));
typedef unsigned u32x4 __attribute__((ext_vector_type(4)));
constexpr int BM = 256, BK = 64, HALF = 128, HTB = HALF * BK * 2  , STAGE_BYTES = 8 * HTB, NXCD = 8, WGM = 8;

__host__ __device__ __forceinline__ int lds_byte(int r, int c) { const int st = (r >> 4) * 2 + (c >> 5), rr = r & 15, cc = c & 31, ob = rr * 64 + cc * 2; return st * 1024 + (ob ^ (((ob >> 9) & 1) << 5)); }
__host__ __device__ __forceinline__ void stage_rc(int b, int& R, int& C) { const int st = b / 1024, sb = b % 1024, swz = sb ^ (((sb >> 9) & 1) << 5); R = (st >> 1) * 16 + swz / 64; C = (st & 1) * 32 + (swz % 64) / 2; }
__host__ __device__ __forceinline__ int perm32(int rho) { const int n = rho >> 4, i = rho & 15; return 8 * (i >> 2) + 4 * n + (i & 3); }

struct Unit { int pm, pn; };
struct Gemm { const bf16_t* A; const bf16_t* Bt; int M, N, K; };

struct StaticOrder {
    int nM, nN, nwg, G, c;
    __host__ __device__ void init(int M, int N, int G_, int c_) { nM = M / BM; nN = N / BM; nwg = nM * nN; G = G_; c = c_; }
    __host__ __device__ bool next(int i, Unit& u) const {
        const long L = (long)i * G + c; if (L >= nwg) return false;
        int wgid = (int)L; { const int q = nwg / NXCD, r = nwg % NXCD, xcd = wgid % NXCD, off = wgid / NXCD; wgid = (xcd < r ? xcd * (q + 1) : r * (q + 1) + (xcd - r) * q) + off; }
        const int nig = WGM * nN, gid = wgid / nig, fm = gid * WGM, gsz = (nM - fm) < WGM ? (nM - fm) : WGM;
        u.pm = fm + ((wgid % nig) % gsz); u.pn = (wgid % nig) / gsz; return true;
    }
    __device__ __forceinline__ void a_ready(const Unit&) const {}
    __device__ __forceinline__ void done(const Unit&) const {}
};

__device__ __forceinline__ unsigned cvt_pk_bf16(float lo, float hi) { unsigned r; asm volatile("v_cvt_pk_bf16_f32 %0, %1, %2" : "=v"(r) : "v"(lo), "v"(hi)); return r; }
typedef float f32x2 __attribute__((ext_vector_type(2)));
template <class Epi, class Sched, bool ALIGN_EPI = false, bool SP2 = false>
__device__ __forceinline__ void gemm_phase(PG8_LAS unsigned char* lds, const Gemm g, const Sched& S, const Epi& E) {
    const int tid = threadIdx.x, wid = __builtin_amdgcn_readfirstlane(tid >> 6), lane = tid & 63, wr = wid >> 2, wc = wid & 3, fr = lane & 15, fq = lane >> 4;
    const int K = g.K, nt = K / BK;
    unsigned voffA[2], voffB[2];
#pragma unroll
    for (int i = 0; i < 2; ++i) { int R, C; stage_rc(tid * 16 + i * 8192, R, C); const int Rb = Epi::PERM ? ((R & ~31) + perm32(R & 31)) : R;
        voffA[i] = (unsigned)(R * K + C) * 2u; voffB[i] = (unsigned)(Rb * K + C) * 2u; }
    const size_t kstep = (size_t)(BK * 2);
    const size_t hstep = (size_t)HALF * K * 2;
    const size_t tstep = 2 * hstep;
    const unsigned ldsw = (unsigned)wid * 1024u;
    const int aoff = lds_byte(wr * 64 + fr, fq * 8), boff = lds_byte(wc * 32 + fr, fq * 8);
#define PG8_SA(b, h) (((b) * 2 + (h)) * HTB)
#define PG8_SB(b, h) ((4 + (b) * 2 + (h)) * HTB)
#define PG8_STAGE(bufoff, gbase, voff) do { _Pragma("unroll") for (int _i = 0; _i < 2; ++_i) \
        __builtin_amdgcn_global_load_lds((const unsigned*)((const char*)(gbase) + (voff)[_i]), (PG8_LAS unsigned*)(lds + (bufoff) + ldsw + _i * 8192), 16, 0, 0); } while (0)
#define PG8_LDA(dst, b, h) do { _Pragma("unroll") for (int m = 0; m < 4; ++m) _Pragma("unroll") for (int k = 0; k < 2; ++k) dst[m][k] = *(const PG8_LAS bf16x8*)(lds + PG8_SA(b, h) + aoff + m * 2048 + k * 1024); } while (0)
#define PG8_LDB(dst, b, h) do { _Pragma("unroll") for (int n = 0; n < 2; ++n) _Pragma("unroll") for (int k = 0; k < 2; ++k) dst[n][k] = *(const PG8_LAS bf16x8*)(lds + PG8_SB(b, h) + boff + n * 2048 + k * 1024); } while (0)
#define PG8_MMA(ai, bj, At, Bt) do { __builtin_amdgcn_s_setprio(1); _Pragma("unroll") for (int m = 0; m < 4; ++m) _Pragma("unroll") for (int n = 0; n < 2; ++n) _Pragma("unroll") for (int k = 0; k < 2; ++k) \
        acc[ai][bj][m][n] = __builtin_amdgcn_mfma_f32_16x16x32_bf16(Bt[n][k], At[m][k], acc[ai][bj][m][n], 0, 0, 0); __builtin_amdgcn_s_setprio(0); } while (0)
#define PG8_WAIT_V(n) asm volatile("s_waitcnt vmcnt(" #n ")" ::: "memory")
#define PG8_WAIT_L(n) asm volatile("s_waitcnt lgkmcnt(" #n ")" ::: "memory")
#define PG8_BAR __builtin_amdgcn_s_barrier()
#define PG8_SCHED __builtin_amdgcn_sched_barrier(0)
    Unit cur, nxt; int ui = 0;
    if (!S.next(0, cur)) return;
    f32x4 acc[2][2][4][2];
#pragma unroll
    for (int a = 0; a < 2; ++a)
#pragma unroll
        for (int b = 0; b < 2; ++b)
#pragma unroll
            for (int m = 0; m < 4; ++m)
#pragma unroll
                for (int n = 0; n < 2; ++n) acc[a][b][m][n] = (f32x4){0.f, 0.f, 0.f, 0.f};
    bf16x8 At[4][2], B0[2][2], B1[2][2];
    const char* cA = (const char*)g.A + (size_t)cur.pm * tstep; const char* cB = (const char*)g.Bt + (size_t)cur.pn * tstep;
    S.a_ready(cur);
    if constexpr (SP2) {
        PG8_STAGE(PG8_SB(0, 0), cB, voffB); PG8_STAGE(PG8_SB(0, 1), cB + hstep, voffB); PG8_STAGE(PG8_SA(0, 0), cA, voffA); PG8_STAGE(PG8_SA(0, 1), cA + hstep, voffA);
        if (wr == 1) PG8_BAR;
        PG8_WAIT_V(2); PG8_BAR;
        PG8_STAGE(PG8_SB(1, 0), cB + kstep, voffB); PG8_STAGE(PG8_SA(1, 0), cA + kstep, voffA); PG8_STAGE(PG8_SB(1, 1), cB + hstep + kstep, voffB);
        PG8_WAIT_V(6); PG8_BAR;
    } else {
        PG8_STAGE(PG8_SB(0, 0), cB, voffB); PG8_STAGE(PG8_SA(0, 0), cA, voffA); PG8_STAGE(PG8_SB(0, 1), cB + hstep, voffB); PG8_STAGE(PG8_SA(0, 1), cA + hstep, voffA);
        if (wr == 1) PG8_BAR;
        PG8_WAIT_V(4); PG8_BAR;
        PG8_STAGE(PG8_SB(1, 0), cB + kstep, voffB); PG8_STAGE(PG8_SA(1, 0), cA + kstep, voffA); PG8_STAGE(PG8_SB(1, 1), cB + hstep + kstep, voffB);
        PG8_WAIT_V(6); PG8_BAR;
    }
    for (;;) {
        const bool has_next = S.next(ui + 1, nxt);
        const char* nA = has_next ? (const char*)g.A + (size_t)nxt.pm * tstep : cA; const char* nB = has_next ? (const char*)g.Bt + (size_t)nxt.pn * tstep : cB;
        for (int t = 0; t < nt; t += 2) {
            const bool last = (t == nt - 2);
            const char* a1 = cA + (size_t)(t + 1) * kstep;
            const char* a2 = last ? nA : cA + (size_t)(t + 2) * kstep; const char* b2 = last ? nB : cB + (size_t)(t + 2) * kstep;
            const char* a3 = a2 + kstep; const char* b3 = b2 + kstep;
            if (last && has_next) S.a_ready(nxt);
            if constexpr (SP2) {
            PG8_LDB(B0, 0, 0); PG8_LDB(B1, 0, 1); PG8_SCHED; PG8_LDA(At, 0, 0); PG8_STAGE(PG8_SA(1, 1), a1 + hstep, voffA);
            PG8_WAIT_V(8); PG8_WAIT_L(0); PG8_BAR; PG8_MMA(0, 0, At, B0); PG8_MMA(0, 1, At, B1); PG8_BAR; PG8_SCHED;
            PG8_LDA(At, 0, 1); PG8_STAGE(PG8_SB(0, 0), b2, voffB); PG8_STAGE(PG8_SB(0, 1), b2 + hstep, voffB); PG8_STAGE(PG8_SA(0, 0), a2, voffA);
            PG8_WAIT_V(8); PG8_WAIT_L(0); PG8_BAR; PG8_MMA(1, 0, At, B0); PG8_MMA(1, 1, At, B1); PG8_BAR; PG8_SCHED;
            PG8_LDB(B0, 1, 0); PG8_LDB(B1, 1, 1); PG8_SCHED; PG8_LDA(At, 1, 0); PG8_STAGE(PG8_SA(0, 1), a2 + hstep, voffA);
            PG8_WAIT_V(8); PG8_WAIT_L(0); PG8_BAR; PG8_MMA(0, 0, At, B0); PG8_MMA(0, 1, At, B1); PG8_BAR; PG8_SCHED;
            PG8_LDA(At, 1, 1); PG8_STAGE(PG8_SB(1, 0), b3, voffB); PG8_STAGE(PG8_SB(1, 1), b3 + hstep, voffB); PG8_STAGE(PG8_SA(1, 0), a3, voffA);
            PG8_WAIT_V(8); PG8_WAIT_L(0); PG8_BAR; PG8_MMA(1, 0, At, B0); PG8_MMA(1, 1, At, B1); PG8_BAR; PG8_SCHED;
            } else {
            PG8_LDB(B0, 0, 0); PG8_SCHED; PG8_LDA(At, 0, 0); PG8_STAGE(PG8_SA(1, 1), a1 + hstep, voffA);
            PG8_WAIT_L(8); PG8_BAR; PG8_WAIT_L(0); PG8_MMA(0, 0, At, B0); PG8_BAR; PG8_SCHED;
            PG8_LDB(B1, 0, 1); PG8_STAGE(PG8_SB(0, 0), b2, voffB);
            PG8_BAR; PG8_WAIT_L(0); PG8_MMA(0, 1, At, B1); PG8_BAR;
            PG8_LDA(At, 0, 1); PG8_STAGE(PG8_SA(0, 0), a2, voffA);
            PG8_BAR; PG8_WAIT_L(0); PG8_MMA(1, 0, At, B0); PG8_BAR; PG8_SCHED;
            PG8_STAGE(PG8_SB(0, 1), b2 + hstep, voffB);
            PG8_WAIT_V(6); PG8_BAR; PG8_MMA(1, 1, At, B1); PG8_BAR;
            PG8_LDB(B0, 1, 0); PG8_SCHED; PG8_LDA(At, 1, 0); PG8_STAGE(PG8_SA(0, 1), a2 + hstep, voffA);
            PG8_WAIT_L(8); PG8_BAR; PG8_WAIT_L(0); PG8_MMA(0, 0, At, B0); PG8_BAR; PG8_SCHED;
            PG8_LDB(B1, 1, 1); PG8_STAGE(PG8_SB(1, 0), b3, voffB);
            PG8_BAR; PG8_WAIT_L(0); PG8_MMA(0, 1, At, B1); PG8_BAR;
            PG8_LDA(At, 1, 1); PG8_STAGE(PG8_SA(1, 0), a3, voffA);
            PG8_BAR; PG8_WAIT_L(0); PG8_MMA(1, 0, At, B0); PG8_BAR; PG8_SCHED;
            PG8_STAGE(PG8_SB(1, 1), b3 + hstep, voffB);
            PG8_WAIT_V(6); PG8_BAR; PG8_MMA(1, 1, At, B1); PG8_BAR;
            }
        }
        if constexpr (ALIGN_EPI) { if (wr == 0) PG8_BAR; }
        if constexpr (!Epi::AFTER_DRAIN) { E(acc, cur, wr, wc, fr, fq); S.done(cur); }
        if (!has_next) break;
#pragma unroll
        for (int a = 0; a < 2; ++a)
#pragma unroll
            for (int b = 0; b < 2; ++b)
#pragma unroll
                for (int m = 0; m < 4; ++m)
#pragma unroll
                    for (int n = 0; n < 2; ++n) acc[a][b][m][n] = (f32x4){0.f, 0.f, 0.f, 0.f};
        cur = nxt; cA = nA; cB = nB; ++ui;
        if constexpr (ALIGN_EPI) { if (wr == 1) PG8_BAR; }
    }
    PG8_WAIT_V(0);
    if constexpr (!ALIGN_EPI) { if (wr == 0) PG8_BAR; }
    PG8_BAR;
    if constexpr (Epi::AFTER_DRAIN) { E.fused(acc, cur, wr, wc, fr, fq, lds, wid, lane); S.done(cur); }
#undef PG8_SA
#undef PG8_SB
#undef PG8_STAGE
#undef PG8_LDA
#undef PG8_LDB
#undef PG8_MMA
#undef PG8_WAIT_V
#undef PG8_WAIT_L
#undef PG8_BAR
#undef PG8_SCHED
}
}
namespace pg8 {
struct EpiProj {
    static constexpr bool PERM = true, AFTER_DRAIN = false;
    bf16_t* O; int ldc;
    __device__ __forceinline__ void operator()(const f32x4 (&acc)[2][2][4][2], const Unit& u, int wr, int wc, int fr, int fq) const {
        const int row0 = u.pm * BM + wr * 64 + fr; const int col0 = u.pn * BM + wc * 32 + 8 * fq;
#pragma unroll
        for (int ai = 0; ai < 2; ++ai)
#pragma unroll
            for (int m = 0; m < 4; ++m) { bf16_t* rowp = O + (size_t)(row0 + ai * HALF + m * 16) * ldc + col0;
#pragma unroll
                for (int bj = 0; bj < 2; ++bj) { const f32x4 v0 = acc[ai][bj][m][0], v1 = acc[ai][bj][m][1];
                    u32x4 w; w.x = cvt_pk_bf16(v0[0], v0[1]); w.y = cvt_pk_bf16(v0[2], v0[3]); w.z = cvt_pk_bf16(v1[0], v1[1]); w.w = cvt_pk_bf16(v1[2], v1[3]);
                    *(u32x4*)(rowp + bj * HALF) = w; } }
    }
};
struct EpiX1 {
    static constexpr bool PERM = true, AFTER_DRAIN = false;
    const float* x; float* x1; bf16_t* x1s; const float* mod; const float* norm2_g; float* rowstat;
    __device__ __forceinline__ void operator()(const f32x4 (&acc)[2][2][4][2], const Unit& u, int wr, int wc, int fr, int fq) const {
        const int row0 = u.pm * BM + wr * 64 + fr; const int col0 = u.pn * BM + wc * 32 + 8 * fq; const int b = (u.pm * BM) >> 11;
        const float* mb = mod + (size_t)b * 6144;
        f32x4 g1[2][2], g2[2][2];
#pragma unroll
        for (int bj = 0; bj < 2; ++bj)
#pragma unroll
            for (int n = 0; n < 2; ++n) { const int c = col0 + bj * HALF + 4 * n; g1[bj][n] = *(const f32x4*)(mb + 2048 + c);
                const f32x4 sc = *(const f32x4*)(mb + 4096 + c), ng = *(const f32x4*)(norm2_g + c); g2[bj][n] = ng * (sc + 1.0f); }
#pragma unroll
        for (int ai = 0; ai < 2; ++ai)
#pragma unroll
            for (int m = 0; m < 4; ++m) { const size_t row = (size_t)(row0 + ai * HALF + m * 16); const size_t off = row * 1024 + col0; float ss = 0.f;
#pragma unroll
                for (int bj = 0; bj < 2; ++bj) {
                    const f32x4 xa = *(const f32x4*)(x + off + bj * HALF), xb = *(const f32x4*)(x + off + bj * HALF + 4);
                    const f32x4 v0 = xa + g1[bj][0] * acc[ai][bj][m][0], v1 = xb + g1[bj][1] * acc[ai][bj][m][1];
                    *(f32x4*)(x1 + off + bj * HALF) = v0; *(f32x4*)(x1 + off + bj * HALF + 4) = v1;
                    ss += (v0[0] * v0[0] + v0[1] * v0[1]) + (v0[2] * v0[2] + v0[3] * v0[3]) + (v1[0] * v1[0] + v1[1] * v1[1]) + (v1[2] * v1[2] + v1[3] * v1[3]);
                    const f32x4 s0 = v0 * g2[bj][0], s1 = v1 * g2[bj][1];
                    u32x4 w; w.x = cvt_pk_bf16(s0[0], s0[1]); w.y = cvt_pk_bf16(s0[2], s0[3]); w.z = cvt_pk_bf16(s1[0], s1[1]); w.w = cvt_pk_bf16(s1[2], s1[3]);
                    *(u32x4*)(x1s + off + bj * HALF) = w; }
                ss += __shfl_xor(ss, 16); ss += __shfl_xor(ss, 32);
                if (fq == 0) atomicAdd(rowstat + row, ss); }
    }
};
struct EpiScores {
    static constexpr bool PERM = true, AFTER_DRAIN = false;
    float* S; const float* sb; const float* rowstat;
    __device__ __forceinline__ void operator()(const f32x4 (&acc)[2][2][4][2], const Unit& u, int wr, int wc, int fr, int fq) const {
        const int row0 = u.pm * BM + wr * 64 + fr; const int col0 = u.pn * BM + wc * 32 + 8 * fq; const int b = (u.pm * BM) >> 11;
        f32x4 bv[2][2];
#pragma unroll
        for (int bj = 0; bj < 2; ++bj)
#pragma unroll
            for (int n = 0; n < 2; ++n) bv[bj][n] = *(const f32x4*)(sb + (size_t)b * 2048 + col0 + bj * HALF + 4 * n);
#pragma unroll
        for (int ai = 0; ai < 2; ++ai)
#pragma unroll
            for (int m = 0; m < 4; ++m) { const size_t row = (size_t)(row0 + ai * HALF + m * 16); const float rs = __builtin_amdgcn_rsqf(rowstat[row] * (1.0f / 1024.0f) + 1e-6f);
                float* rowp = S + row * 2048 + col0;
#pragma unroll
                for (int bj = 0; bj < 2; ++bj) { *(f32x4*)(rowp + bj * HALF) = acc[ai][bj][m][0] * rs + bv[bj][0]; *(f32x4*)(rowp + bj * HALF + 4) = acc[ai][bj][m][1] * rs + bv[bj][1]; } }
    }
};
}
constexpr int NWAVES = 8, NTHR = 512;
constexpr int DM = 1024, NB = 16, SEQ = 2048, MTOK = NB * SEQ;
constexpr int NPROJ = 4096;
constexpr int INW = 4112;
constexpr int NHEADS = 16, HDIM = 64, NGRP = 4, NST = 128, CHUNK = 128;
constexpr int S5G = 64, S5CH = 16, S5P = 64;
constexpr int PH = 8, PK = 16, PNK = 128;
constexpr float EPSF = 1e-6f;
constexpr int NS5PART = 64;

constexpr size_t MiB = 1u << 20;
constexpr size_t WS_CTL = 0, CTL_ZERO_BYTES = 64 * 1024;
constexpr size_t WS_MOD = 1 * MiB;
constexpr size_t WS_WDT = WS_MOD + 0x60000;
constexpr size_t WS_SB = WS_MOD + 0x70000;
constexpr size_t WS_ROWSTAT = WS_MOD + 0x90000;
constexpr size_t WS_S5LB = WS_MOD + 0xB0000;
constexpr size_t WS_S5BB = WS_MOD + 0xC0000;
constexpr size_t WS_DTRAW = 3 * MiB;
constexpr size_t WS_STSSD = 5 * MiB;
constexpr size_t WS_STS5 = 7 * MiB;
constexpr size_t WS_WINT = 15 * MiB;
constexpr size_t WS_WOUTT = 23 * MiB;
constexpr size_t WS_WQKT = 27 * MiB;
constexpr size_t WS_EU = 31 * MiB, WS_EV = 47 * MiB;
constexpr size_t WS_EUS = 63 * MiB, WS_EVS = 63 * MiB + 65536;
constexpr size_t WS_START = 64 * MiB;
constexpr size_t WS_A = 95 * MiB;
constexpr size_t WS_B = 223 * MiB;
constexpr size_t WS_H1 = WS_A, WS_Y = WS_A, WS_PROJ = WS_B, WS_SCORES = WS_A;
constexpr size_t WS_X1S = WS_B + 192 * MiB;
constexpr size_t WS_EID = 479 * MiB, WS_GATE = 495 * MiB;
constexpr size_t WS_END = 511 * MiB;
static_assert(WS_SCORES + (size_t)MTOK * 2048 * 4 <= WS_X1S && WS_X1S + (size_t)MTOK * 1024 * 2 <= WS_EID && WS_GATE + (size_t)MTOK * 128 * 4 <= WS_END, "ws map");

constexpr int LDS_MAIN = 159744;
constexpr int MISC_OFF = LDS_MAIN;
constexpr int LDS_BYTES = LDS_MAIN + 128;

#define GAS __attribute__((address_space(1)))
#define LAS __attribute__((address_space(3)))
typedef unsigned short bf16;
typedef unsigned v4u __attribute__((ext_vector_type(4)));
typedef unsigned v2u __attribute__((ext_vector_type(2)));
typedef float f32x4 __attribute__((ext_vector_type(4)));
typedef float f32x2 __attribute__((ext_vector_type(2)));
typedef short bf16x8 __attribute__((ext_vector_type(8)));
#define LDS_WAIT() asm volatile("s_waitcnt lgkmcnt(0)" ::: "memory")
#define VM_WAIT() asm volatile("s_waitcnt vmcnt(0)" ::: "memory")
typedef __bf16 hwbf16x2 __attribute__((ext_vector_type(2)));
__device__ __forceinline__ unsigned pk2(float lo, float hi) { const f32x2 v = {lo, hi}; const hwbf16x2 b = __builtin_convertvector(v, hwbf16x2); return __builtin_bit_cast(unsigned, b); }
__device__ __forceinline__ unsigned f2bf(float f) { return pk2(f, 0.f) & 0xffffu; }
__device__ __forceinline__ float bflo(unsigned w) { return __builtin_bit_cast(float, w << 16); }
__device__ __forceinline__ float bfhi(unsigned w) { return __builtin_bit_cast(float, w & 0xffff0000u); }
__device__ __forceinline__ float bf2f(bf16 v) { return __builtin_bit_cast(float, (unsigned)v << 16); }
__device__ __forceinline__ float wave_sum(float v) {
#pragma unroll
    for (int o = 1; o < 64; o <<= 1) v += __shfl_xor(v, o);
    return v;
}
__device__ __forceinline__ float sigmoid_f(float v) { return __builtin_amdgcn_rcpf(1.0f + __builtin_amdgcn_exp2f(-1.4426950408889634f * v)); }
__device__ __forceinline__ float silu_f(float v) { return v * sigmoid_f(v); }
__device__ __forceinline__ float rsqrt_f(float v) { return __builtin_amdgcn_rsqf(v); }
__device__ __forceinline__ float gelu_erf(float v) {
    const float av = fabsf(v), t = __builtin_amdgcn_rcpf(av * 0.2316418882f + 1.0f);
    float q = t * 0.5307027145f + (-0.7265760135f); q = q * t + 0.7107068705f; q = q * t + (-0.142248368f); q = q * t + 0.127414796f; q = q * t;
    const float e = __builtin_amdgcn_exp2f((v * v) * (-0.72134752044f));
    const float m = v * (q * e);
    return v < 0.f ? m : v - m;
}
__device__ __forceinline__ float softplus_f(float v) { return fmaxf(v, 0.f) + 0.6931471805599453f * __builtin_amdgcn_logf(1.0f + __builtin_amdgcn_exp2f(-1.4426950408889634f * fabsf(v))); }
__device__ __forceinline__ void unpack8(const v4u w, float* f) { f[0] = bflo(w.x); f[1] = bfhi(w.x); f[2] = bflo(w.y); f[3] = bfhi(w.y); f[4] = bflo(w.z); f[5] = bfhi(w.z); f[6] = bflo(w.w); f[7] = bfhi(w.w); }
#define XB_TMO      128
#define XB_XCNT(j)  (256  + 64 * (j))
#define XB_XSUB(j)  (1280 + 64 * (j))
#define XB_XGEN(j)  (2304 + 64 * (j))
#define XB_TOP      3328
#define XB_TOPGEN   3392
#define XCD_BAR_WORDS 3456
#define XB_SPIN_CAP (1u << 18)

__device__ __forceinline__ unsigned xb_ld(unsigned* p)              { return __hip_atomic_load(p, __ATOMIC_RELAXED, __HIP_MEMORY_SCOPE_AGENT); }
__device__ __forceinline__ unsigned xb_add(unsigned* p, unsigned v) { return __hip_atomic_fetch_add(p, v, __ATOMIC_RELAXED, __HIP_MEMORY_SCOPE_AGENT); }
__device__ __forceinline__ unsigned xb_xcc_id() { return (unsigned)__builtin_amdgcn_s_getreg((3 << 11) | 20) & 0xFu; }
#define XB_SPIN(cond, bar) do { unsigned _sp = 0; while (cond) { __builtin_amdgcn_s_sleep(1); \
    if ((++_sp & 255u) == 0u) { if (xb_ld(&(bar)[XB_TMO])) break; if (_sp > XB_SPIN_CAP) { atomicAdd(&(bar)[XB_TMO], 1u); break; } } } } while (0)

struct XcdBarrier {
    unsigned* bar; unsigned x;
    volatile LAS unsigned* st;
};

__device__ __forceinline__ XcdBarrier xcd_barrier_post(unsigned* bar, volatile LAS unsigned* st) {
    XcdBarrier b; b.bar = bar; b.x = xb_xcc_id(); b.st = st;
    if (threadIdx.x == 0) (void)xb_add(&bar[XB_XCNT(b.x)], 1u);
    return b;
}
__device__ __forceinline__ void xcd_barrier_complete(unsigned* bar, unsigned x, unsigned& nloc, unsigned& nx) {
    const unsigned G = gridDim.x * gridDim.y * gridDim.z;
    unsigned sum, cnt, mine, sp = 0u;
    for (;;) {
        sum = 0u; cnt = 0u; mine = 0u;
#pragma unroll
        for (unsigned j = 0; j < 16; ++j) { const unsigned c = xb_ld(&bar[XB_XCNT(j)]); sum += c; cnt += (c > 0u) ? 1u : 0u; mine = (j == x) ? c : mine; }
        if (sum == G) break;
        __builtin_amdgcn_s_sleep(1);
        if ((++sp & 255u) == 0u) { if (xb_ld(&bar[XB_TMO])) break; if (sp > XB_SPIN_CAP) { atomicAdd(&bar[XB_TMO], 1u); break; } }
    }
    nloc = mine > 0u ? mine : 1u; nx = cnt > 0u ? cnt : 1u;
}

__device__ __forceinline__ void xcd_barrier(const XcdBarrier& b) {
    asm volatile("s_waitcnt vmcnt(0)" ::: "memory");
    __syncthreads();
    if (threadIdx.x == 0) {
        unsigned* bar = b.bar;
        __builtin_amdgcn_s_waitcnt(0);
        unsigned nloc = b.st[0], nx = b.st[1];
        if (nloc == 0u) { xcd_barrier_complete(bar, b.x, nloc, nx); b.st[0] = nloc; b.st[1] = nx; }
        const unsigned old = xb_add(&bar[XB_XSUB(b.x)], 1u);
        const unsigned gen = old / nloc;
        if (old + 1u == (gen + 1u) * nloc) {
            __builtin_amdgcn_fence(__ATOMIC_RELEASE, "agent");
            asm volatile("s_waitcnt vmcnt(0)" ::: "memory");
            const unsigned og = xb_add(&bar[XB_TOP], 1u);
            const unsigned tg = og / nx;
            if (og + 1u == (tg + 1u) * nx) xb_add(&bar[XB_TOPGEN], 1u);
            else XB_SPIN(xb_ld(&bar[XB_TOPGEN]) == tg, bar);
            __builtin_amdgcn_fence(__ATOMIC_ACQUIRE, "agent");
            xb_add(&bar[XB_XGEN(b.x)], 1u);
            asm volatile("s_waitcnt vmcnt(0)" ::: "memory");
        } else {
            XB_SPIN(xb_ld(&bar[XB_XGEN(b.x)]) == gen, bar);
            __builtin_amdgcn_fence(__ATOMIC_ACQUIRE, "agent");
            asm volatile("s_waitcnt vmcnt(0)" ::: "memory");
        }
    }
    __syncthreads();
}
struct Args { const float* in[30]; float* out; unsigned char* ws; int ph_lo, ph_hi; };
struct Frame {
    LAS unsigned char* lds;
    volatile LAS unsigned* MISC;
    int vcu, G;
    unsigned char* ws;
    const Args* a;
    float* out;
};
#define WSP(T, off) ((T*)(F.ws + (off)))

__device__ __forceinline__ void transpose_tile(const float* W, int ldw, int k0, int src_n0, bf16* WT, int K, int dst_n0, LAS float* scr, int lane, const float* kscale) {
#pragma unroll 8
    for (int i = 0; i < 32; ++i) { const int kk = 2 * i + (lane >> 5); float v = W[(size_t)(k0 + kk) * ldw + src_n0 + (lane & 31)]; if (kscale) v *= kscale[k0 + kk]; scr[kk * 33 + (lane & 31)] = v; }
    LDS_WAIT(); asm volatile("" ::: "memory");
    const int c = lane & 7;
#pragma unroll
    for (int j = 0; j < 4; ++j) { const int n = (lane >> 3) + 8 * j; const LAS float* s = scr + (8 * c) * 33 + n;
        v4u o; o.x = pk2(s[0 * 33], s[1 * 33]); o.y = pk2(s[2 * 33], s[3 * 33]); o.z = pk2(s[4 * 33], s[5 * 33]); o.w = pk2(s[6 * 33], s[7 * 33]);
        *(v4u*)(WT + (size_t)(dst_n0 + n) * K + k0 + 8 * c) = o; }
    LDS_WAIT(); asm volatile("" ::: "memory");
}
__device__ __forceinline__ void p0_phase(Frame& F) {
    const int f_tid = threadIdx.x, f_lane = f_tid & 63, f_wave = __builtin_amdgcn_readfirstlane(f_tid >> 6);
    const int gw = F.vcu * NWAVES + f_wave, NGW = F.G * NWAVES, gt = F.vcu * NTHR + f_tid, NGT = F.G * NTHR;
    if (F.vcu < 96) {
        LAS float* sc = (LAS float*)F.lds;
        LAS float* red = (LAS float*)(F.lds + 65536);
        for (int i = f_tid; i < 16 * 1024; i += NTHR) { const int b = i >> 10, k = i & 1023; sc[k * 16 + b] = silu_f((F.a->in[1])[i]); }
        __syncthreads();
        const int ks = f_tid >> 6, col = f_tid & 63, j = F.vcu * 64 + col;
        float acc[16];
#pragma unroll
        for (int b = 0; b < 16; ++b) acc[b] = 0.f;
        const float* wp = (F.a->in[2]) + (size_t)(ks * 128) * 6144 + j;
#pragma unroll 4
        for (int k = 0; k < 128; ++k) { const float w = wp[(size_t)k * 6144]; const LAS f32x4* s4 = (const LAS f32x4*)(sc + (ks * 128 + k) * 16);
#pragma unroll
            for (int q = 0; q < 4; ++q) { const f32x4 s = s4[q]; acc[4 * q] += s[0] * w; acc[4 * q + 1] += s[1] * w; acc[4 * q + 2] += s[2] * w; acc[4 * q + 3] += s[3] * w; } }
#pragma unroll
        for (int b = 0; b < 16; ++b) red[(ks * 16 + b) * 64 + col] = acc[b];
        __syncthreads();
        for (int i = f_tid; i < 16 * 64; i += NTHR) { const int b = i >> 6, cc = i & 63; float s = 0.f;
#pragma unroll
            for (int q = 0; q < 8; ++q) s += red[(q * 16 + b) * 64 + cc];
            WSP(float, WS_MOD)[b * 6144 + F.vcu * 64 + cc] = s + (F.a->in[3])[F.vcu * 64 + cc]; }
        __syncthreads();
    }
    {
        LAS float* scr = (LAS float*)(F.lds + f_wave * 16384);
        constexpr int I_IN = (1024 / 64) * (NPROJ / 32), I_OUT = (2048 / 64) * (1024 / 32);
        for (int it = gw; it < I_IN + I_OUT; it += NGW) {
            if (it < I_IN) { const int kb = it / (NPROJ / 32), nb = it % (NPROJ / 32); const int dn = 32 * nb, sn = dn < 3072 ? dn : dn + 16;
                transpose_tile((F.a->in[5]), INW, 64 * kb, sn, WSP(bf16, WS_WINT), 1024, dn, scr, f_lane, nullptr); }
            else { const int r = it - I_IN, kb = r / 32, nb = r % 32; const int k0 = 64 * kb;
                transpose_tile((F.a->in[23]), 1024, k0, 32 * nb, WSP(bf16, WS_WOUTT), 2048, 32 * nb, scr, f_lane, k0 < 1024 ? (F.a->in[11]) : (F.a->in[22]) - 1024); }
        }
    }
    for (int i = gt; i < 16 * 1024; i += NGT) { const int h = i >> 10, k = i & 1023; WSP(float, WS_WDT)[i] = (F.a->in[5])[(size_t)k * INW + 3072 + h]; }
    for (int task = gw; task < 2048; task += NGW) {
        const int nt = task >> 4, ks = task & 15, n0 = 16 * nt, hc = n0 >> 7, k0 = 64 * ks;
        const int li = f_lane & 15, lq = f_lane >> 4;
        f32x4 acc[4];
#pragma unroll
        for (int s = 0; s < 4; ++s) acc[s] = (f32x4){0.f, 0.f, 0.f, 0.f};
        const float* ap = (F.a->in[26]) + (size_t)(n0 + li) * 128 + 4 * lq;
        const float* bp = (F.a->in[25]) + (size_t)(k0 + li) * 2048 + hc * 128 + 4 * lq;
#pragma unroll
        for (int q = 0; q < 8; ++q) { const f32x4 a = *(const f32x4*)(ap + 16 * q);
#pragma unroll
            for (int s = 0; s < 4; ++s) { const f32x4 b = *(const f32x4*)(bp + (size_t)(16 * s) * 2048 + 16 * q);
#pragma unroll
                for (int jj = 0; jj < 4; ++jj) acc[s] = __builtin_amdgcn_mfma_f32_16x16x4f32(a[jj], b[jj], acc[s], 0, 0, 0); } }
        bf16* o = WSP(bf16, WS_WQKT);
#pragma unroll
        for (int s = 0; s < 4; ++s)
#pragma unroll
            for (int r = 0; r < 4; ++r) o[(size_t)(n0 + 4 * lq + r) * 1024 + k0 + 16 * s + li] = (bf16)f2bf(acc[s][r]);
    }
    for (int rw = gw; rw < 2 * 16384; rw += NGW) {
        const int tb = rw >= 16384, e = tb ? rw - 16384 : rw; const float* src = (tb ? (F.a->in[28]) : (F.a->in[27])) + (size_t)e * 1024 + 16 * f_lane;
        f32x4 v[4]; float mx = 0.f;
#pragma unroll
        for (int q = 0; q < 4; ++q) { v[q] = *(const f32x4*)(src + 4 * q); mx = fmaxf(mx, fmaxf(fmaxf(fabsf(v[q][0]), fabsf(v[q][1])), fmaxf(fabsf(v[q][2]), fabsf(v[q][3])))); }
#pragma unroll
        for (int o = 1; o < 64; o <<= 1) mx = fmaxf(mx, __shfl_xor(mx, o));
        mx = fmaxf(mx, 1e-30f); const float sc = 224.0f / mx;
        v4u w;
#pragma unroll
        for (int q = 0; q < 4; ++q) { int pk = 0; pk = __builtin_amdgcn_cvt_pk_fp8_f32(v[q][0] * sc, v[q][1] * sc, pk, false); pk = __builtin_amdgcn_cvt_pk_fp8_f32(v[q][2] * sc, v[q][3] * sc, pk, true); w[q] = (unsigned)pk; }
        *(v4u*)(F.ws + (tb ? WS_EV : WS_EU) + (size_t)e * 1024 + 16 * f_lane) = w;
        if (f_lane == 0) WSP(float, tb ? WS_EVS : WS_EUS)[e] = mx * (1.0f / 224.0f);
    }
    for (int i = gt; i < S5G * S5P; i += NGT) {
        const float lr = (F.a->in[12])[i], li = (F.a->in[13])[i], dt = expf((F.a->in[14])[i >> 6]);
        const float mag = expf(lr * dt); float sn, cs; sincosf(li * dt, &sn, &cs);
        const float lbr = mag * cs, lbi = mag * sn, den = lr * lr + li * li;
        const float cfr = ((lbr - 1.0f) * lr + lbi * li) / den, cfi = (lbi * lr - (lbr - 1.0f) * li) / den;
        WSP(float, WS_S5LB)[2 * i] = lbr; WSP(float, WS_S5LB)[2 * i + 1] = lbi;
        for (int hh = 0; hh < 16; ++hh) { const float br = (F.a->in[15])[i * 16 + hh], bi = (F.a->in[16])[i * 16 + hh];
            WSP(float, WS_S5BB)[i * 32 + hh] = cfr * br - cfi * bi; WSP(float, WS_S5BB)[i * 32 + 16 + hh] = cfr * bi + cfi * br; }
    }
    for (int i = gt; i < MTOK; i += NGT) WSP(float, WS_ROWSTAT)[i] = 0.f;
}

__device__ __forceinline__ void p1_phase(Frame& F) {
    const int f_tid = threadIdx.x, f_lane = f_tid & 63, f_wave = __builtin_amdgcn_readfirstlane(f_tid >> 6);
    const int gw = F.vcu * NWAVES + f_wave;
    LAS float* wdt = (LAS float*)F.lds;
    for (int i = f_tid; i < 16 * 1024 / 4; i += NTHR) ((LAS f32x4*)wdt)[i] = ((const f32x4*)WSP(float, WS_WDT))[i];
    __syncthreads();
    const int lane = f_lane;
    for (int wq = gw; wq < MTOK / 16; wq += F.G * NWAVES) {
        const int b = wq >> 7; const float* mb = WSP(float, WS_MOD) + (size_t)b * 6144;
        f32x4 Gv[4], Sv[4];
#pragma unroll
        for (int j = 0; j < 4; ++j) { const int k = 4 * lane + 256 * j; const f32x4 g = *(const f32x4*)((F.a->in[4]) + k), sc = *(const f32x4*)(mb + 1024 + k); Gv[j] = g * (sc + 1.0f); Sv[j] = *(const f32x4*)(mb + k); }
        for (int tt = 0; tt < 16; ++tt) {
            asm volatile("" ::: "memory");
            const size_t t = (size_t)wq * 16 + tt; const float* xr = (F.a->in[0]) + t * 1024;
            f32x4 v[4]; float ss = 0.f;
#pragma unroll
            for (int j = 0; j < 4; ++j) { v[j] = *(const f32x4*)(xr + 4 * lane + 256 * j); ss += (v[j][0] * v[j][0] + v[j][1] * v[j][1]) + (v[j][2] * v[j][2] + v[j][3] * v[j][3]); }
            const float rstd = rsqrt_f(wave_sum(ss) * (1.0f / 1024.0f) + EPSF);
            bf16* hr = WSP(bf16, WS_H1) + t * 1024;
#pragma unroll
            for (int j = 0; j < 4; ++j) { v[j] = v[j] * rstd * Gv[j] + Sv[j]; v2u w; w.x = pk2(v[j][0], v[j][1]); w.y = pk2(v[j][2], v[j][3]); *(v2u*)(hr + 4 * lane + 256 * j) = w; }
            float d[16];
#pragma unroll
            for (int h = 0; h < 16; ++h) { float a = 0.f;
#pragma unroll
                for (int j = 0; j < 4; ++j) { const f32x4 w = *(const LAS f32x4*)(wdt + h * 1024 + 4 * lane + 256 * j); a += (v[j][0] * w[0] + v[j][1] * w[1]) + (v[j][2] * w[2] + v[j][3] * w[3]); }
                d[h] = a; }
            float e8[8], e4[4], e2[2], e1;
#pragma unroll
            for (int i = 0; i < 8; ++i) { const bool up = lane & 32; const float snd = up ? d[i] : d[i + 8]; const float rcv = __shfl_xor(snd, 32); e8[i] = (up ? d[i + 8] : d[i]) + rcv; }
#pragma unroll
            for (int i = 0; i < 4; ++i) { const bool up = lane & 16; const float snd = up ? e8[i] : e8[i + 4]; const float rcv = __shfl_xor(snd, 16); e4[i] = (up ? e8[i + 4] : e8[i]) + rcv; }
#pragma unroll
            for (int i = 0; i < 2; ++i) { const bool up = lane & 8; const float snd = up ? e4[i] : e4[i + 2]; const float rcv = __shfl_xor(snd, 8); e2[i] = (up ? e4[i + 2] : e4[i]) + rcv; }
            { const bool up = lane & 4; const float snd = up ? e2[0] : e2[1]; const float rcv = __shfl_xor(snd, 4); e1 = (up ? e2[1] : e2[0]) + rcv; }
            e1 += __shfl_xor(e1, 2); e1 += __shfl_xor(e1, 1);
            const int head = ((lane >> 5) & 1) * 8 + ((lane >> 4) & 1) * 4 + ((lane >> 3) & 1) * 2 + ((lane >> 2) & 1);
            if ((lane & 3) == 0) WSP(float, WS_DTRAW)[t * 16 + head] = e1;
        }
    }
    for (int n = gw; n < 2048; n += F.G * NWAVES) {
        const bf16* wr = WSP(bf16, WS_WQKT) + (size_t)n * 1024 + 16 * lane;
        const v4u w0 = *(const v4u*)wr, w1 = *(const v4u*)(wr + 8);
        float wv[16]; wv[0] = bflo(w0.x); wv[1] = bfhi(w0.x); wv[2] = bflo(w0.y); wv[3] = bfhi(w0.y); wv[4] = bflo(w0.z); wv[5] = bfhi(w0.z); wv[6] = bflo(w0.w); wv[7] = bfhi(w0.w);
        wv[8] = bflo(w1.x); wv[9] = bfhi(w1.x); wv[10] = bflo(w1.y); wv[11] = bfhi(w1.y); wv[12] = bflo(w1.z); wv[13] = bfhi(w1.z); wv[14] = bflo(w1.w); wv[15] = bfhi(w1.w);
        for (int b = 0; b < 16; ++b) { const float* sp = WSP(float, WS_MOD) + (size_t)b * 6144 + 3072 + 16 * lane; float a = 0.f;
#pragma unroll
            for (int q = 0; q < 4; ++q) { const f32x4 s = *(const f32x4*)(sp + 4 * q); a += (s[0] * wv[4 * q] + s[1] * wv[4 * q + 1]) + (s[2] * wv[4 * q + 2] + s[3] * wv[4 * q + 3]); }
            a = wave_sum(a); if (lane == 0) WSP(float, WS_SB)[b * 2048 + n] = a; }
    }
}
__device__ __forceinline__ void p3_ssd_naive(Frame& F) {
    const int f_tid = threadIdx.x;
    const bf16* proj = WSP(bf16, WS_PROJ);
    LAS float* buf = (LAS float*)F.lds;
    LAS float* yl = (LAS float*)(F.lds + 4096);
    for (int item = F.vcu; item < NB * NGRP; item += F.G) {
        const int b = item >> 2, g = item & 3, tid = f_tid;
        const int ch = tid < 256 ? g * 256 + tid : (tid < 384 ? 1024 + g * 128 + (tid - 256) : 1536 + g * 128 + (tid - 384));
        const float w0 = (F.a->in[6])[0 * 2048 + ch], w1 = (F.a->in[6])[1 * 2048 + ch], w2 = (F.a->in[6])[2 * 2048 + ch], w3 = (F.a->in[6])[3 * 2048 + ch], cb = (F.a->in[7])[ch];
        float r0 = 0.f, r1 = 0.f, r2 = 0.f;
        const int r = tid >> 7, nh = (tid >> 6) & 1, p = tid & 63, h = g * 4 + r;
        float st[64];
#pragma unroll
        for (int n = 0; n < 64; ++n) st[n] = 0.f;
        const float A = -__expf((F.a->in[9])[h]), Dh = (F.a->in[10])[h], dtb = (F.a->in[8])[h];
        for (int t = 0; t < SEQ; ++t) {
            const size_t row = (size_t)b * SEQ + t;
            const float r3 = bf2f(proj[row * NPROJ + 1024 + ch]);
            const float cv = silu_f(cb + r0 * w0 + r1 * w1 + r2 * w2 + r3 * w3);
            r0 = r1; r1 = r2; r2 = r3;
            LAS float* cur = buf + (t & 1) * 512; LAS float* ycur = yl + (t & 1) * 512;
            cur[tid] = cv;
            __syncthreads();
            const float dt = softplus_f(WSP(float, WS_DTRAW)[row * 16 + h] + dtb);
            const float dA = __expf(dt * A), xv = cur[r * 64 + p], xd = xv * dt;
            float y = 0.f;
#pragma unroll
            for (int n4 = 0; n4 < 16; ++n4) { const f32x4 Bv = *(const LAS f32x4*)(cur + 256 + 64 * nh + 4 * n4), Cv = *(const LAS f32x4*)(cur + 384 + 64 * nh + 4 * n4);
#pragma unroll
                for (int q = 0; q < 4; ++q) { st[4 * n4 + q] = st[4 * n4 + q] * dA + xd * Bv[q]; y += Cv[q] * st[4 * n4 + q]; } }
            ycur[tid] = y;
            __syncthreads();
            if (nh == 0) {
                y = ycur[tid] + ycur[tid + 64] + Dh * xv;
                const float zv = bf2f(proj[row * NPROJ + h * 64 + p]);
                y *= silu_f(zv);
                WSP(bf16, WS_Y)[row * 2048 + h * 64 + p] = (bf16)f2bf(y);
                const float ss = wave_sum(y * y);
                if (p == 0) WSP(float, WS_STSSD)[row * 16 + h] = ss;
            }
        }
        __syncthreads();
    }
}
__device__ __forceinline__ void p3_s5_naive(Frame& F) {
    const int f_tid = threadIdx.x, f_lane = f_tid & 63, f_wave = __builtin_amdgcn_readfirstlane(f_tid >> 6);
    const bf16* proj = WSP(bf16, WS_PROJ);
    LAS float* xt = (LAS float*)(F.lds + 4096 + f_wave * 19200);
    LAS float* vt = (LAS float*)(F.lds + 4096 + f_wave * 19200 + 16896) + (f_lane & 31) * 17;
    const int lane = f_lane;
    for (int item = F.vcu * NWAVES + f_wave; item < NB * S5G; item += F.G * NWAVES) {
        const int b = item >> 6, g = item & 63, p = lane;
        const float lbr = WSP(float, WS_S5LB)[(g * 64 + p) * 2], lbi = WSP(float, WS_S5LB)[(g * 64 + p) * 2 + 1];
        float bbr[16], bbi[16];
#pragma unroll
        for (int q = 0; q < 4; ++q) { const f32x4 a = *(const f32x4*)(WSP(float, WS_S5BB) + (g * 64 + p) * 32 + 4 * q), c = *(const f32x4*)(WSP(float, WS_S5BB) + (g * 64 + p) * 32 + 16 + 4 * q);
#pragma unroll
            for (int e = 0; e < 4; ++e) { bbr[4 * q + e] = a[e]; bbi[4 * q + e] = c[e]; } }
        float xr = 0.f, xi = 0.f;
        for (int t0 = 0; t0 < SEQ; t0 += 32) {
            for (int tt = 0; tt < 32; ++tt) {
                const bf16* up = proj + ((size_t)b * SEQ + t0 + tt) * NPROJ + 3072 + g * 16;
                const v4u u0 = *(const v4u*)up, u1 = *(const v4u*)(up + 8);
                float uv[16]; uv[0] = bflo(u0.x); uv[1] = bfhi(u0.x); uv[2] = bflo(u0.y); uv[3] = bfhi(u0.y); uv[4] = bflo(u0.z); uv[5] = bfhi(u0.z); uv[6] = bflo(u0.w); uv[7] = bfhi(u0.w);
                uv[8] = bflo(u1.x); uv[9] = bfhi(u1.x); uv[10] = bflo(u1.y); uv[11] = bfhi(u1.y); uv[12] = bflo(u1.z); uv[13] = bfhi(u1.z); uv[14] = bflo(u1.w); uv[15] = bfhi(u1.w);
                float br = 0.f, bi = 0.f;
#pragma unroll
                for (int hh = 0; hh < 16; ++hh) { br += uv[hh] * bbr[hh]; bi += uv[hh] * bbi[hh]; }
                const float nr = lbr * xr - lbi * xi + br, ni = lbr * xi + lbi * xr + bi; xr = nr; xi = ni;
                xt[(tt * 66 + p) * 2] = xr; xt[(tt * 66 + p) * 2 + 1] = xi;
            }
            LDS_WAIT(); asm volatile("" ::: "memory");
            if (lane < 32) {
                const int tt = lane; const size_t row = (size_t)b * SEQ + t0 + tt;
                const bf16* up = proj + row * NPROJ + 3072 + g * 16;
#pragma unroll 1
                for (int hh = 0; hh < 16; ++hh) { float y = 0.f; const float* cr = (F.a->in[17]) + (g * 16 + hh) * 64; const float* ci = (F.a->in[18]) + (g * 16 + hh) * 64;
#pragma unroll 8
                    for (int pp = 0; pp < 64; ++pp) y += xt[(tt * 66 + pp) * 2] * cr[pp] - xt[(tt * 66 + pp) * 2 + 1] * ci[pp];
                    vt[hh] = gelu_erf(y + (F.a->in[19])[g * 16 + hh] * bf2f(up[hh])); }
                float ss = 0.f; unsigned ow[8];
#pragma unroll 1
                for (int k2 = 0; k2 < 8; ++k2) { float o2[2];
#pragma unroll
                    for (int e = 0; e < 2; ++e) { const int k = 2 * k2 + e; float gt = (F.a->in[21])[g * 16 + k];
#pragma unroll
                        for (int hh = 0; hh < 16; ++hh) gt += vt[hh] * (F.a->in[20])[(g * 16 + hh) * 16 + k];
                        o2[e] = vt[k] * sigmoid_f(gt); ss += o2[e] * o2[e]; }
                    const unsigned pw = pk2(o2[0], o2[1]);
#pragma unroll
                    for (int q = 0; q < 8; ++q) ow[q] = (q == k2) ? pw : ow[q]; }
                bf16* yo = WSP(bf16, WS_Y) + row * 2048 + 1024 + g * 16;
                *(v4u*)yo = (v4u){ow[0], ow[1], ow[2], ow[3]}; *(v4u*)(yo + 8) = (v4u){ow[4], ow[5], ow[6], ow[7]};
                WSP(float, WS_STS5)[row * NS5PART + g] = ss;
            }
            LDS_WAIT(); asm volatile("" ::: "memory");
        }
    }
}
__device__ __forceinline__ void p3c_normalize(Frame& F) {
    const int f_tid = threadIdx.x, f_lane = f_tid & 63, f_wave = __builtin_amdgcn_readfirstlane(f_tid >> 6);
    const int lane = f_lane;
    for (int t = F.vcu * NWAVES + f_wave; t < MTOK; t += F.G * NWAVES) {
        const float* sg = WSP(float, WS_STSSD) + (size_t)t * 16; const float* s5 = WSP(float, WS_STS5) + (size_t)t * NS5PART;
        float rg[4];
#pragma unroll
        for (int g = 0; g < 4; ++g) rg[g] = rsqrt_f((sg[4 * g] + sg[4 * g + 1] + sg[4 * g + 2] + sg[4 * g + 3]) * (1.0f / 256.0f) + EPSF);
        float s5s = (NS5PART == 64) ? s5[lane] : (lane < NS5PART ? s5[lane] : 0.f); s5s = wave_sum(s5s);
        const float r5 = rsqrt_f(s5s * (1.0f / 1024.0f) + EPSF);
        bf16* yr = WSP(bf16, WS_Y) + (size_t)t * 2048;
#pragma unroll
        for (int j = 0; j < 4; ++j) { const int e0 = 512 * j + 8 * lane; const float sc = j >= 2 ? r5 : (j == 0 ? (lane < 32 ? rg[0] : rg[1]) : (lane < 32 ? rg[2] : rg[3]));
            v4u w = *(v4u*)(yr + e0);
            w.x = pk2(bflo(w.x) * sc, bfhi(w.x) * sc); w.y = pk2(bflo(w.y) * sc, bfhi(w.y) * sc); w.z = pk2(bflo(w.z) * sc, bfhi(w.z) * sc); w.w = pk2(bflo(w.w) * sc, bfhi(w.w) * sc);
            *(v4u*)(yr + e0) = w; }
    }
}
constexpr int SSD_CS = 0, SSD_BS = 34816, SSD_BWT = 69632, SSD_XDT = 104448, SSD_PREV = 121856, SSD_XS = 139264, SSD_CSF = 157696, SSD_DTF = 158208, SSD_PITCH = 272, SSD_XPITCH = 144;
static_assert(SSD_DTF + 512 <= LDS_MAIN, "SSD LDS map");
__device__ __forceinline__ bf16x8 lds_frag(LAS unsigned char* base, int row, int kbyte) { return *(const LAS bf16x8*)(base + row * SSD_PITCH + kbyte); }
__device__ __forceinline__ void p3_ssd(Frame& F) {
    const int tid = threadIdx.x, lane = tid & 63, w = __builtin_amdgcn_readfirstlane(tid >> 6);
    const int li = lane & 15, lq = lane >> 4;
    LAS unsigned char* L = F.lds;
    LAS float* csf = (LAS float*)(L + SSD_CSF); LAS float* dtf = (LAS float*)(L + SSD_DTF);
    const bf16* proj = WSP(bf16, WS_PROJ);
    for (int item = F.vcu; item < NB * NHEADS; item += F.G) {
        const int b = item >> 4, h = item & 15, g = h >> 2;
        const float A = -__expf((F.a->in[9])[h]), Dh = (F.a->in[10])[h], dtb = (F.a->in[8])[h];
        const int pbs = w >> 1, nb0 = 4 * (w & 1);
        f32x4 st[4];
#pragma unroll
        for (int j = 0; j < 4; ++j) st[j] = (f32x4){0.f, 0.f, 0.f, 0.f};
        for (int i = tid; i < 17408 / 16; i += NTHR) ((LAS v4u*)(L + SSD_PREV))[i] = (v4u){0u, 0u, 0u, 0u};
        for (int c = 0; c < SEQ / CHUNK; ++c) {
            const size_t row0 = (size_t)b * SEQ + (size_t)c * CHUNK;
            if (w == 0) {
                const float d0 = softplus_f(WSP(float, WS_DTRAW)[(row0 + 2 * lane) * 16 + h] + dtb), d1 = softplus_f(WSP(float, WS_DTRAW)[(row0 + 2 * lane + 1) * 16 + h] + dtb);
                const float a0 = d0 * A, a1 = d1 * A; float s = a0 + a1;
#pragma unroll
                for (int o = 1; o < 64; o <<= 1) { const float t = __shfl_up(s, o); if (lane >= o) s += t; }
                dtf[2 * lane] = d0; dtf[2 * lane + 1] = d1; csf[2 * lane] = s - a1; csf[2 * lane + 1] = s;
            }
            __syncthreads();
            const float cs_end = csf[127];
            for (int it = tid; it < 1280; it += NTHR) {
                const int o = it % 40, rg = it / 40, l0 = 4 * rg;
                const int xcol = o < 8 ? h * 64 + 8 * o : (o < 24 ? 1024 + g * 128 + 8 * (o - 8) : 1536 + g * 128 + 8 * (o - 24));
                float raw[7][8];
#pragma unroll
                for (int k = 0; k < 7; ++k) { const int l = l0 - 3 + k; const bool ok = (c > 0) || (l >= 0);
                    v4u wv = (v4u){0u, 0u, 0u, 0u}; if (ok) wv = *(const v4u*)(proj + (size_t)((long)row0 + l) * NPROJ + 1024 + xcol);
                    raw[k][0] = bflo(wv.x); raw[k][1] = bfhi(wv.x); raw[k][2] = bflo(wv.y); raw[k][3] = bfhi(wv.y); raw[k][4] = bflo(wv.z); raw[k][5] = bfhi(wv.z); raw[k][6] = bflo(wv.w); raw[k][7] = bfhi(wv.w); }
                float cw[4][8], cbv[8];
#pragma unroll
                for (int k = 0; k < 4; ++k) { const f32x4 w0 = *(const f32x4*)((F.a->in[6]) + k * 2048 + xcol), w1 = *(const f32x4*)((F.a->in[6]) + k * 2048 + xcol + 4);
#pragma unroll
                    for (int e = 0; e < 4; ++e) { cw[k][e] = w0[e]; cw[k][4 + e] = w1[e]; } }
                { const f32x4 b0 = *(const f32x4*)((F.a->in[7]) + xcol), b1 = *(const f32x4*)((F.a->in[7]) + xcol + 4);
#pragma unroll
                    for (int e = 0; e < 4; ++e) { cbv[e] = b0[e]; cbv[4 + e] = b1[e]; } }
                float v[4][8];
#pragma unroll
                for (int r = 0; r < 4; ++r)
#pragma unroll
                    for (int i = 0; i < 8; ++i) v[r][i] = silu_f(cbv[i] + raw[r][i] * cw[0][i] + raw[r + 1][i] * cw[1][i] + raw[r + 2][i] * cw[2][i] + raw[r + 3][i] * cw[3][i]);
                if (o < 8) {
                    const int p0 = 8 * o;
#pragma unroll
                    for (int r = 0; r < 4; ++r) *(LAS v4u*)(L + SSD_XS + (l0 + r) * SSD_XPITCH + p0 * 2) = (v4u){pk2(v[r][0], v[r][1]), pk2(v[r][2], v[r][3]), pk2(v[r][4], v[r][5]), pk2(v[r][6], v[r][7])};
                    const float t0 = dtf[l0], t1 = dtf[l0 + 1], t2 = dtf[l0 + 2], t3 = dtf[l0 + 3];
#pragma unroll
                    for (int i = 0; i < 8; ++i) *(LAS v2u*)(L + SSD_XDT + (p0 + i) * SSD_PITCH + l0 * 2) = (v2u){pk2(v[0][i] * t0, v[1][i] * t1), pk2(v[2][i] * t2, v[3][i] * t3)};
                } else if (o < 24) {
                    const int n0 = 8 * (o - 8);
#pragma unroll
                    for (int r = 0; r < 4; ++r) *(LAS v4u*)(L + SSD_BS + (l0 + r) * SSD_PITCH + n0 * 2) = (v4u){pk2(v[r][0], v[r][1]), pk2(v[r][2], v[r][3]), pk2(v[r][4], v[r][5]), pk2(v[r][6], v[r][7])};
                    const float t0 = __expf(cs_end - csf[l0]), t1 = __expf(cs_end - csf[l0 + 1]), t2 = __expf(cs_end - csf[l0 + 2]), t3 = __expf(cs_end - csf[l0 + 3]);
#pragma unroll
                    for (int i = 0; i < 8; ++i) *(LAS v2u*)(L + SSD_BWT + (n0 + i) * SSD_PITCH + l0 * 2) = (v2u){pk2(v[0][i] * t0, v[1][i] * t1), pk2(v[2][i] * t2, v[3][i] * t3)};
                } else {
                    const int n0 = 8 * (o - 24);
#pragma unroll
                    for (int r = 0; r < 4; ++r) *(LAS v4u*)(L + SSD_CS + (l0 + r) * SSD_PITCH + n0 * 2) = (v4u){pk2(v[r][0], v[r][1]), pk2(v[r][2], v[r][3]), pk2(v[r][4], v[r][5]), pk2(v[r][6], v[r][7])};
                }
            }
            __syncthreads();
            bf16x8 ca[4];
#pragma unroll
            for (int ks = 0; ks < 4; ++ks) ca[ks] = lds_frag(L + SSD_CS, 16 * w + li, 64 * ks + 16 * lq);
            f32x4 cb[8];
#pragma unroll
            for (int sb = 0; sb < 8; ++sb) { cb[sb] = (f32x4){0.f, 0.f, 0.f, 0.f};
                if (sb <= w) {
#pragma unroll
                    for (int ks = 0; ks < 4; ++ks) cb[sb] = __builtin_amdgcn_mfma_f32_16x16x32_bf16(ca[ks], lds_frag(L + SSD_BS, 16 * sb + li, 64 * ks + 16 * lq), cb[sb], 0, 0, 0); } }
            float csl[4];
#pragma unroll
            for (int r = 0; r < 4; ++r) csl[r] = csf[16 * w + 4 * lq + r];
#pragma unroll
            for (int sb = 0; sb < 8; ++sb) if (sb <= w) { const int s = 16 * sb + li; const float css = csf[s];
#pragma unroll
                for (int r = 0; r < 4; ++r) { const int l = 16 * w + 4 * lq + r; cb[sb][r] = (s <= l) ? cb[sb][r] * __expf(csl[r] - css) : 0.f; } }
            __syncthreads();
#pragma unroll
            for (int sb = 0; sb < 8; ++sb) if (sb <= (w | 1)) {
#pragma unroll
                for (int r = 0; r < 4; ++r) *(LAS unsigned short*)(L + SSD_BS + (16 * w + 4 * lq + r) * SSD_PITCH + (16 * sb + li) * 2) = (unsigned short)f2bf(cb[sb][r]); }
            LDS_WAIT(); asm volatile("" ::: "memory");
            f32x4 yd[4], yo[4];
#pragma unroll
            for (int pb = 0; pb < 4; ++pb) { yd[pb] = (f32x4){0.f, 0.f, 0.f, 0.f}; yo[pb] = (f32x4){0.f, 0.f, 0.f, 0.f}; }
#pragma unroll
            for (int ks = 0; ks < 4; ++ks) if (ks <= (w >> 1)) { const bf16x8 gf = lds_frag(L + SSD_BS, 16 * w + li, 64 * ks + 16 * lq);
#pragma unroll
                for (int pb = 0; pb < 4; ++pb) yd[pb] = __builtin_amdgcn_mfma_f32_16x16x32_bf16(gf, lds_frag(L + SSD_XDT, 16 * pb + li, 64 * ks + 16 * lq), yd[pb], 0, 0, 0); }
#pragma unroll
            for (int ks = 0; ks < 4; ++ks)
#pragma unroll
                for (int pb = 0; pb < 4; ++pb) yo[pb] = __builtin_amdgcn_mfma_f32_16x16x32_bf16(ca[ks], lds_frag(L + SSD_PREV, 16 * pb + li, 64 * ks + 16 * lq), yo[pb], 0, 0, 0);
#pragma unroll
            for (int r = 0; r < 4; ++r) { const float e = __expf(csl[r]);
#pragma unroll
                for (int pb = 0; pb < 4; ++pb) *(LAS float*)(L + SSD_BS + (16 * w + 4 * lq + r) * SSD_PITCH + (16 * pb + li) * 4) = yd[pb][r] + e * yo[pb][r]; }
            __syncthreads();
            { const float dec = __expf(cs_end);
#pragma unroll
              for (int j = 0; j < 4; ++j) st[j] = st[j] * dec;
#pragma unroll
              for (int ks = 0; ks < 4; ++ks) { const bf16x8 xf = lds_frag(L + SSD_XDT, 16 * pbs + li, 64 * ks + 16 * lq);
#pragma unroll
                  for (int j = 0; j < 4; ++j) st[j] = __builtin_amdgcn_mfma_f32_16x16x32_bf16(xf, lds_frag(L + SSD_BWT, 16 * (nb0 + j) + li, 64 * ks + 16 * lq), st[j], 0, 0, 0); }
#pragma unroll
              for (int j = 0; j < 4; ++j)
#pragma unroll
                  for (int r = 0; r < 4; ++r) *(LAS unsigned short*)(L + SSD_PREV + (16 * pbs + 4 * lq + r) * SSD_PITCH + (16 * (nb0 + j) + li) * 2) = (unsigned short)f2bf(st[j][r]); }
#pragma unroll
            for (int k = 0; k < 2; ++k) { const int it = tid + 512 * k, l = it >> 3, o = it & 7; const size_t row = row0 + l;
                const f32x4 y0 = *(const LAS f32x4*)(L + SSD_BS + l * SSD_PITCH + 32 * o), y1 = *(const LAS f32x4*)(L + SSD_BS + l * SSD_PITCH + 32 * o + 16);
                const v4u xw = *(const LAS v4u*)(L + SSD_XS + l * SSD_XPITCH + 16 * o); const v4u zw = *(const v4u*)(proj + row * NPROJ + h * 64 + 8 * o);
                float xv[8], zv[8], yv[8]; unpack8(xw, xv); unpack8(zw, zv);
                float ss = 0.f;
#pragma unroll
                for (int e = 0; e < 8; ++e) { const float yy = (e < 4 ? y0[e] : y1[e - 4]) + Dh * xv[e]; yv[e] = yy * silu_f(zv[e]); ss += yv[e] * yv[e]; }
                ss += __shfl_xor(ss, 1); ss += __shfl_xor(ss, 2); ss += __shfl_xor(ss, 4);
                if (o == 0) WSP(float, WS_STSSD)[row * 16 + h] = ss;
                *(v4u*)(WSP(bf16, WS_Y) + row * 2048 + h * 64 + 8 * o) = (v4u){pk2(yv[0], yv[1]), pk2(yv[2], yv[3]), pk2(yv[4], yv[5]), pk2(yv[6], yv[7])}; }
            __syncthreads();
        }
    }
}
__device__ __forceinline__ void p3pre_conv(Frame& F) {
    const int tid = threadIdx.x;
    const bf16* proj = WSP(bf16, WS_PROJ); bf16* xo = (bf16*)F.out;
    for (int item = F.vcu * NTHR + tid; item < (MTOK / 32) * 256; item += F.G * NTHR) {
        const int oc = item & 255, run = item >> 8; const int t0 = run * 32, ch = 8 * oc;
        float cw[4][8], cbv[8];
#pragma unroll
        for (int k = 0; k < 4; ++k) { const f32x4 w0 = *(const f32x4*)((F.a->in[6]) + k * 2048 + ch), w1 = *(const f32x4*)((F.a->in[6]) + k * 2048 + ch + 4);
#pragma unroll
            for (int e = 0; e < 4; ++e) { cw[k][e] = w0[e]; cw[k][4 + e] = w1[e]; } }
        { const f32x4 b0 = *(const f32x4*)((F.a->in[7]) + ch), b1 = *(const f32x4*)((F.a->in[7]) + ch + 4);
#pragma unroll
            for (int e = 0; e < 4; ++e) { cbv[e] = b0[e]; cbv[4 + e] = b1[e]; } }
        float r0[8], r1[8], r2[8];
        const bool halo = (t0 & (SEQ - 1)) != 0;
        { v4u a = (v4u){0u, 0u, 0u, 0u}, b = a, c = a;
          if (halo) { a = *(const v4u*)(proj + (size_t)(t0 - 3) * NPROJ + 1024 + ch); b = *(const v4u*)(proj + (size_t)(t0 - 2) * NPROJ + 1024 + ch); c = *(const v4u*)(proj + (size_t)(t0 - 1) * NPROJ + 1024 + ch); }
          unpack8(a, r0); unpack8(b, r1); unpack8(c, r2); }
#pragma unroll 4
        for (int tt = 0; tt < 32; ++tt) {
            const v4u w = *(const v4u*)(proj + (size_t)(t0 + tt) * NPROJ + 1024 + ch); float r3[8]; unpack8(w, r3);
            float v[8];
#pragma unroll
            for (int i = 0; i < 8; ++i) { v[i] = silu_f(cbv[i] + r0[i] * cw[0][i] + r1[i] * cw[1][i] + r2[i] * cw[2][i] + r3[i] * cw[3][i]); r0[i] = r1[i]; r1[i] = r2[i]; r2[i] = r3[i]; }
            *(v4u*)(xo + (size_t)(t0 + tt) * 2048 + ch) = (v4u){pk2(v[0], v[1]), pk2(v[2], v[3]), pk2(v[4], v[5]), pk2(v[6], v[7])};
        }
    }
}
struct SsdPre { v4u xr[4], br[4], cr[4]; float d0, d1; };
__device__ __forceinline__ void ssd_prefetch(SsdPre& P, const char* xcb, const float* dtr, unsigned voB, unsigned voX, int tid, int lane, int w) {
#pragma unroll
    for (int r = 0; r < 4; ++r) { P.br[r] = *(const v4u*)(xcb + (voB + r * 4096u)); P.cr[r] = *(const v4u*)(xcb + (voB + 1024u + r * 4096u)); }
    if (tid < 256) {
#pragma unroll
        for (int r = 0; r < 4; ++r) P.xr[r] = *(const v4u*)(xcb + (voX + r * 4096u)); }
    if (w == 0) { P.d0 = dtr[lane * 32]; P.d1 = dtr[lane * 32 + 16]; }
}
__device__ __forceinline__ void p3_ssd2(Frame& F) {
    const int tid = threadIdx.x, lane = tid & 63, w = __builtin_amdgcn_readfirstlane(tid >> 6);
    const int li = lane & 15, lq = lane >> 4;
    LAS unsigned char* L = F.lds;
    LAS float* csf = (LAS float*)(L + SSD_CSF); LAS float* dtf = (LAS float*)(L + SSD_DTF);
    const bf16* proj = WSP(bf16, WS_PROJ); const bf16* xc = (const bf16*)F.out; const float* dtraw = WSP(float, WS_DTRAW);
    for (int item = F.vcu; item < NB * NHEADS; item += F.G) {
        const int b = item >> 4, h = item & 15, g = h >> 2;
        const float A = -__expf((F.a->in[9])[h]), Dh = (F.a->in[10])[h], dtb = (F.a->in[8])[h];
        const int pbs = w >> 1, nb0 = 4 * (w & 1);
        f32x4 st[4];
#pragma unroll
        for (int j = 0; j < 4; ++j) st[j] = (f32x4){0.f, 0.f, 0.f, 0.f};
        __syncthreads();
        for (int i = tid; i < 17408 / 16; i += NTHR) ((LAS v4u*)(L + SSD_PREV))[i] = (v4u){0u, 0u, 0u, 0u};
        SsdPre P;
        const unsigned voB = (unsigned)((4 * (tid >> 4)) * 2048 + 1024 + g * 128 + 8 * (tid & 15)) * 2u, voX = (unsigned)((4 * (tid >> 3)) * 2048 + h * 64 + 8 * (tid & 7)) * 2u;
        const unsigned voZ0 = (unsigned)((tid >> 3) * NPROJ + h * 64 + 8 * (tid & 7)) * 2u, voZ1 = voZ0 + 64u * NPROJ * 2u;
        ssd_prefetch(P, (const char*)xc + (size_t)b * SEQ * 4096, dtraw + (size_t)b * SEQ * 16 + h, voB, voX, tid, lane, w);
        for (int c = 0; c < SEQ / CHUNK; ++c) {
            const size_t row0 = (size_t)b * SEQ + (size_t)c * CHUNK;
            if (w == 0) {
                const float d0 = softplus_f(P.d0 + dtb), d1 = softplus_f(P.d1 + dtb);
                const float a0 = d0 * A, a1 = d1 * A; float s = a0 + a1;
#pragma unroll
                for (int o = 1; o < 64; o <<= 1) { const float t = __shfl_up(s, o); if (lane >= o) s += t; }
                dtf[2 * lane] = d0; dtf[2 * lane + 1] = d1; csf[2 * lane] = s - a1; csf[2 * lane + 1] = s;
            }
            __syncthreads();
            const float cs_end = csf[127];
            { const int ob = tid & 15, lb = 4 * (tid >> 4), n0 = 8 * ob;
#pragma unroll
              for (int r = 0; r < 4; ++r) { *(LAS v4u*)(L + SSD_BS + (lb + r) * SSD_PITCH + n0 * 2) = P.br[r]; *(LAS v4u*)(L + SSD_CS + (lb + r) * SSD_PITCH + n0 * 2) = P.cr[r]; }
              float bv[4][8];
#pragma unroll
              for (int r = 0; r < 4; ++r) { unpack8(P.br[r], bv[r]); const float tw = __expf(cs_end - csf[lb + r]);
#pragma unroll
                  for (int i = 0; i < 8; ++i) bv[r][i] *= tw; }
#pragma unroll
              for (int i = 0; i < 8; ++i) *(LAS v2u*)(L + SSD_BWT + (n0 + i) * SSD_PITCH + lb * 2) = (v2u){pk2(bv[0][i], bv[1][i]), pk2(bv[2][i], bv[3][i])}; }
            if (tid < 256) { const int ox = tid & 7, lx = 4 * (tid >> 3), p0 = 8 * ox; float xv[4][8];
#pragma unroll
              for (int r = 0; r < 4; ++r) { *(LAS v4u*)(L + SSD_XS + (lx + r) * SSD_XPITCH + p0 * 2) = P.xr[r]; unpack8(P.xr[r], xv[r]); const float tw = dtf[lx + r];
#pragma unroll
                  for (int i = 0; i < 8; ++i) xv[r][i] *= tw; }
#pragma unroll
              for (int i = 0; i < 8; ++i) *(LAS v2u*)(L + SSD_XDT + (p0 + i) * SSD_PITCH + lx * 2) = (v2u){pk2(xv[0][i], xv[1][i]), pk2(xv[2][i], xv[3][i])}; }
            const char* prb = (const char*)proj + row0 * (NPROJ * 2);
            const v4u zc0 = *(const v4u*)(prb + voZ0), zc1 = *(const v4u*)(prb + voZ1);
            if (c + 1 < SEQ / CHUNK) ssd_prefetch(P, (const char*)xc + (row0 + CHUNK) * 4096, dtraw + (row0 + CHUNK) * 16 + h, voB, voX, tid, lane, w);
            __syncthreads();
            bf16x8 ca[4];
#pragma unroll
            for (int ks = 0; ks < 4; ++ks) ca[ks] = lds_frag(L + SSD_CS, 16 * w + li, 64 * ks + 16 * lq);
            f32x4 cb[8];
#pragma unroll
            for (int sb = 0; sb < 8; ++sb) { cb[sb] = (f32x4){0.f, 0.f, 0.f, 0.f};
                if (sb <= w) {
#pragma unroll
                    for (int ks = 0; ks < 4; ++ks) cb[sb] = __builtin_amdgcn_mfma_f32_16x16x32_bf16(ca[ks], lds_frag(L + SSD_BS, 16 * sb + li, 64 * ks + 16 * lq), cb[sb], 0, 0, 0); } }
            float csl[4];
#pragma unroll
            for (int r = 0; r < 4; ++r) csl[r] = csf[16 * w + 4 * lq + r];
#pragma unroll
            for (int sb = 0; sb < 8; ++sb) if (sb <= w) { const int s = 16 * sb + li; const float css = csf[s];
#pragma unroll
                for (int r = 0; r < 4; ++r) { const int l = 16 * w + 4 * lq + r; cb[sb][r] = (s <= l) ? cb[sb][r] * __expf(csl[r] - css) : 0.f; } }
            __syncthreads();
#pragma unroll
            for (int sb = 0; sb < 8; ++sb) if (sb <= (w | 1)) {
#pragma unroll
                for (int r = 0; r < 4; ++r) *(LAS unsigned short*)(L + SSD_BS + (16 * w + 4 * lq + r) * SSD_PITCH + (16 * sb + li) * 2) = (unsigned short)f2bf(cb[sb][r]); }
            LDS_WAIT(); asm volatile("" ::: "memory");
            f32x4 yd[4], yo[4];
#pragma unroll
            for (int pb = 0; pb < 4; ++pb) { yd[pb] = (f32x4){0.f, 0.f, 0.f, 0.f}; yo[pb] = (f32x4){0.f, 0.f, 0.f, 0.f}; }
#pragma unroll
            for (int ks = 0; ks < 4; ++ks) if (ks <= (w >> 1)) { const bf16x8 gf = lds_frag(L + SSD_BS, 16 * w + li, 64 * ks + 16 * lq);
#pragma unroll
                for (int pb = 0; pb < 4; ++pb) yd[pb] = __builtin_amdgcn_mfma_f32_16x16x32_bf16(gf, lds_frag(L + SSD_XDT, 16 * pb + li, 64 * ks + 16 * lq), yd[pb], 0, 0, 0); }
#pragma unroll
            for (int ks = 0; ks < 4; ++ks)
#pragma unroll
                for (int pb = 0; pb < 4; ++pb) yo[pb] = __builtin_amdgcn_mfma_f32_16x16x32_bf16(ca[ks], lds_frag(L + SSD_PREV, 16 * pb + li, 64 * ks + 16 * lq), yo[pb], 0, 0, 0);
#pragma unroll
            for (int r = 0; r < 4; ++r) { const float e = __expf(csl[r]);
#pragma unroll
                for (int pb = 0; pb < 4; ++pb) *(LAS float*)(L + SSD_BS + (16 * w + 4 * lq + r) * SSD_PITCH + (16 * pb + li) * 4) = yd[pb][r] + e * yo[pb][r]; }
            __syncthreads();
            { const float dec = __expf(cs_end);
#pragma unroll
              for (int j = 0; j < 4; ++j) st[j] = st[j] * dec;
#pragma unroll
              for (int ks = 0; ks < 4; ++ks) { const bf16x8 xf = lds_frag(L + SSD_XDT, 16 * pbs + li, 64 * ks + 16 * lq);
#pragma unroll
                  for (int j = 0; j < 4; ++j) st[j] = __builtin_amdgcn_mfma_f32_16x16x32_bf16(xf, lds_frag(L + SSD_BWT, 16 * (nb0 + j) + li, 64 * ks + 16 * lq), st[j], 0, 0, 0); }
#pragma unroll
              for (int j = 0; j < 4; ++j)
#pragma unroll
                  for (int r = 0; r < 4; ++r) *(LAS unsigned short*)(L + SSD_PREV + (16 * pbs + 4 * lq + r) * SSD_PITCH + (16 * (nb0 + j) + li) * 2) = (unsigned short)f2bf(st[j][r]); }
#pragma unroll
            for (int k = 0; k < 2; ++k) { const int it = tid + 512 * k, l = it >> 3, o = it & 7; const size_t row = row0 + l;
                const f32x4 y0 = *(const LAS f32x4*)(L + SSD_BS + l * SSD_PITCH + 32 * o), y1 = *(const LAS f32x4*)(L + SSD_BS + l * SSD_PITCH + 32 * o + 16);
                const v4u xw = *(const LAS v4u*)(L + SSD_XS + l * SSD_XPITCH + 16 * o); const v4u zw = k == 0 ? zc0 : zc1;
                float xv[8], zv[8], yv[8]; unpack8(xw, xv); unpack8(zw, zv);
                float ss = 0.f;
#pragma unroll
                for (int e = 0; e < 8; ++e) { const float yy = (e < 4 ? y0[e] : y1[e - 4]) + Dh * xv[e]; yv[e] = yy * silu_f(zv[e]); ss += yv[e] * yv[e]; }
                ss += __shfl_xor(ss, 1); ss += __shfl_xor(ss, 2); ss += __shfl_xor(ss, 4);
                if (o == 0) WSP(float, WS_STSSD)[row * 16 + h] = ss;
                *(v4u*)(WSP(bf16, WS_Y) + row * 2048 + h * 64 + 8 * o) = (v4u){pk2(yv[0], yv[1]), pk2(yv[2], yv[3]), pk2(yv[4], yv[5]), pk2(yv[6], yv[7])}; }
            __syncthreads();
        }
    }
}
constexpr int S5_XT = 0, S5_XPITCH = 2056, S5_BBT = 65792, S5_CC = S5_BBT + 16384, S5_CCPITCH = 272, S5_GLU = S5_CC + 64 * S5_CCPITCH, S5_VS = S5_GLU + 2048, S5_OT = S5_VS + 8 * 512, S5_OPITCH = 144, S5_END = S5_OT + 32 * S5_OPITCH;
static_assert(S5_END <= LDS_MAIN, "S5 LDS map");
typedef float f32x16 __attribute__((ext_vector_type(16)));
__device__ __forceinline__ void p3_s5(Frame& F) {
    const int tid = threadIdx.x, lane = tid & 63, w = __builtin_amdgcn_readfirstlane(tid >> 6);
    const int li = lane & 15, lq = lane >> 4;
    LAS unsigned char* L = F.lds;
    const bf16* proj = WSP(bf16, WS_PROJ);
    for (int item = F.vcu; item < NB * 16; item += F.G) {
        const int b = item >> 4, gs = item & 15;
        __syncthreads();
        { const int gl = tid >> 7, col = tid & 127, p = col >> 1, ri = col & 1; const float* src = WSP(float, WS_S5BB) + ((gs * 4 + gl) * 64 + p) * 32 + ri * 16;
          const f32x4 a0 = *(const f32x4*)src, a1 = *(const f32x4*)(src + 4), a2 = *(const f32x4*)(src + 8), a3 = *(const f32x4*)(src + 12);
          LAS v4u* d = (LAS v4u*)(L + S5_BBT + (gl * 128 + col) * 32);
          d[0] = (v4u){pk2(a0[0], a0[1]), pk2(a0[2], a0[3]), pk2(a1[0], a1[1]), pk2(a1[2], a1[3])}; d[1] = (v4u){pk2(a2[0], a2[1]), pk2(a2[2], a2[3]), pk2(a3[0], a3[1]), pk2(a3[2], a3[3])}; }
        { const int gl = tid >> 7, hh = (tid >> 3) & 15, kq = tid & 7; const int g = gs * 4 + gl; const float* cr = (F.a->in[17]) + (g * 16 + hh) * 64 + 8 * kq; const float* ci = (F.a->in[18]) + (g * 16 + hh) * 64 + 8 * kq;
          const f32x4 r0 = *(const f32x4*)cr, r1 = *(const f32x4*)(cr + 4), i0 = *(const f32x4*)ci, i1 = *(const f32x4*)(ci + 4);
          LAS v4u* d = (LAS v4u*)(L + S5_CC + (gl * 16 + hh) * S5_CCPITCH + kq * 32);
          d[0] = (v4u){pk2(r0[0], -i0[0]), pk2(r0[1], -i0[1]), pk2(r0[2], -i0[2]), pk2(r0[3], -i0[3])}; d[1] = (v4u){pk2(r1[0], -i1[0]), pk2(r1[1], -i1[1]), pk2(r1[2], -i1[2]), pk2(r1[3], -i1[3])}; }
        for (int i = tid; i < 1024; i += NTHR) { const int gl = i >> 8, k = (i >> 4) & 15, hh = i & 15; ((LAS unsigned short*)(L + S5_GLU))[i] = (unsigned short)f2bf((F.a->in[20])[((gs * 4 + gl) * 16 + hh) * 16 + k]); }
        const int gsc = gs * 4 + (w & 3);
        const float lbr = WSP(float, WS_S5LB)[(gsc * 64 + lane) * 2], lbi = WSP(float, WS_S5LB)[(gsc * 64 + lane) * 2 + 1];
        const int glo = w >> 1, mb = w & 1, go = gs * 4 + glo;
        const float dsk = (F.a->in[19])[go * 16 + li], gbias = (F.a->in[21])[go * 16 + li];
        float xr = 0.f, xi = 0.f;
        __syncthreads();
        const bf16* ubase = proj + (size_t)b * SEQ * NPROJ + 3072 + gs * 64;
        v4u ua = *(const v4u*)(ubase + (size_t)(lane & 31) * NPROJ + glo * 16 + 8 * (lane >> 5));
        for (int t0 = 0; t0 < SEQ; t0 += 32) {
            const bf16x8 af = __builtin_bit_cast(bf16x8, ua);
            if (t0 + 32 < SEQ) ua = *(const v4u*)(ubase + (size_t)(t0 + 32 + (lane & 31)) * NPROJ + glo * 16 + 8 * (lane >> 5));
            float uo[4];
#pragma unroll
            for (int r = 0; r < 4; ++r) uo[r] = bf2f(ubase[(size_t)(t0 + 16 * mb + 4 * lq + r) * NPROJ + glo * 16 + li]);
#pragma unroll
            for (int q = 0; q < 2; ++q) { const int cb = 2 * (w & 1) + q;
                const bf16x8 bfrag = *(const LAS bf16x8*)(L + S5_BBT + (glo * 128 + 32 * cb + (lane & 31)) * 32 + 16 * (lane >> 5));
                f32x16 acc;
#pragma unroll
                for (int r = 0; r < 16; ++r) acc[r] = 0.f;
                acc = __builtin_amdgcn_mfma_f32_32x32x16_bf16(af, bfrag, acc, 0, 0, 0);
#pragma unroll
                for (int r = 0; r < 16; ++r) { const int t = (r & 3) + 8 * (r >> 2) + 4 * (lane >> 5); *(LAS float*)(L + S5_XT + t * S5_XPITCH + (glo * 128 + 32 * cb + (lane & 31)) * 4) = acc[r]; } }
            __syncthreads();
            if (w < 4) { LAS f32x2* xp = (LAS f32x2*)(L + S5_XT + (w * 128 + 2 * lane) * 4);
#pragma unroll 8
                for (int t = 0; t < 32; ++t) { const f32x2 bu = xp[t * (S5_XPITCH / 8)]; const float nr = lbr * xr - lbi * xi + bu[0], ni = lbr * xi + lbi * xr + bu[1]; xr = nr; xi = ni; xp[t * (S5_XPITCH / 8)] = (f32x2){xr, xi}; } }
            __syncthreads();
            f32x4 yacc = (f32x4){0.f, 0.f, 0.f, 0.f};
#pragma unroll
            for (int ks = 0; ks < 4; ++ks) { const LAS float* xs = (const LAS float*)(L + S5_XT + (16 * mb + li) * S5_XPITCH + (glo * 128 + 32 * ks + 8 * lq) * 4);
                const f32x4 x0 = *(const LAS f32x4*)xs, x1 = *(const LAS f32x4*)(xs + 4);
                const v4u xa = (v4u){pk2(x0[0], x0[1]), pk2(x0[2], x0[3]), pk2(x1[0], x1[1]), pk2(x1[2], x1[3])};
                const bf16x8 cf = *(const LAS bf16x8*)(L + S5_CC + (glo * 16 + li) * S5_CCPITCH + 64 * ks + 16 * lq);
                yacc = __builtin_amdgcn_mfma_f32_16x16x32_bf16(__builtin_bit_cast(bf16x8, xa), cf, yacc, 0, 0, 0); }
            float v[4];
#pragma unroll
            for (int r = 0; r < 4; ++r) v[r] = gelu_erf(yacc[r] + dsk * uo[r]);
            LAS unsigned char* vs = L + S5_VS + w * 512;
#pragma unroll
            for (int r = 0; r < 4; ++r) *(LAS unsigned short*)(vs + (4 * lq + r) * 32 + li * 2) = (unsigned short)f2bf(v[r]);
            LDS_WAIT(); asm volatile("" ::: "memory");
            v4u va = (v4u){0u, 0u, 0u, 0u}, gw = (v4u){0u, 0u, 0u, 0u};
            if (lq < 2) { va = *(const LAS v4u*)(vs + li * 32 + 16 * lq); gw = *(const LAS v4u*)(L + S5_GLU + ((glo * 16 + li) * 16 + 8 * lq) * 2); }
            f32x4 gacc = (f32x4){0.f, 0.f, 0.f, 0.f};
            gacc = __builtin_amdgcn_mfma_f32_16x16x32_bf16(__builtin_bit_cast(bf16x8, va), __builtin_bit_cast(bf16x8, gw), gacc, 0, 0, 0);
            float o[4], ss[4];
#pragma unroll
            for (int r = 0; r < 4; ++r) { o[r] = v[r] * sigmoid_f(gacc[r] + gbias); ss[r] = o[r] * o[r]; }
#pragma unroll
            for (int r = 0; r < 4; ++r) { ss[r] += __shfl_xor(ss[r], 1); ss[r] += __shfl_xor(ss[r], 2); ss[r] += __shfl_xor(ss[r], 4); ss[r] += __shfl_xor(ss[r], 8); }
            if (li == 0) {
#pragma unroll
                for (int r = 0; r < 4; ++r) WSP(float, WS_STS5)[((size_t)b * SEQ + t0 + 16 * mb + 4 * lq + r) * NS5PART + go] = ss[r]; }
#pragma unroll
            for (int r = 0; r < 4; ++r) *(LAS unsigned short*)(L + S5_OT + (16 * mb + 4 * lq + r) * S5_OPITCH + (glo * 16 + li) * 2) = (unsigned short)f2bf(o[r]);
            __syncthreads();
            if (tid < 256) { const int t = tid >> 3, oc = tid & 7; const v4u ov = *(const LAS v4u*)(L + S5_OT + t * S5_OPITCH + 16 * oc);
                *(v4u*)(WSP(bf16, WS_Y) + ((size_t)b * SEQ + t0 + t) * 2048 + 1024 + gs * 64 + 8 * oc) = ov; }
        }
    }
}
__device__ __forceinline__ unsigned med3u(unsigned a, unsigned b, unsigned c) { unsigned r; asm("v_med3_u32 %0, %1, %2, %3" : "=v"(r) : "v"(a), "v"(b), "v"(c)); return r; }
__device__ __forceinline__ unsigned fkey(float v) { const unsigned u = __builtin_bit_cast(unsigned, v); return (u & 0x80000000u) ? ~u : (u | 0x80000000u); }
__device__ __forceinline__ float fkey_inv(unsigned k) { const unsigned u = (k & 0x80000000u) ? (k & 0x7fffffffu) : ~k; return __builtin_bit_cast(float, u); }
#define TOPK_INSERT(a, x) do { _Pragma("unroll") for (int _i = 15; _i >= 1; --_i) a[_i] = med3u(a[_i - 1], a[_i], (x)); a[0] = a[0] > (x) ? a[0] : (x); } while (0)
__device__ __forceinline__ void p5b_topk(Frame& F) {
    const int f_tid = threadIdx.x, f_lane = f_tid & 63, f_wave = __builtin_amdgcn_readfirstlane(f_tid >> 6);
    const float* scores = WSP(float, WS_SCORES);
    LAS unsigned char* ix = (LAS unsigned char*)F.lds + f_tid * 36;
    for (int item = F.vcu * NTHR + f_tid; item < MTOK * PH; item += F.G * NTHR) {
        const int t = item >> 3, hd = item & 7;
        unsigned a1[16], a2[16];
#pragma unroll
        for (int i = 0; i < 16; ++i) { a1[i] = 0u; a2[i] = 0u; }
        const float* sp = scores + (size_t)t * 2048 + hd * 256;
#pragma unroll 2
        for (int q = 0; q < 32; ++q) { const f32x4 s = *(const f32x4*)(sp + 4 * q);
#pragma unroll
            for (int e = 0; e < 4; ++e) { const unsigned k = (fkey(s[e]) & ~127u) | (unsigned)(127 - (4 * q + e)); TOPK_INSERT(a1, k); } }
#pragma unroll 2
        for (int q = 0; q < 32; ++q) { const f32x4 s = *(const f32x4*)(sp + 128 + 4 * q);
#pragma unroll
            for (int e = 0; e < 4; ++e) { const unsigned k = (fkey(s[e]) & ~127u) | (unsigned)(127 - (4 * q + e)); TOPK_INSERT(a2, k); } }
        float v1[16], v2[16];
#pragma unroll
        for (int i = 0; i < 16; ++i) { ix[i] = (unsigned char)(127u - (a1[i] & 127u)); ix[16 + i] = (unsigned char)(127u - (a2[i] & 127u)); v1[i] = fkey_inv(a1[i] & ~127u); v2[i] = fkey_inv(a2[i] & ~127u); }
        unsigned cb[16];
#pragma unroll
        for (int i = 0; i < 16; ++i) cb[i] = 0u;
#pragma unroll
        for (int i = 0; i < 16; ++i)
#pragma unroll
            for (int j = 0; j < 16; ++j) if ((i + 1) * (j + 1) <= 16) { const unsigned k = (fkey(v1[i] + v2[j]) & ~255u) | (unsigned)(255 - (i * 16 + j)); TOPK_INSERT(cb, k); }
        float tv[16]; float mx = -3.0e38f;
#pragma unroll
        for (int k = 0; k < 16; ++k) { tv[k] = fkey_inv(cb[k] & ~255u); mx = fmaxf(mx, tv[k]); }
        float sum = 0.f;
#pragma unroll
        for (int k = 0; k < 16; ++k) { tv[k] = __expf(tv[k] - mx); sum += tv[k]; }
        const float inv = 1.0f / sum;
        LDS_WAIT(); asm volatile("" ::: "memory");
        int ev[16]; unsigned long long c64 = 0ull;
#pragma unroll
        for (int k = 0; k < 16; ++k) { const unsigned code = 255u - (cb[k] & 255u); const int i = code >> 4, j = code & 15; ev[k] = (int)ix[i] * 128 + (int)ix[16 + j]; c64 += 1ull << (8 * (ev[k] >> 11)); }
        unsigned long long s64 = c64;
#pragma unroll
        for (int o = 1; o < 8; o <<= 1) { const unsigned lo = __shfl_up((unsigned)s64, o, 8), hi = __shfl_up((unsigned)(s64 >> 32), o, 8); if ((f_lane & 7) >= o) s64 += ((unsigned long long)hi << 32) | lo; }
        const unsigned long long e64 = s64 - c64;
        const unsigned long long t64 = ((unsigned long long)__shfl((unsigned)(s64 >> 32), 7, 8) << 32) | __shfl((unsigned)s64, 7, 8);
        const unsigned long long st64 = (t64 * 0x0101010101010101ull) << 8;
        unsigned long long base64 = st64 + e64;
        int* eo = WSP(int, WS_EID) + (size_t)t * 128; float* go = WSP(float, WS_GATE) + (size_t)t * 128;
#pragma unroll
        for (int k = 0; k < 16; ++k) { const int r8 = 8 * (ev[k] >> 11); const int slot = (int)((base64 >> r8) & 255ull); base64 += 1ull << r8; eo[slot] = ev[k]; go[slot] = tv[k] * inv; }
        if (hd == 0) WSP(unsigned long long, WS_START)[t] = st64;
        LDS_WAIT(); asm volatile("" ::: "memory");
    }
}
__device__ __forceinline__ void dec16(const v4u q, float* f) {
#pragma unroll
    for (int i = 0; i < 4; ++i) { const f32x2 lo = __builtin_amdgcn_cvt_pk_f32_fp8((int)q[i], false), hi = __builtin_amdgcn_cvt_pk_f32_fp8((int)q[i], true); f[4 * i] = lo[0]; f[4 * i + 1] = lo[1]; f[4 * i + 2] = hi[0]; f[4 * i + 3] = hi[1]; }
}
__device__ __forceinline__ void p8_peer_up(Frame& F) {
    const int f_tid = threadIdx.x, lane = f_tid & 63, f_wave = __builtin_amdgcn_readfirstlane(f_tid >> 6);
    const int rr = blockIdx.x & 7, wk = (blockIdx.x >> 3) * NWAVES + f_wave, nwk = (F.G >> 3) * NWAVES;
    const unsigned char* EU = F.ws + WS_EU;
    for (int blk = wk; blk < MTOK / 128; blk += nwk) {
        const int b = blk >> 4; const float* mb = WSP(float, WS_MOD) + (size_t)b * 6144;
        float S2[16];
#pragma unroll
        for (int q = 0; q < 4; ++q) { const f32x4 sh = *(const f32x4*)(mb + 3072 + 16 * lane + 4 * q); S2[4 * q] = sh[0]; S2[4 * q + 1] = sh[1]; S2[4 * q + 2] = sh[2]; S2[4 * q + 3] = sh[3]; }
        for (int tt = 0; tt < 128; ++tt) {
            const size_t t = (size_t)blk * 128 + tt;
            const unsigned long long st64 = WSP(unsigned long long, WS_START)[t];
            const int s0 = (int)((st64 >> (8 * rr)) & 255ull), s1 = rr == 7 ? 128 : (int)((st64 >> (8 * rr + 8)) & 255ull), cnt = s1 - s0;
            if (cnt <= 0) continue;
            const float rs = rsqrt_f(WSP(float, WS_ROWSTAT)[t] * (1.0f / 1024.0f) + EPSF);
            const bf16* xr = WSP(bf16, WS_X1S) + t * 1024 + 16 * lane; const v4u xa = *(const v4u*)xr, xb = *(const v4u*)(xr + 8);
            float h2[16]; unpack8(xa, h2); unpack8(xb, h2 + 8);
#pragma unroll
            for (int i = 0; i < 16; ++i) h2[i] = h2[i] * rs + S2[i];
            int* ep = WSP(int, WS_EID) + t * 128 + s0; float* gp = WSP(float, WS_GATE) + t * 128 + s0;
            for (int j0 = 0; j0 < cnt; j0 += 8) {
                const int myi = j0 + (lane & 7) < cnt ? j0 + (lane & 7) : cnt - 1;
                const int emine = ep[myi]; const float gmine = gp[myi];
                v4u q[8];
#pragma unroll
                for (int j = 0; j < 8; ++j) { const int e = __shfl(emine, j); q[j] = *(const v4u*)(EU + (size_t)e * 1024 + 16 * lane); }
                float d[8];
#pragma unroll
                for (int j = 0; j < 8; ++j) { float f[16]; dec16(q[j], f); float a = 0.f;
#pragma unroll
                    for (int i = 0; i < 16; ++i) a += h2[i] * f[i];
                    d[j] = a; }
                float e4[4], e2[2], e1;
#pragma unroll
                for (int i = 0; i < 4; ++i) { const bool up = lane & 32; const float snd = up ? d[i] : d[i + 4]; const float rcv = __shfl_xor(snd, 32); e4[i] = (up ? d[i + 4] : d[i]) + rcv; }
#pragma unroll
                for (int i = 0; i < 2; ++i) { const bool up = lane & 16; const float snd = up ? e4[i] : e4[i + 2]; const float rcv = __shfl_xor(snd, 16); e2[i] = (up ? e4[i + 2] : e4[i]) + rcv; }
                { const bool up = lane & 8; const float snd = up ? e2[0] : e2[1]; const float rcv = __shfl_xor(snd, 8); e1 = (up ? e2[1] : e2[0]) + rcv; }
                e1 += __shfl_xor(e1, 4); e1 += __shfl_xor(e1, 2); e1 += __shfl_xor(e1, 1);
                const int myj = ((lane >> 5) & 1) * 4 + ((lane >> 4) & 1) * 2 + ((lane >> 3) & 1);
                const int ej = __shfl(emine, myj); const float gj = __shfl(gmine, myj);
                const float wv = gj * gelu_erf(e1 * WSP(float, WS_EUS)[ej]) * WSP(float, WS_EVS)[ej];
                if ((lane & 7) == 0 && j0 + myj < cnt) gp[j0 + myj] = wv;
            }
        }
    }
}
__device__ __forceinline__ void p9_peer_down(Frame& F, float* dst) {
    const int f_tid = threadIdx.x, lane = f_tid & 63, f_wave = __builtin_amdgcn_readfirstlane(f_tid >> 6);
    const unsigned char* EV = F.ws + WS_EV;
    for (int wq = F.vcu * NWAVES + f_wave; wq < MTOK / 16; wq += F.G * NWAVES) {
        const int b = wq >> 7; const float* mb = WSP(float, WS_MOD) + (size_t)b * 6144;
        float GT[16], NF[16];
#pragma unroll
        for (int q = 0; q < 4; ++q) { const f32x4 gt = *(const f32x4*)(mb + 5120 + 16 * lane + 4 * q), nf = *(const f32x4*)((F.a->in[29]) + 16 * lane + 4 * q);
#pragma unroll
            for (int e = 0; e < 4; ++e) { GT[4 * q + e] = gt[e]; NF[4 * q + e] = nf[e]; } }
        for (int tt = 0; tt < 16; ++tt) {
            const size_t t = (size_t)wq * 16 + tt; float* xr = F.out + t * 1024 + 16 * lane;
            const int e_lo = WSP(int, WS_EID)[t * 128 + lane], e_hi = WSP(int, WS_EID)[t * 128 + 64 + lane];
            const float w_lo = WSP(float, WS_GATE)[t * 128 + lane], w_hi = WSP(float, WS_GATE)[t * 128 + 64 + lane];
            f32x2 o[8];
#pragma unroll
            for (int i = 0; i < 8; ++i) o[i] = (f32x2){0.f, 0.f};
            for (int grp = 0; grp < 16; ++grp) {
                const int esel = grp < 8 ? e_lo : e_hi; const float wsel = grp < 8 ? w_lo : w_hi; const int base = (grp & 7) * 8;
                v4u q[8];
#pragma unroll
                for (int j = 0; j < 8; ++j) { const int e = __shfl(esel, base + j); q[j] = *(const v4u*)(EV + (size_t)e * 1024 + 16 * lane); }
#pragma unroll
                for (int j = 0; j < 8; ++j) { const float wj = __shfl(wsel, base + j); const f32x2 w2 = (f32x2){wj, wj};
#pragma unroll
                    for (int i = 0; i < 4; ++i) { const f32x2 lo = __builtin_amdgcn_cvt_pk_f32_fp8((int)q[j][i], false), hi = __builtin_amdgcn_cvt_pk_f32_fp8((int)q[j][i], true); o[2 * i] += w2 * lo; o[2 * i + 1] += w2 * hi; } }
            }
            float x1[16]; float ss = 0.f;
#pragma unroll
            for (int q = 0; q < 4; ++q) { const f32x4 v = *(const f32x4*)(xr + 4 * q); x1[4 * q] = v[0]; x1[4 * q + 1] = v[1]; x1[4 * q + 2] = v[2]; x1[4 * q + 3] = v[3]; }
#pragma unroll
            for (int i = 0; i < 16; ++i) { x1[i] += GT[i] * o[i >> 1][i & 1]; ss += x1[i] * x1[i]; }
            const float rf = rsqrt_f(wave_sum(ss) * (1.0f / 1024.0f) + EPSF);
#pragma unroll
            for (int q = 0; q < 4; ++q) { f32x4 v;
#pragma unroll
                for (int e = 0; e < 4; ++e) v[e] = x1[4 * q + e] * rf * NF[4 * q + e];
                *(f32x4*)(dst + t * 1024 + 16 * lane + 4 * q) = v; }
        }
    }
}

__device__ __forceinline__ void p8_peer_fused(Frame& F) {
    const int f_tid = threadIdx.x, lane = f_tid & 63, f_wave = __builtin_amdgcn_readfirstlane(f_tid >> 6);
    const unsigned char* EU = F.ws + WS_EU; const unsigned char* EV = F.ws + WS_EV;
    const int myj = ((lane >> 5) & 1) * 4 + ((lane >> 4) & 1) * 2 + ((lane >> 3) & 1);
    const unsigned l16 = 16u * (unsigned)lane;
    for (int wq = F.vcu * NWAVES + f_wave; wq < MTOK / 16; wq += F.G * NWAVES) {
        const int b = wq >> 7; const float* mb = WSP(float, WS_MOD) + (size_t)b * 6144;
        for (int tt = 0; tt < 16; ++tt) {
            const size_t t = (size_t)wq * 16 + tt;
            unsigned lo16 = 16u * (unsigned)lane; asm volatile("" : "+v"(lo16));
            float* xr = (float*)((char*)(F.out + t * 1024) + 4u * lo16);
            const int e_lo = WSP(int, WS_EID)[t * 128 + lane], e_hi = WSP(int, WS_EID)[t * 128 + 64 + lane];
            const float g_lo = WSP(float, WS_GATE)[t * 128 + lane], g_hi = WSP(float, WS_GATE)[t * 128 + 64 + lane];
            const float su_lo = WSP(float, WS_EUS)[e_lo], su_hi = WSP(float, WS_EUS)[e_hi], sv_lo = WSP(float, WS_EVS)[e_lo], sv_hi = WSP(float, WS_EVS)[e_hi];
            const float rs = rsqrt_f(WSP(float, WS_ROWSTAT)[t] * (1.0f / 1024.0f) + EPSF);
            const char* xs = (const char*)(WSP(bf16, WS_X1S) + t * 1024) + 2u * lo16; const v4u xa = *(const v4u*)xs, xb = *(const v4u*)(xs + 16);
            float h2[16]; unpack8(xa, h2); unpack8(xb, h2 + 8);
#pragma unroll
            for (int q = 0; q < 4; ++q) { const f32x4 sh = *(const f32x4*)(mb + 3072 + 16 * lane + 4 * q);
#pragma unroll
                for (int e = 0; e < 4; ++e) h2[4 * q + e] = h2[4 * q + e] * rs + sh[e]; }
            f32x2 o[8];
#pragma unroll
            for (int i = 0; i < 8; ++i) o[i] = (f32x2){0.f, 0.f};
            v4u qu[8], qv[8], nu[8], nv[8];
#pragma unroll
            for (int j = 0; j < 8; ++j) { const int e = __builtin_amdgcn_readlane(e_lo, j); const unsigned off = (unsigned)e * 1024u + l16; qu[j] = *(const v4u*)(EU + off); qv[j] = *(const v4u*)(EV + off); }
#pragma unroll 1
            for (int grp = 0; grp < 16; ++grp) {
                const int nb = ((grp + 1) & 7) * 8; const int ensel = (grp + 1) < 8 ? e_lo : e_hi;
                if (grp < 15) {
#pragma unroll
                    for (int j = 0; j < 8; ++j) { const int e = __builtin_amdgcn_readlane(ensel, nb + j); const unsigned off = (unsigned)e * 1024u + l16; nu[j] = *(const v4u*)(EU + off); nv[j] = *(const v4u*)(EV + off); } }
                const int base = (grp & 7) * 8;
                const float gsel = grp < 8 ? g_lo : g_hi, susel = grp < 8 ? su_lo : su_hi, svsel = grp < 8 ? sv_lo : sv_hi;
                float d[8];
#pragma unroll
                for (int j = 0; j < 8; ++j) { float f[16]; dec16(qu[j], f); float a = 0.f;
#pragma unroll
                    for (int i = 0; i < 16; ++i) a += h2[i] * f[i];
                    d[j] = a; }
                float e4[4], e2[2], e1;
#pragma unroll
                for (int i = 0; i < 4; ++i) { const bool up = lane & 32; const float snd = up ? d[i] : d[i + 4]; const float rcv = __shfl_xor(snd, 32); e4[i] = (up ? d[i + 4] : d[i]) + rcv; }
#pragma unroll
                for (int i = 0; i < 2; ++i) { const bool up = lane & 16; const float snd = up ? e4[i] : e4[i + 2]; const float rcv = __shfl_xor(snd, 16); e2[i] = (up ? e4[i + 2] : e4[i]) + rcv; }
                { const bool up = lane & 8; const float snd = up ? e2[0] : e2[1]; const float rcv = __shfl_xor(snd, 8); e1 = (up ? e2[1] : e2[0]) + rcv; }
                e1 += __shfl_xor(e1, 4); e1 += __shfl_xor(e1, 2); e1 += __shfl_xor(e1, 1);
                const float wmine = __shfl(gsel, base + myj) * gelu_erf(e1 * __shfl(susel, base + myj)) * __shfl(svsel, base + myj);
#pragma unroll
                for (int j = 0; j < 8; ++j) { const int src = ((j >> 2) & 1) * 32 + ((j >> 1) & 1) * 16 + (j & 1) * 8; const float wj = __builtin_bit_cast(float, __builtin_amdgcn_readlane(__builtin_bit_cast(int, wmine), src)); const f32x2 w2 = (f32x2){wj, wj};
#pragma unroll
                    for (int i = 0; i < 4; ++i) { const f32x2 lo = __builtin_amdgcn_cvt_pk_f32_fp8((int)qv[j][i], false), hi = __builtin_amdgcn_cvt_pk_f32_fp8((int)qv[j][i], true); o[2 * i] += w2 * lo; o[2 * i + 1] += w2 * hi; } }
#pragma unroll
                for (int j = 0; j < 8; ++j) { qu[j] = nu[j]; qv[j] = nv[j]; }
            }
            float x1[16]; float ss = 0.f;
#pragma unroll
            for (int q = 0; q < 4; ++q) { const f32x4 v = *(const f32x4*)(xr + 4 * q); x1[4 * q] = v[0]; x1[4 * q + 1] = v[1]; x1[4 * q + 2] = v[2]; x1[4 * q + 3] = v[3]; }
#pragma unroll
            for (int q = 0; q < 4; ++q) { const f32x4 gt = *(const f32x4*)(mb + 5120 + 16 * lane + 4 * q);
#pragma unroll
                for (int e = 0; e < 4; ++e) { const int i = 4 * q + e; x1[i] += gt[e] * o[i >> 1][i & 1]; ss += x1[i] * x1[i]; } }
            const float rf = rsqrt_f(wave_sum(ss) * (1.0f / 1024.0f) + EPSF);
#pragma unroll
            for (int q = 0; q < 4; ++q) { const f32x4 nf = *(const f32x4*)((F.a->in[29]) + 16 * lane + 4 * q); f32x4 v;
#pragma unroll
                for (int e = 0; e < 4; ++e) v[e] = x1[4 * q + e] * rf * nf[e];
                *(f32x4*)(xr + 4 * q) = v; }
        }
    }
}
constexpr int NPHASE = 9;
__global__ void __launch_bounds__(NTHR, 2) fwd_mega(Args args) {
    extern __shared__ __attribute__((aligned(16))) unsigned char lds[];
    Frame F;
    F.lds = (LAS unsigned char*)lds;
    F.MISC = (volatile LAS unsigned*)(F.lds + MISC_OFF);
    F.G = gridDim.x; { const int bx = blockIdx.x; F.vcu = (F.G % 8 == 0) ? (bx % 8) * (F.G / 8) + bx / 8 : bx; }
    F.ws = args.ws; F.out = args.out;
    F.a = &args;
    for (int u = threadIdx.x; u < 32; u += NTHR) F.MISC[u] = 0u;
    __syncthreads();
    const int lo = args.ph_lo, hi = args.ph_hi;
    const bool use_bar = (hi - lo) > 1;
    XcdBarrier bar; bar.bar = (unsigned*)(F.ws + WS_CTL); bar.x = 0; bar.st = nullptr;
    if (use_bar) bar = xcd_barrier_post((unsigned*)(F.ws + WS_CTL), F.MISC + 8);
#define IN(k) (lo <= (k) && (k) < hi)
#define SEAM(k) do { if (IN(k) && IN((k) + 1)) xcd_barrier(bar); } while (0)
#ifndef REP_PHASE
#define REP_PHASE -1
#endif
#define REPEAT(k, body) do { if (REP_PHASE == (k)) { xcd_barrier(bar); body; } } while (0)
    if (IN(0)) {
#ifndef SKIP_P0
 p0_phase(F); REPEAT(0, p0_phase(F));
#endif
 } SEAM(0);
    if (IN(1)) {
#ifndef SKIP_P1
 p1_phase(F); REPEAT(1, p1_phase(F));
#endif
 } SEAM(1);
    if (IN(2)) {
        pg8::Gemm g{WSP(bf16, WS_H1), WSP(bf16, WS_WINT), MTOK, NPROJ, 1024}; pg8::StaticOrder S; S.init(MTOK, NPROJ, F.G, (int)blockIdx.x);
        pg8::EpiProj E{WSP(bf16, WS_PROJ), NPROJ};
        pg8::gemm_phase<pg8::EpiProj, pg8::StaticOrder, true, true>(F.lds, g, S, E);
        REPEAT(2, (pg8::gemm_phase<pg8::EpiProj, pg8::StaticOrder, true, true>(F.lds, g, S, E)));
    } SEAM(2);
    if (IN(3)) {
#ifndef SKIP_SSD
#ifdef SSD_NAIVE
 p3_ssd_naive(F);
#elif defined(SSD_V1)
 p3_ssd(F); REPEAT(30, p3_ssd(F));
#else
 p3pre_conv(F); xcd_barrier(bar); p3_ssd2(F); REPEAT(30, p3_ssd2(F)); REPEAT(32, p3pre_conv(F));
#endif
#endif
#ifndef SKIP_S5
#ifdef S5_NAIVE
 p3_s5_naive(F);
#else
 p3_s5(F); REPEAT(31, p3_s5(F));
#endif
#endif
 } SEAM(3);
    if (IN(4)) {
#ifndef SKIP_P3C
 p3c_normalize(F);
#endif
 } SEAM(4);
    if (IN(5)) {
        pg8::Gemm g{WSP(bf16, WS_Y), WSP(bf16, WS_WOUTT), MTOK, 1024, 2048}; pg8::StaticOrder S; S.init(MTOK, 1024, F.G, (int)blockIdx.x);
        pg8::EpiX1 E{(F.a->in[0]), F.out, WSP(bf16, WS_X1S), WSP(float, WS_MOD), (F.a->in[24]), WSP(float, WS_ROWSTAT)};
        pg8::gemm_phase<pg8::EpiX1, pg8::StaticOrder, true, true>(F.lds, g, S, E);
    } SEAM(5);
    if (IN(6)) {
        pg8::Gemm g{WSP(bf16, WS_X1S), WSP(bf16, WS_WQKT), MTOK, 2048, 1024}; pg8::StaticOrder S; S.init(MTOK, 2048, F.G, (int)blockIdx.x);
        pg8::EpiScores E{WSP(float, WS_SCORES), WSP(float, WS_SB), WSP(float, WS_ROWSTAT)};
        pg8::gemm_phase<pg8::EpiScores, pg8::StaticOrder, true, true>(F.lds, g, S, E);
        REPEAT(6, (pg8::gemm_phase<pg8::EpiScores, pg8::StaticOrder, true, true>(F.lds, g, S, E)));
    } SEAM(6);
    if (IN(7)) {
#ifndef SKIP_TOPK
 p5b_topk(F); REPEAT(7, p5b_topk(F));
#endif
 } SEAM(7);
    if (IN(8)) { p8_peer_fused(F); }
#undef IN
#undef SEAM
}

#ifndef N_LAUNCHES
#define N_LAUNCHES 1
#endif
extern "C" void kernel_launch(void* const* d_in, const int* in_sizes, int n_in, void* d_out, int out_size, void* d_ws, size_t ws_size, hipStream_t stream) {
    static int grid = 0;
    if (grid == 0) {
        if (n_in != 30 || in_sizes[0] != MTOK * DM || out_size != MTOK * DM || ws_size < WS_END) { fprintf(stderr, "kernel_launch: unexpected shapes (n_in %d, in0 %d, out %d, ws %zu)\n", n_in, n_in > 0 ? in_sizes[0] : -1, out_size, ws_size); grid = -1; return; }
        int dev = 0, cus = 0, per_cu = 0;
        if (hipGetDevice(&dev) != hipSuccess || hipDeviceGetAttribute(&cus, hipDeviceAttributeMultiprocessorCount, dev) != hipSuccess) { grid = -1; return; }
        if (hipFuncSetAttribute((const void*)fwd_mega, hipFuncAttributeMaxDynamicSharedMemorySize, LDS_BYTES) != hipSuccess) { fprintf(stderr, "kernel_launch: hipFuncSetAttribute failed\n"); grid = -1; return; }
        if (hipOccupancyMaxActiveBlocksPerMultiprocessor(&per_cu, (const void*)fwd_mega, NTHR, LDS_BYTES) != hipSuccess || per_cu < 1) { fprintf(stderr, "kernel_launch: occupancy query says %d\n", per_cu); (void)hipGetLastError(); grid = -1; return; }
        grid = cus;
    }
    if (grid < 0) return;
    (void)hipMemsetAsync((char*)d_ws + WS_CTL, 0, CTL_ZERO_BYTES, stream);
    Args a{};
    for (int i = 0; i < 30; ++i) a.in[i] = (const float*)d_in[i];
    a.out = (float*)d_out; a.ws = (unsigned char*)d_ws;
    if (N_LAUNCHES == 1) {
        a.ph_lo = 0; a.ph_hi = NPHASE;
        void* kargs[] = {&a};
        hipError_t e = hipLaunchCooperativeKernel((const void*)fwd_mega, dim3(grid), dim3(NTHR), kargs, LDS_BYTES, stream);
        if (e != hipSuccess) fprintf(stderr, "kernel_launch: cooperative launch failed: %s (grid %d)\n", hipGetErrorString(e), grid);
    } else {
        for (int p = 0; p < NPHASE; ++p) { a.ph_lo = p; a.ph_hi = p + 1; hipLaunchKernelGGL(fwd_mega, dim3(grid), dim3(NTHR), LDS_BYTES, stream, a); }
    }
}
```

```cpp
#include <hip/hip_runtime.h>
#include <cstdio>
#include <cstdint>

namespace pg8 {
#define PG8_LAS __attribute__((address_space(3)))
typedef unsigned short bf16_t;
typedef short bf16x8 __attribute__((ext_vector_type(8)));
typedef float f32x4 __attribute__((ext_vector_type(4)));
typedef unsigned u32x4 __attribute__((ext_vector_type(4)));
constexpr int BM = 256, BK = 64, HALF = 128, HTB = HALF * BK * 2  , STAGE_BYTES = 8 * HTB, NXCD = 8, WGM = 8;

__host__ __device__ __forceinline__ int lds_byte(int r, int c) { const int st = (r >> 4) * 2 + (c >> 5), rr = r & 15, cc = c & 31, ob = rr * 64 + cc * 2; return st * 1024 + (ob ^ (((ob >> 9) & 1) << 5)); }
__host__ __device__ __forceinline__ void stage_rc(int b, int& R, int& C) { const int st = b / 1024, sb = b % 1024, swz = sb ^ (((sb >> 9) & 1) << 5); R = (st >> 1) * 16 + swz / 64; C = (st & 1) * 32 + (swz % 64) / 2; }
__host__ __device__ __forceinline__ int perm32(int rho) { const int n = rho >> 4, i = rho & 15; return 8 * (i >> 2) + 4 * n + (i & 3); }

struct Unit { int pm, pn; };
struct Gemm { const bf16_t* A; const bf16_t* Bt; int M, N, K; };

struct StaticOrder {
    int nM, nN, nwg, G, c;
    __host__ __device__ void init(int M, int N, int G_, int c_) { nM = M / BM; nN = N / BM; nwg = nM * nN; G = G_; c = c_; }
    __host__ __device__ bool next(int i, Unit& u) const {
        const long L = (long)i * G + c; if (L >= nwg) return false;
        int wgid = (int)L; { const int q = nwg / NXCD, r = nwg % NXCD, xcd = wgid % NXCD, off = wgid / NXCD; wgid = (xcd < r ? xcd * (q + 1) : r * (q + 1) + (xcd - r) * q) + off; }
        const int nig = WGM * nN, gid = wgid / nig, fm = gid * WGM, gsz = (nM - fm) < WGM ? (nM - fm) : WGM;
        u.pm = fm + ((wgid % nig) % gsz); u.pn = (wgid % nig) / gsz; return true;
    }
    __device__ __forceinline__ void a_ready(const Unit&) const {}
    __device__ __forceinline__ void done(const Unit&) const {}
};

__device__ __forceinline__ unsigned cvt_pk_bf16(float lo, float hi) { unsigned r; asm volatile("v_cvt_pk_bf16_f32 %0, %1, %2" : "=v"(r) : "v"(lo), "v"(hi)); return r; }
typedef float f32x2 __attribute__((ext_vector_type(2)));
struct NoHook { __device__ __forceinline__ void at_tile(int, const Unit&, f32x4 (&)[2][2][4][2], PG8_LAS unsigned char*, int, int) const {} };
template <class Epi, class Sched, bool ALIGN_EPI = false, bool SP2 = false, class Hook = NoHook>
__device__ __forceinline__ void gemm_phase(PG8_LAS unsigned char* lds, const Gemm g, const Sched& S, const Epi& E, const Hook& H = Hook()) {
    const int tid = threadIdx.x, wid = __builtin_amdgcn_readfirstlane(tid >> 6), lane = tid & 63, wr = wid >> 2, wc = wid & 3, fr = lane & 15, fq = lane >> 4;
    const int K = g.K, nt = K / BK;
    unsigned voffA[2], voffB[2];
#pragma unroll
    for (int i = 0; i < 2; ++i) { int R, C; stage_rc(tid * 16 + i * 8192, R, C); const int Rb = Epi::PERM ? ((R & ~31) + perm32(R & 31)) : R;
        voffA[i] = (unsigned)(R * K + C) * 2u; voffB[i] = (unsigned)(Rb * K + C) * 2u; }
    const size_t kstep = (size_t)(BK * 2);
    const size_t hstep = (size_t)HALF * K * 2;
    const size_t tstep = 2 * hstep;
    const unsigned ldsw = (unsigned)wid * 1024u;
    const int aoff = lds_byte(wr * 64 + fr, fq * 8), boff = lds_byte(wc * 32 + fr, fq * 8);
#define PG8_SA(b, h) (((b) * 2 + (h)) * HTB)
#define PG8_SB(b, h) ((4 + (b) * 2 + (h)) * HTB)
#define PG8_STAGE(bufoff, gbase, voff) do { _Pragma("unroll") for (int _i = 0; _i < 2; ++_i) \
        __builtin_amdgcn_global_load_lds((const unsigned*)((const char*)(gbase) + (voff)[_i]), (PG8_LAS unsigned*)(lds + (bufoff) + ldsw + _i * 8192), 16, 0, 0); } while (0)
#define PG8_LDA(dst, b, h) do { _Pragma("unroll") for (int m = 0; m < 4; ++m) _Pragma("unroll") for (int k = 0; k < 2; ++k) dst[m][k] = *(const PG8_LAS bf16x8*)(lds + PG8_SA(b, h) + aoff + m * 2048 + k * 1024); } while (0)
#define PG8_LDB(dst, b, h) do { _Pragma("unroll") for (int n = 0; n < 2; ++n) _Pragma("unroll") for (int k = 0; k < 2; ++k) dst[n][k] = *(const PG8_LAS bf16x8*)(lds + PG8_SB(b, h) + boff + n * 2048 + k * 1024); } while (0)
#define PG8_MMA(ai, bj, At, Bt) do { __builtin_amdgcn_s_setprio(1); _Pragma("unroll") for (int m = 0; m < 4; ++m) _Pragma("unroll") for (int n = 0; n < 2; ++n) _Pragma("unroll") for (int k = 0; k < 2; ++k) \
        acc[ai][bj][m][n] = __builtin_amdgcn_mfma_f32_16x16x32_bf16(Bt[n][k], At[m][k], acc[ai][bj][m][n], 0, 0, 0); __builtin_amdgcn_s_setprio(0); } while (0)
#define PG8_WAIT_V(n) asm volatile("s_waitcnt vmcnt(" #n ")" ::: "memory")
#define PG8_WAIT_L(n) asm volatile("s_waitcnt lgkmcnt(" #n ")" ::: "memory")
#define PG8_BAR __builtin_amdgcn_s_barrier()
#define PG8_SCHED __builtin_amdgcn_sched_barrier(0)
    Unit cur, nxt; int ui = 0;
    if (!S.next(0, cur)) return;
    f32x4 acc[2][2][4][2];
#pragma unroll
    for (int a = 0; a < 2; ++a)
#pragma unroll
        for (int b = 0; b < 2; ++b)
#pragma unroll
            for (int m = 0; m < 4; ++m)
#pragma unroll
                for (int n = 0; n < 2; ++n) acc[a][b][m][n] = (f32x4){0.f, 0.f, 0.f, 0.f};
    bf16x8 At[4][2], B0[2][2], B1[2][2];
    const char* cA = (const char*)g.A + (size_t)cur.pm * tstep; const char* cB = (const char*)g.Bt + (size_t)cur.pn * tstep;
    S.a_ready(cur);
    if constexpr (SP2) {
        PG8_STAGE(PG8_SB(0, 0), cB, voffB); PG8_STAGE(PG8_SB(0, 1), cB + hstep, voffB); PG8_STAGE(PG8_SA(0, 0), cA, voffA); PG8_STAGE(PG8_SA(0, 1), cA + hstep, voffA);
        if (wr == 1) PG8_BAR;
        PG8_WAIT_V(2); PG8_BAR;
        PG8_STAGE(PG8_SB(1, 0), cB + kstep, voffB); PG8_STAGE(PG8_SA(1, 0), cA + kstep, voffA); PG8_STAGE(PG8_SB(1, 1), cB + hstep + kstep, voffB);
        PG8_WAIT_V(6); PG8_BAR;
    } else {
        PG8_STAGE(PG8_SB(0, 0), cB, voffB); PG8_STAGE(PG8_SA(0, 0), cA, voffA); PG8_STAGE(PG8_SB(0, 1), cB + hstep, voffB); PG8_STAGE(PG8_SA(0, 1), cA + hstep, voffA);
        if (wr == 1) PG8_BAR;
        PG8_WAIT_V(4); PG8_BAR;
        PG8_STAGE(PG8_SB(1, 0), cB + kstep, voffB); PG8_STAGE(PG8_SA(1, 0), cA + kstep, voffA); PG8_STAGE(PG8_SB(1, 1), cB + hstep + kstep, voffB);
        PG8_WAIT_V(6); PG8_BAR;
    }
    for (;;) {
        const bool has_next = S.next(ui + 1, nxt);
        const char* nA = has_next ? (const char*)g.A + (size_t)nxt.pm * tstep : cA; const char* nB = has_next ? (const char*)g.Bt + (size_t)nxt.pn * tstep : cB;
        for (int t = 0; t < nt; t += 2) {
            const bool last = (t == nt - 2);
            H.at_tile(t, cur, acc, lds + STAGE_BYTES, wr, fr);
            const char* a1 = cA + (size_t)(t + 1) * kstep;
            const char* a2 = last ? nA : cA + (size_t)(t + 2) * kstep; const char* b2 = last ? nB : cB + (size_t)(t + 2) * kstep;
            const char* a3 = a2 + kstep; const char* b3 = b2 + kstep;
            if (last && has_next) S.a_ready(nxt);
            if constexpr (SP2) {
            PG8_LDB(B0, 0, 0); PG8_LDB(B1, 0, 1); PG8_SCHED; PG8_LDA(At, 0, 0); PG8_STAGE(PG8_SA(1, 1), a1 + hstep, voffA);
            PG8_WAIT_V(8); PG8_WAIT_L(0); PG8_BAR; PG8_MMA(0, 0, At, B0); PG8_MMA(0, 1, At, B1); PG8_BAR; PG8_SCHED;
            PG8_LDA(At, 0, 1); PG8_STAGE(PG8_SB(0, 0), b2, voffB); PG8_STAGE(PG8_SB(0, 1), b2 + hstep, voffB); PG8_STAGE(PG8_SA(0, 0), a2, voffA);
            PG8_WAIT_V(8); PG8_WAIT_L(0); PG8_BAR; PG8_MMA(1, 0, At, B0); PG8_MMA(1, 1, At, B1); PG8_BAR; PG8_SCHED;
            PG8_LDB(B0, 1, 0); PG8_LDB(B1, 1, 1); PG8_SCHED; PG8_LDA(At, 1, 0); PG8_STAGE(PG8_SA(0, 1), a2 + hstep, voffA);
            PG8_WAIT_V(8); PG8_WAIT_L(0); PG8_BAR; PG8_MMA(0, 0, At, B0); PG8_MMA(0, 1, At, B1); PG8_BAR; PG8_SCHED;
            PG8_LDA(At, 1, 1); PG8_STAGE(PG8_SB(1, 0), b3, voffB); PG8_STAGE(PG8_SB(1, 1), b3 + hstep, voffB); PG8_STAGE(PG8_SA(1, 0), a3, voffA);
            PG8_WAIT_V(8); PG8_WAIT_L(0); PG8_BAR; PG8_MMA(1, 0, At, B0); PG8_MMA(1, 1, At, B1); PG8_BAR; PG8_SCHED;
            } else {
            PG8_LDB(B0, 0, 0); PG8_SCHED; PG8_LDA(At, 0, 0); PG8_STAGE(PG8_SA(1, 1), a1 + hstep, voffA);
            PG8_WAIT_L(8); PG8_BAR; PG8_WAIT_L(0); PG8_MMA(0, 0, At, B0); PG8_BAR; PG8_SCHED;
            PG8_LDB(B1, 0, 1); PG8_STAGE(PG8_SB(0, 0), b2, voffB);
            PG8_BAR; PG8_WAIT_L(0); PG8_MMA(0, 1, At, B1); PG8_BAR;
            PG8_LDA(At, 0, 1); PG8_STAGE(PG8_SA(0, 0), a2, voffA);
            PG8_BAR; PG8_WAIT_L(0); PG8_MMA(1, 0, At, B0); PG8_BAR; PG8_SCHED;
            PG8_STAGE(PG8_SB(0, 1), b2 + hstep, voffB);
            PG8_WAIT_V(6); PG8_BAR; PG8_MMA(1, 1, At, B1); PG8_BAR;
            PG8_LDB(B0, 1, 0); PG8_SCHED; PG8_LDA(At, 1, 0); PG8_STAGE(PG8_SA(0, 1), a2 + hstep, voffA);
            PG8_WAIT_L(8); PG8_BAR; PG8_WAIT_L(0); PG8_MMA(0, 0, At, B0); PG8_BAR; PG8_SCHED;
            PG8_LDB(B1, 1, 1); PG8_STAGE(PG8_SB(1, 0), b3, voffB);
            PG8_BAR; PG8_WAIT_L(0); PG8_MMA(0, 1, At, B1); PG8_BAR;
            PG8_LDA(At, 1, 1); PG8_STAGE(PG8_SA(1, 0), a3, voffA);
            PG8_BAR; PG8_WAIT_L(0); PG8_MMA(1, 0, At, B0); PG8_BAR; PG8_SCHED;
            PG8_STAGE(PG8_SB(1, 1), b3 + hstep, voffB);
            PG8_WAIT_V(6); PG8_BAR; PG8_MMA(1, 1, At, B1); PG8_BAR;
            }
        }
        if constexpr (ALIGN_EPI) { if (wr == 0) PG8_BAR; }
        if constexpr (!Epi::AFTER_DRAIN) { E(acc, cur, wr, wc, fr, fq); S.done(cur); }
        if (!has_next) break;
#pragma unroll
        for (int a = 0; a < 2; ++a)
#pragma unroll
            for (int b = 0; b < 2; ++b)
#pragma unroll
                for (int m = 0; m < 4; ++m)
#pragma unroll
                    for (int n = 0; n < 2; ++n) acc[a][b][m][n] = (f32x4){0.f, 0.f, 0.f, 0.f};
        cur = nxt; cA = nA; cB = nB; ++ui;
        if constexpr (ALIGN_EPI) { if (wr == 1) PG8_BAR; }
    }
    PG8_WAIT_V(0);
    if constexpr (!ALIGN_EPI) { if (wr == 0) PG8_BAR; }
    PG8_BAR;
    if constexpr (Epi::AFTER_DRAIN) { E.fused(acc, cur, wr, wc, fr, fq, lds, wid, lane); S.done(cur); }
#undef PG8_SA
#undef PG8_SB
#undef PG8_STAGE
#undef PG8_LDA
#undef PG8_LDB
#undef PG8_MMA
#undef PG8_WAIT_V
#undef PG8_WAIT_L
#undef PG8_BAR
#undef PG8_SCHED
}
}
namespace pg8 {
struct EpiProj {
    static constexpr bool PERM = true, AFTER_DRAIN = false;
    bf16_t* O; int ldc;
    __device__ __forceinline__ void operator()(const f32x4 (&acc)[2][2][4][2], const Unit& u, int wr, int wc, int fr, int fq) const {
        const int row0 = u.pm * BM + wr * 64 + fr; const int col0 = u.pn * BM + wc * 32 + 8 * fq;
#pragma unroll
        for (int ai = 0; ai < 2; ++ai)
#pragma unroll
            for (int m = 0; m < 4; ++m) { bf16_t* rowp = O + (size_t)(row0 + ai * HALF + m * 16) * ldc + col0;
#pragma unroll
                for (int bj = 0; bj < 2; ++bj) { const f32x4 v0 = acc[ai][bj][m][0], v1 = acc[ai][bj][m][1];
                    u32x4 w; w.x = cvt_pk_bf16(v0[0], v0[1]); w.y = cvt_pk_bf16(v0[2], v0[3]); w.z = cvt_pk_bf16(v1[0], v1[1]); w.w = cvt_pk_bf16(v1[2], v1[3]);
                    *(u32x4*)(rowp + bj * HALF) = w; } }
    }
};
struct EpiX1 {
    static constexpr bool PERM = true, AFTER_DRAIN = false;
    const float* x; float* x1; bf16_t* x1s; const float* mod; const float* norm2_g; float* rowstat; PG8_LAS float* tab;
    __device__ __forceinline__ void operator()(const f32x4 (&acc)[2][2][4][2], const Unit& u, int wr, int wc, int fr, int fq) const {
        const int row0 = u.pm * BM + wr * 64 + fr; const int col0 = u.pn * BM + wc * 32 + 8 * fq; const int b = (u.pm * BM) >> 11;
        const float* mb = mod + (size_t)b * 6144;
        f32x4 g1[2][2], g2[2][2];
#pragma unroll
        for (int bj = 0; bj < 2; ++bj)
#pragma unroll
            for (int n = 0; n < 2; ++n) { const int c = col0 + bj * HALF + 4 * n; g1[bj][n] = *(const f32x4*)(mb + 2048 + c);
                const f32x4 sc = *(const f32x4*)(mb + 4096 + c), ng = *(const f32x4*)(norm2_g + c); g2[bj][n] = ng * (sc + 1.0f); }
#pragma unroll
        for (int ai = 0; ai < 2; ++ai)
#pragma unroll
            for (int m = 0; m < 4; ++m) { const size_t row = (size_t)(row0 + ai * HALF + m * 16); const size_t off = row * 1024 + col0; float ss = 0.f;
                const float rfin = tab[((u.pm >> 3) & 1) * 1280 + 1024 + ai * HALF + wr * 64 + m * 16 + fr];
#pragma unroll
                for (int bj = 0; bj < 2; ++bj) {
                    const f32x4 xa = *(const f32x4*)(x + off + bj * HALF), xb = *(const f32x4*)(x + off + bj * HALF + 4);
                    const f32x4 v0 = xa + g1[bj][0] * (acc[ai][bj][m][0] * rfin), v1 = xb + g1[bj][1] * (acc[ai][bj][m][1] * rfin);
                    *(f32x4*)(x1 + off + bj * HALF) = v0; *(f32x4*)(x1 + off + bj * HALF + 4) = v1;
                    ss += (v0[0] * v0[0] + v0[1] * v0[1]) + (v0[2] * v0[2] + v0[3] * v0[3]) + (v1[0] * v1[0] + v1[1] * v1[1]) + (v1[2] * v1[2] + v1[3] * v1[3]);
                    const f32x4 s0 = v0 * g2[bj][0], s1 = v1 * g2[bj][1];
                    u32x4 w; w.x = cvt_pk_bf16(s0[0], s0[1]); w.y = cvt_pk_bf16(s0[2], s0[3]); w.z = cvt_pk_bf16(s1[0], s1[1]); w.w = cvt_pk_bf16(s1[2], s1[3]);
                    *(u32x4*)(x1s + off + bj * HALF) = w; }
                ss += __shfl_xor(ss, 16); ss += __shfl_xor(ss, 32);
                if (fq == 0) atomicAdd(rowstat + row, ss); }
    }
};
struct EpiScores {
    static constexpr bool PERM = true, AFTER_DRAIN = false;
    float* S; const float* sb; const float* rowstat;
    __device__ __forceinline__ void operator()(const f32x4 (&acc)[2][2][4][2], const Unit& u, int wr, int wc, int fr, int fq) const {
        const int row0 = u.pm * BM + wr * 64 + fr; const int col0 = u.pn * BM + wc * 32 + 8 * fq; const int b = (u.pm * BM) >> 11;
        f32x4 bv[2][2];
#pragma unroll
        for (int bj = 0; bj < 2; ++bj)
#pragma unroll
            for (int n = 0; n < 2; ++n) bv[bj][n] = *(const f32x4*)(sb + (size_t)b * 2048 + col0 + bj * HALF + 4 * n);
#pragma unroll
        for (int ai = 0; ai < 2; ++ai)
#pragma unroll
            for (int m = 0; m < 4; ++m) { const size_t row = (size_t)(row0 + ai * HALF + m * 16); const float rs = __builtin_amdgcn_rsqf(rowstat[row] * (1.0f / 1024.0f) + 1e-6f);
                float* rowp = S + row * 2048 + col0;
#pragma unroll
                for (int bj = 0; bj < 2; ++bj) { *(f32x4*)(rowp + bj * HALF) = acc[ai][bj][m][0] * rs + bv[bj][0]; *(f32x4*)(rowp + bj * HALF + 4) = acc[ai][bj][m][1] * rs + bv[bj][1]; } }
    }
};
struct SegScaleHook {
    __device__ __forceinline__ static void build(PG8_LAS unsigned char* ldsx, const Unit& u, const float* st_ssd, const float* st_s5, int tid) {
        PG8_LAS float* tab = (PG8_LAS float*)ldsx + ((u.pm >> 3) & 1) * 1280;
        if (tid < 256) { const size_t row = (size_t)u.pm * BM + tid; const f32x4* sg = (const f32x4*)(st_ssd + row * 16); const f32x4* s5 = (const f32x4*)(st_s5 + row * 64);
            float r[5];
#pragma unroll
            for (int gI = 0; gI < 4; ++gI) { const f32x4 v = sg[gI]; r[gI] = __builtin_amdgcn_rsqf(((v[0] + v[1]) + (v[2] + v[3])) * (1.0f / 256.0f) + 1e-6f); }
            float a5 = 0.f;
#pragma unroll
            for (int q = 0; q < 16; ++q) { const f32x4 v = s5[q]; a5 += (v[0] + v[1]) + (v[2] + v[3]); }
            r[4] = __builtin_amdgcn_rsqf(a5 * (1.0f / 1024.0f) + 1e-6f);
#pragma unroll
            for (int k = 0; k < 4; ++k) tab[k * 256 + tid] = r[k] * __builtin_amdgcn_rcpf(r[k + 1]);
            tab[1024 + tid] = r[4]; }
    }
    __device__ __forceinline__ void at_tile(int t, const Unit& u, f32x4 (&acc)[2][2][4][2], PG8_LAS unsigned char* ldsx, int wr, int fr) const {
        if (t == 4 || t == 8 || t == 12 || t == 16) { const PG8_LAS float* rt = (const PG8_LAS float*)ldsx + ((u.pm >> 3) & 1) * 1280 + ((t >> 2) - 1) * 256 + wr * 64 + fr;
#pragma unroll
            for (int ai = 0; ai < 2; ++ai)
#pragma unroll
                for (int m = 0; m < 4; ++m) { const float r = rt[ai * HALF + m * 16];
#pragma unroll
                    for (int bj = 0; bj < 2; ++bj) { acc[ai][bj][m][0] = acc[ai][bj][m][0] * r; acc[ai][bj][m][1] = acc[ai][bj][m][1] * r; } } }
    }
};
}
constexpr int NWAVES = 8, NTHR = 512;
constexpr int DM = 1024, NB = 16, SEQ = 2048, MTOK = NB * SEQ;
constexpr int NPROJ = 4096;
constexpr int INW = 4112;
constexpr int NHEADS = 16, HDIM = 64, NGRP = 4, NST = 128, CHUNK = 128;
constexpr int S5G = 64, S5CH = 16, S5P = 64;
constexpr int PH = 8, PK = 16, PNK = 128;
constexpr float EPSF = 1e-6f;
constexpr int NS5PART = 64;

constexpr size_t MiB = 1u << 20;
constexpr size_t WS_CTL = 0, CTL_ZERO_BYTES = 64 * 1024;
constexpr size_t WS_MOD = 1 * MiB;
constexpr size_t WS_WDT = WS_MOD + 0x60000;
constexpr size_t WS_SB = WS_MOD + 0x70000;
constexpr size_t WS_ROWSTAT = WS_MOD + 0x90000;
constexpr size_t WS_S5LB = WS_MOD + 0xB0000;
constexpr size_t WS_S5BB = WS_MOD + 0xC0000;
constexpr size_t WS_DTRAW = 3 * MiB;
constexpr size_t WS_STSSD = 5 * MiB;
constexpr size_t WS_STS5 = 7 * MiB;
constexpr size_t WS_WINT = 15 * MiB;
constexpr size_t WS_WOUTT = 23 * MiB;
constexpr size_t WS_WQKT = 27 * MiB;
constexpr size_t WS_EU = 31 * MiB, WS_EV = 47 * MiB;
constexpr size_t WS_EUS = 63 * MiB, WS_EVS = 63 * MiB + 65536;
constexpr size_t WS_START = 64 * MiB;
constexpr size_t WS_A = 95 * MiB;
constexpr size_t WS_B = 223 * MiB;
constexpr size_t WS_H1 = WS_A, WS_Y = WS_A, WS_PROJ = WS_B, WS_SCORES = WS_A;
constexpr size_t WS_X1S = WS_B + 192 * MiB;
constexpr size_t WS_EID = 479 * MiB, WS_GATE = 495 * MiB;
constexpr size_t WS_END = 511 * MiB;
static_assert(WS_SCORES + (size_t)MTOK * 2048 * 4 <= WS_X1S && WS_X1S + (size_t)MTOK * 1024 * 2 <= WS_EID && WS_GATE + (size_t)MTOK * 128 * 4 <= WS_END, "ws map");

constexpr int LDS_MAIN = 159744;
constexpr int MISC_OFF = LDS_MAIN;
constexpr int LDS_BYTES = LDS_MAIN + 128;

#define GAS __attribute__((address_space(1)))
#define LAS __attribute__((address_space(3)))
typedef unsigned short bf16;
typedef unsigned v4u __attribute__((ext_vector_type(4)));
typedef unsigned v2u __attribute__((ext_vector_type(2)));
typedef float f32x4 __attribute__((ext_vector_type(4)));
typedef float f32x2 __attribute__((ext_vector_type(2)));
typedef short bf16x8 __attribute__((ext_vector_type(8)));
#define LDS_WAIT() asm volatile("s_waitcnt lgkmcnt(0)" ::: "memory")
#define VM_WAIT() asm volatile("s_waitcnt vmcnt(0)" ::: "memory")
typedef __bf16 hwbf16x2 __attribute__((ext_vector_type(2)));
__device__ __forceinline__ unsigned pk2(float lo, float hi) { const f32x2 v = {lo, hi}; const hwbf16x2 b = __builtin_convertvector(v, hwbf16x2); return __builtin_bit_cast(unsigned, b); }
__device__ __forceinline__ unsigned f2bf(float f) { return pk2(f, 0.f) & 0xffffu; }
__device__ __forceinline__ float bflo(unsigned w) { return __builtin_bit_cast(float, w << 16); }
__device__ __forceinline__ float bfhi(unsigned w) { return __builtin_bit_cast(float, w & 0xffff0000u); }
__device__ __forceinline__ float bf2f(bf16 v) { return __builtin_bit_cast(float, (unsigned)v << 16); }
__device__ __forceinline__ float wave_sum(float v) {
#pragma unroll
    for (int o = 1; o < 64; o <<= 1) v += __shfl_xor(v, o);
    return v;
}
__device__ __forceinline__ float sigmoid_f(float v) { return __builtin_amdgcn_rcpf(1.0f + __builtin_amdgcn_exp2f(-1.4426950408889634f * v)); }
__device__ __forceinline__ float silu_f(float v) { return v * sigmoid_f(v); }
__device__ __forceinline__ float rsqrt_f(float v) { return __builtin_amdgcn_rsqf(v); }
__device__ __forceinline__ float gelu_erf(float v) {
    const float av = fabsf(v), t = __builtin_amdgcn_rcpf(av * 0.2316418882f + 1.0f);
    float q = t * 0.5307027145f + (-0.7265760135f); q = q * t + 0.7107068705f; q = q * t + (-0.142248368f); q = q * t + 0.127414796f; q = q * t;
    const float e = __builtin_amdgcn_exp2f((v * v) * (-0.72134752044f));
    const float m = v * (q * e);
    return v < 0.f ? m : v - m;
}
__device__ __forceinline__ float softplus_f(float v) { return fmaxf(v, 0.f) + 0.6931471805599453f * __builtin_amdgcn_logf(1.0f + __builtin_amdgcn_exp2f(-1.4426950408889634f * fabsf(v))); }
__device__ __forceinline__ void unpack8(const v4u w, float* f) { f[0] = bflo(w.x); f[1] = bfhi(w.x); f[2] = bflo(w.y); f[3] = bfhi(w.y); f[4] = bflo(w.z); f[5] = bfhi(w.z); f[6] = bflo(w.w); f[7] = bfhi(w.w); }
#define LDS_BARRIER() do { asm volatile("s_waitcnt lgkmcnt(0)" ::: "memory"); __builtin_amdgcn_s_barrier(); asm volatile("" ::: "memory"); } while (0)
__device__ __forceinline__ float row16_sum_to15(float v) {
    v += __builtin_bit_cast(float, __builtin_amdgcn_update_dpp(0, __builtin_bit_cast(int, v), 0x118, 0xf, 0xf, true));
    v += __builtin_bit_cast(float, __builtin_amdgcn_update_dpp(0, __builtin_bit_cast(int, v), 0x114, 0xf, 0xf, true));
    v += __builtin_bit_cast(float, __builtin_amdgcn_update_dpp(0, __builtin_bit_cast(int, v), 0x112, 0xf, 0xf, true));
    v += __builtin_bit_cast(float, __builtin_amdgcn_update_dpp(0, __builtin_bit_cast(int, v), 0x111, 0xf, 0xf, true));
    return v;
}
__device__ __forceinline__ float wave_sum_to63(float v) {
    v = row16_sum_to15(v);
    v += __builtin_bit_cast(float, __builtin_amdgcn_update_dpp(0, __builtin_bit_cast(int, v), 0x142, 0xa, 0xf, false));
    v += __builtin_bit_cast(float, __builtin_amdgcn_update_dpp(0, __builtin_bit_cast(int, v), 0x143, 0xc, 0xf, false));
    return v;
}
#define XB_TMO      128
#define XB_XCNT(j)  (256  + 64 * (j))
#define XB_XSUB(j)  (1280 + 64 * (j))
#define XB_XGEN(j)  (2304 + 64 * (j))
#define XB_TOP      3328
#define XB_TOPGEN   3392
#define XCD_BAR_WORDS 3456
#define XB_SPIN_CAP (1u << 18)

__device__ __forceinline__ unsigned xb_ld(unsigned* p)              { return __hip_atomic_load(p, __ATOMIC_RELAXED, __HIP_MEMORY_SCOPE_AGENT); }
__device__ __forceinline__ unsigned xb_add(unsigned* p, unsigned v) { return __hip_atomic_fetch_add(p, v, __ATOMIC_RELAXED, __HIP_MEMORY_SCOPE_AGENT); }
__device__ __forceinline__ unsigned xb_xcc_id() { return (unsigned)__builtin_amdgcn_s_getreg((3 << 11) | 20) & 0xFu; }
#define XB_SPIN(cond, bar) do { unsigned _sp = 0; while (cond) { __builtin_amdgcn_s_sleep(1); \
    if ((++_sp & 255u) == 0u) { if (xb_ld(&(bar)[XB_TMO])) break; if (_sp > XB_SPIN_CAP) { atomicAdd(&(bar)[XB_TMO], 1u); break; } } } } while (0)

struct XcdBarrier {
    unsigned* bar; unsigned x;
    volatile LAS unsigned* st;
};

__device__ __forceinline__ XcdBarrier xcd_barrier_post(unsigned* bar, volatile LAS unsigned* st) {
    XcdBarrier b; b.bar = bar; b.x = xb_xcc_id(); b.st = st;
    if (threadIdx.x == 0) (void)xb_add(&bar[XB_XCNT(b.x)], 1u);
    return b;
}
__device__ __forceinline__ void xcd_barrier_complete(unsigned* bar, unsigned x, unsigned& nloc, unsigned& nx) {
    const unsigned G = gridDim.x * gridDim.y * gridDim.z;
    unsigned sum, cnt, mine, sp = 0u;
    for (;;) {
        sum = 0u; cnt = 0u; mine = 0u;
#pragma unroll
        for (unsigned j = 0; j < 16; ++j) { const unsigned c = xb_ld(&bar[XB_XCNT(j)]); sum += c; cnt += (c > 0u) ? 1u : 0u; mine = (j == x) ? c : mine; }
        if (sum == G) break;
        __builtin_amdgcn_s_sleep(1);
        if ((++sp & 255u) == 0u) { if (xb_ld(&bar[XB_TMO])) break; if (sp > XB_SPIN_CAP) { atomicAdd(&bar[XB_TMO], 1u); break; } }
    }
    nloc = mine > 0u ? mine : 1u; nx = cnt > 0u ? cnt : 1u;
}

__device__ __forceinline__ void xcd_barrier(const XcdBarrier& b) {
    asm volatile("s_waitcnt vmcnt(0)" ::: "memory");
    __syncthreads();
    if (threadIdx.x == 0) {
        unsigned* bar = b.bar;
        __builtin_amdgcn_s_waitcnt(0);
        unsigned nloc = b.st[0], nx = b.st[1];
        if (nloc == 0u) { xcd_barrier_complete(bar, b.x, nloc, nx); b.st[0] = nloc; b.st[1] = nx; }
        const unsigned old = xb_add(&bar[XB_XSUB(b.x)], 1u);
        const unsigned gen = old / nloc;
        if (old + 1u == (gen + 1u) * nloc) {
            __builtin_amdgcn_fence(__ATOMIC_RELEASE, "agent");
            asm volatile("s_waitcnt vmcnt(0)" ::: "memory");
            const unsigned og = xb_add(&bar[XB_TOP], 1u);
            const unsigned tg = og / nx;
            if (og + 1u == (tg + 1u) * nx) xb_add(&bar[XB_TOPGEN], 1u);
            else XB_SPIN(xb_ld(&bar[XB_TOPGEN]) == tg, bar);
            __builtin_amdgcn_fence(__ATOMIC_ACQUIRE, "agent");
            xb_add(&bar[XB_XGEN(b.x)], 1u);
            asm volatile("s_waitcnt vmcnt(0)" ::: "memory");
        } else {
            XB_SPIN(xb_ld(&bar[XB_XGEN(b.x)]) == gen, bar);
            __builtin_amdgcn_fence(__ATOMIC_ACQUIRE, "agent");
            asm volatile("s_waitcnt vmcnt(0)" ::: "memory");
        }
    }
    __syncthreads();
}
struct Args { const float* in[30]; float* out; unsigned char* ws; int ph_lo, ph_hi; };
struct Frame {
    LAS unsigned char* lds;
    volatile LAS unsigned* MISC;
    int vcu, G;
    unsigned char* ws;
    const Args* a;
    float* out;
};
#define WSP(T, off) ((T*)(F.ws + (off)))

__device__ __forceinline__ void transpose_tile(const float* W, int ldw, int k0, int src_n0, bf16* WT, int K, int dst_n0, LAS float* scr, int lane, const float* kscale) {
#pragma unroll 8
    for (int i = 0; i < 32; ++i) { const int kk = 2 * i + (lane >> 5); float v = W[(size_t)(k0 + kk) * ldw + src_n0 + (lane & 31)]; if (kscale) v *= kscale[k0 + kk]; scr[kk * 33 + (lane & 31)] = v; }
    LDS_WAIT(); asm volatile("" ::: "memory");
    const int c = lane & 7;
#pragma unroll
    for (int j = 0; j < 4; ++j) { const int n = (lane >> 3) + 8 * j; const LAS float* s = scr + (8 * c) * 33 + n;
        v4u o; o.x = pk2(s[0 * 33], s[1 * 33]); o.y = pk2(s[2 * 33], s[3 * 33]); o.z = pk2(s[4 * 33], s[5 * 33]); o.w = pk2(s[6 * 33], s[7 * 33]);
        *(v4u*)(WT + (size_t)(dst_n0 + n) * K + k0 + 8 * c) = o; }
    LDS_WAIT(); asm volatile("" ::: "memory");
}
__device__ __forceinline__ void p0_phase(Frame& F) {
    const int f_tid = threadIdx.x, f_lane = f_tid & 63, f_wave = __builtin_amdgcn_readfirstlane(f_tid >> 6);
    const int gw = F.vcu * NWAVES + f_wave, NGW = F.G * NWAVES, gt = F.vcu * NTHR + f_tid, NGT = F.G * NTHR;
    {
        LAS float* sc = (LAS float*)F.lds;
        LAS float* red = (LAS float*)(F.lds + 65536);
        for (int i = f_tid; i < 16 * 1024; i += NTHR) { const int b = i >> 10, k = i & 1023; sc[k * 16 + b] = silu_f((F.a->in[1])[i]); }
        __syncthreads();
        const int ks = f_tid / 24, col = f_tid - ks * 24, j = F.vcu * 24 + col;
        if (ks < 21) {
            float acc[16];
#pragma unroll
            for (int b = 0; b < 16; ++b) acc[b] = 0.f;
            const int k0 = ks * 49, kn = (k0 + 49 <= 1024) ? 49 : (1024 - k0);
            const float* wp = (F.a->in[2]) + (size_t)k0 * 6144 + j;
#pragma unroll 1
            for (int kb = 0; kb < 49; kb += 7) {
                asm volatile("" ::: "memory");
                float wv[7];
#pragma unroll
                for (int u = 0; u < 7; ++u) wv[u] = (kb + u < kn) ? wp[(size_t)(kb + u) * 6144] : 0.f;
#pragma unroll
                for (int u = 0; u < 7; ++u) { const int kk = (kb + u < kn) ? (k0 + kb + u) : k0; const LAS f32x4* s4 = (const LAS f32x4*)(sc + kk * 16);
#pragma unroll
                    for (int q = 0; q < 4; ++q) { const f32x4 sv = s4[q]; acc[4 * q] += sv[0] * wv[u]; acc[4 * q + 1] += sv[1] * wv[u]; acc[4 * q + 2] += sv[2] * wv[u]; acc[4 * q + 3] += sv[3] * wv[u]; } }
            }
#pragma unroll
            for (int b = 0; b < 16; ++b) red[(ks * 16 + b) * 24 + col] = acc[b];
        }
        __syncthreads();
        for (int i = f_tid; i < 16 * 24; i += NTHR) { const int b = i / 24, cc = i - b * 24; float sacc = 0.f;
            for (int q = 0; q < 21; ++q) sacc += red[(q * 16 + b) * 24 + cc];
            WSP(float, WS_MOD)[b * 6144 + F.vcu * 24 + cc] = sacc + (F.a->in[3])[F.vcu * 24 + cc]; }
        __syncthreads();
    }
    {
        LAS float* scr = (LAS float*)(F.lds + f_wave * 16384);
        constexpr int I_IN = (1024 / 64) * (NPROJ / 32), I_OUT = (2048 / 64) * (1024 / 32);
        for (int it = gw; it < I_IN + I_OUT; it += NGW) {
            if (it < I_IN) { const int kb = it / (NPROJ / 32), nb = it % (NPROJ / 32); const int dn = 32 * nb, sn = dn < 3072 ? dn : dn + 16;
                transpose_tile((F.a->in[5]), INW, 64 * kb, sn, WSP(bf16, WS_WINT), 1024, dn, scr, f_lane, nullptr); }
            else { const int r = it - I_IN, kb = r / 32, nb = r % 32; const int k0 = 64 * kb;
                transpose_tile((F.a->in[23]), 1024, k0, 32 * nb, WSP(bf16, WS_WOUTT), 2048, 32 * nb, scr, f_lane, k0 < 1024 ? (F.a->in[11]) : (F.a->in[22]) - 1024); }
        }
    }
    for (int i = gt; i < 16 * 1024; i += NGT) { const int h = i >> 10, k = i & 1023; WSP(float, WS_WDT)[i] = (F.a->in[5])[(size_t)k * INW + 3072 + h]; }
    for (int task = gw; task < 2048; task += NGW) {
        const int nt = task >> 4, ks = task & 15, n0 = 16 * nt, hc = n0 >> 7, k0 = 64 * ks;
        const int li = f_lane & 15, lq = f_lane >> 4;
        f32x4 acc[4];
#pragma unroll
        for (int s = 0; s < 4; ++s) acc[s] = (f32x4){0.f, 0.f, 0.f, 0.f};
        const float* ap = (F.a->in[26]) + (size_t)(n0 + li) * 128 + 4 * lq;
        const float* bp = (F.a->in[25]) + (size_t)(k0 + li) * 2048 + hc * 128 + 4 * lq;
#pragma unroll
        for (int q = 0; q < 8; ++q) { const f32x4 a = *(const f32x4*)(ap + 16 * q);
#pragma unroll
            for (int s = 0; s < 4; ++s) { const f32x4 b = *(const f32x4*)(bp + (size_t)(16 * s) * 2048 + 16 * q);
#pragma unroll
                for (int jj = 0; jj < 4; ++jj) acc[s] = __builtin_amdgcn_mfma_f32_16x16x4f32(a[jj], b[jj], acc[s], 0, 0, 0); } }
        bf16* o = WSP(bf16, WS_WQKT);
#pragma unroll
        for (int s = 0; s < 4; ++s)
#pragma unroll
            for (int r = 0; r < 4; ++r) o[(size_t)(n0 + 4 * lq + r) * 1024 + k0 + 16 * s + li] = (bf16)f2bf(acc[s][r]);
    }
    for (int rw = gw; rw < 2 * 16384; rw += 2 * NGW) {
        f32x4 v[2][4]; float mx[2];
#pragma unroll
        for (int u = 0; u < 2; ++u) { const int r = rw + u * NGW; const int tb = r >= 16384, e = tb ? r - 16384 : r; const float* src = (tb ? (F.a->in[28]) : (F.a->in[27])) + (size_t)e * 1024 + 16 * f_lane;
#pragma unroll
            for (int q = 0; q < 4; ++q) v[u][q] = *(const f32x4*)(src + 4 * q); }
#pragma unroll
        for (int u = 0; u < 2; ++u) { float m = 0.f;
#pragma unroll
            for (int q = 0; q < 4; ++q) m = fmaxf(m, fmaxf(fmaxf(fabsf(v[u][q][0]), fabsf(v[u][q][1])), fmaxf(fabsf(v[u][q][2]), fabsf(v[u][q][3]))));
#pragma unroll
            for (int o = 1; o < 64; o <<= 1) m = fmaxf(m, __shfl_xor(m, o));
            mx[u] = fmaxf(m, 1e-30f); }
#pragma unroll
        for (int u = 0; u < 2; ++u) { const int r = rw + u * NGW; const int tb = r >= 16384, e = tb ? r - 16384 : r; const float sc = 224.0f / mx[u];
            v4u w;
#pragma unroll
            for (int q = 0; q < 4; ++q) { int pk = 0; pk = __builtin_amdgcn_cvt_pk_fp8_f32(v[u][q][0] * sc, v[u][q][1] * sc, pk, false); pk = __builtin_amdgcn_cvt_pk_fp8_f32(v[u][q][2] * sc, v[u][q][3] * sc, pk, true); w[q] = (unsigned)pk; }
            *(v4u*)(F.ws + (tb ? WS_EV : WS_EU) + (size_t)e * 1024 + 16 * f_lane) = w;
            if (f_lane == 0) WSP(float, tb ? WS_EVS : WS_EUS)[e] = mx[u] * (1.0f / 224.0f); }
    }
    for (int i = gt; i < S5G * S5P; i += NGT) {
        const float lr = (F.a->in[12])[i], li = (F.a->in[13])[i], dt = expf((F.a->in[14])[i >> 6]);
        const float mag = expf(lr * dt); float sn, cs; sincosf(li * dt, &sn, &cs);
        const float lbr = mag * cs, lbi = mag * sn, den = lr * lr + li * li;
        const float cfr = ((lbr - 1.0f) * lr + lbi * li) / den, cfi = (lbi * lr - (lbr - 1.0f) * li) / den;
        WSP(float, WS_S5LB)[2 * i] = lbr; WSP(float, WS_S5LB)[2 * i + 1] = lbi;
        for (int hh = 0; hh < 16; ++hh) { const float br = (F.a->in[15])[i * 16 + hh], bi = (F.a->in[16])[i * 16 + hh];
            WSP(float, WS_S5BB)[i * 32 + hh] = cfr * br - cfi * bi; WSP(float, WS_S5BB)[i * 32 + 16 + hh] = cfr * bi + cfi * br; }
    }
    for (int i = gt; i < MTOK; i += NGT) WSP(float, WS_ROWSTAT)[i] = 0.f;
}

__device__ __forceinline__ void p1_phase(Frame& F) {
    const int f_tid = threadIdx.x, f_lane = f_tid & 63, f_wave = __builtin_amdgcn_readfirstlane(f_tid >> 6);
    const int gw = F.vcu * NWAVES + f_wave;
    LAS float* wdt = (LAS float*)F.lds;
    for (int i = f_tid; i < 16 * 1024 / 4; i += NTHR) ((LAS f32x4*)wdt)[i] = ((const f32x4*)WSP(float, WS_WDT))[i];
    __syncthreads();
    const int lane = f_lane;
    for (int wq = gw; wq < MTOK / 16; wq += F.G * NWAVES) {
        const int b = wq >> 7; const float* mb = WSP(float, WS_MOD) + (size_t)b * 6144;
        f32x4 Gv[4], Sv[4];
#pragma unroll
        for (int j = 0; j < 4; ++j) { const int k = 4 * lane + 256 * j; const f32x4 g = *(const f32x4*)((F.a->in[4]) + k), sc = *(const f32x4*)(mb + 1024 + k); Gv[j] = g * (sc + 1.0f); Sv[j] = *(const f32x4*)(mb + k); }
        f32x4 nx[4];
#pragma unroll
        for (int j = 0; j < 4; ++j) nx[j] = *(const f32x4*)((F.a->in[0]) + (size_t)wq * 16 * 1024 + 4 * lane + 256 * j);
        for (int tt = 0; tt < 16; ++tt) {
            asm volatile("" ::: "memory");
            const size_t t = (size_t)wq * 16 + tt; const float* xr = (F.a->in[0]) + t * 1024;
            f32x4 v[4]; float ss = 0.f;
#pragma unroll
            for (int j = 0; j < 4; ++j) { v[j] = nx[j]; ss += (v[j][0] * v[j][0] + v[j][1] * v[j][1]) + (v[j][2] * v[j][2] + v[j][3] * v[j][3]); }
            if (tt < 15) {
#pragma unroll
                for (int j = 0; j < 4; ++j) nx[j] = *(const f32x4*)(xr + 1024 + 4 * lane + 256 * j); }
            const float rstd = rsqrt_f(wave_sum(ss) * (1.0f / 1024.0f) + EPSF);
            bf16* hr = WSP(bf16, WS_H1) + t * 1024;
#pragma unroll
            for (int j = 0; j < 4; ++j) { v[j] = v[j] * rstd * Gv[j] + Sv[j]; v2u w; w.x = pk2(v[j][0], v[j][1]); w.y = pk2(v[j][2], v[j][3]); *(v2u*)(hr + 4 * lane + 256 * j) = w; }
            float d[16];
#pragma unroll
            for (int h = 0; h < 16; ++h) { float a = 0.f;
#pragma unroll
                for (int j = 0; j < 4; ++j) { const f32x4 w = *(const LAS f32x4*)(wdt + h * 1024 + 4 * lane + 256 * j); a += (v[j][0] * w[0] + v[j][1] * w[1]) + (v[j][2] * w[2] + v[j][3] * w[3]); }
                d[h] = a; }
            float e8[8], e4[4], e2[2], e1;
#pragma unroll
            for (int i = 0; i < 8; ++i) { const bool up = lane & 32; const float snd = up ? d[i] : d[i + 8]; const float rcv = __shfl_xor(snd, 32); e8[i] = (up ? d[i + 8] : d[i]) + rcv; }
#pragma unroll
            for (int i = 0; i < 4; ++i) { const bool up = lane & 16; const float snd = up ? e8[i] : e8[i + 4]; const float rcv = __shfl_xor(snd, 16); e4[i] = (up ? e8[i + 4] : e8[i]) + rcv; }
#pragma unroll
            for (int i = 0; i < 2; ++i) { const bool up = lane & 8; const float snd = up ? e4[i] : e4[i + 2]; const float rcv = __shfl_xor(snd, 8); e2[i] = (up ? e4[i + 2] : e4[i]) + rcv; }
            { const bool up = lane & 4; const float snd = up ? e2[0] : e2[1]; const float rcv = __shfl_xor(snd, 4); e1 = (up ? e2[1] : e2[0]) + rcv; }
            e1 += __shfl_xor(e1, 2); e1 += __shfl_xor(e1, 1);
            const int head = ((lane >> 5) & 1) * 8 + ((lane >> 4) & 1) * 4 + ((lane >> 3) & 1) * 2 + ((lane >> 2) & 1);
            if ((lane & 3) == 0) WSP(float, WS_DTRAW)[t * 16 + head] = e1;
        }
    }
    for (int n = gw; n < 2048; n += F.G * NWAVES) {
        const bf16* wr = WSP(bf16, WS_WQKT) + (size_t)n * 1024 + 16 * lane;
        const v4u w0 = *(const v4u*)wr, w1 = *(const v4u*)(wr + 8);
        float wv[16]; wv[0] = bflo(w0.x); wv[1] = bfhi(w0.x); wv[2] = bflo(w0.y); wv[3] = bfhi(w0.y); wv[4] = bflo(w0.z); wv[5] = bfhi(w0.z); wv[6] = bflo(w0.w); wv[7] = bfhi(w0.w);
        wv[8] = bflo(w1.x); wv[9] = bfhi(w1.x); wv[10] = bflo(w1.y); wv[11] = bfhi(w1.y); wv[12] = bflo(w1.z); wv[13] = bfhi(w1.z); wv[14] = bflo(w1.w); wv[15] = bfhi(w1.w);
        for (int b = 0; b < 16; ++b) { const float* sp = WSP(float, WS_MOD) + (size_t)b * 6144 + 3072 + 16 * lane; float a = 0.f;
#pragma unroll
            for (int q = 0; q < 4; ++q) { const f32x4 s = *(const f32x4*)(sp + 4 * q); a += (s[0] * wv[4 * q] + s[1] * wv[4 * q + 1]) + (s[2] * wv[4 * q + 2] + s[3] * wv[4 * q + 3]); }
            a = wave_sum(a); if (lane == 0) WSP(float, WS_SB)[b * 2048 + n] = a; }
    }
}
__device__ __forceinline__ void p3_ssd_naive(Frame& F) {
    const int f_tid = threadIdx.x;
    const bf16* proj = WSP(bf16, WS_PROJ);
    LAS float* buf = (LAS float*)F.lds;
    LAS float* yl = (LAS float*)(F.lds + 4096);
    for (int item = F.vcu; item < NB * NGRP; item += F.G) {
        const int b = item >> 2, g = item & 3, tid = f_tid;
        const int ch = tid < 256 ? g * 256 + tid : (tid < 384 ? 1024 + g * 128 + (tid - 256) : 1536 + g * 128 + (tid - 384));
        const float w0 = (F.a->in[6])[0 * 2048 + ch], w1 = (F.a->in[6])[1 * 2048 + ch], w2 = (F.a->in[6])[2 * 2048 + ch], w3 = (F.a->in[6])[3 * 2048 + ch], cb = (F.a->in[7])[ch];
        float r0 = 0.f, r1 = 0.f, r2 = 0.f;
        const int r = tid >> 7, nh = (tid >> 6) & 1, p = tid & 63, h = g * 4 + r;
        float st[64];
#pragma unroll
        for (int n = 0; n < 64; ++n) st[n] = 0.f;
        const float A = -__expf((F.a->in[9])[h]), Dh = (F.a->in[10])[h], dtb = (F.a->in[8])[h];
        for (int t = 0; t < SEQ; ++t) {
            const size_t row = (size_t)b * SEQ + t;
            const float r3 = bf2f(proj[row * NPROJ + 1024 + ch]);
            const float cv = silu_f(cb + r0 * w0 + r1 * w1 + r2 * w2 + r3 * w3);
            r0 = r1; r1 = r2; r2 = r3;
            LAS float* cur = buf + (t & 1) * 512; LAS float* ycur = yl + (t & 1) * 512;
            cur[tid] = cv;
            __syncthreads();
            const float dt = softplus_f(WSP(float, WS_DTRAW)[row * 16 + h] + dtb);
            const float dA = __expf(dt * A), xv = cur[r * 64 + p], xd = xv * dt;
            float y = 0.f;
#pragma unroll
            for (int n4 = 0; n4 < 16; ++n4) { const f32x4 Bv = *(const LAS f32x4*)(cur + 256 + 64 * nh + 4 * n4), Cv = *(const LAS f32x4*)(cur + 384 + 64 * nh + 4 * n4);
#pragma unroll
                for (int q = 0; q < 4; ++q) { st[4 * n4 + q] = st[4 * n4 + q] * dA + xd * Bv[q]; y += Cv[q] * st[4 * n4 + q]; } }
            ycur[tid] = y;
            __syncthreads();
            if (nh == 0) {
                y = ycur[tid] + ycur[tid + 64] + Dh * xv;
                const float zv = bf2f(proj[row * NPROJ + h * 64 + p]);
                y *= silu_f(zv);
                WSP(bf16, WS_Y)[row * 2048 + h * 64 + p] = (bf16)f2bf(y);
                const float ss = wave_sum(y * y);
                if (p == 0) WSP(float, WS_STSSD)[row * 16 + h] = ss;
            }
        }
        __syncthreads();
    }
}
__device__ __forceinline__ void p3_s5_naive(Frame& F) {
    const int f_tid = threadIdx.x, f_lane = f_tid & 63, f_wave = __builtin_amdgcn_readfirstlane(f_tid >> 6);
    const bf16* proj = WSP(bf16, WS_PROJ);
    LAS float* xt = (LAS float*)(F.lds + 4096 + f_wave * 19200);
    LAS float* vt = (LAS float*)(F.lds + 4096 + f_wave * 19200 + 16896) + (f_lane & 31) * 17;
    const int lane = f_lane;
    for (int item = F.vcu * NWAVES + f_wave; item < NB * S5G; item += F.G * NWAVES) {
        const int b = item >> 6, g = item & 63, p = lane;
        const float lbr = WSP(float, WS_S5LB)[(g * 64 + p) * 2], lbi = WSP(float, WS_S5LB)[(g * 64 + p) * 2 + 1];
        float bbr[16], bbi[16];
#pragma unroll
        for (int q = 0; q < 4; ++q) { const f32x4 a = *(const f32x4*)(WSP(float, WS_S5BB) + (g * 64 + p) * 32 + 4 * q), c = *(const f32x4*)(WSP(float, WS_S5BB) + (g * 64 + p) * 32 + 16 + 4 * q);
#pragma unroll
            for (int e = 0; e < 4; ++e) { bbr[4 * q + e] = a[e]; bbi[4 * q + e] = c[e]; } }
        float xr = 0.f, xi = 0.f;
        for (int t0 = 0; t0 < SEQ; t0 += 32) {
            for (int tt = 0; tt < 32; ++tt) {
                const bf16* up = proj + ((size_t)b * SEQ + t0 + tt) * NPROJ + 3072 + g * 16;
                const v4u u0 = *(const v4u*)up, u1 = *(const v4u*)(up + 8);
                float uv[16]; uv[0] = bflo(u0.x); uv[1] = bfhi(u0.x); uv[2] = bflo(u0.y); uv[3] = bfhi(u0.y); uv[4] = bflo(u0.z); uv[5] = bfhi(u0.z); uv[6] = bflo(u0.w); uv[7] = bfhi(u0.w);
                uv[8] = bflo(u1.x); uv[9] = bfhi(u1.x); uv[10] = bflo(u1.y); uv[11] = bfhi(u1.y); uv[12] = bflo(u1.z); uv[13] = bfhi(u1.z); uv[14] = bflo(u1.w); uv[15] = bfhi(u1.w);
                float br = 0.f, bi = 0.f;
#pragma unroll
                for (int hh = 0; hh < 16; ++hh) { br += uv[hh] * bbr[hh]; bi += uv[hh] * bbi[hh]; }
                const float nr = lbr * xr - lbi * xi + br, ni = lbr * xi + lbi * xr + bi; xr = nr; xi = ni;
                xt[(tt * 66 + p) * 2] = xr; xt[(tt * 66 + p) * 2 + 1] = xi;
            }
            LDS_WAIT(); asm volatile("" ::: "memory");
            if (lane < 32) {
                const int tt = lane; const size_t row = (size_t)b * SEQ + t0 + tt;
                const bf16* up = proj + row * NPROJ + 3072 + g * 16;
#pragma unroll 1
                for (int hh = 0; hh < 16; ++hh) { float y = 0.f; const float* cr = (F.a->in[17]) + (g * 16 + hh) * 64; const float* ci = (F.a->in[18]) + (g * 16 + hh) * 64;
#pragma unroll 8
                    for (int pp = 0; pp < 64; ++pp) y += xt[(tt * 66 + pp) * 2] * cr[pp] - xt[(tt * 66 + pp) * 2 + 1] * ci[pp];
                    vt[hh] = gelu_erf(y + (F.a->in[19])[g * 16 + hh] * bf2f(up[hh])); }
                float ss = 0.f; unsigned ow[8];
#pragma unroll 1
                for (int k2 = 0; k2 < 8; ++k2) { float o2[2];
#pragma unroll
                    for (int e = 0; e < 2; ++e) { const int k = 2 * k2 + e; float gt = (F.a->in[21])[g * 16 + k];
#pragma unroll
                        for (int hh = 0; hh < 16; ++hh) gt += vt[hh] * (F.a->in[20])[(g * 16 + hh) * 16 + k];
                        o2[e] = vt[k] * sigmoid_f(gt); ss += o2[e] * o2[e]; }
                    const unsigned pw = pk2(o2[0], o2[1]);
#pragma unroll
                    for (int q = 0; q < 8; ++q) ow[q] = (q == k2) ? pw : ow[q]; }
                bf16* yo = WSP(bf16, WS_Y) + row * 2048 + 1024 + g * 16;
                *(v4u*)yo = (v4u){ow[0], ow[1], ow[2], ow[3]}; *(v4u*)(yo + 8) = (v4u){ow[4], ow[5], ow[6], ow[7]};
                WSP(float, WS_STS5)[row * NS5PART + g] = ss;
            }
            LDS_WAIT(); asm volatile("" ::: "memory");
        }
    }
}
__device__ __forceinline__ void p3c_normalize(Frame& F) {
    const int f_tid = threadIdx.x, f_lane = f_tid & 63, f_wave = __builtin_amdgcn_readfirstlane(f_tid >> 6);
    const int lane = f_lane;
    for (int t = F.vcu * NWAVES + f_wave; t < MTOK; t += F.G * NWAVES) {
        const float* sg = WSP(float, WS_STSSD) + (size_t)t * 16; const float* s5 = WSP(float, WS_STS5) + (size_t)t * NS5PART;
        float rg[4];
#pragma unroll
        for (int g = 0; g < 4; ++g) rg[g] = rsqrt_f((sg[4 * g] + sg[4 * g + 1] + sg[4 * g + 2] + sg[4 * g + 3]) * (1.0f / 256.0f) + EPSF);
        float s5s = (NS5PART == 64) ? s5[lane] : (lane < NS5PART ? s5[lane] : 0.f); s5s = wave_sum(s5s);
        const float r5 = rsqrt_f(s5s * (1.0f / 1024.0f) + EPSF);
        bf16* yr = WSP(bf16, WS_Y) + (size_t)t * 2048;
#pragma unroll
        for (int j = 0; j < 4; ++j) { const int e0 = 512 * j + 8 * lane; const float sc = j >= 2 ? r5 : (j == 0 ? (lane < 32 ? rg[0] : rg[1]) : (lane < 32 ? rg[2] : rg[3]));
            v4u w = *(v4u*)(yr + e0);
            w.x = pk2(bflo(w.x) * sc, bfhi(w.x) * sc); w.y = pk2(bflo(w.y) * sc, bfhi(w.y) * sc); w.z = pk2(bflo(w.z) * sc, bfhi(w.z) * sc); w.w = pk2(bflo(w.w) * sc, bfhi(w.w) * sc);
            *(v4u*)(yr + e0) = w; }
    }
}
constexpr int SSD_CS = 0, SSD_BS = 34816, SSD_BWT = 69632, SSD_XDT = 104448, SSD_PREV = 121856, SSD_XS = 139264, SSD_CSF = 157696, SSD_DTF = 158208, SSD_PITCH = 272, SSD_XPITCH = 144;
static_assert(SSD_DTF + 512 <= LDS_MAIN, "SSD LDS map");
__device__ __forceinline__ bf16x8 lds_frag(LAS unsigned char* base, int row, int kbyte) { return *(const LAS bf16x8*)(base + row * SSD_PITCH + kbyte); }
__device__ __forceinline__ void p3_ssd(Frame& F) {
    const int tid = threadIdx.x, lane = tid & 63, w = __builtin_amdgcn_readfirstlane(tid >> 6);
    const int li = lane & 15, lq = lane >> 4;
    LAS unsigned char* L = F.lds;
    LAS float* csf = (LAS float*)(L + SSD_CSF); LAS float* dtf = (LAS float*)(L + SSD_DTF);
    const bf16* proj = WSP(bf16, WS_PROJ);
    for (int item = F.vcu; item < NB * NHEADS; item += F.G) {
        const int b = item >> 4, h = item & 15, g = h >> 2;
        const float A = -__expf((F.a->in[9])[h]), Dh = (F.a->in[10])[h], dtb = (F.a->in[8])[h];
        const int pbs = w >> 1, nb0 = 4 * (w & 1);
        f32x4 st[4];
#pragma unroll
        for (int j = 0; j < 4; ++j) st[j] = (f32x4){0.f, 0.f, 0.f, 0.f};
        for (int i = tid; i < 17408 / 16; i += NTHR) ((LAS v4u*)(L + SSD_PREV))[i] = (v4u){0u, 0u, 0u, 0u};
        for (int c = 0; c < SEQ / CHUNK; ++c) {
            const size_t row0 = (size_t)b * SEQ + (size_t)c * CHUNK;
            if (w == 0) {
                const float d0 = softplus_f(WSP(float, WS_DTRAW)[(row0 + 2 * lane) * 16 + h] + dtb), d1 = softplus_f(WSP(float, WS_DTRAW)[(row0 + 2 * lane + 1) * 16 + h] + dtb);
                const float a0 = d0 * A, a1 = d1 * A; float s = a0 + a1;
#pragma unroll
                for (int o = 1; o < 64; o <<= 1) { const float t = __shfl_up(s, o); if (lane >= o) s += t; }
                dtf[2 * lane] = d0; dtf[2 * lane + 1] = d1; csf[2 * lane] = s - a1; csf[2 * lane + 1] = s;
            }
            __syncthreads();
            const float cs_end = csf[127];
            for (int it = tid; it < 1280; it += NTHR) {
                const int o = it % 40, rg = it / 40, l0 = 4 * rg;
                const int xcol = o < 8 ? h * 64 + 8 * o : (o < 24 ? 1024 + g * 128 + 8 * (o - 8) : 1536 + g * 128 + 8 * (o - 24));
                float raw[7][8];
#pragma unroll
                for (int k = 0; k < 7; ++k) { const int l = l0 - 3 + k; const bool ok = (c > 0) || (l >= 0);
                    v4u wv = (v4u){0u, 0u, 0u, 0u}; if (ok) wv = *(const v4u*)(proj + (size_t)((long)row0 + l) * NPROJ + 1024 + xcol);
                    raw[k][0] = bflo(wv.x); raw[k][1] = bfhi(wv.x); raw[k][2] = bflo(wv.y); raw[k][3] = bfhi(wv.y); raw[k][4] = bflo(wv.z); raw[k][5] = bfhi(wv.z); raw[k][6] = bflo(wv.w); raw[k][7] = bfhi(wv.w); }
                float cw[4][8], cbv[8];
#pragma unroll
                for (int k = 0; k < 4; ++k) { const f32x4 w0 = *(const f32x4*)((F.a->in[6]) + k * 2048 + xcol), w1 = *(const f32x4*)((F.a->in[6]) + k * 2048 + xcol + 4);
#pragma unroll
                    for (int e = 0; e < 4; ++e) { cw[k][e] = w0[e]; cw[k][4 + e] = w1[e]; } }
                { const f32x4 b0 = *(const f32x4*)((F.a->in[7]) + xcol), b1 = *(const f32x4*)((F.a->in[7]) + xcol + 4);
#pragma unroll
                    for (int e = 0; e < 4; ++e) { cbv[e] = b0[e]; cbv[4 + e] = b1[e]; } }
                float v[4][8];
#pragma unroll
                for (int r = 0; r < 4; ++r)
#pragma unroll
                    for (int i = 0; i < 8; ++i) v[r][i] = silu_f(cbv[i] + raw[r][i] * cw[0][i] + raw[r + 1][i] * cw[1][i] + raw[r + 2][i] * cw[2][i] + raw[r + 3][i] * cw[3][i]);
                if (o < 8) {
                    const int p0 = 8 * o;
#pragma unroll
                    for (int r = 0; r < 4; ++r) *(LAS v4u*)(L + SSD_XS + (l0 + r) * SSD_XPITCH + p0 * 2) = (v4u){pk2(v[r][0], v[r][1]), pk2(v[r][2], v[r][3]), pk2(v[r][4], v[r][5]), pk2(v[r][6], v[r][7])};
                    const float t0 = dtf[l0], t1 = dtf[l0 + 1], t2 = dtf[l0 + 2], t3 = dtf[l0 + 3];
#pragma unroll
                    for (int i = 0; i < 8; ++i) *(LAS v2u*)(L + SSD_XDT + (p0 + i) * SSD_PITCH + l0 * 2) = (v2u){pk2(v[0][i] * t0, v[1][i] * t1), pk2(v[2][i] * t2, v[3][i] * t3)};
                } else if (o < 24) {
                    const int n0 = 8 * (o - 8);
#pragma unroll
                    for (int r = 0; r < 4; ++r) *(LAS v4u*)(L + SSD_BS + (l0 + r) * SSD_PITCH + n0 * 2) = (v4u){pk2(v[r][0], v[r][1]), pk2(v[r][2], v[r][3]), pk2(v[r][4], v[r][5]), pk2(v[r][6], v[r][7])};
                    const float t0 = __expf(cs_end - csf[l0]), t1 = __expf(cs_end - csf[l0 + 1]), t2 = __expf(cs_end - csf[l0 + 2]), t3 = __expf(cs_end - csf[l0 + 3]);
#pragma unroll
                    for (int i = 0; i < 8; ++i) *(LAS v2u*)(L + SSD_BWT + (n0 + i) * SSD_PITCH + l0 * 2) = (v2u){pk2(v[0][i] * t0, v[1][i] * t1), pk2(v[2][i] * t2, v[3][i] * t3)};
                } else {
                    const int n0 = 8 * (o - 24);
#pragma unroll
                    for (int r = 0; r < 4; ++r) *(LAS v4u*)(L + SSD_CS + (l0 + r) * SSD_PITCH + n0 * 2) = (v4u){pk2(v[r][0], v[r][1]), pk2(v[r][2], v[r][3]), pk2(v[r][4], v[r][5]), pk2(v[r][6], v[r][7])};
                }
            }
            __syncthreads();
            bf16x8 ca[4];
#pragma unroll
            for (int ks = 0; ks < 4; ++ks) ca[ks] = lds_frag(L + SSD_CS, 16 * w + li, 64 * ks + 16 * lq);
            f32x4 cb[8];
#pragma unroll
            for (int sb = 0; sb < 8; ++sb) { cb[sb] = (f32x4){0.f, 0.f, 0.f, 0.f};
                if (sb <= w) {
#pragma unroll
                    for (int ks = 0; ks < 4; ++ks) cb[sb] = __builtin_amdgcn_mfma_f32_16x16x32_bf16(ca[ks], lds_frag(L + SSD_BS, 16 * sb + li, 64 * ks + 16 * lq), cb[sb], 0, 0, 0); } }
            float csl[4];
#pragma unroll
            for (int r = 0; r < 4; ++r) csl[r] = csf[16 * w + 4 * lq + r];
#pragma unroll
            for (int sb = 0; sb < 8; ++sb) if (sb <= w) { const int s = 16 * sb + li; const float css = csf[s];
#pragma unroll
                for (int r = 0; r < 4; ++r) { const int l = 16 * w + 4 * lq + r; cb[sb][r] = (s <= l) ? cb[sb][r] * __expf(csl[r] - css) : 0.f; } }
            __syncthreads();
#pragma unroll
            for (int sb = 0; sb < 8; ++sb) if (sb <= (w | 1)) {
#pragma unroll
                for (int r = 0; r < 4; ++r) *(LAS unsigned short*)(L + SSD_BS + (16 * w + 4 * lq + r) * SSD_PITCH + (16 * sb + li) * 2) = (unsigned short)f2bf(cb[sb][r]); }
            LDS_WAIT(); asm volatile("" ::: "memory");
            f32x4 yd[4], yo[4];
#pragma unroll
            for (int pb = 0; pb < 4; ++pb) { yd[pb] = (f32x4){0.f, 0.f, 0.f, 0.f}; yo[pb] = (f32x4){0.f, 0.f, 0.f, 0.f}; }
#pragma unroll
            for (int ks = 0; ks < 4; ++ks) if (ks <= (w >> 1)) { const bf16x8 gf = lds_frag(L + SSD_BS, 16 * w + li, 64 * ks + 16 * lq);
#pragma unroll
                for (int pb = 0; pb < 4; ++pb) yd[pb] = __builtin_amdgcn_mfma_f32_16x16x32_bf16(gf, lds_frag(L + SSD_XDT, 16 * pb + li, 64 * ks + 16 * lq), yd[pb], 0, 0, 0); }
#pragma unroll
            for (int ks = 0; ks < 4; ++ks)
#pragma unroll
                for (int pb = 0; pb < 4; ++pb) yo[pb] = __builtin_amdgcn_mfma_f32_16x16x32_bf16(ca[ks], lds_frag(L + SSD_PREV, 16 * pb + li, 64 * ks + 16 * lq), yo[pb], 0, 0, 0);
#pragma unroll
            for (int r = 0; r < 4; ++r) { const float e = __expf(csl[r]);
#pragma unroll
                for (int pb = 0; pb < 4; ++pb) *(LAS float*)(L + SSD_BS + (16 * w + 4 * lq + r) * SSD_PITCH + (16 * pb + li) * 4) = yd[pb][r] + e * yo[pb][r]; }
            __syncthreads();
            { const float dec = __expf(cs_end);
#pragma unroll
              for (int j = 0; j < 4; ++j) st[j] = st[j] * dec;
#pragma unroll
              for (int ks = 0; ks < 4; ++ks) { const bf16x8 xf = lds_frag(L + SSD_XDT, 16 * pbs + li, 64 * ks + 16 * lq);
#pragma unroll
                  for (int j = 0; j < 4; ++j) st[j] = __builtin_amdgcn_mfma_f32_16x16x32_bf16(xf, lds_frag(L + SSD_BWT, 16 * (nb0 + j) + li, 64 * ks + 16 * lq), st[j], 0, 0, 0); }
#pragma unroll
              for (int j = 0; j < 4; ++j)
#pragma unroll
                  for (int r = 0; r < 4; ++r) *(LAS unsigned short*)(L + SSD_PREV + (16 * pbs + 4 * lq + r) * SSD_PITCH + (16 * (nb0 + j) + li) * 2) = (unsigned short)f2bf(st[j][r]); }
#pragma unroll
            for (int k = 0; k < 2; ++k) { const int it = tid + 512 * k, l = it >> 3, o = it & 7; const size_t row = row0 + l;
                const f32x4 y0 = *(const LAS f32x4*)(L + SSD_BS + l * SSD_PITCH + 32 * o), y1 = *(const LAS f32x4*)(L + SSD_BS + l * SSD_PITCH + 32 * o + 16);
                const v4u xw = *(const LAS v4u*)(L + SSD_XS + l * SSD_XPITCH + 16 * o); const v4u zw = *(const v4u*)(proj + row * NPROJ + h * 64 + 8 * o);
                float xv[8], zv[8], yv[8]; unpack8(xw, xv); unpack8(zw, zv);
                float ss = 0.f;
#pragma unroll
                for (int e = 0; e < 8; ++e) { const float yy = (e < 4 ? y0[e] : y1[e - 4]) + Dh * xv[e]; yv[e] = yy * silu_f(zv[e]); ss += yv[e] * yv[e]; }
                ss += __shfl_xor(ss, 1); ss += __shfl_xor(ss, 2); ss += __shfl_xor(ss, 4);
                if (o == 0) WSP(float, WS_STSSD)[row * 16 + h] = ss;
                *(v4u*)(WSP(bf16, WS_Y) + row * 2048 + h * 64 + 8 * o) = (v4u){pk2(yv[0], yv[1]), pk2(yv[2], yv[3]), pk2(yv[4], yv[5]), pk2(yv[6], yv[7])}; }
            __syncthreads();
        }
    }
}
__device__ __forceinline__ void p3pre_conv(Frame& F) {
    const int tid = threadIdx.x;
    const bf16* proj = WSP(bf16, WS_PROJ); bf16* xo = (bf16*)F.out;
    for (int item = F.vcu * NTHR + tid; item < (MTOK / 16) * 256; item += F.G * NTHR) {
        const int oc = item & 255, run = item >> 8; const int t0 = run * 16, ch = 8 * oc;
        const bool halo = (t0 & (SEQ - 1)) != 0;
        v4u rw[19];
#pragma unroll
        for (int k = 0; k < 19; ++k) { rw[k] = (v4u){0u, 0u, 0u, 0u}; if (k >= 3 || halo) rw[k] = *(const v4u*)(proj + (size_t)(t0 - 3 + k) * NPROJ + 1024 + ch); }
        float cw[4][8], cbv[8];
#pragma unroll
        for (int k = 0; k < 4; ++k) { const f32x4 w0 = *(const f32x4*)((F.a->in[6]) + k * 2048 + ch), w1 = *(const f32x4*)((F.a->in[6]) + k * 2048 + ch + 4);
#pragma unroll
            for (int e = 0; e < 4; ++e) { cw[k][e] = w0[e]; cw[k][4 + e] = w1[e]; } }
        { const f32x4 b0 = *(const f32x4*)((F.a->in[7]) + ch), b1 = *(const f32x4*)((F.a->in[7]) + ch + 4);
#pragma unroll
            for (int e = 0; e < 4; ++e) { cbv[e] = b0[e]; cbv[4 + e] = b1[e]; } }
        float r0[8], r1[8], r2[8];
        unpack8(rw[0], r0); unpack8(rw[1], r1); unpack8(rw[2], r2);
#pragma unroll
        for (int tt = 0; tt < 16; ++tt) {
            float r3[8]; unpack8(rw[3 + tt], r3);
            float v[8];
#pragma unroll
            for (int i = 0; i < 8; ++i) { v[i] = silu_f(cbv[i] + r0[i] * cw[0][i] + r1[i] * cw[1][i] + r2[i] * cw[2][i] + r3[i] * cw[3][i]); r0[i] = r1[i]; r1[i] = r2[i]; r2[i] = r3[i]; }
            *(v4u*)(xo + (size_t)(t0 + tt) * 2048 + ch) = (v4u){pk2(v[0], v[1]), pk2(v[2], v[3]), pk2(v[4], v[5]), pk2(v[6], v[7])};
        }
    }
}
struct SsdPre { v4u xr[4], br[4], cr[4]; float d0, d1; };
__device__ __forceinline__ void ssd_prefetch(SsdPre& P, const char* xcb, const float* dtr, unsigned voB, unsigned voX, int tid, int lane, int w) {
#pragma unroll
    for (int r = 0; r < 4; ++r) { P.br[r] = *(const v4u*)(xcb + (voB + r * 4096u)); P.cr[r] = *(const v4u*)(xcb + (voB + 1024u + r * 4096u)); }
    if (tid < 256) {
#pragma unroll
        for (int r = 0; r < 4; ++r) P.xr[r] = *(const v4u*)(xcb + (voX + r * 4096u)); }
    if (w == 0) { P.d0 = dtr[lane * 32]; P.d1 = dtr[lane * 32 + 16]; }
}
__device__ __forceinline__ void p3_ssd2(Frame& F) {
    const int tid = threadIdx.x, lane = tid & 63, w = __builtin_amdgcn_readfirstlane(tid >> 6);
    const int li = lane & 15, lq = lane >> 4;
    LAS unsigned char* L = F.lds;
    LAS float* csf = (LAS float*)(L + SSD_CSF); LAS float* dtf = (LAS float*)(L + SSD_DTF);
    const bf16* proj = WSP(bf16, WS_PROJ); const bf16* xc = (const bf16*)F.out; const float* dtraw = WSP(float, WS_DTRAW);
    for (int item = F.vcu; item < NB * NHEADS; item += F.G) {
        const int b = item >> 4, h = item & 15, g = h >> 2;
        const float A = -__expf((F.a->in[9])[h]), Dh = (F.a->in[10])[h], dtb = (F.a->in[8])[h];
        const int pbs = w >> 1, nb0 = 4 * (w & 1);
        f32x4 st[4];
#pragma unroll
        for (int j = 0; j < 4; ++j) st[j] = (f32x4){0.f, 0.f, 0.f, 0.f};
        __syncthreads();
        for (int i = tid; i < 17408 / 16; i += NTHR) ((LAS v4u*)(L + SSD_PREV))[i] = (v4u){0u, 0u, 0u, 0u};
        SsdPre P;
        const unsigned voB = (unsigned)((4 * (tid >> 4)) * 2048 + 1024 + g * 128 + 8 * (tid & 15)) * 2u, voX = (unsigned)((4 * (tid >> 3)) * 2048 + h * 64 + 8 * (tid & 7)) * 2u;
        const unsigned voZ0 = (unsigned)((tid >> 3) * NPROJ + h * 64 + 8 * (tid & 7)) * 2u, voZ1 = voZ0 + 64u * NPROJ * 2u;
        ssd_prefetch(P, (const char*)xc + (size_t)b * SEQ * 4096, dtraw + (size_t)b * SEQ * 16 + h, voB, voX, tid, lane, w);
        for (int c = 0; c < SEQ / CHUNK; ++c) {
            const size_t row0 = (size_t)b * SEQ + (size_t)c * CHUNK;
            if (w == 0) {
                const float d0 = softplus_f(P.d0 + dtb), d1 = softplus_f(P.d1 + dtb);
                const float a0 = d0 * A, a1 = d1 * A; float s = a0 + a1;
#pragma unroll
                for (int o = 1; o < 64; o <<= 1) { const float t = __shfl_up(s, o); if (lane >= o) s += t; }
                dtf[2 * lane] = d0; dtf[2 * lane + 1] = d1; csf[2 * lane] = s - a1; csf[2 * lane + 1] = s;
            }
            LDS_BARRIER();
            const float cs_end = csf[127];
            { const int ob = tid & 15, lb = 4 * (tid >> 4), n0 = 8 * ob;
#pragma unroll
              for (int r = 0; r < 4; ++r) { *(LAS v4u*)(L + SSD_BS + (lb + r) * SSD_PITCH + n0 * 2) = P.br[r]; *(LAS v4u*)(L + SSD_CS + (lb + r) * SSD_PITCH + n0 * 2) = P.cr[r]; }
              float bv[4][8];
#pragma unroll
              for (int r = 0; r < 4; ++r) { unpack8(P.br[r], bv[r]); const float tw = __expf(cs_end - csf[lb + r]);
#pragma unroll
                  for (int i = 0; i < 8; ++i) bv[r][i] *= tw; }
#pragma unroll
              for (int i = 0; i < 8; ++i) *(LAS v2u*)(L + SSD_BWT + (n0 + i) * SSD_PITCH + lb * 2) = (v2u){pk2(bv[0][i], bv[1][i]), pk2(bv[2][i], bv[3][i])}; }
            if (tid < 256) { const int ox = tid & 7, lx = 4 * (tid >> 3), p0 = 8 * ox; float xv[4][8];
#pragma unroll
              for (int r = 0; r < 4; ++r) { *(LAS v4u*)(L + SSD_XS + (lx + r) * SSD_XPITCH + p0 * 2) = P.xr[r]; unpack8(P.xr[r], xv[r]); const float tw = dtf[lx + r];
#pragma unroll
                  for (int i = 0; i < 8; ++i) xv[r][i] *= tw; }
#pragma unroll
              for (int i = 0; i < 8; ++i) *(LAS v2u*)(L + SSD_XDT + (p0 + i) * SSD_PITCH + lx * 2) = (v2u){pk2(xv[0][i], xv[1][i]), pk2(xv[2][i], xv[3][i])}; }
            const char* prb = (const char*)proj + row0 * (NPROJ * 2);
            const v4u zc0 = *(const v4u*)(prb + voZ0), zc1 = *(const v4u*)(prb + voZ1);
            if (c + 1 < SEQ / CHUNK) ssd_prefetch(P, (const char*)xc + (row0 + CHUNK) * 4096, dtraw + (row0 + CHUNK) * 16 + h, voB, voX, tid, lane, w);
            LDS_BARRIER();
            bf16x8 ca[4];
#pragma unroll
            for (int ks = 0; ks < 4; ++ks) ca[ks] = lds_frag(L + SSD_CS, 16 * w + li, 64 * ks + 16 * lq);
            f32x4 cb[8];
#pragma unroll
            for (int sb = 0; sb < 8; ++sb) { cb[sb] = (f32x4){0.f, 0.f, 0.f, 0.f};
                if (sb <= w) {
#pragma unroll
                    for (int ks = 0; ks < 4; ++ks) cb[sb] = __builtin_amdgcn_mfma_f32_16x16x32_bf16(ca[ks], lds_frag(L + SSD_BS, 16 * sb + li, 64 * ks + 16 * lq), cb[sb], 0, 0, 0); } }
            float csl[4];
#pragma unroll
            for (int r = 0; r < 4; ++r) csl[r] = csf[16 * w + 4 * lq + r];
#pragma unroll
            for (int sb = 0; sb < 8; ++sb) if (sb <= w) { const int s = 16 * sb + li; const float css = csf[s];
#pragma unroll
                for (int r = 0; r < 4; ++r) { const int l = 16 * w + 4 * lq + r; cb[sb][r] = (s <= l) ? cb[sb][r] * __expf(csl[r] - css) : 0.f; } }
            LDS_BARRIER();
#pragma unroll
            for (int sb = 0; sb < 8; ++sb) if (sb <= (w | 1)) {
#pragma unroll
                for (int r = 0; r < 4; ++r) *(LAS unsigned short*)(L + SSD_BS + (16 * w + 4 * lq + r) * SSD_PITCH + (16 * sb + li) * 2) = (unsigned short)f2bf(cb[sb][r]); }
            LDS_WAIT(); asm volatile("" ::: "memory");
            f32x4 yd[4], yo[4];
#pragma unroll
            for (int pb = 0; pb < 4; ++pb) { yd[pb] = (f32x4){0.f, 0.f, 0.f, 0.f}; yo[pb] = (f32x4){0.f, 0.f, 0.f, 0.f}; }
#pragma unroll
            for (int ks = 0; ks < 4; ++ks) if (ks <= (w >> 1)) { const bf16x8 gf = lds_frag(L + SSD_BS, 16 * w + li, 64 * ks + 16 * lq);
#pragma unroll
                for (int pb = 0; pb < 4; ++pb) yd[pb] = __builtin_amdgcn_mfma_f32_16x16x32_bf16(gf, lds_frag(L + SSD_XDT, 16 * pb + li, 64 * ks + 16 * lq), yd[pb], 0, 0, 0); }
#pragma unroll
            for (int ks = 0; ks < 4; ++ks)
#pragma unroll
                for (int pb = 0; pb < 4; ++pb) yo[pb] = __builtin_amdgcn_mfma_f32_16x16x32_bf16(ca[ks], lds_frag(L + SSD_PREV, 16 * pb + li, 64 * ks + 16 * lq), yo[pb], 0, 0, 0);
#pragma unroll
            for (int r = 0; r < 4; ++r) { const float e = __expf(csl[r]);
#pragma unroll
                for (int pb = 0; pb < 4; ++pb) *(LAS float*)(L + SSD_BS + (16 * w + 4 * lq + r) * SSD_PITCH + (16 * pb + li) * 4) = yd[pb][r] + e * yo[pb][r]; }
            LDS_BARRIER();
            { const float dec = __expf(cs_end);
#pragma unroll
              for (int j = 0; j < 4; ++j) st[j] = st[j] * dec;
#pragma unroll
              for (int ks = 0; ks < 4; ++ks) { const bf16x8 xf = lds_frag(L + SSD_XDT, 16 * pbs + li, 64 * ks + 16 * lq);
#pragma unroll
                  for (int j = 0; j < 4; ++j) st[j] = __builtin_amdgcn_mfma_f32_16x16x32_bf16(xf, lds_frag(L + SSD_BWT, 16 * (nb0 + j) + li, 64 * ks + 16 * lq), st[j], 0, 0, 0); }
#pragma unroll
              for (int j = 0; j < 4; ++j)
#pragma unroll
                  for (int r = 0; r < 4; ++r) *(LAS unsigned short*)(L + SSD_PREV + (16 * pbs + 4 * lq + r) * SSD_PITCH + (16 * (nb0 + j) + li) * 2) = (unsigned short)f2bf(st[j][r]); }
#pragma unroll
            for (int k = 0; k < 2; ++k) { const int it = tid + 512 * k, l = it >> 3, o = it & 7; const size_t row = row0 + l;
                const f32x4 y0 = *(const LAS f32x4*)(L + SSD_BS + l * SSD_PITCH + 32 * o), y1 = *(const LAS f32x4*)(L + SSD_BS + l * SSD_PITCH + 32 * o + 16);
                const v4u xw = *(const LAS v4u*)(L + SSD_XS + l * SSD_XPITCH + 16 * o); const v4u zw = k == 0 ? zc0 : zc1;
                float xv[8], zv[8], yv[8]; unpack8(xw, xv); unpack8(zw, zv);
                float ss = 0.f;
#pragma unroll
                for (int e = 0; e < 8; ++e) { const float yy = (e < 4 ? y0[e] : y1[e - 4]) + Dh * xv[e]; yv[e] = yy * silu_f(zv[e]); ss += yv[e] * yv[e]; }
                ss += __shfl_xor(ss, 1); ss += __shfl_xor(ss, 2); ss += __shfl_xor(ss, 4);
                if (o == 0) WSP(float, WS_STSSD)[row * 16 + h] = ss;
                *(v4u*)(WSP(bf16, WS_Y) + row * 2048 + h * 64 + 8 * o) = (v4u){pk2(yv[0], yv[1]), pk2(yv[2], yv[3]), pk2(yv[4], yv[5]), pk2(yv[6], yv[7])}; }
            LDS_BARRIER();
        }
    }
}
constexpr int S3_CS = 0, S3_BS = 34816, S3_GY = 69632, S3_XDT = 104448, S3_XP = 144, S3_PREV = 122880, S3_CSF = 140288, S3_DTF = 141312, S3_WTS = 142336, S3_END = 143360;
static_assert(S3_END <= LDS_MAIN, "SSD v3 LDS map");
typedef short v4i16_t __attribute__((ext_vector_type(4)));
__device__ __forceinline__ bf16x8 lds_frag_tr(LAS unsigned char* tile, int pitch, int k0, int col0, int li, int lq) {
    LAS unsigned char* p = tile + (k0 + 8 * lq + (li >> 2)) * pitch + (col0 + 4 * (li & 3)) * 2;
    const v4i16_t lo = __builtin_amdgcn_ds_read_tr16_b64_v4i16((LAS v4i16_t*)p), hi = __builtin_amdgcn_ds_read_tr16_b64_v4i16((LAS v4i16_t*)(p + 4 * pitch));
    return __builtin_shufflevector(lo, hi, 0, 1, 2, 3, 4, 5, 6, 7);
}
struct Ssd3Pre { v4u xr[4], br[4], cr[4]; float d0, d1; };
__device__ __forceinline__ void ssd3_prefetch(Ssd3Pre& P, const char* xcb, const float* dtr, unsigned voB, unsigned voX, int tid, int lane, int w) {
#pragma unroll
    for (int r = 0; r < 4; ++r) { P.br[r] = *(const v4u*)(xcb + (voB + r * 4096u)); P.cr[r] = *(const v4u*)(xcb + (voB + 1024u + r * 4096u)); }
    if (tid < 256) {
#pragma unroll
        for (int r = 0; r < 4; ++r) P.xr[r] = *(const v4u*)(xcb + (voX + r * 4096u)); }
    if (w == 0) { P.d0 = dtr[lane * 32]; P.d1 = dtr[lane * 32 + 16]; }
}
__device__ __forceinline__ void ssd3_cumsum(LAS unsigned char* L, int par, float r0, float r1, float dtb, float A, int lane) {
    LAS float* csf = (LAS float*)(L + S3_CSF + par * 512); LAS float* dtf = (LAS float*)(L + S3_DTF + par * 512); LAS float* wts = (LAS float*)(L + S3_WTS + par * 512);
    const float d0 = softplus_f(r0 + dtb), d1 = softplus_f(r1 + dtb);
    const float a0 = d0 * A, a1 = d1 * A; float s = a0 + a1;
#pragma unroll
    for (int o = 1; o < 64; o <<= 1) { const float t = __shfl_up(s, o); if (lane >= o) s += t; }
    const float tot = __shfl(s, 63);
    dtf[2 * lane] = d0; dtf[2 * lane + 1] = d1; csf[2 * lane] = s - a1; csf[2 * lane + 1] = s;
    wts[2 * lane] = __expf(tot - (s - a1)); wts[2 * lane + 1] = __expf(tot - s);
}
__device__ __forceinline__ void p3_ssd3(Frame& F) {
    const int tid0 = threadIdx.x, w = __builtin_amdgcn_readfirstlane(tid0 >> 6);
    LAS unsigned char* L = F.lds;
    const bf16* proj = WSP(bf16, WS_PROJ); const bf16* xc = (const bf16*)F.out; const float* dtraw = WSP(float, WS_DTRAW);
    for (int item = F.vcu; item < NB * NHEADS; item += F.G) {
        const int b = item >> 4, h = item & 15, g = h >> 2;
        int tid = tid0; asm volatile("" : "+v"(tid)); int lane = tid & 63;
        const float A = -__expf((F.a->in[9])[h]), Dh = (F.a->in[10])[h], dtb = (F.a->in[8])[h];
        const int pbs = w >> 1, nb0 = 4 * (w & 1);
        f32x4 st[4];
#pragma unroll
        for (int j = 0; j < 4; ++j) st[j] = (f32x4){0.f, 0.f, 0.f, 0.f};
        __syncthreads();
        for (int i = tid; i < 17408 / 16; i += NTHR) ((LAS v4u*)(L + S3_PREV))[i] = (v4u){0u, 0u, 0u, 0u};
        Ssd3Pre P;
        { const unsigned voB0 = (unsigned)((4 * (tid >> 4)) * 2048 + 1024 + g * 128 + 8 * (tid & 15)) * 2u, voX0 = (unsigned)((4 * (tid >> 3)) * 2048 + h * 64 + 8 * (tid & 7)) * 2u;
          ssd3_prefetch(P, (const char*)xc + (size_t)b * SEQ * 4096, dtraw + (size_t)b * SEQ * 16 + h, voB0, voX0, tid, lane, w); }
        if (w == 0) ssd3_cumsum(L, 0, P.d0, P.d1, dtb, A, lane);
        __syncthreads();
        for (int c = 0; c < SEQ / CHUNK; ++c) {
            const size_t row0 = (size_t)b * SEQ + (size_t)c * CHUNK; const int par = c & 1;
            asm volatile("" : "+v"(tid));
            lane = tid & 63; const int li = lane & 15, lq = lane >> 4;
            const unsigned voB = (unsigned)((4 * (tid >> 4)) * 2048 + 1024 + g * 128 + 8 * (tid & 15)) * 2u, voX = (unsigned)((4 * (tid >> 3)) * 2048 + h * 64 + 8 * (tid & 7)) * 2u;
            const unsigned voZ0 = (unsigned)((tid >> 3) * NPROJ + h * 64 + 8 * (tid & 7)) * 2u, voZ1 = voZ0 + 64u * NPROJ * 2u;
            LAS float* csf = (LAS float*)(L + S3_CSF + par * 512); LAS float* dtf = (LAS float*)(L + S3_DTF + par * 512); LAS float* wts = (LAS float*)(L + S3_WTS + par * 512);
            { const int ob = tid & 15, lb = 4 * (tid >> 4), n0 = 8 * ob;
#pragma unroll
              for (int r = 0; r < 4; ++r) { *(LAS v4u*)(L + S3_BS + (lb + r) * SSD_PITCH + n0 * 2) = P.br[r]; *(LAS v4u*)(L + S3_CS + (lb + r) * SSD_PITCH + n0 * 2) = P.cr[r]; } }
            if (tid < 256) { const int ox = tid & 7, lx = 4 * (tid >> 3), p0 = 8 * ox;
#pragma unroll
              for (int r = 0; r < 4; ++r) { float xv[8]; unpack8(P.xr[r], xv); const float tw = dtf[lx + r];
                  *(LAS v4u*)(L + S3_XDT + (lx + r) * S3_XP + p0 * 2) = (v4u){pk2(xv[0] * tw, xv[1] * tw), pk2(xv[2] * tw, xv[3] * tw), pk2(xv[4] * tw, xv[5] * tw), pk2(xv[6] * tw, xv[7] * tw)}; } }
            const char* prb = (const char*)proj + row0 * (NPROJ * 2);
            const v4u zc0 = *(const v4u*)(prb + voZ0), zc1 = *(const v4u*)(prb + voZ1);
            LDS_BARRIER();
            const float cs_end = csf[127];
            bf16x8 ca[4];
#pragma unroll
            for (int ks = 0; ks < 4; ++ks) ca[ks] = lds_frag(L + S3_CS, 16 * w + li, 64 * ks + 16 * lq);
            float csl[4];
#pragma unroll
            for (int r = 0; r < 4; ++r) csl[r] = csf[16 * w + 4 * lq + r];
            { bf16x8 bq[2][4];
#pragma unroll
              for (int ks = 0; ks < 4; ++ks) bq[0][ks] = lds_frag(L + S3_BS, li, 64 * ks + 16 * lq);
#pragma unroll
              for (int sb = 0; sb < 8; ++sb) if (sb <= (w | 1)) {
                  f32x4 cbv = (f32x4){0.f, 0.f, 0.f, 0.f};
                  const int s = 16 * sb + li; const float css = csf[s];
                  if (sb <= w) {
                      if (sb + 1 <= w) {
#pragma unroll
                          for (int ks = 0; ks < 4; ++ks) bq[(sb + 1) & 1][ks] = lds_frag(L + S3_BS, 16 * (sb + 1) + li, 64 * ks + 16 * lq); }
                      __builtin_amdgcn_sched_barrier(0);
#pragma unroll
                      for (int ks = 0; ks < 4; ++ks) cbv = __builtin_amdgcn_mfma_f32_16x16x32_bf16(ca[ks], bq[sb & 1][ks], cbv, 0, 0, 0);
                      __builtin_amdgcn_sched_barrier(0); }
#pragma unroll
                  for (int r = 0; r < 4; ++r) { const int l = 16 * w + 4 * lq + r; const float gv = (s <= l) ? cbv[r] * __expf(csl[r] - css) : 0.f;
                      *(LAS unsigned short*)(L + S3_GY + l * SSD_PITCH + s * 2) = (unsigned short)f2bf(gv); } } }
            LDS_WAIT(); asm volatile("" ::: "memory");
            f32x4 yd[4], yo[4];
#pragma unroll
            for (int pb = 0; pb < 4; ++pb) { yd[pb] = (f32x4){0.f, 0.f, 0.f, 0.f}; yo[pb] = (f32x4){0.f, 0.f, 0.f, 0.f}; }
            { bf16x8 gq[2], xq[2][4];
              gq[0] = lds_frag(L + S3_GY, 16 * w + li, 16 * lq);
#pragma unroll
              for (int pb = 0; pb < 4; ++pb) xq[0][pb] = lds_frag_tr(L + S3_XDT, S3_XP, 0, 16 * pb, li, lq);
#pragma unroll
              for (int ks = 0; ks < 4; ++ks) if (ks <= (w >> 1)) {
                  if (ks + 1 <= (w >> 1)) { gq[(ks + 1) & 1] = lds_frag(L + S3_GY, 16 * w + li, 64 * (ks + 1) + 16 * lq);
#pragma unroll
                      for (int pb = 0; pb < 4; ++pb) xq[(ks + 1) & 1][pb] = lds_frag_tr(L + S3_XDT, S3_XP, 32 * (ks + 1), 16 * pb, li, lq); }
                  __builtin_amdgcn_sched_barrier(0);
#pragma unroll
                  for (int pb = 0; pb < 4; ++pb) yd[pb] = __builtin_amdgcn_mfma_f32_16x16x32_bf16(gq[ks & 1], xq[ks & 1][pb], yd[pb], 0, 0, 0);
                  __builtin_amdgcn_sched_barrier(0); } }
            { bf16x8 pq[2][4];
#pragma unroll
              for (int pb = 0; pb < 4; ++pb) pq[0][pb] = lds_frag(L + S3_PREV, 16 * pb + li, 16 * lq);
#pragma unroll
              for (int ks = 0; ks < 4; ++ks) {
                  if (ks < 3) {
#pragma unroll
                      for (int pb = 0; pb < 4; ++pb) pq[(ks + 1) & 1][pb] = lds_frag(L + S3_PREV, 16 * pb + li, 64 * (ks + 1) + 16 * lq); }
                  __builtin_amdgcn_sched_barrier(0);
#pragma unroll
                  for (int pb = 0; pb < 4; ++pb) yo[pb] = __builtin_amdgcn_mfma_f32_16x16x32_bf16(ca[ks], pq[ks & 1][pb], yo[pb], 0, 0, 0);
                  __builtin_amdgcn_sched_barrier(0); } }
#pragma unroll
            for (int r = 0; r < 4; ++r) { const float e = __expf(csl[r]);
#pragma unroll
                for (int pb = 0; pb < 4; ++pb) *(LAS float*)(L + S3_GY + (16 * w + 4 * lq + r) * SSD_PITCH + (16 * pb + li) * 4) = yd[pb][r] + e * yo[pb][r]; }
            if (c + 1 < SEQ / CHUNK) { ssd3_prefetch(P, (const char*)xc + (row0 + CHUNK) * 4096, dtraw + (row0 + CHUNK) * 16 + h, voB, voX, tid, lane, w); }
            LDS_BARRIER();
            { const float dec = __expf(cs_end);
#pragma unroll
              for (int j = 0; j < 4; ++j) st[j] = st[j] * dec;
              bf16x8 xq[2], bq2[2][4]; f32x4 wq[2][2];
              xq[0] = lds_frag_tr(L + S3_XDT, S3_XP, 0, 16 * pbs, li, lq); wq[0][0] = *(const LAS f32x4*)(wts + 8 * lq); wq[0][1] = *(const LAS f32x4*)(wts + 8 * lq + 4);
#pragma unroll
              for (int j = 0; j < 4; ++j) bq2[0][j] = lds_frag_tr(L + S3_BS, SSD_PITCH, 0, 16 * (nb0 + j), li, lq);
#pragma unroll
              for (int ks = 0; ks < 4; ++ks) {
                  if (ks < 3) { xq[(ks + 1) & 1] = lds_frag_tr(L + S3_XDT, S3_XP, 32 * (ks + 1), 16 * pbs, li, lq); wq[(ks + 1) & 1][0] = *(const LAS f32x4*)(wts + 32 * (ks + 1) + 8 * lq); wq[(ks + 1) & 1][1] = *(const LAS f32x4*)(wts + 32 * (ks + 1) + 8 * lq + 4);
#pragma unroll
                      for (int j = 0; j < 4; ++j) bq2[(ks + 1) & 1][j] = lds_frag_tr(L + S3_BS, SSD_PITCH, 32 * (ks + 1), 16 * (nb0 + j), li, lq); }
                  __builtin_amdgcn_sched_barrier(0);
                  const f32x4 w0 = wq[ks & 1][0], w1 = wq[ks & 1][1];
                  float xv[8]; unpack8(__builtin_bit_cast(v4u, xq[ks & 1]), xv);
                  const v4u xw = (v4u){pk2(xv[0] * w0[0], xv[1] * w0[1]), pk2(xv[2] * w0[2], xv[3] * w0[3]), pk2(xv[4] * w1[0], xv[5] * w1[1]), pk2(xv[6] * w1[2], xv[7] * w1[3])};
                  const bf16x8 xf = __builtin_bit_cast(bf16x8, xw);
#pragma unroll
                  for (int j = 0; j < 4; ++j) st[j] = __builtin_amdgcn_mfma_f32_16x16x32_bf16(xf, bq2[ks & 1][j], st[j], 0, 0, 0);
                  __builtin_amdgcn_sched_barrier(0); }
#pragma unroll
              for (int j = 0; j < 4; ++j)
#pragma unroll
                  for (int r = 0; r < 4; ++r) *(LAS unsigned short*)(L + S3_PREV + (16 * pbs + 4 * lq + r) * SSD_PITCH + (16 * (nb0 + j) + li) * 2) = (unsigned short)f2bf(st[j][r]); }
#pragma unroll
            for (int k = 0; k < 2; ++k) { const int it = tid + 512 * k, l = it >> 3, o = it & 7; const size_t row = row0 + l;
                const f32x4 y0 = *(const LAS f32x4*)(L + S3_GY + l * SSD_PITCH + 32 * o), y1 = *(const LAS f32x4*)(L + S3_GY + l * SSD_PITCH + 32 * o + 16);
                const v4u xw = *(const LAS v4u*)(L + S3_XDT + l * S3_XP + 16 * o); const v4u zw = k == 0 ? zc0 : zc1; const float dsk = Dh * __builtin_amdgcn_rcpf(dtf[l]);
                float xv[8], zv[8], yv[8]; unpack8(xw, xv); unpack8(zw, zv);
                float ss = 0.f;
#pragma unroll
                for (int e = 0; e < 8; ++e) { const float yy = (e < 4 ? y0[e] : y1[e - 4]) + dsk * xv[e]; yv[e] = yy * silu_f(zv[e]); ss += yv[e] * yv[e]; }
                ss += __shfl_xor(ss, 1); ss += __shfl_xor(ss, 2); ss += __shfl_xor(ss, 4);
                if (o == 0) WSP(float, WS_STSSD)[row * 16 + h] = ss;
                *(v4u*)(WSP(bf16, WS_Y) + row * 2048 + h * 64 + 8 * o) = (v4u){pk2(yv[0], yv[1]), pk2(yv[2], yv[3]), pk2(yv[4], yv[5]), pk2(yv[6], yv[7])}; }
            if (w == 0 && c + 1 < SEQ / CHUNK) ssd3_cumsum(L, par ^ 1, P.d0, P.d1, dtb, A, lane);
            LDS_BARRIER();
        }
    }
}
constexpr int S5_XT = 0, S5_XPITCH = 2056, S5_BBT = 65792, S5_CC = S5_BBT + 16384, S5_CCPITCH = 272, S5_GLU = S5_CC + 64 * S5_CCPITCH, S5_VS = S5_GLU + 2048, S5_OT = S5_VS + 8 * 512, S5_OPITCH = 144, S5_END = S5_OT + 32 * S5_OPITCH;
static_assert(S5_END <= LDS_MAIN, "S5 LDS map");
typedef float f32x16 __attribute__((ext_vector_type(16)));
__device__ __forceinline__ void p3_s5(Frame& F) {
    const int tid = threadIdx.x, lane = tid & 63, w = __builtin_amdgcn_readfirstlane(tid >> 6);
    const int li = lane & 15, lq = lane >> 4;
    LAS unsigned char* L = F.lds;
    const bf16* proj = WSP(bf16, WS_PROJ);
    for (int item = F.vcu; item < NB * 16; item += F.G) {
        const int b = item >> 4, gs = item & 15;
        __syncthreads();
        { const int gl = tid >> 7, col = tid & 127, p = col >> 1, ri = col & 1; const float* src = WSP(float, WS_S5BB) + ((gs * 4 + gl) * 64 + p) * 32 + ri * 16;
          const f32x4 a0 = *(const f32x4*)src, a1 = *(const f32x4*)(src + 4), a2 = *(const f32x4*)(src + 8), a3 = *(const f32x4*)(src + 12);
          LAS v4u* d = (LAS v4u*)(L + S5_BBT + (gl * 128 + col) * 32);
          d[0] = (v4u){pk2(a0[0], a0[1]), pk2(a0[2], a0[3]), pk2(a1[0], a1[1]), pk2(a1[2], a1[3])}; d[1] = (v4u){pk2(a2[0], a2[1]), pk2(a2[2], a2[3]), pk2(a3[0], a3[1]), pk2(a3[2], a3[3])}; }
        { const int gl = tid >> 7, hh = (tid >> 3) & 15, kq = tid & 7; const int g = gs * 4 + gl; const float* cr = (F.a->in[17]) + (g * 16 + hh) * 64 + 8 * kq; const float* ci = (F.a->in[18]) + (g * 16 + hh) * 64 + 8 * kq;
          const f32x4 r0 = *(const f32x4*)cr, r1 = *(const f32x4*)(cr + 4), i0 = *(const f32x4*)ci, i1 = *(const f32x4*)(ci + 4);
          LAS v4u* d = (LAS v4u*)(L + S5_CC + (gl * 16 + hh) * S5_CCPITCH + kq * 32);
          d[0] = (v4u){pk2(r0[0], -i0[0]), pk2(r0[1], -i0[1]), pk2(r0[2], -i0[2]), pk2(r0[3], -i0[3])}; d[1] = (v4u){pk2(r1[0], -i1[0]), pk2(r1[1], -i1[1]), pk2(r1[2], -i1[2]), pk2(r1[3], -i1[3])}; }
        for (int i = tid; i < 1024; i += NTHR) { const int gl = i >> 8, k = (i >> 4) & 15, hh = i & 15; ((LAS unsigned short*)(L + S5_GLU))[i] = (unsigned short)f2bf((F.a->in[20])[((gs * 4 + gl) * 16 + hh) * 16 + k]); }
        const int gsc = gs * 4 + (w & 3);
        const float lbr = WSP(float, WS_S5LB)[(gsc * 64 + lane) * 2], lbi = WSP(float, WS_S5LB)[(gsc * 64 + lane) * 2 + 1];
        const int glo = w >> 1, mb = w & 1, go = gs * 4 + glo;
        const float dsk = (F.a->in[19])[go * 16 + li], gbias = (F.a->in[21])[go * 16 + li];
        float xr = 0.f, xi = 0.f;
        __syncthreads();
        const bf16* ubase = proj + (size_t)b * SEQ * NPROJ + 3072 + gs * 64;
        v4u ua = *(const v4u*)(ubase + (size_t)(lane & 31) * NPROJ + glo * 16 + 8 * (lane >> 5));
        for (int t0 = 0; t0 < SEQ; t0 += 32) {
            const bf16x8 af = __builtin_bit_cast(bf16x8, ua);
            if (t0 + 32 < SEQ) ua = *(const v4u*)(ubase + (size_t)(t0 + 32 + (lane & 31)) * NPROJ + glo * 16 + 8 * (lane >> 5));
            float uo[4];
#pragma unroll
            for (int r = 0; r < 4; ++r) uo[r] = bf2f(ubase[(size_t)(t0 + 16 * mb + 4 * lq + r) * NPROJ + glo * 16 + li]);
#pragma unroll
            for (int q = 0; q < 2; ++q) { const int cb = 2 * (w & 1) + q;
                const bf16x8 bfrag = *(const LAS bf16x8*)(L + S5_BBT + (glo * 128 + 32 * cb + (lane & 31)) * 32 + 16 * (lane >> 5));
                f32x16 acc;
#pragma unroll
                for (int r = 0; r < 16; ++r) acc[r] = 0.f;
                acc = __builtin_amdgcn_mfma_f32_32x32x16_bf16(af, bfrag, acc, 0, 0, 0);
#pragma unroll
                for (int r = 0; r < 16; ++r) { const int t = (r & 3) + 8 * (r >> 2) + 4 * (lane >> 5); *(LAS float*)(L + S5_XT + t * S5_XPITCH + (glo * 128 + 32 * cb + (lane & 31)) * 4) = acc[r]; } }
            __syncthreads();
            if (w < 4) { LAS f32x2* xp = (LAS f32x2*)(L + S5_XT + (w * 128 + 2 * lane) * 4);
#pragma unroll 8
                for (int t = 0; t < 32; ++t) { const f32x2 bu = xp[t * (S5_XPITCH / 8)]; const float nr = lbr * xr - lbi * xi + bu[0], ni = lbr * xi + lbi * xr + bu[1]; xr = nr; xi = ni; xp[t * (S5_XPITCH / 8)] = (f32x2){xr, xi}; } }
            __syncthreads();
            f32x4 yacc = (f32x4){0.f, 0.f, 0.f, 0.f};
#pragma unroll
            for (int ks = 0; ks < 4; ++ks) { const LAS float* xs = (const LAS float*)(L + S5_XT + (16 * mb + li) * S5_XPITCH + (glo * 128 + 32 * ks + 8 * lq) * 4);
                const f32x4 x0 = *(const LAS f32x4*)xs, x1 = *(const LAS f32x4*)(xs + 4);
                const v4u xa = (v4u){pk2(x0[0], x0[1]), pk2(x0[2], x0[3]), pk2(x1[0], x1[1]), pk2(x1[2], x1[3])};
                const bf16x8 cf = *(const LAS bf16x8*)(L + S5_CC + (glo * 16 + li) * S5_CCPITCH + 64 * ks + 16 * lq);
                yacc = __builtin_amdgcn_mfma_f32_16x16x32_bf16(__builtin_bit_cast(bf16x8, xa), cf, yacc, 0, 0, 0); }
            float v[4];
#pragma unroll
            for (int r = 0; r < 4; ++r) v[r] = gelu_erf(yacc[r] + dsk * uo[r]);
            LAS unsigned char* vs = L + S5_VS + w * 512;
#pragma unroll
            for (int r = 0; r < 4; ++r) *(LAS unsigned short*)(vs + (4 * lq + r) * 32 + li * 2) = (unsigned short)f2bf(v[r]);
            LDS_WAIT(); asm volatile("" ::: "memory");
            v4u va = (v4u){0u, 0u, 0u, 0u}, gw = (v4u){0u, 0u, 0u, 0u};
            if (lq < 2) { va = *(const LAS v4u*)(vs + li * 32 + 16 * lq); gw = *(const LAS v4u*)(L + S5_GLU + ((glo * 16 + li) * 16 + 8 * lq) * 2); }
            f32x4 gacc = (f32x4){0.f, 0.f, 0.f, 0.f};
            gacc = __builtin_amdgcn_mfma_f32_16x16x32_bf16(__builtin_bit_cast(bf16x8, va), __builtin_bit_cast(bf16x8, gw), gacc, 0, 0, 0);
            float o[4], ss[4];
#pragma unroll
            for (int r = 0; r < 4; ++r) { o[r] = v[r] * sigmoid_f(gacc[r] + gbias); ss[r] = o[r] * o[r]; }
#pragma unroll
            for (int r = 0; r < 4; ++r) { ss[r] += __shfl_xor(ss[r], 1); ss[r] += __shfl_xor(ss[r], 2); ss[r] += __shfl_xor(ss[r], 4); ss[r] += __shfl_xor(ss[r], 8); }
            if (li == 0) {
#pragma unroll
                for (int r = 0; r < 4; ++r) WSP(float, WS_STS5)[((size_t)b * SEQ + t0 + 16 * mb + 4 * lq + r) * NS5PART + go] = ss[r]; }
#pragma unroll
            for (int r = 0; r < 4; ++r) *(LAS unsigned short*)(L + S5_OT + (16 * mb + 4 * lq + r) * S5_OPITCH + (glo * 16 + li) * 2) = (unsigned short)f2bf(o[r]);
            __syncthreads();
            if (tid < 256) { const int t = tid >> 3, oc = tid & 7; const v4u ov = *(const LAS v4u*)(L + S5_OT + t * S5_OPITCH + 16 * oc);
                *(v4u*)(WSP(bf16, WS_Y) + ((size_t)b * SEQ + t0 + t) * 2048 + 1024 + gs * 64 + 8 * oc) = ov; }
        }
    }
}
constexpr int S5V_BU = 0, S5V_BUP = 2056, S5V_BUSZ = 16 * S5V_BUP, S5V_XT = 2 * S5V_BUSZ, S5V_XTP = 1040, S5V_XTSZ = 16 * S5V_XTP, S5V_VS = S5V_XT + 2 * S5V_XTSZ, S5V_OT = S5V_VS + 4 * 512, S5V_OTP = 144, S5V_OTSZ = 16 * S5V_OTP, S5V_END = S5V_OT + 2 * S5V_OTSZ;
static_assert(S5V_END <= LDS_MAIN, "S5 v2 LDS map");
__device__ __forceinline__ void p3_s5v2(Frame& F) {
    const int tid = threadIdx.x, lane = tid & 63, w = __builtin_amdgcn_readfirstlane(tid >> 6);
    const int li = lane & 15, lq = lane >> 4;
    LAS unsigned char* L = F.lds;
    const bf16* proj = WSP(bf16, WS_PROJ);
    constexpr int NT = SEQ / 16;
    for (int item = F.vcu; item < NB * 16; item += F.G) {
        const int b = item >> 4, gs = item & 15;
        const bool scanw = w < 4; const int gl = w & 3, g = gs * 4 + gl;
        const bf16* ubase = proj + (size_t)b * SEQ * NPROJ + 3072 + gs * 64 + gl * 16;
        __syncthreads();
        if (scanw) {
            const float lbr = WSP(float, WS_S5LB)[(g * 64 + lane) * 2], lbi = WSP(float, WS_S5LB)[(g * 64 + lane) * 2 + 1];
            bf16x8 bfr[8];
#pragma unroll
            for (int cb = 0; cb < 8; ++cb) { v4u v = (v4u){0u, 0u, 0u, 0u};
                if (lq < 2) { const int col = 16 * cb + li; const float* src = WSP(float, WS_S5BB) + (g * 64 + (col >> 1)) * 32 + (col & 1) * 16 + 8 * lq; const f32x4 a0 = *(const f32x4*)src, a1 = *(const f32x4*)(src + 4);
                    v = (v4u){pk2(a0[0], a0[1]), pk2(a0[2], a0[3]), pk2(a1[0], a1[1]), pk2(a1[2], a1[3])}; }
                bfr[cb] = __builtin_bit_cast(bf16x8, v); }
            float xr = 0.f, xi = 0.f;
            v4u ua = (v4u){0u, 0u, 0u, 0u};
            if (lq < 2) ua = *(const v4u*)(ubase + (size_t)li * NPROJ + 8 * lq);
            { const bf16x8 af = __builtin_bit_cast(bf16x8, ua);
              if (lq < 2) ua = *(const v4u*)(ubase + (size_t)(16 + li) * NPROJ + 8 * lq);
#pragma unroll
              for (int cb = 0; cb < 8; ++cb) { f32x4 acc = (f32x4){0.f, 0.f, 0.f, 0.f}; acc = __builtin_amdgcn_mfma_f32_16x16x32_bf16(af, bfr[cb], acc, 0, 0, 0);
#pragma unroll
                  for (int r = 0; r < 4; ++r) *(LAS float*)(L + S5V_BU + (4 * lq + r) * S5V_BUP + (gl * 128 + 16 * cb + li) * 4) = acc[r]; } }
            LDS_BARRIER();
            for (int k = 0; k <= NT; ++k) {
                if (k < NT) {
                    const LAS f32x2* bp = (const LAS f32x2*)(L + S5V_BU + (k & 1) * S5V_BUSZ + (gl * 128 + 2 * lane) * 4);
                    LAS unsigned* xp = (LAS unsigned*)(L + S5V_XT + (k & 1) * S5V_XTSZ + (gl * 128 + 2 * lane) * 2);
                    f32x2 bu[16];
#pragma unroll
                    for (int t = 0; t < 16; ++t) bu[t] = bp[t * (S5V_BUP / 8)];
                    unsigned xo[16];
#pragma unroll
                    for (int t = 0; t < 16; ++t) { const float nr = lbr * xr + (bu[t][0] - lbi * xi), ni = lbr * xi + (lbi * xr + bu[t][1]); xr = nr; xi = ni; xo[t] = pk2(xr, xi); }
#pragma unroll
                    for (int t = 0; t < 16; ++t) xp[t * (S5V_XTP / 4)] = xo[t];
                    if (k + 1 < NT) {
                        const bf16x8 af = __builtin_bit_cast(bf16x8, ua);
                        if (lq < 2 && k + 2 < NT) ua = *(const v4u*)(ubase + (size_t)(16 * (k + 2) + li) * NPROJ + 8 * lq);
                        LAS unsigned char* bun = L + S5V_BU + ((k + 1) & 1) * S5V_BUSZ;
#pragma unroll
                        for (int cb = 0; cb < 8; ++cb) { f32x4 acc = (f32x4){0.f, 0.f, 0.f, 0.f}; acc = __builtin_amdgcn_mfma_f32_16x16x32_bf16(af, bfr[cb], acc, 0, 0, 0);
#pragma unroll
                            for (int r = 0; r < 4; ++r) *(LAS float*)(bun + (4 * lq + r) * S5V_BUP + (gl * 128 + 16 * cb + li) * 4) = acc[r]; }
                    }
                }
                LDS_BARRIER();
            }
        } else {
            bf16x8 cfr[4];
#pragma unroll
            for (int ks = 0; ks < 4; ++ks) { const float* cr = (F.a->in[17]) + (g * 16 + li) * 64 + 16 * ks + 4 * lq; const float* ci = (F.a->in[18]) + (g * 16 + li) * 64 + 16 * ks + 4 * lq;
                const f32x4 r0 = *(const f32x4*)cr, i0 = *(const f32x4*)ci;
                cfr[ks] = __builtin_bit_cast(bf16x8, ((v4u){pk2(r0[0], -i0[0]), pk2(r0[1], -i0[1]), pk2(r0[2], -i0[2]), pk2(r0[3], -i0[3])})); }
            v4u gwv = (v4u){0u, 0u, 0u, 0u};
            if (lq < 2) { float gwf[8];
#pragma unroll
                for (int j = 0; j < 8; ++j) gwf[j] = (F.a->in[20])[(g * 16 + 8 * lq + j) * 16 + li];
                gwv = (v4u){pk2(gwf[0], gwf[1]), pk2(gwf[2], gwf[3]), pk2(gwf[4], gwf[5]), pk2(gwf[6], gwf[7])}; }
            const bf16x8 gfr = __builtin_bit_cast(bf16x8, gwv);
            const float dsk = (F.a->in[19])[g * 16 + li], gbias = (F.a->in[21])[g * 16 + li];
            LAS unsigned char* vs = L + S5V_VS + gl * 512;
            float uo[4];
#pragma unroll
            for (int r = 0; r < 4; ++r) uo[r] = bf2f(ubase[(size_t)(4 * lq + r) * NPROJ + li]);
            LDS_BARRIER();
            for (int k = 0; k <= NT; ++k) {
                if (k >= 2) {
                    const int t = ((tid - 256) >> 3) & 15, oc = tid & 7; const v4u ov = *(const LAS v4u*)(L + S5V_OT + (k & 1) * S5V_OTSZ + t * S5V_OTP + 16 * oc);
                    if (tid < 384) *(v4u*)(WSP(bf16, WS_Y) + ((size_t)b * SEQ + 16 * (k - 2) + t) * 2048 + 1024 + gs * 64 + 8 * oc) = ov; }
                if (k >= 1) {
                    const int kt = k - 1; const LAS unsigned char* xt = L + S5V_XT + (kt & 1) * S5V_XTSZ;
                    float un[4];
                    if (k < NT) {
#pragma unroll
                        for (int r = 0; r < 4; ++r) un[r] = bf2f(ubase[(size_t)(16 * k + 4 * lq + r) * NPROJ + li]); }
                    f32x4 yacc = (f32x4){0.f, 0.f, 0.f, 0.f};
#pragma unroll
                    for (int ks = 0; ks < 4; ++ks) yacc = __builtin_amdgcn_mfma_f32_16x16x32_bf16(*(const LAS bf16x8*)(xt + li * S5V_XTP + (gl * 128 + 32 * ks + 8 * lq) * 2), cfr[ks], yacc, 0, 0, 0);
                    float v[4];
#pragma unroll
                    for (int r = 0; r < 4; ++r) v[r] = gelu_erf(yacc[r] + dsk * uo[r]);
#pragma unroll
                    for (int r = 0; r < 4; ++r) *(LAS unsigned short*)(vs + (4 * lq + r) * 32 + li * 2) = (unsigned short)f2bf(v[r]);
                    LDS_WAIT(); asm volatile("" ::: "memory");
                    v4u va = (v4u){0u, 0u, 0u, 0u};
                    if (lq < 2) va = *(const LAS v4u*)(vs + li * 32 + 16 * lq);
                    f32x4 gacc = (f32x4){0.f, 0.f, 0.f, 0.f};
                    gacc = __builtin_amdgcn_mfma_f32_16x16x32_bf16(__builtin_bit_cast(bf16x8, va), gfr, gacc, 0, 0, 0);
                    float o[4], ss[4];
#pragma unroll
                    for (int r = 0; r < 4; ++r) { o[r] = v[r] * sigmoid_f(gacc[r] + gbias); ss[r] = o[r] * o[r]; }
#pragma unroll
                    for (int r = 0; r < 4; ++r) ss[r] = row16_sum_to15(ss[r]);
                    if (li == 15) {
#pragma unroll
                        for (int r = 0; r < 4; ++r) WSP(float, WS_STS5)[((size_t)b * SEQ + 16 * kt + 4 * lq + r) * NS5PART + g] = ss[r]; }
                    LAS unsigned char* ot = L + S5V_OT + (kt & 1) * S5V_OTSZ;
#pragma unroll
                    for (int r = 0; r < 4; ++r) *(LAS unsigned short*)(ot + (4 * lq + r) * S5V_OTP + (gl * 16 + li) * 2) = (unsigned short)f2bf(o[r]);
                    if (k < NT) {
#pragma unroll
                        for (int r = 0; r < 4; ++r) uo[r] = un[r]; }
                }
                LDS_BARRIER();
            }
            { const int t = ((tid - 256) >> 3) & 15, oc = tid & 7; const v4u ov = *(const LAS v4u*)(L + S5V_OT + ((NT - 1) & 1) * S5V_OTSZ + t * S5V_OTP + 16 * oc);
              if (tid < 384) *(v4u*)(WSP(bf16, WS_Y) + ((size_t)b * SEQ + 16 * (NT - 1) + t) * 2048 + 1024 + gs * 64 + 8 * oc) = ov; }
        }
    }
}
__device__ __forceinline__ unsigned med3u(unsigned a, unsigned b, unsigned c) { unsigned r; asm("v_med3_u32 %0, %1, %2, %3" : "=v"(r) : "v"(a), "v"(b), "v"(c)); return r; }
__device__ __forceinline__ unsigned fkey(float v) { const unsigned u = __builtin_bit_cast(unsigned, v); return (u & 0x80000000u) ? ~u : (u | 0x80000000u); }
__device__ __forceinline__ float fkey_inv(unsigned k) { const unsigned u = (k & 0x80000000u) ? (k & 0x7fffffffu) : ~k; return __builtin_bit_cast(float, u); }
#define TOPK_INSERT(a, x) do { _Pragma("unroll") for (int _i = 15; _i >= 1; --_i) a[_i] = med3u(a[_i - 1], a[_i], (x)); a[0] = a[0] > (x) ? a[0] : (x); } while (0)
__device__ __forceinline__ void p5b_topk(Frame& F) {
    const int f_tid = threadIdx.x, f_lane = f_tid & 63, f_wave = __builtin_amdgcn_readfirstlane(f_tid >> 6);
    const float* scores = WSP(float, WS_SCORES);
    LAS unsigned char* ix = (LAS unsigned char*)F.lds + f_tid * 36;
    for (int item = F.vcu * NTHR + f_tid; item < MTOK * PH; item += F.G * NTHR) {
        const int t = item >> 3, hd = item & 7;
        unsigned a1[16], a2[16];
#pragma unroll
        for (int i = 0; i < 16; ++i) { a1[i] = 0u; a2[i] = 0u; }
        const float* sp = scores + (size_t)t * 2048 + hd * 256;
#pragma unroll 1
        for (int m = 0; m < 4; ++m) { f32x4 sv[8];
#pragma unroll
            for (int q = 0; q < 8; ++q) sv[q] = *(const f32x4*)(sp + 32 * m + 4 * q);
#pragma unroll
            for (int q = 0; q < 8; ++q)
#pragma unroll
                for (int e = 0; e < 4; ++e) { const unsigned k = (fkey(sv[q][e]) & ~127u) | (unsigned)(127 - (32 * m + 4 * q + e)); TOPK_INSERT(a1, k); } }
#pragma unroll 1
        for (int m = 0; m < 4; ++m) { f32x4 sv[8];
#pragma unroll
            for (int q = 0; q < 8; ++q) sv[q] = *(const f32x4*)(sp + 128 + 32 * m + 4 * q);
#pragma unroll
            for (int q = 0; q < 8; ++q)
#pragma unroll
                for (int e = 0; e < 4; ++e) { const unsigned k = (fkey(sv[q][e]) & ~127u) | (unsigned)(127 - (32 * m + 4 * q + e)); TOPK_INSERT(a2, k); } }
        float v1[16], v2[16];
#pragma unroll
        for (int i = 0; i < 16; ++i) { ix[i] = (unsigned char)(127u - (a1[i] & 127u)); ix[16 + i] = (unsigned char)(127u - (a2[i] & 127u)); v1[i] = fkey_inv(a1[i] & ~127u); v2[i] = fkey_inv(a2[i] & ~127u); }
        unsigned cb[16];
#pragma unroll
        for (int i = 0; i < 16; ++i) cb[i] = 0u;
#pragma unroll
        for (int i = 0; i < 16; ++i)
#pragma unroll
            for (int j = 0; j < 16; ++j) if ((i + 1) * (j + 1) <= 16) { const unsigned k = (fkey(v1[i] + v2[j]) & ~255u) | (unsigned)(255 - (i * 16 + j)); TOPK_INSERT(cb, k); }
        float tv[16]; float mx = -3.0e38f;
#pragma unroll
        for (int k = 0; k < 16; ++k) { tv[k] = fkey_inv(cb[k] & ~255u); mx = fmaxf(mx, tv[k]); }
        float sum = 0.f;
#pragma unroll
        for (int k = 0; k < 16; ++k) { tv[k] = __expf(tv[k] - mx); sum += tv[k]; }
        const float inv = 1.0f / sum;
        LDS_WAIT(); asm volatile("" ::: "memory");
        int ev[16]; unsigned long long c64 = 0ull;
#pragma unroll
        for (int k = 0; k < 16; ++k) { const unsigned code = 255u - (cb[k] & 255u); const int i = code >> 4, j = code & 15; ev[k] = (int)ix[i] * 128 + (int)ix[16 + j]; c64 += 1ull << (8 * (ev[k] >> 11)); }
        unsigned long long s64 = c64;
#pragma unroll
        for (int o = 1; o < 8; o <<= 1) { const unsigned lo = __shfl_up((unsigned)s64, o, 8), hi = __shfl_up((unsigned)(s64 >> 32), o, 8); if ((f_lane & 7) >= o) s64 += ((unsigned long long)hi << 32) | lo; }
        const unsigned long long e64 = s64 - c64;
        const unsigned long long t64 = ((unsigned long long)__shfl((unsigned)(s64 >> 32), 7, 8) << 32) | __shfl((unsigned)s64, 7, 8);
        const unsigned long long st64 = (t64 * 0x0101010101010101ull) << 8;
        unsigned long long base64 = st64 + e64;
        int* eo = WSP(int, WS_EID) + (size_t)t * 128; float* go = WSP(float, WS_GATE) + (size_t)t * 128;
#pragma unroll
        for (int k = 0; k < 16; ++k) { const int r8 = 8 * (ev[k] >> 11); const int slot = (int)((base64 >> r8) & 255ull); base64 += 1ull << r8; eo[slot] = ev[k]; go[slot] = tv[k] * inv; }
        if (hd == 0) WSP(unsigned long long, WS_START)[t] = st64;
        LDS_WAIT(); asm volatile("" ::: "memory");
    }
}
__device__ __forceinline__ void dec16(const v4u q, float* f) {
#pragma unroll
    for (int i = 0; i < 4; ++i) { const f32x2 lo = __builtin_amdgcn_cvt_pk_f32_fp8((int)q[i], false), hi = __builtin_amdgcn_cvt_pk_f32_fp8((int)q[i], true); f[4 * i] = lo[0]; f[4 * i + 1] = lo[1]; f[4 * i + 2] = hi[0]; f[4 * i + 3] = hi[1]; }
}
__device__ __forceinline__ void p8_peer_up(Frame& F) {
    const int f_tid = threadIdx.x, lane = f_tid & 63, f_wave = __builtin_amdgcn_readfirstlane(f_tid >> 6);
    const int rr = blockIdx.x & 7, wk = (blockIdx.x >> 3) * NWAVES + f_wave, nwk = (F.G >> 3) * NWAVES;
    const unsigned char* EU = F.ws + WS_EU;
    for (int blk = wk; blk < MTOK / 128; blk += nwk) {
        const int b = blk >> 4; const float* mb = WSP(float, WS_MOD) + (size_t)b * 6144;
        float S2[16];
#pragma unroll
        for (int q = 0; q < 4; ++q) { const f32x4 sh = *(const f32x4*)(mb + 3072 + 16 * lane + 4 * q); S2[4 * q] = sh[0]; S2[4 * q + 1] = sh[1]; S2[4 * q + 2] = sh[2]; S2[4 * q + 3] = sh[3]; }
        for (int tt = 0; tt < 128; ++tt) {
            const size_t t = (size_t)blk * 128 + tt;
            const unsigned long long st64 = WSP(unsigned long long, WS_START)[t];
            const int s0 = (int)((st64 >> (8 * rr)) & 255ull), s1 = rr == 7 ? 128 : (int)((st64 >> (8 * rr + 8)) & 255ull), cnt = s1 - s0;
            if (cnt <= 0) continue;
            const float rs = rsqrt_f(WSP(float, WS_ROWSTAT)[t] * (1.0f / 1024.0f) + EPSF);
            const bf16* xr = WSP(bf16, WS_X1S) + t * 1024 + 16 * lane; const v4u xa = *(const v4u*)xr, xb = *(const v4u*)(xr + 8);
            float h2[16]; unpack8(xa, h2); unpack8(xb, h2 + 8);
#pragma unroll
            for (int i = 0; i < 16; ++i) h2[i] = h2[i] * rs + S2[i];
            int* ep = WSP(int, WS_EID) + t * 128 + s0; float* gp = WSP(float, WS_GATE) + t * 128 + s0;
            for (int j0 = 0; j0 < cnt; j0 += 8) {
                const int myi = j0 + (lane & 7) < cnt ? j0 + (lane & 7) : cnt - 1;
                const int emine = ep[myi]; const float gmine = gp[myi];
                v4u q[8];
#pragma unroll
                for (int j = 0; j < 8; ++j) { const int e = __shfl(emine, j); q[j] = *(const v4u*)(EU + (size_t)e * 1024 + 16 * lane); }
                float d[8];
#pragma unroll
                for (int j = 0; j < 8; ++j) { float f[16]; dec16(q[j], f); float a = 0.f;
#pragma unroll
                    for (int i = 0; i < 16; ++i) a += h2[i] * f[i];
                    d[j] = a; }
                float e4[4], e2[2], e1;
#pragma unroll
                for (int i = 0; i < 4; ++i) { const bool up = lane & 32; const float snd = up ? d[i] : d[i + 4]; const float rcv = __shfl_xor(snd, 32); e4[i] = (up ? d[i + 4] : d[i]) + rcv; }
#pragma unroll
                for (int i = 0; i < 2; ++i) { const bool up = lane & 16; const float snd = up ? e4[i] : e4[i + 2]; const float rcv = __shfl_xor(snd, 16); e2[i] = (up ? e4[i + 2] : e4[i]) + rcv; }
                { const bool up = lane & 8; const float snd = up ? e2[0] : e2[1]; const float rcv = __shfl_xor(snd, 8); e1 = (up ? e2[1] : e2[0]) + rcv; }
                e1 += __shfl_xor(e1, 4); e1 += __shfl_xor(e1, 2); e1 += __shfl_xor(e1, 1);
                const int myj = ((lane >> 5) & 1) * 4 + ((lane >> 4) & 1) * 2 + ((lane >> 3) & 1);
                const int ej = __shfl(emine, myj); const float gj = __shfl(gmine, myj);
                const float wv = gj * gelu_erf(e1 * WSP(float, WS_EUS)[ej]) * WSP(float, WS_EVS)[ej];
                if ((lane & 7) == 0 && j0 + myj < cnt) gp[j0 + myj] = wv;
            }
        }
    }
}
__device__ __forceinline__ void p9_peer_down(Frame& F, float* dst) {
    const int f_tid = threadIdx.x, lane = f_tid & 63, f_wave = __builtin_amdgcn_readfirstlane(f_tid >> 6);
    const unsigned char* EV = F.ws + WS_EV;
    for (int wq = F.vcu * NWAVES + f_wave; wq < MTOK / 16; wq += F.G * NWAVES) {
        const int b = wq >> 7; const float* mb = WSP(float, WS_MOD) + (size_t)b * 6144;
        float GT[16], NF[16];
#pragma unroll
        for (int q = 0; q < 4; ++q) { const f32x4 gt = *(const f32x4*)(mb + 5120 + 16 * lane + 4 * q), nf = *(const f32x4*)((F.a->in[29]) + 16 * lane + 4 * q);
#pragma unroll
            for (int e = 0; e < 4; ++e) { GT[4 * q + e] = gt[e]; NF[4 * q + e] = nf[e]; } }
        for (int tt = 0; tt < 16; ++tt) {
            const size_t t = (size_t)wq * 16 + tt; float* xr = F.out + t * 1024 + 16 * lane;
            const int e_lo = WSP(int, WS_EID)[t * 128 + lane], e_hi = WSP(int, WS_EID)[t * 128 + 64 + lane];
            const float w_lo = WSP(float, WS_GATE)[t * 128 + lane], w_hi = WSP(float, WS_GATE)[t * 128 + 64 + lane];
            f32x2 o[8];
#pragma unroll
            for (int i = 0; i < 8; ++i) o[i] = (f32x2){0.f, 0.f};
            for (int grp = 0; grp < 16; ++grp) {
                const int esel = grp < 8 ? e_lo : e_hi; const float wsel = grp < 8 ? w_lo : w_hi; const int base = (grp & 7) * 8;
                v4u q[8];
#pragma unroll
                for (int j = 0; j < 8; ++j) { const int e = __shfl(esel, base + j); q[j] = *(const v4u*)(EV + (size_t)e * 1024 + 16 * lane); }
#pragma unroll
                for (int j = 0; j < 8; ++j) { const float wj = __shfl(wsel, base + j); const f32x2 w2 = (f32x2){wj, wj};
#pragma unroll
                    for (int i = 0; i < 4; ++i) { const f32x2 lo = __builtin_amdgcn_cvt_pk_f32_fp8((int)q[j][i], false), hi = __builtin_amdgcn_cvt_pk_f32_fp8((int)q[j][i], true); o[2 * i] += w2 * lo; o[2 * i + 1] += w2 * hi; } }
            }
            float x1[16]; float ss = 0.f;
#pragma unroll
            for (int q = 0; q < 4; ++q) { const f32x4 v = *(const f32x4*)(xr + 4 * q); x1[4 * q] = v[0]; x1[4 * q + 1] = v[1]; x1[4 * q + 2] = v[2]; x1[4 * q + 3] = v[3]; }
#pragma unroll
            for (int i = 0; i < 16; ++i) { x1[i] += GT[i] * o[i >> 1][i & 1]; ss += x1[i] * x1[i]; }
            const float rf = rsqrt_f(wave_sum(ss) * (1.0f / 1024.0f) + EPSF);
#pragma unroll
            for (int q = 0; q < 4; ++q) { f32x4 v;
#pragma unroll
                for (int e = 0; e < 4; ++e) v[e] = x1[4 * q + e] * rf * NF[4 * q + e];
                *(f32x4*)(dst + t * 1024 + 16 * lane + 4 * q) = v; }
        }
    }
}

__device__ __forceinline__ void p8_peer_fused(Frame& F) {
    const int f_tid = threadIdx.x, lane = f_tid & 63, f_wave = __builtin_amdgcn_readfirstlane(f_tid >> 6);
    const unsigned char* EU = F.ws + WS_EU; const unsigned char* EV = F.ws + WS_EV;
    const int myj = ((lane >> 5) & 1) * 4 + ((lane >> 4) & 1) * 2 + ((lane >> 3) & 1);
    const unsigned l16 = 16u * (unsigned)lane;
    for (int wq = F.vcu * NWAVES + f_wave; wq < MTOK / 16; wq += F.G * NWAVES) {
        const int b = wq >> 7; const float* mb = WSP(float, WS_MOD) + (size_t)b * 6144;
        for (int tt = 0; tt < 16; ++tt) {
            const size_t t = (size_t)wq * 16 + tt;
            unsigned lo16 = 16u * (unsigned)lane; asm volatile("" : "+v"(lo16));
            float* xr = (float*)((char*)(F.out + t * 1024) + 4u * lo16);
            const int e_lo = WSP(int, WS_EID)[t * 128 + lane], e_hi = WSP(int, WS_EID)[t * 128 + 64 + lane];
            const float g_lo = WSP(float, WS_GATE)[t * 128 + lane], g_hi = WSP(float, WS_GATE)[t * 128 + 64 + lane];
            const float su_lo = WSP(float, WS_EUS)[e_lo], su_hi = WSP(float, WS_EUS)[e_hi], sv_lo = WSP(float, WS_EVS)[e_lo], sv_hi = WSP(float, WS_EVS)[e_hi];
            const float rs = rsqrt_f(WSP(float, WS_ROWSTAT)[t] * (1.0f / 1024.0f) + EPSF);
            const char* xs = (const char*)(WSP(bf16, WS_X1S) + t * 1024) + 2u * lo16; const v4u xa = *(const v4u*)xs, xb = *(const v4u*)(xs + 16);
            float h2[16]; unpack8(xa, h2); unpack8(xb, h2 + 8);
#pragma unroll
            for (int q = 0; q < 4; ++q) { const f32x4 sh = *(const f32x4*)(mb + 3072 + 16 * lane + 4 * q);
#pragma unroll
                for (int e = 0; e < 4; ++e) h2[4 * q + e] = h2[4 * q + e] * rs + sh[e]; }
            f32x2 o[8];
#pragma unroll
            for (int i = 0; i < 8; ++i) o[i] = (f32x2){0.f, 0.f};
            v4u qu[8], qv[8], nu[8], nv[8];
#pragma unroll
            for (int j = 0; j < 8; ++j) { const int e = __builtin_amdgcn_readlane(e_lo, j); const unsigned off = (unsigned)e * 1024u + l16; qu[j] = *(const v4u*)(EU + off); qv[j] = *(const v4u*)(EV + off); }
#pragma unroll 1
            for (int grp = 0; grp < 16; ++grp) {
                const int nb = ((grp + 1) & 7) * 8; const int ensel = (grp + 1) < 8 ? e_lo : e_hi;
                if (grp < 15) {
#pragma unroll
                    for (int j = 0; j < 8; ++j) { const int e = __builtin_amdgcn_readlane(ensel, nb + j); const unsigned off = (unsigned)e * 1024u + l16; nu[j] = *(const v4u*)(EU + off); nv[j] = *(const v4u*)(EV + off); } }
                const int base = (grp & 7) * 8;
                const float gsel = grp < 8 ? g_lo : g_hi, susel = grp < 8 ? su_lo : su_hi, svsel = grp < 8 ? sv_lo : sv_hi;
                float d[8];
#pragma unroll
                for (int j = 0; j < 8; ++j) { float f[16]; dec16(qu[j], f); float a = 0.f;
#pragma unroll
                    for (int i = 0; i < 16; ++i) a += h2[i] * f[i];
                    d[j] = a; }
                float e4[4], e2[2], e1;
#pragma unroll
                for (int i = 0; i < 4; ++i) { const bool up = lane & 32; const float snd = up ? d[i] : d[i + 4]; const float rcv = __shfl_xor(snd, 32); e4[i] = (up ? d[i + 4] : d[i]) + rcv; }
#pragma unroll
                for (int i = 0; i < 2; ++i) { const bool up = lane & 16; const float snd = up ? e4[i] : e4[i + 2]; const float rcv = __shfl_xor(snd, 16); e2[i] = (up ? e4[i + 2] : e4[i]) + rcv; }
                { const bool up = lane & 8; const float snd = up ? e2[0] : e2[1]; const float rcv = __shfl_xor(snd, 8); e1 = (up ? e2[1] : e2[0]) + rcv; }
                e1 += __shfl_xor(e1, 4); e1 += __shfl_xor(e1, 2); e1 += __shfl_xor(e1, 1);
                const float wmine = __shfl(gsel, base + myj) * gelu_erf(e1 * __shfl(susel, base + myj)) * __shfl(svsel, base + myj);
#pragma unroll
                for (int j = 0; j < 8; ++j) { const int src = ((j >> 2) & 1) * 32 + ((j >> 1) & 1) * 16 + (j & 1) * 8; const float wj = __builtin_bit_cast(float, __builtin_amdgcn_readlane(__builtin_bit_cast(int, wmine), src)); const f32x2 w2 = (f32x2){wj, wj};
#pragma unroll
                    for (int i = 0; i < 4; ++i) { const f32x2 lo = __builtin_amdgcn_cvt_pk_f32_fp8((int)qv[j][i], false), hi = __builtin_amdgcn_cvt_pk_f32_fp8((int)qv[j][i], true); o[2 * i] += w2 * lo; o[2 * i + 1] += w2 * hi; } }
#pragma unroll
                for (int j = 0; j < 8; ++j) { qu[j] = nu[j]; qv[j] = nv[j]; }
            }
            float x1[16]; float ss = 0.f;
#pragma unroll
            for (int q = 0; q < 4; ++q) { const f32x4 v = *(const f32x4*)(xr + 4 * q); x1[4 * q] = v[0]; x1[4 * q + 1] = v[1]; x1[4 * q + 2] = v[2]; x1[4 * q + 3] = v[3]; }
#pragma unroll
            for (int q = 0; q < 4; ++q) { const f32x4 gt = *(const f32x4*)(mb + 5120 + 16 * lane + 4 * q);
#pragma unroll
                for (int e = 0; e < 4; ++e) { const int i = 4 * q + e; x1[i] += gt[e] * o[i >> 1][i & 1]; ss += x1[i] * x1[i]; } }
            const float rf = rsqrt_f(wave_sum(ss) * (1.0f / 1024.0f) + EPSF);
#pragma unroll
            for (int q = 0; q < 4; ++q) { const f32x4 nf = *(const f32x4*)((F.a->in[29]) + 16 * lane + 4 * q); f32x4 v;
#pragma unroll
                for (int e = 0; e < 4; ++e) v[e] = x1[4 * q + e] * rf * nf[e];
                *(f32x4*)(xr + 4 * q) = v; }
        }
    }
}
struct PeerMeta { unsigned long long st; float rs; v4u xa, xb; int elo, ehi; float glo, ghi; };
__device__ __forceinline__ void peer_meta_load(PeerMeta& M, const unsigned char* ws, size_t t, unsigned l16) {
    M.st = ((const unsigned long long*)(ws + WS_START))[t]; M.rs = ((const float*)(ws + WS_ROWSTAT))[t];
    const char* xs = (const char*)(ws + WS_X1S) + t * 2048 + 2u * l16; M.xa = *(const v4u*)xs; M.xb = *(const v4u*)(xs + 16);
    const int* ep = (const int*)(ws + WS_EID) + t * 128; const float* gp = (const float*)(ws + WS_GATE) + t * 128;
    const unsigned l = l16 >> 4; M.elo = ep[l]; M.ehi = ep[64 + l]; M.glo = gp[l]; M.ghi = gp[64 + l];
}
__device__ __forceinline__ void peer_rows_issue(const PeerMeta& M, int i0, int iend, const unsigned char* EU, const float* EUS, const float* EVS, unsigned l16, int lane, v4u* q, float& gmine, float& su, float& sv) {
    int idx = i0 + (lane & 7); idx = idx < iend ? idx : iend - 1; idx = idx < 0 ? 0 : (idx > 127 ? 127 : idx);
    const int ea = __shfl(M.elo, idx & 63), eb = __shfl(M.ehi, idx & 63); const int emine = idx < 64 ? ea : eb;
    const float ga = __shfl(M.glo, idx & 63), gb = __shfl(M.ghi, idx & 63); gmine = idx < 64 ? ga : gb;
#pragma unroll
    for (int j = 0; j < 8; ++j) { const int e = __builtin_amdgcn_readlane(emine, j); q[j] = *(const v4u*)(EU + ((unsigned)e * 1024u + l16)); }
    su = EUS[emine]; sv = EVS[emine];
}
__device__ __forceinline__ void p8_peer_up2(Frame& F) {
    const int f_tid = threadIdx.x, lane = f_tid & 63, f_wave = __builtin_amdgcn_readfirstlane(f_tid >> 6);
    const unsigned char* EU = F.ws + WS_EU; const float* EUS = WSP(float, WS_EUS); const float* EVS = WSP(float, WS_EVS);
    unsigned* ctr = (unsigned*)(F.ws + WS_CTL) + 8192;
    int rr = (int)(xb_xcc_id() & 7u), tries = 0;
    for (;;) {
        int blk = 0;
        if (lane == 0) blk = (int)__hip_atomic_fetch_add(ctr + 64 * rr, 1u, __ATOMIC_RELAXED, __HIP_MEMORY_SCOPE_AGENT);
        blk = __builtin_amdgcn_readfirstlane(blk);
        if (blk >= MTOK / 128) { if (++tries >= 8) break; rr = (rr + 1) & 7; continue; }
        const int b = blk >> 4; const float* mb = WSP(float, WS_MOD) + (size_t)b * 6144;
        unsigned l16 = 16u * (unsigned)lane; asm volatile("" : "+v"(l16));
        float S2[16];
#pragma unroll
        for (int q = 0; q < 4; ++q) { const f32x4 sh = *(const f32x4*)((const char*)(mb + 3072) + 4u * l16 + 16 * q); S2[4 * q] = sh[0]; S2[4 * q + 1] = sh[1]; S2[4 * q + 2] = sh[2]; S2[4 * q + 3] = sh[3]; }
        const size_t tb = (size_t)blk * 128;
        PeerMeta M0, M1, M2, M3, M4;
        peer_meta_load(M0, F.ws, tb, l16); peer_meta_load(M1, F.ws, tb + 1, l16); peer_meta_load(M2, F.ws, tb + 2, l16); peer_meta_load(M3, F.ws, tb + 3, l16);
        v4u qa[8], qb[8]; float ga_, sua, sva, gb_ = 0.f, sub = 0.f, svb = 0.f;
        int s0 = (int)((M0.st >> (8 * rr)) & 255ull), s1 = rr == 7 ? 128 : (int)((M0.st >> (8 * rr + 8)) & 255ull);
        peer_rows_issue(M0, s0, s1, EU, EUS, EVS, l16, lane, qa, ga_, sua, sva);
        for (int tt = 0; tt < 128; ++tt) {
            if (tt + 4 < 128) peer_meta_load(M4, F.ws, tb + tt + 4, l16);
            float h2[16]; unpack8(M0.xa, h2); unpack8(M0.xb, h2 + 8);
            const float rs = rsqrt_f(M0.rs * (1.0f / 1024.0f) + EPSF);
#pragma unroll
            for (int i = 0; i < 16; ++i) h2[i] = h2[i] * rs + S2[i];
            const int cnt = s1 - s0, ngrp = cnt > 0 ? (cnt + 7) >> 3 : 1;
            const int n0 = (int)((M1.st >> (8 * rr)) & 255ull), n1 = rr == 7 ? 128 : (int)((M1.st >> (8 * rr + 8)) & 255ull);
            float* gp = WSP(float, WS_GATE) + (tb + tt) * 128;
            for (int g = 0; g < ngrp; ++g) {
                if (g + 1 < ngrp) peer_rows_issue(M0, s0 + 8 * (g + 1), s1, EU, EUS, EVS, l16, lane, qb, gb_, sub, svb);
                else if (tt + 1 < 128) peer_rows_issue(M1, n0, n1, EU, EUS, EVS, l16, lane, qb, gb_, sub, svb);
                float d[8];
#pragma unroll
                for (int j = 0; j < 8; ++j) { float f[16]; dec16(qa[j], f); float a = 0.f;
#pragma unroll
                    for (int i = 0; i < 16; ++i) a += h2[i] * f[i];
                    d[j] = a; }
                float dmine = 0.f;
#pragma unroll
                for (int j = 0; j < 8; ++j) { const float tot = wave_sum_to63(d[j]); const float sj = __builtin_bit_cast(float, __builtin_amdgcn_readlane(__builtin_bit_cast(int, tot), 63)); dmine = (lane == j) ? sj : dmine; }
                const float wv = ga_ * gelu_erf(dmine * sua) * sva;
                { const int idx = s0 + 8 * g + lane; if (lane < 8 && idx < s1) gp[idx] = wv; }
#pragma unroll
                for (int j = 0; j < 8; ++j) qa[j] = qb[j];
                ga_ = gb_; sua = sub; sva = svb;
                asm volatile("" : "+v"(ga_), "+v"(sua), "+v"(sva));
            }
            M0 = M1; M1 = M2; M2 = M3; M3 = M4; s0 = n0; s1 = n1;
        }
    }
}
__device__ __forceinline__ void xcc_rendezvous(Frame& F, const XcdBarrier& bar, int which);
__device__ __forceinline__ void p9_peer_down2(Frame& F, const XcdBarrier& bar) {
    const int f_tid = threadIdx.x, lane = f_tid & 63, f_wave = __builtin_amdgcn_readfirstlane(f_tid >> 6);
    const unsigned char* EV = F.ws + WS_EV;
    for (int wq = F.vcu * NWAVES + f_wave; wq < MTOK / 16; wq += F.G * NWAVES) {
        const int b = wq >> 7; const float* mb = WSP(float, WS_MOD) + (size_t)b * 6144;
        for (int tt = 0; tt < 16; ++tt) {
            const size_t t = (size_t)wq * 16 + tt;
            unsigned l16 = 16u * (unsigned)lane; asm volatile("" : "+v"(l16));
            float* xr = (float*)((char*)(F.out + t * 1024) + 4u * l16);
            const int e_lo = WSP(int, WS_EID)[t * 128 + lane], e_hi = WSP(int, WS_EID)[t * 128 + 64 + lane];
            const float w_lo = WSP(float, WS_GATE)[t * 128 + lane], w_hi = WSP(float, WS_GATE)[t * 128 + 64 + lane];
            f32x2 o[8];
#pragma unroll
            for (int i = 0; i < 8; ++i) o[i] = (f32x2){0.f, 0.f};
            v4u q[8], nq[8];
#pragma unroll
            for (int j = 0; j < 8; ++j) { const int e = __builtin_amdgcn_readlane(e_lo, j); q[j] = *(const v4u*)(EV + ((unsigned)e * 1024u + l16)); }
#pragma unroll 1
            for (int grp = 0; grp < 16; ++grp) {
                const int nb = ((grp + 1) & 7) * 8; const int ensel = (grp + 1) < 8 ? e_lo : e_hi;
                if (grp < 15) {
#pragma unroll
                    for (int j = 0; j < 8; ++j) { const int e = __builtin_amdgcn_readlane(ensel, nb + j); nq[j] = *(const v4u*)(EV + ((unsigned)e * 1024u + l16)); } }
                __builtin_amdgcn_sched_barrier(0);
                const int base = (grp & 7) * 8; const float wsel = grp < 8 ? w_lo : w_hi;
#pragma unroll
                for (int j = 0; j < 8; ++j) { const float wj = __builtin_bit_cast(float, __builtin_amdgcn_readlane(__builtin_bit_cast(int, wsel), base + j)); const f32x2 w2 = (f32x2){wj, wj};
#pragma unroll
                    for (int i = 0; i < 4; ++i) { const f32x2 lo = __builtin_amdgcn_cvt_pk_f32_fp8((int)q[j][i], false), hi = __builtin_amdgcn_cvt_pk_f32_fp8((int)q[j][i], true); o[2 * i] += w2 * lo; o[2 * i + 1] += w2 * hi; } }
#pragma unroll
                for (int j = 0; j < 8; ++j) q[j] = nq[j];
            }
            float x1[16]; float ss = 0.f;
#pragma unroll
            for (int q4 = 0; q4 < 4; ++q4) { const f32x4 v = *(const f32x4*)(xr + 4 * q4); x1[4 * q4] = v[0]; x1[4 * q4 + 1] = v[1]; x1[4 * q4 + 2] = v[2]; x1[4 * q4 + 3] = v[3]; }
#pragma unroll
            for (int q4 = 0; q4 < 4; ++q4) { const f32x4 gt = *(const f32x4*)((const char*)(mb + 5120) + 4u * l16 + 16 * q4);
#pragma unroll
                for (int e = 0; e < 4; ++e) { const int i = 4 * q4 + e; x1[i] += gt[e] * o[i >> 1][i & 1]; ss += x1[i] * x1[i]; } }
            const float rf = rsqrt_f(wave_sum(ss) * (1.0f / 1024.0f) + EPSF);
#pragma unroll
            for (int q4 = 0; q4 < 4; ++q4) { const f32x4 nf = *(const f32x4*)((const char*)(F.a->in[29]) + 4u * l16 + 16 * q4); f32x4 v;
#pragma unroll
                for (int e = 0; e < 4; ++e) v[e] = x1[4 * q4 + e] * rf * nf[e];
                *(f32x4*)(xr + 4 * q4) = v; }
        }
    }
}
__device__ __forceinline__ void xcc_rendezvous(Frame& F, const XcdBarrier& bar, int which) {
    __syncthreads();
    if (threadIdx.x == 0) {
        unsigned* w = (unsigned*)(F.ws + WS_CTL) + 9216 + which * 2048;
        const unsigned nloc = bar.st[0] ? bar.st[0] : 1u; const unsigned x = bar.x;
        const unsigned old = xb_add(&w[64 * x], 1u); const unsigned gen = old / nloc;
        if (old + 1u == (gen + 1u) * nloc) xb_add(&w[1024 + 64 * x], 1u);
        else { unsigned sp = 0; while (xb_ld(&w[1024 + 64 * x]) == gen) { __builtin_amdgcn_s_sleep(1); if (++sp > (1u << 16)) break; } }
    }
    __syncthreads();
}
__device__ __forceinline__ void p8_peer_up3(Frame& F, const XcdBarrier& bar) {
    const int f_tid = threadIdx.x, lane = f_tid & 63, f_wave = __builtin_amdgcn_readfirstlane(f_tid >> 6);
    const unsigned char* EU = F.ws + WS_EU; const float* EUS = WSP(float, WS_EUS); const float* EVS = WSP(float, WS_EVS);
    for (int wq = F.vcu * NWAVES + f_wave; wq < MTOK / 16; wq += F.G * NWAVES) {
        const int b = wq >> 7; const float* mb = WSP(float, WS_MOD) + (size_t)b * 6144;
        for (int tt = 0; tt < 16; ++tt) {
            const size_t t = (size_t)wq * 16 + tt;
            unsigned l16 = 16u * (unsigned)lane; asm volatile("" : "+v"(l16));
            const int e_lo = WSP(int, WS_EID)[t * 128 + lane], e_hi = WSP(int, WS_EID)[t * 128 + 64 + lane];
            const float g_lo = WSP(float, WS_GATE)[t * 128 + lane], g_hi = WSP(float, WS_GATE)[t * 128 + 64 + lane];
#ifdef PROBE_NOSCALE
            const float su_lo = 5.6e-4f, su_hi = 5.6e-4f, sv_lo = 6.3e-3f, sv_hi = 6.3e-3f;
#else
            const float su_lo = EUS[e_lo], su_hi = EUS[e_hi], sv_lo = EVS[e_lo], sv_hi = EVS[e_hi];
#endif
            const float rs = rsqrt_f(WSP(float, WS_ROWSTAT)[t] * (1.0f / 1024.0f) + EPSF);
            const char* xs = (const char*)(WSP(bf16, WS_X1S) + t * 1024) + 2u * l16; const v4u xa = *(const v4u*)xs, xb = *(const v4u*)(xs + 16);
            float h2[16]; unpack8(xa, h2); unpack8(xb, h2 + 8);
            f32x2 h2p[8];
#pragma unroll
            for (int q = 0; q < 4; ++q) { const f32x4 sh = *(const f32x4*)((const char*)(mb + 3072) + 4u * l16 + 16 * q);
                h2p[2 * q] = (f32x2){h2[4 * q] * rs + sh[0], h2[4 * q + 1] * rs + sh[1]}; h2p[2 * q + 1] = (f32x2){h2[4 * q + 2] * rs + sh[2], h2[4 * q + 3] * rs + sh[3]}; }
            float w_lo = 0.f, w_hi = 0.f;
            v4u q[8], nq[8];
#pragma unroll
            for (int j = 0; j < 8; ++j) { const int e = __builtin_amdgcn_readlane(e_lo, j); q[j] = *(const v4u*)(EU + ((unsigned)e * 1024u + l16)); }
#pragma unroll 1
            for (int grp = 0; grp < 16; ++grp) {
                const int nb = ((grp + 1) & 7) * 8; const int ensel = (grp + 1) < 8 ? e_lo : e_hi;
                if (grp < 15) {
#pragma unroll
                    for (int j = 0; j < 8; ++j) { const int e = __builtin_amdgcn_readlane(ensel, nb + j); nq[j] = *(const v4u*)(EU + ((unsigned)e * 1024u + l16)); } }
                __builtin_amdgcn_sched_barrier(0);
                const int base = (grp & 7) * 8;
                float dmine = 0.f;
#pragma unroll
                for (int j = 0; j < 8; ++j) { f32x2 a0 = (f32x2){0.f, 0.f}, a1 = (f32x2){0.f, 0.f};
#pragma unroll
                    for (int i = 0; i < 4; ++i) { const f32x2 lo = __builtin_amdgcn_cvt_pk_f32_fp8((int)q[j][i], false), hi = __builtin_amdgcn_cvt_pk_f32_fp8((int)q[j][i], true); a0 += h2p[2 * i] * lo; a1 += h2p[2 * i + 1] * hi; }
                    const float a = (a0[0] + a0[1]) + (a1[0] + a1[1]);
                    const float tot = wave_sum_to63(a); const float sj = __builtin_bit_cast(float, __builtin_amdgcn_readlane(__builtin_bit_cast(int, tot), 63));
                    dmine = (lane == base + j) ? sj : dmine; }
                const float gsel = grp < 8 ? g_lo : g_hi, susel = grp < 8 ? su_lo : su_hi, svsel = grp < 8 ? sv_lo : sv_hi;
                const float wv = gsel * gelu_erf(dmine * susel) * svsel;
                const bool mine = (lane >= base) && (lane < base + 8);
                if (grp < 8) w_lo = mine ? wv : w_lo; else w_hi = mine ? wv : w_hi;
#pragma unroll
                for (int j = 0; j < 8; ++j) q[j] = nq[j];
            }
            WSP(float, WS_GATE)[t * 128 + lane] = w_lo; WSP(float, WS_GATE)[t * 128 + 64 + lane] = w_hi;
        }
    }
}
typedef long i64_t;
__device__ __forceinline__ void p8_peer_up4(Frame& F) {
    const int f_tid = threadIdx.x, lane = f_tid & 63, f_wave = __builtin_amdgcn_readfirstlane(f_tid >> 6);
    const int li = lane & 15, lq = lane >> 4;
    const unsigned char* EU = F.ws + WS_EU; const float* EUS = WSP(float, WS_EUS); const float* EVS = WSP(float, WS_EVS);
    LAS unsigned char* hq = F.lds + f_wave * 1024;
    for (int wq = F.vcu * NWAVES + f_wave; wq < MTOK / 16; wq += F.G * NWAVES) {
        const int b = wq >> 7; const float* mb = WSP(float, WS_MOD) + (size_t)b * 6144;
        for (int tt = 0; tt < 16; ++tt) {
            const size_t t = (size_t)wq * 16 + tt;
            unsigned l16 = 16u * (unsigned)lane; asm volatile("" : "+v"(l16));
            const unsigned rowoff = 16u * (unsigned)lq;
            const int e_lo = WSP(int, WS_EID)[t * 128 + lane], e_hi = WSP(int, WS_EID)[t * 128 + 64 + lane];
            const float g_lo = WSP(float, WS_GATE)[t * 128 + lane], g_hi = WSP(float, WS_GATE)[t * 128 + 64 + lane];
            v4u q[8], nq[8];
            { const int e = __shfl(e_lo, li);
#pragma unroll
              for (int c = 0; c < 8; ++c) q[c] = *(const v4u*)(EU + ((unsigned)e * 1024u + 64u * c + rowoff)); }
            const float su_lo = EUS[e_lo], su_hi = EUS[e_hi], sv_lo = EVS[e_lo], sv_hi = EVS[e_hi];
            const float rs = rsqrt_f(WSP(float, WS_ROWSTAT)[t] * (1.0f / 1024.0f) + EPSF);
            const char* xs = (const char*)(WSP(bf16, WS_X1S) + t * 1024) + 2u * l16; const v4u xa = *(const v4u*)xs, xb = *(const v4u*)(xs + 16);
            float h2[16]; unpack8(xa, h2); unpack8(xb, h2 + 8); float mx = 0.f;
#pragma unroll
            for (int qd = 0; qd < 4; ++qd) { const f32x4 sh = *(const f32x4*)((const char*)(mb + 3072) + 4u * l16 + 16 * qd);
#pragma unroll
                for (int e = 0; e < 4; ++e) { h2[4 * qd + e] = h2[4 * qd + e] * rs + sh[e]; mx = fmaxf(mx, fabsf(h2[4 * qd + e])); } }
#pragma unroll
            for (int o = 1; o < 64; o <<= 1) mx = fmaxf(mx, __shfl_xor(mx, o));
            mx = fmaxf(mx, 1e-30f); const float hs = 224.0f / mx, hinv = mx * (1.0f / 224.0f);
            { v4u w;
#pragma unroll
              for (int qd = 0; qd < 4; ++qd) { int pk = 0; pk = __builtin_amdgcn_cvt_pk_fp8_f32(h2[4 * qd] * hs, h2[4 * qd + 1] * hs, pk, false); pk = __builtin_amdgcn_cvt_pk_fp8_f32(h2[4 * qd + 2] * hs, h2[4 * qd + 3] * hs, pk, true); w[qd] = (unsigned)pk; }
              *(LAS v4u*)(hq + l16) = w; }
            LDS_WAIT(); asm volatile("" ::: "memory");
            v4u hb[16];
#pragma unroll
            for (int c = 0; c < 16; ++c) hb[c] = *(const LAS v4u*)(hq + 64 * c + rowoff);
            float w_lo = 0.f, w_hi = 0.f;
            f32x4 acc = (f32x4){0.f, 0.f, 0.f, 0.f};
#pragma unroll 1
            for (int u = 0; u < 16; ++u) {
                if (u < 15) { const int g1 = (u + 1) >> 1, kh = (u + 1) & 1; const int e = __shfl(g1 < 4 ? e_lo : e_hi, 16 * (g1 & 3) + li);
#pragma unroll
                    for (int c = 0; c < 8; ++c) nq[c] = *(const v4u*)(EU + ((unsigned)e * 1024u + 512u * kh + 64u * c + rowoff)); }
                __builtin_amdgcn_sched_barrier(0);
                if ((u & 1) == 0) {
#pragma unroll
                    for (int c = 0; c < 8; ++c) { acc = __builtin_amdgcn_mfma_f32_16x16x32_fp8_fp8((i64_t)(((unsigned long long)q[c][1] << 32) | q[c][0]), (i64_t)(((unsigned long long)hb[c][1] << 32) | hb[c][0]), acc, 0, 0, 0);
                        acc = __builtin_amdgcn_mfma_f32_16x16x32_fp8_fp8((i64_t)(((unsigned long long)q[c][3] << 32) | q[c][2]), (i64_t)(((unsigned long long)hb[c][3] << 32) | hb[c][2]), acc, 0, 0, 0); }
                } else {
#pragma unroll
                    for (int c = 0; c < 8; ++c) { acc = __builtin_amdgcn_mfma_f32_16x16x32_fp8_fp8((i64_t)(((unsigned long long)q[c][1] << 32) | q[c][0]), (i64_t)(((unsigned long long)hb[8 + c][1] << 32) | hb[8 + c][0]), acc, 0, 0, 0);
                        acc = __builtin_amdgcn_mfma_f32_16x16x32_fp8_fp8((i64_t)(((unsigned long long)q[c][3] << 32) | q[c][2]), (i64_t)(((unsigned long long)hb[8 + c][3] << 32) | hb[8 + c][2]), acc, 0, 0, 0); }
                    const int g = u >> 1; const int r = li & 3;
                    const float sel = r == 0 ? acc[0] : (r == 1 ? acc[1] : (r == 2 ? acc[2] : acc[3]));
                    const float dmine = __shfl(sel, ((li >> 2) & 3) * 16 + (li & 3));
                    const float gsel = g < 4 ? g_lo : g_hi, susel = g < 4 ? su_lo : su_hi, svsel = g < 4 ? sv_lo : sv_hi;
                    const float wv = gsel * gelu_erf(dmine * susel * hinv) * svsel;
                    const bool mine = (lane >> 4) == (g & 3);
                    if (g < 4) w_lo = mine ? wv : w_lo; else w_hi = mine ? wv : w_hi;
                    acc = (f32x4){0.f, 0.f, 0.f, 0.f};
                }
#pragma unroll
                for (int c = 0; c < 8; ++c) q[c] = nq[c];
            }
            WSP(float, WS_GATE)[t * 128 + lane] = w_lo; WSP(float, WS_GATE)[t * 128 + 64 + lane] = w_hi;
        }
    }
}
__device__ __forceinline__ void p8_peer_fused2(Frame& F) {
    const int f_tid = threadIdx.x, lane = f_tid & 63, f_wave = __builtin_amdgcn_readfirstlane(f_tid >> 6);
    const unsigned char* EU = F.ws + WS_EU; const unsigned char* EV = F.ws + WS_EV; const float* EUS = WSP(float, WS_EUS); const float* EVS = WSP(float, WS_EVS);
    for (int wq = F.vcu * NWAVES + f_wave; wq < MTOK / 16; wq += F.G * NWAVES) {
        const int b = wq >> 7; const float* mb = WSP(float, WS_MOD) + (size_t)b * 6144;
        for (int tt = 0; tt < 16; ++tt) {
            const size_t t = (size_t)wq * 16 + tt;
            unsigned l16 = 16u * (unsigned)lane; asm volatile("" : "+v"(l16));
            float* xr = (float*)((char*)(F.out + t * 1024) + 4u * l16);
            const int e_lo = WSP(int, WS_EID)[t * 128 + lane], e_hi = WSP(int, WS_EID)[t * 128 + 64 + lane];
            const float g_lo = WSP(float, WS_GATE)[t * 128 + lane], g_hi = WSP(float, WS_GATE)[t * 128 + 64 + lane];
            v4u qu[8], qv[8], nu[8], nv[8];
#pragma unroll
            for (int j = 0; j < 8; ++j) { const int e = __builtin_amdgcn_readlane(e_lo, j); const unsigned off = (unsigned)e * 1024u + l16; qu[j] = *(const v4u*)(EU + off); qv[j] = *(const v4u*)(EV + off); }
            const float su_lo = EUS[e_lo], su_hi = EUS[e_hi], sv_lo = EVS[e_lo], sv_hi = EVS[e_hi];
            const float rs = rsqrt_f(WSP(float, WS_ROWSTAT)[t] * (1.0f / 1024.0f) + EPSF);
            const char* xs = (const char*)(WSP(bf16, WS_X1S) + t * 1024) + 2u * l16; const v4u xa = *(const v4u*)xs, xb = *(const v4u*)(xs + 16);
            float h2[16]; unpack8(xa, h2); unpack8(xb, h2 + 8);
            f32x2 h2p[8];
#pragma unroll
            for (int q = 0; q < 4; ++q) { const f32x4 sh = *(const f32x4*)((const char*)(mb + 3072) + 4u * l16 + 16 * q);
                h2p[2 * q] = (f32x2){h2[4 * q] * rs + sh[0], h2[4 * q + 1] * rs + sh[1]}; h2p[2 * q + 1] = (f32x2){h2[4 * q + 2] * rs + sh[2], h2[4 * q + 3] * rs + sh[3]}; }
            f32x2 o[8];
#pragma unroll
            for (int i = 0; i < 8; ++i) o[i] = (f32x2){0.f, 0.f};
#pragma unroll 1
            for (int grp = 0; grp < 16; ++grp) {
                const int nb = ((grp + 1) & 7) * 8; const int ensel = (grp + 1) < 8 ? e_lo : e_hi;
                if (grp < 15) {
#pragma unroll
                    for (int j = 0; j < 8; ++j) { const int e = __builtin_amdgcn_readlane(ensel, nb + j); const unsigned off = (unsigned)e * 1024u + l16; nu[j] = *(const v4u*)(EU + off); nv[j] = *(const v4u*)(EV + off); } }
                __builtin_amdgcn_sched_barrier(0);
                const int base = (grp & 7) * 8;
                float dmine = 0.f;
#pragma unroll
                for (int j = 0; j < 8; ++j) { f32x2 a0 = (f32x2){0.f, 0.f}, a1 = (f32x2){0.f, 0.f};
#pragma unroll
                    for (int i = 0; i < 4; ++i) { const f32x2 lo = __builtin_amdgcn_cvt_pk_f32_fp8((int)qu[j][i], false), hi = __builtin_amdgcn_cvt_pk_f32_fp8((int)qu[j][i], true); a0 += h2p[2 * i] * lo; a1 += h2p[2 * i + 1] * hi; }
                    const float a = (a0[0] + a0[1]) + (a1[0] + a1[1]);
                    const float tot = wave_sum_to63(a); const float sj = __builtin_bit_cast(float, __builtin_amdgcn_readlane(__builtin_bit_cast(int, tot), 63));
                    dmine = (lane == base + j) ? sj : dmine; }
                const float gsel = grp < 8 ? g_lo : g_hi, susel = grp < 8 ? su_lo : su_hi, svsel = grp < 8 ? sv_lo : sv_hi;
                const float wv = gsel * gelu_erf(dmine * susel) * svsel;
#pragma unroll
                for (int j = 0; j < 8; ++j) { const float wj = __builtin_bit_cast(float, __builtin_amdgcn_readlane(__builtin_bit_cast(int, wv), base + j)); const f32x2 w2 = (f32x2){wj, wj};
#pragma unroll
                    for (int i = 0; i < 4; ++i) { const f32x2 lo = __builtin_amdgcn_cvt_pk_f32_fp8((int)qv[j][i], false), hi = __builtin_amdgcn_cvt_pk_f32_fp8((int)qv[j][i], true); o[2 * i] += w2 * lo; o[2 * i + 1] += w2 * hi; } }
#pragma unroll
                for (int j = 0; j < 8; ++j) { qu[j] = nu[j]; qv[j] = nv[j]; }
            }
            float x1[16]; float ss = 0.f;
#pragma unroll
            for (int q4 = 0; q4 < 4; ++q4) { const f32x4 v = *(const f32x4*)(xr + 4 * q4); x1[4 * q4] = v[0]; x1[4 * q4 + 1] = v[1]; x1[4 * q4 + 2] = v[2]; x1[4 * q4 + 3] = v[3]; }
#pragma unroll
            for (int q4 = 0; q4 < 4; ++q4) { const f32x4 gt = *(const f32x4*)((const char*)(mb + 5120) + 4u * l16 + 16 * q4);
#pragma unroll
                for (int e = 0; e < 4; ++e) { const int i = 4 * q4 + e; x1[i] += gt[e] * o[i >> 1][i & 1]; ss += x1[i] * x1[i]; } }
            const float rf = rsqrt_f(wave_sum(ss) * (1.0f / 1024.0f) + EPSF);
#pragma unroll
            for (int q4 = 0; q4 < 4; ++q4) { const f32x4 nf = *(const f32x4*)((const char*)(F.a->in[29]) + 4u * l16 + 16 * q4); f32x4 v;
#pragma unroll
                for (int e = 0; e < 4; ++e) v[e] = x1[4 * q4 + e] * rf * nf[e];
                *(f32x4*)(xr + 4 * q4) = v; }
        }
    }
}
constexpr int NPHASE = 10;
__global__ void __launch_bounds__(NTHR, 2) fwd_mega(Args args) {
    extern __shared__ __attribute__((aligned(16))) unsigned char lds[];
    Frame F;
    F.lds = (LAS unsigned char*)lds;
    F.MISC = (volatile LAS unsigned*)(F.lds + MISC_OFF);
    F.G = gridDim.x; { const int bx = blockIdx.x; F.vcu = (F.G % 8 == 0) ? (bx % 8) * (F.G / 8) + bx / 8 : bx; }
    F.ws = args.ws; F.out = args.out;
    F.a = &args;
    for (int u = threadIdx.x; u < 32; u += NTHR) F.MISC[u] = 0u;
    __syncthreads();
    const int lo = args.ph_lo, hi = args.ph_hi;
    const bool use_bar = (hi - lo) > 1;
    XcdBarrier bar; bar.bar = (unsigned*)(F.ws + WS_CTL); bar.x = 0; bar.st = nullptr;
    if (use_bar) bar = xcd_barrier_post((unsigned*)(F.ws + WS_CTL), F.MISC + 8);
#define IN(k) (lo <= (k) && (k) < hi)
#define SEAM(k) do { if (IN(k) && IN((k) + 1)) xcd_barrier(bar); } while (0)
#ifndef REP_PHASE
#define REP_PHASE -1
#endif
#define REPEAT(k, body) do { if (REP_PHASE == (k)) { xcd_barrier(bar); body; } } while (0)
    if (IN(0)) {
#ifndef SKIP_P0
 p0_phase(F); REPEAT(0, p0_phase(F));
#endif
 } SEAM(0);
    if (IN(1)) {
#ifndef SKIP_P1
 p1_phase(F); REPEAT(1, p1_phase(F));
#endif
 } SEAM(1);
    if (IN(2)) {
        pg8::Gemm g{WSP(bf16, WS_H1), WSP(bf16, WS_WINT), MTOK, NPROJ, 1024}; pg8::StaticOrder S; S.init(MTOK, NPROJ, F.G, (int)blockIdx.x);
        pg8::EpiProj E{WSP(bf16, WS_PROJ), NPROJ};
        pg8::gemm_phase<pg8::EpiProj, pg8::StaticOrder, true, true>(F.lds, g, S, E);
        REPEAT(2, (pg8::gemm_phase<pg8::EpiProj, pg8::StaticOrder, true, true>(F.lds, g, S, E)));
    } SEAM(2);
    if (IN(3)) {
#ifndef SKIP_SSD
#ifdef SSD_NAIVE
 p3_ssd_naive(F);
#elif defined(SSD_V1)
 p3_ssd(F); REPEAT(30, p3_ssd(F));
#elif defined(SSD_V2)
 p3pre_conv(F); xcd_barrier(bar); p3_ssd2(F); REPEAT(30, p3_ssd2(F)); REPEAT(32, p3pre_conv(F));
#else
 p3pre_conv(F); xcd_barrier(bar); p3_ssd3(F); REPEAT(30, p3_ssd3(F)); REPEAT(32, p3pre_conv(F));
#endif
#endif
#ifndef SKIP_S5
#ifdef S5_NAIVE
 p3_s5_naive(F);
#elif defined(S5_V1)
 p3_s5(F); REPEAT(31, p3_s5(F));
#else
 p3_s5v2(F); REPEAT(31, p3_s5v2(F));
#endif
#endif
 } SEAM(3);
#ifdef USE_P3C
    if (IN(4)) { p3c_normalize(F); } SEAM(4);
    if (IN(5)) {
        pg8::Gemm g{WSP(bf16, WS_Y), WSP(bf16, WS_WOUTT), MTOK, 1024, 2048}; pg8::StaticOrder S; S.init(MTOK, 1024, F.G, (int)blockIdx.x);
        PG8_LAS float* tab = (PG8_LAS float*)(F.lds + pg8::STAGE_BYTES);
        for (int i = threadIdx.x; i < 2 * 1280; i += NTHR) tab[i] = 1.0f;
        __syncthreads();
        pg8::EpiX1 E{(F.a->in[0]), F.out, WSP(bf16, WS_X1S), WSP(float, WS_MOD), (F.a->in[24]), WSP(float, WS_ROWSTAT), tab};
        pg8::gemm_phase<pg8::EpiX1, pg8::StaticOrder, true, true>(F.lds, g, S, E);
    } SEAM(5);
#else
    if (IN(5)) {
        pg8::Gemm g{WSP(bf16, WS_Y), WSP(bf16, WS_WOUTT), MTOK, 1024, 2048}; pg8::StaticOrder S; S.init(MTOK, 1024, F.G, (int)blockIdx.x);
        PG8_LAS float* tab = (PG8_LAS float*)(F.lds + pg8::STAGE_BYTES);
        { pg8::Unit u; for (int i = 0; S.next(i, u); ++i) pg8::SegScaleHook::build(F.lds + pg8::STAGE_BYTES, u, WSP(float, WS_STSSD), WSP(float, WS_STS5), (int)threadIdx.x); }
        __syncthreads();
        pg8::EpiX1 E{(F.a->in[0]), F.out, WSP(bf16, WS_X1S), WSP(float, WS_MOD), (F.a->in[24]), WSP(float, WS_ROWSTAT), tab};
        pg8::SegScaleHook H;
        pg8::gemm_phase<pg8::EpiX1, pg8::StaticOrder, true, true, pg8::SegScaleHook>(F.lds, g, S, E, H);
    } SEAM(5);
#endif
    if (IN(6)) {
        pg8::Gemm g{WSP(bf16, WS_X1S), WSP(bf16, WS_WQKT), MTOK, 2048, 1024}; pg8::StaticOrder S; S.init(MTOK, 2048, F.G, (int)blockIdx.x);
        pg8::EpiScores E{WSP(float, WS_SCORES), WSP(float, WS_SB), WSP(float, WS_ROWSTAT)};
        pg8::gemm_phase<pg8::EpiScores, pg8::StaticOrder, true, true>(F.lds, g, S, E);
        REPEAT(6, (pg8::gemm_phase<pg8::EpiScores, pg8::StaticOrder, true, true>(F.lds, g, S, E)));
    } SEAM(6);
    if (IN(7)) {
#ifndef SKIP_TOPK
 p5b_topk(F); REPEAT(7, p5b_topk(F));
#endif
 } SEAM(7);
#ifdef PEER_FUSED
    if (IN(8)) { p8_peer_fused(F); }
#elif defined(PEER_FUSED2)
    if (IN(8)) { p8_peer_fused2(F); }
#else
#ifdef PEER_UP2
    if (IN(8)) { p8_peer_up2(F); } SEAM(8);
#else
#ifndef PEER_UP4
    if (IN(8)) { p8_peer_up3(F, bar); } SEAM(8);
#else
    if (IN(8)) { p8_peer_up4(F); REPEAT(8, { p5b_topk(F); xcd_barrier(bar); p8_peer_up4(F); }); } SEAM(8);
#endif
#endif
    if (IN(9)) { p9_peer_down2(F, bar); }
#endif
#undef IN
#undef SEAM
}

#ifndef N_LAUNCHES
#define N_LAUNCHES 1
#endif
extern "C" void kernel_launch(void* const* d_in, const int* in_sizes, int n_in, void* d_out, int out_size, void* d_ws, size_t ws_size, hipStream_t stream) {
    static int grid = 0;
    if (grid == 0) {
        if (n_in != 30 || in_sizes[0] != MTOK * DM || out_size != MTOK * DM || ws_size < WS_END) { fprintf(stderr, "kernel_launch: unexpected shapes (n_in %d, in0 %d, out %d, ws %zu)\n", n_in, n_in > 0 ? in_sizes[0] : -1, out_size, ws_size); grid = -1; return; }
        int dev = 0, cus = 0, per_cu = 0;
        if (hipGetDevice(&dev) != hipSuccess || hipDeviceGetAttribute(&cus, hipDeviceAttributeMultiprocessorCount, dev) != hipSuccess) { grid = -1; return; }
        if (hipFuncSetAttribute((const void*)fwd_mega, hipFuncAttributeMaxDynamicSharedMemorySize, LDS_BYTES) != hipSuccess) { fprintf(stderr, "kernel_launch: hipFuncSetAttribute failed\n"); grid = -1; return; }
        if (hipOccupancyMaxActiveBlocksPerMultiprocessor(&per_cu, (const void*)fwd_mega, NTHR, LDS_BYTES) != hipSuccess || per_cu < 1) { fprintf(stderr, "kernel_launch: occupancy query says %d\n", per_cu); (void)hipGetLastError(); grid = -1; return; }
        grid = cus;
    }
    if (grid < 0) return;
    (void)hipMemsetAsync((char*)d_ws + WS_CTL, 0, CTL_ZERO_BYTES, stream);
    Args a{};
    for (int i = 0; i < 30; ++i) a.in[i] = (const float*)d_in[i];
    a.out = (float*)d_out; a.ws = (unsigned char*)d_ws;
    if (N_LAUNCHES == 1) {
        a.ph_lo = 0; a.ph_hi = NPHASE;
        void* kargs[] = {&a};
        hipError_t e = hipLaunchCooperativeKernel((const void*)fwd_mega, dim3(grid), dim3(NTHR), kargs, LDS_BYTES, stream);
        if (e != hipSuccess) fprintf(stderr, "kernel_launch: cooperative launch failed: %s (grid %d)\n", hipGetErrorString(e), grid);
    } else {
        for (int p = 0; p < NPHASE; ++p) { a.ph_lo = p; a.ph_hi = p + 1; hipLaunchKernelGGL(fwd_mega, dim3(grid), dim3(NTHR), LDS_BYTES, stream, a); }
    }
}
```

```cpp
#include <hip/hip_runtime.h>
#include <cstdio>
#include <cstdint>

namespace pg8 {
#define PG8_LAS __attribute__((address_space(3)))
typedef unsigned short bf16_t;
typedef short bf16x8 __attribute__((ext_vector_type(8)));
typedef float f32x4 __attribute__((ext_vector_type(4)));
typedef unsigned u32x4 __attribute__((ext_vector_type(4)));
constexpr int BM = 256, BK = 64, HALF = 128, HTB = HALF * BK * 2  , STAGE_BYTES = 8 * HTB, NXCD = 8, WGM = 8;

__host__ __device__ __forceinline__ int lds_byte(int r, int c) { const int st = (r >> 4) * 2 + (c >> 5), rr = r & 15, cc = c & 31, ob = rr * 64 + cc * 2; return st * 1024 + (ob ^ (((ob >> 9) & 1) << 5)); }
__host__ __device__ __forceinline__ void stage_rc(int b, int& R, int& C) { const int st = b / 1024, sb = b % 1024, swz = sb ^ (((sb >> 9) & 1) << 5); R = (st >> 1) * 16 + swz / 64; C = (st & 1) * 32 + (swz % 64) / 2; }
__host__ __device__ __forceinline__ int perm32(int rho) { const int n = rho >> 4, i = rho & 15; return 8 * (i >> 2) + 4 * n + (i & 3); }

struct Unit { int pm, pn; };
struct Gemm { const bf16_t* A; const bf16_t* Bt; int M, N, K; };

struct StaticOrder {
    int nM, nN, nwg, G, c;
    __host__ __device__ void init(int M, int N, int G_, int c_) { nM = M / BM; nN = N / BM; nwg = nM * nN; G = G_; c = c_; }
    __host__ __device__ bool next(int i, Unit& u) const {
        const long L = (long)i * G + c; if (L >= nwg) return false;
        int wgid = (int)L; { const int q = nwg / NXCD, r = nwg % NXCD, xcd = wgid % NXCD, off = wgid / NXCD; wgid = (xcd < r ? xcd * (q + 1) : r * (q + 1) + (xcd - r) * q) + off; }
        const int nig = WGM * nN, gid = wgid / nig, fm = gid * WGM, gsz = (nM - fm) < WGM ? (nM - fm) : WGM;
        u.pm = fm + ((wgid % nig) % gsz); u.pn = (wgid % nig) / gsz; return true;
    }
    __device__ __forceinline__ void a_ready(const Unit&) const {}
    __device__ __forceinline__ void done(const Unit&) const {}
};

__device__ __forceinline__ unsigned cvt_pk_bf16(float lo, float hi) { unsigned r; asm volatile("v_cvt_pk_bf16_f32 %0, %1, %2" : "=v"(r) : "v"(lo), "v"(hi)); return r; }
typedef float f32x2 __attribute__((ext_vector_type(2)));
struct NoHook { __device__ __forceinline__ void at_tile(int, const Unit&, f32x4 (&)[2][2][4][2], PG8_LAS unsigned char*, int, int) const {} };
template <class Epi, class Sched, bool ALIGN_EPI = false, bool SP2 = false, class Hook = NoHook>
__device__ __forceinline__ void gemm_phase(PG8_LAS unsigned char* lds, const Gemm g, const Sched& S, const Epi& E, const Hook& H = Hook()) {
    const int tid = threadIdx.x, wid = __builtin_amdgcn_readfirstlane(tid >> 6), lane = tid & 63, wr = wid >> 2, wc = wid & 3, fr = lane & 15, fq = lane >> 4;
    const int K = g.K, nt = K / BK;
    unsigned voffA[2], voffB[2];
#pragma unroll
    for (int i = 0; i < 2; ++i) { int R, C; stage_rc(tid * 16 + i * 8192, R, C); const int Rb = Epi::PERM ? ((R & ~31) + perm32(R & 31)) : R;
        voffA[i] = (unsigned)(R * K + C) * 2u; voffB[i] = (unsigned)(Rb * K + C) * 2u; }
    const size_t kstep = (size_t)(BK * 2);
    const size_t hstep = (size_t)HALF * K * 2;
    const size_t tstep = 2 * hstep;
    const unsigned ldsw = (unsigned)wid * 1024u;
    const int aoff = lds_byte(wr * 64 + fr, fq * 8), boff = lds_byte(wc * 32 + fr, fq * 8);
#define PG8_SA(b, h) (((b) * 2 + (h)) * HTB)
#define PG8_SB(b, h) ((4 + (b) * 2 + (h)) * HTB)
#define PG8_STAGE(bufoff, gbase, voff) do { _Pragma("unroll") for (int _i = 0; _i < 2; ++_i) \
        __builtin_amdgcn_global_load_lds((const unsigned*)((const char*)(gbase) + (voff)[_i]), (PG8_LAS unsigned*)(lds + (bufoff) + ldsw + _i * 8192), 16, 0, 0); } while (0)
#define PG8_LDA(dst, b, h) do { _Pragma("unroll") for (int m = 0; m < 4; ++m) _Pragma("unroll") for (int k = 0; k < 2; ++k) dst[m][k] = *(const PG8_LAS bf16x8*)(lds + PG8_SA(b, h) + aoff + m * 2048 + k * 1024); } while (0)
#define PG8_LDB(dst, b, h) do { _Pragma("unroll") for (int n = 0; n < 2; ++n) _Pragma("unroll") for (int k = 0; k < 2; ++k) dst[n][k] = *(const PG8_LAS bf16x8*)(lds + PG8_SB(b, h) + boff + n * 2048 + k * 1024); } while (0)
#define PG8_MMA(ai, bj, At, Bt) do { __builtin_amdgcn_s_setprio(1); _Pragma("unroll") for (int m = 0; m < 4; ++m) _Pragma("unroll") for (int n = 0; n < 2; ++n) _Pragma("unroll") for (int k = 0; k < 2; ++k) \
        acc[ai][bj][m][n] = __builtin_amdgcn_mfma_f32_16x16x32_bf16(Bt[n][k], At[m][k], acc[ai][bj][m][n], 0, 0, 0); __builtin_amdgcn_s_setprio(0); } while (0)
#define PG8_WAIT_V(n) asm volatile("s_waitcnt vmcnt(" #n ")" ::: "memory")
#define PG8_WAIT_L(n) asm volatile("s_waitcnt lgkmcnt(" #n ")" ::: "memory")
#define PG8_BAR __builtin_amdgcn_s_barrier()
#define PG8_SCHED __builtin_amdgcn_sched_barrier(0)
    Unit cur, nxt; int ui = 0;
    if (!S.next(0, cur)) return;
    f32x4 acc[2][2][4][2];
#pragma unroll
    for (int a = 0; a < 2; ++a)
#pragma unroll
        for (int b = 0; b < 2; ++b)
#pragma unroll
            for (int m = 0; m < 4; ++m)
#pragma unroll
                for (int n = 0; n < 2; ++n) acc[a][b][m][n] = (f32x4){0.f, 0.f, 0.f, 0.f};
    bf16x8 At[4][2], B0[2][2], B1[2][2];
    const char* cA = (const char*)g.A + (size_t)cur.pm * tstep; const char* cB = (const char*)g.Bt + (size_t)cur.pn * tstep;
    S.a_ready(cur);
    if constexpr (SP2) {
        PG8_STAGE(PG8_SB(0, 0), cB, voffB); PG8_STAGE(PG8_SB(0, 1), cB + hstep, voffB); PG8_STAGE(PG8_SA(0, 0), cA, voffA); PG8_STAGE(PG8_SA(0, 1), cA + hstep, voffA);
        if (wr == 1) PG8_BAR;
        PG8_WAIT_V(2); PG8_BAR;
        PG8_STAGE(PG8_SB(1, 0), cB + kstep, voffB); PG8_STAGE(PG8_SA(1, 0), cA + kstep, voffA); PG8_STAGE(PG8_SB(1, 1), cB + hstep + kstep, voffB);
        PG8_WAIT_V(6); PG8_BAR;
    } else {
        PG8_STAGE(PG8_SB(0, 0), cB, voffB); PG8_STAGE(PG8_SA(0, 0), cA, voffA); PG8_STAGE(PG8_SB(0, 1), cB + hstep, voffB); PG8_STAGE(PG8_SA(0, 1), cA + hstep, voffA);
        if (wr == 1) PG8_BAR;
        PG8_WAIT_V(4); PG8_BAR;
        PG8_STAGE(PG8_SB(1, 0), cB + kstep, voffB); PG8_STAGE(PG8_SA(1, 0), cA + kstep, voffA); PG8_STAGE(PG8_SB(1, 1), cB + hstep + kstep, voffB);
        PG8_WAIT_V(6); PG8_BAR;
    }
    for (;;) {
        const bool has_next = S.next(ui + 1, nxt);
        const char* nA = has_next ? (const char*)g.A + (size_t)nxt.pm * tstep : cA; const char* nB = has_next ? (const char*)g.Bt + (size_t)nxt.pn * tstep : cB;
        for (int t = 0; t < nt; t += 2) {
            const bool last = (t == nt - 2);
            H.at_tile(t, cur, acc, lds + STAGE_BYTES, wr, fr);
            const char* a1 = cA + (size_t)(t + 1) * kstep;
            const char* a2 = last ? nA : cA + (size_t)(t + 2) * kstep; const char* b2 = last ? nB : cB + (size_t)(t + 2) * kstep;
            const char* a3 = a2 + kstep; const char* b3 = b2 + kstep;
            if (last && has_next) S.a_ready(nxt);
            if constexpr (SP2) {
            PG8_LDB(B0, 0, 0); PG8_LDB(B1, 0, 1); PG8_SCHED; PG8_LDA(At, 0, 0); PG8_STAGE(PG8_SA(1, 1), a1 + hstep, voffA);
            PG8_WAIT_V(8); PG8_WAIT_L(0); PG8_BAR; PG8_MMA(0, 0, At, B0); PG8_MMA(0, 1, At, B1); PG8_BAR; PG8_SCHED;
            PG8_LDA(At, 0, 1); PG8_STAGE(PG8_SB(0, 0), b2, voffB); PG8_STAGE(PG8_SB(0, 1), b2 + hstep, voffB); PG8_STAGE(PG8_SA(0, 0), a2, voffA);
            PG8_WAIT_V(8); PG8_WAIT_L(0); PG8_BAR; PG8_MMA(1, 0, At, B0); PG8_MMA(1, 1, At, B1); PG8_BAR; PG8_SCHED;
            PG8_LDB(B0, 1, 0); PG8_LDB(B1, 1, 1); PG8_SCHED; PG8_LDA(At, 1, 0); PG8_STAGE(PG8_SA(0, 1), a2 + hstep, voffA);
            PG8_WAIT_V(8); PG8_WAIT_L(0); PG8_BAR; PG8_MMA(0, 0, At, B0); PG8_MMA(0, 1, At, B1); PG8_BAR; PG8_SCHED;
            PG8_LDA(At, 1, 1); PG8_STAGE(PG8_SB(1, 0), b3, voffB); PG8_STAGE(PG8_SB(1, 1), b3 + hstep, voffB); PG8_STAGE(PG8_SA(1, 0), a3, voffA);
            PG8_WAIT_V(8); PG8_WAIT_L(0); PG8_BAR; PG8_MMA(1, 0, At, B0); PG8_MMA(1, 1, At, B1); PG8_BAR; PG8_SCHED;
            } else {
            PG8_LDB(B0, 0, 0); PG8_SCHED; PG8_LDA(At, 0, 0); PG8_STAGE(PG8_SA(1, 1), a1 + hstep, voffA);
            PG8_WAIT_L(8); PG8_BAR; PG8_WAIT_L(0); PG8_MMA(0, 0, At, B0); PG8_BAR; PG8_SCHED;
            PG8_LDB(B1, 0, 1); PG8_STAGE(PG8_SB(0, 0), b2, voffB);
            PG8_BAR; PG8_WAIT_L(0); PG8_MMA(0, 1, At, B1); PG8_BAR;
            PG8_LDA(At, 0, 1); PG8_STAGE(PG8_SA(0, 0), a2, voffA);
            PG8_BAR; PG8_WAIT_L(0); PG8_MMA(1, 0, At, B0); PG8_BAR; PG8_SCHED;
            PG8_STAGE(PG8_SB(0, 1), b2 + hstep, voffB);
            PG8_WAIT_V(6); PG8_BAR; PG8_MMA(1, 1, At, B1); PG8_BAR;
            PG8_LDB(B0, 1, 0); PG8_SCHED; PG8_LDA(At, 1, 0); PG8_STAGE(PG8_SA(0, 1), a2 + hstep, voffA);
            PG8_WAIT_L(8); PG8_BAR; PG8_WAIT_L(0); PG8_MMA(0, 0, At, B0); PG8_BAR; PG8_SCHED;
            PG8_LDB(B1, 1, 1); PG8_STAGE(PG8_SB(1, 0), b3, voffB);
            PG8_BAR; PG8_WAIT_L(0); PG8_MMA(0, 1, At, B1); PG8_BAR;
            PG8_LDA(At, 1, 1); PG8_STAGE(PG8_SA(1, 0), a3, voffA);
            PG8_BAR; PG8_WAIT_L(0); PG8_MMA(1, 0, At, B0); PG8_BAR; PG8_SCHED;
            PG8_STAGE(PG8_SB(1, 1), b3 + hstep, voffB);
            PG8_WAIT_V(6); PG8_BAR; PG8_MMA(1, 1, At, B1); PG8_BAR;
            }
        }
        if constexpr (ALIGN_EPI) { if (wr == 0) PG8_BAR; }
        if constexpr (!Epi::AFTER_DRAIN) { E(acc, cur, wr, wc, fr, fq); S.done(cur); }
        if (!has_next) break;
#pragma unroll
        for (int a = 0; a < 2; ++a)
#pragma unroll
            for (int b = 0; b < 2; ++b)
#pragma unroll
                for (int m = 0; m < 4; ++m)
#pragma unroll
                    for (int n = 0; n < 2; ++n) acc[a][b][m][n] = (f32x4){0.f, 0.f, 0.f, 0.f};
        cur = nxt; cA = nA; cB = nB; ++ui;
        if constexpr (ALIGN_EPI) { if (wr == 1) PG8_BAR; }
    }
    PG8_WAIT_V(0);
    if constexpr (!ALIGN_EPI) { if (wr == 0) PG8_BAR; }
    PG8_BAR;
    if constexpr (Epi::AFTER_DRAIN) { E.fused(acc, cur, wr, wc, fr, fq, lds, wid, lane); S.done(cur); }
#undef PG8_SA
#undef PG8_SB
#undef PG8_STAGE
#undef PG8_LDA
#undef PG8_LDB
#undef PG8_MMA
#undef PG8_WAIT_V
#undef PG8_WAIT_L
#undef PG8_BAR
#undef PG8_SCHED
}
}
namespace pg8 {
struct EpiProj {
    static constexpr bool PERM = true, AFTER_DRAIN = false;
    bf16_t* O; int ldc;
    __device__ __forceinline__ void operator()(const f32x4 (&acc)[2][2][4][2], const Unit& u, int wr, int wc, int fr, int fq) const {
        const int row0 = u.pm * BM + wr * 64 + fr; const int col0 = u.pn * BM + wc * 32 + 8 * fq;
#pragma unroll
        for (int ai = 0; ai < 2; ++ai)
#pragma unroll
            for (int m = 0; m < 4; ++m) { bf16_t* rowp = O + (size_t)(row0 + ai * HALF + m * 16) * ldc + col0;
#pragma unroll
                for (int bj = 0; bj < 2; ++bj) { const f32x4 v0 = acc[ai][bj][m][0], v1 = acc[ai][bj][m][1];
                    u32x4 w; w.x = cvt_pk_bf16(v0[0], v0[1]); w.y = cvt_pk_bf16(v0[2], v0[3]); w.z = cvt_pk_bf16(v1[0], v1[1]); w.w = cvt_pk_bf16(v1[2], v1[3]);
                    *(u32x4*)(rowp + bj * HALF) = w; } }
    }
};
struct EpiX1 {
    static constexpr bool PERM = true, AFTER_DRAIN = false;
    const float* x; float* x1; bf16_t* x1s; const float* mod; const float* norm2_g; float* rowstat; PG8_LAS float* tab;
    __device__ __forceinline__ void operator()(const f32x4 (&acc)[2][2][4][2], const Unit& u, int wr, int wc, int fr, int fq) const {
        const int row0 = u.pm * BM + wr * 64 + fr; const int col0 = u.pn * BM + wc * 32 + 8 * fq; const int b = (u.pm * BM) >> 11;
        const float* mb = mod + (size_t)b * 6144;
        f32x4 g1[2][2], g2[2][2];
#pragma unroll
        for (int bj = 0; bj < 2; ++bj)
#pragma unroll
            for (int n = 0; n < 2; ++n) { const int c = col0 + bj * HALF + 4 * n; g1[bj][n] = *(const f32x4*)(mb + 2048 + c);
                const f32x4 sc = *(const f32x4*)(mb + 4096 + c), ng = *(const f32x4*)(norm2_g + c); g2[bj][n] = ng * (sc + 1.0f); }
#pragma unroll
        for (int ai = 0; ai < 2; ++ai)
#pragma unroll
            for (int m = 0; m < 4; ++m) { const size_t row = (size_t)(row0 + ai * HALF + m * 16); const size_t off = row * 1024 + col0; float ss = 0.f;
                const float rfin = tab[((u.pm >> 3) & 1) * 1280 + 1024 + ai * HALF + wr * 64 + m * 16 + fr];
#pragma unroll
                for (int bj = 0; bj < 2; ++bj) {
                    const f32x4 xa = *(const f32x4*)(x + off + bj * HALF), xb = *(const f32x4*)(x + off + bj * HALF + 4);
                    const f32x4 v0 = xa + g1[bj][0] * (acc[ai][bj][m][0] * rfin), v1 = xb + g1[bj][1] * (acc[ai][bj][m][1] * rfin);
                    *(f32x4*)(x1 + off + bj * HALF) = v0; *(f32x4*)(x1 + off + bj * HALF + 4) = v1;
                    ss += (v0[0] * v0[0] + v0[1] * v0[1]) + (v0[2] * v0[2] + v0[3] * v0[3]) + (v1[0] * v1[0] + v1[1] * v1[1]) + (v1[2] * v1[2] + v1[3] * v1[3]);
                    const f32x4 s0 = v0 * g2[bj][0], s1 = v1 * g2[bj][1];
                    u32x4 w; w.x = cvt_pk_bf16(s0[0], s0[1]); w.y = cvt_pk_bf16(s0[2], s0[3]); w.z = cvt_pk_bf16(s1[0], s1[1]); w.w = cvt_pk_bf16(s1[2], s1[3]);
                    *(u32x4*)(x1s + off + bj * HALF) = w; }
                ss += __shfl_xor(ss, 16); ss += __shfl_xor(ss, 32);
                if (fq == 0) atomicAdd(rowstat + row, ss); }
    }
};
struct EpiScores {
    static constexpr bool PERM = true, AFTER_DRAIN = false;
    float* S; const float* sb; const float* rowstat;
    __device__ __forceinline__ void operator()(const f32x4 (&acc)[2][2][4][2], const Unit& u, int wr, int wc, int fr, int fq) const {
        const int row0 = u.pm * BM + wr * 64 + fr; const int col0 = u.pn * BM + wc * 32 + 8 * fq; const int b = (u.pm * BM) >> 11;
        f32x4 bv[2][2];
#pragma unroll
        for (int bj = 0; bj < 2; ++bj)
#pragma unroll
            for (int n = 0; n < 2; ++n) bv[bj][n] = *(const f32x4*)(sb + (size_t)b * 2048 + col0 + bj * HALF + 4 * n);
#pragma unroll
        for (int ai = 0; ai < 2; ++ai)
#pragma unroll
            for (int m = 0; m < 4; ++m) { const size_t row = (size_t)(row0 + ai * HALF + m * 16); const float rs = __builtin_amdgcn_rsqf(rowstat[row] * (1.0f / 1024.0f) + 1e-6f);
                float* rowp = S + row * 2048 + col0;
#pragma unroll
                for (int bj = 0; bj < 2; ++bj) { *(f32x4*)(rowp + bj * HALF) = acc[ai][bj][m][0] * rs + bv[bj][0]; *(f32x4*)(rowp + bj * HALF + 4) = acc[ai][bj][m][1] * rs + bv[bj][1]; } }
    }
};
struct SegScaleHook {
    __device__ __forceinline__ static void build(PG8_LAS unsigned char* ldsx, const Unit& u, const float* st_ssd, const float* st_s5, int tid) {
        PG8_LAS float* tab = (PG8_LAS float*)ldsx + ((u.pm >> 3) & 1) * 1280;
        if (tid < 256) { const size_t row = (size_t)u.pm * BM + tid; const f32x4* sg = (const f32x4*)(st_ssd + row * 16); const f32x4* s5 = (const f32x4*)(st_s5 + row * 64);
            float r[5];
#pragma unroll
            for (int gI = 0; gI < 4; ++gI) { const f32x4 v = sg[gI]; r[gI] = __builtin_amdgcn_rsqf(((v[0] + v[1]) + (v[2] + v[3])) * (1.0f / 256.0f) + 1e-6f); }
            float a5 = 0.f;
#pragma unroll
            for (int q = 0; q < 16; ++q) { const f32x4 v = s5[q]; a5 += (v[0] + v[1]) + (v[2] + v[3]); }
            r[4] = __builtin_amdgcn_rsqf(a5 * (1.0f / 1024.0f) + 1e-6f);
#pragma unroll
            for (int k = 0; k < 4; ++k) tab[k * 256 + tid] = r[k] * __builtin_amdgcn_rcpf(r[k + 1]);
            tab[1024 + tid] = r[4]; }
    }
    __device__ __forceinline__ void at_tile(int t, const Unit& u, f32x4 (&acc)[2][2][4][2], PG8_LAS unsigned char* ldsx, int wr, int fr) const {
        if (t == 4 || t == 8 || t == 12 || t == 16) { const PG8_LAS float* rt = (const PG8_LAS float*)ldsx + ((u.pm >> 3) & 1) * 1280 + ((t >> 2) - 1) * 256 + wr * 64 + fr;
#pragma unroll
            for (int ai = 0; ai < 2; ++ai)
#pragma unroll
                for (int m = 0; m < 4; ++m) { const float r = rt[ai * HALF + m * 16];
#pragma unroll
                    for (int bj = 0; bj < 2; ++bj) { acc[ai][bj][m][0] = acc[ai][bj][m][0] * r; acc[ai][bj][m][1] = acc[ai][bj][m][1] * r; } } }
    }
};
}
constexpr int NWAVES = 8, NTHR = 512;
constexpr int DM = 1024, NB = 16, SEQ = 2048, MTOK = NB * SEQ;
constexpr int NPROJ = 4096;
constexpr int INW = 4112;
constexpr int NHEADS = 16, HDIM = 64, NGRP = 4, NST = 128, CHUNK = 128;
constexpr int S5G = 64, S5CH = 16, S5P = 64;
constexpr int PH = 8, PK = 16, PNK = 128;
constexpr float EPSF = 1e-6f;
constexpr int NS5PART = 64;

constexpr size_t MiB = 1u << 20;
constexpr size_t WS_CTL = 0, CTL_ZERO_BYTES = 64 * 1024;
constexpr size_t WS_MOD = 1 * MiB;
constexpr size_t WS_WDT = WS_MOD + 0x60000;
constexpr size_t WS_SB = WS_MOD + 0x70000;
constexpr size_t WS_ROWSTAT = WS_MOD + 0x90000;
constexpr size_t WS_S5LB = WS_MOD + 0xB0000;
constexpr size_t WS_S5BB = WS_MOD + 0xC0000;
constexpr size_t WS_DTRAW = 3 * MiB;
constexpr size_t WS_STSSD = 5 * MiB;
constexpr size_t WS_STS5 = 7 * MiB;
constexpr size_t WS_WINT = 15 * MiB;
constexpr size_t WS_WOUTT = 23 * MiB;
constexpr size_t WS_WQKT = 27 * MiB;
constexpr size_t WS_EU = 31 * MiB, WS_EV = 47 * MiB;
constexpr size_t WS_EUS = 63 * MiB, WS_EVS = 63 * MiB + 65536;
constexpr size_t WS_START = 64 * MiB;
constexpr size_t WS_A = 95 * MiB;
constexpr size_t WS_B = 223 * MiB;
constexpr size_t WS_H1 = WS_A, WS_Y = WS_A, WS_PROJ = WS_B, WS_SCORES = WS_A;
constexpr size_t WS_X1S = WS_B + 192 * MiB;
constexpr size_t WS_EID = 479 * MiB, WS_GATE = 495 * MiB;
constexpr size_t WS_END = 511 * MiB;
static_assert(WS_SCORES + (size_t)MTOK * 2048 * 4 <= WS_X1S && WS_X1S + (size_t)MTOK * 1024 * 2 <= WS_EID && WS_GATE + (size_t)MTOK * 128 * 4 <= WS_END, "ws map");

constexpr int LDS_MAIN = 159744;
constexpr int MISC_OFF = LDS_MAIN;
constexpr int LDS_BYTES = LDS_MAIN + 128;

#define GAS __attribute__((address_space(1)))
#define LAS __attribute__((address_space(3)))
typedef unsigned short bf16;
typedef unsigned v4u __attribute__((ext_vector_type(4)));
typedef unsigned v2u __attribute__((ext_vector_type(2)));
typedef float f32x4 __attribute__((ext_vector_type(4)));
typedef float f32x2 __attribute__((ext_vector_type(2)));
typedef short bf16x8 __attribute__((ext_vector_type(8)));
#define LDS_WAIT() asm volatile("s_waitcnt lgkmcnt(0)" ::: "memory")
#define VM_WAIT() asm volatile("s_waitcnt vmcnt(0)" ::: "memory")
typedef __bf16 hwbf16x2 __attribute__((ext_vector_type(2)));
__device__ __forceinline__ unsigned pk2(float lo, float hi) { const f32x2 v = {lo, hi}; const hwbf16x2 b = __builtin_convertvector(v, hwbf16x2); return __builtin_bit_cast(unsigned, b); }
__device__ __forceinline__ unsigned f2bf(float f) { return pk2(f, 0.f) & 0xffffu; }
__device__ __forceinline__ float bflo(unsigned w) { return __builtin_bit_cast(float, w << 16); }
__device__ __forceinline__ float bfhi(unsigned w) { return __builtin_bit_cast(float, w & 0xffff0000u); }
__device__ __forceinline__ float bf2f(bf16 v) { return __builtin_bit_cast(float, (unsigned)v << 16); }
__device__ __forceinline__ float wave_sum(float v) {
#pragma unroll
    for (int o = 1; o < 64; o <<= 1) v += __shfl_xor(v, o);
    return v;
}
__device__ __forceinline__ float sigmoid_f(float v) { return __builtin_amdgcn_rcpf(1.0f + __builtin_amdgcn_exp2f(-1.4426950408889634f * v)); }
__device__ __forceinline__ float silu_f(float v) { return v * sigmoid_f(v); }
__device__ __forceinline__ float rsqrt_f(float v) { return __builtin_amdgcn_rsqf(v); }
__device__ __forceinline__ float gelu_erf(float v) {
    const float av = fabsf(v), t = __builtin_amdgcn_rcpf(av * 0.2316418882f + 1.0f);
    float q = t * 0.5307027145f + (-0.7265760135f); q = q * t + 0.7107068705f; q = q * t + (-0.142248368f); q = q * t + 0.127414796f; q = q * t;
    const float e = __builtin_amdgcn_exp2f((v * v) * (-0.72134752044f));
    const float m = v * (q * e);
    return v < 0.f ? m : v - m;
}
__device__ __forceinline__ float softplus_f(float v) { return fmaxf(v, 0.f) + 0.6931471805599453f * __builtin_amdgcn_logf(1.0f + __builtin_amdgcn_exp2f(-1.4426950408889634f * fabsf(v))); }
__device__ __forceinline__ void unpack8(const v4u w, float* f) { f[0] = bflo(w.x); f[1] = bfhi(w.x); f[2] = bflo(w.y); f[3] = bfhi(w.y); f[4] = bflo(w.z); f[5] = bfhi(w.z); f[6] = bflo(w.w); f[7] = bfhi(w.w); }
#define LDS_BARRIER() do { asm volatile("s_waitcnt lgkmcnt(0)" ::: "memory"); __builtin_amdgcn_s_barrier(); asm volatile("" ::: "memory"); } while (0)
__device__ __forceinline__ float row16_sum_to15(float v) {
    v += __builtin_bit_cast(float, __builtin_amdgcn_update_dpp(0, __builtin_bit_cast(int, v), 0x118, 0xf, 0xf, true));
    v += __builtin_bit_cast(float, __builtin_amdgcn_update_dpp(0, __builtin_bit_cast(int, v), 0x114, 0xf, 0xf, true));
    v += __builtin_bit_cast(float, __builtin_amdgcn_update_dpp(0, __builtin_bit_cast(int, v), 0x112, 0xf, 0xf, true));
    v += __builtin_bit_cast(float, __builtin_amdgcn_update_dpp(0, __builtin_bit_cast(int, v), 0x111, 0xf, 0xf, true));
    return v;
}
__device__ __forceinline__ float wave_sum_to63(float v) {
    v = row16_sum_to15(v);
    v += __builtin_bit_cast(float, __builtin_amdgcn_update_dpp(0, __builtin_bit_cast(int, v), 0x142, 0xa, 0xf, false));
    v += __builtin_bit_cast(float, __builtin_amdgcn_update_dpp(0, __builtin_bit_cast(int, v), 0x143, 0xc, 0xf, false));
    return v;
}
#define XB_TMO      128
#define XB_XCNT(j)  (256  + 64 * (j))
#define XB_XSUB(j)  (1280 + 64 * (j))
#define XB_XGEN(j)  (2304 + 64 * (j))
#define XB_TOP      3328
#define XB_TOPGEN   3392
#define XCD_BAR_WORDS 3456
#define XB_SPIN_CAP (1u << 18)

__device__ __forceinline__ unsigned xb_ld(unsigned* p)              { return __hip_atomic_load(p, __ATOMIC_RELAXED, __HIP_MEMORY_SCOPE_AGENT); }
__device__ __forceinline__ unsigned xb_add(unsigned* p, unsigned v) { return __hip_atomic_fetch_add(p, v, __ATOMIC_RELAXED, __HIP_MEMORY_SCOPE_AGENT); }
__device__ __forceinline__ unsigned xb_xcc_id() { return (unsigned)__builtin_amdgcn_s_getreg((3 << 11) | 20) & 0xFu; }
#define XB_SPIN(cond, bar) do { unsigned _sp = 0; while (cond) { __builtin_amdgcn_s_sleep(1); \
    if ((++_sp & 255u) == 0u) { if (xb_ld(&(bar)[XB_TMO])) break; if (_sp > XB_SPIN_CAP) { atomicAdd(&(bar)[XB_TMO], 1u); break; } } } } while (0)

struct XcdBarrier {
    unsigned* bar; unsigned x;
    volatile LAS unsigned* st;
};

__device__ __forceinline__ XcdBarrier xcd_barrier_post(unsigned* bar, volatile LAS unsigned* st) {
    XcdBarrier b; b.bar = bar; b.x = xb_xcc_id(); b.st = st;
    if (threadIdx.x == 0) (void)xb_add(&bar[XB_XCNT(b.x)], 1u);
    return b;
}
__device__ __forceinline__ void xcd_barrier_complete(unsigned* bar, unsigned x, unsigned& nloc, unsigned& nx) {
    const unsigned G = gridDim.x * gridDim.y * gridDim.z;
    unsigned sum, cnt, mine, sp = 0u;
    for (;;) {
        sum = 0u; cnt = 0u; mine = 0u;
#pragma unroll
        for (unsigned j = 0; j < 16; ++j) { const unsigned c = xb_ld(&bar[XB_XCNT(j)]); sum += c; cnt += (c > 0u) ? 1u : 0u; mine = (j == x) ? c : mine; }
        if (sum == G) break;
        __builtin_amdgcn_s_sleep(1);
        if ((++sp & 255u) == 0u) { if (xb_ld(&bar[XB_TMO])) break; if (sp > XB_SPIN_CAP) { atomicAdd(&bar[XB_TMO], 1u); break; } }
    }
    nloc = mine > 0u ? mine : 1u; nx = cnt > 0u ? cnt : 1u;
}

__device__ __forceinline__ void xcd_barrier(const XcdBarrier& b) {
    asm volatile("s_waitcnt vmcnt(0)" ::: "memory");
    __syncthreads();
    if (threadIdx.x == 0) {
        unsigned* bar = b.bar;
        __builtin_amdgcn_s_waitcnt(0);
        unsigned nloc = b.st[0], nx = b.st[1];
        if (nloc == 0u) { xcd_barrier_complete(bar, b.x, nloc, nx); b.st[0] = nloc; b.st[1] = nx; }
        const unsigned old = xb_add(&bar[XB_XSUB(b.x)], 1u);
        const unsigned gen = old / nloc;
        if (old + 1u == (gen + 1u) * nloc) {
            __builtin_amdgcn_fence(__ATOMIC_RELEASE, "agent");
            asm volatile("s_waitcnt vmcnt(0)" ::: "memory");
            const unsigned og = xb_add(&bar[XB_TOP], 1u);
            const unsigned tg = og / nx;
            if (og + 1u == (tg + 1u) * nx) xb_add(&bar[XB_TOPGEN], 1u);
            else XB_SPIN(xb_ld(&bar[XB_TOPGEN]) == tg, bar);
            __builtin_amdgcn_fence(__ATOMIC_ACQUIRE, "agent");
            xb_add(&bar[XB_XGEN(b.x)], 1u);
            asm volatile("s_waitcnt vmcnt(0)" ::: "memory");
        } else {
            XB_SPIN(xb_ld(&bar[XB_XGEN(b.x)]) == gen, bar);
            __builtin_amdgcn_fence(__ATOMIC_ACQUIRE, "agent");
            asm volatile("s_waitcnt vmcnt(0)" ::: "memory");
        }
    }
    __syncthreads();
}
struct Args { const float* in[30]; float* out; unsigned char* ws; int ph_lo, ph_hi; };
struct Frame {
    LAS unsigned char* lds;
    volatile LAS unsigned* MISC;
    int vcu, G;
    unsigned char* ws;
    const Args* a;
    float* out;
};
#define WSP(T, off) ((T*)(F.ws + (off)))

__device__ __forceinline__ void transpose_tile(const float* W, int ldw, int k0, int src_n0, bf16* WT, int K, int dst_n0, LAS float* scr, int lane, const float* kscale) {
#pragma unroll 8
    for (int i = 0; i < 32; ++i) { const int kk = 2 * i + (lane >> 5); float v = W[(size_t)(k0 + kk) * ldw + src_n0 + (lane & 31)]; if (kscale) v *= kscale[k0 + kk]; scr[kk * 33 + (lane & 31)] = v; }
    LDS_WAIT(); asm volatile("" ::: "memory");
    const int c = lane & 7;
#pragma unroll
    for (int j = 0; j < 4; ++j) { const int n = (lane >> 3) + 8 * j; const LAS float* s = scr + (8 * c) * 33 + n;
        v4u o; o.x = pk2(s[0 * 33], s[1 * 33]); o.y = pk2(s[2 * 33], s[3 * 33]); o.z = pk2(s[4 * 33], s[5 * 33]); o.w = pk2(s[6 * 33], s[7 * 33]);
        *(v4u*)(WT + (size_t)(dst_n0 + n) * K + k0 + 8 * c) = o; }
    LDS_WAIT(); asm volatile("" ::: "memory");
}
__device__ __forceinline__ void p0_phase(Frame& F) {
    const int f_tid = threadIdx.x, f_lane = f_tid & 63, f_wave = __builtin_amdgcn_readfirstlane(f_tid >> 6);
    const int gw = F.vcu * NWAVES + f_wave, NGW = F.G * NWAVES, gt = F.vcu * NTHR + f_tid, NGT = F.G * NTHR;
    {
        LAS float* sc = (LAS float*)F.lds;
        LAS float* red = (LAS float*)(F.lds + 65536);
        for (int i = f_tid; i < 16 * 1024; i += NTHR) { const int b = i >> 10, k = i & 1023; sc[k * 16 + b] = silu_f((F.a->in[1])[i]); }
        __syncthreads();
        const int ks = f_tid / 24, col = f_tid - ks * 24, j = F.vcu * 24 + col;
        if (ks < 21) {
            float acc[16];
#pragma unroll
            for (int b = 0; b < 16; ++b) acc[b] = 0.f;
            const int k0 = ks * 49, kn = (k0 + 49 <= 1024) ? 49 : (1024 - k0);
            const float* wp = (F.a->in[2]) + (size_t)k0 * 6144 + j;
#pragma unroll 1
            for (int kb = 0; kb < 49; kb += 7) {
                asm volatile("" ::: "memory");
                float wv[7];
#pragma unroll
                for (int u = 0; u < 7; ++u) wv[u] = (kb + u < kn) ? wp[(size_t)(kb + u) * 6144] : 0.f;
#pragma unroll
                for (int u = 0; u < 7; ++u) { const int kk = (kb + u < kn) ? (k0 + kb + u) : k0; const LAS f32x4* s4 = (const LAS f32x4*)(sc + kk * 16);
#pragma unroll
                    for (int q = 0; q < 4; ++q) { const f32x4 sv = s4[q]; acc[4 * q] += sv[0] * wv[u]; acc[4 * q + 1] += sv[1] * wv[u]; acc[4 * q + 2] += sv[2] * wv[u]; acc[4 * q + 3] += sv[3] * wv[u]; } }
            }
#pragma unroll
            for (int b = 0; b < 16; ++b) red[(ks * 16 + b) * 24 + col] = acc[b];
        }
        __syncthreads();
        for (int i = f_tid; i < 16 * 24; i += NTHR) { const int b = i / 24, cc = i - b * 24; float sacc = 0.f;
            for (int q = 0; q < 21; ++q) sacc += red[(q * 16 + b) * 24 + cc];
            WSP(float, WS_MOD)[b * 6144 + F.vcu * 24 + cc] = sacc + (F.a->in[3])[F.vcu * 24 + cc]; }
        __syncthreads();
    }
    {
        LAS float* scr = (LAS float*)(F.lds + f_wave * 16384);
        constexpr int I_IN = (1024 / 64) * (NPROJ / 32), I_OUT = (2048 / 64) * (1024 / 32);
        for (int it = gw; it < I_IN + I_OUT; it += NGW) {
            if (it < I_IN) { const int kb = it / (NPROJ / 32), nb = it % (NPROJ / 32); const int dn = 32 * nb, sn = dn < 3072 ? dn : dn + 16;
                transpose_tile((F.a->in[5]), INW, 64 * kb, sn, WSP(bf16, WS_WINT), 1024, dn, scr, f_lane, nullptr); }
            else { const int r = it - I_IN, kb = r / 32, nb = r % 32; const int k0 = 64 * kb;
                transpose_tile((F.a->in[23]), 1024, k0, 32 * nb, WSP(bf16, WS_WOUTT), 2048, 32 * nb, scr, f_lane, k0 < 1024 ? (F.a->in[11]) : (F.a->in[22]) - 1024); }
        }
    }
    for (int i = gt; i < 16 * 1024; i += NGT) { const int h = i >> 10, k = i & 1023; WSP(float, WS_WDT)[i] = (F.a->in[5])[(size_t)k * INW + 3072 + h]; }
    for (int task = gw; task < 2048; task += NGW) {
        const int nt = task >> 4, ks = task & 15, n0 = 16 * nt, hc = n0 >> 7, k0 = 64 * ks;
        const int li = f_lane & 15, lq = f_lane >> 4;
        f32x4 acc[4];
#pragma unroll
        for (int s = 0; s < 4; ++s) acc[s] = (f32x4){0.f, 0.f, 0.f, 0.f};
        const float* ap = (F.a->in[26]) + (size_t)(n0 + li) * 128 + 4 * lq;
        const float* bp = (F.a->in[25]) + (size_t)(k0 + li) * 2048 + hc * 128 + 4 * lq;
#pragma unroll
        for (int q = 0; q < 8; ++q) { const f32x4 a = *(const f32x4*)(ap + 16 * q);
#pragma unroll
            for (int s = 0; s < 4; ++s) { const f32x4 b = *(const f32x4*)(bp + (size_t)(16 * s) * 2048 + 16 * q);
#pragma unroll
                for (int jj = 0; jj < 4; ++jj) acc[s] = __builtin_amdgcn_mfma_f32_16x16x4f32(a[jj], b[jj], acc[s], 0, 0, 0); } }
        bf16* o = WSP(bf16, WS_WQKT);
#pragma unroll
        for (int s = 0; s < 4; ++s)
#pragma unroll
            for (int r = 0; r < 4; ++r) o[(size_t)(n0 + 4 * lq + r) * 1024 + k0 + 16 * s + li] = (bf16)f2bf(acc[s][r]);
    }
    for (int rw = gw; rw < 2 * 16384; rw += 2 * NGW) {
        f32x4 v[2][4]; float mx[2];
#pragma unroll
        for (int u = 0; u < 2; ++u) { const int r = rw + u * NGW; const int tb = r >= 16384, e = tb ? r - 16384 : r; const float* src = (tb ? (F.a->in[28]) : (F.a->in[27])) + (size_t)e * 1024 + 16 * f_lane;
#pragma unroll
            for (int q = 0; q < 4; ++q) v[u][q] = *(const f32x4*)(src + 4 * q); }
#pragma unroll
        for (int u = 0; u < 2; ++u) { float m = 0.f;
#pragma unroll
            for (int q = 0; q < 4; ++q) m = fmaxf(m, fmaxf(fmaxf(fabsf(v[u][q][0]), fabsf(v[u][q][1])), fmaxf(fabsf(v[u][q][2]), fabsf(v[u][q][3]))));
#pragma unroll
            for (int o = 1; o < 64; o <<= 1) m = fmaxf(m, __shfl_xor(m, o));
            mx[u] = fmaxf(m, 1e-30f); }
#pragma unroll
        for (int u = 0; u < 2; ++u) { const int r = rw + u * NGW; const int tb = r >= 16384, e = tb ? r - 16384 : r; const float sc = 224.0f / mx[u];
            v4u w;
#pragma unroll
            for (int q = 0; q < 4; ++q) { int pk = 0; pk = __builtin_amdgcn_cvt_pk_fp8_f32(v[u][q][0] * sc, v[u][q][1] * sc, pk, false); pk = __builtin_amdgcn_cvt_pk_fp8_f32(v[u][q][2] * sc, v[u][q][3] * sc, pk, true); w[q] = (unsigned)pk; }
            *(v4u*)(F.ws + (tb ? WS_EV : WS_EU) + (size_t)e * 1024 + 16 * f_lane) = w;
            if (f_lane == 0) WSP(float, tb ? WS_EVS : WS_EUS)[e] = mx[u] * (1.0f / 224.0f); }
    }
    for (int i = gt; i < S5G * S5P; i += NGT) {
        const float lr = (F.a->in[12])[i], li = (F.a->in[13])[i], dt = expf((F.a->in[14])[i >> 6]);
        const float mag = expf(lr * dt); float sn, cs; sincosf(li * dt, &sn, &cs);
        const float lbr = mag * cs, lbi = mag * sn, den = lr * lr + li * li;
        const float cfr = ((lbr - 1.0f) * lr + lbi * li) / den, cfi = (lbi * lr - (lbr - 1.0f) * li) / den;
        WSP(float, WS_S5LB)[2 * i] = lbr; WSP(float, WS_S5LB)[2 * i + 1] = lbi;
        for (int hh = 0; hh < 16; ++hh) { const float br = (F.a->in[15])[i * 16 + hh], bi = (F.a->in[16])[i * 16 + hh];
            WSP(float, WS_S5BB)[i * 32 + hh] = cfr * br - cfi * bi; WSP(float, WS_S5BB)[i * 32 + 16 + hh] = cfr * bi + cfi * br; }
    }
    for (int i = gt; i < MTOK; i += NGT) WSP(float, WS_ROWSTAT)[i] = 0.f;
}

__device__ __forceinline__ void p1_phase(Frame& F) {
    const int f_tid = threadIdx.x, f_lane = f_tid & 63, f_wave = __builtin_amdgcn_readfirstlane(f_tid >> 6);
    const int gw = F.vcu * NWAVES + f_wave;
    LAS float* wdt = (LAS float*)F.lds;
    for (int i = f_tid; i < 16 * 1024 / 4; i += NTHR) ((LAS f32x4*)wdt)[i] = ((const f32x4*)WSP(float, WS_WDT))[i];
    __syncthreads();
    const int lane = f_lane;
    for (int wq = gw; wq < MTOK / 16; wq += F.G * NWAVES) {
        const int b = wq >> 7; const float* mb = WSP(float, WS_MOD) + (size_t)b * 6144;
        f32x4 Gv[4], Sv[4];
#pragma unroll
        for (int j = 0; j < 4; ++j) { const int k = 4 * lane + 256 * j; const f32x4 g = *(const f32x4*)((F.a->in[4]) + k), sc = *(const f32x4*)(mb + 1024 + k); Gv[j] = g * (sc + 1.0f); Sv[j] = *(const f32x4*)(mb + k); }
        f32x4 nx[4];
#pragma unroll
        for (int j = 0; j < 4; ++j) nx[j] = *(const f32x4*)((F.a->in[0]) + (size_t)wq * 16 * 1024 + 4 * lane + 256 * j);
        for (int tt = 0; tt < 16; ++tt) {
            asm volatile("" ::: "memory");
            const size_t t = (size_t)wq * 16 + tt; const float* xr = (F.a->in[0]) + t * 1024;
            f32x4 v[4]; float ss = 0.f;
#pragma unroll
            for (int j = 0; j < 4; ++j) { v[j] = nx[j]; ss += (v[j][0] * v[j][0] + v[j][1] * v[j][1]) + (v[j][2] * v[j][2] + v[j][3] * v[j][3]); }
            if (tt < 15) {
#pragma unroll
                for (int j = 0; j < 4; ++j) nx[j] = *(const f32x4*)(xr + 1024 + 4 * lane + 256 * j); }
            const float rstd = rsqrt_f(wave_sum(ss) * (1.0f / 1024.0f) + EPSF);
            bf16* hr = WSP(bf16, WS_H1) + t * 1024;
#pragma unroll
            for (int j = 0; j < 4; ++j) { v[j] = v[j] * rstd * Gv[j] + Sv[j]; v2u w; w.x = pk2(v[j][0], v[j][1]); w.y = pk2(v[j][2], v[j][3]); *(v2u*)(hr + 4 * lane + 256 * j) = w; }
            float d[16];
#pragma unroll
            for (int h = 0; h < 16; ++h) { float a = 0.f;
#pragma unroll
                for (int j = 0; j < 4; ++j) { const f32x4 w = *(const LAS f32x4*)(wdt + h * 1024 + 4 * lane + 256 * j); a += (v[j][0] * w[0] + v[j][1] * w[1]) + (v[j][2] * w[2] + v[j][3] * w[3]); }
                d[h] = a; }
            float e8[8], e4[4], e2[2], e1;
#pragma unroll
            for (int i = 0; i < 8; ++i) { const bool up = lane & 32; const float snd = up ? d[i] : d[i + 8]; const float rcv = __shfl_xor(snd, 32); e8[i] = (up ? d[i + 8] : d[i]) + rcv; }
#pragma unroll
            for (int i = 0; i < 4; ++i) { const bool up = lane & 16; const float snd = up ? e8[i] : e8[i + 4]; const float rcv = __shfl_xor(snd, 16); e4[i] = (up ? e8[i + 4] : e8[i]) + rcv; }
#pragma unroll
            for (int i = 0; i < 2; ++i) { const bool up = lane & 8; const float snd = up ? e4[i] : e4[i + 2]; const float rcv = __shfl_xor(snd, 8); e2[i] = (up ? e4[i + 2] : e4[i]) + rcv; }
            { const bool up = lane & 4; const float snd = up ? e2[0] : e2[1]; const float rcv = __shfl_xor(snd, 4); e1 = (up ? e2[1] : e2[0]) + rcv; }
            e1 += __shfl_xor(e1, 2); e1 += __shfl_xor(e1, 1);
            const int head = ((lane >> 5) & 1) * 8 + ((lane >> 4) & 1) * 4 + ((lane >> 3) & 1) * 2 + ((lane >> 2) & 1);
            if ((lane & 3) == 0) WSP(float, WS_DTRAW)[t * 16 + head] = e1;
        }
    }
    for (int n = gw; n < 2048; n += F.G * NWAVES) {
        const bf16* wr = WSP(bf16, WS_WQKT) + (size_t)n * 1024 + 16 * lane;
        const v4u w0 = *(const v4u*)wr, w1 = *(const v4u*)(wr + 8);
        float wv[16]; wv[0] = bflo(w0.x); wv[1] = bfhi(w0.x); wv[2] = bflo(w0.y); wv[3] = bfhi(w0.y); wv[4] = bflo(w0.z); wv[5] = bfhi(w0.z); wv[6] = bflo(w0.w); wv[7] = bfhi(w0.w);
        wv[8] = bflo(w1.x); wv[9] = bfhi(w1.x); wv[10] = bflo(w1.y); wv[11] = bfhi(w1.y); wv[12] = bflo(w1.z); wv[13] = bfhi(w1.z); wv[14] = bflo(w1.w); wv[15] = bfhi(w1.w);
        for (int b = 0; b < 16; ++b) { const float* sp = WSP(float, WS_MOD) + (size_t)b * 6144 + 3072 + 16 * lane; float a = 0.f;
#pragma unroll
            for (int q = 0; q < 4; ++q) { const f32x4 s = *(const f32x4*)(sp + 4 * q); a += (s[0] * wv[4 * q] + s[1] * wv[4 * q + 1]) + (s[2] * wv[4 * q + 2] + s[3] * wv[4 * q + 3]); }
            a = wave_sum(a); if (lane == 0) WSP(float, WS_SB)[b * 2048 + n] = a; }
    }
}
__device__ __forceinline__ void p3_ssd_naive(Frame& F) {
    const int f_tid = threadIdx.x;
    const bf16* proj = WSP(bf16, WS_PROJ);
    LAS float* buf = (LAS float*)F.lds;
    LAS float* yl = (LAS float*)(F.lds + 4096);
    for (int item = F.vcu; item < NB * NGRP; item += F.G) {
        const int b = item >> 2, g = item & 3, tid = f_tid;
        const int ch = tid < 256 ? g * 256 + tid : (tid < 384 ? 1024 + g * 128 + (tid - 256) : 1536 + g * 128 + (tid - 384));
        const float w0 = (F.a->in[6])[0 * 2048 + ch], w1 = (F.a->in[6])[1 * 2048 + ch], w2 = (F.a->in[6])[2 * 2048 + ch], w3 = (F.a->in[6])[3 * 2048 + ch], cb = (F.a->in[7])[ch];
        float r0 = 0.f, r1 = 0.f, r2 = 0.f;
        const int r = tid >> 7, nh = (tid >> 6) & 1, p = tid & 63, h = g * 4 + r;
        float st[64];
#pragma unroll
        for (int n = 0; n < 64; ++n) st[n] = 0.f;
        const float A = -__expf((F.a->in[9])[h]), Dh = (F.a->in[10])[h], dtb = (F.a->in[8])[h];
        for (int t = 0; t < SEQ; ++t) {
            const size_t row = (size_t)b * SEQ + t;
            const float r3 = bf2f(proj[row * NPROJ + 1024 + ch]);
            const float cv = silu_f(cb + r0 * w0 + r1 * w1 + r2 * w2 + r3 * w3);
            r0 = r1; r1 = r2; r2 = r3;
            LAS float* cur = buf + (t & 1) * 512; LAS float* ycur = yl + (t & 1) * 512;
            cur[tid] = cv;
            __syncthreads();
            const float dt = softplus_f(WSP(float, WS_DTRAW)[row * 16 + h] + dtb);
            const float dA = __expf(dt * A), xv = cur[r * 64 + p], xd = xv * dt;
            float y = 0.f;
#pragma unroll
            for (int n4 = 0; n4 < 16; ++n4) { const f32x4 Bv = *(const LAS f32x4*)(cur + 256 + 64 * nh + 4 * n4), Cv = *(const LAS f32x4*)(cur + 384 + 64 * nh + 4 * n4);
#pragma unroll
                for (int q = 0; q < 4; ++q) { st[4 * n4 + q] = st[4 * n4 + q] * dA + xd * Bv[q]; y += Cv[q] * st[4 * n4 + q]; } }
            ycur[tid] = y;
            __syncthreads();
            if (nh == 0) {
                y = ycur[tid] + ycur[tid + 64] + Dh * xv;
                const float zv = bf2f(proj[row * NPROJ + h * 64 + p]);
                y *= silu_f(zv);
                WSP(bf16, WS_Y)[row * 2048 + h * 64 + p] = (bf16)f2bf(y);
                const float ss = wave_sum(y * y);
                if (p == 0) WSP(float, WS_STSSD)[row * 16 + h] = ss;
            }
        }
        __syncthreads();
    }
}
__device__ __forceinline__ void p3_s5_naive(Frame& F) {
    const int f_tid = threadIdx.x, f_lane = f_tid & 63, f_wave = __builtin_amdgcn_readfirstlane(f_tid >> 6);
    const bf16* proj = WSP(bf16, WS_PROJ);
    LAS float* xt = (LAS float*)(F.lds + 4096 + f_wave * 19200);
    LAS float* vt = (LAS float*)(F.lds + 4096 + f_wave * 19200 + 16896) + (f_lane & 31) * 17;
    const int lane = f_lane;
    for (int item = F.vcu * NWAVES + f_wave; item < NB * S5G; item += F.G * NWAVES) {
        const int b = item >> 6, g = item & 63, p = lane;
        const float lbr = WSP(float, WS_S5LB)[(g * 64 + p) * 2], lbi = WSP(float, WS_S5LB)[(g * 64 + p) * 2 + 1];
        float bbr[16], bbi[16];
#pragma unroll
        for (int q = 0; q < 4; ++q) { const f32x4 a = *(const f32x4*)(WSP(float, WS_S5BB) + (g * 64 + p) * 32 + 4 * q), c = *(const f32x4*)(WSP(float, WS_S5BB) + (g * 64 + p) * 32 + 16 + 4 * q);
#pragma unroll
            for (int e = 0; e < 4; ++e) { bbr[4 * q + e] = a[e]; bbi[4 * q + e] = c[e]; } }
        float xr = 0.f, xi = 0.f;
        for (int t0 = 0; t0 < SEQ; t0 += 32) {
            for (int tt = 0; tt < 32; ++tt) {
                const bf16* up = proj + ((size_t)b * SEQ + t0 + tt) * NPROJ + 3072 + g * 16;
                const v4u u0 = *(const v4u*)up, u1 = *(const v4u*)(up + 8);
                float uv[16]; uv[0] = bflo(u0.x); uv[1] = bfhi(u0.x); uv[2] = bflo(u0.y); uv[3] = bfhi(u0.y); uv[4] = bflo(u0.z); uv[5] = bfhi(u0.z); uv[6] = bflo(u0.w); uv[7] = bfhi(u0.w);
                uv[8] = bflo(u1.x); uv[9] = bfhi(u1.x); uv[10] = bflo(u1.y); uv[11] = bfhi(u1.y); uv[12] = bflo(u1.z); uv[13] = bfhi(u1.z); uv[14] = bflo(u1.w); uv[15] = bfhi(u1.w);
                float br = 0.f, bi = 0.f;
#pragma unroll
                for (int hh = 0; hh < 16; ++hh) { br += uv[hh] * bbr[hh]; bi += uv[hh] * bbi[hh]; }
                const float nr = lbr * xr - lbi * xi + br, ni = lbr * xi + lbi * xr + bi; xr = nr; xi = ni;
                xt[(tt * 66 + p) * 2] = xr; xt[(tt * 66 + p) * 2 + 1] = xi;
            }
            LDS_WAIT(); asm volatile("" ::: "memory");
            if (lane < 32) {
                const int tt = lane; const size_t row = (size_t)b * SEQ + t0 + tt;
                const bf16* up = proj + row * NPROJ + 3072 + g * 16;
#pragma unroll 1
                for (int hh = 0; hh < 16; ++hh) { float y = 0.f; const float* cr = (F.a->in[17]) + (g * 16 + hh) * 64; const float* ci = (F.a->in[18]) + (g * 16 + hh) * 64;
#pragma unroll 8
                    for (int pp = 0; pp < 64; ++pp) y += xt[(tt * 66 + pp) * 2] * cr[pp] - xt[(tt * 66 + pp) * 2 + 1] * ci[pp];
                    vt[hh] = gelu_erf(y + (F.a->in[19])[g * 16 + hh] * bf2f(up[hh])); }
                float ss = 0.f; unsigned ow[8];
#pragma unroll 1
                for (int k2 = 0; k2 < 8; ++k2) { float o2[2];
#pragma unroll
                    for (int e = 0; e < 2; ++e) { const int k = 2 * k2 + e; float gt = (F.a->in[21])[g * 16 + k];
#pragma unroll
                        for (int hh = 0; hh < 16; ++hh) gt += vt[hh] * (F.a->in[20])[(g * 16 + hh) * 16 + k];
                        o2[e] = vt[k] * sigmoid_f(gt); ss += o2[e] * o2[e]; }
                    const unsigned pw = pk2(o2[0], o2[1]);
#pragma unroll
                    for (int q = 0; q < 8; ++q) ow[q] = (q == k2) ? pw : ow[q]; }
                bf16* yo = WSP(bf16, WS_Y) + row * 2048 + 1024 + g * 16;
                *(v4u*)yo = (v4u){ow[0], ow[1], ow[2], ow[3]}; *(v4u*)(yo + 8) = (v4u){ow[4], ow[5], ow[6], ow[7]};
                WSP(float, WS_STS5)[row * NS5PART + g] = ss;
            }
            LDS_WAIT(); asm volatile("" ::: "memory");
        }
    }
}
__device__ __forceinline__ void p3c_normalize(Frame& F) {
    const int f_tid = threadIdx.x, f_lane = f_tid & 63, f_wave = __builtin_amdgcn_readfirstlane(f_tid >> 6);
    const int lane = f_lane;
    for (int t = F.vcu * NWAVES + f_wave; t < MTOK; t += F.G * NWAVES) {
        const float* sg = WSP(float, WS_STSSD) + (size_t)t * 16; const float* s5 = WSP(float, WS_STS5) + (size_t)t * NS5PART;
        float rg[4];
#pragma unroll
        for (int g = 0; g < 4; ++g) rg[g] = rsqrt_f((sg[4 * g] + sg[4 * g + 1] + sg[4 * g + 2] + sg[4 * g + 3]) * (1.0f / 256.0f) + EPSF);
        float s5s = (NS5PART == 64) ? s5[lane] : (lane < NS5PART ? s5[lane] : 0.f); s5s = wave_sum(s5s);
        const float r5 = rsqrt_f(s5s * (1.0f / 1024.0f) + EPSF);
        bf16* yr = WSP(bf16, WS_Y) + (size_t)t * 2048;
#pragma unroll
        for (int j = 0; j < 4; ++j) { const int e0 = 512 * j + 8 * lane; const float sc = j >= 2 ? r5 : (j == 0 ? (lane < 32 ? rg[0] : rg[1]) : (lane < 32 ? rg[2] : rg[3]));
            v4u w = *(v4u*)(yr + e0);
            w.x = pk2(bflo(w.x) * sc, bfhi(w.x) * sc); w.y = pk2(bflo(w.y) * sc, bfhi(w.y) * sc); w.z = pk2(bflo(w.z) * sc, bfhi(w.z) * sc); w.w = pk2(bflo(w.w) * sc, bfhi(w.w) * sc);
            *(v4u*)(yr + e0) = w; }
    }
}
constexpr int SSD_CS = 0, SSD_BS = 34816, SSD_BWT = 69632, SSD_XDT = 104448, SSD_PREV = 121856, SSD_XS = 139264, SSD_CSF = 157696, SSD_DTF = 158208, SSD_PITCH = 272, SSD_XPITCH = 144;
static_assert(SSD_DTF + 512 <= LDS_MAIN, "SSD LDS map");
__device__ __forceinline__ bf16x8 lds_frag(LAS unsigned char* base, int row, int kbyte) { return *(const LAS bf16x8*)(base + row * SSD_PITCH + kbyte); }
__device__ __forceinline__ void p3_ssd(Frame& F) {
    const int tid = threadIdx.x, lane = tid & 63, w = __builtin_amdgcn_readfirstlane(tid >> 6);
    const int li = lane & 15, lq = lane >> 4;
    LAS unsigned char* L = F.lds;
    LAS float* csf = (LAS float*)(L + SSD_CSF); LAS float* dtf = (LAS float*)(L + SSD_DTF);
    const bf16* proj = WSP(bf16, WS_PROJ);
    for (int item = F.vcu; item < NB * NHEADS; item += F.G) {
        const int b = item >> 4, h = item & 15, g = h >> 2;
        const float A = -__expf((F.a->in[9])[h]), Dh = (F.a->in[10])[h], dtb = (F.a->in[8])[h];
        const int pbs = w >> 1, nb0 = 4 * (w & 1);
        f32x4 st[4];
#pragma unroll
        for (int j = 0; j < 4; ++j) st[j] = (f32x4){0.f, 0.f, 0.f, 0.f};
        for (int i = tid; i < 17408 / 16; i += NTHR) ((LAS v4u*)(L + SSD_PREV))[i] = (v4u){0u, 0u, 0u, 0u};
        for (int c = 0; c < SEQ / CHUNK; ++c) {
            const size_t row0 = (size_t)b * SEQ + (size_t)c * CHUNK;
            if (w == 0) {
                const float d0 = softplus_f(WSP(float, WS_DTRAW)[(row0 + 2 * lane) * 16 + h] + dtb), d1 = softplus_f(WSP(float, WS_DTRAW)[(row0 + 2 * lane + 1) * 16 + h] + dtb);
                const float a0 = d0 * A, a1 = d1 * A; float s = a0 + a1;
#pragma unroll
                for (int o = 1; o < 64; o <<= 1) { const float t = __shfl_up(s, o); if (lane >= o) s += t; }
                dtf[2 * lane] = d0; dtf[2 * lane + 1] = d1; csf[2 * lane] = s - a1; csf[2 * lane + 1] = s;
            }
            __syncthreads();
            const float cs_end = csf[127];
            for (int it = tid; it < 1280; it += NTHR) {
                const int o = it % 40, rg = it / 40, l0 = 4 * rg;
                const int xcol = o < 8 ? h * 64 + 8 * o : (o < 24 ? 1024 + g * 128 + 8 * (o - 8) : 1536 + g * 128 + 8 * (o - 24));
                float raw[7][8];
#pragma unroll
                for (int k = 0; k < 7; ++k) { const int l = l0 - 3 + k; const bool ok = (c > 0) || (l >= 0);
                    v4u wv = (v4u){0u, 0u, 0u, 0u}; if (ok) wv = *(const v4u*)(proj + (size_t)((long)row0 + l) * NPROJ + 1024 + xcol);
                    raw[k][0] = bflo(wv.x); raw[k][1] = bfhi(wv.x); raw[k][2] = bflo(wv.y); raw[k][3] = bfhi(wv.y); raw[k][4] = bflo(wv.z); raw[k][5] = bfhi(wv.z); raw[k][6] = bflo(wv.w); raw[k][7] = bfhi(wv.w); }
                float cw[4][8], cbv[8];
#pragma unroll
                for (int k = 0; k < 4; ++k) { const f32x4 w0 = *(const f32x4*)((F.a->in[6]) + k * 2048 + xcol), w1 = *(const f32x4*)((F.a->in[6]) + k * 2048 + xcol + 4);
#pragma unroll
                    for (int e = 0; e < 4; ++e) { cw[k][e] = w0[e]; cw[k][4 + e] = w1[e]; } }
                { const f32x4 b0 = *(const f32x4*)((F.a->in[7]) + xcol), b1 = *(const f32x4*)((F.a->in[7]) + xcol + 4);
#pragma unroll
                    for (int e = 0; e < 4; ++e) { cbv[e] = b0[e]; cbv[4 + e] = b1[e]; } }
                float v[4][8];
#pragma unroll
                for (int r = 0; r < 4; ++r)
#pragma unroll
                    for (int i = 0; i < 8; ++i) v[r][i] = silu_f(cbv[i] + raw[r][i] * cw[0][i] + raw[r + 1][i] * cw[1][i] + raw[r + 2][i] * cw[2][i] + raw[r + 3][i] * cw[3][i]);
                if (o < 8) {
                    const int p0 = 8 * o;
#pragma unroll
                    for (int r = 0; r < 4; ++r) *(LAS v4u*)(L + SSD_XS + (l0 + r) * SSD_XPITCH + p0 * 2) = (v4u){pk2(v[r][0], v[r][1]), pk2(v[r][2], v[r][3]), pk2(v[r][4], v[r][5]), pk2(v[r][6], v[r][7])};
                    const float t0 = dtf[l0], t1 = dtf[l0 + 1], t2 = dtf[l0 + 2], t3 = dtf[l0 + 3];
#pragma unroll
                    for (int i = 0; i < 8; ++i) *(LAS v2u*)(L + SSD_XDT + (p0 + i) * SSD_PITCH + l0 * 2) = (v2u){pk2(v[0][i] * t0, v[1][i] * t1), pk2(v[2][i] * t2, v[3][i] * t3)};
                } else if (o < 24) {
                    const int n0 = 8 * (o - 8);
#pragma unroll
                    for (int r = 0; r < 4; ++r) *(LAS v4u*)(L + SSD_BS + (l0 + r) * SSD_PITCH + n0 * 2) = (v4u){pk2(v[r][0], v[r][1]), pk2(v[r][2], v[r][3]), pk2(v[r][4], v[r][5]), pk2(v[r][6], v[r][7])};
                    const float t0 = __expf(cs_end - csf[l0]), t1 = __expf(cs_end - csf[l0 + 1]), t2 = __expf(cs_end - csf[l0 + 2]), t3 = __expf(cs_end - csf[l0 + 3]);
#pragma unroll
                    for (int i = 0; i < 8; ++i) *(LAS v2u*)(L + SSD_BWT + (n0 + i) * SSD_PITCH + l0 * 2) = (v2u){pk2(v[0][i] * t0, v[1][i] * t1), pk2(v[2][i] * t2, v[3][i] * t3)};
                } else {
                    const int n0 = 8 * (o - 24);
#pragma unroll
                    for (int r = 0; r < 4; ++r) *(LAS v4u*)(L + SSD_CS + (l0 + r) * SSD_PITCH + n0 * 2) = (v4u){pk2(v[r][0], v[r][1]), pk2(v[r][2], v[r][3]), pk2(v[r][4], v[r][5]), pk2(v[r][6], v[r][7])};
                }
            }
            __syncthreads();
            bf16x8 ca[4];
#pragma unroll
            for (int ks = 0; ks < 4; ++ks) ca[ks] = lds_frag(L + SSD_CS, 16 * w + li, 64 * ks + 16 * lq);
            f32x4 cb[8];
#pragma unroll
            for (int sb = 0; sb < 8; ++sb) { cb[sb] = (f32x4){0.f, 0.f, 0.f, 0.f};
                if (sb <= w) {
#pragma unroll
                    for (int ks = 0; ks < 4; ++ks) cb[sb] = __builtin_amdgcn_mfma_f32_16x16x32_bf16(ca[ks], lds_frag(L + SSD_BS, 16 * sb + li, 64 * ks + 16 * lq), cb[sb], 0, 0, 0); } }
            float csl[4];
#pragma unroll
            for (int r = 0; r < 4; ++r) csl[r] = csf[16 * w + 4 * lq + r];
#pragma unroll
            for (int sb = 0; sb < 8; ++sb) if (sb <= w) { const int s = 16 * sb + li; const float css = csf[s];
#pragma unroll
                for (int r = 0; r < 4; ++r) { const int l = 16 * w + 4 * lq + r; cb[sb][r] = (s <= l) ? cb[sb][r] * __expf(csl[r] - css) : 0.f; } }
            __syncthreads();
#pragma unroll
            for (int sb = 0; sb < 8; ++sb) if (sb <= (w | 1)) {
#pragma unroll
                for (int r = 0; r < 4; ++r) *(LAS unsigned short*)(L + SSD_BS + (16 * w + 4 * lq + r) * SSD_PITCH + (16 * sb + li) * 2) = (unsigned short)f2bf(cb[sb][r]); }
            LDS_WAIT(); asm volatile("" ::: "memory");
            f32x4 yd[4], yo[4];
#pragma unroll
            for (int pb = 0; pb < 4; ++pb) { yd[pb] = (f32x4){0.f, 0.f, 0.f, 0.f}; yo[pb] = (f32x4){0.f, 0.f, 0.f, 0.f}; }
#pragma unroll
            for (int ks = 0; ks < 4; ++ks) if (ks <= (w >> 1)) { const bf16x8 gf = lds_frag(L + SSD_BS, 16 * w + li, 64 * ks + 16 * lq);
#pragma unroll
                for (int pb = 0; pb < 4; ++pb) yd[pb] = __builtin_amdgcn_mfma_f32_16x16x32_bf16(gf, lds_frag(L + SSD_XDT, 16 * pb + li, 64 * ks + 16 * lq), yd[pb], 0, 0, 0); }
#pragma unroll
            for (int ks = 0; ks < 4; ++ks)
#pragma unroll
                for (int pb = 0; pb < 4; ++pb) yo[pb] = __builtin_amdgcn_mfma_f32_16x16x32_bf16(ca[ks], lds_frag(L + SSD_PREV, 16 * pb + li, 64 * ks + 16 * lq), yo[pb], 0, 0, 0);
#pragma unroll
            for (int r = 0; r < 4; ++r) { const float e = __expf(csl[r]);
#pragma unroll
                for (int pb = 0; pb < 4; ++pb) *(LAS float*)(L + SSD_BS + (16 * w + 4 * lq + r) * SSD_PITCH + (16 * pb + li) * 4) = yd[pb][r] + e * yo[pb][r]; }
            __syncthreads();
            { const float dec = __expf(cs_end);
#pragma unroll
              for (int j = 0; j < 4; ++j) st[j] = st[j] * dec;
#pragma unroll
              for (int ks = 0; ks < 4; ++ks) { const bf16x8 xf = lds_frag(L + SSD_XDT, 16 * pbs + li, 64 * ks + 16 * lq);
#pragma unroll
                  for (int j = 0; j < 4; ++j) st[j] = __builtin_amdgcn_mfma_f32_16x16x32_bf16(xf, lds_frag(L + SSD_BWT, 16 * (nb0 + j) + li, 64 * ks + 16 * lq), st[j], 0, 0, 0); }
#pragma unroll
              for (int j = 0; j < 4; ++j)
#pragma unroll
                  for (int r = 0; r < 4; ++r) *(LAS unsigned short*)(L + SSD_PREV + (16 * pbs + 4 * lq + r) * SSD_PITCH + (16 * (nb0 + j) + li) * 2) = (unsigned short)f2bf(st[j][r]); }
#pragma unroll
            for (int k = 0; k < 2; ++k) { const int it = tid + 512 * k, l = it >> 3, o = it & 7; const size_t row = row0 + l;
                const f32x4 y0 = *(const LAS f32x4*)(L + SSD_BS + l * SSD_PITCH + 32 * o), y1 = *(const LAS f32x4*)(L + SSD_BS + l * SSD_PITCH + 32 * o + 16);
                const v4u xw = *(const LAS v4u*)(L + SSD_XS + l * SSD_XPITCH + 16 * o); const v4u zw = *(const v4u*)(proj + row * NPROJ + h * 64 + 8 * o);
                float xv[8], zv[8], yv[8]; unpack8(xw, xv); unpack8(zw, zv);
                float ss = 0.f;
#pragma unroll
                for (int e = 0; e < 8; ++e) { const float yy = (e < 4 ? y0[e] : y1[e - 4]) + Dh * xv[e]; yv[e] = yy * silu_f(zv[e]); ss += yv[e] * yv[e]; }
                ss += __shfl_xor(ss, 1); ss += __shfl_xor(ss, 2); ss += __shfl_xor(ss, 4);
                if (o == 0) WSP(float, WS_STSSD)[row * 16 + h] = ss;
                *(v4u*)(WSP(bf16, WS_Y) + row * 2048 + h * 64 + 8 * o) = (v4u){pk2(yv[0], yv[1]), pk2(yv[2], yv[3]), pk2(yv[4], yv[5]), pk2(yv[6], yv[7])}; }
            __syncthreads();
        }
    }
}
__device__ __forceinline__ void p3pre_conv(Frame& F) {
    const int tid = threadIdx.x;
    const bf16* proj = WSP(bf16, WS_PROJ); bf16* xo = (bf16*)F.out;
    for (int item = F.vcu * NTHR + tid; item < (MTOK / 16) * 256; item += F.G * NTHR) {
        const int oc = item & 255, run = item >> 8; const int t0 = run * 16, ch = 8 * oc;
        const bool halo = (t0 & (SEQ - 1)) != 0;
        v4u rw[19];
#pragma unroll
        for (int k = 0; k < 19; ++k) { rw[k] = (v4u){0u, 0u, 0u, 0u}; if (k >= 3 || halo) rw[k] = *(const v4u*)(proj + (size_t)(t0 - 3 + k) * NPROJ + 1024 + ch); }
        float cw[4][8], cbv[8];
#pragma unroll
        for (int k = 0; k < 4; ++k) { const f32x4 w0 = *(const f32x4*)((F.a->in[6]) + k * 2048 + ch), w1 = *(const f32x4*)((F.a->in[6]) + k * 2048 + ch + 4);
#pragma unroll
            for (int e = 0; e < 4; ++e) { cw[k][e] = w0[e]; cw[k][4 + e] = w1[e]; } }
        { const f32x4 b0 = *(const f32x4*)((F.a->in[7]) + ch), b1 = *(const f32x4*)((F.a->in[7]) + ch + 4);
#pragma unroll
            for (int e = 0; e < 4; ++e) { cbv[e] = b0[e]; cbv[4 + e] = b1[e]; } }
        float r0[8], r1[8], r2[8];
        unpack8(rw[0], r0); unpack8(rw[1], r1); unpack8(rw[2], r2);
#pragma unroll
        for (int tt = 0; tt < 16; ++tt) {
            float r3[8]; unpack8(rw[3 + tt], r3);
            float v[8];
#pragma unroll
            for (int i = 0; i < 8; ++i) { v[i] = silu_f(cbv[i] + r0[i] * cw[0][i] + r1[i] * cw[1][i] + r2[i] * cw[2][i] + r3[i] * cw[3][i]); r0[i] = r1[i]; r1[i] = r2[i]; r2[i] = r3[i]; }
            *(v4u*)(xo + (size_t)(t0 + tt) * 2048 + ch) = (v4u){pk2(v[0], v[1]), pk2(v[2], v[3]), pk2(v[4], v[5]), pk2(v[6], v[7])};
        }
    }
}
struct SsdPre { v4u xr[4], br[4], cr[4]; float d0, d1; };
__device__ __forceinline__ void ssd_prefetch(SsdPre& P, const char* xcb, const float* dtr, unsigned voB, unsigned voX, int tid, int lane, int w) {
#pragma unroll
    for (int r = 0; r < 4; ++r) { P.br[r] = *(const v4u*)(xcb + (voB + r * 4096u)); P.cr[r] = *(const v4u*)(xcb + (voB + 1024u + r * 4096u)); }
    if (tid < 256) {
#pragma unroll
        for (int r = 0; r < 4; ++r) P.xr[r] = *(const v4u*)(xcb + (voX + r * 4096u)); }
    if (w == 0) { P.d0 = dtr[lane * 32]; P.d1 = dtr[lane * 32 + 16]; }
}
__device__ __forceinline__ void p3_ssd2(Frame& F) {
    const int tid = threadIdx.x, lane = tid & 63, w = __builtin_amdgcn_readfirstlane(tid >> 6);
    const int li = lane & 15, lq = lane >> 4;
    LAS unsigned char* L = F.lds;
    LAS float* csf = (LAS float*)(L + SSD_CSF); LAS float* dtf = (LAS float*)(L + SSD_DTF);
    const bf16* proj = WSP(bf16, WS_PROJ); const bf16* xc = (const bf16*)F.out; const float* dtraw = WSP(float, WS_DTRAW);
    for (int item = F.vcu; item < NB * NHEADS; item += F.G) {
        const int b = item >> 4, h = item & 15, g = h >> 2;
        const float A = -__expf((F.a->in[9])[h]), Dh = (F.a->in[10])[h], dtb = (F.a->in[8])[h];
        const int pbs = w >> 1, nb0 = 4 * (w & 1);
        f32x4 st[4];
#pragma unroll
        for (int j = 0; j < 4; ++j) st[j] = (f32x4){0.f, 0.f, 0.f, 0.f};
        __syncthreads();
        for (int i = tid; i < 17408 / 16; i += NTHR) ((LAS v4u*)(L + SSD_PREV))[i] = (v4u){0u, 0u, 0u, 0u};
        SsdPre P;
        const unsigned voB = (unsigned)((4 * (tid >> 4)) * 2048 + 1024 + g * 128 + 8 * (tid & 15)) * 2u, voX = (unsigned)((4 * (tid >> 3)) * 2048 + h * 64 + 8 * (tid & 7)) * 2u;
        const unsigned voZ0 = (unsigned)((tid >> 3) * NPROJ + h * 64 + 8 * (tid & 7)) * 2u, voZ1 = voZ0 + 64u * NPROJ * 2u;
        ssd_prefetch(P, (const char*)xc + (size_t)b * SEQ * 4096, dtraw + (size_t)b * SEQ * 16 + h, voB, voX, tid, lane, w);
        for (int c = 0; c < SEQ / CHUNK; ++c) {
            const size_t row0 = (size_t)b * SEQ + (size_t)c * CHUNK;
            if (w == 0) {
                const float d0 = softplus_f(P.d0 + dtb), d1 = softplus_f(P.d1 + dtb);
                const float a0 = d0 * A, a1 = d1 * A; float s = a0 + a1;
#pragma unroll
                for (int o = 1; o < 64; o <<= 1) { const float t = __shfl_up(s, o); if (lane >= o) s += t; }
                dtf[2 * lane] = d0; dtf[2 * lane + 1] = d1; csf[2 * lane] = s - a1; csf[2 * lane + 1] = s;
            }
            LDS_BARRIER();
            const float cs_end = csf[127];
            { const int ob = tid & 15, lb = 4 * (tid >> 4), n0 = 8 * ob;
#pragma unroll
              for (int r = 0; r < 4; ++r) { *(LAS v4u*)(L + SSD_BS + (lb + r) * SSD_PITCH + n0 * 2) = P.br[r]; *(LAS v4u*)(L + SSD_CS + (lb + r) * SSD_PITCH + n0 * 2) = P.cr[r]; }
              float bv[4][8];
#pragma unroll
              for (int r = 0; r < 4; ++r) { unpack8(P.br[r], bv[r]); const float tw = __expf(cs_end - csf[lb + r]);
#pragma unroll
                  for (int i = 0; i < 8; ++i) bv[r][i] *= tw; }
#pragma unroll
              for (int i = 0; i < 8; ++i) *(LAS v2u*)(L + SSD_BWT + (n0 + i) * SSD_PITCH + lb * 2) = (v2u){pk2(bv[0][i], bv[1][i]), pk2(bv[2][i], bv[3][i])}; }
            if (tid < 256) { const int ox = tid & 7, lx = 4 * (tid >> 3), p0 = 8 * ox; float xv[4][8];
#pragma unroll
              for (int r = 0; r < 4; ++r) { *(LAS v4u*)(L + SSD_XS + (lx + r) * SSD_XPITCH + p0 * 2) = P.xr[r]; unpack8(P.xr[r], xv[r]); const float tw = dtf[lx + r];
#pragma unroll
                  for (int i = 0; i < 8; ++i) xv[r][i] *= tw; }
#pragma unroll
              for (int i = 0; i < 8; ++i) *(LAS v2u*)(L + SSD_XDT + (p0 + i) * SSD_PITCH + lx * 2) = (v2u){pk2(xv[0][i], xv[1][i]), pk2(xv[2][i], xv[3][i])}; }
            const char* prb = (const char*)proj + row0 * (NPROJ * 2);
            const v4u zc0 = *(const v4u*)(prb + voZ0), zc1 = *(const v4u*)(prb + voZ1);
            if (c + 1 < SEQ / CHUNK) ssd_prefetch(P, (const char*)xc + (row0 + CHUNK) * 4096, dtraw + (row0 + CHUNK) * 16 + h, voB, voX, tid, lane, w);
            LDS_BARRIER();
            bf16x8 ca[4];
#pragma unroll
            for (int ks = 0; ks < 4; ++ks) ca[ks] = lds_frag(L + SSD_CS, 16 * w + li, 64 * ks + 16 * lq);
            f32x4 cb[8];
#pragma unroll
            for (int sb = 0; sb < 8; ++sb) { cb[sb] = (f32x4){0.f, 0.f, 0.f, 0.f};
                if (sb <= w) {
#pragma unroll
                    for (int ks = 0; ks < 4; ++ks) cb[sb] = __builtin_amdgcn_mfma_f32_16x16x32_bf16(ca[ks], lds_frag(L + SSD_BS, 16 * sb + li, 64 * ks + 16 * lq), cb[sb], 0, 0, 0); } }
            float csl[4];
#pragma unroll
            for (int r = 0; r < 4; ++r) csl[r] = csf[16 * w + 4 * lq + r];
#pragma unroll
            for (int sb = 0; sb < 8; ++sb) if (sb <= w) { const int s = 16 * sb + li; const float css = csf[s];
#pragma unroll
                for (int r = 0; r < 4; ++r) { const int l = 16 * w + 4 * lq + r; cb[sb][r] = (s <= l) ? cb[sb][r] * __expf(csl[r] - css) : 0.f; } }
            LDS_BARRIER();
#pragma unroll
            for (int sb = 0; sb < 8; ++sb) if (sb <= (w | 1)) {
#pragma unroll
                for (int r = 0; r < 4; ++r) *(LAS unsigned short*)(L + SSD_BS + (16 * w + 4 * lq + r) * SSD_PITCH + (16 * sb + li) * 2) = (unsigned short)f2bf(cb[sb][r]); }
            LDS_WAIT(); asm volatile("" ::: "memory");
            f32x4 yd[4], yo[4];
#pragma unroll
            for (int pb = 0; pb < 4; ++pb) { yd[pb] = (f32x4){0.f, 0.f, 0.f, 0.f}; yo[pb] = (f32x4){0.f, 0.f, 0.f, 0.f}; }
#pragma unroll
            for (int ks = 0; ks < 4; ++ks) if (ks <= (w >> 1)) { const bf16x8 gf = lds_frag(L + SSD_BS, 16 * w + li, 64 * ks + 16 * lq);
#pragma unroll
                for (int pb = 0; pb < 4; ++pb) yd[pb] = __builtin_amdgcn_mfma_f32_16x16x32_bf16(gf, lds_frag(L + SSD_XDT, 16 * pb + li, 64 * ks + 16 * lq), yd[pb], 0, 0, 0); }
#pragma unroll
            for (int ks = 0; ks < 4; ++ks)
#pragma unroll
                for (int pb = 0; pb < 4; ++pb) yo[pb] = __builtin_amdgcn_mfma_f32_16x16x32_bf16(ca[ks], lds_frag(L + SSD_PREV, 16 * pb + li, 64 * ks + 16 * lq), yo[pb], 0, 0, 0);
#pragma unroll
            for (int r = 0; r < 4; ++r) { const float e = __expf(csl[r]);
#pragma unroll
                for (int pb = 0; pb < 4; ++pb) *(LAS float*)(L + SSD_BS + (16 * w + 4 * lq + r) * SSD_PITCH + (16 * pb + li) * 4) = yd[pb][r] + e * yo[pb][r]; }
            LDS_BARRIER();
            { const float dec = __expf(cs_end);
#pragma unroll
              for (int j = 0; j < 4; ++j) st[j] = st[j] * dec;
#pragma unroll
              for (int ks = 0; ks < 4; ++ks) { const bf16x8 xf = lds_frag(L + SSD_XDT, 16 * pbs + li, 64 * ks + 16 * lq);
#pragma unroll
                  for (int j = 0; j < 4; ++j) st[j] = __builtin_amdgcn_mfma_f32_16x16x32_bf16(xf, lds_frag(L + SSD_BWT, 16 * (nb0 + j) + li, 64 * ks + 16 * lq), st[j], 0, 0, 0); }
#pragma unroll
              for (int j = 0; j < 4; ++j)
#pragma unroll
                  for (int r = 0; r < 4; ++r) *(LAS unsigned short*)(L + SSD_PREV + (16 * pbs + 4 * lq + r) * SSD_PITCH + (16 * (nb0 + j) + li) * 2) = (unsigned short)f2bf(st[j][r]); }
#pragma unroll
            for (int k = 0; k < 2; ++k) { const int it = tid + 512 * k, l = it >> 3, o = it & 7; const size_t row = row0 + l;
                const f32x4 y0 = *(const LAS f32x4*)(L + SSD_BS + l * SSD_PITCH + 32 * o), y1 = *(const LAS f32x4*)(L + SSD_BS + l * SSD_PITCH + 32 * o + 16);
                const v4u xw = *(const LAS v4u*)(L + SSD_XS + l * SSD_XPITCH + 16 * o); const v4u zw = k == 0 ? zc0 : zc1;
                float xv[8], zv[8], yv[8]; unpack8(xw, xv); unpack8(zw, zv);
                float ss = 0.f;
#pragma unroll
                for (int e = 0; e < 8; ++e) { const float yy = (e < 4 ? y0[e] : y1[e - 4]) + Dh * xv[e]; yv[e] = yy * silu_f(zv[e]); ss += yv[e] * yv[e]; }
                ss += __shfl_xor(ss, 1); ss += __shfl_xor(ss, 2); ss += __shfl_xor(ss, 4);
                if (o == 0) WSP(float, WS_STSSD)[row * 16 + h] = ss;
                *(v4u*)(WSP(bf16, WS_Y) + row * 2048 + h * 64 + 8 * o) = (v4u){pk2(yv[0], yv[1]), pk2(yv[2], yv[3]), pk2(yv[4], yv[5]), pk2(yv[6], yv[7])}; }
            LDS_BARRIER();
        }
    }
}
constexpr int S3_CS = 0, S3_BS = 34816, S3_GY = 69632, S3_XDT = 104448, S3_XP = 144, S3_PREV = 122880, S3_CSF = 140288, S3_DTF = 141312, S3_WTS = 142336, S3_END = 143360;
static_assert(S3_END <= LDS_MAIN, "SSD v3 LDS map");
typedef short v4i16_t __attribute__((ext_vector_type(4)));
__device__ __forceinline__ bf16x8 lds_frag_tr(LAS unsigned char* tile, int pitch, int k0, int col0, int li, int lq) {
    LAS unsigned char* p = tile + (k0 + 8 * lq + (li >> 2)) * pitch + (col0 + 4 * (li & 3)) * 2;
    const v4i16_t lo = __builtin_amdgcn_ds_read_tr16_b64_v4i16((LAS v4i16_t*)p), hi = __builtin_amdgcn_ds_read_tr16_b64_v4i16((LAS v4i16_t*)(p + 4 * pitch));
    return __builtin_shufflevector(lo, hi, 0, 1, 2, 3, 4, 5, 6, 7);
}
struct Ssd3Pre { v4u xr[4], br[4], cr[4]; float d0, d1; };
__device__ __forceinline__ void ssd3_prefetch(Ssd3Pre& P, const char* xcb, const float* dtr, unsigned voB, unsigned voX, int tid, int lane, int w) {
#pragma unroll
    for (int r = 0; r < 4; ++r) { P.br[r] = *(const v4u*)(xcb + (voB + r * 4096u)); P.cr[r] = *(const v4u*)(xcb + (voB + 1024u + r * 4096u)); }
    if (tid < 256) {
#pragma unroll
        for (int r = 0; r < 4; ++r) P.xr[r] = *(const v4u*)(xcb + (voX + r * 4096u)); }
    if (w == 0) { P.d0 = dtr[lane * 32]; P.d1 = dtr[lane * 32 + 16]; }
}
__device__ __forceinline__ void ssd3_cumsum(LAS unsigned char* L, int par, float r0, float r1, float dtb, float A, int lane) {
    LAS float* csf = (LAS float*)(L + S3_CSF + par * 512); LAS float* dtf = (LAS float*)(L + S3_DTF + par * 512); LAS float* wts = (LAS float*)(L + S3_WTS + par * 512);
    const float d0 = softplus_f(r0 + dtb), d1 = softplus_f(r1 + dtb);
    const float a0 = d0 * A, a1 = d1 * A; float s = a0 + a1;
#pragma unroll
    for (int o = 1; o < 64; o <<= 1) { const float t = __shfl_up(s, o); if (lane >= o) s += t; }
    const float tot = __shfl(s, 63);
    dtf[2 * lane] = d0; dtf[2 * lane + 1] = d1; csf[2 * lane] = s - a1; csf[2 * lane + 1] = s;
    wts[2 * lane] = __expf(tot - (s - a1)); wts[2 * lane + 1] = __expf(tot - s);
}
__device__ __forceinline__ void p3_ssd3(Frame& F) {
    const int tid0 = threadIdx.x, w = __builtin_amdgcn_readfirstlane(tid0 >> 6);
    LAS unsigned char* L = F.lds;
    const bf16* proj = WSP(bf16, WS_PROJ); const bf16* xc = (const bf16*)F.out; const float* dtraw = WSP(float, WS_DTRAW);
    for (int item = F.vcu; item < NB * NHEADS; item += F.G) {
        const int b = item >> 4, h = item & 15, g = h >> 2;
        int tid = tid0; asm volatile("" : "+v"(tid)); int lane = tid & 63;
        const float A = -__expf((F.a->in[9])[h]), Dh = (F.a->in[10])[h], dtb = (F.a->in[8])[h];
        const int pbs = w >> 1, nb0 = 4 * (w & 1);
        f32x4 st[4];
#pragma unroll
        for (int j = 0; j < 4; ++j) st[j] = (f32x4){0.f, 0.f, 0.f, 0.f};
        __syncthreads();
        for (int i = tid; i < 17408 / 16; i += NTHR) ((LAS v4u*)(L + S3_PREV))[i] = (v4u){0u, 0u, 0u, 0u};
        Ssd3Pre P;
        { const unsigned voB0 = (unsigned)((4 * (tid >> 4)) * 2048 + 1024 + g * 128 + 8 * (tid & 15)) * 2u, voX0 = (unsigned)((4 * (tid >> 3)) * 2048 + h * 64 + 8 * (tid & 7)) * 2u;
          ssd3_prefetch(P, (const char*)xc + (size_t)b * SEQ * 4096, dtraw + (size_t)b * SEQ * 16 + h, voB0, voX0, tid, lane, w); }
        if (w == 0) ssd3_cumsum(L, 0, P.d0, P.d1, dtb, A, lane);
        __syncthreads();
        for (int c = 0; c < SEQ / CHUNK; ++c) {
            const size_t row0 = (size_t)b * SEQ + (size_t)c * CHUNK; const int par = c & 1;
            asm volatile("" : "+v"(tid));
            lane = tid & 63; const int li = lane & 15, lq = lane >> 4;
            const unsigned voB = (unsigned)((4 * (tid >> 4)) * 2048 + 1024 + g * 128 + 8 * (tid & 15)) * 2u, voX = (unsigned)((4 * (tid >> 3)) * 2048 + h * 64 + 8 * (tid & 7)) * 2u;
            const unsigned voZ0 = (unsigned)((tid >> 3) * NPROJ + h * 64 + 8 * (tid & 7)) * 2u, voZ1 = voZ0 + 64u * NPROJ * 2u;
            LAS float* csf = (LAS float*)(L + S3_CSF + par * 512); LAS float* dtf = (LAS float*)(L + S3_DTF + par * 512); LAS float* wts = (LAS float*)(L + S3_WTS + par * 512);
            { const int ob = tid & 15, lb = 4 * (tid >> 4), n0 = 8 * ob;
#pragma unroll
              for (int r = 0; r < 4; ++r) { *(LAS v4u*)(L + S3_BS + (lb + r) * SSD_PITCH + n0 * 2) = P.br[r]; *(LAS v4u*)(L + S3_CS + (lb + r) * SSD_PITCH + n0 * 2) = P.cr[r]; } }
            if (tid < 256) { const int ox = tid & 7, lx = 4 * (tid >> 3), p0 = 8 * ox;
#pragma unroll
              for (int r = 0; r < 4; ++r) { float xv[8]; unpack8(P.xr[r], xv); const float tw = dtf[lx + r];
                  *(LAS v4u*)(L + S3_XDT + (lx + r) * S3_XP + p0 * 2) = (v4u){pk2(xv[0] * tw, xv[1] * tw), pk2(xv[2] * tw, xv[3] * tw), pk2(xv[4] * tw, xv[5] * tw), pk2(xv[6] * tw, xv[7] * tw)}; } }
            const char* prb = (const char*)proj + row0 * (NPROJ * 2);
            const v4u zc0 = *(const v4u*)(prb + voZ0), zc1 = *(const v4u*)(prb + voZ1);
            LDS_BARRIER();
            const float cs_end = csf[127];
            bf16x8 ca[4];
#pragma unroll
            for (int ks = 0; ks < 4; ++ks) ca[ks] = lds_frag(L + S3_CS, 16 * w + li, 64 * ks + 16 * lq);
            float csl[4];
#pragma unroll
            for (int r = 0; r < 4; ++r) csl[r] = csf[16 * w + 4 * lq + r];
            { bf16x8 bq[2][4];
#pragma unroll
              for (int ks = 0; ks < 4; ++ks) bq[0][ks] = lds_frag(L + S3_BS, li, 64 * ks + 16 * lq);
#pragma unroll
              for (int sb = 0; sb < 8; ++sb) if (sb <= (w | 1)) {
                  f32x4 cbv = (f32x4){0.f, 0.f, 0.f, 0.f};
                  const int s = 16 * sb + li; const float css = csf[s];
                  if (sb <= w) {
                      if (sb + 1 <= w) {
#pragma unroll
                          for (int ks = 0; ks < 4; ++ks) bq[(sb + 1) & 1][ks] = lds_frag(L + S3_BS, 16 * (sb + 1) + li, 64 * ks + 16 * lq); }
                      __builtin_amdgcn_sched_barrier(0);
#pragma unroll
                      for (int ks = 0; ks < 4; ++ks) cbv = __builtin_amdgcn_mfma_f32_16x16x32_bf16(ca[ks], bq[sb & 1][ks], cbv, 0, 0, 0);
                      __builtin_amdgcn_sched_barrier(0); }
#pragma unroll
                  for (int r = 0; r < 4; ++r) { const int l = 16 * w + 4 * lq + r; const float gv = (s <= l) ? cbv[r] * __expf(csl[r] - css) : 0.f;
                      *(LAS unsigned short*)(L + S3_GY + l * SSD_PITCH + s * 2) = (unsigned short)f2bf(gv); } } }
            LDS_WAIT(); asm volatile("" ::: "memory");
            f32x4 yd[4], yo[4];
#pragma unroll
            for (int pb = 0; pb < 4; ++pb) { yd[pb] = (f32x4){0.f, 0.f, 0.f, 0.f}; yo[pb] = (f32x4){0.f, 0.f, 0.f, 0.f}; }
            { bf16x8 gq[2], xq[2][4];
              gq[0] = lds_frag(L + S3_GY, 16 * w + li, 16 * lq);
#pragma unroll
              for (int pb = 0; pb < 4; ++pb) xq[0][pb] = lds_frag_tr(L + S3_XDT, S3_XP, 0, 16 * pb, li, lq);
#pragma unroll
              for (int ks = 0; ks < 4; ++ks) if (ks <= (w >> 1)) {
                  if (ks + 1 <= (w >> 1)) { gq[(ks + 1) & 1] = lds_frag(L + S3_GY, 16 * w + li, 64 * (ks + 1) + 16 * lq);
#pragma unroll
                      for (int pb = 0; pb < 4; ++pb) xq[(ks + 1) & 1][pb] = lds_frag_tr(L + S3_XDT, S3_XP, 32 * (ks + 1), 16 * pb, li, lq); }
                  __builtin_amdgcn_sched_barrier(0);
#pragma unroll
                  for (int pb = 0; pb < 4; ++pb) yd[pb] = __builtin_amdgcn_mfma_f32_16x16x32_bf16(gq[ks & 1], xq[ks & 1][pb], yd[pb], 0, 0, 0);
                  __builtin_amdgcn_sched_barrier(0); } }
            { bf16x8 pq[2][4];
#pragma unroll
              for (int pb = 0; pb < 4; ++pb) pq[0][pb] = lds_frag(L + S3_PREV, 16 * pb + li, 16 * lq);
#pragma unroll
              for (int ks = 0; ks < 4; ++ks) {
                  if (ks < 3) {
#pragma unroll
                      for (int pb = 0; pb < 4; ++pb) pq[(ks + 1) & 1][pb] = lds_frag(L + S3_PREV, 16 * pb + li, 64 * (ks + 1) + 16 * lq); }
                  __builtin_amdgcn_sched_barrier(0);
#pragma unroll
                  for (int pb = 0; pb < 4; ++pb) yo[pb] = __builtin_amdgcn_mfma_f32_16x16x32_bf16(ca[ks], pq[ks & 1][pb], yo[pb], 0, 0, 0);
                  __builtin_amdgcn_sched_barrier(0); } }
#pragma unroll
            for (int r = 0; r < 4; ++r) { const float e = __expf(csl[r]);
#pragma unroll
                for (int pb = 0; pb < 4; ++pb) *(LAS float*)(L + S3_GY + (16 * w + 4 * lq + r) * SSD_PITCH + (16 * pb + li) * 4) = yd[pb][r] + e * yo[pb][r]; }
            if (c + 1 < SEQ / CHUNK) { ssd3_prefetch(P, (const char*)xc + (row0 + CHUNK) * 4096, dtraw + (row0 + CHUNK) * 16 + h, voB, voX, tid, lane, w); }
            LDS_BARRIER();
            { const float dec = __expf(cs_end);
#pragma unroll
              for (int j = 0; j < 4; ++j) st[j] = st[j] * dec;
              bf16x8 xq[2], bq2[2][4]; f32x4 wq[2][2];
              xq[0] = lds_frag_tr(L + S3_XDT, S3_XP, 0, 16 * pbs, li, lq); wq[0][0] = *(const LAS f32x4*)(wts + 8 * lq); wq[0][1] = *(const LAS f32x4*)(wts + 8 * lq + 4);
#pragma unroll
              for (int j = 0; j < 4; ++j) bq2[0][j] = lds_frag_tr(L + S3_BS, SSD_PITCH, 0, 16 * (nb0 + j), li, lq);
#pragma unroll
              for (int ks = 0; ks < 4; ++ks) {
                  if (ks < 3) { xq[(ks + 1) & 1] = lds_frag_tr(L + S3_XDT, S3_XP, 32 * (ks + 1), 16 * pbs, li, lq); wq[(ks + 1) & 1][0] = *(const LAS f32x4*)(wts + 32 * (ks + 1) + 8 * lq); wq[(ks + 1) & 1][1] = *(const LAS f32x4*)(wts + 32 * (ks + 1) + 8 * lq + 4);
#pragma unroll
                      for (int j = 0; j < 4; ++j) bq2[(ks + 1) & 1][j] = lds_frag_tr(L + S3_BS, SSD_PITCH, 32 * (ks + 1), 16 * (nb0 + j), li, lq); }
                  __builtin_amdgcn_sched_barrier(0);
                  const f32x4 w0 = wq[ks & 1][0], w1 = wq[ks & 1][1];
                  float xv[8]; unpack8(__builtin_bit_cast(v4u, xq[ks & 1]), xv);
                  const v4u xw = (v4u){pk2(xv[0] * w0[0], xv[1] * w0[1]), pk2(xv[2] * w0[2], xv[3] * w0[3]), pk2(xv[4] * w1[0], xv[5] * w1[1]), pk2(xv[6] * w1[2], xv[7] * w1[3])};
                  const bf16x8 xf = __builtin_bit_cast(bf16x8, xw);
#pragma unroll
                  for (int j = 0; j < 4; ++j) st[j] = __builtin_amdgcn_mfma_f32_16x16x32_bf16(xf, bq2[ks & 1][j], st[j], 0, 0, 0);
                  __builtin_amdgcn_sched_barrier(0); }
#pragma unroll
              for (int j = 0; j < 4; ++j)
#pragma unroll
                  for (int r = 0; r < 4; ++r) *(LAS unsigned short*)(L + S3_PREV + (16 * pbs + 4 * lq + r) * SSD_PITCH + (16 * (nb0 + j) + li) * 2) = (unsigned short)f2bf(st[j][r]); }
#pragma unroll
            for (int k = 0; k < 2; ++k) { const int it = tid + 512 * k, l = it >> 3, o = it & 7; const size_t row = row0 + l;
                const f32x4 y0 = *(const LAS f32x4*)(L + S3_GY + l * SSD_PITCH + 32 * o), y1 = *(const LAS f32x4*)(L + S3_GY + l * SSD_PITCH + 32 * o + 16);
                const v4u xw = *(const LAS v4u*)(L + S3_XDT + l * S3_XP + 16 * o); const v4u zw = k == 0 ? zc0 : zc1; const float dsk = Dh * __builtin_amdgcn_rcpf(dtf[l]);
                float xv[8], zv[8], yv[8]; unpack8(xw, xv); unpack8(zw, zv);
                float ss = 0.f;
#pragma unroll
                for (int e = 0; e < 8; ++e) { const float yy = (e < 4 ? y0[e] : y1[e - 4]) + dsk * xv[e]; yv[e] = yy * silu_f(zv[e]); ss += yv[e] * yv[e]; }
                ss += __shfl_xor(ss, 1); ss += __shfl_xor(ss, 2); ss += __shfl_xor(ss, 4);
                if (o == 0) WSP(float, WS_STSSD)[row * 16 + h] = ss;
                *(v4u*)(WSP(bf16, WS_Y) + row * 2048 + h * 64 + 8 * o) = (v4u){pk2(yv[0], yv[1]), pk2(yv[2], yv[3]), pk2(yv[4], yv[5]), pk2(yv[6], yv[7])}; }
            if (w == 0 && c + 1 < SEQ / CHUNK) ssd3_cumsum(L, par ^ 1, P.d0, P.d1, dtb, A, lane);
            LDS_BARRIER();
        }
    }
}
constexpr int S5_XT = 0, S5_XPITCH = 2056, S5_BBT = 65792, S5_CC = S5_BBT + 16384, S5_CCPITCH = 272, S5_GLU = S5_CC + 64 * S5_CCPITCH, S5_VS = S5_GLU + 2048, S5_OT = S5_VS + 8 * 512, S5_OPITCH = 144, S5_END = S5_OT + 32 * S5_OPITCH;
static_assert(S5_END <= LDS_MAIN, "S5 LDS map");
typedef float f32x16 __attribute__((ext_vector_type(16)));
__device__ __forceinline__ void p3_s5(Frame& F) {
    const int tid = threadIdx.x, lane = tid & 63, w = __builtin_amdgcn_readfirstlane(tid >> 6);
    const int li = lane & 15, lq = lane >> 4;
    LAS unsigned char* L = F.lds;
    const bf16* proj = WSP(bf16, WS_PROJ);
    for (int item = F.vcu; item < NB * 16; item += F.G) {
        const int b = item >> 4, gs = item & 15;
        __syncthreads();
        { const int gl = tid >> 7, col = tid & 127, p = col >> 1, ri = col & 1; const float* src = WSP(float, WS_S5BB) + ((gs * 4 + gl) * 64 + p) * 32 + ri * 16;
          const f32x4 a0 = *(const f32x4*)src, a1 = *(const f32x4*)(src + 4), a2 = *(const f32x4*)(src + 8), a3 = *(const f32x4*)(src + 12);
          LAS v4u* d = (LAS v4u*)(L + S5_BBT + (gl * 128 + col) * 32);
          d[0] = (v4u){pk2(a0[0], a0[1]), pk2(a0[2], a0[3]), pk2(a1[0], a1[1]), pk2(a1[2], a1[3])}; d[1] = (v4u){pk2(a2[0], a2[1]), pk2(a2[2], a2[3]), pk2(a3[0], a3[1]), pk2(a3[2], a3[3])}; }
        { const int gl = tid >> 7, hh = (tid >> 3) & 15, kq = tid & 7; const int g = gs * 4 + gl; const float* cr = (F.a->in[17]) + (g * 16 + hh) * 64 + 8 * kq; const float* ci = (F.a->in[18]) + (g * 16 + hh) * 64 + 8 * kq;
          const f32x4 r0 = *(const f32x4*)cr, r1 = *(const f32x4*)(cr + 4), i0 = *(const f32x4*)ci, i1 = *(const f32x4*)(ci + 4);
          LAS v4u* d = (LAS v4u*)(L + S5_CC + (gl * 16 + hh) * S5_CCPITCH + kq * 32);
          d[0] = (v4u){pk2(r0[0], -i0[0]), pk2(r0[1], -i0[1]), pk2(r0[2], -i0[2]), pk2(r0[3], -i0[3])}; d[1] = (v4u){pk2(r1[0], -i1[0]), pk2(r1[1], -i1[1]), pk2(r1[2], -i1[2]), pk2(r1[3], -i1[3])}; }
        for (int i = tid; i < 1024; i += NTHR) { const int gl = i >> 8, k = (i >> 4) & 15, hh = i & 15; ((LAS unsigned short*)(L + S5_GLU))[i] = (unsigned short)f2bf((F.a->in[20])[((gs * 4 + gl) * 16 + hh) * 16 + k]); }
        const int gsc = gs * 4 + (w & 3);
        const float lbr = WSP(float, WS_S5LB)[(gsc * 64 + lane) * 2], lbi = WSP(float, WS_S5LB)[(gsc * 64 + lane) * 2 + 1];
        const int glo = w >> 1, mb = w & 1, go = gs * 4 + glo;
        const float dsk = (F.a->in[19])[go * 16 + li], gbias = (F.a->in[21])[go * 16 + li];
        float xr = 0.f, xi = 0.f;
        __syncthreads();
        const bf16* ubase = proj + (size_t)b * SEQ * NPROJ + 3072 + gs * 64;
        v4u ua = *(const v4u*)(ubase + (size_t)(lane & 31) * NPROJ + glo * 16 + 8 * (lane >> 5));
        for (int t0 = 0; t0 < SEQ; t0 += 32) {
            const bf16x8 af = __builtin_bit_cast(bf16x8, ua);
            if (t0 + 32 < SEQ) ua = *(const v4u*)(ubase + (size_t)(t0 + 32 + (lane & 31)) * NPROJ + glo * 16 + 8 * (lane >> 5));
            float uo[4];
#pragma unroll
            for (int r = 0; r < 4; ++r) uo[r] = bf2f(ubase[(size_t)(t0 + 16 * mb + 4 * lq + r) * NPROJ + glo * 16 + li]);
#pragma unroll
            for (int q = 0; q < 2; ++q) { const int cb = 2 * (w & 1) + q;
                const bf16x8 bfrag = *(const LAS bf16x8*)(L + S5_BBT + (glo * 128 + 32 * cb + (lane & 31)) * 32 + 16 * (lane >> 5));
                f32x16 acc;
#pragma unroll
                for (int r = 0; r < 16; ++r) acc[r] = 0.f;
                acc = __builtin_amdgcn_mfma_f32_32x32x16_bf16(af, bfrag, acc, 0, 0, 0);
#pragma unroll
                for (int r = 0; r < 16; ++r) { const int t = (r & 3) + 8 * (r >> 2) + 4 * (lane >> 5); *(LAS float*)(L + S5_XT + t * S5_XPITCH + (glo * 128 + 32 * cb + (lane & 31)) * 4) = acc[r]; } }
            __syncthreads();
            if (w < 4) { LAS f32x2* xp = (LAS f32x2*)(L + S5_XT + (w * 128 + 2 * lane) * 4);
#pragma unroll 8
                for (int t = 0; t < 32; ++t) { const f32x2 bu = xp[t * (S5_XPITCH / 8)]; const float nr = lbr * xr - lbi * xi + bu[0], ni = lbr * xi + lbi * xr + bu[1]; xr = nr; xi = ni; xp[t * (S5_XPITCH / 8)] = (f32x2){xr, xi}; } }
            __syncthreads();
            f32x4 yacc = (f32x4){0.f, 0.f, 0.f, 0.f};
#pragma unroll
            for (int ks = 0; ks < 4; ++ks) { const LAS float* xs = (const LAS float*)(L + S5_XT + (16 * mb + li) * S5_XPITCH + (glo * 128 + 32 * ks + 8 * lq) * 4);
                const f32x4 x0 = *(const LAS f32x4*)xs, x1 = *(const LAS f32x4*)(xs + 4);
                const v4u xa = (v4u){pk2(x0[0], x0[1]), pk2(x0[2], x0[3]), pk2(x1[0], x1[1]), pk2(x1[2], x1[3])};
                const bf16x8 cf = *(const LAS bf16x8*)(L + S5_CC + (glo * 16 + li) * S5_CCPITCH + 64 * ks + 16 * lq);
                yacc = __builtin_amdgcn_mfma_f32_16x16x32_bf16(__builtin_bit_cast(bf16x8, xa), cf, yacc, 0, 0, 0); }
            float v[4];
#pragma unroll
            for (int r = 0; r < 4; ++r) v[r] = gelu_erf(yacc[r] + dsk * uo[r]);
            LAS unsigned char* vs = L + S5_VS + w * 512;
#pragma unroll
            for (int r = 0; r < 4; ++r) *(LAS unsigned short*)(vs + (4 * lq + r) * 32 + li * 2) = (unsigned short)f2bf(v[r]);
            LDS_WAIT(); asm volatile("" ::: "memory");
            v4u va = (v4u){0u, 0u, 0u, 0u}, gw = (v4u){0u, 0u, 0u, 0u};
            if (lq < 2) { va = *(const LAS v4u*)(vs + li * 32 + 16 * lq); gw = *(const LAS v4u*)(L + S5_GLU + ((glo * 16 + li) * 16 + 8 * lq) * 2); }
            f32x4 gacc = (f32x4){0.f, 0.f, 0.f, 0.f};
            gacc = __builtin_amdgcn_mfma_f32_16x16x32_bf16(__builtin_bit_cast(bf16x8, va), __builtin_bit_cast(bf16x8, gw), gacc, 0, 0, 0);
            float o[4], ss[4];
#pragma unroll
            for (int r = 0; r < 4; ++r) { o[r] = v[r] * sigmoid_f(gacc[r] + gbias); ss[r] = o[r] * o[r]; }
#pragma unroll
            for (int r = 0; r < 4; ++r) { ss[r] += __shfl_xor(ss[r], 1); ss[r] += __shfl_xor(ss[r], 2); ss[r] += __shfl_xor(ss[r], 4); ss[r] += __shfl_xor(ss[r], 8); }
            if (li == 0) {
#pragma unroll
                for (int r = 0; r < 4; ++r) WSP(float, WS_STS5)[((size_t)b * SEQ + t0 + 16 * mb + 4 * lq + r) * NS5PART + go] = ss[r]; }
#pragma unroll
            for (int r = 0; r < 4; ++r) *(LAS unsigned short*)(L + S5_OT + (16 * mb + 4 * lq + r) * S5_OPITCH + (glo * 16 + li) * 2) = (unsigned short)f2bf(o[r]);
            __syncthreads();
            if (tid < 256) { const int t = tid >> 3, oc = tid & 7; const v4u ov = *(const LAS v4u*)(L + S5_OT + t * S5_OPITCH + 16 * oc);
                *(v4u*)(WSP(bf16, WS_Y) + ((size_t)b * SEQ + t0 + t) * 2048 + 1024 + gs * 64 + 8 * oc) = ov; }
        }
    }
}
constexpr int S5V_BU = 0, S5V_BUP = 2056, S5V_BUSZ = 16 * S5V_BUP, S5V_XT = 2 * S5V_BUSZ, S5V_XTP = 1040, S5V_XTSZ = 16 * S5V_XTP, S5V_VS = S5V_XT + 2 * S5V_XTSZ, S5V_OT = S5V_VS + 4 * 512, S5V_OTP = 144, S5V_OTSZ = 16 * S5V_OTP, S5V_END = S5V_OT + 2 * S5V_OTSZ;
static_assert(S5V_END <= LDS_MAIN, "S5 v2 LDS map");
__device__ __forceinline__ void p3_s5v2(Frame& F) {
    const int tid = threadIdx.x, lane = tid & 63, w = __builtin_amdgcn_readfirstlane(tid >> 6);
    const int li = lane & 15, lq = lane >> 4;
    LAS unsigned char* L = F.lds;
    const bf16* proj = WSP(bf16, WS_PROJ);
    constexpr int NT = SEQ / 16;
    for (int item = F.vcu; item < NB * 16; item += F.G) {
        const int b = item >> 4, gs = item & 15;
        const bool scanw = w < 4; const int gl = w & 3, g = gs * 4 + gl;
        const bf16* ubase = proj + (size_t)b * SEQ * NPROJ + 3072 + gs * 64 + gl * 16;
        __syncthreads();
        if (scanw) {
            const float lbr = WSP(float, WS_S5LB)[(g * 64 + lane) * 2], lbi = WSP(float, WS_S5LB)[(g * 64 + lane) * 2 + 1];
            bf16x8 bfr[8];
#pragma unroll
            for (int cb = 0; cb < 8; ++cb) { v4u v = (v4u){0u, 0u, 0u, 0u};
                if (lq < 2) { const int col = 16 * cb + li; const float* src = WSP(float, WS_S5BB) + (g * 64 + (col >> 1)) * 32 + (col & 1) * 16 + 8 * lq; const f32x4 a0 = *(const f32x4*)src, a1 = *(const f32x4*)(src + 4);
                    v = (v4u){pk2(a0[0], a0[1]), pk2(a0[2], a0[3]), pk2(a1[0], a1[1]), pk2(a1[2], a1[3])}; }
                bfr[cb] = __builtin_bit_cast(bf16x8, v); }
            float xr = 0.f, xi = 0.f;
            v4u ua = (v4u){0u, 0u, 0u, 0u};
            if (lq < 2) ua = *(const v4u*)(ubase + (size_t)li * NPROJ + 8 * lq);
            { const bf16x8 af = __builtin_bit_cast(bf16x8, ua);
              if (lq < 2) ua = *(const v4u*)(ubase + (size_t)(16 + li) * NPROJ + 8 * lq);
#pragma unroll
              for (int cb = 0; cb < 8; ++cb) { f32x4 acc = (f32x4){0.f, 0.f, 0.f, 0.f}; acc = __builtin_amdgcn_mfma_f32_16x16x32_bf16(af, bfr[cb], acc, 0, 0, 0);
#pragma unroll
                  for (int r = 0; r < 4; ++r) *(LAS float*)(L + S5V_BU + (4 * lq + r) * S5V_BUP + (gl * 128 + 16 * cb + li) * 4) = acc[r]; } }
            LDS_BARRIER();
            for (int k = 0; k <= NT; ++k) {
                if (k < NT) {
                    const LAS f32x2* bp = (const LAS f32x2*)(L + S5V_BU + (k & 1) * S5V_BUSZ + (gl * 128 + 2 * lane) * 4);
                    LAS unsigned* xp = (LAS unsigned*)(L + S5V_XT + (k & 1) * S5V_XTSZ + (gl * 128 + 2 * lane) * 2);
                    f32x2 bu[16];
#pragma unroll
                    for (int t = 0; t < 16; ++t) bu[t] = bp[t * (S5V_BUP / 8)];
                    unsigned xo[16];
#pragma unroll
                    for (int t = 0; t < 16; ++t) { const float nr = lbr * xr + (bu[t][0] - lbi * xi), ni = lbr * xi + (lbi * xr + bu[t][1]); xr = nr; xi = ni; xo[t] = pk2(xr, xi); }
#pragma unroll
                    for (int t = 0; t < 16; ++t) xp[t * (S5V_XTP / 4)] = xo[t];
                    if (k + 1 < NT) {
                        const bf16x8 af = __builtin_bit_cast(bf16x8, ua);
                        if (lq < 2 && k + 2 < NT) ua = *(const v4u*)(ubase + (size_t)(16 * (k + 2) + li) * NPROJ + 8 * lq);
                        LAS unsigned char* bun = L + S5V_BU + ((k + 1) & 1) * S5V_BUSZ;
#pragma unroll
                        for (int cb = 0; cb < 8; ++cb) { f32x4 acc = (f32x4){0.f, 0.f, 0.f, 0.f}; acc = __builtin_amdgcn_mfma_f32_16x16x32_bf16(af, bfr[cb], acc, 0, 0, 0);
#pragma unroll
                            for (int r = 0; r < 4; ++r) *(LAS float*)(bun + (4 * lq + r) * S5V_BUP + (gl * 128 + 16 * cb + li) * 4) = acc[r]; }
                    }
                }
                LDS_BARRIER();
            }
        } else {
            bf16x8 cfr[4];
#pragma unroll
            for (int ks = 0; ks < 4; ++ks) { const float* cr = (F.a->in[17]) + (g * 16 + li) * 64 + 16 * ks + 4 * lq; const float* ci = (F.a->in[18]) + (g * 16 + li) * 64 + 16 * ks + 4 * lq;
                const f32x4 r0 = *(const f32x4*)cr, i0 = *(const f32x4*)ci;
                cfr[ks] = __builtin_bit_cast(bf16x8, ((v4u){pk2(r0[0], -i0[0]), pk2(r0[1], -i0[1]), pk2(r0[2], -i0[2]), pk2(r0[3], -i0[3])})); }
            v4u gwv = (v4u){0u, 0u, 0u, 0u};
            if (lq < 2) { float gwf[8];
#pragma unroll
                for (int j = 0; j < 8; ++j) gwf[j] = (F.a->in[20])[(g * 16 + 8 * lq + j) * 16 + li];
                gwv = (v4u){pk2(gwf[0], gwf[1]), pk2(gwf[2], gwf[3]), pk2(gwf[4], gwf[5]), pk2(gwf[6], gwf[7])}; }
            const bf16x8 gfr = __builtin_bit_cast(bf16x8, gwv);
            const float dsk = (F.a->in[19])[g * 16 + li], gbias = (F.a->in[21])[g * 16 + li];
            LAS unsigned char* vs = L + S5V_VS + gl * 512;
            float uo[4];
#pragma unroll
            for (int r = 0; r < 4; ++r) uo[r] = bf2f(ubase[(size_t)(4 * lq + r) * NPROJ + li]);
            LDS_BARRIER();
            for (int k = 0; k <= NT; ++k) {
                if (k >= 2) {
                    const int t = ((tid - 256) >> 3) & 15, oc = tid & 7; const v4u ov = *(const LAS v4u*)(L + S5V_OT + (k & 1) * S5V_OTSZ + t * S5V_OTP + 16 * oc);
                    if (tid < 384) *(v4u*)(WSP(bf16, WS_Y) + ((size_t)b * SEQ + 16 * (k - 2) + t) * 2048 + 1024 + gs * 64 + 8 * oc) = ov; }
                if (k >= 1) {
                    const int kt = k - 1; const LAS unsigned char* xt = L + S5V_XT + (kt & 1) * S5V_XTSZ;
                    float un[4];
                    if (k < NT) {
#pragma unroll
                        for (int r = 0; r < 4; ++r) un[r] = bf2f(ubase[(size_t)(16 * k + 4 * lq + r) * NPROJ + li]); }
                    f32x4 yacc = (f32x4){0.f, 0.f, 0.f, 0.f};
#pragma unroll
                    for (int ks = 0; ks < 4; ++ks) yacc = __builtin_amdgcn_mfma_f32_16x16x32_bf16(*(const LAS bf16x8*)(xt + li * S5V_XTP + (gl * 128 + 32 * ks + 8 * lq) * 2), cfr[ks], yacc, 0, 0, 0);
                    float v[4];
#pragma unroll
                    for (int r = 0; r < 4; ++r) v[r] = gelu_erf(yacc[r] + dsk * uo[r]);
#pragma unroll
                    for (int r = 0; r < 4; ++r) *(LAS unsigned short*)(vs + (4 * lq + r) * 32 + li * 2) = (unsigned short)f2bf(v[r]);
                    LDS_WAIT(); asm volatile("" ::: "memory");
                    v4u va = (v4u){0u, 0u, 0u, 0u};
                    if (lq < 2) va = *(const LAS v4u*)(vs + li * 32 + 16 * lq);
                    f32x4 gacc = (f32x4){0.f, 0.f, 0.f, 0.f};
                    gacc = __builtin_amdgcn_mfma_f32_16x16x32_bf16(__builtin_bit_cast(bf16x8, va), gfr, gacc, 0, 0, 0);
                    float o[4], ss[4];
#pragma unroll
                    for (int r = 0; r < 4; ++r) { o[r] = v[r] * sigmoid_f(gacc[r] + gbias); ss[r] = o[r] * o[r]; }
#pragma unroll
                    for (int r = 0; r < 4; ++r) ss[r] = row16_sum_to15(ss[r]);
                    if (li == 15) {
#pragma unroll
                        for (int r = 0; r < 4; ++r) WSP(float, WS_STS5)[((size_t)b * SEQ + 16 * kt + 4 * lq + r) * NS5PART + g] = ss[r]; }
                    LAS unsigned char* ot = L + S5V_OT + (kt & 1) * S5V_OTSZ;
#pragma unroll
                    for (int r = 0; r < 4; ++r) *(LAS unsigned short*)(ot + (4 * lq + r) * S5V_OTP + (gl * 16 + li) * 2) = (unsigned short)f2bf(o[r]);
                    if (k < NT) {
#pragma unroll
                        for (int r = 0; r < 4; ++r) uo[r] = un[r]; }
                }
                LDS_BARRIER();
            }
            { const int t = ((tid - 256) >> 3) & 15, oc = tid & 7; const v4u ov = *(const LAS v4u*)(L + S5V_OT + ((NT - 1) & 1) * S5V_OTSZ + t * S5V_OTP + 16 * oc);
              if (tid < 384) *(v4u*)(WSP(bf16, WS_Y) + ((size_t)b * SEQ + 16 * (NT - 1) + t) * 2048 + 1024 + gs * 64 + 8 * oc) = ov; }
        }
    }
}
__device__ __forceinline__ unsigned med3u(unsigned a, unsigned b, unsigned c) { unsigned r; asm("v_med3_u32 %0, %1, %2, %3" : "=v"(r) : "v"(a), "v"(b), "v"(c)); return r; }
__device__ __forceinline__ unsigned fkey(float v) { const unsigned u = __builtin_bit_cast(unsigned, v); return (u & 0x80000000u) ? ~u : (u | 0x80000000u); }
__device__ __forceinline__ float fkey_inv(unsigned k) { const unsigned u = (k & 0x80000000u) ? (k & 0x7fffffffu) : ~k; return __builtin_bit_cast(float, u); }
#define TOPK_INSERT(a, x) do { _Pragma("unroll") for (int _i = 15; _i >= 1; --_i) a[_i] = med3u(a[_i - 1], a[_i], (x)); a[0] = a[0] > (x) ? a[0] : (x); } while (0)
__device__ __forceinline__ void p5b_topk(Frame& F) {
    const int f_tid = threadIdx.x, f_lane = f_tid & 63, f_wave = __builtin_amdgcn_readfirstlane(f_tid >> 6);
    const float* scores = WSP(float, WS_SCORES);
    LAS unsigned char* ix = (LAS unsigned char*)F.lds + f_tid * 36;
    for (int item = F.vcu * NTHR + f_tid; item < MTOK * PH; item += F.G * NTHR) {
        const int t = item >> 3, hd = item & 7;
        unsigned a1[16], a2[16];
#pragma unroll
        for (int i = 0; i < 16; ++i) { a1[i] = 0u; a2[i] = 0u; }
        const float* sp = scores + (size_t)t * 2048 + hd * 256;
#pragma unroll 1
        for (int m = 0; m < 4; ++m) { f32x4 sv[8];
#pragma unroll
            for (int q = 0; q < 8; ++q) sv[q] = *(const f32x4*)(sp + 32 * m + 4 * q);
#pragma unroll
            for (int q = 0; q < 8; ++q)
#pragma unroll
                for (int e = 0; e < 4; ++e) { const unsigned k = (fkey(sv[q][e]) & ~127u) | (unsigned)(127 - (32 * m + 4 * q + e)); TOPK_INSERT(a1, k); } }
#pragma unroll 1
        for (int m = 0; m < 4; ++m) { f32x4 sv[8];
#pragma unroll
            for (int q = 0; q < 8; ++q) sv[q] = *(const f32x4*)(sp + 128 + 32 * m + 4 * q);
#pragma unroll
            for (int q = 0; q < 8; ++q)
#pragma unroll
                for (int e = 0; e < 4; ++e) { const unsigned k = (fkey(sv[q][e]) & ~127u) | (unsigned)(127 - (32 * m + 4 * q + e)); TOPK_INSERT(a2, k); } }
        float v1[16], v2[16];
#pragma unroll
        for (int i = 0; i < 16; ++i) { ix[i] = (unsigned char)(127u - (a1[i] & 127u)); ix[16 + i] = (unsigned char)(127u - (a2[i] & 127u)); v1[i] = fkey_inv(a1[i] & ~127u); v2[i] = fkey_inv(a2[i] & ~127u); }
        unsigned cb[16];
#pragma unroll
        for (int i = 0; i < 16; ++i) cb[i] = 0u;
#pragma unroll
        for (int i = 0; i < 16; ++i)
#pragma unroll
            for (int j = 0; j < 16; ++j) if ((i + 1) * (j + 1) <= 16) { const unsigned k = (fkey(v1[i] + v2[j]) & ~255u) | (unsigned)(255 - (i * 16 + j)); TOPK_INSERT(cb, k); }
        float tv[16]; float mx = -3.0e38f;
#pragma unroll
        for (int k = 0; k < 16; ++k) { tv[k] = fkey_inv(cb[k] & ~255u); mx = fmaxf(mx, tv[k]); }
        float sum = 0.f;
#pragma unroll
        for (int k = 0; k < 16; ++k) { tv[k] = __expf(tv[k] - mx); sum += tv[k]; }
        const float inv = 1.0f / sum;
        LDS_WAIT(); asm volatile("" ::: "memory");
        int ev[16]; unsigned long long c64 = 0ull;
#pragma unroll
        for (int k = 0; k < 16; ++k) { const unsigned code = 255u - (cb[k] & 255u); const int i = code >> 4, j = code & 15; ev[k] = (int)ix[i] * 128 + (int)ix[16 + j]; c64 += 1ull << (8 * (ev[k] >> 11)); }
        unsigned long long s64 = c64;
#pragma unroll
        for (int o = 1; o < 8; o <<= 1) { const unsigned lo = __shfl_up((unsigned)s64, o, 8), hi = __shfl_up((unsigned)(s64 >> 32), o, 8); if ((f_lane & 7) >= o) s64 += ((unsigned long long)hi << 32) | lo; }
        const unsigned long long e64 = s64 - c64;
        const unsigned long long t64 = ((unsigned long long)__shfl((unsigned)(s64 >> 32), 7, 8) << 32) | __shfl((unsigned)s64, 7, 8);
        const unsigned long long st64 = (t64 * 0x0101010101010101ull) << 8;
        unsigned long long base64 = st64 + e64;
        int* eo = WSP(int, WS_EID) + (size_t)t * 128; float* go = WSP(float, WS_GATE) + (size_t)t * 128;
#pragma unroll
        for (int k = 0; k < 16; ++k) { const int r8 = 8 * (ev[k] >> 11); const int slot = (int)((base64 >> r8) & 255ull); base64 += 1ull << r8; eo[slot] = ev[k]; go[slot] = tv[k] * inv; }
        if (hd == 0) WSP(unsigned long long, WS_START)[t] = st64;
        LDS_WAIT(); asm volatile("" ::: "memory");
    }
}
__device__ __forceinline__ void dec16(const v4u q, float* f) {
#pragma unroll
    for (int i = 0; i < 4; ++i) { const f32x2 lo = __builtin_amdgcn_cvt_pk_f32_fp8((int)q[i], false), hi = __builtin_amdgcn_cvt_pk_f32_fp8((int)q[i], true); f[4 * i] = lo[0]; f[4 * i + 1] = lo[1]; f[4 * i + 2] = hi[0]; f[4 * i + 3] = hi[1]; }
}
__device__ __forceinline__ void p8_peer_up(Frame& F) {
    const int f_tid = threadIdx.x, lane = f_tid & 63, f_wave = __builtin_amdgcn_readfirstlane(f_tid >> 6);
    const int rr = blockIdx.x & 7, wk = (blockIdx.x >> 3) * NWAVES + f_wave, nwk = (F.G >> 3) * NWAVES;
    const unsigned char* EU = F.ws + WS_EU;
    for (int blk = wk; blk < MTOK / 128; blk += nwk) {
        const int b = blk >> 4; const float* mb = WSP(float, WS_MOD) + (size_t)b * 6144;
        float S2[16];
#pragma unroll
        for (int q = 0; q < 4; ++q) { const f32x4 sh = *(const f32x4*)(mb + 3072 + 16 * lane + 4 * q); S2[4 * q] = sh[0]; S2[4 * q + 1] = sh[1]; S2[4 * q + 2] = sh[2]; S2[4 * q + 3] = sh[3]; }
        for (int tt = 0; tt < 128; ++tt) {
            const size_t t = (size_t)blk * 128 + tt;
            const unsigned long long st64 = WSP(unsigned long long, WS_START)[t];
            const int s0 = (int)((st64 >> (8 * rr)) & 255ull), s1 = rr == 7 ? 128 : (int)((st64 >> (8 * rr + 8)) & 255ull), cnt = s1 - s0;
            if (cnt <= 0) continue;
            const float rs = rsqrt_f(WSP(float, WS_ROWSTAT)[t] * (1.0f / 1024.0f) + EPSF);
            const bf16* xr = WSP(bf16, WS_X1S) + t * 1024 + 16 * lane; const v4u xa = *(const v4u*)xr, xb = *(const v4u*)(xr + 8);
            float h2[16]; unpack8(xa, h2); unpack8(xb, h2 + 8);
#pragma unroll
            for (int i = 0; i < 16; ++i) h2[i] = h2[i] * rs + S2[i];
            int* ep = WSP(int, WS_EID) + t * 128 + s0; float* gp = WSP(float, WS_GATE) + t * 128 + s0;
            for (int j0 = 0; j0 < cnt; j0 += 8) {
                const int myi = j0 + (lane & 7) < cnt ? j0 + (lane & 7) : cnt - 1;
                const int emine = ep[myi]; const float gmine = gp[myi];
                v4u q[8];
#pragma unroll
                for (int j = 0; j < 8; ++j) { const int e = __shfl(emine, j); q[j] = *(const v4u*)(EU + (size_t)e * 1024 + 16 * lane); }
                float d[8];
#pragma unroll
                for (int j = 0; j < 8; ++j) { float f[16]; dec16(q[j], f); float a = 0.f;
#pragma unroll
                    for (int i = 0; i < 16; ++i) a += h2[i] * f[i];
                    d[j] = a; }
                float e4[4], e2[2], e1;
#pragma unroll
                for (int i = 0; i < 4; ++i) { const bool up = lane & 32; const float snd = up ? d[i] : d[i + 4]; const float rcv = __shfl_xor(snd, 32); e4[i] = (up ? d[i + 4] : d[i]) + rcv; }
#pragma unroll
                for (int i = 0; i < 2; ++i) { const bool up = lane & 16; const float snd = up ? e4[i] : e4[i + 2]; const float rcv = __shfl_xor(snd, 16); e2[i] = (up ? e4[i + 2] : e4[i]) + rcv; }
                { const bool up = lane & 8; const float snd = up ? e2[0] : e2[1]; const float rcv = __shfl_xor(snd, 8); e1 = (up ? e2[1] : e2[0]) + rcv; }
                e1 += __shfl_xor(e1, 4); e1 += __shfl_xor(e1, 2); e1 += __shfl_xor(e1, 1);
                const int myj = ((lane >> 5) & 1) * 4 + ((lane >> 4) & 1) * 2 + ((lane >> 3) & 1);
                const int ej = __shfl(emine, myj); const float gj = __shfl(gmine, myj);
                const float wv = gj * gelu_erf(e1 * WSP(float, WS_EUS)[ej]) * WSP(float, WS_EVS)[ej];
                if ((lane & 7) == 0 && j0 + myj < cnt) gp[j0 + myj] = wv;
            }
        }
    }
}
__device__ __forceinline__ void p9_peer_down(Frame& F, float* dst) {
    const int f_tid = threadIdx.x, lane = f_tid & 63, f_wave = __builtin_amdgcn_readfirstlane(f_tid >> 6);
    const unsigned char* EV = F.ws + WS_EV;
    for (int wq = F.vcu * NWAVES + f_wave; wq < MTOK / 16; wq += F.G * NWAVES) {
        const int b = wq >> 7; const float* mb = WSP(float, WS_MOD) + (size_t)b * 6144;
        float GT[16], NF[16];
#pragma unroll
        for (int q = 0; q < 4; ++q) { const f32x4 gt = *(const f32x4*)(mb + 5120 + 16 * lane + 4 * q), nf = *(const f32x4*)((F.a->in[29]) + 16 * lane + 4 * q);
#pragma unroll
            for (int e = 0; e < 4; ++e) { GT[4 * q + e] = gt[e]; NF[4 * q + e] = nf[e]; } }
        for (int tt = 0; tt < 16; ++tt) {
            const size_t t = (size_t)wq * 16 + tt; float* xr = F.out + t * 1024 + 16 * lane;
            const int e_lo = WSP(int, WS_EID)[t * 128 + lane], e_hi = WSP(int, WS_EID)[t * 128 + 64 + lane];
            const float w_lo = WSP(float, WS_GATE)[t * 128 + lane], w_hi = WSP(float, WS_GATE)[t * 128 + 64 + lane];
            f32x2 o[8];
#pragma unroll
            for (int i = 0; i < 8; ++i) o[i] = (f32x2){0.f, 0.f};
            for (int grp = 0; grp < 16; ++grp) {
                const int esel = grp < 8 ? e_lo : e_hi; const float wsel = grp < 8 ? w_lo : w_hi; const int base = (grp & 7) * 8;
                v4u q[8];
#pragma unroll
                for (int j = 0; j < 8; ++j) { const int e = __shfl(esel, base + j); q[j] = *(const v4u*)(EV + (size_t)e * 1024 + 16 * lane); }
#pragma unroll
                for (int j = 0; j < 8; ++j) { const float wj = __shfl(wsel, base + j); const f32x2 w2 = (f32x2){wj, wj};
#pragma unroll
                    for (int i = 0; i < 4; ++i) { const f32x2 lo = __builtin_amdgcn_cvt_pk_f32_fp8((int)q[j][i], false), hi = __builtin_amdgcn_cvt_pk_f32_fp8((int)q[j][i], true); o[2 * i] += w2 * lo; o[2 * i + 1] += w2 * hi; } }
            }
            float x1[16]; float ss = 0.f;
#pragma unroll
            for (int q = 0; q < 4; ++q) { const f32x4 v = *(const f32x4*)(xr + 4 * q); x1[4 * q] = v[0]; x1[4 * q + 1] = v[1]; x1[4 * q + 2] = v[2]; x1[4 * q + 3] = v[3]; }
#pragma unroll
            for (int i = 0; i < 16; ++i) { x1[i] += GT[i] * o[i >> 1][i & 1]; ss += x1[i] * x1[i]; }
            const float rf = rsqrt_f(wave_sum(ss) * (1.0f / 1024.0f) + EPSF);
#pragma unroll
            for (int q = 0; q < 4; ++q) { f32x4 v;
#pragma unroll
                for (int e = 0; e < 4; ++e) v[e] = x1[4 * q + e] * rf * NF[4 * q + e];
                *(f32x4*)(dst + t * 1024 + 16 * lane + 4 * q) = v; }
        }
    }
}

__device__ __forceinline__ void p8_peer_fused(Frame& F) {
    const int f_tid = threadIdx.x, lane = f_tid & 63, f_wave = __builtin_amdgcn_readfirstlane(f_tid >> 6);
    const unsigned char* EU = F.ws + WS_EU; const unsigned char* EV = F.ws + WS_EV;
    const int myj = ((lane >> 5) & 1) * 4 + ((lane >> 4) & 1) * 2 + ((lane >> 3) & 1);
    const unsigned l16 = 16u * (unsigned)lane;
    for (int wq = F.vcu * NWAVES + f_wave; wq < MTOK / 16; wq += F.G * NWAVES) {
        const int b = wq >> 7; const float* mb = WSP(float, WS_MOD) + (size_t)b * 6144;
        for (int tt = 0; tt < 16; ++tt) {
            const size_t t = (size_t)wq * 16 + tt;
            unsigned lo16 = 16u * (unsigned)lane; asm volatile("" : "+v"(lo16));
            float* xr = (float*)((char*)(F.out + t * 1024) + 4u * lo16);
            const int e_lo = WSP(int, WS_EID)[t * 128 + lane], e_hi = WSP(int, WS_EID)[t * 128 + 64 + lane];
            const float g_lo = WSP(float, WS_GATE)[t * 128 + lane], g_hi = WSP(float, WS_GATE)[t * 128 + 64 + lane];
            const float su_lo = WSP(float, WS_EUS)[e_lo], su_hi = WSP(float, WS_EUS)[e_hi], sv_lo = WSP(float, WS_EVS)[e_lo], sv_hi = WSP(float, WS_EVS)[e_hi];
            const float rs = rsqrt_f(WSP(float, WS_ROWSTAT)[t] * (1.0f / 1024.0f) + EPSF);
            const char* xs = (const char*)(WSP(bf16, WS_X1S) + t * 1024) + 2u * lo16; const v4u xa = *(const v4u*)xs, xb = *(const v4u*)(xs + 16);
            float h2[16]; unpack8(xa, h2); unpack8(xb, h2 + 8);
#pragma unroll
            for (int q = 0; q < 4; ++q) { const f32x4 sh = *(const f32x4*)(mb + 3072 + 16 * lane + 4 * q);
#pragma unroll
                for (int e = 0; e < 4; ++e) h2[4 * q + e] = h2[4 * q + e] * rs + sh[e]; }
            f32x2 o[8];
#pragma unroll
            for (int i = 0; i < 8; ++i) o[i] = (f32x2){0.f, 0.f};
            v4u qu[8], qv[8], nu[8], nv[8];
#pragma unroll
            for (int j = 0; j < 8; ++j) { const int e = __builtin_amdgcn_readlane(e_lo, j); const unsigned off = (unsigned)e * 1024u + l16; qu[j] = *(const v4u*)(EU + off); qv[j] = *(const v4u*)(EV + off); }
#pragma unroll 1
            for (int grp = 0; grp < 16; ++grp) {
                const int nb = ((grp + 1) & 7) * 8; const int ensel = (grp + 1) < 8 ? e_lo : e_hi;
                if (grp < 15) {
#pragma unroll
                    for (int j = 0; j < 8; ++j) { const int e = __builtin_amdgcn_readlane(ensel, nb + j); const unsigned off = (unsigned)e * 1024u + l16; nu[j] = *(const v4u*)(EU + off); nv[j] = *(const v4u*)(EV + off); } }
                const int base = (grp & 7) * 8;
                const float gsel = grp < 8 ? g_lo : g_hi, susel = grp < 8 ? su_lo : su_hi, svsel = grp < 8 ? sv_lo : sv_hi;
                float d[8];
#pragma unroll
                for (int j = 0; j < 8; ++j) { float f[16]; dec16(qu[j], f); float a = 0.f;
#pragma unroll
                    for (int i = 0; i < 16; ++i) a += h2[i] * f[i];
                    d[j] = a; }
                float e4[4], e2[2], e1;
#pragma unroll
                for (int i = 0; i < 4; ++i) { const bool up = lane & 32; const float snd = up ? d[i] : d[i + 4]; const float rcv = __shfl_xor(snd, 32); e4[i] = (up ? d[i + 4] : d[i]) + rcv; }
#pragma unroll
                for (int i = 0; i < 2; ++i) { const bool up = lane & 16; const float snd = up ? e4[i] : e4[i + 2]; const float rcv = __shfl_xor(snd, 16); e2[i] = (up ? e4[i + 2] : e4[i]) + rcv; }
                { const bool up = lane & 8; const float snd = up ? e2[0] : e2[1]; const float rcv = __shfl_xor(snd, 8); e1 = (up ? e2[1] : e2[0]) + rcv; }
                e1 += __shfl_xor(e1, 4); e1 += __shfl_xor(e1, 2); e1 += __shfl_xor(e1, 1);
                const float wmine = __shfl(gsel, base + myj) * gelu_erf(e1 * __shfl(susel, base + myj)) * __shfl(svsel, base + myj);
#pragma unroll
                for (int j = 0; j < 8; ++j) { const int src = ((j >> 2) & 1) * 32 + ((j >> 1) & 1) * 16 + (j & 1) * 8; const float wj = __builtin_bit_cast(float, __builtin_amdgcn_readlane(__builtin_bit_cast(int, wmine), src)); const f32x2 w2 = (f32x2){wj, wj};
#pragma unroll
                    for (int i = 0; i < 4; ++i) { const f32x2 lo = __builtin_amdgcn_cvt_pk_f32_fp8((int)qv[j][i], false), hi = __builtin_amdgcn_cvt_pk_f32_fp8((int)qv[j][i], true); o[2 * i] += w2 * lo; o[2 * i + 1] += w2 * hi; } }
#pragma unroll
                for (int j = 0; j < 8; ++j) { qu[j] = nu[j]; qv[j] = nv[j]; }
            }
            float x1[16]; float ss = 0.f;
#pragma unroll
            for (int q = 0; q < 4; ++q) { const f32x4 v = *(const f32x4*)(xr + 4 * q); x1[4 * q] = v[0]; x1[4 * q + 1] = v[1]; x1[4 * q + 2] = v[2]; x1[4 * q + 3] = v[3]; }
#pragma unroll
            for (int q = 0; q < 4; ++q) { const f32x4 gt = *(const f32x4*)(mb + 5120 + 16 * lane + 4 * q);
#pragma unroll
                for (int e = 0; e < 4; ++e) { const int i = 4 * q + e; x1[i] += gt[e] * o[i >> 1][i & 1]; ss += x1[i] * x1[i]; } }
            const float rf = rsqrt_f(wave_sum(ss) * (1.0f / 1024.0f) + EPSF);
#pragma unroll
            for (int q = 0; q < 4; ++q) { const f32x4 nf = *(const f32x4*)((F.a->in[29]) + 16 * lane + 4 * q); f32x4 v;
#pragma unroll
                for (int e = 0; e < 4; ++e) v[e] = x1[4 * q + e] * rf * nf[e];
                *(f32x4*)(xr + 4 * q) = v; }
        }
    }
}
struct PeerMeta { unsigned long long st; float rs; v4u xa, xb; int elo, ehi; float glo, ghi; };
__device__ __forceinline__ void peer_meta_load(PeerMeta& M, const unsigned char* ws, size_t t, unsigned l16) {
    M.st = ((const unsigned long long*)(ws + WS_START))[t]; M.rs = ((const float*)(ws + WS_ROWSTAT))[t];
    const char* xs = (const char*)(ws + WS_X1S) + t * 2048 + 2u * l16; M.xa = *(const v4u*)xs; M.xb = *(const v4u*)(xs + 16);
    const int* ep = (const int*)(ws + WS_EID) + t * 128; const float* gp = (const float*)(ws + WS_GATE) + t * 128;
    const unsigned l = l16 >> 4; M.elo = ep[l]; M.ehi = ep[64 + l]; M.glo = gp[l]; M.ghi = gp[64 + l];
}
__device__ __forceinline__ void peer_rows_issue(int elo, int ehi, float glo, float ghi, int i0, int iend, const unsigned char* EU, const float* EUS, const float* EVS, unsigned l16, int lane, v4u* q, float& gmine, float& su, float& sv) {
    int idx = i0 + (lane & 7); idx = idx < iend ? idx : iend - 1; idx = idx < 0 ? 0 : (idx > 127 ? 127 : idx);
    const int ea = __shfl(elo, idx & 63), eb = __shfl(ehi, idx & 63); const int emine = idx < 64 ? ea : eb;
    const float ga = __shfl(glo, idx & 63), gb = __shfl(ghi, idx & 63); gmine = idx < 64 ? ga : gb;
#pragma unroll
    for (int j = 0; j < 8; ++j) { const int e = __builtin_amdgcn_readlane(emine, j); q[j] = *(const v4u*)(EU + ((unsigned)e * 1024u + l16)); }
    su = EUS[emine]; sv = EVS[emine];
}
__device__ __forceinline__ void p8_peer_up2(Frame& F) {
    const int f_tid = threadIdx.x, lane = f_tid & 63, f_wave = __builtin_amdgcn_readfirstlane(f_tid >> 6);
    const unsigned char* EU = F.ws + WS_EU; const float* EUS = WSP(float, WS_EUS); const float* EVS = WSP(float, WS_EVS);
    unsigned* ctr = (unsigned*)(F.ws + WS_CTL) + 8192;
    int rr = (int)(xb_xcc_id() & 7u), tries = 0;
    for (;;) {
        int blk = 0;
        if (lane == 0) blk = (int)__hip_atomic_fetch_add(ctr + 64 * rr, 1u, __ATOMIC_RELAXED, __HIP_MEMORY_SCOPE_AGENT);
        blk = __builtin_amdgcn_readfirstlane(blk);
        if (blk >= MTOK / 128) { if (++tries >= 8) break; rr = (rr + 1) & 7; continue; }
        const int b = blk >> 4; const float* mb = WSP(float, WS_MOD) + (size_t)b * 6144;
        unsigned l16 = 16u * (unsigned)lane; asm volatile("" : "+v"(l16));
        float S2[16];
#pragma unroll
        for (int q = 0; q < 4; ++q) { const f32x4 sh = *(const f32x4*)((const char*)(mb + 3072) + 4u * l16 + 16 * q); S2[4 * q] = sh[0]; S2[4 * q + 1] = sh[1]; S2[4 * q + 2] = sh[2]; S2[4 * q + 3] = sh[3]; }
        const size_t tb = (size_t)blk * 128;
        PeerMeta M0, M1, M2, M3, M4;
        peer_meta_load(M0, F.ws, tb, l16); peer_meta_load(M1, F.ws, tb + 1, l16); peer_meta_load(M2, F.ws, tb + 2, l16); peer_meta_load(M3, F.ws, tb + 3, l16);
        v4u qa[8], qb[8]; float ga_, sua, sva, gb_ = 0.f, sub = 0.f, svb = 0.f;
        int s0 = (int)((M0.st >> (8 * rr)) & 255ull), s1 = rr == 7 ? 128 : (int)((M0.st >> (8 * rr + 8)) & 255ull);
        peer_rows_issue(M0.elo, M0.ehi, M0.glo, M0.ghi, s0, s1, EU, EUS, EVS, l16, lane, qa, ga_, sua, sva);
        for (int tt = 0; tt < 128; ++tt) {
            if (tt + 4 < 128) peer_meta_load(M4, F.ws, tb + tt + 4, l16);
            float h2[16]; unpack8(M0.xa, h2); unpack8(M0.xb, h2 + 8);
            const float rs = rsqrt_f(M0.rs * (1.0f / 1024.0f) + EPSF);
#pragma unroll
            for (int i = 0; i < 16; ++i) h2[i] = h2[i] * rs + S2[i];
            const int cnt = s1 - s0, ngrp = cnt > 0 ? (cnt + 7) >> 3 : 1;
            const int n0 = (int)((M1.st >> (8 * rr)) & 255ull), n1 = rr == 7 ? 128 : (int)((M1.st >> (8 * rr + 8)) & 255ull);
            float* gp = WSP(float, WS_GATE) + (tb + tt) * 128;
            for (int g = 0; g < ngrp; ++g) {
                { const bool same = (g + 1 < ngrp);
                  peer_rows_issue(same ? M0.elo : M1.elo, same ? M0.ehi : M1.ehi, same ? M0.glo : M1.glo, same ? M0.ghi : M1.ghi, same ? s0 + 8 * (g + 1) : n0, same ? s1 : n1, EU, EUS, EVS, l16, lane, qb, gb_, sub, svb); }
                __builtin_amdgcn_sched_barrier(0);
                float d[8];
#pragma unroll
                for (int j = 0; j < 8; ++j) { float f[16]; dec16(qa[j], f); float a = 0.f;
#pragma unroll
                    for (int i = 0; i < 16; ++i) a += h2[i] * f[i];
                    d[j] = a; }
                float dmine = 0.f;
#pragma unroll
                for (int j = 0; j < 8; ++j) { const float tot = wave_sum_to63(d[j]); const float sj = __builtin_bit_cast(float, __builtin_amdgcn_readlane(__builtin_bit_cast(int, tot), 63)); dmine = (lane == j) ? sj : dmine; }
                const float wv = ga_ * gelu_erf(dmine * sua) * sva;
                { const int idx = s0 + 8 * g + lane; if (lane < 8 && idx < s1) gp[idx] = wv; }
#pragma unroll
                for (int j = 0; j < 8; ++j) qa[j] = qb[j];
                ga_ = gb_; sua = sub; sva = svb;
                asm volatile("" : "+v"(ga_), "+v"(sua), "+v"(sva));
            }
            M0 = M1; M1 = M2; M2 = M3; M3 = M4; s0 = n0; s1 = n1;
        }
    }
}
__device__ __forceinline__ void xcc_rendezvous(Frame& F, const XcdBarrier& bar, int which);
__device__ __forceinline__ void p9_peer_down2(Frame& F, const XcdBarrier& bar) {
    const int f_tid = threadIdx.x, lane = f_tid & 63, f_wave = __builtin_amdgcn_readfirstlane(f_tid >> 6);
    const unsigned char* EV = F.ws + WS_EV;
    for (int wq = F.vcu * NWAVES + f_wave; wq < MTOK / 16; wq += F.G * NWAVES) {
        const int b = wq >> 7; const float* mb = WSP(float, WS_MOD) + (size_t)b * 6144;
        for (int tt = 0; tt < 16; ++tt) {
            const size_t t = (size_t)wq * 16 + tt;
            unsigned l16 = 16u * (unsigned)lane; asm volatile("" : "+v"(l16));
            float* xr = (float*)((char*)(F.out + t * 1024) + 4u * l16);
            const int e_lo = WSP(int, WS_EID)[t * 128 + lane], e_hi = WSP(int, WS_EID)[t * 128 + 64 + lane];
            const float w_lo = WSP(float, WS_GATE)[t * 128 + lane], w_hi = WSP(float, WS_GATE)[t * 128 + 64 + lane];
            f32x2 o[8];
#pragma unroll
            for (int i = 0; i < 8; ++i) o[i] = (f32x2){0.f, 0.f};
            v4u qa[8], qb[8];
#pragma unroll
            for (int j = 0; j < 8; ++j) { const int e = __builtin_amdgcn_readlane(e_lo, j); qa[j] = *(const v4u*)(EV + ((unsigned)e * 1024u + l16)); }
#define DN2_STEP(GRP, CUR, NXT) { \
                const int grp = (GRP); const int nb = ((grp + 1) & 7) * 8; const int ensel = (grp + 1) < 8 ? e_lo : e_hi; \
                { _Pragma("unroll") for (int j = 0; j < 8; ++j) { const int e = __builtin_amdgcn_readlane(ensel, nb + j); NXT[j] = *(const v4u*)(EV + ((unsigned)e * 1024u + l16)); } } \
                __builtin_amdgcn_sched_barrier(0); \
                const int base = (grp & 7) * 8; const float wsel = grp < 8 ? w_lo : w_hi; \
                _Pragma("unroll") for (int j = 0; j < 8; ++j) { const float wj = __builtin_bit_cast(float, __builtin_amdgcn_readlane(__builtin_bit_cast(int, wsel), base + j)); const f32x2 w2 = (f32x2){wj, wj}; \
                    _Pragma("unroll") for (int i = 0; i < 4; ++i) { const f32x2 lo = __builtin_amdgcn_cvt_pk_f32_fp8((int)CUR[j][i], false), hi = __builtin_amdgcn_cvt_pk_f32_fp8((int)CUR[j][i], true); o[2 * i] += w2 * lo; o[2 * i + 1] += w2 * hi; } } }
#pragma unroll 1
            for (int g2 = 0; g2 < 16; g2 += 2) { DN2_STEP(g2, qa, qb) DN2_STEP(g2 + 1, qb, qa) }
#undef DN2_STEP
            float x1[16]; float ss = 0.f;
#pragma unroll
            for (int q4 = 0; q4 < 4; ++q4) { const f32x4 v = *(const f32x4*)(xr + 4 * q4); x1[4 * q4] = v[0]; x1[4 * q4 + 1] = v[1]; x1[4 * q4 + 2] = v[2]; x1[4 * q4 + 3] = v[3]; }
#pragma unroll
            for (int q4 = 0; q4 < 4; ++q4) { const f32x4 gt = *(const f32x4*)((const char*)(mb + 5120) + 4u * l16 + 16 * q4);
#pragma unroll
                for (int e = 0; e < 4; ++e) { const int i = 4 * q4 + e; x1[i] += gt[e] * o[i >> 1][i & 1]; ss += x1[i] * x1[i]; } }
            const float rf = rsqrt_f(wave_sum(ss) * (1.0f / 1024.0f) + EPSF);
#pragma unroll
            for (int q4 = 0; q4 < 4; ++q4) { const f32x4 nf = *(const f32x4*)((const char*)(F.a->in[29]) + 4u * l16 + 16 * q4); f32x4 v;
#pragma unroll
                for (int e = 0; e < 4; ++e) v[e] = x1[4 * q4 + e] * rf * nf[e];
                *(f32x4*)(xr + 4 * q4) = v; }
        }
    }
}
__device__ __forceinline__ void xcc_rendezvous(Frame& F, const XcdBarrier& bar, int which) {
    __syncthreads();
    if (threadIdx.x == 0) {
        unsigned* w = (unsigned*)(F.ws + WS_CTL) + 9216 + which * 2048;
        const unsigned nloc = bar.st[0] ? bar.st[0] : 1u; const unsigned x = bar.x;
        const unsigned old = xb_add(&w[64 * x], 1u); const unsigned gen = old / nloc;
        if (old + 1u == (gen + 1u) * nloc) xb_add(&w[1024 + 64 * x], 1u);
        else { unsigned sp = 0; while (xb_ld(&w[1024 + 64 * x]) == gen) { __builtin_amdgcn_s_sleep(1); if (++sp > (1u << 16)) break; } }
    }
    __syncthreads();
}
__device__ __forceinline__ void p8_peer_up3(Frame& F, const XcdBarrier& bar) {
    const int f_tid = threadIdx.x, lane = f_tid & 63, f_wave = __builtin_amdgcn_readfirstlane(f_tid >> 6);
    const unsigned char* EU = F.ws + WS_EU; const float* EUS = WSP(float, WS_EUS); const float* EVS = WSP(float, WS_EVS);
    for (int wq = F.vcu * NWAVES + f_wave; wq < MTOK / 16; wq += F.G * NWAVES) {
        const int b = wq >> 7; const float* mb = WSP(float, WS_MOD) + (size_t)b * 6144;
        for (int tt = 0; tt < 16; ++tt) {
            const size_t t = (size_t)wq * 16 + tt;
            unsigned l16 = 16u * (unsigned)lane; asm volatile("" : "+v"(l16));
            const int e_lo = WSP(int, WS_EID)[t * 128 + lane], e_hi = WSP(int, WS_EID)[t * 128 + 64 + lane];
            const float g_lo = WSP(float, WS_GATE)[t * 128 + lane], g_hi = WSP(float, WS_GATE)[t * 128 + 64 + lane];
#ifdef PROBE_NOSCALE
            const float su_lo = 5.6e-4f, su_hi = 5.6e-4f, sv_lo = 6.3e-3f, sv_hi = 6.3e-3f;
#else
            const float su_lo = EUS[e_lo], su_hi = EUS[e_hi], sv_lo = EVS[e_lo], sv_hi = EVS[e_hi];
#endif
            const float rs = rsqrt_f(WSP(float, WS_ROWSTAT)[t] * (1.0f / 1024.0f) + EPSF);
            const char* xs = (const char*)(WSP(bf16, WS_X1S) + t * 1024) + 2u * l16; const v4u xa = *(const v4u*)xs, xb = *(const v4u*)(xs + 16);
            float h2[16]; unpack8(xa, h2); unpack8(xb, h2 + 8);
            f32x2 h2p[8];
#pragma unroll
            for (int q = 0; q < 4; ++q) { const f32x4 sh = *(const f32x4*)((const char*)(mb + 3072) + 4u * l16 + 16 * q);
                h2p[2 * q] = (f32x2){h2[4 * q] * rs + sh[0], h2[4 * q + 1] * rs + sh[1]}; h2p[2 * q + 1] = (f32x2){h2[4 * q + 2] * rs + sh[2], h2[4 * q + 3] * rs + sh[3]}; }
            float w_lo = 0.f, w_hi = 0.f;
            v4u qa[8], qb[8];
#pragma unroll
            for (int j = 0; j < 8; ++j) { const int e = __builtin_amdgcn_readlane(e_lo, j); qa[j] = *(const v4u*)(EU + ((unsigned)e * 1024u + l16)); }
#define UP3_STEP(GRP, CUR, NXT) { \
                const int grp = (GRP); const int nb = ((grp + 1) & 7) * 8; const int ensel = (grp + 1) < 8 ? e_lo : e_hi; \
                  \
                { _Pragma("unroll") for (int j = 0; j < 8; ++j) { const int e = __builtin_amdgcn_readlane(ensel, nb + j); NXT[j] = *(const v4u*)(EU + ((unsigned)e * 1024u + l16)); } } \
                __builtin_amdgcn_sched_barrier(0); \
                const int base = (grp & 7) * 8; float dmine = 0.f; \
                _Pragma("unroll") for (int j = 0; j < 8; ++j) { f32x2 a0 = (f32x2){0.f, 0.f}, a1 = (f32x2){0.f, 0.f}; \
                    _Pragma("unroll") for (int i = 0; i < 4; ++i) { const f32x2 lo = __builtin_amdgcn_cvt_pk_f32_fp8((int)CUR[j][i], false), hi = __builtin_amdgcn_cvt_pk_f32_fp8((int)CUR[j][i], true); a0 += h2p[2 * i] * lo; a1 += h2p[2 * i + 1] * hi; } \
                    const float a = (a0[0] + a0[1]) + (a1[0] + a1[1]); \
                    const float tot = wave_sum_to63(a); const float sj = __builtin_bit_cast(float, __builtin_amdgcn_readlane(__builtin_bit_cast(int, tot), 63)); \
                    dmine = (lane == base + j) ? sj : dmine; } \
                const float gsel = grp < 8 ? g_lo : g_hi, susel = grp < 8 ? su_lo : su_hi, svsel = grp < 8 ? sv_lo : sv_hi; \
                const float wv = gsel * gelu_erf(dmine * susel) * svsel; \
                const bool mine = (lane >= base) && (lane < base + 8); \
                if (grp < 8) w_lo = mine ? wv : w_lo; else w_hi = mine ? wv : w_hi; }
#pragma unroll 1
            for (int g2 = 0; g2 < 16; g2 += 2) { UP3_STEP(g2, qa, qb) UP3_STEP(g2 + 1, qb, qa) }
#undef UP3_STEP
            WSP(float, WS_GATE)[t * 128 + lane] = w_lo; WSP(float, WS_GATE)[t * 128 + 64 + lane] = w_hi;
        }
    }
}
typedef long i64_t;
__device__ __forceinline__ void p8_peer_up4(Frame& F) {
    const int f_tid = threadIdx.x, lane = f_tid & 63, f_wave = __builtin_amdgcn_readfirstlane(f_tid >> 6);
    const int li = lane & 15, lq = lane >> 4;
    const unsigned char* EU = F.ws + WS_EU; const float* EUS = WSP(float, WS_EUS); const float* EVS = WSP(float, WS_EVS);
    LAS unsigned char* hq = F.lds + f_wave * 1024;
    for (int wq = F.vcu * NWAVES + f_wave; wq < MTOK / 16; wq += F.G * NWAVES) {
        const int b = wq >> 7; const float* mb = WSP(float, WS_MOD) + (size_t)b * 6144;
        for (int tt = 0; tt < 16; ++tt) {
            const size_t t = (size_t)wq * 16 + tt;
            unsigned l16 = 16u * (unsigned)lane; asm volatile("" : "+v"(l16));
            const unsigned rowoff = 16u * (unsigned)lq;
            const int e_lo = WSP(int, WS_EID)[t * 128 + lane], e_hi = WSP(int, WS_EID)[t * 128 + 64 + lane];
            const float g_lo = WSP(float, WS_GATE)[t * 128 + lane], g_hi = WSP(float, WS_GATE)[t * 128 + 64 + lane];
            v4u q[8], nq[8];
            { const int e = __shfl(e_lo, li);
#pragma unroll
              for (int c = 0; c < 8; ++c) q[c] = *(const v4u*)(EU + ((unsigned)e * 1024u + 64u * c + rowoff)); }
            const float su_lo = EUS[e_lo], su_hi = EUS[e_hi], sv_lo = EVS[e_lo], sv_hi = EVS[e_hi];
            const float rs = rsqrt_f(WSP(float, WS_ROWSTAT)[t] * (1.0f / 1024.0f) + EPSF);
            const char* xs = (const char*)(WSP(bf16, WS_X1S) + t * 1024) + 2u * l16; const v4u xa = *(const v4u*)xs, xb = *(const v4u*)(xs + 16);
            float h2[16]; unpack8(xa, h2); unpack8(xb, h2 + 8); float mx = 0.f;
#pragma unroll
            for (int qd = 0; qd < 4; ++qd) { const f32x4 sh = *(const f32x4*)((const char*)(mb + 3072) + 4u * l16 + 16 * qd);
#pragma unroll
                for (int e = 0; e < 4; ++e) { h2[4 * qd + e] = h2[4 * qd + e] * rs + sh[e]; mx = fmaxf(mx, fabsf(h2[4 * qd + e])); } }
#pragma unroll
            for (int o = 1; o < 64; o <<= 1) mx = fmaxf(mx, __shfl_xor(mx, o));
            mx = fmaxf(mx, 1e-30f); const float hs = 224.0f / mx, hinv = mx * (1.0f / 224.0f);
            { v4u w;
#pragma unroll
              for (int qd = 0; qd < 4; ++qd) { int pk = 0; pk = __builtin_amdgcn_cvt_pk_fp8_f32(h2[4 * qd] * hs, h2[4 * qd + 1] * hs, pk, false); pk = __builtin_amdgcn_cvt_pk_fp8_f32(h2[4 * qd + 2] * hs, h2[4 * qd + 3] * hs, pk, true); w[qd] = (unsigned)pk; }
              *(LAS v4u*)(hq + l16) = w; }
            LDS_WAIT(); asm volatile("" ::: "memory");
            v4u hb[16];
#pragma unroll
            for (int c = 0; c < 16; ++c) hb[c] = *(const LAS v4u*)(hq + 64 * c + rowoff);
            float w_lo = 0.f, w_hi = 0.f;
            f32x4 acc = (f32x4){0.f, 0.f, 0.f, 0.f};
#pragma unroll 1
            for (int u = 0; u < 16; ++u) {
                if (u < 15) { const int g1 = (u + 1) >> 1, kh = (u + 1) & 1; const int e = __shfl(g1 < 4 ? e_lo : e_hi, 16 * (g1 & 3) + li);
#pragma unroll
                    for (int c = 0; c < 8; ++c) nq[c] = *(const v4u*)(EU + ((unsigned)e * 1024u + 512u * kh + 64u * c + rowoff)); }
                __builtin_amdgcn_sched_barrier(0);
                if ((u & 1) == 0) {
#pragma unroll
                    for (int c = 0; c < 8; ++c) { acc = __builtin_amdgcn_mfma_f32_16x16x32_fp8_fp8((i64_t)(((unsigned long long)q[c][1] << 32) | q[c][0]), (i64_t)(((unsigned long long)hb[c][1] << 32) | hb[c][0]), acc, 0, 0, 0);
                        acc = __builtin_amdgcn_mfma_f32_16x16x32_fp8_fp8((i64_t)(((unsigned long long)q[c][3] << 32) | q[c][2]), (i64_t)(((unsigned long long)hb[c][3] << 32) | hb[c][2]), acc, 0, 0, 0); }
                } else {
#pragma unroll
                    for (int c = 0; c < 8; ++c) { acc = __builtin_amdgcn_mfma_f32_16x16x32_fp8_fp8((i64_t)(((unsigned long long)q[c][1] << 32) | q[c][0]), (i64_t)(((unsigned long long)hb[8 + c][1] << 32) | hb[8 + c][0]), acc, 0, 0, 0);
                        acc = __builtin_amdgcn_mfma_f32_16x16x32_fp8_fp8((i64_t)(((unsigned long long)q[c][3] << 32) | q[c][2]), (i64_t)(((unsigned long long)hb[8 + c][3] << 32) | hb[8 + c][2]), acc, 0, 0, 0); }
                    const int g = u >> 1; const int r = li & 3;
                    const float sel = r == 0 ? acc[0] : (r == 1 ? acc[1] : (r == 2 ? acc[2] : acc[3]));
                    const float dmine = __shfl(sel, ((li >> 2) & 3) * 16 + (li & 3));
                    const float gsel = g < 4 ? g_lo : g_hi, susel = g < 4 ? su_lo : su_hi, svsel = g < 4 ? sv_lo : sv_hi;
                    const float wv = gsel * gelu_erf(dmine * susel * hinv) * svsel;
                    const bool mine = (lane >> 4) == (g & 3);
                    if (g < 4) w_lo = mine ? wv : w_lo; else w_hi = mine ? wv : w_hi;
                    acc = (f32x4){0.f, 0.f, 0.f, 0.f};
                }
#pragma unroll
                for (int c = 0; c < 8; ++c) q[c] = nq[c];
            }
            WSP(float, WS_GATE)[t * 128 + lane] = w_lo; WSP(float, WS_GATE)[t * 128 + 64 + lane] = w_hi;
        }
    }
}
__device__ __forceinline__ void p8_peer_fused2(Frame& F) {
    const int f_tid = threadIdx.x, lane = f_tid & 63, f_wave = __builtin_amdgcn_readfirstlane(f_tid >> 6);
    const unsigned char* EU = F.ws + WS_EU; const unsigned char* EV = F.ws + WS_EV; const float* EUS = WSP(float, WS_EUS); const float* EVS = WSP(float, WS_EVS);
    for (int wq = F.vcu * NWAVES + f_wave; wq < MTOK / 16; wq += F.G * NWAVES) {
        const int b = wq >> 7; const float* mb = WSP(float, WS_MOD) + (size_t)b * 6144;
        for (int tt = 0; tt < 16; ++tt) {
            const size_t t = (size_t)wq * 16 + tt;
            unsigned l16 = 16u * (unsigned)lane; asm volatile("" : "+v"(l16));
            float* xr = (float*)((char*)(F.out + t * 1024) + 4u * l16);
            const int e_lo = WSP(int, WS_EID)[t * 128 + lane], e_hi = WSP(int, WS_EID)[t * 128 + 64 + lane];
            const float g_lo = WSP(float, WS_GATE)[t * 128 + lane], g_hi = WSP(float, WS_GATE)[t * 128 + 64 + lane];
            v4u qu[8], qv[8], nu[8], nv[8];
#pragma unroll
            for (int j = 0; j < 8; ++j) { const int e = __builtin_amdgcn_readlane(e_lo, j); const unsigned off = (unsigned)e * 1024u + l16; qu[j] = *(const v4u*)(EU + off); qv[j] = *(const v4u*)(EV + off); }
            const float su_lo = EUS[e_lo], su_hi = EUS[e_hi], sv_lo = EVS[e_lo], sv_hi = EVS[e_hi];
            const float rs = rsqrt_f(WSP(float, WS_ROWSTAT)[t] * (1.0f / 1024.0f) + EPSF);
            const char* xs = (const char*)(WSP(bf16, WS_X1S) + t * 1024) + 2u * l16; const v4u xa = *(const v4u*)xs, xb = *(const v4u*)(xs + 16);
            float h2[16]; unpack8(xa, h2); unpack8(xb, h2 + 8);
            f32x2 h2p[8];
#pragma unroll
            for (int q = 0; q < 4; ++q) { const f32x4 sh = *(const f32x4*)((const char*)(mb + 3072) + 4u * l16 + 16 * q);
                h2p[2 * q] = (f32x2){h2[4 * q] * rs + sh[0], h2[4 * q + 1] * rs + sh[1]}; h2p[2 * q + 1] = (f32x2){h2[4 * q + 2] * rs + sh[2], h2[4 * q + 3] * rs + sh[3]}; }
            f32x2 o[8];
#pragma unroll
            for (int i = 0; i < 8; ++i) o[i] = (f32x2){0.f, 0.f};
#pragma unroll 1
            for (int grp = 0; grp < 16; ++grp) {
                const int nb = ((grp + 1) & 7) * 8; const int ensel = (grp + 1) < 8 ? e_lo : e_hi;
                if (grp < 15) {
#pragma unroll
                    for (int j = 0; j < 8; ++j) { const int e = __builtin_amdgcn_readlane(ensel, nb + j); const unsigned off = (unsigned)e * 1024u + l16; nu[j] = *(const v4u*)(EU + off); nv[j] = *(const v4u*)(EV + off); } }
                __builtin_amdgcn_sched_barrier(0);
                const int base = (grp & 7) * 8;
                float dmine = 0.f;
#pragma unroll
                for (int j = 0; j < 8; ++j) { f32x2 a0 = (f32x2){0.f, 0.f}, a1 = (f32x2){0.f, 0.f};
#pragma unroll
                    for (int i = 0; i < 4; ++i) { const f32x2 lo = __builtin_amdgcn_cvt_pk_f32_fp8((int)qu[j][i], false), hi = __builtin_amdgcn_cvt_pk_f32_fp8((int)qu[j][i], true); a0 += h2p[2 * i] * lo; a1 += h2p[2 * i + 1] * hi; }
                    const float a = (a0[0] + a0[1]) + (a1[0] + a1[1]);
                    const float tot = wave_sum_to63(a); const float sj = __builtin_bit_cast(float, __builtin_amdgcn_readlane(__builtin_bit_cast(int, tot), 63));
                    dmine = (lane == base + j) ? sj : dmine; }
                const float gsel = grp < 8 ? g_lo : g_hi, susel = grp < 8 ? su_lo : su_hi, svsel = grp < 8 ? sv_lo : sv_hi;
                const float wv = gsel * gelu_erf(dmine * susel) * svsel;
#pragma unroll
                for (int j = 0; j < 8; ++j) { const float wj = __builtin_bit_cast(float, __builtin_amdgcn_readlane(__builtin_bit_cast(int, wv), base + j)); const f32x2 w2 = (f32x2){wj, wj};
#pragma unroll
                    for (int i = 0; i < 4; ++i) { const f32x2 lo = __builtin_amdgcn_cvt_pk_f32_fp8((int)qv[j][i], false), hi = __builtin_amdgcn_cvt_pk_f32_fp8((int)qv[j][i], true); o[2 * i] += w2 * lo; o[2 * i + 1] += w2 * hi; } }
#pragma unroll
                for (int j = 0; j < 8; ++j) { qu[j] = nu[j]; qv[j] = nv[j]; }
            }
            float x1[16]; float ss = 0.f;
#pragma unroll
            for (int q4 = 0; q4 < 4; ++q4) { const f32x4 v = *(const f32x4*)(xr + 4 * q4); x1[4 * q4] = v[0]; x1[4 * q4 + 1] = v[1]; x1[4 * q4 + 2] = v[2]; x1[4 * q4 + 3] = v[3]; }
#pragma unroll
            for (int q4 = 0; q4 < 4; ++q4) { const f32x4 gt = *(const f32x4*)((const char*)(mb + 5120) + 4u * l16 + 16 * q4);
#pragma unroll
                for (int e = 0; e < 4; ++e) { const int i = 4 * q4 + e; x1[i] += gt[e] * o[i >> 1][i & 1]; ss += x1[i] * x1[i]; } }
            const float rf = rsqrt_f(wave_sum(ss) * (1.0f / 1024.0f) + EPSF);
#pragma unroll
            for (int q4 = 0; q4 < 4; ++q4) { const f32x4 nf = *(const f32x4*)((const char*)(F.a->in[29]) + 4u * l16 + 16 * q4); f32x4 v;
#pragma unroll
                for (int e = 0; e < 4; ++e) v[e] = x1[4 * q4 + e] * rf * nf[e];
                *(f32x4*)(xr + 4 * q4) = v; }
        }
    }
}
constexpr int U6_ROWP = 1040, U6_BUF = 8 * U6_ROWP, U6_WAVE = 2 * U6_BUF + 1024;
static_assert(8 * U6_WAVE <= LDS_MAIN, "U6 LDS map");
__device__ __forceinline__ void p8_peer_up6(Frame& F) {
    const int f_tid = threadIdx.x, lane = f_tid & 63, f_wave = __builtin_amdgcn_readfirstlane(f_tid >> 6);
    const int li = lane & 15, lq = lane >> 4;
    const unsigned char* EU = F.ws + WS_EU; const float* EUS = WSP(float, WS_EUS); const float* EVS = WSP(float, WS_EVS);
    LAS unsigned char* ring = F.lds + f_wave * U6_WAVE; LAS unsigned char* hq = ring + 2 * U6_BUF;
    for (int wq = F.vcu * NWAVES + f_wave; wq < MTOK / 16; wq += F.G * NWAVES) {
        const int b = wq >> 7; const float* mb = WSP(float, WS_MOD) + (size_t)b * 6144;
        for (int tt = 0; tt < 16; ++tt) {
            const size_t t = (size_t)wq * 16 + tt;
            unsigned l16 = 16u * (unsigned)lane; asm volatile("" : "+v"(l16));
            const int e_lo = WSP(int, WS_EID)[t * 128 + lane], e_hi = WSP(int, WS_EID)[t * 128 + 64 + lane];
            const float g_lo = WSP(float, WS_GATE)[t * 128 + lane], g_hi = WSP(float, WS_GATE)[t * 128 + 64 + lane];
            const float rs = rsqrt_f(WSP(float, WS_ROWSTAT)[t] * (1.0f / 1024.0f) + EPSF);
            const char* xs = (const char*)(WSP(bf16, WS_X1S) + t * 1024) + 2u * l16; const v4u xa = *(const v4u*)xs, xb = *(const v4u*)(xs + 16);
            asm volatile("s_waitcnt vmcnt(0)" ::: "memory");
#pragma unroll
            for (int j = 0; j < 8; ++j) { const int e = __builtin_amdgcn_readlane(e_lo, j);
                __builtin_amdgcn_global_load_lds((const unsigned*)(EU + ((unsigned)e * 1024u + l16)), (LAS unsigned*)(ring + j * U6_ROWP), 16, 0, 0); }
            const float su_lo = EUS[e_lo], su_hi = EUS[e_hi], sv_lo = EVS[e_lo], sv_hi = EVS[e_hi];
            float h2[16]; unpack8(xa, h2); unpack8(xb, h2 + 8); float mx = 0.f;
#pragma unroll
            for (int qd = 0; qd < 4; ++qd) { const f32x4 sh = *(const f32x4*)((const char*)(mb + 3072) + 4u * l16 + 16 * qd);
#pragma unroll
                for (int e = 0; e < 4; ++e) { h2[4 * qd + e] = h2[4 * qd + e] * rs + sh[e]; mx = fmaxf(mx, fabsf(h2[4 * qd + e])); } }
#pragma unroll
            for (int o = 1; o < 64; o <<= 1) mx = fmaxf(mx, __shfl_xor(mx, o));
            mx = fmaxf(mx, 1e-30f); const float hs = 224.0f / mx, hinv = mx * (1.0f / 224.0f);
            { v4u w;
#pragma unroll
              for (int qd = 0; qd < 4; ++qd) { int pk = 0; pk = __builtin_amdgcn_cvt_pk_fp8_f32(h2[4 * qd] * hs, h2[4 * qd + 1] * hs, pk, false); pk = __builtin_amdgcn_cvt_pk_fp8_f32(h2[4 * qd + 2] * hs, h2[4 * qd + 3] * hs, pk, true); w[qd] = (unsigned)pk; }
              *(LAS v4u*)(hq + l16) = w; }
            LDS_WAIT(); asm volatile("" ::: "memory");
            v4u hb[16];
#pragma unroll
            for (int c = 0; c < 16; ++c) hb[c] = *(const LAS v4u*)(hq + 64 * c + 16 * lq);
            asm volatile("s_waitcnt vmcnt(0)" ::: "memory");
            float w_lo = 0.f, w_hi = 0.f;
#pragma unroll 1
            for (int u = 0; u < 16; ++u) {
                { const int un = (u + 1) & 15; const int ensel = un < 8 ? e_lo : e_hi; const int nb = (un & 7) * 8; LAS unsigned char* dst = ring + ((u + 1) & 1) * U6_BUF;
#pragma unroll
                  for (int j = 0; j < 8; ++j) { const int e = __builtin_amdgcn_readlane(ensel, nb + j);
                      __builtin_amdgcn_global_load_lds((const unsigned*)(EU + ((unsigned)e * 1024u + l16)), (LAS unsigned*)(dst + j * U6_ROWP), 16, 0, 0); } }
                asm volatile("s_waitcnt vmcnt(8)" ::: "memory");
                const LAS unsigned char* src = ring + (u & 1) * U6_BUF + (li & 7) * U6_ROWP + 16 * lq;
                f32x4 acc = (f32x4){0.f, 0.f, 0.f, 0.f};
#pragma unroll
                for (int c = 0; c < 16; ++c) { const v4u a = *(const LAS v4u*)(src + 64 * c);
                    acc = __builtin_amdgcn_mfma_f32_16x16x32_fp8_fp8((i64_t)(((unsigned long long)a[1] << 32) | a[0]), (i64_t)(((unsigned long long)hb[c][1] << 32) | hb[c][0]), acc, 0, 0, 0);
                    acc = __builtin_amdgcn_mfma_f32_16x16x32_fp8_fp8((i64_t)(((unsigned long long)a[3] << 32) | a[2]), (i64_t)(((unsigned long long)hb[c][3] << 32) | hb[c][2]), acc, 0, 0, 0); }
                const int base = (u & 7) * 8; const int r = li & 3;
                const float sel = r == 0 ? acc[0] : (r == 1 ? acc[1] : (r == 2 ? acc[2] : acc[3]));
                const float dmine = __shfl(sel, ((lane & 7) >> 2) * 16 + (lane & 3));
                const float gsel = u < 8 ? g_lo : g_hi, susel = u < 8 ? su_lo : su_hi, svsel = u < 8 ? sv_lo : sv_hi;
                const float wv = gsel * gelu_erf(dmine * susel * hinv) * svsel;
                const bool mine = (lane >= base) && (lane < base + 8);
                if (u < 8) w_lo = mine ? wv : w_lo; else w_hi = mine ? wv : w_hi;
                asm volatile("s_waitcnt lgkmcnt(0)" ::: "memory");
            }
            WSP(float, WS_GATE)[t * 128 + lane] = w_lo; WSP(float, WS_GATE)[t * 128 + 64 + lane] = w_hi;
        }
    }
}
constexpr int NPHASE = 10;
__global__ void __launch_bounds__(NTHR, 2) fwd_mega(Args args) {
    extern __shared__ __attribute__((aligned(16))) unsigned char lds[];
    Frame F;
    F.lds = (LAS unsigned char*)lds;
    F.MISC = (volatile LAS unsigned*)(F.lds + MISC_OFF);
    F.G = gridDim.x; { const int bx = blockIdx.x; F.vcu = (F.G % 8 == 0) ? (bx % 8) * (F.G / 8) + bx / 8 : bx; }
    F.ws = args.ws; F.out = args.out;
    F.a = &args;
    for (int u = threadIdx.x; u < 32; u += NTHR) F.MISC[u] = 0u;
    __syncthreads();
    const int lo = args.ph_lo, hi = args.ph_hi;
    const bool use_bar = (hi - lo) > 1;
    XcdBarrier bar; bar.bar = (unsigned*)(F.ws + WS_CTL); bar.x = 0; bar.st = nullptr;
    if (use_bar) bar = xcd_barrier_post((unsigned*)(F.ws + WS_CTL), F.MISC + 8);
#define IN(k) (lo <= (k) && (k) < hi)
#define SEAM(k) do { if (IN(k) && IN((k) + 1)) xcd_barrier(bar); } while (0)
#ifndef REP_PHASE
#define REP_PHASE -1
#endif
#define REPEAT(k, body) do { if (REP_PHASE == (k)) { xcd_barrier(bar); body; } } while (0)
    if (IN(0)) {
#ifndef SKIP_P0
 p0_phase(F); REPEAT(0, p0_phase(F));
#endif
 } SEAM(0);
    if (IN(1)) {
#ifndef SKIP_P1
 p1_phase(F); REPEAT(1, p1_phase(F));
#endif
 } SEAM(1);
    if (IN(2)) {
        pg8::Gemm g{WSP(bf16, WS_H1), WSP(bf16, WS_WINT), MTOK, NPROJ, 1024}; pg8::StaticOrder S; S.init(MTOK, NPROJ, F.G, (int)blockIdx.x);
        pg8::EpiProj E{WSP(bf16, WS_PROJ), NPROJ};
        pg8::gemm_phase<pg8::EpiProj, pg8::StaticOrder, true, true>(F.lds, g, S, E);
        REPEAT(2, (pg8::gemm_phase<pg8::EpiProj, pg8::StaticOrder, true, true>(F.lds, g, S, E)));
    } SEAM(2);
    if (IN(3)) {
#ifndef SKIP_SSD
#ifdef SSD_NAIVE
 p3_ssd_naive(F);
#elif defined(SSD_V1)
 p3_ssd(F); REPEAT(30, p3_ssd(F));
#elif defined(SSD_V2)
 p3pre_conv(F); xcd_barrier(bar); p3_ssd2(F); REPEAT(30, p3_ssd2(F)); REPEAT(32, p3pre_conv(F));
#else
 p3pre_conv(F); xcd_barrier(bar); p3_ssd3(F); REPEAT(30, p3_ssd3(F)); REPEAT(32, p3pre_conv(F));
#endif
#endif
#ifndef SKIP_S5
#ifdef S5_NAIVE
 p3_s5_naive(F);
#elif defined(S5_V1)
 p3_s5(F); REPEAT(31, p3_s5(F));
#else
 p3_s5v2(F); REPEAT(31, p3_s5v2(F));
#endif
#endif
 } SEAM(3);
#ifdef USE_P3C
    if (IN(4)) { p3c_normalize(F); } SEAM(4);
    if (IN(5)) {
        pg8::Gemm g{WSP(bf16, WS_Y), WSP(bf16, WS_WOUTT), MTOK, 1024, 2048}; pg8::StaticOrder S; S.init(MTOK, 1024, F.G, (int)blockIdx.x);
        PG8_LAS float* tab = (PG8_LAS float*)(F.lds + pg8::STAGE_BYTES);
        for (int i = threadIdx.x; i < 2 * 1280; i += NTHR) tab[i] = 1.0f;
        __syncthreads();
        pg8::EpiX1 E{(F.a->in[0]), F.out, WSP(bf16, WS_X1S), WSP(float, WS_MOD), (F.a->in[24]), WSP(float, WS_ROWSTAT), tab};
        pg8::gemm_phase<pg8::EpiX1, pg8::StaticOrder, true, true>(F.lds, g, S, E);
    } SEAM(5);
#else
    if (IN(5)) {
        pg8::Gemm g{WSP(bf16, WS_Y), WSP(bf16, WS_WOUTT), MTOK, 1024, 2048}; pg8::StaticOrder S; S.init(MTOK, 1024, F.G, (int)blockIdx.x);
        PG8_LAS float* tab = (PG8_LAS float*)(F.lds + pg8::STAGE_BYTES);
        { pg8::Unit u; for (int i = 0; S.next(i, u); ++i) pg8::SegScaleHook::build(F.lds + pg8::STAGE_BYTES, u, WSP(float, WS_STSSD), WSP(float, WS_STS5), (int)threadIdx.x); }
        __syncthreads();
        pg8::EpiX1 E{(F.a->in[0]), F.out, WSP(bf16, WS_X1S), WSP(float, WS_MOD), (F.a->in[24]), WSP(float, WS_ROWSTAT), tab};
        pg8::SegScaleHook H;
        pg8::gemm_phase<pg8::EpiX1, pg8::StaticOrder, true, true, pg8::SegScaleHook>(F.lds, g, S, E, H);
    } SEAM(5);
#endif
    if (IN(6)) {
        pg8::Gemm g{WSP(bf16, WS_X1S), WSP(bf16, WS_WQKT), MTOK, 2048, 1024}; pg8::StaticOrder S; S.init(MTOK, 2048, F.G, (int)blockIdx.x);
        pg8::EpiScores E{WSP(float, WS_SCORES), WSP(float, WS_SB), WSP(float, WS_ROWSTAT)};
        pg8::gemm_phase<pg8::EpiScores, pg8::StaticOrder, true, true>(F.lds, g, S, E);
        REPEAT(6, (pg8::gemm_phase<pg8::EpiScores, pg8::StaticOrder, true, true>(F.lds, g, S, E)));
    } SEAM(6);
    if (IN(7)) {
#ifndef SKIP_TOPK
 p5b_topk(F); REPEAT(7, p5b_topk(F));
#endif
 } SEAM(7);
#ifdef PEER_FUSED
    if (IN(8)) { p8_peer_fused(F); }
#elif defined(PEER_FUSED2)
    if (IN(8)) { p8_peer_fused2(F); }
#else
#ifdef PEER_UP2
    if (IN(8)) { p8_peer_up2(F); } SEAM(8);
#else
#ifndef PEER_UP3
    if (IN(8)) { p8_peer_up6(F); REPEAT(8, { p5b_topk(F); xcd_barrier(bar); p8_peer_up6(F); }); } SEAM(8);
#elif !defined(PEER_UP4)
    if (IN(8)) { p8_peer_up3(F, bar); } SEAM(8);
#else
    if (IN(8)) { p8_peer_up4(F); REPEAT(8, { p5b_topk(F); xcd_barrier(bar); p8_peer_up4(F); }); } SEAM(8);
#endif
#endif
    if (IN(9)) { p9_peer_down2(F, bar); }
#endif
#undef IN
#undef SEAM
}

#ifndef N_LAUNCHES
#define N_LAUNCHES 1
#endif
extern "C" void kernel_launch(void* const* d_in, const int* in_sizes, int n_in, void* d_out, int out_size, void* d_ws, size_t ws_size, hipStream_t stream) {
    static int grid = 0;
    if (grid == 0) {
        if (n_in != 30 || in_sizes[0] != MTOK * DM || out_size != MTOK * DM || ws_size < WS_END) { fprintf(stderr, "kernel_launch: unexpected shapes (n_in %d, in0 %d, out %d, ws %zu)\n", n_in, n_in > 0 ? in_sizes[0] : -1, out_size, ws_size); grid = -1; return; }
        int dev = 0, cus = 0, per_cu = 0;
        if (hipGetDevice(&dev) != hipSuccess || hipDeviceGetAttribute(&cus, hipDeviceAttributeMultiprocessorCount, dev) != hipSuccess) { grid = -1; return; }
        if (hipFuncSetAttribute((const void*)fwd_mega, hipFuncAttributeMaxDynamicSharedMemorySize, LDS_BYTES) != hipSuccess) { fprintf(stderr, "kernel_launch: hipFuncSetAttribute failed\n"); grid = -1; return; }
        if (hipOccupancyMaxActiveBlocksPerMultiprocessor(&per_cu, (const void*)fwd_mega, NTHR, LDS_BYTES) != hipSuccess || per_cu < 1) { fprintf(stderr, "kernel_launch: occupancy query says %d\n", per_cu); (void)hipGetLastError(); grid = -1; return; }
        grid = cus;
    }
    if (grid < 0) return;
    (void)hipMemsetAsync((char*)d_ws + WS_CTL, 0, CTL_ZERO_BYTES, stream);
    Args a{};
    for (int i = 0; i < 30; ++i) a.in[i] = (const float*)d_in[i];
    a.out = (float*)d_out; a.ws = (unsigned char*)d_ws;
    if (N_LAUNCHES == 1) {
        a.ph_lo = 0; a.ph_hi = NPHASE;
        void* kargs[] = {&a};
        hipError_t e = hipLaunchCooperativeKernel((const void*)fwd_mega, dim3(grid), dim3(NTHR), kargs, LDS_BYTES, stream);
        if (e != hipSuccess) fprintf(stderr, "kernel_launch: cooperative launch failed: %s (grid %d)\n", hipGetErrorString(e), grid);
    } else {
        for (int p = 0; p < NPHASE; ++p) { a.ph_lo = p; a.ph_hi = p + 1; hipLaunchKernelGGL(fwd_mega, dim3(grid), dim3(NTHR), LDS_BYTES, stream, a); }
    }
}
```

```cpp
#include <hip/hip_runtime.h>
#include <cstdio>
#include <cstdint>

namespace pg8 {
#define PG8_LAS __attribute__((address_space(3)))
typedef unsigned short bf16_t;
typedef short bf16x8 __attribute__((ext_vector_type(8)));
typedef float f32x4 __attribute__((ext_vector_type(4)));
typedef unsigned u32x4 __attribute__((ext_vector_type(4)));
constexpr int BM = 256, BK = 64, HALF = 128, HTB = HALF * BK * 2  , STAGE_BYTES = 8 * HTB, NXCD = 8, WGM = 8;

__host__ __device__ __forceinline__ int lds_byte(int r, int c) { const int st = (r >> 4) * 2 + (c >> 5), rr = r & 15, cc = c & 31, ob = rr * 64 + cc * 2; return st * 1024 + (ob ^ (((ob >> 9) & 1) << 5)); }
__host__ __device__ __forceinline__ void stage_rc(int b, int& R, int& C) { const int st = b / 1024, sb = b % 1024, swz = sb ^ (((sb >> 9) & 1) << 5); R = (st >> 1) * 16 + swz / 64; C = (st & 1) * 32 + (swz % 64) / 2; }
__host__ __device__ __forceinline__ int perm32(int rho) { const int n = rho >> 4, i = rho & 15; return 8 * (i >> 2) + 4 * n + (i & 3); }

struct Unit { int pm, pn; };
struct Gemm { const bf16_t* A; const bf16_t* Bt; int M, N, K; };

struct StaticOrder {
    int nM, nN, nwg, G, c;
    __host__ __device__ void init(int M, int N, int G_, int c_) { nM = M / BM; nN = N / BM; nwg = nM * nN; G = G_; c = c_; }
    __host__ __device__ bool next(int i, Unit& u) const {
        const long L = (long)i * G + c; if (L >= nwg) return false;
        int wgid = (int)L; { const int q = nwg / NXCD, r = nwg % NXCD, xcd = wgid % NXCD, off = wgid / NXCD; wgid = (xcd < r ? xcd * (q + 1) : r * (q + 1) + (xcd - r) * q) + off; }
        const int nig = WGM * nN, gid = wgid / nig, fm = gid * WGM, gsz = (nM - fm) < WGM ? (nM - fm) : WGM;
        u.pm = fm + ((wgid % nig) % gsz); u.pn = (wgid % nig) / gsz; return true;
    }
    __device__ __forceinline__ void a_ready(const Unit&) const {}
    __device__ __forceinline__ void done(const Unit&) const {}
};

__device__ __forceinline__ unsigned cvt_pk_bf16(float lo, float hi) { unsigned r; asm volatile("v_cvt_pk_bf16_f32 %0, %1, %2" : "=v"(r) : "v"(lo), "v"(hi)); return r; }
typedef float f32x2 __attribute__((ext_vector_type(2)));
struct NoHook { __device__ __forceinline__ void at_tile(int, const Unit&, f32x4 (&)[2][2][4][2], PG8_LAS unsigned char*, int, int) const {} };
template <class Epi, class Sched, bool ALIGN_EPI = false, bool SP2 = false, class Hook = NoHook>
__device__ __forceinline__ void gemm_phase(PG8_LAS unsigned char* lds, const Gemm g, const Sched& S, const Epi& E, const Hook& H = Hook()) {
    const int tid = threadIdx.x, wid = __builtin_amdgcn_readfirstlane(tid >> 6), lane = tid & 63, wr = wid >> 2, wc = wid & 3, fr = lane & 15, fq = lane >> 4;
    const int K = g.K, nt = K / BK;
    unsigned voffA[2], voffB[2];
#pragma unroll
    for (int i = 0; i < 2; ++i) { int R, C; stage_rc(tid * 16 + i * 8192, R, C); const int Rb = Epi::PERM ? ((R & ~31) + perm32(R & 31)) : R;
        voffA[i] = (unsigned)(R * K + C) * 2u; voffB[i] = (unsigned)(Rb * K + C) * 2u; }
    const size_t kstep = (size_t)(BK * 2);
    const size_t hstep = (size_t)HALF * K * 2;
    const size_t tstep = 2 * hstep;
    const unsigned ldsw = (unsigned)wid * 1024u;
    const int aoff = lds_byte(wr * 64 + fr, fq * 8), boff = lds_byte(wc * 32 + fr, fq * 8);
#define PG8_SA(b, h) (((b) * 2 + (h)) * HTB)
#define PG8_SB(b, h) ((4 + (b) * 2 + (h)) * HTB)
#define PG8_STAGE(bufoff, gbase, voff) do { _Pragma("unroll") for (int _i = 0; _i < 2; ++_i) \
        __builtin_amdgcn_global_load_lds((const unsigned*)((const char*)(gbase) + (voff)[_i]), (PG8_LAS unsigned*)(lds + (bufoff) + ldsw + _i * 8192), 16, 0, 0); } while (0)
#define PG8_LDA(dst, b, h) do { _Pragma("unroll") for (int m = 0; m < 4; ++m) _Pragma("unroll") for (int k = 0; k < 2; ++k) dst[m][k] = *(const PG8_LAS bf16x8*)(lds + PG8_SA(b, h) + aoff + m * 2048 + k * 1024); } while (0)
#define PG8_LDB(dst, b, h) do { _Pragma("unroll") for (int n = 0; n < 2; ++n) _Pragma("unroll") for (int k = 0; k < 2; ++k) dst[n][k] = *(const PG8_LAS bf16x8*)(lds + PG8_SB(b, h) + boff + n * 2048 + k * 1024); } while (0)
#define PG8_MMA(ai, bj, At, Bt) do { __builtin_amdgcn_s_setprio(1); _Pragma("unroll") for (int m = 0; m < 4; ++m) _Pragma("unroll") for (int n = 0; n < 2; ++n) _Pragma("unroll") for (int k = 0; k < 2; ++k) \
        acc[ai][bj][m][n] = __builtin_amdgcn_mfma_f32_16x16x32_bf16(Bt[n][k], At[m][k], acc[ai][bj][m][n], 0, 0, 0); __builtin_amdgcn_s_setprio(0); } while (0)
#define PG8_WAIT_V(n) asm volatile("s_waitcnt vmcnt(" #n ")" ::: "memory")
#define PG8_WAIT_L(n) asm volatile("s_waitcnt lgkmcnt(" #n ")" ::: "memory")
#define PG8_BAR __builtin_amdgcn_s_barrier()
#define PG8_SCHED __builtin_amdgcn_sched_barrier(0)
    Unit cur, nxt; int ui = 0;
    if (!S.next(0, cur)) return;
    f32x4 acc[2][2][4][2];
#pragma unroll
    for (int a = 0; a < 2; ++a)
#pragma unroll
        for (int b = 0; b < 2; ++b)
#pragma unroll
            for (int m = 0; m < 4; ++m)
#pragma unroll
                for (int n = 0; n < 2; ++n) acc[a][b][m][n] = (f32x4){0.f, 0.f, 0.f, 0.f};
    bf16x8 At[4][2], B0[2][2], B1[2][2];
    const char* cA = (const char*)g.A + (size_t)cur.pm * tstep; const char* cB = (const char*)g.Bt + (size_t)cur.pn * tstep;
    S.a_ready(cur);
    if constexpr (SP2) {
        PG8_STAGE(PG8_SB(0, 0), cB, voffB); PG8_STAGE(PG8_SB(0, 1), cB + hstep, voffB); PG8_STAGE(PG8_SA(0, 0), cA, voffA); PG8_STAGE(PG8_SA(0, 1), cA + hstep, voffA);
        if (wr == 1) PG8_BAR;
        PG8_WAIT_V(2); PG8_BAR;
        PG8_STAGE(PG8_SB(1, 0), cB + kstep, voffB); PG8_STAGE(PG8_SA(1, 0), cA + kstep, voffA); PG8_STAGE(PG8_SB(1, 1), cB + hstep + kstep, voffB);
        PG8_WAIT_V(6); PG8_BAR;
    } else {
        PG8_STAGE(PG8_SB(0, 0), cB, voffB); PG8_STAGE(PG8_SA(0, 0), cA, voffA); PG8_STAGE(PG8_SB(0, 1), cB + hstep, voffB); PG8_STAGE(PG8_SA(0, 1), cA + hstep, voffA);
        if (wr == 1) PG8_BAR;
        PG8_WAIT_V(4); PG8_BAR;
        PG8_STAGE(PG8_SB(1, 0), cB + kstep, voffB); PG8_STAGE(PG8_SA(1, 0), cA + kstep, voffA); PG8_STAGE(PG8_SB(1, 1), cB + hstep + kstep, voffB);
        PG8_WAIT_V(6); PG8_BAR;
    }
    for (;;) {
        const bool has_next = S.next(ui + 1, nxt);
        const char* nA = has_next ? (const char*)g.A + (size_t)nxt.pm * tstep : cA; const char* nB = has_next ? (const char*)g.Bt + (size_t)nxt.pn * tstep : cB;
        for (int t = 0; t < nt; t += 2) {
            const bool last = (t == nt - 2);
            H.at_tile(t, cur, acc, lds + STAGE_BYTES, wr, fr);
            const char* a1 = cA + (size_t)(t + 1) * kstep;
            const char* a2 = last ? nA : cA + (size_t)(t + 2) * kstep; const char* b2 = last ? nB : cB + (size_t)(t + 2) * kstep;
            const char* a3 = a2 + kstep; const char* b3 = b2 + kstep;
            if (last && has_next) S.a_ready(nxt);
            if constexpr (SP2) {
            PG8_LDB(B0, 0, 0); PG8_LDB(B1, 0, 1); PG8_SCHED; PG8_LDA(At, 0, 0); PG8_STAGE(PG8_SA(1, 1), a1 + hstep, voffA);
            PG8_WAIT_V(8); PG8_WAIT_L(0); PG8_BAR; PG8_MMA(0, 0, At, B0); PG8_MMA(0, 1, At, B1); PG8_BAR; PG8_SCHED;
            PG8_LDA(At, 0, 1); PG8_STAGE(PG8_SB(0, 0), b2, voffB); PG8_STAGE(PG8_SB(0, 1), b2 + hstep, voffB); PG8_STAGE(PG8_SA(0, 0), a2, voffA);
            PG8_WAIT_V(8); PG8_WAIT_L(0); PG8_BAR; PG8_MMA(1, 0, At, B0); PG8_MMA(1, 1, At, B1); PG8_BAR; PG8_SCHED;
            PG8_LDB(B0, 1, 0); PG8_LDB(B1, 1, 1); PG8_SCHED; PG8_LDA(At, 1, 0); PG8_STAGE(PG8_SA(0, 1), a2 + hstep, voffA);
            PG8_WAIT_V(8); PG8_WAIT_L(0); PG8_BAR; PG8_MMA(0, 0, At, B0); PG8_MMA(0, 1, At, B1); PG8_BAR; PG8_SCHED;
            PG8_LDA(At, 1, 1); PG8_STAGE(PG8_SB(1, 0), b3, voffB); PG8_STAGE(PG8_SB(1, 1), b3 + hstep, voffB); PG8_STAGE(PG8_SA(1, 0), a3, voffA);
            PG8_WAIT_V(8); PG8_WAIT_L(0); PG8_BAR; PG8_MMA(1, 0, At, B0); PG8_MMA(1, 1, At, B1); PG8_BAR; PG8_SCHED;
            } else {
            PG8_LDB(B0, 0, 0); PG8_SCHED; PG8_LDA(At, 0, 0); PG8_STAGE(PG8_SA(1, 1), a1 + hstep, voffA);
            PG8_WAIT_L(8); PG8_BAR; PG8_WAIT_L(0); PG8_MMA(0, 0, At, B0); PG8_BAR; PG8_SCHED;
            PG8_LDB(B1, 0, 1); PG8_STAGE(PG8_SB(0, 0), b2, voffB);
            PG8_BAR; PG8_WAIT_L(0); PG8_MMA(0, 1, At, B1); PG8_BAR;
            PG8_LDA(At, 0, 1); PG8_STAGE(PG8_SA(0, 0), a2, voffA);
            PG8_BAR; PG8_WAIT_L(0); PG8_MMA(1, 0, At, B0); PG8_BAR; PG8_SCHED;
            PG8_STAGE(PG8_SB(0, 1), b2 + hstep, voffB);
            PG8_WAIT_V(6); PG8_BAR; PG8_MMA(1, 1, At, B1); PG8_BAR;
            PG8_LDB(B0, 1, 0); PG8_SCHED; PG8_LDA(At, 1, 0); PG8_STAGE(PG8_SA(0, 1), a2 + hstep, voffA);
            PG8_WAIT_L(8); PG8_BAR; PG8_WAIT_L(0); PG8_MMA(0, 0, At, B0); PG8_BAR; PG8_SCHED;
            PG8_LDB(B1, 1, 1); PG8_STAGE(PG8_SB(1, 0), b3, voffB);
            PG8_BAR; PG8_WAIT_L(0); PG8_MMA(0, 1, At, B1); PG8_BAR;
            PG8_LDA(At, 1, 1); PG8_STAGE(PG8_SA(1, 0), a3, voffA);
            PG8_BAR; PG8_WAIT_L(0); PG8_MMA(1, 0, At, B0); PG8_BAR; PG8_SCHED;
            PG8_STAGE(PG8_SB(1, 1), b3 + hstep, voffB);
            PG8_WAIT_V(6); PG8_BAR; PG8_MMA(1, 1, At, B1); PG8_BAR;
            }
        }
        if constexpr (ALIGN_EPI) { if (wr == 0) PG8_BAR; }
        if constexpr (!Epi::AFTER_DRAIN) { E(acc, cur, wr, wc, fr, fq);
#ifdef PROBE_EPI2
            if constexpr (Epi::PROBE_TWICE) { asm volatile("" ::: "memory"); E(acc, cur, wr, wc, fr, fq); }
#endif
            S.done(cur); }
        if (!has_next) break;
#pragma unroll
        for (int a = 0; a < 2; ++a)
#pragma unroll
            for (int b = 0; b < 2; ++b)
#pragma unroll
                for (int m = 0; m < 4; ++m)
#pragma unroll
                    for (int n = 0; n < 2; ++n) acc[a][b][m][n] = (f32x4){0.f, 0.f, 0.f, 0.f};
        cur = nxt; cA = nA; cB = nB; ++ui;
        if constexpr (ALIGN_EPI) { if (wr == 1) PG8_BAR; }
    }
    PG8_WAIT_V(0);
    if constexpr (!ALIGN_EPI) { if (wr == 0) PG8_BAR; }
    PG8_BAR;
    if constexpr (Epi::AFTER_DRAIN) { E.fused(acc, cur, wr, wc, fr, fq, lds, wid, lane); S.done(cur); }
#undef PG8_SA
#undef PG8_SB
#undef PG8_STAGE
#undef PG8_LDA
#undef PG8_LDB
#undef PG8_MMA
#undef PG8_WAIT_V
#undef PG8_WAIT_L
#undef PG8_BAR
#undef PG8_SCHED
}
}
namespace pg8 {
struct EpiProj {
    static constexpr bool PERM = true, AFTER_DRAIN = false, PROBE_TWICE = true;
    bf16_t* O; int ldc;
    __device__ __forceinline__ void operator()(const f32x4 (&acc)[2][2][4][2], const Unit& u, int wr, int wc, int fr, int fq) const {
        const int row0 = u.pm * BM + wr * 64 + fr; const int col0 = u.pn * BM + wc * 32 + 8 * fq;
#pragma unroll
        for (int ai = 0; ai < 2; ++ai)
#pragma unroll
            for (int m = 0; m < 4; ++m) { bf16_t* rowp = O + (size_t)(row0 + ai * HALF + m * 16) * ldc + col0;
#pragma unroll
                for (int bj = 0; bj < 2; ++bj) { const f32x4 v0 = acc[ai][bj][m][0], v1 = acc[ai][bj][m][1];
                    u32x4 w; w.x = cvt_pk_bf16(v0[0], v0[1]); w.y = cvt_pk_bf16(v0[2], v0[3]); w.z = cvt_pk_bf16(v1[0], v1[1]); w.w = cvt_pk_bf16(v1[2], v1[3]);
                    __builtin_nontemporal_store(w, (u32x4*)(rowp + bj * HALF)); } }
    }
};
struct EpiX1 {
    static constexpr bool PERM = true, AFTER_DRAIN = false, PROBE_TWICE = false;
    const float* x; float* x1; bf16_t* x1s; const float* mod; const float* norm2_g; float* rowstat; PG8_LAS float* tab;
    __device__ __forceinline__ void operator()(const f32x4 (&acc)[2][2][4][2], const Unit& u, int wr, int wc, int fr, int fq) const {
        const int row0 = u.pm * BM + wr * 64 + fr; const int col0 = u.pn * BM + wc * 32 + 8 * fq; const int b = (u.pm * BM) >> 11;
        const float* mb = mod + (size_t)b * 6144;
        f32x4 g1[2][2], g2[2][2];
#pragma unroll
        for (int bj = 0; bj < 2; ++bj)
#pragma unroll
            for (int n = 0; n < 2; ++n) { const int c = col0 + bj * HALF + 4 * n; g1[bj][n] = *(const f32x4*)(mb + 2048 + c);
                const f32x4 sc = *(const f32x4*)(mb + 4096 + c), ng = *(const f32x4*)(norm2_g + c); g2[bj][n] = ng * (sc + 1.0f); }
#pragma unroll
        for (int ai = 0; ai < 2; ++ai)
#pragma unroll
            for (int m = 0; m < 4; ++m) { const size_t row = (size_t)(row0 + ai * HALF + m * 16); const size_t off = row * 1024 + col0; float ss = 0.f;
                const float rfin = tab[((u.pm >> 3) & 1) * 1280 + 1024 + ai * HALF + wr * 64 + m * 16 + fr];
#pragma unroll
                for (int bj = 0; bj < 2; ++bj) {
                    const f32x4 xa = *(const f32x4*)(x + off + bj * HALF), xb = *(const f32x4*)(x + off + bj * HALF + 4);
                    const f32x4 v0 = xa + g1[bj][0] * (acc[ai][bj][m][0] * rfin), v1 = xb + g1[bj][1] * (acc[ai][bj][m][1] * rfin);
                    *(f32x4*)(x1 + off + bj * HALF) = v0; *(f32x4*)(x1 + off + bj * HALF + 4) = v1;
                    ss += (v0[0] * v0[0] + v0[1] * v0[1]) + (v0[2] * v0[2] + v0[3] * v0[3]) + (v1[0] * v1[0] + v1[1] * v1[1]) + (v1[2] * v1[2] + v1[3] * v1[3]);
                    const f32x4 s0 = v0 * g2[bj][0], s1 = v1 * g2[bj][1];
                    u32x4 w; w.x = cvt_pk_bf16(s0[0], s0[1]); w.y = cvt_pk_bf16(s0[2], s0[3]); w.z = cvt_pk_bf16(s1[0], s1[1]); w.w = cvt_pk_bf16(s1[2], s1[3]);
                    *(u32x4*)(x1s + off + bj * HALF) = w; }
                ss += __shfl_xor(ss, 16); ss += __shfl_xor(ss, 32);
                if (fq == 0) atomicAdd(rowstat + row, ss); }
    }
};
typedef _Float16 f16x8 __attribute__((ext_vector_type(8)));
struct EpiScores {
    static constexpr bool PERM = true, AFTER_DRAIN = false, PROBE_TWICE = false;
    _Float16* S; const float* sb; const float* rowstat;
    __device__ __forceinline__ void operator()(const f32x4 (&acc)[2][2][4][2], const Unit& u, int wr, int wc, int fr, int fq) const {
        const int row0 = u.pm * BM + wr * 64 + fr; const int col0 = u.pn * BM + wc * 32 + 8 * fq; const int b = (u.pm * BM) >> 11;
        f32x4 bv[2][2];
#pragma unroll
        for (int bj = 0; bj < 2; ++bj)
#pragma unroll
            for (int n = 0; n < 2; ++n) bv[bj][n] = *(const f32x4*)(sb + (size_t)b * 2048 + col0 + bj * HALF + 4 * n);
#pragma unroll
        for (int ai = 0; ai < 2; ++ai)
#pragma unroll
            for (int m = 0; m < 4; ++m) { const size_t row = (size_t)(row0 + ai * HALF + m * 16); const float rs = __builtin_amdgcn_rsqf(rowstat[row] * (1.0f / 1024.0f) + 1e-6f);
                _Float16* rowp = S + row * 2048 + col0;
#pragma unroll
                for (int bj = 0; bj < 2; ++bj) { const f32x4 v0 = acc[ai][bj][m][0] * rs + bv[bj][0], v1 = acc[ai][bj][m][1] * rs + bv[bj][1];
                    f16x8 h; h[0] = (_Float16)v0[0]; h[1] = (_Float16)v0[1]; h[2] = (_Float16)v0[2]; h[3] = (_Float16)v0[3]; h[4] = (_Float16)v1[0]; h[5] = (_Float16)v1[1]; h[6] = (_Float16)v1[2]; h[7] = (_Float16)v1[3];
                    *(f16x8*)(rowp + bj * HALF) = h; } }
    }
};
struct SegScaleHook {
    __device__ __forceinline__ static void build(PG8_LAS unsigned char* ldsx, const Unit& u, const float* st_ssd, const float* st_s5, int tid) {
        PG8_LAS float* tab = (PG8_LAS float*)ldsx + ((u.pm >> 3) & 1) * 1280;
        if (tid < 256) { const size_t row = (size_t)u.pm * BM + tid; const f32x4* sg = (const f32x4*)(st_ssd + row * 16); const f32x4* s5 = (const f32x4*)(st_s5 + row * 64);
            float r[5];
#pragma unroll
            for (int gI = 0; gI < 4; ++gI) { const f32x4 v = sg[gI]; r[gI] = __builtin_amdgcn_rsqf(((v[0] + v[1]) + (v[2] + v[3])) * (1.0f / 256.0f) + 1e-6f); }
            float a5 = 0.f;
#pragma unroll
            for (int q = 0; q < 16; ++q) { const f32x4 v = s5[q]; a5 += (v[0] + v[1]) + (v[2] + v[3]); }
            r[4] = __builtin_amdgcn_rsqf(a5 * (1.0f / 1024.0f) + 1e-6f);
#pragma unroll
            for (int k = 0; k < 4; ++k) tab[k * 256 + tid] = r[k] * __builtin_amdgcn_rcpf(r[k + 1]);
            tab[1024 + tid] = r[4]; }
    }
    __device__ __forceinline__ void at_tile(int t, const Unit& u, f32x4 (&acc)[2][2][4][2], PG8_LAS unsigned char* ldsx, int wr, int fr) const {
        if (t == 4 || t == 8 || t == 12 || t == 16) { const PG8_LAS float* rt = (const PG8_LAS float*)ldsx + ((u.pm >> 3) & 1) * 1280 + ((t >> 2) - 1) * 256 + wr * 64 + fr;
#pragma unroll
            for (int ai = 0; ai < 2; ++ai)
#pragma unroll
                for (int m = 0; m < 4; ++m) { const float r = rt[ai * HALF + m * 16];
#pragma unroll
                    for (int bj = 0; bj < 2; ++bj) { acc[ai][bj][m][0] = acc[ai][bj][m][0] * r; acc[ai][bj][m][1] = acc[ai][bj][m][1] * r; } } }
    }
};
}
constexpr int NWAVES = 8, NTHR = 512;
constexpr int DM = 1024, NB = 16, SEQ = 2048, MTOK = NB * SEQ;
constexpr int NPROJ = 4096;
constexpr int INW = 4112;
constexpr int NHEADS = 16, HDIM = 64, NGRP = 4, NST = 128, CHUNK = 128;
constexpr int S5G = 64, S5CH = 16, S5P = 64;
constexpr int PH = 8, PK = 16, PNK = 128;
constexpr float EPSF = 1e-6f;
constexpr int NS5PART = 64;

constexpr size_t MiB = 1u << 20;
constexpr size_t WS_CTL = 0, CTL_ZERO_BYTES = 64 * 1024;
constexpr size_t WS_MOD = 1 * MiB;
constexpr size_t WS_WDT = WS_MOD + 0x60000;
constexpr size_t WS_SB = WS_MOD + 0x70000;
constexpr size_t WS_ROWSTAT = WS_MOD + 0x90000;
constexpr size_t WS_S5LB = WS_MOD + 0xB0000;
constexpr size_t WS_S5BB = WS_MOD + 0xC0000;
constexpr size_t WS_DTRAW = 3 * MiB;
constexpr size_t WS_STSSD = 5 * MiB;
constexpr size_t WS_STS5 = 7 * MiB;
constexpr size_t WS_WINT = 15 * MiB;
constexpr size_t WS_WOUTT = 23 * MiB;
constexpr size_t WS_WQKT = 27 * MiB;
constexpr size_t WS_EU = 31 * MiB, WS_EV = 47 * MiB;
constexpr size_t WS_EUS = 63 * MiB, WS_EVS = 63 * MiB + 65536;
constexpr size_t WS_START = 64 * MiB;
constexpr size_t WS_A = 95 * MiB;
constexpr size_t WS_B = 223 * MiB;
constexpr size_t WS_H1 = WS_A, WS_Y = WS_A, WS_PROJ = WS_B, WS_SCORES = WS_A;
constexpr size_t WS_X1S = WS_B + 192 * MiB;
constexpr size_t WS_EID = 479 * MiB, WS_GATE = 495 * MiB;
constexpr size_t WS_END = 511 * MiB;
static_assert(WS_SCORES + (size_t)MTOK * 2048 * 4 <= WS_X1S && WS_X1S + (size_t)MTOK * 1024 * 2 <= WS_EID && WS_GATE + (size_t)MTOK * 128 * 4 <= WS_END, "ws map");

constexpr int LDS_MAIN = 159744;
constexpr int MISC_OFF = LDS_MAIN;
constexpr int LDS_BYTES = LDS_MAIN + 128;

#define GAS __attribute__((address_space(1)))
#define LAS __attribute__((address_space(3)))
typedef unsigned short bf16;
typedef unsigned v4u __attribute__((ext_vector_type(4)));
typedef unsigned v2u __attribute__((ext_vector_type(2)));
typedef float f32x4 __attribute__((ext_vector_type(4)));
typedef float f32x2 __attribute__((ext_vector_type(2)));
typedef short bf16x8 __attribute__((ext_vector_type(8)));
#define LDS_WAIT() asm volatile("s_waitcnt lgkmcnt(0)" ::: "memory")
#define VM_WAIT() asm volatile("s_waitcnt vmcnt(0)" ::: "memory")
typedef __bf16 hwbf16x2 __attribute__((ext_vector_type(2)));
__device__ __forceinline__ unsigned pk2(float lo, float hi) { const f32x2 v = {lo, hi}; const hwbf16x2 b = __builtin_convertvector(v, hwbf16x2); return __builtin_bit_cast(unsigned, b); }
__device__ __forceinline__ unsigned f2bf(float f) { return pk2(f, 0.f) & 0xffffu; }
__device__ __forceinline__ float bflo(unsigned w) { return __builtin_bit_cast(float, w << 16); }
__device__ __forceinline__ float bfhi(unsigned w) { return __builtin_bit_cast(float, w & 0xffff0000u); }
__device__ __forceinline__ float bf2f(bf16 v) { return __builtin_bit_cast(float, (unsigned)v << 16); }
__device__ __forceinline__ float wave_sum(float v) {
#pragma unroll
    for (int o = 1; o < 64; o <<= 1) v += __shfl_xor(v, o);
    return v;
}
__device__ __forceinline__ float sigmoid_f(float v) { return __builtin_amdgcn_rcpf(1.0f + __builtin_amdgcn_exp2f(-1.4426950408889634f * v)); }
__device__ __forceinline__ float silu_f(float v) { return v * sigmoid_f(v); }
__device__ __forceinline__ float rsqrt_f(float v) { return __builtin_amdgcn_rsqf(v); }
__device__ __forceinline__ float gelu_erf(float v) {
    const float av = fabsf(v), t = __builtin_amdgcn_rcpf(av * 0.2316418882f + 1.0f);
    float q = t * 0.5307027145f + (-0.7265760135f); q = q * t + 0.7107068705f; q = q * t + (-0.142248368f); q = q * t + 0.127414796f; q = q * t;
    const float e = __builtin_amdgcn_exp2f((v * v) * (-0.72134752044f));
    const float m = v * (q * e);
    return v < 0.f ? m : v - m;
}
__device__ __forceinline__ float softplus_f(float v) { return fmaxf(v, 0.f) + 0.6931471805599453f * __builtin_amdgcn_logf(1.0f + __builtin_amdgcn_exp2f(-1.4426950408889634f * fabsf(v))); }
__device__ __forceinline__ void unpack8(const v4u w, float* f) { f[0] = bflo(w.x); f[1] = bfhi(w.x); f[2] = bflo(w.y); f[3] = bfhi(w.y); f[4] = bflo(w.z); f[5] = bfhi(w.z); f[6] = bflo(w.w); f[7] = bfhi(w.w); }
#define LDS_BARRIER() do { asm volatile("s_waitcnt lgkmcnt(0)" ::: "memory"); __builtin_amdgcn_s_barrier(); asm volatile("" ::: "memory"); } while (0)
__device__ __forceinline__ float row16_sum_to15(float v) {
    v += __builtin_bit_cast(float, __builtin_amdgcn_update_dpp(0, __builtin_bit_cast(int, v), 0x118, 0xf, 0xf, true));
    v += __builtin_bit_cast(float, __builtin_amdgcn_update_dpp(0, __builtin_bit_cast(int, v), 0x114, 0xf, 0xf, true));
    v += __builtin_bit_cast(float, __builtin_amdgcn_update_dpp(0, __builtin_bit_cast(int, v), 0x112, 0xf, 0xf, true));
    v += __builtin_bit_cast(float, __builtin_amdgcn_update_dpp(0, __builtin_bit_cast(int, v), 0x111, 0xf, 0xf, true));
    return v;
}
__device__ __forceinline__ float wave_sum_to63(float v) {
    v = row16_sum_to15(v);
    v += __builtin_bit_cast(float, __builtin_amdgcn_update_dpp(0, __builtin_bit_cast(int, v), 0x142, 0xa, 0xf, false));
    v += __builtin_bit_cast(float, __builtin_amdgcn_update_dpp(0, __builtin_bit_cast(int, v), 0x143, 0xc, 0xf, false));
    return v;
}
__device__ __forceinline__ f32x2 gelu_pk2(f32x2 v) {
    const f32x2 av = __builtin_elementwise_abs(v), d = av * 0.2316418882f + 1.0f;
    f32x2 t; t[0] = __builtin_amdgcn_rcpf(d[0]); t[1] = __builtin_amdgcn_rcpf(d[1]);
    f32x2 q = t * 0.5307027145f + (-0.7265760135f); q = q * t + 0.7107068705f; q = q * t + (-0.142248368f); q = q * t + 0.127414796f; q = q * t;
    const f32x2 s = (v * v) * (-0.72134752044f);
    f32x2 e; e[0] = __builtin_amdgcn_exp2f(s[0]); e[1] = __builtin_amdgcn_exp2f(s[1]);
    const f32x2 m = v * (q * e), r = v - m;
    f32x2 o; o[0] = v[0] < 0.f ? m[0] : r[0]; o[1] = v[1] < 0.f ? m[1] : r[1]; return o;
}
#define XB_TMO      128
#define XB_XCNT(j)  (256  + 64 * (j))
#define XB_XSUB(j)  (1280 + 64 * (j))
#define XB_XGEN(j)  (2304 + 64 * (j))
#define XB_TOP      3328
#define XB_TOPGEN   3392
#define XCD_BAR_WORDS 3456
#define XB_SPIN_CAP (1u << 18)

__device__ __forceinline__ unsigned xb_ld(unsigned* p)              { return __hip_atomic_load(p, __ATOMIC_RELAXED, __HIP_MEMORY_SCOPE_AGENT); }
__device__ __forceinline__ unsigned xb_add(unsigned* p, unsigned v) { return __hip_atomic_fetch_add(p, v, __ATOMIC_RELAXED, __HIP_MEMORY_SCOPE_AGENT); }
__device__ __forceinline__ unsigned xb_xcc_id() { return (unsigned)__builtin_amdgcn_s_getreg((3 << 11) | 20) & 0xFu; }
#define XB_SPIN(cond, bar) do { unsigned _sp = 0; while (cond) { __builtin_amdgcn_s_sleep(1); \
    if ((++_sp & 255u) == 0u) { if (xb_ld(&(bar)[XB_TMO])) break; if (_sp > XB_SPIN_CAP) { atomicAdd(&(bar)[XB_TMO], 1u); break; } } } } while (0)

struct XcdBarrier {
    unsigned* bar; unsigned x;
    volatile LAS unsigned* st;
};

__device__ __forceinline__ XcdBarrier xcd_barrier_post(unsigned* bar, volatile LAS unsigned* st) {
    XcdBarrier b; b.bar = bar; b.x = xb_xcc_id(); b.st = st;
    if (threadIdx.x == 0) (void)xb_add(&bar[XB_XCNT(b.x)], 1u);
    return b;
}
__device__ __forceinline__ void xcd_barrier_complete(unsigned* bar, unsigned x, unsigned& nloc, unsigned& nx) {
    const unsigned G = gridDim.x * gridDim.y * gridDim.z;
    unsigned sum, cnt, mine, sp = 0u;
    for (;;) {
        sum = 0u; cnt = 0u; mine = 0u;
#pragma unroll
        for (unsigned j = 0; j < 16; ++j) { const unsigned c = xb_ld(&bar[XB_XCNT(j)]); sum += c; cnt += (c > 0u) ? 1u : 0u; mine = (j == x) ? c : mine; }
        if (sum == G) break;
        __builtin_amdgcn_s_sleep(1);
        if ((++sp & 255u) == 0u) { if (xb_ld(&bar[XB_TMO])) break; if (sp > XB_SPIN_CAP) { atomicAdd(&bar[XB_TMO], 1u); break; } }
    }
    nloc = mine > 0u ? mine : 1u; nx = cnt > 0u ? cnt : 1u;
}

__device__ __forceinline__ void xcd_barrier(const XcdBarrier& b) {
    asm volatile("s_waitcnt vmcnt(0)" ::: "memory");
    __syncthreads();
    if (threadIdx.x == 0) {
        unsigned* bar = b.bar;
        __builtin_amdgcn_s_waitcnt(0);
        unsigned nloc = b.st[0], nx = b.st[1];
        if (nloc == 0u) { xcd_barrier_complete(bar, b.x, nloc, nx); b.st[0] = nloc; b.st[1] = nx; }
        const unsigned old = xb_add(&bar[XB_XSUB(b.x)], 1u);
        const unsigned gen = old / nloc;
        if (old + 1u == (gen + 1u) * nloc) {
            __builtin_amdgcn_fence(__ATOMIC_RELEASE, "agent");
            asm volatile("s_waitcnt vmcnt(0)" ::: "memory");
            const unsigned og = xb_add(&bar[XB_TOP], 1u);
            const unsigned tg = og / nx;
            if (og + 1u == (tg + 1u) * nx) xb_add(&bar[XB_TOPGEN], 1u);
            else XB_SPIN(xb_ld(&bar[XB_TOPGEN]) == tg, bar);
            __builtin_amdgcn_fence(__ATOMIC_ACQUIRE, "agent");
            xb_add(&bar[XB_XGEN(b.x)], 1u);
            asm volatile("s_waitcnt vmcnt(0)" ::: "memory");
        } else {
            XB_SPIN(xb_ld(&bar[XB_XGEN(b.x)]) == gen, bar);
            __builtin_amdgcn_fence(__ATOMIC_ACQUIRE, "agent");
            asm volatile("s_waitcnt vmcnt(0)" ::: "memory");
        }
    }
    __syncthreads();
}
struct Args { const float* in[30]; float* out; unsigned char* ws; int ph_lo, ph_hi; };
struct Frame {
    LAS unsigned char* lds;
    volatile LAS unsigned* MISC;
    int vcu, G;
    unsigned char* ws;
    const Args* a;
    float* out;
};
#define WSP(T, off) ((T*)(F.ws + (off)))

__device__ __forceinline__ void transpose_tile(const float* W, int ldw, int k0, int src_n0, bf16* WT, int K, int dst_n0, LAS float* scr, int lane, const float* kscale) {
#pragma unroll 8
    for (int i = 0; i < 32; ++i) { const int kk = 2 * i + (lane >> 5); float v = W[(size_t)(k0 + kk) * ldw + src_n0 + (lane & 31)]; if (kscale) v *= kscale[k0 + kk]; scr[kk * 33 + (lane & 31)] = v; }
    LDS_WAIT(); asm volatile("" ::: "memory");
    const int c = lane & 7;
#pragma unroll
    for (int j = 0; j < 4; ++j) { const int n = (lane >> 3) + 8 * j; const LAS float* s = scr + (8 * c) * 33 + n;
        v4u o; o.x = pk2(s[0 * 33], s[1 * 33]); o.y = pk2(s[2 * 33], s[3 * 33]); o.z = pk2(s[4 * 33], s[5 * 33]); o.w = pk2(s[6 * 33], s[7 * 33]);
        *(v4u*)(WT + (size_t)(dst_n0 + n) * K + k0 + 8 * c) = o; }
    LDS_WAIT(); asm volatile("" ::: "memory");
}
__device__ __forceinline__ void p0_phase(Frame& F) {
    const int f_tid = threadIdx.x, f_lane = f_tid & 63, f_wave = __builtin_amdgcn_readfirstlane(f_tid >> 6);
    const int gw = F.vcu * NWAVES + f_wave, NGW = F.G * NWAVES, gt = F.vcu * NTHR + f_tid, NGT = F.G * NTHR;
    {
        LAS float* sc = (LAS float*)F.lds;
        LAS float* red = (LAS float*)(F.lds + 65536);
        for (int i = f_tid; i < 16 * 1024; i += NTHR) { const int b = i >> 10, k = i & 1023; sc[k * 16 + b] = silu_f((F.a->in[1])[i]); }
        __syncthreads();
        const int ks = f_tid / 24, col = f_tid - ks * 24, j = F.vcu * 24 + col;
        if (ks < 21) {
            float acc[16];
#pragma unroll
            for (int b = 0; b < 16; ++b) acc[b] = 0.f;
            const int k0 = ks * 49, kn = (k0 + 49 <= 1024) ? 49 : (1024 - k0);
            const float* wp = (F.a->in[2]) + (size_t)k0 * 6144 + j;
#pragma unroll 1
            for (int kb = 0; kb < 49; kb += 7) {
                asm volatile("" ::: "memory");
                float wv[7];
#pragma unroll
                for (int u = 0; u < 7; ++u) wv[u] = (kb + u < kn) ? wp[(size_t)(kb + u) * 6144] : 0.f;
#pragma unroll
                for (int u = 0; u < 7; ++u) { const int kk = (kb + u < kn) ? (k0 + kb + u) : k0; const LAS f32x4* s4 = (const LAS f32x4*)(sc + kk * 16);
#pragma unroll
                    for (int q = 0; q < 4; ++q) { const f32x4 sv = s4[q]; acc[4 * q] += sv[0] * wv[u]; acc[4 * q + 1] += sv[1] * wv[u]; acc[4 * q + 2] += sv[2] * wv[u]; acc[4 * q + 3] += sv[3] * wv[u]; } }
            }
#pragma unroll
            for (int b = 0; b < 16; ++b) red[(ks * 16 + b) * 24 + col] = acc[b];
        }
        __syncthreads();
        for (int i = f_tid; i < 16 * 24; i += NTHR) { const int b = i / 24, cc = i - b * 24; float sacc = 0.f;
            for (int q = 0; q < 21; ++q) sacc += red[(q * 16 + b) * 24 + cc];
            WSP(float, WS_MOD)[b * 6144 + F.vcu * 24 + cc] = sacc + (F.a->in[3])[F.vcu * 24 + cc]; }
        __syncthreads();
    }
    {
        LAS float* scr = (LAS float*)(F.lds + f_wave * 16384);
        constexpr int I_IN = (1024 / 64) * (NPROJ / 32), I_OUT = (2048 / 64) * (1024 / 32);
        for (int it = gw; it < I_IN + I_OUT; it += NGW) {
            if (it < I_IN) { const int kb = it / (NPROJ / 32), nb = it % (NPROJ / 32); const int dn = 32 * nb, sn = dn < 3072 ? dn : dn + 16;
                transpose_tile((F.a->in[5]), INW, 64 * kb, sn, WSP(bf16, WS_WINT), 1024, dn, scr, f_lane, nullptr); }
            else { const int r = it - I_IN, kb = r / 32, nb = r % 32; const int k0 = 64 * kb;
                transpose_tile((F.a->in[23]), 1024, k0, 32 * nb, WSP(bf16, WS_WOUTT), 2048, 32 * nb, scr, f_lane, k0 < 1024 ? (F.a->in[11]) : (F.a->in[22]) - 1024); }
        }
    }
    for (int i = gt; i < 16 * 1024; i += NGT) { const int h = i >> 10, k = i & 1023; WSP(float, WS_WDT)[i] = (F.a->in[5])[(size_t)k * INW + 3072 + h]; }
    for (int task = gw; task < 2048; task += NGW) {
        const int nt = task >> 4, ks = task & 15, n0 = 16 * nt, hc = n0 >> 7, k0 = 64 * ks;
        const int li = f_lane & 15, lq = f_lane >> 4;
        f32x4 acc[4];
#pragma unroll
        for (int s = 0; s < 4; ++s) acc[s] = (f32x4){0.f, 0.f, 0.f, 0.f};
        const float* ap = (F.a->in[26]) + (size_t)(n0 + li) * 128 + 4 * lq;
        const float* bp = (F.a->in[25]) + (size_t)(k0 + li) * 2048 + hc * 128 + 4 * lq;
#pragma unroll
        for (int q = 0; q < 8; ++q) { const f32x4 a = *(const f32x4*)(ap + 16 * q);
#pragma unroll
            for (int s = 0; s < 4; ++s) { const f32x4 b = *(const f32x4*)(bp + (size_t)(16 * s) * 2048 + 16 * q);
#pragma unroll
                for (int jj = 0; jj < 4; ++jj) acc[s] = __builtin_amdgcn_mfma_f32_16x16x4f32(a[jj], b[jj], acc[s], 0, 0, 0); } }
        bf16* o = WSP(bf16, WS_WQKT);
#pragma unroll
        for (int s = 0; s < 4; ++s)
#pragma unroll
            for (int r = 0; r < 4; ++r) o[(size_t)(n0 + 4 * lq + r) * 1024 + k0 + 16 * s + li] = (bf16)f2bf(acc[s][r]);
    }
    for (int rw = gw; rw < 2 * 16384; rw += 2 * NGW) {
        f32x4 v[2][4]; float mx[2];
#pragma unroll
        for (int u = 0; u < 2; ++u) { const int r = rw + u * NGW; const int tb = r >= 16384, e = tb ? r - 16384 : r; const float* src = (tb ? (F.a->in[28]) : (F.a->in[27])) + (size_t)e * 1024 + 16 * f_lane;
#pragma unroll
            for (int q = 0; q < 4; ++q) v[u][q] = *(const f32x4*)(src + 4 * q); }
#pragma unroll
        for (int u = 0; u < 2; ++u) { float m = 0.f;
#pragma unroll
            for (int q = 0; q < 4; ++q) m = fmaxf(m, fmaxf(fmaxf(fabsf(v[u][q][0]), fabsf(v[u][q][1])), fmaxf(fabsf(v[u][q][2]), fabsf(v[u][q][3]))));
#pragma unroll
            for (int o = 1; o < 64; o <<= 1) m = fmaxf(m, __shfl_xor(m, o));
            mx[u] = fmaxf(m, 1e-30f); }
#pragma unroll
        for (int u = 0; u < 2; ++u) { const int r = rw + u * NGW; const int tb = r >= 16384, e = tb ? r - 16384 : r; const float sc = 224.0f / mx[u];
            v4u w;
#pragma unroll
            for (int q = 0; q < 4; ++q) { int pk = 0; pk = __builtin_amdgcn_cvt_pk_fp8_f32(v[u][q][0] * sc, v[u][q][1] * sc, pk, false); pk = __builtin_amdgcn_cvt_pk_fp8_f32(v[u][q][2] * sc, v[u][q][3] * sc, pk, true); w[q] = (unsigned)pk; }
            *(v4u*)(F.ws + (tb ? WS_EV : WS_EU) + (size_t)e * 1024 + 16 * f_lane) = w;
            if (f_lane == 0) WSP(float, tb ? WS_EVS : WS_EUS)[e] = mx[u] * (1.0f / 224.0f); }
    }
    for (int i = gt; i < S5G * S5P; i += NGT) {
        const float lr = (F.a->in[12])[i], li = (F.a->in[13])[i], dt = expf((F.a->in[14])[i >> 6]);
        const float mag = expf(lr * dt); float sn, cs; sincosf(li * dt, &sn, &cs);
        const float lbr = mag * cs, lbi = mag * sn, den = lr * lr + li * li;
        const float cfr = ((lbr - 1.0f) * lr + lbi * li) / den, cfi = (lbi * lr - (lbr - 1.0f) * li) / den;
        WSP(float, WS_S5LB)[2 * i] = lbr; WSP(float, WS_S5LB)[2 * i + 1] = lbi;
        for (int hh = 0; hh < 16; ++hh) { const float br = (F.a->in[15])[i * 16 + hh], bi = (F.a->in[16])[i * 16 + hh];
            WSP(float, WS_S5BB)[i * 32 + hh] = cfr * br - cfi * bi; WSP(float, WS_S5BB)[i * 32 + 16 + hh] = cfr * bi + cfi * br; }
    }
    for (int i = gt; i < MTOK; i += NGT) WSP(float, WS_ROWSTAT)[i] = 0.f;
}

__device__ __forceinline__ void p1_phase(Frame& F) {
    const int f_tid = threadIdx.x, f_lane = f_tid & 63, f_wave = __builtin_amdgcn_readfirstlane(f_tid >> 6);
    const int gw = F.vcu * NWAVES + f_wave;
    LAS float* wdt = (LAS float*)F.lds;
    for (int i = f_tid; i < 16 * 1024 / 4; i += NTHR) ((LAS f32x4*)wdt)[i] = ((const f32x4*)WSP(float, WS_WDT))[i];
    __syncthreads();
    const int lane = f_lane;
    for (int wq = gw; wq < MTOK / 16; wq += F.G * NWAVES) {
        const int b = wq >> 7; const float* mb = WSP(float, WS_MOD) + (size_t)b * 6144;
        f32x4 Gv[4], Sv[4];
#pragma unroll
        for (int j = 0; j < 4; ++j) { const int k = 4 * lane + 256 * j; const f32x4 g = *(const f32x4*)((F.a->in[4]) + k), sc = *(const f32x4*)(mb + 1024 + k); Gv[j] = g * (sc + 1.0f); Sv[j] = *(const f32x4*)(mb + k); }
        f32x4 nx[4];
#pragma unroll
        for (int j = 0; j < 4; ++j) nx[j] = *(const f32x4*)((F.a->in[0]) + (size_t)wq * 16 * 1024 + 4 * lane + 256 * j);
        for (int tt = 0; tt < 16; ++tt) {
            asm volatile("" ::: "memory");
            const size_t t = (size_t)wq * 16 + tt; const float* xr = (F.a->in[0]) + t * 1024;
            f32x4 v[4]; float ss = 0.f;
#pragma unroll
            for (int j = 0; j < 4; ++j) { v[j] = nx[j]; ss += (v[j][0] * v[j][0] + v[j][1] * v[j][1]) + (v[j][2] * v[j][2] + v[j][3] * v[j][3]); }
            if (tt < 15) {
#pragma unroll
                for (int j = 0; j < 4; ++j) nx[j] = *(const f32x4*)(xr + 1024 + 4 * lane + 256 * j); }
            const float rstd = rsqrt_f(wave_sum(ss) * (1.0f / 1024.0f) + EPSF);
            bf16* hr = WSP(bf16, WS_H1) + t * 1024;
#pragma unroll
            for (int j = 0; j < 4; ++j) { v[j] = v[j] * rstd * Gv[j] + Sv[j]; v2u w; w.x = pk2(v[j][0], v[j][1]); w.y = pk2(v[j][2], v[j][3]); *(v2u*)(hr + 4 * lane + 256 * j) = w; }
            float d[16];
#pragma unroll
            for (int h = 0; h < 16; ++h) { float a = 0.f;
#pragma unroll
                for (int j = 0; j < 4; ++j) { const f32x4 w = *(const LAS f32x4*)(wdt + h * 1024 + 4 * lane + 256 * j); a += (v[j][0] * w[0] + v[j][1] * w[1]) + (v[j][2] * w[2] + v[j][3] * w[3]); }
                d[h] = a; }
            float e8[8], e4[4], e2[2], e1;
#pragma unroll
            for (int i = 0; i < 8; ++i) { const bool up = lane & 32; const float snd = up ? d[i] : d[i + 8]; const float rcv = __shfl_xor(snd, 32); e8[i] = (up ? d[i + 8] : d[i]) + rcv; }
#pragma unroll
            for (int i = 0; i < 4; ++i) { const bool up = lane & 16; const float snd = up ? e8[i] : e8[i + 4]; const float rcv = __shfl_xor(snd, 16); e4[i] = (up ? e8[i + 4] : e8[i]) + rcv; }
#pragma unroll
            for (int i = 0; i < 2; ++i) { const bool up = lane & 8; const float snd = up ? e4[i] : e4[i + 2]; const float rcv = __shfl_xor(snd, 8); e2[i] = (up ? e4[i + 2] : e4[i]) + rcv; }
            { const bool up = lane & 4; const float snd = up ? e2[0] : e2[1]; const float rcv = __shfl_xor(snd, 4); e1 = (up ? e2[1] : e2[0]) + rcv; }
            e1 += __shfl_xor(e1, 2); e1 += __shfl_xor(e1, 1);
            const int head = ((lane >> 5) & 1) * 8 + ((lane >> 4) & 1) * 4 + ((lane >> 3) & 1) * 2 + ((lane >> 2) & 1);
            if ((lane & 3) == 0) WSP(float, WS_DTRAW)[t * 16 + head] = e1;
        }
    }
    for (int n = gw; n < 2048; n += F.G * NWAVES) {
        const bf16* wr = WSP(bf16, WS_WQKT) + (size_t)n * 1024 + 16 * lane;
        const v4u w0 = *(const v4u*)wr, w1 = *(const v4u*)(wr + 8);
        float wv[16]; wv[0] = bflo(w0.x); wv[1] = bfhi(w0.x); wv[2] = bflo(w0.y); wv[3] = bfhi(w0.y); wv[4] = bflo(w0.z); wv[5] = bfhi(w0.z); wv[6] = bflo(w0.w); wv[7] = bfhi(w0.w);
        wv[8] = bflo(w1.x); wv[9] = bfhi(w1.x); wv[10] = bflo(w1.y); wv[11] = bfhi(w1.y); wv[12] = bflo(w1.z); wv[13] = bfhi(w1.z); wv[14] = bflo(w1.w); wv[15] = bfhi(w1.w);
        for (int b = 0; b < 16; ++b) { const float* sp = WSP(float, WS_MOD) + (size_t)b * 6144 + 3072 + 16 * lane; float a = 0.f;
#pragma unroll
            for (int q = 0; q < 4; ++q) { const f32x4 s = *(const f32x4*)(sp + 4 * q); a += (s[0] * wv[4 * q] + s[1] * wv[4 * q + 1]) + (s[2] * wv[4 * q + 2] + s[3] * wv[4 * q + 3]); }
            a = wave_sum(a); if (lane == 0) WSP(float, WS_SB)[b * 2048 + n] = a; }
    }
}
__device__ __forceinline__ void p3_ssd_naive(Frame& F) {
    const int f_tid = threadIdx.x;
    const bf16* proj = WSP(bf16, WS_PROJ);
    LAS float* buf = (LAS float*)F.lds;
    LAS float* yl = (LAS float*)(F.lds + 4096);
    for (int item = F.vcu; item < NB * NGRP; item += F.G) {
        const int b = item >> 2, g = item & 3, tid = f_tid;
        const int ch = tid < 256 ? g * 256 + tid : (tid < 384 ? 1024 + g * 128 + (tid - 256) : 1536 + g * 128 + (tid - 384));
        const float w0 = (F.a->in[6])[0 * 2048 + ch], w1 = (F.a->in[6])[1 * 2048 + ch], w2 = (F.a->in[6])[2 * 2048 + ch], w3 = (F.a->in[6])[3 * 2048 + ch], cb = (F.a->in[7])[ch];
        float r0 = 0.f, r1 = 0.f, r2 = 0.f;
        const int r = tid >> 7, nh = (tid >> 6) & 1, p = tid & 63, h = g * 4 + r;
        float st[64];
#pragma unroll
        for (int n = 0; n < 64; ++n) st[n] = 0.f;
        const float A = -__expf((F.a->in[9])[h]), Dh = (F.a->in[10])[h], dtb = (F.a->in[8])[h];
        for (int t = 0; t < SEQ; ++t) {
            const size_t row = (size_t)b * SEQ + t;
            const float r3 = bf2f(proj[row * NPROJ + 1024 + ch]);
            const float cv = silu_f(cb + r0 * w0 + r1 * w1 + r2 * w2 + r3 * w3);
            r0 = r1; r1 = r2; r2 = r3;
            LAS float* cur = buf + (t & 1) * 512; LAS float* ycur = yl + (t & 1) * 512;
            cur[tid] = cv;
            __syncthreads();
            const float dt = softplus_f(WSP(float, WS_DTRAW)[row * 16 + h] + dtb);
            const float dA = __expf(dt * A), xv = cur[r * 64 + p], xd = xv * dt;
            float y = 0.f;
#pragma unroll
            for (int n4 = 0; n4 < 16; ++n4) { const f32x4 Bv = *(const LAS f32x4*)(cur + 256 + 64 * nh + 4 * n4), Cv = *(const LAS f32x4*)(cur + 384 + 64 * nh + 4 * n4);
#pragma unroll
                for (int q = 0; q < 4; ++q) { st[4 * n4 + q] = st[4 * n4 + q] * dA + xd * Bv[q]; y += Cv[q] * st[4 * n4 + q]; } }
            ycur[tid] = y;
            __syncthreads();
            if (nh == 0) {
                y = ycur[tid] + ycur[tid + 64] + Dh * xv;
                const float zv = bf2f(proj[row * NPROJ + h * 64 + p]);
                y *= silu_f(zv);
                WSP(bf16, WS_Y)[row * 2048 + h * 64 + p] = (bf16)f2bf(y);
                const float ss = wave_sum(y * y);
                if (p == 0) WSP(float, WS_STSSD)[row * 16 + h] = ss;
            }
        }
        __syncthreads();
    }
}
__device__ __forceinline__ void p3_s5_naive(Frame& F) {
    const int f_tid = threadIdx.x, f_lane = f_tid & 63, f_wave = __builtin_amdgcn_readfirstlane(f_tid >> 6);
    const bf16* proj = WSP(bf16, WS_PROJ);
    LAS float* xt = (LAS float*)(F.lds + 4096 + f_wave * 19200);
    LAS float* vt = (LAS float*)(F.lds + 4096 + f_wave * 19200 + 16896) + (f_lane & 31) * 17;
    const int lane = f_lane;
    for (int item = F.vcu * NWAVES + f_wave; item < NB * S5G; item += F.G * NWAVES) {
        const int b = item >> 6, g = item & 63, p = lane;
        const float lbr = WSP(float, WS_S5LB)[(g * 64 + p) * 2], lbi = WSP(float, WS_S5LB)[(g * 64 + p) * 2 + 1];
        float bbr[16], bbi[16];
#pragma unroll
        for (int q = 0; q < 4; ++q) { const f32x4 a = *(const f32x4*)(WSP(float, WS_S5BB) + (g * 64 + p) * 32 + 4 * q), c = *(const f32x4*)(WSP(float, WS_S5BB) + (g * 64 + p) * 32 + 16 + 4 * q);
#pragma unroll
            for (int e = 0; e < 4; ++e) { bbr[4 * q + e] = a[e]; bbi[4 * q + e] = c[e]; } }
        float xr = 0.f, xi = 0.f;
        for (int t0 = 0; t0 < SEQ; t0 += 32) {
            for (int tt = 0; tt < 32; ++tt) {
                const bf16* up = proj + ((size_t)b * SEQ + t0 + tt) * NPROJ + 3072 + g * 16;
                const v4u u0 = *(const v4u*)up, u1 = *(const v4u*)(up + 8);
                float uv[16]; uv[0] = bflo(u0.x); uv[1] = bfhi(u0.x); uv[2] = bflo(u0.y); uv[3] = bfhi(u0.y); uv[4] = bflo(u0.z); uv[5] = bfhi(u0.z); uv[6] = bflo(u0.w); uv[7] = bfhi(u0.w);
                uv[8] = bflo(u1.x); uv[9] = bfhi(u1.x); uv[10] = bflo(u1.y); uv[11] = bfhi(u1.y); uv[12] = bflo(u1.z); uv[13] = bfhi(u1.z); uv[14] = bflo(u1.w); uv[15] = bfhi(u1.w);
                float br = 0.f, bi = 0.f;
#pragma unroll
                for (int hh = 0; hh < 16; ++hh) { br += uv[hh] * bbr[hh]; bi += uv[hh] * bbi[hh]; }
                const float nr = lbr * xr - lbi * xi + br, ni = lbr * xi + lbi * xr + bi; xr = nr; xi = ni;
                xt[(tt * 66 + p) * 2] = xr; xt[(tt * 66 + p) * 2 + 1] = xi;
            }
            LDS_WAIT(); asm volatile("" ::: "memory");
            if (lane < 32) {
                const int tt = lane; const size_t row = (size_t)b * SEQ + t0 + tt;
                const bf16* up = proj + row * NPROJ + 3072 + g * 16;
#pragma unroll 1
                for (int hh = 0; hh < 16; ++hh) { float y = 0.f; const float* cr = (F.a->in[17]) + (g * 16 + hh) * 64; const float* ci = (F.a->in[18]) + (g * 16 + hh) * 64;
#pragma unroll 8
                    for (int pp = 0; pp < 64; ++pp) y += xt[(tt * 66 + pp) * 2] * cr[pp] - xt[(tt * 66 + pp) * 2 + 1] * ci[pp];
                    vt[hh] = gelu_erf(y + (F.a->in[19])[g * 16 + hh] * bf2f(up[hh])); }
                float ss = 0.f; unsigned ow[8];
#pragma unroll 1
                for (int k2 = 0; k2 < 8; ++k2) { float o2[2];
#pragma unroll
                    for (int e = 0; e < 2; ++e) { const int k = 2 * k2 + e; float gt = (F.a->in[21])[g * 16 + k];
#pragma unroll
                        for (int hh = 0; hh < 16; ++hh) gt += vt[hh] * (F.a->in[20])[(g * 16 + hh) * 16 + k];
                        o2[e] = vt[k] * sigmoid_f(gt); ss += o2[e] * o2[e]; }
                    const unsigned pw = pk2(o2[0], o2[1]);
#pragma unroll
                    for (int q = 0; q < 8; ++q) ow[q] = (q == k2) ? pw : ow[q]; }
                bf16* yo = WSP(bf16, WS_Y) + row * 2048 + 1024 + g * 16;
                *(v4u*)yo = (v4u){ow[0], ow[1], ow[2], ow[3]}; *(v4u*)(yo + 8) = (v4u){ow[4], ow[5], ow[6], ow[7]};
                WSP(float, WS_STS5)[row * NS5PART + g] = ss;
            }
            LDS_WAIT(); asm volatile("" ::: "memory");
        }
    }
}
__device__ __forceinline__ void p3c_normalize(Frame& F) {
    const int f_tid = threadIdx.x, f_lane = f_tid & 63, f_wave = __builtin_amdgcn_readfirstlane(f_tid >> 6);
    const int lane = f_lane;
    for (int t = F.vcu * NWAVES + f_wave; t < MTOK; t += F.G * NWAVES) {
        const float* sg = WSP(float, WS_STSSD) + (size_t)t * 16; const float* s5 = WSP(float, WS_STS5) + (size_t)t * NS5PART;
        float rg[4];
#pragma unroll
        for (int g = 0; g < 4; ++g) rg[g] = rsqrt_f((sg[4 * g] + sg[4 * g + 1] + sg[4 * g + 2] + sg[4 * g + 3]) * (1.0f / 256.0f) + EPSF);
        float s5s = (NS5PART == 64) ? s5[lane] : (lane < NS5PART ? s5[lane] : 0.f); s5s = wave_sum(s5s);
        const float r5 = rsqrt_f(s5s * (1.0f / 1024.0f) + EPSF);
        bf16* yr = WSP(bf16, WS_Y) + (size_t)t * 2048;
#pragma unroll
        for (int j = 0; j < 4; ++j) { const int e0 = 512 * j + 8 * lane; const float sc = j >= 2 ? r5 : (j == 0 ? (lane < 32 ? rg[0] : rg[1]) : (lane < 32 ? rg[2] : rg[3]));
            v4u w = *(v4u*)(yr + e0);
            w.x = pk2(bflo(w.x) * sc, bfhi(w.x) * sc); w.y = pk2(bflo(w.y) * sc, bfhi(w.y) * sc); w.z = pk2(bflo(w.z) * sc, bfhi(w.z) * sc); w.w = pk2(bflo(w.w) * sc, bfhi(w.w) * sc);
            *(v4u*)(yr + e0) = w; }
    }
}
constexpr int SSD_CS = 0, SSD_BS = 34816, SSD_BWT = 69632, SSD_XDT = 104448, SSD_PREV = 121856, SSD_XS = 139264, SSD_CSF = 157696, SSD_DTF = 158208, SSD_PITCH = 272, SSD_XPITCH = 144;
static_assert(SSD_DTF + 512 <= LDS_MAIN, "SSD LDS map");
__device__ __forceinline__ bf16x8 lds_frag(LAS unsigned char* base, int row, int kbyte) { return *(const LAS bf16x8*)(base + row * SSD_PITCH + kbyte); }
__device__ __forceinline__ void p3_ssd(Frame& F) {
    const int tid = threadIdx.x, lane = tid & 63, w = __builtin_amdgcn_readfirstlane(tid >> 6);
    const int li = lane & 15, lq = lane >> 4;
    LAS unsigned char* L = F.lds;
    LAS float* csf = (LAS float*)(L + SSD_CSF); LAS float* dtf = (LAS float*)(L + SSD_DTF);
    const bf16* proj = WSP(bf16, WS_PROJ);
    for (int item = F.vcu; item < NB * NHEADS; item += F.G) {
        const int b = item >> 4, h = item & 15, g = h >> 2;
        const float A = -__expf((F.a->in[9])[h]), Dh = (F.a->in[10])[h], dtb = (F.a->in[8])[h];
        const int pbs = w >> 1, nb0 = 4 * (w & 1);
        f32x4 st[4];
#pragma unroll
        for (int j = 0; j < 4; ++j) st[j] = (f32x4){0.f, 0.f, 0.f, 0.f};
        for (int i = tid; i < 17408 / 16; i += NTHR) ((LAS v4u*)(L + SSD_PREV))[i] = (v4u){0u, 0u, 0u, 0u};
        for (int c = 0; c < SEQ / CHUNK; ++c) {
            const size_t row0 = (size_t)b * SEQ + (size_t)c * CHUNK;
            if (w == 0) {
                const float d0 = softplus_f(WSP(float, WS_DTRAW)[(row0 + 2 * lane) * 16 + h] + dtb), d1 = softplus_f(WSP(float, WS_DTRAW)[(row0 + 2 * lane + 1) * 16 + h] + dtb);
                const float a0 = d0 * A, a1 = d1 * A; float s = a0 + a1;
#pragma unroll
                for (int o = 1; o < 64; o <<= 1) { const float t = __shfl_up(s, o); if (lane >= o) s += t; }
                dtf[2 * lane] = d0; dtf[2 * lane + 1] = d1; csf[2 * lane] = s - a1; csf[2 * lane + 1] = s;
            }
            __syncthreads();
            const float cs_end = csf[127];
            for (int it = tid; it < 1280; it += NTHR) {
                const int o = it % 40, rg = it / 40, l0 = 4 * rg;
                const int xcol = o < 8 ? h * 64 + 8 * o : (o < 24 ? 1024 + g * 128 + 8 * (o - 8) : 1536 + g * 128 + 8 * (o - 24));
                float raw[7][8];
#pragma unroll
                for (int k = 0; k < 7; ++k) { const int l = l0 - 3 + k; const bool ok = (c > 0) || (l >= 0);
                    v4u wv = (v4u){0u, 0u, 0u, 0u}; if (ok) wv = *(const v4u*)(proj + (size_t)((long)row0 + l) * NPROJ + 1024 + xcol);
                    raw[k][0] = bflo(wv.x); raw[k][1] = bfhi(wv.x); raw[k][2] = bflo(wv.y); raw[k][3] = bfhi(wv.y); raw[k][4] = bflo(wv.z); raw[k][5] = bfhi(wv.z); raw[k][6] = bflo(wv.w); raw[k][7] = bfhi(wv.w); }
                float cw[4][8], cbv[8];
#pragma unroll
                for (int k = 0; k < 4; ++k) { const f32x4 w0 = *(const f32x4*)((F.a->in[6]) + k * 2048 + xcol), w1 = *(const f32x4*)((F.a->in[6]) + k * 2048 + xcol + 4);
#pragma unroll
                    for (int e = 0; e < 4; ++e) { cw[k][e] = w0[e]; cw[k][4 + e] = w1[e]; } }
                { const f32x4 b0 = *(const f32x4*)((F.a->in[7]) + xcol), b1 = *(const f32x4*)((F.a->in[7]) + xcol + 4);
#pragma unroll
                    for (int e = 0; e < 4; ++e) { cbv[e] = b0[e]; cbv[4 + e] = b1[e]; } }
                float v[4][8];
#pragma unroll
                for (int r = 0; r < 4; ++r)
#pragma unroll
                    for (int i = 0; i < 8; ++i) v[r][i] = silu_f(cbv[i] + raw[r][i] * cw[0][i] + raw[r + 1][i] * cw[1][i] + raw[r + 2][i] * cw[2][i] + raw[r + 3][i] * cw[3][i]);
                if (o < 8) {
                    const int p0 = 8 * o;
#pragma unroll
                    for (int r = 0; r < 4; ++r) *(LAS v4u*)(L + SSD_XS + (l0 + r) * SSD_XPITCH + p0 * 2) = (v4u){pk2(v[r][0], v[r][1]), pk2(v[r][2], v[r][3]), pk2(v[r][4], v[r][5]), pk2(v[r][6], v[r][7])};
                    const float t0 = dtf[l0], t1 = dtf[l0 + 1], t2 = dtf[l0 + 2], t3 = dtf[l0 + 3];
#pragma unroll
                    for (int i = 0; i < 8; ++i) *(LAS v2u*)(L + SSD_XDT + (p0 + i) * SSD_PITCH + l0 * 2) = (v2u){pk2(v[0][i] * t0, v[1][i] * t1), pk2(v[2][i] * t2, v[3][i] * t3)};
                } else if (o < 24) {
                    const int n0 = 8 * (o - 8);
#pragma unroll
                    for (int r = 0; r < 4; ++r) *(LAS v4u*)(L + SSD_BS + (l0 + r) * SSD_PITCH + n0 * 2) = (v4u){pk2(v[r][0], v[r][1]), pk2(v[r][2], v[r][3]), pk2(v[r][4], v[r][5]), pk2(v[r][6], v[r][7])};
                    const float t0 = __expf(cs_end - csf[l0]), t1 = __expf(cs_end - csf[l0 + 1]), t2 = __expf(cs_end - csf[l0 + 2]), t3 = __expf(cs_end - csf[l0 + 3]);
#pragma unroll
                    for (int i = 0; i < 8; ++i) *(LAS v2u*)(L + SSD_BWT + (n0 + i) * SSD_PITCH + l0 * 2) = (v2u){pk2(v[0][i] * t0, v[1][i] * t1), pk2(v[2][i] * t2, v[3][i] * t3)};
                } else {
                    const int n0 = 8 * (o - 24);
#pragma unroll
                    for (int r = 0; r < 4; ++r) *(LAS v4u*)(L + SSD_CS + (l0 + r) * SSD_PITCH + n0 * 2) = (v4u){pk2(v[r][0], v[r][1]), pk2(v[r][2], v[r][3]), pk2(v[r][4], v[r][5]), pk2(v[r][6], v[r][7])};
                }
            }
            __syncthreads();
            bf16x8 ca[4];
#pragma unroll
            for (int ks = 0; ks < 4; ++ks) ca[ks] = lds_frag(L + SSD_CS, 16 * w + li, 64 * ks + 16 * lq);
            f32x4 cb[8];
#pragma unroll
            for (int sb = 0; sb < 8; ++sb) { cb[sb] = (f32x4){0.f, 0.f, 0.f, 0.f};
                if (sb <= w) {
#pragma unroll
                    for (int ks = 0; ks < 4; ++ks) cb[sb] = __builtin_amdgcn_mfma_f32_16x16x32_bf16(ca[ks], lds_frag(L + SSD_BS, 16 * sb + li, 64 * ks + 16 * lq), cb[sb], 0, 0, 0); } }
            float csl[4];
#pragma unroll
            for (int r = 0; r < 4; ++r) csl[r] = csf[16 * w + 4 * lq + r];
#pragma unroll
            for (int sb = 0; sb < 8; ++sb) if (sb <= w) { const int s = 16 * sb + li; const float css = csf[s];
#pragma unroll
                for (int r = 0; r < 4; ++r) { const int l = 16 * w + 4 * lq + r; cb[sb][r] = (s <= l) ? cb[sb][r] * __expf(csl[r] - css) : 0.f; } }
            __syncthreads();
#pragma unroll
            for (int sb = 0; sb < 8; ++sb) if (sb <= (w | 1)) {
#pragma unroll
                for (int r = 0; r < 4; ++r) *(LAS unsigned short*)(L + SSD_BS + (16 * w + 4 * lq + r) * SSD_PITCH + (16 * sb + li) * 2) = (unsigned short)f2bf(cb[sb][r]); }
            LDS_WAIT(); asm volatile("" ::: "memory");
            f32x4 yd[4], yo[4];
#pragma unroll
            for (int pb = 0; pb < 4; ++pb) { yd[pb] = (f32x4){0.f, 0.f, 0.f, 0.f}; yo[pb] = (f32x4){0.f, 0.f, 0.f, 0.f}; }
#pragma unroll
            for (int ks = 0; ks < 4; ++ks) if (ks <= (w >> 1)) { const bf16x8 gf = lds_frag(L + SSD_BS, 16 * w + li, 64 * ks + 16 * lq);
#pragma unroll
                for (int pb = 0; pb < 4; ++pb) yd[pb] = __builtin_amdgcn_mfma_f32_16x16x32_bf16(gf, lds_frag(L + SSD_XDT, 16 * pb + li, 64 * ks + 16 * lq), yd[pb], 0, 0, 0); }
#pragma unroll
            for (int ks = 0; ks < 4; ++ks)
#pragma unroll
                for (int pb = 0; pb < 4; ++pb) yo[pb] = __builtin_amdgcn_mfma_f32_16x16x32_bf16(ca[ks], lds_frag(L + SSD_PREV, 16 * pb + li, 64 * ks + 16 * lq), yo[pb], 0, 0, 0);
#pragma unroll
            for (int r = 0; r < 4; ++r) { const float e = __expf(csl[r]);
#pragma unroll
                for (int pb = 0; pb < 4; ++pb) *(LAS float*)(L + SSD_BS + (16 * w + 4 * lq + r) * SSD_PITCH + (16 * pb + li) * 4) = yd[pb][r] + e * yo[pb][r]; }
            __syncthreads();
            { const float dec = __expf(cs_end);
#pragma unroll
              for (int j = 0; j < 4; ++j) st[j] = st[j] * dec;
#pragma unroll
              for (int ks = 0; ks < 4; ++ks) { const bf16x8 xf = lds_frag(L + SSD_XDT, 16 * pbs + li, 64 * ks + 16 * lq);
#pragma unroll
                  for (int j = 0; j < 4; ++j) st[j] = __builtin_amdgcn_mfma_f32_16x16x32_bf16(xf, lds_frag(L + SSD_BWT, 16 * (nb0 + j) + li, 64 * ks + 16 * lq), st[j], 0, 0, 0); }
#pragma unroll
              for (int j = 0; j < 4; ++j)
#pragma unroll
                  for (int r = 0; r < 4; ++r) *(LAS unsigned short*)(L + SSD_PREV + (16 * pbs + 4 * lq + r) * SSD_PITCH + (16 * (nb0 + j) + li) * 2) = (unsigned short)f2bf(st[j][r]); }
#pragma unroll
            for (int k = 0; k < 2; ++k) { const int it = tid + 512 * k, l = it >> 3, o = it & 7; const size_t row = row0 + l;
                const f32x4 y0 = *(const LAS f32x4*)(L + SSD_BS + l * SSD_PITCH + 32 * o), y1 = *(const LAS f32x4*)(L + SSD_BS + l * SSD_PITCH + 32 * o + 16);
                const v4u xw = *(const LAS v4u*)(L + SSD_XS + l * SSD_XPITCH + 16 * o); const v4u zw = *(const v4u*)(proj + row * NPROJ + h * 64 + 8 * o);
                float xv[8], zv[8], yv[8]; unpack8(xw, xv); unpack8(zw, zv);
                float ss = 0.f;
#pragma unroll
                for (int e = 0; e < 8; ++e) { const float yy = (e < 4 ? y0[e] : y1[e - 4]) + Dh * xv[e]; yv[e] = yy * silu_f(zv[e]); ss += yv[e] * yv[e]; }
                ss += __shfl_xor(ss, 1); ss += __shfl_xor(ss, 2); ss += __shfl_xor(ss, 4);
                if (o == 0) WSP(float, WS_STSSD)[row * 16 + h] = ss;
                *(v4u*)(WSP(bf16, WS_Y) + row * 2048 + h * 64 + 8 * o) = (v4u){pk2(yv[0], yv[1]), pk2(yv[2], yv[3]), pk2(yv[4], yv[5]), pk2(yv[6], yv[7])}; }
            __syncthreads();
        }
    }
}
__device__ __forceinline__ void p3pre_conv(Frame& F) {
    const int tid = threadIdx.x;
    const bf16* proj = WSP(bf16, WS_PROJ); bf16* xo = (bf16*)F.out;
    for (int item = F.vcu * NTHR + tid; item < (MTOK / 16) * 256; item += F.G * NTHR) {
        const int oc = item & 255, run = item >> 8; const int t0 = run * 16, ch = 8 * oc;
        const bool halo = (t0 & (SEQ - 1)) != 0;
        v4u rw[19];
#pragma unroll
        for (int k = 0; k < 19; ++k) { rw[k] = (v4u){0u, 0u, 0u, 0u}; if (k >= 3 || halo) rw[k] = *(const v4u*)(proj + (size_t)(t0 - 3 + k) * NPROJ + 1024 + ch); }
        float cw[4][8], cbv[8];
#pragma unroll
        for (int k = 0; k < 4; ++k) { const f32x4 w0 = *(const f32x4*)((F.a->in[6]) + k * 2048 + ch), w1 = *(const f32x4*)((F.a->in[6]) + k * 2048 + ch + 4);
#pragma unroll
            for (int e = 0; e < 4; ++e) { cw[k][e] = w0[e]; cw[k][4 + e] = w1[e]; } }
        { const f32x4 b0 = *(const f32x4*)((F.a->in[7]) + ch), b1 = *(const f32x4*)((F.a->in[7]) + ch + 4);
#pragma unroll
            for (int e = 0; e < 4; ++e) { cbv[e] = b0[e]; cbv[4 + e] = b1[e]; } }
        float r0[8], r1[8], r2[8];
        unpack8(rw[0], r0); unpack8(rw[1], r1); unpack8(rw[2], r2);
#pragma unroll
        for (int tt = 0; tt < 16; ++tt) {
            float r3[8]; unpack8(rw[3 + tt], r3);
            float v[8];
#pragma unroll
            for (int i = 0; i < 8; ++i) { v[i] = silu_f(cbv[i] + r0[i] * cw[0][i] + r1[i] * cw[1][i] + r2[i] * cw[2][i] + r3[i] * cw[3][i]); r0[i] = r1[i]; r1[i] = r2[i]; r2[i] = r3[i]; }
            *(v4u*)(xo + (size_t)(t0 + tt) * 2048 + ch) = (v4u){pk2(v[0], v[1]), pk2(v[2], v[3]), pk2(v[4], v[5]), pk2(v[6], v[7])};
        }
    }
}
struct SsdPre { v4u xr[4], br[4], cr[4]; float d0, d1; };
__device__ __forceinline__ void ssd_prefetch(SsdPre& P, const char* xcb, const float* dtr, unsigned voB, unsigned voX, int tid, int lane, int w) {
#pragma unroll
    for (int r = 0; r < 4; ++r) { P.br[r] = *(const v4u*)(xcb + (voB + r * 4096u)); P.cr[r] = *(const v4u*)(xcb + (voB + 1024u + r * 4096u)); }
    if (tid < 256) {
#pragma unroll
        for (int r = 0; r < 4; ++r) P.xr[r] = *(const v4u*)(xcb + (voX + r * 4096u)); }
    if (w == 0) { P.d0 = dtr[lane * 32]; P.d1 = dtr[lane * 32 + 16]; }
}
__device__ __forceinline__ void p3_ssd2(Frame& F) {
    const int tid = threadIdx.x, lane = tid & 63, w = __builtin_amdgcn_readfirstlane(tid >> 6);
    const int li = lane & 15, lq = lane >> 4;
    LAS unsigned char* L = F.lds;
    LAS float* csf = (LAS float*)(L + SSD_CSF); LAS float* dtf = (LAS float*)(L + SSD_DTF);
    const bf16* proj = WSP(bf16, WS_PROJ); const bf16* xc = (const bf16*)F.out; const float* dtraw = WSP(float, WS_DTRAW);
    for (int item = F.vcu; item < NB * NHEADS; item += F.G) {
        const int b = item >> 4, h = item & 15, g = h >> 2;
        const float A = -__expf((F.a->in[9])[h]), Dh = (F.a->in[10])[h], dtb = (F.a->in[8])[h];
        const int pbs = w >> 1, nb0 = 4 * (w & 1);
        f32x4 st[4];
#pragma unroll
        for (int j = 0; j < 4; ++j) st[j] = (f32x4){0.f, 0.f, 0.f, 0.f};
        __syncthreads();
        for (int i = tid; i < 17408 / 16; i += NTHR) ((LAS v4u*)(L + SSD_PREV))[i] = (v4u){0u, 0u, 0u, 0u};
        SsdPre P;
        const unsigned voB = (unsigned)((4 * (tid >> 4)) * 2048 + 1024 + g * 128 + 8 * (tid & 15)) * 2u, voX = (unsigned)((4 * (tid >> 3)) * 2048 + h * 64 + 8 * (tid & 7)) * 2u;
        const unsigned voZ0 = (unsigned)((tid >> 3) * NPROJ + h * 64 + 8 * (tid & 7)) * 2u, voZ1 = voZ0 + 64u * NPROJ * 2u;
        ssd_prefetch(P, (const char*)xc + (size_t)b * SEQ * 4096, dtraw + (size_t)b * SEQ * 16 + h, voB, voX, tid, lane, w);
        for (int c = 0; c < SEQ / CHUNK; ++c) {
            const size_t row0 = (size_t)b * SEQ + (size_t)c * CHUNK;
            if (w == 0) {
                const float d0 = softplus_f(P.d0 + dtb), d1 = softplus_f(P.d1 + dtb);
                const float a0 = d0 * A, a1 = d1 * A; float s = a0 + a1;
#pragma unroll
                for (int o = 1; o < 64; o <<= 1) { const float t = __shfl_up(s, o); if (lane >= o) s += t; }
                dtf[2 * lane] = d0; dtf[2 * lane + 1] = d1; csf[2 * lane] = s - a1; csf[2 * lane + 1] = s;
            }
            LDS_BARRIER();
            const float cs_end = csf[127];
            { const int ob = tid & 15, lb = 4 * (tid >> 4), n0 = 8 * ob;
#pragma unroll
              for (int r = 0; r < 4; ++r) { *(LAS v4u*)(L + SSD_BS + (lb + r) * SSD_PITCH + n0 * 2) = P.br[r]; *(LAS v4u*)(L + SSD_CS + (lb + r) * SSD_PITCH + n0 * 2) = P.cr[r]; }
              float bv[4][8];
#pragma unroll
              for (int r = 0; r < 4; ++r) { unpack8(P.br[r], bv[r]); const float tw = __expf(cs_end - csf[lb + r]);
#pragma unroll
                  for (int i = 0; i < 8; ++i) bv[r][i] *= tw; }
#pragma unroll
              for (int i = 0; i < 8; ++i) *(LAS v2u*)(L + SSD_BWT + (n0 + i) * SSD_PITCH + lb * 2) = (v2u){pk2(bv[0][i], bv[1][i]), pk2(bv[2][i], bv[3][i])}; }
            if (tid < 256) { const int ox = tid & 7, lx = 4 * (tid >> 3), p0 = 8 * ox; float xv[4][8];
#pragma unroll
              for (int r = 0; r < 4; ++r) { *(LAS v4u*)(L + SSD_XS + (lx + r) * SSD_XPITCH + p0 * 2) = P.xr[r]; unpack8(P.xr[r], xv[r]); const float tw = dtf[lx + r];
#pragma unroll
                  for (int i = 0; i < 8; ++i) xv[r][i] *= tw; }
#pragma unroll
              for (int i = 0; i < 8; ++i) *(LAS v2u*)(L + SSD_XDT + (p0 + i) * SSD_PITCH + lx * 2) = (v2u){pk2(xv[0][i], xv[1][i]), pk2(xv[2][i], xv[3][i])}; }
            const char* prb = (const char*)proj + row0 * (NPROJ * 2);
            const v4u zc0 = *(const v4u*)(prb + voZ0), zc1 = *(const v4u*)(prb + voZ1);
            if (c + 1 < SEQ / CHUNK) ssd_prefetch(P, (const char*)xc + (row0 + CHUNK) * 4096, dtraw + (row0 + CHUNK) * 16 + h, voB, voX, tid, lane, w);
            LDS_BARRIER();
            bf16x8 ca[4];
#pragma unroll
            for (int ks = 0; ks < 4; ++ks) ca[ks] = lds_frag(L + SSD_CS, 16 * w + li, 64 * ks + 16 * lq);
            f32x4 cb[8];
#pragma unroll
            for (int sb = 0; sb < 8; ++sb) { cb[sb] = (f32x4){0.f, 0.f, 0.f, 0.f};
                if (sb <= w) {
#pragma unroll
                    for (int ks = 0; ks < 4; ++ks) cb[sb] = __builtin_amdgcn_mfma_f32_16x16x32_bf16(ca[ks], lds_frag(L + SSD_BS, 16 * sb + li, 64 * ks + 16 * lq), cb[sb], 0, 0, 0); } }
            float csl[4];
#pragma unroll
            for (int r = 0; r < 4; ++r) csl[r] = csf[16 * w + 4 * lq + r];
#pragma unroll
            for (int sb = 0; sb < 8; ++sb) if (sb <= w) { const int s = 16 * sb + li; const float css = csf[s];
#pragma unroll
                for (int r = 0; r < 4; ++r) { const int l = 16 * w + 4 * lq + r; cb[sb][r] = (s <= l) ? cb[sb][r] * __expf(csl[r] - css) : 0.f; } }
            LDS_BARRIER();
#pragma unroll
            for (int sb = 0; sb < 8; ++sb) if (sb <= (w | 1)) {
#pragma unroll
                for (int r = 0; r < 4; ++r) *(LAS unsigned short*)(L + SSD_BS + (16 * w + 4 * lq + r) * SSD_PITCH + (16 * sb + li) * 2) = (unsigned short)f2bf(cb[sb][r]); }
            LDS_WAIT(); asm volatile("" ::: "memory");
            f32x4 yd[4], yo[4];
#pragma unroll
            for (int pb = 0; pb < 4; ++pb) { yd[pb] = (f32x4){0.f, 0.f, 0.f, 0.f}; yo[pb] = (f32x4){0.f, 0.f, 0.f, 0.f}; }
#pragma unroll
            for (int ks = 0; ks < 4; ++ks) if (ks <= (w >> 1)) { const bf16x8 gf = lds_frag(L + SSD_BS, 16 * w + li, 64 * ks + 16 * lq);
#pragma unroll
                for (int pb = 0; pb < 4; ++pb) yd[pb] = __builtin_amdgcn_mfma_f32_16x16x32_bf16(gf, lds_frag(L + SSD_XDT, 16 * pb + li, 64 * ks + 16 * lq), yd[pb], 0, 0, 0); }
#pragma unroll
            for (int ks = 0; ks < 4; ++ks)
#pragma unroll
                for (int pb = 0; pb < 4; ++pb) yo[pb] = __builtin_amdgcn_mfma_f32_16x16x32_bf16(ca[ks], lds_frag(L + SSD_PREV, 16 * pb + li, 64 * ks + 16 * lq), yo[pb], 0, 0, 0);
#pragma unroll
            for (int r = 0; r < 4; ++r) { const float e = __expf(csl[r]);
#pragma unroll
                for (int pb = 0; pb < 4; ++pb) *(LAS float*)(L + SSD_BS + (16 * w + 4 * lq + r) * SSD_PITCH + (16 * pb + li) * 4) = yd[pb][r] + e * yo[pb][r]; }
            LDS_BARRIER();
            { const float dec = __expf(cs_end);
#pragma unroll
              for (int j = 0; j < 4; ++j) st[j] = st[j] * dec;
#pragma unroll
              for (int ks = 0; ks < 4; ++ks) { const bf16x8 xf = lds_frag(L + SSD_XDT, 16 * pbs + li, 64 * ks + 16 * lq);
#pragma unroll
                  for (int j = 0; j < 4; ++j) st[j] = __builtin_amdgcn_mfma_f32_16x16x32_bf16(xf, lds_frag(L + SSD_BWT, 16 * (nb0 + j) + li, 64 * ks + 16 * lq), st[j], 0, 0, 0); }
#pragma unroll
              for (int j = 0; j < 4; ++j)
#pragma unroll
                  for (int r = 0; r < 4; ++r) *(LAS unsigned short*)(L + SSD_PREV + (16 * pbs + 4 * lq + r) * SSD_PITCH + (16 * (nb0 + j) + li) * 2) = (unsigned short)f2bf(st[j][r]); }
#pragma unroll
            for (int k = 0; k < 2; ++k) { const int it = tid + 512 * k, l = it >> 3, o = it & 7; const size_t row = row0 + l;
                const f32x4 y0 = *(const LAS f32x4*)(L + SSD_BS + l * SSD_PITCH + 32 * o), y1 = *(const LAS f32x4*)(L + SSD_BS + l * SSD_PITCH + 32 * o + 16);
                const v4u xw = *(const LAS v4u*)(L + SSD_XS + l * SSD_XPITCH + 16 * o); const v4u zw = k == 0 ? zc0 : zc1;
                float xv[8], zv[8], yv[8]; unpack8(xw, xv); unpack8(zw, zv);
                float ss = 0.f;
#pragma unroll
                for (int e = 0; e < 8; ++e) { const float yy = (e < 4 ? y0[e] : y1[e - 4]) + Dh * xv[e]; yv[e] = yy * silu_f(zv[e]); ss += yv[e] * yv[e]; }
                ss += __shfl_xor(ss, 1); ss += __shfl_xor(ss, 2); ss += __shfl_xor(ss, 4);
                if (o == 0) WSP(float, WS_STSSD)[row * 16 + h] = ss;
                *(v4u*)(WSP(bf16, WS_Y) + row * 2048 + h * 64 + 8 * o) = (v4u){pk2(yv[0], yv[1]), pk2(yv[2], yv[3]), pk2(yv[4], yv[5]), pk2(yv[6], yv[7])}; }
            LDS_BARRIER();
        }
    }
}
constexpr int S3_CS = 0, S3_BS = 34816, S3_GY = 69632, S3_XDT = 104448, S3_XP = 144, S3_PREV = 122880, S3_CSF = 140288, S3_DTF = 141312, S3_WTS = 142336, S3_END = 143360;
static_assert(S3_END <= LDS_MAIN, "SSD v3 LDS map");
typedef short v4i16_t __attribute__((ext_vector_type(4)));
__device__ __forceinline__ bf16x8 lds_frag_tr(LAS unsigned char* tile, int pitch, int k0, int col0, int li, int lq) {
    LAS unsigned char* p = tile + (k0 + 8 * lq + (li >> 2)) * pitch + (col0 + 4 * (li & 3)) * 2;
    const v4i16_t lo = __builtin_amdgcn_ds_read_tr16_b64_v4i16((LAS v4i16_t*)p), hi = __builtin_amdgcn_ds_read_tr16_b64_v4i16((LAS v4i16_t*)(p + 4 * pitch));
    return __builtin_shufflevector(lo, hi, 0, 1, 2, 3, 4, 5, 6, 7);
}
struct Ssd3Pre { v4u xr[4], br[4], cr[4]; float d0, d1; };
__device__ __forceinline__ void ssd3_prefetch(Ssd3Pre& P, const char* xcb, const float* dtr, unsigned voB, unsigned voX, int tid, int lane, int w) {
#pragma unroll
    for (int r = 0; r < 4; ++r) { P.br[r] = *(const v4u*)(xcb + (voB + r * 4096u)); P.cr[r] = *(const v4u*)(xcb + (voB + 1024u + r * 4096u)); }
    if (tid < 256) {
#pragma unroll
        for (int r = 0; r < 4; ++r) P.xr[r] = *(const v4u*)(xcb + (voX + r * 4096u)); }
    if (w == 0) { P.d0 = dtr[lane * 32]; P.d1 = dtr[lane * 32 + 16]; }
}
__device__ __forceinline__ void ssd3_cumsum(LAS unsigned char* L, int par, float r0, float r1, float dtb, float A, int lane) {
    LAS float* csf = (LAS float*)(L + S3_CSF + par * 512); LAS float* dtf = (LAS float*)(L + S3_DTF + par * 512); LAS float* wts = (LAS float*)(L + S3_WTS + par * 512);
    const float d0 = softplus_f(r0 + dtb), d1 = softplus_f(r1 + dtb);
    const float a0 = d0 * A, a1 = d1 * A; float s = a0 + a1;
#pragma unroll
    for (int o = 1; o < 64; o <<= 1) { const float t = __shfl_up(s, o); if (lane >= o) s += t; }
    const float tot = __shfl(s, 63);
    dtf[2 * lane] = d0; dtf[2 * lane + 1] = d1; csf[2 * lane] = s - a1; csf[2 * lane + 1] = s;
    wts[2 * lane] = __expf(tot - (s - a1)); wts[2 * lane + 1] = __expf(tot - s);
}
__device__ __forceinline__ void p3_ssd3(Frame& F) {
    const int tid0 = threadIdx.x, w = __builtin_amdgcn_readfirstlane(tid0 >> 6);
    LAS unsigned char* L = F.lds;
    const bf16* proj = WSP(bf16, WS_PROJ); const bf16* xc = (const bf16*)F.out; const float* dtraw = WSP(float, WS_DTRAW);
    for (int item = F.vcu; item < NB * NHEADS; item += F.G) {
        const int b = item >> 4, h = item & 15, g = h >> 2;
        int tid = tid0; asm volatile("" : "+v"(tid)); int lane = tid & 63;
        const float A = -__expf((F.a->in[9])[h]), Dh = (F.a->in[10])[h], dtb = (F.a->in[8])[h];
        const int pbs = w >> 1, nb0 = 4 * (w & 1);
        f32x4 st[4];
#pragma unroll
        for (int j = 0; j < 4; ++j) st[j] = (f32x4){0.f, 0.f, 0.f, 0.f};
        __syncthreads();
        for (int i = tid; i < 17408 / 16; i += NTHR) ((LAS v4u*)(L + S3_PREV))[i] = (v4u){0u, 0u, 0u, 0u};
        Ssd3Pre P;
        { const unsigned voB0 = (unsigned)((4 * (tid >> 4)) * 2048 + 1024 + g * 128 + 8 * (tid & 15)) * 2u, voX0 = (unsigned)((4 * (tid >> 3)) * 2048 + h * 64 + 8 * (tid & 7)) * 2u;
          ssd3_prefetch(P, (const char*)xc + (size_t)b * SEQ * 4096, dtraw + (size_t)b * SEQ * 16 + h, voB0, voX0, tid, lane, w); }
        if (w == 0) ssd3_cumsum(L, 0, P.d0, P.d1, dtb, A, lane);
        __syncthreads();
        for (int c = 0; c < SEQ / CHUNK; ++c) {
            const size_t row0 = (size_t)b * SEQ + (size_t)c * CHUNK; const int par = c & 1;
            asm volatile("" : "+v"(tid));
            lane = tid & 63; const int li = lane & 15, lq = lane >> 4;
            const unsigned voB = (unsigned)((4 * (tid >> 4)) * 2048 + 1024 + g * 128 + 8 * (tid & 15)) * 2u, voX = (unsigned)((4 * (tid >> 3)) * 2048 + h * 64 + 8 * (tid & 7)) * 2u;
            const unsigned voZ0 = (unsigned)((tid >> 3) * NPROJ + h * 64 + 8 * (tid & 7)) * 2u, voZ1 = voZ0 + 64u * NPROJ * 2u;
            LAS float* csf = (LAS float*)(L + S3_CSF + par * 512); LAS float* dtf = (LAS float*)(L + S3_DTF + par * 512); LAS float* wts = (LAS float*)(L + S3_WTS + par * 512);
            { const int ob = tid & 15, lb = 4 * (tid >> 4), n0 = 8 * ob;
#pragma unroll
              for (int r = 0; r < 4; ++r) { *(LAS v4u*)(L + S3_BS + (lb + r) * SSD_PITCH + n0 * 2) = P.br[r]; *(LAS v4u*)(L + S3_CS + (lb + r) * SSD_PITCH + n0 * 2) = P.cr[r]; } }
            if (tid < 256) { const int ox = tid & 7, lx = 4 * (tid >> 3), p0 = 8 * ox;
#pragma unroll
              for (int r = 0; r < 4; ++r) { float xv[8]; unpack8(P.xr[r], xv); const float tw = dtf[lx + r];
                  *(LAS v4u*)(L + S3_XDT + (lx + r) * S3_XP + p0 * 2) = (v4u){pk2(xv[0] * tw, xv[1] * tw), pk2(xv[2] * tw, xv[3] * tw), pk2(xv[4] * tw, xv[5] * tw), pk2(xv[6] * tw, xv[7] * tw)}; } }
            const char* prb = (const char*)proj + row0 * (NPROJ * 2);
            const v4u zc0 = *(const v4u*)(prb + voZ0), zc1 = *(const v4u*)(prb + voZ1);
            LDS_BARRIER();
            const float cs_end = csf[127];
            bf16x8 ca[4];
#pragma unroll
            for (int ks = 0; ks < 4; ++ks) ca[ks] = lds_frag(L + S3_CS, 16 * w + li, 64 * ks + 16 * lq);
            float csl[4];
#pragma unroll
            for (int r = 0; r < 4; ++r) csl[r] = csf[16 * w + 4 * lq + r];
            { bf16x8 bq[2][4];
#pragma unroll
              for (int ks = 0; ks < 4; ++ks) bq[0][ks] = lds_frag(L + S3_BS, li, 64 * ks + 16 * lq);
#pragma unroll
              for (int sb = 0; sb < 8; ++sb) if (sb <= (w | 1)) {
                  f32x4 cbv = (f32x4){0.f, 0.f, 0.f, 0.f};
                  const int s = 16 * sb + li; const float css = csf[s];
                  if (sb <= w) {
                      if (sb + 1 <= w) {
#pragma unroll
                          for (int ks = 0; ks < 4; ++ks) bq[(sb + 1) & 1][ks] = lds_frag(L + S3_BS, 16 * (sb + 1) + li, 64 * ks + 16 * lq); }
                      __builtin_amdgcn_sched_barrier(0);
#pragma unroll
                      for (int ks = 0; ks < 4; ++ks) cbv = __builtin_amdgcn_mfma_f32_16x16x32_bf16(ca[ks], bq[sb & 1][ks], cbv, 0, 0, 0);
                      __builtin_amdgcn_sched_barrier(0); }
#pragma unroll
                  for (int r = 0; r < 4; ++r) { const int l = 16 * w + 4 * lq + r; const float gv = (s <= l) ? cbv[r] * __expf(csl[r] - css) : 0.f;
                      *(LAS unsigned short*)(L + S3_GY + l * SSD_PITCH + s * 2) = (unsigned short)f2bf(gv); } } }
            LDS_WAIT(); asm volatile("" ::: "memory");
            f32x4 yd[4], yo[4];
#pragma unroll
            for (int pb = 0; pb < 4; ++pb) { yd[pb] = (f32x4){0.f, 0.f, 0.f, 0.f}; yo[pb] = (f32x4){0.f, 0.f, 0.f, 0.f}; }
            { bf16x8 gq[2], xq[2][4];
              gq[0] = lds_frag(L + S3_GY, 16 * w + li, 16 * lq);
#pragma unroll
              for (int pb = 0; pb < 4; ++pb) xq[0][pb] = lds_frag_tr(L + S3_XDT, S3_XP, 0, 16 * pb, li, lq);
#pragma unroll
              for (int ks = 0; ks < 4; ++ks) if (ks <= (w >> 1)) {
                  if (ks + 1 <= (w >> 1)) { gq[(ks + 1) & 1] = lds_frag(L + S3_GY, 16 * w + li, 64 * (ks + 1) + 16 * lq);
#pragma unroll
                      for (int pb = 0; pb < 4; ++pb) xq[(ks + 1) & 1][pb] = lds_frag_tr(L + S3_XDT, S3_XP, 32 * (ks + 1), 16 * pb, li, lq); }
                  __builtin_amdgcn_sched_barrier(0);
#pragma unroll
                  for (int pb = 0; pb < 4; ++pb) yd[pb] = __builtin_amdgcn_mfma_f32_16x16x32_bf16(gq[ks & 1], xq[ks & 1][pb], yd[pb], 0, 0, 0);
                  __builtin_amdgcn_sched_barrier(0); } }
            { bf16x8 pq[2][4];
#pragma unroll
              for (int pb = 0; pb < 4; ++pb) pq[0][pb] = lds_frag(L + S3_PREV, 16 * pb + li, 16 * lq);
#pragma unroll
              for (int ks = 0; ks < 4; ++ks) {
                  if (ks < 3) {
#pragma unroll
                      for (int pb = 0; pb < 4; ++pb) pq[(ks + 1) & 1][pb] = lds_frag(L + S3_PREV, 16 * pb + li, 64 * (ks + 1) + 16 * lq); }
                  __builtin_amdgcn_sched_barrier(0);
#pragma unroll
                  for (int pb = 0; pb < 4; ++pb) yo[pb] = __builtin_amdgcn_mfma_f32_16x16x32_bf16(ca[ks], pq[ks & 1][pb], yo[pb], 0, 0, 0);
                  __builtin_amdgcn_sched_barrier(0); } }
#pragma unroll
            for (int r = 0; r < 4; ++r) { const float e = __expf(csl[r]);
#pragma unroll
                for (int pb = 0; pb < 4; ++pb) *(LAS float*)(L + S3_GY + (16 * w + 4 * lq + r) * SSD_PITCH + (16 * pb + li) * 4) = yd[pb][r] + e * yo[pb][r]; }
            if (c + 1 < SEQ / CHUNK) { ssd3_prefetch(P, (const char*)xc + (row0 + CHUNK) * 4096, dtraw + (row0 + CHUNK) * 16 + h, voB, voX, tid, lane, w); }
            LDS_BARRIER();
            { const float dec = __expf(cs_end);
#pragma unroll
              for (int j = 0; j < 4; ++j) st[j] = st[j] * dec;
              bf16x8 xq[2], bq2[2][4]; f32x4 wq[2][2];
              xq[0] = lds_frag_tr(L + S3_XDT, S3_XP, 0, 16 * pbs, li, lq); wq[0][0] = *(const LAS f32x4*)(wts + 8 * lq); wq[0][1] = *(const LAS f32x4*)(wts + 8 * lq + 4);
#pragma unroll
              for (int j = 0; j < 4; ++j) bq2[0][j] = lds_frag_tr(L + S3_BS, SSD_PITCH, 0, 16 * (nb0 + j), li, lq);
#pragma unroll
              for (int ks = 0; ks < 4; ++ks) {
                  if (ks < 3) { xq[(ks + 1) & 1] = lds_frag_tr(L + S3_XDT, S3_XP, 32 * (ks + 1), 16 * pbs, li, lq); wq[(ks + 1) & 1][0] = *(const LAS f32x4*)(wts + 32 * (ks + 1) + 8 * lq); wq[(ks + 1) & 1][1] = *(const LAS f32x4*)(wts + 32 * (ks + 1) + 8 * lq + 4);
#pragma unroll
                      for (int j = 0; j < 4; ++j) bq2[(ks + 1) & 1][j] = lds_frag_tr(L + S3_BS, SSD_PITCH, 32 * (ks + 1), 16 * (nb0 + j), li, lq); }
                  __builtin_amdgcn_sched_barrier(0);
                  const f32x4 w0 = wq[ks & 1][0], w1 = wq[ks & 1][1];
                  float xv[8]; unpack8(__builtin_bit_cast(v4u, xq[ks & 1]), xv);
                  const v4u xw = (v4u){pk2(xv[0] * w0[0], xv[1] * w0[1]), pk2(xv[2] * w0[2], xv[3] * w0[3]), pk2(xv[4] * w1[0], xv[5] * w1[1]), pk2(xv[6] * w1[2], xv[7] * w1[3])};
                  const bf16x8 xf = __builtin_bit_cast(bf16x8, xw);
#pragma unroll
                  for (int j = 0; j < 4; ++j) st[j] = __builtin_amdgcn_mfma_f32_16x16x32_bf16(xf, bq2[ks & 1][j], st[j], 0, 0, 0);
                  __builtin_amdgcn_sched_barrier(0); }
#pragma unroll
              for (int j = 0; j < 4; ++j)
#pragma unroll
                  for (int r = 0; r < 4; ++r) *(LAS unsigned short*)(L + S3_PREV + (16 * pbs + 4 * lq + r) * SSD_PITCH + (16 * (nb0 + j) + li) * 2) = (unsigned short)f2bf(st[j][r]); }
#pragma unroll
            for (int k = 0; k < 2; ++k) { const int it = tid + 512 * k, l = it >> 3, o = it & 7; const size_t row = row0 + l;
                const f32x4 y0 = *(const LAS f32x4*)(L + S3_GY + l * SSD_PITCH + 32 * o), y1 = *(const LAS f32x4*)(L + S3_GY + l * SSD_PITCH + 32 * o + 16);
                const v4u xw = *(const LAS v4u*)(L + S3_XDT + l * S3_XP + 16 * o); const v4u zw = k == 0 ? zc0 : zc1; const float dsk = Dh * __builtin_amdgcn_rcpf(dtf[l]);
                float xv[8], zv[8], yv[8]; unpack8(xw, xv); unpack8(zw, zv);
                float ss = 0.f;
#pragma unroll
                for (int e = 0; e < 8; ++e) { const float yy = (e < 4 ? y0[e] : y1[e - 4]) + dsk * xv[e]; yv[e] = yy * silu_f(zv[e]); ss += yv[e] * yv[e]; }
                ss += __shfl_xor(ss, 1); ss += __shfl_xor(ss, 2); ss += __shfl_xor(ss, 4);
                if (o == 0) WSP(float, WS_STSSD)[row * 16 + h] = ss;
                *(v4u*)(WSP(bf16, WS_Y) + row * 2048 + h * 64 + 8 * o) = (v4u){pk2(yv[0], yv[1]), pk2(yv[2], yv[3]), pk2(yv[4], yv[5]), pk2(yv[6], yv[7])}; }
            if (w == 0 && c + 1 < SEQ / CHUNK) ssd3_cumsum(L, par ^ 1, P.d0, P.d1, dtb, A, lane);
            LDS_BARRIER();
        }
    }
}
constexpr int S5_XT = 0, S5_XPITCH = 2056, S5_BBT = 65792, S5_CC = S5_BBT + 16384, S5_CCPITCH = 272, S5_GLU = S5_CC + 64 * S5_CCPITCH, S5_VS = S5_GLU + 2048, S5_OT = S5_VS + 8 * 512, S5_OPITCH = 144, S5_END = S5_OT + 32 * S5_OPITCH;
static_assert(S5_END <= LDS_MAIN, "S5 LDS map");
typedef float f32x16 __attribute__((ext_vector_type(16)));
__device__ __forceinline__ void p3_s5(Frame& F) {
    const int tid = threadIdx.x, lane = tid & 63, w = __builtin_amdgcn_readfirstlane(tid >> 6);
    const int li = lane & 15, lq = lane >> 4;
    LAS unsigned char* L = F.lds;
    const bf16* proj = WSP(bf16, WS_PROJ);
    for (int item = F.vcu; item < NB * 16; item += F.G) {
        const int b = item >> 4, gs = item & 15;
        __syncthreads();
        { const int gl = tid >> 7, col = tid & 127, p = col >> 1, ri = col & 1; const float* src = WSP(float, WS_S5BB) + ((gs * 4 + gl) * 64 + p) * 32 + ri * 16;
          const f32x4 a0 = *(const f32x4*)src, a1 = *(const f32x4*)(src + 4), a2 = *(const f32x4*)(src + 8), a3 = *(const f32x4*)(src + 12);
          LAS v4u* d = (LAS v4u*)(L + S5_BBT + (gl * 128 + col) * 32);
          d[0] = (v4u){pk2(a0[0], a0[1]), pk2(a0[2], a0[3]), pk2(a1[0], a1[1]), pk2(a1[2], a1[3])}; d[1] = (v4u){pk2(a2[0], a2[1]), pk2(a2[2], a2[3]), pk2(a3[0], a3[1]), pk2(a3[2], a3[3])}; }
        { const int gl = tid >> 7, hh = (tid >> 3) & 15, kq = tid & 7; const int g = gs * 4 + gl; const float* cr = (F.a->in[17]) + (g * 16 + hh) * 64 + 8 * kq; const float* ci = (F.a->in[18]) + (g * 16 + hh) * 64 + 8 * kq;
          const f32x4 r0 = *(const f32x4*)cr, r1 = *(const f32x4*)(cr + 4), i0 = *(const f32x4*)ci, i1 = *(const f32x4*)(ci + 4);
          LAS v4u* d = (LAS v4u*)(L + S5_CC + (gl * 16 + hh) * S5_CCPITCH + kq * 32);
          d[0] = (v4u){pk2(r0[0], -i0[0]), pk2(r0[1], -i0[1]), pk2(r0[2], -i0[2]), pk2(r0[3], -i0[3])}; d[1] = (v4u){pk2(r1[0], -i1[0]), pk2(r1[1], -i1[1]), pk2(r1[2], -i1[2]), pk2(r1[3], -i1[3])}; }
        for (int i = tid; i < 1024; i += NTHR) { const int gl = i >> 8, k = (i >> 4) & 15, hh = i & 15; ((LAS unsigned short*)(L + S5_GLU))[i] = (unsigned short)f2bf((F.a->in[20])[((gs * 4 + gl) * 16 + hh) * 16 + k]); }
        const int gsc = gs * 4 + (w & 3);
        const float lbr = WSP(float, WS_S5LB)[(gsc * 64 + lane) * 2], lbi = WSP(float, WS_S5LB)[(gsc * 64 + lane) * 2 + 1];
        const int glo = w >> 1, mb = w & 1, go = gs * 4 + glo;
        const float dsk = (F.a->in[19])[go * 16 + li], gbias = (F.a->in[21])[go * 16 + li];
        float xr = 0.f, xi = 0.f;
        __syncthreads();
        const bf16* ubase = proj + (size_t)b * SEQ * NPROJ + 3072 + gs * 64;
        v4u ua = *(const v4u*)(ubase + (size_t)(lane & 31) * NPROJ + glo * 16 + 8 * (lane >> 5));
        for (int t0 = 0; t0 < SEQ; t0 += 32) {
            const bf16x8 af = __builtin_bit_cast(bf16x8, ua);
            if (t0 + 32 < SEQ) ua = *(const v4u*)(ubase + (size_t)(t0 + 32 + (lane & 31)) * NPROJ + glo * 16 + 8 * (lane >> 5));
            float uo[4];
#pragma unroll
            for (int r = 0; r < 4; ++r) uo[r] = bf2f(ubase[(size_t)(t0 + 16 * mb + 4 * lq + r) * NPROJ + glo * 16 + li]);
#pragma unroll
            for (int q = 0; q < 2; ++q) { const int cb = 2 * (w & 1) + q;
                const bf16x8 bfrag = *(const LAS bf16x8*)(L + S5_BBT + (glo * 128 + 32 * cb + (lane & 31)) * 32 + 16 * (lane >> 5));
                f32x16 acc;
#pragma unroll
                for (int r = 0; r < 16; ++r) acc[r] = 0.f;
                acc = __builtin_amdgcn_mfma_f32_32x32x16_bf16(af, bfrag, acc, 0, 0, 0);
#pragma unroll
                for (int r = 0; r < 16; ++r) { const int t = (r & 3) + 8 * (r >> 2) + 4 * (lane >> 5); *(LAS float*)(L + S5_XT + t * S5_XPITCH + (glo * 128 + 32 * cb + (lane & 31)) * 4) = acc[r]; } }
            __syncthreads();
            if (w < 4) { LAS f32x2* xp = (LAS f32x2*)(L + S5_XT + (w * 128 + 2 * lane) * 4);
#pragma unroll 8
                for (int t = 0; t < 32; ++t) { const f32x2 bu = xp[t * (S5_XPITCH / 8)]; const float nr = lbr * xr - lbi * xi + bu[0], ni = lbr * xi + lbi * xr + bu[1]; xr = nr; xi = ni; xp[t * (S5_XPITCH / 8)] = (f32x2){xr, xi}; } }
            __syncthreads();
            f32x4 yacc = (f32x4){0.f, 0.f, 0.f, 0.f};
#pragma unroll
            for (int ks = 0; ks < 4; ++ks) { const LAS float* xs = (const LAS float*)(L + S5_XT + (16 * mb + li) * S5_XPITCH + (glo * 128 + 32 * ks + 8 * lq) * 4);
                const f32x4 x0 = *(const LAS f32x4*)xs, x1 = *(const LAS f32x4*)(xs + 4);
                const v4u xa = (v4u){pk2(x0[0], x0[1]), pk2(x0[2], x0[3]), pk2(x1[0], x1[1]), pk2(x1[2], x1[3])};
                const bf16x8 cf = *(const LAS bf16x8*)(L + S5_CC + (glo * 16 + li) * S5_CCPITCH + 64 * ks + 16 * lq);
                yacc = __builtin_amdgcn_mfma_f32_16x16x32_bf16(__builtin_bit_cast(bf16x8, xa), cf, yacc, 0, 0, 0); }
            float v[4];
#pragma unroll
            for (int r = 0; r < 4; ++r) v[r] = gelu_erf(yacc[r] + dsk * uo[r]);
            LAS unsigned char* vs = L + S5_VS + w * 512;
#pragma unroll
            for (int r = 0; r < 4; ++r) *(LAS unsigned short*)(vs + (4 * lq + r) * 32 + li * 2) = (unsigned short)f2bf(v[r]);
            LDS_WAIT(); asm volatile("" ::: "memory");
            v4u va = (v4u){0u, 0u, 0u, 0u}, gw = (v4u){0u, 0u, 0u, 0u};
            if (lq < 2) { va = *(const LAS v4u*)(vs + li * 32 + 16 * lq); gw = *(const LAS v4u*)(L + S5_GLU + ((glo * 16 + li) * 16 + 8 * lq) * 2); }
            f32x4 gacc = (f32x4){0.f, 0.f, 0.f, 0.f};
            gacc = __builtin_amdgcn_mfma_f32_16x16x32_bf16(__builtin_bit_cast(bf16x8, va), __builtin_bit_cast(bf16x8, gw), gacc, 0, 0, 0);
            float o[4], ss[4];
#pragma unroll
            for (int r = 0; r < 4; ++r) { o[r] = v[r] * sigmoid_f(gacc[r] + gbias); ss[r] = o[r] * o[r]; }
#pragma unroll
            for (int r = 0; r < 4; ++r) { ss[r] += __shfl_xor(ss[r], 1); ss[r] += __shfl_xor(ss[r], 2); ss[r] += __shfl_xor(ss[r], 4); ss[r] += __shfl_xor(ss[r], 8); }
            if (li == 0) {
#pragma unroll
                for (int r = 0; r < 4; ++r) WSP(float, WS_STS5)[((size_t)b * SEQ + t0 + 16 * mb + 4 * lq + r) * NS5PART + go] = ss[r]; }
#pragma unroll
            for (int r = 0; r < 4; ++r) *(LAS unsigned short*)(L + S5_OT + (16 * mb + 4 * lq + r) * S5_OPITCH + (glo * 16 + li) * 2) = (unsigned short)f2bf(o[r]);
            __syncthreads();
            if (tid < 256) { const int t = tid >> 3, oc = tid & 7; const v4u ov = *(const LAS v4u*)(L + S5_OT + t * S5_OPITCH + 16 * oc);
                *(v4u*)(WSP(bf16, WS_Y) + ((size_t)b * SEQ + t0 + t) * 2048 + 1024 + gs * 64 + 8 * oc) = ov; }
        }
    }
}
constexpr int S5V_BU = 0, S5V_BUP = 2056, S5V_BUSZ = 16 * S5V_BUP, S5V_XT = 2 * S5V_BUSZ, S5V_XTP = 1040, S5V_XTSZ = 16 * S5V_XTP, S5V_VS = S5V_XT + 2 * S5V_XTSZ, S5V_OT = S5V_VS + 4 * 512, S5V_OTP = 144, S5V_OTSZ = 16 * S5V_OTP, S5V_END = S5V_OT + 2 * S5V_OTSZ;
static_assert(S5V_END <= LDS_MAIN, "S5 v2 LDS map");
__device__ __forceinline__ void p3_s5v2(Frame& F) {
    const int tid = threadIdx.x, lane = tid & 63, w = __builtin_amdgcn_readfirstlane(tid >> 6);
    const int li = lane & 15, lq = lane >> 4;
    LAS unsigned char* L = F.lds;
    const bf16* proj = WSP(bf16, WS_PROJ);
    constexpr int NT = SEQ / 16;
    for (int item = F.vcu; item < NB * 16; item += F.G) {
        const int b = item >> 4, gs = item & 15;
        const bool scanw = w < 4; const int gl = w & 3, g = gs * 4 + gl;
        const bf16* ubase = proj + (size_t)b * SEQ * NPROJ + 3072 + gs * 64 + gl * 16;
        __syncthreads();
        if (scanw) {
            const float lbr = WSP(float, WS_S5LB)[(g * 64 + lane) * 2], lbi = WSP(float, WS_S5LB)[(g * 64 + lane) * 2 + 1];
            bf16x8 bfr[8];
#pragma unroll
            for (int cb = 0; cb < 8; ++cb) { v4u v = (v4u){0u, 0u, 0u, 0u};
                if (lq < 2) { const int col = 16 * cb + li; const float* src = WSP(float, WS_S5BB) + (g * 64 + (col >> 1)) * 32 + (col & 1) * 16 + 8 * lq; const f32x4 a0 = *(const f32x4*)src, a1 = *(const f32x4*)(src + 4);
                    v = (v4u){pk2(a0[0], a0[1]), pk2(a0[2], a0[3]), pk2(a1[0], a1[1]), pk2(a1[2], a1[3])}; }
                bfr[cb] = __builtin_bit_cast(bf16x8, v); }
            float xr = 0.f, xi = 0.f;
            v4u ua = (v4u){0u, 0u, 0u, 0u};
            if (lq < 2) ua = *(const v4u*)(ubase + (size_t)li * NPROJ + 8 * lq);
            { const bf16x8 af = __builtin_bit_cast(bf16x8, ua);
              if (lq < 2) ua = *(const v4u*)(ubase + (size_t)(16 + li) * NPROJ + 8 * lq);
#pragma unroll
              for (int cb = 0; cb < 8; ++cb) { f32x4 acc = (f32x4){0.f, 0.f, 0.f, 0.f}; acc = __builtin_amdgcn_mfma_f32_16x16x32_bf16(af, bfr[cb], acc, 0, 0, 0);
#pragma unroll
                  for (int r = 0; r < 4; ++r) *(LAS float*)(L + S5V_BU + (4 * lq + r) * S5V_BUP + (gl * 128 + 16 * cb + li) * 4) = acc[r]; } }
            LDS_BARRIER();
            for (int k = 0; k <= NT; ++k) {
                if (k < NT) {
                    const LAS f32x2* bp = (const LAS f32x2*)(L + S5V_BU + (k & 1) * S5V_BUSZ + (gl * 128 + 2 * lane) * 4);
                    LAS unsigned* xp = (LAS unsigned*)(L + S5V_XT + (k & 1) * S5V_XTSZ + (gl * 128 + 2 * lane) * 2);
                    f32x2 bu[16];
#pragma unroll
                    for (int t = 0; t < 16; ++t) bu[t] = bp[t * (S5V_BUP / 8)];
                    unsigned xo[16];
#pragma unroll
                    for (int t = 0; t < 16; ++t) { const float nr = lbr * xr + (bu[t][0] - lbi * xi), ni = lbr * xi + (lbi * xr + bu[t][1]); xr = nr; xi = ni; xo[t] = pk2(xr, xi); }
#pragma unroll
                    for (int t = 0; t < 16; ++t) xp[t * (S5V_XTP / 4)] = xo[t];
                    if (k + 1 < NT) {
                        const bf16x8 af = __builtin_bit_cast(bf16x8, ua);
                        if (lq < 2 && k + 2 < NT) ua = *(const v4u*)(ubase + (size_t)(16 * (k + 2) + li) * NPROJ + 8 * lq);
                        LAS unsigned char* bun = L + S5V_BU + ((k + 1) & 1) * S5V_BUSZ;
#pragma unroll
                        for (int cb = 0; cb < 8; ++cb) { f32x4 acc = (f32x4){0.f, 0.f, 0.f, 0.f}; acc = __builtin_amdgcn_mfma_f32_16x16x32_bf16(af, bfr[cb], acc, 0, 0, 0);
#pragma unroll
                            for (int r = 0; r < 4; ++r) *(LAS float*)(bun + (4 * lq + r) * S5V_BUP + (gl * 128 + 16 * cb + li) * 4) = acc[r]; }
                    }
                }
                LDS_BARRIER();
            }
        } else {
            bf16x8 cfr[4];
#pragma unroll
            for (int ks = 0; ks < 4; ++ks) { const float* cr = (F.a->in[17]) + (g * 16 + li) * 64 + 16 * ks + 4 * lq; const float* ci = (F.a->in[18]) + (g * 16 + li) * 64 + 16 * ks + 4 * lq;
                const f32x4 r0 = *(const f32x4*)cr, i0 = *(const f32x4*)ci;
                cfr[ks] = __builtin_bit_cast(bf16x8, ((v4u){pk2(r0[0], -i0[0]), pk2(r0[1], -i0[1]), pk2(r0[2], -i0[2]), pk2(r0[3], -i0[3])})); }
            v4u gwv = (v4u){0u, 0u, 0u, 0u};
            if (lq < 2) { float gwf[8];
#pragma unroll
                for (int j = 0; j < 8; ++j) gwf[j] = (F.a->in[20])[(g * 16 + 8 * lq + j) * 16 + li];
                gwv = (v4u){pk2(gwf[0], gwf[1]), pk2(gwf[2], gwf[3]), pk2(gwf[4], gwf[5]), pk2(gwf[6], gwf[7])}; }
            const bf16x8 gfr = __builtin_bit_cast(bf16x8, gwv);
            const float dsk = (F.a->in[19])[g * 16 + li], gbias = (F.a->in[21])[g * 16 + li];
            LAS unsigned char* vs = L + S5V_VS + gl * 512;
            float uo[4];
#pragma unroll
            for (int r = 0; r < 4; ++r) uo[r] = bf2f(ubase[(size_t)(4 * lq + r) * NPROJ + li]);
            LDS_BARRIER();
            for (int k = 0; k <= NT; ++k) {
                if (k >= 2) {
                    const int t = ((tid - 256) >> 3) & 15, oc = tid & 7; const v4u ov = *(const LAS v4u*)(L + S5V_OT + (k & 1) * S5V_OTSZ + t * S5V_OTP + 16 * oc);
                    if (tid < 384) *(v4u*)(WSP(bf16, WS_Y) + ((size_t)b * SEQ + 16 * (k - 2) + t) * 2048 + 1024 + gs * 64 + 8 * oc) = ov; }
                if (k >= 1) {
                    const int kt = k - 1; const LAS unsigned char* xt = L + S5V_XT + (kt & 1) * S5V_XTSZ;
                    float un[4];
                    if (k < NT) {
#pragma unroll
                        for (int r = 0; r < 4; ++r) un[r] = bf2f(ubase[(size_t)(16 * k + 4 * lq + r) * NPROJ + li]); }
                    f32x4 yacc = (f32x4){0.f, 0.f, 0.f, 0.f};
#pragma unroll
                    for (int ks = 0; ks < 4; ++ks) yacc = __builtin_amdgcn_mfma_f32_16x16x32_bf16(*(const LAS bf16x8*)(xt + li * S5V_XTP + (gl * 128 + 32 * ks + 8 * lq) * 2), cfr[ks], yacc, 0, 0, 0);
                    float v[4];
                    { const f32x2 g0 = gelu_pk2((f32x2){yacc[0] + dsk * uo[0], yacc[1] + dsk * uo[1]}), g1 = gelu_pk2((f32x2){yacc[2] + dsk * uo[2], yacc[3] + dsk * uo[3]}); v[0] = g0[0]; v[1] = g0[1]; v[2] = g1[0]; v[3] = g1[1]; }
#pragma unroll
                    for (int r = 0; r < 4; ++r) *(LAS unsigned short*)(vs + (4 * lq + r) * 32 + li * 2) = (unsigned short)f2bf(v[r]);
                    LDS_WAIT(); asm volatile("" ::: "memory");
                    v4u va = (v4u){0u, 0u, 0u, 0u};
                    if (lq < 2) va = *(const LAS v4u*)(vs + li * 32 + 16 * lq);
                    f32x4 gacc = (f32x4){0.f, 0.f, 0.f, 0.f};
                    gacc = __builtin_amdgcn_mfma_f32_16x16x32_bf16(__builtin_bit_cast(bf16x8, va), gfr, gacc, 0, 0, 0);
                    float o[4], ss[4];
#pragma unroll
                    for (int r = 0; r < 4; ++r) { o[r] = v[r] * sigmoid_f(gacc[r] + gbias); ss[r] = o[r] * o[r]; }
#pragma unroll
                    for (int r = 0; r < 4; ++r) ss[r] = row16_sum_to15(ss[r]);
                    if (li == 15) {
#pragma unroll
                        for (int r = 0; r < 4; ++r) WSP(float, WS_STS5)[((size_t)b * SEQ + 16 * kt + 4 * lq + r) * NS5PART + g] = ss[r]; }
                    LAS unsigned char* ot = L + S5V_OT + (kt & 1) * S5V_OTSZ;
#pragma unroll
                    for (int r = 0; r < 4; ++r) *(LAS unsigned short*)(ot + (4 * lq + r) * S5V_OTP + (gl * 16 + li) * 2) = (unsigned short)f2bf(o[r]);
                    if (k < NT) {
#pragma unroll
                        for (int r = 0; r < 4; ++r) uo[r] = un[r]; }
                }
                LDS_BARRIER();
            }
            { const int t = ((tid - 256) >> 3) & 15, oc = tid & 7; const v4u ov = *(const LAS v4u*)(L + S5V_OT + ((NT - 1) & 1) * S5V_OTSZ + t * S5V_OTP + 16 * oc);
              if (tid < 384) *(v4u*)(WSP(bf16, WS_Y) + ((size_t)b * SEQ + 16 * (NT - 1) + t) * 2048 + 1024 + gs * 64 + 8 * oc) = ov; }
        }
    }
}
__device__ __forceinline__ unsigned med3u(unsigned a, unsigned b, unsigned c) { unsigned r; asm("v_med3_u32 %0, %1, %2, %3" : "=v"(r) : "v"(a), "v"(b), "v"(c)); return r; }
__device__ __forceinline__ unsigned fkey(float v) { const unsigned u = __builtin_bit_cast(unsigned, v); return (u & 0x80000000u) ? ~u : (u | 0x80000000u); }
__device__ __forceinline__ float fkey_inv(unsigned k) { const unsigned u = (k & 0x80000000u) ? (k & 0x7fffffffu) : ~k; return __builtin_bit_cast(float, u); }
#define TOPK_INSERT(a, x) do { _Pragma("unroll") for (int _i = 15; _i >= 1; --_i) a[_i] = med3u(a[_i - 1], a[_i], (x)); a[0] = a[0] > (x) ? a[0] : (x); } while (0)
__device__ __forceinline__ void p5b_topk(Frame& F) {
    const int f_tid = threadIdx.x, f_lane = f_tid & 63, f_wave = __builtin_amdgcn_readfirstlane(f_tid >> 6);
    const _Float16* scores = WSP(_Float16, WS_SCORES);
    LAS unsigned char* ix = (LAS unsigned char*)F.lds + f_tid * 36;
    for (int item = F.vcu * NTHR + f_tid; item < MTOK * PH; item += F.G * NTHR) {
        const int t = item >> 3, hd = item & 7;
        unsigned a1[16], a2[16];
#pragma unroll
        for (int i = 0; i < 16; ++i) { a1[i] = 0u; a2[i] = 0u; }
        const _Float16* sp = scores + (size_t)t * 2048 + hd * 256;
        typedef _Float16 f16x8 __attribute__((ext_vector_type(8)));
#pragma unroll 1
        for (int m = 0; m < 2; ++m) { f16x8 sv[8];
#pragma unroll
            for (int q = 0; q < 8; ++q) sv[q] = *(const f16x8*)(sp + 64 * m + 8 * q);
#pragma unroll
            for (int q = 0; q < 8; ++q)
#pragma unroll
                for (int e = 0; e < 8; ++e) { const unsigned k = (fkey((float)sv[q][e]) & ~127u) | (unsigned)(127 - (64 * m + 8 * q + e)); TOPK_INSERT(a1, k); } }
#pragma unroll 1
        for (int m = 0; m < 2; ++m) { f16x8 sv[8];
#pragma unroll
            for (int q = 0; q < 8; ++q) sv[q] = *(const f16x8*)(sp + 128 + 64 * m + 8 * q);
#pragma unroll
            for (int q = 0; q < 8; ++q)
#pragma unroll
                for (int e = 0; e < 8; ++e) { const unsigned k = (fkey((float)sv[q][e]) & ~127u) | (unsigned)(127 - (64 * m + 8 * q + e)); TOPK_INSERT(a2, k); } }
        float v1[16], v2[16];
#pragma unroll
        for (int i = 0; i < 16; ++i) { ix[i] = (unsigned char)(127u - (a1[i] & 127u)); ix[16 + i] = (unsigned char)(127u - (a2[i] & 127u)); v1[i] = fkey_inv(a1[i] & ~127u); v2[i] = fkey_inv(a2[i] & ~127u); }
        unsigned cb[16];
#pragma unroll
        for (int i = 0; i < 16; ++i) cb[i] = 0u;
#pragma unroll
        for (int i = 0; i < 16; ++i)
#pragma unroll
            for (int j = 0; j < 16; ++j) if ((i + 1) * (j + 1) <= 16) { const unsigned k = (fkey(v1[i] + v2[j]) & ~255u) | (unsigned)(255 - (i * 16 + j)); TOPK_INSERT(cb, k); }
        float tv[16]; float mx = -3.0e38f;
#pragma unroll
        for (int k = 0; k < 16; ++k) { tv[k] = fkey_inv(cb[k] & ~255u); mx = fmaxf(mx, tv[k]); }
        float sum = 0.f;
#pragma unroll
        for (int k = 0; k < 16; ++k) { tv[k] = __expf(tv[k] - mx); sum += tv[k]; }
        const float inv = 1.0f / sum;
        LDS_WAIT(); asm volatile("" ::: "memory");
        int ev[16]; unsigned long long c64 = 0ull;
#pragma unroll
        for (int k = 0; k < 16; ++k) { const unsigned code = 255u - (cb[k] & 255u); const int i = code >> 4, j = code & 15; ev[k] = (int)ix[i] * 128 + (int)ix[16 + j]; c64 += 1ull << (8 * (ev[k] >> 11)); }
        unsigned long long s64 = c64;
#pragma unroll
        for (int o = 1; o < 8; o <<= 1) { const unsigned lo = __shfl_up((unsigned)s64, o, 8), hi = __shfl_up((unsigned)(s64 >> 32), o, 8); if ((f_lane & 7) >= o) s64 += ((unsigned long long)hi << 32) | lo; }
        const unsigned long long e64 = s64 - c64;
        const unsigned long long t64 = ((unsigned long long)__shfl((unsigned)(s64 >> 32), 7, 8) << 32) | __shfl((unsigned)s64, 7, 8);
        const unsigned long long st64 = (t64 * 0x0101010101010101ull) << 8;
        unsigned long long base64 = st64 + e64;
        int* eo = WSP(int, WS_EID) + (size_t)t * 128; float* go = WSP(float, WS_GATE) + (size_t)t * 128;
#pragma unroll
        for (int k = 0; k < 16; ++k) { const int r8 = 8 * (ev[k] >> 11); const int slot = (int)((base64 >> r8) & 255ull); base64 += 1ull << r8; eo[slot] = ev[k]; go[slot] = tv[k] * inv; }
        if (hd == 0) WSP(unsigned long long, WS_START)[t] = st64;
        LDS_WAIT(); asm volatile("" ::: "memory");
    }
}
__device__ __forceinline__ void dec16(const v4u q, float* f) {
#pragma unroll
    for (int i = 0; i < 4; ++i) { const f32x2 lo = __builtin_amdgcn_cvt_pk_f32_fp8((int)q[i], false), hi = __builtin_amdgcn_cvt_pk_f32_fp8((int)q[i], true); f[4 * i] = lo[0]; f[4 * i + 1] = lo[1]; f[4 * i + 2] = hi[0]; f[4 * i + 3] = hi[1]; }
}
__device__ __forceinline__ void p8_peer_up(Frame& F) {
    const int f_tid = threadIdx.x, lane = f_tid & 63, f_wave = __builtin_amdgcn_readfirstlane(f_tid >> 6);
    const int rr = blockIdx.x & 7, wk = (blockIdx.x >> 3) * NWAVES + f_wave, nwk = (F.G >> 3) * NWAVES;
    const unsigned char* EU = F.ws + WS_EU;
    for (int blk = wk; blk < MTOK / 128; blk += nwk) {
        const int b = blk >> 4; const float* mb = WSP(float, WS_MOD) + (size_t)b * 6144;
        float S2[16];
#pragma unroll
        for (int q = 0; q < 4; ++q) { const f32x4 sh = *(const f32x4*)(mb + 3072 + 16 * lane + 4 * q); S2[4 * q] = sh[0]; S2[4 * q + 1] = sh[1]; S2[4 * q + 2] = sh[2]; S2[4 * q + 3] = sh[3]; }
        for (int tt = 0; tt < 128; ++tt) {
            const size_t t = (size_t)blk * 128 + tt;
            const unsigned long long st64 = WSP(unsigned long long, WS_START)[t];
            const int s0 = (int)((st64 >> (8 * rr)) & 255ull), s1 = rr == 7 ? 128 : (int)((st64 >> (8 * rr + 8)) & 255ull), cnt = s1 - s0;
            if (cnt <= 0) continue;
            const float rs = rsqrt_f(WSP(float, WS_ROWSTAT)[t] * (1.0f / 1024.0f) + EPSF);
            const bf16* xr = WSP(bf16, WS_X1S) + t * 1024 + 16 * lane; const v4u xa = *(const v4u*)xr, xb = *(const v4u*)(xr + 8);
            float h2[16]; unpack8(xa, h2); unpack8(xb, h2 + 8);
#pragma unroll
            for (int i = 0; i < 16; ++i) h2[i] = h2[i] * rs + S2[i];
            int* ep = WSP(int, WS_EID) + t * 128 + s0; float* gp = WSP(float, WS_GATE) + t * 128 + s0;
            for (int j0 = 0; j0 < cnt; j0 += 8) {
                const int myi = j0 + (lane & 7) < cnt ? j0 + (lane & 7) : cnt - 1;
                const int emine = ep[myi]; const float gmine = gp[myi];
                v4u q[8];
#pragma unroll
                for (int j = 0; j < 8; ++j) { const int e = __shfl(emine, j); q[j] = *(const v4u*)(EU + (size_t)e * 1024 + 16 * lane); }
                float d[8];
#pragma unroll
                for (int j = 0; j < 8; ++j) { float f[16]; dec16(q[j], f); float a = 0.f;
#pragma unroll
                    for (int i = 0; i < 16; ++i) a += h2[i] * f[i];
                    d[j] = a; }
                float e4[4], e2[2], e1;
#pragma unroll
                for (int i = 0; i < 4; ++i) { const bool up = lane & 32; const float snd = up ? d[i] : d[i + 4]; const float rcv = __shfl_xor(snd, 32); e4[i] = (up ? d[i + 4] : d[i]) + rcv; }
#pragma unroll
                for (int i = 0; i < 2; ++i) { const bool up = lane & 16; const float snd = up ? e4[i] : e4[i + 2]; const float rcv = __shfl_xor(snd, 16); e2[i] = (up ? e4[i + 2] : e4[i]) + rcv; }
                { const bool up = lane & 8; const float snd = up ? e2[0] : e2[1]; const float rcv = __shfl_xor(snd, 8); e1 = (up ? e2[1] : e2[0]) + rcv; }
                e1 += __shfl_xor(e1, 4); e1 += __shfl_xor(e1, 2); e1 += __shfl_xor(e1, 1);
                const int myj = ((lane >> 5) & 1) * 4 + ((lane >> 4) & 1) * 2 + ((lane >> 3) & 1);
                const int ej = __shfl(emine, myj); const float gj = __shfl(gmine, myj);
                const float wv = gj * gelu_erf(e1 * WSP(float, WS_EUS)[ej]) * WSP(float, WS_EVS)[ej];
                if ((lane & 7) == 0 && j0 + myj < cnt) gp[j0 + myj] = wv;
            }
        }
    }
}
__device__ __forceinline__ void p9_peer_down(Frame& F, float* dst) {
    const int f_tid = threadIdx.x, lane = f_tid & 63, f_wave = __builtin_amdgcn_readfirstlane(f_tid >> 6);
    const unsigned char* EV = F.ws + WS_EV;
    for (int wq = F.vcu * NWAVES + f_wave; wq < MTOK / 16; wq += F.G * NWAVES) {
        const int b = wq >> 7; const float* mb = WSP(float, WS_MOD) + (size_t)b * 6144;
        float GT[16], NF[16];
#pragma unroll
        for (int q = 0; q < 4; ++q) { const f32x4 gt = *(const f32x4*)(mb + 5120 + 16 * lane + 4 * q), nf = *(const f32x4*)((F.a->in[29]) + 16 * lane + 4 * q);
#pragma unroll
            for (int e = 0; e < 4; ++e) { GT[4 * q + e] = gt[e]; NF[4 * q + e] = nf[e]; } }
        for (int tt = 0; tt < 16; ++tt) {
            const size_t t = (size_t)wq * 16 + tt; float* xr = F.out + t * 1024 + 16 * lane;
            const int e_lo = WSP(int, WS_EID)[t * 128 + lane], e_hi = WSP(int, WS_EID)[t * 128 + 64 + lane];
            const float w_lo = WSP(float, WS_GATE)[t * 128 + lane], w_hi = WSP(float, WS_GATE)[t * 128 + 64 + lane];
            f32x2 o[8];
#pragma unroll
            for (int i = 0; i < 8; ++i) o[i] = (f32x2){0.f, 0.f};
            for (int grp = 0; grp < 16; ++grp) {
                const int esel = grp < 8 ? e_lo : e_hi; const float wsel = grp < 8 ? w_lo : w_hi; const int base = (grp & 7) * 8;
                v4u q[8];
#pragma unroll
                for (int j = 0; j < 8; ++j) { const int e = __shfl(esel, base + j); q[j] = *(const v4u*)(EV + (size_t)e * 1024 + 16 * lane); }
#pragma unroll
                for (int j = 0; j < 8; ++j) { const float wj = __shfl(wsel, base + j); const f32x2 w2 = (f32x2){wj, wj};
#pragma unroll
                    for (int i = 0; i < 4; ++i) { const f32x2 lo = __builtin_amdgcn_cvt_pk_f32_fp8((int)q[j][i], false), hi = __builtin_amdgcn_cvt_pk_f32_fp8((int)q[j][i], true); o[2 * i] += w2 * lo; o[2 * i + 1] += w2 * hi; } }
            }
            float x1[16]; float ss = 0.f;
#pragma unroll
            for (int q = 0; q < 4; ++q) { const f32x4 v = *(const f32x4*)(xr + 4 * q); x1[4 * q] = v[0]; x1[4 * q + 1] = v[1]; x1[4 * q + 2] = v[2]; x1[4 * q + 3] = v[3]; }
#pragma unroll
            for (int i = 0; i < 16; ++i) { x1[i] += GT[i] * o[i >> 1][i & 1]; ss += x1[i] * x1[i]; }
            const float rf = rsqrt_f(wave_sum(ss) * (1.0f / 1024.0f) + EPSF);
#pragma unroll
            for (int q = 0; q < 4; ++q) { f32x4 v;
#pragma unroll
                for (int e = 0; e < 4; ++e) v[e] = x1[4 * q + e] * rf * NF[4 * q + e];
                *(f32x4*)(dst + t * 1024 + 16 * lane + 4 * q) = v; }
        }
    }
}

__device__ __forceinline__ void p8_peer_fused(Frame& F) {
    const int f_tid = threadIdx.x, lane = f_tid & 63, f_wave = __builtin_amdgcn_readfirstlane(f_tid >> 6);
    const unsigned char* EU = F.ws + WS_EU; const unsigned char* EV = F.ws + WS_EV;
    const int myj = ((lane >> 5) & 1) * 4 + ((lane >> 4) & 1) * 2 + ((lane >> 3) & 1);
    const unsigned l16 = 16u * (unsigned)lane;
    for (int wq = F.vcu * NWAVES + f_wave; wq < MTOK / 16; wq += F.G * NWAVES) {
        const int b = wq >> 7; const float* mb = WSP(float, WS_MOD) + (size_t)b * 6144;
        for (int tt = 0; tt < 16; ++tt) {
            const size_t t = (size_t)wq * 16 + tt;
            unsigned lo16 = 16u * (unsigned)lane; asm volatile("" : "+v"(lo16));
            float* xr = (float*)((char*)(F.out + t * 1024) + 4u * lo16);
            const int e_lo = WSP(int, WS_EID)[t * 128 + lane], e_hi = WSP(int, WS_EID)[t * 128 + 64 + lane];
            const float g_lo = WSP(float, WS_GATE)[t * 128 + lane], g_hi = WSP(float, WS_GATE)[t * 128 + 64 + lane];
            const float su_lo = WSP(float, WS_EUS)[e_lo], su_hi = WSP(float, WS_EUS)[e_hi], sv_lo = WSP(float, WS_EVS)[e_lo], sv_hi = WSP(float, WS_EVS)[e_hi];
            const float rs = rsqrt_f(WSP(float, WS_ROWSTAT)[t] * (1.0f / 1024.0f) + EPSF);
            const char* xs = (const char*)(WSP(bf16, WS_X1S) + t * 1024) + 2u * lo16; const v4u xa = *(const v4u*)xs, xb = *(const v4u*)(xs + 16);
            float h2[16]; unpack8(xa, h2); unpack8(xb, h2 + 8);
#pragma unroll
            for (int q = 0; q < 4; ++q) { const f32x4 sh = *(const f32x4*)(mb + 3072 + 16 * lane + 4 * q);
#pragma unroll
                for (int e = 0; e < 4; ++e) h2[4 * q + e] = h2[4 * q + e] * rs + sh[e]; }
            f32x2 o[8];
#pragma unroll
            for (int i = 0; i < 8; ++i) o[i] = (f32x2){0.f, 0.f};
            v4u qu[8], qv[8], nu[8], nv[8];
#pragma unroll
            for (int j = 0; j < 8; ++j) { const int e = __builtin_amdgcn_readlane(e_lo, j); const unsigned off = (unsigned)e * 1024u + l16; qu[j] = *(const v4u*)(EU + off); qv[j] = *(const v4u*)(EV + off); }
#pragma unroll 1
            for (int grp = 0; grp < 16; ++grp) {
                const int nb = ((grp + 1) & 7) * 8; const int ensel = (grp + 1) < 8 ? e_lo : e_hi;
                if (grp < 15) {
#pragma unroll
                    for (int j = 0; j < 8; ++j) { const int e = __builtin_amdgcn_readlane(ensel, nb + j); const unsigned off = (unsigned)e * 1024u + l16; nu[j] = *(const v4u*)(EU + off); nv[j] = *(const v4u*)(EV + off); } }
                const int base = (grp & 7) * 8;
                const float gsel = grp < 8 ? g_lo : g_hi, susel = grp < 8 ? su_lo : su_hi, svsel = grp < 8 ? sv_lo : sv_hi;
                float d[8];
#pragma unroll
                for (int j = 0; j < 8; ++j) { float f[16]; dec16(qu[j], f); float a = 0.f;
#pragma unroll
                    for (int i = 0; i < 16; ++i) a += h2[i] * f[i];
                    d[j] = a; }
                float e4[4], e2[2], e1;
#pragma unroll
                for (int i = 0; i < 4; ++i) { const bool up = lane & 32; const float snd = up ? d[i] : d[i + 4]; const float rcv = __shfl_xor(snd, 32); e4[i] = (up ? d[i + 4] : d[i]) + rcv; }
#pragma unroll
                for (int i = 0; i < 2; ++i) { const bool up = lane & 16; const float snd = up ? e4[i] : e4[i + 2]; const float rcv = __shfl_xor(snd, 16); e2[i] = (up ? e4[i + 2] : e4[i]) + rcv; }
                { const bool up = lane & 8; const float snd = up ? e2[0] : e2[1]; const float rcv = __shfl_xor(snd, 8); e1 = (up ? e2[1] : e2[0]) + rcv; }
                e1 += __shfl_xor(e1, 4); e1 += __shfl_xor(e1, 2); e1 += __shfl_xor(e1, 1);
                const float wmine = __shfl(gsel, base + myj) * gelu_erf(e1 * __shfl(susel, base + myj)) * __shfl(svsel, base + myj);
#pragma unroll
                for (int j = 0; j < 8; ++j) { const int src = ((j >> 2) & 1) * 32 + ((j >> 1) & 1) * 16 + (j & 1) * 8; const float wj = __builtin_bit_cast(float, __builtin_amdgcn_readlane(__builtin_bit_cast(int, wmine), src)); const f32x2 w2 = (f32x2){wj, wj};
#pragma unroll
                    for (int i = 0; i < 4; ++i) { const f32x2 lo = __builtin_amdgcn_cvt_pk_f32_fp8((int)qv[j][i], false), hi = __builtin_amdgcn_cvt_pk_f32_fp8((int)qv[j][i], true); o[2 * i] += w2 * lo; o[2 * i + 1] += w2 * hi; } }
#pragma unroll
                for (int j = 0; j < 8; ++j) { qu[j] = nu[j]; qv[j] = nv[j]; }
            }
            float x1[16]; float ss = 0.f;
#pragma unroll
            for (int q = 0; q < 4; ++q) { const f32x4 v = *(const f32x4*)(xr + 4 * q); x1[4 * q] = v[0]; x1[4 * q + 1] = v[1]; x1[4 * q + 2] = v[2]; x1[4 * q + 3] = v[3]; }
#pragma unroll
            for (int q = 0; q < 4; ++q) { const f32x4 gt = *(const f32x4*)(mb + 5120 + 16 * lane + 4 * q);
#pragma unroll
                for (int e = 0; e < 4; ++e) { const int i = 4 * q + e; x1[i] += gt[e] * o[i >> 1][i & 1]; ss += x1[i] * x1[i]; } }
            const float rf = rsqrt_f(wave_sum(ss) * (1.0f / 1024.0f) + EPSF);
#pragma unroll
            for (int q = 0; q < 4; ++q) { const f32x4 nf = *(const f32x4*)((F.a->in[29]) + 16 * lane + 4 * q); f32x4 v;
#pragma unroll
                for (int e = 0; e < 4; ++e) v[e] = x1[4 * q + e] * rf * nf[e];
                *(f32x4*)(xr + 4 * q) = v; }
        }
    }
}
struct PeerMeta { unsigned long long st; float rs; v4u xa, xb; int elo, ehi; float glo, ghi; };
__device__ __forceinline__ void peer_meta_load(PeerMeta& M, const unsigned char* ws, size_t t, unsigned l16) {
    M.st = ((const unsigned long long*)(ws + WS_START))[t]; M.rs = ((const float*)(ws + WS_ROWSTAT))[t];
    const char* xs = (const char*)(ws + WS_X1S) + t * 2048 + 2u * l16; M.xa = *(const v4u*)xs; M.xb = *(const v4u*)(xs + 16);
    const int* ep = (const int*)(ws + WS_EID) + t * 128; const float* gp = (const float*)(ws + WS_GATE) + t * 128;
    const unsigned l = l16 >> 4; M.elo = ep[l]; M.ehi = ep[64 + l]; M.glo = gp[l]; M.ghi = gp[64 + l];
}
__device__ __forceinline__ void peer_rows_issue(int elo, int ehi, float glo, float ghi, int i0, int iend, const unsigned char* EU, const float* EUS, const float* EVS, unsigned l16, int lane, v4u* q, float& gmine, float& su, float& sv) {
    int idx = i0 + (lane & 7); idx = idx < iend ? idx : iend - 1; idx = idx < 0 ? 0 : (idx > 127 ? 127 : idx);
    const int ea = __shfl(elo, idx & 63), eb = __shfl(ehi, idx & 63); const int emine = idx < 64 ? ea : eb;
    const float ga = __shfl(glo, idx & 63), gb = __shfl(ghi, idx & 63); gmine = idx < 64 ? ga : gb;
#pragma unroll
    for (int j = 0; j < 8; ++j) { const int e = __builtin_amdgcn_readlane(emine, j); q[j] = *(const v4u*)(EU + ((unsigned)e * 1024u + l16)); }
    su = EUS[emine]; sv = EVS[emine];
}
__device__ __forceinline__ void p8_peer_up2(Frame& F) {
    const int f_tid = threadIdx.x, lane = f_tid & 63, f_wave = __builtin_amdgcn_readfirstlane(f_tid >> 6);
    const unsigned char* EU = F.ws + WS_EU; const float* EUS = WSP(float, WS_EUS); const float* EVS = WSP(float, WS_EVS);
    unsigned* ctr = (unsigned*)(F.ws + WS_CTL) + 8192;
    int rr = (int)(xb_xcc_id() & 7u), tries = 0;
    for (;;) {
        int blk = 0;
        if (lane == 0) blk = (int)__hip_atomic_fetch_add(ctr + 64 * rr, 1u, __ATOMIC_RELAXED, __HIP_MEMORY_SCOPE_AGENT);
        blk = __builtin_amdgcn_readfirstlane(blk);
        if (blk >= MTOK / 128) { if (++tries >= 8) break; rr = (rr + 1) & 7; continue; }
        const int b = blk >> 4; const float* mb = WSP(float, WS_MOD) + (size_t)b * 6144;
        unsigned l16 = 16u * (unsigned)lane; asm volatile("" : "+v"(l16));
        float S2[16];
#pragma unroll
        for (int q = 0; q < 4; ++q) { const f32x4 sh = *(const f32x4*)((const char*)(mb + 3072) + 4u * l16 + 16 * q); S2[4 * q] = sh[0]; S2[4 * q + 1] = sh[1]; S2[4 * q + 2] = sh[2]; S2[4 * q + 3] = sh[3]; }
        const size_t tb = (size_t)blk * 128;
        PeerMeta M0, M1, M2, M3, M4;
        peer_meta_load(M0, F.ws, tb, l16); peer_meta_load(M1, F.ws, tb + 1, l16); peer_meta_load(M2, F.ws, tb + 2, l16); peer_meta_load(M3, F.ws, tb + 3, l16);
        v4u qa[8], qb[8]; float ga_, sua, sva, gb_ = 0.f, sub = 0.f, svb = 0.f;
        int s0 = (int)((M0.st >> (8 * rr)) & 255ull), s1 = rr == 7 ? 128 : (int)((M0.st >> (8 * rr + 8)) & 255ull);
        peer_rows_issue(M0.elo, M0.ehi, M0.glo, M0.ghi, s0, s1, EU, EUS, EVS, l16, lane, qa, ga_, sua, sva);
        for (int tt = 0; tt < 128; ++tt) {
            if (tt + 4 < 128) peer_meta_load(M4, F.ws, tb + tt + 4, l16);
            float h2[16]; unpack8(M0.xa, h2); unpack8(M0.xb, h2 + 8);
            const float rs = rsqrt_f(M0.rs * (1.0f / 1024.0f) + EPSF);
#pragma unroll
            for (int i = 0; i < 16; ++i) h2[i] = h2[i] * rs + S2[i];
            const int cnt = s1 - s0, ngrp = cnt > 0 ? (cnt + 7) >> 3 : 1;
            const int n0 = (int)((M1.st >> (8 * rr)) & 255ull), n1 = rr == 7 ? 128 : (int)((M1.st >> (8 * rr + 8)) & 255ull);
            float* gp = WSP(float, WS_GATE) + (tb + tt) * 128;
            for (int g = 0; g < ngrp; ++g) {
                { const bool same = (g + 1 < ngrp);
                  peer_rows_issue(same ? M0.elo : M1.elo, same ? M0.ehi : M1.ehi, same ? M0.glo : M1.glo, same ? M0.ghi : M1.ghi, same ? s0 + 8 * (g + 1) : n0, same ? s1 : n1, EU, EUS, EVS, l16, lane, qb, gb_, sub, svb); }
                __builtin_amdgcn_sched_barrier(0);
                float d[8];
#pragma unroll
                for (int j = 0; j < 8; ++j) { float f[16]; dec16(qa[j], f); float a = 0.f;
#pragma unroll
                    for (int i = 0; i < 16; ++i) a += h2[i] * f[i];
                    d[j] = a; }
                float dmine = 0.f;
#pragma unroll
                for (int j = 0; j < 8; ++j) { const float tot = wave_sum_to63(d[j]); const float sj = __builtin_bit_cast(float, __builtin_amdgcn_readlane(__builtin_bit_cast(int, tot), 63)); dmine = (lane == j) ? sj : dmine; }
                const float wv = ga_ * gelu_erf(dmine * sua) * sva;
                { const int idx = s0 + 8 * g + lane; if (lane < 8 && idx < s1) gp[idx] = wv; }
#pragma unroll
                for (int j = 0; j < 8; ++j) qa[j] = qb[j];
                ga_ = gb_; sua = sub; sva = svb;
                asm volatile("" : "+v"(ga_), "+v"(sua), "+v"(sva));
            }
            M0 = M1; M1 = M2; M2 = M3; M3 = M4; s0 = n0; s1 = n1;
        }
    }
}
__device__ __forceinline__ void xcc_rendezvous(Frame& F, const XcdBarrier& bar, int which);
__device__ __forceinline__ void p9_peer_down2(Frame& F, const XcdBarrier& bar) {
    const int f_tid = threadIdx.x, lane = f_tid & 63, f_wave = __builtin_amdgcn_readfirstlane(f_tid >> 6);
    const unsigned char* EV = F.ws + WS_EV;
    for (int wq = F.vcu * NWAVES + f_wave; wq < MTOK / 16; wq += F.G * NWAVES) {
        const int b = wq >> 7; const float* mb = WSP(float, WS_MOD) + (size_t)b * 6144;
        for (int tt = 0; tt < 16; ++tt) {
            const size_t t = (size_t)wq * 16 + tt;
            unsigned l16 = 16u * (unsigned)lane; asm volatile("" : "+v"(l16));
            float* xr = (float*)((char*)(F.out + t * 1024) + 4u * l16);
            const int e_lo = WSP(int, WS_EID)[t * 128 + lane], e_hi = WSP(int, WS_EID)[t * 128 + 64 + lane];
            const float w_lo = WSP(float, WS_GATE)[t * 128 + lane], w_hi = WSP(float, WS_GATE)[t * 128 + 64 + lane];
            f32x2 o[8];
#pragma unroll
            for (int i = 0; i < 8; ++i) o[i] = (f32x2){0.f, 0.f};
            v4u qa[8], qb[8];
#pragma unroll
            for (int j = 0; j < 8; ++j) { const int e = __builtin_amdgcn_readlane(e_lo, j); qa[j] = *(const v4u*)(EV + ((unsigned)e * 1024u + l16)); }
#define DN2_STEP(GRP, CUR, NXT) { \
                const int grp = (GRP); const int nb = ((grp + 1) & 7) * 8; const int ensel = (grp + 1) < 8 ? e_lo : e_hi; \
                { _Pragma("unroll") for (int j = 0; j < 8; ++j) { const int e = __builtin_amdgcn_readlane(ensel, nb + j); NXT[j] = *(const v4u*)(EV + ((unsigned)e * 1024u + l16)); } } \
                __builtin_amdgcn_sched_barrier(0); \
                const int base = (grp & 7) * 8; const float wsel = grp < 8 ? w_lo : w_hi; \
                _Pragma("unroll") for (int j = 0; j < 8; ++j) { const float wj = __builtin_bit_cast(float, __builtin_amdgcn_readlane(__builtin_bit_cast(int, wsel), base + j)); const f32x2 w2 = (f32x2){wj, wj}; \
                    _Pragma("unroll") for (int i = 0; i < 4; ++i) { const f32x2 lo = __builtin_amdgcn_cvt_pk_f32_fp8((int)CUR[j][i], false), hi = __builtin_amdgcn_cvt_pk_f32_fp8((int)CUR[j][i], true); o[2 * i] += w2 * lo; o[2 * i + 1] += w2 * hi; } } }
#pragma unroll 1
            for (int g2 = 0; g2 < 16; g2 += 2) { DN2_STEP(g2, qa, qb) DN2_STEP(g2 + 1, qb, qa) }
#undef DN2_STEP
            float x1[16]; float ss = 0.f;
#pragma unroll
            for (int q4 = 0; q4 < 4; ++q4) { const f32x4 v = *(const f32x4*)(xr + 4 * q4); x1[4 * q4] = v[0]; x1[4 * q4 + 1] = v[1]; x1[4 * q4 + 2] = v[2]; x1[4 * q4 + 3] = v[3]; }
#pragma unroll
            for (int q4 = 0; q4 < 4; ++q4) { const f32x4 gt = *(const f32x4*)((const char*)(mb + 5120) + 4u * l16 + 16 * q4);
#pragma unroll
                for (int e = 0; e < 4; ++e) { const int i = 4 * q4 + e; x1[i] += gt[e] * o[i >> 1][i & 1]; ss += x1[i] * x1[i]; } }
            const float rf = rsqrt_f(wave_sum(ss) * (1.0f / 1024.0f) + EPSF);
#pragma unroll
            for (int q4 = 0; q4 < 4; ++q4) { const f32x4 nf = *(const f32x4*)((const char*)(F.a->in[29]) + 4u * l16 + 16 * q4); f32x4 v;
#pragma unroll
                for (int e = 0; e < 4; ++e) v[e] = x1[4 * q4 + e] * rf * nf[e];
                *(f32x4*)(xr + 4 * q4) = v; }
        }
    }
}
__device__ __forceinline__ void xcc_rendezvous(Frame& F, const XcdBarrier& bar, int which) {
    __syncthreads();
    if (threadIdx.x == 0) {
        unsigned* w = (unsigned*)(F.ws + WS_CTL) + 9216 + which * 2048;
        const unsigned nloc = bar.st[0] ? bar.st[0] : 1u; const unsigned x = bar.x;
        const unsigned old = xb_add(&w[64 * x], 1u); const unsigned gen = old / nloc;
        if (old + 1u == (gen + 1u) * nloc) xb_add(&w[1024 + 64 * x], 1u);
        else { unsigned sp = 0; while (xb_ld(&w[1024 + 64 * x]) == gen) { __builtin_amdgcn_s_sleep(1); if (++sp > (1u << 16)) break; } }
    }
    __syncthreads();
}
__device__ __forceinline__ void p8_peer_up3(Frame& F, const XcdBarrier& bar) {
    const int f_tid = threadIdx.x, lane = f_tid & 63, f_wave = __builtin_amdgcn_readfirstlane(f_tid >> 6);
    const unsigned char* EU = F.ws + WS_EU; const float* EUS = WSP(float, WS_EUS); const float* EVS = WSP(float, WS_EVS);
    for (int wq = F.vcu * NWAVES + f_wave; wq < MTOK / 16; wq += F.G * NWAVES) {
        const int b = wq >> 7; const float* mb = WSP(float, WS_MOD) + (size_t)b * 6144;
        for (int tt = 0; tt < 16; ++tt) {
            const size_t t = (size_t)wq * 16 + tt;
            unsigned l16 = 16u * (unsigned)lane; asm volatile("" : "+v"(l16));
            const int e_lo = WSP(int, WS_EID)[t * 128 + lane], e_hi = WSP(int, WS_EID)[t * 128 + 64 + lane];
            const float g_lo = WSP(float, WS_GATE)[t * 128 + lane], g_hi = WSP(float, WS_GATE)[t * 128 + 64 + lane];
#ifdef PROBE_NOSCALE
            const float su_lo = 5.6e-4f, su_hi = 5.6e-4f, sv_lo = 6.3e-3f, sv_hi = 6.3e-3f;
#else
            const float su_lo = EUS[e_lo], su_hi = EUS[e_hi], sv_lo = EVS[e_lo], sv_hi = EVS[e_hi];
#endif
            const float rs = rsqrt_f(WSP(float, WS_ROWSTAT)[t] * (1.0f / 1024.0f) + EPSF);
            const char* xs = (const char*)(WSP(bf16, WS_X1S) + t * 1024) + 2u * l16; const v4u xa = *(const v4u*)xs, xb = *(const v4u*)(xs + 16);
            float h2[16]; unpack8(xa, h2); unpack8(xb, h2 + 8);
            f32x2 h2p[8];
#pragma unroll
            for (int q = 0; q < 4; ++q) { const f32x4 sh = *(const f32x4*)((const char*)(mb + 3072) + 4u * l16 + 16 * q);
                h2p[2 * q] = (f32x2){h2[4 * q] * rs + sh[0], h2[4 * q + 1] * rs + sh[1]}; h2p[2 * q + 1] = (f32x2){h2[4 * q + 2] * rs + sh[2], h2[4 * q + 3] * rs + sh[3]}; }
            float w_lo = 0.f, w_hi = 0.f;
            v4u qa[8], qb[8];
#pragma unroll
            for (int j = 0; j < 8; ++j) { const int e = __builtin_amdgcn_readlane(e_lo, j); qa[j] = *(const v4u*)(EU + ((unsigned)e * 1024u + l16)); }
#define UP3_STEP(GRP, CUR, NXT) { \
                const int grp = (GRP); const int nb = ((grp + 1) & 7) * 8; const int ensel = (grp + 1) < 8 ? e_lo : e_hi; \
                  \
                { _Pragma("unroll") for (int j = 0; j < 8; ++j) { const int e = __builtin_amdgcn_readlane(ensel, nb + j); NXT[j] = *(const v4u*)(EU + ((unsigned)e * 1024u + l16)); } } \
                __builtin_amdgcn_sched_barrier(0); \
                const int base = (grp & 7) * 8; float dmine = 0.f; \
                _Pragma("unroll") for (int j = 0; j < 8; ++j) { f32x2 a0 = (f32x2){0.f, 0.f}, a1 = (f32x2){0.f, 0.f}; \
                    _Pragma("unroll") for (int i = 0; i < 4; ++i) { const f32x2 lo = __builtin_amdgcn_cvt_pk_f32_fp8((int)CUR[j][i], false), hi = __builtin_amdgcn_cvt_pk_f32_fp8((int)CUR[j][i], true); a0 += h2p[2 * i] * lo; a1 += h2p[2 * i + 1] * hi; } \
                    const float a = (a0[0] + a0[1]) + (a1[0] + a1[1]); \
                    const float tot = wave_sum_to63(a); const float sj = __builtin_bit_cast(float, __builtin_amdgcn_readlane(__builtin_bit_cast(int, tot), 63)); \
                    dmine = (lane == base + j) ? sj : dmine; } \
                const float gsel = grp < 8 ? g_lo : g_hi, susel = grp < 8 ? su_lo : su_hi, svsel = grp < 8 ? sv_lo : sv_hi; \
                const float wv = gsel * gelu_erf(dmine * susel) * svsel; \
                const bool mine = (lane >= base) && (lane < base + 8); \
                if (grp < 8) w_lo = mine ? wv : w_lo; else w_hi = mine ? wv : w_hi; }
#pragma unroll 1
            for (int g2 = 0; g2 < 16; g2 += 2) { UP3_STEP(g2, qa, qb) UP3_STEP(g2 + 1, qb, qa) }
#undef UP3_STEP
            WSP(float, WS_GATE)[t * 128 + lane] = w_lo; WSP(float, WS_GATE)[t * 128 + 64 + lane] = w_hi;
        }
    }
}
typedef long i64_t;
__device__ __forceinline__ void p8_peer_up4(Frame& F) {
    const int f_tid = threadIdx.x, lane = f_tid & 63, f_wave = __builtin_amdgcn_readfirstlane(f_tid >> 6);
    const int li = lane & 15, lq = lane >> 4;
    const unsigned char* EU = F.ws + WS_EU; const float* EUS = WSP(float, WS_EUS); const float* EVS = WSP(float, WS_EVS);
    LAS unsigned char* hq = F.lds + f_wave * 1024;
    for (int wq = F.vcu * NWAVES + f_wave; wq < MTOK / 16; wq += F.G * NWAVES) {
        const int b = wq >> 7; const float* mb = WSP(float, WS_MOD) + (size_t)b * 6144;
        for (int tt = 0; tt < 16; ++tt) {
            const size_t t = (size_t)wq * 16 + tt;
            unsigned l16 = 16u * (unsigned)lane; asm volatile("" : "+v"(l16));
            const unsigned rowoff = 16u * (unsigned)lq;
            const int e_lo = WSP(int, WS_EID)[t * 128 + lane], e_hi = WSP(int, WS_EID)[t * 128 + 64 + lane];
            const float g_lo = WSP(float, WS_GATE)[t * 128 + lane], g_hi = WSP(float, WS_GATE)[t * 128 + 64 + lane];
            v4u q[8], nq[8];
            { const int e = __shfl(e_lo, li);
#pragma unroll
              for (int c = 0; c < 8; ++c) q[c] = *(const v4u*)(EU + ((unsigned)e * 1024u + 64u * c + rowoff)); }
            const float su_lo = EUS[e_lo], su_hi = EUS[e_hi], sv_lo = EVS[e_lo], sv_hi = EVS[e_hi];
            const float rs = rsqrt_f(WSP(float, WS_ROWSTAT)[t] * (1.0f / 1024.0f) + EPSF);
            const char* xs = (const char*)(WSP(bf16, WS_X1S) + t * 1024) + 2u * l16; const v4u xa = *(const v4u*)xs, xb = *(const v4u*)(xs + 16);
            float h2[16]; unpack8(xa, h2); unpack8(xb, h2 + 8); float mx = 0.f;
#pragma unroll
            for (int qd = 0; qd < 4; ++qd) { const f32x4 sh = *(const f32x4*)((const char*)(mb + 3072) + 4u * l16 + 16 * qd);
#pragma unroll
                for (int e = 0; e < 4; ++e) { h2[4 * qd + e] = h2[4 * qd + e] * rs + sh[e]; mx = fmaxf(mx, fabsf(h2[4 * qd + e])); } }
#pragma unroll
            for (int o = 1; o < 64; o <<= 1) mx = fmaxf(mx, __shfl_xor(mx, o));
            mx = fmaxf(mx, 1e-30f); const float hs = 224.0f / mx, hinv = mx * (1.0f / 224.0f);
            { v4u w;
#pragma unroll
              for (int qd = 0; qd < 4; ++qd) { int pk = 0; pk = __builtin_amdgcn_cvt_pk_fp8_f32(h2[4 * qd] * hs, h2[4 * qd + 1] * hs, pk, false); pk = __builtin_amdgcn_cvt_pk_fp8_f32(h2[4 * qd + 2] * hs, h2[4 * qd + 3] * hs, pk, true); w[qd] = (unsigned)pk; }
              *(LAS v4u*)(hq + l16) = w; }
            LDS_WAIT(); asm volatile("" ::: "memory");
            v4u hb[16];
#pragma unroll
            for (int c = 0; c < 16; ++c) hb[c] = *(const LAS v4u*)(hq + 64 * c + rowoff);
            float w_lo = 0.f, w_hi = 0.f;
            f32x4 acc = (f32x4){0.f, 0.f, 0.f, 0.f};
#pragma unroll 1
            for (int u = 0; u < 16; ++u) {
                if (u < 15) { const int g1 = (u + 1) >> 1, kh = (u + 1) & 1; const int e = __shfl(g1 < 4 ? e_lo : e_hi, 16 * (g1 & 3) + li);
#pragma unroll
                    for (int c = 0; c < 8; ++c) nq[c] = *(const v4u*)(EU + ((unsigned)e * 1024u + 512u * kh + 64u * c + rowoff)); }
                __builtin_amdgcn_sched_barrier(0);
                if ((u & 1) == 0) {
#pragma unroll
                    for (int c = 0; c < 8; ++c) { acc = __builtin_amdgcn_mfma_f32_16x16x32_fp8_fp8((i64_t)(((unsigned long long)q[c][1] << 32) | q[c][0]), (i64_t)(((unsigned long long)hb[c][1] << 32) | hb[c][0]), acc, 0, 0, 0);
                        acc = __builtin_amdgcn_mfma_f32_16x16x32_fp8_fp8((i64_t)(((unsigned long long)q[c][3] << 32) | q[c][2]), (i64_t)(((unsigned long long)hb[c][3] << 32) | hb[c][2]), acc, 0, 0, 0); }
                } else {
#pragma unroll
                    for (int c = 0; c < 8; ++c) { acc = __builtin_amdgcn_mfma_f32_16x16x32_fp8_fp8((i64_t)(((unsigned long long)q[c][1] << 32) | q[c][0]), (i64_t)(((unsigned long long)hb[8 + c][1] << 32) | hb[8 + c][0]), acc, 0, 0, 0);
                        acc = __builtin_amdgcn_mfma_f32_16x16x32_fp8_fp8((i64_t)(((unsigned long long)q[c][3] << 32) | q[c][2]), (i64_t)(((unsigned long long)hb[8 + c][3] << 32) | hb[8 + c][2]), acc, 0, 0, 0); }
                    const int g = u >> 1; const int r = li & 3;
                    const float sel = r == 0 ? acc[0] : (r == 1 ? acc[1] : (r == 2 ? acc[2] : acc[3]));
                    const float dmine = __shfl(sel, ((li >> 2) & 3) * 16 + (li & 3));
                    const float gsel = g < 4 ? g_lo : g_hi, susel = g < 4 ? su_lo : su_hi, svsel = g < 4 ? sv_lo : sv_hi;
                    const float wv = gsel * gelu_erf(dmine * susel * hinv) * svsel;
                    const bool mine = (lane >> 4) == (g & 3);
                    if (g < 4) w_lo = mine ? wv : w_lo; else w_hi = mine ? wv : w_hi;
                    acc = (f32x4){0.f, 0.f, 0.f, 0.f};
                }
#pragma unroll
                for (int c = 0; c < 8; ++c) q[c] = nq[c];
            }
            WSP(float, WS_GATE)[t * 128 + lane] = w_lo; WSP(float, WS_GATE)[t * 128 + 64 + lane] = w_hi;
        }
    }
}
__device__ __forceinline__ void p8_peer_fused2(Frame& F) {
    const int f_tid = threadIdx.x, lane = f_tid & 63, f_wave = __builtin_amdgcn_readfirstlane(f_tid >> 6);
    const unsigned char* EU = F.ws + WS_EU; const unsigned char* EV = F.ws + WS_EV; const float* EUS = WSP(float, WS_EUS); const float* EVS = WSP(float, WS_EVS);
    for (int wq = F.vcu * NWAVES + f_wave; wq < MTOK / 16; wq += F.G * NWAVES) {
        const int b = wq >> 7; const float* mb = WSP(float, WS_MOD) + (size_t)b * 6144;
        for (int tt = 0; tt < 16; ++tt) {
            const size_t t = (size_t)wq * 16 + tt;
            unsigned l16 = 16u * (unsigned)lane; asm volatile("" : "+v"(l16));
            float* xr = (float*)((char*)(F.out + t * 1024) + 4u * l16);
            const int e_lo = WSP(int, WS_EID)[t * 128 + lane], e_hi = WSP(int, WS_EID)[t * 128 + 64 + lane];
            const float g_lo = WSP(float, WS_GATE)[t * 128 + lane], g_hi = WSP(float, WS_GATE)[t * 128 + 64 + lane];
            v4u qu[8], qv[8], nu[8], nv[8];
#pragma unroll
            for (int j = 0; j < 8; ++j) { const int e = __builtin_amdgcn_readlane(e_lo, j); const unsigned off = (unsigned)e * 1024u + l16; qu[j] = *(const v4u*)(EU + off); qv[j] = *(const v4u*)(EV + off); }
            const float su_lo = EUS[e_lo], su_hi = EUS[e_hi], sv_lo = EVS[e_lo], sv_hi = EVS[e_hi];
            const float rs = rsqrt_f(WSP(float, WS_ROWSTAT)[t] * (1.0f / 1024.0f) + EPSF);
            const char* xs = (const char*)(WSP(bf16, WS_X1S) + t * 1024) + 2u * l16; const v4u xa = *(const v4u*)xs, xb = *(const v4u*)(xs + 16);
            float h2[16]; unpack8(xa, h2); unpack8(xb, h2 + 8);
            f32x2 h2p[8];
#pragma unroll
            for (int q = 0; q < 4; ++q) { const f32x4 sh = *(const f32x4*)((const char*)(mb + 3072) + 4u * l16 + 16 * q);
                h2p[2 * q] = (f32x2){h2[4 * q] * rs + sh[0], h2[4 * q + 1] * rs + sh[1]}; h2p[2 * q + 1] = (f32x2){h2[4 * q + 2] * rs + sh[2], h2[4 * q + 3] * rs + sh[3]}; }
            f32x2 o[8];
#pragma unroll
            for (int i = 0; i < 8; ++i) o[i] = (f32x2){0.f, 0.f};
#pragma unroll 1
            for (int grp = 0; grp < 16; ++grp) {
                const int nb = ((grp + 1) & 7) * 8; const int ensel = (grp + 1) < 8 ? e_lo : e_hi;
                if (grp < 15) {
#pragma unroll
                    for (int j = 0; j < 8; ++j) { const int e = __builtin_amdgcn_readlane(ensel, nb + j); const unsigned off = (unsigned)e * 1024u + l16; nu[j] = *(const v4u*)(EU + off); nv[j] = *(const v4u*)(EV + off); } }
                __builtin_amdgcn_sched_barrier(0);
                const int base = (grp & 7) * 8;
                float dmine = 0.f;
#pragma unroll
                for (int j = 0; j < 8; ++j) { f32x2 a0 = (f32x2){0.f, 0.f}, a1 = (f32x2){0.f, 0.f};
#pragma unroll
                    for (int i = 0; i < 4; ++i) { const f32x2 lo = __builtin_amdgcn_cvt_pk_f32_fp8((int)qu[j][i], false), hi = __builtin_amdgcn_cvt_pk_f32_fp8((int)qu[j][i], true); a0 += h2p[2 * i] * lo; a1 += h2p[2 * i + 1] * hi; }
                    const float a = (a0[0] + a0[1]) + (a1[0] + a1[1]);
                    const float tot = wave_sum_to63(a); const float sj = __builtin_bit_cast(float, __builtin_amdgcn_readlane(__builtin_bit_cast(int, tot), 63));
                    dmine = (lane == base + j) ? sj : dmine; }
                const float gsel = grp < 8 ? g_lo : g_hi, susel = grp < 8 ? su_lo : su_hi, svsel = grp < 8 ? sv_lo : sv_hi;
                const float wv = gsel * gelu_erf(dmine * susel) * svsel;
#pragma unroll
                for (int j = 0; j < 8; ++j) { const float wj = __builtin_bit_cast(float, __builtin_amdgcn_readlane(__builtin_bit_cast(int, wv), base + j)); const f32x2 w2 = (f32x2){wj, wj};
#pragma unroll
                    for (int i = 0; i < 4; ++i) { const f32x2 lo = __builtin_amdgcn_cvt_pk_f32_fp8((int)qv[j][i], false), hi = __builtin_amdgcn_cvt_pk_f32_fp8((int)qv[j][i], true); o[2 * i] += w2 * lo; o[2 * i + 1] += w2 * hi; } }
#pragma unroll
                for (int j = 0; j < 8; ++j) { qu[j] = nu[j]; qv[j] = nv[j]; }
            }
            float x1[16]; float ss = 0.f;
#pragma unroll
            for (int q4 = 0; q4 < 4; ++q4) { const f32x4 v = *(const f32x4*)(xr + 4 * q4); x1[4 * q4] = v[0]; x1[4 * q4 + 1] = v[1]; x1[4 * q4 + 2] = v[2]; x1[4 * q4 + 3] = v[3]; }
#pragma unroll
            for (int q4 = 0; q4 < 4; ++q4) { const f32x4 gt = *(const f32x4*)((const char*)(mb + 5120) + 4u * l16 + 16 * q4);
#pragma unroll
                for (int e = 0; e < 4; ++e) { const int i = 4 * q4 + e; x1[i] += gt[e] * o[i >> 1][i & 1]; ss += x1[i] * x1[i]; } }
            const float rf = rsqrt_f(wave_sum(ss) * (1.0f / 1024.0f) + EPSF);
#pragma unroll
            for (int q4 = 0; q4 < 4; ++q4) { const f32x4 nf = *(const f32x4*)((const char*)(F.a->in[29]) + 4u * l16 + 16 * q4); f32x4 v;
#pragma unroll
                for (int e = 0; e < 4; ++e) v[e] = x1[4 * q4 + e] * rf * nf[e];
                *(f32x4*)(xr + 4 * q4) = v; }
        }
    }
}
constexpr int U6_ROWP = 1040, U6_BUF = 8 * U6_ROWP, U6_WAVE = 2 * U6_BUF + 1024;
static_assert(8 * U6_WAVE <= LDS_MAIN, "U6 LDS map");
__device__ __forceinline__ void p8_peer_up6(Frame& F) {
    const int f_tid = threadIdx.x, lane = f_tid & 63, f_wave = __builtin_amdgcn_readfirstlane(f_tid >> 6);
    const int li = lane & 15, lq = lane >> 4;
    const unsigned char* EU = F.ws + WS_EU; const float* EUS = WSP(float, WS_EUS); const float* EVS = WSP(float, WS_EVS);
    LAS unsigned char* ring = F.lds + f_wave * U6_WAVE; LAS unsigned char* hq = ring + 2 * U6_BUF;
    for (int wq = F.vcu * NWAVES + f_wave; wq < MTOK / 16; wq += F.G * NWAVES) {
        const int b = wq >> 7; const float* mb = WSP(float, WS_MOD) + (size_t)b * 6144;
        for (int tt = 0; tt < 16; ++tt) {
            const size_t t = (size_t)wq * 16 + tt;
            unsigned l16 = 16u * (unsigned)lane; asm volatile("" : "+v"(l16));
            const int e_lo = WSP(int, WS_EID)[t * 128 + lane], e_hi = WSP(int, WS_EID)[t * 128 + 64 + lane];
            const float g_lo = WSP(float, WS_GATE)[t * 128 + lane], g_hi = WSP(float, WS_GATE)[t * 128 + 64 + lane];
            const float rs = rsqrt_f(WSP(float, WS_ROWSTAT)[t] * (1.0f / 1024.0f) + EPSF);
            const char* xs = (const char*)(WSP(bf16, WS_X1S) + t * 1024) + 2u * l16; const v4u xa = *(const v4u*)xs, xb = *(const v4u*)(xs + 16);
            asm volatile("s_waitcnt vmcnt(0)" ::: "memory");
#pragma unroll
            for (int j = 0; j < 8; ++j) { const int e = __builtin_amdgcn_readlane(e_lo, j);
                __builtin_amdgcn_global_load_lds((const unsigned*)(EU + ((unsigned)e * 1024u + l16)), (LAS unsigned*)(ring + j * U6_ROWP), 16, 0, 0); }
            const float su_lo = EUS[e_lo], su_hi = EUS[e_hi], sv_lo = EVS[e_lo], sv_hi = EVS[e_hi];
            float h2[16]; unpack8(xa, h2); unpack8(xb, h2 + 8); float mx = 0.f;
#pragma unroll
            for (int qd = 0; qd < 4; ++qd) { const f32x4 sh = *(const f32x4*)((const char*)(mb + 3072) + 4u * l16 + 16 * qd);
#pragma unroll
                for (int e = 0; e < 4; ++e) { h2[4 * qd + e] = h2[4 * qd + e] * rs + sh[e]; mx = fmaxf(mx, fabsf(h2[4 * qd + e])); } }
#pragma unroll
            for (int o = 1; o < 64; o <<= 1) mx = fmaxf(mx, __shfl_xor(mx, o));
            mx = fmaxf(mx, 1e-30f); const float hs = 224.0f / mx, hinv = mx * (1.0f / 224.0f);
            { v4u w;
#pragma unroll
              for (int qd = 0; qd < 4; ++qd) { int pk = 0; pk = __builtin_amdgcn_cvt_pk_fp8_f32(h2[4 * qd] * hs, h2[4 * qd + 1] * hs, pk, false); pk = __builtin_amdgcn_cvt_pk_fp8_f32(h2[4 * qd + 2] * hs, h2[4 * qd + 3] * hs, pk, true); w[qd] = (unsigned)pk; }
              *(LAS v4u*)(hq + l16) = w; }
            LDS_WAIT(); asm volatile("" ::: "memory");
            v4u hb[16];
#pragma unroll
            for (int c = 0; c < 16; ++c) hb[c] = *(const LAS v4u*)(hq + 64 * c + 16 * lq);
            asm volatile("s_waitcnt vmcnt(0)" ::: "memory");
            float w_lo = 0.f, w_hi = 0.f;
#pragma unroll 1
            for (int u = 0; u < 16; ++u) {
                { const int un = (u + 1) & 15; const int ensel = un < 8 ? e_lo : e_hi; const int nb = (un & 7) * 8; LAS unsigned char* dst = ring + ((u + 1) & 1) * U6_BUF;
#pragma unroll
                  for (int j = 0; j < 8; ++j) { const int e = __builtin_amdgcn_readlane(ensel, nb + j);
                      __builtin_amdgcn_global_load_lds((const unsigned*)(EU + ((unsigned)e * 1024u + l16)), (LAS unsigned*)(dst + j * U6_ROWP), 16, 0, 0); } }
                asm volatile("s_waitcnt vmcnt(8)" ::: "memory");
                const LAS unsigned char* src = ring + (u & 1) * U6_BUF + (li & 7) * U6_ROWP + 16 * lq;
                f32x4 acc = (f32x4){0.f, 0.f, 0.f, 0.f};
#pragma unroll
                for (int c = 0; c < 16; ++c) { const v4u a = *(const LAS v4u*)(src + 64 * c);
                    acc = __builtin_amdgcn_mfma_f32_16x16x32_fp8_fp8((i64_t)(((unsigned long long)a[1] << 32) | a[0]), (i64_t)(((unsigned long long)hb[c][1] << 32) | hb[c][0]), acc, 0, 0, 0);
                    acc = __builtin_amdgcn_mfma_f32_16x16x32_fp8_fp8((i64_t)(((unsigned long long)a[3] << 32) | a[2]), (i64_t)(((unsigned long long)hb[c][3] << 32) | hb[c][2]), acc, 0, 0, 0); }
                const int base = (u & 7) * 8; const int r = li & 3;
                const float sel = r == 0 ? acc[0] : (r == 1 ? acc[1] : (r == 2 ? acc[2] : acc[3]));
                const float dmine = __shfl(sel, ((lane & 7) >> 2) * 16 + (lane & 3));
                const float gsel = u < 8 ? g_lo : g_hi, susel = u < 8 ? su_lo : su_hi, svsel = u < 8 ? sv_lo : sv_hi;
                const float wv = gsel * gelu_erf(dmine * susel * hinv) * svsel;
                const bool mine = (lane >= base) && (lane < base + 8);
                if (u < 8) w_lo = mine ? wv : w_lo; else w_hi = mine ? wv : w_hi;
                asm volatile("s_waitcnt lgkmcnt(0)" ::: "memory");
            }
            WSP(float, WS_GATE)[t * 128 + lane] = w_lo; WSP(float, WS_GATE)[t * 128 + 64 + lane] = w_hi;
        }
    }
}
struct U7Meta { int elo, ehi; float glo, ghi; v4u xa, xb; float rst; };
__device__ __forceinline__ void u7_meta_load(U7Meta& M, const unsigned char* ws, size_t t, unsigned l16) {
    const unsigned l = l16 >> 4; const int* ep = (const int*)(ws + WS_EID) + t * 128; const float* gp = (const float*)(ws + WS_GATE) + t * 128;
    M.elo = ep[l]; M.ehi = ep[64 + l]; M.glo = gp[l]; M.ghi = gp[64 + l];
    const char* xs = (const char*)(ws + WS_X1S) + t * 2048 + 2u * l16; M.xa = *(const v4u*)xs; M.xb = *(const v4u*)(xs + 16);
    M.rst = ((const float*)(ws + WS_ROWSTAT))[t + (l16 >> 30)];
}
__device__ __forceinline__ void u7_unit_dma(int elo, int ehi, int un, const unsigned char* EU, unsigned l16, LAS unsigned char* dst) {
    const int ensel = un < 8 ? elo : ehi; const int nb = (un & 7) * 8;
#pragma unroll
    for (int j = 0; j < 8; ++j) { const int e = __builtin_amdgcn_readlane(ensel, nb + j);
        __builtin_amdgcn_global_load_lds((const unsigned*)(EU + ((unsigned)e * 1024u + l16)), (LAS unsigned*)(dst + j * U6_ROWP), 16, 0, 0); }
}
__device__ __forceinline__ void u7_h2(const U7Meta& M, const float* S2, LAS unsigned char* hq, unsigned l16, int lq, v4u* hb, float& hinv) {
    float h2[16]; unpack8(M.xa, h2); unpack8(M.xb, h2 + 8); float mx = 0.f;
    const float rs = rsqrt_f(M.rst * (1.0f / 1024.0f) + EPSF);
#pragma unroll
    for (int i = 0; i < 16; ++i) { h2[i] = h2[i] * rs + S2[i]; mx = fmaxf(mx, fabsf(h2[i])); }
#pragma unroll
    for (int o = 1; o < 64; o <<= 1) mx = fmaxf(mx, __shfl_xor(mx, o));
    mx = fmaxf(mx, 1e-30f); const float hs = 224.0f / mx; hinv = mx * (1.0f / 224.0f);
    v4u w;
#pragma unroll
    for (int qd = 0; qd < 4; ++qd) { int pk = 0; pk = __builtin_amdgcn_cvt_pk_fp8_f32(h2[4 * qd] * hs, h2[4 * qd + 1] * hs, pk, false); pk = __builtin_amdgcn_cvt_pk_fp8_f32(h2[4 * qd + 2] * hs, h2[4 * qd + 3] * hs, pk, true); w[qd] = (unsigned)pk; }
    *(LAS v4u*)(hq + l16) = w;
    LDS_WAIT(); asm volatile("" ::: "memory");
#pragma unroll
    for (int c = 0; c < 16; ++c) hb[c] = *(const LAS v4u*)(hq + 64 * c + 16 * lq);
    LDS_WAIT(); asm volatile("" ::: "memory");
}
__device__ __forceinline__ void p8_peer_up7(Frame& F) {
    const int f_tid = threadIdx.x, lane = f_tid & 63, f_wave = __builtin_amdgcn_readfirstlane(f_tid >> 6);
    const int li = lane & 15, lq = lane >> 4;
    const unsigned char* EU = F.ws + WS_EU; const float* EUS = WSP(float, WS_EUS); const float* EVS = WSP(float, WS_EVS);
    LAS unsigned char* ring = F.lds + f_wave * U6_WAVE; LAS unsigned char* hq = ring + 2 * U6_BUF;
    for (int wq = F.vcu * NWAVES + f_wave; wq < MTOK / 16; wq += F.G * NWAVES) {
        const int b = wq >> 7; const float* mb = WSP(float, WS_MOD) + (size_t)b * 6144;
        unsigned l16 = 16u * (unsigned)lane; asm volatile("" : "+v"(l16));
        float S2[16];
#pragma unroll
        for (int q = 0; q < 4; ++q) { const f32x4 sh = *(const f32x4*)((const char*)(mb + 3072) + 4u * l16 + 16 * q); S2[4 * q] = sh[0]; S2[4 * q + 1] = sh[1]; S2[4 * q + 2] = sh[2]; S2[4 * q + 3] = sh[3]; }
        const size_t t0 = (size_t)wq * 16;
        U7Meta C, N;
        u7_meta_load(C, F.ws, t0, l16);
        asm volatile("s_waitcnt vmcnt(0)" ::: "memory");
        u7_unit_dma(C.elo, C.ehi, 0, EU, l16, ring);
        float su_lo = EUS[C.elo], su_hi = EUS[C.ehi], sv_lo = EVS[C.elo], sv_hi = EVS[C.ehi];
        float nsu_lo = 0.f, nsu_hi = 0.f, nsv_lo = 0.f, nsv_hi = 0.f;
        v4u hb[16]; float hinv;
        u7_h2(C, S2, hq, l16, lq, hb, hinv);
        N = C;
        asm volatile("s_waitcnt vmcnt(0)" ::: "memory");
#pragma unroll 1
        for (int tt = 0; tt < 16; ++tt) {
            float w_lo = 0.f, w_hi = 0.f;
#pragma unroll 1
            for (int u = 0; u < 16; ++u) {
                { const bool last = (u == 15);
                  u7_unit_dma(last ? N.elo : C.elo, last ? N.ehi : C.ehi, (u + 1) & 15, EU, l16, ring + ((u + 1) & 1) * U6_BUF); }
                if (u == 0) { if (tt == 0) asm volatile("s_waitcnt vmcnt(8)" ::: "memory"); else asm volatile("s_waitcnt vmcnt(10)" ::: "memory"); }
                else if (u == 3) asm volatile("s_waitcnt vmcnt(15)" ::: "memory");
                else if (u == 11) asm volatile("s_waitcnt vmcnt(12)" ::: "memory");
                else asm volatile("s_waitcnt vmcnt(8)" ::: "memory");
                const LAS unsigned char* src = ring + (u & 1) * U6_BUF + (li & 7) * U6_ROWP + 16 * lq;
                f32x4 acc = (f32x4){0.f, 0.f, 0.f, 0.f};
#pragma unroll
                for (int c = 0; c < 16; ++c) { const v4u a = *(const LAS v4u*)(src + 64 * c);
                    acc = __builtin_amdgcn_mfma_f32_16x16x32_fp8_fp8((i64_t)(((unsigned long long)a[1] << 32) | a[0]), (i64_t)(((unsigned long long)hb[c][1] << 32) | hb[c][0]), acc, 0, 0, 0);
                    acc = __builtin_amdgcn_mfma_f32_16x16x32_fp8_fp8((i64_t)(((unsigned long long)a[3] << 32) | a[2]), (i64_t)(((unsigned long long)hb[c][3] << 32) | hb[c][2]), acc, 0, 0, 0); }
                const int base = (u & 7) * 8; const int r = li & 3;
                const float sel = r == 0 ? acc[0] : (r == 1 ? acc[1] : (r == 2 ? acc[2] : acc[3]));
                const float dmine = __shfl(sel, ((lane & 7) >> 2) * 16 + (lane & 3));
                const float gsel = u < 8 ? C.glo : C.ghi, susel = u < 8 ? su_lo : su_hi, svsel = u < 8 ? sv_lo : sv_hi;
                const float wv = gsel * gelu_erf(dmine * susel * hinv) * svsel;
                const bool mine = (lane >= base) && (lane < base + 8);
                if (u < 8) w_lo = mine ? wv : w_lo; else w_hi = mine ? wv : w_hi;
                asm volatile("s_waitcnt lgkmcnt(0)" ::: "memory");
                if (u == 2) { const size_t tn = t0 + (tt < 15 ? tt + 1 : tt); u7_meta_load(N, F.ws, tn, l16); }
                if (u == 10) { nsu_lo = EUS[N.elo]; nsu_hi = EUS[N.ehi]; nsv_lo = EVS[N.elo]; nsv_hi = EVS[N.ehi]; }
            }
            WSP(float, WS_GATE)[(t0 + tt) * 128 + lane] = w_lo; WSP(float, WS_GATE)[(t0 + tt) * 128 + 64 + lane] = w_hi;
            C = N; su_lo = nsu_lo; su_hi = nsu_hi; sv_lo = nsv_lo; sv_hi = nsv_hi;
            u7_h2(C, S2, hq, l16, lq, hb, hinv);
        }
        asm volatile("s_waitcnt vmcnt(0)" ::: "memory");
    }
}
constexpr int NPHASE = 10;
__global__ void __launch_bounds__(NTHR, 2) fwd_mega(Args args) {
    extern __shared__ __attribute__((aligned(16))) unsigned char lds[];
    Frame F;
    F.lds = (LAS unsigned char*)lds;
    F.MISC = (volatile LAS unsigned*)(F.lds + MISC_OFF);
    F.G = gridDim.x; { const int bx = blockIdx.x; F.vcu = (F.G % 8 == 0) ? (bx % 8) * (F.G / 8) + bx / 8 : bx; }
    F.ws = args.ws; F.out = args.out;
    F.a = &args;
    for (int u = threadIdx.x; u < 32; u += NTHR) F.MISC[u] = 0u;
    __syncthreads();
    const int lo = args.ph_lo, hi = args.ph_hi;
    const bool use_bar = (hi - lo) > 1;
    XcdBarrier bar; bar.bar = (unsigned*)(F.ws + WS_CTL); bar.x = 0; bar.st = nullptr;
    if (use_bar) bar = xcd_barrier_post((unsigned*)(F.ws + WS_CTL), F.MISC + 8);
#define IN(k) (lo <= (k) && (k) < hi)
#define SEAM(k) do { if (IN(k) && IN((k) + 1)) xcd_barrier(bar); } while (0)
#ifndef REP_PHASE
#define REP_PHASE -1
#endif
#define REPEAT(k, body) do { if (REP_PHASE == (k)) { xcd_barrier(bar); body; } } while (0)
    if (IN(0)) {
#ifndef SKIP_P0
 p0_phase(F); REPEAT(0, p0_phase(F));
#endif
 } SEAM(0);
    if (IN(1)) {
#ifndef SKIP_P1
 p1_phase(F); REPEAT(1, p1_phase(F));
#endif
 } SEAM(1);
    if (IN(2)) {
        pg8::Gemm g{WSP(bf16, WS_H1), WSP(bf16, WS_WINT), MTOK, NPROJ, 1024}; pg8::StaticOrder S; S.init(MTOK, NPROJ, F.G, (int)blockIdx.x);
        pg8::EpiProj E{WSP(bf16, WS_PROJ), NPROJ};
        pg8::gemm_phase<pg8::EpiProj, pg8::StaticOrder, true, true>(F.lds, g, S, E);
        REPEAT(2, (pg8::gemm_phase<pg8::EpiProj, pg8::StaticOrder, true, true>(F.lds, g, S, E)));
    } SEAM(2);
    if (IN(3)) {
#ifndef SKIP_SSD
#ifdef SSD_NAIVE
 p3_ssd_naive(F);
#elif defined(SSD_V1)
 p3_ssd(F); REPEAT(30, p3_ssd(F));
#elif defined(SSD_V2)
 p3pre_conv(F); xcd_barrier(bar); p3_ssd2(F); REPEAT(30, p3_ssd2(F)); REPEAT(32, p3pre_conv(F));
#else
 p3pre_conv(F); xcd_barrier(bar); p3_ssd3(F); REPEAT(30, p3_ssd3(F)); REPEAT(32, p3pre_conv(F));
#endif
#endif
#ifndef SKIP_S5
#ifdef S5_NAIVE
 p3_s5_naive(F);
#elif defined(S5_V1)
 p3_s5(F); REPEAT(31, p3_s5(F));
#else
 p3_s5v2(F); REPEAT(31, p3_s5v2(F));
#endif
#endif
 } SEAM(3);
#ifdef USE_P3C
    if (IN(4)) { p3c_normalize(F); } SEAM(4);
    if (IN(5)) {
        pg8::Gemm g{WSP(bf16, WS_Y), WSP(bf16, WS_WOUTT), MTOK, 1024, 2048}; pg8::StaticOrder S; S.init(MTOK, 1024, F.G, (int)blockIdx.x);
        PG8_LAS float* tab = (PG8_LAS float*)(F.lds + pg8::STAGE_BYTES);
        for (int i = threadIdx.x; i < 2 * 1280; i += NTHR) tab[i] = 1.0f;
        __syncthreads();
        pg8::EpiX1 E{(F.a->in[0]), F.out, WSP(bf16, WS_X1S), WSP(float, WS_MOD), (F.a->in[24]), WSP(float, WS_ROWSTAT), tab};
        pg8::gemm_phase<pg8::EpiX1, pg8::StaticOrder, true, true>(F.lds, g, S, E);
    } SEAM(5);
#else
    if (IN(5)) {
        pg8::Gemm g{WSP(bf16, WS_Y), WSP(bf16, WS_WOUTT), MTOK, 1024, 2048}; pg8::StaticOrder S; S.init(MTOK, 1024, F.G, (int)blockIdx.x);
        PG8_LAS float* tab = (PG8_LAS float*)(F.lds + pg8::STAGE_BYTES);
        { pg8::Unit u; for (int i = 0; S.next(i, u); ++i) pg8::SegScaleHook::build(F.lds + pg8::STAGE_BYTES, u, WSP(float, WS_STSSD), WSP(float, WS_STS5), (int)threadIdx.x); }
        __syncthreads();
        pg8::EpiX1 E{(F.a->in[0]), F.out, WSP(bf16, WS_X1S), WSP(float, WS_MOD), (F.a->in[24]), WSP(float, WS_ROWSTAT), tab};
        pg8::SegScaleHook H;
        pg8::gemm_phase<pg8::EpiX1, pg8::StaticOrder, true, true, pg8::SegScaleHook>(F.lds, g, S, E, H);
    } SEAM(5);
#endif
    if (IN(6)) {
        pg8::Gemm g{WSP(bf16, WS_X1S), WSP(bf16, WS_WQKT), MTOK, 2048, 1024}; pg8::StaticOrder S; S.init(MTOK, 2048, F.G, (int)blockIdx.x);
        pg8::EpiScores E{WSP(_Float16, WS_SCORES), WSP(float, WS_SB), WSP(float, WS_ROWSTAT)};
        pg8::gemm_phase<pg8::EpiScores, pg8::StaticOrder, true, true>(F.lds, g, S, E);
        REPEAT(6, (pg8::gemm_phase<pg8::EpiScores, pg8::StaticOrder, true, true>(F.lds, g, S, E)));
    } SEAM(6);
    if (IN(7)) {
#ifndef SKIP_TOPK
 p5b_topk(F); REPEAT(7, p5b_topk(F));
#endif
 } SEAM(7);
#ifdef PEER_FUSED
    if (IN(8)) { p8_peer_fused(F); }
#elif defined(PEER_FUSED2)
    if (IN(8)) { p8_peer_fused2(F); }
#else
#ifdef PEER_UP2
    if (IN(8)) { p8_peer_up2(F); } SEAM(8);
#else
#ifdef PEER_UP7
    if (IN(8)) { p8_peer_up7(F); } SEAM(8);
#elif !defined(PEER_UP3)
    if (IN(8)) { p8_peer_up6(F); REPEAT(8, { p5b_topk(F); xcd_barrier(bar); p8_peer_up6(F); }); } SEAM(8);
#elif !defined(PEER_UP4)
    if (IN(8)) { p8_peer_up3(F, bar); } SEAM(8);
#else
    if (IN(8)) { p8_peer_up4(F); REPEAT(8, { p5b_topk(F); xcd_barrier(bar); p8_peer_up4(F); }); } SEAM(8);
#endif
#endif
    if (IN(9)) { p9_peer_down2(F, bar); }
#endif
#undef IN
#undef SEAM
}

#ifndef N_LAUNCHES
#define N_LAUNCHES 1
#endif
extern "C" void kernel_launch(void* const* d_in, const int* in_sizes, int n_in, void* d_out, int out_size, void* d_ws, size_t ws_size, hipStream_t stream) {
    static int grid = 0;
    if (grid == 0) {
        if (n_in != 30 || in_sizes[0] != MTOK * DM || out_size != MTOK * DM || ws_size < WS_END) { fprintf(stderr, "kernel_launch: unexpected shapes (n_in %d, in0 %d, out %d, ws %zu)\n", n_in, n_in > 0 ? in_sizes[0] : -1, out_size, ws_size); grid = -1; return; }
        int dev = 0, cus = 0, per_cu = 0;
        if (hipGetDevice(&dev) != hipSuccess || hipDeviceGetAttribute(&cus, hipDeviceAttributeMultiprocessorCount, dev) != hipSuccess) { grid = -1; return; }
        if (hipFuncSetAttribute((const void*)fwd_mega, hipFuncAttributeMaxDynamicSharedMemorySize, LDS_BYTES) != hipSuccess) { fprintf(stderr, "kernel_launch: hipFuncSetAttribute failed\n"); grid = -1; return; }
        if (hipOccupancyMaxActiveBlocksPerMultiprocessor(&per_cu, (const void*)fwd_mega, NTHR, LDS_BYTES) != hipSuccess || per_cu < 1) { fprintf(stderr, "kernel_launch: occupancy query says %d\n", per_cu); (void)hipGetLastError(); grid = -1; return; }
        grid = cus;
    }
    if (grid < 0) return;
    (void)hipMemsetAsync((char*)d_ws + WS_CTL, 0, CTL_ZERO_BYTES, stream);
    Args a{};
    for (int i = 0; i < 30; ++i) a.in[i] = (const float*)d_in[i];
    a.out = (float*)d_out; a.ws = (unsigned char*)d_ws;
    if (N_LAUNCHES == 1) {
        a.ph_lo = 0; a.ph_hi = NPHASE;
        void* kargs[] = {&a};
        hipError_t e = hipLaunchCooperativeKernel((const void*)fwd_mega, dim3(grid), dim3(NTHR), kargs, LDS_BYTES, stream);
        if (e != hipSuccess) fprintf(stderr, "kernel_launch: cooperative launch failed: %s (grid %d)\n", hipGetErrorString(e), grid);
    } else {
        for (int p = 0; p < NPHASE; ++p) { a.ph_lo = p; a.ph_hi = p + 1; hipLaunchKernelGGL(fwd_mega, dim3(grid), dim3(NTHR), LDS_BYTES, stream, a); }
    }
}
```

```cpp
#include <hip/hip_runtime.h>
#include <cstdio>
#include <cstdint>

namespace pg8 {
#define PG8_LAS __attribute__((address_space(3)))
typedef unsigned short bf16_t;
typedef short bf16x8 __attribute__((ext_vector_type(8)));
typedef float f32x4 __attribute__((ext_vector_type(4)));
typedef unsigned u32x4 __attribute__((ext_vector_type(4)));
constexpr int BM = 256, BK = 64, HALF = 128, HTB = HALF * BK * 2  , STAGE_BYTES = 8 * HTB, NXCD = 8, WGM = 8;

__host__ __device__ __forceinline__ int lds_byte(int r, int c) { const int st = (r >> 4) * 2 + (c >> 5), rr = r & 15, cc = c & 31, ob = rr * 64 + cc * 2; return st * 1024 + (ob ^ (((ob >> 9) & 1) << 5)); }
__host__ __device__ __forceinline__ void stage_rc(int b, int& R, int& C) { const int st = b / 1024, sb = b % 1024, swz = sb ^ (((sb >> 9) & 1) << 5); R = (st >> 1) * 16 + swz / 64; C = (st & 1) * 32 + (swz % 64) / 2; }
__host__ __device__ __forceinline__ int perm32(int rho) { const int n = rho >> 4, i = rho & 15; return 8 * (i >> 2) + 4 * n + (i & 3); }

struct Unit { int pm, pn; };
struct Gemm { const bf16_t* A; const bf16_t* Bt; int M, N, K; };

struct StaticOrder {
    int nM, nN, nwg, G, c;
    __host__ __device__ void init(int M, int N, int G_, int c_) { nM = M / BM; nN = N / BM; nwg = nM * nN; G = G_; c = c_; }
    __host__ __device__ bool next(int i, Unit& u) const {
        const long L = (long)i * G + c; if (L >= nwg) return false;
        int wgid = (int)L; { const int q = nwg / NXCD, r = nwg % NXCD, xcd = wgid % NXCD, off = wgid / NXCD; wgid = (xcd < r ? xcd * (q + 1) : r * (q + 1) + (xcd - r) * q) + off; }
        const int nig = WGM * nN, gid = wgid / nig, fm = gid * WGM, gsz = (nM - fm) < WGM ? (nM - fm) : WGM;
        u.pm = fm + ((wgid % nig) % gsz); u.pn = (wgid % nig) / gsz; return true;
    }
    __device__ __forceinline__ void a_ready(const Unit&) const {}
    __device__ __forceinline__ void done(const Unit&) const {}
};

__device__ __forceinline__ unsigned cvt_pk_bf16(float lo, float hi) { unsigned r; asm volatile("v_cvt_pk_bf16_f32 %0, %1, %2" : "=v"(r) : "v"(lo), "v"(hi)); return r; }
typedef float f32x2 __attribute__((ext_vector_type(2)));
struct NoHook { __device__ __forceinline__ void at_tile(int, const Unit&, f32x4 (&)[2][2][4][2], PG8_LAS unsigned char*, int, int) const {} };
template <class Epi, class Sched, bool ALIGN_EPI = false, bool SP2 = false, class Hook = NoHook>
__device__ __forceinline__ void gemm_phase(PG8_LAS unsigned char* lds, const Gemm g, const Sched& S, const Epi& E, const Hook& H = Hook()) {
    const int tid = threadIdx.x, wid = __builtin_amdgcn_readfirstlane(tid >> 6), lane = tid & 63, wr = wid >> 2, wc = wid & 3, fr = lane & 15, fq = lane >> 4;
    const int K = g.K, nt = K / BK;
    unsigned voffA[2], voffB[2];
#pragma unroll
    for (int i = 0; i < 2; ++i) { int R, C; stage_rc(tid * 16 + i * 8192, R, C); const int Rb = Epi::PERM ? ((R & ~31) + perm32(R & 31)) : R;
        voffA[i] = (unsigned)(R * K + C) * 2u; voffB[i] = (unsigned)(Rb * K + C) * 2u; }
    const size_t kstep = (size_t)(BK * 2);
    const size_t hstep = (size_t)HALF * K * 2;
    const size_t tstep = 2 * hstep;
    const unsigned ldsw = (unsigned)wid * 1024u;
    const int aoff = lds_byte(wr * 64 + fr, fq * 8), boff = lds_byte(wc * 32 + fr, fq * 8);
#define PG8_SA(b, h) (((b) * 2 + (h)) * HTB)
#define PG8_SB(b, h) ((4 + (b) * 2 + (h)) * HTB)
#define PG8_STAGE(bufoff, gbase, voff) do { _Pragma("unroll") for (int _i = 0; _i < 2; ++_i) \
        __builtin_amdgcn_global_load_lds((const unsigned*)((const char*)(gbase) + (voff)[_i]), (PG8_LAS unsigned*)(lds + (bufoff) + ldsw + _i * 8192), 16, 0, 0); } while (0)
#define PG8_LDA(dst, b, h) do { _Pragma("unroll") for (int m = 0; m < 4; ++m) _Pragma("unroll") for (int k = 0; k < 2; ++k) dst[m][k] = *(const PG8_LAS bf16x8*)(lds + PG8_SA(b, h) + aoff + m * 2048 + k * 1024); } while (0)
#define PG8_LDB(dst, b, h) do { _Pragma("unroll") for (int n = 0; n < 2; ++n) _Pragma("unroll") for (int k = 0; k < 2; ++k) dst[n][k] = *(const PG8_LAS bf16x8*)(lds + PG8_SB(b, h) + boff + n * 2048 + k * 1024); } while (0)
#define PG8_MMA(ai, bj, At, Bt) do { __builtin_amdgcn_s_setprio(1); _Pragma("unroll") for (int m = 0; m < 4; ++m) _Pragma("unroll") for (int n = 0; n < 2; ++n) _Pragma("unroll") for (int k = 0; k < 2; ++k) \
        acc[ai][bj][m][n] = __builtin_amdgcn_mfma_f32_16x16x32_bf16(Bt[n][k], At[m][k], acc[ai][bj][m][n], 0, 0, 0); __builtin_amdgcn_s_setprio(0); } while (0)
#define PG8_WAIT_V(n) asm volatile("s_waitcnt vmcnt(" #n ")" ::: "memory")
#define PG8_WAIT_L(n) asm volatile("s_waitcnt lgkmcnt(" #n ")" ::: "memory")
#define PG8_BAR __builtin_amdgcn_s_barrier()
#define PG8_SCHED __builtin_amdgcn_sched_barrier(0)
    Unit cur, nxt; int ui = 0;
    if (!S.next(0, cur)) return;
    f32x4 acc[2][2][4][2];
#pragma unroll
    for (int a = 0; a < 2; ++a)
#pragma unroll
        for (int b = 0; b < 2; ++b)
#pragma unroll
            for (int m = 0; m < 4; ++m)
#pragma unroll
                for (int n = 0; n < 2; ++n) acc[a][b][m][n] = (f32x4){0.f, 0.f, 0.f, 0.f};
    bf16x8 At[4][2], B0[2][2], B1[2][2];
    const char* cA = (const char*)g.A + (size_t)cur.pm * tstep; const char* cB = (const char*)g.Bt + (size_t)cur.pn * tstep;
    S.a_ready(cur);
    if constexpr (SP2) {
        PG8_STAGE(PG8_SB(0, 0), cB, voffB); PG8_STAGE(PG8_SB(0, 1), cB + hstep, voffB); PG8_STAGE(PG8_SA(0, 0), cA, voffA); PG8_STAGE(PG8_SA(0, 1), cA + hstep, voffA);
        if (wr == 1) PG8_BAR;
        PG8_WAIT_V(2); PG8_BAR;
        PG8_STAGE(PG8_SB(1, 0), cB + kstep, voffB); PG8_STAGE(PG8_SA(1, 0), cA + kstep, voffA); PG8_STAGE(PG8_SB(1, 1), cB + hstep + kstep, voffB);
        PG8_WAIT_V(6); PG8_BAR;
    } else {
        PG8_STAGE(PG8_SB(0, 0), cB, voffB); PG8_STAGE(PG8_SA(0, 0), cA, voffA); PG8_STAGE(PG8_SB(0, 1), cB + hstep, voffB); PG8_STAGE(PG8_SA(0, 1), cA + hstep, voffA);
        if (wr == 1) PG8_BAR;
        PG8_WAIT_V(4); PG8_BAR;
        PG8_STAGE(PG8_SB(1, 0), cB + kstep, voffB); PG8_STAGE(PG8_SA(1, 0), cA + kstep, voffA); PG8_STAGE(PG8_SB(1, 1), cB + hstep + kstep, voffB);
        PG8_WAIT_V(6); PG8_BAR;
    }
    for (;;) {
        const bool has_next = S.next(ui + 1, nxt);
        const char* nA = has_next ? (const char*)g.A + (size_t)nxt.pm * tstep : cA; const char* nB = has_next ? (const char*)g.Bt + (size_t)nxt.pn * tstep : cB;
        for (int t = 0; t < nt; t += 2) {
            const bool last = (t == nt - 2);
            H.at_tile(t, cur, acc, lds + STAGE_BYTES, wr, fr);
            const char* a1 = cA + (size_t)(t + 1) * kstep;
            const char* a2 = last ? nA : cA + (size_t)(t + 2) * kstep; const char* b2 = last ? nB : cB + (size_t)(t + 2) * kstep;
            const char* a3 = a2 + kstep; const char* b3 = b2 + kstep;
            if (last && has_next) S.a_ready(nxt);
            if constexpr (SP2) {
            PG8_LDB(B0, 0, 0); PG8_LDB(B1, 0, 1); PG8_SCHED; PG8_LDA(At, 0, 0); PG8_STAGE(PG8_SA(1, 1), a1 + hstep, voffA);
            PG8_WAIT_V(8); PG8_WAIT_L(0); PG8_BAR; PG8_MMA(0, 0, At, B0); PG8_MMA(0, 1, At, B1); PG8_BAR; PG8_SCHED;
            PG8_LDA(At, 0, 1); PG8_STAGE(PG8_SB(0, 0), b2, voffB); PG8_STAGE(PG8_SB(0, 1), b2 + hstep, voffB); PG8_STAGE(PG8_SA(0, 0), a2, voffA);
            PG8_WAIT_V(8); PG8_WAIT_L(0); PG8_BAR; PG8_MMA(1, 0, At, B0); PG8_MMA(1, 1, At, B1); PG8_BAR; PG8_SCHED;
            PG8_LDB(B0, 1, 0); PG8_LDB(B1, 1, 1); PG8_SCHED; PG8_LDA(At, 1, 0); PG8_STAGE(PG8_SA(0, 1), a2 + hstep, voffA);
            PG8_WAIT_V(8); PG8_WAIT_L(0); PG8_BAR; PG8_MMA(0, 0, At, B0); PG8_MMA(0, 1, At, B1); PG8_BAR; PG8_SCHED;
            PG8_LDA(At, 1, 1); PG8_STAGE(PG8_SB(1, 0), b3, voffB); PG8_STAGE(PG8_SB(1, 1), b3 + hstep, voffB); PG8_STAGE(PG8_SA(1, 0), a3, voffA);
            PG8_WAIT_V(8); PG8_WAIT_L(0); PG8_BAR; PG8_MMA(1, 0, At, B0); PG8_MMA(1, 1, At, B1); PG8_BAR; PG8_SCHED;
            } else {
            PG8_LDB(B0, 0, 0); PG8_SCHED; PG8_LDA(At, 0, 0); PG8_STAGE(PG8_SA(1, 1), a1 + hstep, voffA);
            PG8_WAIT_L(8); PG8_BAR; PG8_WAIT_L(0); PG8_MMA(0, 0, At, B0); PG8_BAR; PG8_SCHED;
            PG8_LDB(B1, 0, 1); PG8_STAGE(PG8_SB(0, 0), b2, voffB);
            PG8_BAR; PG8_WAIT_L(0); PG8_MMA(0, 1, At, B1); PG8_BAR;
            PG8_LDA(At, 0, 1); PG8_STAGE(PG8_SA(0, 0), a2, voffA);
            PG8_BAR; PG8_WAIT_L(0); PG8_MMA(1, 0, At, B0); PG8_BAR; PG8_SCHED;
            PG8_STAGE(PG8_SB(0, 1), b2 + hstep, voffB);
            PG8_WAIT_V(6); PG8_BAR; PG8_MMA(1, 1, At, B1); PG8_BAR;
            PG8_LDB(B0, 1, 0); PG8_SCHED; PG8_LDA(At, 1, 0); PG8_STAGE(PG8_SA(0, 1), a2 + hstep, voffA);
            PG8_WAIT_L(8); PG8_BAR; PG8_WAIT_L(0); PG8_MMA(0, 0, At, B0); PG8_BAR; PG8_SCHED;
            PG8_LDB(B1, 1, 1); PG8_STAGE(PG8_SB(1, 0), b3, voffB);
            PG8_BAR; PG8_WAIT_L(0); PG8_MMA(0, 1, At, B1); PG8_BAR;
            PG8_LDA(At, 1, 1); PG8_STAGE(PG8_SA(1, 0), a3, voffA);
            PG8_BAR; PG8_WAIT_L(0); PG8_MMA(1, 0, At, B0); PG8_BAR; PG8_SCHED;
            PG8_STAGE(PG8_SB(1, 1), b3 + hstep, voffB);
            PG8_WAIT_V(6); PG8_BAR; PG8_MMA(1, 1, At, B1); PG8_BAR;
            }
        }
        if constexpr (ALIGN_EPI) { if (wr == 0) PG8_BAR; }
        if constexpr (!Epi::AFTER_DRAIN) { E(acc, cur, wr, wc, fr, fq);
#ifdef PROBE_EPI2
            if constexpr (Epi::PROBE_TWICE) { asm volatile("" ::: "memory"); E(acc, cur, wr, wc, fr, fq); }
#endif
            S.done(cur); }
        if (!has_next) break;
#pragma unroll
        for (int a = 0; a < 2; ++a)
#pragma unroll
            for (int b = 0; b < 2; ++b)
#pragma unroll
                for (int m = 0; m < 4; ++m)
#pragma unroll
                    for (int n = 0; n < 2; ++n) acc[a][b][m][n] = (f32x4){0.f, 0.f, 0.f, 0.f};
        cur = nxt; cA = nA; cB = nB; ++ui;
        if constexpr (ALIGN_EPI) { if (wr == 1) PG8_BAR; }
    }
    PG8_WAIT_V(0);
    if constexpr (!ALIGN_EPI) { if (wr == 0) PG8_BAR; }
    PG8_BAR;
    if constexpr (Epi::AFTER_DRAIN) { E.fused(acc, cur, wr, wc, fr, fq, lds, wid, lane); S.done(cur); }
#undef PG8_SA
#undef PG8_SB
#undef PG8_STAGE
#undef PG8_LDA
#undef PG8_LDB
#undef PG8_MMA
#undef PG8_WAIT_V
#undef PG8_WAIT_L
#undef PG8_BAR
#undef PG8_SCHED
}
}
namespace pg8 {
struct EpiProj {
    static constexpr bool PERM = true, AFTER_DRAIN = false, PROBE_TWICE = true;
    bf16_t* O; int ldc;
    __device__ __forceinline__ void operator()(const f32x4 (&acc)[2][2][4][2], const Unit& u, int wr, int wc, int fr, int fq) const {
        const int row0 = u.pm * BM + wr * 64 + fr; const int col0 = u.pn * BM + wc * 32 + 8 * fq;
#pragma unroll
        for (int ai = 0; ai < 2; ++ai)
#pragma unroll
            for (int m = 0; m < 4; ++m) { bf16_t* rowp = O + (size_t)(row0 + ai * HALF + m * 16) * ldc + col0;
#pragma unroll
                for (int bj = 0; bj < 2; ++bj) { const f32x4 v0 = acc[ai][bj][m][0], v1 = acc[ai][bj][m][1];
                    u32x4 w; w.x = cvt_pk_bf16(v0[0], v0[1]); w.y = cvt_pk_bf16(v0[2], v0[3]); w.z = cvt_pk_bf16(v1[0], v1[1]); w.w = cvt_pk_bf16(v1[2], v1[3]);
                    __builtin_nontemporal_store(w, (u32x4*)(rowp + bj * HALF)); } }
    }
};
struct EpiX1 {
    static constexpr bool PERM = true, AFTER_DRAIN = false, PROBE_TWICE = false;
    const float* x; float* x1; bf16_t* x1s; const float* mod; const float* norm2_g; float* rowstat; PG8_LAS float* tab;
    __device__ __forceinline__ void operator()(const f32x4 (&acc)[2][2][4][2], const Unit& u, int wr, int wc, int fr, int fq) const {
        const int row0 = u.pm * BM + wr * 64 + fr; const int col0 = u.pn * BM + wc * 32 + 8 * fq; const int b = (u.pm * BM) >> 11;
        const float* mb = mod + (size_t)b * 6144;
        f32x4 g1[2][2], g2[2][2];
#pragma unroll
        for (int bj = 0; bj < 2; ++bj)
#pragma unroll
            for (int n = 0; n < 2; ++n) { const int c = col0 + bj * HALF + 4 * n; g1[bj][n] = *(const f32x4*)(mb + 2048 + c);
                const f32x4 sc = *(const f32x4*)(mb + 4096 + c), ng = *(const f32x4*)(norm2_g + c); g2[bj][n] = ng * (sc + 1.0f); }
#pragma unroll
        for (int ai = 0; ai < 2; ++ai)
#pragma unroll
            for (int m = 0; m < 4; ++m) { const size_t row = (size_t)(row0 + ai * HALF + m * 16); const size_t off = row * 1024 + col0; float ss = 0.f;
                const float rfin = tab[((u.pm >> 3) & 1) * 1280 + 1024 + ai * HALF + wr * 64 + m * 16 + fr];
#pragma unroll
                for (int bj = 0; bj < 2; ++bj) {
                    const f32x4 xa = *(const f32x4*)(x + off + bj * HALF), xb = *(const f32x4*)(x + off + bj * HALF + 4);
                    const f32x4 v0 = xa + g1[bj][0] * (acc[ai][bj][m][0] * rfin), v1 = xb + g1[bj][1] * (acc[ai][bj][m][1] * rfin);
                    *(f32x4*)(x1 + off + bj * HALF) = v0; *(f32x4*)(x1 + off + bj * HALF + 4) = v1;
                    ss += (v0[0] * v0[0] + v0[1] * v0[1]) + (v0[2] * v0[2] + v0[3] * v0[3]) + (v1[0] * v1[0] + v1[1] * v1[1]) + (v1[2] * v1[2] + v1[3] * v1[3]);
                    const f32x4 s0 = v0 * g2[bj][0], s1 = v1 * g2[bj][1];
                    u32x4 w; w.x = cvt_pk_bf16(s0[0], s0[1]); w.y = cvt_pk_bf16(s0[2], s0[3]); w.z = cvt_pk_bf16(s1[0], s1[1]); w.w = cvt_pk_bf16(s1[2], s1[3]);
                    *(u32x4*)(x1s + off + bj * HALF) = w; }
                ss += __shfl_xor(ss, 16); ss += __shfl_xor(ss, 32);
                if (fq == 0) atomicAdd(rowstat + row, ss); }
    }
};
typedef _Float16 f16x8 __attribute__((ext_vector_type(8)));
struct EpiScores {
    static constexpr bool PERM = true, AFTER_DRAIN = false, PROBE_TWICE = false;
    _Float16* S; const float* sb; const float* rowstat;
    __device__ __forceinline__ void operator()(const f32x4 (&acc)[2][2][4][2], const Unit& u, int wr, int wc, int fr, int fq) const {
        const int row0 = u.pm * BM + wr * 64 + fr; const int col0 = u.pn * BM + wc * 32 + 8 * fq; const int b = (u.pm * BM) >> 11;
        f32x4 bv[2][2];
#pragma unroll
        for (int bj = 0; bj < 2; ++bj)
#pragma unroll
            for (int n = 0; n < 2; ++n) bv[bj][n] = *(const f32x4*)(sb + (size_t)b * 2048 + col0 + bj * HALF + 4 * n);
#pragma unroll
        for (int ai = 0; ai < 2; ++ai)
#pragma unroll
            for (int m = 0; m < 4; ++m) { const size_t row = (size_t)(row0 + ai * HALF + m * 16); const float rs = __builtin_amdgcn_rsqf(rowstat[row] * (1.0f / 1024.0f) + 1e-6f);
                _Float16* rowp = S + row * 2048 + col0;
#pragma unroll
                for (int bj = 0; bj < 2; ++bj) { const f32x4 v0 = acc[ai][bj][m][0] * rs + bv[bj][0], v1 = acc[ai][bj][m][1] * rs + bv[bj][1];
                    f16x8 h; h[0] = (_Float16)v0[0]; h[1] = (_Float16)v0[1]; h[2] = (_Float16)v0[2]; h[3] = (_Float16)v0[3]; h[4] = (_Float16)v1[0]; h[5] = (_Float16)v1[1]; h[6] = (_Float16)v1[2]; h[7] = (_Float16)v1[3];
                    *(f16x8*)(rowp + bj * HALF) = h; } }
    }
};
struct SegScaleHook {
    __device__ __forceinline__ static void build(PG8_LAS unsigned char* ldsx, const Unit& u, const float* st_ssd, const float* st_s5, int tid) {
        PG8_LAS float* tab = (PG8_LAS float*)ldsx + ((u.pm >> 3) & 1) * 1280;
        if (tid < 256) { const size_t row = (size_t)u.pm * BM + tid; const f32x4* sg = (const f32x4*)(st_ssd + row * 16); const f32x4* s5 = (const f32x4*)(st_s5 + row * 64);
            float r[5];
#pragma unroll
            for (int gI = 0; gI < 4; ++gI) { const f32x4 v = sg[gI]; r[gI] = __builtin_amdgcn_rsqf(((v[0] + v[1]) + (v[2] + v[3])) * (1.0f / 256.0f) + 1e-6f); }
            float a5 = 0.f;
#pragma unroll
            for (int q = 0; q < 16; ++q) { const f32x4 v = s5[q]; a5 += (v[0] + v[1]) + (v[2] + v[3]); }
            r[4] = __builtin_amdgcn_rsqf(a5 * (1.0f / 1024.0f) + 1e-6f);
#pragma unroll
            for (int k = 0; k < 4; ++k) tab[k * 256 + tid] = r[k] * __builtin_amdgcn_rcpf(r[k + 1]);
            tab[1024 + tid] = r[4]; }
    }
    __device__ __forceinline__ void at_tile(int t, const Unit& u, f32x4 (&acc)[2][2][4][2], PG8_LAS unsigned char* ldsx, int wr, int fr) const {
        if (t == 4 || t == 8 || t == 12 || t == 16) { const PG8_LAS float* rt = (const PG8_LAS float*)ldsx + ((u.pm >> 3) & 1) * 1280 + ((t >> 2) - 1) * 256 + wr * 64 + fr;
#pragma unroll
            for (int ai = 0; ai < 2; ++ai)
#pragma unroll
                for (int m = 0; m < 4; ++m) { const float r = rt[ai * HALF + m * 16];
#pragma unroll
                    for (int bj = 0; bj < 2; ++bj) { acc[ai][bj][m][0] = acc[ai][bj][m][0] * r; acc[ai][bj][m][1] = acc[ai][bj][m][1] * r; } } }
    }
};
}
constexpr int NWAVES = 8, NTHR = 512;
constexpr int DM = 1024, NB = 16, SEQ = 2048, MTOK = NB * SEQ;
constexpr int NPROJ = 4096;
constexpr int INW = 4112;
constexpr int NHEADS = 16, HDIM = 64, NGRP = 4, NST = 128, CHUNK = 128;
constexpr int S5G = 64, S5CH = 16, S5P = 64;
constexpr int PH = 8, PK = 16, PNK = 128;
constexpr float EPSF = 1e-6f;
constexpr int NS5PART = 64;

constexpr size_t MiB = 1u << 20;
constexpr size_t WS_CTL = 0, CTL_ZERO_BYTES = 64 * 1024;
constexpr size_t WS_MOD = 1 * MiB;
constexpr size_t WS_WDT = WS_MOD + 0x60000;
constexpr size_t WS_SB = WS_MOD + 0x70000;
constexpr size_t WS_ROWSTAT = WS_MOD + 0x90000;
constexpr size_t WS_S5LB = WS_MOD + 0xB0000;
constexpr size_t WS_S5BB = WS_MOD + 0xC0000;
constexpr size_t WS_DTRAW = 3 * MiB;
constexpr size_t WS_STSSD = 5 * MiB;
constexpr size_t WS_STS5 = 7 * MiB;
constexpr size_t WS_WINT = 15 * MiB;
constexpr size_t WS_WOUTT = 23 * MiB;
constexpr size_t WS_WQKT = 27 * MiB;
constexpr size_t WS_EU = 31 * MiB, WS_EV = 47 * MiB;
constexpr size_t WS_EUS = 63 * MiB, WS_EVS = 63 * MiB + 65536;
constexpr size_t WS_START = 64 * MiB;
constexpr size_t WS_A = 95 * MiB;
constexpr size_t WS_B = 223 * MiB;
constexpr size_t WS_H1 = WS_A, WS_Y = WS_A, WS_PROJ = WS_B, WS_SCORES = WS_A;
constexpr size_t WS_X1S = WS_B + 192 * MiB;
constexpr size_t WS_EID = 479 * MiB, WS_GATE = 495 * MiB;
constexpr size_t WS_END = 511 * MiB;
static_assert(WS_SCORES + (size_t)MTOK * 2048 * 4 <= WS_X1S && WS_X1S + (size_t)MTOK * 1024 * 2 <= WS_EID && WS_GATE + (size_t)MTOK * 128 * 4 <= WS_END, "ws map");

constexpr int LDS_MAIN = 159744;
constexpr int MISC_OFF = LDS_MAIN;
constexpr int LDS_BYTES = LDS_MAIN + 128;

#define GAS __attribute__((address_space(1)))
#define LAS __attribute__((address_space(3)))
typedef unsigned short bf16;
typedef unsigned v4u __attribute__((ext_vector_type(4)));
typedef unsigned v2u __attribute__((ext_vector_type(2)));
typedef float f32x4 __attribute__((ext_vector_type(4)));
typedef float f32x2 __attribute__((ext_vector_type(2)));
typedef short bf16x8 __attribute__((ext_vector_type(8)));
#define LDS_WAIT() asm volatile("s_waitcnt lgkmcnt(0)" ::: "memory")
#define VM_WAIT() asm volatile("s_waitcnt vmcnt(0)" ::: "memory")
typedef __bf16 hwbf16x2 __attribute__((ext_vector_type(2)));
__device__ __forceinline__ unsigned pk2(float lo, float hi) { const f32x2 v = {lo, hi}; const hwbf16x2 b = __builtin_convertvector(v, hwbf16x2); return __builtin_bit_cast(unsigned, b); }
__device__ __forceinline__ unsigned f2bf(float f) { return pk2(f, 0.f) & 0xffffu; }
__device__ __forceinline__ float bflo(unsigned w) { return __builtin_bit_cast(float, w << 16); }
__device__ __forceinline__ float bfhi(unsigned w) { return __builtin_bit_cast(float, w & 0xffff0000u); }
__device__ __forceinline__ float bf2f(bf16 v) { return __builtin_bit_cast(float, (unsigned)v << 16); }
__device__ __forceinline__ float wave_sum(float v) {
#pragma unroll
    for (int o = 1; o < 64; o <<= 1) v += __shfl_xor(v, o);
    return v;
}
__device__ __forceinline__ float sigmoid_f(float v) { return __builtin_amdgcn_rcpf(1.0f + __builtin_amdgcn_exp2f(-1.4426950408889634f * v)); }
__device__ __forceinline__ float silu_f(float v) { return v * sigmoid_f(v); }
__device__ __forceinline__ float rsqrt_f(float v) { return __builtin_amdgcn_rsqf(v); }
__device__ __forceinline__ float gelu_erf(float v) {
    const float av = fabsf(v), t = __builtin_amdgcn_rcpf(av * 0.2316418882f + 1.0f);
    float q = t * 0.5307027145f + (-0.7265760135f); q = q * t + 0.7107068705f; q = q * t + (-0.142248368f); q = q * t + 0.127414796f; q = q * t;
    const float e = __builtin_amdgcn_exp2f((v * v) * (-0.72134752044f));
    const float m = v * (q * e);
    return v < 0.f ? m : v - m;
}
__device__ __forceinline__ float softplus_f(float v) { return fmaxf(v, 0.f) + 0.6931471805599453f * __builtin_amdgcn_logf(1.0f + __builtin_amdgcn_exp2f(-1.4426950408889634f * fabsf(v))); }
__device__ __forceinline__ void unpack8(const v4u w, float* f) { f[0] = bflo(w.x); f[1] = bfhi(w.x); f[2] = bflo(w.y); f[3] = bfhi(w.y); f[4] = bflo(w.z); f[5] = bfhi(w.z); f[6] = bflo(w.w); f[7] = bfhi(w.w); }
#define LDS_BARRIER() do { asm volatile("s_waitcnt lgkmcnt(0)" ::: "memory"); __builtin_amdgcn_s_barrier(); asm volatile("" ::: "memory"); } while (0)
__device__ __forceinline__ float row16_sum_to15(float v) {
    v += __builtin_bit_cast(float, __builtin_amdgcn_update_dpp(0, __builtin_bit_cast(int, v), 0x118, 0xf, 0xf, true));
    v += __builtin_bit_cast(float, __builtin_amdgcn_update_dpp(0, __builtin_bit_cast(int, v), 0x114, 0xf, 0xf, true));
    v += __builtin_bit_cast(float, __builtin_amdgcn_update_dpp(0, __builtin_bit_cast(int, v), 0x112, 0xf, 0xf, true));
    v += __builtin_bit_cast(float, __builtin_amdgcn_update_dpp(0, __builtin_bit_cast(int, v), 0x111, 0xf, 0xf, true));
    return v;
}
__device__ __forceinline__ float wave_sum_to63(float v) {
    v = row16_sum_to15(v);
    v += __builtin_bit_cast(float, __builtin_amdgcn_update_dpp(0, __builtin_bit_cast(int, v), 0x142, 0xa, 0xf, false));
    v += __builtin_bit_cast(float, __builtin_amdgcn_update_dpp(0, __builtin_bit_cast(int, v), 0x143, 0xc, 0xf, false));
    return v;
}
__device__ __forceinline__ f32x2 gelu_pk2(f32x2 v) {
    const f32x2 av = __builtin_elementwise_abs(v), d = av * 0.2316418882f + 1.0f;
    f32x2 t; t[0] = __builtin_amdgcn_rcpf(d[0]); t[1] = __builtin_amdgcn_rcpf(d[1]);
    f32x2 q = t * 0.5307027145f + (-0.7265760135f); q = q * t + 0.7107068705f; q = q * t + (-0.142248368f); q = q * t + 0.127414796f; q = q * t;
    const f32x2 s = (v * v) * (-0.72134752044f);
    f32x2 e; e[0] = __builtin_amdgcn_exp2f(s[0]); e[1] = __builtin_amdgcn_exp2f(s[1]);
    const f32x2 m = v * (q * e), r = v - m;
    f32x2 o; o[0] = v[0] < 0.f ? m[0] : r[0]; o[1] = v[1] < 0.f ? m[1] : r[1]; return o;
}
#define XB_TMO      128
#define XB_XCNT(j)  (256  + 64 * (j))
#define XB_XSUB(j)  (1280 + 64 * (j))
#define XB_XGEN(j)  (2304 + 64 * (j))
#define XB_TOP      3328
#define XB_TOPGEN   3392
#define XCD_BAR_WORDS 3456
#define XB_SPIN_CAP (1u << 18)

__device__ __forceinline__ unsigned xb_ld(unsigned* p)              { return __hip_atomic_load(p, __ATOMIC_RELAXED, __HIP_MEMORY_SCOPE_AGENT); }
__device__ __forceinline__ unsigned xb_add(unsigned* p, unsigned v) { return __hip_atomic_fetch_add(p, v, __ATOMIC_RELAXED, __HIP_MEMORY_SCOPE_AGENT); }
__device__ __forceinline__ unsigned xb_xcc_id() { return (unsigned)__builtin_amdgcn_s_getreg((3 << 11) | 20) & 0xFu; }
#define XB_SPIN(cond, bar) do { unsigned _sp = 0; while (cond) { __builtin_amdgcn_s_sleep(1); \
    if ((++_sp & 255u) == 0u) { if (xb_ld(&(bar)[XB_TMO])) break; if (_sp > XB_SPIN_CAP) { atomicAdd(&(bar)[XB_TMO], 1u); break; } } } } while (0)

struct XcdBarrier {
    unsigned* bar; unsigned x;
    volatile LAS unsigned* st;
};

__device__ __forceinline__ XcdBarrier xcd_barrier_post(unsigned* bar, volatile LAS unsigned* st) {
    XcdBarrier b; b.bar = bar; b.x = xb_xcc_id(); b.st = st;
    if (threadIdx.x == 0) (void)xb_add(&bar[XB_XCNT(b.x)], 1u);
    return b;
}
__device__ __forceinline__ void xcd_barrier_complete(unsigned* bar, unsigned x, unsigned& nloc, unsigned& nx) {
    const unsigned G = gridDim.x * gridDim.y * gridDim.z;
    unsigned sum, cnt, mine, sp = 0u;
    for (;;) {
        sum = 0u; cnt = 0u; mine = 0u;
#pragma unroll
        for (unsigned j = 0; j < 16; ++j) { const unsigned c = xb_ld(&bar[XB_XCNT(j)]); sum += c; cnt += (c > 0u) ? 1u : 0u; mine = (j == x) ? c : mine; }
        if (sum == G) break;
        __builtin_amdgcn_s_sleep(1);
        if ((++sp & 255u) == 0u) { if (xb_ld(&bar[XB_TMO])) break; if (sp > XB_SPIN_CAP) { atomicAdd(&bar[XB_TMO], 1u); break; } }
    }
    nloc = mine > 0u ? mine : 1u; nx = cnt > 0u ? cnt : 1u;
}

__device__ __forceinline__ void xcd_barrier(const XcdBarrier& b) {
    asm volatile("s_waitcnt vmcnt(0)" ::: "memory");
    __syncthreads();
    if (threadIdx.x == 0) {
        unsigned* bar = b.bar;
        __builtin_amdgcn_s_waitcnt(0);
        unsigned nloc = b.st[0], nx = b.st[1];
        if (nloc == 0u) { xcd_barrier_complete(bar, b.x, nloc, nx); b.st[0] = nloc; b.st[1] = nx; }
        const unsigned old = xb_add(&bar[XB_XSUB(b.x)], 1u);
        const unsigned gen = old / nloc;
        if (old + 1u == (gen + 1u) * nloc) {
            __builtin_amdgcn_fence(__ATOMIC_RELEASE, "agent");
            asm volatile("s_waitcnt vmcnt(0)" ::: "memory");
            const unsigned og = xb_add(&bar[XB_TOP], 1u);
            const unsigned tg = og / nx;
            if (og + 1u == (tg + 1u) * nx) xb_add(&bar[XB_TOPGEN], 1u);
            else XB_SPIN(xb_ld(&bar[XB_TOPGEN]) == tg, bar);
            __builtin_amdgcn_fence(__ATOMIC_ACQUIRE, "agent");
            xb_add(&bar[XB_XGEN(b.x)], 1u);
            asm volatile("s_waitcnt vmcnt(0)" ::: "memory");
        } else {
            XB_SPIN(xb_ld(&bar[XB_XGEN(b.x)]) == gen, bar);
            __builtin_amdgcn_fence(__ATOMIC_ACQUIRE, "agent");
            asm volatile("s_waitcnt vmcnt(0)" ::: "memory");
        }
    }
    __syncthreads();
}
struct Args { const float* in[30]; float* out; unsigned char* ws; int ph_lo, ph_hi; };
struct Frame {
    LAS unsigned char* lds;
    volatile LAS unsigned* MISC;
    int vcu, G;
    unsigned char* ws;
    const Args* a;
    float* out;
};
#define WSP(T, off) ((T*)(F.ws + (off)))

__device__ __forceinline__ void transpose_tile(const float* W, int ldw, int k0, int src_n0, bf16* WT, int K, int dst_n0, LAS float* scr, int lane, const float* kscale) {
#pragma unroll 8
    for (int i = 0; i < 32; ++i) { const int kk = 2 * i + (lane >> 5); float v = W[(size_t)(k0 + kk) * ldw + src_n0 + (lane & 31)]; if (kscale) v *= kscale[k0 + kk]; scr[kk * 33 + (lane & 31)] = v; }
    LDS_WAIT(); asm volatile("" ::: "memory");
    const int c = lane & 7;
#pragma unroll
    for (int j = 0; j < 4; ++j) { const int n = (lane >> 3) + 8 * j; const LAS float* s = scr + (8 * c) * 33 + n;
        v4u o; o.x = pk2(s[0 * 33], s[1 * 33]); o.y = pk2(s[2 * 33], s[3 * 33]); o.z = pk2(s[4 * 33], s[5 * 33]); o.w = pk2(s[6 * 33], s[7 * 33]);
        *(v4u*)(WT + (size_t)(dst_n0 + n) * K + k0 + 8 * c) = o; }
    LDS_WAIT(); asm volatile("" ::: "memory");
}
__device__ __forceinline__ void p0_phase(Frame& F) {
    const int f_tid = threadIdx.x, f_lane = f_tid & 63, f_wave = __builtin_amdgcn_readfirstlane(f_tid >> 6);
    const int gw = F.vcu * NWAVES + f_wave, NGW = F.G * NWAVES, gt = F.vcu * NTHR + f_tid, NGT = F.G * NTHR;
    {
        LAS float* sc = (LAS float*)F.lds;
        LAS float* red = (LAS float*)(F.lds + 65536);
        for (int i = f_tid; i < 16 * 1024; i += NTHR) { const int b = i >> 10, k = i & 1023; sc[k * 16 + b] = silu_f((F.a->in[1])[i]); }
        __syncthreads();
        const int ks = f_tid / 24, col = f_tid - ks * 24, j = F.vcu * 24 + col;
        if (ks < 21) {
            float acc[16];
#pragma unroll
            for (int b = 0; b < 16; ++b) acc[b] = 0.f;
            const int k0 = ks * 49, kn = (k0 + 49 <= 1024) ? 49 : (1024 - k0);
            const float* wp = (F.a->in[2]) + (size_t)k0 * 6144 + j;
#pragma unroll 1
            for (int kb = 0; kb < 49; kb += 7) {
                asm volatile("" ::: "memory");
                float wv[7];
#pragma unroll
                for (int u = 0; u < 7; ++u) wv[u] = (kb + u < kn) ? wp[(size_t)(kb + u) * 6144] : 0.f;
#pragma unroll
                for (int u = 0; u < 7; ++u) { const int kk = (kb + u < kn) ? (k0 + kb + u) : k0; const LAS f32x4* s4 = (const LAS f32x4*)(sc + kk * 16);
#pragma unroll
                    for (int q = 0; q < 4; ++q) { const f32x4 sv = s4[q]; acc[4 * q] += sv[0] * wv[u]; acc[4 * q + 1] += sv[1] * wv[u]; acc[4 * q + 2] += sv[2] * wv[u]; acc[4 * q + 3] += sv[3] * wv[u]; } }
            }
#pragma unroll
            for (int b = 0; b < 16; ++b) red[(ks * 16 + b) * 24 + col] = acc[b];
        }
        __syncthreads();
        for (int i = f_tid; i < 16 * 24; i += NTHR) { const int b = i / 24, cc = i - b * 24; float sacc = 0.f;
            for (int q = 0; q < 21; ++q) sacc += red[(q * 16 + b) * 24 + cc];
            WSP(float, WS_MOD)[b * 6144 + F.vcu * 24 + cc] = sacc + (F.a->in[3])[F.vcu * 24 + cc]; }
        __syncthreads();
    }
    {
        LAS float* scr = (LAS float*)(F.lds + f_wave * 16384);
        constexpr int I_IN = (1024 / 64) * (NPROJ / 32), I_OUT = (2048 / 64) * (1024 / 32);
        for (int it = gw; it < I_IN + I_OUT; it += NGW) {
            if (it < I_IN) { const int kb = it / (NPROJ / 32), nb = it % (NPROJ / 32); const int dn = 32 * nb, sn = dn < 3072 ? dn : dn + 16;
                transpose_tile((F.a->in[5]), INW, 64 * kb, sn, WSP(bf16, WS_WINT), 1024, dn, scr, f_lane, nullptr); }
            else { const int r = it - I_IN, kb = r / 32, nb = r % 32; const int k0 = 64 * kb;
                transpose_tile((F.a->in[23]), 1024, k0, 32 * nb, WSP(bf16, WS_WOUTT), 2048, 32 * nb, scr, f_lane, k0 < 1024 ? (F.a->in[11]) : (F.a->in[22]) - 1024); }
        }
    }
    for (int i = gt; i < 16 * 1024; i += NGT) { const int h = i >> 10, k = i & 1023; WSP(float, WS_WDT)[i] = (F.a->in[5])[(size_t)k * INW + 3072 + h]; }
    for (int task = gw; task < 2048; task += NGW) {
        const int nt = task >> 4, ks = task & 15, n0 = 16 * nt, hc = n0 >> 7, k0 = 64 * ks;
        const int li = f_lane & 15, lq = f_lane >> 4;
        f32x4 acc[4];
#pragma unroll
        for (int s = 0; s < 4; ++s) acc[s] = (f32x4){0.f, 0.f, 0.f, 0.f};
        const float* ap = (F.a->in[26]) + (size_t)(n0 + li) * 128 + 4 * lq;
        const float* bp = (F.a->in[25]) + (size_t)(k0 + li) * 2048 + hc * 128 + 4 * lq;
#pragma unroll
        for (int q = 0; q < 8; ++q) { const f32x4 a = *(const f32x4*)(ap + 16 * q);
#pragma unroll
            for (int s = 0; s < 4; ++s) { const f32x4 b = *(const f32x4*)(bp + (size_t)(16 * s) * 2048 + 16 * q);
#pragma unroll
                for (int jj = 0; jj < 4; ++jj) acc[s] = __builtin_amdgcn_mfma_f32_16x16x4f32(a[jj], b[jj], acc[s], 0, 0, 0); } }
        bf16* o = WSP(bf16, WS_WQKT);
#pragma unroll
        for (int s = 0; s < 4; ++s)
#pragma unroll
            for (int r = 0; r < 4; ++r) o[(size_t)(n0 + 4 * lq + r) * 1024 + k0 + 16 * s + li] = (bf16)f2bf(acc[s][r]);
    }
    for (int i = gt; i < S5G * S5P; i += NGT) {
        const float lr = (F.a->in[12])[i], li = (F.a->in[13])[i], dt = expf((F.a->in[14])[i >> 6]);
        const float mag = expf(lr * dt); float sn, cs; sincosf(li * dt, &sn, &cs);
        const float lbr = mag * cs, lbi = mag * sn, den = lr * lr + li * li;
        const float cfr = ((lbr - 1.0f) * lr + lbi * li) / den, cfi = (lbi * lr - (lbr - 1.0f) * li) / den;
        WSP(float, WS_S5LB)[2 * i] = lbr; WSP(float, WS_S5LB)[2 * i + 1] = lbi;
        for (int hh = 0; hh < 16; ++hh) { const float br = (F.a->in[15])[i * 16 + hh], bi = (F.a->in[16])[i * 16 + hh];
            WSP(float, WS_S5BB)[i * 32 + hh] = cfr * br - cfi * bi; WSP(float, WS_S5BB)[i * 32 + 16 + hh] = cfr * bi + cfi * br; }
    }
    for (int i = gt; i < MTOK; i += NGT) WSP(float, WS_ROWSTAT)[i] = 0.f;
}

__device__ __forceinline__ void p1_phase(Frame& F) {
    const int f_tid = threadIdx.x, f_lane = f_tid & 63, f_wave = __builtin_amdgcn_readfirstlane(f_tid >> 6);
    const int gw = F.vcu * NWAVES + f_wave;
    LAS float* wdt = (LAS float*)F.lds;
    for (int i = f_tid; i < 16 * 1024 / 4; i += NTHR) ((LAS f32x4*)wdt)[i] = ((const f32x4*)WSP(float, WS_WDT))[i];
    __syncthreads();
    const int lane = f_lane;
    for (int wq = gw; wq < MTOK / 16; wq += F.G * NWAVES) {
        const int b = wq >> 7; const float* mb = WSP(float, WS_MOD) + (size_t)b * 6144;
        f32x4 Gv[4], Sv[4];
#pragma unroll
        for (int j = 0; j < 4; ++j) { const int k = 4 * lane + 256 * j; const f32x4 g = *(const f32x4*)((F.a->in[4]) + k), sc = *(const f32x4*)(mb + 1024 + k); Gv[j] = g * (sc + 1.0f); Sv[j] = *(const f32x4*)(mb + k); }
        f32x4 nx[4];
#pragma unroll
        for (int j = 0; j < 4; ++j) nx[j] = *(const f32x4*)((F.a->in[0]) + (size_t)wq * 16 * 1024 + 4 * lane + 256 * j);
        for (int tt = 0; tt < 16; ++tt) {
            asm volatile("" ::: "memory");
            const size_t t = (size_t)wq * 16 + tt; const float* xr = (F.a->in[0]) + t * 1024;
            f32x4 v[4]; float ss = 0.f;
#pragma unroll
            for (int j = 0; j < 4; ++j) { v[j] = nx[j]; ss += (v[j][0] * v[j][0] + v[j][1] * v[j][1]) + (v[j][2] * v[j][2] + v[j][3] * v[j][3]); }
            if (tt < 15) {
#pragma unroll
                for (int j = 0; j < 4; ++j) nx[j] = *(const f32x4*)(xr + 1024 + 4 * lane + 256 * j); }
            const float rstd = rsqrt_f(wave_sum(ss) * (1.0f / 1024.0f) + EPSF);
            bf16* hr = WSP(bf16, WS_H1) + t * 1024;
#pragma unroll
            for (int j = 0; j < 4; ++j) { v[j] = v[j] * rstd * Gv[j] + Sv[j]; v2u w; w.x = pk2(v[j][0], v[j][1]); w.y = pk2(v[j][2], v[j][3]); *(v2u*)(hr + 4 * lane + 256 * j) = w; }
            float d[16];
#pragma unroll
            for (int h = 0; h < 16; ++h) { float a = 0.f;
#pragma unroll
                for (int j = 0; j < 4; ++j) { const f32x4 w = *(const LAS f32x4*)(wdt + h * 1024 + 4 * lane + 256 * j); a += (v[j][0] * w[0] + v[j][1] * w[1]) + (v[j][2] * w[2] + v[j][3] * w[3]); }
                d[h] = a; }
            float e8[8], e4[4], e2[2], e1;
#pragma unroll
            for (int i = 0; i < 8; ++i) { const bool up = lane & 32; const float snd = up ? d[i] : d[i + 8]; const float rcv = __shfl_xor(snd, 32); e8[i] = (up ? d[i + 8] : d[i]) + rcv; }
#pragma unroll
            for (int i = 0; i < 4; ++i) { const bool up = lane & 16; const float snd = up ? e8[i] : e8[i + 4]; const float rcv = __shfl_xor(snd, 16); e4[i] = (up ? e8[i + 4] : e8[i]) + rcv; }
#pragma unroll
            for (int i = 0; i < 2; ++i) { const bool up = lane & 8; const float snd = up ? e4[i] : e4[i + 2]; const float rcv = __shfl_xor(snd, 8); e2[i] = (up ? e4[i + 2] : e4[i]) + rcv; }
            { const bool up = lane & 4; const float snd = up ? e2[0] : e2[1]; const float rcv = __shfl_xor(snd, 4); e1 = (up ? e2[1] : e2[0]) + rcv; }
            e1 += __shfl_xor(e1, 2); e1 += __shfl_xor(e1, 1);
            const int head = ((lane >> 5) & 1) * 8 + ((lane >> 4) & 1) * 4 + ((lane >> 3) & 1) * 2 + ((lane >> 2) & 1);
            if ((lane & 3) == 0) WSP(float, WS_DTRAW)[t * 16 + head] = e1;
        }
    }
    for (int n = gw; n < 2048; n += F.G * NWAVES) {
        const bf16* wr = WSP(bf16, WS_WQKT) + (size_t)n * 1024 + 16 * lane;
        const v4u w0 = *(const v4u*)wr, w1 = *(const v4u*)(wr + 8);
        float wv[16]; wv[0] = bflo(w0.x); wv[1] = bfhi(w0.x); wv[2] = bflo(w0.y); wv[3] = bfhi(w0.y); wv[4] = bflo(w0.z); wv[5] = bfhi(w0.z); wv[6] = bflo(w0.w); wv[7] = bfhi(w0.w);
        wv[8] = bflo(w1.x); wv[9] = bfhi(w1.x); wv[10] = bflo(w1.y); wv[11] = bfhi(w1.y); wv[12] = bflo(w1.z); wv[13] = bfhi(w1.z); wv[14] = bflo(w1.w); wv[15] = bfhi(w1.w);
        for (int b = 0; b < 16; ++b) { const float* sp = WSP(float, WS_MOD) + (size_t)b * 6144 + 3072 + 16 * lane; float a = 0.f;
#pragma unroll
            for (int q = 0; q < 4; ++q) { const f32x4 s = *(const f32x4*)(sp + 4 * q); a += (s[0] * wv[4 * q] + s[1] * wv[4 * q + 1]) + (s[2] * wv[4 * q + 2] + s[3] * wv[4 * q + 3]); }
            a = wave_sum(a); if (lane == 0) WSP(float, WS_SB)[b * 2048 + n] = a; }
    }
}
__device__ __forceinline__ void p3_ssd_naive(Frame& F) {
    const int f_tid = threadIdx.x;
    const bf16* proj = WSP(bf16, WS_PROJ);
    LAS float* buf = (LAS float*)F.lds;
    LAS float* yl = (LAS float*)(F.lds + 4096);
    for (int item = F.vcu; item < NB * NGRP; item += F.G) {
        const int b = item >> 2, g = item & 3, tid = f_tid;
        const int ch = tid < 256 ? g * 256 + tid : (tid < 384 ? 1024 + g * 128 + (tid - 256) : 1536 + g * 128 + (tid - 384));
        const float w0 = (F.a->in[6])[0 * 2048 + ch], w1 = (F.a->in[6])[1 * 2048 + ch], w2 = (F.a->in[6])[2 * 2048 + ch], w3 = (F.a->in[6])[3 * 2048 + ch], cb = (F.a->in[7])[ch];
        float r0 = 0.f, r1 = 0.f, r2 = 0.f;
        const int r = tid >> 7, nh = (tid >> 6) & 1, p = tid & 63, h = g * 4 + r;
        float st[64];
#pragma unroll
        for (int n = 0; n < 64; ++n) st[n] = 0.f;
        const float A = -__expf((F.a->in[9])[h]), Dh = (F.a->in[10])[h], dtb = (F.a->in[8])[h];
        for (int t = 0; t < SEQ; ++t) {
            const size_t row = (size_t)b * SEQ + t;
            const float r3 = bf2f(proj[row * NPROJ + 1024 + ch]);
            const float cv = silu_f(cb + r0 * w0 + r1 * w1 + r2 * w2 + r3 * w3);
            r0 = r1; r1 = r2; r2 = r3;
            LAS float* cur = buf + (t & 1) * 512; LAS float* ycur = yl + (t & 1) * 512;
            cur[tid] = cv;
            __syncthreads();
            const float dt = softplus_f(WSP(float, WS_DTRAW)[row * 16 + h] + dtb);
            const float dA = __expf(dt * A), xv = cur[r * 64 + p], xd = xv * dt;
            float y = 0.f;
#pragma unroll
            for (int n4 = 0; n4 < 16; ++n4) { const f32x4 Bv = *(const LAS f32x4*)(cur + 256 + 64 * nh + 4 * n4), Cv = *(const LAS f32x4*)(cur + 384 + 64 * nh + 4 * n4);
#pragma unroll
                for (int q = 0; q < 4; ++q) { st[4 * n4 + q] = st[4 * n4 + q] * dA + xd * Bv[q]; y += Cv[q] * st[4 * n4 + q]; } }
            ycur[tid] = y;
            __syncthreads();
            if (nh == 0) {
                y = ycur[tid] + ycur[tid + 64] + Dh * xv;
                const float zv = bf2f(proj[row * NPROJ + h * 64 + p]);
                y *= silu_f(zv);
                WSP(bf16, WS_Y)[row * 2048 + h * 64 + p] = (bf16)f2bf(y);
                const float ss = wave_sum(y * y);
                if (p == 0) WSP(float, WS_STSSD)[row * 16 + h] = ss;
            }
        }
        __syncthreads();
    }
}
__device__ __forceinline__ void p3_s5_naive(Frame& F) {
    const int f_tid = threadIdx.x, f_lane = f_tid & 63, f_wave = __builtin_amdgcn_readfirstlane(f_tid >> 6);
    const bf16* proj = WSP(bf16, WS_PROJ);
    LAS float* xt = (LAS float*)(F.lds + 4096 + f_wave * 19200);
    LAS float* vt = (LAS float*)(F.lds + 4096 + f_wave * 19200 + 16896) + (f_lane & 31) * 17;
    const int lane = f_lane;
    for (int item = F.vcu * NWAVES + f_wave; item < NB * S5G; item += F.G * NWAVES) {
        const int b = item >> 6, g = item & 63, p = lane;
        const float lbr = WSP(float, WS_S5LB)[(g * 64 + p) * 2], lbi = WSP(float, WS_S5LB)[(g * 64 + p) * 2 + 1];
        float bbr[16], bbi[16];
#pragma unroll
        for (int q = 0; q < 4; ++q) { const f32x4 a = *(const f32x4*)(WSP(float, WS_S5BB) + (g * 64 + p) * 32 + 4 * q), c = *(const f32x4*)(WSP(float, WS_S5BB) + (g * 64 + p) * 32 + 16 + 4 * q);
#pragma unroll
            for (int e = 0; e < 4; ++e) { bbr[4 * q + e] = a[e]; bbi[4 * q + e] = c[e]; } }
        float xr = 0.f, xi = 0.f;
        for (int t0 = 0; t0 < SEQ; t0 += 32) {
            for (int tt = 0; tt < 32; ++tt) {
                const bf16* up = proj + ((size_t)b * SEQ + t0 + tt) * NPROJ + 3072 + g * 16;
                const v4u u0 = *(const v4u*)up, u1 = *(const v4u*)(up + 8);
                float uv[16]; uv[0] = bflo(u0.x); uv[1] = bfhi(u0.x); uv[2] = bflo(u0.y); uv[3] = bfhi(u0.y); uv[4] = bflo(u0.z); uv[5] = bfhi(u0.z); uv[6] = bflo(u0.w); uv[7] = bfhi(u0.w);
                uv[8] = bflo(u1.x); uv[9] = bfhi(u1.x); uv[10] = bflo(u1.y); uv[11] = bfhi(u1.y); uv[12] = bflo(u1.z); uv[13] = bfhi(u1.z); uv[14] = bflo(u1.w); uv[15] = bfhi(u1.w);
                float br = 0.f, bi = 0.f;
#pragma unroll
                for (int hh = 0; hh < 16; ++hh) { br += uv[hh] * bbr[hh]; bi += uv[hh] * bbi[hh]; }
                const float nr = lbr * xr - lbi * xi + br, ni = lbr * xi + lbi * xr + bi; xr = nr; xi = ni;
                xt[(tt * 66 + p) * 2] = xr; xt[(tt * 66 + p) * 2 + 1] = xi;
            }
            LDS_WAIT(); asm volatile("" ::: "memory");
            if (lane < 32) {
                const int tt = lane; const size_t row = (size_t)b * SEQ + t0 + tt;
                const bf16* up = proj + row * NPROJ + 3072 + g * 16;
#pragma unroll 1
                for (int hh = 0; hh < 16; ++hh) { float y = 0.f; const float* cr = (F.a->in[17]) + (g * 16 + hh) * 64; const float* ci = (F.a->in[18]) + (g * 16 + hh) * 64;
#pragma unroll 8
                    for (int pp = 0; pp < 64; ++pp) y += xt[(tt * 66 + pp) * 2] * cr[pp] - xt[(tt * 66 + pp) * 2 + 1] * ci[pp];
                    vt[hh] = gelu_erf(y + (F.a->in[19])[g * 16 + hh] * bf2f(up[hh])); }
                float ss = 0.f; unsigned ow[8];
#pragma unroll 1
                for (int k2 = 0; k2 < 8; ++k2) { float o2[2];
#pragma unroll
                    for (int e = 0; e < 2; ++e) { const int k = 2 * k2 + e; float gt = (F.a->in[21])[g * 16 + k];
#pragma unroll
                        for (int hh = 0; hh < 16; ++hh) gt += vt[hh] * (F.a->in[20])[(g * 16 + hh) * 16 + k];
                        o2[e] = vt[k] * sigmoid_f(gt); ss += o2[e] * o2[e]; }
                    const unsigned pw = pk2(o2[0], o2[1]);
#pragma unroll
                    for (int q = 0; q < 8; ++q) ow[q] = (q == k2) ? pw : ow[q]; }
                bf16* yo = WSP(bf16, WS_Y) + row * 2048 + 1024 + g * 16;
                *(v4u*)yo = (v4u){ow[0], ow[1], ow[2], ow[3]}; *(v4u*)(yo + 8) = (v4u){ow[4], ow[5], ow[6], ow[7]};
                WSP(float, WS_STS5)[row * NS5PART + g] = ss;
            }
            LDS_WAIT(); asm volatile("" ::: "memory");
        }
    }
}
__device__ __forceinline__ void p3c_normalize(Frame& F) {
    const int f_tid = threadIdx.x, f_lane = f_tid & 63, f_wave = __builtin_amdgcn_readfirstlane(f_tid >> 6);
    const int lane = f_lane;
    for (int t = F.vcu * NWAVES + f_wave; t < MTOK; t += F.G * NWAVES) {
        const float* sg = WSP(float, WS_STSSD) + (size_t)t * 16; const float* s5 = WSP(float, WS_STS5) + (size_t)t * NS5PART;
        float rg[4];
#pragma unroll
        for (int g = 0; g < 4; ++g) rg[g] = rsqrt_f((sg[4 * g] + sg[4 * g + 1] + sg[4 * g + 2] + sg[4 * g + 3]) * (1.0f / 256.0f) + EPSF);
        float s5s = (NS5PART == 64) ? s5[lane] : (lane < NS5PART ? s5[lane] : 0.f); s5s = wave_sum(s5s);
        const float r5 = rsqrt_f(s5s * (1.0f / 1024.0f) + EPSF);
        bf16* yr = WSP(bf16, WS_Y) + (size_t)t * 2048;
#pragma unroll
        for (int j = 0; j < 4; ++j) { const int e0 = 512 * j + 8 * lane; const float sc = j >= 2 ? r5 : (j == 0 ? (lane < 32 ? rg[0] : rg[1]) : (lane < 32 ? rg[2] : rg[3]));
            v4u w = *(v4u*)(yr + e0);
            w.x = pk2(bflo(w.x) * sc, bfhi(w.x) * sc); w.y = pk2(bflo(w.y) * sc, bfhi(w.y) * sc); w.z = pk2(bflo(w.z) * sc, bfhi(w.z) * sc); w.w = pk2(bflo(w.w) * sc, bfhi(w.w) * sc);
            *(v4u*)(yr + e0) = w; }
    }
}
constexpr int SSD_CS = 0, SSD_BS = 34816, SSD_BWT = 69632, SSD_XDT = 104448, SSD_PREV = 121856, SSD_XS = 139264, SSD_CSF = 157696, SSD_DTF = 158208, SSD_PITCH = 272, SSD_XPITCH = 144;
static_assert(SSD_DTF + 512 <= LDS_MAIN, "SSD LDS map");
__device__ __forceinline__ bf16x8 lds_frag(LAS unsigned char* base, int row, int kbyte) { return *(const LAS bf16x8*)(base + row * SSD_PITCH + kbyte); }
__device__ __forceinline__ void p3_ssd(Frame& F) {
    const int tid = threadIdx.x, lane = tid & 63, w = __builtin_amdgcn_readfirstlane(tid >> 6);
    const int li = lane & 15, lq = lane >> 4;
    LAS unsigned char* L = F.lds;
    LAS float* csf = (LAS float*)(L + SSD_CSF); LAS float* dtf = (LAS float*)(L + SSD_DTF);
    const bf16* proj = WSP(bf16, WS_PROJ);
    for (int item = F.vcu; item < NB * NHEADS; item += F.G) {
        const int b = item >> 4, h = item & 15, g = h >> 2;
        const float A = -__expf((F.a->in[9])[h]), Dh = (F.a->in[10])[h], dtb = (F.a->in[8])[h];
        const int pbs = w >> 1, nb0 = 4 * (w & 1);
        f32x4 st[4];
#pragma unroll
        for (int j = 0; j < 4; ++j) st[j] = (f32x4){0.f, 0.f, 0.f, 0.f};
        for (int i = tid; i < 17408 / 16; i += NTHR) ((LAS v4u*)(L + SSD_PREV))[i] = (v4u){0u, 0u, 0u, 0u};
        for (int c = 0; c < SEQ / CHUNK; ++c) {
            const size_t row0 = (size_t)b * SEQ + (size_t)c * CHUNK;
            if (w == 0) {
                const float d0 = softplus_f(WSP(float, WS_DTRAW)[(row0 + 2 * lane) * 16 + h] + dtb), d1 = softplus_f(WSP(float, WS_DTRAW)[(row0 + 2 * lane + 1) * 16 + h] + dtb);
                const float a0 = d0 * A, a1 = d1 * A; float s = a0 + a1;
#pragma unroll
                for (int o = 1; o < 64; o <<= 1) { const float t = __shfl_up(s, o); if (lane >= o) s += t; }
                dtf[2 * lane] = d0; dtf[2 * lane + 1] = d1; csf[2 * lane] = s - a1; csf[2 * lane + 1] = s;
            }
            __syncthreads();
            const float cs_end = csf[127];
            for (int it = tid; it < 1280; it += NTHR) {
                const int o = it % 40, rg = it / 40, l0 = 4 * rg;
                const int xcol = o < 8 ? h * 64 + 8 * o : (o < 24 ? 1024 + g * 128 + 8 * (o - 8) : 1536 + g * 128 + 8 * (o - 24));
                float raw[7][8];
#pragma unroll
                for (int k = 0; k < 7; ++k) { const int l = l0 - 3 + k; const bool ok = (c > 0) || (l >= 0);
                    v4u wv = (v4u){0u, 0u, 0u, 0u}; if (ok) wv = *(const v4u*)(proj + (size_t)((long)row0 + l) * NPROJ + 1024 + xcol);
                    raw[k][0] = bflo(wv.x); raw[k][1] = bfhi(wv.x); raw[k][2] = bflo(wv.y); raw[k][3] = bfhi(wv.y); raw[k][4] = bflo(wv.z); raw[k][5] = bfhi(wv.z); raw[k][6] = bflo(wv.w); raw[k][7] = bfhi(wv.w); }
                float cw[4][8], cbv[8];
#pragma unroll
                for (int k = 0; k < 4; ++k) { const f32x4 w0 = *(const f32x4*)((F.a->in[6]) + k * 2048 + xcol), w1 = *(const f32x4*)((F.a->in[6]) + k * 2048 + xcol + 4);
#pragma unroll
                    for (int e = 0; e < 4; ++e) { cw[k][e] = w0[e]; cw[k][4 + e] = w1[e]; } }
                { const f32x4 b0 = *(const f32x4*)((F.a->in[7]) + xcol), b1 = *(const f32x4*)((F.a->in[7]) + xcol + 4);
#pragma unroll
                    for (int e = 0; e < 4; ++e) { cbv[e] = b0[e]; cbv[4 + e] = b1[e]; } }
                float v[4][8];
#pragma unroll
                for (int r = 0; r < 4; ++r)
#pragma unroll
                    for (int i = 0; i < 8; ++i) v[r][i] = silu_f(cbv[i] + raw[r][i] * cw[0][i] + raw[r + 1][i] * cw[1][i] + raw[r + 2][i] * cw[2][i] + raw[r + 3][i] * cw[3][i]);
                if (o < 8) {
                    const int p0 = 8 * o;
#pragma unroll
                    for (int r = 0; r < 4; ++r) *(LAS v4u*)(L + SSD_XS + (l0 + r) * SSD_XPITCH + p0 * 2) = (v4u){pk2(v[r][0], v[r][1]), pk2(v[r][2], v[r][3]), pk2(v[r][4], v[r][5]), pk2(v[r][6], v[r][7])};
                    const float t0 = dtf[l0], t1 = dtf[l0 + 1], t2 = dtf[l0 + 2], t3 = dtf[l0 + 3];
#pragma unroll
                    for (int i = 0; i < 8; ++i) *(LAS v2u*)(L + SSD_XDT + (p0 + i) * SSD_PITCH + l0 * 2) = (v2u){pk2(v[0][i] * t0, v[1][i] * t1), pk2(v[2][i] * t2, v[3][i] * t3)};
                } else if (o < 24) {
                    const int n0 = 8 * (o - 8);
#pragma unroll
                    for (int r = 0; r < 4; ++r) *(LAS v4u*)(L + SSD_BS + (l0 + r) * SSD_PITCH + n0 * 2) = (v4u){pk2(v[r][0], v[r][1]), pk2(v[r][2], v[r][3]), pk2(v[r][4], v[r][5]), pk2(v[r][6], v[r][7])};
                    const float t0 = __expf(cs_end - csf[l0]), t1 = __expf(cs_end - csf[l0 + 1]), t2 = __expf(cs_end - csf[l0 + 2]), t3 = __expf(cs_end - csf[l0 + 3]);
#pragma unroll
                    for (int i = 0; i < 8; ++i) *(LAS v2u*)(L + SSD_BWT + (n0 + i) * SSD_PITCH + l0 * 2) = (v2u){pk2(v[0][i] * t0, v[1][i] * t1), pk2(v[2][i] * t2, v[3][i] * t3)};
                } else {
                    const int n0 = 8 * (o - 24);
#pragma unroll
                    for (int r = 0; r < 4; ++r) *(LAS v4u*)(L + SSD_CS + (l0 + r) * SSD_PITCH + n0 * 2) = (v4u){pk2(v[r][0], v[r][1]), pk2(v[r][2], v[r][3]), pk2(v[r][4], v[r][5]), pk2(v[r][6], v[r][7])};
                }
            }
            __syncthreads();
            bf16x8 ca[4];
#pragma unroll
            for (int ks = 0; ks < 4; ++ks) ca[ks] = lds_frag(L + SSD_CS, 16 * w + li, 64 * ks + 16 * lq);
            f32x4 cb[8];
#pragma unroll
            for (int sb = 0; sb < 8; ++sb) { cb[sb] = (f32x4){0.f, 0.f, 0.f, 0.f};
                if (sb <= w) {
#pragma unroll
                    for (int ks = 0; ks < 4; ++ks) cb[sb] = __builtin_amdgcn_mfma_f32_16x16x32_bf16(ca[ks], lds_frag(L + SSD_BS, 16 * sb + li, 64 * ks + 16 * lq), cb[sb], 0, 0, 0); } }
            float csl[4];
#pragma unroll
            for (int r = 0; r < 4; ++r) csl[r] = csf[16 * w + 4 * lq + r];
#pragma unroll
            for (int sb = 0; sb < 8; ++sb) if (sb <= w) { const int s = 16 * sb + li; const float css = csf[s];
#pragma unroll
                for (int r = 0; r < 4; ++r) { const int l = 16 * w + 4 * lq + r; cb[sb][r] = (s <= l) ? cb[sb][r] * __expf(csl[r] - css) : 0.f; } }
            __syncthreads();
#pragma unroll
            for (int sb = 0; sb < 8; ++sb) if (sb <= (w | 1)) {
#pragma unroll
                for (int r = 0; r < 4; ++r) *(LAS unsigned short*)(L + SSD_BS + (16 * w + 4 * lq + r) * SSD_PITCH + (16 * sb + li) * 2) = (unsigned short)f2bf(cb[sb][r]); }
            LDS_WAIT(); asm volatile("" ::: "memory");
            f32x4 yd[4], yo[4];
#pragma unroll
            for (int pb = 0; pb < 4; ++pb) { yd[pb] = (f32x4){0.f, 0.f, 0.f, 0.f}; yo[pb] = (f32x4){0.f, 0.f, 0.f, 0.f}; }
#pragma unroll
            for (int ks = 0; ks < 4; ++ks) if (ks <= (w >> 1)) { const bf16x8 gf = lds_frag(L + SSD_BS, 16 * w + li, 64 * ks + 16 * lq);
#pragma unroll
                for (int pb = 0; pb < 4; ++pb) yd[pb] = __builtin_amdgcn_mfma_f32_16x16x32_bf16(gf, lds_frag(L + SSD_XDT, 16 * pb + li, 64 * ks + 16 * lq), yd[pb], 0, 0, 0); }
#pragma unroll
            for (int ks = 0; ks < 4; ++ks)
#pragma unroll
                for (int pb = 0; pb < 4; ++pb) yo[pb] = __builtin_amdgcn_mfma_f32_16x16x32_bf16(ca[ks], lds_frag(L + SSD_PREV, 16 * pb + li, 64 * ks + 16 * lq), yo[pb], 0, 0, 0);
#pragma unroll
            for (int r = 0; r < 4; ++r) { const float e = __expf(csl[r]);
#pragma unroll
                for (int pb = 0; pb < 4; ++pb) *(LAS float*)(L + SSD_BS + (16 * w + 4 * lq + r) * SSD_PITCH + (16 * pb + li) * 4) = yd[pb][r] + e * yo[pb][r]; }
            __syncthreads();
            { const float dec = __expf(cs_end);
#pragma unroll
              for (int j = 0; j < 4; ++j) st[j] = st[j] * dec;
#pragma unroll
              for (int ks = 0; ks < 4; ++ks) { const bf16x8 xf = lds_frag(L + SSD_XDT, 16 * pbs + li, 64 * ks + 16 * lq);
#pragma unroll
                  for (int j = 0; j < 4; ++j) st[j] = __builtin_amdgcn_mfma_f32_16x16x32_bf16(xf, lds_frag(L + SSD_BWT, 16 * (nb0 + j) + li, 64 * ks + 16 * lq), st[j], 0, 0, 0); }
#pragma unroll
              for (int j = 0; j < 4; ++j)
#pragma unroll
                  for (int r = 0; r < 4; ++r) *(LAS unsigned short*)(L + SSD_PREV + (16 * pbs + 4 * lq + r) * SSD_PITCH + (16 * (nb0 + j) + li) * 2) = (unsigned short)f2bf(st[j][r]); }
#pragma unroll
            for (int k = 0; k < 2; ++k) { const int it = tid + 512 * k, l = it >> 3, o = it & 7; const size_t row = row0 + l;
                const f32x4 y0 = *(const LAS f32x4*)(L + SSD_BS + l * SSD_PITCH + 32 * o), y1 = *(const LAS f32x4*)(L + SSD_BS + l * SSD_PITCH + 32 * o + 16);
                const v4u xw = *(const LAS v4u*)(L + SSD_XS + l * SSD_XPITCH + 16 * o); const v4u zw = *(const v4u*)(proj + row * NPROJ + h * 64 + 8 * o);
                float xv[8], zv[8], yv[8]; unpack8(xw, xv); unpack8(zw, zv);
                float ss = 0.f;
#pragma unroll
                for (int e = 0; e < 8; ++e) { const float yy = (e < 4 ? y0[e] : y1[e - 4]) + Dh * xv[e]; yv[e] = yy * silu_f(zv[e]); ss += yv[e] * yv[e]; }
                ss += __shfl_xor(ss, 1); ss += __shfl_xor(ss, 2); ss += __shfl_xor(ss, 4);
                if (o == 0) WSP(float, WS_STSSD)[row * 16 + h] = ss;
                *(v4u*)(WSP(bf16, WS_Y) + row * 2048 + h * 64 + 8 * o) = (v4u){pk2(yv[0], yv[1]), pk2(yv[2], yv[3]), pk2(yv[4], yv[5]), pk2(yv[6], yv[7])}; }
            __syncthreads();
        }
    }
}
__device__ __forceinline__ void p3pre_conv(Frame& F) {
    const int tid = threadIdx.x;
    const bf16* proj = WSP(bf16, WS_PROJ); bf16* xo = (bf16*)F.out;
    for (int item = F.vcu * NTHR + tid; item < (MTOK / 16) * 256; item += F.G * NTHR) {
        const int oc = item & 255, run = item >> 8; const int t0 = run * 16, ch = 8 * oc;
        const bool halo = (t0 & (SEQ - 1)) != 0;
        v4u rw[19];
#pragma unroll
        for (int k = 0; k < 19; ++k) { rw[k] = (v4u){0u, 0u, 0u, 0u}; if (k >= 3 || halo) rw[k] = *(const v4u*)(proj + (size_t)(t0 - 3 + k) * NPROJ + 1024 + ch); }
        float cw[4][8], cbv[8];
#pragma unroll
        for (int k = 0; k < 4; ++k) { const f32x4 w0 = *(const f32x4*)((F.a->in[6]) + k * 2048 + ch), w1 = *(const f32x4*)((F.a->in[6]) + k * 2048 + ch + 4);
#pragma unroll
            for (int e = 0; e < 4; ++e) { cw[k][e] = w0[e]; cw[k][4 + e] = w1[e]; } }
        { const f32x4 b0 = *(const f32x4*)((F.a->in[7]) + ch), b1 = *(const f32x4*)((F.a->in[7]) + ch + 4);
#pragma unroll
            for (int e = 0; e < 4; ++e) { cbv[e] = b0[e]; cbv[4 + e] = b1[e]; } }
        float r0[8], r1[8], r2[8];
        unpack8(rw[0], r0); unpack8(rw[1], r1); unpack8(rw[2], r2);
#pragma unroll
        for (int tt = 0; tt < 16; ++tt) {
            float r3[8]; unpack8(rw[3 + tt], r3);
            float v[8];
#pragma unroll
            for (int i = 0; i < 8; ++i) { v[i] = silu_f(cbv[i] + r0[i] * cw[0][i] + r1[i] * cw[1][i] + r2[i] * cw[2][i] + r3[i] * cw[3][i]); r0[i] = r1[i]; r1[i] = r2[i]; r2[i] = r3[i]; }
            *(v4u*)(xo + (size_t)(t0 + tt) * 2048 + ch) = (v4u){pk2(v[0], v[1]), pk2(v[2], v[3]), pk2(v[4], v[5]), pk2(v[6], v[7])};
        }
    }
}
struct SsdPre { v4u xr[4], br[4], cr[4]; float d0, d1; };
__device__ __forceinline__ void ssd_prefetch(SsdPre& P, const char* xcb, const float* dtr, unsigned voB, unsigned voX, int tid, int lane, int w) {
#pragma unroll
    for (int r = 0; r < 4; ++r) { P.br[r] = *(const v4u*)(xcb + (voB + r * 4096u)); P.cr[r] = *(const v4u*)(xcb + (voB + 1024u + r * 4096u)); }
    if (tid < 256) {
#pragma unroll
        for (int r = 0; r < 4; ++r) P.xr[r] = *(const v4u*)(xcb + (voX + r * 4096u)); }
    if (w == 0) { P.d0 = dtr[lane * 32]; P.d1 = dtr[lane * 32 + 16]; }
}
__device__ __forceinline__ void p3_ssd2(Frame& F) {
    const int tid = threadIdx.x, lane = tid & 63, w = __builtin_amdgcn_readfirstlane(tid >> 6);
    const int li = lane & 15, lq = lane >> 4;
    LAS unsigned char* L = F.lds;
    LAS float* csf = (LAS float*)(L + SSD_CSF); LAS float* dtf = (LAS float*)(L + SSD_DTF);
    const bf16* proj = WSP(bf16, WS_PROJ); const bf16* xc = (const bf16*)F.out; const float* dtraw = WSP(float, WS_DTRAW);
    for (int item = F.vcu; item < NB * NHEADS; item += F.G) {
        const int b = item >> 4, h = item & 15, g = h >> 2;
        const float A = -__expf((F.a->in[9])[h]), Dh = (F.a->in[10])[h], dtb = (F.a->in[8])[h];
        const int pbs = w >> 1, nb0 = 4 * (w & 1);
        f32x4 st[4];
#pragma unroll
        for (int j = 0; j < 4; ++j) st[j] = (f32x4){0.f, 0.f, 0.f, 0.f};
        __syncthreads();
        for (int i = tid; i < 17408 / 16; i += NTHR) ((LAS v4u*)(L + SSD_PREV))[i] = (v4u){0u, 0u, 0u, 0u};
        SsdPre P;
        const unsigned voB = (unsigned)((4 * (tid >> 4)) * 2048 + 1024 + g * 128 + 8 * (tid & 15)) * 2u, voX = (unsigned)((4 * (tid >> 3)) * 2048 + h * 64 + 8 * (tid & 7)) * 2u;
        const unsigned voZ0 = (unsigned)((tid >> 3) * NPROJ + h * 64 + 8 * (tid & 7)) * 2u, voZ1 = voZ0 + 64u * NPROJ * 2u;
        ssd_prefetch(P, (const char*)xc + (size_t)b * SEQ * 4096, dtraw + (size_t)b * SEQ * 16 + h, voB, voX, tid, lane, w);
        for (int c = 0; c < SEQ / CHUNK; ++c) {
            const size_t row0 = (size_t)b * SEQ + (size_t)c * CHUNK;
            if (w == 0) {
                const float d0 = softplus_f(P.d0 + dtb), d1 = softplus_f(P.d1 + dtb);
                const float a0 = d0 * A, a1 = d1 * A; float s = a0 + a1;
#pragma unroll
                for (int o = 1; o < 64; o <<= 1) { const float t = __shfl_up(s, o); if (lane >= o) s += t; }
                dtf[2 * lane] = d0; dtf[2 * lane + 1] = d1; csf[2 * lane] = s - a1; csf[2 * lane + 1] = s;
            }
            LDS_BARRIER();
            const float cs_end = csf[127];
            { const int ob = tid & 15, lb = 4 * (tid >> 4), n0 = 8 * ob;
#pragma unroll
              for (int r = 0; r < 4; ++r) { *(LAS v4u*)(L + SSD_BS + (lb + r) * SSD_PITCH + n0 * 2) = P.br[r]; *(LAS v4u*)(L + SSD_CS + (lb + r) * SSD_PITCH + n0 * 2) = P.cr[r]; }
              float bv[4][8];
#pragma unroll
              for (int r = 0; r < 4; ++r) { unpack8(P.br[r], bv[r]); const float tw = __expf(cs_end - csf[lb + r]);
#pragma unroll
                  for (int i = 0; i < 8; ++i) bv[r][i] *= tw; }
#pragma unroll
              for (int i = 0; i < 8; ++i) *(LAS v2u*)(L + SSD_BWT + (n0 + i) * SSD_PITCH + lb * 2) = (v2u){pk2(bv[0][i], bv[1][i]), pk2(bv[2][i], bv[3][i])}; }
            if (tid < 256) { const int ox = tid & 7, lx = 4 * (tid >> 3), p0 = 8 * ox; float xv[4][8];
#pragma unroll
              for (int r = 0; r < 4; ++r) { *(LAS v4u*)(L + SSD_XS + (lx + r) * SSD_XPITCH + p0 * 2) = P.xr[r]; unpack8(P.xr[r], xv[r]); const float tw = dtf[lx + r];
#pragma unroll
                  for (int i = 0; i < 8; ++i) xv[r][i] *= tw; }
#pragma unroll
              for (int i = 0; i < 8; ++i) *(LAS v2u*)(L + SSD_XDT + (p0 + i) * SSD_PITCH + lx * 2) = (v2u){pk2(xv[0][i], xv[1][i]), pk2(xv[2][i], xv[3][i])}; }
            const char* prb = (const char*)proj + row0 * (NPROJ * 2);
            const v4u zc0 = *(const v4u*)(prb + voZ0), zc1 = *(const v4u*)(prb + voZ1);
            if (c + 1 < SEQ / CHUNK) ssd_prefetch(P, (const char*)xc + (row0 + CHUNK) * 4096, dtraw + (row0 + CHUNK) * 16 + h, voB, voX, tid, lane, w);
            LDS_BARRIER();
            bf16x8 ca[4];
#pragma unroll
            for (int ks = 0; ks < 4; ++ks) ca[ks] = lds_frag(L + SSD_CS, 16 * w + li, 64 * ks + 16 * lq);
            f32x4 cb[8];
#pragma unroll
            for (int sb = 0; sb < 8; ++sb) { cb[sb] = (f32x4){0.f, 0.f, 0.f, 0.f};
                if (sb <= w) {
#pragma unroll
                    for (int ks = 0; ks < 4; ++ks) cb[sb] = __builtin_amdgcn_mfma_f32_16x16x32_bf16(ca[ks], lds_frag(L + SSD_BS, 16 * sb + li, 64 * ks + 16 * lq), cb[sb], 0, 0, 0); } }
            float csl[4];
#pragma unroll
            for (int r = 0; r < 4; ++r) csl[r] = csf[16 * w + 4 * lq + r];
#pragma unroll
            for (int sb = 0; sb < 8; ++sb) if (sb <= w) { const int s = 16 * sb + li; const float css = csf[s];
#pragma unroll
                for (int r = 0; r < 4; ++r) { const int l = 16 * w + 4 * lq + r; cb[sb][r] = (s <= l) ? cb[sb][r] * __expf(csl[r] - css) : 0.f; } }
            LDS_BARRIER();
#pragma unroll
            for (int sb = 0; sb < 8; ++sb) if (sb <= (w | 1)) {
#pragma unroll
                for (int r = 0; r < 4; ++r) *(LAS unsigned short*)(L + SSD_BS + (16 * w + 4 * lq + r) * SSD_PITCH + (16 * sb + li) * 2) = (unsigned short)f2bf(cb[sb][r]); }
            LDS_WAIT(); asm volatile("" ::: "memory");
            f32x4 yd[4], yo[4];
#pragma unroll
            for (int pb = 0; pb < 4; ++pb) { yd[pb] = (f32x4){0.f, 0.f, 0.f, 0.f}; yo[pb] = (f32x4){0.f, 0.f, 0.f, 0.f}; }
#pragma unroll
            for (int ks = 0; ks < 4; ++ks) if (ks <= (w >> 1)) { const bf16x8 gf = lds_frag(L + SSD_BS, 16 * w + li, 64 * ks + 16 * lq);
#pragma unroll
                for (int pb = 0; pb < 4; ++pb) yd[pb] = __builtin_amdgcn_mfma_f32_16x16x32_bf16(gf, lds_frag(L + SSD_XDT, 16 * pb + li, 64 * ks + 16 * lq), yd[pb], 0, 0, 0); }
#pragma unroll
            for (int ks = 0; ks < 4; ++ks)
#pragma unroll
                for (int pb = 0; pb < 4; ++pb) yo[pb] = __builtin_amdgcn_mfma_f32_16x16x32_bf16(ca[ks], lds_frag(L + SSD_PREV, 16 * pb + li, 64 * ks + 16 * lq), yo[pb], 0, 0, 0);
#pragma unroll
            for (int r = 0; r < 4; ++r) { const float e = __expf(csl[r]);
#pragma unroll
                for (int pb = 0; pb < 4; ++pb) *(LAS float*)(L + SSD_BS + (16 * w + 4 * lq + r) * SSD_PITCH + (16 * pb + li) * 4) = yd[pb][r] + e * yo[pb][r]; }
            LDS_BARRIER();
            { const float dec = __expf(cs_end);
#pragma unroll
              for (int j = 0; j < 4; ++j) st[j] = st[j] * dec;
#pragma unroll
              for (int ks = 0; ks < 4; ++ks) { const bf16x8 xf = lds_frag(L + SSD_XDT, 16 * pbs + li, 64 * ks + 16 * lq);
#pragma unroll
                  for (int j = 0; j < 4; ++j) st[j] = __builtin_amdgcn_mfma_f32_16x16x32_bf16(xf, lds_frag(L + SSD_BWT, 16 * (nb0 + j) + li, 64 * ks + 16 * lq), st[j], 0, 0, 0); }
#pragma unroll
              for (int j = 0; j < 4; ++j)
#pragma unroll
                  for (int r = 0; r < 4; ++r) *(LAS unsigned short*)(L + SSD_PREV + (16 * pbs + 4 * lq + r) * SSD_PITCH + (16 * (nb0 + j) + li) * 2) = (unsigned short)f2bf(st[j][r]); }
#pragma unroll
            for (int k = 0; k < 2; ++k) { const int it = tid + 512 * k, l = it >> 3, o = it & 7; const size_t row = row0 + l;
                const f32x4 y0 = *(const LAS f32x4*)(L + SSD_BS + l * SSD_PITCH + 32 * o), y1 = *(const LAS f32x4*)(L + SSD_BS + l * SSD_PITCH + 32 * o + 16);
                const v4u xw = *(const LAS v4u*)(L + SSD_XS + l * SSD_XPITCH + 16 * o); const v4u zw = k == 0 ? zc0 : zc1;
                float xv[8], zv[8], yv[8]; unpack8(xw, xv); unpack8(zw, zv);
                float ss = 0.f;
#pragma unroll
                for (int e = 0; e < 8; ++e) { const float yy = (e < 4 ? y0[e] : y1[e - 4]) + Dh * xv[e]; yv[e] = yy * silu_f(zv[e]); ss += yv[e] * yv[e]; }
                ss += __shfl_xor(ss, 1); ss += __shfl_xor(ss, 2); ss += __shfl_xor(ss, 4);
                if (o == 0) WSP(float, WS_STSSD)[row * 16 + h] = ss;
                *(v4u*)(WSP(bf16, WS_Y) + row * 2048 + h * 64 + 8 * o) = (v4u){pk2(yv[0], yv[1]), pk2(yv[2], yv[3]), pk2(yv[4], yv[5]), pk2(yv[6], yv[7])}; }
            LDS_BARRIER();
        }
    }
}
constexpr int S3_CS = 0, S3_BS = 34816, S3_GY = 69632, S3_XDT = 104448, S3_XP = 144, S3_PREV = 122880, S3_CSF = 140288, S3_DTF = 141312, S3_WTS = 142336, S3_END = 143360;
static_assert(S3_END <= LDS_MAIN, "SSD v3 LDS map");
typedef short v4i16_t __attribute__((ext_vector_type(4)));
__device__ __forceinline__ bf16x8 lds_frag_tr(LAS unsigned char* tile, int pitch, int k0, int col0, int li, int lq) {
    LAS unsigned char* p = tile + (k0 + 8 * lq + (li >> 2)) * pitch + (col0 + 4 * (li & 3)) * 2;
    const v4i16_t lo = __builtin_amdgcn_ds_read_tr16_b64_v4i16((LAS v4i16_t*)p), hi = __builtin_amdgcn_ds_read_tr16_b64_v4i16((LAS v4i16_t*)(p + 4 * pitch));
    return __builtin_shufflevector(lo, hi, 0, 1, 2, 3, 4, 5, 6, 7);
}
struct Ssd3Pre { v4u xr[4], br[4], cr[4]; float d0, d1; };
__device__ __forceinline__ void ssd3_prefetch(Ssd3Pre& P, const char* xcb, const float* dtr, unsigned voB, unsigned voX, int tid, int lane, int w) {
#pragma unroll
    for (int r = 0; r < 4; ++r) { P.br[r] = *(const v4u*)(xcb + (voB + r * 4096u)); P.cr[r] = *(const v4u*)(xcb + (voB + 1024u + r * 4096u)); }
    if (tid < 256) {
#pragma unroll
        for (int r = 0; r < 4; ++r) P.xr[r] = *(const v4u*)(xcb + (voX + r * 4096u)); }
    if (w == 0) { P.d0 = dtr[lane * 32]; P.d1 = dtr[lane * 32 + 16]; }
}
__device__ __forceinline__ void ssd3_cumsum(LAS unsigned char* L, int par, float r0, float r1, float dtb, float A, int lane) {
    LAS float* csf = (LAS float*)(L + S3_CSF + par * 512); LAS float* dtf = (LAS float*)(L + S3_DTF + par * 512); LAS float* wts = (LAS float*)(L + S3_WTS + par * 512);
    const float d0 = softplus_f(r0 + dtb), d1 = softplus_f(r1 + dtb);
    const float a0 = d0 * A, a1 = d1 * A; float s = a0 + a1;
#pragma unroll
    for (int o = 1; o < 64; o <<= 1) { const float t = __shfl_up(s, o); if (lane >= o) s += t; }
    const float tot = __shfl(s, 63);
    dtf[2 * lane] = d0; dtf[2 * lane + 1] = d1; csf[2 * lane] = s - a1; csf[2 * lane + 1] = s;
    wts[2 * lane] = __expf(tot - (s - a1)); wts[2 * lane + 1] = __expf(tot - s);
}
__device__ __forceinline__ void p3_ssd3(Frame& F) {
    const int tid0 = threadIdx.x, w = __builtin_amdgcn_readfirstlane(tid0 >> 6);
    LAS unsigned char* L = F.lds;
    const bf16* proj = WSP(bf16, WS_PROJ); const bf16* xc = (const bf16*)F.out; const float* dtraw = WSP(float, WS_DTRAW);
    for (int item = F.vcu; item < NB * NHEADS; item += F.G) {
        const int b = item >> 4, h = item & 15, g = h >> 2;
        int tid = tid0; asm volatile("" : "+v"(tid)); int lane = tid & 63;
        const float A = -__expf((F.a->in[9])[h]), Dh = (F.a->in[10])[h], dtb = (F.a->in[8])[h];
        const int pbs = w >> 1, nb0 = 4 * (w & 1);
        f32x4 st[4];
#pragma unroll
        for (int j = 0; j < 4; ++j) st[j] = (f32x4){0.f, 0.f, 0.f, 0.f};
        __syncthreads();
        for (int i = tid; i < 17408 / 16; i += NTHR) ((LAS v4u*)(L + S3_PREV))[i] = (v4u){0u, 0u, 0u, 0u};
        Ssd3Pre P;
        { const unsigned voB0 = (unsigned)((4 * (tid >> 4)) * 2048 + 1024 + g * 128 + 8 * (tid & 15)) * 2u, voX0 = (unsigned)((4 * (tid >> 3)) * 2048 + h * 64 + 8 * (tid & 7)) * 2u;
          ssd3_prefetch(P, (const char*)xc + (size_t)b * SEQ * 4096, dtraw + (size_t)b * SEQ * 16 + h, voB0, voX0, tid, lane, w); }
        if (w == 0) ssd3_cumsum(L, 0, P.d0, P.d1, dtb, A, lane);
        __syncthreads();
        for (int c = 0; c < SEQ / CHUNK; ++c) {
            const size_t row0 = (size_t)b * SEQ + (size_t)c * CHUNK; const int par = c & 1;
            asm volatile("" : "+v"(tid));
            lane = tid & 63; const int li = lane & 15, lq = lane >> 4;
            const unsigned voB = (unsigned)((4 * (tid >> 4)) * 2048 + 1024 + g * 128 + 8 * (tid & 15)) * 2u, voX = (unsigned)((4 * (tid >> 3)) * 2048 + h * 64 + 8 * (tid & 7)) * 2u;
            const unsigned voZ0 = (unsigned)((tid >> 3) * NPROJ + h * 64 + 8 * (tid & 7)) * 2u, voZ1 = voZ0 + 64u * NPROJ * 2u;
            LAS float* csf = (LAS float*)(L + S3_CSF + par * 512); LAS float* dtf = (LAS float*)(L + S3_DTF + par * 512); LAS float* wts = (LAS float*)(L + S3_WTS + par * 512);
            { const int ob = tid & 15, lb = 4 * (tid >> 4), n0 = 8 * ob;
#pragma unroll
              for (int r = 0; r < 4; ++r) { *(LAS v4u*)(L + S3_BS + (lb + r) * SSD_PITCH + n0 * 2) = P.br[r]; *(LAS v4u*)(L + S3_CS + (lb + r) * SSD_PITCH + n0 * 2) = P.cr[r]; } }
            if (tid < 256) { const int ox = tid & 7, lx = 4 * (tid >> 3), p0 = 8 * ox;
#pragma unroll
              for (int r = 0; r < 4; ++r) { float xv[8]; unpack8(P.xr[r], xv); const float tw = dtf[lx + r];
                  *(LAS v4u*)(L + S3_XDT + (lx + r) * S3_XP + p0 * 2) = (v4u){pk2(xv[0] * tw, xv[1] * tw), pk2(xv[2] * tw, xv[3] * tw), pk2(xv[4] * tw, xv[5] * tw), pk2(xv[6] * tw, xv[7] * tw)}; } }
            const char* prb = (const char*)proj + row0 * (NPROJ * 2);
            const v4u zc0 = *(const v4u*)(prb + voZ0), zc1 = *(const v4u*)(prb + voZ1);
            LDS_BARRIER();
            const float cs_end = csf[127];
            bf16x8 ca[4];
#pragma unroll
            for (int ks = 0; ks < 4; ++ks) ca[ks] = lds_frag(L + S3_CS, 16 * w + li, 64 * ks + 16 * lq);
            float csl[4];
#pragma unroll
            for (int r = 0; r < 4; ++r) csl[r] = csf[16 * w + 4 * lq + r];
            { bf16x8 bq[2][4];
#pragma unroll
              for (int ks = 0; ks < 4; ++ks) bq[0][ks] = lds_frag(L + S3_BS, li, 64 * ks + 16 * lq);
#pragma unroll
              for (int sb = 0; sb < 8; ++sb) if (sb <= (w | 1)) {
                  f32x4 cbv = (f32x4){0.f, 0.f, 0.f, 0.f};
                  const int s = 16 * sb + li; const float css = csf[s];
                  if (sb <= w) {
                      if (sb + 1 <= w) {
#pragma unroll
                          for (int ks = 0; ks < 4; ++ks) bq[(sb + 1) & 1][ks] = lds_frag(L + S3_BS, 16 * (sb + 1) + li, 64 * ks + 16 * lq); }
                      __builtin_amdgcn_sched_barrier(0);
#pragma unroll
                      for (int ks = 0; ks < 4; ++ks) cbv = __builtin_amdgcn_mfma_f32_16x16x32_bf16(ca[ks], bq[sb & 1][ks], cbv, 0, 0, 0);
                      __builtin_amdgcn_sched_barrier(0); }
#pragma unroll
                  for (int r = 0; r < 4; ++r) { const int l = 16 * w + 4 * lq + r; const float gv = (s <= l) ? cbv[r] * __expf(csl[r] - css) : 0.f;
                      *(LAS unsigned short*)(L + S3_GY + l * SSD_PITCH + s * 2) = (unsigned short)f2bf(gv); } } }
            LDS_WAIT(); asm volatile("" ::: "memory");
            f32x4 yd[4], yo[4];
#pragma unroll
            for (int pb = 0; pb < 4; ++pb) { yd[pb] = (f32x4){0.f, 0.f, 0.f, 0.f}; yo[pb] = (f32x4){0.f, 0.f, 0.f, 0.f}; }
            { bf16x8 gq[2], xq[2][4];
              gq[0] = lds_frag(L + S3_GY, 16 * w + li, 16 * lq);
#pragma unroll
              for (int pb = 0; pb < 4; ++pb) xq[0][pb] = lds_frag_tr(L + S3_XDT, S3_XP, 0, 16 * pb, li, lq);
#pragma unroll
              for (int ks = 0; ks < 4; ++ks) if (ks <= (w >> 1)) {
                  if (ks + 1 <= (w >> 1)) { gq[(ks + 1) & 1] = lds_frag(L + S3_GY, 16 * w + li, 64 * (ks + 1) + 16 * lq);
#pragma unroll
                      for (int pb = 0; pb < 4; ++pb) xq[(ks + 1) & 1][pb] = lds_frag_tr(L + S3_XDT, S3_XP, 32 * (ks + 1), 16 * pb, li, lq); }
                  __builtin_amdgcn_sched_barrier(0);
#pragma unroll
                  for (int pb = 0; pb < 4; ++pb) yd[pb] = __builtin_amdgcn_mfma_f32_16x16x32_bf16(gq[ks & 1], xq[ks & 1][pb], yd[pb], 0, 0, 0);
                  __builtin_amdgcn_sched_barrier(0); } }
            { bf16x8 pq[2][4];
#pragma unroll
              for (int pb = 0; pb < 4; ++pb) pq[0][pb] = lds_frag(L + S3_PREV, 16 * pb + li, 16 * lq);
#pragma unroll
              for (int ks = 0; ks < 4; ++ks) {
                  if (ks < 3) {
#pragma unroll
                      for (int pb = 0; pb < 4; ++pb) pq[(ks + 1) & 1][pb] = lds_frag(L + S3_PREV, 16 * pb + li, 64 * (ks + 1) + 16 * lq); }
                  __builtin_amdgcn_sched_barrier(0);
#pragma unroll
                  for (int pb = 0; pb < 4; ++pb) yo[pb] = __builtin_amdgcn_mfma_f32_16x16x32_bf16(ca[ks], pq[ks & 1][pb], yo[pb], 0, 0, 0);
                  __builtin_amdgcn_sched_barrier(0); } }
#pragma unroll
            for (int r = 0; r < 4; ++r) { const float e = __expf(csl[r]);
#pragma unroll
                for (int pb = 0; pb < 4; ++pb) *(LAS float*)(L + S3_GY + (16 * w + 4 * lq + r) * SSD_PITCH + (16 * pb + li) * 4) = yd[pb][r] + e * yo[pb][r]; }
            if (c + 1 < SEQ / CHUNK) { ssd3_prefetch(P, (const char*)xc + (row0 + CHUNK) * 4096, dtraw + (row0 + CHUNK) * 16 + h, voB, voX, tid, lane, w); }
            LDS_BARRIER();
            { const float dec = __expf(cs_end);
#pragma unroll
              for (int j = 0; j < 4; ++j) st[j] = st[j] * dec;
              bf16x8 xq[2], bq2[2][4]; f32x4 wq[2][2];
              xq[0] = lds_frag_tr(L + S3_XDT, S3_XP, 0, 16 * pbs, li, lq); wq[0][0] = *(const LAS f32x4*)(wts + 8 * lq); wq[0][1] = *(const LAS f32x4*)(wts + 8 * lq + 4);
#pragma unroll
              for (int j = 0; j < 4; ++j) bq2[0][j] = lds_frag_tr(L + S3_BS, SSD_PITCH, 0, 16 * (nb0 + j), li, lq);
#pragma unroll
              for (int ks = 0; ks < 4; ++ks) {
                  if (ks < 3) { xq[(ks + 1) & 1] = lds_frag_tr(L + S3_XDT, S3_XP, 32 * (ks + 1), 16 * pbs, li, lq); wq[(ks + 1) & 1][0] = *(const LAS f32x4*)(wts + 32 * (ks + 1) + 8 * lq); wq[(ks + 1) & 1][1] = *(const LAS f32x4*)(wts + 32 * (ks + 1) + 8 * lq + 4);
#pragma unroll
                      for (int j = 0; j < 4; ++j) bq2[(ks + 1) & 1][j] = lds_frag_tr(L + S3_BS, SSD_PITCH, 32 * (ks + 1), 16 * (nb0 + j), li, lq); }
                  __builtin_amdgcn_sched_barrier(0);
                  const f32x4 w0 = wq[ks & 1][0], w1 = wq[ks & 1][1];
                  float xv[8]; unpack8(__builtin_bit_cast(v4u, xq[ks & 1]), xv);
                  const v4u xw = (v4u){pk2(xv[0] * w0[0], xv[1] * w0[1]), pk2(xv[2] * w0[2], xv[3] * w0[3]), pk2(xv[4] * w1[0], xv[5] * w1[1]), pk2(xv[6] * w1[2], xv[7] * w1[3])};
                  const bf16x8 xf = __builtin_bit_cast(bf16x8, xw);
#pragma unroll
                  for (int j = 0; j < 4; ++j) st[j] = __builtin_amdgcn_mfma_f32_16x16x32_bf16(xf, bq2[ks & 1][j], st[j], 0, 0, 0);
                  __builtin_amdgcn_sched_barrier(0); }
#pragma unroll
              for (int j = 0; j < 4; ++j)
#pragma unroll
                  for (int r = 0; r < 4; ++r) *(LAS unsigned short*)(L + S3_PREV + (16 * pbs + 4 * lq + r) * SSD_PITCH + (16 * (nb0 + j) + li) * 2) = (unsigned short)f2bf(st[j][r]); }
#pragma unroll
            for (int k = 0; k < 2; ++k) { const int it = tid + 512 * k, l = it >> 3, o = it & 7; const size_t row = row0 + l;
                const f32x4 y0 = *(const LAS f32x4*)(L + S3_GY + l * SSD_PITCH + 32 * o), y1 = *(const LAS f32x4*)(L + S3_GY + l * SSD_PITCH + 32 * o + 16);
                const v4u xw = *(const LAS v4u*)(L + S3_XDT + l * S3_XP + 16 * o); const v4u zw = k == 0 ? zc0 : zc1; const float dsk = Dh * __builtin_amdgcn_rcpf(dtf[l]);
                float xv[8], zv[8], yv[8]; unpack8(xw, xv); unpack8(zw, zv);
                float ss = 0.f;
#pragma unroll
                for (int e = 0; e < 8; ++e) { const float yy = (e < 4 ? y0[e] : y1[e - 4]) + dsk * xv[e]; yv[e] = yy * silu_f(zv[e]); ss += yv[e] * yv[e]; }
                ss += __shfl_xor(ss, 1); ss += __shfl_xor(ss, 2); ss += __shfl_xor(ss, 4);
                if (o == 0) WSP(float, WS_STSSD)[row * 16 + h] = ss;
                *(v4u*)(WSP(bf16, WS_Y) + row * 2048 + h * 64 + 8 * o) = (v4u){pk2(yv[0], yv[1]), pk2(yv[2], yv[3]), pk2(yv[4], yv[5]), pk2(yv[6], yv[7])}; }
            if (w == 0 && c + 1 < SEQ / CHUNK) ssd3_cumsum(L, par ^ 1, P.d0, P.d1, dtb, A, lane);
            LDS_BARRIER();
        }
    }
}
constexpr int S5_XT = 0, S5_XPITCH = 2056, S5_BBT = 65792, S5_CC = S5_BBT + 16384, S5_CCPITCH = 272, S5_GLU = S5_CC + 64 * S5_CCPITCH, S5_VS = S5_GLU + 2048, S5_OT = S5_VS + 8 * 512, S5_OPITCH = 144, S5_END = S5_OT + 32 * S5_OPITCH;
static_assert(S5_END <= LDS_MAIN, "S5 LDS map");
typedef float f32x16 __attribute__((ext_vector_type(16)));
__device__ __forceinline__ void p3_s5(Frame& F) {
    const int tid = threadIdx.x, lane = tid & 63, w = __builtin_amdgcn_readfirstlane(tid >> 6);
    const int li = lane & 15, lq = lane >> 4;
    LAS unsigned char* L = F.lds;
    const bf16* proj = WSP(bf16, WS_PROJ);
    for (int item = F.vcu; item < NB * 16; item += F.G) {
        const int b = item >> 4, gs = item & 15;
        __syncthreads();
        { const int gl = tid >> 7, col = tid & 127, p = col >> 1, ri = col & 1; const float* src = WSP(float, WS_S5BB) + ((gs * 4 + gl) * 64 + p) * 32 + ri * 16;
          const f32x4 a0 = *(const f32x4*)src, a1 = *(const f32x4*)(src + 4), a2 = *(const f32x4*)(src + 8), a3 = *(const f32x4*)(src + 12);
          LAS v4u* d = (LAS v4u*)(L + S5_BBT + (gl * 128 + col) * 32);
          d[0] = (v4u){pk2(a0[0], a0[1]), pk2(a0[2], a0[3]), pk2(a1[0], a1[1]), pk2(a1[2], a1[3])}; d[1] = (v4u){pk2(a2[0], a2[1]), pk2(a2[2], a2[3]), pk2(a3[0], a3[1]), pk2(a3[2], a3[3])}; }
        { const int gl = tid >> 7, hh = (tid >> 3) & 15, kq = tid & 7; const int g = gs * 4 + gl; const float* cr = (F.a->in[17]) + (g * 16 + hh) * 64 + 8 * kq; const float* ci = (F.a->in[18]) + (g * 16 + hh) * 64 + 8 * kq;
          const f32x4 r0 = *(const f32x4*)cr, r1 = *(const f32x4*)(cr + 4), i0 = *(const f32x4*)ci, i1 = *(const f32x4*)(ci + 4);
          LAS v4u* d = (LAS v4u*)(L + S5_CC + (gl * 16 + hh) * S5_CCPITCH + kq * 32);
          d[0] = (v4u){pk2(r0[0], -i0[0]), pk2(r0[1], -i0[1]), pk2(r0[2], -i0[2]), pk2(r0[3], -i0[3])}; d[1] = (v4u){pk2(r1[0], -i1[0]), pk2(r1[1], -i1[1]), pk2(r1[2], -i1[2]), pk2(r1[3], -i1[3])}; }
        for (int i = tid; i < 1024; i += NTHR) { const int gl = i >> 8, k = (i >> 4) & 15, hh = i & 15; ((LAS unsigned short*)(L + S5_GLU))[i] = (unsigned short)f2bf((F.a->in[20])[((gs * 4 + gl) * 16 + hh) * 16 + k]); }
        const int gsc = gs * 4 + (w & 3);
        const float lbr = WSP(float, WS_S5LB)[(gsc * 64 + lane) * 2], lbi = WSP(float, WS_S5LB)[(gsc * 64 + lane) * 2 + 1];
        const int glo = w >> 1, mb = w & 1, go = gs * 4 + glo;
        const float dsk = (F.a->in[19])[go * 16 + li], gbias = (F.a->in[21])[go * 16 + li];
        float xr = 0.f, xi = 0.f;
        __syncthreads();
        const bf16* ubase = proj + (size_t)b * SEQ * NPROJ + 3072 + gs * 64;
        v4u ua = *(const v4u*)(ubase + (size_t)(lane & 31) * NPROJ + glo * 16 + 8 * (lane >> 5));
        for (int t0 = 0; t0 < SEQ; t0 += 32) {
            const bf16x8 af = __builtin_bit_cast(bf16x8, ua);
            if (t0 + 32 < SEQ) ua = *(const v4u*)(ubase + (size_t)(t0 + 32 + (lane & 31)) * NPROJ + glo * 16 + 8 * (lane >> 5));
            float uo[4];
#pragma unroll
            for (int r = 0; r < 4; ++r) uo[r] = bf2f(ubase[(size_t)(t0 + 16 * mb + 4 * lq + r) * NPROJ + glo * 16 + li]);
#pragma unroll
            for (int q = 0; q < 2; ++q) { const int cb = 2 * (w & 1) + q;
                const bf16x8 bfrag = *(const LAS bf16x8*)(L + S5_BBT + (glo * 128 + 32 * cb + (lane & 31)) * 32 + 16 * (lane >> 5));
                f32x16 acc;
#pragma unroll
                for (int r = 0; r < 16; ++r) acc[r] = 0.f;
                acc = __builtin_amdgcn_mfma_f32_32x32x16_bf16(af, bfrag, acc, 0, 0, 0);
#pragma unroll
                for (int r = 0; r < 16; ++r) { const int t = (r & 3) + 8 * (r >> 2) + 4 * (lane >> 5); *(LAS float*)(L + S5_XT + t * S5_XPITCH + (glo * 128 + 32 * cb + (lane & 31)) * 4) = acc[r]; } }
            __syncthreads();
            if (w < 4) { LAS f32x2* xp = (LAS f32x2*)(L + S5_XT + (w * 128 + 2 * lane) * 4);
#pragma unroll 8
                for (int t = 0; t < 32; ++t) { const f32x2 bu = xp[t * (S5_XPITCH / 8)]; const float nr = lbr * xr - lbi * xi + bu[0], ni = lbr * xi + lbi * xr + bu[1]; xr = nr; xi = ni; xp[t * (S5_XPITCH / 8)] = (f32x2){xr, xi}; } }
            __syncthreads();
            f32x4 yacc = (f32x4){0.f, 0.f, 0.f, 0.f};
#pragma unroll
            for (int ks = 0; ks < 4; ++ks) { const LAS float* xs = (const LAS float*)(L + S5_XT + (16 * mb + li) * S5_XPITCH + (glo * 128 + 32 * ks + 8 * lq) * 4);
                const f32x4 x0 = *(const LAS f32x4*)xs, x1 = *(const LAS f32x4*)(xs + 4);
                const v4u xa = (v4u){pk2(x0[0], x0[1]), pk2(x0[2], x0[3]), pk2(x1[0], x1[1]), pk2(x1[2], x1[3])};
                const bf16x8 cf = *(const LAS bf16x8*)(L + S5_CC + (glo * 16 + li) * S5_CCPITCH + 64 * ks + 16 * lq);
                yacc = __builtin_amdgcn_mfma_f32_16x16x32_bf16(__builtin_bit_cast(bf16x8, xa), cf, yacc, 0, 0, 0); }
            float v[4];
#pragma unroll
            for (int r = 0; r < 4; ++r) v[r] = gelu_erf(yacc[r] + dsk * uo[r]);
            LAS unsigned char* vs = L + S5_VS + w * 512;
#pragma unroll
            for (int r = 0; r < 4; ++r) *(LAS unsigned short*)(vs + (4 * lq + r) * 32 + li * 2) = (unsigned short)f2bf(v[r]);
            LDS_WAIT(); asm volatile("" ::: "memory");
            v4u va = (v4u){0u, 0u, 0u, 0u}, gw = (v4u){0u, 0u, 0u, 0u};
            if (lq < 2) { va = *(const LAS v4u*)(vs + li * 32 + 16 * lq); gw = *(const LAS v4u*)(L + S5_GLU + ((glo * 16 + li) * 16 + 8 * lq) * 2); }
            f32x4 gacc = (f32x4){0.f, 0.f, 0.f, 0.f};
            gacc = __builtin_amdgcn_mfma_f32_16x16x32_bf16(__builtin_bit_cast(bf16x8, va), __builtin_bit_cast(bf16x8, gw), gacc, 0, 0, 0);
            float o[4], ss[4];
#pragma unroll
            for (int r = 0; r < 4; ++r) { o[r] = v[r] * sigmoid_f(gacc[r] + gbias); ss[r] = o[r] * o[r]; }
#pragma unroll
            for (int r = 0; r < 4; ++r) { ss[r] += __shfl_xor(ss[r], 1); ss[r] += __shfl_xor(ss[r], 2); ss[r] += __shfl_xor(ss[r], 4); ss[r] += __shfl_xor(ss[r], 8); }
            if (li == 0) {
#pragma unroll
                for (int r = 0; r < 4; ++r) WSP(float, WS_STS5)[((size_t)b * SEQ + t0 + 16 * mb + 4 * lq + r) * NS5PART + go] = ss[r]; }
#pragma unroll
            for (int r = 0; r < 4; ++r) *(LAS unsigned short*)(L + S5_OT + (16 * mb + 4 * lq + r) * S5_OPITCH + (glo * 16 + li) * 2) = (unsigned short)f2bf(o[r]);
            __syncthreads();
            if (tid < 256) { const int t = tid >> 3, oc = tid & 7; const v4u ov = *(const LAS v4u*)(L + S5_OT + t * S5_OPITCH + 16 * oc);
                *(v4u*)(WSP(bf16, WS_Y) + ((size_t)b * SEQ + t0 + t) * 2048 + 1024 + gs * 64 + 8 * oc) = ov; }
        }
    }
}
constexpr int S5V_BU = 0, S5V_BUP = 2056, S5V_BUSZ = 16 * S5V_BUP, S5V_XT = 2 * S5V_BUSZ, S5V_XTP = 1040, S5V_XTSZ = 16 * S5V_XTP, S5V_VS = S5V_XT + 2 * S5V_XTSZ, S5V_OT = S5V_VS + 4 * 512, S5V_OTP = 144, S5V_OTSZ = 16 * S5V_OTP, S5V_END = S5V_OT + 2 * S5V_OTSZ;
static_assert(S5V_END <= LDS_MAIN, "S5 v2 LDS map");
__device__ __forceinline__ void p3_s5v2(Frame& F) {
    const int tid = threadIdx.x, lane = tid & 63, w = __builtin_amdgcn_readfirstlane(tid >> 6);
    const int li = lane & 15, lq = lane >> 4;
    LAS unsigned char* L = F.lds;
    const bf16* proj = WSP(bf16, WS_PROJ);
    constexpr int NT = SEQ / 16;
    for (int item = F.vcu; item < NB * 16; item += F.G) {
        const int b = item >> 4, gs = item & 15;
        const bool scanw = w < 4; const int gl = w & 3, g = gs * 4 + gl;
        const bf16* ubase = proj + (size_t)b * SEQ * NPROJ + 3072 + gs * 64 + gl * 16;
        __syncthreads();
        if (scanw) {
            const float lbr = WSP(float, WS_S5LB)[(g * 64 + lane) * 2], lbi = WSP(float, WS_S5LB)[(g * 64 + lane) * 2 + 1];
            bf16x8 bfr[8];
#pragma unroll
            for (int cb = 0; cb < 8; ++cb) { v4u v = (v4u){0u, 0u, 0u, 0u};
                if (lq < 2) { const int col = 16 * cb + li; const float* src = WSP(float, WS_S5BB) + (g * 64 + (col >> 1)) * 32 + (col & 1) * 16 + 8 * lq; const f32x4 a0 = *(const f32x4*)src, a1 = *(const f32x4*)(src + 4);
                    v = (v4u){pk2(a0[0], a0[1]), pk2(a0[2], a0[3]), pk2(a1[0], a1[1]), pk2(a1[2], a1[3])}; }
                bfr[cb] = __builtin_bit_cast(bf16x8, v); }
            float xr = 0.f, xi = 0.f;
            v4u ua = (v4u){0u, 0u, 0u, 0u};
            if (lq < 2) ua = *(const v4u*)(ubase + (size_t)li * NPROJ + 8 * lq);
            { const bf16x8 af = __builtin_bit_cast(bf16x8, ua);
              if (lq < 2) ua = *(const v4u*)(ubase + (size_t)(16 + li) * NPROJ + 8 * lq);
#pragma unroll
              for (int cb = 0; cb < 8; ++cb) { f32x4 acc = (f32x4){0.f, 0.f, 0.f, 0.f}; acc = __builtin_amdgcn_mfma_f32_16x16x32_bf16(af, bfr[cb], acc, 0, 0, 0);
#pragma unroll
                  for (int r = 0; r < 4; ++r) *(LAS float*)(L + S5V_BU + (4 * lq + r) * S5V_BUP + (gl * 128 + 16 * cb + li) * 4) = acc[r]; } }
            LDS_BARRIER();
            for (int k = 0; k <= NT; ++k) {
                if (k < NT) {
                    const LAS f32x2* bp = (const LAS f32x2*)(L + S5V_BU + (k & 1) * S5V_BUSZ + (gl * 128 + 2 * lane) * 4);
                    LAS unsigned* xp = (LAS unsigned*)(L + S5V_XT + (k & 1) * S5V_XTSZ + (gl * 128 + 2 * lane) * 2);
                    f32x2 bu[16];
#pragma unroll
                    for (int t = 0; t < 16; ++t) bu[t] = bp[t * (S5V_BUP / 8)];
                    unsigned xo[16];
#pragma unroll
                    for (int t = 0; t < 16; ++t) { const float nr = lbr * xr + (bu[t][0] - lbi * xi), ni = lbr * xi + (lbi * xr + bu[t][1]); xr = nr; xi = ni; xo[t] = pk2(xr, xi); }
#pragma unroll
                    for (int t = 0; t < 16; ++t) xp[t * (S5V_XTP / 4)] = xo[t];
                    if (k + 1 < NT) {
                        const bf16x8 af = __builtin_bit_cast(bf16x8, ua);
                        if (lq < 2 && k + 2 < NT) ua = *(const v4u*)(ubase + (size_t)(16 * (k + 2) + li) * NPROJ + 8 * lq);
                        LAS unsigned char* bun = L + S5V_BU + ((k + 1) & 1) * S5V_BUSZ;
#pragma unroll
                        for (int cb = 0; cb < 8; ++cb) { f32x4 acc = (f32x4){0.f, 0.f, 0.f, 0.f}; acc = __builtin_amdgcn_mfma_f32_16x16x32_bf16(af, bfr[cb], acc, 0, 0, 0);
#pragma unroll
                            for (int r = 0; r < 4; ++r) *(LAS float*)(bun + (4 * lq + r) * S5V_BUP + (gl * 128 + 16 * cb + li) * 4) = acc[r]; }
                    }
                }
                LDS_BARRIER();
            }
        } else {
            bf16x8 cfr[4];
#pragma unroll
            for (int ks = 0; ks < 4; ++ks) { const float* cr = (F.a->in[17]) + (g * 16 + li) * 64 + 16 * ks + 4 * lq; const float* ci = (F.a->in[18]) + (g * 16 + li) * 64 + 16 * ks + 4 * lq;
                const f32x4 r0 = *(const f32x4*)cr, i0 = *(const f32x4*)ci;
                cfr[ks] = __builtin_bit_cast(bf16x8, ((v4u){pk2(r0[0], -i0[0]), pk2(r0[1], -i0[1]), pk2(r0[2], -i0[2]), pk2(r0[3], -i0[3])})); }
            v4u gwv = (v4u){0u, 0u, 0u, 0u};
            if (lq < 2) { float gwf[8];
#pragma unroll
                for (int j = 0; j < 8; ++j) gwf[j] = (F.a->in[20])[(g * 16 + 8 * lq + j) * 16 + li];
                gwv = (v4u){pk2(gwf[0], gwf[1]), pk2(gwf[2], gwf[3]), pk2(gwf[4], gwf[5]), pk2(gwf[6], gwf[7])}; }
            const bf16x8 gfr = __builtin_bit_cast(bf16x8, gwv);
            const float dsk = (F.a->in[19])[g * 16 + li], gbias = (F.a->in[21])[g * 16 + li];
            LAS unsigned char* vs = L + S5V_VS + gl * 512;
            float uo[4];
#pragma unroll
            for (int r = 0; r < 4; ++r) uo[r] = bf2f(ubase[(size_t)(4 * lq + r) * NPROJ + li]);
            LDS_BARRIER();
            for (int k = 0; k <= NT; ++k) {
                if (k >= 2) {
                    const int t = ((tid - 256) >> 3) & 15, oc = tid & 7; const v4u ov = *(const LAS v4u*)(L + S5V_OT + (k & 1) * S5V_OTSZ + t * S5V_OTP + 16 * oc);
                    if (tid < 384) *(v4u*)(WSP(bf16, WS_Y) + ((size_t)b * SEQ + 16 * (k - 2) + t) * 2048 + 1024 + gs * 64 + 8 * oc) = ov; }
                if (k >= 1) {
                    const int kt = k - 1; const LAS unsigned char* xt = L + S5V_XT + (kt & 1) * S5V_XTSZ;
                    float un[4];
                    if (k < NT) {
#pragma unroll
                        for (int r = 0; r < 4; ++r) un[r] = bf2f(ubase[(size_t)(16 * k + 4 * lq + r) * NPROJ + li]); }
                    f32x4 yacc = (f32x4){0.f, 0.f, 0.f, 0.f};
#pragma unroll
                    for (int ks = 0; ks < 4; ++ks) yacc = __builtin_amdgcn_mfma_f32_16x16x32_bf16(*(const LAS bf16x8*)(xt + li * S5V_XTP + (gl * 128 + 32 * ks + 8 * lq) * 2), cfr[ks], yacc, 0, 0, 0);
                    float v[4];
                    { const f32x2 g0 = gelu_pk2((f32x2){yacc[0] + dsk * uo[0], yacc[1] + dsk * uo[1]}), g1 = gelu_pk2((f32x2){yacc[2] + dsk * uo[2], yacc[3] + dsk * uo[3]}); v[0] = g0[0]; v[1] = g0[1]; v[2] = g1[0]; v[3] = g1[1]; }
#pragma unroll
                    for (int r = 0; r < 4; ++r) *(LAS unsigned short*)(vs + (4 * lq + r) * 32 + li * 2) = (unsigned short)f2bf(v[r]);
                    LDS_WAIT(); asm volatile("" ::: "memory");
                    v4u va = (v4u){0u, 0u, 0u, 0u};
                    if (lq < 2) va = *(const LAS v4u*)(vs + li * 32 + 16 * lq);
                    f32x4 gacc = (f32x4){0.f, 0.f, 0.f, 0.f};
                    gacc = __builtin_amdgcn_mfma_f32_16x16x32_bf16(__builtin_bit_cast(bf16x8, va), gfr, gacc, 0, 0, 0);
                    float o[4], ss[4];
#pragma unroll
                    for (int r = 0; r < 4; ++r) { o[r] = v[r] * sigmoid_f(gacc[r] + gbias); ss[r] = o[r] * o[r]; }
#pragma unroll
                    for (int r = 0; r < 4; ++r) ss[r] = row16_sum_to15(ss[r]);
                    if (li == 15) {
#pragma unroll
                        for (int r = 0; r < 4; ++r) WSP(float, WS_STS5)[((size_t)b * SEQ + 16 * kt + 4 * lq + r) * NS5PART + g] = ss[r]; }
                    LAS unsigned char* ot = L + S5V_OT + (kt & 1) * S5V_OTSZ;
#pragma unroll
                    for (int r = 0; r < 4; ++r) *(LAS unsigned short*)(ot + (4 * lq + r) * S5V_OTP + (gl * 16 + li) * 2) = (unsigned short)f2bf(o[r]);
                    if (k < NT) {
#pragma unroll
                        for (int r = 0; r < 4; ++r) uo[r] = un[r]; }
                }
                LDS_BARRIER();
            }
            { const int t = ((tid - 256) >> 3) & 15, oc = tid & 7; const v4u ov = *(const LAS v4u*)(L + S5V_OT + ((NT - 1) & 1) * S5V_OTSZ + t * S5V_OTP + 16 * oc);
              if (tid < 384) *(v4u*)(WSP(bf16, WS_Y) + ((size_t)b * SEQ + 16 * (NT - 1) + t) * 2048 + 1024 + gs * 64 + 8 * oc) = ov; }
        }
    }
}
__device__ __forceinline__ unsigned med3u(unsigned a, unsigned b, unsigned c) { unsigned r; asm("v_med3_u32 %0, %1, %2, %3" : "=v"(r) : "v"(a), "v"(b), "v"(c)); return r; }
__device__ __forceinline__ unsigned fkey(float v) { const unsigned u = __builtin_bit_cast(unsigned, v); return (u & 0x80000000u) ? ~u : (u | 0x80000000u); }
__device__ __forceinline__ float fkey_inv(unsigned k) { const unsigned u = (k & 0x80000000u) ? (k & 0x7fffffffu) : ~k; return __builtin_bit_cast(float, u); }
#define TOPK_INSERT(a, x) do { _Pragma("unroll") for (int _i = 15; _i >= 1; --_i) a[_i] = med3u(a[_i - 1], a[_i], (x)); a[0] = a[0] > (x) ? a[0] : (x); } while (0)
__device__ __forceinline__ void expert_convert(Frame& F, int w0, int nw, int f_lane) {
    for (int rw = w0; rw < 2 * 16384; rw += 2 * nw) {
        f32x4 v[2][4]; float mx[2];
#pragma unroll
        for (int u = 0; u < 2; ++u) { const int r = rw + u * nw; const int tb = r >= 16384, e = tb ? r - 16384 : r; const float* src = (tb ? (F.a->in[28]) : (F.a->in[27])) + (size_t)e * 1024 + 16 * f_lane;
#pragma unroll
            for (int q = 0; q < 4; ++q) v[u][q] = *(const f32x4*)(src + 4 * q); }
#pragma unroll
        for (int u = 0; u < 2; ++u) { float m = 0.f;
#pragma unroll
            for (int q = 0; q < 4; ++q) m = fmaxf(m, fmaxf(fmaxf(fabsf(v[u][q][0]), fabsf(v[u][q][1])), fmaxf(fabsf(v[u][q][2]), fabsf(v[u][q][3]))));
#pragma unroll
            for (int o = 1; o < 64; o <<= 1) m = fmaxf(m, __shfl_xor(m, o));
            mx[u] = fmaxf(m, 1e-30f); }
#pragma unroll
        for (int u = 0; u < 2; ++u) { const int r = rw + u * nw; const int tb = r >= 16384, e = tb ? r - 16384 : r; const float sc = 224.0f / mx[u];
            v4u w;
#pragma unroll
            for (int q = 0; q < 4; ++q) { int pk = 0; pk = __builtin_amdgcn_cvt_pk_fp8_f32(v[u][q][0] * sc, v[u][q][1] * sc, pk, false); pk = __builtin_amdgcn_cvt_pk_fp8_f32(v[u][q][2] * sc, v[u][q][3] * sc, pk, true); w[q] = (unsigned)pk; }
            *(v4u*)(F.ws + (tb ? WS_EV : WS_EU) + (size_t)e * 1024 + 16 * f_lane) = w;
            if (f_lane == 0) WSP(float, tb ? WS_EVS : WS_EUS)[e] = mx[u] * (1.0f / 224.0f); }
    }
}
__device__ __forceinline__ void p5b_topk(Frame& F) {
    const int f_tid = threadIdx.x, f_lane = f_tid & 63, f_wave = __builtin_amdgcn_readfirstlane(f_tid >> 6);
    const _Float16* scores = WSP(_Float16, WS_SCORES);
    LAS unsigned char* ix = (LAS unsigned char*)F.lds + f_tid * 36;
#pragma unroll 1
    for (int half = 0; half < 2; ++half) {
    if ((f_wave >> 2) != half) { expert_convert(F, (F.vcu * 4 + (f_wave & 3)) * 2 + half, F.G * 8, f_lane); continue; }
    for (int item = (F.vcu * 2 + half) * 256 + (f_tid & 255); item < MTOK * PH; item += F.G * 512) {
        const int t = item >> 3, hd = item & 7;
        unsigned a1[16], a2[16];
#pragma unroll
        for (int i = 0; i < 16; ++i) { a1[i] = 0u; a2[i] = 0u; }
        const _Float16* sp = scores + (size_t)t * 2048 + hd * 256;
        typedef _Float16 f16x8 __attribute__((ext_vector_type(8)));
#pragma unroll 1
        for (int m = 0; m < 2; ++m) { f16x8 sv[8];
#pragma unroll
            for (int q = 0; q < 8; ++q) sv[q] = *(const f16x8*)(sp + 64 * m + 8 * q);
#pragma unroll
            for (int q = 0; q < 8; ++q)
#pragma unroll
                for (int e = 0; e < 8; ++e) { const unsigned k = (fkey((float)sv[q][e]) & ~127u) | (unsigned)(127 - (64 * m + 8 * q + e)); TOPK_INSERT(a1, k); } }
#pragma unroll 1
        for (int m = 0; m < 2; ++m) { f16x8 sv[8];
#pragma unroll
            for (int q = 0; q < 8; ++q) sv[q] = *(const f16x8*)(sp + 128 + 64 * m + 8 * q);
#pragma unroll
            for (int q = 0; q < 8; ++q)
#pragma unroll
                for (int e = 0; e < 8; ++e) { const unsigned k = (fkey((float)sv[q][e]) & ~127u) | (unsigned)(127 - (64 * m + 8 * q + e)); TOPK_INSERT(a2, k); } }
        float v1[16], v2[16];
#pragma unroll
        for (int i = 0; i < 16; ++i) { ix[i] = (unsigned char)(127u - (a1[i] & 127u)); ix[16 + i] = (unsigned char)(127u - (a2[i] & 127u)); v1[i] = fkey_inv(a1[i] & ~127u); v2[i] = fkey_inv(a2[i] & ~127u); }
        unsigned cb[16];
#pragma unroll
        for (int i = 0; i < 16; ++i) cb[i] = 0u;
#pragma unroll
        for (int i = 0; i < 16; ++i)
#pragma unroll
            for (int j = 0; j < 16; ++j) if ((i + 1) * (j + 1) <= 16) { const unsigned k = (fkey(v1[i] + v2[j]) & ~255u) | (unsigned)(255 - (i * 16 + j)); TOPK_INSERT(cb, k); }
        float tv[16]; float mx = -3.0e38f;
#pragma unroll
        for (int k = 0; k < 16; ++k) { tv[k] = fkey_inv(cb[k] & ~255u); mx = fmaxf(mx, tv[k]); }
        float sum = 0.f;
#pragma unroll
        for (int k = 0; k < 16; ++k) { tv[k] = __expf(tv[k] - mx); sum += tv[k]; }
        const float inv = 1.0f / sum;
        LDS_WAIT(); asm volatile("" ::: "memory");
        int ev[16]; unsigned long long c64 = 0ull;
#pragma unroll
        for (int k = 0; k < 16; ++k) { const unsigned code = 255u - (cb[k] & 255u); const int i = code >> 4, j = code & 15; ev[k] = (int)ix[i] * 128 + (int)ix[16 + j]; c64 += 1ull << (8 * (ev[k] >> 11)); }
        unsigned long long s64 = c64;
#pragma unroll
        for (int o = 1; o < 8; o <<= 1) { const unsigned lo = __shfl_up((unsigned)s64, o, 8), hi = __shfl_up((unsigned)(s64 >> 32), o, 8); if ((f_lane & 7) >= o) s64 += ((unsigned long long)hi << 32) | lo; }
        const unsigned long long e64 = s64 - c64;
        const unsigned long long t64 = ((unsigned long long)__shfl((unsigned)(s64 >> 32), 7, 8) << 32) | __shfl((unsigned)s64, 7, 8);
        const unsigned long long st64 = (t64 * 0x0101010101010101ull) << 8;
        unsigned long long base64 = st64 + e64;
        int* eo = WSP(int, WS_EID) + (size_t)t * 128; float* go = WSP(float, WS_GATE) + (size_t)t * 128;
#pragma unroll
        for (int k = 0; k < 16; ++k) { const int r8 = 8 * (ev[k] >> 11); const int slot = (int)((base64 >> r8) & 255ull); base64 += 1ull << r8; eo[slot] = ev[k]; go[slot] = tv[k] * inv; }
        if (hd == 0) WSP(unsigned long long, WS_START)[t] = st64;
        LDS_WAIT(); asm volatile("" ::: "memory");
    }
    }
}
__device__ __forceinline__ void dec16(const v4u q, float* f) {
#pragma unroll
    for (int i = 0; i < 4; ++i) { const f32x2 lo = __builtin_amdgcn_cvt_pk_f32_fp8((int)q[i], false), hi = __builtin_amdgcn_cvt_pk_f32_fp8((int)q[i], true); f[4 * i] = lo[0]; f[4 * i + 1] = lo[1]; f[4 * i + 2] = hi[0]; f[4 * i + 3] = hi[1]; }
}
__device__ __forceinline__ void p8_peer_up(Frame& F) {
    const int f_tid = threadIdx.x, lane = f_tid & 63, f_wave = __builtin_amdgcn_readfirstlane(f_tid >> 6);
    const int rr = blockIdx.x & 7, wk = (blockIdx.x >> 3) * NWAVES + f_wave, nwk = (F.G >> 3) * NWAVES;
    const unsigned char* EU = F.ws + WS_EU;
    for (int blk = wk; blk < MTOK / 128; blk += nwk) {
        const int b = blk >> 4; const float* mb = WSP(float, WS_MOD) + (size_t)b * 6144;
        float S2[16];
#pragma unroll
        for (int q = 0; q < 4; ++q) { const f32x4 sh = *(const f32x4*)(mb + 3072 + 16 * lane + 4 * q); S2[4 * q] = sh[0]; S2[4 * q + 1] = sh[1]; S2[4 * q + 2] = sh[2]; S2[4 * q + 3] = sh[3]; }
        for (int tt = 0; tt < 128; ++tt) {
            const size_t t = (size_t)blk * 128 + tt;
            const unsigned long long st64 = WSP(unsigned long long, WS_START)[t];
            const int s0 = (int)((st64 >> (8 * rr)) & 255ull), s1 = rr == 7 ? 128 : (int)((st64 >> (8 * rr + 8)) & 255ull), cnt = s1 - s0;
            if (cnt <= 0) continue;
            const float rs = rsqrt_f(WSP(float, WS_ROWSTAT)[t] * (1.0f / 1024.0f) + EPSF);
            const bf16* xr = WSP(bf16, WS_X1S) + t * 1024 + 16 * lane; const v4u xa = *(const v4u*)xr, xb = *(const v4u*)(xr + 8);
            float h2[16]; unpack8(xa, h2); unpack8(xb, h2 + 8);
#pragma unroll
            for (int i = 0; i < 16; ++i) h2[i] = h2[i] * rs + S2[i];
            int* ep = WSP(int, WS_EID) + t * 128 + s0; float* gp = WSP(float, WS_GATE) + t * 128 + s0;
            for (int j0 = 0; j0 < cnt; j0 += 8) {
                const int myi = j0 + (lane & 7) < cnt ? j0 + (lane & 7) : cnt - 1;
                const int emine = ep[myi]; const float gmine = gp[myi];
                v4u q[8];
#pragma unroll
                for (int j = 0; j < 8; ++j) { const int e = __shfl(emine, j); q[j] = *(const v4u*)(EU + (size_t)e * 1024 + 16 * lane); }
                float d[8];
#pragma unroll
                for (int j = 0; j < 8; ++j) { float f[16]; dec16(q[j], f); float a = 0.f;
#pragma unroll
                    for (int i = 0; i < 16; ++i) a += h2[i] * f[i];
                    d[j] = a; }
                float e4[4], e2[2], e1;
#pragma unroll
                for (int i = 0; i < 4; ++i) { const bool up = lane & 32; const float snd = up ? d[i] : d[i + 4]; const float rcv = __shfl_xor(snd, 32); e4[i] = (up ? d[i + 4] : d[i]) + rcv; }
#pragma unroll
                for (int i = 0; i < 2; ++i) { const bool up = lane & 16; const float snd = up ? e4[i] : e4[i + 2]; const float rcv = __shfl_xor(snd, 16); e2[i] = (up ? e4[i + 2] : e4[i]) + rcv; }
                { const bool up = lane & 8; const float snd = up ? e2[0] : e2[1]; const float rcv = __shfl_xor(snd, 8); e1 = (up ? e2[1] : e2[0]) + rcv; }
                e1 += __shfl_xor(e1, 4); e1 += __shfl_xor(e1, 2); e1 += __shfl_xor(e1, 1);
                const int myj = ((lane >> 5) & 1) * 4 + ((lane >> 4) & 1) * 2 + ((lane >> 3) & 1);
                const int ej = __shfl(emine, myj); const float gj = __shfl(gmine, myj);
                const float wv = gj * gelu_erf(e1 * WSP(float, WS_EUS)[ej]) * WSP(float, WS_EVS)[ej];
                if ((lane & 7) == 0 && j0 + myj < cnt) gp[j0 + myj] = wv;
            }
        }
    }
}
__device__ __forceinline__ void p9_peer_down(Frame& F, float* dst) {
    const int f_tid = threadIdx.x, lane = f_tid & 63, f_wave = __builtin_amdgcn_readfirstlane(f_tid >> 6);
    const unsigned char* EV = F.ws + WS_EV;
    for (int wq = F.vcu * NWAVES + f_wave; wq < MTOK / 16; wq += F.G * NWAVES) {
        const int b = wq >> 7; const float* mb = WSP(float, WS_MOD) + (size_t)b * 6144;
        float GT[16], NF[16];
#pragma unroll
        for (int q = 0; q < 4; ++q) { const f32x4 gt = *(const f32x4*)(mb + 5120 + 16 * lane + 4 * q), nf = *(const f32x4*)((F.a->in[29]) + 16 * lane + 4 * q);
#pragma unroll
            for (int e = 0; e < 4; ++e) { GT[4 * q + e] = gt[e]; NF[4 * q + e] = nf[e]; } }
        for (int tt = 0; tt < 16; ++tt) {
            const size_t t = (size_t)wq * 16 + tt; float* xr = F.out + t * 1024 + 16 * lane;
            const int e_lo = WSP(int, WS_EID)[t * 128 + lane], e_hi = WSP(int, WS_EID)[t * 128 + 64 + lane];
            const float w_lo = WSP(float, WS_GATE)[t * 128 + lane], w_hi = WSP(float, WS_GATE)[t * 128 + 64 + lane];
            f32x2 o[8];
#pragma unroll
            for (int i = 0; i < 8; ++i) o[i] = (f32x2){0.f, 0.f};
            for (int grp = 0; grp < 16; ++grp) {
                const int esel = grp < 8 ? e_lo : e_hi; const float wsel = grp < 8 ? w_lo : w_hi; const int base = (grp & 7) * 8;
                v4u q[8];
#pragma unroll
                for (int j = 0; j < 8; ++j) { const int e = __shfl(esel, base + j); q[j] = *(const v4u*)(EV + (size_t)e * 1024 + 16 * lane); }
#pragma unroll
                for (int j = 0; j < 8; ++j) { const float wj = __shfl(wsel, base + j); const f32x2 w2 = (f32x2){wj, wj};
#pragma unroll
                    for (int i = 0; i < 4; ++i) { const f32x2 lo = __builtin_amdgcn_cvt_pk_f32_fp8((int)q[j][i], false), hi = __builtin_amdgcn_cvt_pk_f32_fp8((int)q[j][i], true); o[2 * i] += w2 * lo; o[2 * i + 1] += w2 * hi; } }
            }
            float x1[16]; float ss = 0.f;
#pragma unroll
            for (int q = 0; q < 4; ++q) { const f32x4 v = *(const f32x4*)(xr + 4 * q); x1[4 * q] = v[0]; x1[4 * q + 1] = v[1]; x1[4 * q + 2] = v[2]; x1[4 * q + 3] = v[3]; }
#pragma unroll
            for (int i = 0; i < 16; ++i) { x1[i] += GT[i] * o[i >> 1][i & 1]; ss += x1[i] * x1[i]; }
            const float rf = rsqrt_f(wave_sum(ss) * (1.0f / 1024.0f) + EPSF);
#pragma unroll
            for (int q = 0; q < 4; ++q) { f32x4 v;
#pragma unroll
                for (int e = 0; e < 4; ++e) v[e] = x1[4 * q + e] * rf * NF[4 * q + e];
                *(f32x4*)(dst + t * 1024 + 16 * lane + 4 * q) = v; }
        }
    }
}

__device__ __forceinline__ void p8_peer_fused(Frame& F) {
    const int f_tid = threadIdx.x, lane = f_tid & 63, f_wave = __builtin_amdgcn_readfirstlane(f_tid >> 6);
    const unsigned char* EU = F.ws + WS_EU; const unsigned char* EV = F.ws + WS_EV;
    const int myj = ((lane >> 5) & 1) * 4 + ((lane >> 4) & 1) * 2 + ((lane >> 3) & 1);
    const unsigned l16 = 16u * (unsigned)lane;
    for (int wq = F.vcu * NWAVES + f_wave; wq < MTOK / 16; wq += F.G * NWAVES) {
        const int b = wq >> 7; const float* mb = WSP(float, WS_MOD) + (size_t)b * 6144;
        for (int tt = 0; tt < 16; ++tt) {
            const size_t t = (size_t)wq * 16 + tt;
            unsigned lo16 = 16u * (unsigned)lane; asm volatile("" : "+v"(lo16));
            float* xr = (float*)((char*)(F.out + t * 1024) + 4u * lo16);
            const int e_lo = WSP(int, WS_EID)[t * 128 + lane], e_hi = WSP(int, WS_EID)[t * 128 + 64 + lane];
            const float g_lo = WSP(float, WS_GATE)[t * 128 + lane], g_hi = WSP(float, WS_GATE)[t * 128 + 64 + lane];
            const float su_lo = WSP(float, WS_EUS)[e_lo], su_hi = WSP(float, WS_EUS)[e_hi], sv_lo = WSP(float, WS_EVS)[e_lo], sv_hi = WSP(float, WS_EVS)[e_hi];
            const float rs = rsqrt_f(WSP(float, WS_ROWSTAT)[t] * (1.0f / 1024.0f) + EPSF);
            const char* xs = (const char*)(WSP(bf16, WS_X1S) + t * 1024) + 2u * lo16; const v4u xa = *(const v4u*)xs, xb = *(const v4u*)(xs + 16);
            float h2[16]; unpack8(xa, h2); unpack8(xb, h2 + 8);
#pragma unroll
            for (int q = 0; q < 4; ++q) { const f32x4 sh = *(const f32x4*)(mb + 3072 + 16 * lane + 4 * q);
#pragma unroll
                for (int e = 0; e < 4; ++e) h2[4 * q + e] = h2[4 * q + e] * rs + sh[e]; }
            f32x2 o[8];
#pragma unroll
            for (int i = 0; i < 8; ++i) o[i] = (f32x2){0.f, 0.f};
            v4u qu[8], qv[8], nu[8], nv[8];
#pragma unroll
            for (int j = 0; j < 8; ++j) { const int e = __builtin_amdgcn_readlane(e_lo, j); const unsigned off = (unsigned)e * 1024u + l16; qu[j] = *(const v4u*)(EU + off); qv[j] = *(const v4u*)(EV + off); }
#pragma unroll 1
            for (int grp = 0; grp < 16; ++grp) {
                const int nb = ((grp + 1) & 7) * 8; const int ensel = (grp + 1) < 8 ? e_lo : e_hi;
                if (grp < 15) {
#pragma unroll
                    for (int j = 0; j < 8; ++j) { const int e = __builtin_amdgcn_readlane(ensel, nb + j); const unsigned off = (unsigned)e * 1024u + l16; nu[j] = *(const v4u*)(EU + off); nv[j] = *(const v4u*)(EV + off); } }
                const int base = (grp & 7) * 8;
                const float gsel = grp < 8 ? g_lo : g_hi, susel = grp < 8 ? su_lo : su_hi, svsel = grp < 8 ? sv_lo : sv_hi;
                float d[8];
#pragma unroll
                for (int j = 0; j < 8; ++j) { float f[16]; dec16(qu[j], f); float a = 0.f;
#pragma unroll
                    for (int i = 0; i < 16; ++i) a += h2[i] * f[i];
                    d[j] = a; }
                float e4[4], e2[2], e1;
#pragma unroll
                for (int i = 0; i < 4; ++i) { const bool up = lane & 32; const float snd = up ? d[i] : d[i + 4]; const float rcv = __shfl_xor(snd, 32); e4[i] = (up ? d[i + 4] : d[i]) + rcv; }
#pragma unroll
                for (int i = 0; i < 2; ++i) { const bool up = lane & 16; const float snd = up ? e4[i] : e4[i + 2]; const float rcv = __shfl_xor(snd, 16); e2[i] = (up ? e4[i + 2] : e4[i]) + rcv; }
                { const bool up = lane & 8; const float snd = up ? e2[0] : e2[1]; const float rcv = __shfl_xor(snd, 8); e1 = (up ? e2[1] : e2[0]) + rcv; }
                e1 += __shfl_xor(e1, 4); e1 += __shfl_xor(e1, 2); e1 += __shfl_xor(e1, 1);
                const float wmine = __shfl(gsel, base + myj) * gelu_erf(e1 * __shfl(susel, base + myj)) * __shfl(svsel, base + myj);
#pragma unroll
                for (int j = 0; j < 8; ++j) { const int src = ((j >> 2) & 1) * 32 + ((j >> 1) & 1) * 16 + (j & 1) * 8; const float wj = __builtin_bit_cast(float, __builtin_amdgcn_readlane(__builtin_bit_cast(int, wmine), src)); const f32x2 w2 = (f32x2){wj, wj};
#pragma unroll
                    for (int i = 0; i < 4; ++i) { const f32x2 lo = __builtin_amdgcn_cvt_pk_f32_fp8((int)qv[j][i], false), hi = __builtin_amdgcn_cvt_pk_f32_fp8((int)qv[j][i], true); o[2 * i] += w2 * lo; o[2 * i + 1] += w2 * hi; } }
#pragma unroll
                for (int j = 0; j < 8; ++j) { qu[j] = nu[j]; qv[j] = nv[j]; }
            }
            float x1[16]; float ss = 0.f;
#pragma unroll
            for (int q = 0; q < 4; ++q) { const f32x4 v = *(const f32x4*)(xr + 4 * q); x1[4 * q] = v[0]; x1[4 * q + 1] = v[1]; x1[4 * q + 2] = v[2]; x1[4 * q + 3] = v[3]; }
#pragma unroll
            for (int q = 0; q < 4; ++q) { const f32x4 gt = *(const f32x4*)(mb + 5120 + 16 * lane + 4 * q);
#pragma unroll
                for (int e = 0; e < 4; ++e) { const int i = 4 * q + e; x1[i] += gt[e] * o[i >> 1][i & 1]; ss += x1[i] * x1[i]; } }
            const float rf = rsqrt_f(wave_sum(ss) * (1.0f / 1024.0f) + EPSF);
#pragma unroll
            for (int q = 0; q < 4; ++q) { const f32x4 nf = *(const f32x4*)((F.a->in[29]) + 16 * lane + 4 * q); f32x4 v;
#pragma unroll
                for (int e = 0; e < 4; ++e) v[e] = x1[4 * q + e] * rf * nf[e];
                *(f32x4*)(xr + 4 * q) = v; }
        }
    }
}
struct PeerMeta { unsigned long long st; float rs; v4u xa, xb; int elo, ehi; float glo, ghi; };
__device__ __forceinline__ void peer_meta_load(PeerMeta& M, const unsigned char* ws, size_t t, unsigned l16) {
    M.st = ((const unsigned long long*)(ws + WS_START))[t]; M.rs = ((const float*)(ws + WS_ROWSTAT))[t];
    const char* xs = (const char*)(ws + WS_X1S) + t * 2048 + 2u * l16; M.xa = *(const v4u*)xs; M.xb = *(const v4u*)(xs + 16);
    const int* ep = (const int*)(ws + WS_EID) + t * 128; const float* gp = (const float*)(ws + WS_GATE) + t * 128;
    const unsigned l = l16 >> 4; M.elo = ep[l]; M.ehi = ep[64 + l]; M.glo = gp[l]; M.ghi = gp[64 + l];
}
__device__ __forceinline__ void peer_rows_issue(int elo, int ehi, float glo, float ghi, int i0, int iend, const unsigned char* EU, const float* EUS, const float* EVS, unsigned l16, int lane, v4u* q, float& gmine, float& su, float& sv) {
    int idx = i0 + (lane & 7); idx = idx < iend ? idx : iend - 1; idx = idx < 0 ? 0 : (idx > 127 ? 127 : idx);
    const int ea = __shfl(elo, idx & 63), eb = __shfl(ehi, idx & 63); const int emine = idx < 64 ? ea : eb;
    const float ga = __shfl(glo, idx & 63), gb = __shfl(ghi, idx & 63); gmine = idx < 64 ? ga : gb;
#pragma unroll
    for (int j = 0; j < 8; ++j) { const int e = __builtin_amdgcn_readlane(emine, j); q[j] = *(const v4u*)(EU + ((unsigned)e * 1024u + l16)); }
    su = EUS[emine]; sv = EVS[emine];
}
__device__ __forceinline__ void p8_peer_up2(Frame& F) {
    const int f_tid = threadIdx.x, lane = f_tid & 63, f_wave = __builtin_amdgcn_readfirstlane(f_tid >> 6);
    const unsigned char* EU = F.ws + WS_EU; const float* EUS = WSP(float, WS_EUS); const float* EVS = WSP(float, WS_EVS);
    unsigned* ctr = (unsigned*)(F.ws + WS_CTL) + 8192;
    int rr = (int)(xb_xcc_id() & 7u), tries = 0;
    for (;;) {
        int blk = 0;
        if (lane == 0) blk = (int)__hip_atomic_fetch_add(ctr + 64 * rr, 1u, __ATOMIC_RELAXED, __HIP_MEMORY_SCOPE_AGENT);
        blk = __builtin_amdgcn_readfirstlane(blk);
        if (blk >= MTOK / 128) { if (++tries >= 8) break; rr = (rr + 1) & 7; continue; }
        const int b = blk >> 4; const float* mb = WSP(float, WS_MOD) + (size_t)b * 6144;
        unsigned l16 = 16u * (unsigned)lane; asm volatile("" : "+v"(l16));
        float S2[16];
#pragma unroll
        for (int q = 0; q < 4; ++q) { const f32x4 sh = *(const f32x4*)((const char*)(mb + 3072) + 4u * l16 + 16 * q); S2[4 * q] = sh[0]; S2[4 * q + 1] = sh[1]; S2[4 * q + 2] = sh[2]; S2[4 * q + 3] = sh[3]; }
        const size_t tb = (size_t)blk * 128;
        PeerMeta M0, M1, M2, M3, M4;
        peer_meta_load(M0, F.ws, tb, l16); peer_meta_load(M1, F.ws, tb + 1, l16); peer_meta_load(M2, F.ws, tb + 2, l16); peer_meta_load(M3, F.ws, tb + 3, l16);
        v4u qa[8], qb[8]; float ga_, sua, sva, gb_ = 0.f, sub = 0.f, svb = 0.f;
        int s0 = (int)((M0.st >> (8 * rr)) & 255ull), s1 = rr == 7 ? 128 : (int)((M0.st >> (8 * rr + 8)) & 255ull);
        peer_rows_issue(M0.elo, M0.ehi, M0.glo, M0.ghi, s0, s1, EU, EUS, EVS, l16, lane, qa, ga_, sua, sva);
        for (int tt = 0; tt < 128; ++tt) {
            if (tt + 4 < 128) peer_meta_load(M4, F.ws, tb + tt + 4, l16);
            float h2[16]; unpack8(M0.xa, h2); unpack8(M0.xb, h2 + 8);
            const float rs = rsqrt_f(M0.rs * (1.0f / 1024.0f) + EPSF);
#pragma unroll
            for (int i = 0; i < 16; ++i) h2[i] = h2[i] * rs + S2[i];
            const int cnt = s1 - s0, ngrp = cnt > 0 ? (cnt + 7) >> 3 : 1;
            const int n0 = (int)((M1.st >> (8 * rr)) & 255ull), n1 = rr == 7 ? 128 : (int)((M1.st >> (8 * rr + 8)) & 255ull);
            float* gp = WSP(float, WS_GATE) + (tb + tt) * 128;
            for (int g = 0; g < ngrp; ++g) {
                { const bool same = (g + 1 < ngrp);
                  peer_rows_issue(same ? M0.elo : M1.elo, same ? M0.ehi : M1.ehi, same ? M0.glo : M1.glo, same ? M0.ghi : M1.ghi, same ? s0 + 8 * (g + 1) : n0, same ? s1 : n1, EU, EUS, EVS, l16, lane, qb, gb_, sub, svb); }
                __builtin_amdgcn_sched_barrier(0);
                float d[8];
#pragma unroll
                for (int j = 0; j < 8; ++j) { float f[16]; dec16(qa[j], f); float a = 0.f;
#pragma unroll
                    for (int i = 0; i < 16; ++i) a += h2[i] * f[i];
                    d[j] = a; }
                float dmine = 0.f;
#pragma unroll
                for (int j = 0; j < 8; ++j) { const float tot = wave_sum_to63(d[j]); const float sj = __builtin_bit_cast(float, __builtin_amdgcn_readlane(__builtin_bit_cast(int, tot), 63)); dmine = (lane == j) ? sj : dmine; }
                const float wv = ga_ * gelu_erf(dmine * sua) * sva;
                { const int idx = s0 + 8 * g + lane; if (lane < 8 && idx < s1) gp[idx] = wv; }
#pragma unroll
                for (int j = 0; j < 8; ++j) qa[j] = qb[j];
                ga_ = gb_; sua = sub; sva = svb;
                asm volatile("" : "+v"(ga_), "+v"(sua), "+v"(sva));
            }
            M0 = M1; M1 = M2; M2 = M3; M3 = M4; s0 = n0; s1 = n1;
        }
    }
}
__device__ __forceinline__ void xcc_rendezvous(Frame& F, const XcdBarrier& bar, int which);
__device__ __forceinline__ void p9_peer_down2(Frame& F, const XcdBarrier& bar) {
    const int f_tid = threadIdx.x, lane = f_tid & 63, f_wave = __builtin_amdgcn_readfirstlane(f_tid >> 6);
    const unsigned char* EV = F.ws + WS_EV;
    for (int wq = F.vcu * NWAVES + f_wave; wq < MTOK / 16; wq += F.G * NWAVES) {
        const int b = wq >> 7; const float* mb = WSP(float, WS_MOD) + (size_t)b * 6144;
        for (int tt = 0; tt < 16; ++tt) {
            const size_t t = (size_t)wq * 16 + tt;
            unsigned l16 = 16u * (unsigned)lane; asm volatile("" : "+v"(l16));
            float* xr = (float*)((char*)(F.out + t * 1024) + 4u * l16);
            const int e_lo = WSP(int, WS_EID)[t * 128 + lane], e_hi = WSP(int, WS_EID)[t * 128 + 64 + lane];
            const float w_lo = WSP(float, WS_GATE)[t * 128 + lane], w_hi = WSP(float, WS_GATE)[t * 128 + 64 + lane];
            f32x2 o[8];
#pragma unroll
            for (int i = 0; i < 8; ++i) o[i] = (f32x2){0.f, 0.f};
            v4u qa[8], qb[8];
#pragma unroll
            for (int j = 0; j < 8; ++j) { const int e = __builtin_amdgcn_readlane(e_lo, j); qa[j] = *(const v4u*)(EV + ((unsigned)e * 1024u + l16)); }
#define DN2_STEP(GRP, CUR, NXT) { \
                const int grp = (GRP); const int nb = ((grp + 1) & 7) * 8; const int ensel = (grp + 1) < 8 ? e_lo : e_hi; \
                { _Pragma("unroll") for (int j = 0; j < 8; ++j) { const int e = __builtin_amdgcn_readlane(ensel, nb + j); NXT[j] = *(const v4u*)(EV + ((unsigned)e * 1024u + l16)); } } \
                __builtin_amdgcn_sched_barrier(0); \
                const int base = (grp & 7) * 8; const float wsel = grp < 8 ? w_lo : w_hi; \
                _Pragma("unroll") for (int j = 0; j < 8; ++j) { const float wj = __builtin_bit_cast(float, __builtin_amdgcn_readlane(__builtin_bit_cast(int, wsel), base + j)); const f32x2 w2 = (f32x2){wj, wj}; \
                    _Pragma("unroll") for (int i = 0; i < 4; ++i) { const f32x2 lo = __builtin_amdgcn_cvt_pk_f32_fp8((int)CUR[j][i], false), hi = __builtin_amdgcn_cvt_pk_f32_fp8((int)CUR[j][i], true); o[2 * i] += w2 * lo; o[2 * i + 1] += w2 * hi; } } }
#pragma unroll 1
            for (int g2 = 0; g2 < 16; g2 += 2) { DN2_STEP(g2, qa, qb) DN2_STEP(g2 + 1, qb, qa) }
#undef DN2_STEP
            float x1[16]; float ss = 0.f;
#pragma unroll
            for (int q4 = 0; q4 < 4; ++q4) { const f32x4 v = *(const f32x4*)(xr + 4 * q4); x1[4 * q4] = v[0]; x1[4 * q4 + 1] = v[1]; x1[4 * q4 + 2] = v[2]; x1[4 * q4 + 3] = v[3]; }
#pragma unroll
            for (int q4 = 0; q4 < 4; ++q4) { const f32x4 gt = *(const f32x4*)((const char*)(mb + 5120) + 4u * l16 + 16 * q4);
#pragma unroll
                for (int e = 0; e < 4; ++e) { const int i = 4 * q4 + e; x1[i] += gt[e] * o[i >> 1][i & 1]; ss += x1[i] * x1[i]; } }
            const float rf = rsqrt_f(wave_sum(ss) * (1.0f / 1024.0f) + EPSF);
#pragma unroll
            for (int q4 = 0; q4 < 4; ++q4) { const f32x4 nf = *(const f32x4*)((const char*)(F.a->in[29]) + 4u * l16 + 16 * q4); f32x4 v;
#pragma unroll
                for (int e = 0; e < 4; ++e) v[e] = x1[4 * q4 + e] * rf * nf[e];
                *(f32x4*)(xr + 4 * q4) = v; }
        }
    }
}
__device__ __forceinline__ void xcc_rendezvous(Frame& F, const XcdBarrier& bar, int which) {
    __syncthreads();
    if (threadIdx.x == 0) {
        unsigned* w = (unsigned*)(F.ws + WS_CTL) + 9216 + which * 2048;
        const unsigned nloc = bar.st[0] ? bar.st[0] : 1u; const unsigned x = bar.x;
        const unsigned old = xb_add(&w[64 * x], 1u); const unsigned gen = old / nloc;
        if (old + 1u == (gen + 1u) * nloc) xb_add(&w[1024 + 64 * x], 1u);
        else { unsigned sp = 0; while (xb_ld(&w[1024 + 64 * x]) == gen) { __builtin_amdgcn_s_sleep(1); if (++sp > (1u << 16)) break; } }
    }
    __syncthreads();
}
__device__ __forceinline__ void p8_peer_up3(Frame& F, const XcdBarrier& bar) {
    const int f_tid = threadIdx.x, lane = f_tid & 63, f_wave = __builtin_amdgcn_readfirstlane(f_tid >> 6);
    const unsigned char* EU = F.ws + WS_EU; const float* EUS = WSP(float, WS_EUS); const float* EVS = WSP(float, WS_EVS);
    for (int wq = F.vcu * NWAVES + f_wave; wq < MTOK / 16; wq += F.G * NWAVES) {
        const int b = wq >> 7; const float* mb = WSP(float, WS_MOD) + (size_t)b * 6144;
        for (int tt = 0; tt < 16; ++tt) {
            const size_t t = (size_t)wq * 16 + tt;
            unsigned l16 = 16u * (unsigned)lane; asm volatile("" : "+v"(l16));
            const int e_lo = WSP(int, WS_EID)[t * 128 + lane], e_hi = WSP(int, WS_EID)[t * 128 + 64 + lane];
            const float g_lo = WSP(float, WS_GATE)[t * 128 + lane], g_hi = WSP(float, WS_GATE)[t * 128 + 64 + lane];
#ifdef PROBE_NOSCALE
            const float su_lo = 5.6e-4f, su_hi = 5.6e-4f, sv_lo = 6.3e-3f, sv_hi = 6.3e-3f;
#else
            const float su_lo = EUS[e_lo], su_hi = EUS[e_hi], sv_lo = EVS[e_lo], sv_hi = EVS[e_hi];
#endif
            const float rs = rsqrt_f(WSP(float, WS_ROWSTAT)[t] * (1.0f / 1024.0f) + EPSF);
            const char* xs = (const char*)(WSP(bf16, WS_X1S) + t * 1024) + 2u * l16; const v4u xa = *(const v4u*)xs, xb = *(const v4u*)(xs + 16);
            float h2[16]; unpack8(xa, h2); unpack8(xb, h2 + 8);
            f32x2 h2p[8];
#pragma unroll
            for (int q = 0; q < 4; ++q) { const f32x4 sh = *(const f32x4*)((const char*)(mb + 3072) + 4u * l16 + 16 * q);
                h2p[2 * q] = (f32x2){h2[4 * q] * rs + sh[0], h2[4 * q + 1] * rs + sh[1]}; h2p[2 * q + 1] = (f32x2){h2[4 * q + 2] * rs + sh[2], h2[4 * q + 3] * rs + sh[3]}; }
            float w_lo = 0.f, w_hi = 0.f;
            v4u qa[8], qb[8];
#pragma unroll
            for (int j = 0; j < 8; ++j) { const int e = __builtin_amdgcn_readlane(e_lo, j); qa[j] = *(const v4u*)(EU + ((unsigned)e * 1024u + l16)); }
#define UP3_STEP(GRP, CUR, NXT) { \
                const int grp = (GRP); const int nb = ((grp + 1) & 7) * 8; const int ensel = (grp + 1) < 8 ? e_lo : e_hi; \
                  \
                { _Pragma("unroll") for (int j = 0; j < 8; ++j) { const int e = __builtin_amdgcn_readlane(ensel, nb + j); NXT[j] = *(const v4u*)(EU + ((unsigned)e * 1024u + l16)); } } \
                __builtin_amdgcn_sched_barrier(0); \
                const int base = (grp & 7) * 8; float dmine = 0.f; \
                _Pragma("unroll") for (int j = 0; j < 8; ++j) { f32x2 a0 = (f32x2){0.f, 0.f}, a1 = (f32x2){0.f, 0.f}; \
                    _Pragma("unroll") for (int i = 0; i < 4; ++i) { const f32x2 lo = __builtin_amdgcn_cvt_pk_f32_fp8((int)CUR[j][i], false), hi = __builtin_amdgcn_cvt_pk_f32_fp8((int)CUR[j][i], true); a0 += h2p[2 * i] * lo; a1 += h2p[2 * i + 1] * hi; } \
                    const float a = (a0[0] + a0[1]) + (a1[0] + a1[1]); \
                    const float tot = wave_sum_to63(a); const float sj = __builtin_bit_cast(float, __builtin_amdgcn_readlane(__builtin_bit_cast(int, tot), 63)); \
                    dmine = (lane == base + j) ? sj : dmine; } \
                const float gsel = grp < 8 ? g_lo : g_hi, susel = grp < 8 ? su_lo : su_hi, svsel = grp < 8 ? sv_lo : sv_hi; \
                const float wv = gsel * gelu_erf(dmine * susel) * svsel; \
                const bool mine = (lane >= base) && (lane < base + 8); \
                if (grp < 8) w_lo = mine ? wv : w_lo; else w_hi = mine ? wv : w_hi; }
#pragma unroll 1
            for (int g2 = 0; g2 < 16; g2 += 2) { UP3_STEP(g2, qa, qb) UP3_STEP(g2 + 1, qb, qa) }
#undef UP3_STEP
            WSP(float, WS_GATE)[t * 128 + lane] = w_lo; WSP(float, WS_GATE)[t * 128 + 64 + lane] = w_hi;
        }
    }
}
typedef long i64_t;
__device__ __forceinline__ void p8_peer_up4(Frame& F) {
    const int f_tid = threadIdx.x, lane = f_tid & 63, f_wave = __builtin_amdgcn_readfirstlane(f_tid >> 6);
    const int li = lane & 15, lq = lane >> 4;
    const unsigned char* EU = F.ws + WS_EU; const float* EUS = WSP(float, WS_EUS); const float* EVS = WSP(float, WS_EVS);
    LAS unsigned char* hq = F.lds + f_wave * 1024;
    for (int wq = F.vcu * NWAVES + f_wave; wq < MTOK / 16; wq += F.G * NWAVES) {
        const int b = wq >> 7; const float* mb = WSP(float, WS_MOD) + (size_t)b * 6144;
        for (int tt = 0; tt < 16; ++tt) {
            const size_t t = (size_t)wq * 16 + tt;
            unsigned l16 = 16u * (unsigned)lane; asm volatile("" : "+v"(l16));
            const unsigned rowoff = 16u * (unsigned)lq;
            const int e_lo = WSP(int, WS_EID)[t * 128 + lane], e_hi = WSP(int, WS_EID)[t * 128 + 64 + lane];
            const float g_lo = WSP(float, WS_GATE)[t * 128 + lane], g_hi = WSP(float, WS_GATE)[t * 128 + 64 + lane];
            v4u q[8], nq[8];
            { const int e = __shfl(e_lo, li);
#pragma unroll
              for (int c = 0; c < 8; ++c) q[c] = *(const v4u*)(EU + ((unsigned)e * 1024u + 64u * c + rowoff)); }
            const float su_lo = EUS[e_lo], su_hi = EUS[e_hi], sv_lo = EVS[e_lo], sv_hi = EVS[e_hi];
            const float rs = rsqrt_f(WSP(float, WS_ROWSTAT)[t] * (1.0f / 1024.0f) + EPSF);
            const char* xs = (const char*)(WSP(bf16, WS_X1S) + t * 1024) + 2u * l16; const v4u xa = *(const v4u*)xs, xb = *(const v4u*)(xs + 16);
            float h2[16]; unpack8(xa, h2); unpack8(xb, h2 + 8); float mx = 0.f;
#pragma unroll
            for (int qd = 0; qd < 4; ++qd) { const f32x4 sh = *(const f32x4*)((const char*)(mb + 3072) + 4u * l16 + 16 * qd);
#pragma unroll
                for (int e = 0; e < 4; ++e) { h2[4 * qd + e] = h2[4 * qd + e] * rs + sh[e]; mx = fmaxf(mx, fabsf(h2[4 * qd + e])); } }
#pragma unroll
            for (int o = 1; o < 64; o <<= 1) mx = fmaxf(mx, __shfl_xor(mx, o));
            mx = fmaxf(mx, 1e-30f); const float hs = 224.0f / mx, hinv = mx * (1.0f / 224.0f);
            { v4u w;
#pragma unroll
              for (int qd = 0; qd < 4; ++qd) { int pk = 0; pk = __builtin_amdgcn_cvt_pk_fp8_f32(h2[4 * qd] * hs, h2[4 * qd + 1] * hs, pk, false); pk = __builtin_amdgcn_cvt_pk_fp8_f32(h2[4 * qd + 2] * hs, h2[4 * qd + 3] * hs, pk, true); w[qd] = (unsigned)pk; }
              *(LAS v4u*)(hq + l16) = w; }
            LDS_WAIT(); asm volatile("" ::: "memory");
            v4u hb[16];
#pragma unroll
            for (int c = 0; c < 16; ++c) hb[c] = *(const LAS v4u*)(hq + 64 * c + rowoff);
            float w_lo = 0.f, w_hi = 0.f;
            f32x4 acc = (f32x4){0.f, 0.f, 0.f, 0.f};
#pragma unroll 1
            for (int u = 0; u < 16; ++u) {
                if (u < 15) { const int g1 = (u + 1) >> 1, kh = (u + 1) & 1; const int e = __shfl(g1 < 4 ? e_lo : e_hi, 16 * (g1 & 3) + li);
#pragma unroll
                    for (int c = 0; c < 8; ++c) nq[c] = *(const v4u*)(EU + ((unsigned)e * 1024u + 512u * kh + 64u * c + rowoff)); }
                __builtin_amdgcn_sched_barrier(0);
                if ((u & 1) == 0) {
#pragma unroll
                    for (int c = 0; c < 8; ++c) { acc = __builtin_amdgcn_mfma_f32_16x16x32_fp8_fp8((i64_t)(((unsigned long long)q[c][1] << 32) | q[c][0]), (i64_t)(((unsigned long long)hb[c][1] << 32) | hb[c][0]), acc, 0, 0, 0);
                        acc = __builtin_amdgcn_mfma_f32_16x16x32_fp8_fp8((i64_t)(((unsigned long long)q[c][3] << 32) | q[c][2]), (i64_t)(((unsigned long long)hb[c][3] << 32) | hb[c][2]), acc, 0, 0, 0); }
                } else {
#pragma unroll
                    for (int c = 0; c < 8; ++c) { acc = __builtin_amdgcn_mfma_f32_16x16x32_fp8_fp8((i64_t)(((unsigned long long)q[c][1] << 32) | q[c][0]), (i64_t)(((unsigned long long)hb[8 + c][1] << 32) | hb[8 + c][0]), acc, 0, 0, 0);
                        acc = __builtin_amdgcn_mfma_f32_16x16x32_fp8_fp8((i64_t)(((unsigned long long)q[c][3] << 32) | q[c][2]), (i64_t)(((unsigned long long)hb[8 + c][3] << 32) | hb[8 + c][2]), acc, 0, 0, 0); }
                    const int g = u >> 1; const int r = li & 3;
                    const float sel = r == 0 ? acc[0] : (r == 1 ? acc[1] : (r == 2 ? acc[2] : acc[3]));
                    const float dmine = __shfl(sel, ((li >> 2) & 3) * 16 + (li & 3));
                    const float gsel = g < 4 ? g_lo : g_hi, susel = g < 4 ? su_lo : su_hi, svsel = g < 4 ? sv_lo : sv_hi;
                    const float wv = gsel * gelu_erf(dmine * susel * hinv) * svsel;
                    const bool mine = (lane >> 4) == (g & 3);
                    if (g < 4) w_lo = mine ? wv : w_lo; else w_hi = mine ? wv : w_hi;
                    acc = (f32x4){0.f, 0.f, 0.f, 0.f};
                }
#pragma unroll
                for (int c = 0; c < 8; ++c) q[c] = nq[c];
            }
            WSP(float, WS_GATE)[t * 128 + lane] = w_lo; WSP(float, WS_GATE)[t * 128 + 64 + lane] = w_hi;
        }
    }
}
__device__ __forceinline__ void p8_peer_fused2(Frame& F) {
    const int f_tid = threadIdx.x, lane = f_tid & 63, f_wave = __builtin_amdgcn_readfirstlane(f_tid >> 6);
    const unsigned char* EU = F.ws + WS_EU; const unsigned char* EV = F.ws + WS_EV; const float* EUS = WSP(float, WS_EUS); const float* EVS = WSP(float, WS_EVS);
    for (int wq = F.vcu * NWAVES + f_wave; wq < MTOK / 16; wq += F.G * NWAVES) {
        const int b = wq >> 7; const float* mb = WSP(float, WS_MOD) + (size_t)b * 6144;
        for (int tt = 0; tt < 16; ++tt) {
            const size_t t = (size_t)wq * 16 + tt;
            unsigned l16 = 16u * (unsigned)lane; asm volatile("" : "+v"(l16));
            float* xr = (float*)((char*)(F.out + t * 1024) + 4u * l16);
            const int e_lo = WSP(int, WS_EID)[t * 128 + lane], e_hi = WSP(int, WS_EID)[t * 128 + 64 + lane];
            const float g_lo = WSP(float, WS_GATE)[t * 128 + lane], g_hi = WSP(float, WS_GATE)[t * 128 + 64 + lane];
            v4u qu[8], qv[8], nu[8], nv[8];
#pragma unroll
            for (int j = 0; j < 8; ++j) { const int e = __builtin_amdgcn_readlane(e_lo, j); const unsigned off = (unsigned)e * 1024u + l16; qu[j] = *(const v4u*)(EU + off); qv[j] = *(const v4u*)(EV + off); }
            const float su_lo = EUS[e_lo], su_hi = EUS[e_hi], sv_lo = EVS[e_lo], sv_hi = EVS[e_hi];
            const float rs = rsqrt_f(WSP(float, WS_ROWSTAT)[t] * (1.0f / 1024.0f) + EPSF);
            const char* xs = (const char*)(WSP(bf16, WS_X1S) + t * 1024) + 2u * l16; const v4u xa = *(const v4u*)xs, xb = *(const v4u*)(xs + 16);
            float h2[16]; unpack8(xa, h2); unpack8(xb, h2 + 8);
            f32x2 h2p[8];
#pragma unroll
            for (int q = 0; q < 4; ++q) { const f32x4 sh = *(const f32x4*)((const char*)(mb + 3072) + 4u * l16 + 16 * q);
                h2p[2 * q] = (f32x2){h2[4 * q] * rs + sh[0], h2[4 * q + 1] * rs + sh[1]}; h2p[2 * q + 1] = (f32x2){h2[4 * q + 2] * rs + sh[2], h2[4 * q + 3] * rs + sh[3]}; }
            f32x2 o[8];
#pragma unroll
            for (int i = 0; i < 8; ++i) o[i] = (f32x2){0.f, 0.f};
#pragma unroll 1
            for (int grp = 0; grp < 16; ++grp) {
                const int nb = ((grp + 1) & 7) * 8; const int ensel = (grp + 1) < 8 ? e_lo : e_hi;
                if (grp < 15) {
#pragma unroll
                    for (int j = 0; j < 8; ++j) { const int e = __builtin_amdgcn_readlane(ensel, nb + j); const unsigned off = (unsigned)e * 1024u + l16; nu[j] = *(const v4u*)(EU + off); nv[j] = *(const v4u*)(EV + off); } }
                __builtin_amdgcn_sched_barrier(0);
                const int base = (grp & 7) * 8;
                float dmine = 0.f;
#pragma unroll
                for (int j = 0; j < 8; ++j) { f32x2 a0 = (f32x2){0.f, 0.f}, a1 = (f32x2){0.f, 0.f};
#pragma unroll
                    for (int i = 0; i < 4; ++i) { const f32x2 lo = __builtin_amdgcn_cvt_pk_f32_fp8((int)qu[j][i], false), hi = __builtin_amdgcn_cvt_pk_f32_fp8((int)qu[j][i], true); a0 += h2p[2 * i] * lo; a1 += h2p[2 * i + 1] * hi; }
                    const float a = (a0[0] + a0[1]) + (a1[0] + a1[1]);
                    const float tot = wave_sum_to63(a); const float sj = __builtin_bit_cast(float, __builtin_amdgcn_readlane(__builtin_bit_cast(int, tot), 63));
                    dmine = (lane == base + j) ? sj : dmine; }
                const float gsel = grp < 8 ? g_lo : g_hi, susel = grp < 8 ? su_lo : su_hi, svsel = grp < 8 ? sv_lo : sv_hi;
                const float wv = gsel * gelu_erf(dmine * susel) * svsel;
#pragma unroll
                for (int j = 0; j < 8; ++j) { const float wj = __builtin_bit_cast(float, __builtin_amdgcn_readlane(__builtin_bit_cast(int, wv), base + j)); const f32x2 w2 = (f32x2){wj, wj};
#pragma unroll
                    for (int i = 0; i < 4; ++i) { const f32x2 lo = __builtin_amdgcn_cvt_pk_f32_fp8((int)qv[j][i], false), hi = __builtin_amdgcn_cvt_pk_f32_fp8((int)qv[j][i], true); o[2 * i] += w2 * lo; o[2 * i + 1] += w2 * hi; } }
#pragma unroll
                for (int j = 0; j < 8; ++j) { qu[j] = nu[j]; qv[j] = nv[j]; }
            }
            float x1[16]; float ss = 0.f;
#pragma unroll
            for (int q4 = 0; q4 < 4; ++q4) { const f32x4 v = *(const f32x4*)(xr + 4 * q4); x1[4 * q4] = v[0]; x1[4 * q4 + 1] = v[1]; x1[4 * q4 + 2] = v[2]; x1[4 * q4 + 3] = v[3]; }
#pragma unroll
            for (int q4 = 0; q4 < 4; ++q4) { const f32x4 gt = *(const f32x4*)((const char*)(mb + 5120) + 4u * l16 + 16 * q4);
#pragma unroll
                for (int e = 0; e < 4; ++e) { const int i = 4 * q4 + e; x1[i] += gt[e] * o[i >> 1][i & 1]; ss += x1[i] * x1[i]; } }
            const float rf = rsqrt_f(wave_sum(ss) * (1.0f / 1024.0f) + EPSF);
#pragma unroll
            for (int q4 = 0; q4 < 4; ++q4) { const f32x4 nf = *(const f32x4*)((const char*)(F.a->in[29]) + 4u * l16 + 16 * q4); f32x4 v;
#pragma unroll
                for (int e = 0; e < 4; ++e) v[e] = x1[4 * q4 + e] * rf * nf[e];
                *(f32x4*)(xr + 4 * q4) = v; }
        }
    }
}
constexpr int U6_ROWP = 1040, U6_BUF = 8 * U6_ROWP, U6_WAVE = 2 * U6_BUF + 1024;
static_assert(8 * U6_WAVE <= LDS_MAIN, "U6 LDS map");
__device__ __forceinline__ void p8_peer_up6(Frame& F) {
    const int f_tid = threadIdx.x, lane = f_tid & 63, f_wave = __builtin_amdgcn_readfirstlane(f_tid >> 6);
    const int li = lane & 15, lq = lane >> 4;
    const unsigned char* EU = F.ws + WS_EU; const float* EUS = WSP(float, WS_EUS); const float* EVS = WSP(float, WS_EVS);
    LAS unsigned char* ring = F.lds + f_wave * U6_WAVE; LAS unsigned char* hq = ring + 2 * U6_BUF;
    for (int wq = F.vcu * NWAVES + f_wave; wq < MTOK / 16; wq += F.G * NWAVES) {
        const int b = wq >> 7; const float* mb = WSP(float, WS_MOD) + (size_t)b * 6144;
        for (int tt = 0; tt < 16; ++tt) {
            const size_t t = (size_t)wq * 16 + tt;
            unsigned l16 = 16u * (unsigned)lane; asm volatile("" : "+v"(l16));
            const int e_lo = WSP(int, WS_EID)[t * 128 + lane], e_hi = WSP(int, WS_EID)[t * 128 + 64 + lane];
            const float g_lo = WSP(float, WS_GATE)[t * 128 + lane], g_hi = WSP(float, WS_GATE)[t * 128 + 64 + lane];
            const float rs = rsqrt_f(WSP(float, WS_ROWSTAT)[t] * (1.0f / 1024.0f) + EPSF);
            const char* xs = (const char*)(WSP(bf16, WS_X1S) + t * 1024) + 2u * l16; const v4u xa = *(const v4u*)xs, xb = *(const v4u*)(xs + 16);
            asm volatile("s_waitcnt vmcnt(0)" ::: "memory");
#pragma unroll
            for (int j = 0; j < 8; ++j) { const int e = __builtin_amdgcn_readlane(e_lo, j);
                __builtin_amdgcn_global_load_lds((const unsigned*)(EU + ((unsigned)e * 1024u + l16)), (LAS unsigned*)(ring + j * U6_ROWP), 16, 0, 0); }
            const float su_lo = EUS[e_lo], su_hi = EUS[e_hi], sv_lo = EVS[e_lo], sv_hi = EVS[e_hi];
            float h2[16]; unpack8(xa, h2); unpack8(xb, h2 + 8); float mx = 0.f;
#pragma unroll
            for (int qd = 0; qd < 4; ++qd) { const f32x4 sh = *(const f32x4*)((const char*)(mb + 3072) + 4u * l16 + 16 * qd);
#pragma unroll
                for (int e = 0; e < 4; ++e) { h2[4 * qd + e] = h2[4 * qd + e] * rs + sh[e]; mx = fmaxf(mx, fabsf(h2[4 * qd + e])); } }
#pragma unroll
            for (int o = 1; o < 64; o <<= 1) mx = fmaxf(mx, __shfl_xor(mx, o));
            mx = fmaxf(mx, 1e-30f); const float hs = 224.0f / mx, hinv = mx * (1.0f / 224.0f);
            { v4u w;
#pragma unroll
              for (int qd = 0; qd < 4; ++qd) { int pk = 0; pk = __builtin_amdgcn_cvt_pk_fp8_f32(h2[4 * qd] * hs, h2[4 * qd + 1] * hs, pk, false); pk = __builtin_amdgcn_cvt_pk_fp8_f32(h2[4 * qd + 2] * hs, h2[4 * qd + 3] * hs, pk, true); w[qd] = (unsigned)pk; }
              *(LAS v4u*)(hq + l16) = w; }
            LDS_WAIT(); asm volatile("" ::: "memory");
            v4u hb[16];
#pragma unroll
            for (int c = 0; c < 16; ++c) hb[c] = *(const LAS v4u*)(hq + 64 * c + 16 * lq);
            asm volatile("s_waitcnt vmcnt(0)" ::: "memory");
            float w_lo = 0.f, w_hi = 0.f;
#pragma unroll 1
            for (int u = 0; u < 16; ++u) {
                { const int un = (u + 1) & 15; const int ensel = un < 8 ? e_lo : e_hi; const int nb = (un & 7) * 8; LAS unsigned char* dst = ring + ((u + 1) & 1) * U6_BUF;
#pragma unroll
                  for (int j = 0; j < 8; ++j) { const int e = __builtin_amdgcn_readlane(ensel, nb + j);
                      __builtin_amdgcn_global_load_lds((const unsigned*)(EU + ((unsigned)e * 1024u + l16)), (LAS unsigned*)(dst + j * U6_ROWP), 16, 0, 0); } }
                asm volatile("s_waitcnt vmcnt(8)" ::: "memory");
                const LAS unsigned char* src = ring + (u & 1) * U6_BUF + (li & 7) * U6_ROWP + 16 * lq;
                f32x4 acc = (f32x4){0.f, 0.f, 0.f, 0.f};
#pragma unroll
                for (int c = 0; c < 16; ++c) { const v4u a = *(const LAS v4u*)(src + 64 * c);
                    acc = __builtin_amdgcn_mfma_f32_16x16x32_fp8_fp8((i64_t)(((unsigned long long)a[1] << 32) | a[0]), (i64_t)(((unsigned long long)hb[c][1] << 32) | hb[c][0]), acc, 0, 0, 0);
                    acc = __builtin_amdgcn_mfma_f32_16x16x32_fp8_fp8((i64_t)(((unsigned long long)a[3] << 32) | a[2]), (i64_t)(((unsigned long long)hb[c][3] << 32) | hb[c][2]), acc, 0, 0, 0); }
                const int base = (u & 7) * 8; const int r = li & 3;
                const float sel = r == 0 ? acc[0] : (r == 1 ? acc[1] : (r == 2 ? acc[2] : acc[3]));
                const float dmine = __shfl(sel, ((lane & 7) >> 2) * 16 + (lane & 3));
                const float gsel = u < 8 ? g_lo : g_hi, susel = u < 8 ? su_lo : su_hi, svsel = u < 8 ? sv_lo : sv_hi;
                const float wv = gsel * gelu_erf(dmine * susel * hinv) * svsel;
                const bool mine = (lane >= base) && (lane < base + 8);
                if (u < 8) w_lo = mine ? wv : w_lo; else w_hi = mine ? wv : w_hi;
                asm volatile("s_waitcnt lgkmcnt(0)" ::: "memory");
            }
            WSP(float, WS_GATE)[t * 128 + lane] = w_lo; WSP(float, WS_GATE)[t * 128 + 64 + lane] = w_hi;
        }
    }
}
struct U7Meta { int elo, ehi; float glo, ghi; v4u xa, xb; float rst; };
__device__ __forceinline__ void u7_meta_load(U7Meta& M, const unsigned char* ws, size_t t, unsigned l16) {
    const unsigned l = l16 >> 4; const int* ep = (const int*)(ws + WS_EID) + t * 128; const float* gp = (const float*)(ws + WS_GATE) + t * 128;
    M.elo = ep[l]; M.ehi = ep[64 + l]; M.glo = gp[l]; M.ghi = gp[64 + l];
    const char* xs = (const char*)(ws + WS_X1S) + t * 2048 + 2u * l16; M.xa = *(const v4u*)xs; M.xb = *(const v4u*)(xs + 16);
    M.rst = ((const float*)(ws + WS_ROWSTAT))[t + (l16 >> 30)];
}
__device__ __forceinline__ void u7_unit_dma(int elo, int ehi, int un, const unsigned char* EU, unsigned l16, LAS unsigned char* dst) {
    const int ensel = un < 8 ? elo : ehi; const int nb = (un & 7) * 8;
#pragma unroll
    for (int j = 0; j < 8; ++j) { const int e = __builtin_amdgcn_readlane(ensel, nb + j);
        __builtin_amdgcn_global_load_lds((const unsigned*)(EU + ((unsigned)e * 1024u + l16)), (LAS unsigned*)(dst + j * U6_ROWP), 16, 0, 0); }
}
__device__ __forceinline__ void u7_h2(const U7Meta& M, const float* S2, LAS unsigned char* hq, unsigned l16, int lq, v4u* hb, float& hinv) {
    float h2[16]; unpack8(M.xa, h2); unpack8(M.xb, h2 + 8); float mx = 0.f;
    const float rs = rsqrt_f(M.rst * (1.0f / 1024.0f) + EPSF);
#pragma unroll
    for (int i = 0; i < 16; ++i) { h2[i] = h2[i] * rs + S2[i]; mx = fmaxf(mx, fabsf(h2[i])); }
#pragma unroll
    for (int o = 1; o < 64; o <<= 1) mx = fmaxf(mx, __shfl_xor(mx, o));
    mx = fmaxf(mx, 1e-30f); const float hs = 224.0f / mx; hinv = mx * (1.0f / 224.0f);
    v4u w;
#pragma unroll
    for (int qd = 0; qd < 4; ++qd) { int pk = 0; pk = __builtin_amdgcn_cvt_pk_fp8_f32(h2[4 * qd] * hs, h2[4 * qd + 1] * hs, pk, false); pk = __builtin_amdgcn_cvt_pk_fp8_f32(h2[4 * qd + 2] * hs, h2[4 * qd + 3] * hs, pk, true); w[qd] = (unsigned)pk; }
    *(LAS v4u*)(hq + l16) = w;
    LDS_WAIT(); asm volatile("" ::: "memory");
#pragma unroll
    for (int c = 0; c < 16; ++c) hb[c] = *(const LAS v4u*)(hq + 64 * c + 16 * lq);
    LDS_WAIT(); asm volatile("" ::: "memory");
}
__device__ __forceinline__ void p8_peer_up7(Frame& F) {
    const int f_tid = threadIdx.x, lane = f_tid & 63, f_wave = __builtin_amdgcn_readfirstlane(f_tid >> 6);
    const int li = lane & 15, lq = lane >> 4;
    const unsigned char* EU = F.ws + WS_EU; const float* EUS = WSP(float, WS_EUS); const float* EVS = WSP(float, WS_EVS);
    LAS unsigned char* ring = F.lds + f_wave * U6_WAVE; LAS unsigned char* hq = ring + 2 * U6_BUF;
    for (int wq = F.vcu * NWAVES + f_wave; wq < MTOK / 16; wq += F.G * NWAVES) {
        const int b = wq >> 7; const float* mb = WSP(float, WS_MOD) + (size_t)b * 6144;
        unsigned l16 = 16u * (unsigned)lane; asm volatile("" : "+v"(l16));
        float S2[16];
#pragma unroll
        for (int q = 0; q < 4; ++q) { const f32x4 sh = *(const f32x4*)((const char*)(mb + 3072) + 4u * l16 + 16 * q); S2[4 * q] = sh[0]; S2[4 * q + 1] = sh[1]; S2[4 * q + 2] = sh[2]; S2[4 * q + 3] = sh[3]; }
        const size_t t0 = (size_t)wq * 16;
        U7Meta C, N;
        u7_meta_load(C, F.ws, t0, l16);
        asm volatile("s_waitcnt vmcnt(0)" ::: "memory");
        u7_unit_dma(C.elo, C.ehi, 0, EU, l16, ring);
        float su_lo = EUS[C.elo], su_hi = EUS[C.ehi], sv_lo = EVS[C.elo], sv_hi = EVS[C.ehi];
        float nsu_lo = 0.f, nsu_hi = 0.f, nsv_lo = 0.f, nsv_hi = 0.f;
        v4u hb[16]; float hinv;
        u7_h2(C, S2, hq, l16, lq, hb, hinv);
        N = C;
        asm volatile("s_waitcnt vmcnt(0)" ::: "memory");
#pragma unroll 1
        for (int tt = 0; tt < 16; ++tt) {
            float w_lo = 0.f, w_hi = 0.f;
#pragma unroll 1
            for (int u = 0; u < 16; ++u) {
                { const bool last = (u == 15);
                  u7_unit_dma(last ? N.elo : C.elo, last ? N.ehi : C.ehi, (u + 1) & 15, EU, l16, ring + ((u + 1) & 1) * U6_BUF); }
                if (u == 0) { if (tt == 0) asm volatile("s_waitcnt vmcnt(8)" ::: "memory"); else asm volatile("s_waitcnt vmcnt(10)" ::: "memory"); }
                else if (u == 3) asm volatile("s_waitcnt vmcnt(15)" ::: "memory");
                else if (u == 11) asm volatile("s_waitcnt vmcnt(12)" ::: "memory");
                else asm volatile("s_waitcnt vmcnt(8)" ::: "memory");
                const LAS unsigned char* src = ring + (u & 1) * U6_BUF + (li & 7) * U6_ROWP + 16 * lq;
                f32x4 acc = (f32x4){0.f, 0.f, 0.f, 0.f};
#pragma unroll
                for (int c = 0; c < 16; ++c) { const v4u a = *(const LAS v4u*)(src + 64 * c);
                    acc = __builtin_amdgcn_mfma_f32_16x16x32_fp8_fp8((i64_t)(((unsigned long long)a[1] << 32) | a[0]), (i64_t)(((unsigned long long)hb[c][1] << 32) | hb[c][0]), acc, 0, 0, 0);
                    acc = __builtin_amdgcn_mfma_f32_16x16x32_fp8_fp8((i64_t)(((unsigned long long)a[3] << 32) | a[2]), (i64_t)(((unsigned long long)hb[c][3] << 32) | hb[c][2]), acc, 0, 0, 0); }
                const int base = (u & 7) * 8; const int r = li & 3;
                const float sel = r == 0 ? acc[0] : (r == 1 ? acc[1] : (r == 2 ? acc[2] : acc[3]));
                const float dmine = __shfl(sel, ((lane & 7) >> 2) * 16 + (lane & 3));
                const float gsel = u < 8 ? C.glo : C.ghi, susel = u < 8 ? su_lo : su_hi, svsel = u < 8 ? sv_lo : sv_hi;
                const float wv = gsel * gelu_erf(dmine * susel * hinv) * svsel;
                const bool mine = (lane >= base) && (lane < base + 8);
                if (u < 8) w_lo = mine ? wv : w_lo; else w_hi = mine ? wv : w_hi;
                asm volatile("s_waitcnt lgkmcnt(0)" ::: "memory");
                if (u == 2) { const size_t tn = t0 + (tt < 15 ? tt + 1 : tt); u7_meta_load(N, F.ws, tn, l16); }
                if (u == 10) { nsu_lo = EUS[N.elo]; nsu_hi = EUS[N.ehi]; nsv_lo = EVS[N.elo]; nsv_hi = EVS[N.ehi]; }
            }
            WSP(float, WS_GATE)[(t0 + tt) * 128 + lane] = w_lo; WSP(float, WS_GATE)[(t0 + tt) * 128 + 64 + lane] = w_hi;
            C = N; su_lo = nsu_lo; su_hi = nsu_hi; sv_lo = nsv_lo; sv_hi = nsv_hi;
            u7_h2(C, S2, hq, l16, lq, hb, hinv);
        }
        asm volatile("s_waitcnt vmcnt(0)" ::: "memory");
    }
}
constexpr int NPHASE = 10;
__global__ void __launch_bounds__(NTHR, 2) fwd_mega(Args args) {
    extern __shared__ __attribute__((aligned(16))) unsigned char lds[];
    Frame F;
    F.lds = (LAS unsigned char*)lds;
    F.MISC = (volatile LAS unsigned*)(F.lds + MISC_OFF);
    F.G = gridDim.x; { const int bx = blockIdx.x; F.vcu = (F.G % 8 == 0) ? (bx % 8) * (F.G / 8) + bx / 8 : bx; }
    F.ws = args.ws; F.out = args.out;
    F.a = &args;
    for (int u = threadIdx.x; u < 32; u += NTHR) F.MISC[u] = 0u;
    __syncthreads();
    const int lo = args.ph_lo, hi = args.ph_hi;
    const bool use_bar = (hi - lo) > 1;
    XcdBarrier bar; bar.bar = (unsigned*)(F.ws + WS_CTL); bar.x = 0; bar.st = nullptr;
    if (use_bar) bar = xcd_barrier_post((unsigned*)(F.ws + WS_CTL), F.MISC + 8);
#define IN(k) (lo <= (k) && (k) < hi)
#define SEAM(k) do { if (IN(k) && IN((k) + 1)) xcd_barrier(bar); } while (0)
#ifndef REP_PHASE
#define REP_PHASE -1
#endif
#define REPEAT(k, body) do { if (REP_PHASE == (k)) { xcd_barrier(bar); body; } } while (0)
    if (IN(0)) {
#ifndef SKIP_P0
 p0_phase(F); REPEAT(0, p0_phase(F));
#endif
 } SEAM(0);
    if (IN(1)) {
#ifndef SKIP_P1
 p1_phase(F); REPEAT(1, p1_phase(F));
#endif
 } SEAM(1);
    if (IN(2)) {
        pg8::Gemm g{WSP(bf16, WS_H1), WSP(bf16, WS_WINT), MTOK, NPROJ, 1024}; pg8::StaticOrder S; S.init(MTOK, NPROJ, F.G, (int)blockIdx.x);
        pg8::EpiProj E{WSP(bf16, WS_PROJ), NPROJ};
        pg8::gemm_phase<pg8::EpiProj, pg8::StaticOrder, true, true>(F.lds, g, S, E);
        REPEAT(2, (pg8::gemm_phase<pg8::EpiProj, pg8::StaticOrder, true, true>(F.lds, g, S, E)));
    } SEAM(2);
    if (IN(3)) {
#ifndef SKIP_SSD
#ifdef SSD_NAIVE
 p3_ssd_naive(F);
#elif defined(SSD_V1)
 p3_ssd(F); REPEAT(30, p3_ssd(F));
#elif defined(SSD_V2)
 p3pre_conv(F); xcd_barrier(bar); p3_ssd2(F); REPEAT(30, p3_ssd2(F)); REPEAT(32, p3pre_conv(F));
#else
 p3pre_conv(F); xcd_barrier(bar); p3_ssd3(F); REPEAT(30, p3_ssd3(F)); REPEAT(32, p3pre_conv(F));
#endif
#endif
#ifndef SKIP_S5
#ifdef S5_NAIVE
 p3_s5_naive(F);
#elif defined(S5_V1)
 p3_s5(F); REPEAT(31, p3_s5(F));
#else
 p3_s5v2(F); REPEAT(31, p3_s5v2(F));
#endif
#endif
 } SEAM(3);
#ifdef USE_P3C
    if (IN(4)) { p3c_normalize(F); } SEAM(4);
    if (IN(5)) {
        pg8::Gemm g{WSP(bf16, WS_Y), WSP(bf16, WS_WOUTT), MTOK, 1024, 2048}; pg8::StaticOrder S; S.init(MTOK, 1024, F.G, (int)blockIdx.x);
        PG8_LAS float* tab = (PG8_LAS float*)(F.lds + pg8::STAGE_BYTES);
        for (int i = threadIdx.x; i < 2 * 1280; i += NTHR) tab[i] = 1.0f;
        __syncthreads();
        pg8::EpiX1 E{(F.a->in[0]), F.out, WSP(bf16, WS_X1S), WSP(float, WS_MOD), (F.a->in[24]), WSP(float, WS_ROWSTAT), tab};
        pg8::gemm_phase<pg8::EpiX1, pg8::StaticOrder, true, true>(F.lds, g, S, E);
    } SEAM(5);
#else
    if (IN(5)) {
        pg8::Gemm g{WSP(bf16, WS_Y), WSP(bf16, WS_WOUTT), MTOK, 1024, 2048}; pg8::StaticOrder S; S.init(MTOK, 1024, F.G, (int)blockIdx.x);
        PG8_LAS float* tab = (PG8_LAS float*)(F.lds + pg8::STAGE_BYTES);
        { pg8::Unit u; for (int i = 0; S.next(i, u); ++i) pg8::SegScaleHook::build(F.lds + pg8::STAGE_BYTES, u, WSP(float, WS_STSSD), WSP(float, WS_STS5), (int)threadIdx.x); }
        __syncthreads();
        pg8::EpiX1 E{(F.a->in[0]), F.out, WSP(bf16, WS_X1S), WSP(float, WS_MOD), (F.a->in[24]), WSP(float, WS_ROWSTAT), tab};
        pg8::SegScaleHook H;
        pg8::gemm_phase<pg8::EpiX1, pg8::StaticOrder, true, true, pg8::SegScaleHook>(F.lds, g, S, E, H);
    } SEAM(5);
#endif
    if (IN(6)) {
        pg8::Gemm g{WSP(bf16, WS_X1S), WSP(bf16, WS_WQKT), MTOK, 2048, 1024}; pg8::StaticOrder S; S.init(MTOK, 2048, F.G, (int)blockIdx.x);
        pg8::EpiScores E{WSP(_Float16, WS_SCORES), WSP(float, WS_SB), WSP(float, WS_ROWSTAT)};
        pg8::gemm_phase<pg8::EpiScores, pg8::StaticOrder, true, true>(F.lds, g, S, E);
        REPEAT(6, (pg8::gemm_phase<pg8::EpiScores, pg8::StaticOrder, true, true>(F.lds, g, S, E)));
    } SEAM(6);
    if (IN(7)) {
#ifndef SKIP_TOPK
 p5b_topk(F); REPEAT(7, p5b_topk(F));
#endif
 } SEAM(7);
#ifdef PEER_FUSED
    if (IN(8)) { p8_peer_fused(F); }
#elif defined(PEER_FUSED2)
    if (IN(8)) { p8_peer_fused2(F); }
#else
#ifdef PEER_UP2
    if (IN(8)) { p8_peer_up2(F); } SEAM(8);
#else
#ifdef PEER_UP7
    if (IN(8)) { p8_peer_up7(F); } SEAM(8);
#elif !defined(PEER_UP3)
    if (IN(8)) { p8_peer_up6(F); REPEAT(8, { p5b_topk(F); xcd_barrier(bar); p8_peer_up6(F); }); } SEAM(8);
#elif !defined(PEER_UP4)
    if (IN(8)) { p8_peer_up3(F, bar); } SEAM(8);
#else
    if (IN(8)) { p8_peer_up4(F); REPEAT(8, { p5b_topk(F); xcd_barrier(bar); p8_peer_up4(F); }); } SEAM(8);
#endif
#endif
    if (IN(9)) { p9_peer_down2(F, bar); }
#endif
#undef IN
#undef SEAM
}

#ifndef N_LAUNCHES
#define N_LAUNCHES 1
#endif
extern "C" void kernel_launch(void* const* d_in, const int* in_sizes, int n_in, void* d_out, int out_size, void* d_ws, size_t ws_size, hipStream_t stream) {
    static int grid = 0;
    if (grid == 0) {
        if (n_in != 30 || in_sizes[0] != MTOK * DM || out_size != MTOK * DM || ws_size < WS_END) { fprintf(stderr, "kernel_launch: unexpected shapes (n_in %d, in0 %d, out %d, ws %zu)\n", n_in, n_in > 0 ? in_sizes[0] : -1, out_size, ws_size); grid = -1; return; }
        int dev = 0, cus = 0, per_cu = 0;
        if (hipGetDevice(&dev) != hipSuccess || hipDeviceGetAttribute(&cus, hipDeviceAttributeMultiprocessorCount, dev) != hipSuccess) { grid = -1; return; }
        if (hipFuncSetAttribute((const void*)fwd_mega, hipFuncAttributeMaxDynamicSharedMemorySize, LDS_BYTES) != hipSuccess) { fprintf(stderr, "kernel_launch: hipFuncSetAttribute failed\n"); grid = -1; return; }
        if (hipOccupancyMaxActiveBlocksPerMultiprocessor(&per_cu, (const void*)fwd_mega, NTHR, LDS_BYTES) != hipSuccess || per_cu < 1) { fprintf(stderr, "kernel_launch: occupancy query says %d\n", per_cu); (void)hipGetLastError(); grid = -1; return; }
        grid = cus;
    }
    if (grid < 0) return;
    (void)hipMemsetAsync((char*)d_ws + WS_CTL, 0, CTL_ZERO_BYTES, stream);
    Args a{};
    for (int i = 0; i < 30; ++i) a.in[i] = (const float*)d_in[i];
    a.out = (float*)d_out; a.ws = (unsigned char*)d_ws;
    if (N_LAUNCHES == 1) {
        a.ph_lo = 0; a.ph_hi = NPHASE;
        void* kargs[] = {&a};
        hipError_t e = hipLaunchCooperativeKernel((const void*)fwd_mega, dim3(grid), dim3(NTHR), kargs, LDS_BYTES, stream);
        if (e != hipSuccess) fprintf(stderr, "kernel_launch: cooperative launch failed: %s (grid %d)\n", hipGetErrorString(e), grid);
    } else {
        for (int p = 0; p < NPHASE; ++p) { a.ph_lo = p; a.ph_hi = p + 1; hipLaunchKernelGGL(fwd_mega, dim3(grid), dim3(NTHR), LDS_BYTES, stream, a); }
    }
}
```

```cpp
#include <hip/hip_runtime.h>
#include <cstdio>
#include <cstdint>
namespace pg8 {
#define PG8_LAS __attribute__((address_space(3)))
typedef unsigned short bf16_t;
typedef short bf16x8 __attribute__((ext_vector_type(8)));
typedef float f32x4 __attribute__((ext_vector_type(4)));
typedef unsigned u32x4 __attribute__((ext_vector_type(4)));
constexpr int BM = 256, BK = 64, HALF = 128, HTB = HALF * BK * 2  , STAGE_BYTES = 8 * HTB, NXCD = 8, WGM = 8;

__host__ __device__ __forceinline__ int lds_byte(int r, int c) { const int st = (r >> 4) * 2 + (c >> 5), rr = r & 15, cc = c & 31, ob = rr * 64 + cc * 2; return st * 1024 + (ob ^ (((ob >> 9) & 1) << 5)); }
__host__ __device__ __forceinline__ void stage_rc(int b, int& R, int& C) { const int st = b / 1024, sb = b % 1024, swz = sb ^ (((sb >> 9) & 1) << 5); R = (st >> 1) * 16 + swz / 64; C = (st & 1) * 32 + (swz % 64) / 2; }
__host__ __device__ __forceinline__ int perm32(int rho) { const int n = rho >> 4, i = rho & 15; return 8 * (i >> 2) + 4 * n + (i & 3); }

struct Unit { int pm, pn; };
struct Gemm { const bf16_t* A; const bf16_t* Bt; int M, N, K; };

struct StaticOrder {
    int nM, nN, nwg, G, c;
    __host__ __device__ void init(int M, int N, int G_, int c_) { nM = M / BM; nN = N / BM; nwg = nM * nN; G = G_; c = c_; }
    __host__ __device__ bool next(int i, Unit& u) const {
        const long L = (long)i * G + c; if (L >= nwg) return false;
        int wgid = (int)L; { const int q = nwg / NXCD, r = nwg % NXCD, xcd = wgid % NXCD, off = wgid / NXCD; wgid = (xcd < r ? xcd * (q + 1) : r * (q + 1) + (xcd - r) * q) + off; }
        const int nig = WGM * nN, gid = wgid / nig, fm = gid * WGM, gsz = (nM - fm) < WGM ? (nM - fm) : WGM;
        u.pm = fm + ((wgid % nig) % gsz); u.pn = (wgid % nig) / gsz; return true;
    }
    __device__ __forceinline__ void a_ready(const Unit&) const {}
    __device__ __forceinline__ void done(const Unit&) const {}
};

__device__ __forceinline__ unsigned cvt_pk_bf16(float lo, float hi) { unsigned r; asm volatile("v_cvt_pk_bf16_f32 %0, %1, %2" : "=v"(r) : "v"(lo), "v"(hi)); return r; }
typedef float f32x2 __attribute__((ext_vector_type(2)));
struct NoHook { __device__ __forceinline__ void at_tile(int, const Unit&, f32x4 (&)[2][2][4][2], PG8_LAS unsigned char*, int, int) const {} };
template <class Epi, class Sched, bool ALIGN_EPI = false, bool SP2 = false, class Hook = NoHook>
__device__ __forceinline__ void gemm_phase(PG8_LAS unsigned char* lds, const Gemm g, const Sched& S, const Epi& E, const Hook& H = Hook()) {
    const int tid = threadIdx.x, wid = __builtin_amdgcn_readfirstlane(tid >> 6), lane = tid & 63, wr = wid >> 2, wc = wid & 3, fr = lane & 15, fq = lane >> 4;
    const int K = g.K, nt = K / BK;
    unsigned voffA[2], voffB[2];
#pragma unroll
    for (int i = 0; i < 2; ++i) { int R, C; stage_rc(tid * 16 + i * 8192, R, C); const int Rb = Epi::PERM ? ((R & ~31) + perm32(R & 31)) : R;
        voffA[i] = (unsigned)(R * K + C) * 2u; voffB[i] = (unsigned)(Rb * K + C) * 2u; }
    const size_t kstep = (size_t)(BK * 2);
    const size_t hstep = (size_t)HALF * K * 2;
    const size_t tstep = 2 * hstep;
    const unsigned ldsw = (unsigned)wid * 1024u;
    const int aoff = lds_byte(wr * 64 + fr, fq * 8), boff = lds_byte(wc * 32 + fr, fq * 8);
#define PG8_SA(b, h) (((b) * 2 + (h)) * HTB)
#define PG8_SB(b, h) ((4 + (b) * 2 + (h)) * HTB)
#define PG8_STAGE(bufoff, gbase, voff) do { _Pragma("unroll") for (int _i = 0; _i < 2; ++_i) \
        __builtin_amdgcn_global_load_lds((const unsigned*)((const char*)(gbase) + (voff)[_i]), (PG8_LAS unsigned*)(lds + (bufoff) + ldsw + _i * 8192), 16, 0, 0); } while (0)
#define PG8_LDA(dst, b, h) do { _Pragma("unroll") for (int m = 0; m < 4; ++m) _Pragma("unroll") for (int k = 0; k < 2; ++k) dst[m][k] = *(const PG8_LAS bf16x8*)(lds + PG8_SA(b, h) + aoff + m * 2048 + k * 1024); } while (0)
#define PG8_LDB(dst, b, h) do { _Pragma("unroll") for (int n = 0; n < 2; ++n) _Pragma("unroll") for (int k = 0; k < 2; ++k) dst[n][k] = *(const PG8_LAS bf16x8*)(lds + PG8_SB(b, h) + boff + n * 2048 + k * 1024); } while (0)
#define PG8_MMA(ai, bj, At, Bt) do { __builtin_amdgcn_s_setprio(1); _Pragma("unroll") for (int m = 0; m < 4; ++m) _Pragma("unroll") for (int n = 0; n < 2; ++n) _Pragma("unroll") for (int k = 0; k < 2; ++k) \
        acc[ai][bj][m][n] = __builtin_amdgcn_mfma_f32_16x16x32_bf16(Bt[n][k], At[m][k], acc[ai][bj][m][n], 0, 0, 0); __builtin_amdgcn_s_setprio(0); } while (0)
#define PG8_WAIT_V(n) asm volatile("s_waitcnt vmcnt(" #n ")" ::: "memory")
#define PG8_WAIT_L(n) asm volatile("s_waitcnt lgkmcnt(" #n ")" ::: "memory")
#define PG8_BAR __builtin_amdgcn_s_barrier()
#define PG8_SCHED __builtin_amdgcn_sched_barrier(0)
    Unit cur, nxt; int ui = 0;
    if (!S.next(0, cur)) return;
    f32x4 acc[2][2][4][2];
#pragma unroll
    for (int a = 0; a < 2; ++a)
#pragma unroll
        for (int b = 0; b < 2; ++b)
#pragma unroll
            for (int m = 0; m < 4; ++m)
#pragma unroll
                for (int n = 0; n < 2; ++n) acc[a][b][m][n] = (f32x4){0.f, 0.f, 0.f, 0.f};
    bf16x8 At[4][2], B0[2][2], B1[2][2];
    const char* cA = (const char*)g.A + (size_t)cur.pm * tstep; const char* cB = (const char*)g.Bt + (size_t)cur.pn * tstep;
    S.a_ready(cur);
    if constexpr (SP2) {
        PG8_STAGE(PG8_SB(0, 0), cB, voffB); PG8_STAGE(PG8_SB(0, 1), cB + hstep, voffB); PG8_STAGE(PG8_SA(0, 0), cA, voffA); PG8_STAGE(PG8_SA(0, 1), cA + hstep, voffA);
        if (wr == 1) PG8_BAR;
        PG8_WAIT_V(2); PG8_BAR;
        PG8_STAGE(PG8_SB(1, 0), cB + kstep, voffB); PG8_STAGE(PG8_SA(1, 0), cA + kstep, voffA); PG8_STAGE(PG8_SB(1, 1), cB + hstep + kstep, voffB);
        PG8_WAIT_V(6); PG8_BAR;
    } else {
        PG8_STAGE(PG8_SB(0, 0), cB, voffB); PG8_STAGE(PG8_SA(0, 0), cA, voffA); PG8_STAGE(PG8_SB(0, 1), cB + hstep, voffB); PG8_STAGE(PG8_SA(0, 1), cA + hstep, voffA);
        if (wr == 1) PG8_BAR;
        PG8_WAIT_V(4); PG8_BAR;
        PG8_STAGE(PG8_SB(1, 0), cB + kstep, voffB); PG8_STAGE(PG8_SA(1, 0), cA + kstep, voffA); PG8_STAGE(PG8_SB(1, 1), cB + hstep + kstep, voffB);
        PG8_WAIT_V(6); PG8_BAR;
    }
    for (;;) {
        const bool has_next = S.next(ui + 1, nxt);
        const char* nA = has_next ? (const char*)g.A + (size_t)nxt.pm * tstep : cA; const char* nB = has_next ? (const char*)g.Bt + (size_t)nxt.pn * tstep : cB;
        for (int t = 0; t < nt; t += 2) {
            const bool last = (t == nt - 2);
            H.at_tile(t, cur, acc, lds + STAGE_BYTES, wr, fr);
            const char* a1 = cA + (size_t)(t + 1) * kstep;
            const char* a2 = last ? nA : cA + (size_t)(t + 2) * kstep; const char* b2 = last ? nB : cB + (size_t)(t + 2) * kstep;
            const char* a3 = a2 + kstep; const char* b3 = b2 + kstep;
            if (last && has_next) S.a_ready(nxt);
            if constexpr (SP2) {
            PG8_LDB(B0, 0, 0); PG8_LDB(B1, 0, 1); PG8_SCHED; PG8_LDA(At, 0, 0); PG8_STAGE(PG8_SA(1, 1), a1 + hstep, voffA);
            PG8_WAIT_V(8); PG8_WAIT_L(0); PG8_BAR; PG8_MMA(0, 0, At, B0); PG8_MMA(0, 1, At, B1); PG8_BAR; PG8_SCHED;
            PG8_LDA(At, 0, 1); PG8_STAGE(PG8_SB(0, 0), b2, voffB); PG8_STAGE(PG8_SB(0, 1), b2 + hstep, voffB); PG8_STAGE(PG8_SA(0, 0), a2, voffA);
            PG8_WAIT_V(8); PG8_WAIT_L(0); PG8_BAR; PG8_MMA(1, 0, At, B0); PG8_MMA(1, 1, At, B1); PG8_BAR; PG8_SCHED;
            PG8_LDB(B0, 1, 0); PG8_LDB(B1, 1, 1); PG8_SCHED; PG8_LDA(At, 1, 0); PG8_STAGE(PG8_SA(0, 1), a2 + hstep, voffA);
            PG8_WAIT_V(8); PG8_WAIT_L(0); PG8_BAR; PG8_MMA(0, 0, At, B0); PG8_MMA(0, 1, At, B1); PG8_BAR; PG8_SCHED;
            PG8_LDA(At, 1, 1); PG8_STAGE(PG8_SB(1, 0), b3, voffB); PG8_STAGE(PG8_SB(1, 1), b3 + hstep, voffB); PG8_STAGE(PG8_SA(1, 0), a3, voffA);
            PG8_WAIT_V(8); PG8_WAIT_L(0); PG8_BAR; PG8_MMA(1, 0, At, B0); PG8_MMA(1, 1, At, B1); PG8_BAR; PG8_SCHED;
            } else {
            PG8_LDB(B0, 0, 0); PG8_SCHED; PG8_LDA(At, 0, 0); PG8_STAGE(PG8_SA(1, 1), a1 + hstep, voffA);
            PG8_WAIT_L(8); PG8_BAR; PG8_WAIT_L(0); PG8_MMA(0, 0, At, B0); PG8_BAR; PG8_SCHED;
            PG8_LDB(B1, 0, 1); PG8_STAGE(PG8_SB(0, 0), b2, voffB);
            PG8_BAR; PG8_WAIT_L(0); PG8_MMA(0, 1, At, B1); PG8_BAR;
            PG8_LDA(At, 0, 1); PG8_STAGE(PG8_SA(0, 0), a2, voffA);
            PG8_BAR; PG8_WAIT_L(0); PG8_MMA(1, 0, At, B0); PG8_BAR; PG8_SCHED;
            PG8_STAGE(PG8_SB(0, 1), b2 + hstep, voffB);
            PG8_WAIT_V(6); PG8_BAR; PG8_MMA(1, 1, At, B1); PG8_BAR;
            PG8_LDB(B0, 1, 0); PG8_SCHED; PG8_LDA(At, 1, 0); PG8_STAGE(PG8_SA(0, 1), a2 + hstep, voffA);
            PG8_WAIT_L(8); PG8_BAR; PG8_WAIT_L(0); PG8_MMA(0, 0, At, B0); PG8_BAR; PG8_SCHED;
            PG8_LDB(B1, 1, 1); PG8_STAGE(PG8_SB(1, 0), b3, voffB);
            PG8_BAR; PG8_WAIT_L(0); PG8_MMA(0, 1, At, B1); PG8_BAR;
            PG8_LDA(At, 1, 1); PG8_STAGE(PG8_SA(1, 0), a3, voffA);
            PG8_BAR; PG8_WAIT_L(0); PG8_MMA(1, 0, At, B0); PG8_BAR; PG8_SCHED;
            PG8_STAGE(PG8_SB(1, 1), b3 + hstep, voffB);
            PG8_WAIT_V(6); PG8_BAR; PG8_MMA(1, 1, At, B1); PG8_BAR;
            }
        }
        if constexpr (ALIGN_EPI) { if (wr == 0) PG8_BAR; }
        if constexpr (!Epi::AFTER_DRAIN) { E(acc, cur, wr, wc, fr, fq);
#ifdef PROBE_EPI2
            if constexpr (Epi::PROBE_TWICE) { asm volatile("" ::: "memory"); E(acc, cur, wr, wc, fr, fq); }
#endif
            S.done(cur); }
        if (!has_next) break;
#pragma unroll
        for (int a = 0; a < 2; ++a)
#pragma unroll
            for (int b = 0; b < 2; ++b)
#pragma unroll
                for (int m = 0; m < 4; ++m)
#pragma unroll
                    for (int n = 0; n < 2; ++n) acc[a][b][m][n] = (f32x4){0.f, 0.f, 0.f, 0.f};
        cur = nxt; cA = nA; cB = nB; ++ui;
        if constexpr (ALIGN_EPI) { if (wr == 1) PG8_BAR; }
    }
    PG8_WAIT_V(0);
    if constexpr (!ALIGN_EPI) { if (wr == 0) PG8_BAR; }
    PG8_BAR;
    if constexpr (Epi::AFTER_DRAIN) { E.fused(acc, cur, wr, wc, fr, fq, lds, wid, lane); S.done(cur); }
#undef PG8_SA
#undef PG8_SB
#undef PG8_STAGE
#undef PG8_LDA
#undef PG8_LDB
#undef PG8_MMA
#undef PG8_WAIT_V
#undef PG8_WAIT_L
#undef PG8_BAR
#undef PG8_SCHED
}
}
namespace pg8 {
struct EpiProj {
    static constexpr bool PERM = true, AFTER_DRAIN = false, PROBE_TWICE = true;
    bf16_t* O; int ldc;
    __device__ __forceinline__ void operator()(const f32x4 (&acc)[2][2][4][2], const Unit& u, int wr, int wc, int fr, int fq) const {
        const int row0 = u.pm * BM + wr * 64 + fr; const int col0 = u.pn * BM + wc * 32 + 8 * fq;
#pragma unroll
        for (int ai = 0; ai < 2; ++ai)
#pragma unroll
            for (int m = 0; m < 4; ++m) { bf16_t* rowp = O + (size_t)(row0 + ai * HALF + m * 16) * ldc + col0;
#pragma unroll
                for (int bj = 0; bj < 2; ++bj) { const f32x4 v0 = acc[ai][bj][m][0], v1 = acc[ai][bj][m][1];
                    u32x4 w; w.x = cvt_pk_bf16(v0[0], v0[1]); w.y = cvt_pk_bf16(v0[2], v0[3]); w.z = cvt_pk_bf16(v1[0], v1[1]); w.w = cvt_pk_bf16(v1[2], v1[3]);
                    __builtin_nontemporal_store(w, (u32x4*)(rowp + bj * HALF)); } }
    }
};
struct EpiX1 {
    static constexpr bool PERM = true, AFTER_DRAIN = false, PROBE_TWICE = false;
    const float* x; float* x1; bf16_t* x1s; const float* mod; const float* norm2_g; float* rowstat; PG8_LAS float* tab;
    __device__ __forceinline__ void operator()(const f32x4 (&acc)[2][2][4][2], const Unit& u, int wr, int wc, int fr, int fq) const {
        const int row0 = u.pm * BM + wr * 64 + fr; const int col0 = u.pn * BM + wc * 32 + 8 * fq; const int b = (u.pm * BM) >> 11;
        const float* mb = mod + (size_t)b * 6144;
        f32x4 g1[2][2], g2[2][2];
#pragma unroll
        for (int bj = 0; bj < 2; ++bj)
#pragma unroll
            for (int n = 0; n < 2; ++n) { const int c = col0 + bj * HALF + 4 * n; g1[bj][n] = *(const f32x4*)(mb + 2048 + c);
                const f32x4 sc = *(const f32x4*)(mb + 4096 + c), ng = *(const f32x4*)(norm2_g + c); g2[bj][n] = ng * (sc + 1.0f); }
#pragma unroll
        for (int ai = 0; ai < 2; ++ai)
#pragma unroll
            for (int m = 0; m < 4; ++m) { const size_t row = (size_t)(row0 + ai * HALF + m * 16); const size_t off = row * 1024 + col0; float ss = 0.f;
                const float rfin = tab[((u.pm >> 3) & 1) * 1280 + 1024 + ai * HALF + wr * 64 + m * 16 + fr];
#pragma unroll
                for (int bj = 0; bj < 2; ++bj) {
                    const f32x4 xa = *(const f32x4*)(x + off + bj * HALF), xb = *(const f32x4*)(x + off + bj * HALF + 4);
                    const f32x4 v0 = xa + g1[bj][0] * (acc[ai][bj][m][0] * rfin), v1 = xb + g1[bj][1] * (acc[ai][bj][m][1] * rfin);
                    *(f32x4*)(x1 + off + bj * HALF) = v0; *(f32x4*)(x1 + off + bj * HALF + 4) = v1;
                    ss += (v0[0] * v0[0] + v0[1] * v0[1]) + (v0[2] * v0[2] + v0[3] * v0[3]) + (v1[0] * v1[0] + v1[1] * v1[1]) + (v1[2] * v1[2] + v1[3] * v1[3]);
                    const f32x4 s0 = v0 * g2[bj][0], s1 = v1 * g2[bj][1];
                    u32x4 w; w.x = cvt_pk_bf16(s0[0], s0[1]); w.y = cvt_pk_bf16(s0[2], s0[3]); w.z = cvt_pk_bf16(s1[0], s1[1]); w.w = cvt_pk_bf16(s1[2], s1[3]);
                    *(u32x4*)(x1s + off + bj * HALF) = w; }
                ss += __shfl_xor(ss, 16); ss += __shfl_xor(ss, 32);
                if (fq == 0) atomicAdd(rowstat + row, ss); }
    }
};
typedef _Float16 f16x8 __attribute__((ext_vector_type(8)));
struct EpiScores {
    static constexpr bool PERM = true, AFTER_DRAIN = false, PROBE_TWICE = false;
    _Float16* S; const float* sb; const float* rowstat;
    __device__ __forceinline__ void operator()(const f32x4 (&acc)[2][2][4][2], const Unit& u, int wr, int wc, int fr, int fq) const {
        const int row0 = u.pm * BM + wr * 64 + fr; const int col0 = u.pn * BM + wc * 32 + 8 * fq; const int b = (u.pm * BM) >> 11;
        f32x4 bv[2][2];
#pragma unroll
        for (int bj = 0; bj < 2; ++bj)
#pragma unroll
            for (int n = 0; n < 2; ++n) bv[bj][n] = *(const f32x4*)(sb + (size_t)b * 2048 + col0 + bj * HALF + 4 * n);
#pragma unroll
        for (int ai = 0; ai < 2; ++ai)
#pragma unroll
            for (int m = 0; m < 4; ++m) { const size_t row = (size_t)(row0 + ai * HALF + m * 16); const float rs = __builtin_amdgcn_rsqf(rowstat[row] * (1.0f / 1024.0f) + 1e-6f);
                _Float16* rowp = S + row * 2048 + col0;
#pragma unroll
                for (int bj = 0; bj < 2; ++bj) { const f32x4 v0 = acc[ai][bj][m][0] * rs + bv[bj][0], v1 = acc[ai][bj][m][1] * rs + bv[bj][1];
                    f16x8 h; h[0] = (_Float16)v0[0]; h[1] = (_Float16)v0[1]; h[2] = (_Float16)v0[2]; h[3] = (_Float16)v0[3]; h[4] = (_Float16)v1[0]; h[5] = (_Float16)v1[1]; h[6] = (_Float16)v1[2]; h[7] = (_Float16)v1[3];
                    *(f16x8*)(rowp + bj * HALF) = h; } }
    }
};
struct SegScaleHook {
    __device__ __forceinline__ static void build(PG8_LAS unsigned char* ldsx, const Unit& u, const float* st_ssd, const float* st_s5, int tid) {
        PG8_LAS float* tab = (PG8_LAS float*)ldsx + ((u.pm >> 3) & 1) * 1280;
        if (tid < 256) { const size_t row = (size_t)u.pm * BM + tid; const f32x4* sg = (const f32x4*)(st_ssd + row * 16); const f32x4* s5 = (const f32x4*)(st_s5 + row * 64);
            float r[5];
#pragma unroll
            for (int gI = 0; gI < 4; ++gI) { const f32x4 v = sg[gI]; r[gI] = __builtin_amdgcn_rsqf(((v[0] + v[1]) + (v[2] + v[3])) * (1.0f / 256.0f) + 1e-6f); }
            float a5 = 0.f;
#pragma unroll
            for (int q = 0; q < 16; ++q) { const f32x4 v = s5[q]; a5 += (v[0] + v[1]) + (v[2] + v[3]); }
            r[4] = __builtin_amdgcn_rsqf(a5 * (1.0f / 1024.0f) + 1e-6f);
#pragma unroll
            for (int k = 0; k < 4; ++k) tab[k * 256 + tid] = r[k] * __builtin_amdgcn_rcpf(r[k + 1]);
            tab[1024 + tid] = r[4]; }
    }
    __device__ __forceinline__ void at_tile(int t, const Unit& u, f32x4 (&acc)[2][2][4][2], PG8_LAS unsigned char* ldsx, int wr, int fr) const {
        if (t == 4 || t == 8 || t == 12 || t == 16) { const PG8_LAS float* rt = (const PG8_LAS float*)ldsx + ((u.pm >> 3) & 1) * 1280 + ((t >> 2) - 1) * 256 + wr * 64 + fr;
#pragma unroll
            for (int ai = 0; ai < 2; ++ai)
#pragma unroll
                for (int m = 0; m < 4; ++m) { const float r = rt[ai * HALF + m * 16];
#pragma unroll
                    for (int bj = 0; bj < 2; ++bj) { acc[ai][bj][m][0] = acc[ai][bj][m][0] * r; acc[ai][bj][m][1] = acc[ai][bj][m][1] * r; } } }
    }
};
}
constexpr int NWAVES = 8, NTHR = 512;
constexpr int DM = 1024, NB = 16, SEQ = 2048, MTOK = NB * SEQ;
constexpr int NPROJ = 4096;
constexpr int INW = 4112;
constexpr int NHEADS = 16, HDIM = 64, NGRP = 4, NST = 128, CHUNK = 128;
constexpr int S5G = 64, S5CH = 16, S5P = 64;
constexpr int PH = 8, PK = 16, PNK = 128;
constexpr float EPSF = 1e-6f;
constexpr int NS5PART = 64;

constexpr size_t MiB = 1u << 20;
constexpr size_t WS_CTL = 0, CTL_ZERO_BYTES = 64 * 1024;
constexpr size_t WS_MOD = 1 * MiB;
constexpr size_t WS_WDT = WS_MOD + 0x60000;
constexpr size_t WS_SB = WS_MOD + 0x70000;
constexpr size_t WS_ROWSTAT = WS_MOD + 0x90000;
constexpr size_t WS_S5LB = WS_MOD + 0xB0000;
constexpr size_t WS_S5BB = WS_MOD + 0xC0000;
constexpr size_t WS_DTRAW = 3 * MiB;
constexpr size_t WS_STSSD = 5 * MiB;
constexpr size_t WS_STS5 = 7 * MiB;
constexpr size_t WS_WINT = 15 * MiB;
constexpr size_t WS_WOUTT = 23 * MiB;
constexpr size_t WS_WQKT = 27 * MiB;
constexpr size_t WS_EU = 31 * MiB, WS_EV = 47 * MiB;
constexpr size_t WS_EUS = 63 * MiB, WS_EVS = 63 * MiB + 65536;
constexpr size_t WS_START = 64 * MiB;
constexpr size_t WS_A = 95 * MiB;
constexpr size_t WS_B = 223 * MiB;
constexpr size_t WS_H1 = WS_A, WS_Y = WS_A, WS_PROJ = WS_B, WS_SCORES = WS_A;
constexpr size_t WS_X1S = WS_B + 192 * MiB;
constexpr size_t WS_EID = 479 * MiB, WS_GATE = 495 * MiB;
constexpr size_t WS_END = 511 * MiB;
static_assert(WS_SCORES + (size_t)MTOK * 2048 * 4 <= WS_X1S && WS_X1S + (size_t)MTOK * 1024 * 2 <= WS_EID && WS_GATE + (size_t)MTOK * 128 * 4 <= WS_END, "ws map");

constexpr int LDS_MAIN = 159744;
constexpr int MISC_OFF = LDS_MAIN;
constexpr int LDS_BYTES = LDS_MAIN + 128;

#define GAS __attribute__((address_space(1)))
#define LAS __attribute__((address_space(3)))
typedef unsigned short bf16;
typedef unsigned v4u __attribute__((ext_vector_type(4)));
typedef unsigned v2u __attribute__((ext_vector_type(2)));
typedef float f32x4 __attribute__((ext_vector_type(4)));
typedef float f32x2 __attribute__((ext_vector_type(2)));
typedef short bf16x8 __attribute__((ext_vector_type(8)));
#define LDS_WAIT() asm volatile("s_waitcnt lgkmcnt(0)" ::: "memory")
#define VM_WAIT() asm volatile("s_waitcnt vmcnt(0)" ::: "memory")
typedef __bf16 hwbf16x2 __attribute__((ext_vector_type(2)));
__device__ __forceinline__ unsigned pk2(float lo, float hi) { const f32x2 v = {lo, hi}; const hwbf16x2 b = __builtin_convertvector(v, hwbf16x2); return __builtin_bit_cast(unsigned, b); }
__device__ __forceinline__ unsigned f2bf(float f) { return pk2(f, 0.f) & 0xffffu; }
__device__ __forceinline__ float bflo(unsigned w) { return __builtin_bit_cast(float, w << 16); }
__device__ __forceinline__ float bfhi(unsigned w) { return __builtin_bit_cast(float, w & 0xffff0000u); }
__device__ __forceinline__ float bf2f(bf16 v) { return __builtin_bit_cast(float, (unsigned)v << 16); }
__device__ __forceinline__ float wave_sum(float v) {
#pragma unroll
    for (int o = 1; o < 64; o <<= 1) v += __shfl_xor(v, o);
    return v;
}
__device__ __forceinline__ float sigmoid_f(float v) { return __builtin_amdgcn_rcpf(1.0f + __builtin_amdgcn_exp2f(-1.4426950408889634f * v)); }
__device__ __forceinline__ float silu_f(float v) { return v * sigmoid_f(v); }
__device__ __forceinline__ float rsqrt_f(float v) { return __builtin_amdgcn_rsqf(v); }
__device__ __forceinline__ float gelu_erf(float v) {
    const float av = fabsf(v), t = __builtin_amdgcn_rcpf(av * 0.2316418882f + 1.0f);
    float q = t * 0.5307027145f + (-0.7265760135f); q = q * t + 0.7107068705f; q = q * t + (-0.142248368f); q = q * t + 0.127414796f; q = q * t;
    const float e = __builtin_amdgcn_exp2f((v * v) * (-0.72134752044f));
    const float m = v * (q * e);
    return v < 0.f ? m : v - m;
}
__device__ __forceinline__ float softplus_f(float v) { return fmaxf(v, 0.f) + 0.6931471805599453f * __builtin_amdgcn_logf(1.0f + __builtin_amdgcn_exp2f(-1.4426950408889634f * fabsf(v))); }
__device__ __forceinline__ void unpack8(const v4u w, float* f) { f[0] = bflo(w.x); f[1] = bfhi(w.x); f[2] = bflo(w.y); f[3] = bfhi(w.y); f[4] = bflo(w.z); f[5] = bfhi(w.z); f[6] = bflo(w.w); f[7] = bfhi(w.w); }
#define LDS_BARRIER() do { asm volatile("s_waitcnt lgkmcnt(0)" ::: "memory"); __builtin_amdgcn_s_barrier(); asm volatile("" ::: "memory"); } while (0)
__device__ __forceinline__ float row16_sum_to15(float v) {
    v += __builtin_bit_cast(float, __builtin_amdgcn_update_dpp(0, __builtin_bit_cast(int, v), 0x118, 0xf, 0xf, true));
    v += __builtin_bit_cast(float, __builtin_amdgcn_update_dpp(0, __builtin_bit_cast(int, v), 0x114, 0xf, 0xf, true));
    v += __builtin_bit_cast(float, __builtin_amdgcn_update_dpp(0, __builtin_bit_cast(int, v), 0x112, 0xf, 0xf, true));
    v += __builtin_bit_cast(float, __builtin_amdgcn_update_dpp(0, __builtin_bit_cast(int, v), 0x111, 0xf, 0xf, true));
    return v;
}
__device__ __forceinline__ float wave_sum_to63(float v) {
    v = row16_sum_to15(v);
    v += __builtin_bit_cast(float, __builtin_amdgcn_update_dpp(0, __builtin_bit_cast(int, v), 0x142, 0xa, 0xf, false));
    v += __builtin_bit_cast(float, __builtin_amdgcn_update_dpp(0, __builtin_bit_cast(int, v), 0x143, 0xc, 0xf, false));
    return v;
}
__device__ __forceinline__ f32x2 gelu_pk2(f32x2 v) {
    const f32x2 av = __builtin_elementwise_abs(v), d = av * 0.2316418882f + 1.0f;
    f32x2 t; t[0] = __builtin_amdgcn_rcpf(d[0]); t[1] = __builtin_amdgcn_rcpf(d[1]);
    f32x2 q = t * 0.5307027145f + (-0.7265760135f); q = q * t + 0.7107068705f; q = q * t + (-0.142248368f); q = q * t + 0.127414796f; q = q * t;
    const f32x2 s = (v * v) * (-0.72134752044f);
    f32x2 e; e[0] = __builtin_amdgcn_exp2f(s[0]); e[1] = __builtin_amdgcn_exp2f(s[1]);
    const f32x2 m = v * (q * e), r = v - m;
    f32x2 o; o[0] = v[0] < 0.f ? m[0] : r[0]; o[1] = v[1] < 0.f ? m[1] : r[1]; return o;
}
#define XB_TMO      128
#define XB_XCNT(j)  (256  + 64 * (j))
#define XB_XSUB(j)  (1280 + 64 * (j))
#define XB_XGEN(j)  (2304 + 64 * (j))
#define XB_TOP      3328
#define XB_TOPGEN   3392
#define XCD_BAR_WORDS 3456
#define XB_SPIN_CAP (1u << 18)

__device__ __forceinline__ unsigned xb_ld(unsigned* p)              { return __hip_atomic_load(p, __ATOMIC_RELAXED, __HIP_MEMORY_SCOPE_AGENT); }
__device__ __forceinline__ unsigned xb_add(unsigned* p, unsigned v) { return __hip_atomic_fetch_add(p, v, __ATOMIC_RELAXED, __HIP_MEMORY_SCOPE_AGENT); }
__device__ __forceinline__ unsigned xb_xcc_id() { return (unsigned)__builtin_amdgcn_s_getreg((3 << 11) | 20) & 0xFu; }
#define XB_SPIN(cond, bar) do { unsigned _sp = 0; while (cond) { __builtin_amdgcn_s_sleep(1); \
    if ((++_sp & 255u) == 0u) { if (xb_ld(&(bar)[XB_TMO])) break; if (_sp > XB_SPIN_CAP) { atomicAdd(&(bar)[XB_TMO], 1u); break; } } } } while (0)

struct XcdBarrier {
    unsigned* bar; unsigned x;
    volatile LAS unsigned* st;
};

__device__ __forceinline__ XcdBarrier xcd_barrier_post(unsigned* bar, volatile LAS unsigned* st) {
    XcdBarrier b; b.bar = bar; b.x = xb_xcc_id(); b.st = st;
    if (threadIdx.x == 0) (void)xb_add(&bar[XB_XCNT(b.x)], 1u);
    return b;
}
__device__ __forceinline__ void xcd_barrier_complete(unsigned* bar, unsigned x, unsigned& nloc, unsigned& nx) {
    const unsigned G = gridDim.x * gridDim.y * gridDim.z;
    unsigned sum, cnt, mine, sp = 0u;
    for (;;) {
        sum = 0u; cnt = 0u; mine = 0u;
#pragma unroll
        for (unsigned j = 0; j < 16; ++j) { const unsigned c = xb_ld(&bar[XB_XCNT(j)]); sum += c; cnt += (c > 0u) ? 1u : 0u; mine = (j == x) ? c : mine; }
        if (sum == G) break;
        __builtin_amdgcn_s_sleep(1);
        if ((++sp & 255u) == 0u) { if (xb_ld(&bar[XB_TMO])) break; if (sp > XB_SPIN_CAP) { atomicAdd(&bar[XB_TMO], 1u); break; } }
    }
    nloc = mine > 0u ? mine : 1u; nx = cnt > 0u ? cnt : 1u;
}

__device__ __forceinline__ void xcd_barrier(const XcdBarrier& b) {
    asm volatile("s_waitcnt vmcnt(0)" ::: "memory");
    __syncthreads();
    if (threadIdx.x == 0) {
        unsigned* bar = b.bar;
        __builtin_amdgcn_s_waitcnt(0);
        unsigned nloc = b.st[0], nx = b.st[1];
        if (nloc == 0u) { xcd_barrier_complete(bar, b.x, nloc, nx); b.st[0] = nloc; b.st[1] = nx; }
        const unsigned old = xb_add(&bar[XB_XSUB(b.x)], 1u);
        const unsigned gen = old / nloc;
        if (old + 1u == (gen + 1u) * nloc) {
            __builtin_amdgcn_fence(__ATOMIC_RELEASE, "agent");
            asm volatile("s_waitcnt vmcnt(0)" ::: "memory");
            const unsigned og = xb_add(&bar[XB_TOP], 1u);
            const unsigned tg = og / nx;
            if (og + 1u == (tg + 1u) * nx) xb_add(&bar[XB_TOPGEN], 1u);
            else XB_SPIN(xb_ld(&bar[XB_TOPGEN]) == tg, bar);
            __builtin_amdgcn_fence(__ATOMIC_ACQUIRE, "agent");
            xb_add(&bar[XB_XGEN(b.x)], 1u);
            asm volatile("s_waitcnt vmcnt(0)" ::: "memory");
        } else {
            XB_SPIN(xb_ld(&bar[XB_XGEN(b.x)]) == gen, bar);
            __builtin_amdgcn_fence(__ATOMIC_ACQUIRE, "agent");
            asm volatile("s_waitcnt vmcnt(0)" ::: "memory");
        }
    }
    __syncthreads();
}
struct Args { const float* in[30]; float* out; unsigned char* ws; int ph_lo, ph_hi; };
struct Frame {
    LAS unsigned char* lds;
    volatile LAS unsigned* MISC;
    int vcu, G;
    unsigned char* ws;
    const Args* a;
    float* out;
};
#define WSP(T, off) ((T*)(F.ws + (off)))

__device__ __forceinline__ void transpose_tile(const float* W, int ldw, int k0, int src_n0, bf16* WT, int K, int dst_n0, LAS float* scr, int lane, const float* kscale) {
#pragma unroll 8
    for (int i = 0; i < 32; ++i) { const int kk = 2 * i + (lane >> 5); float v = W[(size_t)(k0 + kk) * ldw + src_n0 + (lane & 31)]; if (kscale) v *= kscale[k0 + kk]; scr[kk * 33 + (lane & 31)] = v; }
    LDS_WAIT(); asm volatile("" ::: "memory");
    const int c = lane & 7;
#pragma unroll
    for (int j = 0; j < 4; ++j) { const int n = (lane >> 3) + 8 * j; const LAS float* s = scr + (8 * c) * 33 + n;
        v4u o; o.x = pk2(s[0 * 33], s[1 * 33]); o.y = pk2(s[2 * 33], s[3 * 33]); o.z = pk2(s[4 * 33], s[5 * 33]); o.w = pk2(s[6 * 33], s[7 * 33]);
        *(v4u*)(WT + (size_t)(dst_n0 + n) * K + k0 + 8 * c) = o; }
    LDS_WAIT(); asm volatile("" ::: "memory");
}
__device__ __forceinline__ void p0_phase(Frame& F) {
    const int f_tid = threadIdx.x, f_lane = f_tid & 63, f_wave = __builtin_amdgcn_readfirstlane(f_tid >> 6);
    const int gw = F.vcu * NWAVES + f_wave, NGW = F.G * NWAVES, gt = F.vcu * NTHR + f_tid, NGT = F.G * NTHR;
    {
        LAS float* sc = (LAS float*)F.lds;
        LAS float* red = (LAS float*)(F.lds + 65536);
        for (int i = f_tid; i < 16 * 1024; i += NTHR) { const int b = i >> 10, k = i & 1023; sc[k * 16 + b] = silu_f((F.a->in[1])[i]); }
        __syncthreads();
        const int ks = f_tid / 24, col = f_tid - ks * 24, j = F.vcu * 24 + col;
        if (ks < 21) {
            float acc[16];
#pragma unroll
            for (int b = 0; b < 16; ++b) acc[b] = 0.f;
            const int k0 = ks * 49, kn = (k0 + 49 <= 1024) ? 49 : (1024 - k0);
            const float* wp = (F.a->in[2]) + (size_t)k0 * 6144 + j;
#pragma unroll 1
            for (int kb = 0; kb < 49; kb += 7) {
                asm volatile("" ::: "memory");
                float wv[7];
#pragma unroll
                for (int u = 0; u < 7; ++u) wv[u] = (kb + u < kn) ? wp[(size_t)(kb + u) * 6144] : 0.f;
#pragma unroll
                for (int u = 0; u < 7; ++u) { const int kk = (kb + u < kn) ? (k0 + kb + u) : k0; const LAS f32x4* s4 = (const LAS f32x4*)(sc + kk * 16);
#pragma unroll
                    for (int q = 0; q < 4; ++q) { const f32x4 sv = s4[q]; acc[4 * q] += sv[0] * wv[u]; acc[4 * q + 1] += sv[1] * wv[u]; acc[4 * q + 2] += sv[2] * wv[u]; acc[4 * q + 3] += sv[3] * wv[u]; } }
            }
#pragma unroll
            for (int b = 0; b < 16; ++b) red[(ks * 16 + b) * 24 + col] = acc[b];
        }
        __syncthreads();
        for (int i = f_tid; i < 16 * 24; i += NTHR) { const int b = i / 24, cc = i - b * 24; float sacc = 0.f;
            for (int q = 0; q < 21; ++q) sacc += red[(q * 16 + b) * 24 + cc];
            WSP(float, WS_MOD)[b * 6144 + F.vcu * 24 + cc] = sacc + (F.a->in[3])[F.vcu * 24 + cc]; }
        __syncthreads();
    }
    {
        LAS float* scr = (LAS float*)(F.lds + f_wave * 16384);
        constexpr int I_IN = (1024 / 64) * (NPROJ / 32), I_OUT = (2048 / 64) * (1024 / 32);
        for (int it = gw; it < I_IN + I_OUT; it += NGW) {
            if (it < I_IN) { const int kb = it / (NPROJ / 32), nb = it % (NPROJ / 32); const int dn = 32 * nb, sn = dn < 3072 ? dn : dn + 16;
                transpose_tile((F.a->in[5]), INW, 64 * kb, sn, WSP(bf16, WS_WINT), 1024, dn, scr, f_lane, nullptr); }
            else { const int r = it - I_IN, kb = r / 32, nb = r % 32; const int k0 = 64 * kb;
                transpose_tile((F.a->in[23]), 1024, k0, 32 * nb, WSP(bf16, WS_WOUTT), 2048, 32 * nb, scr, f_lane, k0 < 1024 ? (F.a->in[11]) : (F.a->in[22]) - 1024); }
        }
    }
    for (int i = gt; i < 16 * 1024; i += NGT) { const int h = i >> 10, k = i & 1023; WSP(float, WS_WDT)[i] = (F.a->in[5])[(size_t)k * INW + 3072 + h]; }
    for (int task = gw; task < 2048; task += NGW) {
        const int nt = task >> 4, ks = task & 15, n0 = 16 * nt, hc = n0 >> 7, k0 = 64 * ks;
        const int li = f_lane & 15, lq = f_lane >> 4;
        f32x4 acc[4];
#pragma unroll
        for (int s = 0; s < 4; ++s) acc[s] = (f32x4){0.f, 0.f, 0.f, 0.f};
        const float* ap = (F.a->in[26]) + (size_t)(n0 + li) * 128 + 4 * lq;
        const float* bp = (F.a->in[25]) + (size_t)(k0 + li) * 2048 + hc * 128 + 4 * lq;
#pragma unroll
        for (int q = 0; q < 8; ++q) { const f32x4 a = *(const f32x4*)(ap + 16 * q);
#pragma unroll
            for (int s = 0; s < 4; ++s) { const f32x4 b = *(const f32x4*)(bp + (size_t)(16 * s) * 2048 + 16 * q);
#pragma unroll
                for (int jj = 0; jj < 4; ++jj) acc[s] = __builtin_amdgcn_mfma_f32_16x16x4f32(a[jj], b[jj], acc[s], 0, 0, 0); } }
        bf16* o = WSP(bf16, WS_WQKT);
#pragma unroll
        for (int s = 0; s < 4; ++s)
#pragma unroll
            for (int r = 0; r < 4; ++r) o[(size_t)(n0 + 4 * lq + r) * 1024 + k0 + 16 * s + li] = (bf16)f2bf(acc[s][r]);
    }
    for (int i = gt; i < S5G * S5P; i += NGT) {
        const float lr = (F.a->in[12])[i], li = (F.a->in[13])[i], dt = expf((F.a->in[14])[i >> 6]);
        const float mag = expf(lr * dt); float sn, cs; sincosf(li * dt, &sn, &cs);
        const float lbr = mag * cs, lbi = mag * sn, den = lr * lr + li * li;
        const float cfr = ((lbr - 1.0f) * lr + lbi * li) / den, cfi = (lbi * lr - (lbr - 1.0f) * li) / den;
        WSP(float, WS_S5LB)[2 * i] = lbr; WSP(float, WS_S5LB)[2 * i + 1] = lbi;
        for (int hh = 0; hh < 16; ++hh) { const float br = (F.a->in[15])[i * 16 + hh], bi = (F.a->in[16])[i * 16 + hh];
            WSP(float, WS_S5BB)[i * 32 + hh] = cfr * br - cfi * bi; WSP(float, WS_S5BB)[i * 32 + 16 + hh] = cfr * bi + cfi * br; }
    }
    for (int i = gt; i < MTOK; i += NGT) WSP(float, WS_ROWSTAT)[i] = 0.f;
}

__device__ __forceinline__ void p1_phase(Frame& F) {
    const int f_tid = threadIdx.x, f_lane = f_tid & 63, f_wave = __builtin_amdgcn_readfirstlane(f_tid >> 6);
    const int gw = F.vcu * NWAVES + f_wave;
    LAS float* wdt = (LAS float*)F.lds;
    for (int i = f_tid; i < 16 * 1024 / 4; i += NTHR) ((LAS f32x4*)wdt)[i] = ((const f32x4*)WSP(float, WS_WDT))[i];
    __syncthreads();
    const int lane = f_lane;
    for (int wq = gw; wq < MTOK / 16; wq += F.G * NWAVES) {
        const int b = wq >> 7; const float* mb = WSP(float, WS_MOD) + (size_t)b * 6144;
        f32x4 Gv[4], Sv[4];
#pragma unroll
        for (int j = 0; j < 4; ++j) { const int k = 4 * lane + 256 * j; const f32x4 g = *(const f32x4*)((F.a->in[4]) + k), sc = *(const f32x4*)(mb + 1024 + k); Gv[j] = g * (sc + 1.0f); Sv[j] = *(const f32x4*)(mb + k); }
        f32x4 nx[4];
#pragma unroll
        for (int j = 0; j < 4; ++j) nx[j] = *(const f32x4*)((F.a->in[0]) + (size_t)wq * 16 * 1024 + 4 * lane + 256 * j);
        for (int tt = 0; tt < 16; ++tt) {
            asm volatile("" ::: "memory");
            const size_t t = (size_t)wq * 16 + tt; const float* xr = (F.a->in[0]) + t * 1024;
            f32x4 v[4]; float ss = 0.f;
#pragma unroll
            for (int j = 0; j < 4; ++j) { v[j] = nx[j]; ss += (v[j][0] * v[j][0] + v[j][1] * v[j][1]) + (v[j][2] * v[j][2] + v[j][3] * v[j][3]); }
            if (tt < 15) {
#pragma unroll
                for (int j = 0; j < 4; ++j) nx[j] = *(const f32x4*)(xr + 1024 + 4 * lane + 256 * j); }
            const float rstd = rsqrt_f(wave_sum(ss) * (1.0f / 1024.0f) + EPSF);
            bf16* hr = WSP(bf16, WS_H1) + t * 1024;
#pragma unroll
            for (int j = 0; j < 4; ++j) { v[j] = v[j] * rstd * Gv[j] + Sv[j]; v2u w; w.x = pk2(v[j][0], v[j][1]); w.y = pk2(v[j][2], v[j][3]); *(v2u*)(hr + 4 * lane + 256 * j) = w; }
            float d[16];
#pragma unroll
            for (int h = 0; h < 16; ++h) { float a = 0.f;
#pragma unroll
                for (int j = 0; j < 4; ++j) { const f32x4 w = *(const LAS f32x4*)(wdt + h * 1024 + 4 * lane + 256 * j); a += (v[j][0] * w[0] + v[j][1] * w[1]) + (v[j][2] * w[2] + v[j][3] * w[3]); }
                d[h] = a; }
            float e8[8], e4[4], e2[2], e1;
#pragma unroll
            for (int i = 0; i < 8; ++i) { const bool up = lane & 32; const float snd = up ? d[i] : d[i + 8]; const float rcv = __shfl_xor(snd, 32); e8[i] = (up ? d[i + 8] : d[i]) + rcv; }
#pragma unroll
            for (int i = 0; i < 4; ++i) { const bool up = lane & 16; const float snd = up ? e8[i] : e8[i + 4]; const float rcv = __shfl_xor(snd, 16); e4[i] = (up ? e8[i + 4] : e8[i]) + rcv; }
#pragma unroll
            for (int i = 0; i < 2; ++i) { const bool up = lane & 8; const float snd = up ? e4[i] : e4[i + 2]; const float rcv = __shfl_xor(snd, 8); e2[i] = (up ? e4[i + 2] : e4[i]) + rcv; }
            { const bool up = lane & 4; const float snd = up ? e2[0] : e2[1]; const float rcv = __shfl_xor(snd, 4); e1 = (up ? e2[1] : e2[0]) + rcv; }
            e1 += __shfl_xor(e1, 2); e1 += __shfl_xor(e1, 1);
            const int head = ((lane >> 5) & 1) * 8 + ((lane >> 4) & 1) * 4 + ((lane >> 3) & 1) * 2 + ((lane >> 2) & 1);
            if ((lane & 3) == 0) WSP(float, WS_DTRAW)[t * 16 + head] = e1;
        }
    }
    for (int n = gw; n < 2048; n += F.G * NWAVES) {
        const bf16* wr = WSP(bf16, WS_WQKT) + (size_t)n * 1024 + 16 * lane;
        const v4u w0 = *(const v4u*)wr, w1 = *(const v4u*)(wr + 8);
        float wv[16]; wv[0] = bflo(w0.x); wv[1] = bfhi(w0.x); wv[2] = bflo(w0.y); wv[3] = bfhi(w0.y); wv[4] = bflo(w0.z); wv[5] = bfhi(w0.z); wv[6] = bflo(w0.w); wv[7] = bfhi(w0.w);
        wv[8] = bflo(w1.x); wv[9] = bfhi(w1.x); wv[10] = bflo(w1.y); wv[11] = bfhi(w1.y); wv[12] = bflo(w1.z); wv[13] = bfhi(w1.z); wv[14] = bflo(w1.w); wv[15] = bfhi(w1.w);
        for (int b = 0; b < 16; ++b) { const float* sp = WSP(float, WS_MOD) + (size_t)b * 6144 + 3072 + 16 * lane; float a = 0.f;
#pragma unroll
            for (int q = 0; q < 4; ++q) { const f32x4 s = *(const f32x4*)(sp + 4 * q); a += (s[0] * wv[4 * q] + s[1] * wv[4 * q + 1]) + (s[2] * wv[4 * q + 2] + s[3] * wv[4 * q + 3]); }
            a = wave_sum(a); if (lane == 0) WSP(float, WS_SB)[b * 2048 + n] = a; }
    }
}
__device__ __forceinline__ void p3pre_conv(Frame& F) {
    const int tid = threadIdx.x;
    const bf16* proj = WSP(bf16, WS_PROJ); bf16* xo = (bf16*)F.out;
    for (int item = F.vcu * NTHR + tid; item < (MTOK / 16) * 256; item += F.G * NTHR) {
        const int oc = item & 255, run = item >> 8; const int t0 = run * 16, ch = 8 * oc;
        const bool halo = (t0 & (SEQ - 1)) != 0;
        v4u rw[19];
#pragma unroll
        for (int k = 0; k < 19; ++k) { rw[k] = (v4u){0u, 0u, 0u, 0u}; if (k >= 3 || halo) rw[k] = *(const v4u*)(proj + (size_t)(t0 - 3 + k) * NPROJ + 1024 + ch); }
        float cw[4][8], cbv[8];
#pragma unroll
        for (int k = 0; k < 4; ++k) { const f32x4 w0 = *(const f32x4*)((F.a->in[6]) + k * 2048 + ch), w1 = *(const f32x4*)((F.a->in[6]) + k * 2048 + ch + 4);
#pragma unroll
            for (int e = 0; e < 4; ++e) { cw[k][e] = w0[e]; cw[k][4 + e] = w1[e]; } }
        { const f32x4 b0 = *(const f32x4*)((F.a->in[7]) + ch), b1 = *(const f32x4*)((F.a->in[7]) + ch + 4);
#pragma unroll
            for (int e = 0; e < 4; ++e) { cbv[e] = b0[e]; cbv[4 + e] = b1[e]; } }
        float r0[8], r1[8], r2[8];
        unpack8(rw[0], r0); unpack8(rw[1], r1); unpack8(rw[2], r2);
#pragma unroll
        for (int tt = 0; tt < 16; ++tt) {
            float r3[8]; unpack8(rw[3 + tt], r3);
            float v[8];
#pragma unroll
            for (int i = 0; i < 8; ++i) { v[i] = silu_f(cbv[i] + r0[i] * cw[0][i] + r1[i] * cw[1][i] + r2[i] * cw[2][i] + r3[i] * cw[3][i]); r0[i] = r1[i]; r1[i] = r2[i]; r2[i] = r3[i]; }
            *(v4u*)(xo + (size_t)(t0 + tt) * 2048 + ch) = (v4u){pk2(v[0], v[1]), pk2(v[2], v[3]), pk2(v[4], v[5]), pk2(v[6], v[7])};
        }
    }
}
constexpr int SSD_PITCH = 272;
__device__ __forceinline__ bf16x8 lds_frag(LAS unsigned char* base, int row, int kbyte) { return *(const LAS bf16x8*)(base + row * SSD_PITCH + kbyte); }
constexpr int S3_CS = 0, S3_BS = 34816, S3_GY = 69632, S3_XDT = 104448, S3_XP = 144, S3_PREV = 122880, S3_CSF = 140288, S3_DTF = 141312, S3_WTS = 142336, S3_END = 143360;
static_assert(S3_END <= LDS_MAIN, "SSD v3 LDS map");
typedef short v4i16_t __attribute__((ext_vector_type(4)));
__device__ __forceinline__ bf16x8 lds_frag_tr(LAS unsigned char* tile, int pitch, int k0, int col0, int li, int lq) {
    LAS unsigned char* p = tile + (k0 + 8 * lq + (li >> 2)) * pitch + (col0 + 4 * (li & 3)) * 2;
    const v4i16_t lo = __builtin_amdgcn_ds_read_tr16_b64_v4i16((LAS v4i16_t*)p), hi = __builtin_amdgcn_ds_read_tr16_b64_v4i16((LAS v4i16_t*)(p + 4 * pitch));
    return __builtin_shufflevector(lo, hi, 0, 1, 2, 3, 4, 5, 6, 7);
}
struct Ssd3Pre { v4u xr[4], br[4], cr[4]; float d0, d1; };
__device__ __forceinline__ void ssd3_prefetch(Ssd3Pre& P, const char* xcb, const float* dtr, unsigned voB, unsigned voX, int tid, int lane, int w) {
#pragma unroll
    for (int r = 0; r < 4; ++r) { P.br[r] = *(const v4u*)(xcb + (voB + r * 4096u)); P.cr[r] = *(const v4u*)(xcb + (voB + 1024u + r * 4096u)); }
#pragma unroll
    for (int r = 0; r < 4; ++r) P.xr[r] = *(const v4u*)(xcb + (voX + r * 4096u));
    P.d0 = dtr[lane * 32]; P.d1 = dtr[lane * 32 + 16];
}
__device__ __forceinline__ void ssd3_cumsum(LAS unsigned char* L, int par, float r0, float r1, float dtb, float A, int lane) {
    LAS float* csf = (LAS float*)(L + S3_CSF + par * 512); LAS float* dtf = (LAS float*)(L + S3_DTF + par * 512); LAS float* wts = (LAS float*)(L + S3_WTS + par * 512);
    const float d0 = softplus_f(r0 + dtb), d1 = softplus_f(r1 + dtb);
    const float a0 = d0 * A, a1 = d1 * A; float s = a0 + a1;
#pragma unroll
    for (int o = 1; o < 64; o <<= 1) { const float t = __shfl_up(s, o); if (lane >= o) s += t; }
    const float tot = __shfl(s, 63);
    dtf[2 * lane] = d0; dtf[2 * lane + 1] = d1; csf[2 * lane] = s - a1; csf[2 * lane + 1] = s;
    wts[2 * lane] = __expf(tot - (s - a1)); wts[2 * lane + 1] = __expf(tot - s);
}
__device__ __forceinline__ void p3_ssd3(Frame& F) {
    const int tid0 = threadIdx.x, w = __builtin_amdgcn_readfirstlane(tid0 >> 6);
    LAS unsigned char* L = F.lds;
    const bf16* proj = WSP(bf16, WS_PROJ); const bf16* xc = (const bf16*)F.out; const float* dtraw = WSP(float, WS_DTRAW);
    for (int item = F.vcu; item < NB * NHEADS; item += F.G) {
        const int b = item >> 4, h = item & 15, g = h >> 2;
        int tid = tid0; asm volatile("" : "+v"(tid)); int lane = tid & 63;
        const float A = -__expf((F.a->in[9])[h]), Dh = (F.a->in[10])[h], dtb = (F.a->in[8])[h];
        const int pbs = w >> 1, nb0 = 4 * (w & 1);
        f32x4 st[4];
#pragma unroll
        for (int j = 0; j < 4; ++j) st[j] = (f32x4){0.f, 0.f, 0.f, 0.f};
        __syncthreads();
        for (int i = tid; i < 17408 / 16; i += NTHR) ((LAS v4u*)(L + S3_PREV))[i] = (v4u){0u, 0u, 0u, 0u};
        Ssd3Pre P;
        { const unsigned voB0 = (unsigned)((4 * (tid >> 4)) * 2048 + 1024 + g * 128 + 8 * (tid & 15)) * 2u, voX0 = (unsigned)((4 * ((tid & 255) >> 3)) * 2048 + h * 64 + 8 * (tid & 7)) * 2u;
          ssd3_prefetch(P, (const char*)xc + (size_t)b * SEQ * 4096, dtraw + (size_t)b * SEQ * 16 + h, voB0, voX0, tid, lane, w); }
        if (w == 0) ssd3_cumsum(L, 0, P.d0, P.d1, dtb, A, lane);
        __syncthreads();
        for (int c = 0; c < SEQ / CHUNK; ++c) {
            const size_t row0 = (size_t)b * SEQ + (size_t)c * CHUNK; const int par = c & 1;
            asm volatile("" : "+v"(tid));
            lane = tid & 63; const int li = lane & 15, lq = lane >> 4;
            const unsigned voB = (unsigned)((4 * (tid >> 4)) * 2048 + 1024 + g * 128 + 8 * (tid & 15)) * 2u, voX = (unsigned)((4 * ((tid & 255) >> 3)) * 2048 + h * 64 + 8 * (tid & 7)) * 2u;
            const unsigned voZ0 = (unsigned)((tid >> 3) * NPROJ + h * 64 + 8 * (tid & 7)) * 2u, voZ1 = voZ0 + 64u * NPROJ * 2u;
            LAS float* csf = (LAS float*)(L + S3_CSF + par * 512); LAS float* dtf = (LAS float*)(L + S3_DTF + par * 512); LAS float* wts = (LAS float*)(L + S3_WTS + par * 512);
            { const int ob = tid & 15, lb = 4 * (tid >> 4), n0 = 8 * ob;
#pragma unroll
              for (int r = 0; r < 4; ++r) { *(LAS v4u*)(L + S3_BS + (lb + r) * SSD_PITCH + n0 * 2) = P.br[r]; *(LAS v4u*)(L + S3_CS + (lb + r) * SSD_PITCH + n0 * 2) = P.cr[r]; } }
            if (tid < 256) { const int ox = tid & 7, lx = 4 * (tid >> 3), p0 = 8 * ox;
#pragma unroll
              for (int r = 0; r < 4; ++r) { float xv[8]; unpack8(P.xr[r], xv); const float tw = dtf[lx + r];
                  *(LAS v4u*)(L + S3_XDT + (lx + r) * S3_XP + p0 * 2) = (v4u){pk2(xv[0] * tw, xv[1] * tw), pk2(xv[2] * tw, xv[3] * tw), pk2(xv[4] * tw, xv[5] * tw), pk2(xv[6] * tw, xv[7] * tw)}; } }
            const char* prb = (const char*)proj + row0 * (NPROJ * 2);
            const v4u zc0 = *(const v4u*)(prb + voZ0), zc1 = *(const v4u*)(prb + voZ1);
            LDS_BARRIER();
            const float cs_end = csf[127];
            bf16x8 ca[4];
#pragma unroll
            for (int ks = 0; ks < 4; ++ks) ca[ks] = lds_frag(L + S3_CS, 16 * w + li, 64 * ks + 16 * lq);
            float csl[4];
#pragma unroll
            for (int r = 0; r < 4; ++r) csl[r] = csf[16 * w + 4 * lq + r];
            { bf16x8 bq[2][4];
#pragma unroll
              for (int ks = 0; ks < 4; ++ks) bq[0][ks] = lds_frag(L + S3_BS, li, 64 * ks + 16 * lq);
#pragma unroll
              for (int sb = 0; sb < 8; ++sb) if (sb <= (w | 1)) {
                  f32x4 cbv = (f32x4){0.f, 0.f, 0.f, 0.f};
                  const int s = 16 * sb + li; const float css = csf[s];
                  if (sb <= w) {
                      if (sb + 1 <= w) {
#pragma unroll
                          for (int ks = 0; ks < 4; ++ks) bq[(sb + 1) & 1][ks] = lds_frag(L + S3_BS, 16 * (sb + 1) + li, 64 * ks + 16 * lq); }
                      __builtin_amdgcn_sched_barrier(0);
#pragma unroll
                      for (int ks = 0; ks < 4; ++ks) cbv = __builtin_amdgcn_mfma_f32_16x16x32_bf16(ca[ks], bq[sb & 1][ks], cbv, 0, 0, 0);
                      __builtin_amdgcn_sched_barrier(0); }
#pragma unroll
                  for (int r = 0; r < 4; ++r) { const int l = 16 * w + 4 * lq + r; const float gv = (s <= l) ? cbv[r] * __expf(csl[r] - css) : 0.f;
                      *(LAS unsigned short*)(L + S3_GY + l * SSD_PITCH + s * 2) = (unsigned short)f2bf(gv); } } }
            LDS_WAIT(); asm volatile("" ::: "memory");
            f32x4 yd[4], yo[4];
#pragma unroll
            for (int pb = 0; pb < 4; ++pb) { yd[pb] = (f32x4){0.f, 0.f, 0.f, 0.f}; yo[pb] = (f32x4){0.f, 0.f, 0.f, 0.f}; }
            { bf16x8 gq[2], xq[2][4];
              gq[0] = lds_frag(L + S3_GY, 16 * w + li, 16 * lq);
#pragma unroll
              for (int pb = 0; pb < 4; ++pb) xq[0][pb] = lds_frag_tr(L + S3_XDT, S3_XP, 0, 16 * pb, li, lq);
#pragma unroll
              for (int ks = 0; ks < 4; ++ks) if (ks <= (w >> 1)) {
                  if (ks + 1 <= (w >> 1)) { gq[(ks + 1) & 1] = lds_frag(L + S3_GY, 16 * w + li, 64 * (ks + 1) + 16 * lq);
#pragma unroll
                      for (int pb = 0; pb < 4; ++pb) xq[(ks + 1) & 1][pb] = lds_frag_tr(L + S3_XDT, S3_XP, 32 * (ks + 1), 16 * pb, li, lq); }
                  __builtin_amdgcn_sched_barrier(0);
#pragma unroll
                  for (int pb = 0; pb < 4; ++pb) yd[pb] = __builtin_amdgcn_mfma_f32_16x16x32_bf16(gq[ks & 1], xq[ks & 1][pb], yd[pb], 0, 0, 0);
                  __builtin_amdgcn_sched_barrier(0); } }
            { bf16x8 pq[2][4];
#pragma unroll
              for (int pb = 0; pb < 4; ++pb) pq[0][pb] = lds_frag(L + S3_PREV, 16 * pb + li, 16 * lq);
#pragma unroll
              for (int ks = 0; ks < 4; ++ks) {
                  if (ks < 3) {
#pragma unroll
                      for (int pb = 0; pb < 4; ++pb) pq[(ks + 1) & 1][pb] = lds_frag(L + S3_PREV, 16 * pb + li, 64 * (ks + 1) + 16 * lq); }
                  __builtin_amdgcn_sched_barrier(0);
#pragma unroll
                  for (int pb = 0; pb < 4; ++pb) yo[pb] = __builtin_amdgcn_mfma_f32_16x16x32_bf16(ca[ks], pq[ks & 1][pb], yo[pb], 0, 0, 0);
                  __builtin_amdgcn_sched_barrier(0); } }
#pragma unroll
            for (int r = 0; r < 4; ++r) { const float e = __expf(csl[r]);
#pragma unroll
                for (int pb = 0; pb < 4; ++pb) *(LAS float*)(L + S3_GY + (16 * w + 4 * lq + r) * SSD_PITCH + (16 * pb + li) * 4) = yd[pb][r] + e * yo[pb][r]; }
            { const size_t rown = row0 + (c + 1 < SEQ / CHUNK ? CHUNK : 0);
              ssd3_prefetch(P, (const char*)xc + rown * 4096, dtraw + rown * 16 + h, voB, voX, tid, lane, w); }
            LDS_BARRIER();
            { const float dec = __expf(cs_end);
#pragma unroll
              for (int j = 0; j < 4; ++j) st[j] = st[j] * dec;
              bf16x8 xq[2], bq2[2][4]; f32x4 wq[2][2];
              xq[0] = lds_frag_tr(L + S3_XDT, S3_XP, 0, 16 * pbs, li, lq); wq[0][0] = *(const LAS f32x4*)(wts + 8 * lq); wq[0][1] = *(const LAS f32x4*)(wts + 8 * lq + 4);
#pragma unroll
              for (int j = 0; j < 4; ++j) bq2[0][j] = lds_frag_tr(L + S3_BS, SSD_PITCH, 0, 16 * (nb0 + j), li, lq);
#pragma unroll
              for (int ks = 0; ks < 4; ++ks) {
                  if (ks < 3) { xq[(ks + 1) & 1] = lds_frag_tr(L + S3_XDT, S3_XP, 32 * (ks + 1), 16 * pbs, li, lq); wq[(ks + 1) & 1][0] = *(const LAS f32x4*)(wts + 32 * (ks + 1) + 8 * lq); wq[(ks + 1) & 1][1] = *(const LAS f32x4*)(wts + 32 * (ks + 1) + 8 * lq + 4);
#pragma unroll
                      for (int j = 0; j < 4; ++j) bq2[(ks + 1) & 1][j] = lds_frag_tr(L + S3_BS, SSD_PITCH, 32 * (ks + 1), 16 * (nb0 + j), li, lq); }
                  __builtin_amdgcn_sched_barrier(0);
                  const f32x4 w0 = wq[ks & 1][0], w1 = wq[ks & 1][1];
                  float xv[8]; unpack8(__builtin_bit_cast(v4u, xq[ks & 1]), xv);
                  const v4u xw = (v4u){pk2(xv[0] * w0[0], xv[1] * w0[1]), pk2(xv[2] * w0[2], xv[3] * w0[3]), pk2(xv[4] * w1[0], xv[5] * w1[1]), pk2(xv[6] * w1[2], xv[7] * w1[3])};
                  const bf16x8 xf = __builtin_bit_cast(bf16x8, xw);
#pragma unroll
                  for (int j = 0; j < 4; ++j) st[j] = __builtin_amdgcn_mfma_f32_16x16x32_bf16(xf, bq2[ks & 1][j], st[j], 0, 0, 0);
                  __builtin_amdgcn_sched_barrier(0); }
#pragma unroll
              for (int j = 0; j < 4; ++j)
#pragma unroll
                  for (int r = 0; r < 4; ++r) *(LAS unsigned short*)(L + S3_PREV + (16 * pbs + 4 * lq + r) * SSD_PITCH + (16 * (nb0 + j) + li) * 2) = (unsigned short)f2bf(st[j][r]); }
#pragma unroll
            for (int k = 0; k < 2; ++k) { const int it = tid + 512 * k, l = it >> 3, o = it & 7; const size_t row = row0 + l;
                const f32x4 y0 = *(const LAS f32x4*)(L + S3_GY + l * SSD_PITCH + 32 * o), y1 = *(const LAS f32x4*)(L + S3_GY + l * SSD_PITCH + 32 * o + 16);
                const v4u xw = *(const LAS v4u*)(L + S3_XDT + l * S3_XP + 16 * o); const v4u zw = k == 0 ? zc0 : zc1; const float dsk = Dh * __builtin_amdgcn_rcpf(dtf[l]);
                float xv[8], zv[8], yv[8]; unpack8(xw, xv); unpack8(zw, zv);
                float ss = 0.f;
#pragma unroll
                for (int e = 0; e < 8; ++e) { const float yy = (e < 4 ? y0[e] : y1[e - 4]) + dsk * xv[e]; yv[e] = yy * silu_f(zv[e]); ss += yv[e] * yv[e]; }
                ss += __shfl_xor(ss, 1); ss += __shfl_xor(ss, 2); ss += __shfl_xor(ss, 4);
                if (o == 0) WSP(float, WS_STSSD)[row * 16 + h] = ss;
                *(v4u*)(WSP(bf16, WS_Y) + row * 2048 + h * 64 + 8 * o) = (v4u){pk2(yv[0], yv[1]), pk2(yv[2], yv[3]), pk2(yv[4], yv[5]), pk2(yv[6], yv[7])}; }
            if (w == 0 && c + 1 < SEQ / CHUNK) ssd3_cumsum(L, par ^ 1, P.d0, P.d1, dtb, A, lane);
            LDS_BARRIER();
        }
    }
}
typedef float f32x16 __attribute__((ext_vector_type(16)));
constexpr int S5V_BU = 0, S5V_BUP = 2056, S5V_BUSZ = 16 * S5V_BUP, S5V_XT = 2 * S5V_BUSZ, S5V_XTP = 1040, S5V_XTSZ = 16 * S5V_XTP, S5V_VS = S5V_XT + 2 * S5V_XTSZ, S5V_OT = S5V_VS + 4 * 512, S5V_OTP = 144, S5V_OTSZ = 16 * S5V_OTP, S5V_END = S5V_OT + 2 * S5V_OTSZ;
static_assert(S5V_END <= LDS_MAIN, "S5 v2 LDS map");
__device__ __forceinline__ void p3_s5v2(Frame& F) {
    const int tid = threadIdx.x, lane = tid & 63, w = __builtin_amdgcn_readfirstlane(tid >> 6);
    const int li = lane & 15, lq = lane >> 4;
    LAS unsigned char* L = F.lds;
    const bf16* proj = WSP(bf16, WS_PROJ);
    constexpr int NT = SEQ / 16;
    for (int item = F.vcu; item < NB * 16; item += F.G) {
        const int b = item >> 4, gs = item & 15;
        const bool scanw = w < 4; const int gl = w & 3, g = gs * 4 + gl;
        const bf16* ubase = proj + (size_t)b * SEQ * NPROJ + 3072 + gs * 64 + gl * 16;
        __syncthreads();
        if (scanw) {
            __builtin_amdgcn_s_setprio(2);
            const float lbr = WSP(float, WS_S5LB)[(g * 64 + lane) * 2], lbi = WSP(float, WS_S5LB)[(g * 64 + lane) * 2 + 1];
            bf16x8 bfr[8];
#pragma unroll
            for (int cb = 0; cb < 8; ++cb) { v4u v = (v4u){0u, 0u, 0u, 0u};
                if (lq < 2) { const int col = 16 * cb + li; const float* src = WSP(float, WS_S5BB) + (g * 64 + (col >> 1)) * 32 + (col & 1) * 16 + 8 * lq; const f32x4 a0 = *(const f32x4*)src, a1 = *(const f32x4*)(src + 4);
                    v = (v4u){pk2(a0[0], a0[1]), pk2(a0[2], a0[3]), pk2(a1[0], a1[1]), pk2(a1[2], a1[3])}; }
                bfr[cb] = __builtin_bit_cast(bf16x8, v); }
            float xr = 0.f, xi = 0.f;
            const int lq2 = lq & 1;
            v4u ua = *(const v4u*)(ubase + (size_t)li * NPROJ + 8 * lq2);
            { const bf16x8 af = __builtin_bit_cast(bf16x8, lq < 2 ? ua : (v4u){0u, 0u, 0u, 0u});
              ua = *(const v4u*)(ubase + (size_t)(16 + li) * NPROJ + 8 * lq2);
#pragma unroll
              for (int cb = 0; cb < 8; ++cb) { f32x4 acc = (f32x4){0.f, 0.f, 0.f, 0.f}; acc = __builtin_amdgcn_mfma_f32_16x16x32_bf16(af, bfr[cb], acc, 0, 0, 0);
#pragma unroll
                  for (int r = 0; r < 4; ++r) *(LAS float*)(L + S5V_BU + (4 * lq + r) * S5V_BUP + (gl * 128 + 16 * cb + li) * 4) = acc[r]; } }
            LDS_BARRIER();
            for (int k = 0; k <= NT; ++k) {
                if (k < NT) {
                    const LAS f32x2* bp = (const LAS f32x2*)(L + S5V_BU + (k & 1) * S5V_BUSZ + (gl * 128 + 2 * lane) * 4);
                    LAS unsigned* xp = (LAS unsigned*)(L + S5V_XT + (k & 1) * S5V_XTSZ + (gl * 128 + 2 * lane) * 2);
                    f32x2 bu[16];
#pragma unroll
                    for (int t = 0; t < 16; ++t) bu[t] = bp[t * (S5V_BUP / 8)];
                    unsigned xo[16];
#pragma unroll
                    for (int t = 0; t < 16; ++t) { const float nr = lbr * xr + (bu[t][0] - lbi * xi), ni = lbr * xi + (lbi * xr + bu[t][1]); xr = nr; xi = ni; xo[t] = pk2(xr, xi); }
#pragma unroll
                    for (int t = 0; t < 16; ++t) xp[t * (S5V_XTP / 4)] = xo[t];
                    if (k + 1 < NT) {
                        const bf16x8 af = __builtin_bit_cast(bf16x8, lq < 2 ? ua : (v4u){0u, 0u, 0u, 0u});
                        { const int kn = k + 2 < NT ? k + 2 : NT - 1; ua = *(const v4u*)(ubase + (size_t)(16 * kn + li) * NPROJ + 8 * lq2); }
                        LAS unsigned char* bun = L + S5V_BU + ((k + 1) & 1) * S5V_BUSZ;
#pragma unroll
                        for (int cb = 0; cb < 8; ++cb) { f32x4 acc = (f32x4){0.f, 0.f, 0.f, 0.f}; acc = __builtin_amdgcn_mfma_f32_16x16x32_bf16(af, bfr[cb], acc, 0, 0, 0);
#pragma unroll
                            for (int r = 0; r < 4; ++r) *(LAS float*)(bun + (4 * lq + r) * S5V_BUP + (gl * 128 + 16 * cb + li) * 4) = acc[r]; }
                    }
                }
                LDS_BARRIER();
            }
            __builtin_amdgcn_s_setprio(0);
        } else {
            bf16x8 cfr[4];
#pragma unroll
            for (int ks = 0; ks < 4; ++ks) { const float* cr = (F.a->in[17]) + (g * 16 + li) * 64 + 16 * ks + 4 * lq; const float* ci = (F.a->in[18]) + (g * 16 + li) * 64 + 16 * ks + 4 * lq;
                const f32x4 r0 = *(const f32x4*)cr, i0 = *(const f32x4*)ci;
                cfr[ks] = __builtin_bit_cast(bf16x8, ((v4u){pk2(r0[0], -i0[0]), pk2(r0[1], -i0[1]), pk2(r0[2], -i0[2]), pk2(r0[3], -i0[3])})); }
            v4u gwv = (v4u){0u, 0u, 0u, 0u};
            if (lq < 2) { float gwf[8];
#pragma unroll
                for (int j = 0; j < 8; ++j) gwf[j] = (F.a->in[20])[(g * 16 + 8 * lq + j) * 16 + li];
                gwv = (v4u){pk2(gwf[0], gwf[1]), pk2(gwf[2], gwf[3]), pk2(gwf[4], gwf[5]), pk2(gwf[6], gwf[7])}; }
            const bf16x8 gfr = __builtin_bit_cast(bf16x8, gwv);
            const float dsk = (F.a->in[19])[g * 16 + li], gbias = (F.a->in[21])[g * 16 + li];
            LAS unsigned char* vs = L + S5V_VS + gl * 512;
            float uo[4], un[4];
#pragma unroll
            for (int r = 0; r < 4; ++r) { uo[r] = bf2f(ubase[(size_t)(4 * lq + r) * NPROJ + li]); un[r] = bf2f(ubase[(size_t)(16 + 4 * lq + r) * NPROJ + li]); }
            LDS_BARRIER();
            for (int k = 0; k <= NT; ++k) {
                float u2[4];
                { const int kn = k + 1 < NT ? k + 1 : NT - 1;
#pragma unroll
                  for (int r = 0; r < 4; ++r) u2[r] = bf2f(ubase[(size_t)(16 * kn + 4 * lq + r) * NPROJ + li]); }
                if (k >= 2) {
                    const int t = ((tid - 256) >> 3) & 15, oc = tid & 7; const v4u ov = *(const LAS v4u*)(L + S5V_OT + (k & 1) * S5V_OTSZ + t * S5V_OTP + 16 * oc);
                    if (tid < 384) *(v4u*)(WSP(bf16, WS_Y) + ((size_t)b * SEQ + 16 * (k - 2) + t) * 2048 + 1024 + gs * 64 + 8 * oc) = ov; }
                if (k >= 1) {
                    const int kt = k - 1; const LAS unsigned char* xt = L + S5V_XT + (kt & 1) * S5V_XTSZ;
                    f32x4 yacc = (f32x4){0.f, 0.f, 0.f, 0.f};
#pragma unroll
                    for (int ks = 0; ks < 4; ++ks) yacc = __builtin_amdgcn_mfma_f32_16x16x32_bf16(*(const LAS bf16x8*)(xt + li * S5V_XTP + (gl * 128 + 32 * ks + 8 * lq) * 2), cfr[ks], yacc, 0, 0, 0);
                    float v[4];
                    { const f32x2 g0 = gelu_pk2((f32x2){yacc[0] + dsk * uo[0], yacc[1] + dsk * uo[1]}), g1 = gelu_pk2((f32x2){yacc[2] + dsk * uo[2], yacc[3] + dsk * uo[3]}); v[0] = g0[0]; v[1] = g0[1]; v[2] = g1[0]; v[3] = g1[1]; }
#pragma unroll
                    for (int r = 0; r < 4; ++r) *(LAS unsigned short*)(vs + (4 * lq + r) * 32 + li * 2) = (unsigned short)f2bf(v[r]);
                    LDS_WAIT(); asm volatile("" ::: "memory");
                    v4u va = (v4u){0u, 0u, 0u, 0u};
                    if (lq < 2) va = *(const LAS v4u*)(vs + li * 32 + 16 * lq);
                    f32x4 gacc = (f32x4){0.f, 0.f, 0.f, 0.f};
                    gacc = __builtin_amdgcn_mfma_f32_16x16x32_bf16(__builtin_bit_cast(bf16x8, va), gfr, gacc, 0, 0, 0);
                    float o[4], ss[4];
#pragma unroll
                    for (int r = 0; r < 4; ++r) { o[r] = v[r] * sigmoid_f(gacc[r] + gbias); ss[r] = o[r] * o[r]; }
#pragma unroll
                    for (int r = 0; r < 4; ++r) ss[r] = row16_sum_to15(ss[r]);
                    if (li == 15) {
#pragma unroll
                        for (int r = 0; r < 4; ++r) WSP(float, WS_STS5)[((size_t)b * SEQ + 16 * kt + 4 * lq + r) * NS5PART + g] = ss[r]; }
                    LAS unsigned char* ot = L + S5V_OT + (kt & 1) * S5V_OTSZ;
#pragma unroll
                    for (int r = 0; r < 4; ++r) *(LAS unsigned short*)(ot + (4 * lq + r) * S5V_OTP + (gl * 16 + li) * 2) = (unsigned short)f2bf(o[r]);
#pragma unroll
                    for (int r = 0; r < 4; ++r) { uo[r] = un[r]; un[r] = u2[r]; }
                }
                LDS_BARRIER();
            }
            { const int t = ((tid - 256) >> 3) & 15, oc = tid & 7; const v4u ov = *(const LAS v4u*)(L + S5V_OT + ((NT - 1) & 1) * S5V_OTSZ + t * S5V_OTP + 16 * oc);
              if (tid < 384) *(v4u*)(WSP(bf16, WS_Y) + ((size_t)b * SEQ + 16 * (NT - 1) + t) * 2048 + 1024 + gs * 64 + 8 * oc) = ov; }
        }
    }
}
__device__ __forceinline__ unsigned med3u(unsigned a, unsigned b, unsigned c) { unsigned r; asm("v_med3_u32 %0, %1, %2, %3" : "=v"(r) : "v"(a), "v"(b), "v"(c)); return r; }
__device__ __forceinline__ unsigned fkey(float v) { const unsigned u = __builtin_bit_cast(unsigned, v); return (u & 0x80000000u) ? ~u : (u | 0x80000000u); }
__device__ __forceinline__ float fkey_inv(unsigned k) { const unsigned u = (k & 0x80000000u) ? (k & 0x7fffffffu) : ~k; return __builtin_bit_cast(float, u); }
#define TOPK_INSERT(a, x) do { _Pragma("unroll") for (int _i = 15; _i >= 1; --_i) a[_i] = med3u(a[_i - 1], a[_i], (x)); a[0] = a[0] > (x) ? a[0] : (x); } while (0)
__device__ __forceinline__ void expert_convert(Frame& F, int w0, int nw, int f_lane) {
    for (int rw = w0; rw < 2 * 16384; rw += 2 * nw) {
        f32x4 v[2][4]; float mx[2];
#pragma unroll
        for (int u = 0; u < 2; ++u) { const int r = rw + u * nw; const int tb = r >= 16384, e = tb ? r - 16384 : r; const float* src = (tb ? (F.a->in[28]) : (F.a->in[27])) + (size_t)e * 1024 + 16 * f_lane;
#pragma unroll
            for (int q = 0; q < 4; ++q) v[u][q] = *(const f32x4*)(src + 4 * q); }
#pragma unroll
        for (int u = 0; u < 2; ++u) { float m = 0.f;
#pragma unroll
            for (int q = 0; q < 4; ++q) m = fmaxf(m, fmaxf(fmaxf(fabsf(v[u][q][0]), fabsf(v[u][q][1])), fmaxf(fabsf(v[u][q][2]), fabsf(v[u][q][3]))));
#pragma unroll
            for (int o = 1; o < 64; o <<= 1) m = fmaxf(m, __shfl_xor(m, o));
            mx[u] = fmaxf(m, 1e-30f); }
#pragma unroll
        for (int u = 0; u < 2; ++u) { const int r = rw + u * nw; const int tb = r >= 16384, e = tb ? r - 16384 : r; const float sc = 224.0f / mx[u];
            v4u w;
#pragma unroll
            for (int q = 0; q < 4; ++q) { int pk = 0; pk = __builtin_amdgcn_cvt_pk_fp8_f32(v[u][q][0] * sc, v[u][q][1] * sc, pk, false); pk = __builtin_amdgcn_cvt_pk_fp8_f32(v[u][q][2] * sc, v[u][q][3] * sc, pk, true); w[q] = (unsigned)pk; }
            *(v4u*)(F.ws + (tb ? WS_EV : WS_EU) + (size_t)e * 1024 + 16 * f_lane) = w;
            if (f_lane == 0) WSP(float, tb ? WS_EVS : WS_EUS)[e] = mx[u] * (1.0f / 224.0f); }
    }
}
__device__ __forceinline__ void p5b_topk(Frame& F) {
    const int f_tid = threadIdx.x, f_lane = f_tid & 63, f_wave = __builtin_amdgcn_readfirstlane(f_tid >> 6);
    const _Float16* scores = WSP(_Float16, WS_SCORES);
    LAS unsigned char* ix = (LAS unsigned char*)F.lds + f_tid * 36;
#pragma unroll 1
    for (int half = 0; half < 2; ++half) {
    if ((f_wave >> 2) != half) { expert_convert(F, (F.vcu * 4 + (f_wave & 3)) * 2 + half, F.G * 8, f_lane); continue; }
    for (int item = (F.vcu * 2 + half) * 256 + (f_tid & 255); item < MTOK * PH; item += F.G * 512) {
        const int t = item >> 3, hd = item & 7;
        unsigned a1[16], a2[16];
#pragma unroll
        for (int i = 0; i < 16; ++i) { a1[i] = 0u; a2[i] = 0u; }
        const _Float16* sp = scores + (size_t)t * 2048 + hd * 256;
        typedef _Float16 f16x8 __attribute__((ext_vector_type(8)));
#pragma unroll 1
        for (int m = 0; m < 2; ++m) { f16x8 sv[8];
#pragma unroll
            for (int q = 0; q < 8; ++q) sv[q] = *(const f16x8*)(sp + 64 * m + 8 * q);
#pragma unroll
            for (int q = 0; q < 8; ++q)
#pragma unroll
                for (int e = 0; e < 8; ++e) { const unsigned k = (fkey((float)sv[q][e]) & ~127u) | (unsigned)(127 - (64 * m + 8 * q + e)); TOPK_INSERT(a1, k); } }
#pragma unroll 1
        for (int m = 0; m < 2; ++m) { f16x8 sv[8];
#pragma unroll
            for (int q = 0; q < 8; ++q) sv[q] = *(const f16x8*)(sp + 128 + 64 * m + 8 * q);
#pragma unroll
            for (int q = 0; q < 8; ++q)
#pragma unroll
                for (int e = 0; e < 8; ++e) { const unsigned k = (fkey((float)sv[q][e]) & ~127u) | (unsigned)(127 - (64 * m + 8 * q + e)); TOPK_INSERT(a2, k); } }
        float v1[16], v2[16];
#pragma unroll
        for (int i = 0; i < 16; ++i) { ix[i] = (unsigned char)(127u - (a1[i] & 127u)); ix[16 + i] = (unsigned char)(127u - (a2[i] & 127u)); v1[i] = fkey_inv(a1[i] & ~127u); v2[i] = fkey_inv(a2[i] & ~127u); }
        unsigned cb[16];
#pragma unroll
        for (int i = 0; i < 16; ++i) cb[i] = 0u;
#pragma unroll
        for (int i = 0; i < 16; ++i)
#pragma unroll
            for (int j = 0; j < 16; ++j) if ((i + 1) * (j + 1) <= 16) { const unsigned k = (fkey(v1[i] + v2[j]) & ~255u) | (unsigned)(255 - (i * 16 + j)); TOPK_INSERT(cb, k); }
        float tv[16]; float mx = -3.0e38f;
#pragma unroll
        for (int k = 0; k < 16; ++k) { tv[k] = fkey_inv(cb[k] & ~255u); mx = fmaxf(mx, tv[k]); }
        float sum = 0.f;
#pragma unroll
        for (int k = 0; k < 16; ++k) { tv[k] = __expf(tv[k] - mx); sum += tv[k]; }
        const float inv = 1.0f / sum;
        LDS_WAIT(); asm volatile("" ::: "memory");
        int ev[16]; unsigned long long c64 = 0ull;
#pragma unroll
        for (int k = 0; k < 16; ++k) { const unsigned code = 255u - (cb[k] & 255u); const int i = code >> 4, j = code & 15; ev[k] = (int)ix[i] * 128 + (int)ix[16 + j]; c64 += 1ull << (8 * (ev[k] >> 11)); }
        unsigned long long s64 = c64;
#pragma unroll
        for (int o = 1; o < 8; o <<= 1) { const unsigned lo = __shfl_up((unsigned)s64, o, 8), hi = __shfl_up((unsigned)(s64 >> 32), o, 8); if ((f_lane & 7) >= o) s64 += ((unsigned long long)hi << 32) | lo; }
        const unsigned long long e64 = s64 - c64;
        const unsigned long long t64 = ((unsigned long long)__shfl((unsigned)(s64 >> 32), 7, 8) << 32) | __shfl((unsigned)s64, 7, 8);
        const unsigned long long st64 = (t64 * 0x0101010101010101ull) << 8;
        unsigned long long base64 = st64 + e64;
        int* eo = WSP(int, WS_EID) + (size_t)t * 128; float* go = WSP(float, WS_GATE) + (size_t)t * 128;
#pragma unroll
        for (int k = 0; k < 16; ++k) { const int r8 = 8 * (ev[k] >> 11); const int slot = (int)((base64 >> r8) & 255ull); base64 += 1ull << r8; eo[slot] = ev[k]; go[slot] = tv[k] * inv; }
        if (hd == 0) WSP(unsigned long long, WS_START)[t] = st64;
        LDS_WAIT(); asm volatile("" ::: "memory");
    }
    }
}
__device__ __forceinline__ void dec16(const v4u q, float* f) {
#pragma unroll
    for (int i = 0; i < 4; ++i) { const f32x2 lo = __builtin_amdgcn_cvt_pk_f32_fp8((int)q[i], false), hi = __builtin_amdgcn_cvt_pk_f32_fp8((int)q[i], true); f[4 * i] = lo[0]; f[4 * i + 1] = lo[1]; f[4 * i + 2] = hi[0]; f[4 * i + 3] = hi[1]; }
}
__device__ __forceinline__ void p9_peer_down2(Frame& F) {
    const int f_tid = threadIdx.x, lane = f_tid & 63, f_wave = __builtin_amdgcn_readfirstlane(f_tid >> 6);
    const unsigned char* EV = F.ws + WS_EV;
    for (int wq = F.vcu * NWAVES + f_wave; wq < MTOK / 16; wq += F.G * NWAVES) {
        const int b = wq >> 7; const float* mb = WSP(float, WS_MOD) + (size_t)b * 6144;
        int ne_lo = WSP(int, WS_EID)[(size_t)wq * 16 * 128 + lane], ne_hi = WSP(int, WS_EID)[(size_t)wq * 16 * 128 + 64 + lane];
        float nw_lo = WSP(float, WS_GATE)[(size_t)wq * 16 * 128 + lane], nw_hi = WSP(float, WS_GATE)[(size_t)wq * 16 * 128 + 64 + lane];
        for (int tt = 0; tt < 16; ++tt) {
            const size_t t = (size_t)wq * 16 + tt;
            unsigned l16 = 16u * (unsigned)lane; asm volatile("" : "+v"(l16));
            float* xr = (float*)((char*)(F.out + t * 1024) + 4u * l16);
            const int e_lo = ne_lo, e_hi = ne_hi; const float w_lo = nw_lo, w_hi = nw_hi;
            f32x2 o[8];
#pragma unroll
            for (int i = 0; i < 8; ++i) o[i] = (f32x2){0.f, 0.f};
            v4u qa[8], qb[8];
#pragma unroll
            for (int j = 0; j < 8; ++j) { const int e = __builtin_amdgcn_readlane(e_lo, j); qa[j] = *(const v4u*)(EV + ((unsigned)e * 1024u + l16)); }
#define DN2_STEP(GRP, CUR, NXT) { \
                const int grp = (GRP); const int nb = ((grp + 1) & 7) * 8; const int ensel = (grp + 1) < 8 ? e_lo : e_hi; \
                { _Pragma("unroll") for (int j = 0; j < 8; ++j) { const int e = __builtin_amdgcn_readlane(ensel, nb + j); NXT[j] = *(const v4u*)(EV + ((unsigned)e * 1024u + l16)); } } \
                __builtin_amdgcn_sched_barrier(0); \
                const int base = (grp & 7) * 8; const float wsel = grp < 8 ? w_lo : w_hi; \
                _Pragma("unroll") for (int j = 0; j < 8; ++j) { const float wj = __builtin_bit_cast(float, __builtin_amdgcn_readlane(__builtin_bit_cast(int, wsel), base + j)); const f32x2 w2 = (f32x2){wj, wj}; \
                    _Pragma("unroll") for (int i = 0; i < 4; ++i) { const f32x2 lo = __builtin_amdgcn_cvt_pk_f32_fp8((int)CUR[j][i], false), hi = __builtin_amdgcn_cvt_pk_f32_fp8((int)CUR[j][i], true); o[2 * i] += w2 * lo; o[2 * i + 1] += w2 * hi; } } }
#pragma unroll 1
            for (int g2 = 0; g2 < 16; g2 += 2) { DN2_STEP(g2, qa, qb) DN2_STEP(g2 + 1, qb, qa) }
#undef DN2_STEP
            { const size_t tn = t + (tt < 15 ? 1 : 0); ne_lo = WSP(int, WS_EID)[tn * 128 + lane]; ne_hi = WSP(int, WS_EID)[tn * 128 + 64 + lane]; nw_lo = WSP(float, WS_GATE)[tn * 128 + lane]; nw_hi = WSP(float, WS_GATE)[tn * 128 + 64 + lane]; }
            float x1[16]; float ss = 0.f;
#pragma unroll
            for (int q4 = 0; q4 < 4; ++q4) { const f32x4 v = *(const f32x4*)(xr + 4 * q4); x1[4 * q4] = v[0]; x1[4 * q4 + 1] = v[1]; x1[4 * q4 + 2] = v[2]; x1[4 * q4 + 3] = v[3]; }
#pragma unroll
            for (int q4 = 0; q4 < 4; ++q4) { const f32x4 gt = *(const f32x4*)((const char*)(mb + 5120) + 4u * l16 + 16 * q4);
#pragma unroll
                for (int e = 0; e < 4; ++e) { const int i = 4 * q4 + e; x1[i] += gt[e] * o[i >> 1][i & 1]; ss += x1[i] * x1[i]; } }
            const float rf = rsqrt_f(wave_sum(ss) * (1.0f / 1024.0f) + EPSF);
#pragma unroll
            for (int q4 = 0; q4 < 4; ++q4) { const f32x4 nf = *(const f32x4*)((const char*)(F.a->in[29]) + 4u * l16 + 16 * q4); f32x4 v;
#pragma unroll
                for (int e = 0; e < 4; ++e) v[e] = x1[4 * q4 + e] * rf * nf[e];
                *(f32x4*)(xr + 4 * q4) = v; }
        }
    }
}
typedef long i64_t;
constexpr int U6_ROWP = 1040, U6_BUF = 8 * U6_ROWP, U6_WAVE = 2 * U6_BUF + 1024;
static_assert(8 * U6_WAVE <= LDS_MAIN, "U6 LDS map");
__device__ __forceinline__ void p8_peer_up6(Frame& F) {
    const int f_tid = threadIdx.x, lane = f_tid & 63, f_wave = __builtin_amdgcn_readfirstlane(f_tid >> 6);
    const int li = lane & 15, lq = lane >> 4;
    const unsigned char* EU = F.ws + WS_EU; const float* EUS = WSP(float, WS_EUS); const float* EVS = WSP(float, WS_EVS);
    LAS unsigned char* ring = F.lds + f_wave * U6_WAVE; LAS unsigned char* hq = ring + 2 * U6_BUF;
    for (int wq = F.vcu * NWAVES + f_wave; wq < MTOK / 16; wq += F.G * NWAVES) {
        const int b = wq >> 7; const float* mb = WSP(float, WS_MOD) + (size_t)b * 6144;
        for (int tt = 0; tt < 16; ++tt) {
            const size_t t = (size_t)wq * 16 + tt;
            unsigned l16 = 16u * (unsigned)lane; asm volatile("" : "+v"(l16));
            const int e_lo = WSP(int, WS_EID)[t * 128 + lane], e_hi = WSP(int, WS_EID)[t * 128 + 64 + lane];
            const float g_lo = WSP(float, WS_GATE)[t * 128 + lane], g_hi = WSP(float, WS_GATE)[t * 128 + 64 + lane];
            const float rs = rsqrt_f(WSP(float, WS_ROWSTAT)[t] * (1.0f / 1024.0f) + EPSF);
            const char* xs = (const char*)(WSP(bf16, WS_X1S) + t * 1024) + 2u * l16; const v4u xa = *(const v4u*)xs, xb = *(const v4u*)(xs + 16);
            asm volatile("s_waitcnt vmcnt(0)" ::: "memory");
#pragma unroll
            for (int j = 0; j < 8; ++j) { const int e = __builtin_amdgcn_readlane(e_lo, j);
                __builtin_amdgcn_global_load_lds((const unsigned*)(EU + ((unsigned)e * 1024u + l16)), (LAS unsigned*)(ring + j * U6_ROWP), 16, 0, 0); }
            const float su_lo = EUS[e_lo], su_hi = EUS[e_hi], sv_lo = EVS[e_lo], sv_hi = EVS[e_hi];
            float h2[16]; unpack8(xa, h2); unpack8(xb, h2 + 8); float mx = 0.f;
#pragma unroll
            for (int qd = 0; qd < 4; ++qd) { const f32x4 sh = *(const f32x4*)((const char*)(mb + 3072) + 4u * l16 + 16 * qd);
#pragma unroll
                for (int e = 0; e < 4; ++e) { h2[4 * qd + e] = h2[4 * qd + e] * rs + sh[e]; mx = fmaxf(mx, fabsf(h2[4 * qd + e])); } }
#pragma unroll
            for (int o = 1; o < 64; o <<= 1) mx = fmaxf(mx, __shfl_xor(mx, o));
            mx = fmaxf(mx, 1e-30f); const float hs = 224.0f / mx, hinv = mx * (1.0f / 224.0f);
            { v4u w;
#pragma unroll
              for (int qd = 0; qd < 4; ++qd) { int pk = 0; pk = __builtin_amdgcn_cvt_pk_fp8_f32(h2[4 * qd] * hs, h2[4 * qd + 1] * hs, pk, false); pk = __builtin_amdgcn_cvt_pk_fp8_f32(h2[4 * qd + 2] * hs, h2[4 * qd + 3] * hs, pk, true); w[qd] = (unsigned)pk; }
              *(LAS v4u*)(hq + l16) = w; }
            LDS_WAIT(); asm volatile("" ::: "memory");
            v4u hb[16];
#pragma unroll
            for (int c = 0; c < 16; ++c) hb[c] = *(const LAS v4u*)(hq + 64 * c + 16 * lq);
            asm volatile("s_waitcnt vmcnt(0)" ::: "memory");
            float w_lo = 0.f, w_hi = 0.f;
#pragma unroll 1
            for (int u = 0; u < 16; ++u) {
                { const int un = (u + 1) & 15; const int ensel = un < 8 ? e_lo : e_hi; const int nb = (un & 7) * 8; LAS unsigned char* dst = ring + ((u + 1) & 1) * U6_BUF;
#pragma unroll
                  for (int j = 0; j < 8; ++j) { const int e = __builtin_amdgcn_readlane(ensel, nb + j);
                      __builtin_amdgcn_global_load_lds((const unsigned*)(EU + ((unsigned)e * 1024u + l16)), (LAS unsigned*)(dst + j * U6_ROWP), 16, 0, 0); } }
                asm volatile("s_waitcnt vmcnt(8)" ::: "memory");
                const LAS unsigned char* src = ring + (u & 1) * U6_BUF + (li & 7) * U6_ROWP + 16 * lq;
                f32x4 acc = (f32x4){0.f, 0.f, 0.f, 0.f};
#pragma unroll
                for (int c = 0; c < 16; ++c) { const v4u a = *(const LAS v4u*)(src + 64 * c);
                    acc = __builtin_amdgcn_mfma_f32_16x16x32_fp8_fp8((i64_t)(((unsigned long long)a[1] << 32) | a[0]), (i64_t)(((unsigned long long)hb[c][1] << 32) | hb[c][0]), acc, 0, 0, 0);
                    acc = __builtin_amdgcn_mfma_f32_16x16x32_fp8_fp8((i64_t)(((unsigned long long)a[3] << 32) | a[2]), (i64_t)(((unsigned long long)hb[c][3] << 32) | hb[c][2]), acc, 0, 0, 0); }
                const int base = (u & 7) * 8; const int r = li & 3;
                const float sel = r == 0 ? acc[0] : (r == 1 ? acc[1] : (r == 2 ? acc[2] : acc[3]));
                const float dmine = __shfl(sel, ((lane & 7) >> 2) * 16 + (lane & 3));
                const float gsel = u < 8 ? g_lo : g_hi, susel = u < 8 ? su_lo : su_hi, svsel = u < 8 ? sv_lo : sv_hi;
                const float wv = gsel * gelu_erf(dmine * susel * hinv) * svsel;
                const bool mine = (lane >= base) && (lane < base + 8);
                if (u < 8) w_lo = mine ? wv : w_lo; else w_hi = mine ? wv : w_hi;
                asm volatile("s_waitcnt lgkmcnt(0)" ::: "memory");
            }
            WSP(float, WS_GATE)[t * 128 + lane] = w_lo; WSP(float, WS_GATE)[t * 128 + 64 + lane] = w_hi;
        }
    }
}
constexpr int NPHASE = 10;
__global__ void __launch_bounds__(NTHR, 2) fwd_mega(Args args) {
    extern __shared__ __attribute__((aligned(16))) unsigned char lds[];
    Frame F;
    F.lds = (LAS unsigned char*)lds;
    F.MISC = (volatile LAS unsigned*)(F.lds + MISC_OFF);
    F.G = gridDim.x; { const int bx = blockIdx.x; F.vcu = (F.G % 8 == 0) ? (bx % 8) * (F.G / 8) + bx / 8 : bx; }
    F.ws = args.ws; F.out = args.out;
    F.a = &args;
    for (int u = threadIdx.x; u < 32; u += NTHR) F.MISC[u] = 0u;
    __syncthreads();
    const int lo = args.ph_lo, hi = args.ph_hi;
    const bool use_bar = (hi - lo) > 1;
    XcdBarrier bar; bar.bar = (unsigned*)(F.ws + WS_CTL); bar.x = 0; bar.st = nullptr;
    if (use_bar) bar = xcd_barrier_post((unsigned*)(F.ws + WS_CTL), F.MISC + 8);
#define IN(k) (lo <= (k) && (k) < hi)
#define SEAM(k) do { if (IN(k) && IN((k) + 1)) xcd_barrier(bar); } while (0)
#ifndef REP_PHASE
#define REP_PHASE -1
#endif
#define REPEAT(k, body) do { if (REP_PHASE == (k)) { xcd_barrier(bar); body; } } while (0)
    if (IN(0)) {
#ifndef SKIP_P0
 p0_phase(F); REPEAT(0, p0_phase(F));
#endif
 } SEAM(0);
    if (IN(1)) {
#ifndef SKIP_P1
 p1_phase(F); REPEAT(1, p1_phase(F));
#endif
 } SEAM(1);
    if (IN(2)) {
        pg8::Gemm g{WSP(bf16, WS_H1), WSP(bf16, WS_WINT), MTOK, NPROJ, 1024}; pg8::StaticOrder S; S.init(MTOK, NPROJ, F.G, (int)blockIdx.x);
        pg8::EpiProj E{WSP(bf16, WS_PROJ), NPROJ};
        pg8::gemm_phase<pg8::EpiProj, pg8::StaticOrder, true, true>(F.lds, g, S, E);
        REPEAT(2, (pg8::gemm_phase<pg8::EpiProj, pg8::StaticOrder, true, true>(F.lds, g, S, E)));
    } SEAM(2);
    if (IN(3)) {
#ifndef SKIP_SSD
 p3pre_conv(F); xcd_barrier(bar); p3_ssd3(F); REPEAT(30, p3_ssd3(F)); REPEAT(32, p3pre_conv(F));
#endif
#ifndef SKIP_S5
 p3_s5v2(F); REPEAT(31, p3_s5v2(F));
#endif
 } SEAM(3);
    if (IN(5)) {
        pg8::Gemm g{WSP(bf16, WS_Y), WSP(bf16, WS_WOUTT), MTOK, 1024, 2048}; pg8::StaticOrder S; S.init(MTOK, 1024, F.G, (int)blockIdx.x);
        PG8_LAS float* tab = (PG8_LAS float*)(F.lds + pg8::STAGE_BYTES);
        { pg8::Unit u; for (int i = 0; S.next(i, u); ++i) pg8::SegScaleHook::build(F.lds + pg8::STAGE_BYTES, u, WSP(float, WS_STSSD), WSP(float, WS_STS5), (int)threadIdx.x); }
        __syncthreads();
        pg8::EpiX1 E{(F.a->in[0]), F.out, WSP(bf16, WS_X1S), WSP(float, WS_MOD), (F.a->in[24]), WSP(float, WS_ROWSTAT), tab};
        pg8::SegScaleHook H;
        pg8::gemm_phase<pg8::EpiX1, pg8::StaticOrder, true, true, pg8::SegScaleHook>(F.lds, g, S, E, H);
    } SEAM(5);
    if (IN(6)) {
        pg8::Gemm g{WSP(bf16, WS_X1S), WSP(bf16, WS_WQKT), MTOK, 2048, 1024}; pg8::StaticOrder S; S.init(MTOK, 2048, F.G, (int)blockIdx.x);
        pg8::EpiScores E{WSP(_Float16, WS_SCORES), WSP(float, WS_SB), WSP(float, WS_ROWSTAT)};
        pg8::gemm_phase<pg8::EpiScores, pg8::StaticOrder, true, true>(F.lds, g, S, E);
        REPEAT(6, (pg8::gemm_phase<pg8::EpiScores, pg8::StaticOrder, true, true>(F.lds, g, S, E)));
    } SEAM(6);
    if (IN(7)) {
#ifndef SKIP_TOPK
 p5b_topk(F); REPEAT(7, p5b_topk(F));
#endif
 } SEAM(7);
    if (IN(8)) { p8_peer_up6(F); REPEAT(8, { p5b_topk(F); xcd_barrier(bar); p8_peer_up6(F); }); } SEAM(8);
    if (IN(9)) { p9_peer_down2(F); }
#undef IN
#undef SEAM
}

#ifndef N_LAUNCHES
#define N_LAUNCHES 1
#endif
extern "C" void kernel_launch(void* const* d_in, const int* in_sizes, int n_in, void* d_out, int out_size, void* d_ws, size_t ws_size, hipStream_t stream) {
    static int grid = 0;
    if (grid == 0) {
        if (n_in != 30 || in_sizes[0] != MTOK * DM || out_size != MTOK * DM || ws_size < WS_END) { fprintf(stderr, "kernel_launch: unexpected shapes (n_in %d, in0 %d, out %d, ws %zu)\n", n_in, n_in > 0 ? in_sizes[0] : -1, out_size, ws_size); grid = -1; return; }
        int dev = 0, cus = 0, per_cu = 0;
        if (hipGetDevice(&dev) != hipSuccess || hipDeviceGetAttribute(&cus, hipDeviceAttributeMultiprocessorCount, dev) != hipSuccess) { grid = -1; return; }
        if (hipFuncSetAttribute((const void*)fwd_mega, hipFuncAttributeMaxDynamicSharedMemorySize, LDS_BYTES) != hipSuccess) { fprintf(stderr, "kernel_launch: hipFuncSetAttribute failed\n"); grid = -1; return; }
        if (hipOccupancyMaxActiveBlocksPerMultiprocessor(&per_cu, (const void*)fwd_mega, NTHR, LDS_BYTES) != hipSuccess || per_cu < 1) { fprintf(stderr, "kernel_launch: occupancy query says %d\n", per_cu); (void)hipGetLastError(); grid = -1; return; }
        if (cus != 256) { fprintf(stderr, "kernel_launch: built for a 256-CU device (got %d CUs); nothing launched\n", cus); grid = -1; return; }
        grid = cus;
    }
    if (grid < 0) return;
    (void)hipMemsetAsync((char*)d_ws + WS_CTL, 0, CTL_ZERO_BYTES, stream);
    Args a{};
    for (int i = 0; i < 30; ++i) a.in[i] = (const float*)d_in[i];
    a.out = (float*)d_out; a.ws = (unsigned char*)d_ws;
    if (N_LAUNCHES == 1) {
        a.ph_lo = 0; a.ph_hi = NPHASE;
        void* kargs[] = {&a};
#ifdef PLAIN_LAUNCH
        (void)kargs; hipLaunchKernelGGL(fwd_mega, dim3(grid), dim3(NTHR), LDS_BYTES, stream, a);
#else
        hipError_t e = hipLaunchCooperativeKernel((const void*)fwd_mega, dim3(grid), dim3(NTHR), kargs, LDS_BYTES, stream);
        if (e != hipSuccess) fprintf(stderr, "kernel_launch: cooperative launch failed: %s (grid %d)\n", hipGetErrorString(e), grid);
#endif
    } else {
        for (int p = 0; p < NPHASE; ++p) { a.ph_lo = p; a.ph_hi = p + 1; hipLaunchKernelGGL(fwd_mega, dim3(grid), dim3(NTHR), LDS_BYTES, stream, a); }
    }
}
```

```cpp
#include <hip/hip_runtime.h>
#include <cstdio>
#include <cstdint>
namespace pg8 {
#define PG8_LAS __attribute__((address_space(3)))
typedef unsigned short bf16_t;
typedef short bf16x8 __attribute__((ext_vector_type(8)));
typedef float f32x4 __attribute__((ext_vector_type(4)));
typedef unsigned u32x4 __attribute__((ext_vector_type(4)));
constexpr int BM = 256, BK = 64, HALF = 128, HTB = HALF * BK * 2  , STAGE_BYTES = 8 * HTB, NXCD = 8, WGM = 8;

__host__ __device__ __forceinline__ int lds_byte(int r, int c) { const int st = (r >> 4) * 2 + (c >> 5), rr = r & 15, cc = c & 31, ob = rr * 64 + cc * 2; return st * 1024 + (ob ^ (((ob >> 9) & 1) << 5)); }
__host__ __device__ __forceinline__ void stage_rc(int b, int& R, int& C) { const int st = b / 1024, sb = b % 1024, swz = sb ^ (((sb >> 9) & 1) << 5); R = (st >> 1) * 16 + swz / 64; C = (st & 1) * 32 + (swz % 64) / 2; }
__host__ __device__ __forceinline__ int perm32(int rho) { const int n = rho >> 4, i = rho & 15; return 8 * (i >> 2) + 4 * n + (i & 3); }

struct Unit { int pm, pn; };
struct Gemm { const bf16_t* A; const bf16_t* Bt; int M, N, K; };

struct StaticOrder {
    int nM, nN, nwg, G, c;
    __host__ __device__ void init(int M, int N, int G_, int c_) { nM = M / BM; nN = N / BM; nwg = nM * nN; G = G_; c = c_; }
    __host__ __device__ bool next(int i, Unit& u) const {
        const long L = (long)i * G + c; if (L >= nwg) return false;
        int wgid = (int)L; { const int q = nwg / NXCD, r = nwg % NXCD, xcd = wgid % NXCD, off = wgid / NXCD; wgid = (xcd < r ? xcd * (q + 1) : r * (q + 1) + (xcd - r) * q) + off; }
        const int nig = WGM * nN, gid = wgid / nig, fm = gid * WGM, gsz = (nM - fm) < WGM ? (nM - fm) : WGM;
        u.pm = fm + ((wgid % nig) % gsz); u.pn = (wgid % nig) / gsz; return true;
    }
    __device__ __forceinline__ void a_ready(const Unit&) const {}
    __device__ __forceinline__ void done(const Unit&) const {}
};

__device__ __forceinline__ unsigned cvt_pk_bf16(float lo, float hi) { unsigned r; asm volatile("v_cvt_pk_bf16_f32 %0, %1, %2" : "=v"(r) : "v"(lo), "v"(hi)); return r; }
typedef float f32x2 __attribute__((ext_vector_type(2)));
struct NoHook { __device__ __forceinline__ void at_tile(int, const Unit&, f32x4 (&)[2][2][4][2], PG8_LAS unsigned char*, int, int) const {} };
template <class Epi, class Sched, bool ALIGN_EPI = false, bool SP2 = false, class Hook = NoHook>
__device__ __forceinline__ void gemm_phase(PG8_LAS unsigned char* lds, const Gemm g, const Sched& S, const Epi& E, const Hook& H = Hook()) {
    const int tid = threadIdx.x, wid = __builtin_amdgcn_readfirstlane(tid >> 6), lane = tid & 63, wr = wid >> 2, wc = wid & 3, fr = lane & 15, fq = lane >> 4;
    const int K = g.K, nt = K / BK;
    unsigned voffA[2], voffB[2];
#pragma unroll
    for (int i = 0; i < 2; ++i) { int R, C; stage_rc(tid * 16 + i * 8192, R, C); const int Rb = Epi::PERM ? ((R & ~31) + perm32(R & 31)) : R;
        voffA[i] = (unsigned)(R * K + C) * 2u; voffB[i] = (unsigned)(Rb * K + C) * 2u; }
    const size_t kstep = (size_t)(BK * 2);
    const size_t hstep = (size_t)HALF * K * 2;
    const size_t tstep = 2 * hstep;
    const unsigned ldsw = (unsigned)wid * 1024u;
    const int aoff = lds_byte(wr * 64 + fr, fq * 8), boff = lds_byte(wc * 32 + fr, fq * 8);
#define PG8_SA(b, h) (((b) * 2 + (h)) * HTB)
#define PG8_SB(b, h) ((4 + (b) * 2 + (h)) * HTB)
#define PG8_STAGE(bufoff, gbase, voff) do { _Pragma("unroll") for (int _i = 0; _i < 2; ++_i) \
        __builtin_amdgcn_global_load_lds((const unsigned*)((const char*)(gbase) + (voff)[_i]), (PG8_LAS unsigned*)(lds + (bufoff) + ldsw + _i * 8192), 16, 0, 0); } while (0)
#define PG8_LDA(dst, b, h) do { _Pragma("unroll") for (int m = 0; m < 4; ++m) _Pragma("unroll") for (int k = 0; k < 2; ++k) dst[m][k] = *(const PG8_LAS bf16x8*)(lds + PG8_SA(b, h) + aoff + m * 2048 + k * 1024); } while (0)
#define PG8_LDB(dst, b, h) do { _Pragma("unroll") for (int n = 0; n < 2; ++n) _Pragma("unroll") for (int k = 0; k < 2; ++k) dst[n][k] = *(const PG8_LAS bf16x8*)(lds + PG8_SB(b, h) + boff + n * 2048 + k * 1024); } while (0)
#define PG8_MMA(ai, bj, At, Bt) do { __builtin_amdgcn_s_setprio(1); _Pragma("unroll") for (int m = 0; m < 4; ++m) _Pragma("unroll") for (int n = 0; n < 2; ++n) _Pragma("unroll") for (int k = 0; k < 2; ++k) \
        acc[ai][bj][m][n] = __builtin_amdgcn_mfma_f32_16x16x32_bf16(Bt[n][k], At[m][k], acc[ai][bj][m][n], 0, 0, 0); __builtin_amdgcn_s_setprio(0); } while (0)
#define PG8_WAIT_V(n) asm volatile("s_waitcnt vmcnt(" #n ")" ::: "memory")
#define PG8_WAIT_L(n) asm volatile("s_waitcnt lgkmcnt(" #n ")" ::: "memory")
#define PG8_BAR __builtin_amdgcn_s_barrier()
#define PG8_SCHED __builtin_amdgcn_sched_barrier(0)
    Unit cur, nxt; int ui = 0;
    if (!S.next(0, cur)) return;
    f32x4 acc[2][2][4][2];
#pragma unroll
    for (int a = 0; a < 2; ++a)
#pragma unroll
        for (int b = 0; b < 2; ++b)
#pragma unroll
            for (int m = 0; m < 4; ++m)
#pragma unroll
                for (int n = 0; n < 2; ++n) acc[a][b][m][n] = (f32x4){0.f, 0.f, 0.f, 0.f};
    bf16x8 At[4][2], B0[2][2], B1[2][2];
    const char* cA = (const char*)g.A + (size_t)cur.pm * tstep; const char* cB = (const char*)g.Bt + (size_t)cur.pn * tstep;
    S.a_ready(cur);
    if constexpr (SP2) {
        PG8_STAGE(PG8_SB(0, 0), cB, voffB); PG8_STAGE(PG8_SB(0, 1), cB + hstep, voffB); PG8_STAGE(PG8_SA(0, 0), cA, voffA); PG8_STAGE(PG8_SA(0, 1), cA + hstep, voffA);
        if (wr == 1) PG8_BAR;
        PG8_WAIT_V(2); PG8_BAR;
        PG8_STAGE(PG8_SB(1, 0), cB + kstep, voffB); PG8_STAGE(PG8_SA(1, 0), cA + kstep, voffA); PG8_STAGE(PG8_SB(1, 1), cB + hstep + kstep, voffB);
        PG8_WAIT_V(6); PG8_BAR;
    } else {
        PG8_STAGE(PG8_SB(0, 0), cB, voffB); PG8_STAGE(PG8_SA(0, 0), cA, voffA); PG8_STAGE(PG8_SB(0, 1), cB + hstep, voffB); PG8_STAGE(PG8_SA(0, 1), cA + hstep, voffA);
        if (wr == 1) PG8_BAR;
        PG8_WAIT_V(4); PG8_BAR;
        PG8_STAGE(PG8_SB(1, 0), cB + kstep, voffB); PG8_STAGE(PG8_SA(1, 0), cA + kstep, voffA); PG8_STAGE(PG8_SB(1, 1), cB + hstep + kstep, voffB);
        PG8_WAIT_V(6); PG8_BAR;
    }
    for (;;) {
        const bool has_next = S.next(ui + 1, nxt);
        const char* nA = has_next ? (const char*)g.A + (size_t)nxt.pm * tstep : cA; const char* nB = has_next ? (const char*)g.Bt + (size_t)nxt.pn * tstep : cB;
        for (int t = 0; t < nt; t += 2) {
            const bool last = (t == nt - 2);
            H.at_tile(t, cur, acc, lds + STAGE_BYTES, wr, fr);
            const char* a1 = cA + (size_t)(t + 1) * kstep;
            const char* a2 = last ? nA : cA + (size_t)(t + 2) * kstep; const char* b2 = last ? nB : cB + (size_t)(t + 2) * kstep;
            const char* a3 = a2 + kstep; const char* b3 = b2 + kstep;
            if (last && has_next) S.a_ready(nxt);
            if constexpr (SP2) {
            PG8_LDB(B0, 0, 0); PG8_LDB(B1, 0, 1); PG8_SCHED; PG8_LDA(At, 0, 0); PG8_STAGE(PG8_SA(1, 1), a1 + hstep, voffA);
            PG8_WAIT_V(8); PG8_WAIT_L(0); PG8_BAR; PG8_MMA(0, 0, At, B0); PG8_MMA(0, 1, At, B1); PG8_BAR; PG8_SCHED;
            PG8_LDA(At, 0, 1); PG8_STAGE(PG8_SB(0, 0), b2, voffB); PG8_STAGE(PG8_SB(0, 1), b2 + hstep, voffB); PG8_STAGE(PG8_SA(0, 0), a2, voffA);
            PG8_WAIT_V(8); PG8_WAIT_L(0); PG8_BAR; PG8_MMA(1, 0, At, B0); PG8_MMA(1, 1, At, B1); PG8_BAR; PG8_SCHED;
            PG8_LDB(B0, 1, 0); PG8_LDB(B1, 1, 1); PG8_SCHED; PG8_LDA(At, 1, 0); PG8_STAGE(PG8_SA(0, 1), a2 + hstep, voffA);
            PG8_WAIT_V(8); PG8_WAIT_L(0); PG8_BAR; PG8_MMA(0, 0, At, B0); PG8_MMA(0, 1, At, B1); PG8_BAR; PG8_SCHED;
            PG8_LDA(At, 1, 1); PG8_STAGE(PG8_SB(1, 0), b3, voffB); PG8_STAGE(PG8_SB(1, 1), b3 + hstep, voffB); PG8_STAGE(PG8_SA(1, 0), a3, voffA);
            PG8_WAIT_V(8); PG8_WAIT_L(0); PG8_BAR; PG8_MMA(1, 0, At, B0); PG8_MMA(1, 1, At, B1); PG8_BAR; PG8_SCHED;
            } else {
            PG8_LDB(B0, 0, 0); PG8_SCHED; PG8_LDA(At, 0, 0); PG8_STAGE(PG8_SA(1, 1), a1 + hstep, voffA);
            PG8_WAIT_L(8); PG8_BAR; PG8_WAIT_L(0); PG8_MMA(0, 0, At, B0); PG8_BAR; PG8_SCHED;
            PG8_LDB(B1, 0, 1); PG8_STAGE(PG8_SB(0, 0), b2, voffB);
            PG8_BAR; PG8_WAIT_L(0); PG8_MMA(0, 1, At, B1); PG8_BAR;
            PG8_LDA(At, 0, 1); PG8_STAGE(PG8_SA(0, 0), a2, voffA);
            PG8_BAR; PG8_WAIT_L(0); PG8_MMA(1, 0, At, B0); PG8_BAR; PG8_SCHED;
            PG8_STAGE(PG8_SB(0, 1), b2 + hstep, voffB);
            PG8_WAIT_V(6); PG8_BAR; PG8_MMA(1, 1, At, B1); PG8_BAR;
            PG8_LDB(B0, 1, 0); PG8_SCHED; PG8_LDA(At, 1, 0); PG8_STAGE(PG8_SA(0, 1), a2 + hstep, voffA);
            PG8_WAIT_L(8); PG8_BAR; PG8_WAIT_L(0); PG8_MMA(0, 0, At, B0); PG8_BAR; PG8_SCHED;
            PG8_LDB(B1, 1, 1); PG8_STAGE(PG8_SB(1, 0), b3, voffB);
            PG8_BAR; PG8_WAIT_L(0); PG8_MMA(0, 1, At, B1); PG8_BAR;
            PG8_LDA(At, 1, 1); PG8_STAGE(PG8_SA(1, 0), a3, voffA);
            PG8_BAR; PG8_WAIT_L(0); PG8_MMA(1, 0, At, B0); PG8_BAR; PG8_SCHED;
            PG8_STAGE(PG8_SB(1, 1), b3 + hstep, voffB);
            PG8_WAIT_V(6); PG8_BAR; PG8_MMA(1, 1, At, B1); PG8_BAR;
            }
        }
        if constexpr (ALIGN_EPI) { if (wr == 0) PG8_BAR; }
        if constexpr (!Epi::AFTER_DRAIN) { E(acc, cur, wr, wc, fr, fq);
#ifdef PROBE_EPI2
            if constexpr (Epi::PROBE_TWICE) { asm volatile("" ::: "memory"); E(acc, cur, wr, wc, fr, fq); }
#endif
            S.done(cur); }
        if (!has_next) break;
#pragma unroll
        for (int a = 0; a < 2; ++a)
#pragma unroll
            for (int b = 0; b < 2; ++b)
#pragma unroll
                for (int m = 0; m < 4; ++m)
#pragma unroll
                    for (int n = 0; n < 2; ++n) acc[a][b][m][n] = (f32x4){0.f, 0.f, 0.f, 0.f};
        cur = nxt; cA = nA; cB = nB; ++ui;
        if constexpr (ALIGN_EPI) { if (wr == 1) PG8_BAR; }
    }
    PG8_WAIT_V(0);
    if constexpr (!ALIGN_EPI) { if (wr == 0) PG8_BAR; }
    PG8_BAR;
    if constexpr (Epi::AFTER_DRAIN) { E.fused(acc, cur, wr, wc, fr, fq, lds, wid, lane); S.done(cur); }
#undef PG8_SA
#undef PG8_SB
#undef PG8_STAGE
#undef PG8_LDA
#undef PG8_LDB
#undef PG8_MMA
#undef PG8_WAIT_V
#undef PG8_WAIT_L
#undef PG8_BAR
#undef PG8_SCHED
}
}
namespace pg8 {
struct EpiProj {
    static constexpr bool PERM = true, AFTER_DRAIN = false, PROBE_TWICE = true;
    bf16_t* O; int ldc;
    __device__ __forceinline__ void operator()(const f32x4 (&acc)[2][2][4][2], const Unit& u, int wr, int wc, int fr, int fq) const {
        const int row0 = u.pm * BM + wr * 64 + fr; const int col0 = u.pn * BM + wc * 32 + 8 * fq;
#pragma unroll
        for (int ai = 0; ai < 2; ++ai)
#pragma unroll
            for (int m = 0; m < 4; ++m) { bf16_t* rowp = O + (size_t)(row0 + ai * HALF + m * 16) * ldc + col0;
#pragma unroll
                for (int bj = 0; bj < 2; ++bj) { const f32x4 v0 = acc[ai][bj][m][0], v1 = acc[ai][bj][m][1];
                    u32x4 w; w.x = cvt_pk_bf16(v0[0], v0[1]); w.y = cvt_pk_bf16(v0[2], v0[3]); w.z = cvt_pk_bf16(v1[0], v1[1]); w.w = cvt_pk_bf16(v1[2], v1[3]);
                    __builtin_nontemporal_store(w, (u32x4*)(rowp + bj * HALF)); } }
    }
};
struct EpiX1 {
    static constexpr bool PERM = true, AFTER_DRAIN = false, PROBE_TWICE = false;
    const float* x; float* x1; bf16_t* x1s; const float* mod; const float* norm2_g; float* rowstat; PG8_LAS float* tab;
    __device__ __forceinline__ void operator()(const f32x4 (&acc)[2][2][4][2], const Unit& u, int wr, int wc, int fr, int fq) const {
        const int row0 = u.pm * BM + wr * 64 + fr; const int col0 = u.pn * BM + wc * 32 + 8 * fq; const int b = (u.pm * BM) >> 11;
        const float* mb = mod + (size_t)b * 6144;
        f32x4 g1[2][2], g2[2][2];
#pragma unroll
        for (int bj = 0; bj < 2; ++bj)
#pragma unroll
            for (int n = 0; n < 2; ++n) { const int c = col0 + bj * HALF + 4 * n; g1[bj][n] = *(const f32x4*)(mb + 2048 + c);
                const f32x4 sc = *(const f32x4*)(mb + 4096 + c), ng = *(const f32x4*)(norm2_g + c); g2[bj][n] = ng * (sc + 1.0f); }
#pragma unroll
        for (int ai = 0; ai < 2; ++ai)
#pragma unroll
            for (int m = 0; m < 4; ++m) { const size_t row = (size_t)(row0 + ai * HALF + m * 16); const size_t off = row * 1024 + col0; float ss = 0.f;
                const float rfin = tab[((u.pm >> 3) & 1) * 1280 + 1024 + ai * HALF + wr * 64 + m * 16 + fr];
#pragma unroll
                for (int bj = 0; bj < 2; ++bj) {
                    const f32x4 xa = *(const f32x4*)(x + off + bj * HALF), xb = *(const f32x4*)(x + off + bj * HALF + 4);
                    const f32x4 v0 = xa + g1[bj][0] * (acc[ai][bj][m][0] * rfin), v1 = xb + g1[bj][1] * (acc[ai][bj][m][1] * rfin);
                    *(f32x4*)(x1 + off + bj * HALF) = v0; *(f32x4*)(x1 + off + bj * HALF + 4) = v1;
                    ss += (v0[0] * v0[0] + v0[1] * v0[1]) + (v0[2] * v0[2] + v0[3] * v0[3]) + (v1[0] * v1[0] + v1[1] * v1[1]) + (v1[2] * v1[2] + v1[3] * v1[3]);
                    const f32x4 s0 = v0 * g2[bj][0], s1 = v1 * g2[bj][1];
                    u32x4 w; w.x = cvt_pk_bf16(s0[0], s0[1]); w.y = cvt_pk_bf16(s0[2], s0[3]); w.z = cvt_pk_bf16(s1[0], s1[1]); w.w = cvt_pk_bf16(s1[2], s1[3]);
                    *(u32x4*)(x1s + off + bj * HALF) = w; }
                ss += __shfl_xor(ss, 16); ss += __shfl_xor(ss, 32);
                if (fq == 0) atomicAdd(rowstat + row, ss); }
    }
};
typedef _Float16 f16x8 __attribute__((ext_vector_type(8)));
struct EpiScores {
    static constexpr bool PERM = true, AFTER_DRAIN = false, PROBE_TWICE = false;
    _Float16* S; const float* sb; const float* rowstat;
    __device__ __forceinline__ void operator()(const f32x4 (&acc)[2][2][4][2], const Unit& u, int wr, int wc, int fr, int fq) const {
        const int row0 = u.pm * BM + wr * 64 + fr; const int col0 = u.pn * BM + wc * 32 + 8 * fq; const int b = (u.pm * BM) >> 11;
        f32x4 bv[2][2];
#pragma unroll
        for (int bj = 0; bj < 2; ++bj)
#pragma unroll
            for (int n = 0; n < 2; ++n) bv[bj][n] = *(const f32x4*)(sb + (size_t)b * 2048 + col0 + bj * HALF + 4 * n);
#pragma unroll
        for (int ai = 0; ai < 2; ++ai)
#pragma unroll
            for (int m = 0; m < 4; ++m) { const size_t row = (size_t)(row0 + ai * HALF + m * 16); const float rs = __builtin_amdgcn_rsqf(rowstat[row] * (1.0f / 1024.0f) + 1e-6f);
                _Float16* rowp = S + row * 2048 + col0;
#pragma unroll
                for (int bj = 0; bj < 2; ++bj) { const f32x4 v0 = acc[ai][bj][m][0] * rs + bv[bj][0], v1 = acc[ai][bj][m][1] * rs + bv[bj][1];
                    f16x8 h; h[0] = (_Float16)v0[0]; h[1] = (_Float16)v0[1]; h[2] = (_Float16)v0[2]; h[3] = (_Float16)v0[3]; h[4] = (_Float16)v1[0]; h[5] = (_Float16)v1[1]; h[6] = (_Float16)v1[2]; h[7] = (_Float16)v1[3];
                    *(f16x8*)(rowp + bj * HALF) = h; } }
    }
};
struct SegScaleHook {
    __device__ __forceinline__ static void build(PG8_LAS unsigned char* ldsx, const Unit& u, const float* st_ssd, const float* st_s5, int tid) {
        PG8_LAS float* tab = (PG8_LAS float*)ldsx + ((u.pm >> 3) & 1) * 1280;
        if (tid < 256) { const size_t row = (size_t)u.pm * BM + tid; const f32x4* sg = (const f32x4*)(st_ssd + row * 16); const f32x4* s5 = (const f32x4*)(st_s5 + row * 64);
            float r[5];
#pragma unroll
            for (int gI = 0; gI < 4; ++gI) { const f32x4 v = sg[gI]; r[gI] = __builtin_amdgcn_rsqf(((v[0] + v[1]) + (v[2] + v[3])) * (1.0f / 256.0f) + 1e-6f); }
            float a5 = 0.f;
#pragma unroll
            for (int q = 0; q < 16; ++q) { const f32x4 v = s5[q]; a5 += (v[0] + v[1]) + (v[2] + v[3]); }
            r[4] = __builtin_amdgcn_rsqf(a5 * (1.0f / 1024.0f) + 1e-6f);
#pragma unroll
            for (int k = 0; k < 4; ++k) tab[k * 256 + tid] = r[k] * __builtin_amdgcn_rcpf(r[k + 1]);
            tab[1024 + tid] = r[4]; }
    }
    __device__ __forceinline__ void at_tile(int t, const Unit& u, f32x4 (&acc)[2][2][4][2], PG8_LAS unsigned char* ldsx, int wr, int fr) const {
        if (t == 4 || t == 8 || t == 12 || t == 16) { const PG8_LAS float* rt = (const PG8_LAS float*)ldsx + ((u.pm >> 3) & 1) * 1280 + ((t >> 2) - 1) * 256 + wr * 64 + fr;
#pragma unroll
            for (int ai = 0; ai < 2; ++ai)
#pragma unroll
                for (int m = 0; m < 4; ++m) { const float r = rt[ai * HALF + m * 16];
#pragma unroll
                    for (int bj = 0; bj < 2; ++bj) { acc[ai][bj][m][0] = acc[ai][bj][m][0] * r; acc[ai][bj][m][1] = acc[ai][bj][m][1] * r; } } }
    }
};
}
constexpr int NWAVES = 8, NTHR = 512;
constexpr int DM = 1024, NB = 16, SEQ = 2048, MTOK = NB * SEQ;
constexpr int NPROJ = 4096;
constexpr int INW = 4112;
constexpr int NHEADS = 16, HDIM = 64, NGRP = 4, NST = 128, CHUNK = 128;
constexpr int S5G = 64, S5CH = 16, S5P = 64;
constexpr int PH = 8, PK = 16, PNK = 128;
constexpr float EPSF = 1e-6f;
constexpr int NS5PART = 64;

constexpr size_t MiB = 1u << 20;
constexpr size_t WS_CTL = 0, CTL_ZERO_BYTES = 64 * 1024;
constexpr size_t WS_MOD = 1 * MiB;
constexpr size_t WS_WDT = WS_MOD + 0x60000;
constexpr size_t WS_SB = WS_MOD + 0x70000;
constexpr size_t WS_ROWSTAT = WS_MOD + 0x90000;
constexpr size_t WS_S5LB = WS_MOD + 0xB0000;
constexpr size_t WS_S5BB = WS_MOD + 0xC0000;
constexpr size_t WS_DTRAW = 3 * MiB;
constexpr size_t WS_STSSD = 5 * MiB;
constexpr size_t WS_STS5 = 7 * MiB;
constexpr size_t WS_WINT = 15 * MiB;
constexpr size_t WS_WOUTT = 23 * MiB;
constexpr size_t WS_WQKT = 27 * MiB;
constexpr size_t WS_EU = 31 * MiB, WS_EV = 47 * MiB;
constexpr size_t WS_EUS = 63 * MiB, WS_EVS = 63 * MiB + 65536;
constexpr size_t WS_START = 64 * MiB;
constexpr size_t WS_A = 95 * MiB;
constexpr size_t WS_B = 223 * MiB;
constexpr size_t WS_H1 = WS_A, WS_Y = WS_A, WS_PROJ = WS_B, WS_SCORES = WS_A;
constexpr size_t WS_X1S = WS_B + 192 * MiB;
constexpr size_t WS_EID = 479 * MiB, WS_GATE = 495 * MiB;
constexpr size_t WS_END = 511 * MiB;
static_assert(WS_SCORES + (size_t)MTOK * 2048 * 4 <= WS_X1S && WS_X1S + (size_t)MTOK * 1024 * 2 <= WS_EID && WS_GATE + (size_t)MTOK * 128 * 4 <= WS_END, "ws map");

constexpr int LDS_MAIN = 159744;
constexpr int MISC_OFF = LDS_MAIN;
constexpr int LDS_BYTES = LDS_MAIN + 128;

#define GAS __attribute__((address_space(1)))
#define LAS __attribute__((address_space(3)))
typedef unsigned short bf16;
typedef unsigned v4u __attribute__((ext_vector_type(4)));
typedef unsigned v2u __attribute__((ext_vector_type(2)));
typedef float f32x4 __attribute__((ext_vector_type(4)));
typedef float f32x2 __attribute__((ext_vector_type(2)));
typedef short bf16x8 __attribute__((ext_vector_type(8)));
#define LDS_WAIT() asm volatile("s_waitcnt lgkmcnt(0)" ::: "memory")
#define VM_WAIT() asm volatile("s_waitcnt vmcnt(0)" ::: "memory")
typedef __bf16 hwbf16x2 __attribute__((ext_vector_type(2)));
__device__ __forceinline__ unsigned pk2(float lo, float hi) { const f32x2 v = {lo, hi}; const hwbf16x2 b = __builtin_convertvector(v, hwbf16x2); return __builtin_bit_cast(unsigned, b); }
__device__ __forceinline__ unsigned f2bf(float f) { return pk2(f, 0.f) & 0xffffu; }
__device__ __forceinline__ float bflo(unsigned w) { return __builtin_bit_cast(float, w << 16); }
__device__ __forceinline__ float bfhi(unsigned w) { return __builtin_bit_cast(float, w & 0xffff0000u); }
__device__ __forceinline__ float bf2f(bf16 v) { return __builtin_bit_cast(float, (unsigned)v << 16); }
__device__ __forceinline__ float wave_sum(float v) {
#pragma unroll
    for (int o = 1; o < 64; o <<= 1) v += __shfl_xor(v, o);
    return v;
}
__device__ __forceinline__ float sigmoid_f(float v) { return __builtin_amdgcn_rcpf(1.0f + __builtin_amdgcn_exp2f(-1.4426950408889634f * v)); }
__device__ __forceinline__ float silu_f(float v) { return v * sigmoid_f(v); }
__device__ __forceinline__ float rsqrt_f(float v) { return __builtin_amdgcn_rsqf(v); }
__device__ __forceinline__ float gelu_erf(float v) {
    const float av = fabsf(v), t = __builtin_amdgcn_rcpf(av * 0.2316418882f + 1.0f);
    float q = t * 0.5307027145f + (-0.7265760135f); q = q * t + 0.7107068705f; q = q * t + (-0.142248368f); q = q * t + 0.127414796f; q = q * t;
    const float e = __builtin_amdgcn_exp2f((v * v) * (-0.72134752044f));
    const float m = v * (q * e);
    return v < 0.f ? m : v - m;
}
__device__ __forceinline__ float softplus_f(float v) { return fmaxf(v, 0.f) + 0.6931471805599453f * __builtin_amdgcn_logf(1.0f + __builtin_amdgcn_exp2f(-1.4426950408889634f * fabsf(v))); }
__device__ __forceinline__ void unpack8(const v4u w, float* f) { f[0] = bflo(w.x); f[1] = bfhi(w.x); f[2] = bflo(w.y); f[3] = bfhi(w.y); f[4] = bflo(w.z); f[5] = bfhi(w.z); f[6] = bflo(w.w); f[7] = bfhi(w.w); }
#define LDS_BARRIER() do { asm volatile("s_waitcnt lgkmcnt(0)" ::: "memory"); __builtin_amdgcn_s_barrier(); asm volatile("" ::: "memory"); } while (0)
__device__ __forceinline__ float row16_sum_to15(float v) {
    v += __builtin_bit_cast(float, __builtin_amdgcn_update_dpp(0, __builtin_bit_cast(int, v), 0x118, 0xf, 0xf, true));
    v += __builtin_bit_cast(float, __builtin_amdgcn_update_dpp(0, __builtin_bit_cast(int, v), 0x114, 0xf, 0xf, true));
    v += __builtin_bit_cast(float, __builtin_amdgcn_update_dpp(0, __builtin_bit_cast(int, v), 0x112, 0xf, 0xf, true));
    v += __builtin_bit_cast(float, __builtin_amdgcn_update_dpp(0, __builtin_bit_cast(int, v), 0x111, 0xf, 0xf, true));
    return v;
}
__device__ __forceinline__ float wave_sum_to63(float v) {
    v = row16_sum_to15(v);
    v += __builtin_bit_cast(float, __builtin_amdgcn_update_dpp(0, __builtin_bit_cast(int, v), 0x142, 0xa, 0xf, false));
    v += __builtin_bit_cast(float, __builtin_amdgcn_update_dpp(0, __builtin_bit_cast(int, v), 0x143, 0xc, 0xf, false));
    return v;
}
__device__ __forceinline__ f32x2 gelu_pk2(f32x2 v) {
    const f32x2 av = __builtin_elementwise_abs(v), d = av * 0.2316418882f + 1.0f;
    f32x2 t; t[0] = __builtin_amdgcn_rcpf(d[0]); t[1] = __builtin_amdgcn_rcpf(d[1]);
    f32x2 q = t * 0.5307027145f + (-0.7265760135f); q = q * t + 0.7107068705f; q = q * t + (-0.142248368f); q = q * t + 0.127414796f; q = q * t;
    const f32x2 s = (v * v) * (-0.72134752044f);
    f32x2 e; e[0] = __builtin_amdgcn_exp2f(s[0]); e[1] = __builtin_amdgcn_exp2f(s[1]);
    const f32x2 m = v * (q * e), r = v - m;
    f32x2 o; o[0] = v[0] < 0.f ? m[0] : r[0]; o[1] = v[1] < 0.f ? m[1] : r[1]; return o;
}
#define XB_TMO      128
#define XB_XCNT(j)  (256  + 64 * (j))
#define XB_XSUB(j)  (1280 + 64 * (j))
#define XB_XGEN(j)  (2304 + 64 * (j))
#define XB_TOP      3328
#define XB_TOPGEN   3392
#define XCD_BAR_WORDS 3456
#define XB_SPIN_CAP (1u << 18)

__device__ __forceinline__ unsigned xb_ld(unsigned* p)              { return __hip_atomic_load(p, __ATOMIC_RELAXED, __HIP_MEMORY_SCOPE_AGENT); }
__device__ __forceinline__ unsigned xb_add(unsigned* p, unsigned v) { return __hip_atomic_fetch_add(p, v, __ATOMIC_RELAXED, __HIP_MEMORY_SCOPE_AGENT); }
__device__ __forceinline__ unsigned xb_xcc_id() { return (unsigned)__builtin_amdgcn_s_getreg((3 << 11) | 20) & 0xFu; }
#define XB_SPIN(cond, bar) do { unsigned _sp = 0; while (cond) { __builtin_amdgcn_s_sleep(1); \
    if ((++_sp & 255u) == 0u) { if (xb_ld(&(bar)[XB_TMO])) break; if (_sp > XB_SPIN_CAP) { atomicAdd(&(bar)[XB_TMO], 1u); break; } } } } while (0)

struct XcdBarrier {
    unsigned* bar; unsigned x;
    volatile LAS unsigned* st;
};

__device__ __forceinline__ XcdBarrier xcd_barrier_post(unsigned* bar, volatile LAS unsigned* st) {
    XcdBarrier b; b.bar = bar; b.x = xb_xcc_id(); b.st = st;
    if (threadIdx.x == 0) (void)xb_add(&bar[XB_XCNT(b.x)], 1u);
    return b;
}
__device__ __forceinline__ void xcd_barrier_complete(unsigned* bar, unsigned x, unsigned& nloc, unsigned& nx) {
    const unsigned G = gridDim.x * gridDim.y * gridDim.z;
    unsigned sum, cnt, mine, sp = 0u;
    for (;;) {
        sum = 0u; cnt = 0u; mine = 0u;
#pragma unroll
        for (unsigned j = 0; j < 16; ++j) { const unsigned c = xb_ld(&bar[XB_XCNT(j)]); sum += c; cnt += (c > 0u) ? 1u : 0u; mine = (j == x) ? c : mine; }
        if (sum == G) break;
        __builtin_amdgcn_s_sleep(1);
        if ((++sp & 255u) == 0u) { if (xb_ld(&bar[XB_TMO])) break; if (sp > XB_SPIN_CAP) { atomicAdd(&bar[XB_TMO], 1u); break; } }
    }
    nloc = mine > 0u ? mine : 1u; nx = cnt > 0u ? cnt : 1u;
}

__device__ __forceinline__ void xcd_barrier(const XcdBarrier& b) {
    asm volatile("s_waitcnt vmcnt(0)" ::: "memory");
    __syncthreads();
    if (threadIdx.x == 0) {
        unsigned* bar = b.bar;
        __builtin_amdgcn_s_waitcnt(0);
        unsigned nloc = b.st[0], nx = b.st[1];
        if (nloc == 0u) { xcd_barrier_complete(bar, b.x, nloc, nx); b.st[0] = nloc; b.st[1] = nx; }
        const unsigned old = xb_add(&bar[XB_XSUB(b.x)], 1u);
        const unsigned gen = old / nloc;
        if (old + 1u == (gen + 1u) * nloc) {
            __builtin_amdgcn_fence(__ATOMIC_RELEASE, "agent");
            asm volatile("s_waitcnt vmcnt(0)" ::: "memory");
            const unsigned og = xb_add(&bar[XB_TOP], 1u);
            const unsigned tg = og / nx;
            if (og + 1u == (tg + 1u) * nx) xb_add(&bar[XB_TOPGEN], 1u);
            else XB_SPIN(xb_ld(&bar[XB_TOPGEN]) == tg, bar);
            __builtin_amdgcn_fence(__ATOMIC_ACQUIRE, "agent");
            xb_add(&bar[XB_XGEN(b.x)], 1u);
            asm volatile("s_waitcnt vmcnt(0)" ::: "memory");
        } else {
            XB_SPIN(xb_ld(&bar[XB_XGEN(b.x)]) == gen, bar);
            __builtin_amdgcn_fence(__ATOMIC_ACQUIRE, "agent");
            asm volatile("s_waitcnt vmcnt(0)" ::: "memory");
        }
    }
    __syncthreads();
}
struct Args { const float* in[30]; float* out; unsigned char* ws; int ph_lo, ph_hi; };
struct Frame {
    LAS unsigned char* lds;
    volatile LAS unsigned* MISC;
    int vcu, G;
    unsigned char* ws;
    const Args* a;
    float* out;
};
#define WSP(T, off) ((T*)(F.ws + (off)))

__device__ __forceinline__ void transpose_tile(const float* W, int ldw, int k0, int src_n0, bf16* WT, int K, int dst_n0, LAS float* scr, int lane, const float* kscale) {
#pragma unroll 8
    for (int i = 0; i < 32; ++i) { const int kk = 2 * i + (lane >> 5); float v = W[(size_t)(k0 + kk) * ldw + src_n0 + (lane & 31)]; if (kscale) v *= kscale[k0 + kk]; scr[kk * 33 + (lane & 31)] = v; }
    LDS_WAIT(); asm volatile("" ::: "memory");
    const int c = lane & 7;
#pragma unroll
    for (int j = 0; j < 4; ++j) { const int n = (lane >> 3) + 8 * j; const LAS float* s = scr + (8 * c) * 33 + n;
        v4u o; o.x = pk2(s[0 * 33], s[1 * 33]); o.y = pk2(s[2 * 33], s[3 * 33]); o.z = pk2(s[4 * 33], s[5 * 33]); o.w = pk2(s[6 * 33], s[7 * 33]);
        *(v4u*)(WT + (size_t)(dst_n0 + n) * K + k0 + 8 * c) = o; }
    LDS_WAIT(); asm volatile("" ::: "memory");
}
__device__ __forceinline__ void p0_phase(Frame& F) {
    const int f_tid = threadIdx.x, f_lane = f_tid & 63, f_wave = __builtin_amdgcn_readfirstlane(f_tid >> 6);
    const int gw = F.vcu * NWAVES + f_wave, NGW = F.G * NWAVES, gt = F.vcu * NTHR + f_tid, NGT = F.G * NTHR;
    {
        LAS float* sc = (LAS float*)F.lds;
        LAS float* red = (LAS float*)(F.lds + 65536);
        for (int i = f_tid; i < 16 * 1024; i += NTHR) { const int b = i >> 10, k = i & 1023; sc[k * 16 + b] = silu_f((F.a->in[1])[i]); }
        __syncthreads();
        const int ks = f_tid / 24, col = f_tid - ks * 24, j = F.vcu * 24 + col;
        if (ks < 21) {
            float acc[16];
#pragma unroll
            for (int b = 0; b < 16; ++b) acc[b] = 0.f;
            const int k0 = ks * 49, kn = (k0 + 49 <= 1024) ? 49 : (1024 - k0);
            const float* wp = (F.a->in[2]) + (size_t)k0 * 6144 + j;
#pragma unroll 1
            for (int kb = 0; kb < 49; kb += 7) {
                asm volatile("" ::: "memory");
                float wv[7];
#pragma unroll
                for (int u = 0; u < 7; ++u) wv[u] = (kb + u < kn) ? wp[(size_t)(kb + u) * 6144] : 0.f;
#pragma unroll
                for (int u = 0; u < 7; ++u) { const int kk = (kb + u < kn) ? (k0 + kb + u) : k0; const LAS f32x4* s4 = (const LAS f32x4*)(sc + kk * 16);
#pragma unroll
                    for (int q = 0; q < 4; ++q) { const f32x4 sv = s4[q]; acc[4 * q] += sv[0] * wv[u]; acc[4 * q + 1] += sv[1] * wv[u]; acc[4 * q + 2] += sv[2] * wv[u]; acc[4 * q + 3] += sv[3] * wv[u]; } }
            }
#pragma unroll
            for (int b = 0; b < 16; ++b) red[(ks * 16 + b) * 24 + col] = acc[b];
        }
        __syncthreads();
        for (int i = f_tid; i < 16 * 24; i += NTHR) { const int b = i / 24, cc = i - b * 24; float sacc = 0.f;
            for (int q = 0; q < 21; ++q) sacc += red[(q * 16 + b) * 24 + cc];
            WSP(float, WS_MOD)[b * 6144 + F.vcu * 24 + cc] = sacc + (F.a->in[3])[F.vcu * 24 + cc]; }
        __syncthreads();
    }
    {
        LAS float* scr = (LAS float*)(F.lds + f_wave * 16384);
        constexpr int I_IN = (1024 / 64) * (NPROJ / 32), I_OUT = (2048 / 64) * (1024 / 32);
        for (int it = gw; it < I_IN + I_OUT; it += NGW) {
            if (it < I_IN) { const int kb = it / (NPROJ / 32), nb = it % (NPROJ / 32); const int dn = 32 * nb, sn = dn < 3072 ? dn : dn + 16;
                transpose_tile((F.a->in[5]), INW, 64 * kb, sn, WSP(bf16, WS_WINT), 1024, dn, scr, f_lane, nullptr); }
            else { const int r = it - I_IN, kb = r / 32, nb = r % 32; const int k0 = 64 * kb;
                transpose_tile((F.a->in[23]), 1024, k0, 32 * nb, WSP(bf16, WS_WOUTT), 2048, 32 * nb, scr, f_lane, k0 < 1024 ? (F.a->in[11]) : (F.a->in[22]) - 1024); }
        }
    }
    for (int i = gt; i < 16 * 1024; i += NGT) { const int h = i >> 10, k = i & 1023; WSP(float, WS_WDT)[i] = (F.a->in[5])[(size_t)k * INW + 3072 + h]; }
    for (int task = gw; task < 2048; task += NGW) {
        const int nt = task >> 4, ks = task & 15, n0 = 16 * nt, hc = n0 >> 7, k0 = 64 * ks;
        const int li = f_lane & 15, lq = f_lane >> 4;
        f32x4 acc[4];
#pragma unroll
        for (int s = 0; s < 4; ++s) acc[s] = (f32x4){0.f, 0.f, 0.f, 0.f};
        const float* ap = (F.a->in[26]) + (size_t)(n0 + li) * 128 + 4 * lq;
        const float* bp = (F.a->in[25]) + (size_t)(k0 + li) * 2048 + hc * 128 + 4 * lq;
#pragma unroll
        for (int q = 0; q < 8; ++q) { const f32x4 a = *(const f32x4*)(ap + 16 * q);
#pragma unroll
            for (int s = 0; s < 4; ++s) { const f32x4 b = *(const f32x4*)(bp + (size_t)(16 * s) * 2048 + 16 * q);
#pragma unroll
                for (int jj = 0; jj < 4; ++jj) acc[s] = __builtin_amdgcn_mfma_f32_16x16x4f32(a[jj], b[jj], acc[s], 0, 0, 0); } }
        bf16* o = WSP(bf16, WS_WQKT);
#pragma unroll
        for (int s = 0; s < 4; ++s)
#pragma unroll
            for (int r = 0; r < 4; ++r) o[(size_t)(n0 + 4 * lq + r) * 1024 + k0 + 16 * s + li] = (bf16)f2bf(acc[s][r]);
    }
    for (int i = gt; i < S5G * S5P; i += NGT) {
        const float lr = (F.a->in[12])[i], li = (F.a->in[13])[i], dt = expf((F.a->in[14])[i >> 6]);
        const float mag = expf(lr * dt); float sn, cs; sincosf(li * dt, &sn, &cs);
        const float lbr = mag * cs, lbi = mag * sn, den = lr * lr + li * li;
        const float cfr = ((lbr - 1.0f) * lr + lbi * li) / den, cfi = (lbi * lr - (lbr - 1.0f) * li) / den;
        WSP(float, WS_S5LB)[2 * i] = lbr; WSP(float, WS_S5LB)[2 * i + 1] = lbi;
        for (int hh = 0; hh < 16; ++hh) { const float br = (F.a->in[15])[i * 16 + hh], bi = (F.a->in[16])[i * 16 + hh];
            WSP(float, WS_S5BB)[i * 32 + hh] = cfr * br - cfi * bi; WSP(float, WS_S5BB)[i * 32 + 16 + hh] = cfr * bi + cfi * br; }
    }
    for (int i = gt; i < MTOK; i += NGT) WSP(float, WS_ROWSTAT)[i] = 0.f;
}

__device__ __forceinline__ void p1_phase(Frame& F) {
    const int f_tid = threadIdx.x, f_lane = f_tid & 63, f_wave = __builtin_amdgcn_readfirstlane(f_tid >> 6);
    const int gw = F.vcu * NWAVES + f_wave;
    LAS float* wdt = (LAS float*)F.lds;
    for (int i = f_tid; i < 16 * 1024 / 4; i += NTHR) ((LAS f32x4*)wdt)[i] = ((const f32x4*)WSP(float, WS_WDT))[i];
    __syncthreads();
    const int lane = f_lane;
    for (int wq = gw; wq < MTOK / 16; wq += F.G * NWAVES) {
        const int b = wq >> 7; const float* mb = WSP(float, WS_MOD) + (size_t)b * 6144;
        f32x4 Gv[4], Sv[4];
#pragma unroll
        for (int j = 0; j < 4; ++j) { const int k = 4 * lane + 256 * j; const f32x4 g = *(const f32x4*)((F.a->in[4]) + k), sc = *(const f32x4*)(mb + 1024 + k); Gv[j] = g * (sc + 1.0f); Sv[j] = *(const f32x4*)(mb + k); }
        f32x4 nx[4];
#pragma unroll
        for (int j = 0; j < 4; ++j) nx[j] = *(const f32x4*)((F.a->in[0]) + (size_t)wq * 16 * 1024 + 4 * lane + 256 * j);
        for (int tt = 0; tt < 16; ++tt) {
            asm volatile("" ::: "memory");
            const size_t t = (size_t)wq * 16 + tt; const float* xr = (F.a->in[0]) + t * 1024;
            f32x4 v[4]; float ss = 0.f;
#pragma unroll
            for (int j = 0; j < 4; ++j) { v[j] = nx[j]; ss += (v[j][0] * v[j][0] + v[j][1] * v[j][1]) + (v[j][2] * v[j][2] + v[j][3] * v[j][3]); }
            if (tt < 15) {
#pragma unroll
                for (int j = 0; j < 4; ++j) nx[j] = *(const f32x4*)(xr + 1024 + 4 * lane + 256 * j); }
            const float rstd = rsqrt_f(wave_sum(ss) * (1.0f / 1024.0f) + EPSF);
            bf16* hr = WSP(bf16, WS_H1) + t * 1024;
#pragma unroll
            for (int j = 0; j < 4; ++j) { v[j] = v[j] * rstd * Gv[j] + Sv[j]; v2u w; w.x = pk2(v[j][0], v[j][1]); w.y = pk2(v[j][2], v[j][3]); *(v2u*)(hr + 4 * lane + 256 * j) = w; }
            float d[16];
#pragma unroll
            for (int h = 0; h < 16; ++h) { float a = 0.f;
#pragma unroll
                for (int j = 0; j < 4; ++j) { const f32x4 w = *(const LAS f32x4*)(wdt + h * 1024 + 4 * lane + 256 * j); a += (v[j][0] * w[0] + v[j][1] * w[1]) + (v[j][2] * w[2] + v[j][3] * w[3]); }
                d[h] = a; }
            float e8[8], e4[4], e2[2], e1;
#pragma unroll
            for (int i = 0; i < 8; ++i) { const bool up = lane & 32; const float snd = up ? d[i] : d[i + 8]; const float rcv = __shfl_xor(snd, 32); e8[i] = (up ? d[i + 8] : d[i]) + rcv; }
#pragma unroll
            for (int i = 0; i < 4; ++i) { const bool up = lane & 16; const float snd = up ? e8[i] : e8[i + 4]; const float rcv = __shfl_xor(snd, 16); e4[i] = (up ? e8[i + 4] : e8[i]) + rcv; }
#pragma unroll
            for (int i = 0; i < 2; ++i) { const bool up = lane & 8; const float snd = up ? e4[i] : e4[i + 2]; const float rcv = __shfl_xor(snd, 8); e2[i] = (up ? e4[i + 2] : e4[i]) + rcv; }
            { const bool up = lane & 4; const float snd = up ? e2[0] : e2[1]; const float rcv = __shfl_xor(snd, 4); e1 = (up ? e2[1] : e2[0]) + rcv; }
            e1 += __shfl_xor(e1, 2); e1 += __shfl_xor(e1, 1);
            const int head = ((lane >> 5) & 1) * 8 + ((lane >> 4) & 1) * 4 + ((lane >> 3) & 1) * 2 + ((lane >> 2) & 1);
            if ((lane & 3) == 0) WSP(float, WS_DTRAW)[t * 16 + head] = e1;
        }
    }
    for (int n = gw; n < 2048; n += F.G * NWAVES) {
        const bf16* wr = WSP(bf16, WS_WQKT) + (size_t)n * 1024 + 16 * lane;
        const v4u w0 = *(const v4u*)wr, w1 = *(const v4u*)(wr + 8);
        float wv[16]; wv[0] = bflo(w0.x); wv[1] = bfhi(w0.x); wv[2] = bflo(w0.y); wv[3] = bfhi(w0.y); wv[4] = bflo(w0.z); wv[5] = bfhi(w0.z); wv[6] = bflo(w0.w); wv[7] = bfhi(w0.w);
        wv[8] = bflo(w1.x); wv[9] = bfhi(w1.x); wv[10] = bflo(w1.y); wv[11] = bfhi(w1.y); wv[12] = bflo(w1.z); wv[13] = bfhi(w1.z); wv[14] = bflo(w1.w); wv[15] = bfhi(w1.w);
        for (int b = 0; b < 16; ++b) { const float* sp = WSP(float, WS_MOD) + (size_t)b * 6144 + 3072 + 16 * lane; float a = 0.f;
#pragma unroll
            for (int q = 0; q < 4; ++q) { const f32x4 s = *(const f32x4*)(sp + 4 * q); a += (s[0] * wv[4 * q] + s[1] * wv[4 * q + 1]) + (s[2] * wv[4 * q + 2] + s[3] * wv[4 * q + 3]); }
            a = wave_sum(a); if (lane == 0) WSP(float, WS_SB)[b * 2048 + n] = a; }
    }
}
__device__ __forceinline__ void p3pre_conv(Frame& F) {
    const int tid = threadIdx.x;
    const bf16* proj = WSP(bf16, WS_PROJ); bf16* xo = (bf16*)F.out;
    for (int item = F.vcu * NTHR + tid; item < (MTOK / 16) * 256; item += F.G * NTHR) {
        const int oc = item & 255, run = item >> 8; const int t0 = run * 16, ch = 8 * oc;
        const bool halo = (t0 & (SEQ - 1)) != 0;
        v4u rw[19];
#pragma unroll
        for (int k = 0; k < 19; ++k) { rw[k] = (v4u){0u, 0u, 0u, 0u}; if (k >= 3 || halo) rw[k] = *(const v4u*)(proj + (size_t)(t0 - 3 + k) * NPROJ + 1024 + ch); }
        float cw[4][8], cbv[8];
#pragma unroll
        for (int k = 0; k < 4; ++k) { const f32x4 w0 = *(const f32x4*)((F.a->in[6]) + k * 2048 + ch), w1 = *(const f32x4*)((F.a->in[6]) + k * 2048 + ch + 4);
#pragma unroll
            for (int e = 0; e < 4; ++e) { cw[k][e] = w0[e]; cw[k][4 + e] = w1[e]; } }
        { const f32x4 b0 = *(const f32x4*)((F.a->in[7]) + ch), b1 = *(const f32x4*)((F.a->in[7]) + ch + 4);
#pragma unroll
            for (int e = 0; e < 4; ++e) { cbv[e] = b0[e]; cbv[4 + e] = b1[e]; } }
        float r0[8], r1[8], r2[8];
        unpack8(rw[0], r0); unpack8(rw[1], r1); unpack8(rw[2], r2);
#pragma unroll
        for (int tt = 0; tt < 16; ++tt) {
            float r3[8]; unpack8(rw[3 + tt], r3);
            float v[8];
#pragma unroll
            for (int i = 0; i < 8; ++i) { v[i] = silu_f(cbv[i] + r0[i] * cw[0][i] + r1[i] * cw[1][i] + r2[i] * cw[2][i] + r3[i] * cw[3][i]); r0[i] = r1[i]; r1[i] = r2[i]; r2[i] = r3[i]; }
            *(v4u*)(xo + (size_t)(t0 + tt) * 2048 + ch) = (v4u){pk2(v[0], v[1]), pk2(v[2], v[3]), pk2(v[4], v[5]), pk2(v[6], v[7])};
        }
    }
}
constexpr int SSD_PITCH = 272;
__device__ __forceinline__ bf16x8 lds_frag(LAS unsigned char* base, int row, int kbyte) { return *(const LAS bf16x8*)(base + row * SSD_PITCH + kbyte); }
#ifdef PROBE_SSD
#define SPR_T(v) const unsigned long long v = __builtin_amdgcn_s_memtime();
#define SPR_ACC(i, d) sacc[i] += (d);
#else
#define SPR_T(v)
#define SPR_ACC(i, d)
#endif
constexpr int S3_CS = 0, S3_BS = 34816, S3_GY = 69632, S3_XDT = 104448, S3_XP = 144, S3_PREV = 122880, S3_CSF = 140288, S3_DTF = 141312, S3_WTS = 142336, S3_END = 143360;
static_assert(S3_END <= LDS_MAIN, "SSD v3 LDS map");
typedef short v4i16_t __attribute__((ext_vector_type(4)));
__device__ __forceinline__ bf16x8 lds_frag_tr(LAS unsigned char* tile, int pitch, int k0, int col0, int li, int lq) {
    LAS unsigned char* p = tile + (k0 + 8 * lq + (li >> 2)) * pitch + (col0 + 4 * (li & 3)) * 2;
    const v4i16_t lo = __builtin_amdgcn_ds_read_tr16_b64_v4i16((LAS v4i16_t*)p), hi = __builtin_amdgcn_ds_read_tr16_b64_v4i16((LAS v4i16_t*)(p + 4 * pitch));
    return __builtin_shufflevector(lo, hi, 0, 1, 2, 3, 4, 5, 6, 7);
}
struct Ssd3Pre { v4u xr[4], br[4], cr[4]; float d0, d1; };
__device__ __forceinline__ void ssd3_prefetch(Ssd3Pre& P, const char* xcb, const float* dtr, unsigned voB, unsigned voX, int tid, int lane, int w) {
#pragma unroll
    for (int r = 0; r < 4; ++r) { P.br[r] = *(const v4u*)(xcb + (voB + r * 4096u)); P.cr[r] = *(const v4u*)(xcb + (voB + 1024u + r * 4096u)); }
#pragma unroll
    for (int r = 0; r < 4; ++r) P.xr[r] = *(const v4u*)(xcb + (voX + r * 4096u));
    P.d0 = dtr[lane * 32]; P.d1 = dtr[lane * 32 + 16];
}
__device__ __forceinline__ void ssd3_cumsum(LAS unsigned char* L, int par, float r0, float r1, float dtb, float A, int lane) {
    LAS float* csf = (LAS float*)(L + S3_CSF + par * 512); LAS float* dtf = (LAS float*)(L + S3_DTF + par * 512); LAS float* wts = (LAS float*)(L + S3_WTS + par * 512);
    const float d0 = softplus_f(r0 + dtb), d1 = softplus_f(r1 + dtb);
    const float a0 = d0 * A, a1 = d1 * A; float s = a0 + a1;
#pragma unroll
    for (int o = 1; o < 64; o <<= 1) { const float t = __shfl_up(s, o); if (lane >= o) s += t; }
    const float tot = __shfl(s, 63);
    dtf[2 * lane] = d0; dtf[2 * lane + 1] = d1; csf[2 * lane] = s - a1; csf[2 * lane + 1] = s;
    wts[2 * lane] = __expf(tot - (s - a1)); wts[2 * lane + 1] = __expf(tot - s);
}
__device__ __forceinline__ void p3_ssd3(Frame& F) {
    const int tid0 = threadIdx.x, w = __builtin_amdgcn_readfirstlane(tid0 >> 6);
    LAS unsigned char* L = F.lds;
    const bf16* proj = WSP(bf16, WS_PROJ); const bf16* xc = (const bf16*)F.out; const float* dtraw = WSP(float, WS_DTRAW);
    for (int item = F.vcu; item < NB * NHEADS; item += F.G) {
        const int b = item >> 4, h = item & 15, g = h >> 2;
        int tid = tid0; asm volatile("" : "+v"(tid)); int lane = tid & 63;
        const float A = -__expf((F.a->in[9])[h]), Dh = (F.a->in[10])[h], dtb = (F.a->in[8])[h];
        const int pbs = w >> 1, nb0 = 4 * (w & 1);
        f32x4 st[4];
#pragma unroll
        for (int j = 0; j < 4; ++j) st[j] = (f32x4){0.f, 0.f, 0.f, 0.f};
        __syncthreads();
        for (int i = tid; i < 17408 / 16; i += NTHR) ((LAS v4u*)(L + S3_PREV))[i] = (v4u){0u, 0u, 0u, 0u};
        Ssd3Pre P;
        { const unsigned voB0 = (unsigned)((4 * (tid >> 4)) * 2048 + 1024 + g * 128 + 8 * (tid & 15)) * 2u, voX0 = (unsigned)((4 * ((tid & 255) >> 3)) * 2048 + h * 64 + 8 * (tid & 7)) * 2u;
          ssd3_prefetch(P, (const char*)xc + (size_t)b * SEQ * 4096, dtraw + (size_t)b * SEQ * 16 + h, voB0, voX0, tid, lane, w); }
        if (w == 0) ssd3_cumsum(L, 0, P.d0, P.d1, dtb, A, lane);
        __syncthreads();
#ifdef PROBE_SSD
        unsigned long long sacc[8] = {0, 0, 0, 0, 0, 0, 0, 0};
#endif
        for (int c = 0; c < SEQ / CHUNK; ++c) {
            SPR_T(s0)
            const size_t row0 = (size_t)b * SEQ + (size_t)c * CHUNK; const int par = c & 1;
            asm volatile("" : "+v"(tid));
            lane = tid & 63; const int li = lane & 15, lq = lane >> 4;
            const unsigned voB = (unsigned)((4 * (tid >> 4)) * 2048 + 1024 + g * 128 + 8 * (tid & 15)) * 2u, voX = (unsigned)((4 * ((tid & 255) >> 3)) * 2048 + h * 64 + 8 * (tid & 7)) * 2u;
            const unsigned voZ0 = (unsigned)((tid >> 3) * NPROJ + h * 64 + 8 * (tid & 7)) * 2u, voZ1 = voZ0 + 64u * NPROJ * 2u;
            LAS float* csf = (LAS float*)(L + S3_CSF + par * 512); LAS float* dtf = (LAS float*)(L + S3_DTF + par * 512); LAS float* wts = (LAS float*)(L + S3_WTS + par * 512);
            { const int ob = tid & 15, lb = 4 * (tid >> 4), n0 = 8 * ob;
#pragma unroll
              for (int r = 0; r < 4; ++r) { *(LAS v4u*)(L + S3_BS + (lb + r) * SSD_PITCH + n0 * 2) = P.br[r]; *(LAS v4u*)(L + S3_CS + (lb + r) * SSD_PITCH + n0 * 2) = P.cr[r]; } }
            if (tid < 256) { const int ox = tid & 7, lx = 4 * (tid >> 3), p0 = 8 * ox;
#pragma unroll
              for (int r = 0; r < 4; ++r) { float xv[8]; unpack8(P.xr[r], xv); const float tw = dtf[lx + r];
                  *(LAS v4u*)(L + S3_XDT + (lx + r) * S3_XP + p0 * 2) = (v4u){pk2(xv[0] * tw, xv[1] * tw), pk2(xv[2] * tw, xv[3] * tw), pk2(xv[4] * tw, xv[5] * tw), pk2(xv[6] * tw, xv[7] * tw)}; } }
            const char* prb = (const char*)proj + row0 * (NPROJ * 2);
            const v4u zc0 = *(const v4u*)(prb + voZ0), zc1 = *(const v4u*)(prb + voZ1);
            SPR_T(s1) SPR_ACC(0, s1 - s0)
            LDS_BARRIER();
            SPR_T(s2) SPR_ACC(1, s2 - s1)
            const float cs_end = csf[127];
            bf16x8 ca[4];
#pragma unroll
            for (int ks = 0; ks < 4; ++ks) ca[ks] = lds_frag(L + S3_CS, 16 * w + li, 64 * ks + 16 * lq);
            float csl[4];
#pragma unroll
            for (int r = 0; r < 4; ++r) csl[r] = csf[16 * w + 4 * lq + r];
            { bf16x8 bq[2][4];
#pragma unroll
              for (int ks = 0; ks < 4; ++ks) bq[0][ks] = lds_frag(L + S3_BS, li, 64 * ks + 16 * lq);
#pragma unroll
              for (int sb = 0; sb < 8; ++sb) if (sb <= (w | 1)) {
                  f32x4 cbv = (f32x4){0.f, 0.f, 0.f, 0.f};
                  const int s = 16 * sb + li; const float css = csf[s];
                  if (sb <= w) {
                      if (sb + 1 <= w) {
#pragma unroll
                          for (int ks = 0; ks < 4; ++ks) bq[(sb + 1) & 1][ks] = lds_frag(L + S3_BS, 16 * (sb + 1) + li, 64 * ks + 16 * lq); }
                      __builtin_amdgcn_sched_barrier(0);
#pragma unroll
                      for (int ks = 0; ks < 4; ++ks) cbv = __builtin_amdgcn_mfma_f32_16x16x32_bf16(ca[ks], bq[sb & 1][ks], cbv, 0, 0, 0);
                      __builtin_amdgcn_sched_barrier(0); }
#pragma unroll
                  for (int r = 0; r < 4; ++r) { const int l = 16 * w + 4 * lq + r; const float gv = (s <= l) ? cbv[r] * __expf(csl[r] - css) : 0.f;
                      *(LAS unsigned short*)(L + S3_GY + l * SSD_PITCH + s * 2) = (unsigned short)f2bf(gv); } } }
            LDS_WAIT(); asm volatile("" ::: "memory");
            SPR_T(s3) SPR_ACC(2, s3 - s2)
            f32x4 yd[4], yo[4];
#pragma unroll
            for (int pb = 0; pb < 4; ++pb) { yd[pb] = (f32x4){0.f, 0.f, 0.f, 0.f}; yo[pb] = (f32x4){0.f, 0.f, 0.f, 0.f}; }
            { bf16x8 gq[2], xq[2][4];
              gq[0] = lds_frag(L + S3_GY, 16 * w + li, 16 * lq);
#pragma unroll
              for (int pb = 0; pb < 4; ++pb) xq[0][pb] = lds_frag_tr(L + S3_XDT, S3_XP, 0, 16 * pb, li, lq);
#pragma unroll
              for (int ks = 0; ks < 4; ++ks) if (ks <= (w >> 1)) {
                  if (ks + 1 <= (w >> 1)) { gq[(ks + 1) & 1] = lds_frag(L + S3_GY, 16 * w + li, 64 * (ks + 1) + 16 * lq);
#pragma unroll
                      for (int pb = 0; pb < 4; ++pb) xq[(ks + 1) & 1][pb] = lds_frag_tr(L + S3_XDT, S3_XP, 32 * (ks + 1), 16 * pb, li, lq); }
                  __builtin_amdgcn_sched_barrier(0);
#pragma unroll
                  for (int pb = 0; pb < 4; ++pb) yd[pb] = __builtin_amdgcn_mfma_f32_16x16x32_bf16(gq[ks & 1], xq[ks & 1][pb], yd[pb], 0, 0, 0);
                  __builtin_amdgcn_sched_barrier(0); } }
            { bf16x8 pq[2][4];
#pragma unroll
              for (int pb = 0; pb < 4; ++pb) pq[0][pb] = lds_frag(L + S3_PREV, 16 * pb + li, 16 * lq);
#pragma unroll
              for (int ks = 0; ks < 4; ++ks) {
                  if (ks < 3) {
#pragma unroll
                      for (int pb = 0; pb < 4; ++pb) pq[(ks + 1) & 1][pb] = lds_frag(L + S3_PREV, 16 * pb + li, 64 * (ks + 1) + 16 * lq); }
                  __builtin_amdgcn_sched_barrier(0);
#pragma unroll
                  for (int pb = 0; pb < 4; ++pb) yo[pb] = __builtin_amdgcn_mfma_f32_16x16x32_bf16(ca[ks], pq[ks & 1][pb], yo[pb], 0, 0, 0);
                  __builtin_amdgcn_sched_barrier(0); } }
#pragma unroll
            for (int r = 0; r < 4; ++r) { const float e = __expf(csl[r]);
#pragma unroll
                for (int pb = 0; pb < 4; ++pb) *(LAS float*)(L + S3_GY + (16 * w + 4 * lq + r) * SSD_PITCH + (16 * pb + li) * 4) = yd[pb][r] + e * yo[pb][r]; }
            { const size_t rown = row0 + (c + 1 < SEQ / CHUNK ? CHUNK : 0);
              ssd3_prefetch(P, (const char*)xc + rown * 4096, dtraw + rown * 16 + h, voB, voX, tid, lane, w); }
            SPR_T(s4) SPR_ACC(3, s4 - s3)
            LDS_BARRIER();
            SPR_T(s5) SPR_ACC(4, s5 - s4)
            { const float dec = __expf(cs_end);
#pragma unroll
              for (int j = 0; j < 4; ++j) st[j] = st[j] * dec;
              bf16x8 xq[2], bq2[2][4]; f32x4 wq[2][2];
              xq[0] = lds_frag_tr(L + S3_XDT, S3_XP, 0, 16 * pbs, li, lq); wq[0][0] = *(const LAS f32x4*)(wts + 8 * lq); wq[0][1] = *(const LAS f32x4*)(wts + 8 * lq + 4);
#pragma unroll
              for (int j = 0; j < 4; ++j) bq2[0][j] = lds_frag_tr(L + S3_BS, SSD_PITCH, 0, 16 * (nb0 + j), li, lq);
#pragma unroll
              for (int ks = 0; ks < 4; ++ks) {
                  if (ks < 3) { xq[(ks + 1) & 1] = lds_frag_tr(L + S3_XDT, S3_XP, 32 * (ks + 1), 16 * pbs, li, lq); wq[(ks + 1) & 1][0] = *(const LAS f32x4*)(wts + 32 * (ks + 1) + 8 * lq); wq[(ks + 1) & 1][1] = *(const LAS f32x4*)(wts + 32 * (ks + 1) + 8 * lq + 4);
#pragma unroll
                      for (int j = 0; j < 4; ++j) bq2[(ks + 1) & 1][j] = lds_frag_tr(L + S3_BS, SSD_PITCH, 32 * (ks + 1), 16 * (nb0 + j), li, lq); }
                  __builtin_amdgcn_sched_barrier(0);
                  const f32x4 w0 = wq[ks & 1][0], w1 = wq[ks & 1][1];
                  float xv[8]; unpack8(__builtin_bit_cast(v4u, xq[ks & 1]), xv);
                  const v4u xw = (v4u){pk2(xv[0] * w0[0], xv[1] * w0[1]), pk2(xv[2] * w0[2], xv[3] * w0[3]), pk2(xv[4] * w1[0], xv[5] * w1[1]), pk2(xv[6] * w1[2], xv[7] * w1[3])};
                  const bf16x8 xf = __builtin_bit_cast(bf16x8, xw);
#pragma unroll
                  for (int j = 0; j < 4; ++j) st[j] = __builtin_amdgcn_mfma_f32_16x16x32_bf16(xf, bq2[ks & 1][j], st[j], 0, 0, 0);
                  __builtin_amdgcn_sched_barrier(0); }
#pragma unroll
              for (int j = 0; j < 4; ++j)
#pragma unroll
                  for (int r = 0; r < 4; ++r) *(LAS unsigned short*)(L + S3_PREV + (16 * pbs + 4 * lq + r) * SSD_PITCH + (16 * (nb0 + j) + li) * 2) = (unsigned short)f2bf(st[j][r]); }
            SPR_T(s6) SPR_ACC(5, s6 - s5)
#pragma unroll
            for (int k = 0; k < 2; ++k) { const int it = tid + 512 * k, l = it >> 3, o = it & 7; const size_t row = row0 + l;
                const f32x4 y0 = *(const LAS f32x4*)(L + S3_GY + l * SSD_PITCH + 32 * o), y1 = *(const LAS f32x4*)(L + S3_GY + l * SSD_PITCH + 32 * o + 16);
                const v4u xw = *(const LAS v4u*)(L + S3_XDT + l * S3_XP + 16 * o); const v4u zw = k == 0 ? zc0 : zc1; const float dsk = Dh * __builtin_amdgcn_rcpf(dtf[l]);
                float xv[8], zv[8], yv[8]; unpack8(xw, xv); unpack8(zw, zv);
                float ss = 0.f;
#pragma unroll
                for (int e = 0; e < 8; ++e) { const float yy = (e < 4 ? y0[e] : y1[e - 4]) + dsk * xv[e]; yv[e] = yy * silu_f(zv[e]); ss += yv[e] * yv[e]; }
                ss += __shfl_xor(ss, 1); ss += __shfl_xor(ss, 2); ss += __shfl_xor(ss, 4);
                if (o == 0) WSP(float, WS_STSSD)[row * 16 + h] = ss;
                *(v4u*)(WSP(bf16, WS_Y) + row * 2048 + h * 64 + 8 * o) = (v4u){pk2(yv[0], yv[1]), pk2(yv[2], yv[3]), pk2(yv[4], yv[5]), pk2(yv[6], yv[7])}; }
            if (w == 0 && c + 1 < SEQ / CHUNK) ssd3_cumsum(L, par ^ 1, P.d0, P.d1, dtb, A, lane);
            SPR_T(s7) SPR_ACC(6, s7 - s6)
            LDS_BARRIER();
            SPR_T(s8) SPR_ACC(7, s8 - s7)
        }
#ifdef PROBE_SSD
        if (blockIdx.x == 0 && threadIdx.x == PROBE_TID) *(volatile float*)(F.ws + WS_CTL + 40000) = (float)sacc[PROBE_SSD] * 1e-3f;
#endif
    }
}
typedef float f32x16 __attribute__((ext_vector_type(16)));
#ifdef PROBE_SEL
#define PR_T(v) const unsigned long long v = __builtin_amdgcn_s_memtime();
#define PR_ACC(a, d) a += (d);
#define PR_OUT(i, a) if (PROBE_SEL == (i) && blockIdx.x == 0 && threadIdx.x == 0) *(volatile float*)(F.ws + WS_CTL + 40000) = (float)(a) * 1e-4f;
#define PR_OUT4(i, a) if (PROBE_SEL == (i) && blockIdx.x == 0 && threadIdx.x == 256) *(volatile float*)(F.ws + WS_CTL + 40000) = (float)(a) * 1e-4f;
#else
#define PR_T(v)
#define PR_ACC(a, d)
#define PR_OUT(i, a)
#define PR_OUT4(i, a)
#endif
constexpr int S5V_BU = 0, S5V_BUP = 2056, S5V_BUSZ = 16 * S5V_BUP, S5V_XT = 2 * S5V_BUSZ, S5V_XTP = 1040, S5V_XTSZ = 16 * S5V_XTP, S5V_VS = S5V_XT + 2 * S5V_XTSZ, S5V_OT = S5V_VS + 4 * 512, S5V_OTP = 144, S5V_OTSZ = 16 * S5V_OTP, S5V_END = S5V_OT + 2 * S5V_OTSZ;
static_assert(S5V_END <= LDS_MAIN, "S5 v2 LDS map");
__device__ __forceinline__ void p3_s5v2(Frame& F) {
    const int tid = threadIdx.x, lane = tid & 63, w = __builtin_amdgcn_readfirstlane(tid >> 6);
    const int li = lane & 15, lq = lane >> 4;
    LAS unsigned char* L = F.lds;
    const bf16* proj = WSP(bf16, WS_PROJ);
    constexpr int NT = SEQ / 16;
#ifdef PROBE_S5
    const unsigned long long pr_t0 = PROBE_CLOCK();
#endif
    for (int item = F.vcu; item < NB * 16; item += F.G) {
        const int b = item >> 4, gs = item & 15;
        const bool scanw = w < 4; const int gl = w & 3, g = gs * 4 + gl;
        const bf16* ubase = proj + (size_t)b * SEQ * NPROJ + 3072 + gs * 64 + gl * 16;
        __syncthreads();
        if (scanw) {
            __builtin_amdgcn_s_setprio(2);
            const float lbr = WSP(float, WS_S5LB)[(g * 64 + lane) * 2], lbi = WSP(float, WS_S5LB)[(g * 64 + lane) * 2 + 1], nlbi = -lbi;
            bf16x8 bfr[8];
#pragma unroll
            for (int cb = 0; cb < 8; ++cb) { v4u v = (v4u){0u, 0u, 0u, 0u};
                if (lq < 2) { const int col = 16 * cb + li; const float* src = WSP(float, WS_S5BB) + (g * 64 + (col >> 1)) * 32 + (col & 1) * 16 + 8 * lq; const f32x4 a0 = *(const f32x4*)src, a1 = *(const f32x4*)(src + 4);
                    v = (v4u){pk2(a0[0], a0[1]), pk2(a0[2], a0[3]), pk2(a1[0], a1[1]), pk2(a1[2], a1[3])}; }
                bfr[cb] = __builtin_bit_cast(bf16x8, v); }
            float xr = 0.f, xi = 0.f;
            const int lq2 = lq & 1;
            v4u ua = *(const v4u*)(ubase + (size_t)li * NPROJ + 8 * lq2);
            { const bf16x8 af = __builtin_bit_cast(bf16x8, lq < 2 ? ua : (v4u){0u, 0u, 0u, 0u});
              ua = *(const v4u*)(ubase + (size_t)(16 + li) * NPROJ + 8 * lq2);
#pragma unroll
              for (int cb = 0; cb < 8; ++cb) { f32x4 acc = (f32x4){0.f, 0.f, 0.f, 0.f}; acc = __builtin_amdgcn_mfma_f32_16x16x32_bf16(af, bfr[cb], acc, 0, 0, 0);
#pragma unroll
                  for (int r = 0; r < 4; ++r) *(LAS float*)(L + S5V_BU + (4 * lq + r) * S5V_BUP + (gl * 128 + 16 * cb + li) * 4) = acc[r]; } }
            LDS_BARRIER();
            unsigned long long pa0 = 0, pa1 = 0, pa2 = 0;
            for (int k = 0; k <= NT; ++k) {
                PR_T(pt0)
                if (k < NT) {
                    const LAS f32x2* bp = (const LAS f32x2*)(L + S5V_BU + (k & 1) * S5V_BUSZ + (gl * 128 + 2 * lane) * 4);
                    LAS unsigned* xp = (LAS unsigned*)(L + S5V_XT + (k & 1) * S5V_XTSZ + (gl * 128 + 2 * lane) * 2);
                    f32x2 bu[16];
#pragma unroll
                    for (int t = 0; t < 16; ++t) bu[t] = bp[t * (S5V_BUP / 8)];
                    unsigned xo[16];
#pragma unroll
                    for (int t = 0; t < 16; ++t) {
                        const float a = __builtin_fmaf(nlbi, xi, bu[t][0]), bq = __builtin_fmaf(lbi, xr, bu[t][1]);
                        const float nr = __builtin_fmaf(lbr, xr, a), ni = __builtin_fmaf(lbr, xi, bq); xr = nr; xi = ni; xo[t] = pk2(xr, xi); }
#pragma unroll
                    for (int t = 0; t < 16; ++t) xp[t * (S5V_XTP / 4)] = xo[t];
                    PR_T(pt1) PR_ACC(pa0, pt1 - pt0)
                    if (k + 1 < NT) {
                        const bf16x8 af = __builtin_bit_cast(bf16x8, lq < 2 ? ua : (v4u){0u, 0u, 0u, 0u});
                        { const int kn = k + 2 < NT ? k + 2 : NT - 1; ua = *(const v4u*)(ubase + (size_t)(16 * kn + li) * NPROJ + 8 * lq2); }
                        LAS unsigned char* bun = L + S5V_BU + ((k + 1) & 1) * S5V_BUSZ;
#pragma unroll
                        for (int cb = 0; cb < 8; ++cb) { f32x4 acc = (f32x4){0.f, 0.f, 0.f, 0.f}; acc = __builtin_amdgcn_mfma_f32_16x16x32_bf16(af, bfr[cb], acc, 0, 0, 0);
#pragma unroll
                            for (int r = 0; r < 4; ++r) *(LAS float*)(bun + (4 * lq + r) * S5V_BUP + (gl * 128 + 16 * cb + li) * 4) = acc[r]; }
                    }
                }
                PR_T(pt2) PR_ACC(pa1, pt2 - pt0)
                LDS_BARRIER();
                PR_T(pt3) PR_ACC(pa2, pt3 - pt2)
            }
            __builtin_amdgcn_s_setprio(0);
            PR_OUT(0, pa0) PR_OUT(1, pa1) PR_OUT(2, pa2)
        } else {
            bf16x8 cfr[4];
#pragma unroll
            for (int ks = 0; ks < 4; ++ks) { const float* cr = (F.a->in[17]) + (g * 16 + li) * 64 + 16 * ks + 4 * lq; const float* ci = (F.a->in[18]) + (g * 16 + li) * 64 + 16 * ks + 4 * lq;
                const f32x4 r0 = *(const f32x4*)cr, i0 = *(const f32x4*)ci;
                cfr[ks] = __builtin_bit_cast(bf16x8, ((v4u){pk2(r0[0], -i0[0]), pk2(r0[1], -i0[1]), pk2(r0[2], -i0[2]), pk2(r0[3], -i0[3])})); }
            v4u gwv = (v4u){0u, 0u, 0u, 0u};
            if (lq < 2) { float gwf[8];
#pragma unroll
                for (int j = 0; j < 8; ++j) gwf[j] = (F.a->in[20])[(g * 16 + 8 * lq + j) * 16 + li];
                gwv = (v4u){pk2(gwf[0], gwf[1]), pk2(gwf[2], gwf[3]), pk2(gwf[4], gwf[5]), pk2(gwf[6], gwf[7])}; }
            const bf16x8 gfr = __builtin_bit_cast(bf16x8, gwv);
            const float dsk = (F.a->in[19])[g * 16 + li], gbias = (F.a->in[21])[g * 16 + li];
            LAS unsigned char* vs = L + S5V_VS + gl * 512;
            float uo[4], un[4];
#pragma unroll
            for (int r = 0; r < 4; ++r) { uo[r] = bf2f(ubase[(size_t)(4 * lq + r) * NPROJ + li]); un[r] = bf2f(ubase[(size_t)(16 + 4 * lq + r) * NPROJ + li]); }
            LDS_BARRIER();
            unsigned long long pb0 = 0, pb1 = 0;
            for (int k = 0; k <= NT; ++k) {
                PR_T(qt0)
                float u2[4];
                { const int kn = k + 1 < NT ? k + 1 : NT - 1;
#pragma unroll
                  for (int r = 0; r < 4; ++r) u2[r] = bf2f(ubase[(size_t)(16 * kn + 4 * lq + r) * NPROJ + li]); }
                if (k >= 2) {
                    const int t = ((tid - 256) >> 3) & 15, oc = tid & 7; const v4u ov = *(const LAS v4u*)(L + S5V_OT + (k & 1) * S5V_OTSZ + t * S5V_OTP + 16 * oc);
                    if (tid < 384) *(v4u*)(WSP(bf16, WS_Y) + ((size_t)b * SEQ + 16 * (k - 2) + t) * 2048 + 1024 + gs * 64 + 8 * oc) = ov; }
                if (k >= 1) {
                    const int kt = k - 1; const LAS unsigned char* xt = L + S5V_XT + (kt & 1) * S5V_XTSZ;
                    f32x4 yacc = (f32x4){0.f, 0.f, 0.f, 0.f};
#pragma unroll
                    for (int ks = 0; ks < 4; ++ks) yacc = __builtin_amdgcn_mfma_f32_16x16x32_bf16(*(const LAS bf16x8*)(xt + li * S5V_XTP + (gl * 128 + 32 * ks + 8 * lq) * 2), cfr[ks], yacc, 0, 0, 0);
                    float v[4];
                    { const f32x2 g0 = gelu_pk2((f32x2){yacc[0] + dsk * uo[0], yacc[1] + dsk * uo[1]}), g1 = gelu_pk2((f32x2){yacc[2] + dsk * uo[2], yacc[3] + dsk * uo[3]}); v[0] = g0[0]; v[1] = g0[1]; v[2] = g1[0]; v[3] = g1[1]; }
#pragma unroll
                    for (int r = 0; r < 4; ++r) *(LAS unsigned short*)(vs + (4 * lq + r) * 32 + li * 2) = (unsigned short)f2bf(v[r]);
                    LDS_WAIT(); asm volatile("" ::: "memory");
                    v4u va = (v4u){0u, 0u, 0u, 0u};
                    if (lq < 2) va = *(const LAS v4u*)(vs + li * 32 + 16 * lq);
                    f32x4 gacc = (f32x4){0.f, 0.f, 0.f, 0.f};
                    gacc = __builtin_amdgcn_mfma_f32_16x16x32_bf16(__builtin_bit_cast(bf16x8, va), gfr, gacc, 0, 0, 0);
                    float o[4], ss[4];
#pragma unroll
                    for (int r = 0; r < 4; ++r) { o[r] = v[r] * sigmoid_f(gacc[r] + gbias); ss[r] = o[r] * o[r]; }
#pragma unroll
                    for (int r = 0; r < 4; ++r) ss[r] = row16_sum_to15(ss[r]);
                    if (li == 15) {
#pragma unroll
                        for (int r = 0; r < 4; ++r) WSP(float, WS_STS5)[((size_t)b * SEQ + 16 * kt + 4 * lq + r) * NS5PART + g] = ss[r]; }
                    LAS unsigned char* ot = L + S5V_OT + (kt & 1) * S5V_OTSZ;
#pragma unroll
                    for (int r = 0; r < 4; ++r) *(LAS unsigned short*)(ot + (4 * lq + r) * S5V_OTP + (gl * 16 + li) * 2) = (unsigned short)f2bf(o[r]);
#pragma unroll
                    for (int r = 0; r < 4; ++r) { uo[r] = un[r]; un[r] = u2[r]; }
                }
                PR_T(qt1) PR_ACC(pb0, qt1 - qt0)
                LDS_BARRIER();
                PR_T(qt2) PR_ACC(pb1, qt2 - qt1)
            }
            PR_OUT4(3, pb0) PR_OUT4(4, pb1)
            { const int t = ((tid - 256) >> 3) & 15, oc = tid & 7; const v4u ov = *(const LAS v4u*)(L + S5V_OT + ((NT - 1) & 1) * S5V_OTSZ + t * S5V_OTP + 16 * oc);
              if (tid < 384) *(v4u*)(WSP(bf16, WS_Y) + ((size_t)b * SEQ + 16 * (NT - 1) + t) * 2048 + 1024 + gs * 64 + 8 * oc) = ov; }
        }
    }
#ifdef PROBE_S5
    if (blockIdx.x == 0 && threadIdx.x == 0) *(volatile float*)(F.ws + WS_CTL + 40000) = (float)(PROBE_CLOCK() - pr_t0) * PROBE_SCALE;
#endif
}
__device__ __forceinline__ unsigned med3u(unsigned a, unsigned b, unsigned c) { unsigned r; asm("v_med3_u32 %0, %1, %2, %3" : "=v"(r) : "v"(a), "v"(b), "v"(c)); return r; }
__device__ __forceinline__ unsigned fkey(float v) { const unsigned u = __builtin_bit_cast(unsigned, v); return (u & 0x80000000u) ? ~u : (u | 0x80000000u); }
__device__ __forceinline__ float fkey_inv(unsigned k) { const unsigned u = (k & 0x80000000u) ? (k & 0x7fffffffu) : ~k; return __builtin_bit_cast(float, u); }
#define TOPK_INSERT(a, x) do { _Pragma("unroll") for (int _i = 15; _i >= 1; --_i) a[_i] = med3u(a[_i - 1], a[_i], (x)); a[0] = a[0] > (x) ? a[0] : (x); } while (0)
__device__ __forceinline__ void expert_convert(Frame& F, int w0, int nw, int f_lane) {
    for (int rw = w0; rw < 2 * 16384; rw += 2 * nw) {
        f32x4 v[2][4]; float mx[2];
#pragma unroll
        for (int u = 0; u < 2; ++u) { const int r = rw + u * nw; const int tb = r >= 16384, e = tb ? r - 16384 : r; const float* src = (tb ? (F.a->in[28]) : (F.a->in[27])) + (size_t)e * 1024 + 16 * f_lane;
#pragma unroll
            for (int q = 0; q < 4; ++q) v[u][q] = *(const f32x4*)(src + 4 * q); }
#pragma unroll
        for (int u = 0; u < 2; ++u) { float m = 0.f;
#pragma unroll
            for (int q = 0; q < 4; ++q) m = fmaxf(m, fmaxf(fmaxf(fabsf(v[u][q][0]), fabsf(v[u][q][1])), fmaxf(fabsf(v[u][q][2]), fabsf(v[u][q][3]))));
#pragma unroll
            for (int o = 1; o < 64; o <<= 1) m = fmaxf(m, __shfl_xor(m, o));
            mx[u] = fmaxf(m, 1e-30f); }
#pragma unroll
        for (int u = 0; u < 2; ++u) { const int r = rw + u * nw; const int tb = r >= 16384, e = tb ? r - 16384 : r; const float sc = 224.0f / mx[u];
            v4u w;
#pragma unroll
            for (int q = 0; q < 4; ++q) { int pk = 0; pk = __builtin_amdgcn_cvt_pk_fp8_f32(v[u][q][0] * sc, v[u][q][1] * sc, pk, false); pk = __builtin_amdgcn_cvt_pk_fp8_f32(v[u][q][2] * sc, v[u][q][3] * sc, pk, true); w[q] = (unsigned)pk; }
            *(v4u*)(F.ws + (tb ? WS_EV : WS_EU) + (size_t)e * 1024 + 16 * f_lane) = w;
            if (f_lane == 0) WSP(float, tb ? WS_EVS : WS_EUS)[e] = mx[u] * (1.0f / 224.0f); }
    }
}
__device__ __forceinline__ void p5b_topk(Frame& F) {
    const int f_tid = threadIdx.x, f_lane = f_tid & 63, f_wave = __builtin_amdgcn_readfirstlane(f_tid >> 6);
    const _Float16* scores = WSP(_Float16, WS_SCORES);
    LAS unsigned char* ix = (LAS unsigned char*)F.lds + f_tid * 36;
#pragma unroll 1
    for (int half = 0; half < 2; ++half) {
    if ((f_wave >> 2) != half) { expert_convert(F, (F.vcu * 4 + (f_wave & 3)) * 2 + half, F.G * 8, f_lane); continue; }
    for (int item = (F.vcu * 2 + half) * 256 + (f_tid & 255); item < MTOK * PH; item += F.G * 512) {
        const int t = item >> 3, hd = item & 7;
        unsigned a1[16], a2[16];
#pragma unroll
        for (int i = 0; i < 16; ++i) { a1[i] = 0u; a2[i] = 0u; }
        const _Float16* sp = scores + (size_t)t * 2048 + hd * 256;
        typedef _Float16 f16x8 __attribute__((ext_vector_type(8)));
#pragma unroll 1
        for (int m = 0; m < 2; ++m) { f16x8 sv[8];
#pragma unroll
            for (int q = 0; q < 8; ++q) sv[q] = *(const f16x8*)(sp + 64 * m + 8 * q);
#pragma unroll
            for (int q = 0; q < 8; ++q)
#pragma unroll
                for (int e = 0; e < 8; ++e) { const unsigned k = (fkey((float)sv[q][e]) & ~127u) | (unsigned)(127 - (64 * m + 8 * q + e)); TOPK_INSERT(a1, k); } }
#pragma unroll 1
        for (int m = 0; m < 2; ++m) { f16x8 sv[8];
#pragma unroll
            for (int q = 0; q < 8; ++q) sv[q] = *(const f16x8*)(sp + 128 + 64 * m + 8 * q);
#pragma unroll
            for (int q = 0; q < 8; ++q)
#pragma unroll
                for (int e = 0; e < 8; ++e) { const unsigned k = (fkey((float)sv[q][e]) & ~127u) | (unsigned)(127 - (64 * m + 8 * q + e)); TOPK_INSERT(a2, k); } }
        float v1[16], v2[16];
#pragma unroll
        for (int i = 0; i < 16; ++i) { ix[i] = (unsigned char)(127u - (a1[i] & 127u)); ix[16 + i] = (unsigned char)(127u - (a2[i] & 127u)); v1[i] = fkey_inv(a1[i] & ~127u); v2[i] = fkey_inv(a2[i] & ~127u); }
        unsigned cb[16];
#pragma unroll
        for (int i = 0; i < 16; ++i) cb[i] = 0u;
#pragma unroll
        for (int i = 0; i < 16; ++i)
#pragma unroll
            for (int j = 0; j < 16; ++j) if ((i + 1) * (j + 1) <= 16) { const unsigned k = (fkey(v1[i] + v2[j]) & ~255u) | (unsigned)(255 - (i * 16 + j)); TOPK_INSERT(cb, k); }
        float tv[16]; float mx = -3.0e38f;
#pragma unroll
        for (int k = 0; k < 16; ++k) { tv[k] = fkey_inv(cb[k] & ~255u); mx = fmaxf(mx, tv[k]); }
        float sum = 0.f;
#pragma unroll
        for (int k = 0; k < 16; ++k) { tv[k] = __expf(tv[k] - mx); sum += tv[k]; }
        const float inv = 1.0f / sum;
        LDS_WAIT(); asm volatile("" ::: "memory");
        int ev[16]; unsigned long long c64 = 0ull;
#pragma unroll
        for (int k = 0; k < 16; ++k) { const unsigned code = 255u - (cb[k] & 255u); const int i = code >> 4, j = code & 15; ev[k] = (int)ix[i] * 128 + (int)ix[16 + j]; c64 += 1ull << (8 * (ev[k] >> 11)); }
        unsigned long long s64 = c64;
#pragma unroll
        for (int o = 1; o < 8; o <<= 1) { const unsigned lo = __shfl_up((unsigned)s64, o, 8), hi = __shfl_up((unsigned)(s64 >> 32), o, 8); if ((f_lane & 7) >= o) s64 += ((unsigned long long)hi << 32) | lo; }
        const unsigned long long e64 = s64 - c64;
        const unsigned long long t64 = ((unsigned long long)__shfl((unsigned)(s64 >> 32), 7, 8) << 32) | __shfl((unsigned)s64, 7, 8);
        const unsigned long long st64 = (t64 * 0x0101010101010101ull) << 8;
        unsigned long long base64 = st64 + e64;
        int* eo = WSP(int, WS_EID) + (size_t)t * 128; float* go = WSP(float, WS_GATE) + (size_t)t * 128;
#pragma unroll
        for (int k = 0; k < 16; ++k) { const int r8 = 8 * (ev[k] >> 11); const int slot = (int)((base64 >> r8) & 255ull); base64 += 1ull << r8; eo[slot] = ev[k]; go[slot] = tv[k] * inv; }
        if (hd == 0) WSP(unsigned long long, WS_START)[t] = st64;
        LDS_WAIT(); asm volatile("" ::: "memory");
    }
    }
}
__device__ __forceinline__ void dec16(const v4u q, float* f) {
#pragma unroll
    for (int i = 0; i < 4; ++i) { const f32x2 lo = __builtin_amdgcn_cvt_pk_f32_fp8((int)q[i], false), hi = __builtin_amdgcn_cvt_pk_f32_fp8((int)q[i], true); f[4 * i] = lo[0]; f[4 * i + 1] = lo[1]; f[4 * i + 2] = hi[0]; f[4 * i + 3] = hi[1]; }
}
__device__ __forceinline__ void p9_peer_down2(Frame& F) {
    const int f_tid = threadIdx.x, lane = f_tid & 63, f_wave = __builtin_amdgcn_readfirstlane(f_tid >> 6);
    const unsigned char* EV = F.ws + WS_EV;
    for (int wq = F.vcu * NWAVES + f_wave; wq < MTOK / 16; wq += F.G * NWAVES) {
        const int b = wq >> 7; const float* mb = WSP(float, WS_MOD) + (size_t)b * 6144;
        int ne_lo = WSP(int, WS_EID)[(size_t)wq * 16 * 128 + lane], ne_hi = WSP(int, WS_EID)[(size_t)wq * 16 * 128 + 64 + lane];
        float nw_lo = WSP(float, WS_GATE)[(size_t)wq * 16 * 128 + lane], nw_hi = WSP(float, WS_GATE)[(size_t)wq * 16 * 128 + 64 + lane];
        for (int tt = 0; tt < 16; ++tt) {
            const size_t t = (size_t)wq * 16 + tt;
            unsigned l16 = 16u * (unsigned)lane; asm volatile("" : "+v"(l16));
            float* xr = (float*)((char*)(F.out + t * 1024) + 4u * l16);
            const int e_lo = ne_lo, e_hi = ne_hi; const float w_lo = nw_lo, w_hi = nw_hi;
            f32x2 o[8];
#pragma unroll
            for (int i = 0; i < 8; ++i) o[i] = (f32x2){0.f, 0.f};
            v4u qa[8], qb[8];
#pragma unroll
            for (int j = 0; j < 8; ++j) { const int e = __builtin_amdgcn_readlane(e_lo, j); qa[j] = *(const v4u*)(EV + ((unsigned)e * 1024u + l16)); }
#define DN2_STEP(GRP, CUR, NXT) { \
                const int grp = (GRP); const int nb = ((grp + 1) & 7) * 8; const int ensel = (grp + 1) < 8 ? e_lo : e_hi; \
                { _Pragma("unroll") for (int j = 0; j < 8; ++j) { const int e = __builtin_amdgcn_readlane(ensel, nb + j); NXT[j] = *(const v4u*)(EV + ((unsigned)e * 1024u + l16)); } } \
                __builtin_amdgcn_sched_barrier(0); \
                const int base = (grp & 7) * 8; const float wsel = grp < 8 ? w_lo : w_hi; \
                _Pragma("unroll") for (int j = 0; j < 8; ++j) { const float wj = __builtin_bit_cast(float, __builtin_amdgcn_readlane(__builtin_bit_cast(int, wsel), base + j)); const f32x2 w2 = (f32x2){wj, wj}; \
                    _Pragma("unroll") for (int i = 0; i < 4; ++i) { const f32x2 lo = __builtin_amdgcn_cvt_pk_f32_fp8((int)CUR[j][i], false), hi = __builtin_amdgcn_cvt_pk_f32_fp8((int)CUR[j][i], true); o[2 * i] += w2 * lo; o[2 * i + 1] += w2 * hi; } } }
#pragma unroll 1
            for (int g2 = 0; g2 < 16; g2 += 2) { DN2_STEP(g2, qa, qb) DN2_STEP(g2 + 1, qb, qa) }
#undef DN2_STEP
            { const size_t tn = t + (tt < 15 ? 1 : 0); ne_lo = WSP(int, WS_EID)[tn * 128 + lane]; ne_hi = WSP(int, WS_EID)[tn * 128 + 64 + lane]; nw_lo = WSP(float, WS_GATE)[tn * 128 + lane]; nw_hi = WSP(float, WS_GATE)[tn * 128 + 64 + lane]; }
            float x1[16]; float ss = 0.f;
#pragma unroll
            for (int q4 = 0; q4 < 4; ++q4) { const f32x4 v = *(const f32x4*)(xr + 4 * q4); x1[4 * q4] = v[0]; x1[4 * q4 + 1] = v[1]; x1[4 * q4 + 2] = v[2]; x1[4 * q4 + 3] = v[3]; }
#pragma unroll
            for (int q4 = 0; q4 < 4; ++q4) { const f32x4 gt = *(const f32x4*)((const char*)(mb + 5120) + 4u * l16 + 16 * q4);
#pragma unroll
                for (int e = 0; e < 4; ++e) { const int i = 4 * q4 + e; x1[i] += gt[e] * o[i >> 1][i & 1]; ss += x1[i] * x1[i]; } }
            const float rf = rsqrt_f(wave_sum(ss) * (1.0f / 1024.0f) + EPSF);
#pragma unroll
            for (int q4 = 0; q4 < 4; ++q4) { const f32x4 nf = *(const f32x4*)((const char*)(F.a->in[29]) + 4u * l16 + 16 * q4); f32x4 v;
#pragma unroll
                for (int e = 0; e < 4; ++e) v[e] = x1[4 * q4 + e] * rf * nf[e];
                *(f32x4*)(xr + 4 * q4) = v; }
        }
    }
}
typedef long i64_t;
constexpr int U6_ROWP = 1040, U6_BUF = 8 * U6_ROWP, U6_WAVE = 2 * U6_BUF + 1024;
static_assert(8 * U6_WAVE <= LDS_MAIN, "U6 LDS map");
__device__ __forceinline__ void p8_peer_up6(Frame& F) {
    const int f_tid = threadIdx.x, lane = f_tid & 63, f_wave = __builtin_amdgcn_readfirstlane(f_tid >> 6);
    const int li = lane & 15, lq = lane >> 4;
    const unsigned char* EU = F.ws + WS_EU; const float* EUS = WSP(float, WS_EUS); const float* EVS = WSP(float, WS_EVS);
    LAS unsigned char* ring = F.lds + f_wave * U6_WAVE; LAS unsigned char* hq = ring + 2 * U6_BUF;
    for (int wq = F.vcu * NWAVES + f_wave; wq < MTOK / 16; wq += F.G * NWAVES) {
        const int b = wq >> 7; const float* mb = WSP(float, WS_MOD) + (size_t)b * 6144;
        for (int tt = 0; tt < 16; ++tt) {
            const size_t t = (size_t)wq * 16 + tt;
            unsigned l16 = 16u * (unsigned)lane; asm volatile("" : "+v"(l16));
            const int e_lo = WSP(int, WS_EID)[t * 128 + lane], e_hi = WSP(int, WS_EID)[t * 128 + 64 + lane];
            const float g_lo = WSP(float, WS_GATE)[t * 128 + lane], g_hi = WSP(float, WS_GATE)[t * 128 + 64 + lane];
            const float rs = rsqrt_f(WSP(float, WS_ROWSTAT)[t] * (1.0f / 1024.0f) + EPSF);
            const char* xs = (const char*)(WSP(bf16, WS_X1S) + t * 1024) + 2u * l16; const v4u xa = *(const v4u*)xs, xb = *(const v4u*)(xs + 16);
            asm volatile("s_waitcnt vmcnt(0)" ::: "memory");
#pragma unroll
            for (int j = 0; j < 8; ++j) { const int e = __builtin_amdgcn_readlane(e_lo, j);
                __builtin_amdgcn_global_load_lds((const unsigned*)(EU + ((unsigned)e * 1024u + l16)), (LAS unsigned*)(ring + j * U6_ROWP), 16, 0, 0); }
            const float su_lo = EUS[e_lo], su_hi = EUS[e_hi], sv_lo = EVS[e_lo], sv_hi = EVS[e_hi];
            float h2[16]; unpack8(xa, h2); unpack8(xb, h2 + 8); float mx = 0.f;
#pragma unroll
            for (int qd = 0; qd < 4; ++qd) { const f32x4 sh = *(const f32x4*)((const char*)(mb + 3072) + 4u * l16 + 16 * qd);
#pragma unroll
                for (int e = 0; e < 4; ++e) { h2[4 * qd + e] = h2[4 * qd + e] * rs + sh[e]; mx = fmaxf(mx, fabsf(h2[4 * qd + e])); } }
#pragma unroll
            for (int o = 1; o < 64; o <<= 1) mx = fmaxf(mx, __shfl_xor(mx, o));
            mx = fmaxf(mx, 1e-30f); const float hs = 224.0f / mx, hinv = mx * (1.0f / 224.0f);
            { v4u w;
#pragma unroll
              for (int qd = 0; qd < 4; ++qd) { int pk = 0; pk = __builtin_amdgcn_cvt_pk_fp8_f32(h2[4 * qd] * hs, h2[4 * qd + 1] * hs, pk, false); pk = __builtin_amdgcn_cvt_pk_fp8_f32(h2[4 * qd + 2] * hs, h2[4 * qd + 3] * hs, pk, true); w[qd] = (unsigned)pk; }
              *(LAS v4u*)(hq + l16) = w; }
            LDS_WAIT(); asm volatile("" ::: "memory");
            v4u hb[16];
#pragma unroll
            for (int c = 0; c < 16; ++c) hb[c] = *(const LAS v4u*)(hq + 64 * c + 16 * lq);
            asm volatile("s_waitcnt vmcnt(0)" ::: "memory");
            float w_lo = 0.f, w_hi = 0.f;
#pragma unroll 1
            for (int u = 0; u < 16; ++u) {
                { const int un = (u + 1) & 15; const int ensel = un < 8 ? e_lo : e_hi; const int nb = (un & 7) * 8; LAS unsigned char* dst = ring + ((u + 1) & 1) * U6_BUF;
#pragma unroll
                  for (int j = 0; j < 8; ++j) { const int e = __builtin_amdgcn_readlane(ensel, nb + j);
                      __builtin_amdgcn_global_load_lds((const unsigned*)(EU + ((unsigned)e * 1024u + l16)), (LAS unsigned*)(dst + j * U6_ROWP), 16, 0, 0); } }
                asm volatile("s_waitcnt vmcnt(8)" ::: "memory");
                const LAS unsigned char* src = ring + (u & 1) * U6_BUF + (li & 7) * U6_ROWP + 16 * lq;
                f32x4 acc = (f32x4){0.f, 0.f, 0.f, 0.f};
#pragma unroll
                for (int c = 0; c < 16; ++c) { const v4u a = *(const LAS v4u*)(src + 64 * c);
                    acc = __builtin_amdgcn_mfma_f32_16x16x32_fp8_fp8((i64_t)(((unsigned long long)a[1] << 32) | a[0]), (i64_t)(((unsigned long long)hb[c][1] << 32) | hb[c][0]), acc, 0, 0, 0);
                    acc = __builtin_amdgcn_mfma_f32_16x16x32_fp8_fp8((i64_t)(((unsigned long long)a[3] << 32) | a[2]), (i64_t)(((unsigned long long)hb[c][3] << 32) | hb[c][2]), acc, 0, 0, 0); }
                const int base = (u & 7) * 8; const int r = li & 3;
                const float sel = r == 0 ? acc[0] : (r == 1 ? acc[1] : (r == 2 ? acc[2] : acc[3]));
                const float dmine = __shfl(sel, ((lane & 7) >> 2) * 16 + (lane & 3));
                const float gsel = u < 8 ? g_lo : g_hi, susel = u < 8 ? su_lo : su_hi, svsel = u < 8 ? sv_lo : sv_hi;
                const float wv = gsel * gelu_erf(dmine * susel * hinv) * svsel;
                const bool mine = (lane >= base) && (lane < base + 8);
                if (u < 8) w_lo = mine ? wv : w_lo; else w_hi = mine ? wv : w_hi;
                asm volatile("s_waitcnt lgkmcnt(0)" ::: "memory");
            }
            WSP(float, WS_GATE)[t * 128 + lane] = w_lo; WSP(float, WS_GATE)[t * 128 + 64 + lane] = w_hi;
        }
    }
}
constexpr int NPHASE = 10;
__global__ void __launch_bounds__(NTHR, 2) fwd_mega(Args args) {
    extern __shared__ __attribute__((aligned(16))) unsigned char lds[];
    Frame F;
    F.lds = (LAS unsigned char*)lds;
    F.MISC = (volatile LAS unsigned*)(F.lds + MISC_OFF);
    F.G = gridDim.x; { const int bx = blockIdx.x; F.vcu = (F.G % 8 == 0) ? (bx % 8) * (F.G / 8) + bx / 8 : bx; }
    F.ws = args.ws; F.out = args.out;
    F.a = &args;
    for (int u = threadIdx.x; u < 32; u += NTHR) F.MISC[u] = 0u;
    __syncthreads();
    const int lo = args.ph_lo, hi = args.ph_hi;
    const bool use_bar = (hi - lo) > 1;
    XcdBarrier bar; bar.bar = (unsigned*)(F.ws + WS_CTL); bar.x = 0; bar.st = nullptr;
    if (use_bar) bar = xcd_barrier_post((unsigned*)(F.ws + WS_CTL), F.MISC + 8);
#define IN(k) (lo <= (k) && (k) < hi)
#define SEAM(k) do { if (IN(k) && IN((k) + 1)) xcd_barrier(bar); } while (0)
#ifndef REP_PHASE
#define REP_PHASE -1
#endif
#define REPEAT(k, body) do { if (REP_PHASE == (k)) { xcd_barrier(bar); body; } } while (0)
    if (IN(0)) {
#ifndef SKIP_P0
 p0_phase(F); REPEAT(0, p0_phase(F));
#endif
 } SEAM(0);
    if (IN(1)) {
#ifndef SKIP_P1
 p1_phase(F); REPEAT(1, p1_phase(F));
#endif
 } SEAM(1);
    if (IN(2)) {
        pg8::Gemm g{WSP(bf16, WS_H1), WSP(bf16, WS_WINT), MTOK, NPROJ, 1024}; pg8::StaticOrder S; S.init(MTOK, NPROJ, F.G, (int)blockIdx.x);
        pg8::EpiProj E{WSP(bf16, WS_PROJ), NPROJ};
        pg8::gemm_phase<pg8::EpiProj, pg8::StaticOrder, true, true>(F.lds, g, S, E);
        REPEAT(2, (pg8::gemm_phase<pg8::EpiProj, pg8::StaticOrder, true, true>(F.lds, g, S, E)));
    } SEAM(2);
    if (IN(3)) {
#ifndef SKIP_SSD
 p3pre_conv(F); xcd_barrier(bar); p3_ssd3(F); REPEAT(30, p3_ssd3(F)); REPEAT(32, p3pre_conv(F));
#endif
#ifndef SKIP_S5
 p3_s5v2(F); REPEAT(31, p3_s5v2(F));
#endif
 } SEAM(3);
    if (IN(5)) {
        pg8::Gemm g{WSP(bf16, WS_Y), WSP(bf16, WS_WOUTT), MTOK, 1024, 2048}; pg8::StaticOrder S; S.init(MTOK, 1024, F.G, (int)blockIdx.x);
        PG8_LAS float* tab = (PG8_LAS float*)(F.lds + pg8::STAGE_BYTES);
        { pg8::Unit u; for (int i = 0; S.next(i, u); ++i) pg8::SegScaleHook::build(F.lds + pg8::STAGE_BYTES, u, WSP(float, WS_STSSD), WSP(float, WS_STS5), (int)threadIdx.x); }
        __syncthreads();
        pg8::EpiX1 E{(F.a->in[0]), F.out, WSP(bf16, WS_X1S), WSP(float, WS_MOD), (F.a->in[24]), WSP(float, WS_ROWSTAT), tab};
        pg8::SegScaleHook H;
        pg8::gemm_phase<pg8::EpiX1, pg8::StaticOrder, true, true, pg8::SegScaleHook>(F.lds, g, S, E, H);
    } SEAM(5);
    if (IN(6)) {
        pg8::Gemm g{WSP(bf16, WS_X1S), WSP(bf16, WS_WQKT), MTOK, 2048, 1024}; pg8::StaticOrder S; S.init(MTOK, 2048, F.G, (int)blockIdx.x);
        pg8::EpiScores E{WSP(_Float16, WS_SCORES), WSP(float, WS_SB), WSP(float, WS_ROWSTAT)};
        pg8::gemm_phase<pg8::EpiScores, pg8::StaticOrder, true, true>(F.lds, g, S, E);
        REPEAT(6, (pg8::gemm_phase<pg8::EpiScores, pg8::StaticOrder, true, true>(F.lds, g, S, E)));
    } SEAM(6);
    if (IN(7)) {
#ifndef SKIP_TOPK
 p5b_topk(F); REPEAT(7, p5b_topk(F));
#endif
 } SEAM(7);
    if (IN(8)) { p8_peer_up6(F); REPEAT(8, { p5b_topk(F); xcd_barrier(bar); p8_peer_up6(F); }); } SEAM(8);
    if (IN(9)) { p9_peer_down2(F); }
#ifdef PROBE_OUT
    if (IN(9)) { __syncthreads(); if (blockIdx.x == 0 && threadIdx.x == 0) { asm volatile("s_waitcnt vmcnt(0)" ::: "memory"); F.out[0] = *(volatile float*)(F.ws + WS_CTL + 40000); } }
#endif
#undef IN
#undef SEAM
}

#ifndef N_LAUNCHES
#define N_LAUNCHES 1
#endif
extern "C" void kernel_launch(void* const* d_in, const int* in_sizes, int n_in, void* d_out, int out_size, void* d_ws, size_t ws_size, hipStream_t stream) {
    static int grid = 0;
    if (grid == 0) {
        if (n_in != 30 || in_sizes[0] != MTOK * DM || out_size != MTOK * DM || ws_size < WS_END) { fprintf(stderr, "kernel_launch: unexpected shapes (n_in %d, in0 %d, out %d, ws %zu)\n", n_in, n_in > 0 ? in_sizes[0] : -1, out_size, ws_size); grid = -1; return; }
        int dev = 0, cus = 0, per_cu = 0;
        if (hipGetDevice(&dev) != hipSuccess || hipDeviceGetAttribute(&cus, hipDeviceAttributeMultiprocessorCount, dev) != hipSuccess) { grid = -1; return; }
        if (hipFuncSetAttribute((const void*)fwd_mega, hipFuncAttributeMaxDynamicSharedMemorySize, LDS_BYTES) != hipSuccess) { fprintf(stderr, "kernel_launch: hipFuncSetAttribute failed\n"); grid = -1; return; }
        if (hipOccupancyMaxActiveBlocksPerMultiprocessor(&per_cu, (const void*)fwd_mega, NTHR, LDS_BYTES) != hipSuccess || per_cu < 1) { fprintf(stderr, "kernel_launch: occupancy query says %d\n", per_cu); (void)hipGetLastError(); grid = -1; return; }
        if (cus != 256) { fprintf(stderr, "kernel_launch: built for a 256-CU device (got %d CUs); nothing launched\n", cus); grid = -1; return; }
        grid = cus;
    }
    if (grid < 0) return;
    (void)hipMemsetAsync((char*)d_ws + WS_CTL, 0, CTL_ZERO_BYTES, stream);
    Args a{};
    for (int i = 0; i < 30; ++i) a.in[i] = (const float*)d_in[i];
    a.out = (float*)d_out; a.ws = (unsigned char*)d_ws;
    if (N_LAUNCHES == 1) {
        a.ph_lo = 0; a.ph_hi = NPHASE;
        void* kargs[] = {&a};
#ifdef PLAIN_LAUNCH
        (void)kargs; hipLaunchKernelGGL(fwd_mega, dim3(grid), dim3(NTHR), LDS_BYTES, stream, a);
#else
        hipError_t e = hipLaunchCooperativeKernel((const void*)fwd_mega, dim3(grid), dim3(NTHR), kargs, LDS_BYTES, stream);
        if (e != hipSuccess) fprintf(stderr, "kernel_launch: cooperative launch failed: %s (grid %d)\n", hipGetErrorString(e), grid);
#endif
    } else {
        for (int p = 0; p < NPHASE; ++p) { a.ph_lo = p; a.ph_hi = p + 1; hipLaunchKernelGGL(fwd_mega, dim3(grid), dim3(NTHR), LDS_BYTES, stream, a); }
    }
}
```

```cpp
#include <hip/hip_runtime.h>
#include <cstdio>
#include <cstdint>
namespace pg8 {
#define PG8_LAS __attribute__((address_space(3)))
typedef unsigned short bf16_t;
typedef short bf16x8 __attribute__((ext_vector_type(8)));
typedef float f32x4 __attribute__((ext_vector_type(4)));
typedef unsigned u32x4 __attribute__((ext_vector_type(4)));
constexpr int BM = 256, BK = 64, HALF = 128, HTB = HALF * BK * 2  , STAGE_BYTES = 8 * HTB, NXCD = 8, WGM = 8;

__host__ __device__ __forceinline__ int lds_byte(int r, int c) { const int st = (r >> 4) * 2 + (c >> 5), rr = r & 15, cc = c & 31, ob = rr * 64 + cc * 2; return st * 1024 + (ob ^ (((ob >> 9) & 1) << 5)); }
__host__ __device__ __forceinline__ void stage_rc(int b, int& R, int& C) { const int st = b / 1024, sb = b % 1024, swz = sb ^ (((sb >> 9) & 1) << 5); R = (st >> 1) * 16 + swz / 64; C = (st & 1) * 32 + (swz % 64) / 2; }
__host__ __device__ __forceinline__ int perm32(int rho) { const int n = rho >> 4, i = rho & 15; return 8 * (i >> 2) + 4 * n + (i & 3); }

struct Unit { int pm, pn; };
struct Gemm { const bf16_t* A; const bf16_t* Bt; int M, N, K; };

struct StaticOrder {
    int nM, nN, nwg, G, c;
    __host__ __device__ void init(int M, int N, int G_, int c_) { nM = M / BM; nN = N / BM; nwg = nM * nN; G = G_; c = c_; }
    __host__ __device__ bool next(int i, Unit& u) const {
        const long L = (long)i * G + c; if (L >= nwg) return false;
        int wgid = (int)L; { const int q = nwg / NXCD, r = nwg % NXCD, xcd = wgid % NXCD, off = wgid / NXCD; wgid = (xcd < r ? xcd * (q + 1) : r * (q + 1) + (xcd - r) * q) + off; }
        const int nig = WGM * nN, gid = wgid / nig, fm = gid * WGM, gsz = (nM - fm) < WGM ? (nM - fm) : WGM;
        u.pm = fm + ((wgid % nig) % gsz); u.pn = (wgid % nig) / gsz; return true;
    }
    __device__ __forceinline__ void a_ready(const Unit&) const {}
    __device__ __forceinline__ void done(const Unit&) const {}
};

__device__ __forceinline__ unsigned cvt_pk_bf16(float lo, float hi) { unsigned r; asm volatile("v_cvt_pk_bf16_f32 %0, %1, %2" : "=v"(r) : "v"(lo), "v"(hi)); return r; }
typedef float f32x2 __attribute__((ext_vector_type(2)));
struct NoHook { __device__ __forceinline__ void at_tile(int, const Unit&, f32x4 (&)[2][2][4][2], PG8_LAS unsigned char*, int, int) const {} };
template <class Epi, class Sched, bool ALIGN_EPI = false, bool SP2 = false, class Hook = NoHook>
__device__ __forceinline__ void gemm_phase(PG8_LAS unsigned char* lds, const Gemm g, const Sched& S, const Epi& E, const Hook& H = Hook()) {
    const int tid = threadIdx.x, wid = __builtin_amdgcn_readfirstlane(tid >> 6), lane = tid & 63, wr = wid >> 2, wc = wid & 3, fr = lane & 15, fq = lane >> 4;
    const int K = g.K, nt = K / BK;
    unsigned voffA[2], voffB[2];
#pragma unroll
    for (int i = 0; i < 2; ++i) { int R, C; stage_rc(tid * 16 + i * 8192, R, C); const int Rb = Epi::PERM ? ((R & ~31) + perm32(R & 31)) : R;
        voffA[i] = (unsigned)(R * K + C) * 2u; voffB[i] = (unsigned)(Rb * K + C) * 2u; }
    const size_t kstep = (size_t)(BK * 2);
    const size_t hstep = (size_t)HALF * K * 2;
    const size_t tstep = 2 * hstep;
    const unsigned ldsw = (unsigned)wid * 1024u;
    const int aoff = lds_byte(wr * 64 + fr, fq * 8), boff = lds_byte(wc * 32 + fr, fq * 8);
#define PG8_SA(b, h) (((b) * 2 + (h)) * HTB)
#define PG8_SB(b, h) ((4 + (b) * 2 + (h)) * HTB)
#define PG8_STAGE(bufoff, gbase, voff) do { _Pragma("unroll") for (int _i = 0; _i < 2; ++_i) \
        __builtin_amdgcn_global_load_lds((const unsigned*)((const char*)(gbase) + (voff)[_i]), (PG8_LAS unsigned*)(lds + (bufoff) + ldsw + _i * 8192), 16, 0, 0); } while (0)
#define PG8_LDA(dst, b, h) do { _Pragma("unroll") for (int m = 0; m < 4; ++m) _Pragma("unroll") for (int k = 0; k < 2; ++k) dst[m][k] = *(const PG8_LAS bf16x8*)(lds + PG8_SA(b, h) + aoff + m * 2048 + k * 1024); } while (0)
#define PG8_LDB(dst, b, h) do { _Pragma("unroll") for (int n = 0; n < 2; ++n) _Pragma("unroll") for (int k = 0; k < 2; ++k) dst[n][k] = *(const PG8_LAS bf16x8*)(lds + PG8_SB(b, h) + boff + n * 2048 + k * 1024); } while (0)
#define PG8_MMA(ai, bj, At, Bt) do { __builtin_amdgcn_s_setprio(1); _Pragma("unroll") for (int m = 0; m < 4; ++m) _Pragma("unroll") for (int n = 0; n < 2; ++n) _Pragma("unroll") for (int k = 0; k < 2; ++k) \
        acc[ai][bj][m][n] = __builtin_amdgcn_mfma_f32_16x16x32_bf16(Bt[n][k], At[m][k], acc[ai][bj][m][n], 0, 0, 0); __builtin_amdgcn_s_setprio(0); } while (0)
#define PG8_WAIT_V(n) asm volatile("s_waitcnt vmcnt(" #n ")" ::: "memory")
#define PG8_WAIT_L(n) asm volatile("s_waitcnt lgkmcnt(" #n ")" ::: "memory")
#define PG8_BAR __builtin_amdgcn_s_barrier()
#define PG8_SCHED __builtin_amdgcn_sched_barrier(0)
    Unit cur, nxt; int ui = 0;
    if (!S.next(0, cur)) return;
    f32x4 acc[2][2][4][2];
#pragma unroll
    for (int a = 0; a < 2; ++a)
#pragma unroll
        for (int b = 0; b < 2; ++b)
#pragma unroll
            for (int m = 0; m < 4; ++m)
#pragma unroll
                for (int n = 0; n < 2; ++n) acc[a][b][m][n] = (f32x4){0.f, 0.f, 0.f, 0.f};
    bf16x8 At[4][2], B0[2][2], B1[2][2];
    const char* cA = (const char*)g.A + (size_t)cur.pm * tstep; const char* cB = (const char*)g.Bt + (size_t)cur.pn * tstep;
    S.a_ready(cur);
    if constexpr (SP2) {
        PG8_STAGE(PG8_SB(0, 0), cB, voffB); PG8_STAGE(PG8_SB(0, 1), cB + hstep, voffB); PG8_STAGE(PG8_SA(0, 0), cA, voffA); PG8_STAGE(PG8_SA(0, 1), cA + hstep, voffA);
        if (wr == 1) PG8_BAR;
        PG8_WAIT_V(2); PG8_BAR;
        PG8_STAGE(PG8_SB(1, 0), cB + kstep, voffB); PG8_STAGE(PG8_SA(1, 0), cA + kstep, voffA); PG8_STAGE(PG8_SB(1, 1), cB + hstep + kstep, voffB);
        PG8_WAIT_V(6); PG8_BAR;
    } else {
        PG8_STAGE(PG8_SB(0, 0), cB, voffB); PG8_STAGE(PG8_SA(0, 0), cA, voffA); PG8_STAGE(PG8_SB(0, 1), cB + hstep, voffB); PG8_STAGE(PG8_SA(0, 1), cA + hstep, voffA);
        if (wr == 1) PG8_BAR;
        PG8_WAIT_V(4); PG8_BAR;
        PG8_STAGE(PG8_SB(1, 0), cB + kstep, voffB); PG8_STAGE(PG8_SA(1, 0), cA + kstep, voffA); PG8_STAGE(PG8_SB(1, 1), cB + hstep + kstep, voffB);
        PG8_WAIT_V(6); PG8_BAR;
    }
    for (;;) {
        const bool has_next = S.next(ui + 1, nxt);
        const char* nA = has_next ? (const char*)g.A + (size_t)nxt.pm * tstep : cA; const char* nB = has_next ? (const char*)g.Bt + (size_t)nxt.pn * tstep : cB;
        for (int t = 0; t < nt; t += 2) {
            const bool last = (t == nt - 2);
            H.at_tile(t, cur, acc, lds + STAGE_BYTES, wr, fr);
            const char* a1 = cA + (size_t)(t + 1) * kstep;
            const char* a2 = last ? nA : cA + (size_t)(t + 2) * kstep; const char* b2 = last ? nB : cB + (size_t)(t + 2) * kstep;
            const char* a3 = a2 + kstep; const char* b3 = b2 + kstep;
            if (last && has_next) S.a_ready(nxt);
            if constexpr (SP2) {
            PG8_LDB(B0, 0, 0); PG8_LDB(B1, 0, 1); PG8_SCHED; PG8_LDA(At, 0, 0); PG8_STAGE(PG8_SA(1, 1), a1 + hstep, voffA);
            PG8_WAIT_V(8); PG8_WAIT_L(0); PG8_BAR; PG8_MMA(0, 0, At, B0); PG8_MMA(0, 1, At, B1); PG8_BAR; PG8_SCHED;
            PG8_LDA(At, 0, 1); PG8_STAGE(PG8_SB(0, 0), b2, voffB); PG8_STAGE(PG8_SB(0, 1), b2 + hstep, voffB); PG8_STAGE(PG8_SA(0, 0), a2, voffA);
            PG8_WAIT_V(8); PG8_WAIT_L(0); PG8_BAR; PG8_MMA(1, 0, At, B0); PG8_MMA(1, 1, At, B1); PG8_BAR; PG8_SCHED;
            PG8_LDB(B0, 1, 0); PG8_LDB(B1, 1, 1); PG8_SCHED; PG8_LDA(At, 1, 0); PG8_STAGE(PG8_SA(0, 1), a2 + hstep, voffA);
            PG8_WAIT_V(8); PG8_WAIT_L(0); PG8_BAR; PG8_MMA(0, 0, At, B0); PG8_MMA(0, 1, At, B1); PG8_BAR; PG8_SCHED;
            PG8_LDA(At, 1, 1); PG8_STAGE(PG8_SB(1, 0), b3, voffB); PG8_STAGE(PG8_SB(1, 1), b3 + hstep, voffB); PG8_STAGE(PG8_SA(1, 0), a3, voffA);
            PG8_WAIT_V(8); PG8_WAIT_L(0); PG8_BAR; PG8_MMA(1, 0, At, B0); PG8_MMA(1, 1, At, B1); PG8_BAR; PG8_SCHED;
            } else {
            PG8_LDB(B0, 0, 0); PG8_SCHED; PG8_LDA(At, 0, 0); PG8_STAGE(PG8_SA(1, 1), a1 + hstep, voffA);
            PG8_WAIT_L(8); PG8_BAR; PG8_WAIT_L(0); PG8_MMA(0, 0, At, B0); PG8_BAR; PG8_SCHED;
            PG8_LDB(B1, 0, 1); PG8_STAGE(PG8_SB(0, 0), b2, voffB);
            PG8_BAR; PG8_WAIT_L(0); PG8_MMA(0, 1, At, B1); PG8_BAR;
            PG8_LDA(At, 0, 1); PG8_STAGE(PG8_SA(0, 0), a2, voffA);
            PG8_BAR; PG8_WAIT_L(0); PG8_MMA(1, 0, At, B0); PG8_BAR; PG8_SCHED;
            PG8_STAGE(PG8_SB(0, 1), b2 + hstep, voffB);
            PG8_WAIT_V(6); PG8_BAR; PG8_MMA(1, 1, At, B1); PG8_BAR;
            PG8_LDB(B0, 1, 0); PG8_SCHED; PG8_LDA(At, 1, 0); PG8_STAGE(PG8_SA(0, 1), a2 + hstep, voffA);
            PG8_WAIT_L(8); PG8_BAR; PG8_WAIT_L(0); PG8_MMA(0, 0, At, B0); PG8_BAR; PG8_SCHED;
            PG8_LDB(B1, 1, 1); PG8_STAGE(PG8_SB(1, 0), b3, voffB);
            PG8_BAR; PG8_WAIT_L(0); PG8_MMA(0, 1, At, B1); PG8_BAR;
            PG8_LDA(At, 1, 1); PG8_STAGE(PG8_SA(1, 0), a3, voffA);
            PG8_BAR; PG8_WAIT_L(0); PG8_MMA(1, 0, At, B0); PG8_BAR; PG8_SCHED;
            PG8_STAGE(PG8_SB(1, 1), b3 + hstep, voffB);
            PG8_WAIT_V(6); PG8_BAR; PG8_MMA(1, 1, At, B1); PG8_BAR;
            }
        }
        if constexpr (ALIGN_EPI) { if (wr == 0) PG8_BAR; }
        if constexpr (!Epi::AFTER_DRAIN) { E(acc, cur, wr, wc, fr, fq);
#ifdef PROBE_EPI2
            if constexpr (Epi::PROBE_TWICE) { asm volatile("" ::: "memory"); E(acc, cur, wr, wc, fr, fq); }
#endif
            S.done(cur); }
        if (!has_next) break;
#pragma unroll
        for (int a = 0; a < 2; ++a)
#pragma unroll
            for (int b = 0; b < 2; ++b)
#pragma unroll
                for (int m = 0; m < 4; ++m)
#pragma unroll
                    for (int n = 0; n < 2; ++n) acc[a][b][m][n] = (f32x4){0.f, 0.f, 0.f, 0.f};
        cur = nxt; cA = nA; cB = nB; ++ui;
        if constexpr (ALIGN_EPI) { if (wr == 1) PG8_BAR; }
    }
    PG8_WAIT_V(0);
    if constexpr (!ALIGN_EPI) { if (wr == 0) PG8_BAR; }
    PG8_BAR;
    if constexpr (Epi::AFTER_DRAIN) { E.fused(acc, cur, wr, wc, fr, fq, lds, wid, lane); S.done(cur); }
#undef PG8_SA
#undef PG8_SB
#undef PG8_STAGE
#undef PG8_LDA
#undef PG8_LDB
#undef PG8_MMA
#undef PG8_WAIT_V
#undef PG8_WAIT_L
#undef PG8_BAR
#undef PG8_SCHED
}
}
namespace pg8 {
struct EpiProj {
    static constexpr bool PERM = true, AFTER_DRAIN = false, PROBE_TWICE = true;
    bf16_t* O; int ldc;
    __device__ __forceinline__ void operator()(const f32x4 (&acc)[2][2][4][2], const Unit& u, int wr, int wc, int fr, int fq) const {
        const int row0 = u.pm * BM + wr * 64 + fr; const int col0 = u.pn * BM + wc * 32 + 8 * fq;
#pragma unroll
        for (int ai = 0; ai < 2; ++ai)
#pragma unroll
            for (int m = 0; m < 4; ++m) { bf16_t* rowp = O + (size_t)(row0 + ai * HALF + m * 16) * ldc + col0;
#pragma unroll
                for (int bj = 0; bj < 2; ++bj) { const f32x4 v0 = acc[ai][bj][m][0], v1 = acc[ai][bj][m][1];
                    u32x4 w; w.x = cvt_pk_bf16(v0[0], v0[1]); w.y = cvt_pk_bf16(v0[2], v0[3]); w.z = cvt_pk_bf16(v1[0], v1[1]); w.w = cvt_pk_bf16(v1[2], v1[3]);
                    __builtin_nontemporal_store(w, (u32x4*)(rowp + bj * HALF)); } }
    }
};
struct EpiX1 {
    static constexpr bool PERM = true, AFTER_DRAIN = false, PROBE_TWICE = false;
    const float* x; float* x1; bf16_t* x1s; const float* mod; const float* norm2_g; float* rowstat; PG8_LAS float* tab;
    __device__ __forceinline__ void operator()(const f32x4 (&acc)[2][2][4][2], const Unit& u, int wr, int wc, int fr, int fq) const {
        const int row0 = u.pm * BM + wr * 64 + fr; const int col0 = u.pn * BM + wc * 32 + 8 * fq; const int b = (u.pm * BM) >> 11;
        const float* mb = mod + (size_t)b * 6144;
        f32x4 g1[2][2], g2[2][2];
#pragma unroll
        for (int bj = 0; bj < 2; ++bj)
#pragma unroll
            for (int n = 0; n < 2; ++n) { const int c = col0 + bj * HALF + 4 * n; g1[bj][n] = *(const f32x4*)(mb + 2048 + c);
                const f32x4 sc = *(const f32x4*)(mb + 4096 + c), ng = *(const f32x4*)(norm2_g + c); g2[bj][n] = ng * (sc + 1.0f); }
#pragma unroll
        for (int ai = 0; ai < 2; ++ai)
#pragma unroll
            for (int m = 0; m < 4; ++m) { const size_t row = (size_t)(row0 + ai * HALF + m * 16); const size_t off = row * 1024 + col0; float ss = 0.f;
                const float rfin = tab[((u.pm >> 3) & 1) * 1280 + 1024 + ai * HALF + wr * 64 + m * 16 + fr];
#pragma unroll
                for (int bj = 0; bj < 2; ++bj) {
                    const f32x4 xa = *(const f32x4*)(x + off + bj * HALF), xb = *(const f32x4*)(x + off + bj * HALF + 4);
                    const f32x4 v0 = xa + g1[bj][0] * (acc[ai][bj][m][0] * rfin), v1 = xb + g1[bj][1] * (acc[ai][bj][m][1] * rfin);
                    *(f32x4*)(x1 + off + bj * HALF) = v0; *(f32x4*)(x1 + off + bj * HALF + 4) = v1;
                    ss += (v0[0] * v0[0] + v0[1] * v0[1]) + (v0[2] * v0[2] + v0[3] * v0[3]) + (v1[0] * v1[0] + v1[1] * v1[1]) + (v1[2] * v1[2] + v1[3] * v1[3]);
                    const f32x4 s0 = v0 * g2[bj][0], s1 = v1 * g2[bj][1];
                    u32x4 w; w.x = cvt_pk_bf16(s0[0], s0[1]); w.y = cvt_pk_bf16(s0[2], s0[3]); w.z = cvt_pk_bf16(s1[0], s1[1]); w.w = cvt_pk_bf16(s1[2], s1[3]);
                    *(u32x4*)(x1s + off + bj * HALF) = w; }
                ss += __shfl_xor(ss, 16); ss += __shfl_xor(ss, 32);
                if (fq == 0) atomicAdd(rowstat + row, ss); }
    }
};
typedef _Float16 f16x8 __attribute__((ext_vector_type(8)));
struct EpiScores {
    static constexpr bool PERM = true, AFTER_DRAIN = false, PROBE_TWICE = false;
    _Float16* S; const float* sb; const float* rowstat;
    __device__ __forceinline__ void operator()(const f32x4 (&acc)[2][2][4][2], const Unit& u, int wr, int wc, int fr, int fq) const {
        const int row0 = u.pm * BM + wr * 64 + fr; const int col0 = u.pn * BM + wc * 32 + 8 * fq; const int b = (u.pm * BM) >> 11;
        f32x4 bv[2][2];
#pragma unroll
        for (int bj = 0; bj < 2; ++bj)
#pragma unroll
            for (int n = 0; n < 2; ++n) bv[bj][n] = *(const f32x4*)(sb + (size_t)b * 2048 + col0 + bj * HALF + 4 * n);
#pragma unroll
        for (int ai = 0; ai < 2; ++ai)
#pragma unroll
            for (int m = 0; m < 4; ++m) { const size_t row = (size_t)(row0 + ai * HALF + m * 16); const float rs = __builtin_amdgcn_rsqf(rowstat[row] * (1.0f / 1024.0f) + 1e-6f);
                _Float16* rowp = S + row * 2048 + col0;
#pragma unroll
                for (int bj = 0; bj < 2; ++bj) { const f32x4 v0 = acc[ai][bj][m][0] * rs + bv[bj][0], v1 = acc[ai][bj][m][1] * rs + bv[bj][1];
                    f16x8 h; h[0] = (_Float16)v0[0]; h[1] = (_Float16)v0[1]; h[2] = (_Float16)v0[2]; h[3] = (_Float16)v0[3]; h[4] = (_Float16)v1[0]; h[5] = (_Float16)v1[1]; h[6] = (_Float16)v1[2]; h[7] = (_Float16)v1[3];
                    *(f16x8*)(rowp + bj * HALF) = h; } }
    }
};
struct SegScaleHook {
    __device__ __forceinline__ static void build(PG8_LAS unsigned char* ldsx, const Unit& u, const float* st_ssd, const float* st_s5, int tid) {
        PG8_LAS float* tab = (PG8_LAS float*)ldsx + ((u.pm >> 3) & 1) * 1280;
        if (tid < 256) { const size_t row = (size_t)u.pm * BM + tid; const f32x4* sg = (const f32x4*)(st_ssd + row * 16); const f32x4* s5 = (const f32x4*)(st_s5 + row * 64);
            float r[5];
#pragma unroll
            for (int gI = 0; gI < 4; ++gI) { const f32x4 v = sg[gI]; r[gI] = __builtin_amdgcn_rsqf(((v[0] + v[1]) + (v[2] + v[3])) * (1.0f / 256.0f) + 1e-6f); }
            float a5 = 0.f;
#pragma unroll
            for (int q = 0; q < 16; ++q) { const f32x4 v = s5[q]; a5 += (v[0] + v[1]) + (v[2] + v[3]); }
            r[4] = __builtin_amdgcn_rsqf(a5 * (1.0f / 1024.0f) + 1e-6f);
#pragma unroll
            for (int k = 0; k < 4; ++k) tab[k * 256 + tid] = r[k] * __builtin_amdgcn_rcpf(r[k + 1]);
            tab[1024 + tid] = r[4]; }
    }
    __device__ __forceinline__ void at_tile(int t, const Unit& u, f32x4 (&acc)[2][2][4][2], PG8_LAS unsigned char* ldsx, int wr, int fr) const {
        if (t == 4 || t == 8 || t == 12 || t == 16) { const PG8_LAS float* rt = (const PG8_LAS float*)ldsx + ((u.pm >> 3) & 1) * 1280 + ((t >> 2) - 1) * 256 + wr * 64 + fr;
#pragma unroll
            for (int ai = 0; ai < 2; ++ai)
#pragma unroll
                for (int m = 0; m < 4; ++m) { const float r = rt[ai * HALF + m * 16];
#pragma unroll
                    for (int bj = 0; bj < 2; ++bj) { acc[ai][bj][m][0] = acc[ai][bj][m][0] * r; acc[ai][bj][m][1] = acc[ai][bj][m][1] * r; } } }
    }
};
}
constexpr int NWAVES = 8, NTHR = 512;
constexpr int DM = 1024, NB = 16, SEQ = 2048, MTOK = NB * SEQ;
constexpr int NPROJ = 4096;
constexpr int INW = 4112;
constexpr int NHEADS = 16, HDIM = 64, NGRP = 4, NST = 128, CHUNK = 128;
constexpr int S5G = 64, S5CH = 16, S5P = 64;
constexpr int PH = 8, PK = 16, PNK = 128;
constexpr float EPSF = 1e-6f;
constexpr int NS5PART = 64;

constexpr size_t MiB = 1u << 20;
constexpr size_t WS_CTL = 0, CTL_ZERO_BYTES = 64 * 1024;
constexpr size_t WS_MOD = 1 * MiB;
constexpr size_t WS_WDT = WS_MOD + 0x60000;
constexpr size_t WS_SB = WS_MOD + 0x70000;
constexpr size_t WS_ROWSTAT = WS_MOD + 0x90000;
constexpr size_t WS_S5LB = WS_MOD + 0xB0000;
constexpr size_t WS_S5BB = WS_MOD + 0xC0000;
constexpr size_t WS_DTRAW = 3 * MiB;
constexpr size_t WS_STSSD = 5 * MiB;
constexpr size_t WS_STS5 = 7 * MiB;
constexpr size_t WS_WINT = 15 * MiB;
constexpr size_t WS_WOUTT = 23 * MiB;
constexpr size_t WS_WQKT = 27 * MiB;
constexpr size_t WS_EU = 31 * MiB, WS_EV = 47 * MiB;
constexpr size_t WS_EUS = 63 * MiB, WS_EVS = 63 * MiB + 65536;
constexpr size_t WS_START = 64 * MiB;
constexpr size_t WS_A = 95 * MiB;
constexpr size_t WS_B = 223 * MiB;
constexpr size_t WS_H1 = WS_A, WS_Y = WS_A, WS_PROJ = WS_B, WS_SCORES = WS_A;
constexpr size_t WS_X1S = WS_B + 192 * MiB;
constexpr size_t WS_EID = 479 * MiB, WS_GATE = 495 * MiB;
constexpr size_t WS_END = 511 * MiB;
static_assert(WS_SCORES + (size_t)MTOK * 2048 * 4 <= WS_X1S && WS_X1S + (size_t)MTOK * 1024 * 2 <= WS_EID && WS_GATE + (size_t)MTOK * 128 * 4 <= WS_END, "ws map");

constexpr int LDS_MAIN = 159744;
constexpr int MISC_OFF = LDS_MAIN;
constexpr int LDS_BYTES = LDS_MAIN + 128;

#define GAS __attribute__((address_space(1)))
#define LAS __attribute__((address_space(3)))
typedef unsigned short bf16;
typedef unsigned v4u __attribute__((ext_vector_type(4)));
typedef unsigned v2u __attribute__((ext_vector_type(2)));
typedef float f32x4 __attribute__((ext_vector_type(4)));
typedef float f32x2 __attribute__((ext_vector_type(2)));
typedef short bf16x8 __attribute__((ext_vector_type(8)));
#define LDS_WAIT() asm volatile("s_waitcnt lgkmcnt(0)" ::: "memory")
#define VM_WAIT() asm volatile("s_waitcnt vmcnt(0)" ::: "memory")
typedef __bf16 hwbf16x2 __attribute__((ext_vector_type(2)));
__device__ __forceinline__ unsigned pk2(float lo, float hi) { const f32x2 v = {lo, hi}; const hwbf16x2 b = __builtin_convertvector(v, hwbf16x2); return __builtin_bit_cast(unsigned, b); }
__device__ __forceinline__ unsigned f2bf(float f) { return pk2(f, 0.f) & 0xffffu; }
__device__ __forceinline__ float bflo(unsigned w) { return __builtin_bit_cast(float, w << 16); }
__device__ __forceinline__ float bfhi(unsigned w) { return __builtin_bit_cast(float, w & 0xffff0000u); }
__device__ __forceinline__ float bf2f(bf16 v) { return __builtin_bit_cast(float, (unsigned)v << 16); }
__device__ __forceinline__ float wave_sum(float v) {
#pragma unroll
    for (int o = 1; o < 64; o <<= 1) v += __shfl_xor(v, o);
    return v;
}
__device__ __forceinline__ float sigmoid_f(float v) { return __builtin_amdgcn_rcpf(1.0f + __builtin_amdgcn_exp2f(-1.4426950408889634f * v)); }
__device__ __forceinline__ float silu_f(float v) { return v * sigmoid_f(v); }
__device__ __forceinline__ float rsqrt_f(float v) { return __builtin_amdgcn_rsqf(v); }
__device__ __forceinline__ float gelu_erf(float v) {
    const float av = fabsf(v), t = __builtin_amdgcn_rcpf(av * 0.2316418882f + 1.0f);
    float q = t * 0.5307027145f + (-0.7265760135f); q = q * t + 0.7107068705f; q = q * t + (-0.142248368f); q = q * t + 0.127414796f; q = q * t;
    const float e = __builtin_amdgcn_exp2f((v * v) * (-0.72134752044f));
    const float m = v * (q * e);
    return v < 0.f ? m : v - m;
}
__device__ __forceinline__ float softplus_f(float v) { const float e = __builtin_amdgcn_exp2f(-1.4426950408889634f * fabsf(v));
    const float l = e < 1e-6f ? e : 0.6931471805599453f * __builtin_amdgcn_logf(1.0f + e); return fmaxf(v, 0.f) + l; }
__device__ __forceinline__ void unpack8(const v4u w, float* f) { f[0] = bflo(w.x); f[1] = bfhi(w.x); f[2] = bflo(w.y); f[3] = bfhi(w.y); f[4] = bflo(w.z); f[5] = bfhi(w.z); f[6] = bflo(w.w); f[7] = bfhi(w.w); }
#define LDS_BARRIER() do { asm volatile("s_waitcnt lgkmcnt(0)" ::: "memory"); __builtin_amdgcn_s_barrier(); asm volatile("" ::: "memory"); } while (0)
__device__ __forceinline__ float row16_sum_to15(float v) {
    v += __builtin_bit_cast(float, __builtin_amdgcn_update_dpp(0, __builtin_bit_cast(int, v), 0x118, 0xf, 0xf, true));
    v += __builtin_bit_cast(float, __builtin_amdgcn_update_dpp(0, __builtin_bit_cast(int, v), 0x114, 0xf, 0xf, true));
    v += __builtin_bit_cast(float, __builtin_amdgcn_update_dpp(0, __builtin_bit_cast(int, v), 0x112, 0xf, 0xf, true));
    v += __builtin_bit_cast(float, __builtin_amdgcn_update_dpp(0, __builtin_bit_cast(int, v), 0x111, 0xf, 0xf, true));
    return v;
}
__device__ __forceinline__ float wave_sum_to63(float v) {
    v = row16_sum_to15(v);
    v += __builtin_bit_cast(float, __builtin_amdgcn_update_dpp(0, __builtin_bit_cast(int, v), 0x142, 0xa, 0xf, false));
    v += __builtin_bit_cast(float, __builtin_amdgcn_update_dpp(0, __builtin_bit_cast(int, v), 0x143, 0xc, 0xf, false));
    return v;
}
__device__ __forceinline__ f32x2 gelu_pk2(f32x2 v) {
    const f32x2 av = __builtin_elementwise_abs(v), d = av * 0.2316418882f + 1.0f;
    f32x2 t; t[0] = __builtin_amdgcn_rcpf(d[0]); t[1] = __builtin_amdgcn_rcpf(d[1]);
    f32x2 q = t * 0.5307027145f + (-0.7265760135f); q = q * t + 0.7107068705f; q = q * t + (-0.142248368f); q = q * t + 0.127414796f; q = q * t;
    const f32x2 s = (v * v) * (-0.72134752044f);
    f32x2 e; e[0] = __builtin_amdgcn_exp2f(s[0]); e[1] = __builtin_amdgcn_exp2f(s[1]);
    const f32x2 m = v * (q * e), r = v - m;
    f32x2 o; o[0] = v[0] < 0.f ? m[0] : r[0]; o[1] = v[1] < 0.f ? m[1] : r[1]; return o;
}
#define XB_TMO      128
#define XB_XCNT(j)  (256  + 64 * (j))
#define XB_XSUB(j)  (1280 + 64 * (j))
#define XB_XGEN(j)  (2304 + 64 * (j))
#define XB_TOP      3328
#define XB_TOPGEN   3392
#define XCD_BAR_WORDS 3456
#define XB_SPIN_CAP (1u << 18)

__device__ __forceinline__ unsigned xb_ld(unsigned* p)              { return __hip_atomic_load(p, __ATOMIC_RELAXED, __HIP_MEMORY_SCOPE_AGENT); }
__device__ __forceinline__ unsigned xb_add(unsigned* p, unsigned v) { return __hip_atomic_fetch_add(p, v, __ATOMIC_RELAXED, __HIP_MEMORY_SCOPE_AGENT); }
__device__ __forceinline__ unsigned xb_xcc_id() { return (unsigned)__builtin_amdgcn_s_getreg((3 << 11) | 20) & 0xFu; }
#define XB_SPIN(cond, bar) do { unsigned _sp = 0; while (cond) { __builtin_amdgcn_s_sleep(1); \
    if ((++_sp & 255u) == 0u) { if (xb_ld(&(bar)[XB_TMO])) break; if (_sp > XB_SPIN_CAP) { atomicAdd(&(bar)[XB_TMO], 1u); break; } } } } while (0)

struct XcdBarrier {
    unsigned* bar; unsigned x;
    volatile LAS unsigned* st;
};

__device__ __forceinline__ XcdBarrier xcd_barrier_post(unsigned* bar, volatile LAS unsigned* st) {
    XcdBarrier b; b.bar = bar; b.x = xb_xcc_id(); b.st = st;
    if (threadIdx.x == 0) (void)xb_add(&bar[XB_XCNT(b.x)], 1u);
    return b;
}
__device__ __forceinline__ void xcd_barrier_complete(unsigned* bar, unsigned x, unsigned& nloc, unsigned& nx) {
    const unsigned G = gridDim.x * gridDim.y * gridDim.z;
    unsigned sum, cnt, mine, sp = 0u;
    for (;;) {
        sum = 0u; cnt = 0u; mine = 0u;
#pragma unroll
        for (unsigned j = 0; j < 16; ++j) { const unsigned c = xb_ld(&bar[XB_XCNT(j)]); sum += c; cnt += (c > 0u) ? 1u : 0u; mine = (j == x) ? c : mine; }
        if (sum == G) break;
        __builtin_amdgcn_s_sleep(1);
        if ((++sp & 255u) == 0u) { if (xb_ld(&bar[XB_TMO])) break; if (sp > XB_SPIN_CAP) { atomicAdd(&bar[XB_TMO], 1u); break; } }
    }
    nloc = mine > 0u ? mine : 1u; nx = cnt > 0u ? cnt : 1u;
}

__device__ __forceinline__ void xcd_barrier(const XcdBarrier& b) {
    asm volatile("s_waitcnt vmcnt(0)" ::: "memory");
    __syncthreads();
    if (threadIdx.x == 0) {
        unsigned* bar = b.bar;
        __builtin_amdgcn_s_waitcnt(0);
        unsigned nloc = b.st[0], nx = b.st[1];
        if (nloc == 0u) { xcd_barrier_complete(bar, b.x, nloc, nx); b.st[0] = nloc; b.st[1] = nx; }
        const unsigned old = xb_add(&bar[XB_XSUB(b.x)], 1u);
        const unsigned gen = old / nloc;
        if (old + 1u == (gen + 1u) * nloc) {
            __builtin_amdgcn_fence(__ATOMIC_RELEASE, "agent");
            asm volatile("s_waitcnt vmcnt(0)" ::: "memory");
            const unsigned og = xb_add(&bar[XB_TOP], 1u);
            const unsigned tg = og / nx;
            if (og + 1u == (tg + 1u) * nx) xb_add(&bar[XB_TOPGEN], 1u);
            else XB_SPIN(xb_ld(&bar[XB_TOPGEN]) == tg, bar);
            __builtin_amdgcn_fence(__ATOMIC_ACQUIRE, "agent");
            xb_add(&bar[XB_XGEN(b.x)], 1u);
            asm volatile("s_waitcnt vmcnt(0)" ::: "memory");
        } else {
            XB_SPIN(xb_ld(&bar[XB_XGEN(b.x)]) == gen, bar);
            __builtin_amdgcn_fence(__ATOMIC_ACQUIRE, "agent");
            asm volatile("s_waitcnt vmcnt(0)" ::: "memory");
        }
    }
    __syncthreads();
}
struct Args { const float* in[30]; float* out; unsigned char* ws; int ph_lo, ph_hi; };
struct Frame {
    LAS unsigned char* lds;
    volatile LAS unsigned* MISC;
    int vcu, G;
    unsigned char* ws;
    const Args* a;
    float* out;
};
#define WSP(T, off) ((T*)(F.ws + (off)))

__device__ __forceinline__ void transpose_tile(const float* W, int ldw, int k0, int src_n0, bf16* WT, int K, int dst_n0, LAS float* scr, int lane, const float* kscale) {
#pragma unroll 8
    for (int i = 0; i < 32; ++i) { const int kk = 2 * i + (lane >> 5); float v = W[(size_t)(k0 + kk) * ldw + src_n0 + (lane & 31)]; if (kscale) v *= kscale[k0 + kk]; scr[kk * 33 + (lane & 31)] = v; }
    LDS_WAIT(); asm volatile("" ::: "memory");
    const int c = lane & 7;
#pragma unroll
    for (int j = 0; j < 4; ++j) { const int n = (lane >> 3) + 8 * j; const LAS float* s = scr + (8 * c) * 33 + n;
        v4u o; o.x = pk2(s[0 * 33], s[1 * 33]); o.y = pk2(s[2 * 33], s[3 * 33]); o.z = pk2(s[4 * 33], s[5 * 33]); o.w = pk2(s[6 * 33], s[7 * 33]);
        *(v4u*)(WT + (size_t)(dst_n0 + n) * K + k0 + 8 * c) = o; }
    LDS_WAIT(); asm volatile("" ::: "memory");
}
__device__ __forceinline__ void p0_phase(Frame& F) {
    const int f_tid = threadIdx.x, f_lane = f_tid & 63, f_wave = __builtin_amdgcn_readfirstlane(f_tid >> 6);
    const int gw = F.vcu * NWAVES + f_wave, NGW = F.G * NWAVES, gt = F.vcu * NTHR + f_tid, NGT = F.G * NTHR;
    {
        LAS float* sc = (LAS float*)F.lds;
        LAS float* red = (LAS float*)(F.lds + 65536);
        for (int i = f_tid; i < 16 * 1024; i += NTHR) { const int b = i >> 10, k = i & 1023; sc[k * 16 + b] = silu_f((F.a->in[1])[i]); }
        __syncthreads();
        const int ks = f_tid / 24, col = f_tid - ks * 24, j = F.vcu * 24 + col;
        if (ks < 21) {
            float acc[16];
#pragma unroll
            for (int b = 0; b < 16; ++b) acc[b] = 0.f;
            const int k0 = ks * 49, kn = (k0 + 49 <= 1024) ? 49 : (1024 - k0);
            const float* wp = (F.a->in[2]) + (size_t)k0 * 6144 + j;
#pragma unroll 1
            for (int kb = 0; kb < 49; kb += 7) {
                asm volatile("" ::: "memory");
                float wv[7];
#pragma unroll
                for (int u = 0; u < 7; ++u) wv[u] = (kb + u < kn) ? wp[(size_t)(kb + u) * 6144] : 0.f;
#pragma unroll
                for (int u = 0; u < 7; ++u) { const int kk = (kb + u < kn) ? (k0 + kb + u) : k0; const LAS f32x4* s4 = (const LAS f32x4*)(sc + kk * 16);
#pragma unroll
                    for (int q = 0; q < 4; ++q) { const f32x4 sv = s4[q]; acc[4 * q] += sv[0] * wv[u]; acc[4 * q + 1] += sv[1] * wv[u]; acc[4 * q + 2] += sv[2] * wv[u]; acc[4 * q + 3] += sv[3] * wv[u]; } }
            }
#pragma unroll
            for (int b = 0; b < 16; ++b) red[(ks * 16 + b) * 24 + col] = acc[b];
        }
        __syncthreads();
        for (int i = f_tid; i < 16 * 24; i += NTHR) { const int b = i / 24, cc = i - b * 24; float sacc = 0.f;
            for (int q = 0; q < 21; ++q) sacc += red[(q * 16 + b) * 24 + cc];
            WSP(float, WS_MOD)[b * 6144 + F.vcu * 24 + cc] = sacc + (F.a->in[3])[F.vcu * 24 + cc]; }
        __syncthreads();
    }
    {
        LAS float* scr = (LAS float*)(F.lds + f_wave * 16384);
        constexpr int I_IN = (1024 / 64) * (NPROJ / 32), I_OUT = (2048 / 64) * (1024 / 32);
        for (int it = gw; it < I_IN + I_OUT; it += NGW) {
            if (it < I_IN) { const int kb = it / (NPROJ / 32), nb = it % (NPROJ / 32); const int dn = 32 * nb, sn = dn < 3072 ? dn : dn + 16;
                transpose_tile((F.a->in[5]), INW, 64 * kb, sn, WSP(bf16, WS_WINT), 1024, dn, scr, f_lane, nullptr); }
            else { const int r = it - I_IN, kb = r / 32, nb = r % 32; const int k0 = 64 * kb;
                transpose_tile((F.a->in[23]), 1024, k0, 32 * nb, WSP(bf16, WS_WOUTT), 2048, 32 * nb, scr, f_lane, k0 < 1024 ? (F.a->in[11]) : (F.a->in[22]) - 1024); }
        }
    }
    for (int i = gt; i < 16 * 1024; i += NGT) { const int h = i >> 10, k = i & 1023; WSP(float, WS_WDT)[i] = (F.a->in[5])[(size_t)k * INW + 3072 + h]; }
    for (int task = gw; task < 2048; task += NGW) {
        const int nt = task >> 4, ks = task & 15, n0 = 16 * nt, hc = n0 >> 7, k0 = 64 * ks;
        const int li = f_lane & 15, lq = f_lane >> 4;
        f32x4 acc[4];
#pragma unroll
        for (int s = 0; s < 4; ++s) acc[s] = (f32x4){0.f, 0.f, 0.f, 0.f};
        const float* ap = (F.a->in[26]) + (size_t)(n0 + li) * 128 + 4 * lq;
        const float* bp = (F.a->in[25]) + (size_t)(k0 + li) * 2048 + hc * 128 + 4 * lq;
#pragma unroll
        for (int q = 0; q < 8; ++q) { const f32x4 a = *(const f32x4*)(ap + 16 * q);
#pragma unroll
            for (int s = 0; s < 4; ++s) { const f32x4 b = *(const f32x4*)(bp + (size_t)(16 * s) * 2048 + 16 * q);
#pragma unroll
                for (int jj = 0; jj < 4; ++jj) acc[s] = __builtin_amdgcn_mfma_f32_16x16x4f32(a[jj], b[jj], acc[s], 0, 0, 0); } }
        bf16* o = WSP(bf16, WS_WQKT);
#pragma unroll
        for (int s = 0; s < 4; ++s)
#pragma unroll
            for (int r = 0; r < 4; ++r) o[(size_t)(n0 + 4 * lq + r) * 1024 + k0 + 16 * s + li] = (bf16)f2bf(acc[s][r]);
    }
    for (int i = gt; i < S5G * S5P; i += NGT) {
        const float lr = (F.a->in[12])[i], li = (F.a->in[13])[i], dt = expf((F.a->in[14])[i >> 6]);
        const float mag = expf(lr * dt); float sn, cs; sincosf(li * dt, &sn, &cs);
        const float lbr = mag * cs, lbi = mag * sn, den = lr * lr + li * li;
        const float cfr = ((lbr - 1.0f) * lr + lbi * li) / den, cfi = (lbi * lr - (lbr - 1.0f) * li) / den;
        WSP(float, WS_S5LB)[2 * i] = lbr; WSP(float, WS_S5LB)[2 * i + 1] = lbi;
        for (int hh = 0; hh < 16; ++hh) { const float br = (F.a->in[15])[i * 16 + hh], bi = (F.a->in[16])[i * 16 + hh];
            WSP(float, WS_S5BB)[i * 32 + hh] = cfr * br - cfi * bi; WSP(float, WS_S5BB)[i * 32 + 16 + hh] = cfr * bi + cfi * br; }
    }
    for (int i = gt; i < MTOK; i += NGT) WSP(float, WS_ROWSTAT)[i] = 0.f;
}

__device__ __forceinline__ void p1_phase(Frame& F) {
    const int f_tid = threadIdx.x, f_lane = f_tid & 63, f_wave = __builtin_amdgcn_readfirstlane(f_tid >> 6);
    const int gw = F.vcu * NWAVES + f_wave;
    LAS float* wdt = (LAS float*)F.lds;
    for (int i = f_tid; i < 16 * 1024 / 4; i += NTHR) ((LAS f32x4*)wdt)[i] = ((const f32x4*)WSP(float, WS_WDT))[i];
    __syncthreads();
    const int lane = f_lane;
    for (int wq = gw; wq < MTOK / 16; wq += F.G * NWAVES) {
        const int b = wq >> 7; const float* mb = WSP(float, WS_MOD) + (size_t)b * 6144;
        f32x4 Gv[4], Sv[4];
#pragma unroll
        for (int j = 0; j < 4; ++j) { const int k = 4 * lane + 256 * j; const f32x4 g = *(const f32x4*)((F.a->in[4]) + k), sc = *(const f32x4*)(mb + 1024 + k); Gv[j] = g * (sc + 1.0f); Sv[j] = *(const f32x4*)(mb + k); }
        f32x4 nx[4];
#pragma unroll
        for (int j = 0; j < 4; ++j) nx[j] = *(const f32x4*)((F.a->in[0]) + (size_t)wq * 16 * 1024 + 4 * lane + 256 * j);
        for (int tt = 0; tt < 16; ++tt) {
            asm volatile("" ::: "memory");
            const size_t t = (size_t)wq * 16 + tt; const float* xr = (F.a->in[0]) + t * 1024;
            f32x4 v[4]; float ss = 0.f;
#pragma unroll
            for (int j = 0; j < 4; ++j) { v[j] = nx[j]; ss += (v[j][0] * v[j][0] + v[j][1] * v[j][1]) + (v[j][2] * v[j][2] + v[j][3] * v[j][3]); }
            if (tt < 15) {
#pragma unroll
                for (int j = 0; j < 4; ++j) nx[j] = *(const f32x4*)(xr + 1024 + 4 * lane + 256 * j); }
            const float rstd = rsqrt_f(wave_sum(ss) * (1.0f / 1024.0f) + EPSF);
            bf16* hr = WSP(bf16, WS_H1) + t * 1024;
#pragma unroll
            for (int j = 0; j < 4; ++j) { v[j] = v[j] * rstd * Gv[j] + Sv[j]; v2u w; w.x = pk2(v[j][0], v[j][1]); w.y = pk2(v[j][2], v[j][3]); *(v2u*)(hr + 4 * lane + 256 * j) = w; }
            float d[16];
#pragma unroll
            for (int h = 0; h < 16; ++h) { float a = 0.f;
#pragma unroll
                for (int j = 0; j < 4; ++j) { const f32x4 w = *(const LAS f32x4*)(wdt + h * 1024 + 4 * lane + 256 * j); a += (v[j][0] * w[0] + v[j][1] * w[1]) + (v[j][2] * w[2] + v[j][3] * w[3]); }
                d[h] = a; }
            float e8[8], e4[4], e2[2], e1;
#pragma unroll
            for (int i = 0; i < 8; ++i) { const bool up = lane & 32; const float snd = up ? d[i] : d[i + 8]; const float rcv = __shfl_xor(snd, 32); e8[i] = (up ? d[i + 8] : d[i]) + rcv; }
#pragma unroll
            for (int i = 0; i < 4; ++i) { const bool up = lane & 16; const float snd = up ? e8[i] : e8[i + 4]; const float rcv = __shfl_xor(snd, 16); e4[i] = (up ? e8[i + 4] : e8[i]) + rcv; }
#pragma unroll
            for (int i = 0; i < 2; ++i) { const bool up = lane & 8; const float snd = up ? e4[i] : e4[i + 2]; const float rcv = __shfl_xor(snd, 8); e2[i] = (up ? e4[i + 2] : e4[i]) + rcv; }
            { const bool up = lane & 4; const float snd = up ? e2[0] : e2[1]; const float rcv = __shfl_xor(snd, 4); e1 = (up ? e2[1] : e2[0]) + rcv; }
            e1 += __shfl_xor(e1, 2); e1 += __shfl_xor(e1, 1);
            const int head = ((lane >> 5) & 1) * 8 + ((lane >> 4) & 1) * 4 + ((lane >> 3) & 1) * 2 + ((lane >> 2) & 1);
            if ((lane & 3) == 0) WSP(float, WS_DTRAW)[t * 16 + head] = e1;
        }
    }
    for (int n = gw; n < 2048; n += F.G * NWAVES) {
        const bf16* wr = WSP(bf16, WS_WQKT) + (size_t)n * 1024 + 16 * lane;
        const v4u w0 = *(const v4u*)wr, w1 = *(const v4u*)(wr + 8);
        float wv[16]; wv[0] = bflo(w0.x); wv[1] = bfhi(w0.x); wv[2] = bflo(w0.y); wv[3] = bfhi(w0.y); wv[4] = bflo(w0.z); wv[5] = bfhi(w0.z); wv[6] = bflo(w0.w); wv[7] = bfhi(w0.w);
        wv[8] = bflo(w1.x); wv[9] = bfhi(w1.x); wv[10] = bflo(w1.y); wv[11] = bfhi(w1.y); wv[12] = bflo(w1.z); wv[13] = bfhi(w1.z); wv[14] = bflo(w1.w); wv[15] = bfhi(w1.w);
        for (int b = 0; b < 16; ++b) { const float* sp = WSP(float, WS_MOD) + (size_t)b * 6144 + 3072 + 16 * lane; float a = 0.f;
#pragma unroll
            for (int q = 0; q < 4; ++q) { const f32x4 s = *(const f32x4*)(sp + 4 * q); a += (s[0] * wv[4 * q] + s[1] * wv[4 * q + 1]) + (s[2] * wv[4 * q + 2] + s[3] * wv[4 * q + 3]); }
            a = wave_sum(a); if (lane == 0) WSP(float, WS_SB)[b * 2048 + n] = a; }
    }
}
__device__ __forceinline__ void p3pre_conv(Frame& F) {
    const int tid = threadIdx.x;
    const bf16* proj = WSP(bf16, WS_PROJ); bf16* xo = (bf16*)F.out;
    for (int item = F.vcu * NTHR + tid; item < (MTOK / 16) * 256; item += F.G * NTHR) {
        const int oc = item & 255, run = item >> 8; const int t0 = run * 16, ch = 8 * oc;
        const bool halo = (t0 & (SEQ - 1)) != 0;
        v4u rw[19];
#pragma unroll
        for (int k = 0; k < 19; ++k) { rw[k] = (v4u){0u, 0u, 0u, 0u}; if (k >= 3 || halo) rw[k] = *(const v4u*)(proj + (size_t)(t0 - 3 + k) * NPROJ + 1024 + ch); }
        float cw[4][8], cbv[8];
#pragma unroll
        for (int k = 0; k < 4; ++k) { const f32x4 w0 = *(const f32x4*)((F.a->in[6]) + k * 2048 + ch), w1 = *(const f32x4*)((F.a->in[6]) + k * 2048 + ch + 4);
#pragma unroll
            for (int e = 0; e < 4; ++e) { cw[k][e] = w0[e]; cw[k][4 + e] = w1[e]; } }
        { const f32x4 b0 = *(const f32x4*)((F.a->in[7]) + ch), b1 = *(const f32x4*)((F.a->in[7]) + ch + 4);
#pragma unroll
            for (int e = 0; e < 4; ++e) { cbv[e] = b0[e]; cbv[4 + e] = b1[e]; } }
        float r0[8], r1[8], r2[8];
        unpack8(rw[0], r0); unpack8(rw[1], r1); unpack8(rw[2], r2);
#pragma unroll
        for (int tt = 0; tt < 16; ++tt) {
            float r3[8]; unpack8(rw[3 + tt], r3);
            float v[8];
#pragma unroll
            for (int i = 0; i < 8; ++i) { v[i] = silu_f(cbv[i] + r0[i] * cw[0][i] + r1[i] * cw[1][i] + r2[i] * cw[2][i] + r3[i] * cw[3][i]); r0[i] = r1[i]; r1[i] = r2[i]; r2[i] = r3[i]; }
            *(v4u*)(xo + (size_t)(t0 + tt) * 2048 + ch) = (v4u){pk2(v[0], v[1]), pk2(v[2], v[3]), pk2(v[4], v[5]), pk2(v[6], v[7])};
        }
    }
}
constexpr int SSD_PITCH = 272;
__device__ __forceinline__ bf16x8 lds_frag(LAS unsigned char* base, int row, int kbyte) { return *(const LAS bf16x8*)(base + row * SSD_PITCH + kbyte); }
#ifdef PROBE_SSD
#define SPR_T(v) const unsigned long long v = __builtin_amdgcn_s_memtime();
#define SPR_ACC(i, d) sacc[i] += (d);
#else
#define SPR_T(v)
#define SPR_ACC(i, d)
#endif
constexpr int S3_CS = 0, S3_BS = 34816, S3_GY = 69632, S3_XDT = 104448, S3_XP = 144, S3_PREV = 122880, S3_CSF = 140288, S3_DTF = 141312, S3_WTS = 142336, S3_END = 143360;
static_assert(S3_END <= LDS_MAIN, "SSD v3 LDS map");
typedef short v4i16_t __attribute__((ext_vector_type(4)));
__device__ __forceinline__ bf16x8 lds_frag_tr(LAS unsigned char* tile, int pitch, int k0, int col0, int li, int lq) {
    LAS unsigned char* p = tile + (k0 + 8 * lq + (li >> 2)) * pitch + (col0 + 4 * (li & 3)) * 2;
    const v4i16_t lo = __builtin_amdgcn_ds_read_tr16_b64_v4i16((LAS v4i16_t*)p), hi = __builtin_amdgcn_ds_read_tr16_b64_v4i16((LAS v4i16_t*)(p + 4 * pitch));
    return __builtin_shufflevector(lo, hi, 0, 1, 2, 3, 4, 5, 6, 7);
}
struct Ssd3Pre { v4u xr[4], br[4], cr[4]; float d0, d1; };
__device__ __forceinline__ void ssd3_prefetch(Ssd3Pre& P, const char* xcb, const float* dtr, unsigned voB, unsigned voX, int tid, int lane, int w) {
#pragma unroll
    for (int r = 0; r < 4; ++r) { P.br[r] = *(const v4u*)(xcb + (voB + r * 4096u)); P.cr[r] = *(const v4u*)(xcb + (voB + 1024u + r * 4096u)); }
#pragma unroll
    for (int r = 0; r < 4; ++r) P.xr[r] = *(const v4u*)(xcb + (voX + r * 4096u));
    P.d0 = dtr[lane * 32]; P.d1 = dtr[lane * 32 + 16];
}
__device__ __forceinline__ void ssd3_cumsum(LAS unsigned char* L, int par, float r0, float r1, float dtb, float A, int lane) {
    LAS float* csf = (LAS float*)(L + S3_CSF + par * 512); LAS float* dtf = (LAS float*)(L + S3_DTF + par * 512); LAS float* wts = (LAS float*)(L + S3_WTS + par * 512);
    const float d0 = softplus_f(r0 + dtb), d1 = softplus_f(r1 + dtb);
    const float a0 = d0 * A, a1 = d1 * A; float s = a0 + a1;
#pragma unroll
    for (int o = 1; o < 64; o <<= 1) { const float t = __shfl_up(s, o); if (lane >= o) s += t; }
    const float tot = __shfl(s, 63);
    dtf[2 * lane] = d0; dtf[2 * lane + 1] = d1; csf[2 * lane] = s - a1; csf[2 * lane + 1] = s;
    wts[2 * lane] = __expf(tot - (s - a1)); wts[2 * lane + 1] = __expf(tot - s);
}
__device__ __forceinline__ void p3_ssd3(Frame& F) {
    const int tid0 = threadIdx.x, w = __builtin_amdgcn_readfirstlane(tid0 >> 6);
    LAS unsigned char* L = F.lds;
    const bf16* proj = WSP(bf16, WS_PROJ); const bf16* xc = (const bf16*)F.out; const float* dtraw = WSP(float, WS_DTRAW);
    for (int item = F.vcu; item < NB * NHEADS; item += F.G) {
        const int b = item >> 4, h = item & 15, g = h >> 2;
        int tid = tid0; asm volatile("" : "+v"(tid)); int lane = tid & 63;
        const float A = -__expf((F.a->in[9])[h]), Dh = (F.a->in[10])[h], dtb = (F.a->in[8])[h];
        const int pbs = w >> 1, nb0 = 4 * (w & 1);
        f32x4 st[4];
#pragma unroll
        for (int j = 0; j < 4; ++j) st[j] = (f32x4){0.f, 0.f, 0.f, 0.f};
        __syncthreads();
        for (int i = tid; i < 17408 / 16; i += NTHR) ((LAS v4u*)(L + S3_PREV))[i] = (v4u){0u, 0u, 0u, 0u};
        Ssd3Pre P;
        { const unsigned voB0 = (unsigned)((4 * (tid >> 4)) * 2048 + 1024 + g * 128 + 8 * (tid & 15)) * 2u, voX0 = (unsigned)((4 * ((tid & 255) >> 3)) * 2048 + h * 64 + 8 * (tid & 7)) * 2u;
          ssd3_prefetch(P, (const char*)xc + (size_t)b * SEQ * 4096, dtraw + (size_t)b * SEQ * 16 + h, voB0, voX0, tid, lane, w); }
        if (w == 0) ssd3_cumsum(L, 0, P.d0, P.d1, dtb, A, lane);
        __syncthreads();
#ifdef PROBE_SSD
        unsigned long long sacc[8] = {0, 0, 0, 0, 0, 0, 0, 0};
#endif
        for (int c = 0; c < SEQ / CHUNK; ++c) {
            SPR_T(s0)
            const size_t row0 = (size_t)b * SEQ + (size_t)c * CHUNK; const int par = c & 1;
            asm volatile("" : "+v"(tid));
            lane = tid & 63; const int li = lane & 15, lq = lane >> 4;
            const unsigned voB = (unsigned)((4 * (tid >> 4)) * 2048 + 1024 + g * 128 + 8 * (tid & 15)) * 2u, voX = (unsigned)((4 * ((tid & 255) >> 3)) * 2048 + h * 64 + 8 * (tid & 7)) * 2u;
            const unsigned voZ0 = (unsigned)((tid >> 3) * NPROJ + h * 64 + 8 * (tid & 7)) * 2u, voZ1 = voZ0 + 64u * NPROJ * 2u;
            LAS float* csf = (LAS float*)(L + S3_CSF + par * 512); LAS float* dtf = (LAS float*)(L + S3_DTF + par * 512); LAS float* wts = (LAS float*)(L + S3_WTS + par * 512);
            { const int ob = tid & 15, lb = 4 * (tid >> 4), n0 = 8 * ob;
#pragma unroll
              for (int r = 0; r < 4; ++r) { *(LAS v4u*)(L + S3_BS + (lb + r) * SSD_PITCH + n0 * 2) = P.br[r]; *(LAS v4u*)(L + S3_CS + (lb + r) * SSD_PITCH + n0 * 2) = P.cr[r]; } }
            if (tid < 256) { const int ox = tid & 7, lx = 4 * (tid >> 3), p0 = 8 * ox;
#pragma unroll
              for (int r = 0; r < 4; ++r) { float xv[8]; unpack8(P.xr[r], xv); const float tw = dtf[lx + r];
                  *(LAS v4u*)(L + S3_XDT + (lx + r) * S3_XP + p0 * 2) = (v4u){pk2(xv[0] * tw, xv[1] * tw), pk2(xv[2] * tw, xv[3] * tw), pk2(xv[4] * tw, xv[5] * tw), pk2(xv[6] * tw, xv[7] * tw)}; } }
            const char* prb = (const char*)proj + row0 * (NPROJ * 2);
            const v4u zc0 = *(const v4u*)(prb + voZ0), zc1 = *(const v4u*)(prb + voZ1);
            SPR_T(s1) SPR_ACC(0, s1 - s0)
            LDS_BARRIER();
            SPR_T(s2) SPR_ACC(1, s2 - s1)
            const float cs_end = csf[127];
            bf16x8 ca[4];
#pragma unroll
            for (int ks = 0; ks < 4; ++ks) ca[ks] = lds_frag(L + S3_CS, 16 * w + li, 64 * ks + 16 * lq);
            float csl[4];
#pragma unroll
            for (int r = 0; r < 4; ++r) csl[r] = csf[16 * w + 4 * lq + r];
            { bf16x8 bq[2][4];
#pragma unroll
              for (int ks = 0; ks < 4; ++ks) bq[0][ks] = lds_frag(L + S3_BS, li, 64 * ks + 16 * lq);
#pragma unroll
              for (int sb = 0; sb < 8; ++sb) if (sb <= (w | 1)) {
                  f32x4 cbv = (f32x4){0.f, 0.f, 0.f, 0.f};
                  const int s = 16 * sb + li; const float css = csf[s];
                  if (sb <= w) {
                      if (sb + 1 <= w) {
#pragma unroll
                          for (int ks = 0; ks < 4; ++ks) bq[(sb + 1) & 1][ks] = lds_frag(L + S3_BS, 16 * (sb + 1) + li, 64 * ks + 16 * lq); }
                      __builtin_amdgcn_sched_barrier(0);
#pragma unroll
                      for (int ks = 0; ks < 4; ++ks) cbv = __builtin_amdgcn_mfma_f32_16x16x32_bf16(ca[ks], bq[sb & 1][ks], cbv, 0, 0, 0);
                      __builtin_amdgcn_sched_barrier(0); }
#pragma unroll
                  for (int r = 0; r < 4; ++r) { const int l = 16 * w + 4 * lq + r; const float gv = (s <= l) ? cbv[r] * __expf(csl[r] - css) : 0.f;
                      *(LAS unsigned short*)(L + S3_GY + l * SSD_PITCH + s * 2) = (unsigned short)f2bf(gv); } } }
            LDS_WAIT(); asm volatile("" ::: "memory");
            SPR_T(s3) SPR_ACC(2, s3 - s2)
            f32x4 yd[4], yo[4];
#pragma unroll
            for (int pb = 0; pb < 4; ++pb) { yd[pb] = (f32x4){0.f, 0.f, 0.f, 0.f}; yo[pb] = (f32x4){0.f, 0.f, 0.f, 0.f}; }
            { bf16x8 gq[2], xq[2][4];
              gq[0] = lds_frag(L + S3_GY, 16 * w + li, 16 * lq);
#pragma unroll
              for (int pb = 0; pb < 4; ++pb) xq[0][pb] = lds_frag_tr(L + S3_XDT, S3_XP, 0, 16 * pb, li, lq);
#pragma unroll
              for (int ks = 0; ks < 4; ++ks) if (ks <= (w >> 1)) {
                  if (ks + 1 <= (w >> 1)) { gq[(ks + 1) & 1] = lds_frag(L + S3_GY, 16 * w + li, 64 * (ks + 1) + 16 * lq);
#pragma unroll
                      for (int pb = 0; pb < 4; ++pb) xq[(ks + 1) & 1][pb] = lds_frag_tr(L + S3_XDT, S3_XP, 32 * (ks + 1), 16 * pb, li, lq); }
                  __builtin_amdgcn_sched_barrier(0);
#pragma unroll
                  for (int pb = 0; pb < 4; ++pb) yd[pb] = __builtin_amdgcn_mfma_f32_16x16x32_bf16(gq[ks & 1], xq[ks & 1][pb], yd[pb], 0, 0, 0);
                  __builtin_amdgcn_sched_barrier(0); } }
            { bf16x8 pq[2][4];
#pragma unroll
              for (int pb = 0; pb < 4; ++pb) pq[0][pb] = lds_frag(L + S3_PREV, 16 * pb + li, 16 * lq);
#pragma unroll
              for (int ks = 0; ks < 4; ++ks) {
                  if (ks < 3) {
#pragma unroll
                      for (int pb = 0; pb < 4; ++pb) pq[(ks + 1) & 1][pb] = lds_frag(L + S3_PREV, 16 * pb + li, 64 * (ks + 1) + 16 * lq); }
                  __builtin_amdgcn_sched_barrier(0);
#pragma unroll
                  for (int pb = 0; pb < 4; ++pb) yo[pb] = __builtin_amdgcn_mfma_f32_16x16x32_bf16(ca[ks], pq[ks & 1][pb], yo[pb], 0, 0, 0);
                  __builtin_amdgcn_sched_barrier(0); } }
#pragma unroll
            for (int r = 0; r < 4; ++r) { const float e = __expf(csl[r]);
#pragma unroll
                for (int pb = 0; pb < 4; ++pb) *(LAS float*)(L + S3_GY + (16 * w + 4 * lq + r) * SSD_PITCH + (16 * pb + li) * 4) = yd[pb][r] + e * yo[pb][r]; }
            { const size_t rown = row0 + (c + 1 < SEQ / CHUNK ? CHUNK : 0);
              ssd3_prefetch(P, (const char*)xc + rown * 4096, dtraw + rown * 16 + h, voB, voX, tid, lane, w); }
            SPR_T(s4) SPR_ACC(3, s4 - s3)
            LDS_BARRIER();
            SPR_T(s5) SPR_ACC(4, s5 - s4)
            { const float dec = __expf(cs_end);
#pragma unroll
              for (int j = 0; j < 4; ++j) st[j] = st[j] * dec;
              bf16x8 xq[2], bq2[2][4]; f32x4 wq[2][2];
              xq[0] = lds_frag_tr(L + S3_XDT, S3_XP, 0, 16 * pbs, li, lq); wq[0][0] = *(const LAS f32x4*)(wts + 8 * lq); wq[0][1] = *(const LAS f32x4*)(wts + 8 * lq + 4);
#pragma unroll
              for (int j = 0; j < 4; ++j) bq2[0][j] = lds_frag_tr(L + S3_BS, SSD_PITCH, 0, 16 * (nb0 + j), li, lq);
#pragma unroll
              for (int ks = 0; ks < 4; ++ks) {
                  if (ks < 3) { xq[(ks + 1) & 1] = lds_frag_tr(L + S3_XDT, S3_XP, 32 * (ks + 1), 16 * pbs, li, lq); wq[(ks + 1) & 1][0] = *(const LAS f32x4*)(wts + 32 * (ks + 1) + 8 * lq); wq[(ks + 1) & 1][1] = *(const LAS f32x4*)(wts + 32 * (ks + 1) + 8 * lq + 4);
#pragma unroll
                      for (int j = 0; j < 4; ++j) bq2[(ks + 1) & 1][j] = lds_frag_tr(L + S3_BS, SSD_PITCH, 32 * (ks + 1), 16 * (nb0 + j), li, lq); }
                  __builtin_amdgcn_sched_barrier(0);
                  const f32x4 w0 = wq[ks & 1][0], w1 = wq[ks & 1][1];
                  float xv[8]; unpack8(__builtin_bit_cast(v4u, xq[ks & 1]), xv);
                  const v4u xw = (v4u){pk2(xv[0] * w0[0], xv[1] * w0[1]), pk2(xv[2] * w0[2], xv[3] * w0[3]), pk2(xv[4] * w1[0], xv[5] * w1[1]), pk2(xv[6] * w1[2], xv[7] * w1[3])};
                  const bf16x8 xf = __builtin_bit_cast(bf16x8, xw);
#pragma unroll
                  for (int j = 0; j < 4; ++j) st[j] = __builtin_amdgcn_mfma_f32_16x16x32_bf16(xf, bq2[ks & 1][j], st[j], 0, 0, 0);
                  __builtin_amdgcn_sched_barrier(0); }
#pragma unroll
              for (int j = 0; j < 4; ++j)
#pragma unroll
                  for (int r = 0; r < 4; ++r) *(LAS unsigned short*)(L + S3_PREV + (16 * pbs + 4 * lq + r) * SSD_PITCH + (16 * (nb0 + j) + li) * 2) = (unsigned short)f2bf(st[j][r]); }
            SPR_T(s6) SPR_ACC(5, s6 - s5)
#pragma unroll
            for (int k = 0; k < 2; ++k) { const int it = tid + 512 * k, l = it >> 3, o = it & 7; const size_t row = row0 + l;
                const f32x4 y0 = *(const LAS f32x4*)(L + S3_GY + l * SSD_PITCH + 32 * o), y1 = *(const LAS f32x4*)(L + S3_GY + l * SSD_PITCH + 32 * o + 16);
                const v4u xw = *(const LAS v4u*)(L + S3_XDT + l * S3_XP + 16 * o); const v4u zw = k == 0 ? zc0 : zc1; const float dsk = Dh * __builtin_amdgcn_rcpf(fmaxf(dtf[l], 1e-30f));
                float xv[8], zv[8], yv[8]; unpack8(xw, xv); unpack8(zw, zv);
                float ss = 0.f;
#pragma unroll
                for (int e = 0; e < 8; ++e) { const float yy = (e < 4 ? y0[e] : y1[e - 4]) + dsk * xv[e]; yv[e] = yy * silu_f(zv[e]); ss += yv[e] * yv[e]; }
                ss += __shfl_xor(ss, 1); ss += __shfl_xor(ss, 2); ss += __shfl_xor(ss, 4);
                if (o == 0) WSP(float, WS_STSSD)[row * 16 + h] = ss;
                *(v4u*)(WSP(bf16, WS_Y) + row * 2048 + h * 64 + 8 * o) = (v4u){pk2(yv[0], yv[1]), pk2(yv[2], yv[3]), pk2(yv[4], yv[5]), pk2(yv[6], yv[7])}; }
            if (w == 0 && c + 1 < SEQ / CHUNK) ssd3_cumsum(L, par ^ 1, P.d0, P.d1, dtb, A, lane);
            SPR_T(s7) SPR_ACC(6, s7 - s6)
            LDS_BARRIER();
            SPR_T(s8) SPR_ACC(7, s8 - s7)
        }
#ifdef PROBE_SSD
        if (blockIdx.x == 0 && threadIdx.x == PROBE_TID) *(volatile float*)(F.ws + WS_CTL + 40000) = (float)sacc[PROBE_SSD] * 1e-3f;
#endif
    }
}
typedef float f32x16 __attribute__((ext_vector_type(16)));
#ifdef PROBE_SEL
#define PR_T(v) const unsigned long long v = __builtin_amdgcn_s_memtime();
#define PR_ACC(a, d) a += (d);
#define PR_OUT(i, a) if (PROBE_SEL == (i) && blockIdx.x == 0 && threadIdx.x == 0) *(volatile float*)(F.ws + WS_CTL + 40000) = (float)(a) * 1e-4f;
#define PR_OUT4(i, a) if (PROBE_SEL == (i) && blockIdx.x == 0 && threadIdx.x == 256) *(volatile float*)(F.ws + WS_CTL + 40000) = (float)(a) * 1e-4f;
#else
#define PR_T(v)
#define PR_ACC(a, d)
#define PR_OUT(i, a)
#define PR_OUT4(i, a)
#endif
constexpr int S5V_BU = 0, S5V_BUP = 2056, S5V_BUSZ = 16 * S5V_BUP, S5V_XT = 2 * S5V_BUSZ, S5V_XTP = 1040, S5V_XTSZ = 16 * S5V_XTP, S5V_VS = S5V_XT + 2 * S5V_XTSZ, S5V_OT = S5V_VS + 4 * 512, S5V_OTP = 144, S5V_OTSZ = 16 * S5V_OTP, S5V_END = S5V_OT + 2 * S5V_OTSZ;
static_assert(S5V_END <= LDS_MAIN, "S5 v2 LDS map");
__device__ __forceinline__ void p3_s5v2(Frame& F) {
    const int tid = threadIdx.x, lane = tid & 63, w = __builtin_amdgcn_readfirstlane(tid >> 6);
    const int li = lane & 15, lq = lane >> 4;
    LAS unsigned char* L = F.lds;
    const bf16* proj = WSP(bf16, WS_PROJ);
    constexpr int NT = SEQ / 16;
#ifdef PROBE_S5
    const unsigned long long pr_t0 = PROBE_CLOCK();
#endif
    for (int item = F.vcu; item < NB * 16; item += F.G) {
        const int b = item >> 4, gs = item & 15;
        const bool scanw = w < 4; const int gl = w & 3, g = gs * 4 + gl;
        const bf16* ubase = proj + (size_t)b * SEQ * NPROJ + 3072 + gs * 64 + gl * 16;
        __syncthreads();
        if (scanw) {
            __builtin_amdgcn_s_setprio(2);
            const float lbr = WSP(float, WS_S5LB)[(g * 64 + lane) * 2], lbi = WSP(float, WS_S5LB)[(g * 64 + lane) * 2 + 1], nlbi = -lbi;
            bf16x8 bfr[8];
#pragma unroll
            for (int cb = 0; cb < 8; ++cb) { v4u v = (v4u){0u, 0u, 0u, 0u};
                if (lq < 2) { const int col = 16 * cb + li; const float* src = WSP(float, WS_S5BB) + (g * 64 + (col >> 1)) * 32 + (col & 1) * 16 + 8 * lq; const f32x4 a0 = *(const f32x4*)src, a1 = *(const f32x4*)(src + 4);
                    v = (v4u){pk2(a0[0], a0[1]), pk2(a0[2], a0[3]), pk2(a1[0], a1[1]), pk2(a1[2], a1[3])}; }
                bfr[cb] = __builtin_bit_cast(bf16x8, v); }
            float xr = 0.f, xi = 0.f;
            const int lq2 = lq & 1;
            v4u ua = *(const v4u*)(ubase + (size_t)li * NPROJ + 8 * lq2);
            { const bf16x8 af = __builtin_bit_cast(bf16x8, lq < 2 ? ua : (v4u){0u, 0u, 0u, 0u});
              ua = *(const v4u*)(ubase + (size_t)(16 + li) * NPROJ + 8 * lq2);
#pragma unroll
              for (int cb = 0; cb < 8; ++cb) { f32x4 acc = (f32x4){0.f, 0.f, 0.f, 0.f}; acc = __builtin_amdgcn_mfma_f32_16x16x32_bf16(af, bfr[cb], acc, 0, 0, 0);
#pragma unroll
                  for (int r = 0; r < 4; ++r) *(LAS float*)(L + S5V_BU + (4 * lq + r) * S5V_BUP + (gl * 128 + 16 * cb + li) * 4) = acc[r]; } }
            LDS_BARRIER();
            unsigned long long pa0 = 0, pa1 = 0, pa2 = 0;
            for (int k = 0; k <= NT; ++k) {
                PR_T(pt0)
                if (k < NT) {
                    const LAS f32x2* bp = (const LAS f32x2*)(L + S5V_BU + (k & 1) * S5V_BUSZ + (gl * 128 + 2 * lane) * 4);
                    LAS unsigned* xp = (LAS unsigned*)(L + S5V_XT + (k & 1) * S5V_XTSZ + (gl * 128 + 2 * lane) * 2);
                    f32x2 bu[16];
#pragma unroll
                    for (int t = 0; t < 16; ++t) bu[t] = bp[t * (S5V_BUP / 8)];
                    unsigned xo[16];
#pragma unroll
                    for (int t = 0; t < 16; ++t) {
                        const float a = __builtin_fmaf(nlbi, xi, bu[t][0]), bq = __builtin_fmaf(lbi, xr, bu[t][1]);
                        const float nr = __builtin_fmaf(lbr, xr, a), ni = __builtin_fmaf(lbr, xi, bq); xr = nr; xi = ni; xo[t] = pk2(xr, xi); }
#pragma unroll
                    for (int t = 0; t < 16; ++t) xp[t * (S5V_XTP / 4)] = xo[t];
                    PR_T(pt1) PR_ACC(pa0, pt1 - pt0)
                    if (k + 1 < NT) {
                        const bf16x8 af = __builtin_bit_cast(bf16x8, lq < 2 ? ua : (v4u){0u, 0u, 0u, 0u});
                        { const int kn = k + 2 < NT ? k + 2 : NT - 1; ua = *(const v4u*)(ubase + (size_t)(16 * kn + li) * NPROJ + 8 * lq2); }
                        LAS unsigned char* bun = L + S5V_BU + ((k + 1) & 1) * S5V_BUSZ;
#pragma unroll
                        for (int cb = 0; cb < 8; ++cb) { f32x4 acc = (f32x4){0.f, 0.f, 0.f, 0.f}; acc = __builtin_amdgcn_mfma_f32_16x16x32_bf16(af, bfr[cb], acc, 0, 0, 0);
#pragma unroll
                            for (int r = 0; r < 4; ++r) *(LAS float*)(bun + (4 * lq + r) * S5V_BUP + (gl * 128 + 16 * cb + li) * 4) = acc[r]; }
                    }
                }
                PR_T(pt2) PR_ACC(pa1, pt2 - pt0)
                LDS_BARRIER();
                PR_T(pt3) PR_ACC(pa2, pt3 - pt2)
            }
            __builtin_amdgcn_s_setprio(0);
            PR_OUT(0, pa0) PR_OUT(1, pa1) PR_OUT(2, pa2)
        } else {
            bf16x8 cfr[4];
#pragma unroll
            for (int ks = 0; ks < 4; ++ks) { const float* cr = (F.a->in[17]) + (g * 16 + li) * 64 + 16 * ks + 4 * lq; const float* ci = (F.a->in[18]) + (g * 16 + li) * 64 + 16 * ks + 4 * lq;
                const f32x4 r0 = *(const f32x4*)cr, i0 = *(const f32x4*)ci;
                cfr[ks] = __builtin_bit_cast(bf16x8, ((v4u){pk2(r0[0], -i0[0]), pk2(r0[1], -i0[1]), pk2(r0[2], -i0[2]), pk2(r0[3], -i0[3])})); }
            v4u gwv = (v4u){0u, 0u, 0u, 0u};
            if (lq < 2) { float gwf[8];
#pragma unroll
                for (int j = 0; j < 8; ++j) gwf[j] = (F.a->in[20])[(g * 16 + 8 * lq + j) * 16 + li];
                gwv = (v4u){pk2(gwf[0], gwf[1]), pk2(gwf[2], gwf[3]), pk2(gwf[4], gwf[5]), pk2(gwf[6], gwf[7])}; }
            const bf16x8 gfr = __builtin_bit_cast(bf16x8, gwv);
            const float dsk = (F.a->in[19])[g * 16 + li], gbias = (F.a->in[21])[g * 16 + li];
            LAS unsigned char* vs = L + S5V_VS + gl * 512;
            float uo[4], un[4];
#pragma unroll
            for (int r = 0; r < 4; ++r) { uo[r] = bf2f(ubase[(size_t)(4 * lq + r) * NPROJ + li]); un[r] = bf2f(ubase[(size_t)(16 + 4 * lq + r) * NPROJ + li]); }
            LDS_BARRIER();
            unsigned long long pb0 = 0, pb1 = 0;
            for (int k = 0; k <= NT; ++k) {
                PR_T(qt0)
                float u2[4];
                { const int kn = k + 1 < NT ? k + 1 : NT - 1;
#pragma unroll
                  for (int r = 0; r < 4; ++r) u2[r] = bf2f(ubase[(size_t)(16 * kn + 4 * lq + r) * NPROJ + li]); }
                if (k >= 2) {
                    const int t = ((tid - 256) >> 3) & 15, oc = tid & 7; const v4u ov = *(const LAS v4u*)(L + S5V_OT + (k & 1) * S5V_OTSZ + t * S5V_OTP + 16 * oc);
                    if (tid < 384) *(v4u*)(WSP(bf16, WS_Y) + ((size_t)b * SEQ + 16 * (k - 2) + t) * 2048 + 1024 + gs * 64 + 8 * oc) = ov; }
                if (k >= 1) {
                    const int kt = k - 1; const LAS unsigned char* xt = L + S5V_XT + (kt & 1) * S5V_XTSZ;
                    f32x4 yacc = (f32x4){0.f, 0.f, 0.f, 0.f};
#pragma unroll
                    for (int ks = 0; ks < 4; ++ks) yacc = __builtin_amdgcn_mfma_f32_16x16x32_bf16(*(const LAS bf16x8*)(xt + li * S5V_XTP + (gl * 128 + 32 * ks + 8 * lq) * 2), cfr[ks], yacc, 0, 0, 0);
                    float v[4];
                    { const f32x2 g0 = gelu_pk2((f32x2){yacc[0] + dsk * uo[0], yacc[1] + dsk * uo[1]}), g1 = gelu_pk2((f32x2){yacc[2] + dsk * uo[2], yacc[3] + dsk * uo[3]}); v[0] = g0[0]; v[1] = g0[1]; v[2] = g1[0]; v[3] = g1[1]; }
#pragma unroll
                    for (int r = 0; r < 4; ++r) *(LAS unsigned short*)(vs + (4 * lq + r) * 32 + li * 2) = (unsigned short)f2bf(v[r]);
                    LDS_WAIT(); asm volatile("" ::: "memory");
                    v4u va = (v4u){0u, 0u, 0u, 0u};
                    if (lq < 2) va = *(const LAS v4u*)(vs + li * 32 + 16 * lq);
                    f32x4 gacc = (f32x4){0.f, 0.f, 0.f, 0.f};
                    gacc = __builtin_amdgcn_mfma_f32_16x16x32_bf16(__builtin_bit_cast(bf16x8, va), gfr, gacc, 0, 0, 0);
                    float o[4], ss[4];
#pragma unroll
                    for (int r = 0; r < 4; ++r) { o[r] = v[r] * sigmoid_f(gacc[r] + gbias); ss[r] = o[r] * o[r]; }
#pragma unroll
                    for (int r = 0; r < 4; ++r) ss[r] = row16_sum_to15(ss[r]);
                    if (li == 15) {
#pragma unroll
                        for (int r = 0; r < 4; ++r) WSP(float, WS_STS5)[((size_t)b * SEQ + 16 * kt + 4 * lq + r) * NS5PART + g] = ss[r]; }
                    LAS unsigned char* ot = L + S5V_OT + (kt & 1) * S5V_OTSZ;
#pragma unroll
                    for (int r = 0; r < 4; ++r) *(LAS unsigned short*)(ot + (4 * lq + r) * S5V_OTP + (gl * 16 + li) * 2) = (unsigned short)f2bf(o[r]);
#pragma unroll
                    for (int r = 0; r < 4; ++r) { uo[r] = un[r]; un[r] = u2[r]; }
                }
                PR_T(qt1) PR_ACC(pb0, qt1 - qt0)
                LDS_BARRIER();
                PR_T(qt2) PR_ACC(pb1, qt2 - qt1)
            }
            PR_OUT4(3, pb0) PR_OUT4(4, pb1)
            { const int t = ((tid - 256) >> 3) & 15, oc = tid & 7; const v4u ov = *(const LAS v4u*)(L + S5V_OT + ((NT - 1) & 1) * S5V_OTSZ + t * S5V_OTP + 16 * oc);
              if (tid < 384) *(v4u*)(WSP(bf16, WS_Y) + ((size_t)b * SEQ + 16 * (NT - 1) + t) * 2048 + 1024 + gs * 64 + 8 * oc) = ov; }
        }
    }
#ifdef PROBE_S5
    if (blockIdx.x == 0 && threadIdx.x == 0) *(volatile float*)(F.ws + WS_CTL + 40000) = (float)(PROBE_CLOCK() - pr_t0) * PROBE_SCALE;
#endif
}
__device__ __forceinline__ unsigned med3u(unsigned a, unsigned b, unsigned c) { unsigned r; asm("v_med3_u32 %0, %1, %2, %3" : "=v"(r) : "v"(a), "v"(b), "v"(c)); return r; }
__device__ __forceinline__ unsigned fkey(float v) { const unsigned u = __builtin_bit_cast(unsigned, v); return (u & 0x80000000u) ? ~u : (u | 0x80000000u); }
__device__ __forceinline__ float fkey_inv(unsigned k) { const unsigned u = (k & 0x80000000u) ? (k & 0x7fffffffu) : ~k; return __builtin_bit_cast(float, u); }
#define TOPK_INSERT(a, x) do { _Pragma("unroll") for (int _i = 15; _i >= 1; --_i) a[_i] = med3u(a[_i - 1], a[_i], (x)); a[0] = a[0] > (x) ? a[0] : (x); } while (0)
__device__ __forceinline__ void expert_convert(Frame& F, int w0, int nw, int f_lane) {
    for (int rw = w0; rw < 2 * 16384; rw += 2 * nw) {
        f32x4 v[2][4]; float mx[2];
#pragma unroll
        for (int u = 0; u < 2; ++u) { const int r = rw + u * nw; const int tb = r >= 16384, e = tb ? r - 16384 : r; const float* src = (tb ? (F.a->in[28]) : (F.a->in[27])) + (size_t)e * 1024 + 16 * f_lane;
#pragma unroll
            for (int q = 0; q < 4; ++q) v[u][q] = *(const f32x4*)(src + 4 * q); }
#pragma unroll
        for (int u = 0; u < 2; ++u) { float m = 0.f;
#pragma unroll
            for (int q = 0; q < 4; ++q) m = fmaxf(m, fmaxf(fmaxf(fabsf(v[u][q][0]), fabsf(v[u][q][1])), fmaxf(fabsf(v[u][q][2]), fabsf(v[u][q][3]))));
#pragma unroll
            for (int o = 1; o < 64; o <<= 1) m = fmaxf(m, __shfl_xor(m, o));
            mx[u] = fmaxf(m, 1e-30f); }
#pragma unroll
        for (int u = 0; u < 2; ++u) { const int r = rw + u * nw; const int tb = r >= 16384, e = tb ? r - 16384 : r; const float sc = 224.0f / mx[u];
            v4u w;
#pragma unroll
            for (int q = 0; q < 4; ++q) { int pk = 0; pk = __builtin_amdgcn_cvt_pk_fp8_f32(v[u][q][0] * sc, v[u][q][1] * sc, pk, false); pk = __builtin_amdgcn_cvt_pk_fp8_f32(v[u][q][2] * sc, v[u][q][3] * sc, pk, true); w[q] = (unsigned)pk; }
            *(v4u*)(F.ws + (tb ? WS_EV : WS_EU) + (size_t)e * 1024 + 16 * f_lane) = w;
            if (f_lane == 0) WSP(float, tb ? WS_EVS : WS_EUS)[e] = mx[u] * (1.0f / 224.0f); }
    }
}
__device__ __forceinline__ void p5b_topk(Frame& F) {
    const int f_tid = threadIdx.x, f_lane = f_tid & 63, f_wave = __builtin_amdgcn_readfirstlane(f_tid >> 6);
    const _Float16* scores = WSP(_Float16, WS_SCORES);
    LAS unsigned char* ix = (LAS unsigned char*)F.lds + f_tid * 36;
#pragma unroll 1
    for (int half = 0; half < 2; ++half) {
    if ((f_wave >> 2) != half) { expert_convert(F, (F.vcu * 4 + (f_wave & 3)) * 2 + half, F.G * 8, f_lane); continue; }
    for (int item = (F.vcu * 2 + half) * 256 + (f_tid & 255); item < MTOK * PH; item += F.G * 512) {
        const int t = item >> 3, hd = item & 7;
        unsigned a1[16], a2[16];
#pragma unroll
        for (int i = 0; i < 16; ++i) { a1[i] = 0u; a2[i] = 0u; }
        const _Float16* sp = scores + (size_t)t * 2048 + hd * 256;
        typedef _Float16 f16x8 __attribute__((ext_vector_type(8)));
#pragma unroll 1
        for (int m = 0; m < 2; ++m) { f16x8 sv[8];
#pragma unroll
            for (int q = 0; q < 8; ++q) sv[q] = *(const f16x8*)(sp + 64 * m + 8 * q);
#pragma unroll
            for (int q = 0; q < 8; ++q)
#pragma unroll
                for (int e = 0; e < 8; ++e) { const unsigned k = (fkey((float)sv[q][e]) & ~127u) | (unsigned)(127 - (64 * m + 8 * q + e)); TOPK_INSERT(a1, k); } }
#pragma unroll 1
        for (int m = 0; m < 2; ++m) { f16x8 sv[8];
#pragma unroll
            for (int q = 0; q < 8; ++q) sv[q] = *(const f16x8*)(sp + 128 + 64 * m + 8 * q);
#pragma unroll
            for (int q = 0; q < 8; ++q)
#pragma unroll
                for (int e = 0; e < 8; ++e) { const unsigned k = (fkey((float)sv[q][e]) & ~127u) | (unsigned)(127 - (64 * m + 8 * q + e)); TOPK_INSERT(a2, k); } }
        float v1[16], v2[16];
#pragma unroll
        for (int i = 0; i < 16; ++i) { ix[i] = (unsigned char)(127u - (a1[i] & 127u)); ix[16 + i] = (unsigned char)(127u - (a2[i] & 127u)); v1[i] = fkey_inv(a1[i] & ~127u); v2[i] = fkey_inv(a2[i] & ~127u); }
        unsigned cb[16];
#pragma unroll
        for (int i = 0; i < 16; ++i) cb[i] = 0u;
#pragma unroll
        for (int i = 0; i < 16; ++i)
#pragma unroll
            for (int j = 0; j < 16; ++j) if ((i + 1) * (j + 1) <= 16) { const unsigned k = (fkey(v1[i] + v2[j]) & ~255u) | (unsigned)(255 - (i * 16 + j)); TOPK_INSERT(cb, k); }
        float tv[16]; float mx = -3.0e38f;
#pragma unroll
        for (int k = 0; k < 16; ++k) { tv[k] = fkey_inv(cb[k] & ~255u); mx = fmaxf(mx, tv[k]); }
        float sum = 0.f;
#pragma unroll
        for (int k = 0; k < 16; ++k) { tv[k] = __expf(tv[k] - mx); sum += tv[k]; }
        const float inv = 1.0f / sum;
        LDS_WAIT(); asm volatile("" ::: "memory");
        int ev[16]; unsigned long long c64 = 0ull;
#pragma unroll
        for (int k = 0; k < 16; ++k) { const unsigned code = 255u - (cb[k] & 255u); const int i = code >> 4, j = code & 15; ev[k] = (int)ix[i] * 128 + (int)ix[16 + j]; c64 += 1ull << (8 * (ev[k] >> 11)); }
        unsigned long long s64 = c64;
#pragma unroll
        for (int o = 1; o < 8; o <<= 1) { const unsigned lo = __shfl_up((unsigned)s64, o, 8), hi = __shfl_up((unsigned)(s64 >> 32), o, 8); if ((f_lane & 7) >= o) s64 += ((unsigned long long)hi << 32) | lo; }
        const unsigned long long e64 = s64 - c64;
        const unsigned long long t64 = ((unsigned long long)__shfl((unsigned)(s64 >> 32), 7, 8) << 32) | __shfl((unsigned)s64, 7, 8);
        const unsigned long long st64 = (t64 * 0x0101010101010101ull) << 8;
        unsigned long long base64 = st64 + e64;
        int* eo = WSP(int, WS_EID) + (size_t)t * 128; float* go = WSP(float, WS_GATE) + (size_t)t * 128;
#pragma unroll
        for (int k = 0; k < 16; ++k) { const int r8 = 8 * (ev[k] >> 11); const int slot = (int)((base64 >> r8) & 255ull); base64 += 1ull << r8; eo[slot] = ev[k]; go[slot] = tv[k] * inv; }
        if (hd == 0) WSP(unsigned long long, WS_START)[t] = st64;
        LDS_WAIT(); asm volatile("" ::: "memory");
    }
    }
}
__device__ __forceinline__ void dec16(const v4u q, float* f) {
#pragma unroll
    for (int i = 0; i < 4; ++i) { const f32x2 lo = __builtin_amdgcn_cvt_pk_f32_fp8((int)q[i], false), hi = __builtin_amdgcn_cvt_pk_f32_fp8((int)q[i], true); f[4 * i] = lo[0]; f[4 * i + 1] = lo[1]; f[4 * i + 2] = hi[0]; f[4 * i + 3] = hi[1]; }
}
__device__ __forceinline__ void p9_peer_down2(Frame& F) {
    const int f_tid = threadIdx.x, lane = f_tid & 63, f_wave = __builtin_amdgcn_readfirstlane(f_tid >> 6);
    const unsigned char* EV = F.ws + WS_EV;
    for (int wq = F.vcu * NWAVES + f_wave; wq < MTOK / 16; wq += F.G * NWAVES) {
        const int b = wq >> 7; const float* mb = WSP(float, WS_MOD) + (size_t)b * 6144;
        int ne_lo = WSP(int, WS_EID)[(size_t)wq * 16 * 128 + lane], ne_hi = WSP(int, WS_EID)[(size_t)wq * 16 * 128 + 64 + lane];
        float nw_lo = WSP(float, WS_GATE)[(size_t)wq * 16 * 128 + lane], nw_hi = WSP(float, WS_GATE)[(size_t)wq * 16 * 128 + 64 + lane];
        for (int tt = 0; tt < 16; ++tt) {
            const size_t t = (size_t)wq * 16 + tt;
            unsigned l16 = 16u * (unsigned)lane; asm volatile("" : "+v"(l16));
            float* xr = (float*)((char*)(F.out + t * 1024) + 4u * l16);
            const int e_lo = ne_lo, e_hi = ne_hi; const float w_lo = nw_lo, w_hi = nw_hi;
            f32x2 o[8];
#pragma unroll
            for (int i = 0; i < 8; ++i) o[i] = (f32x2){0.f, 0.f};
            v4u qa[8], qb[8];
#pragma unroll
            for (int j = 0; j < 8; ++j) { const int e = __builtin_amdgcn_readlane(e_lo, j); qa[j] = *(const v4u*)(EV + ((unsigned)e * 1024u + l16)); }
#define DN2_STEP(GRP, CUR, NXT) { \
                const int grp = (GRP); const int nb = ((grp + 1) & 7) * 8; const int ensel = (grp + 1) < 8 ? e_lo : e_hi; \
                { _Pragma("unroll") for (int j = 0; j < 8; ++j) { const int e = __builtin_amdgcn_readlane(ensel, nb + j); NXT[j] = *(const v4u*)(EV + ((unsigned)e * 1024u + l16)); } } \
                __builtin_amdgcn_sched_barrier(0); \
                const int base = (grp & 7) * 8; const float wsel = grp < 8 ? w_lo : w_hi; \
                _Pragma("unroll") for (int j = 0; j < 8; ++j) { const float wj = __builtin_bit_cast(float, __builtin_amdgcn_readlane(__builtin_bit_cast(int, wsel), base + j)); const f32x2 w2 = (f32x2){wj, wj}; \
                    _Pragma("unroll") for (int i = 0; i < 4; ++i) { const f32x2 lo = __builtin_amdgcn_cvt_pk_f32_fp8((int)CUR[j][i], false), hi = __builtin_amdgcn_cvt_pk_f32_fp8((int)CUR[j][i], true); o[2 * i] += w2 * lo; o[2 * i + 1] += w2 * hi; } } }
#pragma unroll 1
            for (int g2 = 0; g2 < 16; g2 += 2) { DN2_STEP(g2, qa, qb) DN2_STEP(g2 + 1, qb, qa) }
#undef DN2_STEP
            { const size_t tn = t + (tt < 15 ? 1 : 0); ne_lo = WSP(int, WS_EID)[tn * 128 + lane]; ne_hi = WSP(int, WS_EID)[tn * 128 + 64 + lane]; nw_lo = WSP(float, WS_GATE)[tn * 128 + lane]; nw_hi = WSP(float, WS_GATE)[tn * 128 + 64 + lane]; }
            float x1[16]; float ss = 0.f;
#pragma unroll
            for (int q4 = 0; q4 < 4; ++q4) { const f32x4 v = *(const f32x4*)(xr + 4 * q4); x1[4 * q4] = v[0]; x1[4 * q4 + 1] = v[1]; x1[4 * q4 + 2] = v[2]; x1[4 * q4 + 3] = v[3]; }
#pragma unroll
            for (int q4 = 0; q4 < 4; ++q4) { const f32x4 gt = *(const f32x4*)((const char*)(mb + 5120) + 4u * l16 + 16 * q4);
#pragma unroll
                for (int e = 0; e < 4; ++e) { const int i = 4 * q4 + e; x1[i] += gt[e] * o[i >> 1][i & 1]; ss += x1[i] * x1[i]; } }
            const float rf = rsqrt_f(wave_sum(ss) * (1.0f / 1024.0f) + EPSF);
#pragma unroll
            for (int q4 = 0; q4 < 4; ++q4) { const f32x4 nf = *(const f32x4*)((const char*)(F.a->in[29]) + 4u * l16 + 16 * q4); f32x4 v;
#pragma unroll
                for (int e = 0; e < 4; ++e) v[e] = x1[4 * q4 + e] * rf * nf[e];
                *(f32x4*)(xr + 4 * q4) = v; }
        }
    }
}
typedef long i64_t;
constexpr int U6_ROWP = 1040, U6_BUF = 8 * U6_ROWP, U6_WAVE = 2 * U6_BUF + 1024;
static_assert(8 * U6_WAVE <= LDS_MAIN, "U6 LDS map");
__device__ __forceinline__ void p8_peer_up6(Frame& F) {
    const int f_tid = threadIdx.x, lane = f_tid & 63, f_wave = __builtin_amdgcn_readfirstlane(f_tid >> 6);
    const int li = lane & 15, lq = lane >> 4;
    const unsigned char* EU = F.ws + WS_EU; const float* EUS = WSP(float, WS_EUS); const float* EVS = WSP(float, WS_EVS);
    LAS unsigned char* ring = F.lds + f_wave * U6_WAVE; LAS unsigned char* hq = ring + 2 * U6_BUF;
    for (int wq = F.vcu * NWAVES + f_wave; wq < MTOK / 16; wq += F.G * NWAVES) {
        const int b = wq >> 7; const float* mb = WSP(float, WS_MOD) + (size_t)b * 6144;
        for (int tt = 0; tt < 16; ++tt) {
            const size_t t = (size_t)wq * 16 + tt;
            unsigned l16 = 16u * (unsigned)lane; asm volatile("" : "+v"(l16));
            const int e_lo = WSP(int, WS_EID)[t * 128 + lane], e_hi = WSP(int, WS_EID)[t * 128 + 64 + lane];
            const float g_lo = WSP(float, WS_GATE)[t * 128 + lane], g_hi = WSP(float, WS_GATE)[t * 128 + 64 + lane];
            const float rs = rsqrt_f(WSP(float, WS_ROWSTAT)[t] * (1.0f / 1024.0f) + EPSF);
            const char* xs = (const char*)(WSP(bf16, WS_X1S) + t * 1024) + 2u * l16; const v4u xa = *(const v4u*)xs, xb = *(const v4u*)(xs + 16);
            asm volatile("s_waitcnt vmcnt(0)" ::: "memory");
#pragma unroll
            for (int j = 0; j < 8; ++j) { const int e = __builtin_amdgcn_readlane(e_lo, j);
                __builtin_amdgcn_global_load_lds((const unsigned*)(EU + ((unsigned)e * 1024u + l16)), (LAS unsigned*)(ring + j * U6_ROWP), 16, 0, 0); }
            const float su_lo = EUS[e_lo], su_hi = EUS[e_hi], sv_lo = EVS[e_lo], sv_hi = EVS[e_hi];
            float h2[16]; unpack8(xa, h2); unpack8(xb, h2 + 8); float mx = 0.f;
#pragma unroll
            for (int qd = 0; qd < 4; ++qd) { const f32x4 sh = *(const f32x4*)((const char*)(mb + 3072) + 4u * l16 + 16 * qd);
#pragma unroll
                for (int e = 0; e < 4; ++e) { h2[4 * qd + e] = h2[4 * qd + e] * rs + sh[e]; mx = fmaxf(mx, fabsf(h2[4 * qd + e])); } }
#pragma unroll
            for (int o = 1; o < 64; o <<= 1) mx = fmaxf(mx, __shfl_xor(mx, o));
            mx = fmaxf(mx, 1e-30f); const float hs = 224.0f / mx, hinv = mx * (1.0f / 224.0f);
            { v4u w;
#pragma unroll
              for (int qd = 0; qd < 4; ++qd) { int pk = 0; pk = __builtin_amdgcn_cvt_pk_fp8_f32(h2[4 * qd] * hs, h2[4 * qd + 1] * hs, pk, false); pk = __builtin_amdgcn_cvt_pk_fp8_f32(h2[4 * qd + 2] * hs, h2[4 * qd + 3] * hs, pk, true); w[qd] = (unsigned)pk; }
              *(LAS v4u*)(hq + l16) = w; }
            LDS_WAIT(); asm volatile("" ::: "memory");
            v4u hb[16];
#pragma unroll
            for (int c = 0; c < 16; ++c) hb[c] = *(const LAS v4u*)(hq + 64 * c + 16 * lq);
            asm volatile("s_waitcnt vmcnt(0)" ::: "memory");
            float w_lo = 0.f, w_hi = 0.f;
#pragma unroll 1
            for (int u = 0; u < 16; ++u) {
                { const int un = (u + 1) & 15; const int ensel = un < 8 ? e_lo : e_hi; const int nb = (un & 7) * 8; LAS unsigned char* dst = ring + ((u + 1) & 1) * U6_BUF;
#pragma unroll
                  for (int j = 0; j < 8; ++j) { const int e = __builtin_amdgcn_readlane(ensel, nb + j);
                      __builtin_amdgcn_global_load_lds((const unsigned*)(EU + ((unsigned)e * 1024u + l16)), (LAS unsigned*)(dst + j * U6_ROWP), 16, 0, 0); } }
                asm volatile("s_waitcnt vmcnt(8)" ::: "memory");
                const LAS unsigned char* src = ring + (u & 1) * U6_BUF + (li & 7) * U6_ROWP + 16 * lq;
                f32x4 acc = (f32x4){0.f, 0.f, 0.f, 0.f};
#pragma unroll
                for (int c = 0; c < 16; ++c) { const v4u a = *(const LAS v4u*)(src + 64 * c);
                    acc = __builtin_amdgcn_mfma_f32_16x16x32_fp8_fp8((i64_t)(((unsigned long long)a[1] << 32) | a[0]), (i64_t)(((unsigned long long)hb[c][1] << 32) | hb[c][0]), acc, 0, 0, 0);
                    acc = __builtin_amdgcn_mfma_f32_16x16x32_fp8_fp8((i64_t)(((unsigned long long)a[3] << 32) | a[2]), (i64_t)(((unsigned long long)hb[c][3] << 32) | hb[c][2]), acc, 0, 0, 0); }
                const int base = (u & 7) * 8; const int r = li & 3;
                const float sel = r == 0 ? acc[0] : (r == 1 ? acc[1] : (r == 2 ? acc[2] : acc[3]));
                const float dmine = __shfl(sel, ((lane & 7) >> 2) * 16 + (lane & 3));
                const float gsel = u < 8 ? g_lo : g_hi, susel = u < 8 ? su_lo : su_hi, svsel = u < 8 ? sv_lo : sv_hi;
                const float wv = gsel * gelu_erf(dmine * susel * hinv) * svsel;
                const bool mine = (lane >= base) && (lane < base + 8);
                if (u < 8) w_lo = mine ? wv : w_lo; else w_hi = mine ? wv : w_hi;
                asm volatile("s_waitcnt lgkmcnt(0)" ::: "memory");
            }
            WSP(float, WS_GATE)[t * 128 + lane] = w_lo; WSP(float, WS_GATE)[t * 128 + 64 + lane] = w_hi;
        }
    }
}
constexpr int NPHASE = 10;
__global__ void __launch_bounds__(NTHR, 2) fwd_mega(Args args) {
    extern __shared__ __attribute__((aligned(16))) unsigned char lds[];
    Frame F;
    F.lds = (LAS unsigned char*)lds;
    F.MISC = (volatile LAS unsigned*)(F.lds + MISC_OFF);
    F.G = gridDim.x; { const int bx = blockIdx.x; F.vcu = (F.G % 8 == 0) ? (bx % 8) * (F.G / 8) + bx / 8 : bx; }
    F.ws = args.ws; F.out = args.out;
    F.a = &args;
    for (int u = threadIdx.x; u < 32; u += NTHR) F.MISC[u] = 0u;
    __syncthreads();
    const int lo = args.ph_lo, hi = args.ph_hi;
    const bool use_bar = (hi - lo) > 1;
    XcdBarrier bar; bar.bar = (unsigned*)(F.ws + WS_CTL); bar.x = 0; bar.st = nullptr;
    if (use_bar) bar = xcd_barrier_post((unsigned*)(F.ws + WS_CTL), F.MISC + 8);
#define IN(k) (lo <= (k) && (k) < hi)
#define SEAM(k) do { if (IN(k) && IN((k) + 1)) xcd_barrier(bar); } while (0)
#ifndef REP_PHASE
#define REP_PHASE -1
#endif
#define REPEAT(k, body) do { if (REP_PHASE == (k)) { xcd_barrier(bar); body; } } while (0)
    if (IN(0)) {
#ifndef SKIP_P0
 p0_phase(F); REPEAT(0, p0_phase(F));
#endif
 } SEAM(0);
    if (IN(1)) {
#ifndef SKIP_P1
 p1_phase(F); REPEAT(1, p1_phase(F));
#endif
 } SEAM(1);
    if (IN(2)) {
        pg8::Gemm g{WSP(bf16, WS_H1), WSP(bf16, WS_WINT), MTOK, NPROJ, 1024}; pg8::StaticOrder S; S.init(MTOK, NPROJ, F.G, (int)blockIdx.x);
        pg8::EpiProj E{WSP(bf16, WS_PROJ), NPROJ};
        pg8::gemm_phase<pg8::EpiProj, pg8::StaticOrder, true, true>(F.lds, g, S, E);
        REPEAT(2, (pg8::gemm_phase<pg8::EpiProj, pg8::StaticOrder, true, true>(F.lds, g, S, E)));
    } SEAM(2);
    if (IN(3)) {
#ifndef SKIP_SSD
 p3pre_conv(F); xcd_barrier(bar); p3_ssd3(F); REPEAT(30, p3_ssd3(F)); REPEAT(32, p3pre_conv(F));
#endif
#ifndef SKIP_S5
 p3_s5v2(F); REPEAT(31, p3_s5v2(F));
#endif
 } SEAM(3);
    if (IN(5)) {
        pg8::Gemm g{WSP(bf16, WS_Y), WSP(bf16, WS_WOUTT), MTOK, 1024, 2048}; pg8::StaticOrder S; S.init(MTOK, 1024, F.G, (int)blockIdx.x);
        PG8_LAS float* tab = (PG8_LAS float*)(F.lds + pg8::STAGE_BYTES);
        { pg8::Unit u; for (int i = 0; S.next(i, u); ++i) pg8::SegScaleHook::build(F.lds + pg8::STAGE_BYTES, u, WSP(float, WS_STSSD), WSP(float, WS_STS5), (int)threadIdx.x); }
        __syncthreads();
        pg8::EpiX1 E{(F.a->in[0]), F.out, WSP(bf16, WS_X1S), WSP(float, WS_MOD), (F.a->in[24]), WSP(float, WS_ROWSTAT), tab};
        pg8::SegScaleHook H;
        pg8::gemm_phase<pg8::EpiX1, pg8::StaticOrder, true, true, pg8::SegScaleHook>(F.lds, g, S, E, H);
    } SEAM(5);
    if (IN(6)) {
        pg8::Gemm g{WSP(bf16, WS_X1S), WSP(bf16, WS_WQKT), MTOK, 2048, 1024}; pg8::StaticOrder S; S.init(MTOK, 2048, F.G, (int)blockIdx.x);
        pg8::EpiScores E{WSP(_Float16, WS_SCORES), WSP(float, WS_SB), WSP(float, WS_ROWSTAT)};
        pg8::gemm_phase<pg8::EpiScores, pg8::StaticOrder, true, true>(F.lds, g, S, E);
        REPEAT(6, (pg8::gemm_phase<pg8::EpiScores, pg8::StaticOrder, true, true>(F.lds, g, S, E)));
    } SEAM(6);
    if (IN(7)) {
#ifndef SKIP_TOPK
 p5b_topk(F); REPEAT(7, p5b_topk(F));
#endif
 } SEAM(7);
    if (IN(8)) { p8_peer_up6(F); REPEAT(8, { p5b_topk(F); xcd_barrier(bar); p8_peer_up6(F); }); } SEAM(8);
    if (IN(9)) { p9_peer_down2(F); }
#ifdef PROBE_OUT
    if (IN(9)) { __syncthreads(); if (blockIdx.x == 0 && threadIdx.x == 0) { asm volatile("s_waitcnt vmcnt(0)" ::: "memory"); F.out[0] = *(volatile float*)(F.ws + WS_CTL + 40000); } }
#endif
#undef IN
#undef SEAM
}

#ifndef N_LAUNCHES
#define N_LAUNCHES 1
#endif
extern "C" void kernel_launch(void* const* d_in, const int* in_sizes, int n_in, void* d_out, int out_size, void* d_ws, size_t ws_size, hipStream_t stream) {
    static int grid = 0;
    if (grid == 0) {
        if (n_in != 30 || in_sizes[0] != MTOK * DM || out_size != MTOK * DM || ws_size < WS_END) { fprintf(stderr, "kernel_launch: unexpected shapes (n_in %d, in0 %d, out %d, ws %zu)\n", n_in, n_in > 0 ? in_sizes[0] : -1, out_size, ws_size); grid = -1; return; }
        int dev = 0, cus = 0, per_cu = 0;
        if (hipGetDevice(&dev) != hipSuccess || hipDeviceGetAttribute(&cus, hipDeviceAttributeMultiprocessorCount, dev) != hipSuccess) { grid = -1; return; }
        if (hipFuncSetAttribute((const void*)fwd_mega, hipFuncAttributeMaxDynamicSharedMemorySize, LDS_BYTES) != hipSuccess) { fprintf(stderr, "kernel_launch: hipFuncSetAttribute failed\n"); grid = -1; return; }
        if (hipOccupancyMaxActiveBlocksPerMultiprocessor(&per_cu, (const void*)fwd_mega, NTHR, LDS_BYTES) != hipSuccess || per_cu < 1) { fprintf(stderr, "kernel_launch: occupancy query says %d\n", per_cu); (void)hipGetLastError(); grid = -1; return; }
        if (cus != 256) { fprintf(stderr, "kernel_launch: built for a 256-CU device (got %d CUs); nothing launched\n", cus); grid = -1; return; }
        grid = cus;
    }
    if (grid < 0) return;
    (void)hipMemsetAsync((char*)d_ws + WS_CTL, 0, CTL_ZERO_BYTES, stream);
    Args a{};
    for (int i = 0; i < 30; ++i) a.in[i] = (const float*)d_in[i];
    a.out = (float*)d_out; a.ws = (unsigned char*)d_ws;
    if (N_LAUNCHES == 1) {
        a.ph_lo = 0; a.ph_hi = NPHASE;
        void* kargs[] = {&a};
#ifdef PLAIN_LAUNCH
        (void)kargs; hipLaunchKernelGGL(fwd_mega, dim3(grid), dim3(NTHR), LDS_BYTES, stream, a);
#else
        hipError_t e = hipLaunchCooperativeKernel((const void*)fwd_mega, dim3(grid), dim3(NTHR), kargs, LDS_BYTES, stream);
        if (e != hipSuccess) fprintf(stderr, "kernel_launch: cooperative launch failed: %s (grid %d)\n", hipGetErrorString(e), grid);
#endif
    } else {
        for (int p = 0; p < NPHASE; ++p) { a.ph_lo = p; a.ph_hi = p + 1; hipLaunchKernelGGL(fwd_mega, dim3(grid), dim3(NTHR), LDS_BYTES, stream, a); }
    }
}
```

```cpp
#define V6
#include <hip/hip_runtime.h>
#include <cstdio>
#include <cstdint>
namespace pg8 {
#define PG8_LAS __attribute__((address_space(3)))
typedef unsigned short bf16_t;
typedef short bf16x8 __attribute__((ext_vector_type(8)));
typedef float f32x4 __attribute__((ext_vector_type(4)));
typedef unsigned u32x4 __attribute__((ext_vector_type(4)));
constexpr int BM = 256, BK = 64, HALF = 128, HTB = HALF * BK * 2  , STAGE_BYTES = 8 * HTB, NXCD = 8, WGM = 8;

__host__ __device__ __forceinline__ int lds_byte(int r, int c) { const int st = (r >> 4) * 2 + (c >> 5), rr = r & 15, cc = c & 31, ob = rr * 64 + cc * 2; return st * 1024 + (ob ^ (((ob >> 9) & 1) << 5)); }
__host__ __device__ __forceinline__ void stage_rc(int b, int& R, int& C) { const int st = b / 1024, sb = b % 1024, swz = sb ^ (((sb >> 9) & 1) << 5); R = (st >> 1) * 16 + swz / 64; C = (st & 1) * 32 + (swz % 64) / 2; }
__host__ __device__ __forceinline__ int perm32(int rho) { const int n = rho >> 4, i = rho & 15; return 8 * (i >> 2) + 4 * n + (i & 3); }

struct Unit { int pm, pn; };
struct Gemm { const bf16_t* A; const bf16_t* Bt; int M, N, K; };

struct StaticOrder {
    int nM, nN, nwg, G, c;
    __host__ __device__ void init(int M, int N, int G_, int c_) { nM = M / BM; nN = N / BM; nwg = nM * nN; G = G_; c = c_; }
    __host__ __device__ bool next(int i, Unit& u) const {
        const long L = (long)i * G + c; if (L >= nwg) return false;
        int wgid = (int)L; { const int q = nwg / NXCD, r = nwg % NXCD, xcd = wgid % NXCD, off = wgid / NXCD; wgid = (xcd < r ? xcd * (q + 1) : r * (q + 1) + (xcd - r) * q) + off; }
        const int nig = WGM * nN, gid = wgid / nig, fm = gid * WGM, gsz = (nM - fm) < WGM ? (nM - fm) : WGM;
        u.pm = fm + ((wgid % nig) % gsz); u.pn = (wgid % nig) / gsz; return true;
    }
    __device__ __forceinline__ void a_ready(const Unit&) const {}
    __device__ __forceinline__ void done(const Unit&) const {}
};

__device__ __forceinline__ unsigned cvt_pk_bf16(float lo, float hi) { unsigned r; asm volatile("v_cvt_pk_bf16_f32 %0, %1, %2" : "=v"(r) : "v"(lo), "v"(hi)); return r; }
typedef float f32x2 __attribute__((ext_vector_type(2)));
struct NoHook { __device__ __forceinline__ void at_tile(int, const Unit&, f32x4 (&)[2][2][4][2], PG8_LAS unsigned char*, int, int) const {} };
template <class Epi, class Sched, bool ALIGN_EPI = false, bool SP2 = false, class Hook = NoHook>
__device__ __forceinline__ void gemm_phase(PG8_LAS unsigned char* lds, const Gemm g, const Sched& S, const Epi& E, const Hook& H = Hook()) {
    const int tid = threadIdx.x, wid = __builtin_amdgcn_readfirstlane(tid >> 6), lane = tid & 63, wr = wid >> 2, wc = wid & 3, fr = lane & 15, fq = lane >> 4;
    const int K = g.K, nt = K / BK;
    unsigned voffA[2], voffB[2];
#pragma unroll
    for (int i = 0; i < 2; ++i) { int R, C; stage_rc(tid * 16 + i * 8192, R, C); const int Rb = Epi::PERM ? ((R & ~31) + perm32(R & 31)) : R;
        voffA[i] = (unsigned)(R * K + C) * 2u; voffB[i] = (unsigned)(Rb * K + C) * 2u; }
    const size_t kstep = (size_t)(BK * 2);
    const size_t hstep = (size_t)HALF * K * 2;
    const size_t tstep = 2 * hstep;
    const unsigned ldsw = (unsigned)wid * 1024u;
    const int aoff = lds_byte(wr * 64 + fr, fq * 8), boff = lds_byte(wc * 32 + fr, fq * 8);
#define PG8_SA(b, h) (((b) * 2 + (h)) * HTB)
#define PG8_SB(b, h) ((4 + (b) * 2 + (h)) * HTB)
#define PG8_STAGE(bufoff, gbase, voff) do { _Pragma("unroll") for (int _i = 0; _i < 2; ++_i) \
        __builtin_amdgcn_global_load_lds((const unsigned*)((const char*)(gbase) + (voff)[_i]), (PG8_LAS unsigned*)(lds + (bufoff) + ldsw + _i * 8192), 16, 0, 0); } while (0)
#define PG8_LDA(dst, b, h) do { _Pragma("unroll") for (int m = 0; m < 4; ++m) _Pragma("unroll") for (int k = 0; k < 2; ++k) dst[m][k] = *(const PG8_LAS bf16x8*)(lds + PG8_SA(b, h) + aoff + m * 2048 + k * 1024); } while (0)
#define PG8_LDB(dst, b, h) do { _Pragma("unroll") for (int n = 0; n < 2; ++n) _Pragma("unroll") for (int k = 0; k < 2; ++k) dst[n][k] = *(const PG8_LAS bf16x8*)(lds + PG8_SB(b, h) + boff + n * 2048 + k * 1024); } while (0)
#define PG8_MMA(ai, bj, At, Bt) do { __builtin_amdgcn_s_setprio(1); _Pragma("unroll") for (int m = 0; m < 4; ++m) _Pragma("unroll") for (int n = 0; n < 2; ++n) _Pragma("unroll") for (int k = 0; k < 2; ++k) \
        acc[ai][bj][m][n] = __builtin_amdgcn_mfma_f32_16x16x32_bf16(Bt[n][k], At[m][k], acc[ai][bj][m][n], 0, 0, 0); __builtin_amdgcn_s_setprio(0); } while (0)
#define PG8_WAIT_V(n) asm volatile("s_waitcnt vmcnt(" #n ")" ::: "memory")
#define PG8_WAIT_L(n) asm volatile("s_waitcnt lgkmcnt(" #n ")" ::: "memory")
#define PG8_BAR __builtin_amdgcn_s_barrier()
#define PG8_SCHED __builtin_amdgcn_sched_barrier(0)
    Unit cur, nxt; int ui = 0;
    if (!S.next(0, cur)) return;
    f32x4 acc[2][2][4][2];
#pragma unroll
    for (int a = 0; a < 2; ++a)
#pragma unroll
        for (int b = 0; b < 2; ++b)
#pragma unroll
            for (int m = 0; m < 4; ++m)
#pragma unroll
                for (int n = 0; n < 2; ++n) acc[a][b][m][n] = (f32x4){0.f, 0.f, 0.f, 0.f};
    bf16x8 At[4][2], B0[2][2], B1[2][2];
    const char* cA = (const char*)g.A + (size_t)cur.pm * tstep; const char* cB = (const char*)g.Bt + (size_t)cur.pn * tstep;
    S.a_ready(cur);
    if constexpr (SP2) {
        PG8_STAGE(PG8_SB(0, 0), cB, voffB); PG8_STAGE(PG8_SB(0, 1), cB + hstep, voffB); PG8_STAGE(PG8_SA(0, 0), cA, voffA); PG8_STAGE(PG8_SA(0, 1), cA + hstep, voffA);
        if (wr == 1) PG8_BAR;
        PG8_WAIT_V(2); PG8_BAR;
        PG8_STAGE(PG8_SB(1, 0), cB + kstep, voffB); PG8_STAGE(PG8_SA(1, 0), cA + kstep, voffA); PG8_STAGE(PG8_SB(1, 1), cB + hstep + kstep, voffB);
        PG8_WAIT_V(6); PG8_BAR;
    } else {
        PG8_STAGE(PG8_SB(0, 0), cB, voffB); PG8_STAGE(PG8_SA(0, 0), cA, voffA); PG8_STAGE(PG8_SB(0, 1), cB + hstep, voffB); PG8_STAGE(PG8_SA(0, 1), cA + hstep, voffA);
        if (wr == 1) PG8_BAR;
        PG8_WAIT_V(4); PG8_BAR;
        PG8_STAGE(PG8_SB(1, 0), cB + kstep, voffB); PG8_STAGE(PG8_SA(1, 0), cA + kstep, voffA); PG8_STAGE(PG8_SB(1, 1), cB + hstep + kstep, voffB);
        PG8_WAIT_V(6); PG8_BAR;
    }
    for (;;) {
        const bool has_next = S.next(ui + 1, nxt);
        const char* nA = has_next ? (const char*)g.A + (size_t)nxt.pm * tstep : cA; const char* nB = has_next ? (const char*)g.Bt + (size_t)nxt.pn * tstep : cB;
        for (int t = 0; t < nt; t += 2) {
            const bool last = (t == nt - 2);
            H.at_tile(t, cur, acc, lds + STAGE_BYTES, wr, fr);
            const char* a1 = cA + (size_t)(t + 1) * kstep;
            const char* a2 = last ? nA : cA + (size_t)(t + 2) * kstep; const char* b2 = last ? nB : cB + (size_t)(t + 2) * kstep;
            const char* a3 = a2 + kstep; const char* b3 = b2 + kstep;
            if (last && has_next) S.a_ready(nxt);
            if constexpr (SP2) {
            PG8_LDB(B0, 0, 0); PG8_LDB(B1, 0, 1); PG8_SCHED; PG8_LDA(At, 0, 0); PG8_STAGE(PG8_SA(1, 1), a1 + hstep, voffA);
            PG8_WAIT_V(8); PG8_WAIT_L(0); PG8_BAR; PG8_MMA(0, 0, At, B0); PG8_MMA(0, 1, At, B1); PG8_BAR; PG8_SCHED;
            PG8_LDA(At, 0, 1); PG8_STAGE(PG8_SB(0, 0), b2, voffB); PG8_STAGE(PG8_SB(0, 1), b2 + hstep, voffB); PG8_STAGE(PG8_SA(0, 0), a2, voffA);
            PG8_WAIT_V(8); PG8_WAIT_L(0); PG8_BAR; PG8_MMA(1, 0, At, B0); PG8_MMA(1, 1, At, B1); PG8_BAR; PG8_SCHED;
            PG8_LDB(B0, 1, 0); PG8_LDB(B1, 1, 1); PG8_SCHED; PG8_LDA(At, 1, 0); PG8_STAGE(PG8_SA(0, 1), a2 + hstep, voffA);
            PG8_WAIT_V(8); PG8_WAIT_L(0); PG8_BAR; PG8_MMA(0, 0, At, B0); PG8_MMA(0, 1, At, B1); PG8_BAR; PG8_SCHED;
            PG8_LDA(At, 1, 1); PG8_STAGE(PG8_SB(1, 0), b3, voffB); PG8_STAGE(PG8_SB(1, 1), b3 + hstep, voffB); PG8_STAGE(PG8_SA(1, 0), a3, voffA);
            PG8_WAIT_V(8); PG8_WAIT_L(0); PG8_BAR; PG8_MMA(1, 0, At, B0); PG8_MMA(1, 1, At, B1); PG8_BAR; PG8_SCHED;
            } else {
            PG8_LDB(B0, 0, 0); PG8_SCHED; PG8_LDA(At, 0, 0); PG8_STAGE(PG8_SA(1, 1), a1 + hstep, voffA);
            PG8_WAIT_L(8); PG8_BAR; PG8_WAIT_L(0); PG8_MMA(0, 0, At, B0); PG8_BAR; PG8_SCHED;
            PG8_LDB(B1, 0, 1); PG8_STAGE(PG8_SB(0, 0), b2, voffB);
            PG8_BAR; PG8_WAIT_L(0); PG8_MMA(0, 1, At, B1); PG8_BAR;
            PG8_LDA(At, 0, 1); PG8_STAGE(PG8_SA(0, 0), a2, voffA);
            PG8_BAR; PG8_WAIT_L(0); PG8_MMA(1, 0, At, B0); PG8_BAR; PG8_SCHED;
            PG8_STAGE(PG8_SB(0, 1), b2 + hstep, voffB);
            PG8_WAIT_V(6); PG8_BAR; PG8_MMA(1, 1, At, B1); PG8_BAR;
            PG8_LDB(B0, 1, 0); PG8_SCHED; PG8_LDA(At, 1, 0); PG8_STAGE(PG8_SA(0, 1), a2 + hstep, voffA);
            PG8_WAIT_L(8); PG8_BAR; PG8_WAIT_L(0); PG8_MMA(0, 0, At, B0); PG8_BAR; PG8_SCHED;
            PG8_LDB(B1, 1, 1); PG8_STAGE(PG8_SB(1, 0), b3, voffB);
            PG8_BAR; PG8_WAIT_L(0); PG8_MMA(0, 1, At, B1); PG8_BAR;
            PG8_LDA(At, 1, 1); PG8_STAGE(PG8_SA(1, 0), a3, voffA);
            PG8_BAR; PG8_WAIT_L(0); PG8_MMA(1, 0, At, B0); PG8_BAR; PG8_SCHED;
            PG8_STAGE(PG8_SB(1, 1), b3 + hstep, voffB);
            PG8_WAIT_V(6); PG8_BAR; PG8_MMA(1, 1, At, B1); PG8_BAR;
            }
        }
        if constexpr (ALIGN_EPI) { if (wr == 0) PG8_BAR; }
        if constexpr (!Epi::AFTER_DRAIN) { E(acc, cur, wr, wc, fr, fq);
#ifdef PROBE_EPI2
            if constexpr (Epi::PROBE_TWICE) { asm volatile("" ::: "memory"); E(acc, cur, wr, wc, fr, fq); }
#endif
            S.done(cur); }
        if (!has_next) break;
#pragma unroll
        for (int a = 0; a < 2; ++a)
#pragma unroll
            for (int b = 0; b < 2; ++b)
#pragma unroll
                for (int m = 0; m < 4; ++m)
#pragma unroll
                    for (int n = 0; n < 2; ++n) acc[a][b][m][n] = (f32x4){0.f, 0.f, 0.f, 0.f};
        cur = nxt; cA = nA; cB = nB; ++ui;
        if constexpr (ALIGN_EPI) { if (wr == 1) PG8_BAR; }
    }
    PG8_WAIT_V(0);
    if constexpr (!ALIGN_EPI) { if (wr == 0) PG8_BAR; }
    PG8_BAR;
    if constexpr (Epi::AFTER_DRAIN) { E.fused(acc, cur, wr, wc, fr, fq, lds, wid, lane); S.done(cur); }
#undef PG8_SA
#undef PG8_SB
#undef PG8_STAGE
#undef PG8_LDA
#undef PG8_LDB
#undef PG8_MMA
#undef PG8_WAIT_V
#undef PG8_WAIT_L
#undef PG8_BAR
#undef PG8_SCHED
}
}
namespace pg8 {
struct EpiProj {
    static constexpr bool PERM = true, AFTER_DRAIN = false, PROBE_TWICE = true;
    bf16_t* O; int ldc;
    __device__ __forceinline__ void operator()(const f32x4 (&acc)[2][2][4][2], const Unit& u, int wr, int wc, int fr, int fq) const {
        const int row0 = u.pm * BM + wr * 64 + fr; const int col0 = u.pn * BM + wc * 32 + 8 * fq;
#pragma unroll
        for (int ai = 0; ai < 2; ++ai)
#pragma unroll
            for (int m = 0; m < 4; ++m) { bf16_t* rowp = O + (size_t)(row0 + ai * HALF + m * 16) * ldc + col0;
#pragma unroll
                for (int bj = 0; bj < 2; ++bj) { const f32x4 v0 = acc[ai][bj][m][0], v1 = acc[ai][bj][m][1];
                    u32x4 w; w.x = cvt_pk_bf16(v0[0], v0[1]); w.y = cvt_pk_bf16(v0[2], v0[3]); w.z = cvt_pk_bf16(v1[0], v1[1]); w.w = cvt_pk_bf16(v1[2], v1[3]);
                    __builtin_nontemporal_store(w, (u32x4*)(rowp + bj * HALF)); } }
    }
};
struct EpiX1 {
    static constexpr bool PERM = true, AFTER_DRAIN = false, PROBE_TWICE = false;
    const float* x; float* x1; bf16_t* x1s; const float* mod; const float* norm2_g; float* rowstat; PG8_LAS float* tab;
    __device__ __forceinline__ void operator()(const f32x4 (&acc)[2][2][4][2], const Unit& u, int wr, int wc, int fr, int fq) const {
        const int row0 = u.pm * BM + wr * 64 + fr; const int col0 = u.pn * BM + wc * 32 + 8 * fq; const int b = (u.pm * BM) >> 11;
        const float* mb = mod + (size_t)b * 6144;
        f32x4 g1[2][2], g2[2][2];
#pragma unroll
        for (int bj = 0; bj < 2; ++bj)
#pragma unroll
            for (int n = 0; n < 2; ++n) { const int c = col0 + bj * HALF + 4 * n; g1[bj][n] = *(const f32x4*)(mb + 2048 + c);
                const f32x4 sc = *(const f32x4*)(mb + 4096 + c), ng = *(const f32x4*)(norm2_g + c); g2[bj][n] = ng * (sc + 1.0f); }
#pragma unroll
        for (int ai = 0; ai < 2; ++ai)
#pragma unroll
            for (int m = 0; m < 4; ++m) { const size_t row = (size_t)(row0 + ai * HALF + m * 16); const size_t off = row * 1024 + col0; float ss = 0.f;
                const float rfin = tab[((u.pm >> 3) & 1) * 1280 + 1024 + ai * HALF + wr * 64 + m * 16 + fr];
#pragma unroll
                for (int bj = 0; bj < 2; ++bj) {
                    const f32x4 xa = *(const f32x4*)(x + off + bj * HALF), xb = *(const f32x4*)(x + off + bj * HALF + 4);
                    const f32x4 v0 = xa + g1[bj][0] * (acc[ai][bj][m][0] * rfin), v1 = xb + g1[bj][1] * (acc[ai][bj][m][1] * rfin);
                    *(f32x4*)(x1 + off + bj * HALF) = v0; *(f32x4*)(x1 + off + bj * HALF + 4) = v1;
                    ss += (v0[0] * v0[0] + v0[1] * v0[1]) + (v0[2] * v0[2] + v0[3] * v0[3]) + (v1[0] * v1[0] + v1[1] * v1[1]) + (v1[2] * v1[2] + v1[3] * v1[3]);
                    const f32x4 s0 = v0 * g2[bj][0], s1 = v1 * g2[bj][1];
                    u32x4 w; w.x = cvt_pk_bf16(s0[0], s0[1]); w.y = cvt_pk_bf16(s0[2], s0[3]); w.z = cvt_pk_bf16(s1[0], s1[1]); w.w = cvt_pk_bf16(s1[2], s1[3]);
                    *(u32x4*)(x1s + off + bj * HALF) = w; }
                ss += __shfl_xor(ss, 16); ss += __shfl_xor(ss, 32);
                if (fq == 0) atomicAdd(rowstat + row, ss); }
    }
};
typedef _Float16 f16x8 __attribute__((ext_vector_type(8)));
struct EpiScores {
    static constexpr bool PERM = true, AFTER_DRAIN = false, PROBE_TWICE = false;
    _Float16* S; const float* sb; const float* rowstat;
    __device__ __forceinline__ void operator()(const f32x4 (&acc)[2][2][4][2], const Unit& u, int wr, int wc, int fr, int fq) const {
        const int row0 = u.pm * BM + wr * 64 + fr; const int col0 = u.pn * BM + wc * 32 + 8 * fq; const int b = (u.pm * BM) >> 11;
        f32x4 bv[2][2];
#pragma unroll
        for (int bj = 0; bj < 2; ++bj)
#pragma unroll
            for (int n = 0; n < 2; ++n) bv[bj][n] = *(const f32x4*)(sb + (size_t)b * 2048 + col0 + bj * HALF + 4 * n);
#pragma unroll
        for (int ai = 0; ai < 2; ++ai)
#pragma unroll
            for (int m = 0; m < 4; ++m) { const size_t row = (size_t)(row0 + ai * HALF + m * 16); const float rs = __builtin_amdgcn_rsqf(rowstat[row] * (1.0f / 1024.0f) + 1e-6f);
                _Float16* rowp = S + row * 2048 + col0;
#pragma unroll
                for (int bj = 0; bj < 2; ++bj) { const f32x4 v0 = acc[ai][bj][m][0] * rs + bv[bj][0], v1 = acc[ai][bj][m][1] * rs + bv[bj][1];
                    f16x8 h; h[0] = (_Float16)v0[0]; h[1] = (_Float16)v0[1]; h[2] = (_Float16)v0[2]; h[3] = (_Float16)v0[3]; h[4] = (_Float16)v1[0]; h[5] = (_Float16)v1[1]; h[6] = (_Float16)v1[2]; h[7] = (_Float16)v1[3];
                    *(f16x8*)(rowp + bj * HALF) = h; } }
    }
};
struct SegScaleHook {
    __device__ __forceinline__ static void build(PG8_LAS unsigned char* ldsx, const Unit& u, const float* st_ssd, const float* st_s5, int tid) {
        PG8_LAS float* tab = (PG8_LAS float*)ldsx + ((u.pm >> 3) & 1) * 1280;
        if (tid < 256) { const size_t row = (size_t)u.pm * BM + tid; const f32x4* sg = (const f32x4*)(st_ssd + row * 16); const f32x4* s5 = (const f32x4*)(st_s5 + row * 64);
            float r[5];
#pragma unroll
            for (int gI = 0; gI < 4; ++gI) { const f32x4 v = sg[gI]; r[gI] = __builtin_amdgcn_rsqf(((v[0] + v[1]) + (v[2] + v[3])) * (1.0f / 256.0f) + 1e-6f); }
            float a5 = 0.f;
#pragma unroll
            for (int q = 0; q < 16; ++q) { const f32x4 v = s5[q]; a5 += (v[0] + v[1]) + (v[2] + v[3]); }
            r[4] = __builtin_amdgcn_rsqf(a5 * (1.0f / 1024.0f) + 1e-6f);
#pragma unroll
            for (int k = 0; k < 4; ++k) tab[k * 256 + tid] = r[k] * __builtin_amdgcn_rcpf(r[k + 1]);
            tab[1024 + tid] = r[4]; }
    }
    __device__ __forceinline__ void at_tile(int t, const Unit& u, f32x4 (&acc)[2][2][4][2], PG8_LAS unsigned char* ldsx, int wr, int fr) const {
        if (t == 4 || t == 8 || t == 12 || t == 16) { const PG8_LAS float* rt = (const PG8_LAS float*)ldsx + ((u.pm >> 3) & 1) * 1280 + ((t >> 2) - 1) * 256 + wr * 64 + fr;
#pragma unroll
            for (int ai = 0; ai < 2; ++ai)
#pragma unroll
                for (int m = 0; m < 4; ++m) { const float r = rt[ai * HALF + m * 16];
#pragma unroll
                    for (int bj = 0; bj < 2; ++bj) { acc[ai][bj][m][0] = acc[ai][bj][m][0] * r; acc[ai][bj][m][1] = acc[ai][bj][m][1] * r; } } }
    }
};
}
constexpr int NWAVES = 8, NTHR = 512;
constexpr int DM = 1024, NB = 16, SEQ = 2048, MTOK = NB * SEQ;
constexpr int NPROJ = 4096;
constexpr int INW = 4112;
constexpr int NHEADS = 16, HDIM = 64, NGRP = 4, NST = 128, CHUNK = 128;
constexpr int S5G = 64, S5CH = 16, S5P = 64;
constexpr int PH = 8, PK = 16, PNK = 128;
constexpr float EPSF = 1e-6f;
constexpr int NS5PART = 64;

constexpr size_t MiB = 1u << 20;
constexpr size_t WS_CTL = 0, CTL_ZERO_BYTES = 64 * 1024;
constexpr size_t WS_MOD = 1 * MiB;
constexpr size_t WS_WDT = WS_MOD + 0x60000;
constexpr size_t WS_SB = WS_MOD + 0x70000;
constexpr size_t WS_ROWSTAT = WS_MOD + 0x90000;
constexpr size_t WS_S5LB = WS_MOD + 0xB0000;
constexpr size_t WS_S5BB = WS_MOD + 0xC0000;
constexpr size_t WS_DTRAW = 3 * MiB;
constexpr size_t WS_STSSD = 5 * MiB;
constexpr size_t WS_STS5 = 7 * MiB;
constexpr size_t WS_WINT = 15 * MiB;
constexpr size_t WS_WOUTT = 23 * MiB;
constexpr size_t WS_WQKT = 27 * MiB;
constexpr size_t WS_EU = 31 * MiB, WS_EV = 47 * MiB;
constexpr size_t WS_EUS = 63 * MiB, WS_EVS = 63 * MiB + 65536;
constexpr size_t WS_START = 64 * MiB;
constexpr size_t WS_A = 95 * MiB;
constexpr size_t WS_B = 223 * MiB;
constexpr size_t WS_H1 = WS_A, WS_Y = WS_A, WS_PROJ = WS_B, WS_SCORES = WS_A;
constexpr size_t WS_X1S = WS_B + 192 * MiB;
constexpr size_t WS_EID = 479 * MiB, WS_GATE = 495 * MiB;
constexpr size_t WS_H2Q = WS_B, WS_HINV = WS_B + 32 * MiB;
constexpr size_t WS_END = 511 * MiB;
static_assert(WS_SCORES + (size_t)MTOK * 2048 * 4 <= WS_X1S && WS_X1S + (size_t)MTOK * 1024 * 2 <= WS_EID && WS_GATE + (size_t)MTOK * 128 * 4 <= WS_END, "ws map");

constexpr int LDS_MAIN = 159744;
constexpr int MISC_OFF = LDS_MAIN;
constexpr int LDS_BYTES = LDS_MAIN + 128;

#define GAS __attribute__((address_space(1)))
#define LAS __attribute__((address_space(3)))
typedef unsigned short bf16;
typedef unsigned v4u __attribute__((ext_vector_type(4)));
typedef unsigned v2u __attribute__((ext_vector_type(2)));
typedef float f32x4 __attribute__((ext_vector_type(4)));
typedef float f32x2 __attribute__((ext_vector_type(2)));
typedef short bf16x8 __attribute__((ext_vector_type(8)));
#define LDS_WAIT() asm volatile("s_waitcnt lgkmcnt(0)" ::: "memory")
#define VM_WAIT() asm volatile("s_waitcnt vmcnt(0)" ::: "memory")
typedef __bf16 hwbf16x2 __attribute__((ext_vector_type(2)));
__device__ __forceinline__ unsigned pk2(float lo, float hi) { const f32x2 v = {lo, hi}; const hwbf16x2 b = __builtin_convertvector(v, hwbf16x2); return __builtin_bit_cast(unsigned, b); }
__device__ __forceinline__ unsigned f2bf(float f) { return pk2(f, 0.f) & 0xffffu; }
__device__ __forceinline__ float bflo(unsigned w) { return __builtin_bit_cast(float, w << 16); }
__device__ __forceinline__ float bfhi(unsigned w) { return __builtin_bit_cast(float, w & 0xffff0000u); }
__device__ __forceinline__ float bf2f(bf16 v) { return __builtin_bit_cast(float, (unsigned)v << 16); }
__device__ __forceinline__ float wave_sum(float v) {
#pragma unroll
    for (int o = 1; o < 64; o <<= 1) v += __shfl_xor(v, o);
    return v;
}
__device__ __forceinline__ float sigmoid_f(float v) { return __builtin_amdgcn_rcpf(1.0f + __builtin_amdgcn_exp2f(-1.4426950408889634f * v)); }
__device__ __forceinline__ float silu_f(float v) { return v * sigmoid_f(v); }
__device__ __forceinline__ float rsqrt_f(float v) { return __builtin_amdgcn_rsqf(v); }
__device__ __forceinline__ float gelu_erf(float v) {
    const float av = fabsf(v), t = __builtin_amdgcn_rcpf(av * 0.2316418882f + 1.0f);
    float q = t * 0.5307027145f + (-0.7265760135f); q = q * t + 0.7107068705f; q = q * t + (-0.142248368f); q = q * t + 0.127414796f; q = q * t;
    const float e = __builtin_amdgcn_exp2f((v * v) * (-0.72134752044f));
    const float m = v * (q * e);
    return v < 0.f ? m : v - m;
}
__device__ __forceinline__ float softplus_f(float v) { const float e = __builtin_amdgcn_exp2f(-1.4426950408889634f * fabsf(v));
    const float l = e < 1e-6f ? e : 0.6931471805599453f * __builtin_amdgcn_logf(1.0f + e); return fmaxf(v, 0.f) + l; }
__device__ __forceinline__ void unpack8(const v4u w, float* f) { f[0] = bflo(w.x); f[1] = bfhi(w.x); f[2] = bflo(w.y); f[3] = bfhi(w.y); f[4] = bflo(w.z); f[5] = bfhi(w.z); f[6] = bflo(w.w); f[7] = bfhi(w.w); }
#define LDS_BARRIER() do { asm volatile("s_waitcnt lgkmcnt(0)" ::: "memory"); __builtin_amdgcn_s_barrier(); asm volatile("" ::: "memory"); } while (0)
__device__ __forceinline__ float row16_sum_to15(float v) {
    v += __builtin_bit_cast(float, __builtin_amdgcn_update_dpp(0, __builtin_bit_cast(int, v), 0x118, 0xf, 0xf, true));
    v += __builtin_bit_cast(float, __builtin_amdgcn_update_dpp(0, __builtin_bit_cast(int, v), 0x114, 0xf, 0xf, true));
    v += __builtin_bit_cast(float, __builtin_amdgcn_update_dpp(0, __builtin_bit_cast(int, v), 0x112, 0xf, 0xf, true));
    v += __builtin_bit_cast(float, __builtin_amdgcn_update_dpp(0, __builtin_bit_cast(int, v), 0x111, 0xf, 0xf, true));
    return v;
}
__device__ __forceinline__ float wave_sum_to63(float v) {
    v = row16_sum_to15(v);
    v += __builtin_bit_cast(float, __builtin_amdgcn_update_dpp(0, __builtin_bit_cast(int, v), 0x142, 0xa, 0xf, false));
    v += __builtin_bit_cast(float, __builtin_amdgcn_update_dpp(0, __builtin_bit_cast(int, v), 0x143, 0xc, 0xf, false));
    return v;
}
__device__ __forceinline__ f32x2 gelu_pk2(f32x2 v) {
    const f32x2 av = __builtin_elementwise_abs(v), d = av * 0.2316418882f + 1.0f;
    f32x2 t; t[0] = __builtin_amdgcn_rcpf(d[0]); t[1] = __builtin_amdgcn_rcpf(d[1]);
    f32x2 q = t * 0.5307027145f + (-0.7265760135f); q = q * t + 0.7107068705f; q = q * t + (-0.142248368f); q = q * t + 0.127414796f; q = q * t;
    const f32x2 s = (v * v) * (-0.72134752044f);
    f32x2 e; e[0] = __builtin_amdgcn_exp2f(s[0]); e[1] = __builtin_amdgcn_exp2f(s[1]);
    const f32x2 m = v * (q * e), r = v - m;
    f32x2 o; o[0] = v[0] < 0.f ? m[0] : r[0]; o[1] = v[1] < 0.f ? m[1] : r[1]; return o;
}
#define XB_TMO      128
#define XB_XCNT(j)  (256  + 64 * (j))
#define XB_XSUB(j)  (1280 + 64 * (j))
#define XB_XGEN(j)  (2304 + 64 * (j))
#define XB_TOP      3328
#define XB_TOPGEN   3392
#define XCD_BAR_WORDS 3456
#define XB_SPIN_CAP (1u << 18)

__device__ __forceinline__ unsigned xb_ld(unsigned* p)              { return __hip_atomic_load(p, __ATOMIC_RELAXED, __HIP_MEMORY_SCOPE_AGENT); }
__device__ __forceinline__ unsigned xb_add(unsigned* p, unsigned v) { return __hip_atomic_fetch_add(p, v, __ATOMIC_RELAXED, __HIP_MEMORY_SCOPE_AGENT); }
__device__ __forceinline__ unsigned xb_xcc_id() { return (unsigned)__builtin_amdgcn_s_getreg((3 << 11) | 20) & 0xFu; }
#define XB_SPIN(cond, bar) do { unsigned _sp = 0; while (cond) { __builtin_amdgcn_s_sleep(1); \
    if ((++_sp & 255u) == 0u) { if (xb_ld(&(bar)[XB_TMO])) break; if (_sp > XB_SPIN_CAP) { atomicAdd(&(bar)[XB_TMO], 1u); break; } } } } while (0)

struct XcdBarrier {
    unsigned* bar; unsigned x;
    volatile LAS unsigned* st;
};

__device__ __forceinline__ XcdBarrier xcd_barrier_post(unsigned* bar, volatile LAS unsigned* st) {
    XcdBarrier b; b.bar = bar; b.x = xb_xcc_id(); b.st = st;
    if (threadIdx.x == 0) (void)xb_add(&bar[XB_XCNT(b.x)], 1u);
    return b;
}
__device__ __forceinline__ void xcd_barrier_complete(unsigned* bar, unsigned x, unsigned& nloc, unsigned& nx) {
    const unsigned G = gridDim.x * gridDim.y * gridDim.z;
    unsigned sum, cnt, mine, sp = 0u;
    for (;;) {
        sum = 0u; cnt = 0u; mine = 0u;
#pragma unroll
        for (unsigned j = 0; j < 16; ++j) { const unsigned c = xb_ld(&bar[XB_XCNT(j)]); sum += c; cnt += (c > 0u) ? 1u : 0u; mine = (j == x) ? c : mine; }
        if (sum == G) break;
        __builtin_amdgcn_s_sleep(1);
        if ((++sp & 255u) == 0u) { if (xb_ld(&bar[XB_TMO])) break; if (sp > XB_SPIN_CAP) { atomicAdd(&bar[XB_TMO], 1u); break; } }
    }
    nloc = mine > 0u ? mine : 1u; nx = cnt > 0u ? cnt : 1u;
}

__device__ __forceinline__ void xcd_barrier(const XcdBarrier& b) {
    asm volatile("s_waitcnt vmcnt(0)" ::: "memory");
    __syncthreads();
    if (threadIdx.x == 0) {
        unsigned* bar = b.bar;
        __builtin_amdgcn_s_waitcnt(0);
        unsigned nloc = b.st[0], nx = b.st[1];
        if (nloc == 0u) { xcd_barrier_complete(bar, b.x, nloc, nx); b.st[0] = nloc; b.st[1] = nx; }
        const unsigned old = xb_add(&bar[XB_XSUB(b.x)], 1u);
        const unsigned gen = old / nloc;
        if (old + 1u == (gen + 1u) * nloc) {
            __builtin_amdgcn_fence(__ATOMIC_RELEASE, "agent");
            asm volatile("s_waitcnt vmcnt(0)" ::: "memory");
            const unsigned og = xb_add(&bar[XB_TOP], 1u);
            const unsigned tg = og / nx;
            if (og + 1u == (tg + 1u) * nx) xb_add(&bar[XB_TOPGEN], 1u);
            else XB_SPIN(xb_ld(&bar[XB_TOPGEN]) == tg, bar);
            __builtin_amdgcn_fence(__ATOMIC_ACQUIRE, "agent");
            xb_add(&bar[XB_XGEN(b.x)], 1u);
            asm volatile("s_waitcnt vmcnt(0)" ::: "memory");
        } else {
            XB_SPIN(xb_ld(&bar[XB_XGEN(b.x)]) == gen, bar);
            __builtin_amdgcn_fence(__ATOMIC_ACQUIRE, "agent");
            asm volatile("s_waitcnt vmcnt(0)" ::: "memory");
        }
    }
    __syncthreads();
}
struct Args { const float* in[30]; float* out; unsigned char* ws; int ph_lo, ph_hi; };
struct Frame {
    LAS unsigned char* lds;
    volatile LAS unsigned* MISC;
    int vcu, G;
    unsigned char* ws;
    const Args* a;
    float* out;
};
#define WSP(T, off) ((T*)(F.ws + (off)))

__device__ __forceinline__ void transpose_tile(const float* W, int ldw, int k0, int src_n0, bf16* WT, int K, int dst_n0, LAS float* scr, int lane, const float* kscale) {
#pragma unroll 8
    for (int i = 0; i < 32; ++i) { const int kk = 2 * i + (lane >> 5); float v = W[(size_t)(k0 + kk) * ldw + src_n0 + (lane & 31)]; if (kscale) v *= kscale[k0 + kk]; scr[kk * 33 + (lane & 31)] = v; }
    LDS_WAIT(); asm volatile("" ::: "memory");
    const int c = lane & 7;
#pragma unroll
    for (int j = 0; j < 4; ++j) { const int n = (lane >> 3) + 8 * j; const LAS float* s = scr + (8 * c) * 33 + n;
        v4u o; o.x = pk2(s[0 * 33], s[1 * 33]); o.y = pk2(s[2 * 33], s[3 * 33]); o.z = pk2(s[4 * 33], s[5 * 33]); o.w = pk2(s[6 * 33], s[7 * 33]);
        *(v4u*)(WT + (size_t)(dst_n0 + n) * K + k0 + 8 * c) = o; }
    LDS_WAIT(); asm volatile("" ::: "memory");
}
__device__ __forceinline__ void p0_phase(Frame& F) {
    const int f_tid = threadIdx.x, f_lane = f_tid & 63, f_wave = __builtin_amdgcn_readfirstlane(f_tid >> 6);
    const int gw = F.vcu * NWAVES + f_wave, NGW = F.G * NWAVES, gt = F.vcu * NTHR + f_tid, NGT = F.G * NTHR;
    {
        LAS float* sc = (LAS float*)F.lds;
        LAS float* red = (LAS float*)(F.lds + 65536);
        for (int i = f_tid; i < 16 * 1024; i += NTHR) { const int b = i >> 10, k = i & 1023; sc[k * 16 + b] = silu_f((F.a->in[1])[i]); }
        __syncthreads();
        const int ks = f_tid / 24, col = f_tid - ks * 24, j = F.vcu * 24 + col;
        if (ks < 21) {
            float acc[16];
#pragma unroll
            for (int b = 0; b < 16; ++b) acc[b] = 0.f;
            const int k0 = ks * 49, kn = (k0 + 49 <= 1024) ? 49 : (1024 - k0);
            const float* wp = (F.a->in[2]) + (size_t)k0 * 6144 + j;
#pragma unroll 1
            for (int kb = 0; kb < 49; kb += 7) {
                asm volatile("" ::: "memory");
                float wv[7];
#pragma unroll
                for (int u = 0; u < 7; ++u) wv[u] = (kb + u < kn) ? wp[(size_t)(kb + u) * 6144] : 0.f;
#pragma unroll
                for (int u = 0; u < 7; ++u) { const int kk = (kb + u < kn) ? (k0 + kb + u) : k0; const LAS f32x4* s4 = (const LAS f32x4*)(sc + kk * 16);
#pragma unroll
                    for (int q = 0; q < 4; ++q) { const f32x4 sv = s4[q]; acc[4 * q] += sv[0] * wv[u]; acc[4 * q + 1] += sv[1] * wv[u]; acc[4 * q + 2] += sv[2] * wv[u]; acc[4 * q + 3] += sv[3] * wv[u]; } }
            }
#pragma unroll
            for (int b = 0; b < 16; ++b) red[(ks * 16 + b) * 24 + col] = acc[b];
        }
        __syncthreads();
        for (int i = f_tid; i < 16 * 24; i += NTHR) { const int b = i / 24, cc = i - b * 24; float sacc = 0.f;
            for (int q = 0; q < 21; ++q) sacc += red[(q * 16 + b) * 24 + cc];
            WSP(float, WS_MOD)[b * 6144 + F.vcu * 24 + cc] = sacc + (F.a->in[3])[F.vcu * 24 + cc]; }
        __syncthreads();
    }
    {
        LAS float* scr = (LAS float*)(F.lds + f_wave * 16384);
        constexpr int I_IN = (1024 / 64) * (NPROJ / 32), I_OUT = (2048 / 64) * (1024 / 32);
        for (int it = gw; it < I_IN + I_OUT; it += NGW) {
            if (it < I_IN) { const int kb = it / (NPROJ / 32), nb = it % (NPROJ / 32); const int dn = 32 * nb, sn = dn < 3072 ? dn : dn + 16;
                transpose_tile((F.a->in[5]), INW, 64 * kb, sn, WSP(bf16, WS_WINT), 1024, dn, scr, f_lane, nullptr); }
            else { const int r = it - I_IN, kb = r / 32, nb = r % 32; const int k0 = 64 * kb;
                transpose_tile((F.a->in[23]), 1024, k0, 32 * nb, WSP(bf16, WS_WOUTT), 2048, 32 * nb, scr, f_lane, k0 < 1024 ? (F.a->in[11]) : (F.a->in[22]) - 1024); }
        }
    }
    for (int i = gt; i < 16 * 1024; i += NGT) { const int h = i >> 10, k = i & 1023; WSP(float, WS_WDT)[i] = (F.a->in[5])[(size_t)k * INW + 3072 + h]; }
    for (int task = gw; task < 2048; task += NGW) {
        const int nt = task >> 4, ks = task & 15, n0 = 16 * nt, hc = n0 >> 7, k0 = 64 * ks;
        const int li = f_lane & 15, lq = f_lane >> 4;
        f32x4 acc[4];
#pragma unroll
        for (int s = 0; s < 4; ++s) acc[s] = (f32x4){0.f, 0.f, 0.f, 0.f};
        const float* ap = (F.a->in[26]) + (size_t)(n0 + li) * 128 + 4 * lq;
        const float* bp = (F.a->in[25]) + (size_t)(k0 + li) * 2048 + hc * 128 + 4 * lq;
#pragma unroll
        for (int q = 0; q < 8; ++q) { const f32x4 a = *(const f32x4*)(ap + 16 * q);
#pragma unroll
            for (int s = 0; s < 4; ++s) { const f32x4 b = *(const f32x4*)(bp + (size_t)(16 * s) * 2048 + 16 * q);
#pragma unroll
                for (int jj = 0; jj < 4; ++jj) acc[s] = __builtin_amdgcn_mfma_f32_16x16x4f32(a[jj], b[jj], acc[s], 0, 0, 0); } }
        bf16* o = WSP(bf16, WS_WQKT);
#pragma unroll
        for (int s = 0; s < 4; ++s)
#pragma unroll
            for (int r = 0; r < 4; ++r) o[(size_t)(n0 + 4 * lq + r) * 1024 + k0 + 16 * s + li] = (bf16)f2bf(acc[s][r]);
    }
    for (int i = gt; i < S5G * S5P; i += NGT) {
        const float lr = (F.a->in[12])[i], li = (F.a->in[13])[i], dt = expf((F.a->in[14])[i >> 6]);
        const float mag = expf(lr * dt); float sn, cs; sincosf(li * dt, &sn, &cs);
        const float lbr = mag * cs, lbi = mag * sn, den = lr * lr + li * li;
        const float cfr = ((lbr - 1.0f) * lr + lbi * li) / den, cfi = (lbi * lr - (lbr - 1.0f) * li) / den;
        WSP(float, WS_S5LB)[2 * i] = lbr; WSP(float, WS_S5LB)[2 * i + 1] = lbi;
        for (int hh = 0; hh < 16; ++hh) { const float br = (F.a->in[15])[i * 16 + hh], bi = (F.a->in[16])[i * 16 + hh];
            WSP(float, WS_S5BB)[i * 32 + hh] = cfr * br - cfi * bi; WSP(float, WS_S5BB)[i * 32 + 16 + hh] = cfr * bi + cfi * br; }
    }
    for (int i = gt; i < MTOK; i += NGT) WSP(float, WS_ROWSTAT)[i] = 0.f;
}

__device__ __forceinline__ void p1_phase(Frame& F) {
    const int f_tid = threadIdx.x, f_lane = f_tid & 63, f_wave = __builtin_amdgcn_readfirstlane(f_tid >> 6);
    const int gw = F.vcu * NWAVES + f_wave;
    LAS float* wdt = (LAS float*)F.lds;
    for (int i = f_tid; i < 16 * 1024 / 4; i += NTHR) ((LAS f32x4*)wdt)[i] = ((const f32x4*)WSP(float, WS_WDT))[i];
    __syncthreads();
    const int lane = f_lane;
    for (int wq = gw; wq < MTOK / 16; wq += F.G * NWAVES) {
        const int b = wq >> 7; const float* mb = WSP(float, WS_MOD) + (size_t)b * 6144;
        f32x4 Gv[4], Sv[4];
#pragma unroll
        for (int j = 0; j < 4; ++j) { const int k = 4 * lane + 256 * j; const f32x4 g = *(const f32x4*)((F.a->in[4]) + k), sc = *(const f32x4*)(mb + 1024 + k); Gv[j] = g * (sc + 1.0f); Sv[j] = *(const f32x4*)(mb + k); }
        f32x4 nx[4];
#pragma unroll
        for (int j = 0; j < 4; ++j) nx[j] = *(const f32x4*)((F.a->in[0]) + (size_t)wq * 16 * 1024 + 4 * lane + 256 * j);
        for (int tt = 0; tt < 16; ++tt) {
            asm volatile("" ::: "memory");
            const size_t t = (size_t)wq * 16 + tt; const float* xr = (F.a->in[0]) + t * 1024;
            f32x4 v[4]; float ss = 0.f;
#pragma unroll
            for (int j = 0; j < 4; ++j) { v[j] = nx[j]; ss += (v[j][0] * v[j][0] + v[j][1] * v[j][1]) + (v[j][2] * v[j][2] + v[j][3] * v[j][3]); }
            if (tt < 15) {
#pragma unroll
                for (int j = 0; j < 4; ++j) nx[j] = *(const f32x4*)(xr + 1024 + 4 * lane + 256 * j); }
            const float rstd = rsqrt_f(wave_sum(ss) * (1.0f / 1024.0f) + EPSF);
            bf16* hr = WSP(bf16, WS_H1) + t * 1024;
#pragma unroll
            for (int j = 0; j < 4; ++j) { v[j] = v[j] * rstd * Gv[j] + Sv[j]; v2u w; w.x = pk2(v[j][0], v[j][1]); w.y = pk2(v[j][2], v[j][3]); *(v2u*)(hr + 4 * lane + 256 * j) = w; }
            float d[16];
#pragma unroll
            for (int h = 0; h < 16; ++h) { float a = 0.f;
#pragma unroll
                for (int j = 0; j < 4; ++j) { const f32x4 w = *(const LAS f32x4*)(wdt + h * 1024 + 4 * lane + 256 * j); a += (v[j][0] * w[0] + v[j][1] * w[1]) + (v[j][2] * w[2] + v[j][3] * w[3]); }
                d[h] = a; }
            float e8[8], e4[4], e2[2], e1;
#pragma unroll
            for (int i = 0; i < 8; ++i) { const bool up = lane & 32; const float snd = up ? d[i] : d[i + 8]; const float rcv = __shfl_xor(snd, 32); e8[i] = (up ? d[i + 8] : d[i]) + rcv; }
#pragma unroll
            for (int i = 0; i < 4; ++i) { const bool up = lane & 16; const float snd = up ? e8[i] : e8[i + 4]; const float rcv = __shfl_xor(snd, 16); e4[i] = (up ? e8[i + 4] : e8[i]) + rcv; }
#pragma unroll
            for (int i = 0; i < 2; ++i) { const bool up = lane & 8; const float snd = up ? e4[i] : e4[i + 2]; const float rcv = __shfl_xor(snd, 8); e2[i] = (up ? e4[i + 2] : e4[i]) + rcv; }
            { const bool up = lane & 4; const float snd = up ? e2[0] : e2[1]; const float rcv = __shfl_xor(snd, 4); e1 = (up ? e2[1] : e2[0]) + rcv; }
            e1 += __shfl_xor(e1, 2); e1 += __shfl_xor(e1, 1);
            const int head = ((lane >> 5) & 1) * 8 + ((lane >> 4) & 1) * 4 + ((lane >> 3) & 1) * 2 + ((lane >> 2) & 1);
            if ((lane & 3) == 0) WSP(float, WS_DTRAW)[t * 16 + head] = e1;
        }
    }
    for (int n = gw; n < 2048; n += F.G * NWAVES) {
        const bf16* wr = WSP(bf16, WS_WQKT) + (size_t)n * 1024 + 16 * lane;
        const v4u w0 = *(const v4u*)wr, w1 = *(const v4u*)(wr + 8);
        float wv[16]; wv[0] = bflo(w0.x); wv[1] = bfhi(w0.x); wv[2] = bflo(w0.y); wv[3] = bfhi(w0.y); wv[4] = bflo(w0.z); wv[5] = bfhi(w0.z); wv[6] = bflo(w0.w); wv[7] = bfhi(w0.w);
        wv[8] = bflo(w1.x); wv[9] = bfhi(w1.x); wv[10] = bflo(w1.y); wv[11] = bfhi(w1.y); wv[12] = bflo(w1.z); wv[13] = bfhi(w1.z); wv[14] = bflo(w1.w); wv[15] = bfhi(w1.w);
        for (int b = 0; b < 16; ++b) { const float* sp = WSP(float, WS_MOD) + (size_t)b * 6144 + 3072 + 16 * lane; float a = 0.f;
#pragma unroll
            for (int q = 0; q < 4; ++q) { const f32x4 s = *(const f32x4*)(sp + 4 * q); a += (s[0] * wv[4 * q] + s[1] * wv[4 * q + 1]) + (s[2] * wv[4 * q + 2] + s[3] * wv[4 * q + 3]); }
            a = wave_sum(a); if (lane == 0) WSP(float, WS_SB)[b * 2048 + n] = a; }
    }
}
__device__ __forceinline__ void p3pre_conv(Frame& F) {
    const int tid = threadIdx.x;
    const bf16* proj = WSP(bf16, WS_PROJ); bf16* xo = (bf16*)F.out;
    for (int item = F.vcu * NTHR + tid; item < (MTOK / 16) * 256; item += F.G * NTHR) {
        const int oc = item & 255, run = item >> 8; const int t0 = run * 16, ch = 8 * oc;
        const bool halo = (t0 & (SEQ - 1)) != 0;
        v4u rw[19];
#pragma unroll
        for (int k = 0; k < 19; ++k) { rw[k] = (v4u){0u, 0u, 0u, 0u}; if (k >= 3 || halo) rw[k] = *(const v4u*)(proj + (size_t)(t0 - 3 + k) * NPROJ + 1024 + ch); }
        float cw[4][8], cbv[8];
#pragma unroll
        for (int k = 0; k < 4; ++k) { const f32x4 w0 = *(const f32x4*)((F.a->in[6]) + k * 2048 + ch), w1 = *(const f32x4*)((F.a->in[6]) + k * 2048 + ch + 4);
#pragma unroll
            for (int e = 0; e < 4; ++e) { cw[k][e] = w0[e]; cw[k][4 + e] = w1[e]; } }
        { const f32x4 b0 = *(const f32x4*)((F.a->in[7]) + ch), b1 = *(const f32x4*)((F.a->in[7]) + ch + 4);
#pragma unroll
            for (int e = 0; e < 4; ++e) { cbv[e] = b0[e]; cbv[4 + e] = b1[e]; } }
        float r0[8], r1[8], r2[8];
        unpack8(rw[0], r0); unpack8(rw[1], r1); unpack8(rw[2], r2);
#pragma unroll
        for (int tt = 0; tt < 16; ++tt) {
            float r3[8]; unpack8(rw[3 + tt], r3);
            float v[8];
#pragma unroll
            for (int i = 0; i < 8; ++i) { v[i] = silu_f(cbv[i] + r0[i] * cw[0][i] + r1[i] * cw[1][i] + r2[i] * cw[2][i] + r3[i] * cw[3][i]); r0[i] = r1[i]; r1[i] = r2[i]; r2[i] = r3[i]; }
            *(v4u*)(xo + (size_t)(t0 + tt) * 2048 + ch) = (v4u){pk2(v[0], v[1]), pk2(v[2], v[3]), pk2(v[4], v[5]), pk2(v[6], v[7])};
        }
    }
}
constexpr int SSD_PITCH = 272;
__device__ __forceinline__ bf16x8 lds_frag(LAS unsigned char* base, int row, int kbyte) { return *(const LAS bf16x8*)(base + row * SSD_PITCH + kbyte); }
#ifdef PROBE_SSD
#define SPR_T(v) const unsigned long long v = __builtin_amdgcn_s_memtime();
#define SPR_ACC(i, d) sacc[i] += (d);
#else
#define SPR_T(v)
#define SPR_ACC(i, d)
#endif
constexpr int S3_CS = 0, S3_BS = 34816, S3_GY = 69632, S3_XDT = 104448, S3_XP = 144, S3_PREV = 122880, S3_CSF = 140288, S3_DTF = 141312, S3_WTS = 142336, S3_END = 143360;
static_assert(S3_END <= LDS_MAIN, "SSD v3 LDS map");
typedef short v4i16_t __attribute__((ext_vector_type(4)));
__device__ __forceinline__ bf16x8 lds_frag_tr(LAS unsigned char* tile, int pitch, int k0, int col0, int li, int lq) {
    LAS unsigned char* p = tile + (k0 + 8 * lq + (li >> 2)) * pitch + (col0 + 4 * (li & 3)) * 2;
    const v4i16_t lo = __builtin_amdgcn_ds_read_tr16_b64_v4i16((LAS v4i16_t*)p), hi = __builtin_amdgcn_ds_read_tr16_b64_v4i16((LAS v4i16_t*)(p + 4 * pitch));
    return __builtin_shufflevector(lo, hi, 0, 1, 2, 3, 4, 5, 6, 7);
}
struct Ssd3Pre { v4u xr[4], br[4], cr[4]; float d0, d1; };
__device__ __forceinline__ void ssd3_prefetch(Ssd3Pre& P, const char* xcb, const float* dtr, unsigned voB, unsigned voX, int tid, int lane, int w) {
#pragma unroll
    for (int r = 0; r < 4; ++r) { P.br[r] = *(const v4u*)(xcb + (voB + r * 4096u)); P.cr[r] = *(const v4u*)(xcb + (voB + 1024u + r * 4096u)); }
#pragma unroll
    for (int r = 0; r < 4; ++r) P.xr[r] = *(const v4u*)(xcb + (voX + r * 4096u));
    P.d0 = dtr[lane * 32]; P.d1 = dtr[lane * 32 + 16];
}
__device__ __forceinline__ void ssd3_cumsum(LAS unsigned char* L, int par, float r0, float r1, float dtb, float A, int lane) {
    LAS float* csf = (LAS float*)(L + S3_CSF + par * 512); LAS float* dtf = (LAS float*)(L + S3_DTF + par * 512); LAS float* wts = (LAS float*)(L + S3_WTS + par * 512);
    const float d0 = softplus_f(r0 + dtb), d1 = softplus_f(r1 + dtb);
    const float a0 = d0 * A, a1 = d1 * A; float s = a0 + a1;
#pragma unroll
    for (int o = 1; o < 64; o <<= 1) { const float t = __shfl_up(s, o); if (lane >= o) s += t; }
    const float tot = __shfl(s, 63);
    dtf[2 * lane] = d0; dtf[2 * lane + 1] = d1; csf[2 * lane] = s - a1; csf[2 * lane + 1] = s;
    wts[2 * lane] = __expf(tot - (s - a1)); wts[2 * lane + 1] = __expf(tot - s);
}
__device__ __forceinline__ void p3_ssd3(Frame& F) {
    const int tid0 = threadIdx.x, w = __builtin_amdgcn_readfirstlane(tid0 >> 6);
    LAS unsigned char* L = F.lds;
    const bf16* proj = WSP(bf16, WS_PROJ); const bf16* xc = (const bf16*)F.out; const float* dtraw = WSP(float, WS_DTRAW);
    for (int item = F.vcu; item < NB * NHEADS; item += F.G) {
        const int b = item >> 4, h = item & 15, g = h >> 2;
        int tid = tid0; asm volatile("" : "+v"(tid)); int lane = tid & 63;
        const float A = -__expf((F.a->in[9])[h]), Dh = (F.a->in[10])[h], dtb = (F.a->in[8])[h];
        const int pbs = w >> 1, nb0 = 4 * (w & 1);
        f32x4 st[4];
#pragma unroll
        for (int j = 0; j < 4; ++j) st[j] = (f32x4){0.f, 0.f, 0.f, 0.f};
        __syncthreads();
        for (int i = tid; i < 17408 / 16; i += NTHR) ((LAS v4u*)(L + S3_PREV))[i] = (v4u){0u, 0u, 0u, 0u};
        Ssd3Pre P;
        { const unsigned voB0 = (unsigned)((4 * (tid >> 4)) * 2048 + 1024 + g * 128 + 8 * (tid & 15)) * 2u, voX0 = (unsigned)((4 * ((tid & 255) >> 3)) * 2048 + h * 64 + 8 * (tid & 7)) * 2u;
          ssd3_prefetch(P, (const char*)xc + (size_t)b * SEQ * 4096, dtraw + (size_t)b * SEQ * 16 + h, voB0, voX0, tid, lane, w); }
        if (w == 0) ssd3_cumsum(L, 0, P.d0, P.d1, dtb, A, lane);
        __syncthreads();
#ifdef PROBE_SSD
        unsigned long long sacc[8] = {0, 0, 0, 0, 0, 0, 0, 0};
#endif
        for (int c = 0; c < SEQ / CHUNK; ++c) {
            SPR_T(s0)
            const size_t row0 = (size_t)b * SEQ + (size_t)c * CHUNK; const int par = c & 1;
            asm volatile("" : "+v"(tid));
            lane = tid & 63; const int li = lane & 15, lq = lane >> 4;
            const unsigned voB = (unsigned)((4 * (tid >> 4)) * 2048 + 1024 + g * 128 + 8 * (tid & 15)) * 2u, voX = (unsigned)((4 * ((tid & 255) >> 3)) * 2048 + h * 64 + 8 * (tid & 7)) * 2u;
            const unsigned voZ0 = (unsigned)((tid >> 3) * NPROJ + h * 64 + 8 * (tid & 7)) * 2u, voZ1 = voZ0 + 64u * NPROJ * 2u;
            LAS float* csf = (LAS float*)(L + S3_CSF + par * 512); LAS float* dtf = (LAS float*)(L + S3_DTF + par * 512); LAS float* wts = (LAS float*)(L + S3_WTS + par * 512);
            { const int ob = tid & 15, lb = 4 * (tid >> 4), n0 = 8 * ob;
#pragma unroll
              for (int r = 0; r < 4; ++r) { *(LAS v4u*)(L + S3_BS + (lb + r) * SSD_PITCH + n0 * 2) = P.br[r]; *(LAS v4u*)(L + S3_CS + (lb + r) * SSD_PITCH + n0 * 2) = P.cr[r]; } }
            if (tid < 256) { const int ox = tid & 7, lx = 4 * (tid >> 3), p0 = 8 * ox;
#pragma unroll
              for (int r = 0; r < 4; ++r) { float xv[8]; unpack8(P.xr[r], xv); const float tw = dtf[lx + r];
                  *(LAS v4u*)(L + S3_XDT + (lx + r) * S3_XP + p0 * 2) = (v4u){pk2(xv[0] * tw, xv[1] * tw), pk2(xv[2] * tw, xv[3] * tw), pk2(xv[4] * tw, xv[5] * tw), pk2(xv[6] * tw, xv[7] * tw)}; } }
            const char* prb = (const char*)proj + row0 * (NPROJ * 2);
            const v4u zc0 = *(const v4u*)(prb + voZ0), zc1 = *(const v4u*)(prb + voZ1);
            SPR_T(s1) SPR_ACC(0, s1 - s0)
            LDS_BARRIER();
            SPR_T(s2) SPR_ACC(1, s2 - s1)
            const float cs_end = csf[127];
            bf16x8 ca[4];
#pragma unroll
            for (int ks = 0; ks < 4; ++ks) ca[ks] = lds_frag(L + S3_CS, 16 * w + li, 64 * ks + 16 * lq);
            float csl[4];
#pragma unroll
            for (int r = 0; r < 4; ++r) csl[r] = csf[16 * w + 4 * lq + r];
            { bf16x8 bq[2][4];
#pragma unroll
              for (int ks = 0; ks < 4; ++ks) bq[0][ks] = lds_frag(L + S3_BS, li, 64 * ks + 16 * lq);
#pragma unroll
              for (int sb = 0; sb < 8; ++sb) if (sb <= (w | 1)) {
                  f32x4 cbv = (f32x4){0.f, 0.f, 0.f, 0.f};
                  const int s = 16 * sb + li; const float css = csf[s];
                  if (sb <= w) {
                      if (sb + 1 <= w) {
#pragma unroll
                          for (int ks = 0; ks < 4; ++ks) bq[(sb + 1) & 1][ks] = lds_frag(L + S3_BS, 16 * (sb + 1) + li, 64 * ks + 16 * lq); }
                      __builtin_amdgcn_sched_barrier(0);
#pragma unroll
                      for (int ks = 0; ks < 4; ++ks) cbv = __builtin_amdgcn_mfma_f32_16x16x32_bf16(ca[ks], bq[sb & 1][ks], cbv, 0, 0, 0);
                      __builtin_amdgcn_sched_barrier(0); }
#pragma unroll
                  for (int r = 0; r < 4; ++r) { const int l = 16 * w + 4 * lq + r; const float gv = (s <= l) ? cbv[r] * __expf(csl[r] - css) : 0.f;
                      *(LAS unsigned short*)(L + S3_GY + l * SSD_PITCH + s * 2) = (unsigned short)f2bf(gv); } } }
            LDS_WAIT(); asm volatile("" ::: "memory");
            SPR_T(s3) SPR_ACC(2, s3 - s2)
            f32x4 yd[4], yo[4];
#pragma unroll
            for (int pb = 0; pb < 4; ++pb) { yd[pb] = (f32x4){0.f, 0.f, 0.f, 0.f}; yo[pb] = (f32x4){0.f, 0.f, 0.f, 0.f}; }
            { bf16x8 gq[2], xq[2][4];
              gq[0] = lds_frag(L + S3_GY, 16 * w + li, 16 * lq);
#pragma unroll
              for (int pb = 0; pb < 4; ++pb) xq[0][pb] = lds_frag_tr(L + S3_XDT, S3_XP, 0, 16 * pb, li, lq);
#pragma unroll
              for (int ks = 0; ks < 4; ++ks) if (ks <= (w >> 1)) {
                  if (ks + 1 <= (w >> 1)) { gq[(ks + 1) & 1] = lds_frag(L + S3_GY, 16 * w + li, 64 * (ks + 1) + 16 * lq);
#pragma unroll
                      for (int pb = 0; pb < 4; ++pb) xq[(ks + 1) & 1][pb] = lds_frag_tr(L + S3_XDT, S3_XP, 32 * (ks + 1), 16 * pb, li, lq); }
                  __builtin_amdgcn_sched_barrier(0);
#pragma unroll
                  for (int pb = 0; pb < 4; ++pb) yd[pb] = __builtin_amdgcn_mfma_f32_16x16x32_bf16(gq[ks & 1], xq[ks & 1][pb], yd[pb], 0, 0, 0);
                  __builtin_amdgcn_sched_barrier(0); } }
            { bf16x8 pq[2][4];
#pragma unroll
              for (int pb = 0; pb < 4; ++pb) pq[0][pb] = lds_frag(L + S3_PREV, 16 * pb + li, 16 * lq);
#pragma unroll
              for (int ks = 0; ks < 4; ++ks) {
                  if (ks < 3) {
#pragma unroll
                      for (int pb = 0; pb < 4; ++pb) pq[(ks + 1) & 1][pb] = lds_frag(L + S3_PREV, 16 * pb + li, 64 * (ks + 1) + 16 * lq); }
                  __builtin_amdgcn_sched_barrier(0);
#pragma unroll
                  for (int pb = 0; pb < 4; ++pb) yo[pb] = __builtin_amdgcn_mfma_f32_16x16x32_bf16(ca[ks], pq[ks & 1][pb], yo[pb], 0, 0, 0);
                  __builtin_amdgcn_sched_barrier(0); } }
#pragma unroll
            for (int r = 0; r < 4; ++r) { const float e = __expf(csl[r]);
#pragma unroll
                for (int pb = 0; pb < 4; ++pb) *(LAS float*)(L + S3_GY + (16 * w + 4 * lq + r) * SSD_PITCH + (16 * pb + li) * 4) = yd[pb][r] + e * yo[pb][r]; }
            { const size_t rown = row0 + (c + 1 < SEQ / CHUNK ? CHUNK : 0);
              ssd3_prefetch(P, (const char*)xc + rown * 4096, dtraw + rown * 16 + h, voB, voX, tid, lane, w); }
            SPR_T(s4) SPR_ACC(3, s4 - s3)
            LDS_BARRIER();
            SPR_T(s5) SPR_ACC(4, s5 - s4)
            { const float dec = __expf(cs_end);
#pragma unroll
              for (int j = 0; j < 4; ++j) st[j] = st[j] * dec;
              bf16x8 xq[2], bq2[2][4]; f32x4 wq[2][2];
              xq[0] = lds_frag_tr(L + S3_XDT, S3_XP, 0, 16 * pbs, li, lq); wq[0][0] = *(const LAS f32x4*)(wts + 8 * lq); wq[0][1] = *(const LAS f32x4*)(wts + 8 * lq + 4);
#pragma unroll
              for (int j = 0; j < 4; ++j) bq2[0][j] = lds_frag_tr(L + S3_BS, SSD_PITCH, 0, 16 * (nb0 + j), li, lq);
#pragma unroll
              for (int ks = 0; ks < 4; ++ks) {
                  if (ks < 3) { xq[(ks + 1) & 1] = lds_frag_tr(L + S3_XDT, S3_XP, 32 * (ks + 1), 16 * pbs, li, lq); wq[(ks + 1) & 1][0] = *(const LAS f32x4*)(wts + 32 * (ks + 1) + 8 * lq); wq[(ks + 1) & 1][1] = *(const LAS f32x4*)(wts + 32 * (ks + 1) + 8 * lq + 4);
#pragma unroll
                      for (int j = 0; j < 4; ++j) bq2[(ks + 1) & 1][j] = lds_frag_tr(L + S3_BS, SSD_PITCH, 32 * (ks + 1), 16 * (nb0 + j), li, lq); }
                  __builtin_amdgcn_sched_barrier(0);
                  const f32x4 w0 = wq[ks & 1][0], w1 = wq[ks & 1][1];
                  float xv[8]; unpack8(__builtin_bit_cast(v4u, xq[ks & 1]), xv);
                  const v4u xw = (v4u){pk2(xv[0] * w0[0], xv[1] * w0[1]), pk2(xv[2] * w0[2], xv[3] * w0[3]), pk2(xv[4] * w1[0], xv[5] * w1[1]), pk2(xv[6] * w1[2], xv[7] * w1[3])};
                  const bf16x8 xf = __builtin_bit_cast(bf16x8, xw);
#pragma unroll
                  for (int j = 0; j < 4; ++j) st[j] = __builtin_amdgcn_mfma_f32_16x16x32_bf16(xf, bq2[ks & 1][j], st[j], 0, 0, 0);
                  __builtin_amdgcn_sched_barrier(0); }
#pragma unroll
              for (int j = 0; j < 4; ++j)
#pragma unroll
                  for (int r = 0; r < 4; ++r) *(LAS unsigned short*)(L + S3_PREV + (16 * pbs + 4 * lq + r) * SSD_PITCH + (16 * (nb0 + j) + li) * 2) = (unsigned short)f2bf(st[j][r]); }
            SPR_T(s6) SPR_ACC(5, s6 - s5)
#pragma unroll
            for (int k = 0; k < 2; ++k) { const int it = tid + 512 * k, l = it >> 3, o = it & 7; const size_t row = row0 + l;
                const f32x4 y0 = *(const LAS f32x4*)(L + S3_GY + l * SSD_PITCH + 32 * o), y1 = *(const LAS f32x4*)(L + S3_GY + l * SSD_PITCH + 32 * o + 16);
                const v4u xw = *(const LAS v4u*)(L + S3_XDT + l * S3_XP + 16 * o); const v4u zw = k == 0 ? zc0 : zc1; const float dsk = Dh * __builtin_amdgcn_rcpf(fmaxf(dtf[l], 1e-30f));
                float xv[8], zv[8], yv[8]; unpack8(xw, xv); unpack8(zw, zv);
                float ss = 0.f;
#pragma unroll
                for (int e = 0; e < 8; ++e) { const float yy = (e < 4 ? y0[e] : y1[e - 4]) + dsk * xv[e]; yv[e] = yy * silu_f(zv[e]); ss += yv[e] * yv[e]; }
                ss += __shfl_xor(ss, 1); ss += __shfl_xor(ss, 2); ss += __shfl_xor(ss, 4);
                if (o == 0) WSP(float, WS_STSSD)[row * 16 + h] = ss;
                *(v4u*)(WSP(bf16, WS_Y) + row * 2048 + h * 64 + 8 * o) = (v4u){pk2(yv[0], yv[1]), pk2(yv[2], yv[3]), pk2(yv[4], yv[5]), pk2(yv[6], yv[7])}; }
            if (w == 0 && c + 1 < SEQ / CHUNK) ssd3_cumsum(L, par ^ 1, P.d0, P.d1, dtb, A, lane);
            SPR_T(s7) SPR_ACC(6, s7 - s6)
            LDS_BARRIER();
            SPR_T(s8) SPR_ACC(7, s8 - s7)
        }
#ifdef PROBE_SSD
        if (blockIdx.x == 0 && threadIdx.x == PROBE_TID) *(volatile float*)(F.ws + WS_CTL + 40000) = (float)sacc[PROBE_SSD] * 1e-3f;
#endif
    }
}
typedef float f32x16 __attribute__((ext_vector_type(16)));
#ifdef PROBE_SEL
#define PR_T(v) const unsigned long long v = __builtin_amdgcn_s_memtime();
#define PR_ACC(a, d) a += (d);
#define PR_OUT(i, a) if (PROBE_SEL == (i) && blockIdx.x == 0 && threadIdx.x == 0) *(volatile float*)(F.ws + WS_CTL + 40000) = (float)(a) * 1e-4f;
#define PR_OUT4(i, a) if (PROBE_SEL == (i) && blockIdx.x == 0 && threadIdx.x == 256) *(volatile float*)(F.ws + WS_CTL + 40000) = (float)(a) * 1e-4f;
#else
#define PR_T(v)
#define PR_ACC(a, d)
#define PR_OUT(i, a)
#define PR_OUT4(i, a)
#endif
constexpr int S5V_BU = 0, S5V_BUP = 2056, S5V_BUSZ = 16 * S5V_BUP, S5V_XT = 2 * S5V_BUSZ, S5V_XTP = 1040, S5V_XTSZ = 16 * S5V_XTP, S5V_VS = S5V_XT + 2 * S5V_XTSZ, S5V_OT = S5V_VS + 4 * 512, S5V_OTP = 144, S5V_OTSZ = 16 * S5V_OTP, S5V_END = S5V_OT + 2 * S5V_OTSZ;
static_assert(S5V_END <= LDS_MAIN, "S5 v2 LDS map");
__device__ __forceinline__ void p3_s5v2(Frame& F) {
    const int tid = threadIdx.x, lane = tid & 63, w = __builtin_amdgcn_readfirstlane(tid >> 6);
    const int li = lane & 15, lq = lane >> 4;
    LAS unsigned char* L = F.lds;
    const bf16* proj = WSP(bf16, WS_PROJ);
    constexpr int NT = SEQ / 16;
#ifdef PROBE_S5
    const unsigned long long pr_t0 = PROBE_CLOCK();
#endif
    for (int item = F.vcu; item < NB * 16; item += F.G) {
        const int b = item >> 4, gs = item & 15;
        const bool scanw = w < 4; const int gl = w & 3, g = gs * 4 + gl;
        const bf16* ubase = proj + (size_t)b * SEQ * NPROJ + 3072 + gs * 64 + gl * 16;
        __syncthreads();
        if (scanw) {
            __builtin_amdgcn_s_setprio(2);
            const float lbr = WSP(float, WS_S5LB)[(g * 64 + lane) * 2], lbi = WSP(float, WS_S5LB)[(g * 64 + lane) * 2 + 1], nlbi = -lbi;
            bf16x8 bfr[8];
#pragma unroll
            for (int cb = 0; cb < 8; ++cb) { v4u v = (v4u){0u, 0u, 0u, 0u};
                if (lq < 2) { const int col = 16 * cb + li; const float* src = WSP(float, WS_S5BB) + (g * 64 + (col >> 1)) * 32 + (col & 1) * 16 + 8 * lq; const f32x4 a0 = *(const f32x4*)src, a1 = *(const f32x4*)(src + 4);
                    v = (v4u){pk2(a0[0], a0[1]), pk2(a0[2], a0[3]), pk2(a1[0], a1[1]), pk2(a1[2], a1[3])}; }
                bfr[cb] = __builtin_bit_cast(bf16x8, v); }
            float xr = 0.f, xi = 0.f;
            const int lq2 = lq & 1;
            v4u ua = *(const v4u*)(ubase + (size_t)li * NPROJ + 8 * lq2);
            { const bf16x8 af = __builtin_bit_cast(bf16x8, lq < 2 ? ua : (v4u){0u, 0u, 0u, 0u});
              ua = *(const v4u*)(ubase + (size_t)(16 + li) * NPROJ + 8 * lq2);
#pragma unroll
              for (int cb = 0; cb < 8; ++cb) { f32x4 acc = (f32x4){0.f, 0.f, 0.f, 0.f}; acc = __builtin_amdgcn_mfma_f32_16x16x32_bf16(af, bfr[cb], acc, 0, 0, 0);
#pragma unroll
                  for (int r = 0; r < 4; ++r) *(LAS float*)(L + S5V_BU + (4 * lq + r) * S5V_BUP + (gl * 128 + 16 * cb + li) * 4) = acc[r]; } }
            LDS_BARRIER();
            unsigned long long pa0 = 0, pa1 = 0, pa2 = 0;
            for (int k = 0; k <= NT; ++k) {
                PR_T(pt0)
                if (k < NT) {
                    const LAS f32x2* bp = (const LAS f32x2*)(L + S5V_BU + (k & 1) * S5V_BUSZ + (gl * 128 + 2 * lane) * 4);
                    LAS unsigned* xp = (LAS unsigned*)(L + S5V_XT + (k & 1) * S5V_XTSZ + (gl * 128 + 2 * lane) * 2);
                    f32x2 bu[16];
#pragma unroll
                    for (int t = 0; t < 16; ++t) bu[t] = bp[t * (S5V_BUP / 8)];
                    unsigned xo[16];
#pragma unroll
                    for (int t = 0; t < 16; ++t) {
                        const float a = __builtin_fmaf(nlbi, xi, bu[t][0]), bq = __builtin_fmaf(lbi, xr, bu[t][1]);
                        const float nr = __builtin_fmaf(lbr, xr, a), ni = __builtin_fmaf(lbr, xi, bq); xr = nr; xi = ni; xo[t] = pk2(xr, xi); }
#pragma unroll
                    for (int t = 0; t < 16; ++t) xp[t * (S5V_XTP / 4)] = xo[t];
                    PR_T(pt1) PR_ACC(pa0, pt1 - pt0)
                    if (k + 1 < NT) {
                        const bf16x8 af = __builtin_bit_cast(bf16x8, lq < 2 ? ua : (v4u){0u, 0u, 0u, 0u});
                        { const int kn = k + 2 < NT ? k + 2 : NT - 1; ua = *(const v4u*)(ubase + (size_t)(16 * kn + li) * NPROJ + 8 * lq2); }
                        LAS unsigned char* bun = L + S5V_BU + ((k + 1) & 1) * S5V_BUSZ;
#pragma unroll
                        for (int cb = 0; cb < 8; ++cb) { f32x4 acc = (f32x4){0.f, 0.f, 0.f, 0.f}; acc = __builtin_amdgcn_mfma_f32_16x16x32_bf16(af, bfr[cb], acc, 0, 0, 0);
#pragma unroll
                            for (int r = 0; r < 4; ++r) *(LAS float*)(bun + (4 * lq + r) * S5V_BUP + (gl * 128 + 16 * cb + li) * 4) = acc[r]; }
                    }
                }
                PR_T(pt2) PR_ACC(pa1, pt2 - pt0)
                LDS_BARRIER();
                PR_T(pt3) PR_ACC(pa2, pt3 - pt2)
            }
            __builtin_amdgcn_s_setprio(0);
            PR_OUT(0, pa0) PR_OUT(1, pa1) PR_OUT(2, pa2)
        } else {
            bf16x8 cfr[4];
#pragma unroll
            for (int ks = 0; ks < 4; ++ks) { const float* cr = (F.a->in[17]) + (g * 16 + li) * 64 + 16 * ks + 4 * lq; const float* ci = (F.a->in[18]) + (g * 16 + li) * 64 + 16 * ks + 4 * lq;
                const f32x4 r0 = *(const f32x4*)cr, i0 = *(const f32x4*)ci;
                cfr[ks] = __builtin_bit_cast(bf16x8, ((v4u){pk2(r0[0], -i0[0]), pk2(r0[1], -i0[1]), pk2(r0[2], -i0[2]), pk2(r0[3], -i0[3])})); }
            v4u gwv = (v4u){0u, 0u, 0u, 0u};
            if (lq < 2) { float gwf[8];
#pragma unroll
                for (int j = 0; j < 8; ++j) gwf[j] = (F.a->in[20])[(g * 16 + 8 * lq + j) * 16 + li];
                gwv = (v4u){pk2(gwf[0], gwf[1]), pk2(gwf[2], gwf[3]), pk2(gwf[4], gwf[5]), pk2(gwf[6], gwf[7])}; }
            const bf16x8 gfr = __builtin_bit_cast(bf16x8, gwv);
            const float dsk = (F.a->in[19])[g * 16 + li], gbias = (F.a->in[21])[g * 16 + li];
            LAS unsigned char* vs = L + S5V_VS + gl * 512;
            float uo[4], un[4];
#pragma unroll
            for (int r = 0; r < 4; ++r) { uo[r] = bf2f(ubase[(size_t)(4 * lq + r) * NPROJ + li]); un[r] = bf2f(ubase[(size_t)(16 + 4 * lq + r) * NPROJ + li]); }
            LDS_BARRIER();
            unsigned long long pb0 = 0, pb1 = 0;
            for (int k = 0; k <= NT; ++k) {
                PR_T(qt0)
                float u2[4];
                { const int kn = k + 1 < NT ? k + 1 : NT - 1;
#pragma unroll
                  for (int r = 0; r < 4; ++r) u2[r] = bf2f(ubase[(size_t)(16 * kn + 4 * lq + r) * NPROJ + li]); }
                if (k >= 2) {
                    const int t = ((tid - 256) >> 3) & 15, oc = tid & 7; const v4u ov = *(const LAS v4u*)(L + S5V_OT + (k & 1) * S5V_OTSZ + t * S5V_OTP + 16 * oc);
                    if (tid < 384) *(v4u*)(WSP(bf16, WS_Y) + ((size_t)b * SEQ + 16 * (k - 2) + t) * 2048 + 1024 + gs * 64 + 8 * oc) = ov; }
                if (k >= 1) {
                    const int kt = k - 1; const LAS unsigned char* xt = L + S5V_XT + (kt & 1) * S5V_XTSZ;
                    f32x4 yacc = (f32x4){0.f, 0.f, 0.f, 0.f};
#pragma unroll
                    for (int ks = 0; ks < 4; ++ks) yacc = __builtin_amdgcn_mfma_f32_16x16x32_bf16(*(const LAS bf16x8*)(xt + li * S5V_XTP + (gl * 128 + 32 * ks + 8 * lq) * 2), cfr[ks], yacc, 0, 0, 0);
                    float v[4];
                    { const f32x2 g0 = gelu_pk2((f32x2){yacc[0] + dsk * uo[0], yacc[1] + dsk * uo[1]}), g1 = gelu_pk2((f32x2){yacc[2] + dsk * uo[2], yacc[3] + dsk * uo[3]}); v[0] = g0[0]; v[1] = g0[1]; v[2] = g1[0]; v[3] = g1[1]; }
#pragma unroll
                    for (int r = 0; r < 4; ++r) *(LAS unsigned short*)(vs + (4 * lq + r) * 32 + li * 2) = (unsigned short)f2bf(v[r]);
                    LDS_WAIT(); asm volatile("" ::: "memory");
                    v4u va = (v4u){0u, 0u, 0u, 0u};
                    if (lq < 2) va = *(const LAS v4u*)(vs + li * 32 + 16 * lq);
                    f32x4 gacc = (f32x4){0.f, 0.f, 0.f, 0.f};
                    gacc = __builtin_amdgcn_mfma_f32_16x16x32_bf16(__builtin_bit_cast(bf16x8, va), gfr, gacc, 0, 0, 0);
                    float o[4], ss[4];
#pragma unroll
                    for (int r = 0; r < 4; ++r) { o[r] = v[r] * sigmoid_f(gacc[r] + gbias); ss[r] = o[r] * o[r]; }
#pragma unroll
                    for (int r = 0; r < 4; ++r) ss[r] = row16_sum_to15(ss[r]);
                    if (li == 15) {
#pragma unroll
                        for (int r = 0; r < 4; ++r) WSP(float, WS_STS5)[((size_t)b * SEQ + 16 * kt + 4 * lq + r) * NS5PART + g] = ss[r]; }
                    LAS unsigned char* ot = L + S5V_OT + (kt & 1) * S5V_OTSZ;
#pragma unroll
                    for (int r = 0; r < 4; ++r) *(LAS unsigned short*)(ot + (4 * lq + r) * S5V_OTP + (gl * 16 + li) * 2) = (unsigned short)f2bf(o[r]);
#pragma unroll
                    for (int r = 0; r < 4; ++r) { uo[r] = un[r]; un[r] = u2[r]; }
                }
                PR_T(qt1) PR_ACC(pb0, qt1 - qt0)
                LDS_BARRIER();
                PR_T(qt2) PR_ACC(pb1, qt2 - qt1)
            }
            PR_OUT4(3, pb0) PR_OUT4(4, pb1)
            { const int t = ((tid - 256) >> 3) & 15, oc = tid & 7; const v4u ov = *(const LAS v4u*)(L + S5V_OT + ((NT - 1) & 1) * S5V_OTSZ + t * S5V_OTP + 16 * oc);
              if (tid < 384) *(v4u*)(WSP(bf16, WS_Y) + ((size_t)b * SEQ + 16 * (NT - 1) + t) * 2048 + 1024 + gs * 64 + 8 * oc) = ov; }
        }
    }
#ifdef PROBE_S5
    if (blockIdx.x == 0 && threadIdx.x == 0) *(volatile float*)(F.ws + WS_CTL + 40000) = (float)(PROBE_CLOCK() - pr_t0) * PROBE_SCALE;
#endif
}
__device__ __forceinline__ unsigned med3u(unsigned a, unsigned b, unsigned c) { unsigned r; asm("v_med3_u32 %0, %1, %2, %3" : "=v"(r) : "v"(a), "v"(b), "v"(c)); return r; }
__device__ __forceinline__ unsigned fkey(float v) { const unsigned u = __builtin_bit_cast(unsigned, v); return (u & 0x80000000u) ? ~u : (u | 0x80000000u); }
__device__ __forceinline__ float fkey_inv(unsigned k) { const unsigned u = (k & 0x80000000u) ? (k & 0x7fffffffu) : ~k; return __builtin_bit_cast(float, u); }
#define TOPK_INSERT(a, x) do { _Pragma("unroll") for (int _i = 15; _i >= 1; --_i) a[_i] = med3u(a[_i - 1], a[_i], (x)); a[0] = a[0] > (x) ? a[0] : (x); } while (0)
__device__ __forceinline__ unsigned fp6_code(float y) {
    const float a = fabsf(y);
    const float c = a < 2.0f ? __builtin_rintf(8.0f * a) : (a < 4.0f ? __builtin_rintf(4.0f * a) + 8.0f : fminf(__builtin_rintf(2.0f * a) + 16.0f, 31.0f));
    return (unsigned)c | (y < 0.f ? 32u : 0u);
}
__device__ __forceinline__ void fp6_pack16(const unsigned* c, unsigned& w0, unsigned& w1, unsigned& w2) {
    w0 = c[0] | (c[1] << 6) | (c[2] << 12) | (c[3] << 18) | (c[4] << 24) | (c[5] << 30);
    w1 = (c[5] >> 2) | (c[6] << 4) | (c[7] << 10) | (c[8] << 16) | (c[9] << 22) | (c[10] << 28);
    w2 = (c[10] >> 4) | (c[11] << 2) | (c[12] << 8) | (c[13] << 14) | (c[14] << 20) | (c[15] << 26);
}
__device__ __forceinline__ void h2_convert(Frame& F, int w0, int nw, int f_lane) {
    for (int tb = w0 * 16; tb < MTOK; tb += nw * 16) {
        const float* sh = WSP(float, WS_MOD) + (size_t)(tb >> 11) * 6144 + 3072 + 16 * f_lane;
        float S2[16];
#pragma unroll
        for (int q = 0; q < 4; ++q) { const f32x4 s4 = *(const f32x4*)(sh + 4 * q); S2[4 * q] = s4[0]; S2[4 * q + 1] = s4[1]; S2[4 * q + 2] = s4[2]; S2[4 * q + 3] = s4[3]; }
#pragma unroll 1
        for (int k = 0; k < 16; k += 4) {
            v4u xa[4], xb[4]; float rst[4];
#pragma unroll
            for (int u = 0; u < 4; ++u) { const int t = tb + k + u; const char* xs = (const char*)(WSP(bf16, WS_X1S) + (size_t)t * 1024) + 32 * f_lane; xa[u] = *(const v4u*)xs; xb[u] = *(const v4u*)(xs + 16); rst[u] = WSP(float, WS_ROWSTAT)[t]; }
#pragma unroll
            for (int u = 0; u < 4; ++u) { const int t = tb + k + u;
                const float rs = rsqrt_f(rst[u] * (1.0f / 1024.0f) + EPSF);
                float h2[16]; unpack8(xa[u], h2); unpack8(xb[u], h2 + 8); float mx = 0.f;
#pragma unroll
                for (int i = 0; i < 16; ++i) { h2[i] = h2[i] * rs + S2[i]; mx = fmaxf(mx, fabsf(h2[i])); }
#pragma unroll
                for (int o = 1; o < 64; o <<= 1) mx = fmaxf(mx, __shfl_xor(mx, o));
                mx = fmaxf(mx, 1e-30f); const float hs = 224.0f / mx;
                v4u w;
#pragma unroll
                for (int q = 0; q < 4; ++q) { int pk = 0; pk = __builtin_amdgcn_cvt_pk_fp8_f32(h2[4 * q] * hs, h2[4 * q + 1] * hs, pk, false); pk = __builtin_amdgcn_cvt_pk_fp8_f32(h2[4 * q + 2] * hs, h2[4 * q + 3] * hs, pk, true); w[q] = (unsigned)pk; }
                *(v4u*)(F.ws + WS_H2Q + (size_t)t * 1024 + 16 * f_lane) = w;
                if (f_lane == 0) WSP(float, WS_HINV)[t] = mx * (1.0f / 224.0f); }
        }
    }
}
__device__ __forceinline__ void expert_convert(Frame& F, int w0, int nw, int f_lane) {
    for (int rw = w0; rw < 2 * 16384; rw += 2 * nw) {
        f32x4 v[2][4]; float mx[2];
#pragma unroll
        for (int u = 0; u < 2; ++u) { const int r = rw + u * nw; const int tb = r >= 16384, e = tb ? r - 16384 : r; const float* src = (tb ? (F.a->in[28]) : (F.a->in[27])) + (size_t)e * 1024 + 16 * f_lane;
#pragma unroll
            for (int q = 0; q < 4; ++q) v[u][q] = *(const f32x4*)(src + 4 * q); }
#pragma unroll
        for (int u = 0; u < 2; ++u) { float m = 0.f;
#pragma unroll
            for (int q = 0; q < 4; ++q) m = fmaxf(m, fmaxf(fmaxf(fabsf(v[u][q][0]), fabsf(v[u][q][1])), fmaxf(fabsf(v[u][q][2]), fabsf(v[u][q][3]))));
#pragma unroll
            for (int o = 1; o < 64; o <<= 1) m = fmaxf(m, __shfl_xor(m, o));
            mx[u] = fmaxf(m, 1e-30f); }
#pragma unroll
        for (int u = 0; u < 2; ++u) { const int r = rw + u * nw; const int tb = r >= 16384, e = tb ? r - 16384 : r; const float sc = 224.0f / mx[u];
            v4u w;
#pragma unroll
            for (int q = 0; q < 4; ++q) { int pk = 0; pk = __builtin_amdgcn_cvt_pk_fp8_f32(v[u][q][0] * sc, v[u][q][1] * sc, pk, false); pk = __builtin_amdgcn_cvt_pk_fp8_f32(v[u][q][2] * sc, v[u][q][3] * sc, pk, true); w[q] = (unsigned)pk; }
#ifdef V6
            if (tb) {
                const float s6 = 7.5f / mx[u]; unsigned cd[16];
#pragma unroll
                for (int q = 0; q < 4; ++q)
#pragma unroll
                    for (int i = 0; i < 4; ++i) cd[4 * q + i] = fp6_code(v[u][q][i] * s6);
                unsigned w0, w1, w2; fp6_pack16(cd, w0, w1, w2);
                unsigned* dst = (unsigned*)(F.ws + WS_EV + (size_t)e * 768 + 12 * f_lane); dst[0] = w0; dst[1] = w1; dst[2] = w2;
                if (f_lane == 0) WSP(float, WS_EVS)[e] = mx[u] * (1.0f / 7.5f);
                continue; }
#endif
            *(v4u*)(F.ws + (tb ? WS_EV : WS_EU) + (size_t)e * 1024 + 16 * f_lane) = w;
            if (f_lane == 0) WSP(float, tb ? WS_EVS : WS_EUS)[e] = mx[u] * (1.0f / 224.0f); }
    }
}
__device__ __forceinline__ void p5b_topk(Frame& F) {
    const int f_tid = threadIdx.x, f_lane = f_tid & 63, f_wave = __builtin_amdgcn_readfirstlane(f_tid >> 6);
    const _Float16* scores = WSP(_Float16, WS_SCORES);
    LAS unsigned char* ix = (LAS unsigned char*)F.lds + f_tid * 36;
#pragma unroll 1
    for (int half = 0; half < 2; ++half) {
#ifdef UP11
    if ((f_wave >> 2) != half) { expert_convert(F, (F.vcu * 4 + (f_wave & 3)) * 2 + half, F.G * 8, f_lane); h2_convert(F, (F.vcu * 4 + (f_wave & 3)) * 2 + half, F.G * 8, f_lane); continue; }
#else
    if ((f_wave >> 2) != half) { expert_convert(F, (F.vcu * 4 + (f_wave & 3)) * 2 + half, F.G * 8, f_lane); continue; }
#endif
    typedef _Float16 f16x8 __attribute__((ext_vector_type(8)));
    f16x8 sva[8], svb[8];
    { const int item0 = (F.vcu * 2 + half) * 256 + (f_tid & 255); const _Float16* sp0 = scores + (size_t)(item0 >> 3) * 2048 + (item0 & 7) * 256;
#pragma unroll
      for (int q = 0; q < 8; ++q) sva[q] = *(const f16x8*)(sp0 + 8 * q); }
#pragma unroll 1
    for (int item = (F.vcu * 2 + half) * 256 + (f_tid & 255); item < MTOK * PH; item += F.G * 512) {
        const int t = item >> 3, hd = item & 7;
        unsigned a1[16], a2[16];
#pragma unroll
        for (int i = 0; i < 16; ++i) { a1[i] = 0u; a2[i] = 0u; }
        const _Float16* sp = scores + (size_t)t * 2048 + hd * 256;
        const int itn = (item + F.G * 512 < MTOK * PH) ? item + F.G * 512 : item;
        const _Float16* spn = scores + (size_t)(itn >> 3) * 2048 + (itn & 7) * 256;
#define TK_BATCH(CUR, NXT, NP, A, M) { \
        { _Pragma("unroll") for (int q = 0; q < 8; ++q) NXT[q] = *(const f16x8*)((NP) + 8 * q); } \
        __builtin_amdgcn_sched_barrier(0); \
        _Pragma("unroll") for (int q = 0; q < 8; ++q) { _Pragma("unroll") for (int e = 0; e < 8; ++e) { const unsigned k = (fkey((float)CUR[q][e]) & ~127u) | (unsigned)(127 - (64 * (M) + 8 * q + e)); TOPK_INSERT(A, k); } } }
        TK_BATCH(sva, svb, sp + 64, a1, 0)
        TK_BATCH(svb, sva, sp + 128, a1, 1)
        TK_BATCH(sva, svb, sp + 192, a2, 0)
        TK_BATCH(svb, sva, spn, a2, 1)
#undef TK_BATCH
        float v1[16], v2[16];
#pragma unroll
        for (int i = 0; i < 16; ++i) { ix[i] = (unsigned char)(127u - (a1[i] & 127u)); ix[16 + i] = (unsigned char)(127u - (a2[i] & 127u)); v1[i] = fkey_inv(a1[i] & ~127u); v2[i] = fkey_inv(a2[i] & ~127u); }
        unsigned cb[16];
#pragma unroll
        for (int i = 0; i < 16; ++i) cb[i] = 0u;
#pragma unroll
        for (int i = 0; i < 16; ++i)
#pragma unroll
            for (int j = 0; j < 16; ++j) if ((i + 1) * (j + 1) <= 16) { const unsigned k = (fkey(v1[i] + v2[j]) & ~255u) | (unsigned)(255 - (i * 16 + j)); TOPK_INSERT(cb, k); }
        float tv[16]; float mx = -3.0e38f;
#pragma unroll
        for (int k = 0; k < 16; ++k) { tv[k] = fkey_inv(cb[k] & ~255u); mx = fmaxf(mx, tv[k]); }
        float sum = 0.f;
#pragma unroll
        for (int k = 0; k < 16; ++k) { tv[k] = __expf(tv[k] - mx); sum += tv[k]; }
        const float inv = 1.0f / sum;
        LDS_WAIT(); asm volatile("" ::: "memory");
        int ev[16]; unsigned long long c64 = 0ull;
#pragma unroll
        for (int k = 0; k < 16; ++k) { const unsigned code = 255u - (cb[k] & 255u); const int i = code >> 4, j = code & 15; ev[k] = (int)ix[i] * 128 + (int)ix[16 + j]; c64 += 1ull << (8 * (ev[k] >> 11)); }
        unsigned long long s64 = c64;
#pragma unroll
        for (int o = 1; o < 8; o <<= 1) { const unsigned lo = __shfl_up((unsigned)s64, o, 8), hi = __shfl_up((unsigned)(s64 >> 32), o, 8); if ((f_lane & 7) >= o) s64 += ((unsigned long long)hi << 32) | lo; }
        const unsigned long long e64 = s64 - c64;
        const unsigned long long t64 = ((unsigned long long)__shfl((unsigned)(s64 >> 32), 7, 8) << 32) | __shfl((unsigned)s64, 7, 8);
        const unsigned long long st64 = (t64 * 0x0101010101010101ull) << 8;
        unsigned long long base64 = st64 + e64;
        int* eo = WSP(int, WS_EID) + (size_t)t * 128; float* go = WSP(float, WS_GATE) + (size_t)t * 128;
#pragma unroll
        for (int k = 0; k < 16; ++k) { const int r8 = 8 * (ev[k] >> 11); const int slot = (int)((base64 >> r8) & 255ull); base64 += 1ull << r8; eo[slot] = ev[k]; go[slot] = tv[k] * inv; }
        if (hd == 0) WSP(unsigned long long, WS_START)[t] = st64;
        LDS_WAIT(); asm volatile("" ::: "memory");
    }
    }
}
__device__ __forceinline__ void dec16(const v4u q, float* f) {
#pragma unroll
    for (int i = 0; i < 4; ++i) { const f32x2 lo = __builtin_amdgcn_cvt_pk_f32_fp8((int)q[i], false), hi = __builtin_amdgcn_cvt_pk_f32_fp8((int)q[i], true); f[4 * i] = lo[0]; f[4 * i + 1] = lo[1]; f[4 * i + 2] = hi[0]; f[4 * i + 3] = hi[1]; }
}
struct CvE { f32x4 v[4]; };
struct CvH { v4u xa, xb; float rst; };
__device__ __forceinline__ void cve_load(CvE& c, Frame& F, int r, int f_lane) {
    const int tb = r >= 16384, e = tb ? r - 16384 : r; const float* src = (tb ? (F.a->in[28]) : (F.a->in[27])) + (size_t)e * 1024 + 16 * f_lane;
#pragma unroll
    for (int q = 0; q < 4; ++q) c.v[q] = *(const f32x4*)(src + 4 * q);
}
__device__ __forceinline__ void cve_finish(const CvE& c, Frame& F, int r, int f_lane) {
    const int tb = r >= 16384, e = tb ? r - 16384 : r; float m = 0.f;
#pragma unroll
    for (int q = 0; q < 4; ++q) m = fmaxf(m, fmaxf(fmaxf(fabsf(c.v[q][0]), fabsf(c.v[q][1])), fmaxf(fabsf(c.v[q][2]), fabsf(c.v[q][3]))));
#pragma unroll
    for (int o = 1; o < 64; o <<= 1) m = fmaxf(m, __shfl_xor(m, o));
    m = fmaxf(m, 1e-30f); const float sc = 224.0f / m;
    v4u w;
#pragma unroll
    for (int q = 0; q < 4; ++q) { int pk = 0; pk = __builtin_amdgcn_cvt_pk_fp8_f32(c.v[q][0] * sc, c.v[q][1] * sc, pk, false); pk = __builtin_amdgcn_cvt_pk_fp8_f32(c.v[q][2] * sc, c.v[q][3] * sc, pk, true); w[q] = (unsigned)pk; }
    *(v4u*)(F.ws + (tb ? WS_EV : WS_EU) + (size_t)e * 1024 + 16 * f_lane) = w;
    if (f_lane == 0) WSP(float, tb ? WS_EVS : WS_EUS)[e] = m * (1.0f / 224.0f);
}
__device__ __forceinline__ void cvh_load(CvH& c, Frame& F, int t, int f_lane) {
    const char* xs = (const char*)(WSP(bf16, WS_X1S) + (size_t)t * 1024) + 32 * f_lane; c.xa = *(const v4u*)xs; c.xb = *(const v4u*)(xs + 16); c.rst = WSP(float, WS_ROWSTAT)[t];
}
__device__ __forceinline__ void cvh_finish(const CvH& c, Frame& F, int t, int f_lane, const float* S2) {
    const float rs = rsqrt_f(c.rst * (1.0f / 1024.0f) + EPSF);
    float h2[16]; unpack8(c.xa, h2); unpack8(c.xb, h2 + 8); float mx = 0.f;
#pragma unroll
    for (int i = 0; i < 16; ++i) { h2[i] = h2[i] * rs + S2[i]; mx = fmaxf(mx, fabsf(h2[i])); }
#pragma unroll
    for (int o = 1; o < 64; o <<= 1) mx = fmaxf(mx, __shfl_xor(mx, o));
    mx = fmaxf(mx, 1e-30f); const float hs = 224.0f / mx;
    v4u w;
#pragma unroll
    for (int q = 0; q < 4; ++q) { int pk = 0; pk = __builtin_amdgcn_cvt_pk_fp8_f32(h2[4 * q] * hs, h2[4 * q + 1] * hs, pk, false); pk = __builtin_amdgcn_cvt_pk_fp8_f32(h2[4 * q + 2] * hs, h2[4 * q + 3] * hs, pk, true); w[q] = (unsigned)pk; }
    *(v4u*)(F.ws + WS_H2Q + (size_t)t * 1024 + 16 * f_lane) = w;
    if (f_lane == 0) WSP(float, WS_HINV)[t] = mx * (1.0f / 224.0f);
}
__device__ __forceinline__ void p5b_topk2(Frame& F) {
    const int f_tid = threadIdx.x, f_lane = f_tid & 63, f_wave = __builtin_amdgcn_readfirstlane(f_tid >> 6);
    const _Float16* scores = WSP(_Float16, WS_SCORES);
    LAS unsigned char* ix = (LAS unsigned char*)F.lds + f_tid * 36;
    const int gw = F.vcu * NWAVES + f_wave;
    static_assert(MTOK * PH == 2 * 256 * NTHR && MTOK == 16 * 256 * NWAVES, "P7 v2 work split");
    float S2[16];
    { const float* sh = WSP(float, WS_MOD) + (size_t)((gw * 16) >> 11) * 6144 + 3072 + 16 * f_lane;
#pragma unroll
      for (int q = 0; q < 4; ++q) { const f32x4 s4 = *(const f32x4*)(sh + 4 * q); S2[4 * q] = s4[0]; S2[4 * q + 1] = s4[1]; S2[4 * q + 2] = s4[2]; S2[4 * q + 3] = s4[3]; } }
    typedef _Float16 f16x8 __attribute__((ext_vector_type(8)));
    const int item_base = F.vcu * NTHR + f_tid, item_step = F.G * NTHR;
    f16x8 sva[8], svb[8];
    { const _Float16* sp0 = scores + (size_t)(item_base >> 3) * 2048 + (item_base & 7) * 256;
#pragma unroll
      for (int q = 0; q < 8; ++q) sva[q] = *(const f16x8*)(sp0 + 8 * q); }
    unsigned a1[16];
#pragma unroll
    for (int i = 0; i < 16; ++i) a1[i] = 0u;
#pragma unroll 1
    for (int hi = 0; hi < 4; ++hi) {
        const int item = item_base + (hi >> 1) * item_step; const int t = item >> 3, hd = item & 7, kh = hi & 1;
        const _Float16* sp = scores + (size_t)t * 2048 + hd * 256 + kh * 128;
        const int hn = hi < 3 ? hi + 1 : hi; const int itn = item_base + (hn >> 1) * item_step;
        const _Float16* spn = scores + (size_t)(itn >> 3) * 2048 + (itn & 7) * 256 + (hn & 1) * 128;
        unsigned a2[16];
#pragma unroll
        for (int i = 0; i < 16; ++i) a2[i] = 0u;
#define TK2_BATCH(CUR, NXT, NP, M) { \
        const int ku = 2 * (2 * hi + (M)); CvE e0, e1; CvH h0, h1; \
        { _Pragma("unroll") for (int q = 0; q < 8; ++q) NXT[q] = *(const f16x8*)((NP) + 8 * q); } \
        cve_load(e0, F, gw + ku * 2048, f_lane); cve_load(e1, F, gw + (ku + 1) * 2048, f_lane); cvh_load(h0, F, gw * 16 + ku, f_lane); cvh_load(h1, F, gw * 16 + ku + 1, f_lane); \
        __builtin_amdgcn_sched_barrier(0); \
        _Pragma("unroll") for (int q = 0; q < 8; ++q) { _Pragma("unroll") for (int e = 0; e < 8; ++e) { const unsigned k = (fkey((float)CUR[q][e]) & ~127u) | (unsigned)(127 - (64 * (M) + 8 * q + e)); TOPK_INSERT(a2, k); } } \
        __builtin_amdgcn_sched_barrier(0); \
        cve_finish(e0, F, gw + ku * 2048, f_lane); cve_finish(e1, F, gw + (ku + 1) * 2048, f_lane); cvh_finish(h0, F, gw * 16 + ku, f_lane, S2); cvh_finish(h1, F, gw * 16 + ku + 1, f_lane, S2); \
        __builtin_amdgcn_sched_barrier(0); }
        TK2_BATCH(sva, svb, sp + 64, 0)
        TK2_BATCH(svb, sva, spn, 1)
#undef TK2_BATCH
        if (kh == 0) {
#pragma unroll
            for (int i = 0; i < 16; ++i) a1[i] = a2[i];
            continue;
        }
        float v1[16], v2[16];
#pragma unroll
        for (int i = 0; i < 16; ++i) { ix[i] = (unsigned char)(127u - (a1[i] & 127u)); ix[16 + i] = (unsigned char)(127u - (a2[i] & 127u)); v1[i] = fkey_inv(a1[i] & ~127u); v2[i] = fkey_inv(a2[i] & ~127u); }
        unsigned cb[16];
#pragma unroll
        for (int i = 0; i < 16; ++i) cb[i] = 0u;
#pragma unroll
        for (int i = 0; i < 16; ++i)
#pragma unroll
            for (int j = 0; j < 16; ++j) if ((i + 1) * (j + 1) <= 16) { const unsigned k = (fkey(v1[i] + v2[j]) & ~255u) | (unsigned)(255 - (i * 16 + j)); TOPK_INSERT(cb, k); }
        float tv[16]; float mx = -3.0e38f;
#pragma unroll
        for (int k = 0; k < 16; ++k) { tv[k] = fkey_inv(cb[k] & ~255u); mx = fmaxf(mx, tv[k]); }
        float sum = 0.f;
#pragma unroll
        for (int k = 0; k < 16; ++k) { tv[k] = __expf(tv[k] - mx); sum += tv[k]; }
        const float inv = 1.0f / sum;
        LDS_WAIT(); asm volatile("" ::: "memory");
        int ev[16]; unsigned long long c64 = 0ull;
#pragma unroll
        for (int k = 0; k < 16; ++k) { const unsigned code = 255u - (cb[k] & 255u); const int i = code >> 4, j = code & 15; ev[k] = (int)ix[i] * 128 + (int)ix[16 + j]; c64 += 1ull << (8 * (ev[k] >> 11)); }
        unsigned long long s64 = c64;
#pragma unroll
        for (int o = 1; o < 8; o <<= 1) { const unsigned lo = __shfl_up((unsigned)s64, o, 8), hi2 = __shfl_up((unsigned)(s64 >> 32), o, 8); if ((f_lane & 7) >= o) s64 += ((unsigned long long)hi2 << 32) | lo; }
        const unsigned long long e64 = s64 - c64;
        const unsigned long long t64 = ((unsigned long long)__shfl((unsigned)(s64 >> 32), 7, 8) << 32) | __shfl((unsigned)s64, 7, 8);
        const unsigned long long st64 = (t64 * 0x0101010101010101ull) << 8;
        unsigned long long base64 = st64 + e64;
        int* eo = WSP(int, WS_EID) + (size_t)t * 128; float* go = WSP(float, WS_GATE) + (size_t)t * 128;
#pragma unroll
        for (int k = 0; k < 16; ++k) { const int r8 = 8 * (ev[k] >> 11); const int slot = (int)((base64 >> r8) & 255ull); base64 += 1ull << r8; eo[slot] = ev[k]; go[slot] = tv[k] * inv; }
        if (hd == 0) WSP(unsigned long long, WS_START)[t] = st64;
        LDS_WAIT(); asm volatile("" ::: "memory");
    }
}
__device__ __forceinline__ void p9_peer_down2(Frame& F) {
    const int f_tid = threadIdx.x, lane = f_tid & 63, f_wave = __builtin_amdgcn_readfirstlane(f_tid >> 6);
    const unsigned char* EV = F.ws + WS_EV;
    for (int wq = F.vcu * NWAVES + f_wave; wq < MTOK / 16; wq += F.G * NWAVES) {
        const int b = wq >> 7; const float* mb = WSP(float, WS_MOD) + (size_t)b * 6144;
        int ne_lo = WSP(int, WS_EID)[(size_t)wq * 16 * 128 + lane], ne_hi = WSP(int, WS_EID)[(size_t)wq * 16 * 128 + 64 + lane];
        float nw_lo = WSP(float, WS_GATE)[(size_t)wq * 16 * 128 + lane], nw_hi = WSP(float, WS_GATE)[(size_t)wq * 16 * 128 + 64 + lane];
        for (int tt = 0; tt < 16; ++tt) {
            const size_t t = (size_t)wq * 16 + tt;
            unsigned l16 = 16u * (unsigned)lane; asm volatile("" : "+v"(l16));
            float* xr = (float*)((char*)(F.out + t * 1024) + 4u * l16);
            const int e_lo = ne_lo, e_hi = ne_hi; const float w_lo = nw_lo, w_hi = nw_hi;
            f32x2 o[8];
#pragma unroll
            for (int i = 0; i < 8; ++i) o[i] = (f32x2){0.f, 0.f};
            v4u qa[8], qb[8];
#pragma unroll
            for (int j = 0; j < 8; ++j) { const int e = __builtin_amdgcn_readlane(e_lo, j); qa[j] = *(const v4u*)(EV + ((unsigned)e * 1024u + l16)); }
#define DN2_STEP(GRP, CUR, NXT) { \
                const int grp = (GRP); const int nb = ((grp + 1) & 7) * 8; const int ensel = (grp + 1) < 8 ? e_lo : e_hi; \
                { _Pragma("unroll") for (int j = 0; j < 8; ++j) { const int e = __builtin_amdgcn_readlane(ensel, nb + j); NXT[j] = *(const v4u*)(EV + ((unsigned)e * 1024u + l16)); } } \
                __builtin_amdgcn_sched_barrier(0); \
                const int base = (grp & 7) * 8; const float wsel = grp < 8 ? w_lo : w_hi; \
                _Pragma("unroll") for (int j = 0; j < 8; ++j) { const float wj = __builtin_bit_cast(float, __builtin_amdgcn_readlane(__builtin_bit_cast(int, wsel), base + j)); const f32x2 w2 = (f32x2){wj, wj}; \
                    _Pragma("unroll") for (int i = 0; i < 4; ++i) { const f32x2 lo = __builtin_amdgcn_cvt_pk_f32_fp8((int)CUR[j][i], false), hi = __builtin_amdgcn_cvt_pk_f32_fp8((int)CUR[j][i], true); o[2 * i] += w2 * lo; o[2 * i + 1] += w2 * hi; } } }
#pragma unroll 1
            for (int g2 = 0; g2 < 16; g2 += 2) { DN2_STEP(g2, qa, qb) DN2_STEP(g2 + 1, qb, qa) }
#undef DN2_STEP
            { const size_t tn = t + (tt < 15 ? 1 : 0); ne_lo = WSP(int, WS_EID)[tn * 128 + lane]; ne_hi = WSP(int, WS_EID)[tn * 128 + 64 + lane]; nw_lo = WSP(float, WS_GATE)[tn * 128 + lane]; nw_hi = WSP(float, WS_GATE)[tn * 128 + 64 + lane]; }
            float x1[16]; float ss = 0.f;
#pragma unroll
            for (int q4 = 0; q4 < 4; ++q4) { const f32x4 v = *(const f32x4*)(xr + 4 * q4); x1[4 * q4] = v[0]; x1[4 * q4 + 1] = v[1]; x1[4 * q4 + 2] = v[2]; x1[4 * q4 + 3] = v[3]; }
#pragma unroll
            for (int q4 = 0; q4 < 4; ++q4) { const f32x4 gt = *(const f32x4*)((const char*)(mb + 5120) + 4u * l16 + 16 * q4);
#pragma unroll
                for (int e = 0; e < 4; ++e) { const int i = 4 * q4 + e; x1[i] += gt[e] * o[i >> 1][i & 1]; ss += x1[i] * x1[i]; } }
            const float rf = rsqrt_f(wave_sum(ss) * (1.0f / 1024.0f) + EPSF);
#pragma unroll
            for (int q4 = 0; q4 < 4; ++q4) { const f32x4 nf = *(const f32x4*)((const char*)(F.a->in[29]) + 4u * l16 + 16 * q4); f32x4 v;
#pragma unroll
                for (int e = 0; e < 4; ++e) v[e] = x1[4 * q4 + e] * rf * nf[e];
                *(f32x4*)(xr + 4 * q4) = v; }
        }
    }
}
typedef long i64_t;
constexpr int U6_ROWP = 1040, U6_BUF = 8 * U6_ROWP, U6_WAVE = 2 * U6_BUF + 1024;
static_assert(8 * U6_WAVE <= LDS_MAIN, "U6 LDS map");
__device__ __forceinline__ void p8_peer_up6(Frame& F) {
    const int f_tid = threadIdx.x, lane = f_tid & 63, f_wave = __builtin_amdgcn_readfirstlane(f_tid >> 6);
    const int li = lane & 15, lq = lane >> 4;
    const unsigned char* EU = F.ws + WS_EU; const float* EUS = WSP(float, WS_EUS); const float* EVS = WSP(float, WS_EVS);
    LAS unsigned char* ring = F.lds + f_wave * U6_WAVE; LAS unsigned char* hq = ring + 2 * U6_BUF;
    for (int wq = F.vcu * NWAVES + f_wave; wq < MTOK / 16; wq += F.G * NWAVES) {
        const int b = wq >> 7; const float* mb = WSP(float, WS_MOD) + (size_t)b * 6144;
        for (int tt = 0; tt < 16; ++tt) {
            const size_t t = (size_t)wq * 16 + tt;
            unsigned l16 = 16u * (unsigned)lane; asm volatile("" : "+v"(l16));
            const int e_lo = WSP(int, WS_EID)[t * 128 + lane], e_hi = WSP(int, WS_EID)[t * 128 + 64 + lane];
            const float g_lo = WSP(float, WS_GATE)[t * 128 + lane], g_hi = WSP(float, WS_GATE)[t * 128 + 64 + lane];
            const float rs = rsqrt_f(WSP(float, WS_ROWSTAT)[t] * (1.0f / 1024.0f) + EPSF);
            const char* xs = (const char*)(WSP(bf16, WS_X1S) + t * 1024) + 2u * l16; const v4u xa = *(const v4u*)xs, xb = *(const v4u*)(xs + 16);
            asm volatile("s_waitcnt vmcnt(0)" ::: "memory");
#pragma unroll
            for (int j = 0; j < 8; ++j) { const int e = __builtin_amdgcn_readlane(e_lo, j);
                __builtin_amdgcn_global_load_lds((const unsigned*)(EU + ((unsigned)e * 1024u + l16)), (LAS unsigned*)(ring + j * U6_ROWP), 16, 0, 0); }
            const float su_lo = EUS[e_lo], su_hi = EUS[e_hi], sv_lo = EVS[e_lo], sv_hi = EVS[e_hi];
            float h2[16]; unpack8(xa, h2); unpack8(xb, h2 + 8); float mx = 0.f;
#pragma unroll
            for (int qd = 0; qd < 4; ++qd) { const f32x4 sh = *(const f32x4*)((const char*)(mb + 3072) + 4u * l16 + 16 * qd);
#pragma unroll
                for (int e = 0; e < 4; ++e) { h2[4 * qd + e] = h2[4 * qd + e] * rs + sh[e]; mx = fmaxf(mx, fabsf(h2[4 * qd + e])); } }
#pragma unroll
            for (int o = 1; o < 64; o <<= 1) mx = fmaxf(mx, __shfl_xor(mx, o));
            mx = fmaxf(mx, 1e-30f); const float hs = 224.0f / mx, hinv = mx * (1.0f / 224.0f);
            { v4u w;
#pragma unroll
              for (int qd = 0; qd < 4; ++qd) { int pk = 0; pk = __builtin_amdgcn_cvt_pk_fp8_f32(h2[4 * qd] * hs, h2[4 * qd + 1] * hs, pk, false); pk = __builtin_amdgcn_cvt_pk_fp8_f32(h2[4 * qd + 2] * hs, h2[4 * qd + 3] * hs, pk, true); w[qd] = (unsigned)pk; }
              *(LAS v4u*)(hq + l16) = w; }
            LDS_WAIT(); asm volatile("" ::: "memory");
            v4u hb[16];
#pragma unroll
            for (int c = 0; c < 16; ++c) hb[c] = *(const LAS v4u*)(hq + 64 * c + 16 * lq);
            asm volatile("s_waitcnt vmcnt(0)" ::: "memory");
            float w_lo = 0.f, w_hi = 0.f;
#pragma unroll 1
            for (int u = 0; u < 16; ++u) {
                { const int un = (u + 1) & 15; const int ensel = un < 8 ? e_lo : e_hi; const int nb = (un & 7) * 8; LAS unsigned char* dst = ring + ((u + 1) & 1) * U6_BUF;
#pragma unroll
                  for (int j = 0; j < 8; ++j) { const int e = __builtin_amdgcn_readlane(ensel, nb + j);
                      __builtin_amdgcn_global_load_lds((const unsigned*)(EU + ((unsigned)e * 1024u + l16)), (LAS unsigned*)(dst + j * U6_ROWP), 16, 0, 0); } }
                asm volatile("s_waitcnt vmcnt(8)" ::: "memory");
                const LAS unsigned char* src = ring + (u & 1) * U6_BUF + (li & 7) * U6_ROWP + 16 * lq;
                f32x4 acc = (f32x4){0.f, 0.f, 0.f, 0.f};
#ifdef HALF_READ
                v4u av[16];
#pragma unroll
                for (int c = 0; c < 16; ++c) asm volatile("" : "=v"(av[c]));
                if (li < 8) {
#pragma unroll
                    for (int c = 0; c < 16; ++c) av[c] = *(const LAS v4u*)(src + 64 * c); }
#pragma unroll
                for (int c = 0; c < 16; ++c) { const v4u a = av[c];
#else
#pragma unroll
                for (int c = 0; c < 16; ++c) { const v4u a = *(const LAS v4u*)(src + 64 * c);
#endif
                    acc = __builtin_amdgcn_mfma_f32_16x16x32_fp8_fp8((i64_t)(((unsigned long long)a[1] << 32) | a[0]), (i64_t)(((unsigned long long)hb[c][1] << 32) | hb[c][0]), acc, 0, 0, 0);
                    acc = __builtin_amdgcn_mfma_f32_16x16x32_fp8_fp8((i64_t)(((unsigned long long)a[3] << 32) | a[2]), (i64_t)(((unsigned long long)hb[c][3] << 32) | hb[c][2]), acc, 0, 0, 0); }
                const int base = (u & 7) * 8; const int r = li & 3;
                const float sel = r == 0 ? acc[0] : (r == 1 ? acc[1] : (r == 2 ? acc[2] : acc[3]));
                const float dmine = __shfl(sel, ((lane & 7) >> 2) * 16 + (lane & 3));
                const float gsel = u < 8 ? g_lo : g_hi, susel = u < 8 ? su_lo : su_hi, svsel = u < 8 ? sv_lo : sv_hi;
                const float wv = gsel * gelu_erf(dmine * susel * hinv) * svsel;
                const bool mine = (lane >= base) && (lane < base + 8);
                if (u < 8) w_lo = mine ? wv : w_lo; else w_hi = mine ? wv : w_hi;
                asm volatile("s_waitcnt lgkmcnt(0)" ::: "memory");
            }
            WSP(float, WS_GATE)[t * 128 + lane] = w_lo; WSP(float, WS_GATE)[t * 128 + 64 + lane] = w_hi;
        }
    }
}
struct U10Meta { int elo, ehi; float glo, ghi; v4u xa, xb; float rst; };
__device__ __forceinline__ void u10_meta_load(U10Meta& M, const unsigned char* ws, size_t t, unsigned l16) {
    const unsigned l = l16 >> 4; const int* ep = (const int*)(ws + WS_EID) + t * 128; const float* gp = (const float*)(ws + WS_GATE) + t * 128;
    M.elo = ep[l]; M.ehi = ep[64 + l]; M.glo = gp[l]; M.ghi = gp[64 + l];
    const char* xs = (const char*)(ws + WS_X1S) + t * 2048 + 2u * l16; M.xa = *(const v4u*)xs; M.xb = *(const v4u*)(xs + 16);
    M.rst = ((const float*)(ws + WS_ROWSTAT))[t + (l16 >> 30)];
}
__device__ __forceinline__ void u10_meta_touch(U10Meta& M) { asm volatile("" : "+v"(M.elo), "+v"(M.ehi), "+v"(M.glo), "+v"(M.ghi), "+v"(M.xa), "+v"(M.xb), "+v"(M.rst)); }
template <int UN> __device__ __forceinline__ void u10_unit_dma(int elo, int ehi, const unsigned char* EU, unsigned l16, LAS unsigned char* dst) {
    const int ensel = UN < 8 ? elo : ehi; constexpr int nb = (UN & 7) * 8;
#pragma unroll
    for (int j = 0; j < 8; ++j) { const int e = __builtin_amdgcn_readlane(ensel, nb + j);
        __builtin_amdgcn_global_load_lds((const unsigned*)(EU + ((unsigned)e * 1024u + l16)), (LAS unsigned*)(dst + j * U6_ROWP), 16, 0, 0); }
}
__device__ __forceinline__ void u10_h2(const U10Meta& M, const float* S2, LAS unsigned char* hq, unsigned l16, int lq, v4u* hb, float& hinv) {
    float h2[16]; unpack8(M.xa, h2); unpack8(M.xb, h2 + 8); float mx = 0.f;
    const float rs = rsqrt_f(M.rst * (1.0f / 1024.0f) + EPSF);
#pragma unroll
    for (int i = 0; i < 16; ++i) { h2[i] = h2[i] * rs + S2[i]; mx = fmaxf(mx, fabsf(h2[i])); }
#pragma unroll
    for (int o = 1; o < 64; o <<= 1) mx = fmaxf(mx, __shfl_xor(mx, o));
    mx = fmaxf(mx, 1e-30f); const float hs = 224.0f / mx; hinv = mx * (1.0f / 224.0f);
    v4u w;
#pragma unroll
    for (int qd = 0; qd < 4; ++qd) { int pk = 0; pk = __builtin_amdgcn_cvt_pk_fp8_f32(h2[4 * qd] * hs, h2[4 * qd + 1] * hs, pk, false); pk = __builtin_amdgcn_cvt_pk_fp8_f32(h2[4 * qd + 2] * hs, h2[4 * qd + 3] * hs, pk, true); w[qd] = (unsigned)pk; }
    *(LAS v4u*)(hq + l16) = w;
    LDS_WAIT(); asm volatile("" ::: "memory");
#pragma unroll
    for (int c = 0; c < 16; ++c) hb[c] = *(const LAS v4u*)(hq + 64 * c + 16 * lq);
    LDS_WAIT(); asm volatile("" ::: "memory");
}
template <int U> __device__ __forceinline__ void u10_unit(const U10Meta& C, U10Meta& N, const unsigned char* EU, const unsigned char* ws, unsigned l16, LAS unsigned char* ring, const v4u* hb, float hinv,
                                                          float su_lo, float su_hi, float sv_lo, float sv_hi, float& nsu_lo, float& nsu_hi, float& nsv_lo, float& nsv_hi,
                                                          float& w_lo, float& w_hi, size_t tn, bool first_token, int lane) {
    const int li = lane & 15, lq = lane >> 4;
    if (U == 15) u10_unit_dma<0>(N.elo, N.ehi, EU, l16, ring); else u10_unit_dma<(U + 1) & 15>(C.elo, C.ehi, EU, l16, ring + ((U + 1) & 1) * U6_BUF);
    __builtin_amdgcn_sched_barrier(0);
    if (U == 0) { if (first_token) asm volatile("s_waitcnt vmcnt(8)" ::: "memory"); else asm volatile("s_waitcnt vmcnt(10)" ::: "memory"); }
    else if (U == 3) asm volatile("s_waitcnt vmcnt(15)" ::: "memory");
    else if (U == 11) asm volatile("s_waitcnt vmcnt(12)" ::: "memory");
    else asm volatile("s_waitcnt vmcnt(8)" ::: "memory");
    if (U == 4) u10_meta_touch(N);
    if (U == 12) asm volatile("" : "+v"(nsu_lo), "+v"(nsu_hi), "+v"(nsv_lo), "+v"(nsv_hi));
    __builtin_amdgcn_sched_barrier(0);
    const LAS unsigned char* src = ring + (U & 1) * U6_BUF + (li & 7) * U6_ROWP + 16 * lq;
    f32x4 acc = (f32x4){0.f, 0.f, 0.f, 0.f};
#pragma unroll
    for (int c = 0; c < 16; ++c) { const v4u a = *(const LAS v4u*)(src + 64 * c);
        acc = __builtin_amdgcn_mfma_f32_16x16x32_fp8_fp8((i64_t)(((unsigned long long)a[1] << 32) | a[0]), (i64_t)(((unsigned long long)hb[c][1] << 32) | hb[c][0]), acc, 0, 0, 0);
        acc = __builtin_amdgcn_mfma_f32_16x16x32_fp8_fp8((i64_t)(((unsigned long long)a[3] << 32) | a[2]), (i64_t)(((unsigned long long)hb[c][3] << 32) | hb[c][2]), acc, 0, 0, 0); }
    constexpr int base = (U & 7) * 8; const int r = li & 3;
    const float sel = r == 0 ? acc[0] : (r == 1 ? acc[1] : (r == 2 ? acc[2] : acc[3]));
    const float dmine = __shfl(sel, ((lane & 7) >> 2) * 16 + (lane & 3));
    const float gsel = U < 8 ? C.glo : C.ghi, susel = U < 8 ? su_lo : su_hi, svsel = U < 8 ? sv_lo : sv_hi;
    const float wv = gsel * gelu_erf(dmine * susel * hinv) * svsel;
    const bool mine = (lane >= base) && (lane < base + 8);
    if (U < 8) w_lo = mine ? wv : w_lo; else w_hi = mine ? wv : w_hi;
    asm volatile("s_waitcnt lgkmcnt(0)" ::: "memory");
    __builtin_amdgcn_sched_barrier(0);
    if (U == 2) { u10_meta_load(N, ws, tn, l16); __builtin_amdgcn_sched_barrier(0); }
    if (U == 10) { const float* EUS = (const float*)(ws + WS_EUS); const float* EVS = (const float*)(ws + WS_EVS); nsu_lo = EUS[N.elo]; nsu_hi = EUS[N.ehi]; nsv_lo = EVS[N.elo]; nsv_hi = EVS[N.ehi]; __builtin_amdgcn_sched_barrier(0); }
}
__device__ __forceinline__ void p8_peer_up10(Frame& F) {
    const int f_tid = threadIdx.x, lane = f_tid & 63, f_wave = __builtin_amdgcn_readfirstlane(f_tid >> 6);
    const int lq = lane >> 4;
    const unsigned char* EU = F.ws + WS_EU; const float* EUS = WSP(float, WS_EUS); const float* EVS = WSP(float, WS_EVS);
    LAS unsigned char* ring = F.lds + f_wave * U6_WAVE; LAS unsigned char* hq = ring + 2 * U6_BUF;
    for (int wq = F.vcu * NWAVES + f_wave; wq < MTOK / 16; wq += F.G * NWAVES) {
        const int b = wq >> 7; const float* mb = WSP(float, WS_MOD) + (size_t)b * 6144;
        unsigned l16 = 16u * (unsigned)lane; asm volatile("" : "+v"(l16));
        float S2[16];
#pragma unroll
        for (int q = 0; q < 4; ++q) { const f32x4 sh = *(const f32x4*)((const char*)(mb + 3072) + 4u * l16 + 16 * q); S2[4 * q] = sh[0]; S2[4 * q + 1] = sh[1]; S2[4 * q + 2] = sh[2]; S2[4 * q + 3] = sh[3]; }
        const size_t t0 = (size_t)wq * 16;
        U10Meta C, N;
        u10_meta_load(C, F.ws, t0, l16);
        asm volatile("s_waitcnt vmcnt(0)" ::: "memory");
        u10_meta_touch(C);
        u10_unit_dma<0>(C.elo, C.ehi, EU, l16, ring);
        float su_lo = EUS[C.elo], su_hi = EUS[C.ehi], sv_lo = EVS[C.elo], sv_hi = EVS[C.ehi];
        float nsu_lo = 0.f, nsu_hi = 0.f, nsv_lo = 0.f, nsv_hi = 0.f;
        v4u hb[16]; float hinv;
        u10_h2(C, S2, hq, l16, lq, hb, hinv);
        N = C;
        asm volatile("s_waitcnt vmcnt(0)" ::: "memory");
        asm volatile("" : "+v"(su_lo), "+v"(su_hi), "+v"(sv_lo), "+v"(sv_hi));
#pragma unroll 1
        for (int tt = 0; tt < 16; ++tt) {
            float w_lo = 0.f, w_hi = 0.f;
            const size_t tn = t0 + (tt < 15 ? tt + 1 : tt);
            const bool ft = (tt == 0);
#define U10_U(U) u10_unit<U>(C, N, EU, F.ws, l16, ring, hb, hinv, su_lo, su_hi, sv_lo, sv_hi, nsu_lo, nsu_hi, nsv_lo, nsv_hi, w_lo, w_hi, tn, ft, lane);
            U10_U(0) U10_U(1) U10_U(2) U10_U(3) U10_U(4) U10_U(5) U10_U(6) U10_U(7) U10_U(8) U10_U(9) U10_U(10) U10_U(11) U10_U(12) U10_U(13) U10_U(14) U10_U(15)
#undef U10_U
            WSP(float, WS_GATE)[(t0 + tt) * 128 + lane] = w_lo; WSP(float, WS_GATE)[(t0 + tt) * 128 + 64 + lane] = w_hi;
            __builtin_amdgcn_sched_barrier(0);
            C = N; su_lo = nsu_lo; su_hi = nsu_hi; sv_lo = nsv_lo; sv_hi = nsv_hi;
            u10_h2(C, S2, hq, l16, lq, hb, hinv);
        }
        asm volatile("s_waitcnt vmcnt(0)" ::: "memory");
    }
}
#ifndef U11_AUX
#define U11_AUX 0
#endif
constexpr int U11_HQ = 2 * U6_BUF, U11_IDS = U11_HQ + 1024, U11_GATES = U11_IDS + 512, U11_SC = U11_GATES + 512, U11_HINV = U11_SC + 1024, U11_WAVE = U11_HINV + 256;
static_assert(8 * U11_WAVE <= LDS_MAIN, "U11 LDS map");
__device__ __forceinline__ void u11_dma4(const void* g, LAS unsigned char* l) { __builtin_amdgcn_global_load_lds((const unsigned*)g, (LAS unsigned*)l, 4, 0, 0); }
__device__ __forceinline__ void u11_stage1(const unsigned char* ws, size_t t, unsigned l16, LAS unsigned char* W) {
    const unsigned l4 = l16 >> 2;
    const unsigned char* ep = ws + WS_EID + t * 512; const unsigned char* gp = ws + WS_GATE + t * 512;
    u11_dma4(ep + l4, W + U11_IDS); u11_dma4(ep + 256 + l4, W + U11_IDS + 256);
    u11_dma4(gp + l4, W + U11_GATES); u11_dma4(gp + 256 + l4, W + U11_GATES + 256);
    __builtin_amdgcn_global_load_lds((const unsigned*)(ws + WS_H2Q + t * 1024 + l16), (LAS unsigned*)(W + U11_HQ), 16, 0, 0);
    u11_dma4(ws + WS_HINV + t * 4 + (l16 >> 30), W + U11_HINV);
}
__device__ __forceinline__ void u11_stage2(const unsigned char* ws, int elo, int ehi, LAS unsigned char* W) {
    u11_dma4(ws + WS_EUS + 4u * (unsigned)elo, W + U11_SC); u11_dma4(ws + WS_EUS + 4u * (unsigned)ehi, W + U11_SC + 256);
    u11_dma4(ws + WS_EVS + 4u * (unsigned)elo, W + U11_SC + 512); u11_dma4(ws + WS_EVS + 4u * (unsigned)ehi, W + U11_SC + 768);
}
template <int UN> __device__ __forceinline__ void u11_unit_dma(int elo, int ehi, const unsigned char* EU, unsigned l16, LAS unsigned char* dst) {
    const int ensel = UN < 8 ? elo : ehi; constexpr int nb = (UN & 7) * 8;
#pragma unroll
    for (int j = 0; j < 8; ++j) { const int e = __builtin_amdgcn_readlane(ensel, nb + j);
        __builtin_amdgcn_global_load_lds((const unsigned*)(EU + ((unsigned)e * 1024u + l16)), (LAS unsigned*)(dst + j * U6_ROWP), 16, 0, U11_AUX); }
}
struct U11Tok { int elo, ehi; float glo, ghi, su_lo, su_hi, sv_lo, sv_hi, hinv; };
__device__ __forceinline__ void u11_switch(U11Tok& C, int nelo, int nehi, LAS unsigned char* W, unsigned l16, int lq, v4u* hb) {
    const unsigned l4 = l16 >> 2;
    C.elo = nelo; C.ehi = nehi;
    C.glo = *(const LAS float*)(W + U11_GATES + l4); C.ghi = *(const LAS float*)(W + U11_GATES + 256 + l4);
    C.su_lo = *(const LAS float*)(W + U11_SC + l4); C.su_hi = *(const LAS float*)(W + U11_SC + 256 + l4); C.sv_lo = *(const LAS float*)(W + U11_SC + 512 + l4); C.sv_hi = *(const LAS float*)(W + U11_SC + 768 + l4);
    C.hinv = *(const LAS float*)(W + U11_HINV + l4);
#pragma unroll
    for (int c = 0; c < 16; ++c) hb[c] = *(const LAS v4u*)(W + U11_HQ + 64 * c + 16 * lq);
    LDS_WAIT(); asm volatile("" ::: "memory");
}
template <int U> __device__ __forceinline__ void u11_unit(const U11Tok& C, int& nelo, int& nehi, const unsigned char* EU, const unsigned char* ws, unsigned l16, LAS unsigned char* W, const v4u* hb,
                                                          float& w_lo, float& w_hi, size_t tn, bool first_token, int lane) {
    const int li = lane & 15, lq = lane >> 4;
    if (U == 15) u11_unit_dma<0>(nelo, nehi, EU, l16, W); else u11_unit_dma<(U + 1) & 15>(C.elo, C.ehi, EU, l16, W + ((U + 1) & 1) * U6_BUF);
    __builtin_amdgcn_sched_barrier(0);
    if (U == 0) { if (first_token) asm volatile("s_waitcnt vmcnt(8)" ::: "memory"); else asm volatile("s_waitcnt vmcnt(10)" ::: "memory"); }
    else if (U == 3) asm volatile("s_waitcnt vmcnt(14)" ::: "memory");
    else if (U == 5) asm volatile("s_waitcnt vmcnt(12)" ::: "memory");
    else asm volatile("s_waitcnt vmcnt(8)" ::: "memory");
    __builtin_amdgcn_sched_barrier(0);
    const LAS unsigned char* src = W + (U & 1) * U6_BUF + (li & 7) * U6_ROWP + 16 * lq;
    f32x4 acc = (f32x4){0.f, 0.f, 0.f, 0.f};
#pragma unroll
    for (int c = 0; c < 16; ++c) { const v4u a = *(const LAS v4u*)(src + 64 * c);
        acc = __builtin_amdgcn_mfma_f32_16x16x32_fp8_fp8((i64_t)(((unsigned long long)a[1] << 32) | a[0]), (i64_t)(((unsigned long long)hb[c][1] << 32) | hb[c][0]), acc, 0, 0, 0);
        acc = __builtin_amdgcn_mfma_f32_16x16x32_fp8_fp8((i64_t)(((unsigned long long)a[3] << 32) | a[2]), (i64_t)(((unsigned long long)hb[c][3] << 32) | hb[c][2]), acc, 0, 0, 0); }
    constexpr int base = (U & 7) * 8; const int r = li & 3;
    const float sel = r == 0 ? acc[0] : (r == 1 ? acc[1] : (r == 2 ? acc[2] : acc[3]));
    const float dmine = __shfl(sel, ((lane & 7) >> 2) * 16 + (lane & 3));
    const float gsel = U < 8 ? C.glo : C.ghi, susel = U < 8 ? C.su_lo : C.su_hi, svsel = U < 8 ? C.sv_lo : C.sv_hi;
    const float wv = gsel * gelu_erf(dmine * susel * C.hinv) * svsel;
    const bool mine = (lane >= base) && (lane < base + 8);
    if (U < 8) w_lo = mine ? wv : w_lo; else w_hi = mine ? wv : w_hi;
    if (U == 4) { nelo = *(const LAS int*)(W + U11_IDS + (l16 >> 2)); nehi = *(const LAS int*)(W + U11_IDS + 256 + (l16 >> 2)); }
    asm volatile("s_waitcnt lgkmcnt(0)" ::: "memory");
    __builtin_amdgcn_sched_barrier(0);
    if (U == 2) { u11_stage1(ws, tn, l16, W); __builtin_amdgcn_sched_barrier(0); }
    if (U == 4) { u11_stage2(ws, nelo, nehi, W); __builtin_amdgcn_sched_barrier(0); }
}
__device__ __forceinline__ void p8_peer_up11(Frame& F) {
    const int f_tid = threadIdx.x, lane = f_tid & 63, f_wave = __builtin_amdgcn_readfirstlane(f_tid >> 6);
    const int lq = lane >> 4;
    const unsigned char* EU = F.ws + WS_EU;
    LAS unsigned char* W = F.lds + f_wave * U11_WAVE;
    for (int wq = F.vcu * NWAVES + f_wave; wq < MTOK / 16; wq += F.G * NWAVES) {
        unsigned l16 = 16u * (unsigned)lane; asm volatile("" : "+v"(l16));
        const size_t t0 = (size_t)wq * 16;
        u11_stage1(F.ws, t0, l16, W);
        asm volatile("s_waitcnt vmcnt(0)" ::: "memory");
        int nelo = *(const LAS int*)(W + U11_IDS + (l16 >> 2)), nehi = *(const LAS int*)(W + U11_IDS + 256 + (l16 >> 2));
        LDS_WAIT(); asm volatile("" ::: "memory");
        u11_stage2(F.ws, nelo, nehi, W);
        u11_unit_dma<0>(nelo, nehi, EU, l16, W);
        asm volatile("s_waitcnt vmcnt(0)" ::: "memory");
        U11Tok C; v4u hb[16];
        u11_switch(C, nelo, nehi, W, l16, lq, hb);
#pragma unroll 1
        for (int tt = 0; tt < 16; ++tt) {
            float w_lo = 0.f, w_hi = 0.f;
            const size_t tn = t0 + (tt < 15 ? tt + 1 : tt);
            const bool ft = (tt == 0);
#define U11_U(U) u11_unit<U>(C, nelo, nehi, EU, F.ws, l16, W, hb, w_lo, w_hi, tn, ft, lane);
            U11_U(0) U11_U(1) U11_U(2) U11_U(3) U11_U(4) U11_U(5) U11_U(6) U11_U(7) U11_U(8) U11_U(9) U11_U(10) U11_U(11) U11_U(12) U11_U(13) U11_U(14) U11_U(15)
#undef U11_U
            WSP(float, WS_GATE)[(t0 + tt) * 128 + lane] = w_lo; WSP(float, WS_GATE)[(t0 + tt) * 128 + 64 + lane] = w_hi;
            __builtin_amdgcn_sched_barrier(0);
            u11_switch(C, nelo, nehi, W, l16, lq, hb);
        }
        asm volatile("s_waitcnt vmcnt(0)" ::: "memory");
    }
}
typedef unsigned v3u __attribute__((ext_vector_type(3)));
typedef unsigned v6u __attribute__((ext_vector_type(6)));
typedef float f32x32 __attribute__((ext_vector_type(32)));
struct __attribute__((packed, aligned(4))) U3 { unsigned a, b, c; };
__device__ __forceinline__ v3u ld_row6(const unsigned char* p) { const U3 u = *(const U3*)p; return (v3u){u.a, u.b, u.c}; }
__device__ __forceinline__ void p9_peer_down3(Frame& F) {
    const int f_tid = threadIdx.x, lane = f_tid & 63, f_wave = __builtin_amdgcn_readfirstlane(f_tid >> 6);
    const unsigned char* EV = F.ws + WS_EV;
    for (int wq = F.vcu * NWAVES + f_wave; wq < MTOK / 16; wq += F.G * NWAVES) {
        const int b = wq >> 7; const float* mb = WSP(float, WS_MOD) + (size_t)b * 6144;
        int ne_lo = WSP(int, WS_EID)[(size_t)wq * 16 * 128 + lane], ne_hi = WSP(int, WS_EID)[(size_t)wq * 16 * 128 + 64 + lane];
        float nw_lo = WSP(float, WS_GATE)[(size_t)wq * 16 * 128 + lane], nw_hi = WSP(float, WS_GATE)[(size_t)wq * 16 * 128 + 64 + lane];
        for (int tt = 0; tt < 16; ++tt) {
            const size_t t = (size_t)wq * 16 + tt;
            unsigned l16 = 16u * (unsigned)lane; asm volatile("" : "+v"(l16));
            const unsigned l12 = (l16 >> 2) * 3u;
            float* xr = (float*)((char*)(F.out + t * 1024) + 4u * l16);
            const int e_lo = ne_lo, e_hi = ne_hi; const float w_lo = nw_lo, w_hi = nw_hi;
            f32x2 o[8];
#pragma unroll
            for (int i = 0; i < 8; ++i) o[i] = (f32x2){0.f, 0.f};
            v3u qa[8], qb[8];
#pragma unroll
            for (int j = 0; j < 8; ++j) { const int e = __builtin_amdgcn_readlane(e_lo, j); qa[j] = ld_row6(EV + ((unsigned)e * 768u + l12)); }
#define DN3_STEP(GRP, CUR, NXT) { \
                const int grp = (GRP); const int nb = ((grp + 1) & 7) * 8; const int ensel = (grp + 1) < 8 ? e_lo : e_hi; \
                { _Pragma("unroll") for (int j = 0; j < 8; ++j) { const int e = __builtin_amdgcn_readlane(ensel, nb + j); NXT[j] = ld_row6(EV + ((unsigned)e * 768u + l12)); } } \
                __builtin_amdgcn_sched_barrier(0); \
                const int base = (grp & 7) * 8; const float wsel = grp < 8 ? w_lo : w_hi; \
                _Pragma("unroll") for (int j = 0; j < 8; j += 2) { \
                    const float wa = __builtin_bit_cast(float, __builtin_amdgcn_readlane(__builtin_bit_cast(int, wsel), base + j)), wb = __builtin_bit_cast(float, __builtin_amdgcn_readlane(__builtin_bit_cast(int, wsel), base + j + 1)); \
                    const f32x2 wa2 = (f32x2){wa, wa}, wb2 = (f32x2){wb, wb}; \
                    const v6u pr = (v6u){CUR[j][0], CUR[j][1], CUR[j][2], CUR[j + 1][0], CUR[j + 1][1], CUR[j + 1][2]}; \
                    const f32x32 r = __builtin_amdgcn_cvt_scalef32_pk32_f32_fp6(pr, 1.0f); \
                    _Pragma("unroll") for (int i = 0; i < 8; ++i) { o[i] += wa2 * (f32x2){r[2 * i], r[2 * i + 1]}; o[i] += wb2 * (f32x2){r[16 + 2 * i], r[17 + 2 * i]}; } } }
#pragma unroll 1
            for (int g2 = 0; g2 < 16; g2 += 2) { DN3_STEP(g2, qa, qb) DN3_STEP(g2 + 1, qb, qa) }
#undef DN3_STEP
            { const size_t tn = t + (tt < 15 ? 1 : 0); ne_lo = WSP(int, WS_EID)[tn * 128 + lane]; ne_hi = WSP(int, WS_EID)[tn * 128 + 64 + lane]; nw_lo = WSP(float, WS_GATE)[tn * 128 + lane]; nw_hi = WSP(float, WS_GATE)[tn * 128 + 64 + lane]; }
            float x1[16]; float ss = 0.f;
#pragma unroll
            for (int q4 = 0; q4 < 4; ++q4) { const f32x4 v = *(const f32x4*)(xr + 4 * q4); x1[4 * q4] = v[0]; x1[4 * q4 + 1] = v[1]; x1[4 * q4 + 2] = v[2]; x1[4 * q4 + 3] = v[3]; }
#pragma unroll
            for (int q4 = 0; q4 < 4; ++q4) { const f32x4 gt = *(const f32x4*)((const char*)(mb + 5120) + 4u * l16 + 16 * q4);
#pragma unroll
                for (int e = 0; e < 4; ++e) { const int i = 4 * q4 + e; x1[i] += gt[e] * o[i >> 1][i & 1]; ss += x1[i] * x1[i]; } }
            const float rf = rsqrt_f(wave_sum(ss) * (1.0f / 1024.0f) + EPSF);
#pragma unroll
            for (int q4 = 0; q4 < 4; ++q4) { const f32x4 nf = *(const f32x4*)((const char*)(F.a->in[29]) + 4u * l16 + 16 * q4); f32x4 v;
#pragma unroll
                for (int e = 0; e < 4; ++e) v[e] = x1[4 * q4 + e] * rf * nf[e];
                *(f32x4*)(xr + 4 * q4) = v; }
        }
    }
}
#ifdef TOPK2
#define P7FN p5b_topk2
#else
#define P7FN p5b_topk
#endif
constexpr int NPHASE = 10;
__global__ void __launch_bounds__(NTHR, 2) fwd_mega(Args args) {
    extern __shared__ __attribute__((aligned(16))) unsigned char lds[];
    Frame F;
    F.lds = (LAS unsigned char*)lds;
    F.MISC = (volatile LAS unsigned*)(F.lds + MISC_OFF);
    F.G = gridDim.x; { const int bx = blockIdx.x; F.vcu = (F.G % 8 == 0) ? (bx % 8) * (F.G / 8) + bx / 8 : bx; }
    F.ws = args.ws; F.out = args.out;
    F.a = &args;
    for (int u = threadIdx.x; u < 32; u += NTHR) F.MISC[u] = 0u;
    __syncthreads();
    const int lo = args.ph_lo, hi = args.ph_hi;
    const bool use_bar = (hi - lo) > 1;
    XcdBarrier bar; bar.bar = (unsigned*)(F.ws + WS_CTL); bar.x = 0; bar.st = nullptr;
    if (use_bar) bar = xcd_barrier_post((unsigned*)(F.ws + WS_CTL), F.MISC + 8);
#define IN(k) (lo <= (k) && (k) < hi)
#define SEAM(k) do { if (IN(k) && IN((k) + 1)) xcd_barrier(bar); } while (0)
#ifndef REP_PHASE
#define REP_PHASE -1
#endif
#define REPEAT(k, body) do { if (REP_PHASE == (k)) { xcd_barrier(bar); body; } } while (0)
    if (IN(0)) {
#ifndef SKIP_P0
 p0_phase(F); REPEAT(0, p0_phase(F));
#endif
 } SEAM(0);
    if (IN(1)) {
#ifndef SKIP_P1
 p1_phase(F); REPEAT(1, p1_phase(F));
#endif
 } SEAM(1);
    if (IN(2)) {
        pg8::Gemm g{WSP(bf16, WS_H1), WSP(bf16, WS_WINT), MTOK, NPROJ, 1024}; pg8::StaticOrder S; S.init(MTOK, NPROJ, F.G, (int)blockIdx.x);
        pg8::EpiProj E{WSP(bf16, WS_PROJ), NPROJ};
        pg8::gemm_phase<pg8::EpiProj, pg8::StaticOrder, true, true>(F.lds, g, S, E);
        REPEAT(2, (pg8::gemm_phase<pg8::EpiProj, pg8::StaticOrder, true, true>(F.lds, g, S, E)));
    } SEAM(2);
    if (IN(3)) {
#ifndef SKIP_SSD
 p3pre_conv(F); xcd_barrier(bar); p3_ssd3(F); REPEAT(30, p3_ssd3(F)); REPEAT(32, p3pre_conv(F));
#endif
#ifndef SKIP_S5
 p3_s5v2(F); REPEAT(31, p3_s5v2(F));
#endif
 } SEAM(3);
    if (IN(5)) {
        pg8::Gemm g{WSP(bf16, WS_Y), WSP(bf16, WS_WOUTT), MTOK, 1024, 2048}; pg8::StaticOrder S; S.init(MTOK, 1024, F.G, (int)blockIdx.x);
        PG8_LAS float* tab = (PG8_LAS float*)(F.lds + pg8::STAGE_BYTES);
        { pg8::Unit u; for (int i = 0; S.next(i, u); ++i) pg8::SegScaleHook::build(F.lds + pg8::STAGE_BYTES, u, WSP(float, WS_STSSD), WSP(float, WS_STS5), (int)threadIdx.x); }
        __syncthreads();
        pg8::EpiX1 E{(F.a->in[0]), F.out, WSP(bf16, WS_X1S), WSP(float, WS_MOD), (F.a->in[24]), WSP(float, WS_ROWSTAT), tab};
        pg8::SegScaleHook H;
        pg8::gemm_phase<pg8::EpiX1, pg8::StaticOrder, true, true, pg8::SegScaleHook>(F.lds, g, S, E, H);
    } SEAM(5);
    if (IN(6)) {
        pg8::Gemm g{WSP(bf16, WS_X1S), WSP(bf16, WS_WQKT), MTOK, 2048, 1024}; pg8::StaticOrder S; S.init(MTOK, 2048, F.G, (int)blockIdx.x);
        pg8::EpiScores E{WSP(_Float16, WS_SCORES), WSP(float, WS_SB), WSP(float, WS_ROWSTAT)};
        pg8::gemm_phase<pg8::EpiScores, pg8::StaticOrder, true, true>(F.lds, g, S, E);
        REPEAT(6, (pg8::gemm_phase<pg8::EpiScores, pg8::StaticOrder, true, true>(F.lds, g, S, E)));
    } SEAM(6);
    if (IN(7)) {
#ifndef SKIP_TOPK
 P7FN(F); REPEAT(7, P7FN(F));
#endif
 } SEAM(7);
#ifdef UP11
    if (IN(8)) { p8_peer_up11(F); REPEAT(8, { P7FN(F); xcd_barrier(bar); p8_peer_up11(F); }); } SEAM(8);
#elif defined(UP10)
    if (IN(8)) { p8_peer_up10(F); } SEAM(8);
#else
    if (IN(8)) { p8_peer_up6(F); REPEAT(8, { P7FN(F); xcd_barrier(bar); p8_peer_up6(F); }); } SEAM(8);
#endif
#ifdef V6
    if (IN(9)) { p9_peer_down3(F); }
#else
    if (IN(9)) { p9_peer_down2(F); }
#endif
#ifdef PROBE_OUT
    if (IN(9)) { __syncthreads(); if (blockIdx.x == 0 && threadIdx.x == 0) { asm volatile("s_waitcnt vmcnt(0)" ::: "memory"); F.out[0] = *(volatile float*)(F.ws + WS_CTL + 40000); } }
#endif
#undef IN
#undef SEAM
}

#ifndef N_LAUNCHES
#define N_LAUNCHES 1
#endif
extern "C" void kernel_launch(void* const* d_in, const int* in_sizes, int n_in, void* d_out, int out_size, void* d_ws, size_t ws_size, hipStream_t stream) {
    static int grid = 0;
    if (grid == 0) {
        if (n_in != 30 || in_sizes[0] != MTOK * DM || out_size != MTOK * DM || ws_size < WS_END) { fprintf(stderr, "kernel_launch: unexpected shapes (n_in %d, in0 %d, out %d, ws %zu)\n", n_in, n_in > 0 ? in_sizes[0] : -1, out_size, ws_size); grid = -1; return; }
        int dev = 0, cus = 0, per_cu = 0;
        if (hipGetDevice(&dev) != hipSuccess || hipDeviceGetAttribute(&cus, hipDeviceAttributeMultiprocessorCount, dev) != hipSuccess) { grid = -1; return; }
        if (hipFuncSetAttribute((const void*)fwd_mega, hipFuncAttributeMaxDynamicSharedMemorySize, LDS_BYTES) != hipSuccess) { fprintf(stderr, "kernel_launch: hipFuncSetAttribute failed\n"); grid = -1; return; }
        if (hipOccupancyMaxActiveBlocksPerMultiprocessor(&per_cu, (const void*)fwd_mega, NTHR, LDS_BYTES) != hipSuccess || per_cu < 1) { fprintf(stderr, "kernel_launch: occupancy query says %d\n", per_cu); (void)hipGetLastError(); grid = -1; return; }
        if (cus != 256) { fprintf(stderr, "kernel_launch: built for a 256-CU device (got %d CUs); nothing launched\n", cus); grid = -1; return; }
        grid = cus;
    }
    if (grid < 0) return;
    (void)hipMemsetAsync((char*)d_ws + WS_CTL, 0, CTL_ZERO_BYTES, stream);
    Args a{};
    for (int i = 0; i < 30; ++i) a.in[i] = (const float*)d_in[i];
    a.out = (float*)d_out; a.ws = (unsigned char*)d_ws;
    if (N_LAUNCHES == 1) {
        a.ph_lo = 0; a.ph_hi = NPHASE;
        void* kargs[] = {&a};
#ifdef PLAIN_LAUNCH
        (void)kargs; hipLaunchKernelGGL(fwd_mega, dim3(grid), dim3(NTHR), LDS_BYTES, stream, a);
#else
        hipError_t e = hipLaunchCooperativeKernel((const void*)fwd_mega, dim3(grid), dim3(NTHR), kargs, LDS_BYTES, stream);
        if (e != hipSuccess) fprintf(stderr, "kernel_launch: cooperative launch failed: %s (grid %d)\n", hipGetErrorString(e), grid);
#endif
    } else {
        for (int p = 0; p < NPHASE; ++p) { a.ph_lo = p; a.ph_hi = p + 1; hipLaunchKernelGGL(fwd_mega, dim3(grid), dim3(NTHR), LDS_BYTES, stream, a); }
    }
}
```

```cpp
#define V6
#define UP12
#include <hip/hip_runtime.h>
#include <cstdio>
#include <cstdint>
namespace pg8 {
#define PG8_LAS __attribute__((address_space(3)))
typedef unsigned short bf16_t;
typedef short bf16x8 __attribute__((ext_vector_type(8)));
typedef float f32x4 __attribute__((ext_vector_type(4)));
typedef unsigned u32x4 __attribute__((ext_vector_type(4)));
constexpr int BM = 256, BK = 64, HALF = 128, HTB = HALF * BK * 2  , STAGE_BYTES = 8 * HTB, NXCD = 8, WGM = 8;

__host__ __device__ __forceinline__ int lds_byte(int r, int c) { const int st = (r >> 4) * 2 + (c >> 5), rr = r & 15, cc = c & 31, ob = rr * 64 + cc * 2; return st * 1024 + (ob ^ (((ob >> 9) & 1) << 5)); }
__host__ __device__ __forceinline__ void stage_rc(int b, int& R, int& C) { const int st = b / 1024, sb = b % 1024, swz = sb ^ (((sb >> 9) & 1) << 5); R = (st >> 1) * 16 + swz / 64; C = (st & 1) * 32 + (swz % 64) / 2; }
__host__ __device__ __forceinline__ int perm32(int rho) { const int n = rho >> 4, i = rho & 15; return 8 * (i >> 2) + 4 * n + (i & 3); }

struct Unit { int pm, pn; };
struct Gemm { const bf16_t* A; const bf16_t* Bt; int M, N, K; };

struct StaticOrder {
    int nM, nN, nwg, G, c;
    __host__ __device__ void init(int M, int N, int G_, int c_) { nM = M / BM; nN = N / BM; nwg = nM * nN; G = G_; c = c_; }
    __host__ __device__ bool next(int i, Unit& u) const {
        const long L = (long)i * G + c; if (L >= nwg) return false;
        int wgid = (int)L; { const int q = nwg / NXCD, r = nwg % NXCD, xcd = wgid % NXCD, off = wgid / NXCD; wgid = (xcd < r ? xcd * (q + 1) : r * (q + 1) + (xcd - r) * q) + off; }
        const int nig = WGM * nN, gid = wgid / nig, fm = gid * WGM, gsz = (nM - fm) < WGM ? (nM - fm) : WGM;
        u.pm = fm + ((wgid % nig) % gsz); u.pn = (wgid % nig) / gsz; return true;
    }
    __device__ __forceinline__ void a_ready(const Unit&) const {}
    __device__ __forceinline__ void done(const Unit&) const {}
};

__device__ __forceinline__ unsigned cvt_pk_bf16(float lo, float hi) { unsigned r; asm volatile("v_cvt_pk_bf16_f32 %0, %1, %2" : "=v"(r) : "v"(lo), "v"(hi)); return r; }
typedef float f32x2 __attribute__((ext_vector_type(2)));
struct NoHook { __device__ __forceinline__ void at_tile(int, const Unit&, f32x4 (&)[2][2][4][2], PG8_LAS unsigned char*, int, int) const {} };
template <class Epi, class Sched, bool ALIGN_EPI = false, bool SP2 = false, class Hook = NoHook>
__device__ __forceinline__ void gemm_phase(PG8_LAS unsigned char* lds, const Gemm g, const Sched& S, const Epi& E, const Hook& H = Hook()) {
    const int tid = threadIdx.x, wid = __builtin_amdgcn_readfirstlane(tid >> 6), lane = tid & 63, wr = wid >> 2, wc = wid & 3, fr = lane & 15, fq = lane >> 4;
    const int K = g.K, nt = K / BK;
    unsigned voffA[2], voffB[2];
#pragma unroll
    for (int i = 0; i < 2; ++i) { int R, C; stage_rc(tid * 16 + i * 8192, R, C); const int Rb = Epi::PERM ? ((R & ~31) + perm32(R & 31)) : R;
        voffA[i] = (unsigned)(R * K + C) * 2u; voffB[i] = (unsigned)(Rb * K + C) * 2u; }
    const size_t kstep = (size_t)(BK * 2);
    const size_t hstep = (size_t)HALF * K * 2;
    const size_t tstep = 2 * hstep;
    const unsigned ldsw = (unsigned)wid * 1024u;
    const int aoff = lds_byte(wr * 64 + fr, fq * 8), boff = lds_byte(wc * 32 + fr, fq * 8);
#define PG8_SA(b, h) (((b) * 2 + (h)) * HTB)
#define PG8_SB(b, h) ((4 + (b) * 2 + (h)) * HTB)
#define PG8_STAGE(bufoff, gbase, voff) do { _Pragma("unroll") for (int _i = 0; _i < 2; ++_i) \
        __builtin_amdgcn_global_load_lds((const unsigned*)((const char*)(gbase) + (voff)[_i]), (PG8_LAS unsigned*)(lds + (bufoff) + ldsw + _i * 8192), 16, 0, 0); } while (0)
#define PG8_LDA(dst, b, h) do { _Pragma("unroll") for (int m = 0; m < 4; ++m) _Pragma("unroll") for (int k = 0; k < 2; ++k) dst[m][k] = *(const PG8_LAS bf16x8*)(lds + PG8_SA(b, h) + aoff + m * 2048 + k * 1024); } while (0)
#define PG8_LDB(dst, b, h) do { _Pragma("unroll") for (int n = 0; n < 2; ++n) _Pragma("unroll") for (int k = 0; k < 2; ++k) dst[n][k] = *(const PG8_LAS bf16x8*)(lds + PG8_SB(b, h) + boff + n * 2048 + k * 1024); } while (0)
#define PG8_MMA(ai, bj, At, Bt) do { __builtin_amdgcn_s_setprio(1); _Pragma("unroll") for (int m = 0; m < 4; ++m) _Pragma("unroll") for (int n = 0; n < 2; ++n) _Pragma("unroll") for (int k = 0; k < 2; ++k) \
        acc[ai][bj][m][n] = __builtin_amdgcn_mfma_f32_16x16x32_bf16(Bt[n][k], At[m][k], acc[ai][bj][m][n], 0, 0, 0); __builtin_amdgcn_s_setprio(0); } while (0)
#define PG8_WAIT_V(n) asm volatile("s_waitcnt vmcnt(" #n ")" ::: "memory")
#define PG8_WAIT_L(n) asm volatile("s_waitcnt lgkmcnt(" #n ")" ::: "memory")
#define PG8_BAR __builtin_amdgcn_s_barrier()
#define PG8_SCHED __builtin_amdgcn_sched_barrier(0)
    Unit cur, nxt; int ui = 0;
    if (!S.next(0, cur)) return;
    f32x4 acc[2][2][4][2];
#pragma unroll
    for (int a = 0; a < 2; ++a)
#pragma unroll
        for (int b = 0; b < 2; ++b)
#pragma unroll
            for (int m = 0; m < 4; ++m)
#pragma unroll
                for (int n = 0; n < 2; ++n) acc[a][b][m][n] = (f32x4){0.f, 0.f, 0.f, 0.f};
    bf16x8 At[4][2], B0[2][2], B1[2][2];
    const char* cA = (const char*)g.A + (size_t)cur.pm * tstep; const char* cB = (const char*)g.Bt + (size_t)cur.pn * tstep;
    S.a_ready(cur);
    if constexpr (SP2) {
        PG8_STAGE(PG8_SB(0, 0), cB, voffB); PG8_STAGE(PG8_SB(0, 1), cB + hstep, voffB); PG8_STAGE(PG8_SA(0, 0), cA, voffA); PG8_STAGE(PG8_SA(0, 1), cA + hstep, voffA);
        if (wr == 1) PG8_BAR;
        PG8_WAIT_V(2); PG8_BAR;
        PG8_STAGE(PG8_SB(1, 0), cB + kstep, voffB); PG8_STAGE(PG8_SA(1, 0), cA + kstep, voffA); PG8_STAGE(PG8_SB(1, 1), cB + hstep + kstep, voffB);
        PG8_WAIT_V(6); PG8_BAR;
    } else {
        PG8_STAGE(PG8_SB(0, 0), cB, voffB); PG8_STAGE(PG8_SA(0, 0), cA, voffA); PG8_STAGE(PG8_SB(0, 1), cB + hstep, voffB); PG8_STAGE(PG8_SA(0, 1), cA + hstep, voffA);
        if (wr == 1) PG8_BAR;
        PG8_WAIT_V(4); PG8_BAR;
        PG8_STAGE(PG8_SB(1, 0), cB + kstep, voffB); PG8_STAGE(PG8_SA(1, 0), cA + kstep, voffA); PG8_STAGE(PG8_SB(1, 1), cB + hstep + kstep, voffB);
        PG8_WAIT_V(6); PG8_BAR;
    }
    for (;;) {
        const bool has_next = S.next(ui + 1, nxt);
        const char* nA = has_next ? (const char*)g.A + (size_t)nxt.pm * tstep : cA; const char* nB = has_next ? (const char*)g.Bt + (size_t)nxt.pn * tstep : cB;
        for (int t = 0; t < nt; t += 2) {
            const bool last = (t == nt - 2);
            H.at_tile(t, cur, acc, lds + STAGE_BYTES, wr, fr);
            const char* a1 = cA + (size_t)(t + 1) * kstep;
            const char* a2 = last ? nA : cA + (size_t)(t + 2) * kstep; const char* b2 = last ? nB : cB + (size_t)(t + 2) * kstep;
            const char* a3 = a2 + kstep; const char* b3 = b2 + kstep;
            if (last && has_next) S.a_ready(nxt);
            if constexpr (SP2) {
            PG8_LDB(B0, 0, 0); PG8_LDB(B1, 0, 1); PG8_SCHED; PG8_LDA(At, 0, 0); PG8_STAGE(PG8_SA(1, 1), a1 + hstep, voffA);
            PG8_WAIT_V(8); PG8_WAIT_L(0); PG8_BAR; PG8_MMA(0, 0, At, B0); PG8_MMA(0, 1, At, B1); PG8_BAR; PG8_SCHED;
            PG8_LDA(At, 0, 1); PG8_STAGE(PG8_SB(0, 0), b2, voffB); PG8_STAGE(PG8_SB(0, 1), b2 + hstep, voffB); PG8_STAGE(PG8_SA(0, 0), a2, voffA);
            PG8_WAIT_V(8); PG8_WAIT_L(0); PG8_BAR; PG8_MMA(1, 0, At, B0); PG8_MMA(1, 1, At, B1); PG8_BAR; PG8_SCHED;
            PG8_LDB(B0, 1, 0); PG8_LDB(B1, 1, 1); PG8_SCHED; PG8_LDA(At, 1, 0); PG8_STAGE(PG8_SA(0, 1), a2 + hstep, voffA);
            PG8_WAIT_V(8); PG8_WAIT_L(0); PG8_BAR; PG8_MMA(0, 0, At, B0); PG8_MMA(0, 1, At, B1); PG8_BAR; PG8_SCHED;
            PG8_LDA(At, 1, 1); PG8_STAGE(PG8_SB(1, 0), b3, voffB); PG8_STAGE(PG8_SB(1, 1), b3 + hstep, voffB); PG8_STAGE(PG8_SA(1, 0), a3, voffA);
            PG8_WAIT_V(8); PG8_WAIT_L(0); PG8_BAR; PG8_MMA(1, 0, At, B0); PG8_MMA(1, 1, At, B1); PG8_BAR; PG8_SCHED;
            } else {
            PG8_LDB(B0, 0, 0); PG8_SCHED; PG8_LDA(At, 0, 0); PG8_STAGE(PG8_SA(1, 1), a1 + hstep, voffA);
            PG8_WAIT_L(8); PG8_BAR; PG8_WAIT_L(0); PG8_MMA(0, 0, At, B0); PG8_BAR; PG8_SCHED;
            PG8_LDB(B1, 0, 1); PG8_STAGE(PG8_SB(0, 0), b2, voffB);
            PG8_BAR; PG8_WAIT_L(0); PG8_MMA(0, 1, At, B1); PG8_BAR;
            PG8_LDA(At, 0, 1); PG8_STAGE(PG8_SA(0, 0), a2, voffA);
            PG8_BAR; PG8_WAIT_L(0); PG8_MMA(1, 0, At, B0); PG8_BAR; PG8_SCHED;
            PG8_STAGE(PG8_SB(0, 1), b2 + hstep, voffB);
            PG8_WAIT_V(6); PG8_BAR; PG8_MMA(1, 1, At, B1); PG8_BAR;
            PG8_LDB(B0, 1, 0); PG8_SCHED; PG8_LDA(At, 1, 0); PG8_STAGE(PG8_SA(0, 1), a2 + hstep, voffA);
            PG8_WAIT_L(8); PG8_BAR; PG8_WAIT_L(0); PG8_MMA(0, 0, At, B0); PG8_BAR; PG8_SCHED;
            PG8_LDB(B1, 1, 1); PG8_STAGE(PG8_SB(1, 0), b3, voffB);
            PG8_BAR; PG8_WAIT_L(0); PG8_MMA(0, 1, At, B1); PG8_BAR;
            PG8_LDA(At, 1, 1); PG8_STAGE(PG8_SA(1, 0), a3, voffA);
            PG8_BAR; PG8_WAIT_L(0); PG8_MMA(1, 0, At, B0); PG8_BAR; PG8_SCHED;
            PG8_STAGE(PG8_SB(1, 1), b3 + hstep, voffB);
            PG8_WAIT_V(6); PG8_BAR; PG8_MMA(1, 1, At, B1); PG8_BAR;
            }
        }
        if constexpr (ALIGN_EPI) { if (wr == 0) PG8_BAR; }
        if constexpr (!Epi::AFTER_DRAIN) { E(acc, cur, wr, wc, fr, fq);
#ifdef PROBE_EPI2
            if constexpr (Epi::PROBE_TWICE) { asm volatile("" ::: "memory"); E(acc, cur, wr, wc, fr, fq); }
#endif
            S.done(cur); }
        if (!has_next) break;
#pragma unroll
        for (int a = 0; a < 2; ++a)
#pragma unroll
            for (int b = 0; b < 2; ++b)
#pragma unroll
                for (int m = 0; m < 4; ++m)
#pragma unroll
                    for (int n = 0; n < 2; ++n) acc[a][b][m][n] = (f32x4){0.f, 0.f, 0.f, 0.f};
        cur = nxt; cA = nA; cB = nB; ++ui;
        if constexpr (ALIGN_EPI) { if (wr == 1) PG8_BAR; }
    }
    PG8_WAIT_V(0);
    if constexpr (!ALIGN_EPI) { if (wr == 0) PG8_BAR; }
    PG8_BAR;
    if constexpr (Epi::AFTER_DRAIN) { E.fused(acc, cur, wr, wc, fr, fq, lds, wid, lane); S.done(cur); }
#undef PG8_SA
#undef PG8_SB
#undef PG8_STAGE
#undef PG8_LDA
#undef PG8_LDB
#undef PG8_MMA
#undef PG8_WAIT_V
#undef PG8_WAIT_L
#undef PG8_BAR
#undef PG8_SCHED
}
}
namespace pg8 {
struct EpiProj {
    static constexpr bool PERM = true, AFTER_DRAIN = false, PROBE_TWICE = true;
    bf16_t* O; int ldc;
    __device__ __forceinline__ void operator()(const f32x4 (&acc)[2][2][4][2], const Unit& u, int wr, int wc, int fr, int fq) const {
        const int row0 = u.pm * BM + wr * 64 + fr; const int col0 = u.pn * BM + wc * 32 + 8 * fq;
#pragma unroll
        for (int ai = 0; ai < 2; ++ai)
#pragma unroll
            for (int m = 0; m < 4; ++m) { bf16_t* rowp = O + (size_t)(row0 + ai * HALF + m * 16) * ldc + col0;
#pragma unroll
                for (int bj = 0; bj < 2; ++bj) { const f32x4 v0 = acc[ai][bj][m][0], v1 = acc[ai][bj][m][1];
                    u32x4 w; w.x = cvt_pk_bf16(v0[0], v0[1]); w.y = cvt_pk_bf16(v0[2], v0[3]); w.z = cvt_pk_bf16(v1[0], v1[1]); w.w = cvt_pk_bf16(v1[2], v1[3]);
                    __builtin_nontemporal_store(w, (u32x4*)(rowp + bj * HALF)); } }
    }
};
struct EpiX1 {
    static constexpr bool PERM = true, AFTER_DRAIN = false, PROBE_TWICE = false;
    const float* x; float* x1; bf16_t* x1s; const float* mod; const float* norm2_g; float* rowstat; PG8_LAS float* tab;
    __device__ __forceinline__ void operator()(const f32x4 (&acc)[2][2][4][2], const Unit& u, int wr, int wc, int fr, int fq) const {
        const int row0 = u.pm * BM + wr * 64 + fr; const int col0 = u.pn * BM + wc * 32 + 8 * fq; const int b = (u.pm * BM) >> 11;
        const float* mb = mod + (size_t)b * 6144;
        f32x4 g1[2][2], g2[2][2];
#pragma unroll
        for (int bj = 0; bj < 2; ++bj)
#pragma unroll
            for (int n = 0; n < 2; ++n) { const int c = col0 + bj * HALF + 4 * n; g1[bj][n] = *(const f32x4*)(mb + 2048 + c);
                const f32x4 sc = *(const f32x4*)(mb + 4096 + c), ng = *(const f32x4*)(norm2_g + c); g2[bj][n] = ng * (sc + 1.0f); }
#pragma unroll
        for (int ai = 0; ai < 2; ++ai)
#pragma unroll
            for (int m = 0; m < 4; ++m) { const size_t row = (size_t)(row0 + ai * HALF + m * 16); const size_t off = row * 1024 + col0; float ss = 0.f;
                const float rfin = tab[((u.pm >> 3) & 1) * 1280 + 1024 + ai * HALF + wr * 64 + m * 16 + fr];
#pragma unroll
                for (int bj = 0; bj < 2; ++bj) {
                    const f32x4 xa = *(const f32x4*)(x + off + bj * HALF), xb = *(const f32x4*)(x + off + bj * HALF + 4);
                    const f32x4 v0 = xa + g1[bj][0] * (acc[ai][bj][m][0] * rfin), v1 = xb + g1[bj][1] * (acc[ai][bj][m][1] * rfin);
                    *(f32x4*)(x1 + off + bj * HALF) = v0; *(f32x4*)(x1 + off + bj * HALF + 4) = v1;
                    ss += (v0[0] * v0[0] + v0[1] * v0[1]) + (v0[2] * v0[2] + v0[3] * v0[3]) + (v1[0] * v1[0] + v1[1] * v1[1]) + (v1[2] * v1[2] + v1[3] * v1[3]);
                    const f32x4 s0 = v0 * g2[bj][0], s1 = v1 * g2[bj][1];
                    u32x4 w; w.x = cvt_pk_bf16(s0[0], s0[1]); w.y = cvt_pk_bf16(s0[2], s0[3]); w.z = cvt_pk_bf16(s1[0], s1[1]); w.w = cvt_pk_bf16(s1[2], s1[3]);
                    *(u32x4*)(x1s + off + bj * HALF) = w; }
                ss += __shfl_xor(ss, 16); ss += __shfl_xor(ss, 32);
                if (fq == 0) atomicAdd(rowstat + row, ss); }
    }
};
typedef _Float16 f16x8 __attribute__((ext_vector_type(8)));
struct EpiScores {
    static constexpr bool PERM = true, AFTER_DRAIN = false, PROBE_TWICE = false;
    _Float16* S; const float* sb; const float* rowstat;
    __device__ __forceinline__ void operator()(const f32x4 (&acc)[2][2][4][2], const Unit& u, int wr, int wc, int fr, int fq) const {
        const int row0 = u.pm * BM + wr * 64 + fr; const int col0 = u.pn * BM + wc * 32 + 8 * fq; const int b = (u.pm * BM) >> 11;
        f32x4 bv[2][2];
#pragma unroll
        for (int bj = 0; bj < 2; ++bj)
#pragma unroll
            for (int n = 0; n < 2; ++n) bv[bj][n] = *(const f32x4*)(sb + (size_t)b * 2048 + col0 + bj * HALF + 4 * n);
#pragma unroll
        for (int ai = 0; ai < 2; ++ai)
#pragma unroll
            for (int m = 0; m < 4; ++m) { const size_t row = (size_t)(row0 + ai * HALF + m * 16); const float rs = __builtin_amdgcn_rsqf(rowstat[row] * (1.0f / 1024.0f) + 1e-6f);
                _Float16* rowp = S + row * 2048 + col0;
#pragma unroll
                for (int bj = 0; bj < 2; ++bj) { const f32x4 v0 = acc[ai][bj][m][0] * rs + bv[bj][0], v1 = acc[ai][bj][m][1] * rs + bv[bj][1];
                    f16x8 h; h[0] = (_Float16)v0[0]; h[1] = (_Float16)v0[1]; h[2] = (_Float16)v0[2]; h[3] = (_Float16)v0[3]; h[4] = (_Float16)v1[0]; h[5] = (_Float16)v1[1]; h[6] = (_Float16)v1[2]; h[7] = (_Float16)v1[3];
                    *(f16x8*)(rowp + bj * HALF) = h; } }
    }
};
struct SegScaleHook {
    __device__ __forceinline__ static void build(PG8_LAS unsigned char* ldsx, const Unit& u, const float* st_ssd, const float* st_s5, int tid) {
        PG8_LAS float* tab = (PG8_LAS float*)ldsx + ((u.pm >> 3) & 1) * 1280;
        if (tid < 256) { const size_t row = (size_t)u.pm * BM + tid; const f32x4* sg = (const f32x4*)(st_ssd + row * 16); const f32x4* s5 = (const f32x4*)(st_s5 + row * 64);
            float r[5];
#pragma unroll
            for (int gI = 0; gI < 4; ++gI) { const f32x4 v = sg[gI]; r[gI] = __builtin_amdgcn_rsqf(((v[0] + v[1]) + (v[2] + v[3])) * (1.0f / 256.0f) + 1e-6f); }
            float a5 = 0.f;
#pragma unroll
            for (int q = 0; q < 16; ++q) { const f32x4 v = s5[q]; a5 += (v[0] + v[1]) + (v[2] + v[3]); }
            r[4] = __builtin_amdgcn_rsqf(a5 * (1.0f / 1024.0f) + 1e-6f);
#pragma unroll
            for (int k = 0; k < 4; ++k) tab[k * 256 + tid] = r[k] * __builtin_amdgcn_rcpf(r[k + 1]);
            tab[1024 + tid] = r[4]; }
    }
    __device__ __forceinline__ void at_tile(int t, const Unit& u, f32x4 (&acc)[2][2][4][2], PG8_LAS unsigned char* ldsx, int wr, int fr) const {
        if (t == 4 || t == 8 || t == 12 || t == 16) { const PG8_LAS float* rt = (const PG8_LAS float*)ldsx + ((u.pm >> 3) & 1) * 1280 + ((t >> 2) - 1) * 256 + wr * 64 + fr;
#pragma unroll
            for (int ai = 0; ai < 2; ++ai)
#pragma unroll
                for (int m = 0; m < 4; ++m) { const float r = rt[ai * HALF + m * 16];
#pragma unroll
                    for (int bj = 0; bj < 2; ++bj) { acc[ai][bj][m][0] = acc[ai][bj][m][0] * r; acc[ai][bj][m][1] = acc[ai][bj][m][1] * r; } } }
    }
};
}
constexpr int NWAVES = 8, NTHR = 512;
constexpr int DM = 1024, NB = 16, SEQ = 2048, MTOK = NB * SEQ;
constexpr int NPROJ = 4096;
constexpr int INW = 4112;
constexpr int NHEADS = 16, HDIM = 64, NGRP = 4, NST = 128, CHUNK = 128;
constexpr int S5G = 64, S5CH = 16, S5P = 64;
constexpr int PH = 8, PK = 16, PNK = 128;
constexpr float EPSF = 1e-6f;
constexpr int NS5PART = 64;

constexpr size_t MiB = 1u << 20;
constexpr size_t WS_CTL = 0, CTL_ZERO_BYTES = 64 * 1024;
constexpr size_t WS_MOD = 1 * MiB;
constexpr size_t WS_WDT = WS_MOD + 0x60000;
constexpr size_t WS_SB = WS_MOD + 0x70000;
constexpr size_t WS_ROWSTAT = WS_MOD + 0x90000;
constexpr size_t WS_S5LB = WS_MOD + 0xB0000;
constexpr size_t WS_S5BB = WS_MOD + 0xC0000;
constexpr size_t WS_DTRAW = 3 * MiB;
constexpr size_t WS_STSSD = 5 * MiB;
constexpr size_t WS_STS5 = 7 * MiB;
constexpr size_t WS_WINT = 15 * MiB;
constexpr size_t WS_WOUTT = 23 * MiB;
constexpr size_t WS_WQKT = 27 * MiB;
constexpr size_t WS_EU = 31 * MiB, WS_EV = 47 * MiB;
constexpr size_t WS_EUS = 63 * MiB, WS_EVS = 63 * MiB + 65536;
constexpr size_t WS_START = 64 * MiB;
constexpr size_t WS_A = 95 * MiB;
constexpr size_t WS_B = 223 * MiB;
constexpr size_t WS_H1 = WS_A, WS_Y = WS_A, WS_PROJ = WS_B, WS_SCORES = WS_A;
constexpr size_t WS_X1S = WS_B + 192 * MiB;
constexpr size_t WS_EID = 479 * MiB, WS_GATE = 495 * MiB;
constexpr size_t WS_H2Q = WS_B, WS_HINV = WS_B + 32 * MiB;
constexpr size_t WS_END = 511 * MiB;
static_assert(WS_SCORES + (size_t)MTOK * 2048 * 4 <= WS_X1S && WS_X1S + (size_t)MTOK * 1024 * 2 <= WS_EID && WS_GATE + (size_t)MTOK * 128 * 4 <= WS_END, "ws map");

constexpr int LDS_MAIN = 159744;
constexpr int MISC_OFF = LDS_MAIN;
constexpr int LDS_BYTES = LDS_MAIN + 128;

#define GAS __attribute__((address_space(1)))
#define LAS __attribute__((address_space(3)))
typedef unsigned short bf16;
typedef unsigned v4u __attribute__((ext_vector_type(4)));
typedef unsigned v2u __attribute__((ext_vector_type(2)));
typedef float f32x4 __attribute__((ext_vector_type(4)));
typedef float f32x2 __attribute__((ext_vector_type(2)));
typedef short bf16x8 __attribute__((ext_vector_type(8)));
#define LDS_WAIT() asm volatile("s_waitcnt lgkmcnt(0)" ::: "memory")
#define VM_WAIT() asm volatile("s_waitcnt vmcnt(0)" ::: "memory")
typedef __bf16 hwbf16x2 __attribute__((ext_vector_type(2)));
__device__ __forceinline__ unsigned pk2(float lo, float hi) { const f32x2 v = {lo, hi}; const hwbf16x2 b = __builtin_convertvector(v, hwbf16x2); return __builtin_bit_cast(unsigned, b); }
__device__ __forceinline__ unsigned f2bf(float f) { return pk2(f, 0.f) & 0xffffu; }
__device__ __forceinline__ float bflo(unsigned w) { return __builtin_bit_cast(float, w << 16); }
__device__ __forceinline__ float bfhi(unsigned w) { return __builtin_bit_cast(float, w & 0xffff0000u); }
__device__ __forceinline__ float bf2f(bf16 v) { return __builtin_bit_cast(float, (unsigned)v << 16); }
__device__ __forceinline__ float wave_sum(float v) {
#pragma unroll
    for (int o = 1; o < 64; o <<= 1) v += __shfl_xor(v, o);
    return v;
}
__device__ __forceinline__ float sigmoid_f(float v) { return __builtin_amdgcn_rcpf(1.0f + __builtin_amdgcn_exp2f(-1.4426950408889634f * v)); }
__device__ __forceinline__ float silu_f(float v) { return v * sigmoid_f(v); }
__device__ __forceinline__ float rsqrt_f(float v) { return __builtin_amdgcn_rsqf(v); }
__device__ __forceinline__ float gelu_erf(float v) {
    const float av = fabsf(v), t = __builtin_amdgcn_rcpf(av * 0.2316418882f + 1.0f);
    float q = t * 0.5307027145f + (-0.7265760135f); q = q * t + 0.7107068705f; q = q * t + (-0.142248368f); q = q * t + 0.127414796f; q = q * t;
    const float e = __builtin_amdgcn_exp2f((v * v) * (-0.72134752044f));
    const float m = v * (q * e);
    return v < 0.f ? m : v - m;
}
__device__ __forceinline__ float softplus_f(float v) { const float e = __builtin_amdgcn_exp2f(-1.4426950408889634f * fabsf(v));
    const float l = e < 1e-6f ? e : 0.6931471805599453f * __builtin_amdgcn_logf(1.0f + e); return fmaxf(v, 0.f) + l; }
__device__ __forceinline__ void unpack8(const v4u w, float* f) { f[0] = bflo(w.x); f[1] = bfhi(w.x); f[2] = bflo(w.y); f[3] = bfhi(w.y); f[4] = bflo(w.z); f[5] = bfhi(w.z); f[6] = bflo(w.w); f[7] = bfhi(w.w); }
#define LDS_BARRIER() do { asm volatile("s_waitcnt lgkmcnt(0)" ::: "memory"); __builtin_amdgcn_s_barrier(); asm volatile("" ::: "memory"); } while (0)
__device__ __forceinline__ float row16_sum_to15(float v) {
    v += __builtin_bit_cast(float, __builtin_amdgcn_update_dpp(0, __builtin_bit_cast(int, v), 0x118, 0xf, 0xf, true));
    v += __builtin_bit_cast(float, __builtin_amdgcn_update_dpp(0, __builtin_bit_cast(int, v), 0x114, 0xf, 0xf, true));
    v += __builtin_bit_cast(float, __builtin_amdgcn_update_dpp(0, __builtin_bit_cast(int, v), 0x112, 0xf, 0xf, true));
    v += __builtin_bit_cast(float, __builtin_amdgcn_update_dpp(0, __builtin_bit_cast(int, v), 0x111, 0xf, 0xf, true));
    return v;
}
__device__ __forceinline__ float wave_sum_to63(float v) {
    v = row16_sum_to15(v);
    v += __builtin_bit_cast(float, __builtin_amdgcn_update_dpp(0, __builtin_bit_cast(int, v), 0x142, 0xa, 0xf, false));
    v += __builtin_bit_cast(float, __builtin_amdgcn_update_dpp(0, __builtin_bit_cast(int, v), 0x143, 0xc, 0xf, false));
    return v;
}
__device__ __forceinline__ f32x2 gelu_pk2(f32x2 v) {
    const f32x2 av = __builtin_elementwise_abs(v), d = av * 0.2316418882f + 1.0f;
    f32x2 t; t[0] = __builtin_amdgcn_rcpf(d[0]); t[1] = __builtin_amdgcn_rcpf(d[1]);
    f32x2 q = t * 0.5307027145f + (-0.7265760135f); q = q * t + 0.7107068705f; q = q * t + (-0.142248368f); q = q * t + 0.127414796f; q = q * t;
    const f32x2 s = (v * v) * (-0.72134752044f);
    f32x2 e; e[0] = __builtin_amdgcn_exp2f(s[0]); e[1] = __builtin_amdgcn_exp2f(s[1]);
    const f32x2 m = v * (q * e), r = v - m;
    f32x2 o; o[0] = v[0] < 0.f ? m[0] : r[0]; o[1] = v[1] < 0.f ? m[1] : r[1]; return o;
}
#define XB_TMO      128
#define XB_XCNT(j)  (256  + 64 * (j))
#define XB_XSUB(j)  (1280 + 64 * (j))
#define XB_XGEN(j)  (2304 + 64 * (j))
#define XB_TOP      3328
#define XB_TOPGEN   3392
#define XCD_BAR_WORDS 3456
#define XB_SPIN_CAP (1u << 18)

__device__ __forceinline__ unsigned xb_ld(unsigned* p)              { return __hip_atomic_load(p, __ATOMIC_RELAXED, __HIP_MEMORY_SCOPE_AGENT); }
__device__ __forceinline__ unsigned xb_add(unsigned* p, unsigned v) { return __hip_atomic_fetch_add(p, v, __ATOMIC_RELAXED, __HIP_MEMORY_SCOPE_AGENT); }
__device__ __forceinline__ unsigned xb_xcc_id() { return (unsigned)__builtin_amdgcn_s_getreg((3 << 11) | 20) & 0xFu; }
#define XB_SPIN(cond, bar) do { unsigned _sp = 0; while (cond) { __builtin_amdgcn_s_sleep(1); \
    if ((++_sp & 255u) == 0u) { if (xb_ld(&(bar)[XB_TMO])) break; if (_sp > XB_SPIN_CAP) { atomicAdd(&(bar)[XB_TMO], 1u); break; } } } } while (0)

struct XcdBarrier {
    unsigned* bar; unsigned x;
    volatile LAS unsigned* st;
};

__device__ __forceinline__ XcdBarrier xcd_barrier_post(unsigned* bar, volatile LAS unsigned* st) {
    XcdBarrier b; b.bar = bar; b.x = xb_xcc_id(); b.st = st;
    if (threadIdx.x == 0) (void)xb_add(&bar[XB_XCNT(b.x)], 1u);
    return b;
}
__device__ __forceinline__ void xcd_barrier_complete(unsigned* bar, unsigned x, unsigned& nloc, unsigned& nx) {
    const unsigned G = gridDim.x * gridDim.y * gridDim.z;
    unsigned sum, cnt, mine, sp = 0u;
    for (;;) {
        sum = 0u; cnt = 0u; mine = 0u;
#pragma unroll
        for (unsigned j = 0; j < 16; ++j) { const unsigned c = xb_ld(&bar[XB_XCNT(j)]); sum += c; cnt += (c > 0u) ? 1u : 0u; mine = (j == x) ? c : mine; }
        if (sum == G) break;
        __builtin_amdgcn_s_sleep(1);
        if ((++sp & 255u) == 0u) { if (xb_ld(&bar[XB_TMO])) break; if (sp > XB_SPIN_CAP) { atomicAdd(&bar[XB_TMO], 1u); break; } }
    }
    nloc = mine > 0u ? mine : 1u; nx = cnt > 0u ? cnt : 1u;
}

__device__ __forceinline__ void xcd_barrier(const XcdBarrier& b) {
    asm volatile("s_waitcnt vmcnt(0)" ::: "memory");
    __syncthreads();
    if (threadIdx.x == 0) {
        unsigned* bar = b.bar;
        __builtin_amdgcn_s_waitcnt(0);
        unsigned nloc = b.st[0], nx = b.st[1];
        if (nloc == 0u) { xcd_barrier_complete(bar, b.x, nloc, nx); b.st[0] = nloc; b.st[1] = nx; }
        const unsigned old = xb_add(&bar[XB_XSUB(b.x)], 1u);
        const unsigned gen = old / nloc;
        if (old + 1u == (gen + 1u) * nloc) {
            __builtin_amdgcn_fence(__ATOMIC_RELEASE, "agent");
            asm volatile("s_waitcnt vmcnt(0)" ::: "memory");
            const unsigned og = xb_add(&bar[XB_TOP], 1u);
            const unsigned tg = og / nx;
            if (og + 1u == (tg + 1u) * nx) xb_add(&bar[XB_TOPGEN], 1u);
            else XB_SPIN(xb_ld(&bar[XB_TOPGEN]) == tg, bar);
            __builtin_amdgcn_fence(__ATOMIC_ACQUIRE, "agent");
            xb_add(&bar[XB_XGEN(b.x)], 1u);
            asm volatile("s_waitcnt vmcnt(0)" ::: "memory");
        } else {
            XB_SPIN(xb_ld(&bar[XB_XGEN(b.x)]) == gen, bar);
            __builtin_amdgcn_fence(__ATOMIC_ACQUIRE, "agent");
            asm volatile("s_waitcnt vmcnt(0)" ::: "memory");
        }
    }
    __syncthreads();
}
struct Args { const float* in[30]; float* out; unsigned char* ws; int ph_lo, ph_hi; };
struct Frame {
    LAS unsigned char* lds;
    volatile LAS unsigned* MISC;
    int vcu, G;
    unsigned char* ws;
    const Args* a;
    float* out;
};
#define WSP(T, off) ((T*)(F.ws + (off)))

__device__ __forceinline__ void transpose_tile(const float* W, int ldw, int k0, int src_n0, bf16* WT, int K, int dst_n0, LAS float* scr, int lane, const float* kscale) {
#pragma unroll 8
    for (int i = 0; i < 32; ++i) { const int kk = 2 * i + (lane >> 5); float v = W[(size_t)(k0 + kk) * ldw + src_n0 + (lane & 31)]; if (kscale) v *= kscale[k0 + kk]; scr[kk * 33 + (lane & 31)] = v; }
    LDS_WAIT(); asm volatile("" ::: "memory");
    const int c = lane & 7;
#pragma unroll
    for (int j = 0; j < 4; ++j) { const int n = (lane >> 3) + 8 * j; const LAS float* s = scr + (8 * c) * 33 + n;
        v4u o; o.x = pk2(s[0 * 33], s[1 * 33]); o.y = pk2(s[2 * 33], s[3 * 33]); o.z = pk2(s[4 * 33], s[5 * 33]); o.w = pk2(s[6 * 33], s[7 * 33]);
        *(v4u*)(WT + (size_t)(dst_n0 + n) * K + k0 + 8 * c) = o; }
    LDS_WAIT(); asm volatile("" ::: "memory");
}
__device__ __forceinline__ void p0_phase(Frame& F) {
    const int f_tid = threadIdx.x, f_lane = f_tid & 63, f_wave = __builtin_amdgcn_readfirstlane(f_tid >> 6);
    const int gw = F.vcu * NWAVES + f_wave, NGW = F.G * NWAVES, gt = F.vcu * NTHR + f_tid, NGT = F.G * NTHR;
    {
        LAS float* sc = (LAS float*)F.lds;
        LAS float* red = (LAS float*)(F.lds + 65536);
        for (int i = f_tid; i < 16 * 1024; i += NTHR) { const int b = i >> 10, k = i & 1023; sc[k * 16 + b] = silu_f((F.a->in[1])[i]); }
        __syncthreads();
        const int ks = f_tid / 24, col = f_tid - ks * 24, j = F.vcu * 24 + col;
        if (ks < 21) {
            float acc[16];
#pragma unroll
            for (int b = 0; b < 16; ++b) acc[b] = 0.f;
            const int k0 = ks * 49, kn = (k0 + 49 <= 1024) ? 49 : (1024 - k0);
            const float* wp = (F.a->in[2]) + (size_t)k0 * 6144 + j;
#pragma unroll 1
            for (int kb = 0; kb < 49; kb += 7) {
                asm volatile("" ::: "memory");
                float wv[7];
#pragma unroll
                for (int u = 0; u < 7; ++u) wv[u] = (kb + u < kn) ? wp[(size_t)(kb + u) * 6144] : 0.f;
#pragma unroll
                for (int u = 0; u < 7; ++u) { const int kk = (kb + u < kn) ? (k0 + kb + u) : k0; const LAS f32x4* s4 = (const LAS f32x4*)(sc + kk * 16);
#pragma unroll
                    for (int q = 0; q < 4; ++q) { const f32x4 sv = s4[q]; acc[4 * q] += sv[0] * wv[u]; acc[4 * q + 1] += sv[1] * wv[u]; acc[4 * q + 2] += sv[2] * wv[u]; acc[4 * q + 3] += sv[3] * wv[u]; } }
            }
#pragma unroll
            for (int b = 0; b < 16; ++b) red[(ks * 16 + b) * 24 + col] = acc[b];
        }
        __syncthreads();
        for (int i = f_tid; i < 16 * 24; i += NTHR) { const int b = i / 24, cc = i - b * 24; float sacc = 0.f;
            for (int q = 0; q < 21; ++q) sacc += red[(q * 16 + b) * 24 + cc];
            WSP(float, WS_MOD)[b * 6144 + F.vcu * 24 + cc] = sacc + (F.a->in[3])[F.vcu * 24 + cc]; }
        __syncthreads();
    }
    {
        LAS float* scr = (LAS float*)(F.lds + f_wave * 16384);
        constexpr int I_IN = (1024 / 64) * (NPROJ / 32), I_OUT = (2048 / 64) * (1024 / 32);
        for (int it = gw; it < I_IN + I_OUT; it += NGW) {
            if (it < I_IN) { const int kb = it / (NPROJ / 32), nb = it % (NPROJ / 32); const int dn = 32 * nb, sn = dn < 3072 ? dn : dn + 16;
                transpose_tile((F.a->in[5]), INW, 64 * kb, sn, WSP(bf16, WS_WINT), 1024, dn, scr, f_lane, nullptr); }
            else { const int r = it - I_IN, kb = r / 32, nb = r % 32; const int k0 = 64 * kb;
                transpose_tile((F.a->in[23]), 1024, k0, 32 * nb, WSP(bf16, WS_WOUTT), 2048, 32 * nb, scr, f_lane, k0 < 1024 ? (F.a->in[11]) : (F.a->in[22]) - 1024); }
        }
    }
    for (int i = gt; i < 16 * 1024; i += NGT) { const int h = i >> 10, k = i & 1023; WSP(float, WS_WDT)[i] = (F.a->in[5])[(size_t)k * INW + 3072 + h]; }
    for (int task = gw; task < 2048; task += NGW) {
        const int nt = task >> 4, ks = task & 15, n0 = 16 * nt, hc = n0 >> 7, k0 = 64 * ks;
        const int li = f_lane & 15, lq = f_lane >> 4;
        f32x4 acc[4];
#pragma unroll
        for (int s = 0; s < 4; ++s) acc[s] = (f32x4){0.f, 0.f, 0.f, 0.f};
        const float* ap = (F.a->in[26]) + (size_t)(n0 + li) * 128 + 4 * lq;
        const float* bp = (F.a->in[25]) + (size_t)(k0 + li) * 2048 + hc * 128 + 4 * lq;
#pragma unroll
        for (int q = 0; q < 8; ++q) { const f32x4 a = *(const f32x4*)(ap + 16 * q);
#pragma unroll
            for (int s = 0; s < 4; ++s) { const f32x4 b = *(const f32x4*)(bp + (size_t)(16 * s) * 2048 + 16 * q);
#pragma unroll
                for (int jj = 0; jj < 4; ++jj) acc[s] = __builtin_amdgcn_mfma_f32_16x16x4f32(a[jj], b[jj], acc[s], 0, 0, 0); } }
        bf16* o = WSP(bf16, WS_WQKT);
#pragma unroll
        for (int s = 0; s < 4; ++s)
#pragma unroll
            for (int r = 0; r < 4; ++r) o[(size_t)(n0 + 4 * lq + r) * 1024 + k0 + 16 * s + li] = (bf16)f2bf(acc[s][r]);
    }
    for (int i = gt; i < S5G * S5P; i += NGT) {
        const float lr = (F.a->in[12])[i], li = (F.a->in[13])[i], dt = expf((F.a->in[14])[i >> 6]);
        const float mag = expf(lr * dt); float sn, cs; sincosf(li * dt, &sn, &cs);
        const float lbr = mag * cs, lbi = mag * sn, den = lr * lr + li * li;
        const float cfr = ((lbr - 1.0f) * lr + lbi * li) / den, cfi = (lbi * lr - (lbr - 1.0f) * li) / den;
        WSP(float, WS_S5LB)[2 * i] = lbr; WSP(float, WS_S5LB)[2 * i + 1] = lbi;
        for (int hh = 0; hh < 16; ++hh) { const float br = (F.a->in[15])[i * 16 + hh], bi = (F.a->in[16])[i * 16 + hh];
            WSP(float, WS_S5BB)[i * 32 + hh] = cfr * br - cfi * bi; WSP(float, WS_S5BB)[i * 32 + 16 + hh] = cfr * bi + cfi * br; }
    }
    for (int i = gt; i < MTOK; i += NGT) WSP(float, WS_ROWSTAT)[i] = 0.f;
}

__device__ __forceinline__ void p1_phase(Frame& F) {
    const int f_tid = threadIdx.x, f_lane = f_tid & 63, f_wave = __builtin_amdgcn_readfirstlane(f_tid >> 6);
    const int gw = F.vcu * NWAVES + f_wave;
    LAS float* wdt = (LAS float*)F.lds;
    for (int i = f_tid; i < 16 * 1024 / 4; i += NTHR) ((LAS f32x4*)wdt)[i] = ((const f32x4*)WSP(float, WS_WDT))[i];
    __syncthreads();
    const int lane = f_lane;
    for (int wq = gw; wq < MTOK / 16; wq += F.G * NWAVES) {
        const int b = wq >> 7; const float* mb = WSP(float, WS_MOD) + (size_t)b * 6144;
        f32x4 Gv[4], Sv[4];
#pragma unroll
        for (int j = 0; j < 4; ++j) { const int k = 4 * lane + 256 * j; const f32x4 g = *(const f32x4*)((F.a->in[4]) + k), sc = *(const f32x4*)(mb + 1024 + k); Gv[j] = g * (sc + 1.0f); Sv[j] = *(const f32x4*)(mb + k); }
        f32x4 nx[4];
#pragma unroll
        for (int j = 0; j < 4; ++j) nx[j] = *(const f32x4*)((F.a->in[0]) + (size_t)wq * 16 * 1024 + 4 * lane + 256 * j);
        for (int tt = 0; tt < 16; ++tt) {
            asm volatile("" ::: "memory");
            const size_t t = (size_t)wq * 16 + tt; const float* xr = (F.a->in[0]) + t * 1024;
            f32x4 v[4]; float ss = 0.f;
#pragma unroll
            for (int j = 0; j < 4; ++j) { v[j] = nx[j]; ss += (v[j][0] * v[j][0] + v[j][1] * v[j][1]) + (v[j][2] * v[j][2] + v[j][3] * v[j][3]); }
            if (tt < 15) {
#pragma unroll
                for (int j = 0; j < 4; ++j) nx[j] = *(const f32x4*)(xr + 1024 + 4 * lane + 256 * j); }
            const float rstd = rsqrt_f(wave_sum(ss) * (1.0f / 1024.0f) + EPSF);
            bf16* hr = WSP(bf16, WS_H1) + t * 1024;
#pragma unroll
            for (int j = 0; j < 4; ++j) { v[j] = v[j] * rstd * Gv[j] + Sv[j]; v2u w; w.x = pk2(v[j][0], v[j][1]); w.y = pk2(v[j][2], v[j][3]); *(v2u*)(hr + 4 * lane + 256 * j) = w; }
            float d[16];
#pragma unroll
            for (int h = 0; h < 16; ++h) { float a = 0.f;
#pragma unroll
                for (int j = 0; j < 4; ++j) { const f32x4 w = *(const LAS f32x4*)(wdt + h * 1024 + 4 * lane + 256 * j); a += (v[j][0] * w[0] + v[j][1] * w[1]) + (v[j][2] * w[2] + v[j][3] * w[3]); }
                d[h] = a; }
            float e8[8], e4[4], e2[2], e1;
#pragma unroll
            for (int i = 0; i < 8; ++i) { const bool up = lane & 32; const float snd = up ? d[i] : d[i + 8]; const float rcv = __shfl_xor(snd, 32); e8[i] = (up ? d[i + 8] : d[i]) + rcv; }
#pragma unroll
            for (int i = 0; i < 4; ++i) { const bool up = lane & 16; const float snd = up ? e8[i] : e8[i + 4]; const float rcv = __shfl_xor(snd, 16); e4[i] = (up ? e8[i + 4] : e8[i]) + rcv; }
#pragma unroll
            for (int i = 0; i < 2; ++i) { const bool up = lane & 8; const float snd = up ? e4[i] : e4[i + 2]; const float rcv = __shfl_xor(snd, 8); e2[i] = (up ? e4[i + 2] : e4[i]) + rcv; }
            { const bool up = lane & 4; const float snd = up ? e2[0] : e2[1]; const float rcv = __shfl_xor(snd, 4); e1 = (up ? e2[1] : e2[0]) + rcv; }
            e1 += __shfl_xor(e1, 2); e1 += __shfl_xor(e1, 1);
            const int head = ((lane >> 5) & 1) * 8 + ((lane >> 4) & 1) * 4 + ((lane >> 3) & 1) * 2 + ((lane >> 2) & 1);
            if ((lane & 3) == 0) WSP(float, WS_DTRAW)[t * 16 + head] = e1;
        }
    }
    for (int n = gw; n < 2048; n += F.G * NWAVES) {
        const bf16* wr = WSP(bf16, WS_WQKT) + (size_t)n * 1024 + 16 * lane;
        const v4u w0 = *(const v4u*)wr, w1 = *(const v4u*)(wr + 8);
        float wv[16]; wv[0] = bflo(w0.x); wv[1] = bfhi(w0.x); wv[2] = bflo(w0.y); wv[3] = bfhi(w0.y); wv[4] = bflo(w0.z); wv[5] = bfhi(w0.z); wv[6] = bflo(w0.w); wv[7] = bfhi(w0.w);
        wv[8] = bflo(w1.x); wv[9] = bfhi(w1.x); wv[10] = bflo(w1.y); wv[11] = bfhi(w1.y); wv[12] = bflo(w1.z); wv[13] = bfhi(w1.z); wv[14] = bflo(w1.w); wv[15] = bfhi(w1.w);
        for (int b = 0; b < 16; ++b) { const float* sp = WSP(float, WS_MOD) + (size_t)b * 6144 + 3072 + 16 * lane; float a = 0.f;
#pragma unroll
            for (int q = 0; q < 4; ++q) { const f32x4 s = *(const f32x4*)(sp + 4 * q); a += (s[0] * wv[4 * q] + s[1] * wv[4 * q + 1]) + (s[2] * wv[4 * q + 2] + s[3] * wv[4 * q + 3]); }
            a = wave_sum(a); if (lane == 0) WSP(float, WS_SB)[b * 2048 + n] = a; }
    }
}
__device__ __forceinline__ void p3pre_conv(Frame& F) {
    const int tid = threadIdx.x;
    const bf16* proj = WSP(bf16, WS_PROJ); bf16* xo = (bf16*)F.out;
    for (int item = F.vcu * NTHR + tid; item < (MTOK / 16) * 256; item += F.G * NTHR) {
        const int oc = item & 255, run = item >> 8; const int t0 = run * 16, ch = 8 * oc;
        const bool halo = (t0 & (SEQ - 1)) != 0;
        v4u rw[19];
#pragma unroll
        for (int k = 0; k < 19; ++k) { rw[k] = (v4u){0u, 0u, 0u, 0u}; if (k >= 3 || halo) rw[k] = *(const v4u*)(proj + (size_t)(t0 - 3 + k) * NPROJ + 1024 + ch); }
        float cw[4][8], cbv[8];
#pragma unroll
        for (int k = 0; k < 4; ++k) { const f32x4 w0 = *(const f32x4*)((F.a->in[6]) + k * 2048 + ch), w1 = *(const f32x4*)((F.a->in[6]) + k * 2048 + ch + 4);
#pragma unroll
            for (int e = 0; e < 4; ++e) { cw[k][e] = w0[e]; cw[k][4 + e] = w1[e]; } }
        { const f32x4 b0 = *(const f32x4*)((F.a->in[7]) + ch), b1 = *(const f32x4*)((F.a->in[7]) + ch + 4);
#pragma unroll
            for (int e = 0; e < 4; ++e) { cbv[e] = b0[e]; cbv[4 + e] = b1[e]; } }
        float r0[8], r1[8], r2[8];
        unpack8(rw[0], r0); unpack8(rw[1], r1); unpack8(rw[2], r2);
#pragma unroll
        for (int tt = 0; tt < 16; ++tt) {
            float r3[8]; unpack8(rw[3 + tt], r3);
            float v[8];
#pragma unroll
            for (int i = 0; i < 8; ++i) { v[i] = silu_f(cbv[i] + r0[i] * cw[0][i] + r1[i] * cw[1][i] + r2[i] * cw[2][i] + r3[i] * cw[3][i]); r0[i] = r1[i]; r1[i] = r2[i]; r2[i] = r3[i]; }
            *(v4u*)(xo + (size_t)(t0 + tt) * 2048 + ch) = (v4u){pk2(v[0], v[1]), pk2(v[2], v[3]), pk2(v[4], v[5]), pk2(v[6], v[7])};
        }
    }
}
constexpr int SSD_PITCH = 272;
__device__ __forceinline__ bf16x8 lds_frag(LAS unsigned char* base, int row, int kbyte) { return *(const LAS bf16x8*)(base + row * SSD_PITCH + kbyte); }
#ifdef PROBE_SSD
#define SPR_T(v) const unsigned long long v = __builtin_amdgcn_s_memtime();
#define SPR_ACC(i, d) sacc[i] += (d);
#else
#define SPR_T(v)
#define SPR_ACC(i, d)
#endif
constexpr int S3_CS = 0, S3_BS = 34816, S3_GY = 69632, S3_XDT = 104448, S3_XP = 144, S3_PREV = 122880, S3_CSF = 140288, S3_DTF = 141312, S3_WTS = 142336, S3_END = 143360;
static_assert(S3_END <= LDS_MAIN, "SSD v3 LDS map");
typedef short v4i16_t __attribute__((ext_vector_type(4)));
__device__ __forceinline__ bf16x8 lds_frag_tr(LAS unsigned char* tile, int pitch, int k0, int col0, int li, int lq) {
    LAS unsigned char* p = tile + (k0 + 8 * lq + (li >> 2)) * pitch + (col0 + 4 * (li & 3)) * 2;
    const v4i16_t lo = __builtin_amdgcn_ds_read_tr16_b64_v4i16((LAS v4i16_t*)p), hi = __builtin_amdgcn_ds_read_tr16_b64_v4i16((LAS v4i16_t*)(p + 4 * pitch));
    return __builtin_shufflevector(lo, hi, 0, 1, 2, 3, 4, 5, 6, 7);
}
struct Ssd3Pre { v4u xr[4], br[4], cr[4]; float d0, d1; };
__device__ __forceinline__ void ssd3_prefetch(Ssd3Pre& P, const char* xcb, const float* dtr, unsigned voB, unsigned voX, int tid, int lane, int w) {
#pragma unroll
    for (int r = 0; r < 4; ++r) { P.br[r] = *(const v4u*)(xcb + (voB + r * 4096u)); P.cr[r] = *(const v4u*)(xcb + (voB + 1024u + r * 4096u)); }
#pragma unroll
    for (int r = 0; r < 4; ++r) P.xr[r] = *(const v4u*)(xcb + (voX + r * 4096u));
    P.d0 = dtr[lane * 32]; P.d1 = dtr[lane * 32 + 16];
}
__device__ __forceinline__ void ssd3_cumsum(LAS unsigned char* L, int par, float r0, float r1, float dtb, float A, int lane) {
    LAS float* csf = (LAS float*)(L + S3_CSF + par * 512); LAS float* dtf = (LAS float*)(L + S3_DTF + par * 512); LAS float* wts = (LAS float*)(L + S3_WTS + par * 512);
    const float d0 = softplus_f(r0 + dtb), d1 = softplus_f(r1 + dtb);
    const float a0 = d0 * A, a1 = d1 * A; float s = a0 + a1;
#pragma unroll
    for (int o = 1; o < 64; o <<= 1) { const float t = __shfl_up(s, o); if (lane >= o) s += t; }
    const float tot = __shfl(s, 63);
    dtf[2 * lane] = d0; dtf[2 * lane + 1] = d1; csf[2 * lane] = s - a1; csf[2 * lane + 1] = s;
    wts[2 * lane] = __expf(tot - (s - a1)); wts[2 * lane + 1] = __expf(tot - s);
}
__device__ __forceinline__ void p3_ssd3(Frame& F) {
    const int tid0 = threadIdx.x, w = __builtin_amdgcn_readfirstlane(tid0 >> 6);
    LAS unsigned char* L = F.lds;
    const bf16* proj = WSP(bf16, WS_PROJ); const bf16* xc = (const bf16*)F.out; const float* dtraw = WSP(float, WS_DTRAW);
    for (int item = F.vcu; item < NB * NHEADS; item += F.G) {
        const int b = item >> 4, h = item & 15, g = h >> 2;
        int tid = tid0; asm volatile("" : "+v"(tid)); int lane = tid & 63;
        const float A = -__expf((F.a->in[9])[h]), Dh = (F.a->in[10])[h], dtb = (F.a->in[8])[h];
        const int pbs = w >> 1, nb0 = 4 * (w & 1);
        f32x4 st[4];
#pragma unroll
        for (int j = 0; j < 4; ++j) st[j] = (f32x4){0.f, 0.f, 0.f, 0.f};
        __syncthreads();
        for (int i = tid; i < 17408 / 16; i += NTHR) ((LAS v4u*)(L + S3_PREV))[i] = (v4u){0u, 0u, 0u, 0u};
        Ssd3Pre P;
        { const unsigned voB0 = (unsigned)((4 * (tid >> 4)) * 2048 + 1024 + g * 128 + 8 * (tid & 15)) * 2u, voX0 = (unsigned)((4 * ((tid & 255) >> 3)) * 2048 + h * 64 + 8 * (tid & 7)) * 2u;
          ssd3_prefetch(P, (const char*)xc + (size_t)b * SEQ * 4096, dtraw + (size_t)b * SEQ * 16 + h, voB0, voX0, tid, lane, w); }
        if (w == 0) ssd3_cumsum(L, 0, P.d0, P.d1, dtb, A, lane);
        __syncthreads();
#ifdef PROBE_SSD
        unsigned long long sacc[8] = {0, 0, 0, 0, 0, 0, 0, 0};
#endif
        for (int c = 0; c < SEQ / CHUNK; ++c) {
            SPR_T(s0)
            const size_t row0 = (size_t)b * SEQ + (size_t)c * CHUNK; const int par = c & 1;
            asm volatile("" : "+v"(tid));
            lane = tid & 63; const int li = lane & 15, lq = lane >> 4;
            const unsigned voB = (unsigned)((4 * (tid >> 4)) * 2048 + 1024 + g * 128 + 8 * (tid & 15)) * 2u, voX = (unsigned)((4 * ((tid & 255) >> 3)) * 2048 + h * 64 + 8 * (tid & 7)) * 2u;
            const unsigned voZ0 = (unsigned)((tid >> 3) * NPROJ + h * 64 + 8 * (tid & 7)) * 2u, voZ1 = voZ0 + 64u * NPROJ * 2u;
            LAS float* csf = (LAS float*)(L + S3_CSF + par * 512); LAS float* dtf = (LAS float*)(L + S3_DTF + par * 512); LAS float* wts = (LAS float*)(L + S3_WTS + par * 512);
            { const int ob = tid & 15, lb = 4 * (tid >> 4), n0 = 8 * ob;
#pragma unroll
              for (int r = 0; r < 4; ++r) { *(LAS v4u*)(L + S3_BS + (lb + r) * SSD_PITCH + n0 * 2) = P.br[r]; *(LAS v4u*)(L + S3_CS + (lb + r) * SSD_PITCH + n0 * 2) = P.cr[r]; } }
            if (tid < 256) { const int ox = tid & 7, lx = 4 * (tid >> 3), p0 = 8 * ox;
#pragma unroll
              for (int r = 0; r < 4; ++r) { float xv[8]; unpack8(P.xr[r], xv); const float tw = dtf[lx + r];
                  *(LAS v4u*)(L + S3_XDT + (lx + r) * S3_XP + p0 * 2) = (v4u){pk2(xv[0] * tw, xv[1] * tw), pk2(xv[2] * tw, xv[3] * tw), pk2(xv[4] * tw, xv[5] * tw), pk2(xv[6] * tw, xv[7] * tw)}; } }
            const char* prb = (const char*)proj + row0 * (NPROJ * 2);
            const v4u zc0 = *(const v4u*)(prb + voZ0), zc1 = *(const v4u*)(prb + voZ1);
            SPR_T(s1) SPR_ACC(0, s1 - s0)
            LDS_BARRIER();
            SPR_T(s2) SPR_ACC(1, s2 - s1)
            const float cs_end = csf[127];
            bf16x8 ca[4];
#pragma unroll
            for (int ks = 0; ks < 4; ++ks) ca[ks] = lds_frag(L + S3_CS, 16 * w + li, 64 * ks + 16 * lq);
            float csl[4];
#pragma unroll
            for (int r = 0; r < 4; ++r) csl[r] = csf[16 * w + 4 * lq + r];
            { bf16x8 bq[2][4];
#pragma unroll
              for (int ks = 0; ks < 4; ++ks) bq[0][ks] = lds_frag(L + S3_BS, li, 64 * ks + 16 * lq);
#pragma unroll
              for (int sb = 0; sb < 8; ++sb) if (sb <= (w | 1)) {
                  f32x4 cbv = (f32x4){0.f, 0.f, 0.f, 0.f};
                  const int s = 16 * sb + li; const float css = csf[s];
                  if (sb <= w) {
                      if (sb + 1 <= w) {
#pragma unroll
                          for (int ks = 0; ks < 4; ++ks) bq[(sb + 1) & 1][ks] = lds_frag(L + S3_BS, 16 * (sb + 1) + li, 64 * ks + 16 * lq); }
                      __builtin_amdgcn_sched_barrier(0);
#pragma unroll
                      for (int ks = 0; ks < 4; ++ks) cbv = __builtin_amdgcn_mfma_f32_16x16x32_bf16(ca[ks], bq[sb & 1][ks], cbv, 0, 0, 0);
                      __builtin_amdgcn_sched_barrier(0); }
#pragma unroll
                  for (int r = 0; r < 4; ++r) { const int l = 16 * w + 4 * lq + r; const float gv = (s <= l) ? cbv[r] * __expf(csl[r] - css) : 0.f;
                      *(LAS unsigned short*)(L + S3_GY + l * SSD_PITCH + s * 2) = (unsigned short)f2bf(gv); } } }
            LDS_WAIT(); asm volatile("" ::: "memory");
            SPR_T(s3) SPR_ACC(2, s3 - s2)
            f32x4 yd[4], yo[4];
#pragma unroll
            for (int pb = 0; pb < 4; ++pb) { yd[pb] = (f32x4){0.f, 0.f, 0.f, 0.f}; yo[pb] = (f32x4){0.f, 0.f, 0.f, 0.f}; }
            { bf16x8 gq[2], xq[2][4];
              gq[0] = lds_frag(L + S3_GY, 16 * w + li, 16 * lq);
#pragma unroll
              for (int pb = 0; pb < 4; ++pb) xq[0][pb] = lds_frag_tr(L + S3_XDT, S3_XP, 0, 16 * pb, li, lq);
#pragma unroll
              for (int ks = 0; ks < 4; ++ks) if (ks <= (w >> 1)) {
                  if (ks + 1 <= (w >> 1)) { gq[(ks + 1) & 1] = lds_frag(L + S3_GY, 16 * w + li, 64 * (ks + 1) + 16 * lq);
#pragma unroll
                      for (int pb = 0; pb < 4; ++pb) xq[(ks + 1) & 1][pb] = lds_frag_tr(L + S3_XDT, S3_XP, 32 * (ks + 1), 16 * pb, li, lq); }
                  __builtin_amdgcn_sched_barrier(0);
#pragma unroll
                  for (int pb = 0; pb < 4; ++pb) yd[pb] = __builtin_amdgcn_mfma_f32_16x16x32_bf16(gq[ks & 1], xq[ks & 1][pb], yd[pb], 0, 0, 0);
                  __builtin_amdgcn_sched_barrier(0); } }
            { bf16x8 pq[2][4];
#pragma unroll
              for (int pb = 0; pb < 4; ++pb) pq[0][pb] = lds_frag(L + S3_PREV, 16 * pb + li, 16 * lq);
#pragma unroll
              for (int ks = 0; ks < 4; ++ks) {
                  if (ks < 3) {
#pragma unroll
                      for (int pb = 0; pb < 4; ++pb) pq[(ks + 1) & 1][pb] = lds_frag(L + S3_PREV, 16 * pb + li, 64 * (ks + 1) + 16 * lq); }
                  __builtin_amdgcn_sched_barrier(0);
#pragma unroll
                  for (int pb = 0; pb < 4; ++pb) yo[pb] = __builtin_amdgcn_mfma_f32_16x16x32_bf16(ca[ks], pq[ks & 1][pb], yo[pb], 0, 0, 0);
                  __builtin_amdgcn_sched_barrier(0); } }
#pragma unroll
            for (int r = 0; r < 4; ++r) { const float e = __expf(csl[r]);
#pragma unroll
                for (int pb = 0; pb < 4; ++pb) *(LAS float*)(L + S3_GY + (16 * w + 4 * lq + r) * SSD_PITCH + (16 * pb + li) * 4) = yd[pb][r] + e * yo[pb][r]; }
            { const size_t rown = row0 + (c + 1 < SEQ / CHUNK ? CHUNK : 0);
              ssd3_prefetch(P, (const char*)xc + rown * 4096, dtraw + rown * 16 + h, voB, voX, tid, lane, w); }
            SPR_T(s4) SPR_ACC(3, s4 - s3)
            LDS_BARRIER();
            SPR_T(s5) SPR_ACC(4, s5 - s4)
            { const float dec = __expf(cs_end);
#pragma unroll
              for (int j = 0; j < 4; ++j) st[j] = st[j] * dec;
              bf16x8 xq[2], bq2[2][4]; f32x4 wq[2][2];
              xq[0] = lds_frag_tr(L + S3_XDT, S3_XP, 0, 16 * pbs, li, lq); wq[0][0] = *(const LAS f32x4*)(wts + 8 * lq); wq[0][1] = *(const LAS f32x4*)(wts + 8 * lq + 4);
#pragma unroll
              for (int j = 0; j < 4; ++j) bq2[0][j] = lds_frag_tr(L + S3_BS, SSD_PITCH, 0, 16 * (nb0 + j), li, lq);
#pragma unroll
              for (int ks = 0; ks < 4; ++ks) {
                  if (ks < 3) { xq[(ks + 1) & 1] = lds_frag_tr(L + S3_XDT, S3_XP, 32 * (ks + 1), 16 * pbs, li, lq); wq[(ks + 1) & 1][0] = *(const LAS f32x4*)(wts + 32 * (ks + 1) + 8 * lq); wq[(ks + 1) & 1][1] = *(const LAS f32x4*)(wts + 32 * (ks + 1) + 8 * lq + 4);
#pragma unroll
                      for (int j = 0; j < 4; ++j) bq2[(ks + 1) & 1][j] = lds_frag_tr(L + S3_BS, SSD_PITCH, 32 * (ks + 1), 16 * (nb0 + j), li, lq); }
                  __builtin_amdgcn_sched_barrier(0);
                  const f32x4 w0 = wq[ks & 1][0], w1 = wq[ks & 1][1];
                  float xv[8]; unpack8(__builtin_bit_cast(v4u, xq[ks & 1]), xv);
                  const v4u xw = (v4u){pk2(xv[0] * w0[0], xv[1] * w0[1]), pk2(xv[2] * w0[2], xv[3] * w0[3]), pk2(xv[4] * w1[0], xv[5] * w1[1]), pk2(xv[6] * w1[2], xv[7] * w1[3])};
                  const bf16x8 xf = __builtin_bit_cast(bf16x8, xw);
#pragma unroll
                  for (int j = 0; j < 4; ++j) st[j] = __builtin_amdgcn_mfma_f32_16x16x32_bf16(xf, bq2[ks & 1][j], st[j], 0, 0, 0);
                  __builtin_amdgcn_sched_barrier(0); }
#pragma unroll
              for (int j = 0; j < 4; ++j)
#pragma unroll
                  for (int r = 0; r < 4; ++r) *(LAS unsigned short*)(L + S3_PREV + (16 * pbs + 4 * lq + r) * SSD_PITCH + (16 * (nb0 + j) + li) * 2) = (unsigned short)f2bf(st[j][r]); }
            SPR_T(s6) SPR_ACC(5, s6 - s5)
#pragma unroll
            for (int k = 0; k < 2; ++k) { const int it = tid + 512 * k, l = it >> 3, o = it & 7; const size_t row = row0 + l;
                const f32x4 y0 = *(const LAS f32x4*)(L + S3_GY + l * SSD_PITCH + 32 * o), y1 = *(const LAS f32x4*)(L + S3_GY + l * SSD_PITCH + 32 * o + 16);
                const v4u xw = *(const LAS v4u*)(L + S3_XDT + l * S3_XP + 16 * o); const v4u zw = k == 0 ? zc0 : zc1; const float dsk = Dh * __builtin_amdgcn_rcpf(fmaxf(dtf[l], 1e-30f));
                float xv[8], zv[8], yv[8]; unpack8(xw, xv); unpack8(zw, zv);
                float ss = 0.f;
#pragma unroll
                for (int e = 0; e < 8; ++e) { const float yy = (e < 4 ? y0[e] : y1[e - 4]) + dsk * xv[e]; yv[e] = yy * silu_f(zv[e]); ss += yv[e] * yv[e]; }
                ss += __shfl_xor(ss, 1); ss += __shfl_xor(ss, 2); ss += __shfl_xor(ss, 4);
                if (o == 0) WSP(float, WS_STSSD)[row * 16 + h] = ss;
                *(v4u*)(WSP(bf16, WS_Y) + row * 2048 + h * 64 + 8 * o) = (v4u){pk2(yv[0], yv[1]), pk2(yv[2], yv[3]), pk2(yv[4], yv[5]), pk2(yv[6], yv[7])}; }
            if (w == 0 && c + 1 < SEQ / CHUNK) ssd3_cumsum(L, par ^ 1, P.d0, P.d1, dtb, A, lane);
            SPR_T(s7) SPR_ACC(6, s7 - s6)
            LDS_BARRIER();
            SPR_T(s8) SPR_ACC(7, s8 - s7)
        }
#ifdef PROBE_SSD
        if (blockIdx.x == 0 && threadIdx.x == PROBE_TID) *(volatile float*)(F.ws + WS_CTL + 40000) = (float)sacc[PROBE_SSD] * 1e-3f;
#endif
    }
}
typedef float f32x16 __attribute__((ext_vector_type(16)));
#ifdef PROBE_SEL
#define PR_T(v) const unsigned long long v = __builtin_amdgcn_s_memtime();
#define PR_ACC(a, d) a += (d);
#define PR_OUT(i, a) if (PROBE_SEL == (i) && blockIdx.x == 0 && threadIdx.x == 0) *(volatile float*)(F.ws + WS_CTL + 40000) = (float)(a) * 1e-4f;
#define PR_OUT4(i, a) if (PROBE_SEL == (i) && blockIdx.x == 0 && threadIdx.x == 256) *(volatile float*)(F.ws + WS_CTL + 40000) = (float)(a) * 1e-4f;
#else
#define PR_T(v)
#define PR_ACC(a, d)
#define PR_OUT(i, a)
#define PR_OUT4(i, a)
#endif
constexpr int S5V_BU = 0, S5V_BUP = 2056, S5V_BUSZ = 16 * S5V_BUP, S5V_XT = 2 * S5V_BUSZ, S5V_XTP = 1040, S5V_XTSZ = 16 * S5V_XTP, S5V_VS = S5V_XT + 2 * S5V_XTSZ, S5V_OT = S5V_VS + 4 * 512, S5V_OTP = 144, S5V_OTSZ = 16 * S5V_OTP, S5V_END = S5V_OT + 2 * S5V_OTSZ;
static_assert(S5V_END <= LDS_MAIN, "S5 v2 LDS map");
__device__ __forceinline__ void p3_s5v2(Frame& F) {
    const int tid = threadIdx.x, lane = tid & 63, w = __builtin_amdgcn_readfirstlane(tid >> 6);
    const int li = lane & 15, lq = lane >> 4;
    LAS unsigned char* L = F.lds;
    const bf16* proj = WSP(bf16, WS_PROJ);
    constexpr int NT = SEQ / 16;
#ifdef PROBE_S5
    const unsigned long long pr_t0 = PROBE_CLOCK();
#endif
    for (int item = F.vcu; item < NB * 16; item += F.G) {
        const int b = item >> 4, gs = item & 15;
        const bool scanw = w < 4; const int gl = w & 3, g = gs * 4 + gl;
        const bf16* ubase = proj + (size_t)b * SEQ * NPROJ + 3072 + gs * 64 + gl * 16;
        __syncthreads();
        if (scanw) {
            __builtin_amdgcn_s_setprio(2);
            const float lbr = WSP(float, WS_S5LB)[(g * 64 + lane) * 2], lbi = WSP(float, WS_S5LB)[(g * 64 + lane) * 2 + 1], nlbi = -lbi;
            bf16x8 bfr[8];
#pragma unroll
            for (int cb = 0; cb < 8; ++cb) { v4u v = (v4u){0u, 0u, 0u, 0u};
                if (lq < 2) { const int col = 16 * cb + li; const float* src = WSP(float, WS_S5BB) + (g * 64 + (col >> 1)) * 32 + (col & 1) * 16 + 8 * lq; const f32x4 a0 = *(const f32x4*)src, a1 = *(const f32x4*)(src + 4);
                    v = (v4u){pk2(a0[0], a0[1]), pk2(a0[2], a0[3]), pk2(a1[0], a1[1]), pk2(a1[2], a1[3])}; }
                bfr[cb] = __builtin_bit_cast(bf16x8, v); }
            float xr = 0.f, xi = 0.f;
            const int lq2 = lq & 1;
            v4u ua = *(const v4u*)(ubase + (size_t)li * NPROJ + 8 * lq2);
            { const bf16x8 af = __builtin_bit_cast(bf16x8, lq < 2 ? ua : (v4u){0u, 0u, 0u, 0u});
              ua = *(const v4u*)(ubase + (size_t)(16 + li) * NPROJ + 8 * lq2);
#pragma unroll
              for (int cb = 0; cb < 8; ++cb) { f32x4 acc = (f32x4){0.f, 0.f, 0.f, 0.f}; acc = __builtin_amdgcn_mfma_f32_16x16x32_bf16(af, bfr[cb], acc, 0, 0, 0);
#pragma unroll
                  for (int r = 0; r < 4; ++r) *(LAS float*)(L + S5V_BU + (4 * lq + r) * S5V_BUP + (gl * 128 + 16 * cb + li) * 4) = acc[r]; } }
            LDS_BARRIER();
            unsigned long long pa0 = 0, pa1 = 0, pa2 = 0;
            for (int k = 0; k <= NT; ++k) {
                PR_T(pt0)
                if (k < NT) {
                    const LAS f32x2* bp = (const LAS f32x2*)(L + S5V_BU + (k & 1) * S5V_BUSZ + (gl * 128 + 2 * lane) * 4);
                    LAS unsigned* xp = (LAS unsigned*)(L + S5V_XT + (k & 1) * S5V_XTSZ + (gl * 128 + 2 * lane) * 2);
                    f32x2 bu[16];
#pragma unroll
                    for (int t = 0; t < 16; ++t) bu[t] = bp[t * (S5V_BUP / 8)];
                    unsigned xo[16];
#pragma unroll
                    for (int t = 0; t < 16; ++t) {
                        const float a = __builtin_fmaf(nlbi, xi, bu[t][0]), bq = __builtin_fmaf(lbi, xr, bu[t][1]);
                        const float nr = __builtin_fmaf(lbr, xr, a), ni = __builtin_fmaf(lbr, xi, bq); xr = nr; xi = ni; xo[t] = pk2(xr, xi); }
#pragma unroll
                    for (int t = 0; t < 16; ++t) xp[t * (S5V_XTP / 4)] = xo[t];
                    PR_T(pt1) PR_ACC(pa0, pt1 - pt0)
                    if (k + 1 < NT) {
                        const bf16x8 af = __builtin_bit_cast(bf16x8, lq < 2 ? ua : (v4u){0u, 0u, 0u, 0u});
                        { const int kn = k + 2 < NT ? k + 2 : NT - 1; ua = *(const v4u*)(ubase + (size_t)(16 * kn + li) * NPROJ + 8 * lq2); }
                        LAS unsigned char* bun = L + S5V_BU + ((k + 1) & 1) * S5V_BUSZ;
#pragma unroll
                        for (int cb = 0; cb < 8; ++cb) { f32x4 acc = (f32x4){0.f, 0.f, 0.f, 0.f}; acc = __builtin_amdgcn_mfma_f32_16x16x32_bf16(af, bfr[cb], acc, 0, 0, 0);
#pragma unroll
                            for (int r = 0; r < 4; ++r) *(LAS float*)(bun + (4 * lq + r) * S5V_BUP + (gl * 128 + 16 * cb + li) * 4) = acc[r]; }
                    }
                }
                PR_T(pt2) PR_ACC(pa1, pt2 - pt0)
                LDS_BARRIER();
                PR_T(pt3) PR_ACC(pa2, pt3 - pt2)
            }
            __builtin_amdgcn_s_setprio(0);
            PR_OUT(0, pa0) PR_OUT(1, pa1) PR_OUT(2, pa2)
        } else {
            bf16x8 cfr[4];
#pragma unroll
            for (int ks = 0; ks < 4; ++ks) { const float* cr = (F.a->in[17]) + (g * 16 + li) * 64 + 16 * ks + 4 * lq; const float* ci = (F.a->in[18]) + (g * 16 + li) * 64 + 16 * ks + 4 * lq;
                const f32x4 r0 = *(const f32x4*)cr, i0 = *(const f32x4*)ci;
                cfr[ks] = __builtin_bit_cast(bf16x8, ((v4u){pk2(r0[0], -i0[0]), pk2(r0[1], -i0[1]), pk2(r0[2], -i0[2]), pk2(r0[3], -i0[3])})); }
            v4u gwv = (v4u){0u, 0u, 0u, 0u};
            if (lq < 2) { float gwf[8];
#pragma unroll
                for (int j = 0; j < 8; ++j) gwf[j] = (F.a->in[20])[(g * 16 + 8 * lq + j) * 16 + li];
                gwv = (v4u){pk2(gwf[0], gwf[1]), pk2(gwf[2], gwf[3]), pk2(gwf[4], gwf[5]), pk2(gwf[6], gwf[7])}; }
            const bf16x8 gfr = __builtin_bit_cast(bf16x8, gwv);
            const float dsk = (F.a->in[19])[g * 16 + li], gbias = (F.a->in[21])[g * 16 + li];
            LAS unsigned char* vs = L + S5V_VS + gl * 512;
            float uo[4], un[4];
#pragma unroll
            for (int r = 0; r < 4; ++r) { uo[r] = bf2f(ubase[(size_t)(4 * lq + r) * NPROJ + li]); un[r] = bf2f(ubase[(size_t)(16 + 4 * lq + r) * NPROJ + li]); }
            LDS_BARRIER();
            unsigned long long pb0 = 0, pb1 = 0;
            for (int k = 0; k <= NT; ++k) {
                PR_T(qt0)
                float u2[4];
                { const int kn = k + 1 < NT ? k + 1 : NT - 1;
#pragma unroll
                  for (int r = 0; r < 4; ++r) u2[r] = bf2f(ubase[(size_t)(16 * kn + 4 * lq + r) * NPROJ + li]); }
                if (k >= 2) {
                    const int t = ((tid - 256) >> 3) & 15, oc = tid & 7; const v4u ov = *(const LAS v4u*)(L + S5V_OT + (k & 1) * S5V_OTSZ + t * S5V_OTP + 16 * oc);
                    if (tid < 384) *(v4u*)(WSP(bf16, WS_Y) + ((size_t)b * SEQ + 16 * (k - 2) + t) * 2048 + 1024 + gs * 64 + 8 * oc) = ov; }
                if (k >= 1) {
                    const int kt = k - 1; const LAS unsigned char* xt = L + S5V_XT + (kt & 1) * S5V_XTSZ;
                    f32x4 yacc = (f32x4){0.f, 0.f, 0.f, 0.f};
#pragma unroll
                    for (int ks = 0; ks < 4; ++ks) yacc = __builtin_amdgcn_mfma_f32_16x16x32_bf16(*(const LAS bf16x8*)(xt + li * S5V_XTP + (gl * 128 + 32 * ks + 8 * lq) * 2), cfr[ks], yacc, 0, 0, 0);
                    float v[4];
                    { const f32x2 g0 = gelu_pk2((f32x2){yacc[0] + dsk * uo[0], yacc[1] + dsk * uo[1]}), g1 = gelu_pk2((f32x2){yacc[2] + dsk * uo[2], yacc[3] + dsk * uo[3]}); v[0] = g0[0]; v[1] = g0[1]; v[2] = g1[0]; v[3] = g1[1]; }
#pragma unroll
                    for (int r = 0; r < 4; ++r) *(LAS unsigned short*)(vs + (4 * lq + r) * 32 + li * 2) = (unsigned short)f2bf(v[r]);
                    LDS_WAIT(); asm volatile("" ::: "memory");
                    v4u va = (v4u){0u, 0u, 0u, 0u};
                    if (lq < 2) va = *(const LAS v4u*)(vs + li * 32 + 16 * lq);
                    f32x4 gacc = (f32x4){0.f, 0.f, 0.f, 0.f};
                    gacc = __builtin_amdgcn_mfma_f32_16x16x32_bf16(__builtin_bit_cast(bf16x8, va), gfr, gacc, 0, 0, 0);
                    float o[4], ss[4];
#pragma unroll
                    for (int r = 0; r < 4; ++r) { o[r] = v[r] * sigmoid_f(gacc[r] + gbias); ss[r] = o[r] * o[r]; }
#pragma unroll
                    for (int r = 0; r < 4; ++r) ss[r] = row16_sum_to15(ss[r]);
                    if (li == 15) {
#pragma unroll
                        for (int r = 0; r < 4; ++r) WSP(float, WS_STS5)[((size_t)b * SEQ + 16 * kt + 4 * lq + r) * NS5PART + g] = ss[r]; }
                    LAS unsigned char* ot = L + S5V_OT + (kt & 1) * S5V_OTSZ;
#pragma unroll
                    for (int r = 0; r < 4; ++r) *(LAS unsigned short*)(ot + (4 * lq + r) * S5V_OTP + (gl * 16 + li) * 2) = (unsigned short)f2bf(o[r]);
#pragma unroll
                    for (int r = 0; r < 4; ++r) { uo[r] = un[r]; un[r] = u2[r]; }
                }
                PR_T(qt1) PR_ACC(pb0, qt1 - qt0)
                LDS_BARRIER();
                PR_T(qt2) PR_ACC(pb1, qt2 - qt1)
            }
            PR_OUT4(3, pb0) PR_OUT4(4, pb1)
            { const int t = ((tid - 256) >> 3) & 15, oc = tid & 7; const v4u ov = *(const LAS v4u*)(L + S5V_OT + ((NT - 1) & 1) * S5V_OTSZ + t * S5V_OTP + 16 * oc);
              if (tid < 384) *(v4u*)(WSP(bf16, WS_Y) + ((size_t)b * SEQ + 16 * (NT - 1) + t) * 2048 + 1024 + gs * 64 + 8 * oc) = ov; }
        }
    }
#ifdef PROBE_S5
    if (blockIdx.x == 0 && threadIdx.x == 0) *(volatile float*)(F.ws + WS_CTL + 40000) = (float)(PROBE_CLOCK() - pr_t0) * PROBE_SCALE;
#endif
}
__device__ __forceinline__ unsigned med3u(unsigned a, unsigned b, unsigned c) { unsigned r; asm("v_med3_u32 %0, %1, %2, %3" : "=v"(r) : "v"(a), "v"(b), "v"(c)); return r; }
__device__ __forceinline__ unsigned fkey(float v) { const unsigned u = __builtin_bit_cast(unsigned, v); return (u & 0x80000000u) ? ~u : (u | 0x80000000u); }
__device__ __forceinline__ float fkey_inv(unsigned k) { const unsigned u = (k & 0x80000000u) ? (k & 0x7fffffffu) : ~k; return __builtin_bit_cast(float, u); }
#define TOPK_INSERT(a, x) do { _Pragma("unroll") for (int _i = 15; _i >= 1; --_i) a[_i] = med3u(a[_i - 1], a[_i], (x)); a[0] = a[0] > (x) ? a[0] : (x); } while (0)
__device__ __forceinline__ unsigned fp6_code(float y) {
    const float a = fabsf(y);
    const float c = a < 2.0f ? __builtin_rintf(8.0f * a) : (a < 4.0f ? __builtin_rintf(4.0f * a) + 8.0f : fminf(__builtin_rintf(2.0f * a) + 16.0f, 31.0f));
    return (unsigned)c | (y < 0.f ? 32u : 0u);
}
__device__ __forceinline__ void fp6_pack16(const unsigned* c, unsigned& w0, unsigned& w1, unsigned& w2) {
    w0 = c[0] | (c[1] << 6) | (c[2] << 12) | (c[3] << 18) | (c[4] << 24) | (c[5] << 30);
    w1 = (c[5] >> 2) | (c[6] << 4) | (c[7] << 10) | (c[8] << 16) | (c[9] << 22) | (c[10] << 28);
    w2 = (c[10] >> 4) | (c[11] << 2) | (c[12] << 8) | (c[13] << 14) | (c[14] << 20) | (c[15] << 26);
}
__device__ __forceinline__ void h2_convert(Frame& F, int w0, int nw, int f_lane) {
    for (int tb = w0 * 16; tb < MTOK; tb += nw * 16) {
        const float* sh = WSP(float, WS_MOD) + (size_t)(tb >> 11) * 6144 + 3072 + 16 * f_lane;
        float S2[16];
#pragma unroll
        for (int q = 0; q < 4; ++q) { const f32x4 s4 = *(const f32x4*)(sh + 4 * q); S2[4 * q] = s4[0]; S2[4 * q + 1] = s4[1]; S2[4 * q + 2] = s4[2]; S2[4 * q + 3] = s4[3]; }
#pragma unroll 1
        for (int k = 0; k < 16; k += 4) {
            v4u xa[4], xb[4]; float rst[4];
#pragma unroll
            for (int u = 0; u < 4; ++u) { const int t = tb + k + u; const char* xs = (const char*)(WSP(bf16, WS_X1S) + (size_t)t * 1024) + 32 * f_lane; xa[u] = *(const v4u*)xs; xb[u] = *(const v4u*)(xs + 16); rst[u] = WSP(float, WS_ROWSTAT)[t]; }
#pragma unroll
            for (int u = 0; u < 4; ++u) { const int t = tb + k + u;
                const float rs = rsqrt_f(rst[u] * (1.0f / 1024.0f) + EPSF);
                float h2[16]; unpack8(xa[u], h2); unpack8(xb[u], h2 + 8); float mx = 0.f;
#pragma unroll
                for (int i = 0; i < 16; ++i) { h2[i] = h2[i] * rs + S2[i]; mx = fmaxf(mx, fabsf(h2[i])); }
#pragma unroll
                for (int o = 1; o < 64; o <<= 1) mx = fmaxf(mx, __shfl_xor(mx, o));
                mx = fmaxf(mx, 1e-30f); const float hs = 224.0f / mx;
                v4u w;
#pragma unroll
                for (int q = 0; q < 4; ++q) { int pk = 0; pk = __builtin_amdgcn_cvt_pk_fp8_f32(h2[4 * q] * hs, h2[4 * q + 1] * hs, pk, false); pk = __builtin_amdgcn_cvt_pk_fp8_f32(h2[4 * q + 2] * hs, h2[4 * q + 3] * hs, pk, true); w[q] = (unsigned)pk; }
                *(v4u*)(F.ws + WS_H2Q + (size_t)t * 1024 + 16 * f_lane) = w;
                if (f_lane == 0) WSP(float, WS_HINV)[t] = mx * (1.0f / 224.0f); }
        }
    }
}
__device__ __forceinline__ void expert_convert(Frame& F, int w0, int nw, int f_lane) {
    for (int rw = w0; rw < 2 * 16384; rw += 2 * nw) {
        f32x4 v[2][4]; float mx[2];
#pragma unroll
        for (int u = 0; u < 2; ++u) { const int r = rw + u * nw; const int tb = r >= 16384, e = tb ? r - 16384 : r; const float* src = (tb ? (F.a->in[28]) : (F.a->in[27])) + (size_t)e * 1024 + 16 * f_lane;
#pragma unroll
            for (int q = 0; q < 4; ++q) v[u][q] = *(const f32x4*)(src + 4 * q); }
#pragma unroll
        for (int u = 0; u < 2; ++u) { float m = 0.f;
#pragma unroll
            for (int q = 0; q < 4; ++q) m = fmaxf(m, fmaxf(fmaxf(fabsf(v[u][q][0]), fabsf(v[u][q][1])), fmaxf(fabsf(v[u][q][2]), fabsf(v[u][q][3]))));
#pragma unroll
            for (int o = 1; o < 64; o <<= 1) m = fmaxf(m, __shfl_xor(m, o));
            mx[u] = fmaxf(m, 1e-30f); }
#pragma unroll
        for (int u = 0; u < 2; ++u) { const int r = rw + u * nw; const int tb = r >= 16384, e = tb ? r - 16384 : r; const float sc = 224.0f / mx[u];
            v4u w;
#pragma unroll
            for (int q = 0; q < 4; ++q) { int pk = 0; pk = __builtin_amdgcn_cvt_pk_fp8_f32(v[u][q][0] * sc, v[u][q][1] * sc, pk, false); pk = __builtin_amdgcn_cvt_pk_fp8_f32(v[u][q][2] * sc, v[u][q][3] * sc, pk, true); w[q] = (unsigned)pk; }
#ifdef V6
#ifdef UP12
            {
#else
            if (tb) {
#endif
                const float s6 = 7.5f / mx[u]; unsigned cd[16];
#pragma unroll
                for (int q = 0; q < 4; ++q)
#pragma unroll
                    for (int i = 0; i < 4; ++i) cd[4 * q + i] = fp6_code(v[u][q][i] * s6);
                unsigned w0, w1, w2; fp6_pack16(cd, w0, w1, w2);
                unsigned* dst = (unsigned*)(F.ws + (tb ? WS_EV : WS_EU) + (size_t)e * 768 + 12 * f_lane); dst[0] = w0; dst[1] = w1; dst[2] = w2;
                if (f_lane == 0) WSP(float, tb ? WS_EVS : WS_EUS)[e] = mx[u] * (1.0f / 7.5f);
                continue; }
#endif
            *(v4u*)(F.ws + (tb ? WS_EV : WS_EU) + (size_t)e * 1024 + 16 * f_lane) = w;
            if (f_lane == 0) WSP(float, tb ? WS_EVS : WS_EUS)[e] = mx[u] * (1.0f / 224.0f); }
    }
}
__device__ __forceinline__ void p5b_topk(Frame& F) {
    const int f_tid = threadIdx.x, f_lane = f_tid & 63, f_wave = __builtin_amdgcn_readfirstlane(f_tid >> 6);
    const _Float16* scores = WSP(_Float16, WS_SCORES);
    LAS unsigned char* ix = (LAS unsigned char*)F.lds + f_tid * 36;
#pragma unroll 1
    for (int half = 0; half < 2; ++half) {
#ifdef UP11
    if ((f_wave >> 2) != half) { expert_convert(F, (F.vcu * 4 + (f_wave & 3)) * 2 + half, F.G * 8, f_lane); h2_convert(F, (F.vcu * 4 + (f_wave & 3)) * 2 + half, F.G * 8, f_lane); continue; }
#else
    if ((f_wave >> 2) != half) { expert_convert(F, (F.vcu * 4 + (f_wave & 3)) * 2 + half, F.G * 8, f_lane); continue; }
#endif
    typedef _Float16 f16x8 __attribute__((ext_vector_type(8)));
    f16x8 sva[8], svb[8];
    { const int item0 = (F.vcu * 2 + half) * 256 + (f_tid & 255); const _Float16* sp0 = scores + (size_t)(item0 >> 3) * 2048 + (item0 & 7) * 256;
#pragma unroll
      for (int q = 0; q < 8; ++q) sva[q] = *(const f16x8*)(sp0 + 8 * q); }
#pragma unroll 1
    for (int item = (F.vcu * 2 + half) * 256 + (f_tid & 255); item < MTOK * PH; item += F.G * 512) {
        const int t = item >> 3, hd = item & 7;
        unsigned a1[16], a2[16];
#pragma unroll
        for (int i = 0; i < 16; ++i) { a1[i] = 0u; a2[i] = 0u; }
        const _Float16* sp = scores + (size_t)t * 2048 + hd * 256;
        const int itn = (item + F.G * 512 < MTOK * PH) ? item + F.G * 512 : item;
        const _Float16* spn = scores + (size_t)(itn >> 3) * 2048 + (itn & 7) * 256;
#define TK_BATCH(CUR, NXT, NP, A, M) { \
        { _Pragma("unroll") for (int q = 0; q < 8; ++q) NXT[q] = *(const f16x8*)((NP) + 8 * q); } \
        __builtin_amdgcn_sched_barrier(0); \
        _Pragma("unroll") for (int q = 0; q < 8; ++q) { _Pragma("unroll") for (int e = 0; e < 8; ++e) { const unsigned k = (fkey((float)CUR[q][e]) & ~127u) | (unsigned)(127 - (64 * (M) + 8 * q + e)); TOPK_INSERT(A, k); } } }
        TK_BATCH(sva, svb, sp + 64, a1, 0)
        TK_BATCH(svb, sva, sp + 128, a1, 1)
        TK_BATCH(sva, svb, sp + 192, a2, 0)
        TK_BATCH(svb, sva, spn, a2, 1)
#undef TK_BATCH
        float v1[16], v2[16];
#pragma unroll
        for (int i = 0; i < 16; ++i) { ix[i] = (unsigned char)(127u - (a1[i] & 127u)); ix[16 + i] = (unsigned char)(127u - (a2[i] & 127u)); v1[i] = fkey_inv(a1[i] & ~127u); v2[i] = fkey_inv(a2[i] & ~127u); }
        unsigned cb[16];
#pragma unroll
        for (int i = 0; i < 16; ++i) cb[i] = 0u;
#pragma unroll
        for (int i = 0; i < 16; ++i)
#pragma unroll
            for (int j = 0; j < 16; ++j) if ((i + 1) * (j + 1) <= 16) { const unsigned k = (fkey(v1[i] + v2[j]) & ~255u) | (unsigned)(255 - (i * 16 + j)); TOPK_INSERT(cb, k); }
        float tv[16]; float mx = -3.0e38f;
#pragma unroll
        for (int k = 0; k < 16; ++k) { tv[k] = fkey_inv(cb[k] & ~255u); mx = fmaxf(mx, tv[k]); }
        float sum = 0.f;
#pragma unroll
        for (int k = 0; k < 16; ++k) { tv[k] = __expf(tv[k] - mx); sum += tv[k]; }
        const float inv = 1.0f / sum;
        LDS_WAIT(); asm volatile("" ::: "memory");
        int ev[16]; unsigned long long c64 = 0ull;
#pragma unroll
        for (int k = 0; k < 16; ++k) { const unsigned code = 255u - (cb[k] & 255u); const int i = code >> 4, j = code & 15; ev[k] = (int)ix[i] * 128 + (int)ix[16 + j]; c64 += 1ull << (8 * (ev[k] >> 11)); }
        unsigned long long s64 = c64;
#pragma unroll
        for (int o = 1; o < 8; o <<= 1) { const unsigned lo = __shfl_up((unsigned)s64, o, 8), hi = __shfl_up((unsigned)(s64 >> 32), o, 8); if ((f_lane & 7) >= o) s64 += ((unsigned long long)hi << 32) | lo; }
        const unsigned long long e64 = s64 - c64;
        const unsigned long long t64 = ((unsigned long long)__shfl((unsigned)(s64 >> 32), 7, 8) << 32) | __shfl((unsigned)s64, 7, 8);
        const unsigned long long st64 = (t64 * 0x0101010101010101ull) << 8;
        unsigned long long base64 = st64 + e64;
        int* eo = WSP(int, WS_EID) + (size_t)t * 128; float* go = WSP(float, WS_GATE) + (size_t)t * 128;
#pragma unroll
        for (int k = 0; k < 16; ++k) { const int r8 = 8 * (ev[k] >> 11); const int slot = (int)((base64 >> r8) & 255ull); base64 += 1ull << r8; eo[slot] = ev[k]; go[slot] = tv[k] * inv; }
        if (hd == 0) WSP(unsigned long long, WS_START)[t] = st64;
        LDS_WAIT(); asm volatile("" ::: "memory");
    }
    }
}
__device__ __forceinline__ void dec16(const v4u q, float* f) {
#pragma unroll
    for (int i = 0; i < 4; ++i) { const f32x2 lo = __builtin_amdgcn_cvt_pk_f32_fp8((int)q[i], false), hi = __builtin_amdgcn_cvt_pk_f32_fp8((int)q[i], true); f[4 * i] = lo[0]; f[4 * i + 1] = lo[1]; f[4 * i + 2] = hi[0]; f[4 * i + 3] = hi[1]; }
}
struct CvE { f32x4 v[4]; };
struct CvH { v4u xa, xb; float rst; };
__device__ __forceinline__ void cve_load(CvE& c, Frame& F, int r, int f_lane) {
    const int tb = r >= 16384, e = tb ? r - 16384 : r; const float* src = (tb ? (F.a->in[28]) : (F.a->in[27])) + (size_t)e * 1024 + 16 * f_lane;
#pragma unroll
    for (int q = 0; q < 4; ++q) c.v[q] = *(const f32x4*)(src + 4 * q);
}
__device__ __forceinline__ void cve_finish(const CvE& c, Frame& F, int r, int f_lane) {
    const int tb = r >= 16384, e = tb ? r - 16384 : r; float m = 0.f;
#pragma unroll
    for (int q = 0; q < 4; ++q) m = fmaxf(m, fmaxf(fmaxf(fabsf(c.v[q][0]), fabsf(c.v[q][1])), fmaxf(fabsf(c.v[q][2]), fabsf(c.v[q][3]))));
#pragma unroll
    for (int o = 1; o < 64; o <<= 1) m = fmaxf(m, __shfl_xor(m, o));
    m = fmaxf(m, 1e-30f); const float sc = 224.0f / m;
    v4u w;
#pragma unroll
    for (int q = 0; q < 4; ++q) { int pk = 0; pk = __builtin_amdgcn_cvt_pk_fp8_f32(c.v[q][0] * sc, c.v[q][1] * sc, pk, false); pk = __builtin_amdgcn_cvt_pk_fp8_f32(c.v[q][2] * sc, c.v[q][3] * sc, pk, true); w[q] = (unsigned)pk; }
    *(v4u*)(F.ws + (tb ? WS_EV : WS_EU) + (size_t)e * 1024 + 16 * f_lane) = w;
    if (f_lane == 0) WSP(float, tb ? WS_EVS : WS_EUS)[e] = m * (1.0f / 224.0f);
}
__device__ __forceinline__ void cvh_load(CvH& c, Frame& F, int t, int f_lane) {
    const char* xs = (const char*)(WSP(bf16, WS_X1S) + (size_t)t * 1024) + 32 * f_lane; c.xa = *(const v4u*)xs; c.xb = *(const v4u*)(xs + 16); c.rst = WSP(float, WS_ROWSTAT)[t];
}
__device__ __forceinline__ void cvh_finish(const CvH& c, Frame& F, int t, int f_lane, const float* S2) {
    const float rs = rsqrt_f(c.rst * (1.0f / 1024.0f) + EPSF);
    float h2[16]; unpack8(c.xa, h2); unpack8(c.xb, h2 + 8); float mx = 0.f;
#pragma unroll
    for (int i = 0; i < 16; ++i) { h2[i] = h2[i] * rs + S2[i]; mx = fmaxf(mx, fabsf(h2[i])); }
#pragma unroll
    for (int o = 1; o < 64; o <<= 1) mx = fmaxf(mx, __shfl_xor(mx, o));
    mx = fmaxf(mx, 1e-30f); const float hs = 224.0f / mx;
    v4u w;
#pragma unroll
    for (int q = 0; q < 4; ++q) { int pk = 0; pk = __builtin_amdgcn_cvt_pk_fp8_f32(h2[4 * q] * hs, h2[4 * q + 1] * hs, pk, false); pk = __builtin_amdgcn_cvt_pk_fp8_f32(h2[4 * q + 2] * hs, h2[4 * q + 3] * hs, pk, true); w[q] = (unsigned)pk; }
    *(v4u*)(F.ws + WS_H2Q + (size_t)t * 1024 + 16 * f_lane) = w;
    if (f_lane == 0) WSP(float, WS_HINV)[t] = mx * (1.0f / 224.0f);
}
__device__ __forceinline__ void p5b_topk2(Frame& F) {
    const int f_tid = threadIdx.x, f_lane = f_tid & 63, f_wave = __builtin_amdgcn_readfirstlane(f_tid >> 6);
    const _Float16* scores = WSP(_Float16, WS_SCORES);
    LAS unsigned char* ix = (LAS unsigned char*)F.lds + f_tid * 36;
    const int gw = F.vcu * NWAVES + f_wave;
    static_assert(MTOK * PH == 2 * 256 * NTHR && MTOK == 16 * 256 * NWAVES, "P7 v2 work split");
    float S2[16];
    { const float* sh = WSP(float, WS_MOD) + (size_t)((gw * 16) >> 11) * 6144 + 3072 + 16 * f_lane;
#pragma unroll
      for (int q = 0; q < 4; ++q) { const f32x4 s4 = *(const f32x4*)(sh + 4 * q); S2[4 * q] = s4[0]; S2[4 * q + 1] = s4[1]; S2[4 * q + 2] = s4[2]; S2[4 * q + 3] = s4[3]; } }
    typedef _Float16 f16x8 __attribute__((ext_vector_type(8)));
    const int item_base = F.vcu * NTHR + f_tid, item_step = F.G * NTHR;
    f16x8 sva[8], svb[8];
    { const _Float16* sp0 = scores + (size_t)(item_base >> 3) * 2048 + (item_base & 7) * 256;
#pragma unroll
      for (int q = 0; q < 8; ++q) sva[q] = *(const f16x8*)(sp0 + 8 * q); }
    unsigned a1[16];
#pragma unroll
    for (int i = 0; i < 16; ++i) a1[i] = 0u;
#pragma unroll 1
    for (int hi = 0; hi < 4; ++hi) {
        const int item = item_base + (hi >> 1) * item_step; const int t = item >> 3, hd = item & 7, kh = hi & 1;
        const _Float16* sp = scores + (size_t)t * 2048 + hd * 256 + kh * 128;
        const int hn = hi < 3 ? hi + 1 : hi; const int itn = item_base + (hn >> 1) * item_step;
        const _Float16* spn = scores + (size_t)(itn >> 3) * 2048 + (itn & 7) * 256 + (hn & 1) * 128;
        unsigned a2[16];
#pragma unroll
        for (int i = 0; i < 16; ++i) a2[i] = 0u;
#define TK2_BATCH(CUR, NXT, NP, M) { \
        const int ku = 2 * (2 * hi + (M)); CvE e0, e1; CvH h0, h1; \
        { _Pragma("unroll") for (int q = 0; q < 8; ++q) NXT[q] = *(const f16x8*)((NP) + 8 * q); } \
        cve_load(e0, F, gw + ku * 2048, f_lane); cve_load(e1, F, gw + (ku + 1) * 2048, f_lane); cvh_load(h0, F, gw * 16 + ku, f_lane); cvh_load(h1, F, gw * 16 + ku + 1, f_lane); \
        __builtin_amdgcn_sched_barrier(0); \
        _Pragma("unroll") for (int q = 0; q < 8; ++q) { _Pragma("unroll") for (int e = 0; e < 8; ++e) { const unsigned k = (fkey((float)CUR[q][e]) & ~127u) | (unsigned)(127 - (64 * (M) + 8 * q + e)); TOPK_INSERT(a2, k); } } \
        __builtin_amdgcn_sched_barrier(0); \
        cve_finish(e0, F, gw + ku * 2048, f_lane); cve_finish(e1, F, gw + (ku + 1) * 2048, f_lane); cvh_finish(h0, F, gw * 16 + ku, f_lane, S2); cvh_finish(h1, F, gw * 16 + ku + 1, f_lane, S2); \
        __builtin_amdgcn_sched_barrier(0); }
        TK2_BATCH(sva, svb, sp + 64, 0)
        TK2_BATCH(svb, sva, spn, 1)
#undef TK2_BATCH
        if (kh == 0) {
#pragma unroll
            for (int i = 0; i < 16; ++i) a1[i] = a2[i];
            continue;
        }
        float v1[16], v2[16];
#pragma unroll
        for (int i = 0; i < 16; ++i) { ix[i] = (unsigned char)(127u - (a1[i] & 127u)); ix[16 + i] = (unsigned char)(127u - (a2[i] & 127u)); v1[i] = fkey_inv(a1[i] & ~127u); v2[i] = fkey_inv(a2[i] & ~127u); }
        unsigned cb[16];
#pragma unroll
        for (int i = 0; i < 16; ++i) cb[i] = 0u;
#pragma unroll
        for (int i = 0; i < 16; ++i)
#pragma unroll
            for (int j = 0; j < 16; ++j) if ((i + 1) * (j + 1) <= 16) { const unsigned k = (fkey(v1[i] + v2[j]) & ~255u) | (unsigned)(255 - (i * 16 + j)); TOPK_INSERT(cb, k); }
        float tv[16]; float mx = -3.0e38f;
#pragma unroll
        for (int k = 0; k < 16; ++k) { tv[k] = fkey_inv(cb[k] & ~255u); mx = fmaxf(mx, tv[k]); }
        float sum = 0.f;
#pragma unroll
        for (int k = 0; k < 16; ++k) { tv[k] = __expf(tv[k] - mx); sum += tv[k]; }
        const float inv = 1.0f / sum;
        LDS_WAIT(); asm volatile("" ::: "memory");
        int ev[16]; unsigned long long c64 = 0ull;
#pragma unroll
        for (int k = 0; k < 16; ++k) { const unsigned code = 255u - (cb[k] & 255u); const int i = code >> 4, j = code & 15; ev[k] = (int)ix[i] * 128 + (int)ix[16 + j]; c64 += 1ull << (8 * (ev[k] >> 11)); }
        unsigned long long s64 = c64;
#pragma unroll
        for (int o = 1; o < 8; o <<= 1) { const unsigned lo = __shfl_up((unsigned)s64, o, 8), hi2 = __shfl_up((unsigned)(s64 >> 32), o, 8); if ((f_lane & 7) >= o) s64 += ((unsigned long long)hi2 << 32) | lo; }
        const unsigned long long e64 = s64 - c64;
        const unsigned long long t64 = ((unsigned long long)__shfl((unsigned)(s64 >> 32), 7, 8) << 32) | __shfl((unsigned)s64, 7, 8);
        const unsigned long long st64 = (t64 * 0x0101010101010101ull) << 8;
        unsigned long long base64 = st64 + e64;
        int* eo = WSP(int, WS_EID) + (size_t)t * 128; float* go = WSP(float, WS_GATE) + (size_t)t * 128;
#pragma unroll
        for (int k = 0; k < 16; ++k) { const int r8 = 8 * (ev[k] >> 11); const int slot = (int)((base64 >> r8) & 255ull); base64 += 1ull << r8; eo[slot] = ev[k]; go[slot] = tv[k] * inv; }
        if (hd == 0) WSP(unsigned long long, WS_START)[t] = st64;
        LDS_WAIT(); asm volatile("" ::: "memory");
    }
}
__device__ __forceinline__ void p9_peer_down2(Frame& F) {
    const int f_tid = threadIdx.x, lane = f_tid & 63, f_wave = __builtin_amdgcn_readfirstlane(f_tid >> 6);
    const unsigned char* EV = F.ws + WS_EV;
    for (int wq = F.vcu * NWAVES + f_wave; wq < MTOK / 16; wq += F.G * NWAVES) {
        const int b = wq >> 7; const float* mb = WSP(float, WS_MOD) + (size_t)b * 6144;
        int ne_lo = WSP(int, WS_EID)[(size_t)wq * 16 * 128 + lane], ne_hi = WSP(int, WS_EID)[(size_t)wq * 16 * 128 + 64 + lane];
        float nw_lo = WSP(float, WS_GATE)[(size_t)wq * 16 * 128 + lane], nw_hi = WSP(float, WS_GATE)[(size_t)wq * 16 * 128 + 64 + lane];
        for (int tt = 0; tt < 16; ++tt) {
            const size_t t = (size_t)wq * 16 + tt;
            unsigned l16 = 16u * (unsigned)lane; asm volatile("" : "+v"(l16));
            float* xr = (float*)((char*)(F.out + t * 1024) + 4u * l16);
            const int e_lo = ne_lo, e_hi = ne_hi; const float w_lo = nw_lo, w_hi = nw_hi;
            f32x2 o[8];
#pragma unroll
            for (int i = 0; i < 8; ++i) o[i] = (f32x2){0.f, 0.f};
            v4u qa[8], qb[8];
#pragma unroll
            for (int j = 0; j < 8; ++j) { const int e = __builtin_amdgcn_readlane(e_lo, j); qa[j] = *(const v4u*)(EV + ((unsigned)e * 1024u + l16)); }
#define DN2_STEP(GRP, CUR, NXT) { \
                const int grp = (GRP); const int nb = ((grp + 1) & 7) * 8; const int ensel = (grp + 1) < 8 ? e_lo : e_hi; \
                { _Pragma("unroll") for (int j = 0; j < 8; ++j) { const int e = __builtin_amdgcn_readlane(ensel, nb + j); NXT[j] = *(const v4u*)(EV + ((unsigned)e * 1024u + l16)); } } \
                __builtin_amdgcn_sched_barrier(0); \
                const int base = (grp & 7) * 8; const float wsel = grp < 8 ? w_lo : w_hi; \
                _Pragma("unroll") for (int j = 0; j < 8; ++j) { const float wj = __builtin_bit_cast(float, __builtin_amdgcn_readlane(__builtin_bit_cast(int, wsel), base + j)); const f32x2 w2 = (f32x2){wj, wj}; \
                    _Pragma("unroll") for (int i = 0; i < 4; ++i) { const f32x2 lo = __builtin_amdgcn_cvt_pk_f32_fp8((int)CUR[j][i], false), hi = __builtin_amdgcn_cvt_pk_f32_fp8((int)CUR[j][i], true); o[2 * i] += w2 * lo; o[2 * i + 1] += w2 * hi; } } }
#pragma unroll 1
            for (int g2 = 0; g2 < 16; g2 += 2) { DN2_STEP(g2, qa, qb) DN2_STEP(g2 + 1, qb, qa) }
#undef DN2_STEP
            { const size_t tn = t + (tt < 15 ? 1 : 0); ne_lo = WSP(int, WS_EID)[tn * 128 + lane]; ne_hi = WSP(int, WS_EID)[tn * 128 + 64 + lane]; nw_lo = WSP(float, WS_GATE)[tn * 128 + lane]; nw_hi = WSP(float, WS_GATE)[tn * 128 + 64 + lane]; }
            float x1[16]; float ss = 0.f;
#pragma unroll
            for (int q4 = 0; q4 < 4; ++q4) { const f32x4 v = *(const f32x4*)(xr + 4 * q4); x1[4 * q4] = v[0]; x1[4 * q4 + 1] = v[1]; x1[4 * q4 + 2] = v[2]; x1[4 * q4 + 3] = v[3]; }
#pragma unroll
            for (int q4 = 0; q4 < 4; ++q4) { const f32x4 gt = *(const f32x4*)((const char*)(mb + 5120) + 4u * l16 + 16 * q4);
#pragma unroll
                for (int e = 0; e < 4; ++e) { const int i = 4 * q4 + e; x1[i] += gt[e] * o[i >> 1][i & 1]; ss += x1[i] * x1[i]; } }
            const float rf = rsqrt_f(wave_sum(ss) * (1.0f / 1024.0f) + EPSF);
#pragma unroll
            for (int q4 = 0; q4 < 4; ++q4) { const f32x4 nf = *(const f32x4*)((const char*)(F.a->in[29]) + 4u * l16 + 16 * q4); f32x4 v;
#pragma unroll
                for (int e = 0; e < 4; ++e) v[e] = x1[4 * q4 + e] * rf * nf[e];
                *(f32x4*)(xr + 4 * q4) = v; }
        }
    }
}
typedef long i64_t;
constexpr int U6_ROWP = 1040, U6_BUF = 8 * U6_ROWP, U6_WAVE = 2 * U6_BUF + 1024;
static_assert(8 * U6_WAVE <= LDS_MAIN, "U6 LDS map");
__device__ __forceinline__ void p8_peer_up6(Frame& F) {
    const int f_tid = threadIdx.x, lane = f_tid & 63, f_wave = __builtin_amdgcn_readfirstlane(f_tid >> 6);
    const int li = lane & 15, lq = lane >> 4;
    const unsigned char* EU = F.ws + WS_EU; const float* EUS = WSP(float, WS_EUS); const float* EVS = WSP(float, WS_EVS);
    LAS unsigned char* ring = F.lds + f_wave * U6_WAVE; LAS unsigned char* hq = ring + 2 * U6_BUF;
    for (int wq = F.vcu * NWAVES + f_wave; wq < MTOK / 16; wq += F.G * NWAVES) {
        const int b = wq >> 7; const float* mb = WSP(float, WS_MOD) + (size_t)b * 6144;
        for (int tt = 0; tt < 16; ++tt) {
            const size_t t = (size_t)wq * 16 + tt;
            unsigned l16 = 16u * (unsigned)lane; asm volatile("" : "+v"(l16));
            const int e_lo = WSP(int, WS_EID)[t * 128 + lane], e_hi = WSP(int, WS_EID)[t * 128 + 64 + lane];
            const float g_lo = WSP(float, WS_GATE)[t * 128 + lane], g_hi = WSP(float, WS_GATE)[t * 128 + 64 + lane];
            const float rs = rsqrt_f(WSP(float, WS_ROWSTAT)[t] * (1.0f / 1024.0f) + EPSF);
            const char* xs = (const char*)(WSP(bf16, WS_X1S) + t * 1024) + 2u * l16; const v4u xa = *(const v4u*)xs, xb = *(const v4u*)(xs + 16);
            asm volatile("s_waitcnt vmcnt(0)" ::: "memory");
#pragma unroll
            for (int j = 0; j < 8; ++j) { const int e = __builtin_amdgcn_readlane(e_lo, j);
                __builtin_amdgcn_global_load_lds((const unsigned*)(EU + ((unsigned)e * 1024u + l16)), (LAS unsigned*)(ring + j * U6_ROWP), 16, 0, 0); }
            const float su_lo = EUS[e_lo], su_hi = EUS[e_hi], sv_lo = EVS[e_lo], sv_hi = EVS[e_hi];
            float h2[16]; unpack8(xa, h2); unpack8(xb, h2 + 8); float mx = 0.f;
#pragma unroll
            for (int qd = 0; qd < 4; ++qd) { const f32x4 sh = *(const f32x4*)((const char*)(mb + 3072) + 4u * l16 + 16 * qd);
#pragma unroll
                for (int e = 0; e < 4; ++e) { h2[4 * qd + e] = h2[4 * qd + e] * rs + sh[e]; mx = fmaxf(mx, fabsf(h2[4 * qd + e])); } }
#pragma unroll
            for (int o = 1; o < 64; o <<= 1) mx = fmaxf(mx, __shfl_xor(mx, o));
            mx = fmaxf(mx, 1e-30f); const float hs = 224.0f / mx, hinv = mx * (1.0f / 224.0f);
            { v4u w;
#pragma unroll
              for (int qd = 0; qd < 4; ++qd) { int pk = 0; pk = __builtin_amdgcn_cvt_pk_fp8_f32(h2[4 * qd] * hs, h2[4 * qd + 1] * hs, pk, false); pk = __builtin_amdgcn_cvt_pk_fp8_f32(h2[4 * qd + 2] * hs, h2[4 * qd + 3] * hs, pk, true); w[qd] = (unsigned)pk; }
              *(LAS v4u*)(hq + l16) = w; }
            LDS_WAIT(); asm volatile("" ::: "memory");
            v4u hb[16];
#pragma unroll
            for (int c = 0; c < 16; ++c) hb[c] = *(const LAS v4u*)(hq + 64 * c + 16 * lq);
            asm volatile("s_waitcnt vmcnt(0)" ::: "memory");
            float w_lo = 0.f, w_hi = 0.f;
#pragma unroll 1
            for (int u = 0; u < 16; ++u) {
                { const int un = (u + 1) & 15; const int ensel = un < 8 ? e_lo : e_hi; const int nb = (un & 7) * 8; LAS unsigned char* dst = ring + ((u + 1) & 1) * U6_BUF;
#pragma unroll
                  for (int j = 0; j < 8; ++j) { const int e = __builtin_amdgcn_readlane(ensel, nb + j);
                      __builtin_amdgcn_global_load_lds((const unsigned*)(EU + ((unsigned)e * 1024u + l16)), (LAS unsigned*)(dst + j * U6_ROWP), 16, 0, 0); } }
                asm volatile("s_waitcnt vmcnt(8)" ::: "memory");
                const LAS unsigned char* src = ring + (u & 1) * U6_BUF + (li & 7) * U6_ROWP + 16 * lq;
                f32x4 acc = (f32x4){0.f, 0.f, 0.f, 0.f};
#ifdef HALF_READ
                v4u av[16];
#pragma unroll
                for (int c = 0; c < 16; ++c) asm volatile("" : "=v"(av[c]));
                if (li < 8) {
#pragma unroll
                    for (int c = 0; c < 16; ++c) av[c] = *(const LAS v4u*)(src + 64 * c); }
#pragma unroll
                for (int c = 0; c < 16; ++c) { const v4u a = av[c];
#else
#pragma unroll
                for (int c = 0; c < 16; ++c) { const v4u a = *(const LAS v4u*)(src + 64 * c);
#endif
                    acc = __builtin_amdgcn_mfma_f32_16x16x32_fp8_fp8((i64_t)(((unsigned long long)a[1] << 32) | a[0]), (i64_t)(((unsigned long long)hb[c][1] << 32) | hb[c][0]), acc, 0, 0, 0);
                    acc = __builtin_amdgcn_mfma_f32_16x16x32_fp8_fp8((i64_t)(((unsigned long long)a[3] << 32) | a[2]), (i64_t)(((unsigned long long)hb[c][3] << 32) | hb[c][2]), acc, 0, 0, 0); }
                const int base = (u & 7) * 8; const int r = li & 3;
                const float sel = r == 0 ? acc[0] : (r == 1 ? acc[1] : (r == 2 ? acc[2] : acc[3]));
                const float dmine = __shfl(sel, ((lane & 7) >> 2) * 16 + (lane & 3));
                const float gsel = u < 8 ? g_lo : g_hi, susel = u < 8 ? su_lo : su_hi, svsel = u < 8 ? sv_lo : sv_hi;
                const float wv = gsel * gelu_erf(dmine * susel * hinv) * svsel;
                const bool mine = (lane >= base) && (lane < base + 8);
                if (u < 8) w_lo = mine ? wv : w_lo; else w_hi = mine ? wv : w_hi;
                asm volatile("s_waitcnt lgkmcnt(0)" ::: "memory");
            }
            WSP(float, WS_GATE)[t * 128 + lane] = w_lo; WSP(float, WS_GATE)[t * 128 + 64 + lane] = w_hi;
        }
    }
}
struct U10Meta { int elo, ehi; float glo, ghi; v4u xa, xb; float rst; };
__device__ __forceinline__ void u10_meta_load(U10Meta& M, const unsigned char* ws, size_t t, unsigned l16) {
    const unsigned l = l16 >> 4; const int* ep = (const int*)(ws + WS_EID) + t * 128; const float* gp = (const float*)(ws + WS_GATE) + t * 128;
    M.elo = ep[l]; M.ehi = ep[64 + l]; M.glo = gp[l]; M.ghi = gp[64 + l];
    const char* xs = (const char*)(ws + WS_X1S) + t * 2048 + 2u * l16; M.xa = *(const v4u*)xs; M.xb = *(const v4u*)(xs + 16);
    M.rst = ((const float*)(ws + WS_ROWSTAT))[t + (l16 >> 30)];
}
__device__ __forceinline__ void u10_meta_touch(U10Meta& M) { asm volatile("" : "+v"(M.elo), "+v"(M.ehi), "+v"(M.glo), "+v"(M.ghi), "+v"(M.xa), "+v"(M.xb), "+v"(M.rst)); }
template <int UN> __device__ __forceinline__ void u10_unit_dma(int elo, int ehi, const unsigned char* EU, unsigned l16, LAS unsigned char* dst) {
    const int ensel = UN < 8 ? elo : ehi; constexpr int nb = (UN & 7) * 8;
#pragma unroll
    for (int j = 0; j < 8; ++j) { const int e = __builtin_amdgcn_readlane(ensel, nb + j);
        __builtin_amdgcn_global_load_lds((const unsigned*)(EU + ((unsigned)e * 1024u + l16)), (LAS unsigned*)(dst + j * U6_ROWP), 16, 0, 0); }
}
__device__ __forceinline__ void u10_h2(const U10Meta& M, const float* S2, LAS unsigned char* hq, unsigned l16, int lq, v4u* hb, float& hinv) {
    float h2[16]; unpack8(M.xa, h2); unpack8(M.xb, h2 + 8); float mx = 0.f;
    const float rs = rsqrt_f(M.rst * (1.0f / 1024.0f) + EPSF);
#pragma unroll
    for (int i = 0; i < 16; ++i) { h2[i] = h2[i] * rs + S2[i]; mx = fmaxf(mx, fabsf(h2[i])); }
#pragma unroll
    for (int o = 1; o < 64; o <<= 1) mx = fmaxf(mx, __shfl_xor(mx, o));
    mx = fmaxf(mx, 1e-30f); const float hs = 224.0f / mx; hinv = mx * (1.0f / 224.0f);
    v4u w;
#pragma unroll
    for (int qd = 0; qd < 4; ++qd) { int pk = 0; pk = __builtin_amdgcn_cvt_pk_fp8_f32(h2[4 * qd] * hs, h2[4 * qd + 1] * hs, pk, false); pk = __builtin_amdgcn_cvt_pk_fp8_f32(h2[4 * qd + 2] * hs, h2[4 * qd + 3] * hs, pk, true); w[qd] = (unsigned)pk; }
    *(LAS v4u*)(hq + l16) = w;
    LDS_WAIT(); asm volatile("" ::: "memory");
#pragma unroll
    for (int c = 0; c < 16; ++c) hb[c] = *(const LAS v4u*)(hq + 64 * c + 16 * lq);
    LDS_WAIT(); asm volatile("" ::: "memory");
}
template <int U> __device__ __forceinline__ void u10_unit(const U10Meta& C, U10Meta& N, const unsigned char* EU, const unsigned char* ws, unsigned l16, LAS unsigned char* ring, const v4u* hb, float hinv,
                                                          float su_lo, float su_hi, float sv_lo, float sv_hi, float& nsu_lo, float& nsu_hi, float& nsv_lo, float& nsv_hi,
                                                          float& w_lo, float& w_hi, size_t tn, bool first_token, int lane) {
    const int li = lane & 15, lq = lane >> 4;
    if (U == 15) u10_unit_dma<0>(N.elo, N.ehi, EU, l16, ring); else u10_unit_dma<(U + 1) & 15>(C.elo, C.ehi, EU, l16, ring + ((U + 1) & 1) * U6_BUF);
    __builtin_amdgcn_sched_barrier(0);
    if (U == 0) { if (first_token) asm volatile("s_waitcnt vmcnt(8)" ::: "memory"); else asm volatile("s_waitcnt vmcnt(10)" ::: "memory"); }
    else if (U == 3) asm volatile("s_waitcnt vmcnt(15)" ::: "memory");
    else if (U == 11) asm volatile("s_waitcnt vmcnt(12)" ::: "memory");
    else asm volatile("s_waitcnt vmcnt(8)" ::: "memory");
    if (U == 4) u10_meta_touch(N);
    if (U == 12) asm volatile("" : "+v"(nsu_lo), "+v"(nsu_hi), "+v"(nsv_lo), "+v"(nsv_hi));
    __builtin_amdgcn_sched_barrier(0);
    const LAS unsigned char* src = ring + (U & 1) * U6_BUF + (li & 7) * U6_ROWP + 16 * lq;
    f32x4 acc = (f32x4){0.f, 0.f, 0.f, 0.f};
#pragma unroll
    for (int c = 0; c < 16; ++c) { const v4u a = *(const LAS v4u*)(src + 64 * c);
        acc = __builtin_amdgcn_mfma_f32_16x16x32_fp8_fp8((i64_t)(((unsigned long long)a[1] << 32) | a[0]), (i64_t)(((unsigned long long)hb[c][1] << 32) | hb[c][0]), acc, 0, 0, 0);
        acc = __builtin_amdgcn_mfma_f32_16x16x32_fp8_fp8((i64_t)(((unsigned long long)a[3] << 32) | a[2]), (i64_t)(((unsigned long long)hb[c][3] << 32) | hb[c][2]), acc, 0, 0, 0); }
    constexpr int base = (U & 7) * 8; const int r = li & 3;
    const float sel = r == 0 ? acc[0] : (r == 1 ? acc[1] : (r == 2 ? acc[2] : acc[3]));
    const float dmine = __shfl(sel, ((lane & 7) >> 2) * 16 + (lane & 3));
    const float gsel = U < 8 ? C.glo : C.ghi, susel = U < 8 ? su_lo : su_hi, svsel = U < 8 ? sv_lo : sv_hi;
    const float wv = gsel * gelu_erf(dmine * susel * hinv) * svsel;
    const bool mine = (lane >= base) && (lane < base + 8);
    if (U < 8) w_lo = mine ? wv : w_lo; else w_hi = mine ? wv : w_hi;
    asm volatile("s_waitcnt lgkmcnt(0)" ::: "memory");
    __builtin_amdgcn_sched_barrier(0);
    if (U == 2) { u10_meta_load(N, ws, tn, l16); __builtin_amdgcn_sched_barrier(0); }
    if (U == 10) { const float* EUS = (const float*)(ws + WS_EUS); const float* EVS = (const float*)(ws + WS_EVS); nsu_lo = EUS[N.elo]; nsu_hi = EUS[N.ehi]; nsv_lo = EVS[N.elo]; nsv_hi = EVS[N.ehi]; __builtin_amdgcn_sched_barrier(0); }
}
__device__ __forceinline__ void p8_peer_up10(Frame& F) {
    const int f_tid = threadIdx.x, lane = f_tid & 63, f_wave = __builtin_amdgcn_readfirstlane(f_tid >> 6);
    const int lq = lane >> 4;
    const unsigned char* EU = F.ws + WS_EU; const float* EUS = WSP(float, WS_EUS); const float* EVS = WSP(float, WS_EVS);
    LAS unsigned char* ring = F.lds + f_wave * U6_WAVE; LAS unsigned char* hq = ring + 2 * U6_BUF;
    for (int wq = F.vcu * NWAVES + f_wave; wq < MTOK / 16; wq += F.G * NWAVES) {
        const int b = wq >> 7; const float* mb = WSP(float, WS_MOD) + (size_t)b * 6144;
        unsigned l16 = 16u * (unsigned)lane; asm volatile("" : "+v"(l16));
        float S2[16];
#pragma unroll
        for (int q = 0; q < 4; ++q) { const f32x4 sh = *(const f32x4*)((const char*)(mb + 3072) + 4u * l16 + 16 * q); S2[4 * q] = sh[0]; S2[4 * q + 1] = sh[1]; S2[4 * q + 2] = sh[2]; S2[4 * q + 3] = sh[3]; }
        const size_t t0 = (size_t)wq * 16;
        U10Meta C, N;
        u10_meta_load(C, F.ws, t0, l16);
        asm volatile("s_waitcnt vmcnt(0)" ::: "memory");
        u10_meta_touch(C);
        u10_unit_dma<0>(C.elo, C.ehi, EU, l16, ring);
        float su_lo = EUS[C.elo], su_hi = EUS[C.ehi], sv_lo = EVS[C.elo], sv_hi = EVS[C.ehi];
        float nsu_lo = 0.f, nsu_hi = 0.f, nsv_lo = 0.f, nsv_hi = 0.f;
        v4u hb[16]; float hinv;
        u10_h2(C, S2, hq, l16, lq, hb, hinv);
        N = C;
        asm volatile("s_waitcnt vmcnt(0)" ::: "memory");
        asm volatile("" : "+v"(su_lo), "+v"(su_hi), "+v"(sv_lo), "+v"(sv_hi));
#pragma unroll 1
        for (int tt = 0; tt < 16; ++tt) {
            float w_lo = 0.f, w_hi = 0.f;
            const size_t tn = t0 + (tt < 15 ? tt + 1 : tt);
            const bool ft = (tt == 0);
#define U10_U(U) u10_unit<U>(C, N, EU, F.ws, l16, ring, hb, hinv, su_lo, su_hi, sv_lo, sv_hi, nsu_lo, nsu_hi, nsv_lo, nsv_hi, w_lo, w_hi, tn, ft, lane);
            U10_U(0) U10_U(1) U10_U(2) U10_U(3) U10_U(4) U10_U(5) U10_U(6) U10_U(7) U10_U(8) U10_U(9) U10_U(10) U10_U(11) U10_U(12) U10_U(13) U10_U(14) U10_U(15)
#undef U10_U
            WSP(float, WS_GATE)[(t0 + tt) * 128 + lane] = w_lo; WSP(float, WS_GATE)[(t0 + tt) * 128 + 64 + lane] = w_hi;
            __builtin_amdgcn_sched_barrier(0);
            C = N; su_lo = nsu_lo; su_hi = nsu_hi; sv_lo = nsv_lo; sv_hi = nsv_hi;
            u10_h2(C, S2, hq, l16, lq, hb, hinv);
        }
        asm volatile("s_waitcnt vmcnt(0)" ::: "memory");
    }
}
#ifndef U11_AUX
#define U11_AUX 0
#endif
constexpr int U11_HQ = 2 * U6_BUF, U11_IDS = U11_HQ + 1024, U11_GATES = U11_IDS + 512, U11_SC = U11_GATES + 512, U11_HINV = U11_SC + 1024, U11_WAVE = U11_HINV + 256;
static_assert(8 * U11_WAVE <= LDS_MAIN, "U11 LDS map");
__device__ __forceinline__ void u11_dma4(const void* g, LAS unsigned char* l) { __builtin_amdgcn_global_load_lds((const unsigned*)g, (LAS unsigned*)l, 4, 0, 0); }
__device__ __forceinline__ void u11_stage1(const unsigned char* ws, size_t t, unsigned l16, LAS unsigned char* W) {
    const unsigned l4 = l16 >> 2;
    const unsigned char* ep = ws + WS_EID + t * 512; const unsigned char* gp = ws + WS_GATE + t * 512;
    u11_dma4(ep + l4, W + U11_IDS); u11_dma4(ep + 256 + l4, W + U11_IDS + 256);
    u11_dma4(gp + l4, W + U11_GATES); u11_dma4(gp + 256 + l4, W + U11_GATES + 256);
    __builtin_amdgcn_global_load_lds((const unsigned*)(ws + WS_H2Q + t * 1024 + l16), (LAS unsigned*)(W + U11_HQ), 16, 0, 0);
    u11_dma4(ws + WS_HINV + t * 4 + (l16 >> 30), W + U11_HINV);
}
__device__ __forceinline__ void u11_stage2(const unsigned char* ws, int elo, int ehi, LAS unsigned char* W) {
    u11_dma4(ws + WS_EUS + 4u * (unsigned)elo, W + U11_SC); u11_dma4(ws + WS_EUS + 4u * (unsigned)ehi, W + U11_SC + 256);
    u11_dma4(ws + WS_EVS + 4u * (unsigned)elo, W + U11_SC + 512); u11_dma4(ws + WS_EVS + 4u * (unsigned)ehi, W + U11_SC + 768);
}
template <int UN> __device__ __forceinline__ void u11_unit_dma(int elo, int ehi, const unsigned char* EU, unsigned l16, LAS unsigned char* dst) {
    const int ensel = UN < 8 ? elo : ehi; constexpr int nb = (UN & 7) * 8;
#pragma unroll
    for (int j = 0; j < 8; ++j) { const int e = __builtin_amdgcn_readlane(ensel, nb + j);
        __builtin_amdgcn_global_load_lds((const unsigned*)(EU + ((unsigned)e * 1024u + l16)), (LAS unsigned*)(dst + j * U6_ROWP), 16, 0, U11_AUX); }
}
struct U11Tok { int elo, ehi; float glo, ghi, su_lo, su_hi, sv_lo, sv_hi, hinv; };
__device__ __forceinline__ void u11_switch(U11Tok& C, int nelo, int nehi, LAS unsigned char* W, unsigned l16, int lq, v4u* hb) {
    const unsigned l4 = l16 >> 2;
    C.elo = nelo; C.ehi = nehi;
    C.glo = *(const LAS float*)(W + U11_GATES + l4); C.ghi = *(const LAS float*)(W + U11_GATES + 256 + l4);
    C.su_lo = *(const LAS float*)(W + U11_SC + l4); C.su_hi = *(const LAS float*)(W + U11_SC + 256 + l4); C.sv_lo = *(const LAS float*)(W + U11_SC + 512 + l4); C.sv_hi = *(const LAS float*)(W + U11_SC + 768 + l4);
    C.hinv = *(const LAS float*)(W + U11_HINV + l4);
#pragma unroll
    for (int c = 0; c < 16; ++c) hb[c] = *(const LAS v4u*)(W + U11_HQ + 64 * c + 16 * lq);
    LDS_WAIT(); asm volatile("" ::: "memory");
}
template <int U> __device__ __forceinline__ void u11_unit(const U11Tok& C, int& nelo, int& nehi, const unsigned char* EU, const unsigned char* ws, unsigned l16, LAS unsigned char* W, const v4u* hb,
                                                          float& w_lo, float& w_hi, size_t tn, bool first_token, int lane) {
    const int li = lane & 15, lq = lane >> 4;
    if (U == 15) u11_unit_dma<0>(nelo, nehi, EU, l16, W); else u11_unit_dma<(U + 1) & 15>(C.elo, C.ehi, EU, l16, W + ((U + 1) & 1) * U6_BUF);
    __builtin_amdgcn_sched_barrier(0);
    if (U == 0) { if (first_token) asm volatile("s_waitcnt vmcnt(8)" ::: "memory"); else asm volatile("s_waitcnt vmcnt(10)" ::: "memory"); }
    else if (U == 3) asm volatile("s_waitcnt vmcnt(14)" ::: "memory");
    else if (U == 5) asm volatile("s_waitcnt vmcnt(12)" ::: "memory");
    else asm volatile("s_waitcnt vmcnt(8)" ::: "memory");
    __builtin_amdgcn_sched_barrier(0);
    const LAS unsigned char* src = W + (U & 1) * U6_BUF + (li & 7) * U6_ROWP + 16 * lq;
    f32x4 acc = (f32x4){0.f, 0.f, 0.f, 0.f};
#pragma unroll
    for (int c = 0; c < 16; ++c) { const v4u a = *(const LAS v4u*)(src + 64 * c);
        acc = __builtin_amdgcn_mfma_f32_16x16x32_fp8_fp8((i64_t)(((unsigned long long)a[1] << 32) | a[0]), (i64_t)(((unsigned long long)hb[c][1] << 32) | hb[c][0]), acc, 0, 0, 0);
        acc = __builtin_amdgcn_mfma_f32_16x16x32_fp8_fp8((i64_t)(((unsigned long long)a[3] << 32) | a[2]), (i64_t)(((unsigned long long)hb[c][3] << 32) | hb[c][2]), acc, 0, 0, 0); }
    constexpr int base = (U & 7) * 8; const int r = li & 3;
    const float sel = r == 0 ? acc[0] : (r == 1 ? acc[1] : (r == 2 ? acc[2] : acc[3]));
    const float dmine = __shfl(sel, ((lane & 7) >> 2) * 16 + (lane & 3));
    const float gsel = U < 8 ? C.glo : C.ghi, susel = U < 8 ? C.su_lo : C.su_hi, svsel = U < 8 ? C.sv_lo : C.sv_hi;
    const float wv = gsel * gelu_erf(dmine * susel * C.hinv) * svsel;
    const bool mine = (lane >= base) && (lane < base + 8);
    if (U < 8) w_lo = mine ? wv : w_lo; else w_hi = mine ? wv : w_hi;
    if (U == 4) { nelo = *(const LAS int*)(W + U11_IDS + (l16 >> 2)); nehi = *(const LAS int*)(W + U11_IDS + 256 + (l16 >> 2)); }
    asm volatile("s_waitcnt lgkmcnt(0)" ::: "memory");
    __builtin_amdgcn_sched_barrier(0);
    if (U == 2) { u11_stage1(ws, tn, l16, W); __builtin_amdgcn_sched_barrier(0); }
    if (U == 4) { u11_stage2(ws, nelo, nehi, W); __builtin_amdgcn_sched_barrier(0); }
}
__device__ __forceinline__ void p8_peer_up11(Frame& F) {
    const int f_tid = threadIdx.x, lane = f_tid & 63, f_wave = __builtin_amdgcn_readfirstlane(f_tid >> 6);
    const int lq = lane >> 4;
    const unsigned char* EU = F.ws + WS_EU;
    LAS unsigned char* W = F.lds + f_wave * U11_WAVE;
    for (int wq = F.vcu * NWAVES + f_wave; wq < MTOK / 16; wq += F.G * NWAVES) {
        unsigned l16 = 16u * (unsigned)lane; asm volatile("" : "+v"(l16));
        const size_t t0 = (size_t)wq * 16;
        u11_stage1(F.ws, t0, l16, W);
        asm volatile("s_waitcnt vmcnt(0)" ::: "memory");
        int nelo = *(const LAS int*)(W + U11_IDS + (l16 >> 2)), nehi = *(const LAS int*)(W + U11_IDS + 256 + (l16 >> 2));
        LDS_WAIT(); asm volatile("" ::: "memory");
        u11_stage2(F.ws, nelo, nehi, W);
        u11_unit_dma<0>(nelo, nehi, EU, l16, W);
        asm volatile("s_waitcnt vmcnt(0)" ::: "memory");
        U11Tok C; v4u hb[16];
        u11_switch(C, nelo, nehi, W, l16, lq, hb);
#pragma unroll 1
        for (int tt = 0; tt < 16; ++tt) {
            float w_lo = 0.f, w_hi = 0.f;
            const size_t tn = t0 + (tt < 15 ? tt + 1 : tt);
            const bool ft = (tt == 0);
#define U11_U(U) u11_unit<U>(C, nelo, nehi, EU, F.ws, l16, W, hb, w_lo, w_hi, tn, ft, lane);
            U11_U(0) U11_U(1) U11_U(2) U11_U(3) U11_U(4) U11_U(5) U11_U(6) U11_U(7) U11_U(8) U11_U(9) U11_U(10) U11_U(11) U11_U(12) U11_U(13) U11_U(14) U11_U(15)
#undef U11_U
            WSP(float, WS_GATE)[(t0 + tt) * 128 + lane] = w_lo; WSP(float, WS_GATE)[(t0 + tt) * 128 + 64 + lane] = w_hi;
            __builtin_amdgcn_sched_barrier(0);
            u11_switch(C, nelo, nehi, W, l16, lq, hb);
        }
        asm volatile("s_waitcnt vmcnt(0)" ::: "memory");
    }
}
typedef unsigned v3u __attribute__((ext_vector_type(3)));
typedef unsigned v6u __attribute__((ext_vector_type(6)));
typedef float f32x32 __attribute__((ext_vector_type(32)));
struct __attribute__((packed, aligned(4))) U3 { unsigned a, b, c; };
__device__ __forceinline__ v3u ld_row6(const unsigned char* p) { const U3 u = *(const U3*)p; return (v3u){u.a, u.b, u.c}; }
__device__ __forceinline__ void p9_peer_down3(Frame& F) {
    const int f_tid = threadIdx.x, lane = f_tid & 63, f_wave = __builtin_amdgcn_readfirstlane(f_tid >> 6);
    const unsigned char* EV = F.ws + WS_EV;
    for (int wq = F.vcu * NWAVES + f_wave; wq < MTOK / 16; wq += F.G * NWAVES) {
        const int b = wq >> 7; const float* mb = WSP(float, WS_MOD) + (size_t)b * 6144;
        int ne_lo = WSP(int, WS_EID)[(size_t)wq * 16 * 128 + lane], ne_hi = WSP(int, WS_EID)[(size_t)wq * 16 * 128 + 64 + lane];
        float nw_lo = WSP(float, WS_GATE)[(size_t)wq * 16 * 128 + lane], nw_hi = WSP(float, WS_GATE)[(size_t)wq * 16 * 128 + 64 + lane];
        for (int tt = 0; tt < 16; ++tt) {
            const size_t t = (size_t)wq * 16 + tt;
            unsigned l16 = 16u * (unsigned)lane; asm volatile("" : "+v"(l16));
            const unsigned l12 = (l16 >> 2) * 3u;
            float* xr = (float*)((char*)(F.out + t * 1024) + 4u * l16);
            const int e_lo = ne_lo, e_hi = ne_hi; const float w_lo = nw_lo, w_hi = nw_hi;
            f32x2 o[8];
#pragma unroll
            for (int i = 0; i < 8; ++i) o[i] = (f32x2){0.f, 0.f};
#ifdef DN3_G16
            v3u qa[16], qb[16];
#pragma unroll
            for (int j = 0; j < 16; ++j) { const int e = __builtin_amdgcn_readlane(e_lo, j); qa[j] = ld_row6(EV + ((unsigned)e * 768u + l12)); }
#define DN3_STEP(GRP, CUR, NXT) { \
                const int grp = (GRP); const int nb = ((grp + 1) & 3) * 16; const int ensel = ((grp + 1) & 7) < 4 ? e_lo : e_hi; \
                { _Pragma("unroll") for (int j = 0; j < 16; ++j) { const int e = __builtin_amdgcn_readlane(ensel, nb + j); NXT[j] = ld_row6(EV + ((unsigned)e * 768u + l12)); } } \
                __builtin_amdgcn_sched_barrier(0); \
                const int base = (grp & 3) * 16; const float wsel = grp < 4 ? w_lo : w_hi; \
                _Pragma("unroll") for (int j = 0; j < 16; j += 2) { \
                    const float wa = __builtin_bit_cast(float, __builtin_amdgcn_readlane(__builtin_bit_cast(int, wsel), base + j)), wb = __builtin_bit_cast(float, __builtin_amdgcn_readlane(__builtin_bit_cast(int, wsel), base + j + 1)); \
                    const f32x2 wa2 = (f32x2){wa, wa}, wb2 = (f32x2){wb, wb}; \
                    const v6u pr = (v6u){CUR[j][0], CUR[j][1], CUR[j][2], CUR[j + 1][0], CUR[j + 1][1], CUR[j + 1][2]}; \
                    const f32x32 r = __builtin_amdgcn_cvt_scalef32_pk32_f32_fp6(pr, 1.0f); \
                    _Pragma("unroll") for (int i = 0; i < 8; ++i) { o[i] += wa2 * (f32x2){r[2 * i], r[2 * i + 1]}; o[i] += wb2 * (f32x2){r[16 + 2 * i], r[17 + 2 * i]}; } } }
#pragma unroll 1
            for (int g2 = 0; g2 < 8; g2 += 2) { DN3_STEP(g2, qa, qb) DN3_STEP(g2 + 1, qb, qa) }
#else
            v3u qa[8], qb[8];
#pragma unroll
            for (int j = 0; j < 8; ++j) { const int e = __builtin_amdgcn_readlane(e_lo, j); qa[j] = ld_row6(EV + ((unsigned)e * 768u + l12)); }
#define DN3_STEP(GRP, CUR, NXT) { \
                const int grp = (GRP); const int nb = ((grp + 1) & 7) * 8; const int ensel = (grp + 1) < 8 ? e_lo : e_hi; \
                { _Pragma("unroll") for (int j = 0; j < 8; ++j) { const int e = __builtin_amdgcn_readlane(ensel, nb + j); NXT[j] = ld_row6(EV + ((unsigned)e * 768u + l12)); } } \
                __builtin_amdgcn_sched_barrier(0); \
                const int base = (grp & 7) * 8; const float wsel = grp < 8 ? w_lo : w_hi; \
                _Pragma("unroll") for (int j = 0; j < 8; j += 2) { \
                    const float wa = __builtin_bit_cast(float, __builtin_amdgcn_readlane(__builtin_bit_cast(int, wsel), base + j)), wb = __builtin_bit_cast(float, __builtin_amdgcn_readlane(__builtin_bit_cast(int, wsel), base + j + 1)); \
                    const f32x2 wa2 = (f32x2){wa, wa}, wb2 = (f32x2){wb, wb}; \
                    const v6u pr = (v6u){CUR[j][0], CUR[j][1], CUR[j][2], CUR[j + 1][0], CUR[j + 1][1], CUR[j + 1][2]}; \
                    const f32x32 r = __builtin_amdgcn_cvt_scalef32_pk32_f32_fp6(pr, 1.0f); \
                    _Pragma("unroll") for (int i = 0; i < 8; ++i) { o[i] += wa2 * (f32x2){r[2 * i], r[2 * i + 1]}; o[i] += wb2 * (f32x2){r[16 + 2 * i], r[17 + 2 * i]}; } } }
#pragma unroll 1
            for (int g2 = 0; g2 < 16; g2 += 2) { DN3_STEP(g2, qa, qb) DN3_STEP(g2 + 1, qb, qa) }
#endif
#undef DN3_STEP
            { const size_t tn = t + (tt < 15 ? 1 : 0); ne_lo = WSP(int, WS_EID)[tn * 128 + lane]; ne_hi = WSP(int, WS_EID)[tn * 128 + 64 + lane]; nw_lo = WSP(float, WS_GATE)[tn * 128 + lane]; nw_hi = WSP(float, WS_GATE)[tn * 128 + 64 + lane]; }
            float x1[16]; float ss = 0.f;
#pragma unroll
            for (int q4 = 0; q4 < 4; ++q4) { const f32x4 v = *(const f32x4*)(xr + 4 * q4); x1[4 * q4] = v[0]; x1[4 * q4 + 1] = v[1]; x1[4 * q4 + 2] = v[2]; x1[4 * q4 + 3] = v[3]; }
#pragma unroll
            for (int q4 = 0; q4 < 4; ++q4) { const f32x4 gt = *(const f32x4*)((const char*)(mb + 5120) + 4u * l16 + 16 * q4);
#pragma unroll
                for (int e = 0; e < 4; ++e) { const int i = 4 * q4 + e; x1[i] += gt[e] * o[i >> 1][i & 1]; ss += x1[i] * x1[i]; } }
            const float rf = rsqrt_f(wave_sum(ss) * (1.0f / 1024.0f) + EPSF);
#pragma unroll
            for (int q4 = 0; q4 < 4; ++q4) { const f32x4 nf = *(const f32x4*)((const char*)(F.a->in[29]) + 4u * l16 + 16 * q4); f32x4 v;
#pragma unroll
                for (int e = 0; e < 4; ++e) v[e] = x1[4 * q4 + e] * rf * nf[e];
                *(f32x4*)(xr + 4 * q4) = v; }
        }
    }
}
constexpr int U12_ROWP = 1040, U12_BUF = 8 * U12_ROWP, U12_WAVE = 2 * U12_BUF + 1024;
static_assert(8 * U12_WAVE <= LDS_MAIN, "U12 LDS map");
typedef int i32x8 __attribute__((ext_vector_type(8)));
typedef unsigned v2u __attribute__((ext_vector_type(2)));
__device__ __forceinline__ void p8_peer_up12(Frame& F) {
    const int f_tid = threadIdx.x, lane = f_tid & 63, f_wave = __builtin_amdgcn_readfirstlane(f_tid >> 6);
    const int li = lane & 15, lq = lane >> 4;
    const unsigned char* EU = F.ws + WS_EU; const float* EUS = WSP(float, WS_EUS); const float* EVS = WSP(float, WS_EVS);
    LAS unsigned char* ring = F.lds + f_wave * U12_WAVE; LAS unsigned char* hq = ring + 2 * U12_BUF;
#ifdef PROBE_MFMA
    if (blockIdx.x == 0 && f_wave == 0) {
        i32x8 A = (i32x8){0, 0, 0, 0, 0, 0, 0, 0}; if (lane == PROBE_ALANE) A[PROBE_AREG] = PROBE_AVAL;
        i32x8 B;
        if (PROBE_BPAT == 0) B = (i32x8){0x48444038, 0x504E4C4A, 0x54535251, 0x58575655, 0x48444038, 0x504E4C4A, 0x54535251, 0x58575655};
        else { const unsigned c0 = (const unsigned[]){0x38u, 0x40u, 0x44u, 0x48u, 0x4Au, 0x4Cu, 0x4Eu, 0x50u}[0]; (void)c0;
               const int k = lane >> 4; const unsigned lo = k == 0 ? 0x38u : (k == 1 ? 0x44u : (k == 2 ? 0x4Au : 0x4Eu)), hi = k == 0 ? 0x40u : (k == 1 ? 0x48u : (k == 2 ? 0x4Cu : 0x50u));
               const int wl = (int)(lo * 0x01010101u), wh = (int)(hi * 0x01010101u); B = (i32x8){wl, wl, wl, wl, wh, wh, wh, wh}; }
        f32x4 acc = (f32x4){0.f, 0.f, 0.f, 0.f};
        acc = __builtin_amdgcn_mfma_scale_f32_16x16x128_f8f6f4(A, B, acc, 2, 0, 0, 0, 0, 0);
        if (lane == 0) *(volatile float*)(F.ws + WS_CTL + 40000) = acc[0] * 100.0f;
    }
#endif
    for (int wq = F.vcu * NWAVES + f_wave; wq < MTOK / 16; wq += F.G * NWAVES) {
        const int b = wq >> 7; const float* mb = WSP(float, WS_MOD) + (size_t)b * 6144;
        for (int tt = 0; tt < 16; ++tt) {
            const size_t t = (size_t)wq * 16 + tt;
            unsigned l16 = 16u * (unsigned)lane; asm volatile("" : "+v"(l16));
            const int e_lo = WSP(int, WS_EID)[t * 128 + lane], e_hi = WSP(int, WS_EID)[t * 128 + 64 + lane];
            const float g_lo = WSP(float, WS_GATE)[t * 128 + lane], g_hi = WSP(float, WS_GATE)[t * 128 + 64 + lane];
            const float rs = rsqrt_f(WSP(float, WS_ROWSTAT)[t] * (1.0f / 1024.0f) + EPSF);
            const char* xs = (const char*)(WSP(bf16, WS_X1S) + t * 1024) + 2u * l16; const v4u xa = *(const v4u*)xs, xb = *(const v4u*)(xs + 16);
            asm volatile("s_waitcnt vmcnt(0)" ::: "memory");
            if (lane < 48) {
#pragma unroll
            for (int j = 0; j < 8; ++j) { const int e = __builtin_amdgcn_readlane(e_lo, j);
                __builtin_amdgcn_global_load_lds((const unsigned*)(EU + ((unsigned)e * 768u + l16)), (LAS unsigned*)(ring + j * U12_ROWP), 16, 0, 0); } }
            const float su_lo = EUS[e_lo], su_hi = EUS[e_hi], sv_lo = EVS[e_lo], sv_hi = EVS[e_hi];
            float h2[16]; unpack8(xa, h2); unpack8(xb, h2 + 8); float mx = 0.f;
#pragma unroll
            for (int qd = 0; qd < 4; ++qd) { const f32x4 sh = *(const f32x4*)((const char*)(mb + 3072) + 4u * l16 + 16 * qd);
#pragma unroll
                for (int e = 0; e < 4; ++e) { h2[4 * qd + e] = h2[4 * qd + e] * rs + sh[e]; mx = fmaxf(mx, fabsf(h2[4 * qd + e])); } }
#pragma unroll
            for (int o = 1; o < 64; o <<= 1) mx = fmaxf(mx, __shfl_xor(mx, o));
            mx = fmaxf(mx, 1e-30f); const float hs = 224.0f / mx, hinv = mx * (1.0f / 224.0f);
            { v4u w;
#pragma unroll
              for (int qd = 0; qd < 4; ++qd) { int pk = 0; pk = __builtin_amdgcn_cvt_pk_fp8_f32(h2[4 * qd] * hs, h2[4 * qd + 1] * hs, pk, false); pk = __builtin_amdgcn_cvt_pk_fp8_f32(h2[4 * qd + 2] * hs, h2[4 * qd + 3] * hs, pk, true); w[qd] = (unsigned)pk; }
              *(LAS v4u*)(hq + l16) = w; }
            LDS_WAIT(); asm volatile("" ::: "memory");
            v4u hb[16];
#pragma unroll
            for (int c = 0; c < 8; ++c) { hb[2 * c] = *(const LAS v4u*)(hq + 128 * c + 16 * lq); hb[2 * c + 1] = *(const LAS v4u*)(hq + 128 * c + 64 + 16 * lq); }
            asm volatile("s_waitcnt vmcnt(0)" ::: "memory");
            float w_lo = 0.f, w_hi = 0.f;
#pragma unroll 1
            for (int u = 0; u < 16; ++u) {
                { const int un = (u + 1) & 15; int ensel = un < 8 ? e_lo : e_hi; asm volatile("" : "+v"(ensel));     const int nb = (un & 7) * 8; LAS unsigned char* dst = ring + ((u + 1) & 1) * U12_BUF;
                  if (lane < 48) {
#pragma unroll
                  for (int j = 0; j < 8; ++j) { const int e = __builtin_amdgcn_readlane(ensel, nb + j);
                      __builtin_amdgcn_global_load_lds((const unsigned*)(EU + ((unsigned)e * 768u + l16)), (LAS unsigned*)(dst + j * U12_ROWP), 16, 0, 0); } } }
                asm volatile("s_waitcnt vmcnt(8)" ::: "memory");
                const LAS unsigned char* src = ring + (u & 1) * U12_BUF + (li & 7) * U12_ROWP + 24 * lq;
                f32x4 acc = (f32x4){0.f, 0.f, 0.f, 0.f};
#pragma unroll
                for (int c = 0; c < 8; ++c) { const v2u a0 = *(const LAS v2u*)(src + 96 * c), a1 = *(const LAS v2u*)(src + 96 * c + 8), a2 = *(const LAS v2u*)(src + 96 * c + 16);
                    const i32x8 A = (i32x8){(int)a0[0], (int)a0[1], (int)a1[0], (int)a1[1], (int)a2[0], (int)a2[1], 0, 0};
                    const i32x8 B = (i32x8){(int)hb[2 * c][0], (int)hb[2 * c][1], (int)hb[2 * c][2], (int)hb[2 * c][3], (int)hb[2 * c + 1][0], (int)hb[2 * c + 1][1], (int)hb[2 * c + 1][2], (int)hb[2 * c + 1][3]};
                    acc = __builtin_amdgcn_mfma_scale_f32_16x16x128_f8f6f4(A, B, acc, 2, 0, 0, 0, 0, 0); }
                const int base = (u & 7) * 8; const int r = li & 3;
                const float sel = r == 0 ? acc[0] : (r == 1 ? acc[1] : (r == 2 ? acc[2] : acc[3]));
                const float dmine = __shfl(sel, ((lane & 7) >> 2) * 16 + (lane & 3));
                const float gsel = u < 8 ? g_lo : g_hi, susel = u < 8 ? su_lo : su_hi, svsel = u < 8 ? sv_lo : sv_hi;
                const float wv = gsel * gelu_erf(dmine * susel * hinv) * svsel;
                const bool mine = (lane >= base) && (lane < base + 8);
                if (u < 8) w_lo = mine ? wv : w_lo; else w_hi = mine ? wv : w_hi;
                asm volatile("s_waitcnt lgkmcnt(0)" ::: "memory");
            }
            WSP(float, WS_GATE)[t * 128 + lane] = w_lo; WSP(float, WS_GATE)[t * 128 + 64 + lane] = w_hi;
        }
    }
}
#ifdef TOPK2
#define P7FN p5b_topk2
#else
#define P7FN p5b_topk
#endif
constexpr int NPHASE = 10;
__global__ void __launch_bounds__(NTHR, 2) fwd_mega(Args args) {
    extern __shared__ __attribute__((aligned(16))) unsigned char lds[];
    Frame F;
    F.lds = (LAS unsigned char*)lds;
    F.MISC = (volatile LAS unsigned*)(F.lds + MISC_OFF);
    F.G = gridDim.x; { const int bx = blockIdx.x; F.vcu = (F.G % 8 == 0) ? (bx % 8) * (F.G / 8) + bx / 8 : bx; }
    F.ws = args.ws; F.out = args.out;
    F.a = &args;
    for (int u = threadIdx.x; u < 32; u += NTHR) F.MISC[u] = 0u;
    __syncthreads();
    const int lo = args.ph_lo, hi = args.ph_hi;
    const bool use_bar = (hi - lo) > 1;
    XcdBarrier bar; bar.bar = (unsigned*)(F.ws + WS_CTL); bar.x = 0; bar.st = nullptr;
    if (use_bar) bar = xcd_barrier_post((unsigned*)(F.ws + WS_CTL), F.MISC + 8);
#define IN(k) (lo <= (k) && (k) < hi)
#define SEAM(k) do { if (IN(k) && IN((k) + 1)) xcd_barrier(bar); } while (0)
#ifndef REP_PHASE
#define REP_PHASE -1
#endif
#define REPEAT(k, body) do { if (REP_PHASE == (k)) { xcd_barrier(bar); body; } } while (0)
    if (IN(0)) {
#ifndef SKIP_P0
 p0_phase(F); REPEAT(0, p0_phase(F));
#endif
 } SEAM(0);
    if (IN(1)) {
#ifndef SKIP_P1
 p1_phase(F); REPEAT(1, p1_phase(F));
#endif
 } SEAM(1);
    if (IN(2)) {
        pg8::Gemm g{WSP(bf16, WS_H1), WSP(bf16, WS_WINT), MTOK, NPROJ, 1024}; pg8::StaticOrder S; S.init(MTOK, NPROJ, F.G, (int)blockIdx.x);
        pg8::EpiProj E{WSP(bf16, WS_PROJ), NPROJ};
        pg8::gemm_phase<pg8::EpiProj, pg8::StaticOrder, true, true>(F.lds, g, S, E);
        REPEAT(2, (pg8::gemm_phase<pg8::EpiProj, pg8::StaticOrder, true, true>(F.lds, g, S, E)));
    } SEAM(2);
    if (IN(3)) {
#ifndef SKIP_SSD
 p3pre_conv(F); xcd_barrier(bar); p3_ssd3(F); REPEAT(30, p3_ssd3(F)); REPEAT(32, p3pre_conv(F));
#endif
#ifndef SKIP_S5
 p3_s5v2(F); REPEAT(31, p3_s5v2(F));
#endif
 } SEAM(3);
    if (IN(5)) {
        pg8::Gemm g{WSP(bf16, WS_Y), WSP(bf16, WS_WOUTT), MTOK, 1024, 2048}; pg8::StaticOrder S; S.init(MTOK, 1024, F.G, (int)blockIdx.x);
        PG8_LAS float* tab = (PG8_LAS float*)(F.lds + pg8::STAGE_BYTES);
        { pg8::Unit u; for (int i = 0; S.next(i, u); ++i) pg8::SegScaleHook::build(F.lds + pg8::STAGE_BYTES, u, WSP(float, WS_STSSD), WSP(float, WS_STS5), (int)threadIdx.x); }
        __syncthreads();
        pg8::EpiX1 E{(F.a->in[0]), F.out, WSP(bf16, WS_X1S), WSP(float, WS_MOD), (F.a->in[24]), WSP(float, WS_ROWSTAT), tab};
        pg8::SegScaleHook H;
        pg8::gemm_phase<pg8::EpiX1, pg8::StaticOrder, true, true, pg8::SegScaleHook>(F.lds, g, S, E, H);
    } SEAM(5);
    if (IN(6)) {
        pg8::Gemm g{WSP(bf16, WS_X1S), WSP(bf16, WS_WQKT), MTOK, 2048, 1024}; pg8::StaticOrder S; S.init(MTOK, 2048, F.G, (int)blockIdx.x);
        pg8::EpiScores E{WSP(_Float16, WS_SCORES), WSP(float, WS_SB), WSP(float, WS_ROWSTAT)};
        pg8::gemm_phase<pg8::EpiScores, pg8::StaticOrder, true, true>(F.lds, g, S, E);
        REPEAT(6, (pg8::gemm_phase<pg8::EpiScores, pg8::StaticOrder, true, true>(F.lds, g, S, E)));
    } SEAM(6);
    if (IN(7)) {
#ifndef SKIP_TOPK
 P7FN(F); REPEAT(7, P7FN(F));
#endif
 } SEAM(7);
#ifdef UP12
    if (IN(8)) { p8_peer_up12(F); REPEAT(8, { P7FN(F); xcd_barrier(bar); p8_peer_up12(F); }); } SEAM(8);
#elif defined(UP11)
    if (IN(8)) { p8_peer_up11(F); REPEAT(8, { P7FN(F); xcd_barrier(bar); p8_peer_up11(F); }); } SEAM(8);
#elif defined(UP10)
    if (IN(8)) { p8_peer_up10(F); } SEAM(8);
#else
    if (IN(8)) { p8_peer_up6(F); REPEAT(8, { P7FN(F); xcd_barrier(bar); p8_peer_up6(F); }); } SEAM(8);
#endif
#ifdef V6
    if (IN(9)) { p9_peer_down3(F); }
#else
    if (IN(9)) { p9_peer_down2(F); }
#endif
#ifdef PROBE_OUT
    if (IN(9)) { __syncthreads(); if (blockIdx.x == 0 && threadIdx.x == 0) { asm volatile("s_waitcnt vmcnt(0)" ::: "memory"); F.out[0] = *(volatile float*)(F.ws + WS_CTL + 40000); } }
#endif
#undef IN
#undef SEAM
}

#ifndef N_LAUNCHES
#define N_LAUNCHES 1
#endif
extern "C" void kernel_launch(void* const* d_in, const int* in_sizes, int n_in, void* d_out, int out_size, void* d_ws, size_t ws_size, hipStream_t stream) {
    static int grid = 0;
    if (grid == 0) {
        if (n_in != 30 || in_sizes[0] != MTOK * DM || out_size != MTOK * DM || ws_size < WS_END) { fprintf(stderr, "kernel_launch: unexpected shapes (n_in %d, in0 %d, out %d, ws %zu)\n", n_in, n_in > 0 ? in_sizes[0] : -1, out_size, ws_size); grid = -1; return; }
        int dev = 0, cus = 0, per_cu = 0;
        if (hipGetDevice(&dev) != hipSuccess || hipDeviceGetAttribute(&cus, hipDeviceAttributeMultiprocessorCount, dev) != hipSuccess) { grid = -1; return; }
        if (hipFuncSetAttribute((const void*)fwd_mega, hipFuncAttributeMaxDynamicSharedMemorySize, LDS_BYTES) != hipSuccess) { fprintf(stderr, "kernel_launch: hipFuncSetAttribute failed\n"); grid = -1; return; }
        if (hipOccupancyMaxActiveBlocksPerMultiprocessor(&per_cu, (const void*)fwd_mega, NTHR, LDS_BYTES) != hipSuccess || per_cu < 1) { fprintf(stderr, "kernel_launch: occupancy query says %d\n", per_cu); (void)hipGetLastError(); grid = -1; return; }
        if (cus != 256) { fprintf(stderr, "kernel_launch: built for a 256-CU device (got %d CUs); nothing launched\n", cus); grid = -1; return; }
        grid = cus;
    }
    if (grid < 0) return;
    (void)hipMemsetAsync((char*)d_ws + WS_CTL, 0, CTL_ZERO_BYTES, stream);
    Args a{};
    for (int i = 0; i < 30; ++i) a.in[i] = (const float*)d_in[i];
    a.out = (float*)d_out; a.ws = (unsigned char*)d_ws;
    if (N_LAUNCHES == 1) {
        a.ph_lo = 0; a.ph_hi = NPHASE;
        void* kargs[] = {&a};
#ifdef PLAIN_LAUNCH
        (void)kargs; hipLaunchKernelGGL(fwd_mega, dim3(grid), dim3(NTHR), LDS_BYTES, stream, a);
#else
        hipError_t e = hipLaunchCooperativeKernel((const void*)fwd_mega, dim3(grid), dim3(NTHR), kargs, LDS_BYTES, stream);
        if (e != hipSuccess) fprintf(stderr, "kernel_launch: cooperative launch failed: %s (grid %d)\n", hipGetErrorString(e), grid);
#endif
    } else {
        for (int p = 0; p < NPHASE; ++p) { a.ph_lo = p; a.ph_hi = p + 1; hipLaunchKernelGGL(fwd_mega, dim3(grid), dim3(NTHR), LDS_BYTES, stream, a); }
    }
}
```

```cpp
#define V6
#define UP12
#include <hip/hip_runtime.h>
#include <cstdio>
#include <cstdint>
namespace pg8 {
#define PG8_LAS __attribute__((address_space(3)))
typedef unsigned short bf16_t;
typedef short bf16x8 __attribute__((ext_vector_type(8)));
typedef float f32x4 __attribute__((ext_vector_type(4)));
typedef unsigned u32x4 __attribute__((ext_vector_type(4)));
constexpr int BM = 256, BK = 64, HALF = 128, HTB = HALF * BK * 2  , STAGE_BYTES = 8 * HTB, NXCD = 8, WGM = 8;

__host__ __device__ __forceinline__ int lds_byte(int r, int c) { const int st = (r >> 4) * 2 + (c >> 5), rr = r & 15, cc = c & 31, ob = rr * 64 + cc * 2; return st * 1024 + (ob ^ (((ob >> 9) & 1) << 5)); }
__host__ __device__ __forceinline__ void stage_rc(int b, int& R, int& C) { const int st = b / 1024, sb = b % 1024, swz = sb ^ (((sb >> 9) & 1) << 5); R = (st >> 1) * 16 + swz / 64; C = (st & 1) * 32 + (swz % 64) / 2; }
__host__ __device__ __forceinline__ int perm32(int rho) { const int n = rho >> 4, i = rho & 15; return 8 * (i >> 2) + 4 * n + (i & 3); }

struct Unit { int pm, pn; };
struct Gemm { const bf16_t* A; const bf16_t* Bt; int M, N, K; };

struct StaticOrder {
    int nM, nN, nwg, G, c;
    __host__ __device__ void init(int M, int N, int G_, int c_) { nM = M / BM; nN = N / BM; nwg = nM * nN; G = G_; c = c_; }
    __host__ __device__ bool next(int i, Unit& u) const {
        const long L = (long)i * G + c; if (L >= nwg) return false;
        int wgid = (int)L; { const int q = nwg / NXCD, r = nwg % NXCD, xcd = wgid % NXCD, off = wgid / NXCD; wgid = (xcd < r ? xcd * (q + 1) : r * (q + 1) + (xcd - r) * q) + off; }
        const int nig = WGM * nN, gid = wgid / nig, fm = gid * WGM, gsz = (nM - fm) < WGM ? (nM - fm) : WGM;
        u.pm = fm + ((wgid % nig) % gsz); u.pn = (wgid % nig) / gsz; return true;
    }
    __device__ __forceinline__ void a_ready(const Unit&) const {}
    __device__ __forceinline__ void done(const Unit&) const {}
};

__device__ __forceinline__ unsigned cvt_pk_bf16(float lo, float hi) { unsigned r; asm volatile("v_cvt_pk_bf16_f32 %0, %1, %2" : "=v"(r) : "v"(lo), "v"(hi)); return r; }
typedef float f32x2 __attribute__((ext_vector_type(2)));
struct NoHook { __device__ __forceinline__ void at_tile(int, const Unit&, f32x4 (&)[2][2][4][2], PG8_LAS unsigned char*, int, int) const {} };
template <class Epi, class Sched, bool ALIGN_EPI = false, bool SP2 = false, class Hook = NoHook>
__device__ __forceinline__ void gemm_phase(PG8_LAS unsigned char* lds, const Gemm g, const Sched& S, const Epi& E, const Hook& H = Hook()) {
    const int tid = threadIdx.x, wid = __builtin_amdgcn_readfirstlane(tid >> 6), lane = tid & 63, wr = wid >> 2, wc = wid & 3, fr = lane & 15, fq = lane >> 4;
    const int K = g.K, nt = K / BK;
    unsigned voffA[2], voffB[2];
#pragma unroll
    for (int i = 0; i < 2; ++i) { int R, C; stage_rc(tid * 16 + i * 8192, R, C); const int Rb = Epi::PERM ? ((R & ~31) + perm32(R & 31)) : R;
        voffA[i] = (unsigned)(R * K + C) * 2u; voffB[i] = (unsigned)(Rb * K + C) * 2u; }
    const size_t kstep = (size_t)(BK * 2);
    const size_t hstep = (size_t)HALF * K * 2;
    const size_t tstep = 2 * hstep;
    const unsigned ldsw = (unsigned)wid * 1024u;
    const int aoff = lds_byte(wr * 64 + fr, fq * 8), boff = lds_byte(wc * 32 + fr, fq * 8);
#define PG8_SA(b, h) (((b) * 2 + (h)) * HTB)
#define PG8_SB(b, h) ((4 + (b) * 2 + (h)) * HTB)
#define PG8_STAGE(bufoff, gbase, voff) do { _Pragma("unroll") for (int _i = 0; _i < 2; ++_i) \
        __builtin_amdgcn_global_load_lds((const unsigned*)((const char*)(gbase) + (voff)[_i]), (PG8_LAS unsigned*)(lds + (bufoff) + ldsw + _i * 8192), 16, 0, 0); } while (0)
#define PG8_LDA(dst, b, h) do { _Pragma("unroll") for (int m = 0; m < 4; ++m) _Pragma("unroll") for (int k = 0; k < 2; ++k) dst[m][k] = *(const PG8_LAS bf16x8*)(lds + PG8_SA(b, h) + aoff + m * 2048 + k * 1024); } while (0)
#define PG8_LDB(dst, b, h) do { _Pragma("unroll") for (int n = 0; n < 2; ++n) _Pragma("unroll") for (int k = 0; k < 2; ++k) dst[n][k] = *(const PG8_LAS bf16x8*)(lds + PG8_SB(b, h) + boff + n * 2048 + k * 1024); } while (0)
#define PG8_MMA(ai, bj, At, Bt) do { __builtin_amdgcn_s_setprio(1); _Pragma("unroll") for (int m = 0; m < 4; ++m) _Pragma("unroll") for (int n = 0; n < 2; ++n) _Pragma("unroll") for (int k = 0; k < 2; ++k) \
        acc[ai][bj][m][n] = __builtin_amdgcn_mfma_f32_16x16x32_bf16(Bt[n][k], At[m][k], acc[ai][bj][m][n], 0, 0, 0); __builtin_amdgcn_s_setprio(0); } while (0)
#define PG8_WAIT_V(n) asm volatile("s_waitcnt vmcnt(" #n ")" ::: "memory")
#define PG8_WAIT_L(n) asm volatile("s_waitcnt lgkmcnt(" #n ")" ::: "memory")
#define PG8_BAR __builtin_amdgcn_s_barrier()
#define PG8_SCHED __builtin_amdgcn_sched_barrier(0)
    Unit cur, nxt; int ui = 0;
    if (!S.next(0, cur)) return;
    f32x4 acc[2][2][4][2];
#pragma unroll
    for (int a = 0; a < 2; ++a)
#pragma unroll
        for (int b = 0; b < 2; ++b)
#pragma unroll
            for (int m = 0; m < 4; ++m)
#pragma unroll
                for (int n = 0; n < 2; ++n) acc[a][b][m][n] = (f32x4){0.f, 0.f, 0.f, 0.f};
    bf16x8 At[4][2], B0[2][2], B1[2][2];
    const char* cA = (const char*)g.A + (size_t)cur.pm * tstep; const char* cB = (const char*)g.Bt + (size_t)cur.pn * tstep;
    S.a_ready(cur);
    if constexpr (SP2) {
        PG8_STAGE(PG8_SB(0, 0), cB, voffB); PG8_STAGE(PG8_SB(0, 1), cB + hstep, voffB); PG8_STAGE(PG8_SA(0, 0), cA, voffA); PG8_STAGE(PG8_SA(0, 1), cA + hstep, voffA);
        if (wr == 1) PG8_BAR;
        PG8_WAIT_V(2); PG8_BAR;
        PG8_STAGE(PG8_SB(1, 0), cB + kstep, voffB); PG8_STAGE(PG8_SA(1, 0), cA + kstep, voffA); PG8_STAGE(PG8_SB(1, 1), cB + hstep + kstep, voffB);
        PG8_WAIT_V(6); PG8_BAR;
    } else {
        PG8_STAGE(PG8_SB(0, 0), cB, voffB); PG8_STAGE(PG8_SA(0, 0), cA, voffA); PG8_STAGE(PG8_SB(0, 1), cB + hstep, voffB); PG8_STAGE(PG8_SA(0, 1), cA + hstep, voffA);
        if (wr == 1) PG8_BAR;
        PG8_WAIT_V(4); PG8_BAR;
        PG8_STAGE(PG8_SB(1, 0), cB + kstep, voffB); PG8_STAGE(PG8_SA(1, 0), cA + kstep, voffA); PG8_STAGE(PG8_SB(1, 1), cB + hstep + kstep, voffB);
        PG8_WAIT_V(6); PG8_BAR;
    }
    for (;;) {
        const bool has_next = S.next(ui + 1, nxt);
        const char* nA = has_next ? (const char*)g.A + (size_t)nxt.pm * tstep : cA; const char* nB = has_next ? (const char*)g.Bt + (size_t)nxt.pn * tstep : cB;
        for (int t = 0; t < nt; t += 2) {
            const bool last = (t == nt - 2);
            H.at_tile(t, cur, acc, lds + STAGE_BYTES, wr, fr);
            const char* a1 = cA + (size_t)(t + 1) * kstep;
            const char* a2 = last ? nA : cA + (size_t)(t + 2) * kstep; const char* b2 = last ? nB : cB + (size_t)(t + 2) * kstep;
            const char* a3 = a2 + kstep; const char* b3 = b2 + kstep;
            if (last && has_next) S.a_ready(nxt);
            if constexpr (SP2) {
            PG8_LDB(B0, 0, 0); PG8_LDB(B1, 0, 1); PG8_SCHED; PG8_LDA(At, 0, 0); PG8_STAGE(PG8_SA(1, 1), a1 + hstep, voffA);
            PG8_WAIT_V(8); PG8_WAIT_L(0); PG8_BAR; PG8_MMA(0, 0, At, B0); PG8_MMA(0, 1, At, B1); PG8_BAR; PG8_SCHED;
            PG8_LDA(At, 0, 1); PG8_STAGE(PG8_SB(0, 0), b2, voffB); PG8_STAGE(PG8_SB(0, 1), b2 + hstep, voffB); PG8_STAGE(PG8_SA(0, 0), a2, voffA);
            PG8_WAIT_V(8); PG8_WAIT_L(0); PG8_BAR; PG8_MMA(1, 0, At, B0); PG8_MMA(1, 1, At, B1); PG8_BAR; PG8_SCHED;
            PG8_LDB(B0, 1, 0); PG8_LDB(B1, 1, 1); PG8_SCHED; PG8_LDA(At, 1, 0); PG8_STAGE(PG8_SA(0, 1), a2 + hstep, voffA);
            PG8_WAIT_V(8); PG8_WAIT_L(0); PG8_BAR; PG8_MMA(0, 0, At, B0); PG8_MMA(0, 1, At, B1); PG8_BAR; PG8_SCHED;
            PG8_LDA(At, 1, 1); PG8_STAGE(PG8_SB(1, 0), b3, voffB); PG8_STAGE(PG8_SB(1, 1), b3 + hstep, voffB); PG8_STAGE(PG8_SA(1, 0), a3, voffA);
            PG8_WAIT_V(8); PG8_WAIT_L(0); PG8_BAR; PG8_MMA(1, 0, At, B0); PG8_MMA(1, 1, At, B1); PG8_BAR; PG8_SCHED;
            } else {
            PG8_LDB(B0, 0, 0); PG8_SCHED; PG8_LDA(At, 0, 0); PG8_STAGE(PG8_SA(1, 1), a1 + hstep, voffA);
            PG8_WAIT_L(8); PG8_BAR; PG8_WAIT_L(0); PG8_MMA(0, 0, At, B0); PG8_BAR; PG8_SCHED;
            PG8_LDB(B1, 0, 1); PG8_STAGE(PG8_SB(0, 0), b2, voffB);
            PG8_BAR; PG8_WAIT_L(0); PG8_MMA(0, 1, At, B1); PG8_BAR;
            PG8_LDA(At, 0, 1); PG8_STAGE(PG8_SA(0, 0), a2, voffA);
            PG8_BAR; PG8_WAIT_L(0); PG8_MMA(1, 0, At, B0); PG8_BAR; PG8_SCHED;
            PG8_STAGE(PG8_SB(0, 1), b2 + hstep, voffB);
            PG8_WAIT_V(6); PG8_BAR; PG8_MMA(1, 1, At, B1); PG8_BAR;
            PG8_LDB(B0, 1, 0); PG8_SCHED; PG8_LDA(At, 1, 0); PG8_STAGE(PG8_SA(0, 1), a2 + hstep, voffA);
            PG8_WAIT_L(8); PG8_BAR; PG8_WAIT_L(0); PG8_MMA(0, 0, At, B0); PG8_BAR; PG8_SCHED;
            PG8_LDB(B1, 1, 1); PG8_STAGE(PG8_SB(1, 0), b3, voffB);
            PG8_BAR; PG8_WAIT_L(0); PG8_MMA(0, 1, At, B1); PG8_BAR;
            PG8_LDA(At, 1, 1); PG8_STAGE(PG8_SA(1, 0), a3, voffA);
            PG8_BAR; PG8_WAIT_L(0); PG8_MMA(1, 0, At, B0); PG8_BAR; PG8_SCHED;
            PG8_STAGE(PG8_SB(1, 1), b3 + hstep, voffB);
            PG8_WAIT_V(6); PG8_BAR; PG8_MMA(1, 1, At, B1); PG8_BAR;
            }
        }
        if constexpr (ALIGN_EPI) { if (wr == 0) PG8_BAR; }
        if constexpr (!Epi::AFTER_DRAIN) { E(acc, cur, wr, wc, fr, fq);
#ifdef PROBE_EPI2
            if constexpr (Epi::PROBE_TWICE) { asm volatile("" ::: "memory"); E(acc, cur, wr, wc, fr, fq); }
#endif
            S.done(cur); }
        if (!has_next) break;
#pragma unroll
        for (int a = 0; a < 2; ++a)
#pragma unroll
            for (int b = 0; b < 2; ++b)
#pragma unroll
                for (int m = 0; m < 4; ++m)
#pragma unroll
                    for (int n = 0; n < 2; ++n) acc[a][b][m][n] = (f32x4){0.f, 0.f, 0.f, 0.f};
        cur = nxt; cA = nA; cB = nB; ++ui;
        if constexpr (ALIGN_EPI) { if (wr == 1) PG8_BAR; }
    }
    PG8_WAIT_V(0);
    if constexpr (!ALIGN_EPI) { if (wr == 0) PG8_BAR; }
    PG8_BAR;
    if constexpr (Epi::AFTER_DRAIN) { E.fused(acc, cur, wr, wc, fr, fq, lds, wid, lane); S.done(cur); }
#undef PG8_SA
#undef PG8_SB
#undef PG8_STAGE
#undef PG8_LDA
#undef PG8_LDB
#undef PG8_MMA
#undef PG8_WAIT_V
#undef PG8_WAIT_L
#undef PG8_BAR
#undef PG8_SCHED
}
}
namespace pg8 {
struct EpiProj {
    static constexpr bool PERM = true, AFTER_DRAIN = false, PROBE_TWICE = true;
    bf16_t* O; int ldc;
    __device__ __forceinline__ void operator()(const f32x4 (&acc)[2][2][4][2], const Unit& u, int wr, int wc, int fr, int fq) const {
        const int row0 = u.pm * BM + wr * 64 + fr; const int col0 = u.pn * BM + wc * 32 + 8 * fq;
#pragma unroll
        for (int ai = 0; ai < 2; ++ai)
#pragma unroll
            for (int m = 0; m < 4; ++m) { bf16_t* rowp = O + (size_t)(row0 + ai * HALF + m * 16) * ldc + col0;
#pragma unroll
                for (int bj = 0; bj < 2; ++bj) { const f32x4 v0 = acc[ai][bj][m][0], v1 = acc[ai][bj][m][1];
                    u32x4 w; w.x = cvt_pk_bf16(v0[0], v0[1]); w.y = cvt_pk_bf16(v0[2], v0[3]); w.z = cvt_pk_bf16(v1[0], v1[1]); w.w = cvt_pk_bf16(v1[2], v1[3]);
                    __builtin_nontemporal_store(w, (u32x4*)(rowp + bj * HALF)); } }
    }
};
struct EpiX1 {
    static constexpr bool PERM = true, AFTER_DRAIN = false, PROBE_TWICE = false;
    const float* x; float* x1; bf16_t* x1s; const float* mod; const float* norm2_g; float* rowstat; PG8_LAS float* tab;
    __device__ __forceinline__ void operator()(const f32x4 (&acc)[2][2][4][2], const Unit& u, int wr, int wc, int fr, int fq) const {
        const int row0 = u.pm * BM + wr * 64 + fr; const int col0 = u.pn * BM + wc * 32 + 8 * fq; const int b = (u.pm * BM) >> 11;
        const float* mb = mod + (size_t)b * 6144;
        f32x4 g1[2][2], g2[2][2];
#pragma unroll
        for (int bj = 0; bj < 2; ++bj)
#pragma unroll
            for (int n = 0; n < 2; ++n) { const int c = col0 + bj * HALF + 4 * n; g1[bj][n] = *(const f32x4*)(mb + 2048 + c);
                const f32x4 sc = *(const f32x4*)(mb + 4096 + c), ng = *(const f32x4*)(norm2_g + c); g2[bj][n] = ng * (sc + 1.0f); }
#pragma unroll
        for (int ai = 0; ai < 2; ++ai)
#pragma unroll
            for (int m = 0; m < 4; ++m) { const size_t row = (size_t)(row0 + ai * HALF + m * 16); const size_t off = row * 1024 + col0; float ss = 0.f;
                const float rfin = tab[((u.pm >> 3) & 1) * 1280 + 1024 + ai * HALF + wr * 64 + m * 16 + fr];
#pragma unroll
                for (int bj = 0; bj < 2; ++bj) {
                    const f32x4 xa = *(const f32x4*)(x + off + bj * HALF), xb = *(const f32x4*)(x + off + bj * HALF + 4);
                    const f32x4 v0 = xa + g1[bj][0] * (acc[ai][bj][m][0] * rfin), v1 = xb + g1[bj][1] * (acc[ai][bj][m][1] * rfin);
                    *(f32x4*)(x1 + off + bj * HALF) = v0; *(f32x4*)(x1 + off + bj * HALF + 4) = v1;
                    ss += (v0[0] * v0[0] + v0[1] * v0[1]) + (v0[2] * v0[2] + v0[3] * v0[3]) + (v1[0] * v1[0] + v1[1] * v1[1]) + (v1[2] * v1[2] + v1[3] * v1[3]);
                    const f32x4 s0 = v0 * g2[bj][0], s1 = v1 * g2[bj][1];
                    u32x4 w; w.x = cvt_pk_bf16(s0[0], s0[1]); w.y = cvt_pk_bf16(s0[2], s0[3]); w.z = cvt_pk_bf16(s1[0], s1[1]); w.w = cvt_pk_bf16(s1[2], s1[3]);
                    *(u32x4*)(x1s + off + bj * HALF) = w; }
                ss += __shfl_xor(ss, 16); ss += __shfl_xor(ss, 32);
                if (fq == 0) atomicAdd(rowstat + row, ss); }
    }
};
typedef _Float16 f16x8 __attribute__((ext_vector_type(8)));
struct EpiScores {
    static constexpr bool PERM = true, AFTER_DRAIN = false, PROBE_TWICE = false;
    _Float16* S; const float* sb; const float* rowstat;
    __device__ __forceinline__ void operator()(const f32x4 (&acc)[2][2][4][2], const Unit& u, int wr, int wc, int fr, int fq) const {
        const int row0 = u.pm * BM + wr * 64 + fr; const int col0 = u.pn * BM + wc * 32 + 8 * fq; const int b = (u.pm * BM) >> 11;
        f32x4 bv[2][2];
#pragma unroll
        for (int bj = 0; bj < 2; ++bj)
#pragma unroll
            for (int n = 0; n < 2; ++n) bv[bj][n] = *(const f32x4*)(sb + (size_t)b * 2048 + col0 + bj * HALF + 4 * n);
#pragma unroll
        for (int ai = 0; ai < 2; ++ai)
#pragma unroll
            for (int m = 0; m < 4; ++m) { const size_t row = (size_t)(row0 + ai * HALF + m * 16); const float rs = __builtin_amdgcn_rsqf(rowstat[row] * (1.0f / 1024.0f) + 1e-6f);
                _Float16* rowp = S + row * 2048 + col0;
#pragma unroll
                for (int bj = 0; bj < 2; ++bj) { const f32x4 v0 = acc[ai][bj][m][0] * rs + bv[bj][0], v1 = acc[ai][bj][m][1] * rs + bv[bj][1];
                    f16x8 h; h[0] = (_Float16)v0[0]; h[1] = (_Float16)v0[1]; h[2] = (_Float16)v0[2]; h[3] = (_Float16)v0[3]; h[4] = (_Float16)v1[0]; h[5] = (_Float16)v1[1]; h[6] = (_Float16)v1[2]; h[7] = (_Float16)v1[3];
                    *(f16x8*)(rowp + bj * HALF) = h; } }
    }
};
struct SegScaleHook {
    __device__ __forceinline__ static void build(PG8_LAS unsigned char* ldsx, const Unit& u, const float* st_ssd, const float* st_s5, int tid) {
        PG8_LAS float* tab = (PG8_LAS float*)ldsx + ((u.pm >> 3) & 1) * 1280;
        if (tid < 256) { const size_t row = (size_t)u.pm * BM + tid; const f32x4* sg = (const f32x4*)(st_ssd + row * 16); const f32x4* s5 = (const f32x4*)(st_s5 + row * 64);
            float r[5];
#pragma unroll
            for (int gI = 0; gI < 4; ++gI) { const f32x4 v = sg[gI]; r[gI] = __builtin_amdgcn_rsqf(((v[0] + v[1]) + (v[2] + v[3])) * (1.0f / 256.0f) + 1e-6f); }
            float a5 = 0.f;
#pragma unroll
            for (int q = 0; q < 16; ++q) { const f32x4 v = s5[q]; a5 += (v[0] + v[1]) + (v[2] + v[3]); }
            r[4] = __builtin_amdgcn_rsqf(a5 * (1.0f / 1024.0f) + 1e-6f);
#pragma unroll
            for (int k = 0; k < 4; ++k) tab[k * 256 + tid] = r[k] * __builtin_amdgcn_rcpf(r[k + 1]);
            tab[1024 + tid] = r[4]; }
    }
    __device__ __forceinline__ void at_tile(int t, const Unit& u, f32x4 (&acc)[2][2][4][2], PG8_LAS unsigned char* ldsx, int wr, int fr) const {
        if (t == 4 || t == 8 || t == 12 || t == 16) { const PG8_LAS float* rt = (const PG8_LAS float*)ldsx + ((u.pm >> 3) & 1) * 1280 + ((t >> 2) - 1) * 256 + wr * 64 + fr;
#pragma unroll
            for (int ai = 0; ai < 2; ++ai)
#pragma unroll
                for (int m = 0; m < 4; ++m) { const float r = rt[ai * HALF + m * 16];
#pragma unroll
                    for (int bj = 0; bj < 2; ++bj) { acc[ai][bj][m][0] = acc[ai][bj][m][0] * r; acc[ai][bj][m][1] = acc[ai][bj][m][1] * r; } } }
    }
};
}
constexpr int NWAVES = 8, NTHR = 512;
constexpr int DM = 1024, NB = 16, SEQ = 2048, MTOK = NB * SEQ;
constexpr int NPROJ = 4096;
constexpr int INW = 4112;
constexpr int NHEADS = 16, HDIM = 64, NGRP = 4, NST = 128, CHUNK = 128;
constexpr int S5G = 64, S5CH = 16, S5P = 64;
constexpr int PH = 8, PK = 16, PNK = 128;
constexpr float EPSF = 1e-6f;
constexpr int NS5PART = 64;

constexpr size_t MiB = 1u << 20;
constexpr size_t WS_CTL = 0, CTL_ZERO_BYTES = 64 * 1024;
constexpr size_t WS_MOD = 1 * MiB;
constexpr size_t WS_WDT = WS_MOD + 0x60000;
constexpr size_t WS_SB = WS_MOD + 0x70000;
constexpr size_t WS_ROWSTAT = WS_MOD + 0x90000;
constexpr size_t WS_S5LB = WS_MOD + 0xB0000;
constexpr size_t WS_S5BB = WS_MOD + 0xC0000;
constexpr size_t WS_DTRAW = 3 * MiB;
constexpr size_t WS_STSSD = 5 * MiB;
constexpr size_t WS_STS5 = 7 * MiB;
constexpr size_t WS_WINT = 15 * MiB;
constexpr size_t WS_WOUTT = 23 * MiB;
constexpr size_t WS_WQKT = 27 * MiB;
constexpr size_t WS_EU = 31 * MiB, WS_EV = 47 * MiB;
constexpr size_t WS_EUS = 63 * MiB, WS_EVS = 63 * MiB + 65536;
constexpr size_t WS_START = 64 * MiB;
constexpr size_t WS_A = 95 * MiB;
constexpr size_t WS_B = 223 * MiB;
constexpr size_t WS_H1 = WS_A, WS_Y = WS_A, WS_PROJ = WS_B, WS_SCORES = WS_A;
constexpr size_t WS_X1S = WS_B + 192 * MiB;
constexpr size_t WS_EID = 479 * MiB, WS_GATE = 495 * MiB;
constexpr size_t WS_H2Q = WS_B, WS_HINV = WS_B + 32 * MiB;
constexpr size_t WS_END = 511 * MiB;
static_assert(WS_SCORES + (size_t)MTOK * 2048 * 4 <= WS_X1S && WS_X1S + (size_t)MTOK * 1024 * 2 <= WS_EID && WS_GATE + (size_t)MTOK * 128 * 4 <= WS_END, "ws map");

constexpr int LDS_MAIN = 159744;
constexpr int MISC_OFF = LDS_MAIN;
constexpr int LDS_BYTES = LDS_MAIN + 128;

#define GAS __attribute__((address_space(1)))
#define LAS __attribute__((address_space(3)))
typedef unsigned short bf16;
typedef unsigned v4u __attribute__((ext_vector_type(4)));
typedef unsigned v2u __attribute__((ext_vector_type(2)));
typedef float f32x4 __attribute__((ext_vector_type(4)));
typedef float f32x2 __attribute__((ext_vector_type(2)));
typedef short bf16x8 __attribute__((ext_vector_type(8)));
#define LDS_WAIT() asm volatile("s_waitcnt lgkmcnt(0)" ::: "memory")
#define VM_WAIT() asm volatile("s_waitcnt vmcnt(0)" ::: "memory")
typedef __bf16 hwbf16x2 __attribute__((ext_vector_type(2)));
__device__ __forceinline__ unsigned pk2(float lo, float hi) { const f32x2 v = {lo, hi}; const hwbf16x2 b = __builtin_convertvector(v, hwbf16x2); return __builtin_bit_cast(unsigned, b); }
__device__ __forceinline__ unsigned f2bf(float f) { return pk2(f, 0.f) & 0xffffu; }
__device__ __forceinline__ float bflo(unsigned w) { return __builtin_bit_cast(float, w << 16); }
__device__ __forceinline__ float bfhi(unsigned w) { return __builtin_bit_cast(float, w & 0xffff0000u); }
__device__ __forceinline__ float bf2f(bf16 v) { return __builtin_bit_cast(float, (unsigned)v << 16); }
__device__ __forceinline__ float wave_sum(float v) {
#pragma unroll
    for (int o = 1; o < 64; o <<= 1) v += __shfl_xor(v, o);
    return v;
}
__device__ __forceinline__ float sigmoid_f(float v) { return __builtin_amdgcn_rcpf(1.0f + __builtin_amdgcn_exp2f(-1.4426950408889634f * v)); }
__device__ __forceinline__ float silu_f(float v) { return v * sigmoid_f(v); }
__device__ __forceinline__ float rsqrt_f(float v) { return __builtin_amdgcn_rsqf(v); }
__device__ __forceinline__ float gelu_erf(float v) {
    const float av = fabsf(v), t = __builtin_amdgcn_rcpf(av * 0.2316418882f + 1.0f);
    float q = t * 0.5307027145f + (-0.7265760135f); q = q * t + 0.7107068705f; q = q * t + (-0.142248368f); q = q * t + 0.127414796f; q = q * t;
    const float e = __builtin_amdgcn_exp2f((v * v) * (-0.72134752044f));
    const float m = v * (q * e);
    return v < 0.f ? m : v - m;
}
__device__ __forceinline__ float softplus_f(float v) { const float e = __builtin_amdgcn_exp2f(-1.4426950408889634f * fabsf(v));
    const float l = e < 1e-6f ? e : 0.6931471805599453f * __builtin_amdgcn_logf(1.0f + e); return fmaxf(v, 0.f) + l; }
__device__ __forceinline__ void unpack8(const v4u w, float* f) { f[0] = bflo(w.x); f[1] = bfhi(w.x); f[2] = bflo(w.y); f[3] = bfhi(w.y); f[4] = bflo(w.z); f[5] = bfhi(w.z); f[6] = bflo(w.w); f[7] = bfhi(w.w); }
#define LDS_BARRIER() do { asm volatile("s_waitcnt lgkmcnt(0)" ::: "memory"); __builtin_amdgcn_s_barrier(); asm volatile("" ::: "memory"); } while (0)
__device__ __forceinline__ float row16_sum_to15(float v) {
    v += __builtin_bit_cast(float, __builtin_amdgcn_update_dpp(0, __builtin_bit_cast(int, v), 0x118, 0xf, 0xf, true));
    v += __builtin_bit_cast(float, __builtin_amdgcn_update_dpp(0, __builtin_bit_cast(int, v), 0x114, 0xf, 0xf, true));
    v += __builtin_bit_cast(float, __builtin_amdgcn_update_dpp(0, __builtin_bit_cast(int, v), 0x112, 0xf, 0xf, true));
    v += __builtin_bit_cast(float, __builtin_amdgcn_update_dpp(0, __builtin_bit_cast(int, v), 0x111, 0xf, 0xf, true));
    return v;
}
__device__ __forceinline__ float wave_sum_to63(float v) {
    v = row16_sum_to15(v);
    v += __builtin_bit_cast(float, __builtin_amdgcn_update_dpp(0, __builtin_bit_cast(int, v), 0x142, 0xa, 0xf, false));
    v += __builtin_bit_cast(float, __builtin_amdgcn_update_dpp(0, __builtin_bit_cast(int, v), 0x143, 0xc, 0xf, false));
    return v;
}
__device__ __forceinline__ f32x2 gelu_pk2(f32x2 v) {
    const f32x2 av = __builtin_elementwise_abs(v), d = av * 0.2316418882f + 1.0f;
    f32x2 t; t[0] = __builtin_amdgcn_rcpf(d[0]); t[1] = __builtin_amdgcn_rcpf(d[1]);
    f32x2 q = t * 0.5307027145f + (-0.7265760135f); q = q * t + 0.7107068705f; q = q * t + (-0.142248368f); q = q * t + 0.127414796f; q = q * t;
    const f32x2 s = (v * v) * (-0.72134752044f);
    f32x2 e; e[0] = __builtin_amdgcn_exp2f(s[0]); e[1] = __builtin_amdgcn_exp2f(s[1]);
    const f32x2 m = v * (q * e), r = v - m;
    f32x2 o; o[0] = v[0] < 0.f ? m[0] : r[0]; o[1] = v[1] < 0.f ? m[1] : r[1]; return o;
}
#define XB_TMO      128
#define XB_XCNT(j)  (256  + 64 * (j))
#define XB_XSUB(j)  (1280 + 64 * (j))
#define XB_XGEN(j)  (2304 + 64 * (j))
#define XB_TOP      3328
#define XB_TOPGEN   3392
#define XCD_BAR_WORDS 3456
#define XB_SPIN_CAP (1u << 18)

__device__ __forceinline__ unsigned xb_ld(unsigned* p)              { return __hip_atomic_load(p, __ATOMIC_RELAXED, __HIP_MEMORY_SCOPE_AGENT); }
__device__ __forceinline__ unsigned xb_add(unsigned* p, unsigned v) { return __hip_atomic_fetch_add(p, v, __ATOMIC_RELAXED, __HIP_MEMORY_SCOPE_AGENT); }
__device__ __forceinline__ unsigned xb_xcc_id() { return (unsigned)__builtin_amdgcn_s_getreg((3 << 11) | 20) & 0xFu; }
#define XB_SPIN(cond, bar) do { unsigned _sp = 0; while (cond) { __builtin_amdgcn_s_sleep(1); \
    if ((++_sp & 255u) == 0u) { if (xb_ld(&(bar)[XB_TMO])) break; if (_sp > XB_SPIN_CAP) { atomicAdd(&(bar)[XB_TMO], 1u); break; } } } } while (0)

struct XcdBarrier {
    unsigned* bar; unsigned x;
    volatile LAS unsigned* st;
};

__device__ __forceinline__ XcdBarrier xcd_barrier_post(unsigned* bar, volatile LAS unsigned* st) {
    XcdBarrier b; b.bar = bar; b.x = xb_xcc_id(); b.st = st;
    if (threadIdx.x == 0) (void)xb_add(&bar[XB_XCNT(b.x)], 1u);
    return b;
}
__device__ __forceinline__ void xcd_barrier_complete(unsigned* bar, unsigned x, unsigned& nloc, unsigned& nx) {
    const unsigned G = gridDim.x * gridDim.y * gridDim.z;
    unsigned sum, cnt, mine, sp = 0u;
    for (;;) {
        sum = 0u; cnt = 0u; mine = 0u;
#pragma unroll
        for (unsigned j = 0; j < 16; ++j) { const unsigned c = xb_ld(&bar[XB_XCNT(j)]); sum += c; cnt += (c > 0u) ? 1u : 0u; mine = (j == x) ? c : mine; }
        if (sum == G) break;
        __builtin_amdgcn_s_sleep(1);
        if ((++sp & 255u) == 0u) { if (xb_ld(&bar[XB_TMO])) break; if (sp > XB_SPIN_CAP) { atomicAdd(&bar[XB_TMO], 1u); break; } }
    }
    nloc = mine > 0u ? mine : 1u; nx = cnt > 0u ? cnt : 1u;
}

__device__ __forceinline__ void xcd_barrier(const XcdBarrier& b) {
    asm volatile("s_waitcnt vmcnt(0)" ::: "memory");
    __syncthreads();
    if (threadIdx.x == 0) {
        unsigned* bar = b.bar;
        __builtin_amdgcn_s_waitcnt(0);
        unsigned nloc = b.st[0], nx = b.st[1];
        if (nloc == 0u) { xcd_barrier_complete(bar, b.x, nloc, nx); b.st[0] = nloc; b.st[1] = nx; }
        const unsigned old = xb_add(&bar[XB_XSUB(b.x)], 1u);
        const unsigned gen = old / nloc;
        if (old + 1u == (gen + 1u) * nloc) {
            __builtin_amdgcn_fence(__ATOMIC_RELEASE, "agent");
            asm volatile("s_waitcnt vmcnt(0)" ::: "memory");
            const unsigned og = xb_add(&bar[XB_TOP], 1u);
            const unsigned tg = og / nx;
            if (og + 1u == (tg + 1u) * nx) xb_add(&bar[XB_TOPGEN], 1u);
            else XB_SPIN(xb_ld(&bar[XB_TOPGEN]) == tg, bar);
            __builtin_amdgcn_fence(__ATOMIC_ACQUIRE, "agent");
            xb_add(&bar[XB_XGEN(b.x)], 1u);
            asm volatile("s_waitcnt vmcnt(0)" ::: "memory");
        } else {
            XB_SPIN(xb_ld(&bar[XB_XGEN(b.x)]) == gen, bar);
            __builtin_amdgcn_fence(__ATOMIC_ACQUIRE, "agent");
            asm volatile("s_waitcnt vmcnt(0)" ::: "memory");
        }
    }
    __syncthreads();
}
struct Args { const float* in[30]; float* out; unsigned char* ws; int ph_lo, ph_hi; };
struct Frame {
    LAS unsigned char* lds;
    volatile LAS unsigned* MISC;
    int vcu, G;
    unsigned char* ws;
    const Args* a;
    float* out;
};
#define WSP(T, off) ((T*)(F.ws + (off)))

__device__ __forceinline__ void transpose_tile(const float* W, int ldw, int k0, int src_n0, bf16* WT, int K, int dst_n0, LAS float* scr, int lane, const float* kscale) {
#pragma unroll 8
    for (int i = 0; i < 32; ++i) { const int kk = 2 * i + (lane >> 5); float v = W[(size_t)(k0 + kk) * ldw + src_n0 + (lane & 31)]; if (kscale) v *= kscale[k0 + kk]; scr[kk * 33 + (lane & 31)] = v; }
    LDS_WAIT(); asm volatile("" ::: "memory");
    const int c = lane & 7;
#pragma unroll
    for (int j = 0; j < 4; ++j) { const int n = (lane >> 3) + 8 * j; const LAS float* s = scr + (8 * c) * 33 + n;
        v4u o; o.x = pk2(s[0 * 33], s[1 * 33]); o.y = pk2(s[2 * 33], s[3 * 33]); o.z = pk2(s[4 * 33], s[5 * 33]); o.w = pk2(s[6 * 33], s[7 * 33]);
        *(v4u*)(WT + (size_t)(dst_n0 + n) * K + k0 + 8 * c) = o; }
    LDS_WAIT(); asm volatile("" ::: "memory");
}
__device__ __forceinline__ void p0_phase(Frame& F) {
    const int f_tid = threadIdx.x, f_lane = f_tid & 63, f_wave = __builtin_amdgcn_readfirstlane(f_tid >> 6);
    const int gw = F.vcu * NWAVES + f_wave, NGW = F.G * NWAVES, gt = F.vcu * NTHR + f_tid, NGT = F.G * NTHR;
    {
        LAS float* sc = (LAS float*)F.lds;
        LAS float* red = (LAS float*)(F.lds + 65536);
        for (int i = f_tid; i < 16 * 1024; i += NTHR) { const int b = i >> 10, k = i & 1023; sc[k * 16 + b] = silu_f((F.a->in[1])[i]); }
        __syncthreads();
        const int ks = f_tid / 24, col = f_tid - ks * 24, j = F.vcu * 24 + col;
        if (ks < 21) {
            float acc[16];
#pragma unroll
            for (int b = 0; b < 16; ++b) acc[b] = 0.f;
            const int k0 = ks * 49, kn = (k0 + 49 <= 1024) ? 49 : (1024 - k0);
            const float* wp = (F.a->in[2]) + (size_t)k0 * 6144 + j;
#pragma unroll 1
            for (int kb = 0; kb < 49; kb += 7) {
                asm volatile("" ::: "memory");
                float wv[7];
#pragma unroll
                for (int u = 0; u < 7; ++u) wv[u] = (kb + u < kn) ? wp[(size_t)(kb + u) * 6144] : 0.f;
#pragma unroll
                for (int u = 0; u < 7; ++u) { const int kk = (kb + u < kn) ? (k0 + kb + u) : k0; const LAS f32x4* s4 = (const LAS f32x4*)(sc + kk * 16);
#pragma unroll
                    for (int q = 0; q < 4; ++q) { const f32x4 sv = s4[q]; acc[4 * q] += sv[0] * wv[u]; acc[4 * q + 1] += sv[1] * wv[u]; acc[4 * q + 2] += sv[2] * wv[u]; acc[4 * q + 3] += sv[3] * wv[u]; } }
            }
#pragma unroll
            for (int b = 0; b < 16; ++b) red[(ks * 16 + b) * 24 + col] = acc[b];
        }
        __syncthreads();
        for (int i = f_tid; i < 16 * 24; i += NTHR) { const int b = i / 24, cc = i - b * 24; float sacc = 0.f;
            for (int q = 0; q < 21; ++q) sacc += red[(q * 16 + b) * 24 + cc];
            WSP(float, WS_MOD)[b * 6144 + F.vcu * 24 + cc] = sacc + (F.a->in[3])[F.vcu * 24 + cc]; }
        __syncthreads();
    }
    {
        LAS float* scr = (LAS float*)(F.lds + f_wave * 16384);
        constexpr int I_IN = (1024 / 64) * (NPROJ / 32), I_OUT = (2048 / 64) * (1024 / 32);
        for (int it = gw; it < I_IN + I_OUT; it += NGW) {
            if (it < I_IN) { const int kb = it / (NPROJ / 32), nb = it % (NPROJ / 32); const int dn = 32 * nb, sn = dn < 3072 ? dn : dn + 16;
                transpose_tile((F.a->in[5]), INW, 64 * kb, sn, WSP(bf16, WS_WINT), 1024, dn, scr, f_lane, nullptr); }
            else { const int r = it - I_IN, kb = r / 32, nb = r % 32; const int k0 = 64 * kb;
                transpose_tile((F.a->in[23]), 1024, k0, 32 * nb, WSP(bf16, WS_WOUTT), 2048, 32 * nb, scr, f_lane, k0 < 1024 ? (F.a->in[11]) : (F.a->in[22]) - 1024); }
        }
    }
    for (int i = gt; i < 16 * 1024; i += NGT) { const int h = i >> 10, k = i & 1023; WSP(float, WS_WDT)[i] = (F.a->in[5])[(size_t)k * INW + 3072 + h]; }
    for (int task = gw; task < 2048; task += NGW) {
        const int nt = task >> 4, ks = task & 15, n0 = 16 * nt, hc = n0 >> 7, k0 = 64 * ks;
        const int li = f_lane & 15, lq = f_lane >> 4;
        f32x4 acc[4];
#pragma unroll
        for (int s = 0; s < 4; ++s) acc[s] = (f32x4){0.f, 0.f, 0.f, 0.f};
        const float* ap = (F.a->in[26]) + (size_t)(n0 + li) * 128 + 4 * lq;
        const float* bp = (F.a->in[25]) + (size_t)(k0 + li) * 2048 + hc * 128 + 4 * lq;
#pragma unroll
        for (int q = 0; q < 8; ++q) { const f32x4 a = *(const f32x4*)(ap + 16 * q);
#pragma unroll
            for (int s = 0; s < 4; ++s) { const f32x4 b = *(const f32x4*)(bp + (size_t)(16 * s) * 2048 + 16 * q);
#pragma unroll
                for (int jj = 0; jj < 4; ++jj) acc[s] = __builtin_amdgcn_mfma_f32_16x16x4f32(a[jj], b[jj], acc[s], 0, 0, 0); } }
        bf16* o = WSP(bf16, WS_WQKT);
#pragma unroll
        for (int s = 0; s < 4; ++s)
#pragma unroll
            for (int r = 0; r < 4; ++r) o[(size_t)(n0 + 4 * lq + r) * 1024 + k0 + 16 * s + li] = (bf16)f2bf(acc[s][r]);
    }
    for (int i = gt; i < S5G * S5P; i += NGT) {
        const float lr = (F.a->in[12])[i], li = (F.a->in[13])[i], dt = expf((F.a->in[14])[i >> 6]);
        const float mag = expf(lr * dt); float sn, cs; sincosf(li * dt, &sn, &cs);
        const float lbr = mag * cs, lbi = mag * sn, den = lr * lr + li * li;
        const float cfr = ((lbr - 1.0f) * lr + lbi * li) / den, cfi = (lbi * lr - (lbr - 1.0f) * li) / den;
        WSP(float, WS_S5LB)[2 * i] = lbr; WSP(float, WS_S5LB)[2 * i + 1] = lbi;
        for (int hh = 0; hh < 16; ++hh) { const float br = (F.a->in[15])[i * 16 + hh], bi = (F.a->in[16])[i * 16 + hh];
            WSP(float, WS_S5BB)[i * 32 + hh] = cfr * br - cfi * bi; WSP(float, WS_S5BB)[i * 32 + 16 + hh] = cfr * bi + cfi * br; }
    }
    for (int i = gt; i < MTOK; i += NGT) WSP(float, WS_ROWSTAT)[i] = 0.f;
}

__device__ __forceinline__ void p1_phase(Frame& F) {
    const int f_tid = threadIdx.x, f_lane = f_tid & 63, f_wave = __builtin_amdgcn_readfirstlane(f_tid >> 6);
    const int gw = F.vcu * NWAVES + f_wave;
    LAS float* wdt = (LAS float*)F.lds;
    for (int i = f_tid; i < 16 * 1024 / 4; i += NTHR) ((LAS f32x4*)wdt)[i] = ((const f32x4*)WSP(float, WS_WDT))[i];
    __syncthreads();
    const int lane = f_lane;
    for (int wq = gw; wq < MTOK / 16; wq += F.G * NWAVES) {
        const int b = wq >> 7; const float* mb = WSP(float, WS_MOD) + (size_t)b * 6144;
        f32x4 Gv[4], Sv[4];
#pragma unroll
        for (int j = 0; j < 4; ++j) { const int k = 4 * lane + 256 * j; const f32x4 g = *(const f32x4*)((F.a->in[4]) + k), sc = *(const f32x4*)(mb + 1024 + k); Gv[j] = g * (sc + 1.0f); Sv[j] = *(const f32x4*)(mb + k); }
        f32x4 nx[4];
#pragma unroll
        for (int j = 0; j < 4; ++j) nx[j] = *(const f32x4*)((F.a->in[0]) + (size_t)wq * 16 * 1024 + 4 * lane + 256 * j);
        for (int tt = 0; tt < 16; ++tt) {
            asm volatile("" ::: "memory");
            const size_t t = (size_t)wq * 16 + tt; const float* xr = (F.a->in[0]) + t * 1024;
            f32x4 v[4]; float ss = 0.f;
#pragma unroll
            for (int j = 0; j < 4; ++j) { v[j] = nx[j]; ss += (v[j][0] * v[j][0] + v[j][1] * v[j][1]) + (v[j][2] * v[j][2] + v[j][3] * v[j][3]); }
            if (tt < 15) {
#pragma unroll
                for (int j = 0; j < 4; ++j) nx[j] = *(const f32x4*)(xr + 1024 + 4 * lane + 256 * j); }
            const float rstd = rsqrt_f(wave_sum(ss) * (1.0f / 1024.0f) + EPSF);
            bf16* hr = WSP(bf16, WS_H1) + t * 1024;
#pragma unroll
            for (int j = 0; j < 4; ++j) { v[j] = v[j] * rstd * Gv[j] + Sv[j]; v2u w; w.x = pk2(v[j][0], v[j][1]); w.y = pk2(v[j][2], v[j][3]); *(v2u*)(hr + 4 * lane + 256 * j) = w; }
            float d[16];
#pragma unroll
            for (int h = 0; h < 16; ++h) { float a = 0.f;
#pragma unroll
                for (int j = 0; j < 4; ++j) { const f32x4 w = *(const LAS f32x4*)(wdt + h * 1024 + 4 * lane + 256 * j); a += (v[j][0] * w[0] + v[j][1] * w[1]) + (v[j][2] * w[2] + v[j][3] * w[3]); }
                d[h] = a; }
            float e8[8], e4[4], e2[2], e1;
#pragma unroll
            for (int i = 0; i < 8; ++i) { const bool up = lane & 32; const float snd = up ? d[i] : d[i + 8]; const float rcv = __shfl_xor(snd, 32); e8[i] = (up ? d[i + 8] : d[i]) + rcv; }
#pragma unroll
            for (int i = 0; i < 4; ++i) { const bool up = lane & 16; const float snd = up ? e8[i] : e8[i + 4]; const float rcv = __shfl_xor(snd, 16); e4[i] = (up ? e8[i + 4] : e8[i]) + rcv; }
#pragma unroll
            for (int i = 0; i < 2; ++i) { const bool up = lane & 8; const float snd = up ? e4[i] : e4[i + 2]; const float rcv = __shfl_xor(snd, 8); e2[i] = (up ? e4[i + 2] : e4[i]) + rcv; }
            { const bool up = lane & 4; const float snd = up ? e2[0] : e2[1]; const float rcv = __shfl_xor(snd, 4); e1 = (up ? e2[1] : e2[0]) + rcv; }
            e1 += __shfl_xor(e1, 2); e1 += __shfl_xor(e1, 1);
            const int head = ((lane >> 5) & 1) * 8 + ((lane >> 4) & 1) * 4 + ((lane >> 3) & 1) * 2 + ((lane >> 2) & 1);
            if ((lane & 3) == 0) WSP(float, WS_DTRAW)[t * 16 + head] = e1;
        }
    }
    for (int n = gw; n < 2048; n += F.G * NWAVES) {
        const bf16* wr = WSP(bf16, WS_WQKT) + (size_t)n * 1024 + 16 * lane;
        const v4u w0 = *(const v4u*)wr, w1 = *(const v4u*)(wr + 8);
        float wv[16]; wv[0] = bflo(w0.x); wv[1] = bfhi(w0.x); wv[2] = bflo(w0.y); wv[3] = bfhi(w0.y); wv[4] = bflo(w0.z); wv[5] = bfhi(w0.z); wv[6] = bflo(w0.w); wv[7] = bfhi(w0.w);
        wv[8] = bflo(w1.x); wv[9] = bfhi(w1.x); wv[10] = bflo(w1.y); wv[11] = bfhi(w1.y); wv[12] = bflo(w1.z); wv[13] = bfhi(w1.z); wv[14] = bflo(w1.w); wv[15] = bfhi(w1.w);
        for (int b = 0; b < 16; ++b) { const float* sp = WSP(float, WS_MOD) + (size_t)b * 6144 + 3072 + 16 * lane; float a = 0.f;
#pragma unroll
            for (int q = 0; q < 4; ++q) { const f32x4 s = *(const f32x4*)(sp + 4 * q); a += (s[0] * wv[4 * q] + s[1] * wv[4 * q + 1]) + (s[2] * wv[4 * q + 2] + s[3] * wv[4 * q + 3]); }
            a = wave_sum(a); if (lane == 0) WSP(float, WS_SB)[b * 2048 + n] = a; }
    }
}
__device__ __forceinline__ void p3pre_conv(Frame& F) {
    const int tid = threadIdx.x;
    const bf16* proj = WSP(bf16, WS_PROJ); bf16* xo = (bf16*)F.out;
    for (int item = F.vcu * NTHR + tid; item < (MTOK / 16) * 256; item += F.G * NTHR) {
        const int oc = item & 255, run = item >> 8; const int t0 = run * 16, ch = 8 * oc;
        const bool halo = (t0 & (SEQ - 1)) != 0;
        v4u rw[19];
#pragma unroll
        for (int k = 0; k < 19; ++k) { rw[k] = (v4u){0u, 0u, 0u, 0u}; if (k >= 3 || halo) rw[k] = *(const v4u*)(proj + (size_t)(t0 - 3 + k) * NPROJ + 1024 + ch); }
        float cw[4][8], cbv[8];
#pragma unroll
        for (int k = 0; k < 4; ++k) { const f32x4 w0 = *(const f32x4*)((F.a->in[6]) + k * 2048 + ch), w1 = *(const f32x4*)((F.a->in[6]) + k * 2048 + ch + 4);
#pragma unroll
            for (int e = 0; e < 4; ++e) { cw[k][e] = w0[e]; cw[k][4 + e] = w1[e]; } }
        { const f32x4 b0 = *(const f32x4*)((F.a->in[7]) + ch), b1 = *(const f32x4*)((F.a->in[7]) + ch + 4);
#pragma unroll
            for (int e = 0; e < 4; ++e) { cbv[e] = b0[e]; cbv[4 + e] = b1[e]; } }
        float r0[8], r1[8], r2[8];
        unpack8(rw[0], r0); unpack8(rw[1], r1); unpack8(rw[2], r2);
#pragma unroll
        for (int tt = 0; tt < 16; ++tt) {
            float r3[8]; unpack8(rw[3 + tt], r3);
            float v[8];
#pragma unroll
            for (int i = 0; i < 8; ++i) { v[i] = silu_f(cbv[i] + r0[i] * cw[0][i] + r1[i] * cw[1][i] + r2[i] * cw[2][i] + r3[i] * cw[3][i]); r0[i] = r1[i]; r1[i] = r2[i]; r2[i] = r3[i]; }
            *(v4u*)(xo + (size_t)(t0 + tt) * 2048 + ch) = (v4u){pk2(v[0], v[1]), pk2(v[2], v[3]), pk2(v[4], v[5]), pk2(v[6], v[7])};
        }
    }
}
constexpr int SSD_PITCH = 272;
__device__ __forceinline__ bf16x8 lds_frag(LAS unsigned char* base, int row, int kbyte) { return *(const LAS bf16x8*)(base + row * SSD_PITCH + kbyte); }
#ifdef PROBE_SSD
#define SPR_T(v) const unsigned long long v = __builtin_amdgcn_s_memtime();
#define SPR_ACC(i, d) sacc[i] += (d);
#else
#define SPR_T(v)
#define SPR_ACC(i, d)
#endif
constexpr int S3_CS = 0, S3_BS = 34816, S3_GY = 69632, S3_XDT = 104448, S3_XP = 144, S3_PREV = 122880, S3_CSF = 140288, S3_DTF = 141312, S3_WTS = 142336, S3_END = 143360;
static_assert(S3_END <= LDS_MAIN, "SSD v3 LDS map");
typedef short v4i16_t __attribute__((ext_vector_type(4)));
__device__ __forceinline__ bf16x8 lds_frag_tr(LAS unsigned char* tile, int pitch, int k0, int col0, int li, int lq) {
    LAS unsigned char* p = tile + (k0 + 8 * lq + (li >> 2)) * pitch + (col0 + 4 * (li & 3)) * 2;
    const v4i16_t lo = __builtin_amdgcn_ds_read_tr16_b64_v4i16((LAS v4i16_t*)p), hi = __builtin_amdgcn_ds_read_tr16_b64_v4i16((LAS v4i16_t*)(p + 4 * pitch));
    return __builtin_shufflevector(lo, hi, 0, 1, 2, 3, 4, 5, 6, 7);
}
struct Ssd3Pre { v4u xr[4], br[4], cr[4]; float d0, d1; };
__device__ __forceinline__ void ssd3_prefetch(Ssd3Pre& P, const char* xcb, const float* dtr, unsigned voB, unsigned voX, int tid, int lane, int w) {
#pragma unroll
    for (int r = 0; r < 4; ++r) { P.br[r] = *(const v4u*)(xcb + (voB + r * 4096u)); P.cr[r] = *(const v4u*)(xcb + (voB + 1024u + r * 4096u)); }
#pragma unroll
    for (int r = 0; r < 4; ++r) P.xr[r] = *(const v4u*)(xcb + (voX + r * 4096u));
    P.d0 = dtr[lane * 32]; P.d1 = dtr[lane * 32 + 16];
}
__device__ __forceinline__ void ssd3_cumsum(LAS unsigned char* L, int par, float r0, float r1, float dtb, float A, int lane) {
    LAS float* csf = (LAS float*)(L + S3_CSF + par * 512); LAS float* dtf = (LAS float*)(L + S3_DTF + par * 512); LAS float* wts = (LAS float*)(L + S3_WTS + par * 512);
    const float d0 = softplus_f(r0 + dtb), d1 = softplus_f(r1 + dtb);
    const float a0 = d0 * A, a1 = d1 * A; float s = a0 + a1;
#pragma unroll
    for (int o = 1; o < 64; o <<= 1) { const float t = __shfl_up(s, o); if (lane >= o) s += t; }
    const float tot = __shfl(s, 63);
    dtf[2 * lane] = d0; dtf[2 * lane + 1] = d1; csf[2 * lane] = s - a1; csf[2 * lane + 1] = s;
    wts[2 * lane] = __expf(tot - (s - a1)); wts[2 * lane + 1] = __expf(tot - s);
}
__device__ __forceinline__ void p3_ssd3(Frame& F) {
    const int tid0 = threadIdx.x, w = __builtin_amdgcn_readfirstlane(tid0 >> 6);
    LAS unsigned char* L = F.lds;
    const bf16* proj = WSP(bf16, WS_PROJ); const bf16* xc = (const bf16*)F.out; const float* dtraw = WSP(float, WS_DTRAW);
    for (int item = F.vcu; item < NB * NHEADS; item += F.G) {
        const int b = item >> 4, h = item & 15, g = h >> 2;
        int tid = tid0; asm volatile("" : "+v"(tid)); int lane = tid & 63;
        const float A = -__expf((F.a->in[9])[h]), Dh = (F.a->in[10])[h], dtb = (F.a->in[8])[h];
        const int pbs = w >> 1, nb0 = 4 * (w & 1);
        f32x4 st[4];
#pragma unroll
        for (int j = 0; j < 4; ++j) st[j] = (f32x4){0.f, 0.f, 0.f, 0.f};
        __syncthreads();
        for (int i = tid; i < 17408 / 16; i += NTHR) ((LAS v4u*)(L + S3_PREV))[i] = (v4u){0u, 0u, 0u, 0u};
        Ssd3Pre P;
        { const unsigned voB0 = (unsigned)((4 * (tid >> 4)) * 2048 + 1024 + g * 128 + 8 * (tid & 15)) * 2u, voX0 = (unsigned)((4 * ((tid & 255) >> 3)) * 2048 + h * 64 + 8 * (tid & 7)) * 2u;
          ssd3_prefetch(P, (const char*)xc + (size_t)b * SEQ * 4096, dtraw + (size_t)b * SEQ * 16 + h, voB0, voX0, tid, lane, w); }
        if (w == 0) ssd3_cumsum(L, 0, P.d0, P.d1, dtb, A, lane);
        __syncthreads();
#ifdef PROBE_SSD
        unsigned long long sacc[8] = {0, 0, 0, 0, 0, 0, 0, 0};
#endif
        for (int c = 0; c < SEQ / CHUNK; ++c) {
            SPR_T(s0)
            const size_t row0 = (size_t)b * SEQ + (size_t)c * CHUNK; const int par = c & 1;
            asm volatile("" : "+v"(tid));
            lane = tid & 63; const int li = lane & 15, lq = lane >> 4;
            const unsigned voB = (unsigned)((4 * (tid >> 4)) * 2048 + 1024 + g * 128 + 8 * (tid & 15)) * 2u, voX = (unsigned)((4 * ((tid & 255) >> 3)) * 2048 + h * 64 + 8 * (tid & 7)) * 2u;
            const unsigned voZ0 = (unsigned)((tid >> 3) * NPROJ + h * 64 + 8 * (tid & 7)) * 2u, voZ1 = voZ0 + 64u * NPROJ * 2u;
            LAS float* csf = (LAS float*)(L + S3_CSF + par * 512); LAS float* dtf = (LAS float*)(L + S3_DTF + par * 512); LAS float* wts = (LAS float*)(L + S3_WTS + par * 512);
            { const int ob = tid & 15, lb = 4 * (tid >> 4), n0 = 8 * ob;
#pragma unroll
              for (int r = 0; r < 4; ++r) { *(LAS v4u*)(L + S3_BS + (lb + r) * SSD_PITCH + n0 * 2) = P.br[r]; *(LAS v4u*)(L + S3_CS + (lb + r) * SSD_PITCH + n0 * 2) = P.cr[r]; } }
            if (tid < 256) { const int ox = tid & 7, lx = 4 * (tid >> 3), p0 = 8 * ox;
#pragma unroll
              for (int r = 0; r < 4; ++r) { float xv[8]; unpack8(P.xr[r], xv); const float tw = dtf[lx + r];
                  *(LAS v4u*)(L + S3_XDT + (lx + r) * S3_XP + p0 * 2) = (v4u){pk2(xv[0] * tw, xv[1] * tw), pk2(xv[2] * tw, xv[3] * tw), pk2(xv[4] * tw, xv[5] * tw), pk2(xv[6] * tw, xv[7] * tw)}; } }
            const char* prb = (const char*)proj + row0 * (NPROJ * 2);
            const v4u zc0 = *(const v4u*)(prb + voZ0), zc1 = *(const v4u*)(prb + voZ1);
            SPR_T(s1) SPR_ACC(0, s1 - s0)
            LDS_BARRIER();
            SPR_T(s2) SPR_ACC(1, s2 - s1)
            const float cs_end = csf[127];
            bf16x8 ca[4];
#pragma unroll
            for (int ks = 0; ks < 4; ++ks) ca[ks] = lds_frag(L + S3_CS, 16 * w + li, 64 * ks + 16 * lq);
            float csl[4];
#pragma unroll
            for (int r = 0; r < 4; ++r) csl[r] = csf[16 * w + 4 * lq + r];
            { bf16x8 bq[2][4];
#pragma unroll
              for (int ks = 0; ks < 4; ++ks) bq[0][ks] = lds_frag(L + S3_BS, li, 64 * ks + 16 * lq);
#pragma unroll
              for (int sb = 0; sb < 8; ++sb) if (sb <= (w | 1)) {
                  f32x4 cbv = (f32x4){0.f, 0.f, 0.f, 0.f};
                  const int s = 16 * sb + li; const float css = csf[s];
                  if (sb <= w) {
                      if (sb + 1 <= w) {
#pragma unroll
                          for (int ks = 0; ks < 4; ++ks) bq[(sb + 1) & 1][ks] = lds_frag(L + S3_BS, 16 * (sb + 1) + li, 64 * ks + 16 * lq); }
                      __builtin_amdgcn_sched_barrier(0);
#pragma unroll
                      for (int ks = 0; ks < 4; ++ks) cbv = __builtin_amdgcn_mfma_f32_16x16x32_bf16(ca[ks], bq[sb & 1][ks], cbv, 0, 0, 0);
                      __builtin_amdgcn_sched_barrier(0); }
#pragma unroll
                  for (int r = 0; r < 4; ++r) { const int l = 16 * w + 4 * lq + r; const float gv = (s <= l) ? cbv[r] * __expf(csl[r] - css) : 0.f;
                      *(LAS unsigned short*)(L + S3_GY + l * SSD_PITCH + s * 2) = (unsigned short)f2bf(gv); } } }
            LDS_WAIT(); asm volatile("" ::: "memory");
            SPR_T(s3) SPR_ACC(2, s3 - s2)
            f32x4 yd[4], yo[4];
#pragma unroll
            for (int pb = 0; pb < 4; ++pb) { yd[pb] = (f32x4){0.f, 0.f, 0.f, 0.f}; yo[pb] = (f32x4){0.f, 0.f, 0.f, 0.f}; }
            { bf16x8 gq[2], xq[2][4];
              gq[0] = lds_frag(L + S3_GY, 16 * w + li, 16 * lq);
#pragma unroll
              for (int pb = 0; pb < 4; ++pb) xq[0][pb] = lds_frag_tr(L + S3_XDT, S3_XP, 0, 16 * pb, li, lq);
#pragma unroll
              for (int ks = 0; ks < 4; ++ks) if (ks <= (w >> 1)) {
                  if (ks + 1 <= (w >> 1)) { gq[(ks + 1) & 1] = lds_frag(L + S3_GY, 16 * w + li, 64 * (ks + 1) + 16 * lq);
#pragma unroll
                      for (int pb = 0; pb < 4; ++pb) xq[(ks + 1) & 1][pb] = lds_frag_tr(L + S3_XDT, S3_XP, 32 * (ks + 1), 16 * pb, li, lq); }
                  __builtin_amdgcn_sched_barrier(0);
#pragma unroll
                  for (int pb = 0; pb < 4; ++pb) yd[pb] = __builtin_amdgcn_mfma_f32_16x16x32_bf16(gq[ks & 1], xq[ks & 1][pb], yd[pb], 0, 0, 0);
                  __builtin_amdgcn_sched_barrier(0); } }
            { bf16x8 pq[2][4];
#pragma unroll
              for (int pb = 0; pb < 4; ++pb) pq[0][pb] = lds_frag(L + S3_PREV, 16 * pb + li, 16 * lq);
#pragma unroll
              for (int ks = 0; ks < 4; ++ks) {
                  if (ks < 3) {
#pragma unroll
                      for (int pb = 0; pb < 4; ++pb) pq[(ks + 1) & 1][pb] = lds_frag(L + S3_PREV, 16 * pb + li, 64 * (ks + 1) + 16 * lq); }
                  __builtin_amdgcn_sched_barrier(0);
#pragma unroll
                  for (int pb = 0; pb < 4; ++pb) yo[pb] = __builtin_amdgcn_mfma_f32_16x16x32_bf16(ca[ks], pq[ks & 1][pb], yo[pb], 0, 0, 0);
                  __builtin_amdgcn_sched_barrier(0); } }
#pragma unroll
            for (int r = 0; r < 4; ++r) { const float e = __expf(csl[r]);
#pragma unroll
                for (int pb = 0; pb < 4; ++pb) *(LAS float*)(L + S3_GY + (16 * w + 4 * lq + r) * SSD_PITCH + (16 * pb + li) * 4) = yd[pb][r] + e * yo[pb][r]; }
            { const size_t rown = row0 + (c + 1 < SEQ / CHUNK ? CHUNK : 0);
              ssd3_prefetch(P, (const char*)xc + rown * 4096, dtraw + rown * 16 + h, voB, voX, tid, lane, w); }
            SPR_T(s4) SPR_ACC(3, s4 - s3)
            LDS_BARRIER();
            SPR_T(s5) SPR_ACC(4, s5 - s4)
            { const float dec = __expf(cs_end);
#pragma unroll
              for (int j = 0; j < 4; ++j) st[j] = st[j] * dec;
              bf16x8 xq[2], bq2[2][4]; f32x4 wq[2][2];
              xq[0] = lds_frag_tr(L + S3_XDT, S3_XP, 0, 16 * pbs, li, lq); wq[0][0] = *(const LAS f32x4*)(wts + 8 * lq); wq[0][1] = *(const LAS f32x4*)(wts + 8 * lq + 4);
#pragma unroll
              for (int j = 0; j < 4; ++j) bq2[0][j] = lds_frag_tr(L + S3_BS, SSD_PITCH, 0, 16 * (nb0 + j), li, lq);
#pragma unroll
              for (int ks = 0; ks < 4; ++ks) {
                  if (ks < 3) { xq[(ks + 1) & 1] = lds_frag_tr(L + S3_XDT, S3_XP, 32 * (ks + 1), 16 * pbs, li, lq); wq[(ks + 1) & 1][0] = *(const LAS f32x4*)(wts + 32 * (ks + 1) + 8 * lq); wq[(ks + 1) & 1][1] = *(const LAS f32x4*)(wts + 32 * (ks + 1) + 8 * lq + 4);
#pragma unroll
                      for (int j = 0; j < 4; ++j) bq2[(ks + 1) & 1][j] = lds_frag_tr(L + S3_BS, SSD_PITCH, 32 * (ks + 1), 16 * (nb0 + j), li, lq); }
                  __builtin_amdgcn_sched_barrier(0);
                  const f32x4 w0 = wq[ks & 1][0], w1 = wq[ks & 1][1];
                  float xv[8]; unpack8(__builtin_bit_cast(v4u, xq[ks & 1]), xv);
                  const v4u xw = (v4u){pk2(xv[0] * w0[0], xv[1] * w0[1]), pk2(xv[2] * w0[2], xv[3] * w0[3]), pk2(xv[4] * w1[0], xv[5] * w1[1]), pk2(xv[6] * w1[2], xv[7] * w1[3])};
                  const bf16x8 xf = __builtin_bit_cast(bf16x8, xw);
#pragma unroll
                  for (int j = 0; j < 4; ++j) st[j] = __builtin_amdgcn_mfma_f32_16x16x32_bf16(xf, bq2[ks & 1][j], st[j], 0, 0, 0);
                  __builtin_amdgcn_sched_barrier(0); }
#pragma unroll
              for (int j = 0; j < 4; ++j)
#pragma unroll
                  for (int r = 0; r < 4; ++r) *(LAS unsigned short*)(L + S3_PREV + (16 * pbs + 4 * lq + r) * SSD_PITCH + (16 * (nb0 + j) + li) * 2) = (unsigned short)f2bf(st[j][r]); }
            SPR_T(s6) SPR_ACC(5, s6 - s5)
#pragma unroll
            for (int k = 0; k < 2; ++k) { const int it = tid + 512 * k, l = it >> 3, o = it & 7; const size_t row = row0 + l;
                const f32x4 y0 = *(const LAS f32x4*)(L + S3_GY + l * SSD_PITCH + 32 * o), y1 = *(const LAS f32x4*)(L + S3_GY + l * SSD_PITCH + 32 * o + 16);
                const v4u xw = *(const LAS v4u*)(L + S3_XDT + l * S3_XP + 16 * o); const v4u zw = k == 0 ? zc0 : zc1; const float dsk = Dh * __builtin_amdgcn_rcpf(fmaxf(dtf[l], 1e-30f));
                float xv[8], zv[8], yv[8]; unpack8(xw, xv); unpack8(zw, zv);
                float ss = 0.f;
#pragma unroll
                for (int e = 0; e < 8; ++e) { const float yy = (e < 4 ? y0[e] : y1[e - 4]) + dsk * xv[e]; yv[e] = yy * silu_f(zv[e]); ss += yv[e] * yv[e]; }
                ss += __shfl_xor(ss, 1); ss += __shfl_xor(ss, 2); ss += __shfl_xor(ss, 4);
                if (o == 0) WSP(float, WS_STSSD)[row * 16 + h] = ss;
                *(v4u*)(WSP(bf16, WS_Y) + row * 2048 + h * 64 + 8 * o) = (v4u){pk2(yv[0], yv[1]), pk2(yv[2], yv[3]), pk2(yv[4], yv[5]), pk2(yv[6], yv[7])}; }
            if (w == 0 && c + 1 < SEQ / CHUNK) ssd3_cumsum(L, par ^ 1, P.d0, P.d1, dtb, A, lane);
            SPR_T(s7) SPR_ACC(6, s7 - s6)
            LDS_BARRIER();
            SPR_T(s8) SPR_ACC(7, s8 - s7)
        }
#ifdef PROBE_SSD
        if (blockIdx.x == 0 && threadIdx.x == PROBE_TID) *(volatile float*)(F.ws + WS_CTL + 40000) = (float)sacc[PROBE_SSD] * 1e-3f;
#endif
    }
}
typedef float f32x16 __attribute__((ext_vector_type(16)));
#ifdef PROBE_SEL
#define PR_T(v) const unsigned long long v = __builtin_amdgcn_s_memtime();
#define PR_ACC(a, d) a += (d);
#define PR_OUT(i, a) if (PROBE_SEL == (i) && blockIdx.x == 0 && threadIdx.x == 0) *(volatile float*)(F.ws + WS_CTL + 40000) = (float)(a) * 1e-4f;
#define PR_OUT4(i, a) if (PROBE_SEL == (i) && blockIdx.x == 0 && threadIdx.x == 256) *(volatile float*)(F.ws + WS_CTL + 40000) = (float)(a) * 1e-4f;
#else
#define PR_T(v)
#define PR_ACC(a, d)
#define PR_OUT(i, a)
#define PR_OUT4(i, a)
#endif
constexpr int S5V_BU = 0, S5V_BUP = 2056, S5V_BUSZ = 16 * S5V_BUP, S5V_XT = 2 * S5V_BUSZ, S5V_XTP = 1040, S5V_XTSZ = 16 * S5V_XTP, S5V_VS = S5V_XT + 2 * S5V_XTSZ, S5V_OT = S5V_VS + 4 * 512, S5V_OTP = 144, S5V_OTSZ = 16 * S5V_OTP, S5V_END = S5V_OT + 2 * S5V_OTSZ;
static_assert(S5V_END <= LDS_MAIN, "S5 v2 LDS map");
__device__ __forceinline__ void p3_s5v2(Frame& F) {
    const int tid = threadIdx.x, lane = tid & 63, w = __builtin_amdgcn_readfirstlane(tid >> 6);
    const int li = lane & 15, lq = lane >> 4;
    LAS unsigned char* L = F.lds;
    const bf16* proj = WSP(bf16, WS_PROJ);
    constexpr int NT = SEQ / 16;
#ifdef PROBE_S5
    const unsigned long long pr_t0 = PROBE_CLOCK();
#endif
    for (int item = F.vcu; item < NB * 16; item += F.G) {
        const int b = item >> 4, gs = item & 15;
        const bool scanw = w < 4; const int gl = w & 3, g = gs * 4 + gl;
        const bf16* ubase = proj + (size_t)b * SEQ * NPROJ + 3072 + gs * 64 + gl * 16;
        __syncthreads();
        if (scanw) {
            __builtin_amdgcn_s_setprio(2);
            const float lbr = WSP(float, WS_S5LB)[(g * 64 + lane) * 2], lbi = WSP(float, WS_S5LB)[(g * 64 + lane) * 2 + 1], nlbi = -lbi;
            bf16x8 bfr[8];
#pragma unroll
            for (int cb = 0; cb < 8; ++cb) { v4u v = (v4u){0u, 0u, 0u, 0u};
                if (lq < 2) { const int col = 16 * cb + li; const float* src = WSP(float, WS_S5BB) + (g * 64 + (col >> 1)) * 32 + (col & 1) * 16 + 8 * lq; const f32x4 a0 = *(const f32x4*)src, a1 = *(const f32x4*)(src + 4);
                    v = (v4u){pk2(a0[0], a0[1]), pk2(a0[2], a0[3]), pk2(a1[0], a1[1]), pk2(a1[2], a1[3])}; }
                bfr[cb] = __builtin_bit_cast(bf16x8, v); }
            float xr = 0.f, xi = 0.f;
            const int lq2 = lq & 1;
            v4u ua = *(const v4u*)(ubase + (size_t)li * NPROJ + 8 * lq2);
            { const bf16x8 af = __builtin_bit_cast(bf16x8, lq < 2 ? ua : (v4u){0u, 0u, 0u, 0u});
              ua = *(const v4u*)(ubase + (size_t)(16 + li) * NPROJ + 8 * lq2);
#pragma unroll
              for (int cb = 0; cb < 8; ++cb) { f32x4 acc = (f32x4){0.f, 0.f, 0.f, 0.f}; acc = __builtin_amdgcn_mfma_f32_16x16x32_bf16(af, bfr[cb], acc, 0, 0, 0);
#pragma unroll
                  for (int r = 0; r < 4; ++r) *(LAS float*)(L + S5V_BU + (4 * lq + r) * S5V_BUP + (gl * 128 + 16 * cb + li) * 4) = acc[r]; } }
            LDS_BARRIER();
            unsigned long long pa0 = 0, pa1 = 0, pa2 = 0;
            for (int k = 0; k <= NT; ++k) {
                PR_T(pt0)
                if (k < NT) {
                    const LAS f32x2* bp = (const LAS f32x2*)(L + S5V_BU + (k & 1) * S5V_BUSZ + (gl * 128 + 2 * lane) * 4);
                    LAS unsigned* xp = (LAS unsigned*)(L + S5V_XT + (k & 1) * S5V_XTSZ + (gl * 128 + 2 * lane) * 2);
                    f32x2 bu[16];
#pragma unroll
                    for (int t = 0; t < 16; ++t) bu[t] = bp[t * (S5V_BUP / 8)];
                    unsigned xo[16];
#pragma unroll
                    for (int t = 0; t < 16; ++t) {
                        const float a = __builtin_fmaf(nlbi, xi, bu[t][0]), bq = __builtin_fmaf(lbi, xr, bu[t][1]);
                        const float nr = __builtin_fmaf(lbr, xr, a), ni = __builtin_fmaf(lbr, xi, bq); xr = nr; xi = ni; xo[t] = pk2(xr, xi); }
#pragma unroll
                    for (int t = 0; t < 16; ++t) xp[t * (S5V_XTP / 4)] = xo[t];
                    PR_T(pt1) PR_ACC(pa0, pt1 - pt0)
                    if (k + 1 < NT) {
                        const bf16x8 af = __builtin_bit_cast(bf16x8, lq < 2 ? ua : (v4u){0u, 0u, 0u, 0u});
                        { const int kn = k + 2 < NT ? k + 2 : NT - 1; ua = *(const v4u*)(ubase + (size_t)(16 * kn + li) * NPROJ + 8 * lq2); }
                        LAS unsigned char* bun = L + S5V_BU + ((k + 1) & 1) * S5V_BUSZ;
#pragma unroll
                        for (int cb = 0; cb < 8; ++cb) { f32x4 acc = (f32x4){0.f, 0.f, 0.f, 0.f}; acc = __builtin_amdgcn_mfma_f32_16x16x32_bf16(af, bfr[cb], acc, 0, 0, 0);
#pragma unroll
                            for (int r = 0; r < 4; ++r) *(LAS float*)(bun + (4 * lq + r) * S5V_BUP + (gl * 128 + 16 * cb + li) * 4) = acc[r]; }
                    }
                }
                PR_T(pt2) PR_ACC(pa1, pt2 - pt0)
                LDS_BARRIER();
                PR_T(pt3) PR_ACC(pa2, pt3 - pt2)
            }
            __builtin_amdgcn_s_setprio(0);
            PR_OUT(0, pa0) PR_OUT(1, pa1) PR_OUT(2, pa2)
        } else {
            bf16x8 cfr[4];
#pragma unroll
            for (int ks = 0; ks < 4; ++ks) { const float* cr = (F.a->in[17]) + (g * 16 + li) * 64 + 16 * ks + 4 * lq; const float* ci = (F.a->in[18]) + (g * 16 + li) * 64 + 16 * ks + 4 * lq;
                const f32x4 r0 = *(const f32x4*)cr, i0 = *(const f32x4*)ci;
                cfr[ks] = __builtin_bit_cast(bf16x8, ((v4u){pk2(r0[0], -i0[0]), pk2(r0[1], -i0[1]), pk2(r0[2], -i0[2]), pk2(r0[3], -i0[3])})); }
            v4u gwv = (v4u){0u, 0u, 0u, 0u};
            if (lq < 2) { float gwf[8];
#pragma unroll
                for (int j = 0; j < 8; ++j) gwf[j] = (F.a->in[20])[(g * 16 + 8 * lq + j) * 16 + li];
                gwv = (v4u){pk2(gwf[0], gwf[1]), pk2(gwf[2], gwf[3]), pk2(gwf[4], gwf[5]), pk2(gwf[6], gwf[7])}; }
            const bf16x8 gfr = __builtin_bit_cast(bf16x8, gwv);
            const float dsk = (F.a->in[19])[g * 16 + li], gbias = (F.a->in[21])[g * 16 + li];
            LAS unsigned char* vs = L + S5V_VS + gl * 512;
            float uo[4], un[4];
#pragma unroll
            for (int r = 0; r < 4; ++r) { uo[r] = bf2f(ubase[(size_t)(4 * lq + r) * NPROJ + li]); un[r] = bf2f(ubase[(size_t)(16 + 4 * lq + r) * NPROJ + li]); }
            LDS_BARRIER();
            unsigned long long pb0 = 0, pb1 = 0;
            for (int k = 0; k <= NT; ++k) {
                PR_T(qt0)
                float u2[4];
                { const int kn = k + 1 < NT ? k + 1 : NT - 1;
#pragma unroll
                  for (int r = 0; r < 4; ++r) u2[r] = bf2f(ubase[(size_t)(16 * kn + 4 * lq + r) * NPROJ + li]); }
                if (k >= 2) {
                    const int t = ((tid - 256) >> 3) & 15, oc = tid & 7; const v4u ov = *(const LAS v4u*)(L + S5V_OT + (k & 1) * S5V_OTSZ + t * S5V_OTP + 16 * oc);
                    if (tid < 384) *(v4u*)(WSP(bf16, WS_Y) + ((size_t)b * SEQ + 16 * (k - 2) + t) * 2048 + 1024 + gs * 64 + 8 * oc) = ov; }
                if (k >= 1) {
                    const int kt = k - 1; const LAS unsigned char* xt = L + S5V_XT + (kt & 1) * S5V_XTSZ;
                    f32x4 yacc = (f32x4){0.f, 0.f, 0.f, 0.f};
#pragma unroll
                    for (int ks = 0; ks < 4; ++ks) yacc = __builtin_amdgcn_mfma_f32_16x16x32_bf16(*(const LAS bf16x8*)(xt + li * S5V_XTP + (gl * 128 + 32 * ks + 8 * lq) * 2), cfr[ks], yacc, 0, 0, 0);
                    float v[4];
                    { const f32x2 g0 = gelu_pk2((f32x2){yacc[0] + dsk * uo[0], yacc[1] + dsk * uo[1]}), g1 = gelu_pk2((f32x2){yacc[2] + dsk * uo[2], yacc[3] + dsk * uo[3]}); v[0] = g0[0]; v[1] = g0[1]; v[2] = g1[0]; v[3] = g1[1]; }
#pragma unroll
                    for (int r = 0; r < 4; ++r) *(LAS unsigned short*)(vs + (4 * lq + r) * 32 + li * 2) = (unsigned short)f2bf(v[r]);
                    LDS_WAIT(); asm volatile("" ::: "memory");
                    v4u va = (v4u){0u, 0u, 0u, 0u};
                    if (lq < 2) va = *(const LAS v4u*)(vs + li * 32 + 16 * lq);
                    f32x4 gacc = (f32x4){0.f, 0.f, 0.f, 0.f};
                    gacc = __builtin_amdgcn_mfma_f32_16x16x32_bf16(__builtin_bit_cast(bf16x8, va), gfr, gacc, 0, 0, 0);
                    float o[4], ss[4];
#pragma unroll
                    for (int r = 0; r < 4; ++r) { o[r] = v[r] * sigmoid_f(gacc[r] + gbias); ss[r] = o[r] * o[r]; }
#pragma unroll
                    for (int r = 0; r < 4; ++r) ss[r] = row16_sum_to15(ss[r]);
                    if (li == 15) {
#pragma unroll
                        for (int r = 0; r < 4; ++r) WSP(float, WS_STS5)[((size_t)b * SEQ + 16 * kt + 4 * lq + r) * NS5PART + g] = ss[r]; }
                    LAS unsigned char* ot = L + S5V_OT + (kt & 1) * S5V_OTSZ;
#pragma unroll
                    for (int r = 0; r < 4; ++r) *(LAS unsigned short*)(ot + (4 * lq + r) * S5V_OTP + (gl * 16 + li) * 2) = (unsigned short)f2bf(o[r]);
#pragma unroll
                    for (int r = 0; r < 4; ++r) { uo[r] = un[r]; un[r] = u2[r]; }
                }
                PR_T(qt1) PR_ACC(pb0, qt1 - qt0)
                LDS_BARRIER();
                PR_T(qt2) PR_ACC(pb1, qt2 - qt1)
            }
            PR_OUT4(3, pb0) PR_OUT4(4, pb1)
            { const int t = ((tid - 256) >> 3) & 15, oc = tid & 7; const v4u ov = *(const LAS v4u*)(L + S5V_OT + ((NT - 1) & 1) * S5V_OTSZ + t * S5V_OTP + 16 * oc);
              if (tid < 384) *(v4u*)(WSP(bf16, WS_Y) + ((size_t)b * SEQ + 16 * (NT - 1) + t) * 2048 + 1024 + gs * 64 + 8 * oc) = ov; }
        }
    }
#ifdef PROBE_S5
    if (blockIdx.x == 0 && threadIdx.x == 0) *(volatile float*)(F.ws + WS_CTL + 40000) = (float)(PROBE_CLOCK() - pr_t0) * PROBE_SCALE;
#endif
}
__device__ __forceinline__ unsigned med3u(unsigned a, unsigned b, unsigned c) { unsigned r; asm("v_med3_u32 %0, %1, %2, %3" : "=v"(r) : "v"(a), "v"(b), "v"(c)); return r; }
__device__ __forceinline__ unsigned fkey(float v) { const unsigned u = __builtin_bit_cast(unsigned, v); return (u & 0x80000000u) ? ~u : (u | 0x80000000u); }
__device__ __forceinline__ float fkey_inv(unsigned k) { const unsigned u = (k & 0x80000000u) ? (k & 0x7fffffffu) : ~k; return __builtin_bit_cast(float, u); }
#define TOPK_INSERT(a, x) do { _Pragma("unroll") for (int _i = 15; _i >= 1; --_i) a[_i] = med3u(a[_i - 1], a[_i], (x)); a[0] = a[0] > (x) ? a[0] : (x); } while (0)
__device__ __forceinline__ unsigned fp6_code(float y) {
    const float a = fabsf(y);
    const float c = a < 2.0f ? __builtin_rintf(8.0f * a) : (a < 4.0f ? __builtin_rintf(4.0f * a) + 8.0f : fminf(__builtin_rintf(2.0f * a) + 16.0f, 31.0f));
    return (unsigned)c | (y < 0.f ? 32u : 0u);
}
__device__ __forceinline__ void fp6_pack16(const unsigned* c, unsigned& w0, unsigned& w1, unsigned& w2) {
    w0 = c[0] | (c[1] << 6) | (c[2] << 12) | (c[3] << 18) | (c[4] << 24) | (c[5] << 30);
    w1 = (c[5] >> 2) | (c[6] << 4) | (c[7] << 10) | (c[8] << 16) | (c[9] << 22) | (c[10] << 28);
    w2 = (c[10] >> 4) | (c[11] << 2) | (c[12] << 8) | (c[13] << 14) | (c[14] << 20) | (c[15] << 26);
}
__device__ __forceinline__ void h2_convert(Frame& F, int w0, int nw, int f_lane) {
    for (int tb = w0 * 16; tb < MTOK; tb += nw * 16) {
        const float* sh = WSP(float, WS_MOD) + (size_t)(tb >> 11) * 6144 + 3072 + 16 * f_lane;
        float S2[16];
#pragma unroll
        for (int q = 0; q < 4; ++q) { const f32x4 s4 = *(const f32x4*)(sh + 4 * q); S2[4 * q] = s4[0]; S2[4 * q + 1] = s4[1]; S2[4 * q + 2] = s4[2]; S2[4 * q + 3] = s4[3]; }
#pragma unroll 1
        for (int k = 0; k < 16; k += 4) {
            v4u xa[4], xb[4]; float rst[4];
#pragma unroll
            for (int u = 0; u < 4; ++u) { const int t = tb + k + u; const char* xs = (const char*)(WSP(bf16, WS_X1S) + (size_t)t * 1024) + 32 * f_lane; xa[u] = *(const v4u*)xs; xb[u] = *(const v4u*)(xs + 16); rst[u] = WSP(float, WS_ROWSTAT)[t]; }
#pragma unroll
            for (int u = 0; u < 4; ++u) { const int t = tb + k + u;
                const float rs = rsqrt_f(rst[u] * (1.0f / 1024.0f) + EPSF);
                float h2[16]; unpack8(xa[u], h2); unpack8(xb[u], h2 + 8); float mx = 0.f;
#pragma unroll
                for (int i = 0; i < 16; ++i) { h2[i] = h2[i] * rs + S2[i]; mx = fmaxf(mx, fabsf(h2[i])); }
#pragma unroll
                for (int o = 1; o < 64; o <<= 1) mx = fmaxf(mx, __shfl_xor(mx, o));
                mx = fmaxf(mx, 1e-30f); const float hs = 224.0f / mx;
                v4u w;
#pragma unroll
                for (int q = 0; q < 4; ++q) { int pk = 0; pk = __builtin_amdgcn_cvt_pk_fp8_f32(h2[4 * q] * hs, h2[4 * q + 1] * hs, pk, false); pk = __builtin_amdgcn_cvt_pk_fp8_f32(h2[4 * q + 2] * hs, h2[4 * q + 3] * hs, pk, true); w[q] = (unsigned)pk; }
                *(v4u*)(F.ws + WS_H2Q + (size_t)t * 1024 + 16 * f_lane) = w;
                if (f_lane == 0) WSP(float, WS_HINV)[t] = mx * (1.0f / 224.0f); }
        }
    }
}
__device__ __forceinline__ void expert_convert(Frame& F, int w0, int nw, int f_lane) {
    for (int rw = w0; rw < 2 * 16384; rw += 2 * nw) {
        f32x4 v[2][4]; float mx[2];
#pragma unroll
        for (int u = 0; u < 2; ++u) { const int r = rw + u * nw; const int tb = r >= 16384, e = tb ? r - 16384 : r; const float* src = (tb ? (F.a->in[28]) : (F.a->in[27])) + (size_t)e * 1024 + 16 * f_lane;
#pragma unroll
            for (int q = 0; q < 4; ++q) v[u][q] = *(const f32x4*)(src + 4 * q); }
#pragma unroll
        for (int u = 0; u < 2; ++u) { float m = 0.f;
#pragma unroll
            for (int q = 0; q < 4; ++q) m = fmaxf(m, fmaxf(fmaxf(fabsf(v[u][q][0]), fabsf(v[u][q][1])), fmaxf(fabsf(v[u][q][2]), fabsf(v[u][q][3]))));
#pragma unroll
            for (int o = 1; o < 64; o <<= 1) m = fmaxf(m, __shfl_xor(m, o));
            mx[u] = fmaxf(m, 1e-30f); }
#pragma unroll
        for (int u = 0; u < 2; ++u) { const int r = rw + u * nw; const int tb = r >= 16384, e = tb ? r - 16384 : r; const float sc = 224.0f / mx[u];
            v4u w;
#pragma unroll
            for (int q = 0; q < 4; ++q) { int pk = 0; pk = __builtin_amdgcn_cvt_pk_fp8_f32(v[u][q][0] * sc, v[u][q][1] * sc, pk, false); pk = __builtin_amdgcn_cvt_pk_fp8_f32(v[u][q][2] * sc, v[u][q][3] * sc, pk, true); w[q] = (unsigned)pk; }
#ifdef V6
#ifdef UP12
            {
#else
            if (tb) {
#endif
                const float s6 = 7.5f / mx[u]; unsigned cd[16];
#pragma unroll
                for (int q = 0; q < 4; ++q)
#pragma unroll
                    for (int i = 0; i < 4; ++i) cd[4 * q + i] = fp6_code(v[u][q][i] * s6);
                unsigned w0, w1, w2; fp6_pack16(cd, w0, w1, w2);
                unsigned* dst = (unsigned*)(F.ws + (tb ? WS_EV : WS_EU) + (size_t)e * 768 + 12 * f_lane); dst[0] = w0; dst[1] = w1; dst[2] = w2;
                if (f_lane == 0) WSP(float, tb ? WS_EVS : WS_EUS)[e] = mx[u] * (1.0f / 7.5f);
                continue; }
#endif
            *(v4u*)(F.ws + (tb ? WS_EV : WS_EU) + (size_t)e * 1024 + 16 * f_lane) = w;
            if (f_lane == 0) WSP(float, tb ? WS_EVS : WS_EUS)[e] = mx[u] * (1.0f / 224.0f); }
    }
}
__device__ __forceinline__ void p5b_topk(Frame& F) {
    const int f_tid = threadIdx.x, f_lane = f_tid & 63, f_wave = __builtin_amdgcn_readfirstlane(f_tid >> 6);
    const _Float16* scores = WSP(_Float16, WS_SCORES);
    LAS unsigned char* ix = (LAS unsigned char*)F.lds + f_tid * 36;
#pragma unroll 1
    for (int half = 0; half < 2; ++half) {
#ifdef UP11
    if ((f_wave >> 2) != half) { expert_convert(F, (F.vcu * 4 + (f_wave & 3)) * 2 + half, F.G * 8, f_lane); h2_convert(F, (F.vcu * 4 + (f_wave & 3)) * 2 + half, F.G * 8, f_lane); continue; }
#else
    if ((f_wave >> 2) != half) { expert_convert(F, (F.vcu * 4 + (f_wave & 3)) * 2 + half, F.G * 8, f_lane); continue; }
#endif
    typedef _Float16 f16x8 __attribute__((ext_vector_type(8)));
    f16x8 sva[8], svb[8];
    { const int item0 = (F.vcu * 2 + half) * 256 + (f_tid & 255); const _Float16* sp0 = scores + (size_t)(item0 >> 3) * 2048 + (item0 & 7) * 256;
#pragma unroll
      for (int q = 0; q < 8; ++q) sva[q] = *(const f16x8*)(sp0 + 8 * q); }
#pragma unroll 1
    for (int item = (F.vcu * 2 + half) * 256 + (f_tid & 255); item < MTOK * PH; item += F.G * 512) {
        const int t = item >> 3, hd = item & 7;
        unsigned a1[16], a2[16];
#pragma unroll
        for (int i = 0; i < 16; ++i) { a1[i] = 0u; a2[i] = 0u; }
        const _Float16* sp = scores + (size_t)t * 2048 + hd * 256;
        const int itn = (item + F.G * 512 < MTOK * PH) ? item + F.G * 512 : item;
        const _Float16* spn = scores + (size_t)(itn >> 3) * 2048 + (itn & 7) * 256;
#define TK_BATCH(CUR, NXT, NP, A, M) { \
        { _Pragma("unroll") for (int q = 0; q < 8; ++q) NXT[q] = *(const f16x8*)((NP) + 8 * q); } \
        __builtin_amdgcn_sched_barrier(0); \
        _Pragma("unroll") for (int q = 0; q < 8; ++q) { _Pragma("unroll") for (int e = 0; e < 8; ++e) { const unsigned k = (fkey((float)CUR[q][e]) & ~127u) | (unsigned)(127 - (64 * (M) + 8 * q + e)); TOPK_INSERT(A, k); } } }
        TK_BATCH(sva, svb, sp + 64, a1, 0)
        TK_BATCH(svb, sva, sp + 128, a1, 1)
        TK_BATCH(sva, svb, sp + 192, a2, 0)
        TK_BATCH(svb, sva, spn, a2, 1)
#undef TK_BATCH
        float v1[16], v2[16];
#pragma unroll
        for (int i = 0; i < 16; ++i) { ix[i] = (unsigned char)(127u - (a1[i] & 127u)); ix[16 + i] = (unsigned char)(127u - (a2[i] & 127u)); v1[i] = fkey_inv(a1[i] & ~127u); v2[i] = fkey_inv(a2[i] & ~127u); }
        unsigned cb[16];
#pragma unroll
        for (int i = 0; i < 16; ++i) cb[i] = 0u;
#pragma unroll
        for (int i = 0; i < 16; ++i)
#pragma unroll
            for (int j = 0; j < 16; ++j) if ((i + 1) * (j + 1) <= 16) { const unsigned k = (fkey(v1[i] + v2[j]) & ~255u) | (unsigned)(255 - (i * 16 + j)); TOPK_INSERT(cb, k); }
        float tv[16]; float mx = -3.0e38f;
#pragma unroll
        for (int k = 0; k < 16; ++k) { tv[k] = fkey_inv(cb[k] & ~255u); mx = fmaxf(mx, tv[k]); }
        float sum = 0.f;
#pragma unroll
        for (int k = 0; k < 16; ++k) { tv[k] = __expf(tv[k] - mx); sum += tv[k]; }
        const float inv = 1.0f / sum;
        LDS_WAIT(); asm volatile("" ::: "memory");
        int ev[16]; unsigned long long c64 = 0ull;
#pragma unroll
        for (int k = 0; k < 16; ++k) { const unsigned code = 255u - (cb[k] & 255u); const int i = code >> 4, j = code & 15; ev[k] = (int)ix[i] * 128 + (int)ix[16 + j]; c64 += 1ull << (8 * (ev[k] >> 11)); }
        unsigned long long s64 = c64;
#pragma unroll
        for (int o = 1; o < 8; o <<= 1) { const unsigned lo = __shfl_up((unsigned)s64, o, 8), hi = __shfl_up((unsigned)(s64 >> 32), o, 8); if ((f_lane & 7) >= o) s64 += ((unsigned long long)hi << 32) | lo; }
        const unsigned long long e64 = s64 - c64;
        const unsigned long long t64 = ((unsigned long long)__shfl((unsigned)(s64 >> 32), 7, 8) << 32) | __shfl((unsigned)s64, 7, 8);
        const unsigned long long st64 = (t64 * 0x0101010101010101ull) << 8;
        unsigned long long base64 = st64 + e64;
        int* eo = WSP(int, WS_EID) + (size_t)t * 128; float* go = WSP(float, WS_GATE) + (size_t)t * 128;
#pragma unroll
        for (int k = 0; k < 16; ++k) { const int r8 = 8 * (ev[k] >> 11); const int slot = (int)((base64 >> r8) & 255ull); base64 += 1ull << r8; eo[slot] = ev[k]; go[slot] = tv[k] * inv; }
        if (hd == 0) WSP(unsigned long long, WS_START)[t] = st64;
        LDS_WAIT(); asm volatile("" ::: "memory");
    }
    }
}
__device__ __forceinline__ void dec16(const v4u q, float* f) {
#pragma unroll
    for (int i = 0; i < 4; ++i) { const f32x2 lo = __builtin_amdgcn_cvt_pk_f32_fp8((int)q[i], false), hi = __builtin_amdgcn_cvt_pk_f32_fp8((int)q[i], true); f[4 * i] = lo[0]; f[4 * i + 1] = lo[1]; f[4 * i + 2] = hi[0]; f[4 * i + 3] = hi[1]; }
}
struct CvE { f32x4 v[4]; };
struct CvH { v4u xa, xb; float rst; };
__device__ __forceinline__ void cve_load(CvE& c, Frame& F, int r, int f_lane) {
    const int tb = r >= 16384, e = tb ? r - 16384 : r; const float* src = (tb ? (F.a->in[28]) : (F.a->in[27])) + (size_t)e * 1024 + 16 * f_lane;
#pragma unroll
    for (int q = 0; q < 4; ++q) c.v[q] = *(const f32x4*)(src + 4 * q);
}
__device__ __forceinline__ void cve_finish(const CvE& c, Frame& F, int r, int f_lane) {
    const int tb = r >= 16384, e = tb ? r - 16384 : r; float m = 0.f;
#pragma unroll
    for (int q = 0; q < 4; ++q) m = fmaxf(m, fmaxf(fmaxf(fabsf(c.v[q][0]), fabsf(c.v[q][1])), fmaxf(fabsf(c.v[q][2]), fabsf(c.v[q][3]))));
#pragma unroll
    for (int o = 1; o < 64; o <<= 1) m = fmaxf(m, __shfl_xor(m, o));
    m = fmaxf(m, 1e-30f); const float sc = 224.0f / m;
    v4u w;
#pragma unroll
    for (int q = 0; q < 4; ++q) { int pk = 0; pk = __builtin_amdgcn_cvt_pk_fp8_f32(c.v[q][0] * sc, c.v[q][1] * sc, pk, false); pk = __builtin_amdgcn_cvt_pk_fp8_f32(c.v[q][2] * sc, c.v[q][3] * sc, pk, true); w[q] = (unsigned)pk; }
    *(v4u*)(F.ws + (tb ? WS_EV : WS_EU) + (size_t)e * 1024 + 16 * f_lane) = w;
    if (f_lane == 0) WSP(float, tb ? WS_EVS : WS_EUS)[e] = m * (1.0f / 224.0f);
}
__device__ __forceinline__ void cvh_load(CvH& c, Frame& F, int t, int f_lane) {
    const char* xs = (const char*)(WSP(bf16, WS_X1S) + (size_t)t * 1024) + 32 * f_lane; c.xa = *(const v4u*)xs; c.xb = *(const v4u*)(xs + 16); c.rst = WSP(float, WS_ROWSTAT)[t];
}
__device__ __forceinline__ void cvh_finish(const CvH& c, Frame& F, int t, int f_lane, const float* S2) {
    const float rs = rsqrt_f(c.rst * (1.0f / 1024.0f) + EPSF);
    float h2[16]; unpack8(c.xa, h2); unpack8(c.xb, h2 + 8); float mx = 0.f;
#pragma unroll
    for (int i = 0; i < 16; ++i) { h2[i] = h2[i] * rs + S2[i]; mx = fmaxf(mx, fabsf(h2[i])); }
#pragma unroll
    for (int o = 1; o < 64; o <<= 1) mx = fmaxf(mx, __shfl_xor(mx, o));
    mx = fmaxf(mx, 1e-30f); const float hs = 224.0f / mx;
    v4u w;
#pragma unroll
    for (int q = 0; q < 4; ++q) { int pk = 0; pk = __builtin_amdgcn_cvt_pk_fp8_f32(h2[4 * q] * hs, h2[4 * q + 1] * hs, pk, false); pk = __builtin_amdgcn_cvt_pk_fp8_f32(h2[4 * q + 2] * hs, h2[4 * q + 3] * hs, pk, true); w[q] = (unsigned)pk; }
    *(v4u*)(F.ws + WS_H2Q + (size_t)t * 1024 + 16 * f_lane) = w;
    if (f_lane == 0) WSP(float, WS_HINV)[t] = mx * (1.0f / 224.0f);
}
__device__ __forceinline__ void p5b_topk2(Frame& F) {
    const int f_tid = threadIdx.x, f_lane = f_tid & 63, f_wave = __builtin_amdgcn_readfirstlane(f_tid >> 6);
    const _Float16* scores = WSP(_Float16, WS_SCORES);
    LAS unsigned char* ix = (LAS unsigned char*)F.lds + f_tid * 36;
    const int gw = F.vcu * NWAVES + f_wave;
    static_assert(MTOK * PH == 2 * 256 * NTHR && MTOK == 16 * 256 * NWAVES, "P7 v2 work split");
    float S2[16];
    { const float* sh = WSP(float, WS_MOD) + (size_t)((gw * 16) >> 11) * 6144 + 3072 + 16 * f_lane;
#pragma unroll
      for (int q = 0; q < 4; ++q) { const f32x4 s4 = *(const f32x4*)(sh + 4 * q); S2[4 * q] = s4[0]; S2[4 * q + 1] = s4[1]; S2[4 * q + 2] = s4[2]; S2[4 * q + 3] = s4[3]; } }
    typedef _Float16 f16x8 __attribute__((ext_vector_type(8)));
    const int item_base = F.vcu * NTHR + f_tid, item_step = F.G * NTHR;
    f16x8 sva[8], svb[8];
    { const _Float16* sp0 = scores + (size_t)(item_base >> 3) * 2048 + (item_base & 7) * 256;
#pragma unroll
      for (int q = 0; q < 8; ++q) sva[q] = *(const f16x8*)(sp0 + 8 * q); }
    unsigned a1[16];
#pragma unroll
    for (int i = 0; i < 16; ++i) a1[i] = 0u;
#pragma unroll 1
    for (int hi = 0; hi < 4; ++hi) {
        const int item = item_base + (hi >> 1) * item_step; const int t = item >> 3, hd = item & 7, kh = hi & 1;
        const _Float16* sp = scores + (size_t)t * 2048 + hd * 256 + kh * 128;
        const int hn = hi < 3 ? hi + 1 : hi; const int itn = item_base + (hn >> 1) * item_step;
        const _Float16* spn = scores + (size_t)(itn >> 3) * 2048 + (itn & 7) * 256 + (hn & 1) * 128;
        unsigned a2[16];
#pragma unroll
        for (int i = 0; i < 16; ++i) a2[i] = 0u;
#define TK2_BATCH(CUR, NXT, NP, M) { \
        const int ku = 2 * (2 * hi + (M)); CvE e0, e1; CvH h0, h1; \
        { _Pragma("unroll") for (int q = 0; q < 8; ++q) NXT[q] = *(const f16x8*)((NP) + 8 * q); } \
        cve_load(e0, F, gw + ku * 2048, f_lane); cve_load(e1, F, gw + (ku + 1) * 2048, f_lane); cvh_load(h0, F, gw * 16 + ku, f_lane); cvh_load(h1, F, gw * 16 + ku + 1, f_lane); \
        __builtin_amdgcn_sched_barrier(0); \
        _Pragma("unroll") for (int q = 0; q < 8; ++q) { _Pragma("unroll") for (int e = 0; e < 8; ++e) { const unsigned k = (fkey((float)CUR[q][e]) & ~127u) | (unsigned)(127 - (64 * (M) + 8 * q + e)); TOPK_INSERT(a2, k); } } \
        __builtin_amdgcn_sched_barrier(0); \
        cve_finish(e0, F, gw + ku * 2048, f_lane); cve_finish(e1, F, gw + (ku + 1) * 2048, f_lane); cvh_finish(h0, F, gw * 16 + ku, f_lane, S2); cvh_finish(h1, F, gw * 16 + ku + 1, f_lane, S2); \
        __builtin_amdgcn_sched_barrier(0); }
        TK2_BATCH(sva, svb, sp + 64, 0)
        TK2_BATCH(svb, sva, spn, 1)
#undef TK2_BATCH
        if (kh == 0) {
#pragma unroll
            for (int i = 0; i < 16; ++i) a1[i] = a2[i];
            continue;
        }
        float v1[16], v2[16];
#pragma unroll
        for (int i = 0; i < 16; ++i) { ix[i] = (unsigned char)(127u - (a1[i] & 127u)); ix[16 + i] = (unsigned char)(127u - (a2[i] & 127u)); v1[i] = fkey_inv(a1[i] & ~127u); v2[i] = fkey_inv(a2[i] & ~127u); }
        unsigned cb[16];
#pragma unroll
        for (int i = 0; i < 16; ++i) cb[i] = 0u;
#pragma unroll
        for (int i = 0; i < 16; ++i)
#pragma unroll
            for (int j = 0; j < 16; ++j) if ((i + 1) * (j + 1) <= 16) { const unsigned k = (fkey(v1[i] + v2[j]) & ~255u) | (unsigned)(255 - (i * 16 + j)); TOPK_INSERT(cb, k); }
        float tv[16]; float mx = -3.0e38f;
#pragma unroll
        for (int k = 0; k < 16; ++k) { tv[k] = fkey_inv(cb[k] & ~255u); mx = fmaxf(mx, tv[k]); }
        float sum = 0.f;
#pragma unroll
        for (int k = 0; k < 16; ++k) { tv[k] = __expf(tv[k] - mx); sum += tv[k]; }
        const float inv = 1.0f / sum;
        LDS_WAIT(); asm volatile("" ::: "memory");
        int ev[16]; unsigned long long c64 = 0ull;
#pragma unroll
        for (int k = 0; k < 16; ++k) { const unsigned code = 255u - (cb[k] & 255u); const int i = code >> 4, j = code & 15; ev[k] = (int)ix[i] * 128 + (int)ix[16 + j]; c64 += 1ull << (8 * (ev[k] >> 11)); }
        unsigned long long s64 = c64;
#pragma unroll
        for (int o = 1; o < 8; o <<= 1) { const unsigned lo = __shfl_up((unsigned)s64, o, 8), hi2 = __shfl_up((unsigned)(s64 >> 32), o, 8); if ((f_lane & 7) >= o) s64 += ((unsigned long long)hi2 << 32) | lo; }
        const unsigned long long e64 = s64 - c64;
        const unsigned long long t64 = ((unsigned long long)__shfl((unsigned)(s64 >> 32), 7, 8) << 32) | __shfl((unsigned)s64, 7, 8);
        const unsigned long long st64 = (t64 * 0x0101010101010101ull) << 8;
        unsigned long long base64 = st64 + e64;
        int* eo = WSP(int, WS_EID) + (size_t)t * 128; float* go = WSP(float, WS_GATE) + (size_t)t * 128;
#pragma unroll
        for (int k = 0; k < 16; ++k) { const int r8 = 8 * (ev[k] >> 11); const int slot = (int)((base64 >> r8) & 255ull); base64 += 1ull << r8; eo[slot] = ev[k]; go[slot] = tv[k] * inv; }
        if (hd == 0) WSP(unsigned long long, WS_START)[t] = st64;
        LDS_WAIT(); asm volatile("" ::: "memory");
    }
}
__device__ __forceinline__ void p9_peer_down2(Frame& F) {
    const int f_tid = threadIdx.x, lane = f_tid & 63, f_wave = __builtin_amdgcn_readfirstlane(f_tid >> 6);
    const unsigned char* EV = F.ws + WS_EV;
    for (int wq = F.vcu * NWAVES + f_wave; wq < MTOK / 16; wq += F.G * NWAVES) {
        const int b = wq >> 7; const float* mb = WSP(float, WS_MOD) + (size_t)b * 6144;
        int ne_lo = WSP(int, WS_EID)[(size_t)wq * 16 * 128 + lane], ne_hi = WSP(int, WS_EID)[(size_t)wq * 16 * 128 + 64 + lane];
        float nw_lo = WSP(float, WS_GATE)[(size_t)wq * 16 * 128 + lane], nw_hi = WSP(float, WS_GATE)[(size_t)wq * 16 * 128 + 64 + lane];
        for (int tt = 0; tt < 16; ++tt) {
            const size_t t = (size_t)wq * 16 + tt;
            unsigned l16 = 16u * (unsigned)lane; asm volatile("" : "+v"(l16));
            float* xr = (float*)((char*)(F.out + t * 1024) + 4u * l16);
            const int e_lo = ne_lo, e_hi = ne_hi; const float w_lo = nw_lo, w_hi = nw_hi;
            f32x2 o[8];
#pragma unroll
            for (int i = 0; i < 8; ++i) o[i] = (f32x2){0.f, 0.f};
            v4u qa[8], qb[8];
#pragma unroll
            for (int j = 0; j < 8; ++j) { const int e = __builtin_amdgcn_readlane(e_lo, j); qa[j] = *(const v4u*)(EV + ((unsigned)e * 1024u + l16)); }
#define DN2_STEP(GRP, CUR, NXT) { \
                const int grp = (GRP); const int nb = ((grp + 1) & 7) * 8; const int ensel = (grp + 1) < 8 ? e_lo : e_hi; \
                { _Pragma("unroll") for (int j = 0; j < 8; ++j) { const int e = __builtin_amdgcn_readlane(ensel, nb + j); NXT[j] = *(const v4u*)(EV + ((unsigned)e * 1024u + l16)); } } \
                __builtin_amdgcn_sched_barrier(0); \
                const int base = (grp & 7) * 8; const float wsel = grp < 8 ? w_lo : w_hi; \
                _Pragma("unroll") for (int j = 0; j < 8; ++j) { const float wj = __builtin_bit_cast(float, __builtin_amdgcn_readlane(__builtin_bit_cast(int, wsel), base + j)); const f32x2 w2 = (f32x2){wj, wj}; \
                    _Pragma("unroll") for (int i = 0; i < 4; ++i) { const f32x2 lo = __builtin_amdgcn_cvt_pk_f32_fp8((int)CUR[j][i], false), hi = __builtin_amdgcn_cvt_pk_f32_fp8((int)CUR[j][i], true); o[2 * i] += w2 * lo; o[2 * i + 1] += w2 * hi; } } }
#pragma unroll 1
            for (int g2 = 0; g2 < 16; g2 += 2) { DN2_STEP(g2, qa, qb) DN2_STEP(g2 + 1, qb, qa) }
#undef DN2_STEP
            { const size_t tn = t + (tt < 15 ? 1 : 0); ne_lo = WSP(int, WS_EID)[tn * 128 + lane]; ne_hi = WSP(int, WS_EID)[tn * 128 + 64 + lane]; nw_lo = WSP(float, WS_GATE)[tn * 128 + lane]; nw_hi = WSP(float, WS_GATE)[tn * 128 + 64 + lane]; }
            float x1[16]; float ss = 0.f;
#pragma unroll
            for (int q4 = 0; q4 < 4; ++q4) { const f32x4 v = *(const f32x4*)(xr + 4 * q4); x1[4 * q4] = v[0]; x1[4 * q4 + 1] = v[1]; x1[4 * q4 + 2] = v[2]; x1[4 * q4 + 3] = v[3]; }
#pragma unroll
            for (int q4 = 0; q4 < 4; ++q4) { const f32x4 gt = *(const f32x4*)((const char*)(mb + 5120) + 4u * l16 + 16 * q4);
#pragma unroll
                for (int e = 0; e < 4; ++e) { const int i = 4 * q4 + e; x1[i] += gt[e] * o[i >> 1][i & 1]; ss += x1[i] * x1[i]; } }
            const float rf = rsqrt_f(wave_sum(ss) * (1.0f / 1024.0f) + EPSF);
#pragma unroll
            for (int q4 = 0; q4 < 4; ++q4) { const f32x4 nf = *(const f32x4*)((const char*)(F.a->in[29]) + 4u * l16 + 16 * q4); f32x4 v;
#pragma unroll
                for (int e = 0; e < 4; ++e) v[e] = x1[4 * q4 + e] * rf * nf[e];
                *(f32x4*)(xr + 4 * q4) = v; }
        }
    }
}
typedef long i64_t;
constexpr int U6_ROWP = 1040, U6_BUF = 8 * U6_ROWP, U6_WAVE = 2 * U6_BUF + 1024;
static_assert(8 * U6_WAVE <= LDS_MAIN, "U6 LDS map");
__device__ __forceinline__ void p8_peer_up6(Frame& F) {
    const int f_tid = threadIdx.x, lane = f_tid & 63, f_wave = __builtin_amdgcn_readfirstlane(f_tid >> 6);
    const int li = lane & 15, lq = lane >> 4;
    const unsigned char* EU = F.ws + WS_EU; const float* EUS = WSP(float, WS_EUS); const float* EVS = WSP(float, WS_EVS);
    LAS unsigned char* ring = F.lds + f_wave * U6_WAVE; LAS unsigned char* hq = ring + 2 * U6_BUF;
    for (int wq = F.vcu * NWAVES + f_wave; wq < MTOK / 16; wq += F.G * NWAVES) {
        const int b = wq >> 7; const float* mb = WSP(float, WS_MOD) + (size_t)b * 6144;
        for (int tt = 0; tt < 16; ++tt) {
            const size_t t = (size_t)wq * 16 + tt;
            unsigned l16 = 16u * (unsigned)lane; asm volatile("" : "+v"(l16));
            const int e_lo = WSP(int, WS_EID)[t * 128 + lane], e_hi = WSP(int, WS_EID)[t * 128 + 64 + lane];
            const float g_lo = WSP(float, WS_GATE)[t * 128 + lane], g_hi = WSP(float, WS_GATE)[t * 128 + 64 + lane];
            const float rs = rsqrt_f(WSP(float, WS_ROWSTAT)[t] * (1.0f / 1024.0f) + EPSF);
            const char* xs = (const char*)(WSP(bf16, WS_X1S) + t * 1024) + 2u * l16; const v4u xa = *(const v4u*)xs, xb = *(const v4u*)(xs + 16);
            asm volatile("s_waitcnt vmcnt(0)" ::: "memory");
#pragma unroll
            for (int j = 0; j < 8; ++j) { const int e = __builtin_amdgcn_readlane(e_lo, j);
                __builtin_amdgcn_global_load_lds((const unsigned*)(EU + ((unsigned)e * 1024u + l16)), (LAS unsigned*)(ring + j * U6_ROWP), 16, 0, 0); }
            const float su_lo = EUS[e_lo], su_hi = EUS[e_hi], sv_lo = EVS[e_lo], sv_hi = EVS[e_hi];
            float h2[16]; unpack8(xa, h2); unpack8(xb, h2 + 8); float mx = 0.f;
#pragma unroll
            for (int qd = 0; qd < 4; ++qd) { const f32x4 sh = *(const f32x4*)((const char*)(mb + 3072) + 4u * l16 + 16 * qd);
#pragma unroll
                for (int e = 0; e < 4; ++e) { h2[4 * qd + e] = h2[4 * qd + e] * rs + sh[e]; mx = fmaxf(mx, fabsf(h2[4 * qd + e])); } }
#pragma unroll
            for (int o = 1; o < 64; o <<= 1) mx = fmaxf(mx, __shfl_xor(mx, o));
            mx = fmaxf(mx, 1e-30f); const float hs = 224.0f / mx, hinv = mx * (1.0f / 224.0f);
            { v4u w;
#pragma unroll
              for (int qd = 0; qd < 4; ++qd) { int pk = 0; pk = __builtin_amdgcn_cvt_pk_fp8_f32(h2[4 * qd] * hs, h2[4 * qd + 1] * hs, pk, false); pk = __builtin_amdgcn_cvt_pk_fp8_f32(h2[4 * qd + 2] * hs, h2[4 * qd + 3] * hs, pk, true); w[qd] = (unsigned)pk; }
              *(LAS v4u*)(hq + l16) = w; }
            LDS_WAIT(); asm volatile("" ::: "memory");
            v4u hb[16];
#pragma unroll
            for (int c = 0; c < 16; ++c) hb[c] = *(const LAS v4u*)(hq + 64 * c + 16 * lq);
            asm volatile("s_waitcnt vmcnt(0)" ::: "memory");
            float w_lo = 0.f, w_hi = 0.f;
#pragma unroll 1
            for (int u = 0; u < 16; ++u) {
                { const int un = (u + 1) & 15; const int ensel = un < 8 ? e_lo : e_hi; const int nb = (un & 7) * 8; LAS unsigned char* dst = ring + ((u + 1) & 1) * U6_BUF;
#pragma unroll
                  for (int j = 0; j < 8; ++j) { const int e = __builtin_amdgcn_readlane(ensel, nb + j);
                      __builtin_amdgcn_global_load_lds((const unsigned*)(EU + ((unsigned)e * 1024u + l16)), (LAS unsigned*)(dst + j * U6_ROWP), 16, 0, 0); } }
                asm volatile("s_waitcnt vmcnt(8)" ::: "memory");
                const LAS unsigned char* src = ring + (u & 1) * U6_BUF + (li & 7) * U6_ROWP + 16 * lq;
                f32x4 acc = (f32x4){0.f, 0.f, 0.f, 0.f};
#ifdef HALF_READ
                v4u av[16];
#pragma unroll
                for (int c = 0; c < 16; ++c) asm volatile("" : "=v"(av[c]));
                if (li < 8) {
#pragma unroll
                    for (int c = 0; c < 16; ++c) av[c] = *(const LAS v4u*)(src + 64 * c); }
#pragma unroll
                for (int c = 0; c < 16; ++c) { const v4u a = av[c];
#else
#pragma unroll
                for (int c = 0; c < 16; ++c) { const v4u a = *(const LAS v4u*)(src + 64 * c);
#endif
                    acc = __builtin_amdgcn_mfma_f32_16x16x32_fp8_fp8((i64_t)(((unsigned long long)a[1] << 32) | a[0]), (i64_t)(((unsigned long long)hb[c][1] << 32) | hb[c][0]), acc, 0, 0, 0);
                    acc = __builtin_amdgcn_mfma_f32_16x16x32_fp8_fp8((i64_t)(((unsigned long long)a[3] << 32) | a[2]), (i64_t)(((unsigned long long)hb[c][3] << 32) | hb[c][2]), acc, 0, 0, 0); }
                const int base = (u & 7) * 8; const int r = li & 3;
                const float sel = r == 0 ? acc[0] : (r == 1 ? acc[1] : (r == 2 ? acc[2] : acc[3]));
                const float dmine = __shfl(sel, ((lane & 7) >> 2) * 16 + (lane & 3));
                const float gsel = u < 8 ? g_lo : g_hi, susel = u < 8 ? su_lo : su_hi, svsel = u < 8 ? sv_lo : sv_hi;
                const float wv = gsel * gelu_erf(dmine * susel * hinv) * svsel;
                const bool mine = (lane >= base) && (lane < base + 8);
                if (u < 8) w_lo = mine ? wv : w_lo; else w_hi = mine ? wv : w_hi;
                asm volatile("s_waitcnt lgkmcnt(0)" ::: "memory");
            }
            WSP(float, WS_GATE)[t * 128 + lane] = w_lo; WSP(float, WS_GATE)[t * 128 + 64 + lane] = w_hi;
        }
    }
}
struct U10Meta { int elo, ehi; float glo, ghi; v4u xa, xb; float rst; };
__device__ __forceinline__ void u10_meta_load(U10Meta& M, const unsigned char* ws, size_t t, unsigned l16) {
    const unsigned l = l16 >> 4; const int* ep = (const int*)(ws + WS_EID) + t * 128; const float* gp = (const float*)(ws + WS_GATE) + t * 128;
    M.elo = ep[l]; M.ehi = ep[64 + l]; M.glo = gp[l]; M.ghi = gp[64 + l];
    const char* xs = (const char*)(ws + WS_X1S) + t * 2048 + 2u * l16; M.xa = *(const v4u*)xs; M.xb = *(const v4u*)(xs + 16);
    M.rst = ((const float*)(ws + WS_ROWSTAT))[t + (l16 >> 30)];
}
__device__ __forceinline__ void u10_meta_touch(U10Meta& M) { asm volatile("" : "+v"(M.elo), "+v"(M.ehi), "+v"(M.glo), "+v"(M.ghi), "+v"(M.xa), "+v"(M.xb), "+v"(M.rst)); }
template <int UN> __device__ __forceinline__ void u10_unit_dma(int elo, int ehi, const unsigned char* EU, unsigned l16, LAS unsigned char* dst) {
    const int ensel = UN < 8 ? elo : ehi; constexpr int nb = (UN & 7) * 8;
#pragma unroll
    for (int j = 0; j < 8; ++j) { const int e = __builtin_amdgcn_readlane(ensel, nb + j);
        __builtin_amdgcn_global_load_lds((const unsigned*)(EU + ((unsigned)e * 1024u + l16)), (LAS unsigned*)(dst + j * U6_ROWP), 16, 0, 0); }
}
__device__ __forceinline__ void u10_h2(const U10Meta& M, const float* S2, LAS unsigned char* hq, unsigned l16, int lq, v4u* hb, float& hinv) {
    float h2[16]; unpack8(M.xa, h2); unpack8(M.xb, h2 + 8); float mx = 0.f;
    const float rs = rsqrt_f(M.rst * (1.0f / 1024.0f) + EPSF);
#pragma unroll
    for (int i = 0; i < 16; ++i) { h2[i] = h2[i] * rs + S2[i]; mx = fmaxf(mx, fabsf(h2[i])); }
#pragma unroll
    for (int o = 1; o < 64; o <<= 1) mx = fmaxf(mx, __shfl_xor(mx, o));
    mx = fmaxf(mx, 1e-30f); const float hs = 224.0f / mx; hinv = mx * (1.0f / 224.0f);
    v4u w;
#pragma unroll
    for (int qd = 0; qd < 4; ++qd) { int pk = 0; pk = __builtin_amdgcn_cvt_pk_fp8_f32(h2[4 * qd] * hs, h2[4 * qd + 1] * hs, pk, false); pk = __builtin_amdgcn_cvt_pk_fp8_f32(h2[4 * qd + 2] * hs, h2[4 * qd + 3] * hs, pk, true); w[qd] = (unsigned)pk; }
    *(LAS v4u*)(hq + l16) = w;
    LDS_WAIT(); asm volatile("" ::: "memory");
#pragma unroll
    for (int c = 0; c < 16; ++c) hb[c] = *(const LAS v4u*)(hq + 64 * c + 16 * lq);
    LDS_WAIT(); asm volatile("" ::: "memory");
}
template <int U> __device__ __forceinline__ void u10_unit(const U10Meta& C, U10Meta& N, const unsigned char* EU, const unsigned char* ws, unsigned l16, LAS unsigned char* ring, const v4u* hb, float hinv,
                                                          float su_lo, float su_hi, float sv_lo, float sv_hi, float& nsu_lo, float& nsu_hi, float& nsv_lo, float& nsv_hi,
                                                          float& w_lo, float& w_hi, size_t tn, bool first_token, int lane) {
    const int li = lane & 15, lq = lane >> 4;
    if (U == 15) u10_unit_dma<0>(N.elo, N.ehi, EU, l16, ring); else u10_unit_dma<(U + 1) & 15>(C.elo, C.ehi, EU, l16, ring + ((U + 1) & 1) * U6_BUF);
    __builtin_amdgcn_sched_barrier(0);
    if (U == 0) { if (first_token) asm volatile("s_waitcnt vmcnt(8)" ::: "memory"); else asm volatile("s_waitcnt vmcnt(10)" ::: "memory"); }
    else if (U == 3) asm volatile("s_waitcnt vmcnt(15)" ::: "memory");
    else if (U == 11) asm volatile("s_waitcnt vmcnt(12)" ::: "memory");
    else asm volatile("s_waitcnt vmcnt(8)" ::: "memory");
    if (U == 4) u10_meta_touch(N);
    if (U == 12) asm volatile("" : "+v"(nsu_lo), "+v"(nsu_hi), "+v"(nsv_lo), "+v"(nsv_hi));
    __builtin_amdgcn_sched_barrier(0);
    const LAS unsigned char* src = ring + (U & 1) * U6_BUF + (li & 7) * U6_ROWP + 16 * lq;
    f32x4 acc = (f32x4){0.f, 0.f, 0.f, 0.f};
#pragma unroll
    for (int c = 0; c < 16; ++c) { const v4u a = *(const LAS v4u*)(src + 64 * c);
        acc = __builtin_amdgcn_mfma_f32_16x16x32_fp8_fp8((i64_t)(((unsigned long long)a[1] << 32) | a[0]), (i64_t)(((unsigned long long)hb[c][1] << 32) | hb[c][0]), acc, 0, 0, 0);
        acc = __builtin_amdgcn_mfma_f32_16x16x32_fp8_fp8((i64_t)(((unsigned long long)a[3] << 32) | a[2]), (i64_t)(((unsigned long long)hb[c][3] << 32) | hb[c][2]), acc, 0, 0, 0); }
    constexpr int base = (U & 7) * 8; const int r = li & 3;
    const float sel = r == 0 ? acc[0] : (r == 1 ? acc[1] : (r == 2 ? acc[2] : acc[3]));
    const float dmine = __shfl(sel, ((lane & 7) >> 2) * 16 + (lane & 3));
    const float gsel = U < 8 ? C.glo : C.ghi, susel = U < 8 ? su_lo : su_hi, svsel = U < 8 ? sv_lo : sv_hi;
    const float wv = gsel * gelu_erf(dmine * susel * hinv) * svsel;
    const bool mine = (lane >= base) && (lane < base + 8);
    if (U < 8) w_lo = mine ? wv : w_lo; else w_hi = mine ? wv : w_hi;
    asm volatile("s_waitcnt lgkmcnt(0)" ::: "memory");
    __builtin_amdgcn_sched_barrier(0);
    if (U == 2) { u10_meta_load(N, ws, tn, l16); __builtin_amdgcn_sched_barrier(0); }
    if (U == 10) { const float* EUS = (const float*)(ws + WS_EUS); const float* EVS = (const float*)(ws + WS_EVS); nsu_lo = EUS[N.elo]; nsu_hi = EUS[N.ehi]; nsv_lo = EVS[N.elo]; nsv_hi = EVS[N.ehi]; __builtin_amdgcn_sched_barrier(0); }
}
__device__ __forceinline__ void p8_peer_up10(Frame& F) {
    const int f_tid = threadIdx.x, lane = f_tid & 63, f_wave = __builtin_amdgcn_readfirstlane(f_tid >> 6);
    const int lq = lane >> 4;
    const unsigned char* EU = F.ws + WS_EU; const float* EUS = WSP(float, WS_EUS); const float* EVS = WSP(float, WS_EVS);
    LAS unsigned char* ring = F.lds + f_wave * U6_WAVE; LAS unsigned char* hq = ring + 2 * U6_BUF;
    for (int wq = F.vcu * NWAVES + f_wave; wq < MTOK / 16; wq += F.G * NWAVES) {
        const int b = wq >> 7; const float* mb = WSP(float, WS_MOD) + (size_t)b * 6144;
        unsigned l16 = 16u * (unsigned)lane; asm volatile("" : "+v"(l16));
        float S2[16];
#pragma unroll
        for (int q = 0; q < 4; ++q) { const f32x4 sh = *(const f32x4*)((const char*)(mb + 3072) + 4u * l16 + 16 * q); S2[4 * q] = sh[0]; S2[4 * q + 1] = sh[1]; S2[4 * q + 2] = sh[2]; S2[4 * q + 3] = sh[3]; }
        const size_t t0 = (size_t)wq * 16;
        U10Meta C, N;
        u10_meta_load(C, F.ws, t0, l16);
        asm volatile("s_waitcnt vmcnt(0)" ::: "memory");
        u10_meta_touch(C);
        u10_unit_dma<0>(C.elo, C.ehi, EU, l16, ring);
        float su_lo = EUS[C.elo], su_hi = EUS[C.ehi], sv_lo = EVS[C.elo], sv_hi = EVS[C.ehi];
        float nsu_lo = 0.f, nsu_hi = 0.f, nsv_lo = 0.f, nsv_hi = 0.f;
        v4u hb[16]; float hinv;
        u10_h2(C, S2, hq, l16, lq, hb, hinv);
        N = C;
        asm volatile("s_waitcnt vmcnt(0)" ::: "memory");
        asm volatile("" : "+v"(su_lo), "+v"(su_hi), "+v"(sv_lo), "+v"(sv_hi));
#pragma unroll 1
        for (int tt = 0; tt < 16; ++tt) {
            float w_lo = 0.f, w_hi = 0.f;
            const size_t tn = t0 + (tt < 15 ? tt + 1 : tt);
            const bool ft = (tt == 0);
#define U10_U(U) u10_unit<U>(C, N, EU, F.ws, l16, ring, hb, hinv, su_lo, su_hi, sv_lo, sv_hi, nsu_lo, nsu_hi, nsv_lo, nsv_hi, w_lo, w_hi, tn, ft, lane);
            U10_U(0) U10_U(1) U10_U(2) U10_U(3) U10_U(4) U10_U(5) U10_U(6) U10_U(7) U10_U(8) U10_U(9) U10_U(10) U10_U(11) U10_U(12) U10_U(13) U10_U(14) U10_U(15)
#undef U10_U
            WSP(float, WS_GATE)[(t0 + tt) * 128 + lane] = w_lo; WSP(float, WS_GATE)[(t0 + tt) * 128 + 64 + lane] = w_hi;
            __builtin_amdgcn_sched_barrier(0);
            C = N; su_lo = nsu_lo; su_hi = nsu_hi; sv_lo = nsv_lo; sv_hi = nsv_hi;
            u10_h2(C, S2, hq, l16, lq, hb, hinv);
        }
        asm volatile("s_waitcnt vmcnt(0)" ::: "memory");
    }
}
#ifndef U11_AUX
#define U11_AUX 0
#endif
constexpr int U11_HQ = 2 * U6_BUF, U11_IDS = U11_HQ + 1024, U11_GATES = U11_IDS + 512, U11_SC = U11_GATES + 512, U11_HINV = U11_SC + 1024, U11_WAVE = U11_HINV + 256;
static_assert(8 * U11_WAVE <= LDS_MAIN, "U11 LDS map");
__device__ __forceinline__ void u11_dma4(const void* g, LAS unsigned char* l) { __builtin_amdgcn_global_load_lds((const unsigned*)g, (LAS unsigned*)l, 4, 0, 0); }
__device__ __forceinline__ void u11_stage1(const unsigned char* ws, size_t t, unsigned l16, LAS unsigned char* W) {
    const unsigned l4 = l16 >> 2;
    const unsigned char* ep = ws + WS_EID + t * 512; const unsigned char* gp = ws + WS_GATE + t * 512;
    u11_dma4(ep + l4, W + U11_IDS); u11_dma4(ep + 256 + l4, W + U11_IDS + 256);
    u11_dma4(gp + l4, W + U11_GATES); u11_dma4(gp + 256 + l4, W + U11_GATES + 256);
    __builtin_amdgcn_global_load_lds((const unsigned*)(ws + WS_H2Q + t * 1024 + l16), (LAS unsigned*)(W + U11_HQ), 16, 0, 0);
    u11_dma4(ws + WS_HINV + t * 4 + (l16 >> 30), W + U11_HINV);
}
__device__ __forceinline__ void u11_stage2(const unsigned char* ws, int elo, int ehi, LAS unsigned char* W) {
    u11_dma4(ws + WS_EUS + 4u * (unsigned)elo, W + U11_SC); u11_dma4(ws + WS_EUS + 4u * (unsigned)ehi, W + U11_SC + 256);
    u11_dma4(ws + WS_EVS + 4u * (unsigned)elo, W + U11_SC + 512); u11_dma4(ws + WS_EVS + 4u * (unsigned)ehi, W + U11_SC + 768);
}
template <int UN> __device__ __forceinline__ void u11_unit_dma(int elo, int ehi, const unsigned char* EU, unsigned l16, LAS unsigned char* dst) {
    const int ensel = UN < 8 ? elo : ehi; constexpr int nb = (UN & 7) * 8;
#pragma unroll
    for (int j = 0; j < 8; ++j) { const int e = __builtin_amdgcn_readlane(ensel, nb + j);
        __builtin_amdgcn_global_load_lds((const unsigned*)(EU + ((unsigned)e * 1024u + l16)), (LAS unsigned*)(dst + j * U6_ROWP), 16, 0, U11_AUX); }
}
struct U11Tok { int elo, ehi; float glo, ghi, su_lo, su_hi, sv_lo, sv_hi, hinv; };
__device__ __forceinline__ void u11_switch(U11Tok& C, int nelo, int nehi, LAS unsigned char* W, unsigned l16, int lq, v4u* hb) {
    const unsigned l4 = l16 >> 2;
    C.elo = nelo; C.ehi = nehi;
    C.glo = *(const LAS float*)(W + U11_GATES + l4); C.ghi = *(const LAS float*)(W + U11_GATES + 256 + l4);
    C.su_lo = *(const LAS float*)(W + U11_SC + l4); C.su_hi = *(const LAS float*)(W + U11_SC + 256 + l4); C.sv_lo = *(const LAS float*)(W + U11_SC + 512 + l4); C.sv_hi = *(const LAS float*)(W + U11_SC + 768 + l4);
    C.hinv = *(const LAS float*)(W + U11_HINV + l4);
#pragma unroll
    for (int c = 0; c < 16; ++c) hb[c] = *(const LAS v4u*)(W + U11_HQ + 64 * c + 16 * lq);
    LDS_WAIT(); asm volatile("" ::: "memory");
}
template <int U> __device__ __forceinline__ void u11_unit(const U11Tok& C, int& nelo, int& nehi, const unsigned char* EU, const unsigned char* ws, unsigned l16, LAS unsigned char* W, const v4u* hb,
                                                          float& w_lo, float& w_hi, size_t tn, bool first_token, int lane) {
    const int li = lane & 15, lq = lane >> 4;
    if (U == 15) u11_unit_dma<0>(nelo, nehi, EU, l16, W); else u11_unit_dma<(U + 1) & 15>(C.elo, C.ehi, EU, l16, W + ((U + 1) & 1) * U6_BUF);
    __builtin_amdgcn_sched_barrier(0);
    if (U == 0) { if (first_token) asm volatile("s_waitcnt vmcnt(8)" ::: "memory"); else asm volatile("s_waitcnt vmcnt(10)" ::: "memory"); }
    else if (U == 3) asm volatile("s_waitcnt vmcnt(14)" ::: "memory");
    else if (U == 5) asm volatile("s_waitcnt vmcnt(12)" ::: "memory");
    else asm volatile("s_waitcnt vmcnt(8)" ::: "memory");
    __builtin_amdgcn_sched_barrier(0);
    const LAS unsigned char* src = W + (U & 1) * U6_BUF + (li & 7) * U6_ROWP + 16 * lq;
    f32x4 acc = (f32x4){0.f, 0.f, 0.f, 0.f};
#pragma unroll
    for (int c = 0; c < 16; ++c) { const v4u a = *(const LAS v4u*)(src + 64 * c);
        acc = __builtin_amdgcn_mfma_f32_16x16x32_fp8_fp8((i64_t)(((unsigned long long)a[1] << 32) | a[0]), (i64_t)(((unsigned long long)hb[c][1] << 32) | hb[c][0]), acc, 0, 0, 0);
        acc = __builtin_amdgcn_mfma_f32_16x16x32_fp8_fp8((i64_t)(((unsigned long long)a[3] << 32) | a[2]), (i64_t)(((unsigned long long)hb[c][3] << 32) | hb[c][2]), acc, 0, 0, 0); }
    constexpr int base = (U & 7) * 8; const int r = li & 3;
    const float sel = r == 0 ? acc[0] : (r == 1 ? acc[1] : (r == 2 ? acc[2] : acc[3]));
    const float dmine = __shfl(sel, ((lane & 7) >> 2) * 16 + (lane & 3));
    const float gsel = U < 8 ? C.glo : C.ghi, susel = U < 8 ? C.su_lo : C.su_hi, svsel = U < 8 ? C.sv_lo : C.sv_hi;
    const float wv = gsel * gelu_erf(dmine * susel * C.hinv) * svsel;
    const bool mine = (lane >= base) && (lane < base + 8);
    if (U < 8) w_lo = mine ? wv : w_lo; else w_hi = mine ? wv : w_hi;
    if (U == 4) { nelo = *(const LAS int*)(W + U11_IDS + (l16 >> 2)); nehi = *(const LAS int*)(W + U11_IDS + 256 + (l16 >> 2)); }
    asm volatile("s_waitcnt lgkmcnt(0)" ::: "memory");
    __builtin_amdgcn_sched_barrier(0);
    if (U == 2) { u11_stage1(ws, tn, l16, W); __builtin_amdgcn_sched_barrier(0); }
    if (U == 4) { u11_stage2(ws, nelo, nehi, W); __builtin_amdgcn_sched_barrier(0); }
}
__device__ __forceinline__ void p8_peer_up11(Frame& F) {
    const int f_tid = threadIdx.x, lane = f_tid & 63, f_wave = __builtin_amdgcn_readfirstlane(f_tid >> 6);
    const int lq = lane >> 4;
    const unsigned char* EU = F.ws + WS_EU;
    LAS unsigned char* W = F.lds + f_wave * U11_WAVE;
    for (int wq = F.vcu * NWAVES + f_wave; wq < MTOK / 16; wq += F.G * NWAVES) {
        unsigned l16 = 16u * (unsigned)lane; asm volatile("" : "+v"(l16));
        const size_t t0 = (size_t)wq * 16;
        u11_stage1(F.ws, t0, l16, W);
        asm volatile("s_waitcnt vmcnt(0)" ::: "memory");
        int nelo = *(const LAS int*)(W + U11_IDS + (l16 >> 2)), nehi = *(const LAS int*)(W + U11_IDS + 256 + (l16 >> 2));
        LDS_WAIT(); asm volatile("" ::: "memory");
        u11_stage2(F.ws, nelo, nehi, W);
        u11_unit_dma<0>(nelo, nehi, EU, l16, W);
        asm volatile("s_waitcnt vmcnt(0)" ::: "memory");
        U11Tok C; v4u hb[16];
        u11_switch(C, nelo, nehi, W, l16, lq, hb);
#pragma unroll 1
        for (int tt = 0; tt < 16; ++tt) {
            float w_lo = 0.f, w_hi = 0.f;
            const size_t tn = t0 + (tt < 15 ? tt + 1 : tt);
            const bool ft = (tt == 0);
#define U11_U(U) u11_unit<U>(C, nelo, nehi, EU, F.ws, l16, W, hb, w_lo, w_hi, tn, ft, lane);
            U11_U(0) U11_U(1) U11_U(2) U11_U(3) U11_U(4) U11_U(5) U11_U(6) U11_U(7) U11_U(8) U11_U(9) U11_U(10) U11_U(11) U11_U(12) U11_U(13) U11_U(14) U11_U(15)
#undef U11_U
            WSP(float, WS_GATE)[(t0 + tt) * 128 + lane] = w_lo; WSP(float, WS_GATE)[(t0 + tt) * 128 + 64 + lane] = w_hi;
            __builtin_amdgcn_sched_barrier(0);
            u11_switch(C, nelo, nehi, W, l16, lq, hb);
        }
        asm volatile("s_waitcnt vmcnt(0)" ::: "memory");
    }
}
typedef unsigned v3u __attribute__((ext_vector_type(3)));
typedef unsigned v6u __attribute__((ext_vector_type(6)));
typedef float f32x32 __attribute__((ext_vector_type(32)));
struct __attribute__((packed, aligned(4))) U3 { unsigned a, b, c; };
__device__ __forceinline__ v3u ld_row6(const unsigned char* p) { const U3 u = *(const U3*)p; return (v3u){u.a, u.b, u.c}; }
__device__ __forceinline__ void p9_peer_down3(Frame& F) {
    const int f_tid = threadIdx.x, lane = f_tid & 63, f_wave = __builtin_amdgcn_readfirstlane(f_tid >> 6);
    const unsigned char* EV = F.ws + WS_EV;
    for (int wq = F.vcu * NWAVES + f_wave; wq < MTOK / 16; wq += F.G * NWAVES) {
        const int b = wq >> 7; const float* mb = WSP(float, WS_MOD) + (size_t)b * 6144;
        int ne_lo = WSP(int, WS_EID)[(size_t)wq * 16 * 128 + lane], ne_hi = WSP(int, WS_EID)[(size_t)wq * 16 * 128 + 64 + lane];
        float nw_lo = WSP(float, WS_GATE)[(size_t)wq * 16 * 128 + lane], nw_hi = WSP(float, WS_GATE)[(size_t)wq * 16 * 128 + 64 + lane];
        for (int tt = 0; tt < 16; ++tt) {
            const size_t t = (size_t)wq * 16 + tt;
            unsigned l16 = 16u * (unsigned)lane; asm volatile("" : "+v"(l16));
            const unsigned l12 = (l16 >> 2) * 3u;
            float* xr = (float*)((char*)(F.out + t * 1024) + 4u * l16);
            const int e_lo = ne_lo, e_hi = ne_hi; const float w_lo = nw_lo, w_hi = nw_hi;
            f32x2 o[8];
#pragma unroll
            for (int i = 0; i < 8; ++i) o[i] = (f32x2){0.f, 0.f};
#ifdef DN3_G16
            v3u qa[16], qb[16];
#pragma unroll
            for (int j = 0; j < 16; ++j) { const int e = __builtin_amdgcn_readlane(e_lo, j); qa[j] = ld_row6(EV + ((unsigned)e * 768u + l12)); }
#define DN3_STEP(GRP, CUR, NXT) { \
                const int grp = (GRP); const int nb = ((grp + 1) & 3) * 16; const int ensel = ((grp + 1) & 7) < 4 ? e_lo : e_hi; \
                { _Pragma("unroll") for (int j = 0; j < 16; ++j) { const int e = __builtin_amdgcn_readlane(ensel, nb + j); NXT[j] = ld_row6(EV + ((unsigned)e * 768u + l12)); } } \
                __builtin_amdgcn_sched_barrier(0); \
                const int base = (grp & 3) * 16; const float wsel = grp < 4 ? w_lo : w_hi; \
                _Pragma("unroll") for (int j = 0; j < 16; j += 2) { \
                    const float wa = __builtin_bit_cast(float, __builtin_amdgcn_readlane(__builtin_bit_cast(int, wsel), base + j)), wb = __builtin_bit_cast(float, __builtin_amdgcn_readlane(__builtin_bit_cast(int, wsel), base + j + 1)); \
                    const f32x2 wa2 = (f32x2){wa, wa}, wb2 = (f32x2){wb, wb}; \
                    const v6u pr = (v6u){CUR[j][0], CUR[j][1], CUR[j][2], CUR[j + 1][0], CUR[j + 1][1], CUR[j + 1][2]}; \
                    const f32x32 r = __builtin_amdgcn_cvt_scalef32_pk32_f32_fp6(pr, 1.0f); \
                    _Pragma("unroll") for (int i = 0; i < 8; ++i) { o[i] += wa2 * (f32x2){r[2 * i], r[2 * i + 1]}; o[i] += wb2 * (f32x2){r[16 + 2 * i], r[17 + 2 * i]}; } } }
#pragma unroll 1
            for (int g2 = 0; g2 < 8; g2 += 2) { DN3_STEP(g2, qa, qb) DN3_STEP(g2 + 1, qb, qa) }
#else
            v3u qa[8], qb[8];
#pragma unroll
            for (int j = 0; j < 8; ++j) { const int e = __builtin_amdgcn_readlane(e_lo, j); qa[j] = ld_row6(EV + ((unsigned)e * 768u + l12)); }
#define DN3_STEP(GRP, CUR, NXT) { \
                const int grp = (GRP); const int nb = ((grp + 1) & 7) * 8; const int ensel = (grp + 1) < 8 ? e_lo : e_hi; \
                { _Pragma("unroll") for (int j = 0; j < 8; ++j) { const int e = __builtin_amdgcn_readlane(ensel, nb + j); NXT[j] = ld_row6(EV + ((unsigned)e * 768u + l12)); } } \
                __builtin_amdgcn_sched_barrier(0); \
                const int base = (grp & 7) * 8; const float wsel = grp < 8 ? w_lo : w_hi; \
                _Pragma("unroll") for (int j = 0; j < 8; j += 2) { \
                    const float wa = __builtin_bit_cast(float, __builtin_amdgcn_readlane(__builtin_bit_cast(int, wsel), base + j)), wb = __builtin_bit_cast(float, __builtin_amdgcn_readlane(__builtin_bit_cast(int, wsel), base + j + 1)); \
                    const f32x2 wa2 = (f32x2){wa, wa}, wb2 = (f32x2){wb, wb}; \
                    const v6u pr = (v6u){CUR[j][0], CUR[j][1], CUR[j][2], CUR[j + 1][0], CUR[j + 1][1], CUR[j + 1][2]}; \
                    const f32x32 r = __builtin_amdgcn_cvt_scalef32_pk32_f32_fp6(pr, 1.0f); \
                    _Pragma("unroll") for (int i = 0; i < 8; ++i) { o[i] += wa2 * (f32x2){r[2 * i], r[2 * i + 1]}; o[i] += wb2 * (f32x2){r[16 + 2 * i], r[17 + 2 * i]}; } } }
#pragma unroll 1
            for (int g2 = 0; g2 < 16; g2 += 2) { DN3_STEP(g2, qa, qb) DN3_STEP(g2 + 1, qb, qa) }
#endif
#undef DN3_STEP
            { const size_t tn = t + (tt < 15 ? 1 : 0); ne_lo = WSP(int, WS_EID)[tn * 128 + lane]; ne_hi = WSP(int, WS_EID)[tn * 128 + 64 + lane]; nw_lo = WSP(float, WS_GATE)[tn * 128 + lane]; nw_hi = WSP(float, WS_GATE)[tn * 128 + 64 + lane]; }
            float x1[16]; float ss = 0.f;
#pragma unroll
            for (int q4 = 0; q4 < 4; ++q4) { const f32x4 v = *(const f32x4*)(xr + 4 * q4); x1[4 * q4] = v[0]; x1[4 * q4 + 1] = v[1]; x1[4 * q4 + 2] = v[2]; x1[4 * q4 + 3] = v[3]; }
#pragma unroll
            for (int q4 = 0; q4 < 4; ++q4) { const f32x4 gt = *(const f32x4*)((const char*)(mb + 5120) + 4u * l16 + 16 * q4);
#pragma unroll
                for (int e = 0; e < 4; ++e) { const int i = 4 * q4 + e; x1[i] += gt[e] * o[i >> 1][i & 1]; ss += x1[i] * x1[i]; } }
            const float rf = rsqrt_f(wave_sum(ss) * (1.0f / 1024.0f) + EPSF);
#pragma unroll
            for (int q4 = 0; q4 < 4; ++q4) { const f32x4 nf = *(const f32x4*)((const char*)(F.a->in[29]) + 4u * l16 + 16 * q4); f32x4 v;
#pragma unroll
                for (int e = 0; e < 4; ++e) v[e] = x1[4 * q4 + e] * rf * nf[e];
                *(f32x4*)(xr + 4 * q4) = v; }
        }
    }
}
constexpr int U12_ROWP = 784, U12_NBUF = 3, U12_BUF = 8 * U12_ROWP, U12_WAVE = U12_NBUF * U12_BUF + 1024;
static_assert(8 * U12_WAVE <= LDS_MAIN, "U12 LDS map");
typedef int i32x8 __attribute__((ext_vector_type(8)));
typedef unsigned v2u __attribute__((ext_vector_type(2)));
__device__ __forceinline__ void p8_peer_up12(Frame& F) {
    const int f_tid = threadIdx.x, lane = f_tid & 63, f_wave = __builtin_amdgcn_readfirstlane(f_tid >> 6);
    const int li = lane & 15, lq = lane >> 4;
    const unsigned char* EU = F.ws + WS_EU; const float* EUS = WSP(float, WS_EUS); const float* EVS = WSP(float, WS_EVS);
    LAS unsigned char* ring = F.lds + f_wave * U12_WAVE; LAS unsigned char* hq = ring + U12_NBUF * U12_BUF;
#ifdef PROBE_MFMA
    if (blockIdx.x == 0 && f_wave == 0) {
        i32x8 A = (i32x8){0, 0, 0, 0, 0, 0, 0, 0}; if (lane == PROBE_ALANE) A[PROBE_AREG] = PROBE_AVAL;
        i32x8 B;
        if (PROBE_BPAT == 0) B = (i32x8){0x48444038, 0x504E4C4A, 0x54535251, 0x58575655, 0x48444038, 0x504E4C4A, 0x54535251, 0x58575655};
        else { const unsigned c0 = (const unsigned[]){0x38u, 0x40u, 0x44u, 0x48u, 0x4Au, 0x4Cu, 0x4Eu, 0x50u}[0]; (void)c0;
               const int k = lane >> 4; const unsigned lo = k == 0 ? 0x38u : (k == 1 ? 0x44u : (k == 2 ? 0x4Au : 0x4Eu)), hi = k == 0 ? 0x40u : (k == 1 ? 0x48u : (k == 2 ? 0x4Cu : 0x50u));
               const int wl = (int)(lo * 0x01010101u), wh = (int)(hi * 0x01010101u); B = (i32x8){wl, wl, wl, wl, wh, wh, wh, wh}; }
        f32x4 acc = (f32x4){0.f, 0.f, 0.f, 0.f};
        acc = __builtin_amdgcn_mfma_scale_f32_16x16x128_f8f6f4(A, B, acc, 2, 0, 0, 0, 0, 0);
        if (lane == 0) *(volatile float*)(F.ws + WS_CTL + 40000) = acc[0] * 100.0f;
    }
#endif
    for (int wq = F.vcu * NWAVES + f_wave; wq < MTOK / 16; wq += F.G * NWAVES) {
        const int b = wq >> 7; const float* mb = WSP(float, WS_MOD) + (size_t)b * 6144;
        for (int tt = 0; tt < 16; ++tt) {
            const size_t t = (size_t)wq * 16 + tt;
            unsigned l16 = 16u * (unsigned)lane; asm volatile("" : "+v"(l16));
            const int e_lo = WSP(int, WS_EID)[t * 128 + lane], e_hi = WSP(int, WS_EID)[t * 128 + 64 + lane];
            const float g_lo = WSP(float, WS_GATE)[t * 128 + lane], g_hi = WSP(float, WS_GATE)[t * 128 + 64 + lane];
            const float rs = rsqrt_f(WSP(float, WS_ROWSTAT)[t] * (1.0f / 1024.0f) + EPSF);
            const char* xs = (const char*)(WSP(bf16, WS_X1S) + t * 1024) + 2u * l16; const v4u xa = *(const v4u*)xs, xb = *(const v4u*)(xs + 16);
            asm volatile("s_waitcnt vmcnt(0)" ::: "memory");
            if (lane < 48) {
#pragma unroll
            for (int j = 0; j < 16; ++j) { const int e = __builtin_amdgcn_readlane(e_lo, j);
                __builtin_amdgcn_global_load_lds((const unsigned*)(EU + ((unsigned)e * 768u + l16)), (LAS unsigned*)(ring + j * U12_ROWP), 16, 0, 0); } }
            const float su_lo = EUS[e_lo], su_hi = EUS[e_hi], sv_lo = EVS[e_lo], sv_hi = EVS[e_hi];
            float h2[16]; unpack8(xa, h2); unpack8(xb, h2 + 8); float mx = 0.f;
#pragma unroll
            for (int qd = 0; qd < 4; ++qd) { const f32x4 sh = *(const f32x4*)((const char*)(mb + 3072) + 4u * l16 + 16 * qd);
#pragma unroll
                for (int e = 0; e < 4; ++e) { h2[4 * qd + e] = h2[4 * qd + e] * rs + sh[e]; mx = fmaxf(mx, fabsf(h2[4 * qd + e])); } }
#pragma unroll
            for (int o = 1; o < 64; o <<= 1) mx = fmaxf(mx, __shfl_xor(mx, o));
            mx = fmaxf(mx, 1e-30f); const float hs = 224.0f / mx, hinv = mx * (1.0f / 224.0f);
            { v4u w;
#pragma unroll
              for (int qd = 0; qd < 4; ++qd) { int pk = 0; pk = __builtin_amdgcn_cvt_pk_fp8_f32(h2[4 * qd] * hs, h2[4 * qd + 1] * hs, pk, false); pk = __builtin_amdgcn_cvt_pk_fp8_f32(h2[4 * qd + 2] * hs, h2[4 * qd + 3] * hs, pk, true); w[qd] = (unsigned)pk; }
              *(LAS v4u*)(hq + l16) = w; }
            LDS_WAIT(); asm volatile("" ::: "memory");
            v4u hb[16];
#pragma unroll
            for (int c = 0; c < 8; ++c) { hb[2 * c] = *(const LAS v4u*)(hq + 128 * c + 16 * lq); hb[2 * c + 1] = *(const LAS v4u*)(hq + 128 * c + 64 + 16 * lq); }
            asm volatile("s_waitcnt vmcnt(0)" ::: "memory");
            float w_lo = 0.f, w_hi = 0.f;
            int cur = 0, nx2 = 2 * U12_BUF;
#pragma unroll 1
            for (int u = 0; u < 16; ++u) {
                if (u < 14) { const int un = u + 2; int ensel = un < 8 ? e_lo : e_hi; asm volatile("" : "+v"(ensel));     const int nb = (un & 7) * 8; LAS unsigned char* dst = ring + nx2;
                  if (lane < 48) {
#pragma unroll
                  for (int j = 0; j < 8; ++j) { const int e = __builtin_amdgcn_readlane(ensel, nb + j);
                      __builtin_amdgcn_global_load_lds((const unsigned*)(EU + ((unsigned)e * 768u + l16)), (LAS unsigned*)(dst + j * U12_ROWP), 16, 0, 0); } }
                  asm volatile("s_waitcnt vmcnt(16)" ::: "memory"); }
                else if (u == 14) asm volatile("s_waitcnt vmcnt(8)" ::: "memory");
                else asm volatile("s_waitcnt vmcnt(0)" ::: "memory");
                const LAS unsigned char* src = ring + cur + (li & 7) * U12_ROWP + 24 * lq;
                f32x4 acc = (f32x4){0.f, 0.f, 0.f, 0.f};
#pragma unroll
                for (int c = 0; c < 8; ++c) { const v2u a0 = *(const LAS v2u*)(src + 96 * c), a1 = *(const LAS v2u*)(src + 96 * c + 8), a2 = *(const LAS v2u*)(src + 96 * c + 16);
                    const i32x8 A = (i32x8){(int)a0[0], (int)a0[1], (int)a1[0], (int)a1[1], (int)a2[0], (int)a2[1], 0, 0};
                    const i32x8 B = (i32x8){(int)hb[2 * c][0], (int)hb[2 * c][1], (int)hb[2 * c][2], (int)hb[2 * c][3], (int)hb[2 * c + 1][0], (int)hb[2 * c + 1][1], (int)hb[2 * c + 1][2], (int)hb[2 * c + 1][3]};
                    acc = __builtin_amdgcn_mfma_scale_f32_16x16x128_f8f6f4(A, B, acc, 2, 0, 0, 0, 0, 0); }
                const int base = (u & 7) * 8; const int r = li & 3;
                const float sel = r == 0 ? acc[0] : (r == 1 ? acc[1] : (r == 2 ? acc[2] : acc[3]));
                const float dmine = __shfl(sel, ((lane & 7) >> 2) * 16 + (lane & 3));
                const float gsel = u < 8 ? g_lo : g_hi, susel = u < 8 ? su_lo : su_hi, svsel = u < 8 ? sv_lo : sv_hi;
                const float wv = gsel * gelu_erf(dmine * susel * hinv) * svsel;
                const bool mine = (lane >= base) && (lane < base + 8);
                if (u < 8) w_lo = mine ? wv : w_lo; else w_hi = mine ? wv : w_hi;
                asm volatile("s_waitcnt lgkmcnt(0)" ::: "memory");
                cur = cur == 2 * U12_BUF ? 0 : cur + U12_BUF; nx2 = nx2 == 2 * U12_BUF ? 0 : nx2 + U12_BUF;
            }
            WSP(float, WS_GATE)[t * 128 + lane] = w_lo; WSP(float, WS_GATE)[t * 128 + 64 + lane] = w_hi;
        }
    }
}
#ifdef TOPK2
#define P7FN p5b_topk2
#else
#define P7FN p5b_topk
#endif
constexpr int NPHASE = 10;
__global__ void __launch_bounds__(NTHR, 2) fwd_mega(Args args) {
    extern __shared__ __attribute__((aligned(16))) unsigned char lds[];
    Frame F;
    F.lds = (LAS unsigned char*)lds;
    F.MISC = (volatile LAS unsigned*)(F.lds + MISC_OFF);
    F.G = gridDim.x; { const int bx = blockIdx.x; F.vcu = (F.G % 8 == 0) ? (bx % 8) * (F.G / 8) + bx / 8 : bx; }
    F.ws = args.ws; F.out = args.out;
    F.a = &args;
    for (int u = threadIdx.x; u < 32; u += NTHR) F.MISC[u] = 0u;
    __syncthreads();
    const int lo = args.ph_lo, hi = args.ph_hi;
    const bool use_bar = (hi - lo) > 1;
    XcdBarrier bar; bar.bar = (unsigned*)(F.ws + WS_CTL); bar.x = 0; bar.st = nullptr;
    if (use_bar) bar = xcd_barrier_post((unsigned*)(F.ws + WS_CTL), F.MISC + 8);
#define IN(k) (lo <= (k) && (k) < hi)
#define SEAM(k) do { if (IN(k) && IN((k) + 1)) xcd_barrier(bar); } while (0)
#ifndef REP_PHASE
#define REP_PHASE -1
#endif
#define REPEAT(k, body) do { if (REP_PHASE == (k)) { xcd_barrier(bar); body; } } while (0)
    if (IN(0)) {
#ifndef SKIP_P0
 p0_phase(F); REPEAT(0, p0_phase(F));
#endif
 } SEAM(0);
    if (IN(1)) {
#ifndef SKIP_P1
 p1_phase(F); REPEAT(1, p1_phase(F));
#endif
 } SEAM(1);
    if (IN(2)) {
        pg8::Gemm g{WSP(bf16, WS_H1), WSP(bf16, WS_WINT), MTOK, NPROJ, 1024}; pg8::StaticOrder S; S.init(MTOK, NPROJ, F.G, (int)blockIdx.x);
        pg8::EpiProj E{WSP(bf16, WS_PROJ), NPROJ};
        pg8::gemm_phase<pg8::EpiProj, pg8::StaticOrder, true, true>(F.lds, g, S, E);
        REPEAT(2, (pg8::gemm_phase<pg8::EpiProj, pg8::StaticOrder, true, true>(F.lds, g, S, E)));
    } SEAM(2);
    if (IN(3)) {
#ifndef SKIP_SSD
 p3pre_conv(F); xcd_barrier(bar); p3_ssd3(F); REPEAT(30, p3_ssd3(F)); REPEAT(32, p3pre_conv(F));
#endif
#ifndef SKIP_S5
 p3_s5v2(F); REPEAT(31, p3_s5v2(F));
#endif
 } SEAM(3);
    if (IN(5)) {
        pg8::Gemm g{WSP(bf16, WS_Y), WSP(bf16, WS_WOUTT), MTOK, 1024, 2048}; pg8::StaticOrder S; S.init(MTOK, 1024, F.G, (int)blockIdx.x);
        PG8_LAS float* tab = (PG8_LAS float*)(F.lds + pg8::STAGE_BYTES);
        { pg8::Unit u; for (int i = 0; S.next(i, u); ++i) pg8::SegScaleHook::build(F.lds + pg8::STAGE_BYTES, u, WSP(float, WS_STSSD), WSP(float, WS_STS5), (int)threadIdx.x); }
        __syncthreads();
        pg8::EpiX1 E{(F.a->in[0]), F.out, WSP(bf16, WS_X1S), WSP(float, WS_MOD), (F.a->in[24]), WSP(float, WS_ROWSTAT), tab};
        pg8::SegScaleHook H;
        pg8::gemm_phase<pg8::EpiX1, pg8::StaticOrder, true, true, pg8::SegScaleHook>(F.lds, g, S, E, H);
    } SEAM(5);
    if (IN(6)) {
        pg8::Gemm g{WSP(bf16, WS_X1S), WSP(bf16, WS_WQKT), MTOK, 2048, 1024}; pg8::StaticOrder S; S.init(MTOK, 2048, F.G, (int)blockIdx.x);
        pg8::EpiScores E{WSP(_Float16, WS_SCORES), WSP(float, WS_SB), WSP(float, WS_ROWSTAT)};
        pg8::gemm_phase<pg8::EpiScores, pg8::StaticOrder, true, true>(F.lds, g, S, E);
        REPEAT(6, (pg8::gemm_phase<pg8::EpiScores, pg8::StaticOrder, true, true>(F.lds, g, S, E)));
    } SEAM(6);
    if (IN(7)) {
#ifndef SKIP_TOPK
 P7FN(F); REPEAT(7, P7FN(F));
#endif
 } SEAM(7);
#ifdef UP12
    if (IN(8)) { p8_peer_up12(F); REPEAT(8, { P7FN(F); xcd_barrier(bar); p8_peer_up12(F); }); } SEAM(8);
#elif defined(UP11)
    if (IN(8)) { p8_peer_up11(F); REPEAT(8, { P7FN(F); xcd_barrier(bar); p8_peer_up11(F); }); } SEAM(8);
#elif defined(UP10)
    if (IN(8)) { p8_peer_up10(F); } SEAM(8);
#else
    if (IN(8)) { p8_peer_up6(F); REPEAT(8, { P7FN(F); xcd_barrier(bar); p8_peer_up6(F); }); } SEAM(8);
#endif
#ifdef V6
    if (IN(9)) { p9_peer_down3(F); }
#else
    if (IN(9)) { p9_peer_down2(F); }
#endif
#ifdef PROBE_OUT
    if (IN(9)) { __syncthreads(); if (blockIdx.x == 0 && threadIdx.x == 0) { asm volatile("s_waitcnt vmcnt(0)" ::: "memory"); F.out[0] = *(volatile float*)(F.ws + WS_CTL + 40000); } }
#endif
#undef IN
#undef SEAM
}

#ifndef N_LAUNCHES
#define N_LAUNCHES 1
#endif
extern "C" void kernel_launch(void* const* d_in, const int* in_sizes, int n_in, void* d_out, int out_size, void* d_ws, size_t ws_size, hipStream_t stream) {
    static int grid = 0;
    if (grid == 0) {
        if (n_in != 30 || in_sizes[0] != MTOK * DM || out_size != MTOK * DM || ws_size < WS_END) { fprintf(stderr, "kernel_launch: unexpected shapes (n_in %d, in0 %d, out %d, ws %zu)\n", n_in, n_in > 0 ? in_sizes[0] : -1, out_size, ws_size); grid = -1; return; }
        int dev = 0, cus = 0, per_cu = 0;
        if (hipGetDevice(&dev) != hipSuccess || hipDeviceGetAttribute(&cus, hipDeviceAttributeMultiprocessorCount, dev) != hipSuccess) { grid = -1; return; }
        if (hipFuncSetAttribute((const void*)fwd_mega, hipFuncAttributeMaxDynamicSharedMemorySize, LDS_BYTES) != hipSuccess) { fprintf(stderr, "kernel_launch: hipFuncSetAttribute failed\n"); grid = -1; return; }
        if (hipOccupancyMaxActiveBlocksPerMultiprocessor(&per_cu, (const void*)fwd_mega, NTHR, LDS_BYTES) != hipSuccess || per_cu < 1) { fprintf(stderr, "kernel_launch: occupancy query says %d\n", per_cu); (void)hipGetLastError(); grid = -1; return; }
        if (cus != 256) { fprintf(stderr, "kernel_launch: built for a 256-CU device (got %d CUs); nothing launched\n", cus); grid = -1; return; }
        grid = cus;
    }
    if (grid < 0) return;
    (void)hipMemsetAsync((char*)d_ws + WS_CTL, 0, CTL_ZERO_BYTES, stream);
    Args a{};
    for (int i = 0; i < 30; ++i) a.in[i] = (const float*)d_in[i];
    a.out = (float*)d_out; a.ws = (unsigned char*)d_ws;
    if (N_LAUNCHES == 1) {
        a.ph_lo = 0; a.ph_hi = NPHASE;
        void* kargs[] = {&a};
#ifdef PLAIN_LAUNCH
        (void)kargs; hipLaunchKernelGGL(fwd_mega, dim3(grid), dim3(NTHR), LDS_BYTES, stream, a);
#else
        hipError_t e = hipLaunchCooperativeKernel((const void*)fwd_mega, dim3(grid), dim3(NTHR), kargs, LDS_BYTES, stream);
        if (e != hipSuccess) fprintf(stderr, "kernel_launch: cooperative launch failed: %s (grid %d)\n", hipGetErrorString(e), grid);
#endif
    } else {
        for (int p = 0; p < NPHASE; ++p) { a.ph_lo = p; a.ph_hi = p + 1; hipLaunchKernelGGL(fwd_mega, dim3(grid), dim3(NTHR), LDS_BYTES, stream, a); }
    }
}
```

```cpp
#define V6
#define UP12
#include <hip/hip_runtime.h>
#include <cstdio>
#include <cstdint>
namespace pg8 {
#define PG8_LAS __attribute__((address_space(3)))
typedef unsigned short bf16_t;
typedef short bf16x8 __attribute__((ext_vector_type(8)));
typedef float f32x4 __attribute__((ext_vector_type(4)));
typedef unsigned u32x4 __attribute__((ext_vector_type(4)));
constexpr int BM = 256, BK = 64, HALF = 128, HTB = HALF * BK * 2  , STAGE_BYTES = 8 * HTB, NXCD = 8, WGM = 8;

__host__ __device__ __forceinline__ int lds_byte(int r, int c) { const int st = (r >> 4) * 2 + (c >> 5), rr = r & 15, cc = c & 31, ob = rr * 64 + cc * 2; return st * 1024 + (ob ^ (((ob >> 9) & 1) << 5)); }
__host__ __device__ __forceinline__ void stage_rc(int b, int& R, int& C) { const int st = b / 1024, sb = b % 1024, swz = sb ^ (((sb >> 9) & 1) << 5); R = (st >> 1) * 16 + swz / 64; C = (st & 1) * 32 + (swz % 64) / 2; }
__host__ __device__ __forceinline__ int perm32(int rho) { const int n = rho >> 4, i = rho & 15; return 8 * (i >> 2) + 4 * n + (i & 3); }

struct Unit { int pm, pn; };
struct Gemm { const bf16_t* A; const bf16_t* Bt; int M, N, K; };

struct StaticOrder {
    int nM, nN, nwg, G, c;
    __host__ __device__ void init(int M, int N, int G_, int c_) { nM = M / BM; nN = N / BM; nwg = nM * nN; G = G_; c = c_; }
    __host__ __device__ bool next(int i, Unit& u) const {
        const long L = (long)i * G + c; if (L >= nwg) return false;
        int wgid = (int)L; { const int q = nwg / NXCD, r = nwg % NXCD, xcd = wgid % NXCD, off = wgid / NXCD; wgid = (xcd < r ? xcd * (q + 1) : r * (q + 1) + (xcd - r) * q) + off; }
        const int nig = WGM * nN, gid = wgid / nig, fm = gid * WGM, gsz = (nM - fm) < WGM ? (nM - fm) : WGM;
        u.pm = fm + ((wgid % nig) % gsz); u.pn = (wgid % nig) / gsz; return true;
    }
    __device__ __forceinline__ void a_ready(const Unit&) const {}
    __device__ __forceinline__ void done(const Unit&) const {}
};

__device__ __forceinline__ unsigned cvt_pk_bf16(float lo, float hi) { unsigned r; asm volatile("v_cvt_pk_bf16_f32 %0, %1, %2" : "=v"(r) : "v"(lo), "v"(hi)); return r; }
typedef float f32x2 __attribute__((ext_vector_type(2)));
struct NoHook { __device__ __forceinline__ void at_tile(int, const Unit&, f32x4 (&)[2][2][4][2], PG8_LAS unsigned char*, int, int) const {} };
template <class Epi, class Sched, bool ALIGN_EPI = false, bool SP2 = false, class Hook = NoHook>
__device__ __forceinline__ void gemm_phase(PG8_LAS unsigned char* lds, const Gemm g, const Sched& S, const Epi& E, const Hook& H = Hook()) {
    const int tid = threadIdx.x, wid = __builtin_amdgcn_readfirstlane(tid >> 6), lane = tid & 63, wr = wid >> 2, wc = wid & 3, fr = lane & 15, fq = lane >> 4;
    const int K = g.K, nt = K / BK;
    unsigned voffA[2], voffB[2];
#pragma unroll
    for (int i = 0; i < 2; ++i) { int R, C; stage_rc(tid * 16 + i * 8192, R, C); const int Rb = Epi::PERM ? ((R & ~31) + perm32(R & 31)) : R;
        voffA[i] = (unsigned)(R * K + C) * 2u; voffB[i] = (unsigned)(Rb * K + C) * 2u; }
    const size_t kstep = (size_t)(BK * 2);
    const size_t hstep = (size_t)HALF * K * 2;
    const size_t tstep = 2 * hstep;
    const unsigned ldsw = (unsigned)wid * 1024u;
    const int aoff = lds_byte(wr * 64 + fr, fq * 8), boff = lds_byte(wc * 32 + fr, fq * 8);
#define PG8_SA(b, h) (((b) * 2 + (h)) * HTB)
#define PG8_SB(b, h) ((4 + (b) * 2 + (h)) * HTB)
#define PG8_STAGE(bufoff, gbase, voff) do { _Pragma("unroll") for (int _i = 0; _i < 2; ++_i) \
        __builtin_amdgcn_global_load_lds((const unsigned*)((const char*)(gbase) + (voff)[_i]), (PG8_LAS unsigned*)(lds + (bufoff) + ldsw + _i * 8192), 16, 0, 0); } while (0)
#define PG8_LDA(dst, b, h) do { _Pragma("unroll") for (int m = 0; m < 4; ++m) _Pragma("unroll") for (int k = 0; k < 2; ++k) dst[m][k] = *(const PG8_LAS bf16x8*)(lds + PG8_SA(b, h) + aoff + m * 2048 + k * 1024); } while (0)
#define PG8_LDB(dst, b, h) do { _Pragma("unroll") for (int n = 0; n < 2; ++n) _Pragma("unroll") for (int k = 0; k < 2; ++k) dst[n][k] = *(const PG8_LAS bf16x8*)(lds + PG8_SB(b, h) + boff + n * 2048 + k * 1024); } while (0)
#define PG8_MMA(ai, bj, At, Bt) do { __builtin_amdgcn_s_setprio(1); _Pragma("unroll") for (int m = 0; m < 4; ++m) _Pragma("unroll") for (int n = 0; n < 2; ++n) _Pragma("unroll") for (int k = 0; k < 2; ++k) \
        acc[ai][bj][m][n] = __builtin_amdgcn_mfma_f32_16x16x32_bf16(Bt[n][k], At[m][k], acc[ai][bj][m][n], 0, 0, 0); __builtin_amdgcn_s_setprio(0); } while (0)
#define PG8_WAIT_V(n) asm volatile("s_waitcnt vmcnt(" #n ")" ::: "memory")
#define PG8_WAIT_L(n) asm volatile("s_waitcnt lgkmcnt(" #n ")" ::: "memory")
#define PG8_BAR __builtin_amdgcn_s_barrier()
#define PG8_SCHED __builtin_amdgcn_sched_barrier(0)
    Unit cur, nxt; int ui = 0;
    if (!S.next(0, cur)) return;
    f32x4 acc[2][2][4][2];
#pragma unroll
    for (int a = 0; a < 2; ++a)
#pragma unroll
        for (int b = 0; b < 2; ++b)
#pragma unroll
            for (int m = 0; m < 4; ++m)
#pragma unroll
                for (int n = 0; n < 2; ++n) acc[a][b][m][n] = (f32x4){0.f, 0.f, 0.f, 0.f};
    bf16x8 At[4][2], B0[2][2], B1[2][2];
    const char* cA = (const char*)g.A + (size_t)cur.pm * tstep; const char* cB = (const char*)g.Bt + (size_t)cur.pn * tstep;
    S.a_ready(cur);
    if constexpr (SP2) {
        PG8_STAGE(PG8_SB(0, 0), cB, voffB); PG8_STAGE(PG8_SB(0, 1), cB + hstep, voffB); PG8_STAGE(PG8_SA(0, 0), cA, voffA); PG8_STAGE(PG8_SA(0, 1), cA + hstep, voffA);
        if (wr == 1) PG8_BAR;
        PG8_WAIT_V(2); PG8_BAR;
        PG8_STAGE(PG8_SB(1, 0), cB + kstep, voffB); PG8_STAGE(PG8_SA(1, 0), cA + kstep, voffA); PG8_STAGE(PG8_SB(1, 1), cB + hstep + kstep, voffB);
        PG8_WAIT_V(6); PG8_BAR;
    } else {
        PG8_STAGE(PG8_SB(0, 0), cB, voffB); PG8_STAGE(PG8_SA(0, 0), cA, voffA); PG8_STAGE(PG8_SB(0, 1), cB + hstep, voffB); PG8_STAGE(PG8_SA(0, 1), cA + hstep, voffA);
        if (wr == 1) PG8_BAR;
        PG8_WAIT_V(4); PG8_BAR;
        PG8_STAGE(PG8_SB(1, 0), cB + kstep, voffB); PG8_STAGE(PG8_SA(1, 0), cA + kstep, voffA); PG8_STAGE(PG8_SB(1, 1), cB + hstep + kstep, voffB);
        PG8_WAIT_V(6); PG8_BAR;
    }
    for (;;) {
        const bool has_next = S.next(ui + 1, nxt);
        const char* nA = has_next ? (const char*)g.A + (size_t)nxt.pm * tstep : cA; const char* nB = has_next ? (const char*)g.Bt + (size_t)nxt.pn * tstep : cB;
        for (int t = 0; t < nt; t += 2) {
            const bool last = (t == nt - 2);
            H.at_tile(t, cur, acc, lds + STAGE_BYTES, wr, fr);
            const char* a1 = cA + (size_t)(t + 1) * kstep;
            const char* a2 = last ? nA : cA + (size_t)(t + 2) * kstep; const char* b2 = last ? nB : cB + (size_t)(t + 2) * kstep;
            const char* a3 = a2 + kstep; const char* b3 = b2 + kstep;
            if (last && has_next) S.a_ready(nxt);
            if constexpr (SP2) {
            PG8_LDB(B0, 0, 0); PG8_LDB(B1, 0, 1); PG8_SCHED; PG8_LDA(At, 0, 0); PG8_STAGE(PG8_SA(1, 1), a1 + hstep, voffA);
            PG8_WAIT_V(8); PG8_WAIT_L(0); PG8_BAR; PG8_MMA(0, 0, At, B0); PG8_MMA(0, 1, At, B1); PG8_BAR; PG8_SCHED;
            PG8_LDA(At, 0, 1); PG8_STAGE(PG8_SB(0, 0), b2, voffB); PG8_STAGE(PG8_SB(0, 1), b2 + hstep, voffB); PG8_STAGE(PG8_SA(0, 0), a2, voffA);
            PG8_WAIT_V(8); PG8_WAIT_L(0); PG8_BAR; PG8_MMA(1, 0, At, B0); PG8_MMA(1, 1, At, B1); PG8_BAR; PG8_SCHED;
            PG8_LDB(B0, 1, 0); PG8_LDB(B1, 1, 1); PG8_SCHED; PG8_LDA(At, 1, 0); PG8_STAGE(PG8_SA(0, 1), a2 + hstep, voffA);
            PG8_WAIT_V(8); PG8_WAIT_L(0); PG8_BAR; PG8_MMA(0, 0, At, B0); PG8_MMA(0, 1, At, B1); PG8_BAR; PG8_SCHED;
            PG8_LDA(At, 1, 1); PG8_STAGE(PG8_SB(1, 0), b3, voffB); PG8_STAGE(PG8_SB(1, 1), b3 + hstep, voffB); PG8_STAGE(PG8_SA(1, 0), a3, voffA);
            PG8_WAIT_V(8); PG8_WAIT_L(0); PG8_BAR; PG8_MMA(1, 0, At, B0); PG8_MMA(1, 1, At, B1); PG8_BAR; PG8_SCHED;
            } else {
            PG8_LDB(B0, 0, 0); PG8_SCHED; PG8_LDA(At, 0, 0); PG8_STAGE(PG8_SA(1, 1), a1 + hstep, voffA);
            PG8_WAIT_L(8); PG8_BAR; PG8_WAIT_L(0); PG8_MMA(0, 0, At, B0); PG8_BAR; PG8_SCHED;
            PG8_LDB(B1, 0, 1); PG8_STAGE(PG8_SB(0, 0), b2, voffB);
            PG8_BAR; PG8_WAIT_L(0); PG8_MMA(0, 1, At, B1); PG8_BAR;
            PG8_LDA(At, 0, 1); PG8_STAGE(PG8_SA(0, 0), a2, voffA);
            PG8_BAR; PG8_WAIT_L(0); PG8_MMA(1, 0, At, B0); PG8_BAR; PG8_SCHED;
            PG8_STAGE(PG8_SB(0, 1), b2 + hstep, voffB);
            PG8_WAIT_V(6); PG8_BAR; PG8_MMA(1, 1, At, B1); PG8_BAR;
            PG8_LDB(B0, 1, 0); PG8_SCHED; PG8_LDA(At, 1, 0); PG8_STAGE(PG8_SA(0, 1), a2 + hstep, voffA);
            PG8_WAIT_L(8); PG8_BAR; PG8_WAIT_L(0); PG8_MMA(0, 0, At, B0); PG8_BAR; PG8_SCHED;
            PG8_LDB(B1, 1, 1); PG8_STAGE(PG8_SB(1, 0), b3, voffB);
            PG8_BAR; PG8_WAIT_L(0); PG8_MMA(0, 1, At, B1); PG8_BAR;
            PG8_LDA(At, 1, 1); PG8_STAGE(PG8_SA(1, 0), a3, voffA);
            PG8_BAR; PG8_WAIT_L(0); PG8_MMA(1, 0, At, B0); PG8_BAR; PG8_SCHED;
            PG8_STAGE(PG8_SB(1, 1), b3 + hstep, voffB);
            PG8_WAIT_V(6); PG8_BAR; PG8_MMA(1, 1, At, B1); PG8_BAR;
            }
        }
        if constexpr (ALIGN_EPI) { if (wr == 0) PG8_BAR; }
        if constexpr (!Epi::AFTER_DRAIN) { E(acc, cur, wr, wc, fr, fq);
#ifdef PROBE_EPI2
            if constexpr (Epi::PROBE_TWICE) { asm volatile("" ::: "memory"); E(acc, cur, wr, wc, fr, fq); }
#endif
            S.done(cur); }
        if (!has_next) break;
#pragma unroll
        for (int a = 0; a < 2; ++a)
#pragma unroll
            for (int b = 0; b < 2; ++b)
#pragma unroll
                for (int m = 0; m < 4; ++m)
#pragma unroll
                    for (int n = 0; n < 2; ++n) acc[a][b][m][n] = (f32x4){0.f, 0.f, 0.f, 0.f};
        cur = nxt; cA = nA; cB = nB; ++ui;
        if constexpr (ALIGN_EPI) { if (wr == 1) PG8_BAR; }
    }
    PG8_WAIT_V(0);
    if constexpr (!ALIGN_EPI) { if (wr == 0) PG8_BAR; }
    PG8_BAR;
    if constexpr (Epi::AFTER_DRAIN) { E.fused(acc, cur, wr, wc, fr, fq, lds, wid, lane); S.done(cur); }
#undef PG8_SA
#undef PG8_SB
#undef PG8_STAGE
#undef PG8_LDA
#undef PG8_LDB
#undef PG8_MMA
#undef PG8_WAIT_V
#undef PG8_WAIT_L
#undef PG8_BAR
#undef PG8_SCHED
}
}
namespace pg8 {
struct EpiProj {
    static constexpr bool PERM = true, AFTER_DRAIN = false, PROBE_TWICE = true;
    bf16_t* O; int ldc;
    __device__ __forceinline__ void operator()(const f32x4 (&acc)[2][2][4][2], const Unit& u, int wr, int wc, int fr, int fq) const {
        const int row0 = u.pm * BM + wr * 64 + fr; const int col0 = u.pn * BM + wc * 32 + 8 * fq;
#pragma unroll
        for (int ai = 0; ai < 2; ++ai)
#pragma unroll
            for (int m = 0; m < 4; ++m) { bf16_t* rowp = O + (size_t)(row0 + ai * HALF + m * 16) * ldc + col0;
#pragma unroll
                for (int bj = 0; bj < 2; ++bj) { const f32x4 v0 = acc[ai][bj][m][0], v1 = acc[ai][bj][m][1];
                    u32x4 w; w.x = cvt_pk_bf16(v0[0], v0[1]); w.y = cvt_pk_bf16(v0[2], v0[3]); w.z = cvt_pk_bf16(v1[0], v1[1]); w.w = cvt_pk_bf16(v1[2], v1[3]);
                    __builtin_nontemporal_store(w, (u32x4*)(rowp + bj * HALF)); } }
    }
};
struct EpiX1 {
    static constexpr bool PERM = true, AFTER_DRAIN = false, PROBE_TWICE = false;
    const float* x; float* x1; bf16_t* x1s; const float* mod; const float* norm2_g; float* rowstat; PG8_LAS float* tab;
    __device__ __forceinline__ void operator()(const f32x4 (&acc)[2][2][4][2], const Unit& u, int wr, int wc, int fr, int fq) const {
        const int row0 = u.pm * BM + wr * 64 + fr; const int col0 = u.pn * BM + wc * 32 + 8 * fq; const int b = (u.pm * BM) >> 11;
        const float* mb = mod + (size_t)b * 6144;
        f32x4 g1[2][2], g2[2][2];
#pragma unroll
        for (int bj = 0; bj < 2; ++bj)
#pragma unroll
            for (int n = 0; n < 2; ++n) { const int c = col0 + bj * HALF + 4 * n; g1[bj][n] = *(const f32x4*)(mb + 2048 + c);
                const f32x4 sc = *(const f32x4*)(mb + 4096 + c), ng = *(const f32x4*)(norm2_g + c); g2[bj][n] = ng * (sc + 1.0f); }
#pragma unroll
        for (int ai = 0; ai < 2; ++ai)
#pragma unroll
            for (int m = 0; m < 4; ++m) { const size_t row = (size_t)(row0 + ai * HALF + m * 16); const size_t off = row * 1024 + col0; float ss = 0.f;
                const float rfin = tab[((u.pm >> 3) & 1) * 1280 + 1024 + ai * HALF + wr * 64 + m * 16 + fr];
#pragma unroll
                for (int bj = 0; bj < 2; ++bj) {
                    const f32x4 xa = *(const f32x4*)(x + off + bj * HALF), xb = *(const f32x4*)(x + off + bj * HALF + 4);
                    const f32x4 v0 = xa + g1[bj][0] * (acc[ai][bj][m][0] * rfin), v1 = xb + g1[bj][1] * (acc[ai][bj][m][1] * rfin);
                    *(f32x4*)(x1 + off + bj * HALF) = v0; *(f32x4*)(x1 + off + bj * HALF + 4) = v1;
                    ss += (v0[0] * v0[0] + v0[1] * v0[1]) + (v0[2] * v0[2] + v0[3] * v0[3]) + (v1[0] * v1[0] + v1[1] * v1[1]) + (v1[2] * v1[2] + v1[3] * v1[3]);
                    const f32x4 s0 = v0 * g2[bj][0], s1 = v1 * g2[bj][1];
                    u32x4 w; w.x = cvt_pk_bf16(s0[0], s0[1]); w.y = cvt_pk_bf16(s0[2], s0[3]); w.z = cvt_pk_bf16(s1[0], s1[1]); w.w = cvt_pk_bf16(s1[2], s1[3]);
                    *(u32x4*)(x1s + off + bj * HALF) = w; }
                ss += __shfl_xor(ss, 16); ss += __shfl_xor(ss, 32);
                if (fq == 0) atomicAdd(rowstat + row, ss); }
    }
};
typedef _Float16 f16x8 __attribute__((ext_vector_type(8)));
struct EpiScores {
    static constexpr bool PERM = true, AFTER_DRAIN = false, PROBE_TWICE = false;
    _Float16* S; const float* sb; const float* rowstat;
    __device__ __forceinline__ void operator()(const f32x4 (&acc)[2][2][4][2], const Unit& u, int wr, int wc, int fr, int fq) const {
        const int row0 = u.pm * BM + wr * 64 + fr; const int col0 = u.pn * BM + wc * 32 + 8 * fq; const int b = (u.pm * BM) >> 11;
        f32x4 bv[2][2];
#pragma unroll
        for (int bj = 0; bj < 2; ++bj)
#pragma unroll
            for (int n = 0; n < 2; ++n) bv[bj][n] = *(const f32x4*)(sb + (size_t)b * 2048 + col0 + bj * HALF + 4 * n);
#pragma unroll
        for (int ai = 0; ai < 2; ++ai)
#pragma unroll
            for (int m = 0; m < 4; ++m) { const size_t row = (size_t)(row0 + ai * HALF + m * 16); const float rs = __builtin_amdgcn_rsqf(rowstat[row] * (1.0f / 1024.0f) + 1e-6f);
                _Float16* rowp = S + row * 2048 + col0;
#pragma unroll
                for (int bj = 0; bj < 2; ++bj) { const f32x4 v0 = acc[ai][bj][m][0] * rs + bv[bj][0], v1 = acc[ai][bj][m][1] * rs + bv[bj][1];
                    f16x8 h; h[0] = (_Float16)v0[0]; h[1] = (_Float16)v0[1]; h[2] = (_Float16)v0[2]; h[3] = (_Float16)v0[3]; h[4] = (_Float16)v1[0]; h[5] = (_Float16)v1[1]; h[6] = (_Float16)v1[2]; h[7] = (_Float16)v1[3];
                    *(f16x8*)(rowp + bj * HALF) = h; } }
    }
};
struct SegScaleHook {
    __device__ __forceinline__ static void build(PG8_LAS unsigned char* ldsx, const Unit& u, const float* st_ssd, const float* st_s5, int tid) {
        PG8_LAS float* tab = (PG8_LAS float*)ldsx + ((u.pm >> 3) & 1) * 1280;
        if (tid < 256) { const size_t row = (size_t)u.pm * BM + tid; const f32x4* sg = (const f32x4*)(st_ssd + row * 16); const f32x4* s5 = (const f32x4*)(st_s5 + row * 64);
            float r[5];
#pragma unroll
            for (int gI = 0; gI < 4; ++gI) { const f32x4 v = sg[gI]; r[gI] = __builtin_amdgcn_rsqf(((v[0] + v[1]) + (v[2] + v[3])) * (1.0f / 256.0f) + 1e-6f); }
            float a5 = 0.f;
#pragma unroll
            for (int q = 0; q < 16; ++q) { const f32x4 v = s5[q]; a5 += (v[0] + v[1]) + (v[2] + v[3]); }
            r[4] = __builtin_amdgcn_rsqf(a5 * (1.0f / 1024.0f) + 1e-6f);
#pragma unroll
            for (int k = 0; k < 4; ++k) tab[k * 256 + tid] = r[k] * __builtin_amdgcn_rcpf(r[k + 1]);
            tab[1024 + tid] = r[4]; }
    }
    __device__ __forceinline__ void at_tile(int t, const Unit& u, f32x4 (&acc)[2][2][4][2], PG8_LAS unsigned char* ldsx, int wr, int fr) const {
        if (t == 4 || t == 8 || t == 12 || t == 16) { const PG8_LAS float* rt = (const PG8_LAS float*)ldsx + ((u.pm >> 3) & 1) * 1280 + ((t >> 2) - 1) * 256 + wr * 64 + fr;
#pragma unroll
            for (int ai = 0; ai < 2; ++ai)
#pragma unroll
                for (int m = 0; m < 4; ++m) { const float r = rt[ai * HALF + m * 16];
#pragma unroll
                    for (int bj = 0; bj < 2; ++bj) { acc[ai][bj][m][0] = acc[ai][bj][m][0] * r; acc[ai][bj][m][1] = acc[ai][bj][m][1] * r; } } }
    }
};
}
constexpr int NWAVES = 8, NTHR = 512;
constexpr int DM = 1024, NB = 16, SEQ = 2048, MTOK = NB * SEQ;
constexpr int NPROJ = 4096;
constexpr int INW = 4112;
constexpr int NHEADS = 16, HDIM = 64, NGRP = 4, NST = 128, CHUNK = 128;
constexpr int S5G = 64, S5CH = 16, S5P = 64;
constexpr int PH = 8, PK = 16, PNK = 128;
constexpr float EPSF = 1e-6f;
constexpr int NS5PART = 64;

constexpr size_t MiB = 1u << 20;
constexpr size_t WS_CTL = 0, CTL_ZERO_BYTES = 64 * 1024;
constexpr size_t WS_MOD = 1 * MiB;
constexpr size_t WS_WDT = WS_MOD + 0x60000;
constexpr size_t WS_SB = WS_MOD + 0x70000;
constexpr size_t WS_ROWSTAT = WS_MOD + 0x90000;
constexpr size_t WS_S5LB = WS_MOD + 0xB0000;
constexpr size_t WS_S5BB = WS_MOD + 0xC0000;
constexpr size_t WS_DTRAW = 3 * MiB;
constexpr size_t WS_STSSD = 5 * MiB;
constexpr size_t WS_STS5 = 7 * MiB;
constexpr size_t WS_WINT = 15 * MiB;
constexpr size_t WS_WOUTT = 23 * MiB;
constexpr size_t WS_WQKT = 27 * MiB;
constexpr size_t WS_EU = 31 * MiB, WS_EV = 47 * MiB;
constexpr size_t WS_EUS = 63 * MiB, WS_EVS = 63 * MiB + 65536;
constexpr size_t WS_START = 64 * MiB;
constexpr size_t WS_A = 95 * MiB;
constexpr size_t WS_B = 223 * MiB;
constexpr size_t WS_H1 = WS_A, WS_Y = WS_A, WS_PROJ = WS_B, WS_SCORES = WS_A;
constexpr size_t WS_X1S = WS_B + 192 * MiB;
constexpr size_t WS_EID = 479 * MiB, WS_GATE = 495 * MiB;
constexpr size_t WS_H2Q = WS_B, WS_HINV = WS_B + 32 * MiB;
constexpr size_t WS_END = 511 * MiB;
static_assert(WS_SCORES + (size_t)MTOK * 2048 * 4 <= WS_X1S && WS_X1S + (size_t)MTOK * 1024 * 2 <= WS_EID && WS_GATE + (size_t)MTOK * 128 * 4 <= WS_END, "ws map");

constexpr int LDS_MAIN = 159744;
constexpr int MISC_OFF = LDS_MAIN;
constexpr int LDS_BYTES = LDS_MAIN + 128;

#define GAS __attribute__((address_space(1)))
#define LAS __attribute__((address_space(3)))
typedef unsigned short bf16;
typedef unsigned v4u __attribute__((ext_vector_type(4)));
typedef unsigned v2u __attribute__((ext_vector_type(2)));
typedef float f32x4 __attribute__((ext_vector_type(4)));
typedef float f32x2 __attribute__((ext_vector_type(2)));
typedef short bf16x8 __attribute__((ext_vector_type(8)));
#define LDS_WAIT() asm volatile("s_waitcnt lgkmcnt(0)" ::: "memory")
#define VM_WAIT() asm volatile("s_waitcnt vmcnt(0)" ::: "memory")
typedef __bf16 hwbf16x2 __attribute__((ext_vector_type(2)));
__device__ __forceinline__ unsigned pk2(float lo, float hi) { const f32x2 v = {lo, hi}; const hwbf16x2 b = __builtin_convertvector(v, hwbf16x2); return __builtin_bit_cast(unsigned, b); }
__device__ __forceinline__ unsigned f2bf(float f) { return pk2(f, 0.f) & 0xffffu; }
__device__ __forceinline__ float bflo(unsigned w) { return __builtin_bit_cast(float, w << 16); }
__device__ __forceinline__ float bfhi(unsigned w) { return __builtin_bit_cast(float, w & 0xffff0000u); }
__device__ __forceinline__ float bf2f(bf16 v) { return __builtin_bit_cast(float, (unsigned)v << 16); }
__device__ __forceinline__ float wave_sum(float v) {
#pragma unroll
    for (int o = 1; o < 64; o <<= 1) v += __shfl_xor(v, o);
    return v;
}
__device__ __forceinline__ float sigmoid_f(float v) { return __builtin_amdgcn_rcpf(1.0f + __builtin_amdgcn_exp2f(-1.4426950408889634f * v)); }
__device__ __forceinline__ float silu_f(float v) { return v * sigmoid_f(v); }
__device__ __forceinline__ float rsqrt_f(float v) { return __builtin_amdgcn_rsqf(v); }
__device__ __forceinline__ float gelu_erf(float v) {
    const float av = fabsf(v), t = __builtin_amdgcn_rcpf(av * 0.2316418882f + 1.0f);
    float q = t * 0.5307027145f + (-0.7265760135f); q = q * t + 0.7107068705f; q = q * t + (-0.142248368f); q = q * t + 0.127414796f; q = q * t;
    const float e = __builtin_amdgcn_exp2f((v * v) * (-0.72134752044f));
    const float m = v * (q * e);
    return v < 0.f ? m : v - m;
}
__device__ __forceinline__ float softplus_f(float v) { const float e = __builtin_amdgcn_exp2f(-1.4426950408889634f * fabsf(v));
    const float l = e < 1e-6f ? e : 0.6931471805599453f * __builtin_amdgcn_logf(1.0f + e); return fmaxf(v, 0.f) + l; }
__device__ __forceinline__ void unpack8(const v4u w, float* f) { f[0] = bflo(w.x); f[1] = bfhi(w.x); f[2] = bflo(w.y); f[3] = bfhi(w.y); f[4] = bflo(w.z); f[5] = bfhi(w.z); f[6] = bflo(w.w); f[7] = bfhi(w.w); }
#define LDS_BARRIER() do { asm volatile("s_waitcnt lgkmcnt(0)" ::: "memory"); __builtin_amdgcn_s_barrier(); asm volatile("" ::: "memory"); } while (0)
__device__ __forceinline__ float row16_sum_to15(float v) {
    v += __builtin_bit_cast(float, __builtin_amdgcn_update_dpp(0, __builtin_bit_cast(int, v), 0x118, 0xf, 0xf, true));
    v += __builtin_bit_cast(float, __builtin_amdgcn_update_dpp(0, __builtin_bit_cast(int, v), 0x114, 0xf, 0xf, true));
    v += __builtin_bit_cast(float, __builtin_amdgcn_update_dpp(0, __builtin_bit_cast(int, v), 0x112, 0xf, 0xf, true));
    v += __builtin_bit_cast(float, __builtin_amdgcn_update_dpp(0, __builtin_bit_cast(int, v), 0x111, 0xf, 0xf, true));
    return v;
}
__device__ __forceinline__ float wave_sum_to63(float v) {
    v = row16_sum_to15(v);
    v += __builtin_bit_cast(float, __builtin_amdgcn_update_dpp(0, __builtin_bit_cast(int, v), 0x142, 0xa, 0xf, false));
    v += __builtin_bit_cast(float, __builtin_amdgcn_update_dpp(0, __builtin_bit_cast(int, v), 0x143, 0xc, 0xf, false));
    return v;
}
__device__ __forceinline__ f32x2 gelu_pk2(f32x2 v) {
    const f32x2 av = __builtin_elementwise_abs(v), d = av * 0.2316418882f + 1.0f;
    f32x2 t; t[0] = __builtin_amdgcn_rcpf(d[0]); t[1] = __builtin_amdgcn_rcpf(d[1]);
    f32x2 q = t * 0.5307027145f + (-0.7265760135f); q = q * t + 0.7107068705f; q = q * t + (-0.142248368f); q = q * t + 0.127414796f; q = q * t;
    const f32x2 s = (v * v) * (-0.72134752044f);
    f32x2 e; e[0] = __builtin_amdgcn_exp2f(s[0]); e[1] = __builtin_amdgcn_exp2f(s[1]);
    const f32x2 m = v * (q * e), r = v - m;
    f32x2 o; o[0] = v[0] < 0.f ? m[0] : r[0]; o[1] = v[1] < 0.f ? m[1] : r[1]; return o;
}
#define XB_TMO      128
#define XB_XCNT(j)  (256  + 64 * (j))
#define XB_XSUB(j)  (1280 + 64 * (j))
#define XB_XGEN(j)  (2304 + 64 * (j))
#define XB_TOP      3328
#define XB_TOPGEN   3392
#define XCD_BAR_WORDS 3456
#define XB_SPIN_CAP (1u << 18)

__device__ __forceinline__ unsigned xb_ld(unsigned* p)              { return __hip_atomic_load(p, __ATOMIC_RELAXED, __HIP_MEMORY_SCOPE_AGENT); }
__device__ __forceinline__ unsigned xb_add(unsigned* p, unsigned v) { return __hip_atomic_fetch_add(p, v, __ATOMIC_RELAXED, __HIP_MEMORY_SCOPE_AGENT); }
__device__ __forceinline__ unsigned xb_xcc_id() { return (unsigned)__builtin_amdgcn_s_getreg((3 << 11) | 20) & 0xFu; }
#define XB_SPIN(cond, bar) do { unsigned _sp = 0; while (cond) { __builtin_amdgcn_s_sleep(1); \
    if ((++_sp & 255u) == 0u) { if (xb_ld(&(bar)[XB_TMO])) break; if (_sp > XB_SPIN_CAP) { atomicAdd(&(bar)[XB_TMO], 1u); break; } } } } while (0)

struct XcdBarrier {
    unsigned* bar; unsigned x;
    volatile LAS unsigned* st;
};

__device__ __forceinline__ XcdBarrier xcd_barrier_post(unsigned* bar, volatile LAS unsigned* st) {
    XcdBarrier b; b.bar = bar; b.x = xb_xcc_id(); b.st = st;
    if (threadIdx.x == 0) (void)xb_add(&bar[XB_XCNT(b.x)], 1u);
    return b;
}
__device__ __forceinline__ void xcd_barrier_complete(unsigned* bar, unsigned x, unsigned& nloc, unsigned& nx) {
    const unsigned G = gridDim.x * gridDim.y * gridDim.z;
    unsigned sum, cnt, mine, sp = 0u;
    for (;;) {
        sum = 0u; cnt = 0u; mine = 0u;
#pragma unroll
        for (unsigned j = 0; j < 16; ++j) { const unsigned c = xb_ld(&bar[XB_XCNT(j)]); sum += c; cnt += (c > 0u) ? 1u : 0u; mine = (j == x) ? c : mine; }
        if (sum == G) break;
        __builtin_amdgcn_s_sleep(1);
        if ((++sp & 255u) == 0u) { if (xb_ld(&bar[XB_TMO])) break; if (sp > XB_SPIN_CAP) { atomicAdd(&bar[XB_TMO], 1u); break; } }
    }
    nloc = mine > 0u ? mine : 1u; nx = cnt > 0u ? cnt : 1u;
}

__device__ __forceinline__ void xcd_barrier(const XcdBarrier& b) {
    asm volatile("s_waitcnt vmcnt(0)" ::: "memory");
    __syncthreads();
    if (threadIdx.x == 0) {
        unsigned* bar = b.bar;
        __builtin_amdgcn_s_waitcnt(0);
        unsigned nloc = b.st[0], nx = b.st[1];
        if (nloc == 0u) { xcd_barrier_complete(bar, b.x, nloc, nx); b.st[0] = nloc; b.st[1] = nx; }
        const unsigned old = xb_add(&bar[XB_XSUB(b.x)], 1u);
        const unsigned gen = old / nloc;
        if (old + 1u == (gen + 1u) * nloc) {
            __builtin_amdgcn_fence(__ATOMIC_RELEASE, "agent");
            asm volatile("s_waitcnt vmcnt(0)" ::: "memory");
            const unsigned og = xb_add(&bar[XB_TOP], 1u);
            const unsigned tg = og / nx;
            if (og + 1u == (tg + 1u) * nx) xb_add(&bar[XB_TOPGEN], 1u);
            else XB_SPIN(xb_ld(&bar[XB_TOPGEN]) == tg, bar);
            __builtin_amdgcn_fence(__ATOMIC_ACQUIRE, "agent");
            xb_add(&bar[XB_XGEN(b.x)], 1u);
            asm volatile("s_waitcnt vmcnt(0)" ::: "memory");
        } else {
            XB_SPIN(xb_ld(&bar[XB_XGEN(b.x)]) == gen, bar);
            __builtin_amdgcn_fence(__ATOMIC_ACQUIRE, "agent");
            asm volatile("s_waitcnt vmcnt(0)" ::: "memory");
        }
    }
    __syncthreads();
}
struct Args { const float* in[30]; float* out; unsigned char* ws; int ph_lo, ph_hi; };
struct Frame {
    LAS unsigned char* lds;
    volatile LAS unsigned* MISC;
    int vcu, G;
    unsigned char* ws;
    const Args* a;
    float* out;
};
#define WSP(T, off) ((T*)(F.ws + (off)))

__device__ __forceinline__ void transpose_tile(const float* W, int ldw, int k0, int src_n0, bf16* WT, int K, int dst_n0, LAS float* scr, int lane, const float* kscale) {
#pragma unroll 8
    for (int i = 0; i < 32; ++i) { const int kk = 2 * i + (lane >> 5); float v = W[(size_t)(k0 + kk) * ldw + src_n0 + (lane & 31)]; if (kscale) v *= kscale[k0 + kk]; scr[kk * 33 + (lane & 31)] = v; }
    LDS_WAIT(); asm volatile("" ::: "memory");
    const int c = lane & 7;
#pragma unroll
    for (int j = 0; j < 4; ++j) { const int n = (lane >> 3) + 8 * j; const LAS float* s = scr + (8 * c) * 33 + n;
        v4u o; o.x = pk2(s[0 * 33], s[1 * 33]); o.y = pk2(s[2 * 33], s[3 * 33]); o.z = pk2(s[4 * 33], s[5 * 33]); o.w = pk2(s[6 * 33], s[7 * 33]);
        *(v4u*)(WT + (size_t)(dst_n0 + n) * K + k0 + 8 * c) = o; }
    LDS_WAIT(); asm volatile("" ::: "memory");
}
__device__ __forceinline__ void p0_phase(Frame& F) {
    const int f_tid = threadIdx.x, f_lane = f_tid & 63, f_wave = __builtin_amdgcn_readfirstlane(f_tid >> 6);
    const int gw = F.vcu * NWAVES + f_wave, NGW = F.G * NWAVES, gt = F.vcu * NTHR + f_tid, NGT = F.G * NTHR;
    {
        LAS float* sc = (LAS float*)F.lds;
        LAS float* red = (LAS float*)(F.lds + 65536);
        for (int i = f_tid; i < 16 * 1024; i += NTHR) { const int b = i >> 10, k = i & 1023; sc[k * 16 + b] = silu_f((F.a->in[1])[i]); }
        __syncthreads();
        const int ks = f_tid / 24, col = f_tid - ks * 24, j = F.vcu * 24 + col;
        if (ks < 21) {
            float acc[16];
#pragma unroll
            for (int b = 0; b < 16; ++b) acc[b] = 0.f;
            const int k0 = ks * 49, kn = (k0 + 49 <= 1024) ? 49 : (1024 - k0);
            const float* wp = (F.a->in[2]) + (size_t)k0 * 6144 + j;
#pragma unroll 1
            for (int kb = 0; kb < 49; kb += 7) {
                asm volatile("" ::: "memory");
                float wv[7];
#pragma unroll
                for (int u = 0; u < 7; ++u) wv[u] = (kb + u < kn) ? wp[(size_t)(kb + u) * 6144] : 0.f;
#pragma unroll
                for (int u = 0; u < 7; ++u) { const int kk = (kb + u < kn) ? (k0 + kb + u) : k0; const LAS f32x4* s4 = (const LAS f32x4*)(sc + kk * 16);
#pragma unroll
                    for (int q = 0; q < 4; ++q) { const f32x4 sv = s4[q]; acc[4 * q] += sv[0] * wv[u]; acc[4 * q + 1] += sv[1] * wv[u]; acc[4 * q + 2] += sv[2] * wv[u]; acc[4 * q + 3] += sv[3] * wv[u]; } }
            }
#pragma unroll
            for (int b = 0; b < 16; ++b) red[(ks * 16 + b) * 24 + col] = acc[b];
        }
        __syncthreads();
        for (int i = f_tid; i < 16 * 24; i += NTHR) { const int b = i / 24, cc = i - b * 24; float sacc = 0.f;
            for (int q = 0; q < 21; ++q) sacc += red[(q * 16 + b) * 24 + cc];
            WSP(float, WS_MOD)[b * 6144 + F.vcu * 24 + cc] = sacc + (F.a->in[3])[F.vcu * 24 + cc]; }
        __syncthreads();
    }
    {
        LAS float* scr = (LAS float*)(F.lds + f_wave * 16384);
        constexpr int I_IN = (1024 / 64) * (NPROJ / 32), I_OUT = (2048 / 64) * (1024 / 32);
        for (int it = gw; it < I_IN + I_OUT; it += NGW) {
            if (it < I_IN) { const int kb = it / (NPROJ / 32), nb = it % (NPROJ / 32); const int dn = 32 * nb, sn = dn < 3072 ? dn : dn + 16;
                transpose_tile((F.a->in[5]), INW, 64 * kb, sn, WSP(bf16, WS_WINT), 1024, dn, scr, f_lane, nullptr); }
            else { const int r = it - I_IN, kb = r / 32, nb = r % 32; const int k0 = 64 * kb;
                transpose_tile((F.a->in[23]), 1024, k0, 32 * nb, WSP(bf16, WS_WOUTT), 2048, 32 * nb, scr, f_lane, k0 < 1024 ? (F.a->in[11]) : (F.a->in[22]) - 1024); }
        }
    }
    for (int i = gt; i < 16 * 1024; i += NGT) { const int h = i >> 10, k = i & 1023; WSP(float, WS_WDT)[i] = (F.a->in[5])[(size_t)k * INW + 3072 + h]; }
    for (int task = gw; task < 2048; task += NGW) {
        const int nt = task >> 4, ks = task & 15, n0 = 16 * nt, hc = n0 >> 7, k0 = 64 * ks;
        const int li = f_lane & 15, lq = f_lane >> 4;
        f32x4 acc[4];
#pragma unroll
        for (int s = 0; s < 4; ++s) acc[s] = (f32x4){0.f, 0.f, 0.f, 0.f};
        const float* ap = (F.a->in[26]) + (size_t)(n0 + li) * 128 + 4 * lq;
        const float* bp = (F.a->in[25]) + (size_t)(k0 + li) * 2048 + hc * 128 + 4 * lq;
#pragma unroll
        for (int q = 0; q < 8; ++q) { const f32x4 a = *(const f32x4*)(ap + 16 * q);
#pragma unroll
            for (int s = 0; s < 4; ++s) { const f32x4 b = *(const f32x4*)(bp + (size_t)(16 * s) * 2048 + 16 * q);
#pragma unroll
                for (int jj = 0; jj < 4; ++jj) acc[s] = __builtin_amdgcn_mfma_f32_16x16x4f32(a[jj], b[jj], acc[s], 0, 0, 0); } }
        bf16* o = WSP(bf16, WS_WQKT);
#pragma unroll
        for (int s = 0; s < 4; ++s)
#pragma unroll
            for (int r = 0; r < 4; ++r) o[(size_t)(n0 + 4 * lq + r) * 1024 + k0 + 16 * s + li] = (bf16)f2bf(acc[s][r]);
    }
    for (int i = gt; i < S5G * S5P; i += NGT) {
        const float lr = (F.a->in[12])[i], li = (F.a->in[13])[i], dt = expf((F.a->in[14])[i >> 6]);
        const float mag = expf(lr * dt); float sn, cs; sincosf(li * dt, &sn, &cs);
        const float lbr = mag * cs, lbi = mag * sn, den = lr * lr + li * li;
        const float cfr = ((lbr - 1.0f) * lr + lbi * li) / den, cfi = (lbi * lr - (lbr - 1.0f) * li) / den;
        WSP(float, WS_S5LB)[2 * i] = lbr; WSP(float, WS_S5LB)[2 * i + 1] = lbi;
        for (int hh = 0; hh < 16; ++hh) { const float br = (F.a->in[15])[i * 16 + hh], bi = (F.a->in[16])[i * 16 + hh];
            WSP(float, WS_S5BB)[i * 32 + hh] = cfr * br - cfi * bi; WSP(float, WS_S5BB)[i * 32 + 16 + hh] = cfr * bi + cfi * br; }
    }
    for (int i = gt; i < MTOK; i += NGT) WSP(float, WS_ROWSTAT)[i] = 0.f;
}

__device__ __forceinline__ void p1_phase(Frame& F) {
    const int f_tid = threadIdx.x, f_lane = f_tid & 63, f_wave = __builtin_amdgcn_readfirstlane(f_tid >> 6);
    const int gw = F.vcu * NWAVES + f_wave;
    LAS float* wdt = (LAS float*)F.lds;
    for (int i = f_tid; i < 16 * 1024 / 4; i += NTHR) ((LAS f32x4*)wdt)[i] = ((const f32x4*)WSP(float, WS_WDT))[i];
    __syncthreads();
    const int lane = f_lane;
    for (int wq = gw; wq < MTOK / 16; wq += F.G * NWAVES) {
        const int b = wq >> 7; const float* mb = WSP(float, WS_MOD) + (size_t)b * 6144;
        f32x4 Gv[4], Sv[4];
#pragma unroll
        for (int j = 0; j < 4; ++j) { const int k = 4 * lane + 256 * j; const f32x4 g = *(const f32x4*)((F.a->in[4]) + k), sc = *(const f32x4*)(mb + 1024 + k); Gv[j] = g * (sc + 1.0f); Sv[j] = *(const f32x4*)(mb + k); }
        f32x4 nx[4];
#pragma unroll
        for (int j = 0; j < 4; ++j) nx[j] = *(const f32x4*)((F.a->in[0]) + (size_t)wq * 16 * 1024 + 4 * lane + 256 * j);
        for (int tt = 0; tt < 16; ++tt) {
            asm volatile("" ::: "memory");
            const size_t t = (size_t)wq * 16 + tt; const float* xr = (F.a->in[0]) + t * 1024;
            f32x4 v[4]; float ss = 0.f;
#pragma unroll
            for (int j = 0; j < 4; ++j) { v[j] = nx[j]; ss += (v[j][0] * v[j][0] + v[j][1] * v[j][1]) + (v[j][2] * v[j][2] + v[j][3] * v[j][3]); }
            if (tt < 15) {
#pragma unroll
                for (int j = 0; j < 4; ++j) nx[j] = *(const f32x4*)(xr + 1024 + 4 * lane + 256 * j); }
            const float rstd = rsqrt_f(wave_sum(ss) * (1.0f / 1024.0f) + EPSF);
            bf16* hr = WSP(bf16, WS_H1) + t * 1024;
#pragma unroll
            for (int j = 0; j < 4; ++j) { v[j] = v[j] * rstd * Gv[j] + Sv[j]; v2u w; w.x = pk2(v[j][0], v[j][1]); w.y = pk2(v[j][2], v[j][3]); *(v2u*)(hr + 4 * lane + 256 * j) = w; }
            float d[16];
#pragma unroll
            for (int h = 0; h < 16; ++h) { float a = 0.f;
#pragma unroll
                for (int j = 0; j < 4; ++j) { const f32x4 w = *(const LAS f32x4*)(wdt + h * 1024 + 4 * lane + 256 * j); a += (v[j][0] * w[0] + v[j][1] * w[1]) + (v[j][2] * w[2] + v[j][3] * w[3]); }
                d[h] = a; }
            float e8[8], e4[4], e2[2], e1;
#pragma unroll
            for (int i = 0; i < 8; ++i) { const bool up = lane & 32; const float snd = up ? d[i] : d[i + 8]; const float rcv = __shfl_xor(snd, 32); e8[i] = (up ? d[i + 8] : d[i]) + rcv; }
#pragma unroll
            for (int i = 0; i < 4; ++i) { const bool up = lane & 16; const float snd = up ? e8[i] : e8[i + 4]; const float rcv = __shfl_xor(snd, 16); e4[i] = (up ? e8[i + 4] : e8[i]) + rcv; }
#pragma unroll
            for (int i = 0; i < 2; ++i) { const bool up = lane & 8; const float snd = up ? e4[i] : e4[i + 2]; const float rcv = __shfl_xor(snd, 8); e2[i] = (up ? e4[i + 2] : e4[i]) + rcv; }
            { const bool up = lane & 4; const float snd = up ? e2[0] : e2[1]; const float rcv = __shfl_xor(snd, 4); e1 = (up ? e2[1] : e2[0]) + rcv; }
            e1 += __shfl_xor(e1, 2); e1 += __shfl_xor(e1, 1);
            const int head = ((lane >> 5) & 1) * 8 + ((lane >> 4) & 1) * 4 + ((lane >> 3) & 1) * 2 + ((lane >> 2) & 1);
            if ((lane & 3) == 0) WSP(float, WS_DTRAW)[t * 16 + head] = e1;
        }
    }
    for (int n = gw; n < 2048; n += F.G * NWAVES) {
        const bf16* wr = WSP(bf16, WS_WQKT) + (size_t)n * 1024 + 16 * lane;
        const v4u w0 = *(const v4u*)wr, w1 = *(const v4u*)(wr + 8);
        float wv[16]; wv[0] = bflo(w0.x); wv[1] = bfhi(w0.x); wv[2] = bflo(w0.y); wv[3] = bfhi(w0.y); wv[4] = bflo(w0.z); wv[5] = bfhi(w0.z); wv[6] = bflo(w0.w); wv[7] = bfhi(w0.w);
        wv[8] = bflo(w1.x); wv[9] = bfhi(w1.x); wv[10] = bflo(w1.y); wv[11] = bfhi(w1.y); wv[12] = bflo(w1.z); wv[13] = bfhi(w1.z); wv[14] = bflo(w1.w); wv[15] = bfhi(w1.w);
        for (int b = 0; b < 16; ++b) { const float* sp = WSP(float, WS_MOD) + (size_t)b * 6144 + 3072 + 16 * lane; float a = 0.f;
#pragma unroll
            for (int q = 0; q < 4; ++q) { const f32x4 s = *(const f32x4*)(sp + 4 * q); a += (s[0] * wv[4 * q] + s[1] * wv[4 * q + 1]) + (s[2] * wv[4 * q + 2] + s[3] * wv[4 * q + 3]); }
            a = wave_sum(a); if (lane == 0) WSP(float, WS_SB)[b * 2048 + n] = a; }
    }
}
__device__ __forceinline__ void p3pre_conv(Frame& F) {
    const int tid = threadIdx.x;
    const bf16* proj = WSP(bf16, WS_PROJ); bf16* xo = (bf16*)F.out;
    for (int item = F.vcu * NTHR + tid; item < (MTOK / 16) * 256; item += F.G * NTHR) {
        const int oc = item & 255, run = item >> 8; const int t0 = run * 16, ch = 8 * oc;
        const bool halo = (t0 & (SEQ - 1)) != 0;
        v4u rw[19];
#pragma unroll
        for (int k = 0; k < 19; ++k) { rw[k] = (v4u){0u, 0u, 0u, 0u}; if (k >= 3 || halo) rw[k] = *(const v4u*)(proj + (size_t)(t0 - 3 + k) * NPROJ + 1024 + ch); }
        float cw[4][8], cbv[8];
#pragma unroll
        for (int k = 0; k < 4; ++k) { const f32x4 w0 = *(const f32x4*)((F.a->in[6]) + k * 2048 + ch), w1 = *(const f32x4*)((F.a->in[6]) + k * 2048 + ch + 4);
#pragma unroll
            for (int e = 0; e < 4; ++e) { cw[k][e] = w0[e]; cw[k][4 + e] = w1[e]; } }
        { const f32x4 b0 = *(const f32x4*)((F.a->in[7]) + ch), b1 = *(const f32x4*)((F.a->in[7]) + ch + 4);
#pragma unroll
            for (int e = 0; e < 4; ++e) { cbv[e] = b0[e]; cbv[4 + e] = b1[e]; } }
        float r0[8], r1[8], r2[8];
        unpack8(rw[0], r0); unpack8(rw[1], r1); unpack8(rw[2], r2);
#pragma unroll
        for (int tt = 0; tt < 16; ++tt) {
            float r3[8]; unpack8(rw[3 + tt], r3);
            float v[8];
#pragma unroll
            for (int i = 0; i < 8; ++i) { v[i] = silu_f(cbv[i] + r0[i] * cw[0][i] + r1[i] * cw[1][i] + r2[i] * cw[2][i] + r3[i] * cw[3][i]); r0[i] = r1[i]; r1[i] = r2[i]; r2[i] = r3[i]; }
            *(v4u*)(xo + (size_t)(t0 + tt) * 2048 + ch) = (v4u){pk2(v[0], v[1]), pk2(v[2], v[3]), pk2(v[4], v[5]), pk2(v[6], v[7])};
        }
    }
}
constexpr int SSD_PITCH = 272;
__device__ __forceinline__ bf16x8 lds_frag(LAS unsigned char* base, int row, int kbyte) { return *(const LAS bf16x8*)(base + row * SSD_PITCH + kbyte); }
#ifdef PROBE_SSD
#define SPR_T(v) const unsigned long long v = __builtin_amdgcn_s_memtime();
#define SPR_ACC(i, d) sacc[i] += (d);
#else
#define SPR_T(v)
#define SPR_ACC(i, d)
#endif
constexpr int S3_CS = 0, S3_BS = 34816, S3_GY = 69632, S3_XDT = 104448, S3_XP = 144, S3_PREV = 122880, S3_CSF = 140288, S3_DTF = 141312, S3_WTS = 142336, S3_END = 143360;
static_assert(S3_END <= LDS_MAIN, "SSD v3 LDS map");
typedef short v4i16_t __attribute__((ext_vector_type(4)));
__device__ __forceinline__ bf16x8 lds_frag_tr(LAS unsigned char* tile, int pitch, int k0, int col0, int li, int lq) {
    LAS unsigned char* p = tile + (k0 + 8 * lq + (li >> 2)) * pitch + (col0 + 4 * (li & 3)) * 2;
    const v4i16_t lo = __builtin_amdgcn_ds_read_tr16_b64_v4i16((LAS v4i16_t*)p), hi = __builtin_amdgcn_ds_read_tr16_b64_v4i16((LAS v4i16_t*)(p + 4 * pitch));
    return __builtin_shufflevector(lo, hi, 0, 1, 2, 3, 4, 5, 6, 7);
}
struct Ssd3Pre { v4u xr[4], br[4], cr[4]; float d0, d1; };
__device__ __forceinline__ void ssd3_prefetch(Ssd3Pre& P, const char* xcb, const float* dtr, unsigned voB, unsigned voX, int tid, int lane, int w) {
#pragma unroll
    for (int r = 0; r < 4; ++r) { P.br[r] = *(const v4u*)(xcb + (voB + r * 4096u)); P.cr[r] = *(const v4u*)(xcb + (voB + 1024u + r * 4096u)); }
#pragma unroll
    for (int r = 0; r < 4; ++r) P.xr[r] = *(const v4u*)(xcb + (voX + r * 4096u));
    P.d0 = dtr[lane * 32]; P.d1 = dtr[lane * 32 + 16];
}
__device__ __forceinline__ void ssd3_cumsum(LAS unsigned char* L, int par, float r0, float r1, float dtb, float A, int lane) {
    LAS float* csf = (LAS float*)(L + S3_CSF + par * 512); LAS float* dtf = (LAS float*)(L + S3_DTF + par * 512); LAS float* wts = (LAS float*)(L + S3_WTS + par * 512);
    const float d0 = softplus_f(r0 + dtb), d1 = softplus_f(r1 + dtb);
    const float a0 = d0 * A, a1 = d1 * A; float s = a0 + a1;
#pragma unroll
    for (int o = 1; o < 64; o <<= 1) { const float t = __shfl_up(s, o); if (lane >= o) s += t; }
    const float tot = __shfl(s, 63);
    dtf[2 * lane] = d0; dtf[2 * lane + 1] = d1; csf[2 * lane] = s - a1; csf[2 * lane + 1] = s;
    wts[2 * lane] = __expf(tot - (s - a1)); wts[2 * lane + 1] = __expf(tot - s);
}
__device__ __forceinline__ void p3_ssd3(Frame& F) {
    const int tid0 = threadIdx.x, w = __builtin_amdgcn_readfirstlane(tid0 >> 6);
    LAS unsigned char* L = F.lds;
    const bf16* proj = WSP(bf16, WS_PROJ); const bf16* xc = (const bf16*)F.out; const float* dtraw = WSP(float, WS_DTRAW);
    for (int item = F.vcu; item < NB * NHEADS; item += F.G) {
        const int b = item >> 4, h = item & 15, g = h >> 2;
        int tid = tid0; asm volatile("" : "+v"(tid)); int lane = tid & 63;
        const float A = -__expf((F.a->in[9])[h]), Dh = (F.a->in[10])[h], dtb = (F.a->in[8])[h];
        const int pbs = w >> 1, nb0 = 4 * (w & 1);
        f32x4 st[4];
#pragma unroll
        for (int j = 0; j < 4; ++j) st[j] = (f32x4){0.f, 0.f, 0.f, 0.f};
        __syncthreads();
        for (int i = tid; i < 17408 / 16; i += NTHR) ((LAS v4u*)(L + S3_PREV))[i] = (v4u){0u, 0u, 0u, 0u};
        Ssd3Pre P;
        { const unsigned voB0 = (unsigned)((4 * (tid >> 4)) * 2048 + 1024 + g * 128 + 8 * (tid & 15)) * 2u, voX0 = (unsigned)((4 * ((tid & 255) >> 3)) * 2048 + h * 64 + 8 * (tid & 7)) * 2u;
          ssd3_prefetch(P, (const char*)xc + (size_t)b * SEQ * 4096, dtraw + (size_t)b * SEQ * 16 + h, voB0, voX0, tid, lane, w); }
        if (w == 0) ssd3_cumsum(L, 0, P.d0, P.d1, dtb, A, lane);
        __syncthreads();
#ifdef PROBE_SSD
        unsigned long long sacc[8] = {0, 0, 0, 0, 0, 0, 0, 0};
#endif
        for (int c = 0; c < SEQ / CHUNK; ++c) {
            SPR_T(s0)
            const size_t row0 = (size_t)b * SEQ + (size_t)c * CHUNK; const int par = c & 1;
            asm volatile("" : "+v"(tid));
            lane = tid & 63; const int li = lane & 15, lq = lane >> 4;
            const unsigned voB = (unsigned)((4 * (tid >> 4)) * 2048 + 1024 + g * 128 + 8 * (tid & 15)) * 2u, voX = (unsigned)((4 * ((tid & 255) >> 3)) * 2048 + h * 64 + 8 * (tid & 7)) * 2u;
            const unsigned voZ0 = (unsigned)((tid >> 3) * NPROJ + h * 64 + 8 * (tid & 7)) * 2u, voZ1 = voZ0 + 64u * NPROJ * 2u;
            LAS float* csf = (LAS float*)(L + S3_CSF + par * 512); LAS float* dtf = (LAS float*)(L + S3_DTF + par * 512); LAS float* wts = (LAS float*)(L + S3_WTS + par * 512);
            { const int ob = tid & 15, lb = 4 * (tid >> 4), n0 = 8 * ob;
#pragma unroll
              for (int r = 0; r < 4; ++r) { *(LAS v4u*)(L + S3_BS + (lb + r) * SSD_PITCH + n0 * 2) = P.br[r]; *(LAS v4u*)(L + S3_CS + (lb + r) * SSD_PITCH + n0 * 2) = P.cr[r]; } }
            if (tid < 256) { const int ox = tid & 7, lx = 4 * (tid >> 3), p0 = 8 * ox;
#pragma unroll
              for (int r = 0; r < 4; ++r) { float xv[8]; unpack8(P.xr[r], xv); const float tw = dtf[lx + r];
                  *(LAS v4u*)(L + S3_XDT + (lx + r) * S3_XP + p0 * 2) = (v4u){pk2(xv[0] * tw, xv[1] * tw), pk2(xv[2] * tw, xv[3] * tw), pk2(xv[4] * tw, xv[5] * tw), pk2(xv[6] * tw, xv[7] * tw)}; } }
            const char* prb = (const char*)proj + row0 * (NPROJ * 2);
            const v4u zc0 = *(const v4u*)(prb + voZ0), zc1 = *(const v4u*)(prb + voZ1);
            SPR_T(s1) SPR_ACC(0, s1 - s0)
            LDS_BARRIER();
            SPR_T(s2) SPR_ACC(1, s2 - s1)
            const float cs_end = csf[127];
            bf16x8 ca[4];
#pragma unroll
            for (int ks = 0; ks < 4; ++ks) ca[ks] = lds_frag(L + S3_CS, 16 * w + li, 64 * ks + 16 * lq);
            float csl[4];
#pragma unroll
            for (int r = 0; r < 4; ++r) csl[r] = csf[16 * w + 4 * lq + r];
            { bf16x8 bq[2][4];
#pragma unroll
              for (int ks = 0; ks < 4; ++ks) bq[0][ks] = lds_frag(L + S3_BS, li, 64 * ks + 16 * lq);
#pragma unroll
              for (int sb = 0; sb < 8; ++sb) if (sb <= (w | 1)) {
                  f32x4 cbv = (f32x4){0.f, 0.f, 0.f, 0.f};
                  const int s = 16 * sb + li; const float css = csf[s];
                  if (sb <= w) {
                      if (sb + 1 <= w) {
#pragma unroll
                          for (int ks = 0; ks < 4; ++ks) bq[(sb + 1) & 1][ks] = lds_frag(L + S3_BS, 16 * (sb + 1) + li, 64 * ks + 16 * lq); }
                      __builtin_amdgcn_sched_barrier(0);
#pragma unroll
                      for (int ks = 0; ks < 4; ++ks) cbv = __builtin_amdgcn_mfma_f32_16x16x32_bf16(ca[ks], bq[sb & 1][ks], cbv, 0, 0, 0);
                      __builtin_amdgcn_sched_barrier(0); }
#pragma unroll
                  for (int r = 0; r < 4; ++r) { const int l = 16 * w + 4 * lq + r; const float gv = (s <= l) ? cbv[r] * __expf(csl[r] - css) : 0.f;
                      *(LAS unsigned short*)(L + S3_GY + l * SSD_PITCH + s * 2) = (unsigned short)f2bf(gv); } } }
            LDS_WAIT(); asm volatile("" ::: "memory");
            SPR_T(s3) SPR_ACC(2, s3 - s2)
            f32x4 yd[4], yo[4];
#pragma unroll
            for (int pb = 0; pb < 4; ++pb) { yd[pb] = (f32x4){0.f, 0.f, 0.f, 0.f}; yo[pb] = (f32x4){0.f, 0.f, 0.f, 0.f}; }
            { bf16x8 gq[2], xq[2][4];
              gq[0] = lds_frag(L + S3_GY, 16 * w + li, 16 * lq);
#pragma unroll
              for (int pb = 0; pb < 4; ++pb) xq[0][pb] = lds_frag_tr(L + S3_XDT, S3_XP, 0, 16 * pb, li, lq);
#pragma unroll
              for (int ks = 0; ks < 4; ++ks) if (ks <= (w >> 1)) {
                  if (ks + 1 <= (w >> 1)) { gq[(ks + 1) & 1] = lds_frag(L + S3_GY, 16 * w + li, 64 * (ks + 1) + 16 * lq);
#pragma unroll
                      for (int pb = 0; pb < 4; ++pb) xq[(ks + 1) & 1][pb] = lds_frag_tr(L + S3_XDT, S3_XP, 32 * (ks + 1), 16 * pb, li, lq); }
                  __builtin_amdgcn_sched_barrier(0);
#pragma unroll
                  for (int pb = 0; pb < 4; ++pb) yd[pb] = __builtin_amdgcn_mfma_f32_16x16x32_bf16(gq[ks & 1], xq[ks & 1][pb], yd[pb], 0, 0, 0);
                  __builtin_amdgcn_sched_barrier(0); } }
            { bf16x8 pq[2][4];
#pragma unroll
              for (int pb = 0; pb < 4; ++pb) pq[0][pb] = lds_frag(L + S3_PREV, 16 * pb + li, 16 * lq);
#pragma unroll
              for (int ks = 0; ks < 4; ++ks) {
                  if (ks < 3) {
#pragma unroll
                      for (int pb = 0; pb < 4; ++pb) pq[(ks + 1) & 1][pb] = lds_frag(L + S3_PREV, 16 * pb + li, 64 * (ks + 1) + 16 * lq); }
                  __builtin_amdgcn_sched_barrier(0);
#pragma unroll
                  for (int pb = 0; pb < 4; ++pb) yo[pb] = __builtin_amdgcn_mfma_f32_16x16x32_bf16(ca[ks], pq[ks & 1][pb], yo[pb], 0, 0, 0);
                  __builtin_amdgcn_sched_barrier(0); } }
#pragma unroll
            for (int r = 0; r < 4; ++r) { const float e = __expf(csl[r]);
#pragma unroll
                for (int pb = 0; pb < 4; ++pb) *(LAS float*)(L + S3_GY + (16 * w + 4 * lq + r) * SSD_PITCH + (16 * pb + li) * 4) = yd[pb][r] + e * yo[pb][r]; }
            { const size_t rown = row0 + (c + 1 < SEQ / CHUNK ? CHUNK : 0);
              ssd3_prefetch(P, (const char*)xc + rown * 4096, dtraw + rown * 16 + h, voB, voX, tid, lane, w); }
            SPR_T(s4) SPR_ACC(3, s4 - s3)
            LDS_BARRIER();
            SPR_T(s5) SPR_ACC(4, s5 - s4)
            { const float dec = __expf(cs_end);
#pragma unroll
              for (int j = 0; j < 4; ++j) st[j] = st[j] * dec;
              bf16x8 xq[2], bq2[2][4]; f32x4 wq[2][2];
              xq[0] = lds_frag_tr(L + S3_XDT, S3_XP, 0, 16 * pbs, li, lq); wq[0][0] = *(const LAS f32x4*)(wts + 8 * lq); wq[0][1] = *(const LAS f32x4*)(wts + 8 * lq + 4);
#pragma unroll
              for (int j = 0; j < 4; ++j) bq2[0][j] = lds_frag_tr(L + S3_BS, SSD_PITCH, 0, 16 * (nb0 + j), li, lq);
#pragma unroll
              for (int ks = 0; ks < 4; ++ks) {
                  if (ks < 3) { xq[(ks + 1) & 1] = lds_frag_tr(L + S3_XDT, S3_XP, 32 * (ks + 1), 16 * pbs, li, lq); wq[(ks + 1) & 1][0] = *(const LAS f32x4*)(wts + 32 * (ks + 1) + 8 * lq); wq[(ks + 1) & 1][1] = *(const LAS f32x4*)(wts + 32 * (ks + 1) + 8 * lq + 4);
#pragma unroll
                      for (int j = 0; j < 4; ++j) bq2[(ks + 1) & 1][j] = lds_frag_tr(L + S3_BS, SSD_PITCH, 32 * (ks + 1), 16 * (nb0 + j), li, lq); }
                  __builtin_amdgcn_sched_barrier(0);
                  const f32x4 w0 = wq[ks & 1][0], w1 = wq[ks & 1][1];
                  float xv[8]; unpack8(__builtin_bit_cast(v4u, xq[ks & 1]), xv);
                  const v4u xw = (v4u){pk2(xv[0] * w0[0], xv[1] * w0[1]), pk2(xv[2] * w0[2], xv[3] * w0[3]), pk2(xv[4] * w1[0], xv[5] * w1[1]), pk2(xv[6] * w1[2], xv[7] * w1[3])};
                  const bf16x8 xf = __builtin_bit_cast(bf16x8, xw);
#pragma unroll
                  for (int j = 0; j < 4; ++j) st[j] = __builtin_amdgcn_mfma_f32_16x16x32_bf16(xf, bq2[ks & 1][j], st[j], 0, 0, 0);
                  __builtin_amdgcn_sched_barrier(0); }
#pragma unroll
              for (int j = 0; j < 4; ++j)
#pragma unroll
                  for (int r = 0; r < 4; ++r) *(LAS unsigned short*)(L + S3_PREV + (16 * pbs + 4 * lq + r) * SSD_PITCH + (16 * (nb0 + j) + li) * 2) = (unsigned short)f2bf(st[j][r]); }
            SPR_T(s6) SPR_ACC(5, s6 - s5)
#pragma unroll
            for (int k = 0; k < 2; ++k) { const int it = tid + 512 * k, l = it >> 3, o = it & 7; const size_t row = row0 + l;
                const f32x4 y0 = *(const LAS f32x4*)(L + S3_GY + l * SSD_PITCH + 32 * o), y1 = *(const LAS f32x4*)(L + S3_GY + l * SSD_PITCH + 32 * o + 16);
                const v4u xw = *(const LAS v4u*)(L + S3_XDT + l * S3_XP + 16 * o); const v4u zw = k == 0 ? zc0 : zc1; const float dsk = Dh * __builtin_amdgcn_rcpf(fmaxf(dtf[l], 1e-30f));
                float xv[8], zv[8], yv[8]; unpack8(xw, xv); unpack8(zw, zv);
                float ss = 0.f;
#pragma unroll
                for (int e = 0; e < 8; ++e) { const float yy = (e < 4 ? y0[e] : y1[e - 4]) + dsk * xv[e]; yv[e] = yy * silu_f(zv[e]); ss += yv[e] * yv[e]; }
                ss += __shfl_xor(ss, 1); ss += __shfl_xor(ss, 2); ss += __shfl_xor(ss, 4);
                if (o == 0) WSP(float, WS_STSSD)[row * 16 + h] = ss;
                *(v4u*)(WSP(bf16, WS_Y) + row * 2048 + h * 64 + 8 * o) = (v4u){pk2(yv[0], yv[1]), pk2(yv[2], yv[3]), pk2(yv[4], yv[5]), pk2(yv[6], yv[7])}; }
            if (w == 0 && c + 1 < SEQ / CHUNK) ssd3_cumsum(L, par ^ 1, P.d0, P.d1, dtb, A, lane);
            SPR_T(s7) SPR_ACC(6, s7 - s6)
            LDS_BARRIER();
            SPR_T(s8) SPR_ACC(7, s8 - s7)
        }
#ifdef PROBE_SSD
        if (blockIdx.x == 0 && threadIdx.x == PROBE_TID) *(volatile float*)(F.ws + WS_CTL + 40000) = (float)sacc[PROBE_SSD] * 1e-3f;
#endif
    }
}
typedef float f32x16 __attribute__((ext_vector_type(16)));
#ifdef PROBE_SEL
#define PR_T(v) const unsigned long long v = __builtin_amdgcn_s_memtime();
#define PR_ACC(a, d) a += (d);
#define PR_OUT(i, a) if (PROBE_SEL == (i) && blockIdx.x == 0 && threadIdx.x == 0) *(volatile float*)(F.ws + WS_CTL + 40000) = (float)(a) * 1e-4f;
#define PR_OUT4(i, a) if (PROBE_SEL == (i) && blockIdx.x == 0 && threadIdx.x == 256) *(volatile float*)(F.ws + WS_CTL + 40000) = (float)(a) * 1e-4f;
#else
#define PR_T(v)
#define PR_ACC(a, d)
#define PR_OUT(i, a)
#define PR_OUT4(i, a)
#endif
constexpr int S5V_BU = 0, S5V_BUP = 2056, S5V_BUSZ = 16 * S5V_BUP, S5V_XT = 2 * S5V_BUSZ, S5V_XTP = 1040, S5V_XTSZ = 16 * S5V_XTP, S5V_VS = S5V_XT + 2 * S5V_XTSZ, S5V_OT = S5V_VS + 4 * 512, S5V_OTP = 144, S5V_OTSZ = 16 * S5V_OTP, S5V_END = S5V_OT + 2 * S5V_OTSZ;
static_assert(S5V_END <= LDS_MAIN, "S5 v2 LDS map");
__device__ __forceinline__ void p3_s5v2(Frame& F) {
    const int tid = threadIdx.x, lane = tid & 63, w = __builtin_amdgcn_readfirstlane(tid >> 6);
    const int li = lane & 15, lq = lane >> 4;
    LAS unsigned char* L = F.lds;
    const bf16* proj = WSP(bf16, WS_PROJ);
    constexpr int NT = SEQ / 16;
#ifdef PROBE_S5
    const unsigned long long pr_t0 = PROBE_CLOCK();
#endif
    for (int item = F.vcu; item < NB * 16; item += F.G) {
        const int b = item >> 4, gs = item & 15;
        const bool scanw = w < 4; const int gl = w & 3, g = gs * 4 + gl;
        const bf16* ubase = proj + (size_t)b * SEQ * NPROJ + 3072 + gs * 64 + gl * 16;
        __syncthreads();
        if (scanw) {
            __builtin_amdgcn_s_setprio(2);
            const float lbr = WSP(float, WS_S5LB)[(g * 64 + lane) * 2], lbi = WSP(float, WS_S5LB)[(g * 64 + lane) * 2 + 1], nlbi = -lbi;
            bf16x8 bfr[8];
#pragma unroll
            for (int cb = 0; cb < 8; ++cb) { v4u v = (v4u){0u, 0u, 0u, 0u};
                if (lq < 2) { const int col = 16 * cb + li; const float* src = WSP(float, WS_S5BB) + (g * 64 + (col >> 1)) * 32 + (col & 1) * 16 + 8 * lq; const f32x4 a0 = *(const f32x4*)src, a1 = *(const f32x4*)(src + 4);
                    v = (v4u){pk2(a0[0], a0[1]), pk2(a0[2], a0[3]), pk2(a1[0], a1[1]), pk2(a1[2], a1[3])}; }
                bfr[cb] = __builtin_bit_cast(bf16x8, v); }
            float xr = 0.f, xi = 0.f;
            const int lq2 = lq & 1;
            v4u ua = *(const v4u*)(ubase + (size_t)li * NPROJ + 8 * lq2);
            { const bf16x8 af = __builtin_bit_cast(bf16x8, lq < 2 ? ua : (v4u){0u, 0u, 0u, 0u});
              ua = *(const v4u*)(ubase + (size_t)(16 + li) * NPROJ + 8 * lq2);
#pragma unroll
              for (int cb = 0; cb < 8; ++cb) { f32x4 acc = (f32x4){0.f, 0.f, 0.f, 0.f}; acc = __builtin_amdgcn_mfma_f32_16x16x32_bf16(af, bfr[cb], acc, 0, 0, 0);
#pragma unroll
                  for (int r = 0; r < 4; ++r) *(LAS float*)(L + S5V_BU + (4 * lq + r) * S5V_BUP + (gl * 128 + 16 * cb + li) * 4) = acc[r]; } }
            LDS_BARRIER();
            unsigned long long pa0 = 0, pa1 = 0, pa2 = 0;
            for (int k = 0; k <= NT; ++k) {
                PR_T(pt0)
                if (k < NT) {
                    const LAS f32x2* bp = (const LAS f32x2*)(L + S5V_BU + (k & 1) * S5V_BUSZ + (gl * 128 + 2 * lane) * 4);
                    LAS unsigned* xp = (LAS unsigned*)(L + S5V_XT + (k & 1) * S5V_XTSZ + (gl * 128 + 2 * lane) * 2);
                    f32x2 bu[16];
#pragma unroll
                    for (int t = 0; t < 16; ++t) bu[t] = bp[t * (S5V_BUP / 8)];
                    unsigned xo[16];
#pragma unroll
                    for (int t = 0; t < 16; ++t) {
                        const float a = __builtin_fmaf(nlbi, xi, bu[t][0]), bq = __builtin_fmaf(lbi, xr, bu[t][1]);
                        const float nr = __builtin_fmaf(lbr, xr, a), ni = __builtin_fmaf(lbr, xi, bq); xr = nr; xi = ni; xo[t] = pk2(xr, xi); }
#pragma unroll
                    for (int t = 0; t < 16; ++t) xp[t * (S5V_XTP / 4)] = xo[t];
                    PR_T(pt1) PR_ACC(pa0, pt1 - pt0)
                    if (k + 1 < NT) {
                        const bf16x8 af = __builtin_bit_cast(bf16x8, lq < 2 ? ua : (v4u){0u, 0u, 0u, 0u});
                        { const int kn = k + 2 < NT ? k + 2 : NT - 1; ua = *(const v4u*)(ubase + (size_t)(16 * kn + li) * NPROJ + 8 * lq2); }
                        LAS unsigned char* bun = L + S5V_BU + ((k + 1) & 1) * S5V_BUSZ;
#pragma unroll
                        for (int cb = 0; cb < 8; ++cb) { f32x4 acc = (f32x4){0.f, 0.f, 0.f, 0.f}; acc = __builtin_amdgcn_mfma_f32_16x16x32_bf16(af, bfr[cb], acc, 0, 0, 0);
#pragma unroll
                            for (int r = 0; r < 4; ++r) *(LAS float*)(bun + (4 * lq + r) * S5V_BUP + (gl * 128 + 16 * cb + li) * 4) = acc[r]; }
                    }
                }
                PR_T(pt2) PR_ACC(pa1, pt2 - pt0)
                LDS_BARRIER();
                PR_T(pt3) PR_ACC(pa2, pt3 - pt2)
            }
            __builtin_amdgcn_s_setprio(0);
            PR_OUT(0, pa0) PR_OUT(1, pa1) PR_OUT(2, pa2)
        } else {
            bf16x8 cfr[4];
#pragma unroll
            for (int ks = 0; ks < 4; ++ks) { const float* cr = (F.a->in[17]) + (g * 16 + li) * 64 + 16 * ks + 4 * lq; const float* ci = (F.a->in[18]) + (g * 16 + li) * 64 + 16 * ks + 4 * lq;
                const f32x4 r0 = *(const f32x4*)cr, i0 = *(const f32x4*)ci;
                cfr[ks] = __builtin_bit_cast(bf16x8, ((v4u){pk2(r0[0], -i0[0]), pk2(r0[1], -i0[1]), pk2(r0[2], -i0[2]), pk2(r0[3], -i0[3])})); }
            v4u gwv = (v4u){0u, 0u, 0u, 0u};
            if (lq < 2) { float gwf[8];
#pragma unroll
                for (int j = 0; j < 8; ++j) gwf[j] = (F.a->in[20])[(g * 16 + 8 * lq + j) * 16 + li];
                gwv = (v4u){pk2(gwf[0], gwf[1]), pk2(gwf[2], gwf[3]), pk2(gwf[4], gwf[5]), pk2(gwf[6], gwf[7])}; }
            const bf16x8 gfr = __builtin_bit_cast(bf16x8, gwv);
            const float dsk = (F.a->in[19])[g * 16 + li], gbias = (F.a->in[21])[g * 16 + li];
            LAS unsigned char* vs = L + S5V_VS + gl * 512;
            float uo[4], un[4];
#pragma unroll
            for (int r = 0; r < 4; ++r) { uo[r] = bf2f(ubase[(size_t)(4 * lq + r) * NPROJ + li]); un[r] = bf2f(ubase[(size_t)(16 + 4 * lq + r) * NPROJ + li]); }
            LDS_BARRIER();
            unsigned long long pb0 = 0, pb1 = 0;
            for (int k = 0; k <= NT; ++k) {
                PR_T(qt0)
                float u2[4];
                { const int kn = k + 1 < NT ? k + 1 : NT - 1;
#pragma unroll
                  for (int r = 0; r < 4; ++r) u2[r] = bf2f(ubase[(size_t)(16 * kn + 4 * lq + r) * NPROJ + li]); }
                if (k >= 2) {
                    const int t = ((tid - 256) >> 3) & 15, oc = tid & 7; const v4u ov = *(const LAS v4u*)(L + S5V_OT + (k & 1) * S5V_OTSZ + t * S5V_OTP + 16 * oc);
                    if (tid < 384) *(v4u*)(WSP(bf16, WS_Y) + ((size_t)b * SEQ + 16 * (k - 2) + t) * 2048 + 1024 + gs * 64 + 8 * oc) = ov; }
                if (k >= 1) {
                    const int kt = k - 1; const LAS unsigned char* xt = L + S5V_XT + (kt & 1) * S5V_XTSZ;
                    f32x4 yacc = (f32x4){0.f, 0.f, 0.f, 0.f};
#pragma unroll
                    for (int ks = 0; ks < 4; ++ks) yacc = __builtin_amdgcn_mfma_f32_16x16x32_bf16(*(const LAS bf16x8*)(xt + li * S5V_XTP + (gl * 128 + 32 * ks + 8 * lq) * 2), cfr[ks], yacc, 0, 0, 0);
                    float v[4];
                    { const f32x2 g0 = gelu_pk2((f32x2){yacc[0] + dsk * uo[0], yacc[1] + dsk * uo[1]}), g1 = gelu_pk2((f32x2){yacc[2] + dsk * uo[2], yacc[3] + dsk * uo[3]}); v[0] = g0[0]; v[1] = g0[1]; v[2] = g1[0]; v[3] = g1[1]; }
#pragma unroll
                    for (int r = 0; r < 4; ++r) *(LAS unsigned short*)(vs + (4 * lq + r) * 32 + li * 2) = (unsigned short)f2bf(v[r]);
                    LDS_WAIT(); asm volatile("" ::: "memory");
                    v4u va = (v4u){0u, 0u, 0u, 0u};
                    if (lq < 2) va = *(const LAS v4u*)(vs + li * 32 + 16 * lq);
                    f32x4 gacc = (f32x4){0.f, 0.f, 0.f, 0.f};
                    gacc = __builtin_amdgcn_mfma_f32_16x16x32_bf16(__builtin_bit_cast(bf16x8, va), gfr, gacc, 0, 0, 0);
                    float o[4], ss[4];
#pragma unroll
                    for (int r = 0; r < 4; ++r) { o[r] = v[r] * sigmoid_f(gacc[r] + gbias); ss[r] = o[r] * o[r]; }
#pragma unroll
                    for (int r = 0; r < 4; ++r) ss[r] = row16_sum_to15(ss[r]);
                    if (li == 15) {
#pragma unroll
                        for (int r = 0; r < 4; ++r) WSP(float, WS_STS5)[((size_t)b * SEQ + 16 * kt + 4 * lq + r) * NS5PART + g] = ss[r]; }
                    LAS unsigned char* ot = L + S5V_OT + (kt & 1) * S5V_OTSZ;
#pragma unroll
                    for (int r = 0; r < 4; ++r) *(LAS unsigned short*)(ot + (4 * lq + r) * S5V_OTP + (gl * 16 + li) * 2) = (unsigned short)f2bf(o[r]);
#pragma unroll
                    for (int r = 0; r < 4; ++r) { uo[r] = un[r]; un[r] = u2[r]; }
                }
                PR_T(qt1) PR_ACC(pb0, qt1 - qt0)
                LDS_BARRIER();
                PR_T(qt2) PR_ACC(pb1, qt2 - qt1)
            }
            PR_OUT4(3, pb0) PR_OUT4(4, pb1)
            { const int t = ((tid - 256) >> 3) & 15, oc = tid & 7; const v4u ov = *(const LAS v4u*)(L + S5V_OT + ((NT - 1) & 1) * S5V_OTSZ + t * S5V_OTP + 16 * oc);
              if (tid < 384) *(v4u*)(WSP(bf16, WS_Y) + ((size_t)b * SEQ + 16 * (NT - 1) + t) * 2048 + 1024 + gs * 64 + 8 * oc) = ov; }
        }
    }
#ifdef PROBE_S5
    if (blockIdx.x == 0 && threadIdx.x == 0) *(volatile float*)(F.ws + WS_CTL + 40000) = (float)(PROBE_CLOCK() - pr_t0) * PROBE_SCALE;
#endif
}
__device__ __forceinline__ unsigned med3u(unsigned a, unsigned b, unsigned c) { unsigned r; asm("v_med3_u32 %0, %1, %2, %3" : "=v"(r) : "v"(a), "v"(b), "v"(c)); return r; }
__device__ __forceinline__ unsigned fkey(float v) { const unsigned u = __builtin_bit_cast(unsigned, v); return (u & 0x80000000u) ? ~u : (u | 0x80000000u); }
__device__ __forceinline__ float fkey_inv(unsigned k) { const unsigned u = (k & 0x80000000u) ? (k & 0x7fffffffu) : ~k; return __builtin_bit_cast(float, u); }
#define TOPK_INSERT(a, x) do { _Pragma("unroll") for (int _i = 15; _i >= 1; --_i) a[_i] = med3u(a[_i - 1], a[_i], (x)); a[0] = a[0] > (x) ? a[0] : (x); } while (0)
__device__ __forceinline__ unsigned fp6_code(float y) {
    const float a = fabsf(y);
    const float c = a < 2.0f ? __builtin_rintf(8.0f * a) : (a < 4.0f ? __builtin_rintf(4.0f * a) + 8.0f : fminf(__builtin_rintf(2.0f * a) + 16.0f, 31.0f));
    return (unsigned)c | (y < 0.f ? 32u : 0u);
}
__device__ __forceinline__ void fp6_pack16(const unsigned* c, unsigned& w0, unsigned& w1, unsigned& w2) {
    w0 = c[0] | (c[1] << 6) | (c[2] << 12) | (c[3] << 18) | (c[4] << 24) | (c[5] << 30);
    w1 = (c[5] >> 2) | (c[6] << 4) | (c[7] << 10) | (c[8] << 16) | (c[9] << 22) | (c[10] << 28);
    w2 = (c[10] >> 4) | (c[11] << 2) | (c[12] << 8) | (c[13] << 14) | (c[14] << 20) | (c[15] << 26);
}
__device__ __forceinline__ void h2_convert(Frame& F, int w0, int nw, int f_lane) {
    for (int tb = w0 * 16; tb < MTOK; tb += nw * 16) {
        const float* sh = WSP(float, WS_MOD) + (size_t)(tb >> 11) * 6144 + 3072 + 16 * f_lane;
        float S2[16];
#pragma unroll
        for (int q = 0; q < 4; ++q) { const f32x4 s4 = *(const f32x4*)(sh + 4 * q); S2[4 * q] = s4[0]; S2[4 * q + 1] = s4[1]; S2[4 * q + 2] = s4[2]; S2[4 * q + 3] = s4[3]; }
#pragma unroll 1
        for (int k = 0; k < 16; k += 4) {
            v4u xa[4], xb[4]; float rst[4];
#pragma unroll
            for (int u = 0; u < 4; ++u) { const int t = tb + k + u; const char* xs = (const char*)(WSP(bf16, WS_X1S) + (size_t)t * 1024) + 32 * f_lane; xa[u] = *(const v4u*)xs; xb[u] = *(const v4u*)(xs + 16); rst[u] = WSP(float, WS_ROWSTAT)[t]; }
#pragma unroll
            for (int u = 0; u < 4; ++u) { const int t = tb + k + u;
                const float rs = rsqrt_f(rst[u] * (1.0f / 1024.0f) + EPSF);
                float h2[16]; unpack8(xa[u], h2); unpack8(xb[u], h2 + 8); float mx = 0.f;
#pragma unroll
                for (int i = 0; i < 16; ++i) { h2[i] = h2[i] * rs + S2[i]; mx = fmaxf(mx, fabsf(h2[i])); }
#pragma unroll
                for (int o = 1; o < 64; o <<= 1) mx = fmaxf(mx, __shfl_xor(mx, o));
                mx = fmaxf(mx, 1e-30f); const float hs = 224.0f / mx;
                v4u w;
#pragma unroll
                for (int q = 0; q < 4; ++q) { int pk = 0; pk = __builtin_amdgcn_cvt_pk_fp8_f32(h2[4 * q] * hs, h2[4 * q + 1] * hs, pk, false); pk = __builtin_amdgcn_cvt_pk_fp8_f32(h2[4 * q + 2] * hs, h2[4 * q + 3] * hs, pk, true); w[q] = (unsigned)pk; }
                *(v4u*)(F.ws + WS_H2Q + (size_t)t * 1024 + 16 * f_lane) = w;
                if (f_lane == 0) WSP(float, WS_HINV)[t] = mx * (1.0f / 224.0f); }
        }
    }
}
__device__ __forceinline__ void expert_convert(Frame& F, int w0, int nw, int f_lane) {
    for (int rw = w0; rw < 2 * 16384; rw += 2 * nw) {
        f32x4 v[2][4]; float mx[2];
#pragma unroll
        for (int u = 0; u < 2; ++u) { const int r = rw + u * nw; const int tb = r >= 16384, e = tb ? r - 16384 : r; const float* src = (tb ? (F.a->in[28]) : (F.a->in[27])) + (size_t)e * 1024 + 16 * f_lane;
#pragma unroll
            for (int q = 0; q < 4; ++q) v[u][q] = *(const f32x4*)(src + 4 * q); }
#pragma unroll
        for (int u = 0; u < 2; ++u) { float m = 0.f;
#pragma unroll
            for (int q = 0; q < 4; ++q) m = fmaxf(m, fmaxf(fmaxf(fabsf(v[u][q][0]), fabsf(v[u][q][1])), fmaxf(fabsf(v[u][q][2]), fabsf(v[u][q][3]))));
#pragma unroll
            for (int o = 1; o < 64; o <<= 1) m = fmaxf(m, __shfl_xor(m, o));
            mx[u] = fmaxf(m, 1e-30f); }
#pragma unroll
        for (int u = 0; u < 2; ++u) { const int r = rw + u * nw; const int tb = r >= 16384, e = tb ? r - 16384 : r; const float sc = 224.0f / mx[u];
            v4u w;
#pragma unroll
            for (int q = 0; q < 4; ++q) { int pk = 0; pk = __builtin_amdgcn_cvt_pk_fp8_f32(v[u][q][0] * sc, v[u][q][1] * sc, pk, false); pk = __builtin_amdgcn_cvt_pk_fp8_f32(v[u][q][2] * sc, v[u][q][3] * sc, pk, true); w[q] = (unsigned)pk; }
#ifdef V6
#ifdef UP12
            {
#else
            if (tb) {
#endif
                const float s6 = 7.5f / mx[u]; unsigned cd[16];
#pragma unroll
                for (int q = 0; q < 4; ++q)
#pragma unroll
                    for (int i = 0; i < 4; ++i) cd[4 * q + i] = fp6_code(v[u][q][i] * s6);
                unsigned w0, w1, w2; fp6_pack16(cd, w0, w1, w2);
                unsigned* dst = (unsigned*)(F.ws + (tb ? WS_EV : WS_EU) + (size_t)e * 768 + 12 * f_lane); dst[0] = w0; dst[1] = w1; dst[2] = w2;
                if (f_lane == 0) WSP(float, tb ? WS_EVS : WS_EUS)[e] = mx[u] * (1.0f / 7.5f);
                continue; }
#endif
            *(v4u*)(F.ws + (tb ? WS_EV : WS_EU) + (size_t)e * 1024 + 16 * f_lane) = w;
            if (f_lane == 0) WSP(float, tb ? WS_EVS : WS_EUS)[e] = mx[u] * (1.0f / 224.0f); }
    }
}
__device__ __forceinline__ void p5b_topk(Frame& F) {
    const int f_tid = threadIdx.x, f_lane = f_tid & 63, f_wave = __builtin_amdgcn_readfirstlane(f_tid >> 6);
    const _Float16* scores = WSP(_Float16, WS_SCORES);
    LAS unsigned char* ix = (LAS unsigned char*)F.lds + f_tid * 36;
#pragma unroll 1
    for (int half = 0; half < 2; ++half) {
#ifdef UP11
    if ((f_wave >> 2) != half) { expert_convert(F, (F.vcu * 4 + (f_wave & 3)) * 2 + half, F.G * 8, f_lane); h2_convert(F, (F.vcu * 4 + (f_wave & 3)) * 2 + half, F.G * 8, f_lane); continue; }
#else
    if ((f_wave >> 2) != half) { expert_convert(F, (F.vcu * 4 + (f_wave & 3)) * 2 + half, F.G * 8, f_lane); continue; }
#endif
    typedef _Float16 f16x8 __attribute__((ext_vector_type(8)));
    f16x8 sva[8], svb[8];
    { const int item0 = (F.vcu * 2 + half) * 256 + (f_tid & 255); const _Float16* sp0 = scores + (size_t)(item0 >> 3) * 2048 + (item0 & 7) * 256;
#pragma unroll
      for (int q = 0; q < 8; ++q) sva[q] = *(const f16x8*)(sp0 + 8 * q); }
#pragma unroll 1
    for (int item = (F.vcu * 2 + half) * 256 + (f_tid & 255); item < MTOK * PH; item += F.G * 512) {
        const int t = item >> 3, hd = item & 7;
        unsigned a1[16], a2[16];
#pragma unroll
        for (int i = 0; i < 16; ++i) { a1[i] = 0u; a2[i] = 0u; }
        const _Float16* sp = scores + (size_t)t * 2048 + hd * 256;
        const int itn = (item + F.G * 512 < MTOK * PH) ? item + F.G * 512 : item;
        const _Float16* spn = scores + (size_t)(itn >> 3) * 2048 + (itn & 7) * 256;
#define TK_BATCH(CUR, NXT, NP, A, M) { \
        { _Pragma("unroll") for (int q = 0; q < 8; ++q) NXT[q] = *(const f16x8*)((NP) + 8 * q); } \
        __builtin_amdgcn_sched_barrier(0); \
        _Pragma("unroll") for (int q = 0; q < 8; ++q) { _Pragma("unroll") for (int e = 0; e < 8; ++e) { const unsigned k = (fkey((float)CUR[q][e]) & ~127u) | (unsigned)(127 - (64 * (M) + 8 * q + e)); TOPK_INSERT(A, k); } } }
        TK_BATCH(sva, svb, sp + 64, a1, 0)
        TK_BATCH(svb, sva, sp + 128, a1, 1)
        TK_BATCH(sva, svb, sp + 192, a2, 0)
        TK_BATCH(svb, sva, spn, a2, 1)
#undef TK_BATCH
        float v1[16], v2[16];
#pragma unroll
        for (int i = 0; i < 16; ++i) { ix[i] = (unsigned char)(127u - (a1[i] & 127u)); ix[16 + i] = (unsigned char)(127u - (a2[i] & 127u)); v1[i] = fkey_inv(a1[i] & ~127u); v2[i] = fkey_inv(a2[i] & ~127u); }
        unsigned cb[16];
#pragma unroll
        for (int i = 0; i < 16; ++i) cb[i] = 0u;
#pragma unroll
        for (int i = 0; i < 16; ++i)
#pragma unroll
            for (int j = 0; j < 16; ++j) if ((i + 1) * (j + 1) <= 16) { const unsigned k = (fkey(v1[i] + v2[j]) & ~255u) | (unsigned)(255 - (i * 16 + j)); TOPK_INSERT(cb, k); }
        float tv[16]; float mx = -3.0e38f;
#pragma unroll
        for (int k = 0; k < 16; ++k) { tv[k] = fkey_inv(cb[k] & ~255u); mx = fmaxf(mx, tv[k]); }
        float sum = 0.f;
#pragma unroll
        for (int k = 0; k < 16; ++k) { tv[k] = __expf(tv[k] - mx); sum += tv[k]; }
        const float inv = 1.0f / sum;
        LDS_WAIT(); asm volatile("" ::: "memory");
        int ev[16]; unsigned long long c64 = 0ull;
#pragma unroll
        for (int k = 0; k < 16; ++k) { const unsigned code = 255u - (cb[k] & 255u); const int i = code >> 4, j = code & 15; ev[k] = (int)ix[i] * 128 + (int)ix[16 + j]; c64 += 1ull << (8 * (ev[k] >> 11)); }
        unsigned long long s64 = c64;
#pragma unroll
        for (int o = 1; o < 8; o <<= 1) { const unsigned lo = __shfl_up((unsigned)s64, o, 8), hi = __shfl_up((unsigned)(s64 >> 32), o, 8); if ((f_lane & 7) >= o) s64 += ((unsigned long long)hi << 32) | lo; }
        const unsigned long long e64 = s64 - c64;
        const unsigned long long t64 = ((unsigned long long)__shfl((unsigned)(s64 >> 32), 7, 8) << 32) | __shfl((unsigned)s64, 7, 8);
        const unsigned long long st64 = (t64 * 0x0101010101010101ull) << 8;
        unsigned long long base64 = st64 + e64;
        int* eo = WSP(int, WS_EID) + (size_t)t * 128; float* go = WSP(float, WS_GATE) + (size_t)t * 128;
#pragma unroll
        for (int k = 0; k < 16; ++k) { const int r8 = 8 * (ev[k] >> 11); const int slot = (int)((base64 >> r8) & 255ull); base64 += 1ull << r8; eo[slot] = ev[k]; go[slot] = tv[k] * inv; }
        if (hd == 0) WSP(unsigned long long, WS_START)[t] = st64;
        LDS_WAIT(); asm volatile("" ::: "memory");
    }
    }
}
__device__ __forceinline__ void dec16(const v4u q, float* f) {
#pragma unroll
    for (int i = 0; i < 4; ++i) { const f32x2 lo = __builtin_amdgcn_cvt_pk_f32_fp8((int)q[i], false), hi = __builtin_amdgcn_cvt_pk_f32_fp8((int)q[i], true); f[4 * i] = lo[0]; f[4 * i + 1] = lo[1]; f[4 * i + 2] = hi[0]; f[4 * i + 3] = hi[1]; }
}
struct CvE { f32x4 v[4]; };
struct CvH { v4u xa, xb; float rst; };
__device__ __forceinline__ void cve_load(CvE& c, Frame& F, int r, int f_lane) {
    const int tb = r >= 16384, e = tb ? r - 16384 : r; const float* src = (tb ? (F.a->in[28]) : (F.a->in[27])) + (size_t)e * 1024 + 16 * f_lane;
#pragma unroll
    for (int q = 0; q < 4; ++q) c.v[q] = *(const f32x4*)(src + 4 * q);
}
__device__ __forceinline__ void cve_finish(const CvE& c, Frame& F, int r, int f_lane) {
    const int tb = r >= 16384, e = tb ? r - 16384 : r; float m = 0.f;
#pragma unroll
    for (int q = 0; q < 4; ++q) m = fmaxf(m, fmaxf(fmaxf(fabsf(c.v[q][0]), fabsf(c.v[q][1])), fmaxf(fabsf(c.v[q][2]), fabsf(c.v[q][3]))));
#pragma unroll
    for (int o = 1; o < 64; o <<= 1) m = fmaxf(m, __shfl_xor(m, o));
    m = fmaxf(m, 1e-30f); const float sc = 224.0f / m;
    v4u w;
#pragma unroll
    for (int q = 0; q < 4; ++q) { int pk = 0; pk = __builtin_amdgcn_cvt_pk_fp8_f32(c.v[q][0] * sc, c.v[q][1] * sc, pk, false); pk = __builtin_amdgcn_cvt_pk_fp8_f32(c.v[q][2] * sc, c.v[q][3] * sc, pk, true); w[q] = (unsigned)pk; }
    *(v4u*)(F.ws + (tb ? WS_EV : WS_EU) + (size_t)e * 1024 + 16 * f_lane) = w;
    if (f_lane == 0) WSP(float, tb ? WS_EVS : WS_EUS)[e] = m * (1.0f / 224.0f);
}
__device__ __forceinline__ void cvh_load(CvH& c, Frame& F, int t, int f_lane) {
    const char* xs = (const char*)(WSP(bf16, WS_X1S) + (size_t)t * 1024) + 32 * f_lane; c.xa = *(const v4u*)xs; c.xb = *(const v4u*)(xs + 16); c.rst = WSP(float, WS_ROWSTAT)[t];
}
__device__ __forceinline__ void cvh_finish(const CvH& c, Frame& F, int t, int f_lane, const float* S2) {
    const float rs = rsqrt_f(c.rst * (1.0f / 1024.0f) + EPSF);
    float h2[16]; unpack8(c.xa, h2); unpack8(c.xb, h2 + 8); float mx = 0.f;
#pragma unroll
    for (int i = 0; i < 16; ++i) { h2[i] = h2[i] * rs + S2[i]; mx = fmaxf(mx, fabsf(h2[i])); }
#pragma unroll
    for (int o = 1; o < 64; o <<= 1) mx = fmaxf(mx, __shfl_xor(mx, o));
    mx = fmaxf(mx, 1e-30f); const float hs = 224.0f / mx;
    v4u w;
#pragma unroll
    for (int q = 0; q < 4; ++q) { int pk = 0; pk = __builtin_amdgcn_cvt_pk_fp8_f32(h2[4 * q] * hs, h2[4 * q + 1] * hs, pk, false); pk = __builtin_amdgcn_cvt_pk_fp8_f32(h2[4 * q + 2] * hs, h2[4 * q + 3] * hs, pk, true); w[q] = (unsigned)pk; }
    *(v4u*)(F.ws + WS_H2Q + (size_t)t * 1024 + 16 * f_lane) = w;
    if (f_lane == 0) WSP(float, WS_HINV)[t] = mx * (1.0f / 224.0f);
}
__device__ __forceinline__ void p5b_topk2(Frame& F) {
    const int f_tid = threadIdx.x, f_lane = f_tid & 63, f_wave = __builtin_amdgcn_readfirstlane(f_tid >> 6);
    const _Float16* scores = WSP(_Float16, WS_SCORES);
    LAS unsigned char* ix = (LAS unsigned char*)F.lds + f_tid * 36;
    const int gw = F.vcu * NWAVES + f_wave;
    static_assert(MTOK * PH == 2 * 256 * NTHR && MTOK == 16 * 256 * NWAVES, "P7 v2 work split");
    float S2[16];
    { const float* sh = WSP(float, WS_MOD) + (size_t)((gw * 16) >> 11) * 6144 + 3072 + 16 * f_lane;
#pragma unroll
      for (int q = 0; q < 4; ++q) { const f32x4 s4 = *(const f32x4*)(sh + 4 * q); S2[4 * q] = s4[0]; S2[4 * q + 1] = s4[1]; S2[4 * q + 2] = s4[2]; S2[4 * q + 3] = s4[3]; } }
    typedef _Float16 f16x8 __attribute__((ext_vector_type(8)));
    const int item_base = F.vcu * NTHR + f_tid, item_step = F.G * NTHR;
    f16x8 sva[8], svb[8];
    { const _Float16* sp0 = scores + (size_t)(item_base >> 3) * 2048 + (item_base & 7) * 256;
#pragma unroll
      for (int q = 0; q < 8; ++q) sva[q] = *(const f16x8*)(sp0 + 8 * q); }
    unsigned a1[16];
#pragma unroll
    for (int i = 0; i < 16; ++i) a1[i] = 0u;
#pragma unroll 1
    for (int hi = 0; hi < 4; ++hi) {
        const int item = item_base + (hi >> 1) * item_step; const int t = item >> 3, hd = item & 7, kh = hi & 1;
        const _Float16* sp = scores + (size_t)t * 2048 + hd * 256 + kh * 128;
        const int hn = hi < 3 ? hi + 1 : hi; const int itn = item_base + (hn >> 1) * item_step;
        const _Float16* spn = scores + (size_t)(itn >> 3) * 2048 + (itn & 7) * 256 + (hn & 1) * 128;
        unsigned a2[16];
#pragma unroll
        for (int i = 0; i < 16; ++i) a2[i] = 0u;
#define TK2_BATCH(CUR, NXT, NP, M) { \
        const int ku = 2 * (2 * hi + (M)); CvE e0, e1; CvH h0, h1; \
        { _Pragma("unroll") for (int q = 0; q < 8; ++q) NXT[q] = *(const f16x8*)((NP) + 8 * q); } \
        cve_load(e0, F, gw + ku * 2048, f_lane); cve_load(e1, F, gw + (ku + 1) * 2048, f_lane); cvh_load(h0, F, gw * 16 + ku, f_lane); cvh_load(h1, F, gw * 16 + ku + 1, f_lane); \
        __builtin_amdgcn_sched_barrier(0); \
        _Pragma("unroll") for (int q = 0; q < 8; ++q) { _Pragma("unroll") for (int e = 0; e < 8; ++e) { const unsigned k = (fkey((float)CUR[q][e]) & ~127u) | (unsigned)(127 - (64 * (M) + 8 * q + e)); TOPK_INSERT(a2, k); } } \
        __builtin_amdgcn_sched_barrier(0); \
        cve_finish(e0, F, gw + ku * 2048, f_lane); cve_finish(e1, F, gw + (ku + 1) * 2048, f_lane); cvh_finish(h0, F, gw * 16 + ku, f_lane, S2); cvh_finish(h1, F, gw * 16 + ku + 1, f_lane, S2); \
        __builtin_amdgcn_sched_barrier(0); }
        TK2_BATCH(sva, svb, sp + 64, 0)
        TK2_BATCH(svb, sva, spn, 1)
#undef TK2_BATCH
        if (kh == 0) {
#pragma unroll
            for (int i = 0; i < 16; ++i) a1[i] = a2[i];
            continue;
        }
        float v1[16], v2[16];
#pragma unroll
        for (int i = 0; i < 16; ++i) { ix[i] = (unsigned char)(127u - (a1[i] & 127u)); ix[16 + i] = (unsigned char)(127u - (a2[i] & 127u)); v1[i] = fkey_inv(a1[i] & ~127u); v2[i] = fkey_inv(a2[i] & ~127u); }
        unsigned cb[16];
#pragma unroll
        for (int i = 0; i < 16; ++i) cb[i] = 0u;
#pragma unroll
        for (int i = 0; i < 16; ++i)
#pragma unroll
            for (int j = 0; j < 16; ++j) if ((i + 1) * (j + 1) <= 16) { const unsigned k = (fkey(v1[i] + v2[j]) & ~255u) | (unsigned)(255 - (i * 16 + j)); TOPK_INSERT(cb, k); }
        float tv[16]; float mx = -3.0e38f;
#pragma unroll
        for (int k = 0; k < 16; ++k) { tv[k] = fkey_inv(cb[k] & ~255u); mx = fmaxf(mx, tv[k]); }
        float sum = 0.f;
#pragma unroll
        for (int k = 0; k < 16; ++k) { tv[k] = __expf(tv[k] - mx); sum += tv[k]; }
        const float inv = 1.0f / sum;
        LDS_WAIT(); asm volatile("" ::: "memory");
        int ev[16]; unsigned long long c64 = 0ull;
#pragma unroll
        for (int k = 0; k < 16; ++k) { const unsigned code = 255u - (cb[k] & 255u); const int i = code >> 4, j = code & 15; ev[k] = (int)ix[i] * 128 + (int)ix[16 + j]; c64 += 1ull << (8 * (ev[k] >> 11)); }
        unsigned long long s64 = c64;
#pragma unroll
        for (int o = 1; o < 8; o <<= 1) { const unsigned lo = __shfl_up((unsigned)s64, o, 8), hi2 = __shfl_up((unsigned)(s64 >> 32), o, 8); if ((f_lane & 7) >= o) s64 += ((unsigned long long)hi2 << 32) | lo; }
        const unsigned long long e64 = s64 - c64;
        const unsigned long long t64 = ((unsigned long long)__shfl((unsigned)(s64 >> 32), 7, 8) << 32) | __shfl((unsigned)s64, 7, 8);
        const unsigned long long st64 = (t64 * 0x0101010101010101ull) << 8;
        unsigned long long base64 = st64 + e64;
        int* eo = WSP(int, WS_EID) + (size_t)t * 128; float* go = WSP(float, WS_GATE) + (size_t)t * 128;
#pragma unroll
        for (int k = 0; k < 16; ++k) { const int r8 = 8 * (ev[k] >> 11); const int slot = (int)((base64 >> r8) & 255ull); base64 += 1ull << r8; eo[slot] = ev[k]; go[slot] = tv[k] * inv; }
        if (hd == 0) WSP(unsigned long long, WS_START)[t] = st64;
        LDS_WAIT(); asm volatile("" ::: "memory");
    }
}
__device__ __forceinline__ void p9_peer_down2(Frame& F) {
    const int f_tid = threadIdx.x, lane = f_tid & 63, f_wave = __builtin_amdgcn_readfirstlane(f_tid >> 6);
    const unsigned char* EV = F.ws + WS_EV;
    for (int wq = F.vcu * NWAVES + f_wave; wq < MTOK / 16; wq += F.G * NWAVES) {
        const int b = wq >> 7; const float* mb = WSP(float, WS_MOD) + (size_t)b * 6144;
        int ne_lo = WSP(int, WS_EID)[(size_t)wq * 16 * 128 + lane], ne_hi = WSP(int, WS_EID)[(size_t)wq * 16 * 128 + 64 + lane];
        float nw_lo = WSP(float, WS_GATE)[(size_t)wq * 16 * 128 + lane], nw_hi = WSP(float, WS_GATE)[(size_t)wq * 16 * 128 + 64 + lane];
        for (int tt = 0; tt < 16; ++tt) {
            const size_t t = (size_t)wq * 16 + tt;
            unsigned l16 = 16u * (unsigned)lane; asm volatile("" : "+v"(l16));
            float* xr = (float*)((char*)(F.out + t * 1024) + 4u * l16);
            const int e_lo = ne_lo, e_hi = ne_hi; const float w_lo = nw_lo, w_hi = nw_hi;
            f32x2 o[8];
#pragma unroll
            for (int i = 0; i < 8; ++i) o[i] = (f32x2){0.f, 0.f};
            v4u qa[8], qb[8];
#pragma unroll
            for (int j = 0; j < 8; ++j) { const int e = __builtin_amdgcn_readlane(e_lo, j); qa[j] = *(const v4u*)(EV + ((unsigned)e * 1024u + l16)); }
#define DN2_STEP(GRP, CUR, NXT) { \
                const int grp = (GRP); const int nb = ((grp + 1) & 7) * 8; const int ensel = (grp + 1) < 8 ? e_lo : e_hi; \
                { _Pragma("unroll") for (int j = 0; j < 8; ++j) { const int e = __builtin_amdgcn_readlane(ensel, nb + j); NXT[j] = *(const v4u*)(EV + ((unsigned)e * 1024u + l16)); } } \
                __builtin_amdgcn_sched_barrier(0); \
                const int base = (grp & 7) * 8; const float wsel = grp < 8 ? w_lo : w_hi; \
                _Pragma("unroll") for (int j = 0; j < 8; ++j) { const float wj = __builtin_bit_cast(float, __builtin_amdgcn_readlane(__builtin_bit_cast(int, wsel), base + j)); const f32x2 w2 = (f32x2){wj, wj}; \
                    _Pragma("unroll") for (int i = 0; i < 4; ++i) { const f32x2 lo = __builtin_amdgcn_cvt_pk_f32_fp8((int)CUR[j][i], false), hi = __builtin_amdgcn_cvt_pk_f32_fp8((int)CUR[j][i], true); o[2 * i] += w2 * lo; o[2 * i + 1] += w2 * hi; } } }
#pragma unroll 1
            for (int g2 = 0; g2 < 16; g2 += 2) { DN2_STEP(g2, qa, qb) DN2_STEP(g2 + 1, qb, qa) }
#undef DN2_STEP
            { const size_t tn = t + (tt < 15 ? 1 : 0); ne_lo = WSP(int, WS_EID)[tn * 128 + lane]; ne_hi = WSP(int, WS_EID)[tn * 128 + 64 + lane]; nw_lo = WSP(float, WS_GATE)[tn * 128 + lane]; nw_hi = WSP(float, WS_GATE)[tn * 128 + 64 + lane]; }
            float x1[16]; float ss = 0.f;
#pragma unroll
            for (int q4 = 0; q4 < 4; ++q4) { const f32x4 v = *(const f32x4*)(xr + 4 * q4); x1[4 * q4] = v[0]; x1[4 * q4 + 1] = v[1]; x1[4 * q4 + 2] = v[2]; x1[4 * q4 + 3] = v[3]; }
#pragma unroll
            for (int q4 = 0; q4 < 4; ++q4) { const f32x4 gt = *(const f32x4*)((const char*)(mb + 5120) + 4u * l16 + 16 * q4);
#pragma unroll
                for (int e = 0; e < 4; ++e) { const int i = 4 * q4 + e; x1[i] += gt[e] * o[i >> 1][i & 1]; ss += x1[i] * x1[i]; } }
            const float rf = rsqrt_f(wave_sum(ss) * (1.0f / 1024.0f) + EPSF);
#pragma unroll
            for (int q4 = 0; q4 < 4; ++q4) { const f32x4 nf = *(const f32x4*)((const char*)(F.a->in[29]) + 4u * l16 + 16 * q4); f32x4 v;
#pragma unroll
                for (int e = 0; e < 4; ++e) v[e] = x1[4 * q4 + e] * rf * nf[e];
                *(f32x4*)(xr + 4 * q4) = v; }
        }
    }
}
typedef long i64_t;
constexpr int U6_ROWP = 1040, U6_BUF = 8 * U6_ROWP, U6_WAVE = 2 * U6_BUF + 1024;
static_assert(8 * U6_WAVE <= LDS_MAIN, "U6 LDS map");
__device__ __forceinline__ void p8_peer_up6(Frame& F) {
    const int f_tid = threadIdx.x, lane = f_tid & 63, f_wave = __builtin_amdgcn_readfirstlane(f_tid >> 6);
    const int li = lane & 15, lq = lane >> 4;
    const unsigned char* EU = F.ws + WS_EU; const float* EUS = WSP(float, WS_EUS); const float* EVS = WSP(float, WS_EVS);
    LAS unsigned char* ring = F.lds + f_wave * U6_WAVE; LAS unsigned char* hq = ring + 2 * U6_BUF;
    for (int wq = F.vcu * NWAVES + f_wave; wq < MTOK / 16; wq += F.G * NWAVES) {
        const int b = wq >> 7; const float* mb = WSP(float, WS_MOD) + (size_t)b * 6144;
        for (int tt = 0; tt < 16; ++tt) {
            const size_t t = (size_t)wq * 16 + tt;
            unsigned l16 = 16u * (unsigned)lane; asm volatile("" : "+v"(l16));
            const int e_lo = WSP(int, WS_EID)[t * 128 + lane], e_hi = WSP(int, WS_EID)[t * 128 + 64 + lane];
            const float g_lo = WSP(float, WS_GATE)[t * 128 + lane], g_hi = WSP(float, WS_GATE)[t * 128 + 64 + lane];
            const float rs = rsqrt_f(WSP(float, WS_ROWSTAT)[t] * (1.0f / 1024.0f) + EPSF);
            const char* xs = (const char*)(WSP(bf16, WS_X1S) + t * 1024) + 2u * l16; const v4u xa = *(const v4u*)xs, xb = *(const v4u*)(xs + 16);
            asm volatile("s_waitcnt vmcnt(0)" ::: "memory");
#pragma unroll
            for (int j = 0; j < 8; ++j) { const int e = __builtin_amdgcn_readlane(e_lo, j);
                __builtin_amdgcn_global_load_lds((const unsigned*)(EU + ((unsigned)e * 1024u + l16)), (LAS unsigned*)(ring + j * U6_ROWP), 16, 0, 0); }
            const float su_lo = EUS[e_lo], su_hi = EUS[e_hi], sv_lo = EVS[e_lo], sv_hi = EVS[e_hi];
            float h2[16]; unpack8(xa, h2); unpack8(xb, h2 + 8); float mx = 0.f;
#pragma unroll
            for (int qd = 0; qd < 4; ++qd) { const f32x4 sh = *(const f32x4*)((const char*)(mb + 3072) + 4u * l16 + 16 * qd);
#pragma unroll
                for (int e = 0; e < 4; ++e) { h2[4 * qd + e] = h2[4 * qd + e] * rs + sh[e]; mx = fmaxf(mx, fabsf(h2[4 * qd + e])); } }
#pragma unroll
            for (int o = 1; o < 64; o <<= 1) mx = fmaxf(mx, __shfl_xor(mx, o));
            mx = fmaxf(mx, 1e-30f); const float hs = 224.0f / mx, hinv = mx * (1.0f / 224.0f);
            { v4u w;
#pragma unroll
              for (int qd = 0; qd < 4; ++qd) { int pk = 0; pk = __builtin_amdgcn_cvt_pk_fp8_f32(h2[4 * qd] * hs, h2[4 * qd + 1] * hs, pk, false); pk = __builtin_amdgcn_cvt_pk_fp8_f32(h2[4 * qd + 2] * hs, h2[4 * qd + 3] * hs, pk, true); w[qd] = (unsigned)pk; }
              *(LAS v4u*)(hq + l16) = w; }
            LDS_WAIT(); asm volatile("" ::: "memory");
            v4u hb[16];
#pragma unroll
            for (int c = 0; c < 16; ++c) hb[c] = *(const LAS v4u*)(hq + 64 * c + 16 * lq);
            asm volatile("s_waitcnt vmcnt(0)" ::: "memory");
            float w_lo = 0.f, w_hi = 0.f;
#pragma unroll 1
            for (int u = 0; u < 16; ++u) {
                { const int un = (u + 1) & 15; const int ensel = un < 8 ? e_lo : e_hi; const int nb = (un & 7) * 8; LAS unsigned char* dst = ring + ((u + 1) & 1) * U6_BUF;
#pragma unroll
                  for (int j = 0; j < 8; ++j) { const int e = __builtin_amdgcn_readlane(ensel, nb + j);
                      __builtin_amdgcn_global_load_lds((const unsigned*)(EU + ((unsigned)e * 1024u + l16)), (LAS unsigned*)(dst + j * U6_ROWP), 16, 0, 0); } }
                asm volatile("s_waitcnt vmcnt(8)" ::: "memory");
                const LAS unsigned char* src = ring + (u & 1) * U6_BUF + (li & 7) * U6_ROWP + 16 * lq;
                f32x4 acc = (f32x4){0.f, 0.f, 0.f, 0.f};
#ifdef HALF_READ
                v4u av[16];
#pragma unroll
                for (int c = 0; c < 16; ++c) asm volatile("" : "=v"(av[c]));
                if (li < 8) {
#pragma unroll
                    for (int c = 0; c < 16; ++c) av[c] = *(const LAS v4u*)(src + 64 * c); }
#pragma unroll
                for (int c = 0; c < 16; ++c) { const v4u a = av[c];
#else
#pragma unroll
                for (int c = 0; c < 16; ++c) { const v4u a = *(const LAS v4u*)(src + 64 * c);
#endif
                    acc = __builtin_amdgcn_mfma_f32_16x16x32_fp8_fp8((i64_t)(((unsigned long long)a[1] << 32) | a[0]), (i64_t)(((unsigned long long)hb[c][1] << 32) | hb[c][0]), acc, 0, 0, 0);
                    acc = __builtin_amdgcn_mfma_f32_16x16x32_fp8_fp8((i64_t)(((unsigned long long)a[3] << 32) | a[2]), (i64_t)(((unsigned long long)hb[c][3] << 32) | hb[c][2]), acc, 0, 0, 0); }
                const int base = (u & 7) * 8; const int r = li & 3;
                const float sel = r == 0 ? acc[0] : (r == 1 ? acc[1] : (r == 2 ? acc[2] : acc[3]));
                const float dmine = __shfl(sel, ((lane & 7) >> 2) * 16 + (lane & 3));
                const float gsel = u < 8 ? g_lo : g_hi, susel = u < 8 ? su_lo : su_hi, svsel = u < 8 ? sv_lo : sv_hi;
                const float wv = gsel * gelu_erf(dmine * susel * hinv) * svsel;
                const bool mine = (lane >= base) && (lane < base + 8);
                if (u < 8) w_lo = mine ? wv : w_lo; else w_hi = mine ? wv : w_hi;
                asm volatile("s_waitcnt lgkmcnt(0)" ::: "memory");
            }
            WSP(float, WS_GATE)[t * 128 + lane] = w_lo; WSP(float, WS_GATE)[t * 128 + 64 + lane] = w_hi;
        }
    }
}
struct U10Meta { int elo, ehi; float glo, ghi; v4u xa, xb; float rst; };
__device__ __forceinline__ void u10_meta_load(U10Meta& M, const unsigned char* ws, size_t t, unsigned l16) {
    const unsigned l = l16 >> 4; const int* ep = (const int*)(ws + WS_EID) + t * 128; const float* gp = (const float*)(ws + WS_GATE) + t * 128;
    M.elo = ep[l]; M.ehi = ep[64 + l]; M.glo = gp[l]; M.ghi = gp[64 + l];
    const char* xs = (const char*)(ws + WS_X1S) + t * 2048 + 2u * l16; M.xa = *(const v4u*)xs; M.xb = *(const v4u*)(xs + 16);
    M.rst = ((const float*)(ws + WS_ROWSTAT))[t + (l16 >> 30)];
}
__device__ __forceinline__ void u10_meta_touch(U10Meta& M) { asm volatile("" : "+v"(M.elo), "+v"(M.ehi), "+v"(M.glo), "+v"(M.ghi), "+v"(M.xa), "+v"(M.xb), "+v"(M.rst)); }
template <int UN> __device__ __forceinline__ void u10_unit_dma(int elo, int ehi, const unsigned char* EU, unsigned l16, LAS unsigned char* dst) {
    const int ensel = UN < 8 ? elo : ehi; constexpr int nb = (UN & 7) * 8;
#pragma unroll
    for (int j = 0; j < 8; ++j) { const int e = __builtin_amdgcn_readlane(ensel, nb + j);
        __builtin_amdgcn_global_load_lds((const unsigned*)(EU + ((unsigned)e * 1024u + l16)), (LAS unsigned*)(dst + j * U6_ROWP), 16, 0, 0); }
}
__device__ __forceinline__ void u10_h2(const U10Meta& M, const float* S2, LAS unsigned char* hq, unsigned l16, int lq, v4u* hb, float& hinv) {
    float h2[16]; unpack8(M.xa, h2); unpack8(M.xb, h2 + 8); float mx = 0.f;
    const float rs = rsqrt_f(M.rst * (1.0f / 1024.0f) + EPSF);
#pragma unroll
    for (int i = 0; i < 16; ++i) { h2[i] = h2[i] * rs + S2[i]; mx = fmaxf(mx, fabsf(h2[i])); }
#pragma unroll
    for (int o = 1; o < 64; o <<= 1) mx = fmaxf(mx, __shfl_xor(mx, o));
    mx = fmaxf(mx, 1e-30f); const float hs = 224.0f / mx; hinv = mx * (1.0f / 224.0f);
    v4u w;
#pragma unroll
    for (int qd = 0; qd < 4; ++qd) { int pk = 0; pk = __builtin_amdgcn_cvt_pk_fp8_f32(h2[4 * qd] * hs, h2[4 * qd + 1] * hs, pk, false); pk = __builtin_amdgcn_cvt_pk_fp8_f32(h2[4 * qd + 2] * hs, h2[4 * qd + 3] * hs, pk, true); w[qd] = (unsigned)pk; }
    *(LAS v4u*)(hq + l16) = w;
    LDS_WAIT(); asm volatile("" ::: "memory");
#pragma unroll
    for (int c = 0; c < 16; ++c) hb[c] = *(const LAS v4u*)(hq + 64 * c + 16 * lq);
    LDS_WAIT(); asm volatile("" ::: "memory");
}
template <int U> __device__ __forceinline__ void u10_unit(const U10Meta& C, U10Meta& N, const unsigned char* EU, const unsigned char* ws, unsigned l16, LAS unsigned char* ring, const v4u* hb, float hinv,
                                                          float su_lo, float su_hi, float sv_lo, float sv_hi, float& nsu_lo, float& nsu_hi, float& nsv_lo, float& nsv_hi,
                                                          float& w_lo, float& w_hi, size_t tn, bool first_token, int lane) {
    const int li = lane & 15, lq = lane >> 4;
    if (U == 15) u10_unit_dma<0>(N.elo, N.ehi, EU, l16, ring); else u10_unit_dma<(U + 1) & 15>(C.elo, C.ehi, EU, l16, ring + ((U + 1) & 1) * U6_BUF);
    __builtin_amdgcn_sched_barrier(0);
    if (U == 0) { if (first_token) asm volatile("s_waitcnt vmcnt(8)" ::: "memory"); else asm volatile("s_waitcnt vmcnt(10)" ::: "memory"); }
    else if (U == 3) asm volatile("s_waitcnt vmcnt(15)" ::: "memory");
    else if (U == 11) asm volatile("s_waitcnt vmcnt(12)" ::: "memory");
    else asm volatile("s_waitcnt vmcnt(8)" ::: "memory");
    if (U == 4) u10_meta_touch(N);
    if (U == 12) asm volatile("" : "+v"(nsu_lo), "+v"(nsu_hi), "+v"(nsv_lo), "+v"(nsv_hi));
    __builtin_amdgcn_sched_barrier(0);
    const LAS unsigned char* src = ring + (U & 1) * U6_BUF + (li & 7) * U6_ROWP + 16 * lq;
    f32x4 acc = (f32x4){0.f, 0.f, 0.f, 0.f};
#pragma unroll
    for (int c = 0; c < 16; ++c) { const v4u a = *(const LAS v4u*)(src + 64 * c);
        acc = __builtin_amdgcn_mfma_f32_16x16x32_fp8_fp8((i64_t)(((unsigned long long)a[1] << 32) | a[0]), (i64_t)(((unsigned long long)hb[c][1] << 32) | hb[c][0]), acc, 0, 0, 0);
        acc = __builtin_amdgcn_mfma_f32_16x16x32_fp8_fp8((i64_t)(((unsigned long long)a[3] << 32) | a[2]), (i64_t)(((unsigned long long)hb[c][3] << 32) | hb[c][2]), acc, 0, 0, 0); }
    constexpr int base = (U & 7) * 8; const int r = li & 3;
    const float sel = r == 0 ? acc[0] : (r == 1 ? acc[1] : (r == 2 ? acc[2] : acc[3]));
    const float dmine = __shfl(sel, ((lane & 7) >> 2) * 16 + (lane & 3));
    const float gsel = U < 8 ? C.glo : C.ghi, susel = U < 8 ? su_lo : su_hi, svsel = U < 8 ? sv_lo : sv_hi;
    const float wv = gsel * gelu_erf(dmine * susel * hinv) * svsel;
    const bool mine = (lane >= base) && (lane < base + 8);
    if (U < 8) w_lo = mine ? wv : w_lo; else w_hi = mine ? wv : w_hi;
    asm volatile("s_waitcnt lgkmcnt(0)" ::: "memory");
    __builtin_amdgcn_sched_barrier(0);
    if (U == 2) { u10_meta_load(N, ws, tn, l16); __builtin_amdgcn_sched_barrier(0); }
    if (U == 10) { const float* EUS = (const float*)(ws + WS_EUS); const float* EVS = (const float*)(ws + WS_EVS); nsu_lo = EUS[N.elo]; nsu_hi = EUS[N.ehi]; nsv_lo = EVS[N.elo]; nsv_hi = EVS[N.ehi]; __builtin_amdgcn_sched_barrier(0); }
}
__device__ __forceinline__ void p8_peer_up10(Frame& F) {
    const int f_tid = threadIdx.x, lane = f_tid & 63, f_wave = __builtin_amdgcn_readfirstlane(f_tid >> 6);
    const int lq = lane >> 4;
    const unsigned char* EU = F.ws + WS_EU; const float* EUS = WSP(float, WS_EUS); const float* EVS = WSP(float, WS_EVS);
    LAS unsigned char* ring = F.lds + f_wave * U6_WAVE; LAS unsigned char* hq = ring + 2 * U6_BUF;
    for (int wq = F.vcu * NWAVES + f_wave; wq < MTOK / 16; wq += F.G * NWAVES) {
        const int b = wq >> 7; const float* mb = WSP(float, WS_MOD) + (size_t)b * 6144;
        unsigned l16 = 16u * (unsigned)lane; asm volatile("" : "+v"(l16));
        float S2[16];
#pragma unroll
        for (int q = 0; q < 4; ++q) { const f32x4 sh = *(const f32x4*)((const char*)(mb + 3072) + 4u * l16 + 16 * q); S2[4 * q] = sh[0]; S2[4 * q + 1] = sh[1]; S2[4 * q + 2] = sh[2]; S2[4 * q + 3] = sh[3]; }
        const size_t t0 = (size_t)wq * 16;
        U10Meta C, N;
        u10_meta_load(C, F.ws, t0, l16);
        asm volatile("s_waitcnt vmcnt(0)" ::: "memory");
        u10_meta_touch(C);
        u10_unit_dma<0>(C.elo, C.ehi, EU, l16, ring);
        float su_lo = EUS[C.elo], su_hi = EUS[C.ehi], sv_lo = EVS[C.elo], sv_hi = EVS[C.ehi];
        float nsu_lo = 0.f, nsu_hi = 0.f, nsv_lo = 0.f, nsv_hi = 0.f;
        v4u hb[16]; float hinv;
        u10_h2(C, S2, hq, l16, lq, hb, hinv);
        N = C;
        asm volatile("s_waitcnt vmcnt(0)" ::: "memory");
        asm volatile("" : "+v"(su_lo), "+v"(su_hi), "+v"(sv_lo), "+v"(sv_hi));
#pragma unroll 1
        for (int tt = 0; tt < 16; ++tt) {
            float w_lo = 0.f, w_hi = 0.f;
            const size_t tn = t0 + (tt < 15 ? tt + 1 : tt);
            const bool ft = (tt == 0);
#define U10_U(U) u10_unit<U>(C, N, EU, F.ws, l16, ring, hb, hinv, su_lo, su_hi, sv_lo, sv_hi, nsu_lo, nsu_hi, nsv_lo, nsv_hi, w_lo, w_hi, tn, ft, lane);
            U10_U(0) U10_U(1) U10_U(2) U10_U(3) U10_U(4) U10_U(5) U10_U(6) U10_U(7) U10_U(8) U10_U(9) U10_U(10) U10_U(11) U10_U(12) U10_U(13) U10_U(14) U10_U(15)
#undef U10_U
            WSP(float, WS_GATE)[(t0 + tt) * 128 + lane] = w_lo; WSP(float, WS_GATE)[(t0 + tt) * 128 + 64 + lane] = w_hi;
            __builtin_amdgcn_sched_barrier(0);
            C = N; su_lo = nsu_lo; su_hi = nsu_hi; sv_lo = nsv_lo; sv_hi = nsv_hi;
            u10_h2(C, S2, hq, l16, lq, hb, hinv);
        }
        asm volatile("s_waitcnt vmcnt(0)" ::: "memory");
    }
}
#ifndef U11_AUX
#define U11_AUX 0
#endif
constexpr int U11_HQ = 2 * U6_BUF, U11_IDS = U11_HQ + 1024, U11_GATES = U11_IDS + 512, U11_SC = U11_GATES + 512, U11_HINV = U11_SC + 1024, U11_WAVE = U11_HINV + 256;
static_assert(8 * U11_WAVE <= LDS_MAIN, "U11 LDS map");
__device__ __forceinline__ void u11_dma4(const void* g, LAS unsigned char* l) { __builtin_amdgcn_global_load_lds((const unsigned*)g, (LAS unsigned*)l, 4, 0, 0); }
__device__ __forceinline__ void u11_stage1(const unsigned char* ws, size_t t, unsigned l16, LAS unsigned char* W) {
    const unsigned l4 = l16 >> 2;
    const unsigned char* ep = ws + WS_EID + t * 512; const unsigned char* gp = ws + WS_GATE + t * 512;
    u11_dma4(ep + l4, W + U11_IDS); u11_dma4(ep + 256 + l4, W + U11_IDS + 256);
    u11_dma4(gp + l4, W + U11_GATES); u11_dma4(gp + 256 + l4, W + U11_GATES + 256);
    __builtin_amdgcn_global_load_lds((const unsigned*)(ws + WS_H2Q + t * 1024 + l16), (LAS unsigned*)(W + U11_HQ), 16, 0, 0);
    u11_dma4(ws + WS_HINV + t * 4 + (l16 >> 30), W + U11_HINV);
}
__device__ __forceinline__ void u11_stage2(const unsigned char* ws, int elo, int ehi, LAS unsigned char* W) {
    u11_dma4(ws + WS_EUS + 4u * (unsigned)elo, W + U11_SC); u11_dma4(ws + WS_EUS + 4u * (unsigned)ehi, W + U11_SC + 256);
    u11_dma4(ws + WS_EVS + 4u * (unsigned)elo, W + U11_SC + 512); u11_dma4(ws + WS_EVS + 4u * (unsigned)ehi, W + U11_SC + 768);
}
template <int UN> __device__ __forceinline__ void u11_unit_dma(int elo, int ehi, const unsigned char* EU, unsigned l16, LAS unsigned char* dst) {
    const int ensel = UN < 8 ? elo : ehi; constexpr int nb = (UN & 7) * 8;
#pragma unroll
    for (int j = 0; j < 8; ++j) { const int e = __builtin_amdgcn_readlane(ensel, nb + j);
        __builtin_amdgcn_global_load_lds((const unsigned*)(EU + ((unsigned)e * 1024u + l16)), (LAS unsigned*)(dst + j * U6_ROWP), 16, 0, U11_AUX); }
}
struct U11Tok { int elo, ehi; float glo, ghi, su_lo, su_hi, sv_lo, sv_hi, hinv; };
__device__ __forceinline__ void u11_switch(U11Tok& C, int nelo, int nehi, LAS unsigned char* W, unsigned l16, int lq, v4u* hb) {
    const unsigned l4 = l16 >> 2;
    C.elo = nelo; C.ehi = nehi;
    C.glo = *(const LAS float*)(W + U11_GATES + l4); C.ghi = *(const LAS float*)(W + U11_GATES + 256 + l4);
    C.su_lo = *(const LAS float*)(W + U11_SC + l4); C.su_hi = *(const LAS float*)(W + U11_SC + 256 + l4); C.sv_lo = *(const LAS float*)(W + U11_SC + 512 + l4); C.sv_hi = *(const LAS float*)(W + U11_SC + 768 + l4);
    C.hinv = *(const LAS float*)(W + U11_HINV + l4);
#pragma unroll
    for (int c = 0; c < 16; ++c) hb[c] = *(const LAS v4u*)(W + U11_HQ + 64 * c + 16 * lq);
    LDS_WAIT(); asm volatile("" ::: "memory");
}
template <int U> __device__ __forceinline__ void u11_unit(const U11Tok& C, int& nelo, int& nehi, const unsigned char* EU, const unsigned char* ws, unsigned l16, LAS unsigned char* W, const v4u* hb,
                                                          float& w_lo, float& w_hi, size_t tn, bool first_token, int lane) {
    const int li = lane & 15, lq = lane >> 4;
    if (U == 15) u11_unit_dma<0>(nelo, nehi, EU, l16, W); else u11_unit_dma<(U + 1) & 15>(C.elo, C.ehi, EU, l16, W + ((U + 1) & 1) * U6_BUF);
    __builtin_amdgcn_sched_barrier(0);
    if (U == 0) { if (first_token) asm volatile("s_waitcnt vmcnt(8)" ::: "memory"); else asm volatile("s_waitcnt vmcnt(10)" ::: "memory"); }
    else if (U == 3) asm volatile("s_waitcnt vmcnt(14)" ::: "memory");
    else if (U == 5) asm volatile("s_waitcnt vmcnt(12)" ::: "memory");
    else asm volatile("s_waitcnt vmcnt(8)" ::: "memory");
    __builtin_amdgcn_sched_barrier(0);
    const LAS unsigned char* src = W + (U & 1) * U6_BUF + (li & 7) * U6_ROWP + 16 * lq;
    f32x4 acc = (f32x4){0.f, 0.f, 0.f, 0.f};
#pragma unroll
    for (int c = 0; c < 16; ++c) { const v4u a = *(const LAS v4u*)(src + 64 * c);
        acc = __builtin_amdgcn_mfma_f32_16x16x32_fp8_fp8((i64_t)(((unsigned long long)a[1] << 32) | a[0]), (i64_t)(((unsigned long long)hb[c][1] << 32) | hb[c][0]), acc, 0, 0, 0);
        acc = __builtin_amdgcn_mfma_f32_16x16x32_fp8_fp8((i64_t)(((unsigned long long)a[3] << 32) | a[2]), (i64_t)(((unsigned long long)hb[c][3] << 32) | hb[c][2]), acc, 0, 0, 0); }
    constexpr int base = (U & 7) * 8; const int r = li & 3;
    const float sel = r == 0 ? acc[0] : (r == 1 ? acc[1] : (r == 2 ? acc[2] : acc[3]));
    const float dmine = __shfl(sel, ((lane & 7) >> 2) * 16 + (lane & 3));
    const float gsel = U < 8 ? C.glo : C.ghi, susel = U < 8 ? C.su_lo : C.su_hi, svsel = U < 8 ? C.sv_lo : C.sv_hi;
    const float wv = gsel * gelu_erf(dmine * susel * C.hinv) * svsel;
    const bool mine = (lane >= base) && (lane < base + 8);
    if (U < 8) w_lo = mine ? wv : w_lo; else w_hi = mine ? wv : w_hi;
    if (U == 4) { nelo = *(const LAS int*)(W + U11_IDS + (l16 >> 2)); nehi = *(const LAS int*)(W + U11_IDS + 256 + (l16 >> 2)); }
    asm volatile("s_waitcnt lgkmcnt(0)" ::: "memory");
    __builtin_amdgcn_sched_barrier(0);
    if (U == 2) { u11_stage1(ws, tn, l16, W); __builtin_amdgcn_sched_barrier(0); }
    if (U == 4) { u11_stage2(ws, nelo, nehi, W); __builtin_amdgcn_sched_barrier(0); }
}
__device__ __forceinline__ void p8_peer_up11(Frame& F) {
    const int f_tid = threadIdx.x, lane = f_tid & 63, f_wave = __builtin_amdgcn_readfirstlane(f_tid >> 6);
    const int lq = lane >> 4;
    const unsigned char* EU = F.ws + WS_EU;
    LAS unsigned char* W = F.lds + f_wave * U11_WAVE;
    for (int wq = F.vcu * NWAVES + f_wave; wq < MTOK / 16; wq += F.G * NWAVES) {
        unsigned l16 = 16u * (unsigned)lane; asm volatile("" : "+v"(l16));
        const size_t t0 = (size_t)wq * 16;
        u11_stage1(F.ws, t0, l16, W);
        asm volatile("s_waitcnt vmcnt(0)" ::: "memory");
        int nelo = *(const LAS int*)(W + U11_IDS + (l16 >> 2)), nehi = *(const LAS int*)(W + U11_IDS + 256 + (l16 >> 2));
        LDS_WAIT(); asm volatile("" ::: "memory");
        u11_stage2(F.ws, nelo, nehi, W);
        u11_unit_dma<0>(nelo, nehi, EU, l16, W);
        asm volatile("s_waitcnt vmcnt(0)" ::: "memory");
        U11Tok C; v4u hb[16];
        u11_switch(C, nelo, nehi, W, l16, lq, hb);
#pragma unroll 1
        for (int tt = 0; tt < 16; ++tt) {
            float w_lo = 0.f, w_hi = 0.f;
            const size_t tn = t0 + (tt < 15 ? tt + 1 : tt);
            const bool ft = (tt == 0);
#define U11_U(U) u11_unit<U>(C, nelo, nehi, EU, F.ws, l16, W, hb, w_lo, w_hi, tn, ft, lane);
            U11_U(0) U11_U(1) U11_U(2) U11_U(3) U11_U(4) U11_U(5) U11_U(6) U11_U(7) U11_U(8) U11_U(9) U11_U(10) U11_U(11) U11_U(12) U11_U(13) U11_U(14) U11_U(15)
#undef U11_U
            WSP(float, WS_GATE)[(t0 + tt) * 128 + lane] = w_lo; WSP(float, WS_GATE)[(t0 + tt) * 128 + 64 + lane] = w_hi;
            __builtin_amdgcn_sched_barrier(0);
            u11_switch(C, nelo, nehi, W, l16, lq, hb);
        }
        asm volatile("s_waitcnt vmcnt(0)" ::: "memory");
    }
}
typedef unsigned v3u __attribute__((ext_vector_type(3)));
typedef unsigned v6u __attribute__((ext_vector_type(6)));
typedef float f32x32 __attribute__((ext_vector_type(32)));
struct __attribute__((packed, aligned(4))) U3 { unsigned a, b, c; };
__device__ __forceinline__ v3u ld_row6(const unsigned char* p) { const U3 u = *(const U3*)p; return (v3u){u.a, u.b, u.c}; }
__device__ __forceinline__ void p9_peer_down3(Frame& F) {
    const int f_tid = threadIdx.x, lane = f_tid & 63, f_wave = __builtin_amdgcn_readfirstlane(f_tid >> 6);
    const unsigned char* EV = F.ws + WS_EV;
    for (int wq = F.vcu * NWAVES + f_wave; wq < MTOK / 16; wq += F.G * NWAVES) {
        const int b = wq >> 7; const float* mb = WSP(float, WS_MOD) + (size_t)b * 6144;
        int ne_lo = WSP(int, WS_EID)[(size_t)wq * 16 * 128 + lane], ne_hi = WSP(int, WS_EID)[(size_t)wq * 16 * 128 + 64 + lane];
        float nw_lo = WSP(float, WS_GATE)[(size_t)wq * 16 * 128 + lane], nw_hi = WSP(float, WS_GATE)[(size_t)wq * 16 * 128 + 64 + lane];
        for (int tt = 0; tt < 16; ++tt) {
            const size_t t = (size_t)wq * 16 + tt;
            unsigned l16 = 16u * (unsigned)lane; asm volatile("" : "+v"(l16));
            const unsigned l12 = (l16 >> 2) * 3u;
            float* xr = (float*)((char*)(F.out + t * 1024) + 4u * l16);
            const int e_lo = ne_lo, e_hi = ne_hi; const float w_lo = nw_lo, w_hi = nw_hi;
            f32x2 o[8];
#pragma unroll
            for (int i = 0; i < 8; ++i) o[i] = (f32x2){0.f, 0.f};
#ifdef DN3_G16
            v3u qa[16], qb[16];
#pragma unroll
            for (int j = 0; j < 16; ++j) { const int e = __builtin_amdgcn_readlane(e_lo, j); qa[j] = ld_row6(EV + ((unsigned)e * 768u + l12)); }
#define DN3_STEP(GRP, CUR, NXT) { \
                const int grp = (GRP); const int nb = ((grp + 1) & 3) * 16; const int ensel = ((grp + 1) & 7) < 4 ? e_lo : e_hi; \
                { _Pragma("unroll") for (int j = 0; j < 16; ++j) { const int e = __builtin_amdgcn_readlane(ensel, nb + j); NXT[j] = ld_row6(EV + ((unsigned)e * 768u + l12)); } } \
                __builtin_amdgcn_sched_barrier(0); \
                const int base = (grp & 3) * 16; const float wsel = grp < 4 ? w_lo : w_hi; \
                _Pragma("unroll") for (int j = 0; j < 16; j += 2) { \
                    const float wa = __builtin_bit_cast(float, __builtin_amdgcn_readlane(__builtin_bit_cast(int, wsel), base + j)), wb = __builtin_bit_cast(float, __builtin_amdgcn_readlane(__builtin_bit_cast(int, wsel), base + j + 1)); \
                    const f32x2 wa2 = (f32x2){wa, wa}, wb2 = (f32x2){wb, wb}; \
                    const v6u pr = (v6u){CUR[j][0], CUR[j][1], CUR[j][2], CUR[j + 1][0], CUR[j + 1][1], CUR[j + 1][2]}; \
                    const f32x32 r = __builtin_amdgcn_cvt_scalef32_pk32_f32_fp6(pr, 1.0f); \
                    _Pragma("unroll") for (int i = 0; i < 8; ++i) { o[i] += wa2 * (f32x2){r[2 * i], r[2 * i + 1]}; o[i] += wb2 * (f32x2){r[16 + 2 * i], r[17 + 2 * i]}; } } }
#pragma unroll 1
            for (int g2 = 0; g2 < 8; g2 += 2) { DN3_STEP(g2, qa, qb) DN3_STEP(g2 + 1, qb, qa) }
#else
            v3u qa[8], qb[8];
#pragma unroll
            for (int j = 0; j < 8; ++j) { const int e = __builtin_amdgcn_readlane(e_lo, j); qa[j] = ld_row6(EV + ((unsigned)e * 768u + l12)); }
#define DN3_STEP(GRP, CUR, NXT) { \
                const int grp = (GRP); const int nb = ((grp + 1) & 7) * 8; const int ensel = (grp + 1) < 8 ? e_lo : e_hi; \
                { _Pragma("unroll") for (int j = 0; j < 8; ++j) { const int e = __builtin_amdgcn_readlane(ensel, nb + j); NXT[j] = ld_row6(EV + ((unsigned)e * 768u + l12)); } } \
                __builtin_amdgcn_sched_barrier(0); \
                const int base = (grp & 7) * 8; const float wsel = grp < 8 ? w_lo : w_hi; \
                _Pragma("unroll") for (int j = 0; j < 8; j += 2) { \
                    const float wa = __builtin_bit_cast(float, __builtin_amdgcn_readlane(__builtin_bit_cast(int, wsel), base + j)), wb = __builtin_bit_cast(float, __builtin_amdgcn_readlane(__builtin_bit_cast(int, wsel), base + j + 1)); \
                    const f32x2 wa2 = (f32x2){wa, wa}, wb2 = (f32x2){wb, wb}; \
                    const v6u pr = (v6u){CUR[j][0], CUR[j][1], CUR[j][2], CUR[j + 1][0], CUR[j + 1][1], CUR[j + 1][2]}; \
                    const f32x32 r = __builtin_amdgcn_cvt_scalef32_pk32_f32_fp6(pr, 1.0f); \
                    _Pragma("unroll") for (int i = 0; i < 8; ++i) { o[i] += wa2 * (f32x2){r[2 * i], r[2 * i + 1]}; o[i] += wb2 * (f32x2){r[16 + 2 * i], r[17 + 2 * i]}; } } }
#pragma unroll 1
            for (int g2 = 0; g2 < 16; g2 += 2) { DN3_STEP(g2, qa, qb) DN3_STEP(g2 + 1, qb, qa) }
#endif
#undef DN3_STEP
            { const size_t tn = t + (tt < 15 ? 1 : 0); ne_lo = WSP(int, WS_EID)[tn * 128 + lane]; ne_hi = WSP(int, WS_EID)[tn * 128 + 64 + lane]; nw_lo = WSP(float, WS_GATE)[tn * 128 + lane]; nw_hi = WSP(float, WS_GATE)[tn * 128 + 64 + lane]; }
            float x1[16]; float ss = 0.f;
#pragma unroll
            for (int q4 = 0; q4 < 4; ++q4) { const f32x4 v = *(const f32x4*)(xr + 4 * q4); x1[4 * q4] = v[0]; x1[4 * q4 + 1] = v[1]; x1[4 * q4 + 2] = v[2]; x1[4 * q4 + 3] = v[3]; }
#pragma unroll
            for (int q4 = 0; q4 < 4; ++q4) { const f32x4 gt = *(const f32x4*)((const char*)(mb + 5120) + 4u * l16 + 16 * q4);
#pragma unroll
                for (int e = 0; e < 4; ++e) { const int i = 4 * q4 + e; x1[i] += gt[e] * o[i >> 1][i & 1]; ss += x1[i] * x1[i]; } }
            const float rf = rsqrt_f(wave_sum(ss) * (1.0f / 1024.0f) + EPSF);
#pragma unroll
            for (int q4 = 0; q4 < 4; ++q4) { const f32x4 nf = *(const f32x4*)((const char*)(F.a->in[29]) + 4u * l16 + 16 * q4); f32x4 v;
#pragma unroll
                for (int e = 0; e < 4; ++e) v[e] = x1[4 * q4 + e] * rf * nf[e];
                *(f32x4*)(xr + 4 * q4) = v; }
        }
    }
}
constexpr int U12_ROWP = 784, U12_NBUF = 3, U12_BUF = 8 * U12_ROWP, U12_WAVE = U12_NBUF * U12_BUF + 1024;
static_assert(8 * U12_WAVE <= LDS_MAIN, "U12 LDS map");
typedef int i32x8 __attribute__((ext_vector_type(8)));
typedef unsigned v2u __attribute__((ext_vector_type(2)));
__device__ __forceinline__ void p8_peer_up12(Frame& F) {
    const int f_tid = threadIdx.x, lane = f_tid & 63, f_wave = __builtin_amdgcn_readfirstlane(f_tid >> 6);
    const int li = lane & 15, lq = lane >> 4;
    const unsigned char* EU = F.ws + WS_EU; const float* EUS = WSP(float, WS_EUS); const float* EVS = WSP(float, WS_EVS);
    LAS unsigned char* ring = F.lds + f_wave * U12_WAVE; LAS unsigned char* hq = ring + U12_NBUF * U12_BUF;
#ifdef PROBE_MFMA
    if (blockIdx.x == 0 && f_wave == 0) {
        i32x8 A = (i32x8){0, 0, 0, 0, 0, 0, 0, 0}; if (lane == PROBE_ALANE) A[PROBE_AREG] = PROBE_AVAL;
        i32x8 B;
        if (PROBE_BPAT == 0) B = (i32x8){0x48444038, 0x504E4C4A, 0x54535251, 0x58575655, 0x48444038, 0x504E4C4A, 0x54535251, 0x58575655};
        else { const unsigned c0 = (const unsigned[]){0x38u, 0x40u, 0x44u, 0x48u, 0x4Au, 0x4Cu, 0x4Eu, 0x50u}[0]; (void)c0;
               const int k = lane >> 4; const unsigned lo = k == 0 ? 0x38u : (k == 1 ? 0x44u : (k == 2 ? 0x4Au : 0x4Eu)), hi = k == 0 ? 0x40u : (k == 1 ? 0x48u : (k == 2 ? 0x4Cu : 0x50u));
               const int wl = (int)(lo * 0x01010101u), wh = (int)(hi * 0x01010101u); B = (i32x8){wl, wl, wl, wl, wh, wh, wh, wh}; }
        f32x4 acc = (f32x4){0.f, 0.f, 0.f, 0.f};
        acc = __builtin_amdgcn_mfma_scale_f32_16x16x128_f8f6f4(A, B, acc, 2, 0, 0, 0, 0, 0);
        if (lane == 0) *(volatile float*)(F.ws + WS_CTL + 40000) = acc[0] * 100.0f;
    }
#endif
    for (int wq = F.vcu * NWAVES + f_wave; wq < MTOK / 16; wq += F.G * NWAVES) {
        const int b = wq >> 7; const float* mb = WSP(float, WS_MOD) + (size_t)b * 6144;
        for (int tt = 0; tt < 16; ++tt) {
            const size_t t = (size_t)wq * 16 + tt;
            unsigned l16 = 16u * (unsigned)lane; asm volatile("" : "+v"(l16));
            const int e_lo = WSP(int, WS_EID)[t * 128 + lane], e_hi = WSP(int, WS_EID)[t * 128 + 64 + lane];
            const float g_lo = WSP(float, WS_GATE)[t * 128 + lane], g_hi = WSP(float, WS_GATE)[t * 128 + 64 + lane];
            const float rs = rsqrt_f(WSP(float, WS_ROWSTAT)[t] * (1.0f / 1024.0f) + EPSF);
            const char* xs = (const char*)(WSP(bf16, WS_X1S) + t * 1024) + 2u * l16; const v4u xa = *(const v4u*)xs, xb = *(const v4u*)(xs + 16);
            asm volatile("s_waitcnt vmcnt(0)" ::: "memory");
            if (lane < 48) {
#pragma unroll
            for (int j = 0; j < 16; ++j) { const int e = __builtin_amdgcn_readlane(e_lo, j);
                __builtin_amdgcn_global_load_lds((const unsigned*)(EU + ((unsigned)e * 768u + l16)), (LAS unsigned*)(ring + j * U12_ROWP), 16, 0, 0); } }
            const float su_lo = EUS[e_lo], su_hi = EUS[e_hi], sv_lo = EVS[e_lo], sv_hi = EVS[e_hi];
            float h2[16]; unpack8(xa, h2); unpack8(xb, h2 + 8); float mx = 0.f;
#pragma unroll
            for (int qd = 0; qd < 4; ++qd) { const f32x4 sh = *(const f32x4*)((const char*)(mb + 3072) + 4u * l16 + 16 * qd);
#pragma unroll
                for (int e = 0; e < 4; ++e) { h2[4 * qd + e] = h2[4 * qd + e] * rs + sh[e]; mx = fmaxf(mx, fabsf(h2[4 * qd + e])); } }
#pragma unroll
            for (int o = 1; o < 64; o <<= 1) mx = fmaxf(mx, __shfl_xor(mx, o));
            mx = fmaxf(mx, 1e-30f); const float hs = 224.0f / mx, hinv = mx * (1.0f / 224.0f);
            { v4u w;
#pragma unroll
              for (int qd = 0; qd < 4; ++qd) { int pk = 0; pk = __builtin_amdgcn_cvt_pk_fp8_f32(h2[4 * qd] * hs, h2[4 * qd + 1] * hs, pk, false); pk = __builtin_amdgcn_cvt_pk_fp8_f32(h2[4 * qd + 2] * hs, h2[4 * qd + 3] * hs, pk, true); w[qd] = (unsigned)pk; }
              *(LAS v4u*)(hq + l16) = w; }
            LDS_WAIT(); asm volatile("" ::: "memory");
            v4u hb[8];
#pragma unroll
            for (int c = 0; c < 4; ++c) { hb[2 * c] = *(const LAS v4u*)(hq + (li & 1) * 512 + 128 * c + 16 * lq); hb[2 * c + 1] = *(const LAS v4u*)(hq + (li & 1) * 512 + 128 * c + 64 + 16 * lq); }
            asm volatile("s_waitcnt vmcnt(0)" ::: "memory");
            float w_lo = 0.f, w_hi = 0.f;
            int cur = 0, nx2 = 2 * U12_BUF;
#pragma unroll 1
            for (int u = 0; u < 16; ++u) {
                if (u < 14) { const int un = u + 2; int ensel = un < 8 ? e_lo : e_hi; asm volatile("" : "+v"(ensel));     const int nb = (un & 7) * 8; LAS unsigned char* dst = ring + nx2;
                  if (lane < 48) {
#pragma unroll
                  for (int j = 0; j < 8; ++j) { const int e = __builtin_amdgcn_readlane(ensel, nb + j);
                      __builtin_amdgcn_global_load_lds((const unsigned*)(EU + ((unsigned)e * 768u + l16)), (LAS unsigned*)(dst + j * U12_ROWP), 16, 0, 0); } }
                  asm volatile("s_waitcnt vmcnt(16)" ::: "memory"); }
                else if (u == 14) asm volatile("s_waitcnt vmcnt(8)" ::: "memory");
                else asm volatile("s_waitcnt vmcnt(0)" ::: "memory");
                const LAS unsigned char* src = ring + cur + (li & 7) * U12_ROWP + (li >> 3) * 384 + 24 * lq;
                f32x4 acc = (f32x4){0.f, 0.f, 0.f, 0.f};
#pragma unroll
                for (int c = 0; c < 4; ++c) { const v2u a0 = *(const LAS v2u*)(src + 96 * c), a1 = *(const LAS v2u*)(src + 96 * c + 8), a2 = *(const LAS v2u*)(src + 96 * c + 16);
                    const i32x8 A = (i32x8){(int)a0[0], (int)a0[1], (int)a1[0], (int)a1[1], (int)a2[0], (int)a2[1], 0, 0};
                    const i32x8 B = (i32x8){(int)hb[2 * c][0], (int)hb[2 * c][1], (int)hb[2 * c][2], (int)hb[2 * c][3], (int)hb[2 * c + 1][0], (int)hb[2 * c + 1][1], (int)hb[2 * c + 1][2], (int)hb[2 * c + 1][3]};
                    acc = __builtin_amdgcn_mfma_scale_f32_16x16x128_f8f6f4(A, B, acc, 2, 0, 0, 0, 0, 0); }
                const int base = (u & 7) * 8; const int r = (li >> 1) & 3;
                const float sel = r == 0 ? acc[0] : (r == 1 ? acc[1] : (r == 2 ? acc[2] : acc[3]));
                const int sl = ((lane & 7) >> 2) * 16 + 2 * (lane & 3);
                const float dmine = __shfl(sel, sl) + __shfl(sel, sl + 33);
                const float gsel = u < 8 ? g_lo : g_hi, susel = u < 8 ? su_lo : su_hi, svsel = u < 8 ? sv_lo : sv_hi;
                const float wv = gsel * gelu_erf(dmine * susel * hinv) * svsel;
                const bool mine = (lane >= base) && (lane < base + 8);
                if (u < 8) w_lo = mine ? wv : w_lo; else w_hi = mine ? wv : w_hi;
                asm volatile("s_waitcnt lgkmcnt(0)" ::: "memory");
                cur = cur == 2 * U12_BUF ? 0 : cur + U12_BUF; nx2 = nx2 == 2 * U12_BUF ? 0 : nx2 + U12_BUF;
            }
            WSP(float, WS_GATE)[t * 128 + lane] = w_lo; WSP(float, WS_GATE)[t * 128 + 64 + lane] = w_hi;
        }
    }
}
#ifdef TOPK2
#define P7FN p5b_topk2
#else
#define P7FN p5b_topk
#endif
constexpr int NPHASE = 10;
__global__ void __launch_bounds__(NTHR, 2) fwd_mega(Args args) {
    extern __shared__ __attribute__((aligned(16))) unsigned char lds[];
    Frame F;
    F.lds = (LAS unsigned char*)lds;
    F.MISC = (volatile LAS unsigned*)(F.lds + MISC_OFF);
    F.G = gridDim.x; { const int bx = blockIdx.x; F.vcu = (F.G % 8 == 0) ? (bx % 8) * (F.G / 8) + bx / 8 : bx; }
    F.ws = args.ws; F.out = args.out;
    F.a = &args;
    for (int u = threadIdx.x; u < 32; u += NTHR) F.MISC[u] = 0u;
    __syncthreads();
    const int lo = args.ph_lo, hi = args.ph_hi;
    const bool use_bar = (hi - lo) > 1;
    XcdBarrier bar; bar.bar = (unsigned*)(F.ws + WS_CTL); bar.x = 0; bar.st = nullptr;
    if (use_bar) bar = xcd_barrier_post((unsigned*)(F.ws + WS_CTL), F.MISC + 8);
#define IN(k) (lo <= (k) && (k) < hi)
#define SEAM(k) do { if (IN(k) && IN((k) + 1)) xcd_barrier(bar); } while (0)
#ifndef REP_PHASE
#define REP_PHASE -1
#endif
#define REPEAT(k, body) do { if (REP_PHASE == (k)) { xcd_barrier(bar); body; } } while (0)
    if (IN(0)) {
#ifndef SKIP_P0
 p0_phase(F); REPEAT(0, p0_phase(F));
#endif
 } SEAM(0);
    if (IN(1)) {
#ifndef SKIP_P1
 p1_phase(F); REPEAT(1, p1_phase(F));
#endif
 } SEAM(1);
    if (IN(2)) {
        pg8::Gemm g{WSP(bf16, WS_H1), WSP(bf16, WS_WINT), MTOK, NPROJ, 1024}; pg8::StaticOrder S; S.init(MTOK, NPROJ, F.G, (int)blockIdx.x);
        pg8::EpiProj E{WSP(bf16, WS_PROJ), NPROJ};
        pg8::gemm_phase<pg8::EpiProj, pg8::StaticOrder, true, true>(F.lds, g, S, E);
        REPEAT(2, (pg8::gemm_phase<pg8::EpiProj, pg8::StaticOrder, true, true>(F.lds, g, S, E)));
    } SEAM(2);
    if (IN(3)) {
#ifndef SKIP_SSD
 p3pre_conv(F); xcd_barrier(bar); p3_ssd3(F); REPEAT(30, p3_ssd3(F)); REPEAT(32, p3pre_conv(F));
#endif
#ifndef SKIP_S5
 p3_s5v2(F); REPEAT(31, p3_s5v2(F));
#endif
 } SEAM(3);
    if (IN(5)) {
        pg8::Gemm g{WSP(bf16, WS_Y), WSP(bf16, WS_WOUTT), MTOK, 1024, 2048}; pg8::StaticOrder S; S.init(MTOK, 1024, F.G, (int)blockIdx.x);
        PG8_LAS float* tab = (PG8_LAS float*)(F.lds + pg8::STAGE_BYTES);
        { pg8::Unit u; for (int i = 0; S.next(i, u); ++i) pg8::SegScaleHook::build(F.lds + pg8::STAGE_BYTES, u, WSP(float, WS_STSSD), WSP(float, WS_STS5), (int)threadIdx.x); }
        __syncthreads();
        pg8::EpiX1 E{(F.a->in[0]), F.out, WSP(bf16, WS_X1S), WSP(float, WS_MOD), (F.a->in[24]), WSP(float, WS_ROWSTAT), tab};
        pg8::SegScaleHook H;
        pg8::gemm_phase<pg8::EpiX1, pg8::StaticOrder, true, true, pg8::SegScaleHook>(F.lds, g, S, E, H);
    } SEAM(5);
    if (IN(6)) {
        pg8::Gemm g{WSP(bf16, WS_X1S), WSP(bf16, WS_WQKT), MTOK, 2048, 1024}; pg8::StaticOrder S; S.init(MTOK, 2048, F.G, (int)blockIdx.x);
        pg8::EpiScores E{WSP(_Float16, WS_SCORES), WSP(float, WS_SB), WSP(float, WS_ROWSTAT)};
        pg8::gemm_phase<pg8::EpiScores, pg8::StaticOrder, true, true>(F.lds, g, S, E);
        REPEAT(6, (pg8::gemm_phase<pg8::EpiScores, pg8::StaticOrder, true, true>(F.lds, g, S, E)));
    } SEAM(6);
    if (IN(7)) {
#ifndef SKIP_TOPK
 P7FN(F); REPEAT(7, P7FN(F));
#endif
 } SEAM(7);
#ifdef UP12
    if (IN(8)) { p8_peer_up12(F); REPEAT(8, { P7FN(F); xcd_barrier(bar); p8_peer_up12(F); }); } SEAM(8);
#elif defined(UP11)
    if (IN(8)) { p8_peer_up11(F); REPEAT(8, { P7FN(F); xcd_barrier(bar); p8_peer_up11(F); }); } SEAM(8);
#elif defined(UP10)
    if (IN(8)) { p8_peer_up10(F); } SEAM(8);
#else
    if (IN(8)) { p8_peer_up6(F); REPEAT(8, { P7FN(F); xcd_barrier(bar); p8_peer_up6(F); }); } SEAM(8);
#endif
#ifdef V6
    if (IN(9)) { p9_peer_down3(F); }
#else
    if (IN(9)) { p9_peer_down2(F); }
#endif
#ifdef PROBE_OUT
    if (IN(9)) { __syncthreads(); if (blockIdx.x == 0 && threadIdx.x == 0) { asm volatile("s_waitcnt vmcnt(0)" ::: "memory"); F.out[0] = *(volatile float*)(F.ws + WS_CTL + 40000); } }
#endif
#undef IN
#undef SEAM
}

#ifndef N_LAUNCHES
#define N_LAUNCHES 1
#endif
extern "C" void kernel_launch(void* const* d_in, const int* in_sizes, int n_in, void* d_out, int out_size, void* d_ws, size_t ws_size, hipStream_t stream) {
    static int grid = 0;
    if (grid == 0) {
        if (n_in != 30 || in_sizes[0] != MTOK * DM || out_size != MTOK * DM || ws_size < WS_END) { fprintf(stderr, "kernel_launch: unexpected shapes (n_in %d, in0 %d, out %d, ws %zu)\n", n_in, n_in > 0 ? in_sizes[0] : -1, out_size, ws_size); grid = -1; return; }
        int dev = 0, cus = 0, per_cu = 0;
        if (hipGetDevice(&dev) != hipSuccess || hipDeviceGetAttribute(&cus, hipDeviceAttributeMultiprocessorCount, dev) != hipSuccess) { grid = -1; return; }
        if (hipFuncSetAttribute((const void*)fwd_mega, hipFuncAttributeMaxDynamicSharedMemorySize, LDS_BYTES) != hipSuccess) { fprintf(stderr, "kernel_launch: hipFuncSetAttribute failed\n"); grid = -1; return; }
        if (hipOccupancyMaxActiveBlocksPerMultiprocessor(&per_cu, (const void*)fwd_mega, NTHR, LDS_BYTES) != hipSuccess || per_cu < 1) { fprintf(stderr, "kernel_launch: occupancy query says %d\n", per_cu); (void)hipGetLastError(); grid = -1; return; }
        if (cus != 256) { fprintf(stderr, "kernel_launch: built for a 256-CU device (got %d CUs); nothing launched\n", cus); grid = -1; return; }
        grid = cus;
    }
    if (grid < 0) return;
    (void)hipMemsetAsync((char*)d_ws + WS_CTL, 0, CTL_ZERO_BYTES, stream);
    Args a{};
    for (int i = 0; i < 30; ++i) a.in[i] = (const float*)d_in[i];
    a.out = (float*)d_out; a.ws = (unsigned char*)d_ws;
    if (N_LAUNCHES == 1) {
        a.ph_lo = 0; a.ph_hi = NPHASE;
        void* kargs[] = {&a};
#ifdef PLAIN_LAUNCH
        (void)kargs; hipLaunchKernelGGL(fwd_mega, dim3(grid), dim3(NTHR), LDS_BYTES, stream, a);
#else
        hipError_t e = hipLaunchCooperativeKernel((const void*)fwd_mega, dim3(grid), dim3(NTHR), kargs, LDS_BYTES, stream);
        if (e != hipSuccess) fprintf(stderr, "kernel_launch: cooperative launch failed: %s (grid %d)\n", hipGetErrorString(e), grid);
#endif
    } else {
        for (int p = 0; p < NPHASE; ++p) { a.ph_lo = p; a.ph_hi = p + 1; hipLaunchKernelGGL(fwd_mega, dim3(grid), dim3(NTHR), LDS_BYTES, stream, a); }
    }
}
```

```cpp
#define V6
#define UP14
#include <hip/hip_runtime.h>
#include <cstdio>
#include <cstdint>
namespace pg8 {
#define PG8_LAS __attribute__((address_space(3)))
typedef unsigned short bf16_t;
typedef short bf16x8 __attribute__((ext_vector_type(8)));
typedef float f32x4 __attribute__((ext_vector_type(4)));
typedef unsigned u32x4 __attribute__((ext_vector_type(4)));
constexpr int BM = 256, BK = 64, HALF = 128, HTB = HALF * BK * 2  , STAGE_BYTES = 8 * HTB, NXCD = 8, WGM = 8;

__host__ __device__ __forceinline__ int lds_byte(int r, int c) { const int st = (r >> 4) * 2 + (c >> 5), rr = r & 15, cc = c & 31, ob = rr * 64 + cc * 2; return st * 1024 + (ob ^ (((ob >> 9) & 1) << 5)); }
__host__ __device__ __forceinline__ void stage_rc(int b, int& R, int& C) { const int st = b / 1024, sb = b % 1024, swz = sb ^ (((sb >> 9) & 1) << 5); R = (st >> 1) * 16 + swz / 64; C = (st & 1) * 32 + (swz % 64) / 2; }
__host__ __device__ __forceinline__ int perm32(int rho) { const int n = rho >> 4, i = rho & 15; return 8 * (i >> 2) + 4 * n + (i & 3); }

struct Unit { int pm, pn; };
struct Gemm { const bf16_t* A; const bf16_t* Bt; int M, N, K; };

struct StaticOrder {
    int nM, nN, nwg, G, c;
    __host__ __device__ void init(int M, int N, int G_, int c_) { nM = M / BM; nN = N / BM; nwg = nM * nN; G = G_; c = c_; }
    __host__ __device__ bool next(int i, Unit& u) const {
        const long L = (long)i * G + c; if (L >= nwg) return false;
        int wgid = (int)L; { const int q = nwg / NXCD, r = nwg % NXCD, xcd = wgid % NXCD, off = wgid / NXCD; wgid = (xcd < r ? xcd * (q + 1) : r * (q + 1) + (xcd - r) * q) + off; }
        const int nig = WGM * nN, gid = wgid / nig, fm = gid * WGM, gsz = (nM - fm) < WGM ? (nM - fm) : WGM;
        u.pm = fm + ((wgid % nig) % gsz); u.pn = (wgid % nig) / gsz; return true;
    }
    __device__ __forceinline__ void a_ready(const Unit&) const {}
    __device__ __forceinline__ void done(const Unit&) const {}
};

__device__ __forceinline__ unsigned cvt_pk_bf16(float lo, float hi) { unsigned r; asm volatile("v_cvt_pk_bf16_f32 %0, %1, %2" : "=v"(r) : "v"(lo), "v"(hi)); return r; }
typedef float f32x2 __attribute__((ext_vector_type(2)));
struct NoHook { __device__ __forceinline__ void at_tile(int, const Unit&, f32x4 (&)[2][2][4][2], PG8_LAS unsigned char*, int, int) const {} };
template <class Epi, class Sched, bool ALIGN_EPI = false, bool SP2 = false, class Hook = NoHook>
__device__ __forceinline__ void gemm_phase(PG8_LAS unsigned char* lds, const Gemm g, const Sched& S, const Epi& E, const Hook& H = Hook()) {
    const int tid = threadIdx.x, wid = __builtin_amdgcn_readfirstlane(tid >> 6), lane = tid & 63, wr = wid >> 2, wc = wid & 3, fr = lane & 15, fq = lane >> 4;
    const int K = g.K, nt = K / BK;
    unsigned voffA[2], voffB[2];
#pragma unroll
    for (int i = 0; i < 2; ++i) { int R, C; stage_rc(tid * 16 + i * 8192, R, C); const int Rb = Epi::PERM ? ((R & ~31) + perm32(R & 31)) : R;
        voffA[i] = (unsigned)(R * K + C) * 2u; voffB[i] = (unsigned)(Rb * K + C) * 2u; }
    const size_t kstep = (size_t)(BK * 2);
    const size_t hstep = (size_t)HALF * K * 2;
    const size_t tstep = 2 * hstep;
    const unsigned ldsw = (unsigned)wid * 1024u;
    const int aoff = lds_byte(wr * 64 + fr, fq * 8), boff = lds_byte(wc * 32 + fr, fq * 8);
#define PG8_SA(b, h) (((b) * 2 + (h)) * HTB)
#define PG8_SB(b, h) ((4 + (b) * 2 + (h)) * HTB)
#define PG8_STAGE(bufoff, gbase, voff) do { _Pragma("unroll") for (int _i = 0; _i < 2; ++_i) \
        __builtin_amdgcn_global_load_lds((const unsigned*)((const char*)(gbase) + (voff)[_i]), (PG8_LAS unsigned*)(lds + (bufoff) + ldsw + _i * 8192), 16, 0, 0); } while (0)
#define PG8_LDA(dst, b, h) do { _Pragma("unroll") for (int m = 0; m < 4; ++m) _Pragma("unroll") for (int k = 0; k < 2; ++k) dst[m][k] = *(const PG8_LAS bf16x8*)(lds + PG8_SA(b, h) + aoff + m * 2048 + k * 1024); } while (0)
#define PG8_LDB(dst, b, h) do { _Pragma("unroll") for (int n = 0; n < 2; ++n) _Pragma("unroll") for (int k = 0; k < 2; ++k) dst[n][k] = *(const PG8_LAS bf16x8*)(lds + PG8_SB(b, h) + boff + n * 2048 + k * 1024); } while (0)
#define PG8_MMA(ai, bj, At, Bt) do { __builtin_amdgcn_s_setprio(1); _Pragma("unroll") for (int m = 0; m < 4; ++m) _Pragma("unroll") for (int n = 0; n < 2; ++n) _Pragma("unroll") for (int k = 0; k < 2; ++k) \
        acc[ai][bj][m][n] = __builtin_amdgcn_mfma_f32_16x16x32_bf16(Bt[n][k], At[m][k], acc[ai][bj][m][n], 0, 0, 0); __builtin_amdgcn_s_setprio(0); } while (0)
#define PG8_WAIT_V(n) asm volatile("s_waitcnt vmcnt(" #n ")" ::: "memory")
#define PG8_WAIT_L(n) asm volatile("s_waitcnt lgkmcnt(" #n ")" ::: "memory")
#define PG8_BAR __builtin_amdgcn_s_barrier()
#define PG8_SCHED __builtin_amdgcn_sched_barrier(0)
    Unit cur, nxt; int ui = 0;
    if (!S.next(0, cur)) return;
    f32x4 acc[2][2][4][2];
#pragma unroll
    for (int a = 0; a < 2; ++a)
#pragma unroll
        for (int b = 0; b < 2; ++b)
#pragma unroll
            for (int m = 0; m < 4; ++m)
#pragma unroll
                for (int n = 0; n < 2; ++n) acc[a][b][m][n] = (f32x4){0.f, 0.f, 0.f, 0.f};
    bf16x8 At[4][2], B0[2][2], B1[2][2];
    const char* cA = (const char*)g.A + (size_t)cur.pm * tstep; const char* cB = (const char*)g.Bt + (size_t)cur.pn * tstep;
    S.a_ready(cur);
    if constexpr (SP2) {
        PG8_STAGE(PG8_SB(0, 0), cB, voffB); PG8_STAGE(PG8_SB(0, 1), cB + hstep, voffB); PG8_STAGE(PG8_SA(0, 0), cA, voffA); PG8_STAGE(PG8_SA(0, 1), cA + hstep, voffA);
        if (wr == 1) PG8_BAR;
        PG8_WAIT_V(2); PG8_BAR;
        PG8_STAGE(PG8_SB(1, 0), cB + kstep, voffB); PG8_STAGE(PG8_SA(1, 0), cA + kstep, voffA); PG8_STAGE(PG8_SB(1, 1), cB + hstep + kstep, voffB);
        PG8_WAIT_V(6); PG8_BAR;
    } else {
        PG8_STAGE(PG8_SB(0, 0), cB, voffB); PG8_STAGE(PG8_SA(0, 0), cA, voffA); PG8_STAGE(PG8_SB(0, 1), cB + hstep, voffB); PG8_STAGE(PG8_SA(0, 1), cA + hstep, voffA);
        if (wr == 1) PG8_BAR;
        PG8_WAIT_V(4); PG8_BAR;
        PG8_STAGE(PG8_SB(1, 0), cB + kstep, voffB); PG8_STAGE(PG8_SA(1, 0), cA + kstep, voffA); PG8_STAGE(PG8_SB(1, 1), cB + hstep + kstep, voffB);
        PG8_WAIT_V(6); PG8_BAR;
    }
    for (;;) {
        const bool has_next = S.next(ui + 1, nxt);
        const char* nA = has_next ? (const char*)g.A + (size_t)nxt.pm * tstep : cA; const char* nB = has_next ? (const char*)g.Bt + (size_t)nxt.pn * tstep : cB;
        for (int t = 0; t < nt; t += 2) {
            const bool last = (t == nt - 2);
            H.at_tile(t, cur, acc, lds + STAGE_BYTES, wr, fr);
            const char* a1 = cA + (size_t)(t + 1) * kstep;
            const char* a2 = last ? nA : cA + (size_t)(t + 2) * kstep; const char* b2 = last ? nB : cB + (size_t)(t + 2) * kstep;
            const char* a3 = a2 + kstep; const char* b3 = b2 + kstep;
            if (last && has_next) S.a_ready(nxt);
            if constexpr (SP2) {
            PG8_LDB(B0, 0, 0); PG8_LDB(B1, 0, 1); PG8_SCHED; PG8_LDA(At, 0, 0); PG8_STAGE(PG8_SA(1, 1), a1 + hstep, voffA);
            PG8_WAIT_V(8); PG8_WAIT_L(0); PG8_BAR; PG8_MMA(0, 0, At, B0); PG8_MMA(0, 1, At, B1); PG8_BAR; PG8_SCHED;
            PG8_LDA(At, 0, 1); PG8_STAGE(PG8_SB(0, 0), b2, voffB); PG8_STAGE(PG8_SB(0, 1), b2 + hstep, voffB); PG8_STAGE(PG8_SA(0, 0), a2, voffA);
            PG8_WAIT_V(8); PG8_WAIT_L(0); PG8_BAR; PG8_MMA(1, 0, At, B0); PG8_MMA(1, 1, At, B1); PG8_BAR; PG8_SCHED;
            PG8_LDB(B0, 1, 0); PG8_LDB(B1, 1, 1); PG8_SCHED; PG8_LDA(At, 1, 0); PG8_STAGE(PG8_SA(0, 1), a2 + hstep, voffA);
            PG8_WAIT_V(8); PG8_WAIT_L(0); PG8_BAR; PG8_MMA(0, 0, At, B0); PG8_MMA(0, 1, At, B1); PG8_BAR; PG8_SCHED;
            PG8_LDA(At, 1, 1); PG8_STAGE(PG8_SB(1, 0), b3, voffB); PG8_STAGE(PG8_SB(1, 1), b3 + hstep, voffB); PG8_STAGE(PG8_SA(1, 0), a3, voffA);
            PG8_WAIT_V(8); PG8_WAIT_L(0); PG8_BAR; PG8_MMA(1, 0, At, B0); PG8_MMA(1, 1, At, B1); PG8_BAR; PG8_SCHED;
            } else {
            PG8_LDB(B0, 0, 0); PG8_SCHED; PG8_LDA(At, 0, 0); PG8_STAGE(PG8_SA(1, 1), a1 + hstep, voffA);
            PG8_WAIT_L(8); PG8_BAR; PG8_WAIT_L(0); PG8_MMA(0, 0, At, B0); PG8_BAR; PG8_SCHED;
            PG8_LDB(B1, 0, 1); PG8_STAGE(PG8_SB(0, 0), b2, voffB);
            PG8_BAR; PG8_WAIT_L(0); PG8_MMA(0, 1, At, B1); PG8_BAR;
            PG8_LDA(At, 0, 1); PG8_STAGE(PG8_SA(0, 0), a2, voffA);
            PG8_BAR; PG8_WAIT_L(0); PG8_MMA(1, 0, At, B0); PG8_BAR; PG8_SCHED;
            PG8_STAGE(PG8_SB(0, 1), b2 + hstep, voffB);
            PG8_WAIT_V(6); PG8_BAR; PG8_MMA(1, 1, At, B1); PG8_BAR;
            PG8_LDB(B0, 1, 0); PG8_SCHED; PG8_LDA(At, 1, 0); PG8_STAGE(PG8_SA(0, 1), a2 + hstep, voffA);
            PG8_WAIT_L(8); PG8_BAR; PG8_WAIT_L(0); PG8_MMA(0, 0, At, B0); PG8_BAR; PG8_SCHED;
            PG8_LDB(B1, 1, 1); PG8_STAGE(PG8_SB(1, 0), b3, voffB);
            PG8_BAR; PG8_WAIT_L(0); PG8_MMA(0, 1, At, B1); PG8_BAR;
            PG8_LDA(At, 1, 1); PG8_STAGE(PG8_SA(1, 0), a3, voffA);
            PG8_BAR; PG8_WAIT_L(0); PG8_MMA(1, 0, At, B0); PG8_BAR; PG8_SCHED;
            PG8_STAGE(PG8_SB(1, 1), b3 + hstep, voffB);
            PG8_WAIT_V(6); PG8_BAR; PG8_MMA(1, 1, At, B1); PG8_BAR;
            }
        }
        if constexpr (ALIGN_EPI) { if (wr == 0) PG8_BAR; }
        if constexpr (!Epi::AFTER_DRAIN) { E(acc, cur, wr, wc, fr, fq);
#ifdef PROBE_EPI2
            if constexpr (Epi::PROBE_TWICE) { asm volatile("" ::: "memory"); E(acc, cur, wr, wc, fr, fq); }
#endif
            S.done(cur); }
        if (!has_next) break;
#pragma unroll
        for (int a = 0; a < 2; ++a)
#pragma unroll
            for (int b = 0; b < 2; ++b)
#pragma unroll
                for (int m = 0; m < 4; ++m)
#pragma unroll
                    for (int n = 0; n < 2; ++n) acc[a][b][m][n] = (f32x4){0.f, 0.f, 0.f, 0.f};
        cur = nxt; cA = nA; cB = nB; ++ui;
        if constexpr (ALIGN_EPI) { if (wr == 1) PG8_BAR; }
    }
    PG8_WAIT_V(0);
    if constexpr (!ALIGN_EPI) { if (wr == 0) PG8_BAR; }
    PG8_BAR;
    if constexpr (Epi::AFTER_DRAIN) { E.fused(acc, cur, wr, wc, fr, fq, lds, wid, lane); S.done(cur); }
#undef PG8_SA
#undef PG8_SB
#undef PG8_STAGE
#undef PG8_LDA
#undef PG8_LDB
#undef PG8_MMA
#undef PG8_WAIT_V
#undef PG8_WAIT_L
#undef PG8_BAR
#undef PG8_SCHED
}
}
namespace pg8 {
struct EpiProj {
    static constexpr bool PERM = true, AFTER_DRAIN = false, PROBE_TWICE = true;
    bf16_t* O; int ldc;
    __device__ __forceinline__ void operator()(const f32x4 (&acc)[2][2][4][2], const Unit& u, int wr, int wc, int fr, int fq) const {
        const int row0 = u.pm * BM + wr * 64 + fr; const int col0 = u.pn * BM + wc * 32 + 8 * fq;
#pragma unroll
        for (int ai = 0; ai < 2; ++ai)
#pragma unroll
            for (int m = 0; m < 4; ++m) { bf16_t* rowp = O + (size_t)(row0 + ai * HALF + m * 16) * ldc + col0;
#pragma unroll
                for (int bj = 0; bj < 2; ++bj) { const f32x4 v0 = acc[ai][bj][m][0], v1 = acc[ai][bj][m][1];
                    u32x4 w; w.x = cvt_pk_bf16(v0[0], v0[1]); w.y = cvt_pk_bf16(v0[2], v0[3]); w.z = cvt_pk_bf16(v1[0], v1[1]); w.w = cvt_pk_bf16(v1[2], v1[3]);
                    __builtin_nontemporal_store(w, (u32x4*)(rowp + bj * HALF)); } }
    }
};
struct EpiX1 {
    static constexpr bool PERM = true, AFTER_DRAIN = false, PROBE_TWICE = false;
    const float* x; float* x1; bf16_t* x1s; const float* mod; const float* norm2_g; float* rowstat; PG8_LAS float* tab;
    __device__ __forceinline__ void operator()(const f32x4 (&acc)[2][2][4][2], const Unit& u, int wr, int wc, int fr, int fq) const {
        const int row0 = u.pm * BM + wr * 64 + fr; const int col0 = u.pn * BM + wc * 32 + 8 * fq; const int b = (u.pm * BM) >> 11;
        const float* mb = mod + (size_t)b * 6144;
        f32x4 g1[2][2], g2[2][2];
#pragma unroll
        for (int bj = 0; bj < 2; ++bj)
#pragma unroll
            for (int n = 0; n < 2; ++n) { const int c = col0 + bj * HALF + 4 * n; g1[bj][n] = *(const f32x4*)(mb + 2048 + c);
                const f32x4 sc = *(const f32x4*)(mb + 4096 + c), ng = *(const f32x4*)(norm2_g + c); g2[bj][n] = ng * (sc + 1.0f); }
#pragma unroll
        for (int ai = 0; ai < 2; ++ai)
#pragma unroll
            for (int m = 0; m < 4; ++m) { const size_t row = (size_t)(row0 + ai * HALF + m * 16); const size_t off = row * 1024 + col0; float ss = 0.f;
                const float rfin = tab[((u.pm >> 3) & 1) * 1280 + 1024 + ai * HALF + wr * 64 + m * 16 + fr];
#pragma unroll
                for (int bj = 0; bj < 2; ++bj) {
                    const f32x4 xa = *(const f32x4*)(x + off + bj * HALF), xb = *(const f32x4*)(x + off + bj * HALF + 4);
                    const f32x4 v0 = xa + g1[bj][0] * (acc[ai][bj][m][0] * rfin), v1 = xb + g1[bj][1] * (acc[ai][bj][m][1] * rfin);
                    *(f32x4*)(x1 + off + bj * HALF) = v0; *(f32x4*)(x1 + off + bj * HALF + 4) = v1;
                    ss += (v0[0] * v0[0] + v0[1] * v0[1]) + (v0[2] * v0[2] + v0[3] * v0[3]) + (v1[0] * v1[0] + v1[1] * v1[1]) + (v1[2] * v1[2] + v1[3] * v1[3]);
                    const f32x4 s0 = v0 * g2[bj][0], s1 = v1 * g2[bj][1];
                    u32x4 w; w.x = cvt_pk_bf16(s0[0], s0[1]); w.y = cvt_pk_bf16(s0[2], s0[3]); w.z = cvt_pk_bf16(s1[0], s1[1]); w.w = cvt_pk_bf16(s1[2], s1[3]);
                    *(u32x4*)(x1s + off + bj * HALF) = w; }
                ss += __shfl_xor(ss, 16); ss += __shfl_xor(ss, 32);
                if (fq == 0) atomicAdd(rowstat + row, ss); }
    }
};
typedef _Float16 f16x8 __attribute__((ext_vector_type(8)));
struct EpiScores {
    static constexpr bool PERM = true, AFTER_DRAIN = false, PROBE_TWICE = false;
    _Float16* S; const float* sb; const float* rowstat;
    __device__ __forceinline__ void operator()(const f32x4 (&acc)[2][2][4][2], const Unit& u, int wr, int wc, int fr, int fq) const {
        const int row0 = u.pm * BM + wr * 64 + fr; const int col0 = u.pn * BM + wc * 32 + 8 * fq; const int b = (u.pm * BM) >> 11;
        f32x4 bv[2][2];
#pragma unroll
        for (int bj = 0; bj < 2; ++bj)
#pragma unroll
            for (int n = 0; n < 2; ++n) bv[bj][n] = *(const f32x4*)(sb + (size_t)b * 2048 + col0 + bj * HALF + 4 * n);
#pragma unroll
        for (int ai = 0; ai < 2; ++ai)
#pragma unroll
            for (int m = 0; m < 4; ++m) { const size_t row = (size_t)(row0 + ai * HALF + m * 16); const float rs = __builtin_amdgcn_rsqf(rowstat[row] * (1.0f / 1024.0f) + 1e-6f);
                _Float16* rowp = S + row * 2048 + col0;
#pragma unroll
                for (int bj = 0; bj < 2; ++bj) { const f32x4 v0 = acc[ai][bj][m][0] * rs + bv[bj][0], v1 = acc[ai][bj][m][1] * rs + bv[bj][1];
                    f16x8 h; h[0] = (_Float16)v0[0]; h[1] = (_Float16)v0[1]; h[2] = (_Float16)v0[2]; h[3] = (_Float16)v0[3]; h[4] = (_Float16)v1[0]; h[5] = (_Float16)v1[1]; h[6] = (_Float16)v1[2]; h[7] = (_Float16)v1[3];
                    *(f16x8*)(rowp + bj * HALF) = h; } }
    }
};
struct SegScaleHook {
    __device__ __forceinline__ static void build(PG8_LAS unsigned char* ldsx, const Unit& u, const float* st_ssd, const float* st_s5, int tid) {
        PG8_LAS float* tab = (PG8_LAS float*)ldsx + ((u.pm >> 3) & 1) * 1280;
        if (tid < 256) { const size_t row = (size_t)u.pm * BM + tid; const f32x4* sg = (const f32x4*)(st_ssd + row * 16); const f32x4* s5 = (const f32x4*)(st_s5 + row * 64);
            float r[5];
#pragma unroll
            for (int gI = 0; gI < 4; ++gI) { const f32x4 v = sg[gI]; r[gI] = __builtin_amdgcn_rsqf(((v[0] + v[1]) + (v[2] + v[3])) * (1.0f / 256.0f) + 1e-6f); }
            float a5 = 0.f;
#pragma unroll
            for (int q = 0; q < 16; ++q) { const f32x4 v = s5[q]; a5 += (v[0] + v[1]) + (v[2] + v[3]); }
            r[4] = __builtin_amdgcn_rsqf(a5 * (1.0f / 1024.0f) + 1e-6f);
#pragma unroll
            for (int k = 0; k < 4; ++k) tab[k * 256 + tid] = r[k] * __builtin_amdgcn_rcpf(r[k + 1]);
            tab[1024 + tid] = r[4]; }
    }
    __device__ __forceinline__ void at_tile(int t, const Unit& u, f32x4 (&acc)[2][2][4][2], PG8_LAS unsigned char* ldsx, int wr, int fr) const {
        if (t == 4 || t == 8 || t == 12 || t == 16) { const PG8_LAS float* rt = (const PG8_LAS float*)ldsx + ((u.pm >> 3) & 1) * 1280 + ((t >> 2) - 1) * 256 + wr * 64 + fr;
#pragma unroll
            for (int ai = 0; ai < 2; ++ai)
#pragma unroll
                for (int m = 0; m < 4; ++m) { const float r = rt[ai * HALF + m * 16];
#pragma unroll
                    for (int bj = 0; bj < 2; ++bj) { acc[ai][bj][m][0] = acc[ai][bj][m][0] * r; acc[ai][bj][m][1] = acc[ai][bj][m][1] * r; } } }
    }
};
}
constexpr int NWAVES = 8, NTHR = 512;
constexpr int DM = 1024, NB = 16, SEQ = 2048, MTOK = NB * SEQ;
constexpr int NPROJ = 4096;
constexpr int INW = 4112;
constexpr int NHEADS = 16, HDIM = 64, NGRP = 4, NST = 128, CHUNK = 128;
constexpr int S5G = 64, S5CH = 16, S5P = 64;
constexpr int PH = 8, PK = 16, PNK = 128;
constexpr float EPSF = 1e-6f;
constexpr int NS5PART = 64;

constexpr size_t MiB = 1u << 20;
constexpr size_t WS_CTL = 0, CTL_ZERO_BYTES = 64 * 1024;
constexpr size_t WS_MOD = 1 * MiB;
constexpr size_t WS_WDT = WS_MOD + 0x60000;
constexpr size_t WS_SB = WS_MOD + 0x70000;
constexpr size_t WS_ROWSTAT = WS_MOD + 0x90000;
constexpr size_t WS_S5LB = WS_MOD + 0xB0000;
constexpr size_t WS_S5BB = WS_MOD + 0xC0000;
constexpr size_t WS_DTRAW = 3 * MiB;
constexpr size_t WS_STSSD = 5 * MiB;
constexpr size_t WS_STS5 = 7 * MiB;
constexpr size_t WS_WINT = 15 * MiB;
constexpr size_t WS_WOUTT = 23 * MiB;
constexpr size_t WS_WQKT = 27 * MiB;
constexpr size_t WS_EU = 31 * MiB, WS_EV = 47 * MiB;
constexpr size_t WS_EUS = 63 * MiB, WS_EVS = 63 * MiB + 65536;
constexpr size_t WS_START = 64 * MiB;
constexpr size_t WS_A = 95 * MiB;
constexpr size_t WS_B = 223 * MiB;
constexpr size_t WS_H1 = WS_A, WS_Y = WS_A, WS_PROJ = WS_B, WS_SCORES = WS_A;
constexpr size_t WS_X1S = WS_B + 192 * MiB;
constexpr size_t WS_EID = 479 * MiB, WS_GATE = 495 * MiB;
constexpr size_t WS_H2Q = WS_B, WS_HINV = WS_B + 32 * MiB;
constexpr size_t WS_END = 511 * MiB;
static_assert(WS_SCORES + (size_t)MTOK * 2048 * 4 <= WS_X1S && WS_X1S + (size_t)MTOK * 1024 * 2 <= WS_EID && WS_GATE + (size_t)MTOK * 128 * 4 <= WS_END, "ws map");

constexpr int LDS_MAIN = 159744;
constexpr int MISC_OFF = LDS_MAIN;
constexpr int LDS_BYTES = LDS_MAIN + 128;

#define GAS __attribute__((address_space(1)))
#define LAS __attribute__((address_space(3)))
typedef unsigned short bf16;
typedef unsigned v4u __attribute__((ext_vector_type(4)));
typedef unsigned v2u __attribute__((ext_vector_type(2)));
typedef float f32x4 __attribute__((ext_vector_type(4)));
typedef float f32x2 __attribute__((ext_vector_type(2)));
typedef short bf16x8 __attribute__((ext_vector_type(8)));
#define LDS_WAIT() asm volatile("s_waitcnt lgkmcnt(0)" ::: "memory")
#define VM_WAIT() asm volatile("s_waitcnt vmcnt(0)" ::: "memory")
typedef __bf16 hwbf16x2 __attribute__((ext_vector_type(2)));
__device__ __forceinline__ unsigned pk2(float lo, float hi) { const f32x2 v = {lo, hi}; const hwbf16x2 b = __builtin_convertvector(v, hwbf16x2); return __builtin_bit_cast(unsigned, b); }
__device__ __forceinline__ unsigned f2bf(float f) { return pk2(f, 0.f) & 0xffffu; }
__device__ __forceinline__ float bflo(unsigned w) { return __builtin_bit_cast(float, w << 16); }
__device__ __forceinline__ float bfhi(unsigned w) { return __builtin_bit_cast(float, w & 0xffff0000u); }
__device__ __forceinline__ float bf2f(bf16 v) { return __builtin_bit_cast(float, (unsigned)v << 16); }
__device__ __forceinline__ float wave_sum(float v) {
#pragma unroll
    for (int o = 1; o < 64; o <<= 1) v += __shfl_xor(v, o);
    return v;
}
__device__ __forceinline__ float sigmoid_f(float v) { return __builtin_amdgcn_rcpf(1.0f + __builtin_amdgcn_exp2f(-1.4426950408889634f * v)); }
__device__ __forceinline__ float silu_f(float v) { return v * sigmoid_f(v); }
__device__ __forceinline__ float rsqrt_f(float v) { return __builtin_amdgcn_rsqf(v); }
__device__ __forceinline__ float gelu_erf(float v) {
    const float av = fabsf(v), t = __builtin_amdgcn_rcpf(av * 0.2316418882f + 1.0f);
    float q = t * 0.5307027145f + (-0.7265760135f); q = q * t + 0.7107068705f; q = q * t + (-0.142248368f); q = q * t + 0.127414796f; q = q * t;
    const float e = __builtin_amdgcn_exp2f((v * v) * (-0.72134752044f));
    const float m = v * (q * e);
    return v < 0.f ? m : v - m;
}
__device__ __forceinline__ float softplus_f(float v) { const float e = __builtin_amdgcn_exp2f(-1.4426950408889634f * fabsf(v));
    const float l = e < 1e-6f ? e : 0.6931471805599453f * __builtin_amdgcn_logf(1.0f + e); return fmaxf(v, 0.f) + l; }
__device__ __forceinline__ void unpack8(const v4u w, float* f) { f[0] = bflo(w.x); f[1] = bfhi(w.x); f[2] = bflo(w.y); f[3] = bfhi(w.y); f[4] = bflo(w.z); f[5] = bfhi(w.z); f[6] = bflo(w.w); f[7] = bfhi(w.w); }
#define LDS_BARRIER() do { asm volatile("s_waitcnt lgkmcnt(0)" ::: "memory"); __builtin_amdgcn_s_barrier(); asm volatile("" ::: "memory"); } while (0)
__device__ __forceinline__ float row16_sum_to15(float v) {
    v += __builtin_bit_cast(float, __builtin_amdgcn_update_dpp(0, __builtin_bit_cast(int, v), 0x118, 0xf, 0xf, true));
    v += __builtin_bit_cast(float, __builtin_amdgcn_update_dpp(0, __builtin_bit_cast(int, v), 0x114, 0xf, 0xf, true));
    v += __builtin_bit_cast(float, __builtin_amdgcn_update_dpp(0, __builtin_bit_cast(int, v), 0x112, 0xf, 0xf, true));
    v += __builtin_bit_cast(float, __builtin_amdgcn_update_dpp(0, __builtin_bit_cast(int, v), 0x111, 0xf, 0xf, true));
    return v;
}
__device__ __forceinline__ float wave_sum_to63(float v) {
    v = row16_sum_to15(v);
    v += __builtin_bit_cast(float, __builtin_amdgcn_update_dpp(0, __builtin_bit_cast(int, v), 0x142, 0xa, 0xf, false));
    v += __builtin_bit_cast(float, __builtin_amdgcn_update_dpp(0, __builtin_bit_cast(int, v), 0x143, 0xc, 0xf, false));
    return v;
}
__device__ __forceinline__ f32x2 gelu_pk2(f32x2 v) {
    const f32x2 av = __builtin_elementwise_abs(v), d = av * 0.2316418882f + 1.0f;
    f32x2 t; t[0] = __builtin_amdgcn_rcpf(d[0]); t[1] = __builtin_amdgcn_rcpf(d[1]);
    f32x2 q = t * 0.5307027145f + (-0.7265760135f); q = q * t + 0.7107068705f; q = q * t + (-0.142248368f); q = q * t + 0.127414796f; q = q * t;
    const f32x2 s = (v * v) * (-0.72134752044f);
    f32x2 e; e[0] = __builtin_amdgcn_exp2f(s[0]); e[1] = __builtin_amdgcn_exp2f(s[1]);
    const f32x2 m = v * (q * e), r = v - m;
    f32x2 o; o[0] = v[0] < 0.f ? m[0] : r[0]; o[1] = v[1] < 0.f ? m[1] : r[1]; return o;
}
#define XB_TMO      128
#define XB_XCNT(j)  (256  + 64 * (j))
#define XB_XSUB(j)  (1280 + 64 * (j))
#define XB_XGEN(j)  (2304 + 64 * (j))
#define XB_TOP      3328
#define XB_TOPGEN   3392
#define XCD_BAR_WORDS 3456
#define XB_SPIN_CAP (1u << 18)

__device__ __forceinline__ unsigned xb_ld(unsigned* p)              { return __hip_atomic_load(p, __ATOMIC_RELAXED, __HIP_MEMORY_SCOPE_AGENT); }
__device__ __forceinline__ unsigned xb_add(unsigned* p, unsigned v) { return __hip_atomic_fetch_add(p, v, __ATOMIC_RELAXED, __HIP_MEMORY_SCOPE_AGENT); }
__device__ __forceinline__ unsigned xb_xcc_id() { return (unsigned)__builtin_amdgcn_s_getreg((3 << 11) | 20) & 0xFu; }
#define XB_SPIN(cond, bar) do { unsigned _sp = 0; while (cond) { __builtin_amdgcn_s_sleep(1); \
    if ((++_sp & 255u) == 0u) { if (xb_ld(&(bar)[XB_TMO])) break; if (_sp > XB_SPIN_CAP) { atomicAdd(&(bar)[XB_TMO], 1u); break; } } } } while (0)

struct XcdBarrier {
    unsigned* bar; unsigned x;
    volatile LAS unsigned* st;
};

__device__ __forceinline__ XcdBarrier xcd_barrier_post(unsigned* bar, volatile LAS unsigned* st) {
    XcdBarrier b; b.bar = bar; b.x = xb_xcc_id(); b.st = st;
    if (threadIdx.x == 0) (void)xb_add(&bar[XB_XCNT(b.x)], 1u);
    return b;
}
__device__ __forceinline__ void xcd_barrier_complete(unsigned* bar, unsigned x, unsigned& nloc, unsigned& nx) {
    const unsigned G = gridDim.x * gridDim.y * gridDim.z;
    unsigned sum, cnt, mine, sp = 0u;
    for (;;) {
        sum = 0u; cnt = 0u; mine = 0u;
#pragma unroll
        for (unsigned j = 0; j < 16; ++j) { const unsigned c = xb_ld(&bar[XB_XCNT(j)]); sum += c; cnt += (c > 0u) ? 1u : 0u; mine = (j == x) ? c : mine; }
        if (sum == G) break;
        __builtin_amdgcn_s_sleep(1);
        if ((++sp & 255u) == 0u) { if (xb_ld(&bar[XB_TMO])) break; if (sp > XB_SPIN_CAP) { atomicAdd(&bar[XB_TMO], 1u); break; } }
    }
    nloc = mine > 0u ? mine : 1u; nx = cnt > 0u ? cnt : 1u;
}

__device__ __forceinline__ void xcd_barrier(const XcdBarrier& b) {
    asm volatile("s_waitcnt vmcnt(0)" ::: "memory");
    __syncthreads();
    if (threadIdx.x == 0) {
        unsigned* bar = b.bar;
        __builtin_amdgcn_s_waitcnt(0);
        unsigned nloc = b.st[0], nx = b.st[1];
        if (nloc == 0u) { xcd_barrier_complete(bar, b.x, nloc, nx); b.st[0] = nloc; b.st[1] = nx; }
        const unsigned old = xb_add(&bar[XB_XSUB(b.x)], 1u);
        const unsigned gen = old / nloc;
        if (old + 1u == (gen + 1u) * nloc) {
            __builtin_amdgcn_fence(__ATOMIC_RELEASE, "agent");
            asm volatile("s_waitcnt vmcnt(0)" ::: "memory");
            const unsigned og = xb_add(&bar[XB_TOP], 1u);
            const unsigned tg = og / nx;
            if (og + 1u == (tg + 1u) * nx) xb_add(&bar[XB_TOPGEN], 1u);
            else XB_SPIN(xb_ld(&bar[XB_TOPGEN]) == tg, bar);
            __builtin_amdgcn_fence(__ATOMIC_ACQUIRE, "agent");
            xb_add(&bar[XB_XGEN(b.x)], 1u);
            asm volatile("s_waitcnt vmcnt(0)" ::: "memory");
        } else {
            XB_SPIN(xb_ld(&bar[XB_XGEN(b.x)]) == gen, bar);
            __builtin_amdgcn_fence(__ATOMIC_ACQUIRE, "agent");
            asm volatile("s_waitcnt vmcnt(0)" ::: "memory");
        }
    }
    __syncthreads();
}
struct Args { const float* in[30]; float* out; unsigned char* ws; int ph_lo, ph_hi; };
struct Frame {
    LAS unsigned char* lds;
    volatile LAS unsigned* MISC;
    int vcu, G;
    unsigned char* ws;
    const Args* a;
    float* out;
};
#define WSP(T, off) ((T*)(F.ws + (off)))

__device__ __forceinline__ void transpose_tile(const float* W, int ldw, int k0, int src_n0, bf16* WT, int K, int dst_n0, LAS float* scr, int lane, const float* kscale) {
#pragma unroll 8
    for (int i = 0; i < 32; ++i) { const int kk = 2 * i + (lane >> 5); float v = W[(size_t)(k0 + kk) * ldw + src_n0 + (lane & 31)]; if (kscale) v *= kscale[k0 + kk]; scr[kk * 33 + (lane & 31)] = v; }
    LDS_WAIT(); asm volatile("" ::: "memory");
    const int c = lane & 7;
#pragma unroll
    for (int j = 0; j < 4; ++j) { const int n = (lane >> 3) + 8 * j; const LAS float* s = scr + (8 * c) * 33 + n;
        v4u o; o.x = pk2(s[0 * 33], s[1 * 33]); o.y = pk2(s[2 * 33], s[3 * 33]); o.z = pk2(s[4 * 33], s[5 * 33]); o.w = pk2(s[6 * 33], s[7 * 33]);
        *(v4u*)(WT + (size_t)(dst_n0 + n) * K + k0 + 8 * c) = o; }
    LDS_WAIT(); asm volatile("" ::: "memory");
}
__device__ __forceinline__ void p0_phase(Frame& F) {
    const int f_tid = threadIdx.x, f_lane = f_tid & 63, f_wave = __builtin_amdgcn_readfirstlane(f_tid >> 6);
    const int gw = F.vcu * NWAVES + f_wave, NGW = F.G * NWAVES, gt = F.vcu * NTHR + f_tid, NGT = F.G * NTHR;
    {
        LAS float* sc = (LAS float*)F.lds;
        LAS float* red = (LAS float*)(F.lds + 65536);
        for (int i = f_tid; i < 16 * 1024; i += NTHR) { const int b = i >> 10, k = i & 1023; sc[k * 16 + b] = silu_f((F.a->in[1])[i]); }
        __syncthreads();
        const int ks = f_tid / 24, col = f_tid - ks * 24, j = F.vcu * 24 + col;
        if (ks < 21) {
            float acc[16];
#pragma unroll
            for (int b = 0; b < 16; ++b) acc[b] = 0.f;
            const int k0 = ks * 49, kn = (k0 + 49 <= 1024) ? 49 : (1024 - k0);
            const float* wp = (F.a->in[2]) + (size_t)k0 * 6144 + j;
#pragma unroll 1
            for (int kb = 0; kb < 49; kb += 7) {
                asm volatile("" ::: "memory");
                float wv[7];
#pragma unroll
                for (int u = 0; u < 7; ++u) wv[u] = (kb + u < kn) ? wp[(size_t)(kb + u) * 6144] : 0.f;
#pragma unroll
                for (int u = 0; u < 7; ++u) { const int kk = (kb + u < kn) ? (k0 + kb + u) : k0; const LAS f32x4* s4 = (const LAS f32x4*)(sc + kk * 16);
#pragma unroll
                    for (int q = 0; q < 4; ++q) { const f32x4 sv = s4[q]; acc[4 * q] += sv[0] * wv[u]; acc[4 * q + 1] += sv[1] * wv[u]; acc[4 * q + 2] += sv[2] * wv[u]; acc[4 * q + 3] += sv[3] * wv[u]; } }
            }
#pragma unroll
            for (int b = 0; b < 16; ++b) red[(ks * 16 + b) * 24 + col] = acc[b];
        }
        __syncthreads();
        for (int i = f_tid; i < 16 * 24; i += NTHR) { const int b = i / 24, cc = i - b * 24; float sacc = 0.f;
            for (int q = 0; q < 21; ++q) sacc += red[(q * 16 + b) * 24 + cc];
            WSP(float, WS_MOD)[b * 6144 + F.vcu * 24 + cc] = sacc + (F.a->in[3])[F.vcu * 24 + cc]; }
        __syncthreads();
    }
    {
        LAS float* scr = (LAS float*)(F.lds + f_wave * 16384);
        constexpr int I_IN = (1024 / 64) * (NPROJ / 32), I_OUT = (2048 / 64) * (1024 / 32);
        for (int it = gw; it < I_IN + I_OUT; it += NGW) {
            if (it < I_IN) { const int kb = it / (NPROJ / 32), nb = it % (NPROJ / 32); const int dn = 32 * nb, sn = dn < 3072 ? dn : dn + 16;
                transpose_tile((F.a->in[5]), INW, 64 * kb, sn, WSP(bf16, WS_WINT), 1024, dn, scr, f_lane, nullptr); }
            else { const int r = it - I_IN, kb = r / 32, nb = r % 32; const int k0 = 64 * kb;
                transpose_tile((F.a->in[23]), 1024, k0, 32 * nb, WSP(bf16, WS_WOUTT), 2048, 32 * nb, scr, f_lane, k0 < 1024 ? (F.a->in[11]) : (F.a->in[22]) - 1024); }
        }
    }
    for (int i = gt; i < 16 * 1024; i += NGT) { const int h = i >> 10, k = i & 1023; WSP(float, WS_WDT)[i] = (F.a->in[5])[(size_t)k * INW + 3072 + h]; }
    for (int task = gw; task < 2048; task += NGW) {
        const int nt = task >> 4, ks = task & 15, n0 = 16 * nt, hc = n0 >> 7, k0 = 64 * ks;
        const int li = f_lane & 15, lq = f_lane >> 4;
        f32x4 acc[4];
#pragma unroll
        for (int s = 0; s < 4; ++s) acc[s] = (f32x4){0.f, 0.f, 0.f, 0.f};
        const float* ap = (F.a->in[26]) + (size_t)(n0 + li) * 128 + 4 * lq;
        const float* bp = (F.a->in[25]) + (size_t)(k0 + li) * 2048 + hc * 128 + 4 * lq;
#pragma unroll
        for (int q = 0; q < 8; ++q) { const f32x4 a = *(const f32x4*)(ap + 16 * q);
#pragma unroll
            for (int s = 0; s < 4; ++s) { const f32x4 b = *(const f32x4*)(bp + (size_t)(16 * s) * 2048 + 16 * q);
#pragma unroll
                for (int jj = 0; jj < 4; ++jj) acc[s] = __builtin_amdgcn_mfma_f32_16x16x4f32(a[jj], b[jj], acc[s], 0, 0, 0); } }
        bf16* o = WSP(bf16, WS_WQKT);
#pragma unroll
        for (int s = 0; s < 4; ++s)
#pragma unroll
            for (int r = 0; r < 4; ++r) o[(size_t)(n0 + 4 * lq + r) * 1024 + k0 + 16 * s + li] = (bf16)f2bf(acc[s][r]);
    }
    for (int i = gt; i < S5G * S5P; i += NGT) {
        const float lr = (F.a->in[12])[i], li = (F.a->in[13])[i], dt = expf((F.a->in[14])[i >> 6]);
        const float mag = expf(lr * dt); float sn, cs; sincosf(li * dt, &sn, &cs);
        const float lbr = mag * cs, lbi = mag * sn, den = lr * lr + li * li;
        const float cfr = ((lbr - 1.0f) * lr + lbi * li) / den, cfi = (lbi * lr - (lbr - 1.0f) * li) / den;
        WSP(float, WS_S5LB)[2 * i] = lbr; WSP(float, WS_S5LB)[2 * i + 1] = lbi;
        for (int hh = 0; hh < 16; ++hh) { const float br = (F.a->in[15])[i * 16 + hh], bi = (F.a->in[16])[i * 16 + hh];
            WSP(float, WS_S5BB)[i * 32 + hh] = cfr * br - cfi * bi; WSP(float, WS_S5BB)[i * 32 + 16 + hh] = cfr * bi + cfi * br; }
    }
    for (int i = gt; i < MTOK; i += NGT) WSP(float, WS_ROWSTAT)[i] = 0.f;
}

__device__ __forceinline__ void p1_phase(Frame& F) {
    const int f_tid = threadIdx.x, f_lane = f_tid & 63, f_wave = __builtin_amdgcn_readfirstlane(f_tid >> 6);
    const int gw = F.vcu * NWAVES + f_wave;
    LAS float* wdt = (LAS float*)F.lds;
    for (int i = f_tid; i < 16 * 1024 / 4; i += NTHR) ((LAS f32x4*)wdt)[i] = ((const f32x4*)WSP(float, WS_WDT))[i];
    __syncthreads();
    const int lane = f_lane;
    for (int wq = gw; wq < MTOK / 16; wq += F.G * NWAVES) {
        const int b = wq >> 7; const float* mb = WSP(float, WS_MOD) + (size_t)b * 6144;
        f32x4 Gv[4], Sv[4];
#pragma unroll
        for (int j = 0; j < 4; ++j) { const int k = 4 * lane + 256 * j; const f32x4 g = *(const f32x4*)((F.a->in[4]) + k), sc = *(const f32x4*)(mb + 1024 + k); Gv[j] = g * (sc + 1.0f); Sv[j] = *(const f32x4*)(mb + k); }
        f32x4 nx[4];
#pragma unroll
        for (int j = 0; j < 4; ++j) nx[j] = *(const f32x4*)((F.a->in[0]) + (size_t)wq * 16 * 1024 + 4 * lane + 256 * j);
        for (int tt = 0; tt < 16; ++tt) {
            asm volatile("" ::: "memory");
            const size_t t = (size_t)wq * 16 + tt; const float* xr = (F.a->in[0]) + t * 1024;
            f32x4 v[4]; float ss = 0.f;
#pragma unroll
            for (int j = 0; j < 4; ++j) { v[j] = nx[j]; ss += (v[j][0] * v[j][0] + v[j][1] * v[j][1]) + (v[j][2] * v[j][2] + v[j][3] * v[j][3]); }
            if (tt < 15) {
#pragma unroll
                for (int j = 0; j < 4; ++j) nx[j] = *(const f32x4*)(xr + 1024 + 4 * lane + 256 * j); }
            const float rstd = rsqrt_f(wave_sum(ss) * (1.0f / 1024.0f) + EPSF);
            bf16* hr = WSP(bf16, WS_H1) + t * 1024;
#pragma unroll
            for (int j = 0; j < 4; ++j) { v[j] = v[j] * rstd * Gv[j] + Sv[j]; v2u w; w.x = pk2(v[j][0], v[j][1]); w.y = pk2(v[j][2], v[j][3]); *(v2u*)(hr + 4 * lane + 256 * j) = w; }
            float d[16];
#pragma unroll
            for (int h = 0; h < 16; ++h) { float a = 0.f;
#pragma unroll
                for (int j = 0; j < 4; ++j) { const f32x4 w = *(const LAS f32x4*)(wdt + h * 1024 + 4 * lane + 256 * j); a += (v[j][0] * w[0] + v[j][1] * w[1]) + (v[j][2] * w[2] + v[j][3] * w[3]); }
                d[h] = a; }
            float e8[8], e4[4], e2[2], e1;
#pragma unroll
            for (int i = 0; i < 8; ++i) { const bool up = lane & 32; const float snd = up ? d[i] : d[i + 8]; const float rcv = __shfl_xor(snd, 32); e8[i] = (up ? d[i + 8] : d[i]) + rcv; }
#pragma unroll
            for (int i = 0; i < 4; ++i) { const bool up = lane & 16; const float snd = up ? e8[i] : e8[i + 4]; const float rcv = __shfl_xor(snd, 16); e4[i] = (up ? e8[i + 4] : e8[i]) + rcv; }
#pragma unroll
            for (int i = 0; i < 2; ++i) { const bool up = lane & 8; const float snd = up ? e4[i] : e4[i + 2]; const float rcv = __shfl_xor(snd, 8); e2[i] = (up ? e4[i + 2] : e4[i]) + rcv; }
            { const bool up = lane & 4; const float snd = up ? e2[0] : e2[1]; const float rcv = __shfl_xor(snd, 4); e1 = (up ? e2[1] : e2[0]) + rcv; }
            e1 += __shfl_xor(e1, 2); e1 += __shfl_xor(e1, 1);
            const int head = ((lane >> 5) & 1) * 8 + ((lane >> 4) & 1) * 4 + ((lane >> 3) & 1) * 2 + ((lane >> 2) & 1);
            if ((lane & 3) == 0) WSP(float, WS_DTRAW)[t * 16 + head] = e1;
        }
    }
    for (int n = gw; n < 2048; n += F.G * NWAVES) {
        const bf16* wr = WSP(bf16, WS_WQKT) + (size_t)n * 1024 + 16 * lane;
        const v4u w0 = *(const v4u*)wr, w1 = *(const v4u*)(wr + 8);
        float wv[16]; wv[0] = bflo(w0.x); wv[1] = bfhi(w0.x); wv[2] = bflo(w0.y); wv[3] = bfhi(w0.y); wv[4] = bflo(w0.z); wv[5] = bfhi(w0.z); wv[6] = bflo(w0.w); wv[7] = bfhi(w0.w);
        wv[8] = bflo(w1.x); wv[9] = bfhi(w1.x); wv[10] = bflo(w1.y); wv[11] = bfhi(w1.y); wv[12] = bflo(w1.z); wv[13] = bfhi(w1.z); wv[14] = bflo(w1.w); wv[15] = bfhi(w1.w);
        for (int b = 0; b < 16; ++b) { const float* sp = WSP(float, WS_MOD) + (size_t)b * 6144 + 3072 + 16 * lane; float a = 0.f;
#pragma unroll
            for (int q = 0; q < 4; ++q) { const f32x4 s = *(const f32x4*)(sp + 4 * q); a += (s[0] * wv[4 * q] + s[1] * wv[4 * q + 1]) + (s[2] * wv[4 * q + 2] + s[3] * wv[4 * q + 3]); }
            a = wave_sum(a); if (lane == 0) WSP(float, WS_SB)[b * 2048 + n] = a; }
    }
}
__device__ __forceinline__ void p3pre_conv(Frame& F) {
    const int tid = threadIdx.x;
    const bf16* proj = WSP(bf16, WS_PROJ); bf16* xo = (bf16*)F.out;
    for (int item = F.vcu * NTHR + tid; item < (MTOK / 16) * 256; item += F.G * NTHR) {
        const int oc = item & 255, run = item >> 8; const int t0 = run * 16, ch = 8 * oc;
        const bool halo = (t0 & (SEQ - 1)) != 0;
        v4u rw[19];
#pragma unroll
        for (int k = 0; k < 19; ++k) { rw[k] = (v4u){0u, 0u, 0u, 0u}; if (k >= 3 || halo) rw[k] = *(const v4u*)(proj + (size_t)(t0 - 3 + k) * NPROJ + 1024 + ch); }
        float cw[4][8], cbv[8];
#pragma unroll
        for (int k = 0; k < 4; ++k) { const f32x4 w0 = *(const f32x4*)((F.a->in[6]) + k * 2048 + ch), w1 = *(const f32x4*)((F.a->in[6]) + k * 2048 + ch + 4);
#pragma unroll
            for (int e = 0; e < 4; ++e) { cw[k][e] = w0[e]; cw[k][4 + e] = w1[e]; } }
        { const f32x4 b0 = *(const f32x4*)((F.a->in[7]) + ch), b1 = *(const f32x4*)((F.a->in[7]) + ch + 4);
#pragma unroll
            for (int e = 0; e < 4; ++e) { cbv[e] = b0[e]; cbv[4 + e] = b1[e]; } }
        float r0[8], r1[8], r2[8];
        unpack8(rw[0], r0); unpack8(rw[1], r1); unpack8(rw[2], r2);
#pragma unroll
        for (int tt = 0; tt < 16; ++tt) {
            float r3[8]; unpack8(rw[3 + tt], r3);
            float v[8];
#pragma unroll
            for (int i = 0; i < 8; ++i) { v[i] = silu_f(cbv[i] + r0[i] * cw[0][i] + r1[i] * cw[1][i] + r2[i] * cw[2][i] + r3[i] * cw[3][i]); r0[i] = r1[i]; r1[i] = r2[i]; r2[i] = r3[i]; }
            *(v4u*)(xo + (size_t)(t0 + tt) * 2048 + ch) = (v4u){pk2(v[0], v[1]), pk2(v[2], v[3]), pk2(v[4], v[5]), pk2(v[6], v[7])};
        }
    }
}
constexpr int SSD_PITCH = 272;
__device__ __forceinline__ bf16x8 lds_frag(LAS unsigned char* base, int row, int kbyte) { return *(const LAS bf16x8*)(base + row * SSD_PITCH + kbyte); }
#ifdef PROBE_SSD
#define SPR_T(v) const unsigned long long v = __builtin_amdgcn_s_memtime();
#define SPR_ACC(i, d) sacc[i] += (d);
#else
#define SPR_T(v)
#define SPR_ACC(i, d)
#endif
constexpr int S3_CS = 0, S3_BS = 34816, S3_GY = 69632, S3_XDT = 104448, S3_XP = 144, S3_PREV = 122880, S3_CSF = 140288, S3_DTF = 141312, S3_WTS = 142336, S3_END = 143360;
static_assert(S3_END <= LDS_MAIN, "SSD v3 LDS map");
typedef short v4i16_t __attribute__((ext_vector_type(4)));
__device__ __forceinline__ bf16x8 lds_frag_tr(LAS unsigned char* tile, int pitch, int k0, int col0, int li, int lq) {
    LAS unsigned char* p = tile + (k0 + 8 * lq + (li >> 2)) * pitch + (col0 + 4 * (li & 3)) * 2;
    const v4i16_t lo = __builtin_amdgcn_ds_read_tr16_b64_v4i16((LAS v4i16_t*)p), hi = __builtin_amdgcn_ds_read_tr16_b64_v4i16((LAS v4i16_t*)(p + 4 * pitch));
    return __builtin_shufflevector(lo, hi, 0, 1, 2, 3, 4, 5, 6, 7);
}
struct Ssd3Pre { v4u xr[4], br[4], cr[4]; float d0, d1; };
__device__ __forceinline__ void ssd3_prefetch(Ssd3Pre& P, const char* xcb, const float* dtr, unsigned voB, unsigned voX, int tid, int lane, int w) {
#pragma unroll
    for (int r = 0; r < 4; ++r) { P.br[r] = *(const v4u*)(xcb + (voB + r * 4096u)); P.cr[r] = *(const v4u*)(xcb + (voB + 1024u + r * 4096u)); }
#pragma unroll
    for (int r = 0; r < 4; ++r) P.xr[r] = *(const v4u*)(xcb + (voX + r * 4096u));
    P.d0 = dtr[lane * 32]; P.d1 = dtr[lane * 32 + 16];
}
__device__ __forceinline__ void ssd3_cumsum(LAS unsigned char* L, int par, float r0, float r1, float dtb, float A, int lane) {
    LAS float* csf = (LAS float*)(L + S3_CSF + par * 512); LAS float* dtf = (LAS float*)(L + S3_DTF + par * 512); LAS float* wts = (LAS float*)(L + S3_WTS + par * 512);
    const float d0 = softplus_f(r0 + dtb), d1 = softplus_f(r1 + dtb);
    const float a0 = d0 * A, a1 = d1 * A; float s = a0 + a1;
#pragma unroll
    for (int o = 1; o < 64; o <<= 1) { const float t = __shfl_up(s, o); if (lane >= o) s += t; }
    const float tot = __shfl(s, 63);
    dtf[2 * lane] = d0; dtf[2 * lane + 1] = d1; csf[2 * lane] = s - a1; csf[2 * lane + 1] = s;
    wts[2 * lane] = __expf(tot - (s - a1)); wts[2 * lane + 1] = __expf(tot - s);
}
__device__ __forceinline__ void p3_ssd3(Frame& F) {
    const int tid0 = threadIdx.x, w = __builtin_amdgcn_readfirstlane(tid0 >> 6);
    LAS unsigned char* L = F.lds;
    const bf16* proj = WSP(bf16, WS_PROJ); const bf16* xc = (const bf16*)F.out; const float* dtraw = WSP(float, WS_DTRAW);
    for (int item = F.vcu; item < NB * NHEADS; item += F.G) {
        const int b = item >> 4, h = item & 15, g = h >> 2;
        int tid = tid0; asm volatile("" : "+v"(tid)); int lane = tid & 63;
        const float A = -__expf((F.a->in[9])[h]), Dh = (F.a->in[10])[h], dtb = (F.a->in[8])[h];
        const int pbs = w >> 1, nb0 = 4 * (w & 1);
        f32x4 st[4];
#pragma unroll
        for (int j = 0; j < 4; ++j) st[j] = (f32x4){0.f, 0.f, 0.f, 0.f};
        __syncthreads();
        for (int i = tid; i < 17408 / 16; i += NTHR) ((LAS v4u*)(L + S3_PREV))[i] = (v4u){0u, 0u, 0u, 0u};
        Ssd3Pre P;
        { const unsigned voB0 = (unsigned)((4 * (tid >> 4)) * 2048 + 1024 + g * 128 + 8 * (tid & 15)) * 2u, voX0 = (unsigned)((4 * ((tid & 255) >> 3)) * 2048 + h * 64 + 8 * (tid & 7)) * 2u;
          ssd3_prefetch(P, (const char*)xc + (size_t)b * SEQ * 4096, dtraw + (size_t)b * SEQ * 16 + h, voB0, voX0, tid, lane, w); }
        if (w == 0) ssd3_cumsum(L, 0, P.d0, P.d1, dtb, A, lane);
        __syncthreads();
#ifdef PROBE_SSD
        unsigned long long sacc[8] = {0, 0, 0, 0, 0, 0, 0, 0};
#endif
        for (int c = 0; c < SEQ / CHUNK; ++c) {
            SPR_T(s0)
            const size_t row0 = (size_t)b * SEQ + (size_t)c * CHUNK; const int par = c & 1;
            asm volatile("" : "+v"(tid));
            lane = tid & 63; const int li = lane & 15, lq = lane >> 4;
            const unsigned voB = (unsigned)((4 * (tid >> 4)) * 2048 + 1024 + g * 128 + 8 * (tid & 15)) * 2u, voX = (unsigned)((4 * ((tid & 255) >> 3)) * 2048 + h * 64 + 8 * (tid & 7)) * 2u;
            const unsigned voZ0 = (unsigned)((tid >> 3) * NPROJ + h * 64 + 8 * (tid & 7)) * 2u, voZ1 = voZ0 + 64u * NPROJ * 2u;
            LAS float* csf = (LAS float*)(L + S3_CSF + par * 512); LAS float* dtf = (LAS float*)(L + S3_DTF + par * 512); LAS float* wts = (LAS float*)(L + S3_WTS + par * 512);
            { const int ob = tid & 15, lb = 4 * (tid >> 4), n0 = 8 * ob;
#pragma unroll
              for (int r = 0; r < 4; ++r) { *(LAS v4u*)(L + S3_BS + (lb + r) * SSD_PITCH + n0 * 2) = P.br[r]; *(LAS v4u*)(L + S3_CS + (lb + r) * SSD_PITCH + n0 * 2) = P.cr[r]; } }
            if (tid < 256) { const int ox = tid & 7, lx = 4 * (tid >> 3), p0 = 8 * ox;
#pragma unroll
              for (int r = 0; r < 4; ++r) { float xv[8]; unpack8(P.xr[r], xv); const float tw = dtf[lx + r];
                  *(LAS v4u*)(L + S3_XDT + (lx + r) * S3_XP + p0 * 2) = (v4u){pk2(xv[0] * tw, xv[1] * tw), pk2(xv[2] * tw, xv[3] * tw), pk2(xv[4] * tw, xv[5] * tw), pk2(xv[6] * tw, xv[7] * tw)}; } }
            const char* prb = (const char*)proj + row0 * (NPROJ * 2);
            const v4u zc0 = *(const v4u*)(prb + voZ0), zc1 = *(const v4u*)(prb + voZ1);
            SPR_T(s1) SPR_ACC(0, s1 - s0)
            LDS_BARRIER();
            SPR_T(s2) SPR_ACC(1, s2 - s1)
            const float cs_end = csf[127];
            bf16x8 ca[4];
#pragma unroll
            for (int ks = 0; ks < 4; ++ks) ca[ks] = lds_frag(L + S3_CS, 16 * w + li, 64 * ks + 16 * lq);
            float csl[4];
#pragma unroll
            for (int r = 0; r < 4; ++r) csl[r] = csf[16 * w + 4 * lq + r];
            { bf16x8 bq[2][4];
#pragma unroll
              for (int ks = 0; ks < 4; ++ks) bq[0][ks] = lds_frag(L + S3_BS, li, 64 * ks + 16 * lq);
#pragma unroll
              for (int sb = 0; sb < 8; ++sb) if (sb <= (w | 1)) {
                  f32x4 cbv = (f32x4){0.f, 0.f, 0.f, 0.f};
                  const int s = 16 * sb + li; const float css = csf[s];
                  if (sb <= w) {
                      if (sb + 1 <= w) {
#pragma unroll
                          for (int ks = 0; ks < 4; ++ks) bq[(sb + 1) & 1][ks] = lds_frag(L + S3_BS, 16 * (sb + 1) + li, 64 * ks + 16 * lq); }
                      __builtin_amdgcn_sched_barrier(0);
#pragma unroll
                      for (int ks = 0; ks < 4; ++ks) cbv = __builtin_amdgcn_mfma_f32_16x16x32_bf16(ca[ks], bq[sb & 1][ks], cbv, 0, 0, 0);
                      __builtin_amdgcn_sched_barrier(0); }
#pragma unroll
                  for (int r = 0; r < 4; ++r) { const int l = 16 * w + 4 * lq + r; const float gv = (s <= l) ? cbv[r] * __expf(csl[r] - css) : 0.f;
                      *(LAS unsigned short*)(L + S3_GY + l * SSD_PITCH + s * 2) = (unsigned short)f2bf(gv); } } }
            LDS_WAIT(); asm volatile("" ::: "memory");
            SPR_T(s3) SPR_ACC(2, s3 - s2)
            f32x4 yd[4], yo[4];
#pragma unroll
            for (int pb = 0; pb < 4; ++pb) { yd[pb] = (f32x4){0.f, 0.f, 0.f, 0.f}; yo[pb] = (f32x4){0.f, 0.f, 0.f, 0.f}; }
            { bf16x8 gq[2], xq[2][4];
              gq[0] = lds_frag(L + S3_GY, 16 * w + li, 16 * lq);
#pragma unroll
              for (int pb = 0; pb < 4; ++pb) xq[0][pb] = lds_frag_tr(L + S3_XDT, S3_XP, 0, 16 * pb, li, lq);
#pragma unroll
              for (int ks = 0; ks < 4; ++ks) if (ks <= (w >> 1)) {
                  if (ks + 1 <= (w >> 1)) { gq[(ks + 1) & 1] = lds_frag(L + S3_GY, 16 * w + li, 64 * (ks + 1) + 16 * lq);
#pragma unroll
                      for (int pb = 0; pb < 4; ++pb) xq[(ks + 1) & 1][pb] = lds_frag_tr(L + S3_XDT, S3_XP, 32 * (ks + 1), 16 * pb, li, lq); }
                  __builtin_amdgcn_sched_barrier(0);
#pragma unroll
                  for (int pb = 0; pb < 4; ++pb) yd[pb] = __builtin_amdgcn_mfma_f32_16x16x32_bf16(gq[ks & 1], xq[ks & 1][pb], yd[pb], 0, 0, 0);
                  __builtin_amdgcn_sched_barrier(0); } }
            { bf16x8 pq[2][4];
#pragma unroll
              for (int pb = 0; pb < 4; ++pb) pq[0][pb] = lds_frag(L + S3_PREV, 16 * pb + li, 16 * lq);
#pragma unroll
              for (int ks = 0; ks < 4; ++ks) {
                  if (ks < 3) {
#pragma unroll
                      for (int pb = 0; pb < 4; ++pb) pq[(ks + 1) & 1][pb] = lds_frag(L + S3_PREV, 16 * pb + li, 64 * (ks + 1) + 16 * lq); }
                  __builtin_amdgcn_sched_barrier(0);
#pragma unroll
                  for (int pb = 0; pb < 4; ++pb) yo[pb] = __builtin_amdgcn_mfma_f32_16x16x32_bf16(ca[ks], pq[ks & 1][pb], yo[pb], 0, 0, 0);
                  __builtin_amdgcn_sched_barrier(0); } }
#pragma unroll
            for (int r = 0; r < 4; ++r) { const float e = __expf(csl[r]);
#pragma unroll
                for (int pb = 0; pb < 4; ++pb) *(LAS float*)(L + S3_GY + (16 * w + 4 * lq + r) * SSD_PITCH + (16 * pb + li) * 4) = yd[pb][r] + e * yo[pb][r]; }
            { const size_t rown = row0 + (c + 1 < SEQ / CHUNK ? CHUNK : 0);
              ssd3_prefetch(P, (const char*)xc + rown * 4096, dtraw + rown * 16 + h, voB, voX, tid, lane, w); }
            SPR_T(s4) SPR_ACC(3, s4 - s3)
            LDS_BARRIER();
            SPR_T(s5) SPR_ACC(4, s5 - s4)
            { const float dec = __expf(cs_end);
#pragma unroll
              for (int j = 0; j < 4; ++j) st[j] = st[j] * dec;
              bf16x8 xq[2], bq2[2][4]; f32x4 wq[2][2];
              xq[0] = lds_frag_tr(L + S3_XDT, S3_XP, 0, 16 * pbs, li, lq); wq[0][0] = *(const LAS f32x4*)(wts + 8 * lq); wq[0][1] = *(const LAS f32x4*)(wts + 8 * lq + 4);
#pragma unroll
              for (int j = 0; j < 4; ++j) bq2[0][j] = lds_frag_tr(L + S3_BS, SSD_PITCH, 0, 16 * (nb0 + j), li, lq);
#pragma unroll
              for (int ks = 0; ks < 4; ++ks) {
                  if (ks < 3) { xq[(ks + 1) & 1] = lds_frag_tr(L + S3_XDT, S3_XP, 32 * (ks + 1), 16 * pbs, li, lq); wq[(ks + 1) & 1][0] = *(const LAS f32x4*)(wts + 32 * (ks + 1) + 8 * lq); wq[(ks + 1) & 1][1] = *(const LAS f32x4*)(wts + 32 * (ks + 1) + 8 * lq + 4);
#pragma unroll
                      for (int j = 0; j < 4; ++j) bq2[(ks + 1) & 1][j] = lds_frag_tr(L + S3_BS, SSD_PITCH, 32 * (ks + 1), 16 * (nb0 + j), li, lq); }
                  __builtin_amdgcn_sched_barrier(0);
                  const f32x4 w0 = wq[ks & 1][0], w1 = wq[ks & 1][1];
                  float xv[8]; unpack8(__builtin_bit_cast(v4u, xq[ks & 1]), xv);
                  const v4u xw = (v4u){pk2(xv[0] * w0[0], xv[1] * w0[1]), pk2(xv[2] * w0[2], xv[3] * w0[3]), pk2(xv[4] * w1[0], xv[5] * w1[1]), pk2(xv[6] * w1[2], xv[7] * w1[3])};
                  const bf16x8 xf = __builtin_bit_cast(bf16x8, xw);
#pragma unroll
                  for (int j = 0; j < 4; ++j) st[j] = __builtin_amdgcn_mfma_f32_16x16x32_bf16(xf, bq2[ks & 1][j], st[j], 0, 0, 0);
                  __builtin_amdgcn_sched_barrier(0); }
#pragma unroll
              for (int j = 0; j < 4; ++j)
#pragma unroll
                  for (int r = 0; r < 4; ++r) *(LAS unsigned short*)(L + S3_PREV + (16 * pbs + 4 * lq + r) * SSD_PITCH + (16 * (nb0 + j) + li) * 2) = (unsigned short)f2bf(st[j][r]); }
            SPR_T(s6) SPR_ACC(5, s6 - s5)
#pragma unroll
            for (int k = 0; k < 2; ++k) { const int it = tid + 512 * k, l = it >> 3, o = it & 7; const size_t row = row0 + l;
                const f32x4 y0 = *(const LAS f32x4*)(L + S3_GY + l * SSD_PITCH + 32 * o), y1 = *(const LAS f32x4*)(L + S3_GY + l * SSD_PITCH + 32 * o + 16);
                const v4u xw = *(const LAS v4u*)(L + S3_XDT + l * S3_XP + 16 * o); const v4u zw = k == 0 ? zc0 : zc1; const float dsk = Dh * __builtin_amdgcn_rcpf(fmaxf(dtf[l], 1e-30f));
                float xv[8], zv[8], yv[8]; unpack8(xw, xv); unpack8(zw, zv);
                float ss = 0.f;
#pragma unroll
                for (int e = 0; e < 8; ++e) { const float yy = (e < 4 ? y0[e] : y1[e - 4]) + dsk * xv[e]; yv[e] = yy * silu_f(zv[e]); ss += yv[e] * yv[e]; }
                ss += __shfl_xor(ss, 1); ss += __shfl_xor(ss, 2); ss += __shfl_xor(ss, 4);
                if (o == 0) WSP(float, WS_STSSD)[row * 16 + h] = ss;
                *(v4u*)(WSP(bf16, WS_Y) + row * 2048 + h * 64 + 8 * o) = (v4u){pk2(yv[0], yv[1]), pk2(yv[2], yv[3]), pk2(yv[4], yv[5]), pk2(yv[6], yv[7])}; }
            if (w == 0 && c + 1 < SEQ / CHUNK) ssd3_cumsum(L, par ^ 1, P.d0, P.d1, dtb, A, lane);
            SPR_T(s7) SPR_ACC(6, s7 - s6)
            LDS_BARRIER();
            SPR_T(s8) SPR_ACC(7, s8 - s7)
        }
#ifdef PROBE_SSD
        if (blockIdx.x == 0 && threadIdx.x == PROBE_TID) *(volatile float*)(F.ws + WS_CTL + 40000) = (float)sacc[PROBE_SSD] * 1e-3f;
#endif
    }
}
typedef float f32x16 __attribute__((ext_vector_type(16)));
#ifdef PROBE_SEL
#define PR_T(v) const unsigned long long v = __builtin_amdgcn_s_memtime();
#define PR_ACC(a, d) a += (d);
#define PR_OUT(i, a) if (PROBE_SEL == (i) && blockIdx.x == 0 && threadIdx.x == 0) *(volatile float*)(F.ws + WS_CTL + 40000) = (float)(a) * 1e-4f;
#define PR_OUT4(i, a) if (PROBE_SEL == (i) && blockIdx.x == 0 && threadIdx.x == 256) *(volatile float*)(F.ws + WS_CTL + 40000) = (float)(a) * 1e-4f;
#else
#define PR_T(v)
#define PR_ACC(a, d)
#define PR_OUT(i, a)
#define PR_OUT4(i, a)
#endif
constexpr int S5V_BU = 0, S5V_BUP = 2056, S5V_BUSZ = 16 * S5V_BUP, S5V_XT = 2 * S5V_BUSZ, S5V_XTP = 1040, S5V_XTSZ = 16 * S5V_XTP, S5V_VS = S5V_XT + 2 * S5V_XTSZ, S5V_OT = S5V_VS + 4 * 512, S5V_OTP = 144, S5V_OTSZ = 16 * S5V_OTP, S5V_END = S5V_OT + 2 * S5V_OTSZ;
static_assert(S5V_END <= LDS_MAIN, "S5 v2 LDS map");
__device__ __forceinline__ void p3_s5v2(Frame& F) {
    const int tid = threadIdx.x, lane = tid & 63, w = __builtin_amdgcn_readfirstlane(tid >> 6);
    const int li = lane & 15, lq = lane >> 4;
    LAS unsigned char* L = F.lds;
    const bf16* proj = WSP(bf16, WS_PROJ);
    constexpr int NT = SEQ / 16;
#ifdef PROBE_S5
    const unsigned long long pr_t0 = PROBE_CLOCK();
#endif
    for (int item = F.vcu; item < NB * 16; item += F.G) {
        const int b = item >> 4, gs = item & 15;
        const bool scanw = w < 4; const int gl = w & 3, g = gs * 4 + gl;
        const bf16* ubase = proj + (size_t)b * SEQ * NPROJ + 3072 + gs * 64 + gl * 16;
        __syncthreads();
        if (scanw) {
            __builtin_amdgcn_s_setprio(2);
            const float lbr = WSP(float, WS_S5LB)[(g * 64 + lane) * 2], lbi = WSP(float, WS_S5LB)[(g * 64 + lane) * 2 + 1], nlbi = -lbi;
            bf16x8 bfr[8];
#pragma unroll
            for (int cb = 0; cb < 8; ++cb) { v4u v = (v4u){0u, 0u, 0u, 0u};
                if (lq < 2) { const int col = 16 * cb + li; const float* src = WSP(float, WS_S5BB) + (g * 64 + (col >> 1)) * 32 + (col & 1) * 16 + 8 * lq; const f32x4 a0 = *(const f32x4*)src, a1 = *(const f32x4*)(src + 4);
                    v = (v4u){pk2(a0[0], a0[1]), pk2(a0[2], a0[3]), pk2(a1[0], a1[1]), pk2(a1[2], a1[3])}; }
                bfr[cb] = __builtin_bit_cast(bf16x8, v); }
            float xr = 0.f, xi = 0.f;
            const int lq2 = lq & 1;
            v4u ua = *(const v4u*)(ubase + (size_t)li * NPROJ + 8 * lq2);
            { const bf16x8 af = __builtin_bit_cast(bf16x8, lq < 2 ? ua : (v4u){0u, 0u, 0u, 0u});
              ua = *(const v4u*)(ubase + (size_t)(16 + li) * NPROJ + 8 * lq2);
#pragma unroll
              for (int cb = 0; cb < 8; ++cb) { f32x4 acc = (f32x4){0.f, 0.f, 0.f, 0.f}; acc = __builtin_amdgcn_mfma_f32_16x16x32_bf16(af, bfr[cb], acc, 0, 0, 0);
#pragma unroll
                  for (int r = 0; r < 4; ++r) *(LAS float*)(L + S5V_BU + (4 * lq + r) * S5V_BUP + (gl * 128 + 16 * cb + li) * 4) = acc[r]; } }
            LDS_BARRIER();
            unsigned long long pa0 = 0, pa1 = 0, pa2 = 0;
            for (int k = 0; k <= NT; ++k) {
                PR_T(pt0)
                if (k < NT) {
                    const LAS f32x2* bp = (const LAS f32x2*)(L + S5V_BU + (k & 1) * S5V_BUSZ + (gl * 128 + 2 * lane) * 4);
                    LAS unsigned* xp = (LAS unsigned*)(L + S5V_XT + (k & 1) * S5V_XTSZ + (gl * 128 + 2 * lane) * 2);
                    f32x2 bu[16];
#pragma unroll
                    for (int t = 0; t < 16; ++t) bu[t] = bp[t * (S5V_BUP / 8)];
                    unsigned xo[16];
#pragma unroll
                    for (int t = 0; t < 16; ++t) {
                        const float a = __builtin_fmaf(nlbi, xi, bu[t][0]), bq = __builtin_fmaf(lbi, xr, bu[t][1]);
                        const float nr = __builtin_fmaf(lbr, xr, a), ni = __builtin_fmaf(lbr, xi, bq); xr = nr; xi = ni; xo[t] = pk2(xr, xi); }
#pragma unroll
                    for (int t = 0; t < 16; ++t) xp[t * (S5V_XTP / 4)] = xo[t];
                    PR_T(pt1) PR_ACC(pa0, pt1 - pt0)
                    if (k + 1 < NT) {
                        const bf16x8 af = __builtin_bit_cast(bf16x8, lq < 2 ? ua : (v4u){0u, 0u, 0u, 0u});
                        { const int kn = k + 2 < NT ? k + 2 : NT - 1; ua = *(const v4u*)(ubase + (size_t)(16 * kn + li) * NPROJ + 8 * lq2); }
                        LAS unsigned char* bun = L + S5V_BU + ((k + 1) & 1) * S5V_BUSZ;
#pragma unroll
                        for (int cb = 0; cb < 8; ++cb) { f32x4 acc = (f32x4){0.f, 0.f, 0.f, 0.f}; acc = __builtin_amdgcn_mfma_f32_16x16x32_bf16(af, bfr[cb], acc, 0, 0, 0);
#pragma unroll
                            for (int r = 0; r < 4; ++r) *(LAS float*)(bun + (4 * lq + r) * S5V_BUP + (gl * 128 + 16 * cb + li) * 4) = acc[r]; }
                    }
                }
                PR_T(pt2) PR_ACC(pa1, pt2 - pt0)
                LDS_BARRIER();
                PR_T(pt3) PR_ACC(pa2, pt3 - pt2)
            }
            __builtin_amdgcn_s_setprio(0);
            PR_OUT(0, pa0) PR_OUT(1, pa1) PR_OUT(2, pa2)
        } else {
            bf16x8 cfr[4];
#pragma unroll
            for (int ks = 0; ks < 4; ++ks) { const float* cr = (F.a->in[17]) + (g * 16 + li) * 64 + 16 * ks + 4 * lq; const float* ci = (F.a->in[18]) + (g * 16 + li) * 64 + 16 * ks + 4 * lq;
                const f32x4 r0 = *(const f32x4*)cr, i0 = *(const f32x4*)ci;
                cfr[ks] = __builtin_bit_cast(bf16x8, ((v4u){pk2(r0[0], -i0[0]), pk2(r0[1], -i0[1]), pk2(r0[2], -i0[2]), pk2(r0[3], -i0[3])})); }
            v4u gwv = (v4u){0u, 0u, 0u, 0u};
            if (lq < 2) { float gwf[8];
#pragma unroll
                for (int j = 0; j < 8; ++j) gwf[j] = (F.a->in[20])[(g * 16 + 8 * lq + j) * 16 + li];
                gwv = (v4u){pk2(gwf[0], gwf[1]), pk2(gwf[2], gwf[3]), pk2(gwf[4], gwf[5]), pk2(gwf[6], gwf[7])}; }
            const bf16x8 gfr = __builtin_bit_cast(bf16x8, gwv);
            const float dsk = (F.a->in[19])[g * 16 + li], gbias = (F.a->in[21])[g * 16 + li];
            LAS unsigned char* vs = L + S5V_VS + gl * 512;
            float uo[4], un[4];
#pragma unroll
            for (int r = 0; r < 4; ++r) { uo[r] = bf2f(ubase[(size_t)(4 * lq + r) * NPROJ + li]); un[r] = bf2f(ubase[(size_t)(16 + 4 * lq + r) * NPROJ + li]); }
            LDS_BARRIER();
            unsigned long long pb0 = 0, pb1 = 0;
            for (int k = 0; k <= NT; ++k) {
                PR_T(qt0)
                float u2[4];
                { const int kn = k + 1 < NT ? k + 1 : NT - 1;
#pragma unroll
                  for (int r = 0; r < 4; ++r) u2[r] = bf2f(ubase[(size_t)(16 * kn + 4 * lq + r) * NPROJ + li]); }
                if (k >= 2) {
                    const int t = ((tid - 256) >> 3) & 15, oc = tid & 7; const v4u ov = *(const LAS v4u*)(L + S5V_OT + (k & 1) * S5V_OTSZ + t * S5V_OTP + 16 * oc);
                    if (tid < 384) *(v4u*)(WSP(bf16, WS_Y) + ((size_t)b * SEQ + 16 * (k - 2) + t) * 2048 + 1024 + gs * 64 + 8 * oc) = ov; }
                if (k >= 1) {
                    const int kt = k - 1; const LAS unsigned char* xt = L + S5V_XT + (kt & 1) * S5V_XTSZ;
                    f32x4 yacc = (f32x4){0.f, 0.f, 0.f, 0.f};
#pragma unroll
                    for (int ks = 0; ks < 4; ++ks) yacc = __builtin_amdgcn_mfma_f32_16x16x32_bf16(*(const LAS bf16x8*)(xt + li * S5V_XTP + (gl * 128 + 32 * ks + 8 * lq) * 2), cfr[ks], yacc, 0, 0, 0);
                    float v[4];
                    { const f32x2 g0 = gelu_pk2((f32x2){yacc[0] + dsk * uo[0], yacc[1] + dsk * uo[1]}), g1 = gelu_pk2((f32x2){yacc[2] + dsk * uo[2], yacc[3] + dsk * uo[3]}); v[0] = g0[0]; v[1] = g0[1]; v[2] = g1[0]; v[3] = g1[1]; }
#pragma unroll
                    for (int r = 0; r < 4; ++r) *(LAS unsigned short*)(vs + (4 * lq + r) * 32 + li * 2) = (unsigned short)f2bf(v[r]);
                    LDS_WAIT(); asm volatile("" ::: "memory");
                    v4u va = (v4u){0u, 0u, 0u, 0u};
                    if (lq < 2) va = *(const LAS v4u*)(vs + li * 32 + 16 * lq);
                    f32x4 gacc = (f32x4){0.f, 0.f, 0.f, 0.f};
                    gacc = __builtin_amdgcn_mfma_f32_16x16x32_bf16(__builtin_bit_cast(bf16x8, va), gfr, gacc, 0, 0, 0);
                    float o[4], ss[4];
#pragma unroll
                    for (int r = 0; r < 4; ++r) { o[r] = v[r] * sigmoid_f(gacc[r] + gbias); ss[r] = o[r] * o[r]; }
#pragma unroll
                    for (int r = 0; r < 4; ++r) ss[r] = row16_sum_to15(ss[r]);
                    if (li == 15) {
#pragma unroll
                        for (int r = 0; r < 4; ++r) WSP(float, WS_STS5)[((size_t)b * SEQ + 16 * kt + 4 * lq + r) * NS5PART + g] = ss[r]; }
                    LAS unsigned char* ot = L + S5V_OT + (kt & 1) * S5V_OTSZ;
#pragma unroll
                    for (int r = 0; r < 4; ++r) *(LAS unsigned short*)(ot + (4 * lq + r) * S5V_OTP + (gl * 16 + li) * 2) = (unsigned short)f2bf(o[r]);
#pragma unroll
                    for (int r = 0; r < 4; ++r) { uo[r] = un[r]; un[r] = u2[r]; }
                }
                PR_T(qt1) PR_ACC(pb0, qt1 - qt0)
                LDS_BARRIER();
                PR_T(qt2) PR_ACC(pb1, qt2 - qt1)
            }
            PR_OUT4(3, pb0) PR_OUT4(4, pb1)
            { const int t = ((tid - 256) >> 3) & 15, oc = tid & 7; const v4u ov = *(const LAS v4u*)(L + S5V_OT + ((NT - 1) & 1) * S5V_OTSZ + t * S5V_OTP + 16 * oc);
              if (tid < 384) *(v4u*)(WSP(bf16, WS_Y) + ((size_t)b * SEQ + 16 * (NT - 1) + t) * 2048 + 1024 + gs * 64 + 8 * oc) = ov; }
        }
    }
#ifdef PROBE_S5
    if (blockIdx.x == 0 && threadIdx.x == 0) *(volatile float*)(F.ws + WS_CTL + 40000) = (float)(PROBE_CLOCK() - pr_t0) * PROBE_SCALE;
#endif
}
__device__ __forceinline__ unsigned med3u(unsigned a, unsigned b, unsigned c) { unsigned r; asm("v_med3_u32 %0, %1, %2, %3" : "=v"(r) : "v"(a), "v"(b), "v"(c)); return r; }
__device__ __forceinline__ unsigned fkey(float v) { const unsigned u = __builtin_bit_cast(unsigned, v); return (u & 0x80000000u) ? ~u : (u | 0x80000000u); }
__device__ __forceinline__ float fkey_inv(unsigned k) { const unsigned u = (k & 0x80000000u) ? (k & 0x7fffffffu) : ~k; return __builtin_bit_cast(float, u); }
#define TOPK_INSERT(a, x) do { _Pragma("unroll") for (int _i = 15; _i >= 1; --_i) a[_i] = med3u(a[_i - 1], a[_i], (x)); a[0] = a[0] > (x) ? a[0] : (x); } while (0)
__device__ __forceinline__ unsigned fp6_code(float y) {
    const float a = fabsf(y);
    const float c = a < 2.0f ? __builtin_rintf(8.0f * a) : (a < 4.0f ? __builtin_rintf(4.0f * a) + 8.0f : fminf(__builtin_rintf(2.0f * a) + 16.0f, 31.0f));
    return (unsigned)c | (y < 0.f ? 32u : 0u);
}
__device__ __forceinline__ void fp6_pack16(const unsigned* c, unsigned& w0, unsigned& w1, unsigned& w2) {
    w0 = c[0] | (c[1] << 6) | (c[2] << 12) | (c[3] << 18) | (c[4] << 24) | (c[5] << 30);
    w1 = (c[5] >> 2) | (c[6] << 4) | (c[7] << 10) | (c[8] << 16) | (c[9] << 22) | (c[10] << 28);
    w2 = (c[10] >> 4) | (c[11] << 2) | (c[12] << 8) | (c[13] << 14) | (c[14] << 20) | (c[15] << 26);
}
__device__ __forceinline__ void h2_convert(Frame& F, int w0, int nw, int f_lane) {
    for (int tb = w0 * 16; tb < MTOK; tb += nw * 16) {
        const float* sh = WSP(float, WS_MOD) + (size_t)(tb >> 11) * 6144 + 3072 + 16 * f_lane;
        float S2[16];
#pragma unroll
        for (int q = 0; q < 4; ++q) { const f32x4 s4 = *(const f32x4*)(sh + 4 * q); S2[4 * q] = s4[0]; S2[4 * q + 1] = s4[1]; S2[4 * q + 2] = s4[2]; S2[4 * q + 3] = s4[3]; }
#pragma unroll 1
        for (int k = 0; k < 16; k += 4) {
            v4u xa[4], xb[4]; float rst[4];
#pragma unroll
            for (int u = 0; u < 4; ++u) { const int t = tb + k + u; const char* xs = (const char*)(WSP(bf16, WS_X1S) + (size_t)t * 1024) + 32 * f_lane; xa[u] = *(const v4u*)xs; xb[u] = *(const v4u*)(xs + 16); rst[u] = WSP(float, WS_ROWSTAT)[t]; }
#pragma unroll
            for (int u = 0; u < 4; ++u) { const int t = tb + k + u;
                const float rs = rsqrt_f(rst[u] * (1.0f / 1024.0f) + EPSF);
                float h2[16]; unpack8(xa[u], h2); unpack8(xb[u], h2 + 8); float mx = 0.f;
#pragma unroll
                for (int i = 0; i < 16; ++i) { h2[i] = h2[i] * rs + S2[i]; mx = fmaxf(mx, fabsf(h2[i])); }
#pragma unroll
                for (int o = 1; o < 64; o <<= 1) mx = fmaxf(mx, __shfl_xor(mx, o));
                mx = fmaxf(mx, 1e-30f); const float hs = 224.0f / mx;
                v4u w;
#pragma unroll
                for (int q = 0; q < 4; ++q) { int pk = 0; pk = __builtin_amdgcn_cvt_pk_fp8_f32(h2[4 * q] * hs, h2[4 * q + 1] * hs, pk, false); pk = __builtin_amdgcn_cvt_pk_fp8_f32(h2[4 * q + 2] * hs, h2[4 * q + 3] * hs, pk, true); w[q] = (unsigned)pk; }
                *(v4u*)(F.ws + WS_H2Q + (size_t)t * 1024 + 16 * f_lane) = w;
                if (f_lane == 0) WSP(float, WS_HINV)[t] = mx * (1.0f / 224.0f); }
        }
    }
}
__device__ __forceinline__ void expert_convert(Frame& F, int w0, int nw, int f_lane) {
    for (int rw = w0; rw < 2 * 16384; rw += 2 * nw) {
        f32x4 v[2][4]; float mx[2];
#pragma unroll
        for (int u = 0; u < 2; ++u) { const int r = rw + u * nw; const int tb = r >= 16384, e = tb ? r - 16384 : r; const float* src = (tb ? (F.a->in[28]) : (F.a->in[27])) + (size_t)e * 1024 + 16 * f_lane;
#pragma unroll
            for (int q = 0; q < 4; ++q) v[u][q] = *(const f32x4*)(src + 4 * q); }
#pragma unroll
        for (int u = 0; u < 2; ++u) { float m = 0.f;
#pragma unroll
            for (int q = 0; q < 4; ++q) m = fmaxf(m, fmaxf(fmaxf(fabsf(v[u][q][0]), fabsf(v[u][q][1])), fmaxf(fabsf(v[u][q][2]), fabsf(v[u][q][3]))));
#pragma unroll
            for (int o = 1; o < 64; o <<= 1) m = fmaxf(m, __shfl_xor(m, o));
            mx[u] = fmaxf(m, 1e-30f); }
#pragma unroll
        for (int u = 0; u < 2; ++u) { const int r = rw + u * nw; const int tb = r >= 16384, e = tb ? r - 16384 : r; const float sc = 224.0f / mx[u];
            v4u w;
#pragma unroll
            for (int q = 0; q < 4; ++q) { int pk = 0; pk = __builtin_amdgcn_cvt_pk_fp8_f32(v[u][q][0] * sc, v[u][q][1] * sc, pk, false); pk = __builtin_amdgcn_cvt_pk_fp8_f32(v[u][q][2] * sc, v[u][q][3] * sc, pk, true); w[q] = (unsigned)pk; }
#ifdef V6
#if defined(UP12) || defined(UP14)
            {
#else
            if (tb) {
#endif
                const float s6 = 7.5f / mx[u]; unsigned cd[16];
#pragma unroll
                for (int q = 0; q < 4; ++q)
#pragma unroll
                    for (int i = 0; i < 4; ++i) cd[4 * q + i] = fp6_code(v[u][q][i] * s6);
                unsigned w0, w1, w2; fp6_pack16(cd, w0, w1, w2);
                unsigned* dst = (unsigned*)(F.ws + (tb ? WS_EV : WS_EU) + (size_t)e * 768 + 12 * f_lane); dst[0] = w0; dst[1] = w1; dst[2] = w2;
                if (f_lane == 0) WSP(float, tb ? WS_EVS : WS_EUS)[e] = mx[u] * (1.0f / 7.5f);
                continue; }
#endif
            *(v4u*)(F.ws + (tb ? WS_EV : WS_EU) + (size_t)e * 1024 + 16 * f_lane) = w;
            if (f_lane == 0) WSP(float, tb ? WS_EVS : WS_EUS)[e] = mx[u] * (1.0f / 224.0f); }
    }
}
__device__ __forceinline__ void p5b_topk(Frame& F) {
    const int f_tid = threadIdx.x, f_lane = f_tid & 63, f_wave = __builtin_amdgcn_readfirstlane(f_tid >> 6);
    const _Float16* scores = WSP(_Float16, WS_SCORES);
    LAS unsigned char* ix = (LAS unsigned char*)F.lds + f_tid * 36;
#pragma unroll 1
    for (int half = 0; half < 2; ++half) {
#ifdef UP11
    if ((f_wave >> 2) != half) { expert_convert(F, (F.vcu * 4 + (f_wave & 3)) * 2 + half, F.G * 8, f_lane); h2_convert(F, (F.vcu * 4 + (f_wave & 3)) * 2 + half, F.G * 8, f_lane); continue; }
#else
    if ((f_wave >> 2) != half) { expert_convert(F, (F.vcu * 4 + (f_wave & 3)) * 2 + half, F.G * 8, f_lane); continue; }
#endif
    typedef _Float16 f16x8 __attribute__((ext_vector_type(8)));
    f16x8 sva[8], svb[8];
    { const int item0 = (F.vcu * 2 + half) * 256 + (f_tid & 255); const _Float16* sp0 = scores + (size_t)(item0 >> 3) * 2048 + (item0 & 7) * 256;
#pragma unroll
      for (int q = 0; q < 8; ++q) sva[q] = *(const f16x8*)(sp0 + 8 * q); }
#pragma unroll 1
    for (int item = (F.vcu * 2 + half) * 256 + (f_tid & 255); item < MTOK * PH; item += F.G * 512) {
        const int t = item >> 3, hd = item & 7;
        unsigned a1[16], a2[16];
#pragma unroll
        for (int i = 0; i < 16; ++i) { a1[i] = 0u; a2[i] = 0u; }
        const _Float16* sp = scores + (size_t)t * 2048 + hd * 256;
        const int itn = (item + F.G * 512 < MTOK * PH) ? item + F.G * 512 : item;
        const _Float16* spn = scores + (size_t)(itn >> 3) * 2048 + (itn & 7) * 256;
#define TK_BATCH(CUR, NXT, NP, A, M) { \
        { _Pragma("unroll") for (int q = 0; q < 8; ++q) NXT[q] = *(const f16x8*)((NP) + 8 * q); } \
        __builtin_amdgcn_sched_barrier(0); \
        _Pragma("unroll") for (int q = 0; q < 8; ++q) { _Pragma("unroll") for (int e = 0; e < 8; ++e) { const unsigned k = (fkey((float)CUR[q][e]) & ~127u) | (unsigned)(127 - (64 * (M) + 8 * q + e)); TOPK_INSERT(A, k); } } }
        TK_BATCH(sva, svb, sp + 64, a1, 0)
        TK_BATCH(svb, sva, sp + 128, a1, 1)
        TK_BATCH(sva, svb, sp + 192, a2, 0)
        TK_BATCH(svb, sva, spn, a2, 1)
#undef TK_BATCH
        float v1[16], v2[16];
#pragma unroll
        for (int i = 0; i < 16; ++i) { ix[i] = (unsigned char)(127u - (a1[i] & 127u)); ix[16 + i] = (unsigned char)(127u - (a2[i] & 127u)); v1[i] = fkey_inv(a1[i] & ~127u); v2[i] = fkey_inv(a2[i] & ~127u); }
        unsigned cb[16];
#pragma unroll
        for (int i = 0; i < 16; ++i) cb[i] = 0u;
#pragma unroll
        for (int i = 0; i < 16; ++i)
#pragma unroll
            for (int j = 0; j < 16; ++j) if ((i + 1) * (j + 1) <= 16) { const unsigned k = (fkey(v1[i] + v2[j]) & ~255u) | (unsigned)(255 - (i * 16 + j)); TOPK_INSERT(cb, k); }
        float tv[16]; float mx = -3.0e38f;
#pragma unroll
        for (int k = 0; k < 16; ++k) { tv[k] = fkey_inv(cb[k] & ~255u); mx = fmaxf(mx, tv[k]); }
        float sum = 0.f;
#pragma unroll
        for (int k = 0; k < 16; ++k) { tv[k] = __expf(tv[k] - mx); sum += tv[k]; }
        const float inv = 1.0f / sum;
        LDS_WAIT(); asm volatile("" ::: "memory");
        int ev[16]; unsigned long long c64 = 0ull;
#pragma unroll
        for (int k = 0; k < 16; ++k) { const unsigned code = 255u - (cb[k] & 255u); const int i = code >> 4, j = code & 15; ev[k] = (int)ix[i] * 128 + (int)ix[16 + j]; c64 += 1ull << (8 * (ev[k] >> 11)); }
        unsigned long long s64 = c64;
#pragma unroll
        for (int o = 1; o < 8; o <<= 1) { const unsigned lo = __shfl_up((unsigned)s64, o, 8), hi = __shfl_up((unsigned)(s64 >> 32), o, 8); if ((f_lane & 7) >= o) s64 += ((unsigned long long)hi << 32) | lo; }
        const unsigned long long e64 = s64 - c64;
        const unsigned long long t64 = ((unsigned long long)__shfl((unsigned)(s64 >> 32), 7, 8) << 32) | __shfl((unsigned)s64, 7, 8);
        const unsigned long long st64 = (t64 * 0x0101010101010101ull) << 8;
        unsigned long long base64 = st64 + e64;
        int* eo = WSP(int, WS_EID) + (size_t)t * 128; float* go = WSP(float, WS_GATE) + (size_t)t * 128;
#pragma unroll
        for (int k = 0; k < 16; ++k) { const int r8 = 8 * (ev[k] >> 11); const int slot = (int)((base64 >> r8) & 255ull); base64 += 1ull << r8; eo[slot] = ev[k]; go[slot] = tv[k] * inv; }
        if (hd == 0) WSP(unsigned long long, WS_START)[t] = st64;
        LDS_WAIT(); asm volatile("" ::: "memory");
    }
    }
}
__device__ __forceinline__ void dec16(const v4u q, float* f) {
#pragma unroll
    for (int i = 0; i < 4; ++i) { const f32x2 lo = __builtin_amdgcn_cvt_pk_f32_fp8((int)q[i], false), hi = __builtin_amdgcn_cvt_pk_f32_fp8((int)q[i], true); f[4 * i] = lo[0]; f[4 * i + 1] = lo[1]; f[4 * i + 2] = hi[0]; f[4 * i + 3] = hi[1]; }
}
struct CvE { f32x4 v[4]; };
struct CvH { v4u xa, xb; float rst; };
__device__ __forceinline__ void cve_load(CvE& c, Frame& F, int r, int f_lane) {
    const int tb = r >= 16384, e = tb ? r - 16384 : r; const float* src = (tb ? (F.a->in[28]) : (F.a->in[27])) + (size_t)e * 1024 + 16 * f_lane;
#pragma unroll
    for (int q = 0; q < 4; ++q) c.v[q] = *(const f32x4*)(src + 4 * q);
}
__device__ __forceinline__ void cve_finish(const CvE& c, Frame& F, int r, int f_lane) {
    const int tb = r >= 16384, e = tb ? r - 16384 : r; float m = 0.f;
#pragma unroll
    for (int q = 0; q < 4; ++q) m = fmaxf(m, fmaxf(fmaxf(fabsf(c.v[q][0]), fabsf(c.v[q][1])), fmaxf(fabsf(c.v[q][2]), fabsf(c.v[q][3]))));
#pragma unroll
    for (int o = 1; o < 64; o <<= 1) m = fmaxf(m, __shfl_xor(m, o));
    m = fmaxf(m, 1e-30f); const float sc = 224.0f / m;
    v4u w;
#pragma unroll
    for (int q = 0; q < 4; ++q) { int pk = 0; pk = __builtin_amdgcn_cvt_pk_fp8_f32(c.v[q][0] * sc, c.v[q][1] * sc, pk, false); pk = __builtin_amdgcn_cvt_pk_fp8_f32(c.v[q][2] * sc, c.v[q][3] * sc, pk, true); w[q] = (unsigned)pk; }
    *(v4u*)(F.ws + (tb ? WS_EV : WS_EU) + (size_t)e * 1024 + 16 * f_lane) = w;
    if (f_lane == 0) WSP(float, tb ? WS_EVS : WS_EUS)[e] = m * (1.0f / 224.0f);
}
__device__ __forceinline__ void cvh_load(CvH& c, Frame& F, int t, int f_lane) {
    const char* xs = (const char*)(WSP(bf16, WS_X1S) + (size_t)t * 1024) + 32 * f_lane; c.xa = *(const v4u*)xs; c.xb = *(const v4u*)(xs + 16); c.rst = WSP(float, WS_ROWSTAT)[t];
}
__device__ __forceinline__ void cvh_finish(const CvH& c, Frame& F, int t, int f_lane, const float* S2) {
    const float rs = rsqrt_f(c.rst * (1.0f / 1024.0f) + EPSF);
    float h2[16]; unpack8(c.xa, h2); unpack8(c.xb, h2 + 8); float mx = 0.f;
#pragma unroll
    for (int i = 0; i < 16; ++i) { h2[i] = h2[i] * rs + S2[i]; mx = fmaxf(mx, fabsf(h2[i])); }
#pragma unroll
    for (int o = 1; o < 64; o <<= 1) mx = fmaxf(mx, __shfl_xor(mx, o));
    mx = fmaxf(mx, 1e-30f); const float hs = 224.0f / mx;
    v4u w;
#pragma unroll
    for (int q = 0; q < 4; ++q) { int pk = 0; pk = __builtin_amdgcn_cvt_pk_fp8_f32(h2[4 * q] * hs, h2[4 * q + 1] * hs, pk, false); pk = __builtin_amdgcn_cvt_pk_fp8_f32(h2[4 * q + 2] * hs, h2[4 * q + 3] * hs, pk, true); w[q] = (unsigned)pk; }
    *(v4u*)(F.ws + WS_H2Q + (size_t)t * 1024 + 16 * f_lane) = w;
    if (f_lane == 0) WSP(float, WS_HINV)[t] = mx * (1.0f / 224.0f);
}
__device__ __forceinline__ void p5b_topk2(Frame& F) {
    const int f_tid = threadIdx.x, f_lane = f_tid & 63, f_wave = __builtin_amdgcn_readfirstlane(f_tid >> 6);
    const _Float16* scores = WSP(_Float16, WS_SCORES);
    LAS unsigned char* ix = (LAS unsigned char*)F.lds + f_tid * 36;
    const int gw = F.vcu * NWAVES + f_wave;
    static_assert(MTOK * PH == 2 * 256 * NTHR && MTOK == 16 * 256 * NWAVES, "P7 v2 work split");
    float S2[16];
    { const float* sh = WSP(float, WS_MOD) + (size_t)((gw * 16) >> 11) * 6144 + 3072 + 16 * f_lane;
#pragma unroll
      for (int q = 0; q < 4; ++q) { const f32x4 s4 = *(const f32x4*)(sh + 4 * q); S2[4 * q] = s4[0]; S2[4 * q + 1] = s4[1]; S2[4 * q + 2] = s4[2]; S2[4 * q + 3] = s4[3]; } }
    typedef _Float16 f16x8 __attribute__((ext_vector_type(8)));
    const int item_base = F.vcu * NTHR + f_tid, item_step = F.G * NTHR;
    f16x8 sva[8], svb[8];
    { const _Float16* sp0 = scores + (size_t)(item_base >> 3) * 2048 + (item_base & 7) * 256;
#pragma unroll
      for (int q = 0; q < 8; ++q) sva[q] = *(const f16x8*)(sp0 + 8 * q); }
    unsigned a1[16];
#pragma unroll
    for (int i = 0; i < 16; ++i) a1[i] = 0u;
#pragma unroll 1
    for (int hi = 0; hi < 4; ++hi) {
        const int item = item_base + (hi >> 1) * item_step; const int t = item >> 3, hd = item & 7, kh = hi & 1;
        const _Float16* sp = scores + (size_t)t * 2048 + hd * 256 + kh * 128;
        const int hn = hi < 3 ? hi + 1 : hi; const int itn = item_base + (hn >> 1) * item_step;
        const _Float16* spn = scores + (size_t)(itn >> 3) * 2048 + (itn & 7) * 256 + (hn & 1) * 128;
        unsigned a2[16];
#pragma unroll
        for (int i = 0; i < 16; ++i) a2[i] = 0u;
#define TK2_BATCH(CUR, NXT, NP, M) { \
        const int ku = 2 * (2 * hi + (M)); CvE e0, e1; CvH h0, h1; \
        { _Pragma("unroll") for (int q = 0; q < 8; ++q) NXT[q] = *(const f16x8*)((NP) + 8 * q); } \
        cve_load(e0, F, gw + ku * 2048, f_lane); cve_load(e1, F, gw + (ku + 1) * 2048, f_lane); cvh_load(h0, F, gw * 16 + ku, f_lane); cvh_load(h1, F, gw * 16 + ku + 1, f_lane); \
        __builtin_amdgcn_sched_barrier(0); \
        _Pragma("unroll") for (int q = 0; q < 8; ++q) { _Pragma("unroll") for (int e = 0; e < 8; ++e) { const unsigned k = (fkey((float)CUR[q][e]) & ~127u) | (unsigned)(127 - (64 * (M) + 8 * q + e)); TOPK_INSERT(a2, k); } } \
        __builtin_amdgcn_sched_barrier(0); \
        cve_finish(e0, F, gw + ku * 2048, f_lane); cve_finish(e1, F, gw + (ku + 1) * 2048, f_lane); cvh_finish(h0, F, gw * 16 + ku, f_lane, S2); cvh_finish(h1, F, gw * 16 + ku + 1, f_lane, S2); \
        __builtin_amdgcn_sched_barrier(0); }
        TK2_BATCH(sva, svb, sp + 64, 0)
        TK2_BATCH(svb, sva, spn, 1)
#undef TK2_BATCH
        if (kh == 0) {
#pragma unroll
            for (int i = 0; i < 16; ++i) a1[i] = a2[i];
            continue;
        }
        float v1[16], v2[16];
#pragma unroll
        for (int i = 0; i < 16; ++i) { ix[i] = (unsigned char)(127u - (a1[i] & 127u)); ix[16 + i] = (unsigned char)(127u - (a2[i] & 127u)); v1[i] = fkey_inv(a1[i] & ~127u); v2[i] = fkey_inv(a2[i] & ~127u); }
        unsigned cb[16];
#pragma unroll
        for (int i = 0; i < 16; ++i) cb[i] = 0u;
#pragma unroll
        for (int i = 0; i < 16; ++i)
#pragma unroll
            for (int j = 0; j < 16; ++j) if ((i + 1) * (j + 1) <= 16) { const unsigned k = (fkey(v1[i] + v2[j]) & ~255u) | (unsigned)(255 - (i * 16 + j)); TOPK_INSERT(cb, k); }
        float tv[16]; float mx = -3.0e38f;
#pragma unroll
        for (int k = 0; k < 16; ++k) { tv[k] = fkey_inv(cb[k] & ~255u); mx = fmaxf(mx, tv[k]); }
        float sum = 0.f;
#pragma unroll
        for (int k = 0; k < 16; ++k) { tv[k] = __expf(tv[k] - mx); sum += tv[k]; }
        const float inv = 1.0f / sum;
        LDS_WAIT(); asm volatile("" ::: "memory");
        int ev[16]; unsigned long long c64 = 0ull;
#pragma unroll
        for (int k = 0; k < 16; ++k) { const unsigned code = 255u - (cb[k] & 255u); const int i = code >> 4, j = code & 15; ev[k] = (int)ix[i] * 128 + (int)ix[16 + j]; c64 += 1ull << (8 * (ev[k] >> 11)); }
        unsigned long long s64 = c64;
#pragma unroll
        for (int o = 1; o < 8; o <<= 1) { const unsigned lo = __shfl_up((unsigned)s64, o, 8), hi2 = __shfl_up((unsigned)(s64 >> 32), o, 8); if ((f_lane & 7) >= o) s64 += ((unsigned long long)hi2 << 32) | lo; }
        const unsigned long long e64 = s64 - c64;
        const unsigned long long t64 = ((unsigned long long)__shfl((unsigned)(s64 >> 32), 7, 8) << 32) | __shfl((unsigned)s64, 7, 8);
        const unsigned long long st64 = (t64 * 0x0101010101010101ull) << 8;
        unsigned long long base64 = st64 + e64;
        int* eo = WSP(int, WS_EID) + (size_t)t * 128; float* go = WSP(float, WS_GATE) + (size_t)t * 128;
#pragma unroll
        for (int k = 0; k < 16; ++k) { const int r8 = 8 * (ev[k] >> 11); const int slot = (int)((base64 >> r8) & 255ull); base64 += 1ull << r8; eo[slot] = ev[k]; go[slot] = tv[k] * inv; }
        if (hd == 0) WSP(unsigned long long, WS_START)[t] = st64;
        LDS_WAIT(); asm volatile("" ::: "memory");
    }
}
__device__ __forceinline__ void p9_peer_down2(Frame& F) {
    const int f_tid = threadIdx.x, lane = f_tid & 63, f_wave = __builtin_amdgcn_readfirstlane(f_tid >> 6);
    const unsigned char* EV = F.ws + WS_EV;
    for (int wq = F.vcu * NWAVES + f_wave; wq < MTOK / 16; wq += F.G * NWAVES) {
        const int b = wq >> 7; const float* mb = WSP(float, WS_MOD) + (size_t)b * 6144;
        int ne_lo = WSP(int, WS_EID)[(size_t)wq * 16 * 128 + lane], ne_hi = WSP(int, WS_EID)[(size_t)wq * 16 * 128 + 64 + lane];
        float nw_lo = WSP(float, WS_GATE)[(size_t)wq * 16 * 128 + lane], nw_hi = WSP(float, WS_GATE)[(size_t)wq * 16 * 128 + 64 + lane];
        for (int tt = 0; tt < 16; ++tt) {
            const size_t t = (size_t)wq * 16 + tt;
            unsigned l16 = 16u * (unsigned)lane; asm volatile("" : "+v"(l16));
            float* xr = (float*)((char*)(F.out + t * 1024) + 4u * l16);
            const int e_lo = ne_lo, e_hi = ne_hi; const float w_lo = nw_lo, w_hi = nw_hi;
            f32x2 o[8];
#pragma unroll
            for (int i = 0; i < 8; ++i) o[i] = (f32x2){0.f, 0.f};
            v4u qa[8], qb[8];
#pragma unroll
            for (int j = 0; j < 8; ++j) { const int e = __builtin_amdgcn_readlane(e_lo, j); qa[j] = *(const v4u*)(EV + ((unsigned)e * 1024u + l16)); }
#define DN2_STEP(GRP, CUR, NXT) { \
                const int grp = (GRP); const int nb = ((grp + 1) & 7) * 8; const int ensel = (grp + 1) < 8 ? e_lo : e_hi; \
                { _Pragma("unroll") for (int j = 0; j < 8; ++j) { const int e = __builtin_amdgcn_readlane(ensel, nb + j); NXT[j] = *(const v4u*)(EV + ((unsigned)e * 1024u + l16)); } } \
                __builtin_amdgcn_sched_barrier(0); \
                const int base = (grp & 7) * 8; const float wsel = grp < 8 ? w_lo : w_hi; \
                _Pragma("unroll") for (int j = 0; j < 8; ++j) { const float wj = __builtin_bit_cast(float, __builtin_amdgcn_readlane(__builtin_bit_cast(int, wsel), base + j)); const f32x2 w2 = (f32x2){wj, wj}; \
                    _Pragma("unroll") for (int i = 0; i < 4; ++i) { const f32x2 lo = __builtin_amdgcn_cvt_pk_f32_fp8((int)CUR[j][i], false), hi = __builtin_amdgcn_cvt_pk_f32_fp8((int)CUR[j][i], true); o[2 * i] += w2 * lo; o[2 * i + 1] += w2 * hi; } } }
#pragma unroll 1
            for (int g2 = 0; g2 < 16; g2 += 2) { DN2_STEP(g2, qa, qb) DN2_STEP(g2 + 1, qb, qa) }
#undef DN2_STEP
            { const size_t tn = t + (tt < 15 ? 1 : 0); ne_lo = WSP(int, WS_EID)[tn * 128 + lane]; ne_hi = WSP(int, WS_EID)[tn * 128 + 64 + lane]; nw_lo = WSP(float, WS_GATE)[tn * 128 + lane]; nw_hi = WSP(float, WS_GATE)[tn * 128 + 64 + lane]; }
            float x1[16]; float ss = 0.f;
#pragma unroll
            for (int q4 = 0; q4 < 4; ++q4) { const f32x4 v = *(const f32x4*)(xr + 4 * q4); x1[4 * q4] = v[0]; x1[4 * q4 + 1] = v[1]; x1[4 * q4 + 2] = v[2]; x1[4 * q4 + 3] = v[3]; }
#pragma unroll
            for (int q4 = 0; q4 < 4; ++q4) { const f32x4 gt = *(const f32x4*)((const char*)(mb + 5120) + 4u * l16 + 16 * q4);
#pragma unroll
                for (int e = 0; e < 4; ++e) { const int i = 4 * q4 + e; x1[i] += gt[e] * o[i >> 1][i & 1]; ss += x1[i] * x1[i]; } }
            const float rf = rsqrt_f(wave_sum(ss) * (1.0f / 1024.0f) + EPSF);
#pragma unroll
            for (int q4 = 0; q4 < 4; ++q4) { const f32x4 nf = *(const f32x4*)((const char*)(F.a->in[29]) + 4u * l16 + 16 * q4); f32x4 v;
#pragma unroll
                for (int e = 0; e < 4; ++e) v[e] = x1[4 * q4 + e] * rf * nf[e];
                *(f32x4*)(xr + 4 * q4) = v; }
        }
    }
}
typedef long i64_t;
constexpr int U6_ROWP = 1040, U6_BUF = 8 * U6_ROWP, U6_WAVE = 2 * U6_BUF + 1024;
static_assert(8 * U6_WAVE <= LDS_MAIN, "U6 LDS map");
__device__ __forceinline__ void p8_peer_up6(Frame& F) {
    const int f_tid = threadIdx.x, lane = f_tid & 63, f_wave = __builtin_amdgcn_readfirstlane(f_tid >> 6);
    const int li = lane & 15, lq = lane >> 4;
    const unsigned char* EU = F.ws + WS_EU; const float* EUS = WSP(float, WS_EUS); const float* EVS = WSP(float, WS_EVS);
    LAS unsigned char* ring = F.lds + f_wave * U6_WAVE; LAS unsigned char* hq = ring + 2 * U6_BUF;
    for (int wq = F.vcu * NWAVES + f_wave; wq < MTOK / 16; wq += F.G * NWAVES) {
        const int b = wq >> 7; const float* mb = WSP(float, WS_MOD) + (size_t)b * 6144;
        for (int tt = 0; tt < 16; ++tt) {
            const size_t t = (size_t)wq * 16 + tt;
            unsigned l16 = 16u * (unsigned)lane; asm volatile("" : "+v"(l16));
            const int e_lo = WSP(int, WS_EID)[t * 128 + lane], e_hi = WSP(int, WS_EID)[t * 128 + 64 + lane];
            const float g_lo = WSP(float, WS_GATE)[t * 128 + lane], g_hi = WSP(float, WS_GATE)[t * 128 + 64 + lane];
            const float rs = rsqrt_f(WSP(float, WS_ROWSTAT)[t] * (1.0f / 1024.0f) + EPSF);
            const char* xs = (const char*)(WSP(bf16, WS_X1S) + t * 1024) + 2u * l16; const v4u xa = *(const v4u*)xs, xb = *(const v4u*)(xs + 16);
            asm volatile("s_waitcnt vmcnt(0)" ::: "memory");
#pragma unroll
            for (int j = 0; j < 8; ++j) { const int e = __builtin_amdgcn_readlane(e_lo, j);
                __builtin_amdgcn_global_load_lds((const unsigned*)(EU + ((unsigned)e * 1024u + l16)), (LAS unsigned*)(ring + j * U6_ROWP), 16, 0, 0); }
            const float su_lo = EUS[e_lo], su_hi = EUS[e_hi], sv_lo = EVS[e_lo], sv_hi = EVS[e_hi];
            float h2[16]; unpack8(xa, h2); unpack8(xb, h2 + 8); float mx = 0.f;
#pragma unroll
            for (int qd = 0; qd < 4; ++qd) { const f32x4 sh = *(const f32x4*)((const char*)(mb + 3072) + 4u * l16 + 16 * qd);
#pragma unroll
                for (int e = 0; e < 4; ++e) { h2[4 * qd + e] = h2[4 * qd + e] * rs + sh[e]; mx = fmaxf(mx, fabsf(h2[4 * qd + e])); } }
#pragma unroll
            for (int o = 1; o < 64; o <<= 1) mx = fmaxf(mx, __shfl_xor(mx, o));
            mx = fmaxf(mx, 1e-30f); const float hs = 224.0f / mx, hinv = mx * (1.0f / 224.0f);
            { v4u w;
#pragma unroll
              for (int qd = 0; qd < 4; ++qd) { int pk = 0; pk = __builtin_amdgcn_cvt_pk_fp8_f32(h2[4 * qd] * hs, h2[4 * qd + 1] * hs, pk, false); pk = __builtin_amdgcn_cvt_pk_fp8_f32(h2[4 * qd + 2] * hs, h2[4 * qd + 3] * hs, pk, true); w[qd] = (unsigned)pk; }
              *(LAS v4u*)(hq + l16) = w; }
            LDS_WAIT(); asm volatile("" ::: "memory");
            v4u hb[16];
#pragma unroll
            for (int c = 0; c < 16; ++c) hb[c] = *(const LAS v4u*)(hq + 64 * c + 16 * lq);
            asm volatile("s_waitcnt vmcnt(0)" ::: "memory");
            float w_lo = 0.f, w_hi = 0.f;
#pragma unroll 1
            for (int u = 0; u < 16; ++u) {
                { const int un = (u + 1) & 15; const int ensel = un < 8 ? e_lo : e_hi; const int nb = (un & 7) * 8; LAS unsigned char* dst = ring + ((u + 1) & 1) * U6_BUF;
#pragma unroll
                  for (int j = 0; j < 8; ++j) { const int e = __builtin_amdgcn_readlane(ensel, nb + j);
                      __builtin_amdgcn_global_load_lds((const unsigned*)(EU + ((unsigned)e * 1024u + l16)), (LAS unsigned*)(dst + j * U6_ROWP), 16, 0, 0); } }
                asm volatile("s_waitcnt vmcnt(8)" ::: "memory");
                const LAS unsigned char* src = ring + (u & 1) * U6_BUF + (li & 7) * U6_ROWP + 16 * lq;
                f32x4 acc = (f32x4){0.f, 0.f, 0.f, 0.f};
#ifdef HALF_READ
                v4u av[16];
#pragma unroll
                for (int c = 0; c < 16; ++c) asm volatile("" : "=v"(av[c]));
                if (li < 8) {
#pragma unroll
                    for (int c = 0; c < 16; ++c) av[c] = *(const LAS v4u*)(src + 64 * c); }
#pragma unroll
                for (int c = 0; c < 16; ++c) { const v4u a = av[c];
#else
#pragma unroll
                for (int c = 0; c < 16; ++c) { const v4u a = *(const LAS v4u*)(src + 64 * c);
#endif
                    acc = __builtin_amdgcn_mfma_f32_16x16x32_fp8_fp8((i64_t)(((unsigned long long)a[1] << 32) | a[0]), (i64_t)(((unsigned long long)hb[c][1] << 32) | hb[c][0]), acc, 0, 0, 0);
                    acc = __builtin_amdgcn_mfma_f32_16x16x32_fp8_fp8((i64_t)(((unsigned long long)a[3] << 32) | a[2]), (i64_t)(((unsigned long long)hb[c][3] << 32) | hb[c][2]), acc, 0, 0, 0); }
                const int base = (u & 7) * 8; const int r = li & 3;
                const float sel = r == 0 ? acc[0] : (r == 1 ? acc[1] : (r == 2 ? acc[2] : acc[3]));
                const float dmine = __shfl(sel, ((lane & 7) >> 2) * 16 + (lane & 3));
                const float gsel = u < 8 ? g_lo : g_hi, susel = u < 8 ? su_lo : su_hi, svsel = u < 8 ? sv_lo : sv_hi;
                const float wv = gsel * gelu_erf(dmine * susel * hinv) * svsel;
                const bool mine = (lane >= base) && (lane < base + 8);
                if (u < 8) w_lo = mine ? wv : w_lo; else w_hi = mine ? wv : w_hi;
                asm volatile("s_waitcnt lgkmcnt(0)" ::: "memory");
            }
            WSP(float, WS_GATE)[t * 128 + lane] = w_lo; WSP(float, WS_GATE)[t * 128 + 64 + lane] = w_hi;
        }
    }
}
struct U10Meta { int elo, ehi; float glo, ghi; v4u xa, xb; float rst; };
__device__ __forceinline__ void u10_meta_load(U10Meta& M, const unsigned char* ws, size_t t, unsigned l16) {
    const unsigned l = l16 >> 4; const int* ep = (const int*)(ws + WS_EID) + t * 128; const float* gp = (const float*)(ws + WS_GATE) + t * 128;
    M.elo = ep[l]; M.ehi = ep[64 + l]; M.glo = gp[l]; M.ghi = gp[64 + l];
    const char* xs = (const char*)(ws + WS_X1S) + t * 2048 + 2u * l16; M.xa = *(const v4u*)xs; M.xb = *(const v4u*)(xs + 16);
    M.rst = ((const float*)(ws + WS_ROWSTAT))[t + (l16 >> 30)];
}
__device__ __forceinline__ void u10_meta_touch(U10Meta& M) { asm volatile("" : "+v"(M.elo), "+v"(M.ehi), "+v"(M.glo), "+v"(M.ghi), "+v"(M.xa), "+v"(M.xb), "+v"(M.rst)); }
template <int UN> __device__ __forceinline__ void u10_unit_dma(int elo, int ehi, const unsigned char* EU, unsigned l16, LAS unsigned char* dst) {
    const int ensel = UN < 8 ? elo : ehi; constexpr int nb = (UN & 7) * 8;
#pragma unroll
    for (int j = 0; j < 8; ++j) { const int e = __builtin_amdgcn_readlane(ensel, nb + j);
        __builtin_amdgcn_global_load_lds((const unsigned*)(EU + ((unsigned)e * 1024u + l16)), (LAS unsigned*)(dst + j * U6_ROWP), 16, 0, 0); }
}
__device__ __forceinline__ void u10_h2(const U10Meta& M, const float* S2, LAS unsigned char* hq, unsigned l16, int lq, v4u* hb, float& hinv) {
    float h2[16]; unpack8(M.xa, h2); unpack8(M.xb, h2 + 8); float mx = 0.f;
    const float rs = rsqrt_f(M.rst * (1.0f / 1024.0f) + EPSF);
#pragma unroll
    for (int i = 0; i < 16; ++i) { h2[i] = h2[i] * rs + S2[i]; mx = fmaxf(mx, fabsf(h2[i])); }
#pragma unroll
    for (int o = 1; o < 64; o <<= 1) mx = fmaxf(mx, __shfl_xor(mx, o));
    mx = fmaxf(mx, 1e-30f); const float hs = 224.0f / mx; hinv = mx * (1.0f / 224.0f);
    v4u w;
#pragma unroll
    for (int qd = 0; qd < 4; ++qd) { int pk = 0; pk = __builtin_amdgcn_cvt_pk_fp8_f32(h2[4 * qd] * hs, h2[4 * qd + 1] * hs, pk, false); pk = __builtin_amdgcn_cvt_pk_fp8_f32(h2[4 * qd + 2] * hs, h2[4 * qd + 3] * hs, pk, true); w[qd] = (unsigned)pk; }
    *(LAS v4u*)(hq + l16) = w;
    LDS_WAIT(); asm volatile("" ::: "memory");
#pragma unroll
    for (int c = 0; c < 16; ++c) hb[c] = *(const LAS v4u*)(hq + 64 * c + 16 * lq);
    LDS_WAIT(); asm volatile("" ::: "memory");
}
template <int U> __device__ __forceinline__ void u10_unit(const U10Meta& C, U10Meta& N, const unsigned char* EU, const unsigned char* ws, unsigned l16, LAS unsigned char* ring, const v4u* hb, float hinv,
                                                          float su_lo, float su_hi, float sv_lo, float sv_hi, float& nsu_lo, float& nsu_hi, float& nsv_lo, float& nsv_hi,
                                                          float& w_lo, float& w_hi, size_t tn, bool first_token, int lane) {
    const int li = lane & 15, lq = lane >> 4;
    if (U == 15) u10_unit_dma<0>(N.elo, N.ehi, EU, l16, ring); else u10_unit_dma<(U + 1) & 15>(C.elo, C.ehi, EU, l16, ring + ((U + 1) & 1) * U6_BUF);
    __builtin_amdgcn_sched_barrier(0);
    if (U == 0) { if (first_token) asm volatile("s_waitcnt vmcnt(8)" ::: "memory"); else asm volatile("s_waitcnt vmcnt(10)" ::: "memory"); }
    else if (U == 3) asm volatile("s_waitcnt vmcnt(15)" ::: "memory");
    else if (U == 11) asm volatile("s_waitcnt vmcnt(12)" ::: "memory");
    else asm volatile("s_waitcnt vmcnt(8)" ::: "memory");
    if (U == 4) u10_meta_touch(N);
    if (U == 12) asm volatile("" : "+v"(nsu_lo), "+v"(nsu_hi), "+v"(nsv_lo), "+v"(nsv_hi));
    __builtin_amdgcn_sched_barrier(0);
    const LAS unsigned char* src = ring + (U & 1) * U6_BUF + (li & 7) * U6_ROWP + 16 * lq;
    f32x4 acc = (f32x4){0.f, 0.f, 0.f, 0.f};
#pragma unroll
    for (int c = 0; c < 16; ++c) { const v4u a = *(const LAS v4u*)(src + 64 * c);
        acc = __builtin_amdgcn_mfma_f32_16x16x32_fp8_fp8((i64_t)(((unsigned long long)a[1] << 32) | a[0]), (i64_t)(((unsigned long long)hb[c][1] << 32) | hb[c][0]), acc, 0, 0, 0);
        acc = __builtin_amdgcn_mfma_f32_16x16x32_fp8_fp8((i64_t)(((unsigned long long)a[3] << 32) | a[2]), (i64_t)(((unsigned long long)hb[c][3] << 32) | hb[c][2]), acc, 0, 0, 0); }
    constexpr int base = (U & 7) * 8; const int r = li & 3;
    const float sel = r == 0 ? acc[0] : (r == 1 ? acc[1] : (r == 2 ? acc[2] : acc[3]));
    const float dmine = __shfl(sel, ((lane & 7) >> 2) * 16 + (lane & 3));
    const float gsel = U < 8 ? C.glo : C.ghi, susel = U < 8 ? su_lo : su_hi, svsel = U < 8 ? sv_lo : sv_hi;
    const float wv = gsel * gelu_erf(dmine * susel * hinv) * svsel;
    const bool mine = (lane >= base) && (lane < base + 8);
    if (U < 8) w_lo = mine ? wv : w_lo; else w_hi = mine ? wv : w_hi;
    asm volatile("s_waitcnt lgkmcnt(0)" ::: "memory");
    __builtin_amdgcn_sched_barrier(0);
    if (U == 2) { u10_meta_load(N, ws, tn, l16); __builtin_amdgcn_sched_barrier(0); }
    if (U == 10) { const float* EUS = (const float*)(ws + WS_EUS); const float* EVS = (const float*)(ws + WS_EVS); nsu_lo = EUS[N.elo]; nsu_hi = EUS[N.ehi]; nsv_lo = EVS[N.elo]; nsv_hi = EVS[N.ehi]; __builtin_amdgcn_sched_barrier(0); }
}
__device__ __forceinline__ void p8_peer_up10(Frame& F) {
    const int f_tid = threadIdx.x, lane = f_tid & 63, f_wave = __builtin_amdgcn_readfirstlane(f_tid >> 6);
    const int lq = lane >> 4;
    const unsigned char* EU = F.ws + WS_EU; const float* EUS = WSP(float, WS_EUS); const float* EVS = WSP(float, WS_EVS);
    LAS unsigned char* ring = F.lds + f_wave * U6_WAVE; LAS unsigned char* hq = ring + 2 * U6_BUF;
    for (int wq = F.vcu * NWAVES + f_wave; wq < MTOK / 16; wq += F.G * NWAVES) {
        const int b = wq >> 7; const float* mb = WSP(float, WS_MOD) + (size_t)b * 6144;
        unsigned l16 = 16u * (unsigned)lane; asm volatile("" : "+v"(l16));
        float S2[16];
#pragma unroll
        for (int q = 0; q < 4; ++q) { const f32x4 sh = *(const f32x4*)((const char*)(mb + 3072) + 4u * l16 + 16 * q); S2[4 * q] = sh[0]; S2[4 * q + 1] = sh[1]; S2[4 * q + 2] = sh[2]; S2[4 * q + 3] = sh[3]; }
        const size_t t0 = (size_t)wq * 16;
        U10Meta C, N;
        u10_meta_load(C, F.ws, t0, l16);
        asm volatile("s_waitcnt vmcnt(0)" ::: "memory");
        u10_meta_touch(C);
        u10_unit_dma<0>(C.elo, C.ehi, EU, l16, ring);
        float su_lo = EUS[C.elo], su_hi = EUS[C.ehi], sv_lo = EVS[C.elo], sv_hi = EVS[C.ehi];
        float nsu_lo = 0.f, nsu_hi = 0.f, nsv_lo = 0.f, nsv_hi = 0.f;
        v4u hb[16]; float hinv;
        u10_h2(C, S2, hq, l16, lq, hb, hinv);
        N = C;
        asm volatile("s_waitcnt vmcnt(0)" ::: "memory");
        asm volatile("" : "+v"(su_lo), "+v"(su_hi), "+v"(sv_lo), "+v"(sv_hi));
#pragma unroll 1
        for (int tt = 0; tt < 16; ++tt) {
            float w_lo = 0.f, w_hi = 0.f;
            const size_t tn = t0 + (tt < 15 ? tt + 1 : tt);
            const bool ft = (tt == 0);
#define U10_U(U) u10_unit<U>(C, N, EU, F.ws, l16, ring, hb, hinv, su_lo, su_hi, sv_lo, sv_hi, nsu_lo, nsu_hi, nsv_lo, nsv_hi, w_lo, w_hi, tn, ft, lane);
            U10_U(0) U10_U(1) U10_U(2) U10_U(3) U10_U(4) U10_U(5) U10_U(6) U10_U(7) U10_U(8) U10_U(9) U10_U(10) U10_U(11) U10_U(12) U10_U(13) U10_U(14) U10_U(15)
#undef U10_U
            WSP(float, WS_GATE)[(t0 + tt) * 128 + lane] = w_lo; WSP(float, WS_GATE)[(t0 + tt) * 128 + 64 + lane] = w_hi;
            __builtin_amdgcn_sched_barrier(0);
            C = N; su_lo = nsu_lo; su_hi = nsu_hi; sv_lo = nsv_lo; sv_hi = nsv_hi;
            u10_h2(C, S2, hq, l16, lq, hb, hinv);
        }
        asm volatile("s_waitcnt vmcnt(0)" ::: "memory");
    }
}
#ifndef U11_AUX
#define U11_AUX 0
#endif
constexpr int U11_HQ = 2 * U6_BUF, U11_IDS = U11_HQ + 1024, U11_GATES = U11_IDS + 512, U11_SC = U11_GATES + 512, U11_HINV = U11_SC + 1024, U11_WAVE = U11_HINV + 256;
static_assert(8 * U11_WAVE <= LDS_MAIN, "U11 LDS map");
__device__ __forceinline__ void u11_dma4(const void* g, LAS unsigned char* l) { __builtin_amdgcn_global_load_lds((const unsigned*)g, (LAS unsigned*)l, 4, 0, 0); }
__device__ __forceinline__ void u11_stage1(const unsigned char* ws, size_t t, unsigned l16, LAS unsigned char* W) {
    const unsigned l4 = l16 >> 2;
    const unsigned char* ep = ws + WS_EID + t * 512; const unsigned char* gp = ws + WS_GATE + t * 512;
    u11_dma4(ep + l4, W + U11_IDS); u11_dma4(ep + 256 + l4, W + U11_IDS + 256);
    u11_dma4(gp + l4, W + U11_GATES); u11_dma4(gp + 256 + l4, W + U11_GATES + 256);
    __builtin_amdgcn_global_load_lds((const unsigned*)(ws + WS_H2Q + t * 1024 + l16), (LAS unsigned*)(W + U11_HQ), 16, 0, 0);
    u11_dma4(ws + WS_HINV + t * 4 + (l16 >> 30), W + U11_HINV);
}
__device__ __forceinline__ void u11_stage2(const unsigned char* ws, int elo, int ehi, LAS unsigned char* W) {
    u11_dma4(ws + WS_EUS + 4u * (unsigned)elo, W + U11_SC); u11_dma4(ws + WS_EUS + 4u * (unsigned)ehi, W + U11_SC + 256);
    u11_dma4(ws + WS_EVS + 4u * (unsigned)elo, W + U11_SC + 512); u11_dma4(ws + WS_EVS + 4u * (unsigned)ehi, W + U11_SC + 768);
}
template <int UN> __device__ __forceinline__ void u11_unit_dma(int elo, int ehi, const unsigned char* EU, unsigned l16, LAS unsigned char* dst) {
    const int ensel = UN < 8 ? elo : ehi; constexpr int nb = (UN & 7) * 8;
#pragma unroll
    for (int j = 0; j < 8; ++j) { const int e = __builtin_amdgcn_readlane(ensel, nb + j);
        __builtin_amdgcn_global_load_lds((const unsigned*)(EU + ((unsigned)e * 1024u + l16)), (LAS unsigned*)(dst + j * U6_ROWP), 16, 0, U11_AUX); }
}
struct U11Tok { int elo, ehi; float glo, ghi, su_lo, su_hi, sv_lo, sv_hi, hinv; };
__device__ __forceinline__ void u11_switch(U11Tok& C, int nelo, int nehi, LAS unsigned char* W, unsigned l16, int lq, v4u* hb) {
    const unsigned l4 = l16 >> 2;
    C.elo = nelo; C.ehi = nehi;
    C.glo = *(const LAS float*)(W + U11_GATES + l4); C.ghi = *(const LAS float*)(W + U11_GATES + 256 + l4);
    C.su_lo = *(const LAS float*)(W + U11_SC + l4); C.su_hi = *(const LAS float*)(W + U11_SC + 256 + l4); C.sv_lo = *(const LAS float*)(W + U11_SC + 512 + l4); C.sv_hi = *(const LAS float*)(W + U11_SC + 768 + l4);
    C.hinv = *(const LAS float*)(W + U11_HINV + l4);
#pragma unroll
    for (int c = 0; c < 16; ++c) hb[c] = *(const LAS v4u*)(W + U11_HQ + 64 * c + 16 * lq);
    LDS_WAIT(); asm volatile("" ::: "memory");
}
template <int U> __device__ __forceinline__ void u11_unit(const U11Tok& C, int& nelo, int& nehi, const unsigned char* EU, const unsigned char* ws, unsigned l16, LAS unsigned char* W, const v4u* hb,
                                                          float& w_lo, float& w_hi, size_t tn, bool first_token, int lane) {
    const int li = lane & 15, lq = lane >> 4;
    if (U == 15) u11_unit_dma<0>(nelo, nehi, EU, l16, W); else u11_unit_dma<(U + 1) & 15>(C.elo, C.ehi, EU, l16, W + ((U + 1) & 1) * U6_BUF);
    __builtin_amdgcn_sched_barrier(0);
    if (U == 0) { if (first_token) asm volatile("s_waitcnt vmcnt(8)" ::: "memory"); else asm volatile("s_waitcnt vmcnt(10)" ::: "memory"); }
    else if (U == 3) asm volatile("s_waitcnt vmcnt(14)" ::: "memory");
    else if (U == 5) asm volatile("s_waitcnt vmcnt(12)" ::: "memory");
    else asm volatile("s_waitcnt vmcnt(8)" ::: "memory");
    __builtin_amdgcn_sched_barrier(0);
    const LAS unsigned char* src = W + (U & 1) * U6_BUF + (li & 7) * U6_ROWP + 16 * lq;
    f32x4 acc = (f32x4){0.f, 0.f, 0.f, 0.f};
#pragma unroll
    for (int c = 0; c < 16; ++c) { const v4u a = *(const LAS v4u*)(src + 64 * c);
        acc = __builtin_amdgcn_mfma_f32_16x16x32_fp8_fp8((i64_t)(((unsigned long long)a[1] << 32) | a[0]), (i64_t)(((unsigned long long)hb[c][1] << 32) | hb[c][0]), acc, 0, 0, 0);
        acc = __builtin_amdgcn_mfma_f32_16x16x32_fp8_fp8((i64_t)(((unsigned long long)a[3] << 32) | a[2]), (i64_t)(((unsigned long long)hb[c][3] << 32) | hb[c][2]), acc, 0, 0, 0); }
    constexpr int base = (U & 7) * 8; const int r = li & 3;
    const float sel = r == 0 ? acc[0] : (r == 1 ? acc[1] : (r == 2 ? acc[2] : acc[3]));
    const float dmine = __shfl(sel, ((lane & 7) >> 2) * 16 + (lane & 3));
    const float gsel = U < 8 ? C.glo : C.ghi, susel = U < 8 ? C.su_lo : C.su_hi, svsel = U < 8 ? C.sv_lo : C.sv_hi;
    const float wv = gsel * gelu_erf(dmine * susel * C.hinv) * svsel;
    const bool mine = (lane >= base) && (lane < base + 8);
    if (U < 8) w_lo = mine ? wv : w_lo; else w_hi = mine ? wv : w_hi;
    if (U == 4) { nelo = *(const LAS int*)(W + U11_IDS + (l16 >> 2)); nehi = *(const LAS int*)(W + U11_IDS + 256 + (l16 >> 2)); }
    asm volatile("s_waitcnt lgkmcnt(0)" ::: "memory");
    __builtin_amdgcn_sched_barrier(0);
    if (U == 2) { u11_stage1(ws, tn, l16, W); __builtin_amdgcn_sched_barrier(0); }
    if (U == 4) { u11_stage2(ws, nelo, nehi, W); __builtin_amdgcn_sched_barrier(0); }
}
__device__ __forceinline__ void p8_peer_up11(Frame& F) {
    const int f_tid = threadIdx.x, lane = f_tid & 63, f_wave = __builtin_amdgcn_readfirstlane(f_tid >> 6);
    const int lq = lane >> 4;
    const unsigned char* EU = F.ws + WS_EU;
    LAS unsigned char* W = F.lds + f_wave * U11_WAVE;
    for (int wq = F.vcu * NWAVES + f_wave; wq < MTOK / 16; wq += F.G * NWAVES) {
        unsigned l16 = 16u * (unsigned)lane; asm volatile("" : "+v"(l16));
        const size_t t0 = (size_t)wq * 16;
        u11_stage1(F.ws, t0, l16, W);
        asm volatile("s_waitcnt vmcnt(0)" ::: "memory");
        int nelo = *(const LAS int*)(W + U11_IDS + (l16 >> 2)), nehi = *(const LAS int*)(W + U11_IDS + 256 + (l16 >> 2));
        LDS_WAIT(); asm volatile("" ::: "memory");
        u11_stage2(F.ws, nelo, nehi, W);
        u11_unit_dma<0>(nelo, nehi, EU, l16, W);
        asm volatile("s_waitcnt vmcnt(0)" ::: "memory");
        U11Tok C; v4u hb[16];
        u11_switch(C, nelo, nehi, W, l16, lq, hb);
#pragma unroll 1
        for (int tt = 0; tt < 16; ++tt) {
            float w_lo = 0.f, w_hi = 0.f;
            const size_t tn = t0 + (tt < 15 ? tt + 1 : tt);
            const bool ft = (tt == 0);
#define U11_U(U) u11_unit<U>(C, nelo, nehi, EU, F.ws, l16, W, hb, w_lo, w_hi, tn, ft, lane);
            U11_U(0) U11_U(1) U11_U(2) U11_U(3) U11_U(4) U11_U(5) U11_U(6) U11_U(7) U11_U(8) U11_U(9) U11_U(10) U11_U(11) U11_U(12) U11_U(13) U11_U(14) U11_U(15)
#undef U11_U
            WSP(float, WS_GATE)[(t0 + tt) * 128 + lane] = w_lo; WSP(float, WS_GATE)[(t0 + tt) * 128 + 64 + lane] = w_hi;
            __builtin_amdgcn_sched_barrier(0);
            u11_switch(C, nelo, nehi, W, l16, lq, hb);
        }
        asm volatile("s_waitcnt vmcnt(0)" ::: "memory");
    }
}
typedef unsigned v3u __attribute__((ext_vector_type(3)));
typedef unsigned v6u __attribute__((ext_vector_type(6)));
typedef float f32x32 __attribute__((ext_vector_type(32)));
struct __attribute__((packed, aligned(4))) U3 { unsigned a, b, c; };
__device__ __forceinline__ v3u ld_row6(const unsigned char* p) { const U3 u = *(const U3*)p; return (v3u){u.a, u.b, u.c}; }
__device__ __forceinline__ void p9_peer_down3(Frame& F) {
    const int f_tid = threadIdx.x, lane = f_tid & 63, f_wave = __builtin_amdgcn_readfirstlane(f_tid >> 6);
    const unsigned char* EV = F.ws + WS_EV;
    for (int wq = F.vcu * NWAVES + f_wave; wq < MTOK / 16; wq += F.G * NWAVES) {
        const int b = wq >> 7; const float* mb = WSP(float, WS_MOD) + (size_t)b * 6144;
        int ne_lo = WSP(int, WS_EID)[(size_t)wq * 16 * 128 + lane], ne_hi = WSP(int, WS_EID)[(size_t)wq * 16 * 128 + 64 + lane];
        float nw_lo = WSP(float, WS_GATE)[(size_t)wq * 16 * 128 + lane], nw_hi = WSP(float, WS_GATE)[(size_t)wq * 16 * 128 + 64 + lane];
        for (int tt = 0; tt < 16; ++tt) {
            const size_t t = (size_t)wq * 16 + tt;
            unsigned l16 = 16u * (unsigned)lane; asm volatile("" : "+v"(l16));
            const unsigned l12 = (l16 >> 2) * 3u;
            float* xr = (float*)((char*)(F.out + t * 1024) + 4u * l16);
            const int e_lo = ne_lo, e_hi = ne_hi; const float w_lo = nw_lo, w_hi = nw_hi;
            f32x2 o[8];
#pragma unroll
            for (int i = 0; i < 8; ++i) o[i] = (f32x2){0.f, 0.f};
#ifdef DN3_G16
            v3u qa[16], qb[16];
#pragma unroll
            for (int j = 0; j < 16; ++j) { const int e = __builtin_amdgcn_readlane(e_lo, j); qa[j] = ld_row6(EV + ((unsigned)e * 768u + l12)); }
#define DN3_STEP(GRP, CUR, NXT) { \
                const int grp = (GRP); const int nb = ((grp + 1) & 3) * 16; const int ensel = ((grp + 1) & 7) < 4 ? e_lo : e_hi; \
                { _Pragma("unroll") for (int j = 0; j < 16; ++j) { const int e = __builtin_amdgcn_readlane(ensel, nb + j); NXT[j] = ld_row6(EV + ((unsigned)e * 768u + l12)); } } \
                __builtin_amdgcn_sched_barrier(0); \
                const int base = (grp & 3) * 16; const float wsel = grp < 4 ? w_lo : w_hi; \
                _Pragma("unroll") for (int j = 0; j < 16; j += 2) { \
                    const float wa = __builtin_bit_cast(float, __builtin_amdgcn_readlane(__builtin_bit_cast(int, wsel), base + j)), wb = __builtin_bit_cast(float, __builtin_amdgcn_readlane(__builtin_bit_cast(int, wsel), base + j + 1)); \
                    const f32x2 wa2 = (f32x2){wa, wa}, wb2 = (f32x2){wb, wb}; \
                    const v6u pr = (v6u){CUR[j][0], CUR[j][1], CUR[j][2], CUR[j + 1][0], CUR[j + 1][1], CUR[j + 1][2]}; \
                    const f32x32 r = __builtin_amdgcn_cvt_scalef32_pk32_f32_fp6(pr, 1.0f); \
                    _Pragma("unroll") for (int i = 0; i < 8; ++i) { o[i] += wa2 * (f32x2){r[2 * i], r[2 * i + 1]}; o[i] += wb2 * (f32x2){r[16 + 2 * i], r[17 + 2 * i]}; } } }
#pragma unroll 1
            for (int g2 = 0; g2 < 8; g2 += 2) { DN3_STEP(g2, qa, qb) DN3_STEP(g2 + 1, qb, qa) }
#else
            v3u qa[8], qb[8];
#pragma unroll
            for (int j = 0; j < 8; ++j) { const int e = __builtin_amdgcn_readlane(e_lo, j); qa[j] = ld_row6(EV + ((unsigned)e * 768u + l12)); }
#define DN3_STEP(GRP, CUR, NXT) { \
                const int grp = (GRP); const int nb = ((grp + 1) & 7) * 8; const int ensel = (grp + 1) < 8 ? e_lo : e_hi; \
                { _Pragma("unroll") for (int j = 0; j < 8; ++j) { const int e = __builtin_amdgcn_readlane(ensel, nb + j); NXT[j] = ld_row6(EV + ((unsigned)e * 768u + l12)); } } \
                __builtin_amdgcn_sched_barrier(0); \
                const int base = (grp & 7) * 8; const float wsel = grp < 8 ? w_lo : w_hi; \
                _Pragma("unroll") for (int j = 0; j < 8; j += 2) { \
                    const float wa = __builtin_bit_cast(float, __builtin_amdgcn_readlane(__builtin_bit_cast(int, wsel), base + j)), wb = __builtin_bit_cast(float, __builtin_amdgcn_readlane(__builtin_bit_cast(int, wsel), base + j + 1)); \
                    const f32x2 wa2 = (f32x2){wa, wa}, wb2 = (f32x2){wb, wb}; \
                    const v6u pr = (v6u){CUR[j][0], CUR[j][1], CUR[j][2], CUR[j + 1][0], CUR[j + 1][1], CUR[j + 1][2]}; \
                    const f32x32 r = __builtin_amdgcn_cvt_scalef32_pk32_f32_fp6(pr, 1.0f); \
                    _Pragma("unroll") for (int i = 0; i < 8; ++i) { o[i] += wa2 * (f32x2){r[2 * i], r[2 * i + 1]}; o[i] += wb2 * (f32x2){r[16 + 2 * i], r[17 + 2 * i]}; } } }
#pragma unroll 1
            for (int g2 = 0; g2 < 16; g2 += 2) { DN3_STEP(g2, qa, qb) DN3_STEP(g2 + 1, qb, qa) }
#endif
#undef DN3_STEP
            { const size_t tn = t + (tt < 15 ? 1 : 0); ne_lo = WSP(int, WS_EID)[tn * 128 + lane]; ne_hi = WSP(int, WS_EID)[tn * 128 + 64 + lane]; nw_lo = WSP(float, WS_GATE)[tn * 128 + lane]; nw_hi = WSP(float, WS_GATE)[tn * 128 + 64 + lane]; }
            float x1[16]; float ss = 0.f;
#pragma unroll
            for (int q4 = 0; q4 < 4; ++q4) { const f32x4 v = *(const f32x4*)(xr + 4 * q4); x1[4 * q4] = v[0]; x1[4 * q4 + 1] = v[1]; x1[4 * q4 + 2] = v[2]; x1[4 * q4 + 3] = v[3]; }
#pragma unroll
            for (int q4 = 0; q4 < 4; ++q4) { const f32x4 gt = *(const f32x4*)((const char*)(mb + 5120) + 4u * l16 + 16 * q4);
#pragma unroll
                for (int e = 0; e < 4; ++e) { const int i = 4 * q4 + e; x1[i] += gt[e] * o[i >> 1][i & 1]; ss += x1[i] * x1[i]; } }
            const float rf = rsqrt_f(wave_sum(ss) * (1.0f / 1024.0f) + EPSF);
#pragma unroll
            for (int q4 = 0; q4 < 4; ++q4) { const f32x4 nf = *(const f32x4*)((const char*)(F.a->in[29]) + 4u * l16 + 16 * q4); f32x4 v;
#pragma unroll
                for (int e = 0; e < 4; ++e) v[e] = x1[4 * q4 + e] * rf * nf[e];
                *(f32x4*)(xr + 4 * q4) = v; }
        }
    }
}
constexpr int U12_ROWP = 784, U12_NBUF = 3, U12_BUF = 8 * U12_ROWP, U12_WAVE = U12_NBUF * U12_BUF + 1024;
static_assert(8 * U12_WAVE <= LDS_MAIN, "U12 LDS map");
typedef int i32x8 __attribute__((ext_vector_type(8)));
typedef unsigned v2u __attribute__((ext_vector_type(2)));
__device__ __forceinline__ void p8_peer_up12(Frame& F) {
    const int f_tid = threadIdx.x, lane = f_tid & 63, f_wave = __builtin_amdgcn_readfirstlane(f_tid >> 6);
    const int li = lane & 15, lq = lane >> 4;
    const unsigned char* EU = F.ws + WS_EU; const float* EUS = WSP(float, WS_EUS); const float* EVS = WSP(float, WS_EVS);
    LAS unsigned char* ring = F.lds + f_wave * U12_WAVE; LAS unsigned char* hq = ring + U12_NBUF * U12_BUF;
#ifdef PROBE_MFMA
    if (blockIdx.x == 0 && f_wave == 0) {
        i32x8 A = (i32x8){0, 0, 0, 0, 0, 0, 0, 0}; if (lane == PROBE_ALANE) A[PROBE_AREG] = PROBE_AVAL;
        i32x8 B;
        if (PROBE_BPAT == 0) B = (i32x8){0x48444038, 0x504E4C4A, 0x54535251, 0x58575655, 0x48444038, 0x504E4C4A, 0x54535251, 0x58575655};
        else { const unsigned c0 = (const unsigned[]){0x38u, 0x40u, 0x44u, 0x48u, 0x4Au, 0x4Cu, 0x4Eu, 0x50u}[0]; (void)c0;
               const int k = lane >> 4; const unsigned lo = k == 0 ? 0x38u : (k == 1 ? 0x44u : (k == 2 ? 0x4Au : 0x4Eu)), hi = k == 0 ? 0x40u : (k == 1 ? 0x48u : (k == 2 ? 0x4Cu : 0x50u));
               const int wl = (int)(lo * 0x01010101u), wh = (int)(hi * 0x01010101u); B = (i32x8){wl, wl, wl, wl, wh, wh, wh, wh}; }
        f32x4 acc = (f32x4){0.f, 0.f, 0.f, 0.f};
        acc = __builtin_amdgcn_mfma_scale_f32_16x16x128_f8f6f4(A, B, acc, 2, 0, 0, 0, 0, 0);
        if (lane == 0) *(volatile float*)(F.ws + WS_CTL + 40000) = acc[0] * 100.0f;
    }
#endif
    for (int wq = F.vcu * NWAVES + f_wave; wq < MTOK / 16; wq += F.G * NWAVES) {
        const int b = wq >> 7; const float* mb = WSP(float, WS_MOD) + (size_t)b * 6144;
        for (int tt = 0; tt < 16; ++tt) {
            const size_t t = (size_t)wq * 16 + tt;
            unsigned l16 = 16u * (unsigned)lane; asm volatile("" : "+v"(l16));
            const int e_lo = WSP(int, WS_EID)[t * 128 + lane], e_hi = WSP(int, WS_EID)[t * 128 + 64 + lane];
            const float g_lo = WSP(float, WS_GATE)[t * 128 + lane], g_hi = WSP(float, WS_GATE)[t * 128 + 64 + lane];
            const float rs = rsqrt_f(WSP(float, WS_ROWSTAT)[t] * (1.0f / 1024.0f) + EPSF);
            const char* xs = (const char*)(WSP(bf16, WS_X1S) + t * 1024) + 2u * l16; const v4u xa = *(const v4u*)xs, xb = *(const v4u*)(xs + 16);
            asm volatile("s_waitcnt vmcnt(0)" ::: "memory");
            if (lane < 48) {
#pragma unroll
            for (int j = 0; j < 16; ++j) { const int e = __builtin_amdgcn_readlane(e_lo, j);
                __builtin_amdgcn_global_load_lds((const unsigned*)(EU + ((unsigned)e * 768u + l16)), (LAS unsigned*)(ring + j * U12_ROWP), 16, 0, 0); } }
            const float su_lo = EUS[e_lo], su_hi = EUS[e_hi], sv_lo = EVS[e_lo], sv_hi = EVS[e_hi];
            float h2[16]; unpack8(xa, h2); unpack8(xb, h2 + 8); float mx = 0.f;
#pragma unroll
            for (int qd = 0; qd < 4; ++qd) { const f32x4 sh = *(const f32x4*)((const char*)(mb + 3072) + 4u * l16 + 16 * qd);
#pragma unroll
                for (int e = 0; e < 4; ++e) { h2[4 * qd + e] = h2[4 * qd + e] * rs + sh[e]; mx = fmaxf(mx, fabsf(h2[4 * qd + e])); } }
#pragma unroll
            for (int o = 1; o < 64; o <<= 1) mx = fmaxf(mx, __shfl_xor(mx, o));
            mx = fmaxf(mx, 1e-30f); const float hs = 224.0f / mx, hinv = mx * (1.0f / 224.0f);
            { v4u w;
#pragma unroll
              for (int qd = 0; qd < 4; ++qd) { int pk = 0; pk = __builtin_amdgcn_cvt_pk_fp8_f32(h2[4 * qd] * hs, h2[4 * qd + 1] * hs, pk, false); pk = __builtin_amdgcn_cvt_pk_fp8_f32(h2[4 * qd + 2] * hs, h2[4 * qd + 3] * hs, pk, true); w[qd] = (unsigned)pk; }
              *(LAS v4u*)(hq + l16) = w; }
            LDS_WAIT(); asm volatile("" ::: "memory");
            v4u hb[8];
#pragma unroll
            for (int c = 0; c < 4; ++c) { hb[2 * c] = *(const LAS v4u*)(hq + (li & 1) * 512 + 128 * c + 16 * lq); hb[2 * c + 1] = *(const LAS v4u*)(hq + (li & 1) * 512 + 128 * c + 64 + 16 * lq); }
            asm volatile("s_waitcnt vmcnt(0)" ::: "memory");
            float w_lo = 0.f, w_hi = 0.f;
            int cur = 0, nx2 = 2 * U12_BUF;
#pragma unroll 1
            for (int u = 0; u < 16; ++u) {
                if (u < 14) { const int un = u + 2; int ensel = un < 8 ? e_lo : e_hi; asm volatile("" : "+v"(ensel));     const int nb = (un & 7) * 8; LAS unsigned char* dst = ring + nx2;
                  if (lane < 48) {
#pragma unroll
                  for (int j = 0; j < 8; ++j) { const int e = __builtin_amdgcn_readlane(ensel, nb + j);
                      __builtin_amdgcn_global_load_lds((const unsigned*)(EU + ((unsigned)e * 768u + l16)), (LAS unsigned*)(dst + j * U12_ROWP), 16, 0, 0); } }
                  asm volatile("s_waitcnt vmcnt(16)" ::: "memory"); }
                else if (u == 14) asm volatile("s_waitcnt vmcnt(8)" ::: "memory");
                else asm volatile("s_waitcnt vmcnt(0)" ::: "memory");
                const LAS unsigned char* src = ring + cur + (li & 7) * U12_ROWP + (li >> 3) * 384 + 24 * lq;
                f32x4 acc = (f32x4){0.f, 0.f, 0.f, 0.f};
#pragma unroll
                for (int c = 0; c < 4; ++c) { const v2u a0 = *(const LAS v2u*)(src + 96 * c), a1 = *(const LAS v2u*)(src + 96 * c + 8), a2 = *(const LAS v2u*)(src + 96 * c + 16);
                    const i32x8 A = (i32x8){(int)a0[0], (int)a0[1], (int)a1[0], (int)a1[1], (int)a2[0], (int)a2[1], 0, 0};
                    const i32x8 B = (i32x8){(int)hb[2 * c][0], (int)hb[2 * c][1], (int)hb[2 * c][2], (int)hb[2 * c][3], (int)hb[2 * c + 1][0], (int)hb[2 * c + 1][1], (int)hb[2 * c + 1][2], (int)hb[2 * c + 1][3]};
                    acc = __builtin_amdgcn_mfma_scale_f32_16x16x128_f8f6f4(A, B, acc, 2, 0, 0, 0, 0, 0); }
                const int base = (u & 7) * 8; const int r = (li >> 1) & 3;
                const float sel = r == 0 ? acc[0] : (r == 1 ? acc[1] : (r == 2 ? acc[2] : acc[3]));
                const int sl = ((lane & 7) >> 2) * 16 + 2 * (lane & 3);
                const float dmine = __shfl(sel, sl) + __shfl(sel, sl + 33);
                const float gsel = u < 8 ? g_lo : g_hi, susel = u < 8 ? su_lo : su_hi, svsel = u < 8 ? sv_lo : sv_hi;
                const float wv = gsel * gelu_erf(dmine * susel * hinv) * svsel;
                const bool mine = (lane >= base) && (lane < base + 8);
                if (u < 8) w_lo = mine ? wv : w_lo; else w_hi = mine ? wv : w_hi;
                asm volatile("s_waitcnt lgkmcnt(0)" ::: "memory");
                cur = cur == 2 * U12_BUF ? 0 : cur + U12_BUF; nx2 = nx2 == 2 * U12_BUF ? 0 : nx2 + U12_BUF;
            }
            WSP(float, WS_GATE)[t * 128 + lane] = w_lo; WSP(float, WS_GATE)[t * 128 + 64 + lane] = w_hi;
        }
    }
}
constexpr int U14_ROWP = 1040, U14_BUF = 8 * U14_ROWP, U14_WAVE = 2 * U14_BUF + 1024;
static_assert(8 * U14_WAVE <= LDS_MAIN, "U14 LDS map");
struct U14Meta { int elo, ehi; float glo, ghi; v4u xa, xb; float rst; };
__device__ __forceinline__ void u14_meta_load(U14Meta& M, const unsigned char* ws, size_t t, unsigned l16) {
    const unsigned l = l16 >> 4; const int* ep = (const int*)(ws + WS_EID) + t * 128; const float* gp = (const float*)(ws + WS_GATE) + t * 128;
    M.elo = ep[l]; M.ehi = ep[64 + l]; M.glo = gp[l]; M.ghi = gp[64 + l];
    const char* xs = (const char*)(ws + WS_X1S) + t * 2048 + 2u * l16; M.xa = *(const v4u*)xs; M.xb = *(const v4u*)(xs + 16);
    M.rst = ((const float*)(ws + WS_ROWSTAT))[t];
}
__device__ __forceinline__ void u14_h2(const U14Meta& M, const float* S2, LAS unsigned char* hq, unsigned l16, int li, int lq, v4u* hb, float& hinv) {
    float h2[16]; unpack8(M.xa, h2); unpack8(M.xb, h2 + 8); float mx = 0.f;
    const float rs = rsqrt_f(M.rst * (1.0f / 1024.0f) + EPSF);
#pragma unroll
    for (int i = 0; i < 16; ++i) { h2[i] = h2[i] * rs + S2[i]; mx = fmaxf(mx, fabsf(h2[i])); }
#pragma unroll
    for (int o = 1; o < 64; o <<= 1) mx = fmaxf(mx, __shfl_xor(mx, o));
    mx = fmaxf(mx, 1e-30f); const float hs = 224.0f / mx; hinv = mx * (1.0f / 224.0f);
    v4u w;
#pragma unroll
    for (int qd = 0; qd < 4; ++qd) { int pk = 0; pk = __builtin_amdgcn_cvt_pk_fp8_f32(h2[4 * qd] * hs, h2[4 * qd + 1] * hs, pk, false); pk = __builtin_amdgcn_cvt_pk_fp8_f32(h2[4 * qd + 2] * hs, h2[4 * qd + 3] * hs, pk, true); w[qd] = (unsigned)pk; }
    *(LAS v4u*)(hq + l16) = w;
    LDS_WAIT(); asm volatile("" ::: "memory");
#pragma unroll
    for (int c = 0; c < 4; ++c) { hb[2 * c] = *(const LAS v4u*)(hq + (li & 1) * 512 + 128 * c + 16 * lq); hb[2 * c + 1] = *(const LAS v4u*)(hq + (li & 1) * 512 + 128 * c + 64 + 16 * lq); }
    LDS_WAIT(); asm volatile("" ::: "memory");
}
__device__ __forceinline__ void p8_peer_up14(Frame& F) {
    const int f_tid = threadIdx.x, lane = f_tid & 63, f_wave = __builtin_amdgcn_readfirstlane(f_tid >> 6);
    const int li = lane & 15, lq = lane >> 4;
    const unsigned char* EU = F.ws + WS_EU; const float* EUS = WSP(float, WS_EUS); const float* EVS = WSP(float, WS_EVS);
    LAS unsigned char* tile = F.lds + f_wave * U14_WAVE; LAS unsigned char* hq = tile + 2 * U14_BUF;
    for (int wq = F.vcu * NWAVES + f_wave; wq < MTOK / 16; wq += F.G * NWAVES) {
        const int b = wq >> 7; const float* mb = WSP(float, WS_MOD) + (size_t)b * 6144;
        unsigned l16 = 16u * (unsigned)lane; asm volatile("" : "+v"(l16));
        const unsigned rof = l16 < 768u ? l16 : l16 - 768u;
        float S2[16];
#pragma unroll
        for (int q = 0; q < 4; ++q) { const f32x4 sh = *(const f32x4*)((const char*)(mb + 3072) + 4u * l16 + 16 * q); S2[4 * q] = sh[0]; S2[4 * q + 1] = sh[1]; S2[4 * q + 2] = sh[2]; S2[4 * q + 3] = sh[3]; }
        const size_t t0 = (size_t)wq * 16;
        U14Meta N; u14_meta_load(N, F.ws, t0, l16);
        float nsu_lo = EUS[N.elo], nsu_hi = EUS[N.ehi], nsv_lo = EVS[N.elo], nsv_hi = EVS[N.ehi];
        v4u qa[8], qb[8];
#pragma unroll
        for (int j = 0; j < 8; ++j) { const int e = __builtin_amdgcn_readlane(N.elo, j); qa[j] = *(const v4u*)(EU + ((unsigned)e * 768u + rof)); }
#pragma unroll 1
        for (int tt = 0; tt < 16; ++tt) {
            const size_t t = t0 + tt;
            const int e_lo = N.elo, e_hi = N.ehi; const float g_lo = N.glo, g_hi = N.ghi, su_lo = nsu_lo, su_hi = nsu_hi, sv_lo = nsv_lo, sv_hi = nsv_hi;
            v4u hb[8]; float hinv;
            u14_h2(N, S2, hq, l16, li, lq, hb, hinv);
            u14_meta_load(N, F.ws, t + (tt < 15 ? 1 : 0), l16);
            float w_lo = 0.f, w_hi = 0.f;
#define U14_STEP(UU, CUR, NXT, NLO, NHI) { \
            const int u = (UU); const int un = (u + 1) & 15; const int nb = (un & 7) * 8; const int ensel = un < 8 ? (NLO) : (NHI); \
            { _Pragma("unroll") for (int j = 0; j < 8; ++j) { const int e = __builtin_amdgcn_readlane(ensel, nb + j); NXT[j] = *(const v4u*)(EU + ((unsigned)e * 768u + rof)); } } \
            __builtin_amdgcn_sched_barrier(0); \
            LAS unsigned char* tb = tile + (u & 1) * U14_BUF; \
            { _Pragma("unroll") for (int j = 0; j < 8; ++j) *(LAS v4u*)(tb + j * U14_ROWP + l16) = CUR[j]; } \
            LDS_WAIT(); asm volatile("" ::: "memory"); \
            const LAS unsigned char* src = tb + (li & 7) * U14_ROWP + (li >> 3) * 384 + 24 * lq; \
            f32x4 acc = (f32x4){0.f, 0.f, 0.f, 0.f}; \
            _Pragma("unroll") for (int c = 0; c < 4; ++c) { const v2u a0 = *(const LAS v2u*)(src + 96 * c), a1 = *(const LAS v2u*)(src + 96 * c + 8), a2 = *(const LAS v2u*)(src + 96 * c + 16); \
                const i32x8 A = (i32x8){(int)a0[0], (int)a0[1], (int)a1[0], (int)a1[1], (int)a2[0], (int)a2[1], 0, 0}; \
                const i32x8 B = (i32x8){(int)hb[2 * c][0], (int)hb[2 * c][1], (int)hb[2 * c][2], (int)hb[2 * c][3], (int)hb[2 * c + 1][0], (int)hb[2 * c + 1][1], (int)hb[2 * c + 1][2], (int)hb[2 * c + 1][3]}; \
                acc = __builtin_amdgcn_mfma_scale_f32_16x16x128_f8f6f4(A, B, acc, 2, 0, 0, 0, 0, 0); }        \
            const int base = (u & 7) * 8; const int r = (li >> 1) & 3; \
            const float sel = r == 0 ? acc[0] : (r == 1 ? acc[1] : (r == 2 ? acc[2] : acc[3])); \
            const int sl = ((lane & 7) >> 2) * 16 + 2 * (lane & 3);                          \
            const float dmine = __shfl(sel, sl) + __shfl(sel, sl + 33); \
            const float gsel = u < 8 ? g_lo : g_hi, susel = u < 8 ? su_lo : su_hi, svsel = u < 8 ? sv_lo : sv_hi; \
            const float wv = gsel * gelu_erf(dmine * susel * hinv) * svsel; \
            const bool mine = (lane >= base) && (lane < base + 8); \
            if (u < 8) w_lo = mine ? wv : w_lo; else w_hi = mine ? wv : w_hi; }
#pragma unroll 1
            for (int u2 = 0; u2 < 14; u2 += 2) { U14_STEP(u2, qa, qb, e_lo, e_hi) U14_STEP(u2 + 1, qb, qa, e_lo, e_hi) }
            U14_STEP(14, qa, qb, e_lo, e_hi)
            U14_STEP(15, qb, qa, N.elo, N.ehi)
#undef U14_STEP
            nsu_lo = EUS[N.elo]; nsu_hi = EUS[N.ehi]; nsv_lo = EVS[N.elo]; nsv_hi = EVS[N.ehi];
            __builtin_amdgcn_sched_barrier(0);
            WSP(float, WS_GATE)[t * 128 + lane] = w_lo; WSP(float, WS_GATE)[t * 128 + 64 + lane] = w_hi;
        }
    }
}
#ifdef TOPK2
#define P7FN p5b_topk2
#else
#define P7FN p5b_topk
#endif
constexpr int NPHASE = 10;
__global__ void __launch_bounds__(NTHR, 2) fwd_mega(Args args) {
    extern __shared__ __attribute__((aligned(16))) unsigned char lds[];
    Frame F;
    F.lds = (LAS unsigned char*)lds;
    F.MISC = (volatile LAS unsigned*)(F.lds + MISC_OFF);
    F.G = gridDim.x; { const int bx = blockIdx.x; F.vcu = (F.G % 8 == 0) ? (bx % 8) * (F.G / 8) + bx / 8 : bx; }
    F.ws = args.ws; F.out = args.out;
    F.a = &args;
    for (int u = threadIdx.x; u < 32; u += NTHR) F.MISC[u] = 0u;
    __syncthreads();
    const int lo = args.ph_lo, hi = args.ph_hi;
    const bool use_bar = (hi - lo) > 1;
    XcdBarrier bar; bar.bar = (unsigned*)(F.ws + WS_CTL); bar.x = 0; bar.st = nullptr;
    if (use_bar) bar = xcd_barrier_post((unsigned*)(F.ws + WS_CTL), F.MISC + 8);
#define IN(k) (lo <= (k) && (k) < hi)
#define SEAM(k) do { if (IN(k) && IN((k) + 1)) xcd_barrier(bar); } while (0)
#ifndef REP_PHASE
#define REP_PHASE -1
#endif
#define REPEAT(k, body) do { if (REP_PHASE == (k)) { xcd_barrier(bar); body; } } while (0)
    if (IN(0)) {
#ifndef SKIP_P0
 p0_phase(F); REPEAT(0, p0_phase(F));
#endif
 } SEAM(0);
    if (IN(1)) {
#ifndef SKIP_P1
 p1_phase(F); REPEAT(1, p1_phase(F));
#endif
 } SEAM(1);
    if (IN(2)) {
        pg8::Gemm g{WSP(bf16, WS_H1), WSP(bf16, WS_WINT), MTOK, NPROJ, 1024}; pg8::StaticOrder S; S.init(MTOK, NPROJ, F.G, (int)blockIdx.x);
        pg8::EpiProj E{WSP(bf16, WS_PROJ), NPROJ};
        pg8::gemm_phase<pg8::EpiProj, pg8::StaticOrder, true, true>(F.lds, g, S, E);
        REPEAT(2, (pg8::gemm_phase<pg8::EpiProj, pg8::StaticOrder, true, true>(F.lds, g, S, E)));
    } SEAM(2);
    if (IN(3)) {
#ifndef SKIP_SSD
 p3pre_conv(F); xcd_barrier(bar); p3_ssd3(F); REPEAT(30, p3_ssd3(F)); REPEAT(32, p3pre_conv(F));
#endif
#ifndef SKIP_S5
 p3_s5v2(F); REPEAT(31, p3_s5v2(F));
#endif
 } SEAM(3);
    if (IN(5)) {
        pg8::Gemm g{WSP(bf16, WS_Y), WSP(bf16, WS_WOUTT), MTOK, 1024, 2048}; pg8::StaticOrder S; S.init(MTOK, 1024, F.G, (int)blockIdx.x);
        PG8_LAS float* tab = (PG8_LAS float*)(F.lds + pg8::STAGE_BYTES);
        { pg8::Unit u; for (int i = 0; S.next(i, u); ++i) pg8::SegScaleHook::build(F.lds + pg8::STAGE_BYTES, u, WSP(float, WS_STSSD), WSP(float, WS_STS5), (int)threadIdx.x); }
        __syncthreads();
        pg8::EpiX1 E{(F.a->in[0]), F.out, WSP(bf16, WS_X1S), WSP(float, WS_MOD), (F.a->in[24]), WSP(float, WS_ROWSTAT), tab};
        pg8::SegScaleHook H;
        pg8::gemm_phase<pg8::EpiX1, pg8::StaticOrder, true, true, pg8::SegScaleHook>(F.lds, g, S, E, H);
    } SEAM(5);
    if (IN(6)) {
        pg8::Gemm g{WSP(bf16, WS_X1S), WSP(bf16, WS_WQKT), MTOK, 2048, 1024}; pg8::StaticOrder S; S.init(MTOK, 2048, F.G, (int)blockIdx.x);
        pg8::EpiScores E{WSP(_Float16, WS_SCORES), WSP(float, WS_SB), WSP(float, WS_ROWSTAT)};
        pg8::gemm_phase<pg8::EpiScores, pg8::StaticOrder, true, true>(F.lds, g, S, E);
        REPEAT(6, (pg8::gemm_phase<pg8::EpiScores, pg8::StaticOrder, true, true>(F.lds, g, S, E)));
    } SEAM(6);
    if (IN(7)) {
#ifndef SKIP_TOPK
 P7FN(F); REPEAT(7, P7FN(F));
#endif
 } SEAM(7);
#ifdef UP14
    if (IN(8)) { p8_peer_up14(F); REPEAT(8, { P7FN(F); xcd_barrier(bar); p8_peer_up14(F); }); } SEAM(8);
#elif defined(UP12)
    if (IN(8)) { p8_peer_up12(F); REPEAT(8, { P7FN(F); xcd_barrier(bar); p8_peer_up12(F); }); } SEAM(8);
#elif defined(UP11)
    if (IN(8)) { p8_peer_up11(F); REPEAT(8, { P7FN(F); xcd_barrier(bar); p8_peer_up11(F); }); } SEAM(8);
#elif defined(UP10)
    if (IN(8)) { p8_peer_up10(F); } SEAM(8);
#else
    if (IN(8)) { p8_peer_up6(F); REPEAT(8, { P7FN(F); xcd_barrier(bar); p8_peer_up6(F); }); } SEAM(8);
#endif
#ifdef V6
    if (IN(9)) { p9_peer_down3(F); }
#else
    if (IN(9)) { p9_peer_down2(F); }
#endif
#ifdef PROBE_OUT
    if (IN(9)) { __syncthreads(); if (blockIdx.x == 0 && threadIdx.x == 0) { asm volatile("s_waitcnt vmcnt(0)" ::: "memory"); F.out[0] = *(volatile float*)(F.ws + WS_CTL + 40000); } }
#endif
#undef IN
#undef SEAM
}

#ifndef N_LAUNCHES
#define N_LAUNCHES 1
#endif
extern "C" void kernel_launch(void* const* d_in, const int* in_sizes, int n_in, void* d_out, int out_size, void* d_ws, size_t ws_size, hipStream_t stream) {
    static int grid = 0;
    if (grid == 0) {
        if (n_in != 30 || in_sizes[0] != MTOK * DM || out_size != MTOK * DM || ws_size < WS_END) { fprintf(stderr, "kernel_launch: unexpected shapes (n_in %d, in0 %d, out %d, ws %zu)\n", n_in, n_in > 0 ? in_sizes[0] : -1, out_size, ws_size); grid = -1; return; }
        int dev = 0, cus = 0, per_cu = 0;
        if (hipGetDevice(&dev) != hipSuccess || hipDeviceGetAttribute(&cus, hipDeviceAttributeMultiprocessorCount, dev) != hipSuccess) { grid = -1; return; }
        if (hipFuncSetAttribute((const void*)fwd_mega, hipFuncAttributeMaxDynamicSharedMemorySize, LDS_BYTES) != hipSuccess) { fprintf(stderr, "kernel_launch: hipFuncSetAttribute failed\n"); grid = -1; return; }
        if (hipOccupancyMaxActiveBlocksPerMultiprocessor(&per_cu, (const void*)fwd_mega, NTHR, LDS_BYTES) != hipSuccess || per_cu < 1) { fprintf(stderr, "kernel_launch: occupancy query says %d\n", per_cu); (void)hipGetLastError(); grid = -1; return; }
        if (cus != 256) { fprintf(stderr, "kernel_launch: built for a 256-CU device (got %d CUs); nothing launched\n", cus); grid = -1; return; }
        grid = cus;
    }
    if (grid < 0) return;
    (void)hipMemsetAsync((char*)d_ws + WS_CTL, 0, CTL_ZERO_BYTES, stream);
    Args a{};
    for (int i = 0; i < 30; ++i) a.in[i] = (const float*)d_in[i];
    a.out = (float*)d_out; a.ws = (unsigned char*)d_ws;
    if (N_LAUNCHES == 1) {
        a.ph_lo = 0; a.ph_hi = NPHASE;
        void* kargs[] = {&a};
#ifdef PLAIN_LAUNCH
        (void)kargs; hipLaunchKernelGGL(fwd_mega, dim3(grid), dim3(NTHR), LDS_BYTES, stream, a);
#else
        hipError_t e = hipLaunchCooperativeKernel((const void*)fwd_mega, dim3(grid), dim3(NTHR), kargs, LDS_BYTES, stream);
        if (e != hipSuccess) fprintf(stderr, "kernel_launch: cooperative launch failed: %s (grid %d)\n", hipGetErrorString(e), grid);
#endif
    } else {
        for (int p = 0; p < NPHASE; ++p) { a.ph_lo = p; a.ph_hi = p + 1; hipLaunchKernelGGL(fwd_mega, dim3(grid), dim3(NTHR), LDS_BYTES, stream, a); }
    }
}
```

```cpp
#define V6
#define UP14
#define HWENC
#include <hip/hip_runtime.h>
#include <cstdio>
#include <cstdint>
namespace pg8 {
#define PG8_LAS __attribute__((address_space(3)))
typedef unsigned short bf16_t;
typedef short bf16x8 __attribute__((ext_vector_type(8)));
typedef float f32x4 __attribute__((ext_vector_type(4)));
typedef unsigned u32x4 __attribute__((ext_vector_type(4)));
constexpr int BM = 256, BK = 64, HALF = 128, HTB = HALF * BK * 2  , STAGE_BYTES = 8 * HTB, NXCD = 8, WGM = 8;

__host__ __device__ __forceinline__ int lds_byte(int r, int c) { const int st = (r >> 4) * 2 + (c >> 5), rr = r & 15, cc = c & 31, ob = rr * 64 + cc * 2; return st * 1024 + (ob ^ (((ob >> 9) & 1) << 5)); }
__host__ __device__ __forceinline__ void stage_rc(int b, int& R, int& C) { const int st = b / 1024, sb = b % 1024, swz = sb ^ (((sb >> 9) & 1) << 5); R = (st >> 1) * 16 + swz / 64; C = (st & 1) * 32 + (swz % 64) / 2; }
__host__ __device__ __forceinline__ int perm32(int rho) { const int n = rho >> 4, i = rho & 15; return 8 * (i >> 2) + 4 * n + (i & 3); }

struct Unit { int pm, pn; };
struct Gemm { const bf16_t* A; const bf16_t* Bt; int M, N, K; };

struct StaticOrder {
    int nM, nN, nwg, G, c;
    __host__ __device__ void init(int M, int N, int G_, int c_) { nM = M / BM; nN = N / BM; nwg = nM * nN; G = G_; c = c_; }
    __host__ __device__ bool next(int i, Unit& u) const {
        const long L = (long)i * G + c; if (L >= nwg) return false;
        int wgid = (int)L; { const int q = nwg / NXCD, r = nwg % NXCD, xcd = wgid % NXCD, off = wgid / NXCD; wgid = (xcd < r ? xcd * (q + 1) : r * (q + 1) + (xcd - r) * q) + off; }
        const int nig = WGM * nN, gid = wgid / nig, fm = gid * WGM, gsz = (nM - fm) < WGM ? (nM - fm) : WGM;
        u.pm = fm + ((wgid % nig) % gsz); u.pn = (wgid % nig) / gsz; return true;
    }
    __device__ __forceinline__ void a_ready(const Unit&) const {}
    __device__ __forceinline__ void done(const Unit&) const {}
};

__device__ __forceinline__ unsigned cvt_pk_bf16(float lo, float hi) { unsigned r; asm volatile("v_cvt_pk_bf16_f32 %0, %1, %2" : "=v"(r) : "v"(lo), "v"(hi)); return r; }
typedef float f32x2 __attribute__((ext_vector_type(2)));
struct NoHook { __device__ __forceinline__ void at_tile(int, const Unit&, f32x4 (&)[2][2][4][2], PG8_LAS unsigned char*, int, int) const {} };
template <class Epi, class Sched, bool ALIGN_EPI = false, bool SP2 = false, class Hook = NoHook>
__device__ __forceinline__ void gemm_phase(PG8_LAS unsigned char* lds, const Gemm g, const Sched& S, const Epi& E, const Hook& H = Hook()) {
    const int tid = threadIdx.x, wid = __builtin_amdgcn_readfirstlane(tid >> 6), lane = tid & 63, wr = wid >> 2, wc = wid & 3, fr = lane & 15, fq = lane >> 4;
    const int K = g.K, nt = K / BK;
    unsigned voffA[2], voffB[2];
#pragma unroll
    for (int i = 0; i < 2; ++i) { int R, C; stage_rc(tid * 16 + i * 8192, R, C); const int Rb = Epi::PERM ? ((R & ~31) + perm32(R & 31)) : R;
        voffA[i] = (unsigned)(R * K + C) * 2u; voffB[i] = (unsigned)(Rb * K + C) * 2u; }
    const size_t kstep = (size_t)(BK * 2);
    const size_t hstep = (size_t)HALF * K * 2;
    const size_t tstep = 2 * hstep;
    const unsigned ldsw = (unsigned)wid * 1024u;
    const int aoff = lds_byte(wr * 64 + fr, fq * 8), boff = lds_byte(wc * 32 + fr, fq * 8);
#define PG8_SA(b, h) (((b) * 2 + (h)) * HTB)
#define PG8_SB(b, h) ((4 + (b) * 2 + (h)) * HTB)
#define PG8_STAGE(bufoff, gbase, voff) do { _Pragma("unroll") for (int _i = 0; _i < 2; ++_i) \
        __builtin_amdgcn_global_load_lds((const unsigned*)((const char*)(gbase) + (voff)[_i]), (PG8_LAS unsigned*)(lds + (bufoff) + ldsw + _i * 8192), 16, 0, 0); } while (0)
#define PG8_LDA(dst, b, h) do { _Pragma("unroll") for (int m = 0; m < 4; ++m) _Pragma("unroll") for (int k = 0; k < 2; ++k) dst[m][k] = *(const PG8_LAS bf16x8*)(lds + PG8_SA(b, h) + aoff + m * 2048 + k * 1024); } while (0)
#define PG8_LDB(dst, b, h) do { _Pragma("unroll") for (int n = 0; n < 2; ++n) _Pragma("unroll") for (int k = 0; k < 2; ++k) dst[n][k] = *(const PG8_LAS bf16x8*)(lds + PG8_SB(b, h) + boff + n * 2048 + k * 1024); } while (0)
#define PG8_MMA(ai, bj, At, Bt) do { __builtin_amdgcn_s_setprio(1); _Pragma("unroll") for (int m = 0; m < 4; ++m) _Pragma("unroll") for (int n = 0; n < 2; ++n) _Pragma("unroll") for (int k = 0; k < 2; ++k) \
        acc[ai][bj][m][n] = __builtin_amdgcn_mfma_f32_16x16x32_bf16(Bt[n][k], At[m][k], acc[ai][bj][m][n], 0, 0, 0); __builtin_amdgcn_s_setprio(0); } while (0)
#define PG8_WAIT_V(n) asm volatile("s_waitcnt vmcnt(" #n ")" ::: "memory")
#define PG8_WAIT_L(n) asm volatile("s_waitcnt lgkmcnt(" #n ")" ::: "memory")
#define PG8_BAR __builtin_amdgcn_s_barrier()
#define PG8_SCHED __builtin_amdgcn_sched_barrier(0)
    Unit cur, nxt; int ui = 0;
    if (!S.next(0, cur)) return;
    f32x4 acc[2][2][4][2];
#pragma unroll
    for (int a = 0; a < 2; ++a)
#pragma unroll
        for (int b = 0; b < 2; ++b)
#pragma unroll
            for (int m = 0; m < 4; ++m)
#pragma unroll
                for (int n = 0; n < 2; ++n) acc[a][b][m][n] = (f32x4){0.f, 0.f, 0.f, 0.f};
    bf16x8 At[4][2], B0[2][2], B1[2][2];
    const char* cA = (const char*)g.A + (size_t)cur.pm * tstep; const char* cB = (const char*)g.Bt + (size_t)cur.pn * tstep;
    S.a_ready(cur);
    if constexpr (SP2) {
        PG8_STAGE(PG8_SB(0, 0), cB, voffB); PG8_STAGE(PG8_SB(0, 1), cB + hstep, voffB); PG8_STAGE(PG8_SA(0, 0), cA, voffA); PG8_STAGE(PG8_SA(0, 1), cA + hstep, voffA);
        if (wr == 1) PG8_BAR;
        PG8_WAIT_V(2); PG8_BAR;
        PG8_STAGE(PG8_SB(1, 0), cB + kstep, voffB); PG8_STAGE(PG8_SA(1, 0), cA + kstep, voffA); PG8_STAGE(PG8_SB(1, 1), cB + hstep + kstep, voffB);
        PG8_WAIT_V(6); PG8_BAR;
    } else {
        PG8_STAGE(PG8_SB(0, 0), cB, voffB); PG8_STAGE(PG8_SA(0, 0), cA, voffA); PG8_STAGE(PG8_SB(0, 1), cB + hstep, voffB); PG8_STAGE(PG8_SA(0, 1), cA + hstep, voffA);
        if (wr == 1) PG8_BAR;
        PG8_WAIT_V(4); PG8_BAR;
        PG8_STAGE(PG8_SB(1, 0), cB + kstep, voffB); PG8_STAGE(PG8_SA(1, 0), cA + kstep, voffA); PG8_STAGE(PG8_SB(1, 1), cB + hstep + kstep, voffB);
        PG8_WAIT_V(6); PG8_BAR;
    }
    for (;;) {
        const bool has_next = S.next(ui + 1, nxt);
        const char* nA = has_next ? (const char*)g.A + (size_t)nxt.pm * tstep : cA; const char* nB = has_next ? (const char*)g.Bt + (size_t)nxt.pn * tstep : cB;
        for (int t = 0; t < nt; t += 2) {
            const bool last = (t == nt - 2);
            H.at_tile(t, cur, acc, lds + STAGE_BYTES, wr, fr);
            const char* a1 = cA + (size_t)(t + 1) * kstep;
            const char* a2 = last ? nA : cA + (size_t)(t + 2) * kstep; const char* b2 = last ? nB : cB + (size_t)(t + 2) * kstep;
            const char* a3 = a2 + kstep; const char* b3 = b2 + kstep;
            if (last && has_next) S.a_ready(nxt);
            if constexpr (SP2) {
            PG8_LDB(B0, 0, 0); PG8_LDB(B1, 0, 1); PG8_SCHED; PG8_LDA(At, 0, 0); PG8_STAGE(PG8_SA(1, 1), a1 + hstep, voffA);
            PG8_WAIT_V(8); PG8_WAIT_L(0); PG8_BAR; PG8_MMA(0, 0, At, B0); PG8_MMA(0, 1, At, B1); PG8_BAR; PG8_SCHED;
            PG8_LDA(At, 0, 1); PG8_STAGE(PG8_SB(0, 0), b2, voffB); PG8_STAGE(PG8_SB(0, 1), b2 + hstep, voffB); PG8_STAGE(PG8_SA(0, 0), a2, voffA);
            PG8_WAIT_V(8); PG8_WAIT_L(0); PG8_BAR; PG8_MMA(1, 0, At, B0); PG8_MMA(1, 1, At, B1); PG8_BAR; PG8_SCHED;
            PG8_LDB(B0, 1, 0); PG8_LDB(B1, 1, 1); PG8_SCHED; PG8_LDA(At, 1, 0); PG8_STAGE(PG8_SA(0, 1), a2 + hstep, voffA);
            PG8_WAIT_V(8); PG8_WAIT_L(0); PG8_BAR; PG8_MMA(0, 0, At, B0); PG8_MMA(0, 1, At, B1); PG8_BAR; PG8_SCHED;
            PG8_LDA(At, 1, 1); PG8_STAGE(PG8_SB(1, 0), b3, voffB); PG8_STAGE(PG8_SB(1, 1), b3 + hstep, voffB); PG8_STAGE(PG8_SA(1, 0), a3, voffA);
            PG8_WAIT_V(8); PG8_WAIT_L(0); PG8_BAR; PG8_MMA(1, 0, At, B0); PG8_MMA(1, 1, At, B1); PG8_BAR; PG8_SCHED;
            } else {
            PG8_LDB(B0, 0, 0); PG8_SCHED; PG8_LDA(At, 0, 0); PG8_STAGE(PG8_SA(1, 1), a1 + hstep, voffA);
            PG8_WAIT_L(8); PG8_BAR; PG8_WAIT_L(0); PG8_MMA(0, 0, At, B0); PG8_BAR; PG8_SCHED;
            PG8_LDB(B1, 0, 1); PG8_STAGE(PG8_SB(0, 0), b2, voffB);
            PG8_BAR; PG8_WAIT_L(0); PG8_MMA(0, 1, At, B1); PG8_BAR;
            PG8_LDA(At, 0, 1); PG8_STAGE(PG8_SA(0, 0), a2, voffA);
            PG8_BAR; PG8_WAIT_L(0); PG8_MMA(1, 0, At, B0); PG8_BAR; PG8_SCHED;
            PG8_STAGE(PG8_SB(0, 1), b2 + hstep, voffB);
            PG8_WAIT_V(6); PG8_BAR; PG8_MMA(1, 1, At, B1); PG8_BAR;
            PG8_LDB(B0, 1, 0); PG8_SCHED; PG8_LDA(At, 1, 0); PG8_STAGE(PG8_SA(0, 1), a2 + hstep, voffA);
            PG8_WAIT_L(8); PG8_BAR; PG8_WAIT_L(0); PG8_MMA(0, 0, At, B0); PG8_BAR; PG8_SCHED;
            PG8_LDB(B1, 1, 1); PG8_STAGE(PG8_SB(1, 0), b3, voffB);
            PG8_BAR; PG8_WAIT_L(0); PG8_MMA(0, 1, At, B1); PG8_BAR;
            PG8_LDA(At, 1, 1); PG8_STAGE(PG8_SA(1, 0), a3, voffA);
            PG8_BAR; PG8_WAIT_L(0); PG8_MMA(1, 0, At, B0); PG8_BAR; PG8_SCHED;
            PG8_STAGE(PG8_SB(1, 1), b3 + hstep, voffB);
            PG8_WAIT_V(6); PG8_BAR; PG8_MMA(1, 1, At, B1); PG8_BAR;
            }
        }
        if constexpr (ALIGN_EPI) { if (wr == 0) PG8_BAR; }
        if constexpr (!Epi::AFTER_DRAIN) { E(acc, cur, wr, wc, fr, fq);
#ifdef PROBE_EPI2
            if constexpr (Epi::PROBE_TWICE) { asm volatile("" ::: "memory"); E(acc, cur, wr, wc, fr, fq); }
#endif
            S.done(cur); }
        if (!has_next) break;
#pragma unroll
        for (int a = 0; a < 2; ++a)
#pragma unroll
            for (int b = 0; b < 2; ++b)
#pragma unroll
                for (int m = 0; m < 4; ++m)
#pragma unroll
                    for (int n = 0; n < 2; ++n) acc[a][b][m][n] = (f32x4){0.f, 0.f, 0.f, 0.f};
        cur = nxt; cA = nA; cB = nB; ++ui;
        if constexpr (ALIGN_EPI) { if (wr == 1) PG8_BAR; }
    }
    PG8_WAIT_V(0);
    if constexpr (!ALIGN_EPI) { if (wr == 0) PG8_BAR; }
    PG8_BAR;
    if constexpr (Epi::AFTER_DRAIN) { E.fused(acc, cur, wr, wc, fr, fq, lds, wid, lane); S.done(cur); }
#undef PG8_SA
#undef PG8_SB
#undef PG8_STAGE
#undef PG8_LDA
#undef PG8_LDB
#undef PG8_MMA
#undef PG8_WAIT_V
#undef PG8_WAIT_L
#undef PG8_BAR
#undef PG8_SCHED
}
}
namespace pg8 {
struct EpiProj {
    static constexpr bool PERM = true, AFTER_DRAIN = false, PROBE_TWICE = true;
    bf16_t* O; int ldc;
    __device__ __forceinline__ void operator()(const f32x4 (&acc)[2][2][4][2], const Unit& u, int wr, int wc, int fr, int fq) const {
        const int row0 = u.pm * BM + wr * 64 + fr; const int col0 = u.pn * BM + wc * 32 + 8 * fq;
#pragma unroll
        for (int ai = 0; ai < 2; ++ai)
#pragma unroll
            for (int m = 0; m < 4; ++m) { bf16_t* rowp = O + (size_t)(row0 + ai * HALF + m * 16) * ldc + col0;
#pragma unroll
                for (int bj = 0; bj < 2; ++bj) { const f32x4 v0 = acc[ai][bj][m][0], v1 = acc[ai][bj][m][1];
                    u32x4 w; w.x = cvt_pk_bf16(v0[0], v0[1]); w.y = cvt_pk_bf16(v0[2], v0[3]); w.z = cvt_pk_bf16(v1[0], v1[1]); w.w = cvt_pk_bf16(v1[2], v1[3]);
                    __builtin_nontemporal_store(w, (u32x4*)(rowp + bj * HALF)); } }
    }
};
struct EpiX1 {
    static constexpr bool PERM = true, AFTER_DRAIN = false, PROBE_TWICE = false;
    const float* x; float* x1; bf16_t* x1s; const float* mod; const float* norm2_g; float* rowstat; PG8_LAS float* tab;
    __device__ __forceinline__ void operator()(const f32x4 (&acc)[2][2][4][2], const Unit& u, int wr, int wc, int fr, int fq) const {
        const int row0 = u.pm * BM + wr * 64 + fr; const int col0 = u.pn * BM + wc * 32 + 8 * fq; const int b = (u.pm * BM) >> 11;
        const float* mb = mod + (size_t)b * 6144;
        f32x4 g1[2][2], g2[2][2];
#pragma unroll
        for (int bj = 0; bj < 2; ++bj)
#pragma unroll
            for (int n = 0; n < 2; ++n) { const int c = col0 + bj * HALF + 4 * n; g1[bj][n] = *(const f32x4*)(mb + 2048 + c);
                const f32x4 sc = *(const f32x4*)(mb + 4096 + c), ng = *(const f32x4*)(norm2_g + c); g2[bj][n] = ng * (sc + 1.0f); }
#pragma unroll
        for (int ai = 0; ai < 2; ++ai)
#pragma unroll
            for (int m = 0; m < 4; ++m) { const size_t row = (size_t)(row0 + ai * HALF + m * 16); const size_t off = row * 1024 + col0; float ss = 0.f;
                const float rfin = tab[((u.pm >> 3) & 1) * 1280 + 1024 + ai * HALF + wr * 64 + m * 16 + fr];
#pragma unroll
                for (int bj = 0; bj < 2; ++bj) {
                    const f32x4 xa = *(const f32x4*)(x + off + bj * HALF), xb = *(const f32x4*)(x + off + bj * HALF + 4);
                    const f32x4 v0 = xa + g1[bj][0] * (acc[ai][bj][m][0] * rfin), v1 = xb + g1[bj][1] * (acc[ai][bj][m][1] * rfin);
                    *(f32x4*)(x1 + off + bj * HALF) = v0; *(f32x4*)(x1 + off + bj * HALF + 4) = v1;
                    ss += (v0[0] * v0[0] + v0[1] * v0[1]) + (v0[2] * v0[2] + v0[3] * v0[3]) + (v1[0] * v1[0] + v1[1] * v1[1]) + (v1[2] * v1[2] + v1[3] * v1[3]);
                    const f32x4 s0 = v0 * g2[bj][0], s1 = v1 * g2[bj][1];
                    u32x4 w; w.x = cvt_pk_bf16(s0[0], s0[1]); w.y = cvt_pk_bf16(s0[2], s0[3]); w.z = cvt_pk_bf16(s1[0], s1[1]); w.w = cvt_pk_bf16(s1[2], s1[3]);
                    *(u32x4*)(x1s + off + bj * HALF) = w; }
                ss += __shfl_xor(ss, 16); ss += __shfl_xor(ss, 32);
                if (fq == 0) atomicAdd(rowstat + row, ss); }
    }
};
typedef _Float16 f16x8 __attribute__((ext_vector_type(8)));
struct EpiScores {
    static constexpr bool PERM = true, AFTER_DRAIN = false, PROBE_TWICE = false;
    _Float16* S; const float* sb; const float* rowstat;
    __device__ __forceinline__ void operator()(const f32x4 (&acc)[2][2][4][2], const Unit& u, int wr, int wc, int fr, int fq) const {
        const int row0 = u.pm * BM + wr * 64 + fr; const int col0 = u.pn * BM + wc * 32 + 8 * fq; const int b = (u.pm * BM) >> 11;
        f32x4 bv[2][2];
#pragma unroll
        for (int bj = 0; bj < 2; ++bj)
#pragma unroll
            for (int n = 0; n < 2; ++n) bv[bj][n] = *(const f32x4*)(sb + (size_t)b * 2048 + col0 + bj * HALF + 4 * n);
#pragma unroll
        for (int ai = 0; ai < 2; ++ai)
#pragma unroll
            for (int m = 0; m < 4; ++m) { const size_t row = (size_t)(row0 + ai * HALF + m * 16); const float rs = __builtin_amdgcn_rsqf(rowstat[row] * (1.0f / 1024.0f) + 1e-6f);
                _Float16* rowp = S + row * 2048 + col0;
#pragma unroll
                for (int bj = 0; bj < 2; ++bj) { const f32x4 v0 = acc[ai][bj][m][0] * rs + bv[bj][0], v1 = acc[ai][bj][m][1] * rs + bv[bj][1];
                    f16x8 h; h[0] = (_Float16)v0[0]; h[1] = (_Float16)v0[1]; h[2] = (_Float16)v0[2]; h[3] = (_Float16)v0[3]; h[4] = (_Float16)v1[0]; h[5] = (_Float16)v1[1]; h[6] = (_Float16)v1[2]; h[7] = (_Float16)v1[3];
                    *(f16x8*)(rowp + bj * HALF) = h; } }
    }
};
struct SegScaleHook {
    __device__ __forceinline__ static void build(PG8_LAS unsigned char* ldsx, const Unit& u, const float* st_ssd, const float* st_s5, int tid) {
        PG8_LAS float* tab = (PG8_LAS float*)ldsx + ((u.pm >> 3) & 1) * 1280;
        if (tid < 256) { const size_t row = (size_t)u.pm * BM + tid; const f32x4* sg = (const f32x4*)(st_ssd + row * 16); const f32x4* s5 = (const f32x4*)(st_s5 + row * 64);
            float r[5];
#pragma unroll
            for (int gI = 0; gI < 4; ++gI) { const f32x4 v = sg[gI]; r[gI] = __builtin_amdgcn_rsqf(((v[0] + v[1]) + (v[2] + v[3])) * (1.0f / 256.0f) + 1e-6f); }
            float a5 = 0.f;
#pragma unroll
            for (int q = 0; q < 16; ++q) { const f32x4 v = s5[q]; a5 += (v[0] + v[1]) + (v[2] + v[3]); }
            r[4] = __builtin_amdgcn_rsqf(a5 * (1.0f / 1024.0f) + 1e-6f);
#pragma unroll
            for (int k = 0; k < 4; ++k) tab[k * 256 + tid] = r[k] * __builtin_amdgcn_rcpf(r[k + 1]);
            tab[1024 + tid] = r[4]; }
    }
    __device__ __forceinline__ void at_tile(int t, const Unit& u, f32x4 (&acc)[2][2][4][2], PG8_LAS unsigned char* ldsx, int wr, int fr) const {
        if (t == 4 || t == 8 || t == 12 || t == 16) { const PG8_LAS float* rt = (const PG8_LAS float*)ldsx + ((u.pm >> 3) & 1) * 1280 + ((t >> 2) - 1) * 256 + wr * 64 + fr;
#pragma unroll
            for (int ai = 0; ai < 2; ++ai)
#pragma unroll
                for (int m = 0; m < 4; ++m) { const float r = rt[ai * HALF + m * 16];
#pragma unroll
                    for (int bj = 0; bj < 2; ++bj) { acc[ai][bj][m][0] = acc[ai][bj][m][0] * r; acc[ai][bj][m][1] = acc[ai][bj][m][1] * r; } } }
    }
};
}
constexpr int NWAVES = 8, NTHR = 512;
constexpr int DM = 1024, NB = 16, SEQ = 2048, MTOK = NB * SEQ;
constexpr int NPROJ = 4096;
constexpr int INW = 4112;
constexpr int NHEADS = 16, HDIM = 64, NGRP = 4, NST = 128, CHUNK = 128;
constexpr int S5G = 64, S5CH = 16, S5P = 64;
constexpr int PH = 8, PK = 16, PNK = 128;
constexpr float EPSF = 1e-6f;
constexpr int NS5PART = 64;

constexpr size_t MiB = 1u << 20;
constexpr size_t WS_CTL = 0, CTL_ZERO_BYTES = 64 * 1024;
constexpr size_t WS_MOD = 1 * MiB;
constexpr size_t WS_WDT = WS_MOD + 0x60000;
constexpr size_t WS_SB = WS_MOD + 0x70000;
constexpr size_t WS_ROWSTAT = WS_MOD + 0x90000;
constexpr size_t WS_S5LB = WS_MOD + 0xB0000;
constexpr size_t WS_S5BB = WS_MOD + 0xC0000;
constexpr size_t WS_DTRAW = 3 * MiB;
constexpr size_t WS_STSSD = 5 * MiB;
constexpr size_t WS_STS5 = 7 * MiB;
constexpr size_t WS_WINT = 15 * MiB;
constexpr size_t WS_WOUTT = 23 * MiB;
constexpr size_t WS_WQKT = 27 * MiB;
constexpr size_t WS_EU = 31 * MiB, WS_EV = 47 * MiB;
constexpr size_t WS_EUS = 63 * MiB, WS_EVS = 63 * MiB + 65536;
constexpr size_t WS_START = 64 * MiB;
constexpr size_t WS_A = 95 * MiB;
constexpr size_t WS_B = 223 * MiB;
constexpr size_t WS_H1 = WS_A, WS_Y = WS_A, WS_PROJ = WS_B, WS_SCORES = WS_A;
constexpr size_t WS_X1S = WS_B + 192 * MiB;
constexpr size_t WS_EID = 479 * MiB, WS_GATE = 495 * MiB;
constexpr size_t WS_H2Q = WS_B, WS_HINV = WS_B + 32 * MiB;
constexpr size_t WS_END = 511 * MiB;
static_assert(WS_SCORES + (size_t)MTOK * 2048 * 4 <= WS_X1S && WS_X1S + (size_t)MTOK * 1024 * 2 <= WS_EID && WS_GATE + (size_t)MTOK * 128 * 4 <= WS_END, "ws map");

constexpr int LDS_MAIN = 159744;
constexpr int MISC_OFF = LDS_MAIN;
constexpr int LDS_BYTES = LDS_MAIN + 128;

#define GAS __attribute__((address_space(1)))
#define LAS __attribute__((address_space(3)))
typedef unsigned short bf16;
typedef unsigned v4u __attribute__((ext_vector_type(4)));
typedef unsigned v2u __attribute__((ext_vector_type(2)));
typedef float f32x4 __attribute__((ext_vector_type(4)));
typedef float f32x2 __attribute__((ext_vector_type(2)));
typedef short bf16x8 __attribute__((ext_vector_type(8)));
#define LDS_WAIT() asm volatile("s_waitcnt lgkmcnt(0)" ::: "memory")
#define VM_WAIT() asm volatile("s_waitcnt vmcnt(0)" ::: "memory")
typedef __bf16 hwbf16x2 __attribute__((ext_vector_type(2)));
__device__ __forceinline__ unsigned pk2(float lo, float hi) { const f32x2 v = {lo, hi}; const hwbf16x2 b = __builtin_convertvector(v, hwbf16x2); return __builtin_bit_cast(unsigned, b); }
__device__ __forceinline__ unsigned f2bf(float f) { return pk2(f, 0.f) & 0xffffu; }
__device__ __forceinline__ float bflo(unsigned w) { return __builtin_bit_cast(float, w << 16); }
__device__ __forceinline__ float bfhi(unsigned w) { return __builtin_bit_cast(float, w & 0xffff0000u); }
__device__ __forceinline__ float bf2f(bf16 v) { return __builtin_bit_cast(float, (unsigned)v << 16); }
__device__ __forceinline__ float wave_sum(float v) {
#pragma unroll
    for (int o = 1; o < 64; o <<= 1) v += __shfl_xor(v, o);
    return v;
}
__device__ __forceinline__ float sigmoid_f(float v) { return __builtin_amdgcn_rcpf(1.0f + __builtin_amdgcn_exp2f(-1.4426950408889634f * v)); }
__device__ __forceinline__ float silu_f(float v) { return v * sigmoid_f(v); }
__device__ __forceinline__ float rsqrt_f(float v) { return __builtin_amdgcn_rsqf(v); }
__device__ __forceinline__ float gelu_erf(float v) {
    const float av = fabsf(v), t = __builtin_amdgcn_rcpf(av * 0.2316418882f + 1.0f);
    float q = t * 0.5307027145f + (-0.7265760135f); q = q * t + 0.7107068705f; q = q * t + (-0.142248368f); q = q * t + 0.127414796f; q = q * t;
    const float e = __builtin_amdgcn_exp2f((v * v) * (-0.72134752044f));
    const float m = v * (q * e);
    return v < 0.f ? m : v - m;
}
__device__ __forceinline__ float softplus_f(float v) { const float e = __builtin_amdgcn_exp2f(-1.4426950408889634f * fabsf(v));
    const float l = e < 1e-6f ? e : 0.6931471805599453f * __builtin_amdgcn_logf(1.0f + e); return fmaxf(v, 0.f) + l; }
__device__ __forceinline__ void unpack8(const v4u w, float* f) { f[0] = bflo(w.x); f[1] = bfhi(w.x); f[2] = bflo(w.y); f[3] = bfhi(w.y); f[4] = bflo(w.z); f[5] = bfhi(w.z); f[6] = bflo(w.w); f[7] = bfhi(w.w); }
#define LDS_BARRIER() do { asm volatile("s_waitcnt lgkmcnt(0)" ::: "memory"); __builtin_amdgcn_s_barrier(); asm volatile("" ::: "memory"); } while (0)
__device__ __forceinline__ float row16_sum_to15(float v) {
    v += __builtin_bit_cast(float, __builtin_amdgcn_update_dpp(0, __builtin_bit_cast(int, v), 0x118, 0xf, 0xf, true));
    v += __builtin_bit_cast(float, __builtin_amdgcn_update_dpp(0, __builtin_bit_cast(int, v), 0x114, 0xf, 0xf, true));
    v += __builtin_bit_cast(float, __builtin_amdgcn_update_dpp(0, __builtin_bit_cast(int, v), 0x112, 0xf, 0xf, true));
    v += __builtin_bit_cast(float, __builtin_amdgcn_update_dpp(0, __builtin_bit_cast(int, v), 0x111, 0xf, 0xf, true));
    return v;
}
__device__ __forceinline__ float wave_sum_to63(float v) {
    v = row16_sum_to15(v);
    v += __builtin_bit_cast(float, __builtin_amdgcn_update_dpp(0, __builtin_bit_cast(int, v), 0x142, 0xa, 0xf, false));
    v += __builtin_bit_cast(float, __builtin_amdgcn_update_dpp(0, __builtin_bit_cast(int, v), 0x143, 0xc, 0xf, false));
    return v;
}
__device__ __forceinline__ f32x2 gelu_pk2(f32x2 v) {
    const f32x2 av = __builtin_elementwise_abs(v), d = av * 0.2316418882f + 1.0f;
    f32x2 t; t[0] = __builtin_amdgcn_rcpf(d[0]); t[1] = __builtin_amdgcn_rcpf(d[1]);
    f32x2 q = t * 0.5307027145f + (-0.7265760135f); q = q * t + 0.7107068705f; q = q * t + (-0.142248368f); q = q * t + 0.127414796f; q = q * t;
    const f32x2 s = (v * v) * (-0.72134752044f);
    f32x2 e; e[0] = __builtin_amdgcn_exp2f(s[0]); e[1] = __builtin_amdgcn_exp2f(s[1]);
    const f32x2 m = v * (q * e), r = v - m;
    f32x2 o; o[0] = v[0] < 0.f ? m[0] : r[0]; o[1] = v[1] < 0.f ? m[1] : r[1]; return o;
}
#define XB_TMO      128
#define XB_XCNT(j)  (256  + 64 * (j))
#define XB_XSUB(j)  (1280 + 64 * (j))
#define XB_XGEN(j)  (2304 + 64 * (j))
#define XB_TOP      3328
#define XB_TOPGEN   3392
#define XCD_BAR_WORDS 3456
#define XB_SPIN_CAP (1u << 18)

__device__ __forceinline__ unsigned xb_ld(unsigned* p)              { return __hip_atomic_load(p, __ATOMIC_RELAXED, __HIP_MEMORY_SCOPE_AGENT); }
__device__ __forceinline__ unsigned xb_add(unsigned* p, unsigned v) { return __hip_atomic_fetch_add(p, v, __ATOMIC_RELAXED, __HIP_MEMORY_SCOPE_AGENT); }
__device__ __forceinline__ unsigned xb_xcc_id() { return (unsigned)__builtin_amdgcn_s_getreg((3 << 11) | 20) & 0xFu; }
#define XB_SPIN(cond, bar) do { unsigned _sp = 0; while (cond) { __builtin_amdgcn_s_sleep(1); \
    if ((++_sp & 255u) == 0u) { if (xb_ld(&(bar)[XB_TMO])) break; if (_sp > XB_SPIN_CAP) { atomicAdd(&(bar)[XB_TMO], 1u); break; } } } } while (0)

struct XcdBarrier {
    unsigned* bar; unsigned x;
    volatile LAS unsigned* st;
};

__device__ __forceinline__ XcdBarrier xcd_barrier_post(unsigned* bar, volatile LAS unsigned* st) {
    XcdBarrier b; b.bar = bar; b.x = xb_xcc_id(); b.st = st;
    if (threadIdx.x == 0) (void)xb_add(&bar[XB_XCNT(b.x)], 1u);
    return b;
}
__device__ __forceinline__ void xcd_barrier_complete(unsigned* bar, unsigned x, unsigned& nloc, unsigned& nx) {
    const unsigned G = gridDim.x * gridDim.y * gridDim.z;
    unsigned sum, cnt, mine, sp = 0u;
    for (;;) {
        sum = 0u; cnt = 0u; mine = 0u;
#pragma unroll
        for (unsigned j = 0; j < 16; ++j) { const unsigned c = xb_ld(&bar[XB_XCNT(j)]); sum += c; cnt += (c > 0u) ? 1u : 0u; mine = (j == x) ? c : mine; }
        if (sum == G) break;
        __builtin_amdgcn_s_sleep(1);
        if ((++sp & 255u) == 0u) { if (xb_ld(&bar[XB_TMO])) break; if (sp > XB_SPIN_CAP) { atomicAdd(&bar[XB_TMO], 1u); break; } }
    }
    nloc = mine > 0u ? mine : 1u; nx = cnt > 0u ? cnt : 1u;
}

__device__ __forceinline__ void xcd_barrier(const XcdBarrier& b) {
    asm volatile("s_waitcnt vmcnt(0)" ::: "memory");
    __syncthreads();
    if (threadIdx.x == 0) {
        unsigned* bar = b.bar;
        __builtin_amdgcn_s_waitcnt(0);
        unsigned nloc = b.st[0], nx = b.st[1];
        if (nloc == 0u) { xcd_barrier_complete(bar, b.x, nloc, nx); b.st[0] = nloc; b.st[1] = nx; }
        const unsigned old = xb_add(&bar[XB_XSUB(b.x)], 1u);
        const unsigned gen = old / nloc;
        if (old + 1u == (gen + 1u) * nloc) {
            __builtin_amdgcn_fence(__ATOMIC_RELEASE, "agent");
            asm volatile("s_waitcnt vmcnt(0)" ::: "memory");
            const unsigned og = xb_add(&bar[XB_TOP], 1u);
            const unsigned tg = og / nx;
            if (og + 1u == (tg + 1u) * nx) xb_add(&bar[XB_TOPGEN], 1u);
            else XB_SPIN(xb_ld(&bar[XB_TOPGEN]) == tg, bar);
            __builtin_amdgcn_fence(__ATOMIC_ACQUIRE, "agent");
            xb_add(&bar[XB_XGEN(b.x)], 1u);
            asm volatile("s_waitcnt vmcnt(0)" ::: "memory");
        } else {
            XB_SPIN(xb_ld(&bar[XB_XGEN(b.x)]) == gen, bar);
            __builtin_amdgcn_fence(__ATOMIC_ACQUIRE, "agent");
            asm volatile("s_waitcnt vmcnt(0)" ::: "memory");
        }
    }
    __syncthreads();
}
struct Args { const float* in[30]; float* out; unsigned char* ws; int ph_lo, ph_hi; };
struct Frame {
    LAS unsigned char* lds;
    volatile LAS unsigned* MISC;
    int vcu, G;
    unsigned char* ws;
    const Args* a;
    float* out;
};
#define WSP(T, off) ((T*)(F.ws + (off)))

__device__ __forceinline__ void transpose_tile(const float* W, int ldw, int k0, int src_n0, bf16* WT, int K, int dst_n0, LAS float* scr, int lane, const float* kscale) {
#pragma unroll 8
    for (int i = 0; i < 32; ++i) { const int kk = 2 * i + (lane >> 5); float v = W[(size_t)(k0 + kk) * ldw + src_n0 + (lane & 31)]; if (kscale) v *= kscale[k0 + kk]; scr[kk * 33 + (lane & 31)] = v; }
    LDS_WAIT(); asm volatile("" ::: "memory");
    const int c = lane & 7;
#pragma unroll
    for (int j = 0; j < 4; ++j) { const int n = (lane >> 3) + 8 * j; const LAS float* s = scr + (8 * c) * 33 + n;
        v4u o; o.x = pk2(s[0 * 33], s[1 * 33]); o.y = pk2(s[2 * 33], s[3 * 33]); o.z = pk2(s[4 * 33], s[5 * 33]); o.w = pk2(s[6 * 33], s[7 * 33]);
        *(v4u*)(WT + (size_t)(dst_n0 + n) * K + k0 + 8 * c) = o; }
    LDS_WAIT(); asm volatile("" ::: "memory");
}
__device__ __forceinline__ void p0_phase(Frame& F) {
    const int f_tid = threadIdx.x, f_lane = f_tid & 63, f_wave = __builtin_amdgcn_readfirstlane(f_tid >> 6);
    const int gw = F.vcu * NWAVES + f_wave, NGW = F.G * NWAVES, gt = F.vcu * NTHR + f_tid, NGT = F.G * NTHR;
    {
        LAS float* sc = (LAS float*)F.lds;
        LAS float* red = (LAS float*)(F.lds + 65536);
        for (int i = f_tid; i < 16 * 1024; i += NTHR) { const int b = i >> 10, k = i & 1023; sc[k * 16 + b] = silu_f((F.a->in[1])[i]); }
        __syncthreads();
        const int ks = f_tid / 24, col = f_tid - ks * 24, j = F.vcu * 24 + col;
        if (ks < 21) {
            float acc[16];
#pragma unroll
            for (int b = 0; b < 16; ++b) acc[b] = 0.f;
            const int k0 = ks * 49, kn = (k0 + 49 <= 1024) ? 49 : (1024 - k0);
            const float* wp = (F.a->in[2]) + (size_t)k0 * 6144 + j;
#pragma unroll 1
            for (int kb = 0; kb < 49; kb += 7) {
                asm volatile("" ::: "memory");
                float wv[7];
#pragma unroll
                for (int u = 0; u < 7; ++u) wv[u] = (kb + u < kn) ? wp[(size_t)(kb + u) * 6144] : 0.f;
#pragma unroll
                for (int u = 0; u < 7; ++u) { const int kk = (kb + u < kn) ? (k0 + kb + u) : k0; const LAS f32x4* s4 = (const LAS f32x4*)(sc + kk * 16);
#pragma unroll
                    for (int q = 0; q < 4; ++q) { const f32x4 sv = s4[q]; acc[4 * q] += sv[0] * wv[u]; acc[4 * q + 1] += sv[1] * wv[u]; acc[4 * q + 2] += sv[2] * wv[u]; acc[4 * q + 3] += sv[3] * wv[u]; } }
            }
#pragma unroll
            for (int b = 0; b < 16; ++b) red[(ks * 16 + b) * 24 + col] = acc[b];
        }
        __syncthreads();
        for (int i = f_tid; i < 16 * 24; i += NTHR) { const int b = i / 24, cc = i - b * 24; float sacc = 0.f;
            for (int q = 0; q < 21; ++q) sacc += red[(q * 16 + b) * 24 + cc];
            WSP(float, WS_MOD)[b * 6144 + F.vcu * 24 + cc] = sacc + (F.a->in[3])[F.vcu * 24 + cc]; }
        __syncthreads();
    }
    {
        LAS float* scr = (LAS float*)(F.lds + f_wave * 16384);
        constexpr int I_IN = (1024 / 64) * (NPROJ / 32), I_OUT = (2048 / 64) * (1024 / 32);
        for (int it = gw; it < I_IN + I_OUT; it += NGW) {
            if (it < I_IN) { const int kb = it / (NPROJ / 32), nb = it % (NPROJ / 32); const int dn = 32 * nb, sn = dn < 3072 ? dn : dn + 16;
                transpose_tile((F.a->in[5]), INW, 64 * kb, sn, WSP(bf16, WS_WINT), 1024, dn, scr, f_lane, nullptr); }
            else { const int r = it - I_IN, kb = r / 32, nb = r % 32; const int k0 = 64 * kb;
                transpose_tile((F.a->in[23]), 1024, k0, 32 * nb, WSP(bf16, WS_WOUTT), 2048, 32 * nb, scr, f_lane, k0 < 1024 ? (F.a->in[11]) : (F.a->in[22]) - 1024); }
        }
    }
    for (int i = gt; i < 16 * 1024; i += NGT) { const int h = i >> 10, k = i & 1023; WSP(float, WS_WDT)[i] = (F.a->in[5])[(size_t)k * INW + 3072 + h]; }
    for (int task = gw; task < 2048; task += NGW) {
        const int nt = task >> 4, ks = task & 15, n0 = 16 * nt, hc = n0 >> 7, k0 = 64 * ks;
        const int li = f_lane & 15, lq = f_lane >> 4;
        f32x4 acc[4];
#pragma unroll
        for (int s = 0; s < 4; ++s) acc[s] = (f32x4){0.f, 0.f, 0.f, 0.f};
        const float* ap = (F.a->in[26]) + (size_t)(n0 + li) * 128 + 4 * lq;
        const float* bp = (F.a->in[25]) + (size_t)(k0 + li) * 2048 + hc * 128 + 4 * lq;
#pragma unroll
        for (int q = 0; q < 8; ++q) { const f32x4 a = *(const f32x4*)(ap + 16 * q);
#pragma unroll
            for (int s = 0; s < 4; ++s) { const f32x4 b = *(const f32x4*)(bp + (size_t)(16 * s) * 2048 + 16 * q);
#pragma unroll
                for (int jj = 0; jj < 4; ++jj) acc[s] = __builtin_amdgcn_mfma_f32_16x16x4f32(a[jj], b[jj], acc[s], 0, 0, 0); } }
        bf16* o = WSP(bf16, WS_WQKT);
#pragma unroll
        for (int s = 0; s < 4; ++s)
#pragma unroll
            for (int r = 0; r < 4; ++r) o[(size_t)(n0 + 4 * lq + r) * 1024 + k0 + 16 * s + li] = (bf16)f2bf(acc[s][r]);
    }
    for (int i = gt; i < S5G * S5P; i += NGT) {
        const float lr = (F.a->in[12])[i], li = (F.a->in[13])[i], dt = expf((F.a->in[14])[i >> 6]);
        const float mag = expf(lr * dt); float sn, cs; sincosf(li * dt, &sn, &cs);
        const float lbr = mag * cs, lbi = mag * sn, den = lr * lr + li * li;
        const float cfr = ((lbr - 1.0f) * lr + lbi * li) / den, cfi = (lbi * lr - (lbr - 1.0f) * li) / den;
        WSP(float, WS_S5LB)[2 * i] = lbr; WSP(float, WS_S5LB)[2 * i + 1] = lbi;
        for (int hh = 0; hh < 16; ++hh) { const float br = (F.a->in[15])[i * 16 + hh], bi = (F.a->in[16])[i * 16 + hh];
            WSP(float, WS_S5BB)[i * 32 + hh] = cfr * br - cfi * bi; WSP(float, WS_S5BB)[i * 32 + 16 + hh] = cfr * bi + cfi * br; }
    }
    for (int i = gt; i < MTOK; i += NGT) WSP(float, WS_ROWSTAT)[i] = 0.f;
}

__device__ __forceinline__ void p1_phase(Frame& F) {
    const int f_tid = threadIdx.x, f_lane = f_tid & 63, f_wave = __builtin_amdgcn_readfirstlane(f_tid >> 6);
    const int gw = F.vcu * NWAVES + f_wave;
    LAS float* wdt = (LAS float*)F.lds;
    for (int i = f_tid; i < 16 * 1024 / 4; i += NTHR) ((LAS f32x4*)wdt)[i] = ((const f32x4*)WSP(float, WS_WDT))[i];
    __syncthreads();
    const int lane = f_lane;
    for (int wq = gw; wq < MTOK / 16; wq += F.G * NWAVES) {
        const int b = wq >> 7; const float* mb = WSP(float, WS_MOD) + (size_t)b * 6144;
        f32x4 Gv[4], Sv[4];
#pragma unroll
        for (int j = 0; j < 4; ++j) { const int k = 4 * lane + 256 * j; const f32x4 g = *(const f32x4*)((F.a->in[4]) + k), sc = *(const f32x4*)(mb + 1024 + k); Gv[j] = g * (sc + 1.0f); Sv[j] = *(const f32x4*)(mb + k); }
        f32x4 nx[4];
#pragma unroll
        for (int j = 0; j < 4; ++j) nx[j] = *(const f32x4*)((F.a->in[0]) + (size_t)wq * 16 * 1024 + 4 * lane + 256 * j);
        for (int tt = 0; tt < 16; ++tt) {
            asm volatile("" ::: "memory");
            const size_t t = (size_t)wq * 16 + tt; const float* xr = (F.a->in[0]) + t * 1024;
            f32x4 v[4]; float ss = 0.f;
#pragma unroll
            for (int j = 0; j < 4; ++j) { v[j] = nx[j]; ss += (v[j][0] * v[j][0] + v[j][1] * v[j][1]) + (v[j][2] * v[j][2] + v[j][3] * v[j][3]); }
            if (tt < 15) {
#pragma unroll
                for (int j = 0; j < 4; ++j) nx[j] = *(const f32x4*)(xr + 1024 + 4 * lane + 256 * j); }
            const float rstd = rsqrt_f(wave_sum(ss) * (1.0f / 1024.0f) + EPSF);
            bf16* hr = WSP(bf16, WS_H1) + t * 1024;
#pragma unroll
            for (int j = 0; j < 4; ++j) { v[j] = v[j] * rstd * Gv[j] + Sv[j]; v2u w; w.x = pk2(v[j][0], v[j][1]); w.y = pk2(v[j][2], v[j][3]); *(v2u*)(hr + 4 * lane + 256 * j) = w; }
            float d[16];
#pragma unroll
            for (int h = 0; h < 16; ++h) { float a = 0.f;
#pragma unroll
                for (int j = 0; j < 4; ++j) { const f32x4 w = *(const LAS f32x4*)(wdt + h * 1024 + 4 * lane + 256 * j); a += (v[j][0] * w[0] + v[j][1] * w[1]) + (v[j][2] * w[2] + v[j][3] * w[3]); }
                d[h] = a; }
            float e8[8], e4[4], e2[2], e1;
#pragma unroll
            for (int i = 0; i < 8; ++i) { const bool up = lane & 32; const float snd = up ? d[i] : d[i + 8]; const float rcv = __shfl_xor(snd, 32); e8[i] = (up ? d[i + 8] : d[i]) + rcv; }
#pragma unroll
            for (int i = 0; i < 4; ++i) { const bool up = lane & 16; const float snd = up ? e8[i] : e8[i + 4]; const float rcv = __shfl_xor(snd, 16); e4[i] = (up ? e8[i + 4] : e8[i]) + rcv; }
#pragma unroll
            for (int i = 0; i < 2; ++i) { const bool up = lane & 8; const float snd = up ? e4[i] : e4[i + 2]; const float rcv = __shfl_xor(snd, 8); e2[i] = (up ? e4[i + 2] : e4[i]) + rcv; }
            { const bool up = lane & 4; const float snd = up ? e2[0] : e2[1]; const float rcv = __shfl_xor(snd, 4); e1 = (up ? e2[1] : e2[0]) + rcv; }
            e1 += __shfl_xor(e1, 2); e1 += __shfl_xor(e1, 1);
            const int head = ((lane >> 5) & 1) * 8 + ((lane >> 4) & 1) * 4 + ((lane >> 3) & 1) * 2 + ((lane >> 2) & 1);
            if ((lane & 3) == 0) WSP(float, WS_DTRAW)[t * 16 + head] = e1;
        }
    }
    for (int n = gw; n < 2048; n += F.G * NWAVES) {
        const bf16* wr = WSP(bf16, WS_WQKT) + (size_t)n * 1024 + 16 * lane;
        const v4u w0 = *(const v4u*)wr, w1 = *(const v4u*)(wr + 8);
        float wv[16]; wv[0] = bflo(w0.x); wv[1] = bfhi(w0.x); wv[2] = bflo(w0.y); wv[3] = bfhi(w0.y); wv[4] = bflo(w0.z); wv[5] = bfhi(w0.z); wv[6] = bflo(w0.w); wv[7] = bfhi(w0.w);
        wv[8] = bflo(w1.x); wv[9] = bfhi(w1.x); wv[10] = bflo(w1.y); wv[11] = bfhi(w1.y); wv[12] = bflo(w1.z); wv[13] = bfhi(w1.z); wv[14] = bflo(w1.w); wv[15] = bfhi(w1.w);
        for (int b = 0; b < 16; ++b) { const float* sp = WSP(float, WS_MOD) + (size_t)b * 6144 + 3072 + 16 * lane; float a = 0.f;
#pragma unroll
            for (int q = 0; q < 4; ++q) { const f32x4 s = *(const f32x4*)(sp + 4 * q); a += (s[0] * wv[4 * q] + s[1] * wv[4 * q + 1]) + (s[2] * wv[4 * q + 2] + s[3] * wv[4 * q + 3]); }
            a = wave_sum(a); if (lane == 0) WSP(float, WS_SB)[b * 2048 + n] = a; }
    }
}
__device__ __forceinline__ void p3pre_conv(Frame& F) {
    const int tid = threadIdx.x;
    const bf16* proj = WSP(bf16, WS_PROJ); bf16* xo = (bf16*)F.out;
    for (int item = F.vcu * NTHR + tid; item < (MTOK / 16) * 256; item += F.G * NTHR) {
        const int oc = item & 255, run = item >> 8; const int t0 = run * 16, ch = 8 * oc;
        const bool halo = (t0 & (SEQ - 1)) != 0;
        v4u rw[19];
#pragma unroll
        for (int k = 0; k < 19; ++k) { rw[k] = (v4u){0u, 0u, 0u, 0u}; if (k >= 3 || halo) rw[k] = *(const v4u*)(proj + (size_t)(t0 - 3 + k) * NPROJ + 1024 + ch); }
        float cw[4][8], cbv[8];
#pragma unroll
        for (int k = 0; k < 4; ++k) { const f32x4 w0 = *(const f32x4*)((F.a->in[6]) + k * 2048 + ch), w1 = *(const f32x4*)((F.a->in[6]) + k * 2048 + ch + 4);
#pragma unroll
            for (int e = 0; e < 4; ++e) { cw[k][e] = w0[e]; cw[k][4 + e] = w1[e]; } }
        { const f32x4 b0 = *(const f32x4*)((F.a->in[7]) + ch), b1 = *(const f32x4*)((F.a->in[7]) + ch + 4);
#pragma unroll
            for (int e = 0; e < 4; ++e) { cbv[e] = b0[e]; cbv[4 + e] = b1[e]; } }
        float r0[8], r1[8], r2[8];
        unpack8(rw[0], r0); unpack8(rw[1], r1); unpack8(rw[2], r2);
#pragma unroll
        for (int tt = 0; tt < 16; ++tt) {
            float r3[8]; unpack8(rw[3 + tt], r3);
            float v[8];
#pragma unroll
            for (int i = 0; i < 8; ++i) { v[i] = silu_f(cbv[i] + r0[i] * cw[0][i] + r1[i] * cw[1][i] + r2[i] * cw[2][i] + r3[i] * cw[3][i]); r0[i] = r1[i]; r1[i] = r2[i]; r2[i] = r3[i]; }
            *(v4u*)(xo + (size_t)(t0 + tt) * 2048 + ch) = (v4u){pk2(v[0], v[1]), pk2(v[2], v[3]), pk2(v[4], v[5]), pk2(v[6], v[7])};
        }
    }
}
constexpr int SSD_PITCH = 272;
__device__ __forceinline__ bf16x8 lds_frag(LAS unsigned char* base, int row, int kbyte) { return *(const LAS bf16x8*)(base + row * SSD_PITCH + kbyte); }
#ifdef PROBE_SSD
#define SPR_T(v) const unsigned long long v = __builtin_amdgcn_s_memtime();
#define SPR_ACC(i, d) sacc[i] += (d);
#else
#define SPR_T(v)
#define SPR_ACC(i, d)
#endif
constexpr int S3_CS = 0, S3_BS = 34816, S3_GY = 69632, S3_XDT = 104448, S3_XP = 144, S3_PREV = 122880, S3_CSF = 140288, S3_DTF = 141312, S3_WTS = 142336, S3_END = 143360;
static_assert(S3_END <= LDS_MAIN, "SSD v3 LDS map");
typedef short v4i16_t __attribute__((ext_vector_type(4)));
__device__ __forceinline__ bf16x8 lds_frag_tr(LAS unsigned char* tile, int pitch, int k0, int col0, int li, int lq) {
    LAS unsigned char* p = tile + (k0 + 8 * lq + (li >> 2)) * pitch + (col0 + 4 * (li & 3)) * 2;
    const v4i16_t lo = __builtin_amdgcn_ds_read_tr16_b64_v4i16((LAS v4i16_t*)p), hi = __builtin_amdgcn_ds_read_tr16_b64_v4i16((LAS v4i16_t*)(p + 4 * pitch));
    return __builtin_shufflevector(lo, hi, 0, 1, 2, 3, 4, 5, 6, 7);
}
struct Ssd3Pre { v4u xr[4], br[4], cr[4]; float d0, d1; };
__device__ __forceinline__ void ssd3_prefetch(Ssd3Pre& P, const char* xcb, const float* dtr, unsigned voB, unsigned voX, int tid, int lane, int w) {
#pragma unroll
    for (int r = 0; r < 4; ++r) { P.br[r] = *(const v4u*)(xcb + (voB + r * 4096u)); P.cr[r] = *(const v4u*)(xcb + (voB + 1024u + r * 4096u)); }
#pragma unroll
    for (int r = 0; r < 4; ++r) P.xr[r] = *(const v4u*)(xcb + (voX + r * 4096u));
    P.d0 = dtr[lane * 32]; P.d1 = dtr[lane * 32 + 16];
}
__device__ __forceinline__ void ssd3_cumsum(LAS unsigned char* L, int par, float r0, float r1, float dtb, float A, int lane) {
    LAS float* csf = (LAS float*)(L + S3_CSF + par * 512); LAS float* dtf = (LAS float*)(L + S3_DTF + par * 512); LAS float* wts = (LAS float*)(L + S3_WTS + par * 512);
    const float d0 = softplus_f(r0 + dtb), d1 = softplus_f(r1 + dtb);
    const float a0 = d0 * A, a1 = d1 * A; float s = a0 + a1;
#pragma unroll
    for (int o = 1; o < 64; o <<= 1) { const float t = __shfl_up(s, o); if (lane >= o) s += t; }
    const float tot = __shfl(s, 63);
    dtf[2 * lane] = d0; dtf[2 * lane + 1] = d1; csf[2 * lane] = s - a1; csf[2 * lane + 1] = s;
    wts[2 * lane] = __expf(tot - (s - a1)); wts[2 * lane + 1] = __expf(tot - s);
}
__device__ __forceinline__ void p3_ssd3(Frame& F) {
    const int tid0 = threadIdx.x, w = __builtin_amdgcn_readfirstlane(tid0 >> 6);
    LAS unsigned char* L = F.lds;
    const bf16* proj = WSP(bf16, WS_PROJ); const bf16* xc = (const bf16*)F.out; const float* dtraw = WSP(float, WS_DTRAW);
    for (int item = F.vcu; item < NB * NHEADS; item += F.G) {
        const int b = item >> 4, h = item & 15, g = h >> 2;
        int tid = tid0; asm volatile("" : "+v"(tid)); int lane = tid & 63;
        const float A = -__expf((F.a->in[9])[h]), Dh = (F.a->in[10])[h], dtb = (F.a->in[8])[h];
        const int pbs = w >> 1, nb0 = 4 * (w & 1);
        f32x4 st[4];
#pragma unroll
        for (int j = 0; j < 4; ++j) st[j] = (f32x4){0.f, 0.f, 0.f, 0.f};
        __syncthreads();
        for (int i = tid; i < 17408 / 16; i += NTHR) ((LAS v4u*)(L + S3_PREV))[i] = (v4u){0u, 0u, 0u, 0u};
        Ssd3Pre P;
        { const unsigned voB0 = (unsigned)((4 * (tid >> 4)) * 2048 + 1024 + g * 128 + 8 * (tid & 15)) * 2u, voX0 = (unsigned)((4 * ((tid & 255) >> 3)) * 2048 + h * 64 + 8 * (tid & 7)) * 2u;
          ssd3_prefetch(P, (const char*)xc + (size_t)b * SEQ * 4096, dtraw + (size_t)b * SEQ * 16 + h, voB0, voX0, tid, lane, w); }
        if (w == 0) ssd3_cumsum(L, 0, P.d0, P.d1, dtb, A, lane);
        __syncthreads();
#ifdef PROBE_SSD
        unsigned long long sacc[8] = {0, 0, 0, 0, 0, 0, 0, 0};
#endif
        for (int c = 0; c < SEQ / CHUNK; ++c) {
            SPR_T(s0)
            const size_t row0 = (size_t)b * SEQ + (size_t)c * CHUNK; const int par = c & 1;
            asm volatile("" : "+v"(tid));
            lane = tid & 63; const int li = lane & 15, lq = lane >> 4;
            const unsigned voB = (unsigned)((4 * (tid >> 4)) * 2048 + 1024 + g * 128 + 8 * (tid & 15)) * 2u, voX = (unsigned)((4 * ((tid & 255) >> 3)) * 2048 + h * 64 + 8 * (tid & 7)) * 2u;
            const unsigned voZ0 = (unsigned)((tid >> 3) * NPROJ + h * 64 + 8 * (tid & 7)) * 2u, voZ1 = voZ0 + 64u * NPROJ * 2u;
            LAS float* csf = (LAS float*)(L + S3_CSF + par * 512); LAS float* dtf = (LAS float*)(L + S3_DTF + par * 512); LAS float* wts = (LAS float*)(L + S3_WTS + par * 512);
            { const int ob = tid & 15, lb = 4 * (tid >> 4), n0 = 8 * ob;
#pragma unroll
              for (int r = 0; r < 4; ++r) { *(LAS v4u*)(L + S3_BS + (lb + r) * SSD_PITCH + n0 * 2) = P.br[r]; *(LAS v4u*)(L + S3_CS + (lb + r) * SSD_PITCH + n0 * 2) = P.cr[r]; } }
            if (tid < 256) { const int ox = tid & 7, lx = 4 * (tid >> 3), p0 = 8 * ox;
#pragma unroll
              for (int r = 0; r < 4; ++r) { float xv[8]; unpack8(P.xr[r], xv); const float tw = dtf[lx + r];
                  *(LAS v4u*)(L + S3_XDT + (lx + r) * S3_XP + p0 * 2) = (v4u){pk2(xv[0] * tw, xv[1] * tw), pk2(xv[2] * tw, xv[3] * tw), pk2(xv[4] * tw, xv[5] * tw), pk2(xv[6] * tw, xv[7] * tw)}; } }
            const char* prb = (const char*)proj + row0 * (NPROJ * 2);
            const v4u zc0 = *(const v4u*)(prb + voZ0), zc1 = *(const v4u*)(prb + voZ1);
            SPR_T(s1) SPR_ACC(0, s1 - s0)
            LDS_BARRIER();
            SPR_T(s2) SPR_ACC(1, s2 - s1)
            const float cs_end = csf[127];
            bf16x8 ca[4];
#pragma unroll
            for (int ks = 0; ks < 4; ++ks) ca[ks] = lds_frag(L + S3_CS, 16 * w + li, 64 * ks + 16 * lq);
            float csl[4];
#pragma unroll
            for (int r = 0; r < 4; ++r) csl[r] = csf[16 * w + 4 * lq + r];
            { bf16x8 bq[2][4];
#pragma unroll
              for (int ks = 0; ks < 4; ++ks) bq[0][ks] = lds_frag(L + S3_BS, li, 64 * ks + 16 * lq);
#pragma unroll
              for (int sb = 0; sb < 8; ++sb) if (sb <= (w | 1)) {
                  f32x4 cbv = (f32x4){0.f, 0.f, 0.f, 0.f};
                  const int s = 16 * sb + li; const float css = csf[s];
                  if (sb <= w) {
                      if (sb + 1 <= w) {
#pragma unroll
                          for (int ks = 0; ks < 4; ++ks) bq[(sb + 1) & 1][ks] = lds_frag(L + S3_BS, 16 * (sb + 1) + li, 64 * ks + 16 * lq); }
                      __builtin_amdgcn_sched_barrier(0);
#pragma unroll
                      for (int ks = 0; ks < 4; ++ks) cbv = __builtin_amdgcn_mfma_f32_16x16x32_bf16(ca[ks], bq[sb & 1][ks], cbv, 0, 0, 0);
                      __builtin_amdgcn_sched_barrier(0); }
#pragma unroll
                  for (int r = 0; r < 4; ++r) { const int l = 16 * w + 4 * lq + r; const float gv = (s <= l) ? cbv[r] * __expf(csl[r] - css) : 0.f;
                      *(LAS unsigned short*)(L + S3_GY + l * SSD_PITCH + s * 2) = (unsigned short)f2bf(gv); } } }
            LDS_WAIT(); asm volatile("" ::: "memory");
            SPR_T(s3) SPR_ACC(2, s3 - s2)
            f32x4 yd[4], yo[4];
#pragma unroll
            for (int pb = 0; pb < 4; ++pb) { yd[pb] = (f32x4){0.f, 0.f, 0.f, 0.f}; yo[pb] = (f32x4){0.f, 0.f, 0.f, 0.f}; }
            { bf16x8 gq[2], xq[2][4];
              gq[0] = lds_frag(L + S3_GY, 16 * w + li, 16 * lq);
#pragma unroll
              for (int pb = 0; pb < 4; ++pb) xq[0][pb] = lds_frag_tr(L + S3_XDT, S3_XP, 0, 16 * pb, li, lq);
#pragma unroll
              for (int ks = 0; ks < 4; ++ks) if (ks <= (w >> 1)) {
                  if (ks + 1 <= (w >> 1)) { gq[(ks + 1) & 1] = lds_frag(L + S3_GY, 16 * w + li, 64 * (ks + 1) + 16 * lq);
#pragma unroll
                      for (int pb = 0; pb < 4; ++pb) xq[(ks + 1) & 1][pb] = lds_frag_tr(L + S3_XDT, S3_XP, 32 * (ks + 1), 16 * pb, li, lq); }
                  __builtin_amdgcn_sched_barrier(0);
#pragma unroll
                  for (int pb = 0; pb < 4; ++pb) yd[pb] = __builtin_amdgcn_mfma_f32_16x16x32_bf16(gq[ks & 1], xq[ks & 1][pb], yd[pb], 0, 0, 0);
                  __builtin_amdgcn_sched_barrier(0); } }
            { bf16x8 pq[2][4];
#pragma unroll
              for (int pb = 0; pb < 4; ++pb) pq[0][pb] = lds_frag(L + S3_PREV, 16 * pb + li, 16 * lq);
#pragma unroll
              for (int ks = 0; ks < 4; ++ks) {
                  if (ks < 3) {
#pragma unroll
                      for (int pb = 0; pb < 4; ++pb) pq[(ks + 1) & 1][pb] = lds_frag(L + S3_PREV, 16 * pb + li, 64 * (ks + 1) + 16 * lq); }
                  __builtin_amdgcn_sched_barrier(0);
#pragma unroll
                  for (int pb = 0; pb < 4; ++pb) yo[pb] = __builtin_amdgcn_mfma_f32_16x16x32_bf16(ca[ks], pq[ks & 1][pb], yo[pb], 0, 0, 0);
                  __builtin_amdgcn_sched_barrier(0); } }
#pragma unroll
            for (int r = 0; r < 4; ++r) { const float e = __expf(csl[r]);
#pragma unroll
                for (int pb = 0; pb < 4; ++pb) *(LAS float*)(L + S3_GY + (16 * w + 4 * lq + r) * SSD_PITCH + (16 * pb + li) * 4) = yd[pb][r] + e * yo[pb][r]; }
            { const size_t rown = row0 + (c + 1 < SEQ / CHUNK ? CHUNK : 0);
              ssd3_prefetch(P, (const char*)xc + rown * 4096, dtraw + rown * 16 + h, voB, voX, tid, lane, w); }
            SPR_T(s4) SPR_ACC(3, s4 - s3)
            LDS_BARRIER();
            SPR_T(s5) SPR_ACC(4, s5 - s4)
            { const float dec = __expf(cs_end);
#pragma unroll
              for (int j = 0; j < 4; ++j) st[j] = st[j] * dec;
              bf16x8 xq[2], bq2[2][4]; f32x4 wq[2][2];
              xq[0] = lds_frag_tr(L + S3_XDT, S3_XP, 0, 16 * pbs, li, lq); wq[0][0] = *(const LAS f32x4*)(wts + 8 * lq); wq[0][1] = *(const LAS f32x4*)(wts + 8 * lq + 4);
#pragma unroll
              for (int j = 0; j < 4; ++j) bq2[0][j] = lds_frag_tr(L + S3_BS, SSD_PITCH, 0, 16 * (nb0 + j), li, lq);
#pragma unroll
              for (int ks = 0; ks < 4; ++ks) {
                  if (ks < 3) { xq[(ks + 1) & 1] = lds_frag_tr(L + S3_XDT, S3_XP, 32 * (ks + 1), 16 * pbs, li, lq); wq[(ks + 1) & 1][0] = *(const LAS f32x4*)(wts + 32 * (ks + 1) + 8 * lq); wq[(ks + 1) & 1][1] = *(const LAS f32x4*)(wts + 32 * (ks + 1) + 8 * lq + 4);
#pragma unroll
                      for (int j = 0; j < 4; ++j) bq2[(ks + 1) & 1][j] = lds_frag_tr(L + S3_BS, SSD_PITCH, 32 * (ks + 1), 16 * (nb0 + j), li, lq); }
                  __builtin_amdgcn_sched_barrier(0);
                  const f32x4 w0 = wq[ks & 1][0], w1 = wq[ks & 1][1];
                  float xv[8]; unpack8(__builtin_bit_cast(v4u, xq[ks & 1]), xv);
                  const v4u xw = (v4u){pk2(xv[0] * w0[0], xv[1] * w0[1]), pk2(xv[2] * w0[2], xv[3] * w0[3]), pk2(xv[4] * w1[0], xv[5] * w1[1]), pk2(xv[6] * w1[2], xv[7] * w1[3])};
                  const bf16x8 xf = __builtin_bit_cast(bf16x8, xw);
#pragma unroll
                  for (int j = 0; j < 4; ++j) st[j] = __builtin_amdgcn_mfma_f32_16x16x32_bf16(xf, bq2[ks & 1][j], st[j], 0, 0, 0);
                  __builtin_amdgcn_sched_barrier(0); }
#pragma unroll
              for (int j = 0; j < 4; ++j)
#pragma unroll
                  for (int r = 0; r < 4; ++r) *(LAS unsigned short*)(L + S3_PREV + (16 * pbs + 4 * lq + r) * SSD_PITCH + (16 * (nb0 + j) + li) * 2) = (unsigned short)f2bf(st[j][r]); }
            SPR_T(s6) SPR_ACC(5, s6 - s5)
#pragma unroll
            for (int k = 0; k < 2; ++k) { const int it = tid + 512 * k, l = it >> 3, o = it & 7; const size_t row = row0 + l;
                const f32x4 y0 = *(const LAS f32x4*)(L + S3_GY + l * SSD_PITCH + 32 * o), y1 = *(const LAS f32x4*)(L + S3_GY + l * SSD_PITCH + 32 * o + 16);
                const v4u xw = *(const LAS v4u*)(L + S3_XDT + l * S3_XP + 16 * o); const v4u zw = k == 0 ? zc0 : zc1; const float dsk = Dh * __builtin_amdgcn_rcpf(fmaxf(dtf[l], 1e-30f));
                float xv[8], zv[8], yv[8]; unpack8(xw, xv); unpack8(zw, zv);
                float ss = 0.f;
#pragma unroll
                for (int e = 0; e < 8; ++e) { const float yy = (e < 4 ? y0[e] : y1[e - 4]) + dsk * xv[e]; yv[e] = yy * silu_f(zv[e]); ss += yv[e] * yv[e]; }
                ss += __shfl_xor(ss, 1); ss += __shfl_xor(ss, 2); ss += __shfl_xor(ss, 4);
                if (o == 0) WSP(float, WS_STSSD)[row * 16 + h] = ss;
                *(v4u*)(WSP(bf16, WS_Y) + row * 2048 + h * 64 + 8 * o) = (v4u){pk2(yv[0], yv[1]), pk2(yv[2], yv[3]), pk2(yv[4], yv[5]), pk2(yv[6], yv[7])}; }
            if (w == 0 && c + 1 < SEQ / CHUNK) ssd3_cumsum(L, par ^ 1, P.d0, P.d1, dtb, A, lane);
            SPR_T(s7) SPR_ACC(6, s7 - s6)
            LDS_BARRIER();
            SPR_T(s8) SPR_ACC(7, s8 - s7)
        }
#ifdef PROBE_SSD
        if (blockIdx.x == 0 && threadIdx.x == PROBE_TID) *(volatile float*)(F.ws + WS_CTL + 40000) = (float)sacc[PROBE_SSD] * 1e-3f;
#endif
    }
}
typedef float f32x16 __attribute__((ext_vector_type(16)));
#ifdef PROBE_SEL
#define PR_T(v) const unsigned long long v = __builtin_amdgcn_s_memtime();
#define PR_ACC(a, d) a += (d);
#define PR_OUT(i, a) if (PROBE_SEL == (i) && blockIdx.x == 0 && threadIdx.x == 0) *(volatile float*)(F.ws + WS_CTL + 40000) = (float)(a) * 1e-4f;
#define PR_OUT4(i, a) if (PROBE_SEL == (i) && blockIdx.x == 0 && threadIdx.x == 256) *(volatile float*)(F.ws + WS_CTL + 40000) = (float)(a) * 1e-4f;
#else
#define PR_T(v)
#define PR_ACC(a, d)
#define PR_OUT(i, a)
#define PR_OUT4(i, a)
#endif
constexpr int S5V_BU = 0, S5V_BUP = 2056, S5V_BUSZ = 16 * S5V_BUP, S5V_XT = 2 * S5V_BUSZ, S5V_XTP = 1040, S5V_XTSZ = 16 * S5V_XTP, S5V_VS = S5V_XT + 2 * S5V_XTSZ, S5V_OT = S5V_VS + 4 * 512, S5V_OTP = 144, S5V_OTSZ = 16 * S5V_OTP, S5V_END = S5V_OT + 2 * S5V_OTSZ;
static_assert(S5V_END <= LDS_MAIN, "S5 v2 LDS map");
__device__ __forceinline__ void p3_s5v2(Frame& F) {
    const int tid = threadIdx.x, lane = tid & 63, w = __builtin_amdgcn_readfirstlane(tid >> 6);
    const int li = lane & 15, lq = lane >> 4;
    LAS unsigned char* L = F.lds;
    const bf16* proj = WSP(bf16, WS_PROJ);
    constexpr int NT = SEQ / 16;
#ifdef PROBE_S5
    const unsigned long long pr_t0 = PROBE_CLOCK();
#endif
    for (int item = F.vcu; item < NB * 16; item += F.G) {
        const int b = item >> 4, gs = item & 15;
        const bool scanw = w < 4; const int gl = w & 3, g = gs * 4 + gl;
        const bf16* ubase = proj + (size_t)b * SEQ * NPROJ + 3072 + gs * 64 + gl * 16;
        __syncthreads();
        if (scanw) {
            __builtin_amdgcn_s_setprio(2);
            const float lbr = WSP(float, WS_S5LB)[(g * 64 + lane) * 2], lbi = WSP(float, WS_S5LB)[(g * 64 + lane) * 2 + 1], nlbi = -lbi;
            bf16x8 bfr[8];
#pragma unroll
            for (int cb = 0; cb < 8; ++cb) { v4u v = (v4u){0u, 0u, 0u, 0u};
                if (lq < 2) { const int col = 16 * cb + li; const float* src = WSP(float, WS_S5BB) + (g * 64 + (col >> 1)) * 32 + (col & 1) * 16 + 8 * lq; const f32x4 a0 = *(const f32x4*)src, a1 = *(const f32x4*)(src + 4);
                    v = (v4u){pk2(a0[0], a0[1]), pk2(a0[2], a0[3]), pk2(a1[0], a1[1]), pk2(a1[2], a1[3])}; }
                bfr[cb] = __builtin_bit_cast(bf16x8, v); }
            float xr = 0.f, xi = 0.f;
            const int lq2 = lq & 1;
            v4u ua = *(const v4u*)(ubase + (size_t)li * NPROJ + 8 * lq2);
            { const bf16x8 af = __builtin_bit_cast(bf16x8, lq < 2 ? ua : (v4u){0u, 0u, 0u, 0u});
              ua = *(const v4u*)(ubase + (size_t)(16 + li) * NPROJ + 8 * lq2);
#pragma unroll
              for (int cb = 0; cb < 8; ++cb) { f32x4 acc = (f32x4){0.f, 0.f, 0.f, 0.f}; acc = __builtin_amdgcn_mfma_f32_16x16x32_bf16(af, bfr[cb], acc, 0, 0, 0);
#pragma unroll
                  for (int r = 0; r < 4; ++r) *(LAS float*)(L + S5V_BU + (4 * lq + r) * S5V_BUP + (gl * 128 + 16 * cb + li) * 4) = acc[r]; } }
            LDS_BARRIER();
            unsigned long long pa0 = 0, pa1 = 0, pa2 = 0;
            for (int k = 0; k <= NT; ++k) {
                PR_T(pt0)
                if (k < NT) {
                    const LAS f32x2* bp = (const LAS f32x2*)(L + S5V_BU + (k & 1) * S5V_BUSZ + (gl * 128 + 2 * lane) * 4);
                    LAS unsigned* xp = (LAS unsigned*)(L + S5V_XT + (k & 1) * S5V_XTSZ + (gl * 128 + 2 * lane) * 2);
                    f32x2 bu[16];
#pragma unroll
                    for (int t = 0; t < 16; ++t) bu[t] = bp[t * (S5V_BUP / 8)];
                    unsigned xo[16];
#pragma unroll
                    for (int t = 0; t < 16; ++t) {
                        const float a = __builtin_fmaf(nlbi, xi, bu[t][0]), bq = __builtin_fmaf(lbi, xr, bu[t][1]);
                        const float nr = __builtin_fmaf(lbr, xr, a), ni = __builtin_fmaf(lbr, xi, bq); xr = nr; xi = ni; xo[t] = pk2(xr, xi); }
#pragma unroll
                    for (int t = 0; t < 16; ++t) xp[t * (S5V_XTP / 4)] = xo[t];
                    PR_T(pt1) PR_ACC(pa0, pt1 - pt0)
                    if (k + 1 < NT) {
                        const bf16x8 af = __builtin_bit_cast(bf16x8, lq < 2 ? ua : (v4u){0u, 0u, 0u, 0u});
                        { const int kn = k + 2 < NT ? k + 2 : NT - 1; ua = *(const v4u*)(ubase + (size_t)(16 * kn + li) * NPROJ + 8 * lq2); }
                        LAS unsigned char* bun = L + S5V_BU + ((k + 1) & 1) * S5V_BUSZ;
#pragma unroll
                        for (int cb = 0; cb < 8; ++cb) { f32x4 acc = (f32x4){0.f, 0.f, 0.f, 0.f}; acc = __builtin_amdgcn_mfma_f32_16x16x32_bf16(af, bfr[cb], acc, 0, 0, 0);
#pragma unroll
                            for (int r = 0; r < 4; ++r) *(LAS float*)(bun + (4 * lq + r) * S5V_BUP + (gl * 128 + 16 * cb + li) * 4) = acc[r]; }
                    }
                }
                PR_T(pt2) PR_ACC(pa1, pt2 - pt0)
                LDS_BARRIER();
                PR_T(pt3) PR_ACC(pa2, pt3 - pt2)
            }
            __builtin_amdgcn_s_setprio(0);
            PR_OUT(0, pa0) PR_OUT(1, pa1) PR_OUT(2, pa2)
        } else {
            bf16x8 cfr[4];
#pragma unroll
            for (int ks = 0; ks < 4; ++ks) { const float* cr = (F.a->in[17]) + (g * 16 + li) * 64 + 16 * ks + 4 * lq; const float* ci = (F.a->in[18]) + (g * 16 + li) * 64 + 16 * ks + 4 * lq;
                const f32x4 r0 = *(const f32x4*)cr, i0 = *(const f32x4*)ci;
                cfr[ks] = __builtin_bit_cast(bf16x8, ((v4u){pk2(r0[0], -i0[0]), pk2(r0[1], -i0[1]), pk2(r0[2], -i0[2]), pk2(r0[3], -i0[3])})); }
            v4u gwv = (v4u){0u, 0u, 0u, 0u};
            if (lq < 2) { float gwf[8];
#pragma unroll
                for (int j = 0; j < 8; ++j) gwf[j] = (F.a->in[20])[(g * 16 + 8 * lq + j) * 16 + li];
                gwv = (v4u){pk2(gwf[0], gwf[1]), pk2(gwf[2], gwf[3]), pk2(gwf[4], gwf[5]), pk2(gwf[6], gwf[7])}; }
            const bf16x8 gfr = __builtin_bit_cast(bf16x8, gwv);
            const float dsk = (F.a->in[19])[g * 16 + li], gbias = (F.a->in[21])[g * 16 + li];
            LAS unsigned char* vs = L + S5V_VS + gl * 512;
            float uo[4], un[4];
#pragma unroll
            for (int r = 0; r < 4; ++r) { uo[r] = bf2f(ubase[(size_t)(4 * lq + r) * NPROJ + li]); un[r] = bf2f(ubase[(size_t)(16 + 4 * lq + r) * NPROJ + li]); }
            LDS_BARRIER();
            unsigned long long pb0 = 0, pb1 = 0;
            for (int k = 0; k <= NT; ++k) {
                PR_T(qt0)
                float u2[4];
                { const int kn = k + 1 < NT ? k + 1 : NT - 1;
#pragma unroll
                  for (int r = 0; r < 4; ++r) u2[r] = bf2f(ubase[(size_t)(16 * kn + 4 * lq + r) * NPROJ + li]); }
                if (k >= 2) {
                    const int t = ((tid - 256) >> 3) & 15, oc = tid & 7; const v4u ov = *(const LAS v4u*)(L + S5V_OT + (k & 1) * S5V_OTSZ + t * S5V_OTP + 16 * oc);
                    if (tid < 384) *(v4u*)(WSP(bf16, WS_Y) + ((size_t)b * SEQ + 16 * (k - 2) + t) * 2048 + 1024 + gs * 64 + 8 * oc) = ov; }
                if (k >= 1) {
                    const int kt = k - 1; const LAS unsigned char* xt = L + S5V_XT + (kt & 1) * S5V_XTSZ;
                    f32x4 yacc = (f32x4){0.f, 0.f, 0.f, 0.f};
#pragma unroll
                    for (int ks = 0; ks < 4; ++ks) yacc = __builtin_amdgcn_mfma_f32_16x16x32_bf16(*(const LAS bf16x8*)(xt + li * S5V_XTP + (gl * 128 + 32 * ks + 8 * lq) * 2), cfr[ks], yacc, 0, 0, 0);
                    float v[4];
                    { const f32x2 g0 = gelu_pk2((f32x2){yacc[0] + dsk * uo[0], yacc[1] + dsk * uo[1]}), g1 = gelu_pk2((f32x2){yacc[2] + dsk * uo[2], yacc[3] + dsk * uo[3]}); v[0] = g0[0]; v[1] = g0[1]; v[2] = g1[0]; v[3] = g1[1]; }
#pragma unroll
                    for (int r = 0; r < 4; ++r) *(LAS unsigned short*)(vs + (4 * lq + r) * 32 + li * 2) = (unsigned short)f2bf(v[r]);
                    LDS_WAIT(); asm volatile("" ::: "memory");
                    v4u va = (v4u){0u, 0u, 0u, 0u};
                    if (lq < 2) va = *(const LAS v4u*)(vs + li * 32 + 16 * lq);
                    f32x4 gacc = (f32x4){0.f, 0.f, 0.f, 0.f};
                    gacc = __builtin_amdgcn_mfma_f32_16x16x32_bf16(__builtin_bit_cast(bf16x8, va), gfr, gacc, 0, 0, 0);
                    float o[4], ss[4];
#pragma unroll
                    for (int r = 0; r < 4; ++r) { o[r] = v[r] * sigmoid_f(gacc[r] + gbias); ss[r] = o[r] * o[r]; }
#pragma unroll
                    for (int r = 0; r < 4; ++r) ss[r] = row16_sum_to15(ss[r]);
                    if (li == 15) {
#pragma unroll
                        for (int r = 0; r < 4; ++r) WSP(float, WS_STS5)[((size_t)b * SEQ + 16 * kt + 4 * lq + r) * NS5PART + g] = ss[r]; }
                    LAS unsigned char* ot = L + S5V_OT + (kt & 1) * S5V_OTSZ;
#pragma unroll
                    for (int r = 0; r < 4; ++r) *(LAS unsigned short*)(ot + (4 * lq + r) * S5V_OTP + (gl * 16 + li) * 2) = (unsigned short)f2bf(o[r]);
#pragma unroll
                    for (int r = 0; r < 4; ++r) { uo[r] = un[r]; un[r] = u2[r]; }
                }
                PR_T(qt1) PR_ACC(pb0, qt1 - qt0)
                LDS_BARRIER();
                PR_T(qt2) PR_ACC(pb1, qt2 - qt1)
            }
            PR_OUT4(3, pb0) PR_OUT4(4, pb1)
            { const int t = ((tid - 256) >> 3) & 15, oc = tid & 7; const v4u ov = *(const LAS v4u*)(L + S5V_OT + ((NT - 1) & 1) * S5V_OTSZ + t * S5V_OTP + 16 * oc);
              if (tid < 384) *(v4u*)(WSP(bf16, WS_Y) + ((size_t)b * SEQ + 16 * (NT - 1) + t) * 2048 + 1024 + gs * 64 + 8 * oc) = ov; }
        }
    }
#ifdef PROBE_S5
    if (blockIdx.x == 0 && threadIdx.x == 0) *(volatile float*)(F.ws + WS_CTL + 40000) = (float)(PROBE_CLOCK() - pr_t0) * PROBE_SCALE;
#endif
}
__device__ __forceinline__ unsigned med3u(unsigned a, unsigned b, unsigned c) { unsigned r; asm("v_med3_u32 %0, %1, %2, %3" : "=v"(r) : "v"(a), "v"(b), "v"(c)); return r; }
__device__ __forceinline__ unsigned fkey(float v) { const unsigned u = __builtin_bit_cast(unsigned, v); return (u & 0x80000000u) ? ~u : (u | 0x80000000u); }
__device__ __forceinline__ float fkey_inv(unsigned k) { const unsigned u = (k & 0x80000000u) ? (k & 0x7fffffffu) : ~k; return __builtin_bit_cast(float, u); }
#define TOPK_INSERT(a, x) do { _Pragma("unroll") for (int _i = 15; _i >= 1; --_i) a[_i] = med3u(a[_i - 1], a[_i], (x)); a[0] = a[0] > (x) ? a[0] : (x); } while (0)
__device__ __forceinline__ unsigned fp6_code(float y) {
    const float a = fabsf(y);
    const float c = a < 2.0f ? __builtin_rintf(8.0f * a) : (a < 4.0f ? __builtin_rintf(4.0f * a) + 8.0f : fminf(__builtin_rintf(2.0f * a) + 16.0f, 31.0f));
    return (unsigned)c | (y < 0.f ? 32u : 0u);
}
__device__ __forceinline__ void fp6_pack16(const unsigned* c, unsigned& w0, unsigned& w1, unsigned& w2) {
    w0 = c[0] | (c[1] << 6) | (c[2] << 12) | (c[3] << 18) | (c[4] << 24) | (c[5] << 30);
    w1 = (c[5] >> 2) | (c[6] << 4) | (c[7] << 10) | (c[8] << 16) | (c[9] << 22) | (c[10] << 28);
    w2 = (c[10] >> 4) | (c[11] << 2) | (c[12] << 8) | (c[13] << 14) | (c[14] << 20) | (c[15] << 26);
}
__device__ __forceinline__ void h2_convert(Frame& F, int w0, int nw, int f_lane) {
    for (int tb = w0 * 16; tb < MTOK; tb += nw * 16) {
        const float* sh = WSP(float, WS_MOD) + (size_t)(tb >> 11) * 6144 + 3072 + 16 * f_lane;
        float S2[16];
#pragma unroll
        for (int q = 0; q < 4; ++q) { const f32x4 s4 = *(const f32x4*)(sh + 4 * q); S2[4 * q] = s4[0]; S2[4 * q + 1] = s4[1]; S2[4 * q + 2] = s4[2]; S2[4 * q + 3] = s4[3]; }
#pragma unroll 1
        for (int k = 0; k < 16; k += 4) {
            v4u xa[4], xb[4]; float rst[4];
#pragma unroll
            for (int u = 0; u < 4; ++u) { const int t = tb + k + u; const char* xs = (const char*)(WSP(bf16, WS_X1S) + (size_t)t * 1024) + 32 * f_lane; xa[u] = *(const v4u*)xs; xb[u] = *(const v4u*)(xs + 16); rst[u] = WSP(float, WS_ROWSTAT)[t]; }
#pragma unroll
            for (int u = 0; u < 4; ++u) { const int t = tb + k + u;
                const float rs = rsqrt_f(rst[u] * (1.0f / 1024.0f) + EPSF);
                float h2[16]; unpack8(xa[u], h2); unpack8(xb[u], h2 + 8); float mx = 0.f;
#pragma unroll
                for (int i = 0; i < 16; ++i) { h2[i] = h2[i] * rs + S2[i]; mx = fmaxf(mx, fabsf(h2[i])); }
#pragma unroll
                for (int o = 1; o < 64; o <<= 1) mx = fmaxf(mx, __shfl_xor(mx, o));
                mx = fmaxf(mx, 1e-30f); const float hs = 224.0f / mx;
                v4u w;
#pragma unroll
                for (int q = 0; q < 4; ++q) { int pk = 0; pk = __builtin_amdgcn_cvt_pk_fp8_f32(h2[4 * q] * hs, h2[4 * q + 1] * hs, pk, false); pk = __builtin_amdgcn_cvt_pk_fp8_f32(h2[4 * q + 2] * hs, h2[4 * q + 3] * hs, pk, true); w[q] = (unsigned)pk; }
                *(v4u*)(F.ws + WS_H2Q + (size_t)t * 1024 + 16 * f_lane) = w;
                if (f_lane == 0) WSP(float, WS_HINV)[t] = mx * (1.0f / 224.0f); }
        }
    }
}
__device__ __forceinline__ void expert_convert(Frame& F, int w0, int nw, int f_lane) {
    for (int rw = w0; rw < 2 * 16384; rw += 2 * nw) {
        f32x4 v[2][4]; float mx[2];
#pragma unroll
        for (int u = 0; u < 2; ++u) { const int r = rw + u * nw; const int tb = r >= 16384, e = tb ? r - 16384 : r; const float* src = (tb ? (F.a->in[28]) : (F.a->in[27])) + (size_t)e * 1024 + 16 * f_lane;
#pragma unroll
            for (int q = 0; q < 4; ++q) v[u][q] = *(const f32x4*)(src + 4 * q); }
#pragma unroll
        for (int u = 0; u < 2; ++u) { float m = 0.f;
#pragma unroll
            for (int q = 0; q < 4; ++q) m = fmaxf(m, fmaxf(fmaxf(fabsf(v[u][q][0]), fabsf(v[u][q][1])), fmaxf(fabsf(v[u][q][2]), fabsf(v[u][q][3]))));
#pragma unroll
            for (int o = 1; o < 64; o <<= 1) m = fmaxf(m, __shfl_xor(m, o));
            mx[u] = fmaxf(m, 1e-30f); }
#ifdef HWENC
        {
            typedef float f32x16 __attribute__((ext_vector_type(16))); typedef unsigned v6u_t __attribute__((ext_vector_type(6)));
            const float sa = 7.5f / mx[0], sb = 7.5f / mx[1]; f32x16 s0, s1;
#pragma unroll
            for (int i = 0; i < 8; ++i) {
#ifdef HWENC_SEQ
                s0[i] = v[0][i >> 2][i & 3] * sa; s0[8 + i] = v[0][2 + (i >> 2)][i & 3] * sa; s1[i] = v[1][i >> 2][i & 3] * sb; s1[8 + i] = v[1][2 + (i >> 2)][i & 3] * sb;
#else
                s0[i] = v[0][(2 * i) >> 2][(2 * i) & 3] * sa; s1[i] = v[0][(2 * i + 1) >> 2][(2 * i + 1) & 3] * sa; s0[8 + i] = v[1][(2 * i) >> 2][(2 * i) & 3] * sb; s1[8 + i] = v[1][(2 * i + 1) >> 2][(2 * i + 1) & 3] * sb;
#endif
            }
            const v6u_t enc = __builtin_amdgcn_cvt_scalef32_2xpk16_fp6_f32(s0, s1, 1.0f);
#pragma unroll
            for (int u = 0; u < 2; ++u) { const int r = rw + u * nw; const int tb = r >= 16384, e = tb ? r - 16384 : r;
                unsigned* dst = (unsigned*)(F.ws + (tb ? WS_EV : WS_EU) + (size_t)e * 768 + 12 * f_lane); dst[0] = enc[3 * u]; dst[1] = enc[3 * u + 1]; dst[2] = enc[3 * u + 2];
                if (f_lane == 0) WSP(float, tb ? WS_EVS : WS_EUS)[e] = mx[u] * (1.0f / 7.5f); }
            continue;
        }
#endif
#pragma unroll
        for (int u = 0; u < 2; ++u) { const int r = rw + u * nw; const int tb = r >= 16384, e = tb ? r - 16384 : r; const float sc = 224.0f / mx[u];
            v4u w;
#pragma unroll
            for (int q = 0; q < 4; ++q) { int pk = 0; pk = __builtin_amdgcn_cvt_pk_fp8_f32(v[u][q][0] * sc, v[u][q][1] * sc, pk, false); pk = __builtin_amdgcn_cvt_pk_fp8_f32(v[u][q][2] * sc, v[u][q][3] * sc, pk, true); w[q] = (unsigned)pk; }
#ifdef V6
#if defined(UP12) || defined(UP14) || defined(UP15) || defined(UP16)
            {
#else
            if (tb) {
#endif
                const float s6 = 7.5f / mx[u]; unsigned cd[16];
#pragma unroll
                for (int q = 0; q < 4; ++q)
#pragma unroll
                    for (int i = 0; i < 4; ++i) cd[4 * q + i] = fp6_code(v[u][q][i] * s6);
                unsigned w0, w1, w2; fp6_pack16(cd, w0, w1, w2);
#ifdef UP15
                if (!tb) {
                    unsigned char* rowp = F.ws + WS_EU + (size_t)e * 768 + 16 * (f_lane >> 3); const int d0 = 3 * (f_lane & 7);
                    *(unsigned*)(rowp + 128 * (d0 >> 2) + 4 * (d0 & 3)) = w0; *(unsigned*)(rowp + 128 * ((d0 + 1) >> 2) + 4 * ((d0 + 1) & 3)) = w1; *(unsigned*)(rowp + 128 * ((d0 + 2) >> 2) + 4 * ((d0 + 2) & 3)) = w2;
                    if (f_lane == 0) WSP(float, WS_EUS)[e] = mx[u] * (1.0f / 7.5f);
                    continue; }
#endif
                unsigned* dst = (unsigned*)(F.ws + (tb ? WS_EV : WS_EU) + (size_t)e * 768 + 12 * f_lane); dst[0] = w0; dst[1] = w1; dst[2] = w2;
                if (f_lane == 0) WSP(float, tb ? WS_EVS : WS_EUS)[e] = mx[u] * (1.0f / 7.5f);
                continue; }
#endif
            *(v4u*)(F.ws + (tb ? WS_EV : WS_EU) + (size_t)e * 1024 + 16 * f_lane) = w;
            if (f_lane == 0) WSP(float, tb ? WS_EVS : WS_EUS)[e] = mx[u] * (1.0f / 224.0f); }
    }
}
__device__ __forceinline__ void p5b_topk(Frame& F) {
    const int f_tid = threadIdx.x, f_lane = f_tid & 63, f_wave = __builtin_amdgcn_readfirstlane(f_tid >> 6);
    const _Float16* scores = WSP(_Float16, WS_SCORES);
    LAS unsigned char* ix = (LAS unsigned char*)F.lds + f_tid * 36;
#pragma unroll 1
    for (int half = 0; half < 2; ++half) {
#ifdef UP11
    if ((f_wave >> 2) != half) { expert_convert(F, (F.vcu * 4 + (f_wave & 3)) * 2 + half, F.G * 8, f_lane); h2_convert(F, (F.vcu * 4 + (f_wave & 3)) * 2 + half, F.G * 8, f_lane); continue; }
#else
    if ((f_wave >> 2) != half) { expert_convert(F, (F.vcu * 4 + (f_wave & 3)) * 2 + half, F.G * 8, f_lane); continue; }
#endif
    typedef _Float16 f16x8 __attribute__((ext_vector_type(8)));
    f16x8 sva[8], svb[8];
    { const int item0 = (F.vcu * 2 + half) * 256 + (f_tid & 255); const _Float16* sp0 = scores + (size_t)(item0 >> 3) * 2048 + (item0 & 7) * 256;
#pragma unroll
      for (int q = 0; q < 8; ++q) sva[q] = *(const f16x8*)(sp0 + 8 * q); }
#pragma unroll 1
    for (int item = (F.vcu * 2 + half) * 256 + (f_tid & 255); item < MTOK * PH; item += F.G * 512) {
        const int t = item >> 3, hd = item & 7;
        unsigned a1[16], a2[16];
#pragma unroll
        for (int i = 0; i < 16; ++i) { a1[i] = 0u; a2[i] = 0u; }
        const _Float16* sp = scores + (size_t)t * 2048 + hd * 256;
        const int itn = (item + F.G * 512 < MTOK * PH) ? item + F.G * 512 : item;
        const _Float16* spn = scores + (size_t)(itn >> 3) * 2048 + (itn & 7) * 256;
#define TK_BATCH(CUR, NXT, NP, A, M) { \
        { _Pragma("unroll") for (int q = 0; q < 8; ++q) NXT[q] = *(const f16x8*)((NP) + 8 * q); } \
        __builtin_amdgcn_sched_barrier(0); \
        _Pragma("unroll") for (int q = 0; q < 8; ++q) { _Pragma("unroll") for (int e = 0; e < 8; ++e) { const unsigned k = (fkey((float)CUR[q][e]) & ~127u) | (unsigned)(127 - (64 * (M) + 8 * q + e)); TOPK_INSERT(A, k); } } }
        TK_BATCH(sva, svb, sp + 64, a1, 0)
        TK_BATCH(svb, sva, sp + 128, a1, 1)
        TK_BATCH(sva, svb, sp + 192, a2, 0)
        TK_BATCH(svb, sva, spn, a2, 1)
#undef TK_BATCH
        float v1[16], v2[16];
#pragma unroll
        for (int i = 0; i < 16; ++i) { ix[i] = (unsigned char)(127u - (a1[i] & 127u)); ix[16 + i] = (unsigned char)(127u - (a2[i] & 127u)); v1[i] = fkey_inv(a1[i] & ~127u); v2[i] = fkey_inv(a2[i] & ~127u); }
        unsigned cb[16];
#pragma unroll
        for (int i = 0; i < 16; ++i) cb[i] = 0u;
#pragma unroll
        for (int i = 0; i < 16; ++i)
#pragma unroll
            for (int j = 0; j < 16; ++j) if ((i + 1) * (j + 1) <= 16) { const unsigned k = (fkey(v1[i] + v2[j]) & ~255u) | (unsigned)(255 - (i * 16 + j)); TOPK_INSERT(cb, k); }
        float tv[16]; float mx = -3.0e38f;
#pragma unroll
        for (int k = 0; k < 16; ++k) { tv[k] = fkey_inv(cb[k] & ~255u); mx = fmaxf(mx, tv[k]); }
        float sum = 0.f;
#pragma unroll
        for (int k = 0; k < 16; ++k) { tv[k] = __expf(tv[k] - mx); sum += tv[k]; }
        const float inv = 1.0f / sum;
        LDS_WAIT(); asm volatile("" ::: "memory");
        int ev[16]; unsigned long long c64 = 0ull;
#pragma unroll
        for (int k = 0; k < 16; ++k) { const unsigned code = 255u - (cb[k] & 255u); const int i = code >> 4, j = code & 15; ev[k] = (int)ix[i] * 128 + (int)ix[16 + j]; c64 += 1ull << (8 * (ev[k] >> 11)); }
        unsigned long long s64 = c64;
#pragma unroll
        for (int o = 1; o < 8; o <<= 1) { const unsigned lo = __shfl_up((unsigned)s64, o, 8), hi = __shfl_up((unsigned)(s64 >> 32), o, 8); if ((f_lane & 7) >= o) s64 += ((unsigned long long)hi << 32) | lo; }
        const unsigned long long e64 = s64 - c64;
        const unsigned long long t64 = ((unsigned long long)__shfl((unsigned)(s64 >> 32), 7, 8) << 32) | __shfl((unsigned)s64, 7, 8);
        const unsigned long long st64 = (t64 * 0x0101010101010101ull) << 8;
        unsigned long long base64 = st64 + e64;
        int* eo = WSP(int, WS_EID) + (size_t)t * 128; float* go = WSP(float, WS_GATE) + (size_t)t * 128;
#pragma unroll
        for (int k = 0; k < 16; ++k) { const int r8 = 8 * (ev[k] >> 11); const int slot = (int)((base64 >> r8) & 255ull); base64 += 1ull << r8; eo[slot] = ev[k]; go[slot] = tv[k] * inv; }
        if (hd == 0) WSP(unsigned long long, WS_START)[t] = st64;
        LDS_WAIT(); asm volatile("" ::: "memory");
    }
    }
}
__device__ __forceinline__ void dec16(const v4u q, float* f) {
#pragma unroll
    for (int i = 0; i < 4; ++i) { const f32x2 lo = __builtin_amdgcn_cvt_pk_f32_fp8((int)q[i], false), hi = __builtin_amdgcn_cvt_pk_f32_fp8((int)q[i], true); f[4 * i] = lo[0]; f[4 * i + 1] = lo[1]; f[4 * i + 2] = hi[0]; f[4 * i + 3] = hi[1]; }
}
struct CvE { f32x4 v[4]; };
struct CvH { v4u xa, xb; float rst; };
__device__ __forceinline__ void cve_load(CvE& c, Frame& F, int r, int f_lane) {
    const int tb = r >= 16384, e = tb ? r - 16384 : r; const float* src = (tb ? (F.a->in[28]) : (F.a->in[27])) + (size_t)e * 1024 + 16 * f_lane;
#pragma unroll
    for (int q = 0; q < 4; ++q) c.v[q] = *(const f32x4*)(src + 4 * q);
}
__device__ __forceinline__ void cve_finish(const CvE& c, Frame& F, int r, int f_lane) {
    const int tb = r >= 16384, e = tb ? r - 16384 : r; float m = 0.f;
#pragma unroll
    for (int q = 0; q < 4; ++q) m = fmaxf(m, fmaxf(fmaxf(fabsf(c.v[q][0]), fabsf(c.v[q][1])), fmaxf(fabsf(c.v[q][2]), fabsf(c.v[q][3]))));
#pragma unroll
    for (int o = 1; o < 64; o <<= 1) m = fmaxf(m, __shfl_xor(m, o));
    m = fmaxf(m, 1e-30f); const float sc = 224.0f / m;
    v4u w;
#pragma unroll
    for (int q = 0; q < 4; ++q) { int pk = 0; pk = __builtin_amdgcn_cvt_pk_fp8_f32(c.v[q][0] * sc, c.v[q][1] * sc, pk, false); pk = __builtin_amdgcn_cvt_pk_fp8_f32(c.v[q][2] * sc, c.v[q][3] * sc, pk, true); w[q] = (unsigned)pk; }
    *(v4u*)(F.ws + (tb ? WS_EV : WS_EU) + (size_t)e * 1024 + 16 * f_lane) = w;
    if (f_lane == 0) WSP(float, tb ? WS_EVS : WS_EUS)[e] = m * (1.0f / 224.0f);
}
__device__ __forceinline__ void cvh_load(CvH& c, Frame& F, int t, int f_lane) {
    const char* xs = (const char*)(WSP(bf16, WS_X1S) + (size_t)t * 1024) + 32 * f_lane; c.xa = *(const v4u*)xs; c.xb = *(const v4u*)(xs + 16); c.rst = WSP(float, WS_ROWSTAT)[t];
}
__device__ __forceinline__ void cvh_finish(const CvH& c, Frame& F, int t, int f_lane, const float* S2) {
    const float rs = rsqrt_f(c.rst * (1.0f / 1024.0f) + EPSF);
    float h2[16]; unpack8(c.xa, h2); unpack8(c.xb, h2 + 8); float mx = 0.f;
#pragma unroll
    for (int i = 0; i < 16; ++i) { h2[i] = h2[i] * rs + S2[i]; mx = fmaxf(mx, fabsf(h2[i])); }
#pragma unroll
    for (int o = 1; o < 64; o <<= 1) mx = fmaxf(mx, __shfl_xor(mx, o));
    mx = fmaxf(mx, 1e-30f); const float hs = 224.0f / mx;
    v4u w;
#pragma unroll
    for (int q = 0; q < 4; ++q) { int pk = 0; pk = __builtin_amdgcn_cvt_pk_fp8_f32(h2[4 * q] * hs, h2[4 * q + 1] * hs, pk, false); pk = __builtin_amdgcn_cvt_pk_fp8_f32(h2[4 * q + 2] * hs, h2[4 * q + 3] * hs, pk, true); w[q] = (unsigned)pk; }
    *(v4u*)(F.ws + WS_H2Q + (size_t)t * 1024 + 16 * f_lane) = w;
    if (f_lane == 0) WSP(float, WS_HINV)[t] = mx * (1.0f / 224.0f);
}
__device__ __forceinline__ void p5b_topk2(Frame& F) {
    const int f_tid = threadIdx.x, f_lane = f_tid & 63, f_wave = __builtin_amdgcn_readfirstlane(f_tid >> 6);
    const _Float16* scores = WSP(_Float16, WS_SCORES);
    LAS unsigned char* ix = (LAS unsigned char*)F.lds + f_tid * 36;
    const int gw = F.vcu * NWAVES + f_wave;
    static_assert(MTOK * PH == 2 * 256 * NTHR && MTOK == 16 * 256 * NWAVES, "P7 v2 work split");
    float S2[16];
    { const float* sh = WSP(float, WS_MOD) + (size_t)((gw * 16) >> 11) * 6144 + 3072 + 16 * f_lane;
#pragma unroll
      for (int q = 0; q < 4; ++q) { const f32x4 s4 = *(const f32x4*)(sh + 4 * q); S2[4 * q] = s4[0]; S2[4 * q + 1] = s4[1]; S2[4 * q + 2] = s4[2]; S2[4 * q + 3] = s4[3]; } }
    typedef _Float16 f16x8 __attribute__((ext_vector_type(8)));
    const int item_base = F.vcu * NTHR + f_tid, item_step = F.G * NTHR;
    f16x8 sva[8], svb[8];
    { const _Float16* sp0 = scores + (size_t)(item_base >> 3) * 2048 + (item_base & 7) * 256;
#pragma unroll
      for (int q = 0; q < 8; ++q) sva[q] = *(const f16x8*)(sp0 + 8 * q); }
    unsigned a1[16];
#pragma unroll
    for (int i = 0; i < 16; ++i) a1[i] = 0u;
#pragma unroll 1
    for (int hi = 0; hi < 4; ++hi) {
        const int item = item_base + (hi >> 1) * item_step; const int t = item >> 3, hd = item & 7, kh = hi & 1;
        const _Float16* sp = scores + (size_t)t * 2048 + hd * 256 + kh * 128;
        const int hn = hi < 3 ? hi + 1 : hi; const int itn = item_base + (hn >> 1) * item_step;
        const _Float16* spn = scores + (size_t)(itn >> 3) * 2048 + (itn & 7) * 256 + (hn & 1) * 128;
        unsigned a2[16];
#pragma unroll
        for (int i = 0; i < 16; ++i) a2[i] = 0u;
#define TK2_BATCH(CUR, NXT, NP, M) { \
        const int ku = 2 * (2 * hi + (M)); CvE e0, e1; CvH h0, h1; \
        { _Pragma("unroll") for (int q = 0; q < 8; ++q) NXT[q] = *(const f16x8*)((NP) + 8 * q); } \
        cve_load(e0, F, gw + ku * 2048, f_lane); cve_load(e1, F, gw + (ku + 1) * 2048, f_lane); cvh_load(h0, F, gw * 16 + ku, f_lane); cvh_load(h1, F, gw * 16 + ku + 1, f_lane); \
        __builtin_amdgcn_sched_barrier(0); \
        _Pragma("unroll") for (int q = 0; q < 8; ++q) { _Pragma("unroll") for (int e = 0; e < 8; ++e) { const unsigned k = (fkey((float)CUR[q][e]) & ~127u) | (unsigned)(127 - (64 * (M) + 8 * q + e)); TOPK_INSERT(a2, k); } } \
        __builtin_amdgcn_sched_barrier(0); \
        cve_finish(e0, F, gw + ku * 2048, f_lane); cve_finish(e1, F, gw + (ku + 1) * 2048, f_lane); cvh_finish(h0, F, gw * 16 + ku, f_lane, S2); cvh_finish(h1, F, gw * 16 + ku + 1, f_lane, S2); \
        __builtin_amdgcn_sched_barrier(0); }
        TK2_BATCH(sva, svb, sp + 64, 0)
        TK2_BATCH(svb, sva, spn, 1)
#undef TK2_BATCH
        if (kh == 0) {
#pragma unroll
            for (int i = 0; i < 16; ++i) a1[i] = a2[i];
            continue;
        }
        float v1[16], v2[16];
#pragma unroll
        for (int i = 0; i < 16; ++i) { ix[i] = (unsigned char)(127u - (a1[i] & 127u)); ix[16 + i] = (unsigned char)(127u - (a2[i] & 127u)); v1[i] = fkey_inv(a1[i] & ~127u); v2[i] = fkey_inv(a2[i] & ~127u); }
        unsigned cb[16];
#pragma unroll
        for (int i = 0; i < 16; ++i) cb[i] = 0u;
#pragma unroll
        for (int i = 0; i < 16; ++i)
#pragma unroll
            for (int j = 0; j < 16; ++j) if ((i + 1) * (j + 1) <= 16) { const unsigned k = (fkey(v1[i] + v2[j]) & ~255u) | (unsigned)(255 - (i * 16 + j)); TOPK_INSERT(cb, k); }
        float tv[16]; float mx = -3.0e38f;
#pragma unroll
        for (int k = 0; k < 16; ++k) { tv[k] = fkey_inv(cb[k] & ~255u); mx = fmaxf(mx, tv[k]); }
        float sum = 0.f;
#pragma unroll
        for (int k = 0; k < 16; ++k) { tv[k] = __expf(tv[k] - mx); sum += tv[k]; }
        const float inv = 1.0f / sum;
        LDS_WAIT(); asm volatile("" ::: "memory");
        int ev[16]; unsigned long long c64 = 0ull;
#pragma unroll
        for (int k = 0; k < 16; ++k) { const unsigned code = 255u - (cb[k] & 255u); const int i = code >> 4, j = code & 15; ev[k] = (int)ix[i] * 128 + (int)ix[16 + j]; c64 += 1ull << (8 * (ev[k] >> 11)); }
        unsigned long long s64 = c64;
#pragma unroll
        for (int o = 1; o < 8; o <<= 1) { const unsigned lo = __shfl_up((unsigned)s64, o, 8), hi2 = __shfl_up((unsigned)(s64 >> 32), o, 8); if ((f_lane & 7) >= o) s64 += ((unsigned long long)hi2 << 32) | lo; }
        const unsigned long long e64 = s64 - c64;
        const unsigned long long t64 = ((unsigned long long)__shfl((unsigned)(s64 >> 32), 7, 8) << 32) | __shfl((unsigned)s64, 7, 8);
        const unsigned long long st64 = (t64 * 0x0101010101010101ull) << 8;
        unsigned long long base64 = st64 + e64;
        int* eo = WSP(int, WS_EID) + (size_t)t * 128; float* go = WSP(float, WS_GATE) + (size_t)t * 128;
#pragma unroll
        for (int k = 0; k < 16; ++k) { const int r8 = 8 * (ev[k] >> 11); const int slot = (int)((base64 >> r8) & 255ull); base64 += 1ull << r8; eo[slot] = ev[k]; go[slot] = tv[k] * inv; }
        if (hd == 0) WSP(unsigned long long, WS_START)[t] = st64;
        LDS_WAIT(); asm volatile("" ::: "memory");
    }
}
__device__ __forceinline__ void p9_peer_down2(Frame& F) {
    const int f_tid = threadIdx.x, lane = f_tid & 63, f_wave = __builtin_amdgcn_readfirstlane(f_tid >> 6);
    const unsigned char* EV = F.ws + WS_EV;
    for (int wq = F.vcu * NWAVES + f_wave; wq < MTOK / 16; wq += F.G * NWAVES) {
        const int b = wq >> 7; const float* mb = WSP(float, WS_MOD) + (size_t)b * 6144;
        int ne_lo = WSP(int, WS_EID)[(size_t)wq * 16 * 128 + lane], ne_hi = WSP(int, WS_EID)[(size_t)wq * 16 * 128 + 64 + lane];
        float nw_lo = WSP(float, WS_GATE)[(size_t)wq * 16 * 128 + lane], nw_hi = WSP(float, WS_GATE)[(size_t)wq * 16 * 128 + 64 + lane];
        for (int tt = 0; tt < 16; ++tt) {
            const size_t t = (size_t)wq * 16 + tt;
            unsigned l16 = 16u * (unsigned)lane; asm volatile("" : "+v"(l16));
            float* xr = (float*)((char*)(F.out + t * 1024) + 4u * l16);
            const int e_lo = ne_lo, e_hi = ne_hi; const float w_lo = nw_lo, w_hi = nw_hi;
            f32x2 o[8];
#pragma unroll
            for (int i = 0; i < 8; ++i) o[i] = (f32x2){0.f, 0.f};
            v4u qa[8], qb[8];
#pragma unroll
            for (int j = 0; j < 8; ++j) { const int e = __builtin_amdgcn_readlane(e_lo, j); qa[j] = *(const v4u*)(EV + ((unsigned)e * 1024u + l16)); }
#define DN2_STEP(GRP, CUR, NXT) { \
                const int grp = (GRP); const int nb = ((grp + 1) & 7) * 8; const int ensel = (grp + 1) < 8 ? e_lo : e_hi; \
                { _Pragma("unroll") for (int j = 0; j < 8; ++j) { const int e = __builtin_amdgcn_readlane(ensel, nb + j); NXT[j] = *(const v4u*)(EV + ((unsigned)e * 1024u + l16)); } } \
                __builtin_amdgcn_sched_barrier(0); \
                const int base = (grp & 7) * 8; const float wsel = grp < 8 ? w_lo : w_hi; \
                _Pragma("unroll") for (int j = 0; j < 8; ++j) { const float wj = __builtin_bit_cast(float, __builtin_amdgcn_readlane(__builtin_bit_cast(int, wsel), base + j)); const f32x2 w2 = (f32x2){wj, wj}; \
                    _Pragma("unroll") for (int i = 0; i < 4; ++i) { const f32x2 lo = __builtin_amdgcn_cvt_pk_f32_fp8((int)CUR[j][i], false), hi = __builtin_amdgcn_cvt_pk_f32_fp8((int)CUR[j][i], true); o[2 * i] += w2 * lo; o[2 * i + 1] += w2 * hi; } } }
#pragma unroll 1
            for (int g2 = 0; g2 < 16; g2 += 2) { DN2_STEP(g2, qa, qb) DN2_STEP(g2 + 1, qb, qa) }
#undef DN2_STEP
            { const size_t tn = t + (tt < 15 ? 1 : 0); ne_lo = WSP(int, WS_EID)[tn * 128 + lane]; ne_hi = WSP(int, WS_EID)[tn * 128 + 64 + lane]; nw_lo = WSP(float, WS_GATE)[tn * 128 + lane]; nw_hi = WSP(float, WS_GATE)[tn * 128 + 64 + lane]; }
            float x1[16]; float ss = 0.f;
#pragma unroll
            for (int q4 = 0; q4 < 4; ++q4) { const f32x4 v = *(const f32x4*)(xr + 4 * q4); x1[4 * q4] = v[0]; x1[4 * q4 + 1] = v[1]; x1[4 * q4 + 2] = v[2]; x1[4 * q4 + 3] = v[3]; }
#pragma unroll
            for (int q4 = 0; q4 < 4; ++q4) { const f32x4 gt = *(const f32x4*)((const char*)(mb + 5120) + 4u * l16 + 16 * q4);
#pragma unroll
                for (int e = 0; e < 4; ++e) { const int i = 4 * q4 + e; x1[i] += gt[e] * o[i >> 1][i & 1]; ss += x1[i] * x1[i]; } }
            const float rf = rsqrt_f(wave_sum(ss) * (1.0f / 1024.0f) + EPSF);
#pragma unroll
            for (int q4 = 0; q4 < 4; ++q4) { const f32x4 nf = *(const f32x4*)((const char*)(F.a->in[29]) + 4u * l16 + 16 * q4); f32x4 v;
#pragma unroll
                for (int e = 0; e < 4; ++e) v[e] = x1[4 * q4 + e] * rf * nf[e];
                *(f32x4*)(xr + 4 * q4) = v; }
        }
    }
}
typedef long i64_t;
constexpr int U6_ROWP = 1040, U6_BUF = 8 * U6_ROWP, U6_WAVE = 2 * U6_BUF + 1024;
static_assert(8 * U6_WAVE <= LDS_MAIN, "U6 LDS map");
__device__ __forceinline__ void p8_peer_up6(Frame& F) {
    const int f_tid = threadIdx.x, lane = f_tid & 63, f_wave = __builtin_amdgcn_readfirstlane(f_tid >> 6);
    const int li = lane & 15, lq = lane >> 4;
    const unsigned char* EU = F.ws + WS_EU; const float* EUS = WSP(float, WS_EUS); const float* EVS = WSP(float, WS_EVS);
    LAS unsigned char* ring = F.lds + f_wave * U6_WAVE; LAS unsigned char* hq = ring + 2 * U6_BUF;
    for (int wq = F.vcu * NWAVES + f_wave; wq < MTOK / 16; wq += F.G * NWAVES) {
        const int b = wq >> 7; const float* mb = WSP(float, WS_MOD) + (size_t)b * 6144;
        for (int tt = 0; tt < 16; ++tt) {
            const size_t t = (size_t)wq * 16 + tt;
            unsigned l16 = 16u * (unsigned)lane; asm volatile("" : "+v"(l16));
            const int e_lo = WSP(int, WS_EID)[t * 128 + lane], e_hi = WSP(int, WS_EID)[t * 128 + 64 + lane];
            const float g_lo = WSP(float, WS_GATE)[t * 128 + lane], g_hi = WSP(float, WS_GATE)[t * 128 + 64 + lane];
            const float rs = rsqrt_f(WSP(float, WS_ROWSTAT)[t] * (1.0f / 1024.0f) + EPSF);
            const char* xs = (const char*)(WSP(bf16, WS_X1S) + t * 1024) + 2u * l16; const v4u xa = *(const v4u*)xs, xb = *(const v4u*)(xs + 16);
            asm volatile("s_waitcnt vmcnt(0)" ::: "memory");
#pragma unroll
            for (int j = 0; j < 8; ++j) { const int e = __builtin_amdgcn_readlane(e_lo, j);
                __builtin_amdgcn_global_load_lds((const unsigned*)(EU + ((unsigned)e * 1024u + l16)), (LAS unsigned*)(ring + j * U6_ROWP), 16, 0, 0); }
            const float su_lo = EUS[e_lo], su_hi = EUS[e_hi], sv_lo = EVS[e_lo], sv_hi = EVS[e_hi];
            float h2[16]; unpack8(xa, h2); unpack8(xb, h2 + 8); float mx = 0.f;
#pragma unroll
            for (int qd = 0; qd < 4; ++qd) { const f32x4 sh = *(const f32x4*)((const char*)(mb + 3072) + 4u * l16 + 16 * qd);
#pragma unroll
                for (int e = 0; e < 4; ++e) { h2[4 * qd + e] = h2[4 * qd + e] * rs + sh[e]; mx = fmaxf(mx, fabsf(h2[4 * qd + e])); } }
#pragma unroll
            for (int o = 1; o < 64; o <<= 1) mx = fmaxf(mx, __shfl_xor(mx, o));
            mx = fmaxf(mx, 1e-30f); const float hs = 224.0f / mx, hinv = mx * (1.0f / 224.0f);
            { v4u w;
#pragma unroll
              for (int qd = 0; qd < 4; ++qd) { int pk = 0; pk = __builtin_amdgcn_cvt_pk_fp8_f32(h2[4 * qd] * hs, h2[4 * qd + 1] * hs, pk, false); pk = __builtin_amdgcn_cvt_pk_fp8_f32(h2[4 * qd + 2] * hs, h2[4 * qd + 3] * hs, pk, true); w[qd] = (unsigned)pk; }
              *(LAS v4u*)(hq + l16) = w; }
            LDS_WAIT(); asm volatile("" ::: "memory");
            v4u hb[16];
#pragma unroll
            for (int c = 0; c < 16; ++c) hb[c] = *(const LAS v4u*)(hq + 64 * c + 16 * lq);
            asm volatile("s_waitcnt vmcnt(0)" ::: "memory");
            float w_lo = 0.f, w_hi = 0.f;
#pragma unroll 1
            for (int u = 0; u < 16; ++u) {
                { const int un = (u + 1) & 15; const int ensel = un < 8 ? e_lo : e_hi; const int nb = (un & 7) * 8; LAS unsigned char* dst = ring + ((u + 1) & 1) * U6_BUF;
#pragma unroll
                  for (int j = 0; j < 8; ++j) { const int e = __builtin_amdgcn_readlane(ensel, nb + j);
                      __builtin_amdgcn_global_load_lds((const unsigned*)(EU + ((unsigned)e * 1024u + l16)), (LAS unsigned*)(dst + j * U6_ROWP), 16, 0, 0); } }
                asm volatile("s_waitcnt vmcnt(8)" ::: "memory");
                const LAS unsigned char* src = ring + (u & 1) * U6_BUF + (li & 7) * U6_ROWP + 16 * lq;
                f32x4 acc = (f32x4){0.f, 0.f, 0.f, 0.f};
#ifdef HALF_READ
                v4u av[16];
#pragma unroll
                for (int c = 0; c < 16; ++c) asm volatile("" : "=v"(av[c]));
                if (li < 8) {
#pragma unroll
                    for (int c = 0; c < 16; ++c) av[c] = *(const LAS v4u*)(src + 64 * c); }
#pragma unroll
                for (int c = 0; c < 16; ++c) { const v4u a = av[c];
#else
#pragma unroll
                for (int c = 0; c < 16; ++c) { const v4u a = *(const LAS v4u*)(src + 64 * c);
#endif
                    acc = __builtin_amdgcn_mfma_f32_16x16x32_fp8_fp8((i64_t)(((unsigned long long)a[1] << 32) | a[0]), (i64_t)(((unsigned long long)hb[c][1] << 32) | hb[c][0]), acc, 0, 0, 0);
                    acc = __builtin_amdgcn_mfma_f32_16x16x32_fp8_fp8((i64_t)(((unsigned long long)a[3] << 32) | a[2]), (i64_t)(((unsigned long long)hb[c][3] << 32) | hb[c][2]), acc, 0, 0, 0); }
                const int base = (u & 7) * 8; const int r = li & 3;
                const float sel = r == 0 ? acc[0] : (r == 1 ? acc[1] : (r == 2 ? acc[2] : acc[3]));
                const float dmine = __shfl(sel, ((lane & 7) >> 2) * 16 + (lane & 3));
                const float gsel = u < 8 ? g_lo : g_hi, susel = u < 8 ? su_lo : su_hi, svsel = u < 8 ? sv_lo : sv_hi;
                const float wv = gsel * gelu_erf(dmine * susel * hinv) * svsel;
                const bool mine = (lane >= base) && (lane < base + 8);
                if (u < 8) w_lo = mine ? wv : w_lo; else w_hi = mine ? wv : w_hi;
                asm volatile("s_waitcnt lgkmcnt(0)" ::: "memory");
            }
            WSP(float, WS_GATE)[t * 128 + lane] = w_lo; WSP(float, WS_GATE)[t * 128 + 64 + lane] = w_hi;
        }
    }
}
struct U10Meta { int elo, ehi; float glo, ghi; v4u xa, xb; float rst; };
__device__ __forceinline__ void u10_meta_load(U10Meta& M, const unsigned char* ws, size_t t, unsigned l16) {
    const unsigned l = l16 >> 4; const int* ep = (const int*)(ws + WS_EID) + t * 128; const float* gp = (const float*)(ws + WS_GATE) + t * 128;
    M.elo = ep[l]; M.ehi = ep[64 + l]; M.glo = gp[l]; M.ghi = gp[64 + l];
    const char* xs = (const char*)(ws + WS_X1S) + t * 2048 + 2u * l16; M.xa = *(const v4u*)xs; M.xb = *(const v4u*)(xs + 16);
    M.rst = ((const float*)(ws + WS_ROWSTAT))[t + (l16 >> 30)];
}
__device__ __forceinline__ void u10_meta_touch(U10Meta& M) { asm volatile("" : "+v"(M.elo), "+v"(M.ehi), "+v"(M.glo), "+v"(M.ghi), "+v"(M.xa), "+v"(M.xb), "+v"(M.rst)); }
template <int UN> __device__ __forceinline__ void u10_unit_dma(int elo, int ehi, const unsigned char* EU, unsigned l16, LAS unsigned char* dst) {
    const int ensel = UN < 8 ? elo : ehi; constexpr int nb = (UN & 7) * 8;
#pragma unroll
    for (int j = 0; j < 8; ++j) { const int e = __builtin_amdgcn_readlane(ensel, nb + j);
        __builtin_amdgcn_global_load_lds((const unsigned*)(EU + ((unsigned)e * 1024u + l16)), (LAS unsigned*)(dst + j * U6_ROWP), 16, 0, 0); }
}
__device__ __forceinline__ void u10_h2(const U10Meta& M, const float* S2, LAS unsigned char* hq, unsigned l16, int lq, v4u* hb, float& hinv) {
    float h2[16]; unpack8(M.xa, h2); unpack8(M.xb, h2 + 8); float mx = 0.f;
    const float rs = rsqrt_f(M.rst * (1.0f / 1024.0f) + EPSF);
#pragma unroll
    for (int i = 0; i < 16; ++i) { h2[i] = h2[i] * rs + S2[i]; mx = fmaxf(mx, fabsf(h2[i])); }
#pragma unroll
    for (int o = 1; o < 64; o <<= 1) mx = fmaxf(mx, __shfl_xor(mx, o));
    mx = fmaxf(mx, 1e-30f); const float hs = 224.0f / mx; hinv = mx * (1.0f / 224.0f);
    v4u w;
#pragma unroll
    for (int qd = 0; qd < 4; ++qd) { int pk = 0; pk = __builtin_amdgcn_cvt_pk_fp8_f32(h2[4 * qd] * hs, h2[4 * qd + 1] * hs, pk, false); pk = __builtin_amdgcn_cvt_pk_fp8_f32(h2[4 * qd + 2] * hs, h2[4 * qd + 3] * hs, pk, true); w[qd] = (unsigned)pk; }
    *(LAS v4u*)(hq + l16) = w;
    LDS_WAIT(); asm volatile("" ::: "memory");
#pragma unroll
    for (int c = 0; c < 16; ++c) hb[c] = *(const LAS v4u*)(hq + 64 * c + 16 * lq);
    LDS_WAIT(); asm volatile("" ::: "memory");
}
template <int U> __device__ __forceinline__ void u10_unit(const U10Meta& C, U10Meta& N, const unsigned char* EU, const unsigned char* ws, unsigned l16, LAS unsigned char* ring, const v4u* hb, float hinv,
                                                          float su_lo, float su_hi, float sv_lo, float sv_hi, float& nsu_lo, float& nsu_hi, float& nsv_lo, float& nsv_hi,
                                                          float& w_lo, float& w_hi, size_t tn, bool first_token, int lane) {
    const int li = lane & 15, lq = lane >> 4;
    if (U == 15) u10_unit_dma<0>(N.elo, N.ehi, EU, l16, ring); else u10_unit_dma<(U + 1) & 15>(C.elo, C.ehi, EU, l16, ring + ((U + 1) & 1) * U6_BUF);
    __builtin_amdgcn_sched_barrier(0);
    if (U == 0) { if (first_token) asm volatile("s_waitcnt vmcnt(8)" ::: "memory"); else asm volatile("s_waitcnt vmcnt(10)" ::: "memory"); }
    else if (U == 3) asm volatile("s_waitcnt vmcnt(15)" ::: "memory");
    else if (U == 11) asm volatile("s_waitcnt vmcnt(12)" ::: "memory");
    else asm volatile("s_waitcnt vmcnt(8)" ::: "memory");
    if (U == 4) u10_meta_touch(N);
    if (U == 12) asm volatile("" : "+v"(nsu_lo), "+v"(nsu_hi), "+v"(nsv_lo), "+v"(nsv_hi));
    __builtin_amdgcn_sched_barrier(0);
    const LAS unsigned char* src = ring + (U & 1) * U6_BUF + (li & 7) * U6_ROWP + 16 * lq;
    f32x4 acc = (f32x4){0.f, 0.f, 0.f, 0.f};
#pragma unroll
    for (int c = 0; c < 16; ++c) { const v4u a = *(const LAS v4u*)(src + 64 * c);
        acc = __builtin_amdgcn_mfma_f32_16x16x32_fp8_fp8((i64_t)(((unsigned long long)a[1] << 32) | a[0]), (i64_t)(((unsigned long long)hb[c][1] << 32) | hb[c][0]), acc, 0, 0, 0);
        acc = __builtin_amdgcn_mfma_f32_16x16x32_fp8_fp8((i64_t)(((unsigned long long)a[3] << 32) | a[2]), (i64_t)(((unsigned long long)hb[c][3] << 32) | hb[c][2]), acc, 0, 0, 0); }
    constexpr int base = (U & 7) * 8; const int r = li & 3;
    const float sel = r == 0 ? acc[0] : (r == 1 ? acc[1] : (r == 2 ? acc[2] : acc[3]));
    const float dmine = __shfl(sel, ((lane & 7) >> 2) * 16 + (lane & 3));
    const float gsel = U < 8 ? C.glo : C.ghi, susel = U < 8 ? su_lo : su_hi, svsel = U < 8 ? sv_lo : sv_hi;
    const float wv = gsel * gelu_erf(dmine * susel * hinv) * svsel;
    const bool mine = (lane >= base) && (lane < base + 8);
    if (U < 8) w_lo = mine ? wv : w_lo; else w_hi = mine ? wv : w_hi;
    asm volatile("s_waitcnt lgkmcnt(0)" ::: "memory");
    __builtin_amdgcn_sched_barrier(0);
    if (U == 2) { u10_meta_load(N, ws, tn, l16); __builtin_amdgcn_sched_barrier(0); }
    if (U == 10) { const float* EUS = (const float*)(ws + WS_EUS); const float* EVS = (const float*)(ws + WS_EVS); nsu_lo = EUS[N.elo]; nsu_hi = EUS[N.ehi]; nsv_lo = EVS[N.elo]; nsv_hi = EVS[N.ehi]; __builtin_amdgcn_sched_barrier(0); }
}
__device__ __forceinline__ void p8_peer_up10(Frame& F) {
    const int f_tid = threadIdx.x, lane = f_tid & 63, f_wave = __builtin_amdgcn_readfirstlane(f_tid >> 6);
    const int lq = lane >> 4;
    const unsigned char* EU = F.ws + WS_EU; const float* EUS = WSP(float, WS_EUS); const float* EVS = WSP(float, WS_EVS);
    LAS unsigned char* ring = F.lds + f_wave * U6_WAVE; LAS unsigned char* hq = ring + 2 * U6_BUF;
    for (int wq = F.vcu * NWAVES + f_wave; wq < MTOK / 16; wq += F.G * NWAVES) {
        const int b = wq >> 7; const float* mb = WSP(float, WS_MOD) + (size_t)b * 6144;
        unsigned l16 = 16u * (unsigned)lane; asm volatile("" : "+v"(l16));
        float S2[16];
#pragma unroll
        for (int q = 0; q < 4; ++q) { const f32x4 sh = *(const f32x4*)((const char*)(mb + 3072) + 4u * l16 + 16 * q); S2[4 * q] = sh[0]; S2[4 * q + 1] = sh[1]; S2[4 * q + 2] = sh[2]; S2[4 * q + 3] = sh[3]; }
        const size_t t0 = (size_t)wq * 16;
        U10Meta C, N;
        u10_meta_load(C, F.ws, t0, l16);
        asm volatile("s_waitcnt vmcnt(0)" ::: "memory");
        u10_meta_touch(C);
        u10_unit_dma<0>(C.elo, C.ehi, EU, l16, ring);
        float su_lo = EUS[C.elo], su_hi = EUS[C.ehi], sv_lo = EVS[C.elo], sv_hi = EVS[C.ehi];
        float nsu_lo = 0.f, nsu_hi = 0.f, nsv_lo = 0.f, nsv_hi = 0.f;
        v4u hb[16]; float hinv;
        u10_h2(C, S2, hq, l16, lq, hb, hinv);
        N = C;
        asm volatile("s_waitcnt vmcnt(0)" ::: "memory");
        asm volatile("" : "+v"(su_lo), "+v"(su_hi), "+v"(sv_lo), "+v"(sv_hi));
#pragma unroll 1
        for (int tt = 0; tt < 16; ++tt) {
            float w_lo = 0.f, w_hi = 0.f;
            const size_t tn = t0 + (tt < 15 ? tt + 1 : tt);
            const bool ft = (tt == 0);
#define U10_U(U) u10_unit<U>(C, N, EU, F.ws, l16, ring, hb, hinv, su_lo, su_hi, sv_lo, sv_hi, nsu_lo, nsu_hi, nsv_lo, nsv_hi, w_lo, w_hi, tn, ft, lane);
            U10_U(0) U10_U(1) U10_U(2) U10_U(3) U10_U(4) U10_U(5) U10_U(6) U10_U(7) U10_U(8) U10_U(9) U10_U(10) U10_U(11) U10_U(12) U10_U(13) U10_U(14) U10_U(15)
#undef U10_U
            WSP(float, WS_GATE)[(t0 + tt) * 128 + lane] = w_lo; WSP(float, WS_GATE)[(t0 + tt) * 128 + 64 + lane] = w_hi;
            __builtin_amdgcn_sched_barrier(0);
            C = N; su_lo = nsu_lo; su_hi = nsu_hi; sv_lo = nsv_lo; sv_hi = nsv_hi;
            u10_h2(C, S2, hq, l16, lq, hb, hinv);
        }
        asm volatile("s_waitcnt vmcnt(0)" ::: "memory");
    }
}
#ifndef U11_AUX
#define U11_AUX 0
#endif
constexpr int U11_HQ = 2 * U6_BUF, U11_IDS = U11_HQ + 1024, U11_GATES = U11_IDS + 512, U11_SC = U11_GATES + 512, U11_HINV = U11_SC + 1024, U11_WAVE = U11_HINV + 256;
static_assert(8 * U11_WAVE <= LDS_MAIN, "U11 LDS map");
__device__ __forceinline__ void u11_dma4(const void* g, LAS unsigned char* l) { __builtin_amdgcn_global_load_lds((const unsigned*)g, (LAS unsigned*)l, 4, 0, 0); }
__device__ __forceinline__ void u11_stage1(const unsigned char* ws, size_t t, unsigned l16, LAS unsigned char* W) {
    const unsigned l4 = l16 >> 2;
    const unsigned char* ep = ws + WS_EID + t * 512; const unsigned char* gp = ws + WS_GATE + t * 512;
    u11_dma4(ep + l4, W + U11_IDS); u11_dma4(ep + 256 + l4, W + U11_IDS + 256);
    u11_dma4(gp + l4, W + U11_GATES); u11_dma4(gp + 256 + l4, W + U11_GATES + 256);
    __builtin_amdgcn_global_load_lds((const unsigned*)(ws + WS_H2Q + t * 1024 + l16), (LAS unsigned*)(W + U11_HQ), 16, 0, 0);
    u11_dma4(ws + WS_HINV + t * 4 + (l16 >> 30), W + U11_HINV);
}
__device__ __forceinline__ void u11_stage2(const unsigned char* ws, int elo, int ehi, LAS unsigned char* W) {
    u11_dma4(ws + WS_EUS + 4u * (unsigned)elo, W + U11_SC); u11_dma4(ws + WS_EUS + 4u * (unsigned)ehi, W + U11_SC + 256);
    u11_dma4(ws + WS_EVS + 4u * (unsigned)elo, W + U11_SC + 512); u11_dma4(ws + WS_EVS + 4u * (unsigned)ehi, W + U11_SC + 768);
}
template <int UN> __device__ __forceinline__ void u11_unit_dma(int elo, int ehi, const unsigned char* EU, unsigned l16, LAS unsigned char* dst) {
    const int ensel = UN < 8 ? elo : ehi; constexpr int nb = (UN & 7) * 8;
#pragma unroll
    for (int j = 0; j < 8; ++j) { const int e = __builtin_amdgcn_readlane(ensel, nb + j);
        __builtin_amdgcn_global_load_lds((const unsigned*)(EU + ((unsigned)e * 1024u + l16)), (LAS unsigned*)(dst + j * U6_ROWP), 16, 0, U11_AUX); }
}
struct U11Tok { int elo, ehi; float glo, ghi, su_lo, su_hi, sv_lo, sv_hi, hinv; };
__device__ __forceinline__ void u11_switch(U11Tok& C, int nelo, int nehi, LAS unsigned char* W, unsigned l16, int lq, v4u* hb) {
    const unsigned l4 = l16 >> 2;
    C.elo = nelo; C.ehi = nehi;
    C.glo = *(const LAS float*)(W + U11_GATES + l4); C.ghi = *(const LAS float*)(W + U11_GATES + 256 + l4);
    C.su_lo = *(const LAS float*)(W + U11_SC + l4); C.su_hi = *(const LAS float*)(W + U11_SC + 256 + l4); C.sv_lo = *(const LAS float*)(W + U11_SC + 512 + l4); C.sv_hi = *(const LAS float*)(W + U11_SC + 768 + l4);
    C.hinv = *(const LAS float*)(W + U11_HINV + l4);
#pragma unroll
    for (int c = 0; c < 16; ++c) hb[c] = *(const LAS v4u*)(W + U11_HQ + 64 * c + 16 * lq);
    LDS_WAIT(); asm volatile("" ::: "memory");
}
template <int U> __device__ __forceinline__ void u11_unit(const U11Tok& C, int& nelo, int& nehi, const unsigned char* EU, const unsigned char* ws, unsigned l16, LAS unsigned char* W, const v4u* hb,
                                                          float& w_lo, float& w_hi, size_t tn, bool first_token, int lane) {
    const int li = lane & 15, lq = lane >> 4;
    if (U == 15) u11_unit_dma<0>(nelo, nehi, EU, l16, W); else u11_unit_dma<(U + 1) & 15>(C.elo, C.ehi, EU, l16, W + ((U + 1) & 1) * U6_BUF);
    __builtin_amdgcn_sched_barrier(0);
    if (U == 0) { if (first_token) asm volatile("s_waitcnt vmcnt(8)" ::: "memory"); else asm volatile("s_waitcnt vmcnt(10)" ::: "memory"); }
    else if (U == 3) asm volatile("s_waitcnt vmcnt(14)" ::: "memory");
    else if (U == 5) asm volatile("s_waitcnt vmcnt(12)" ::: "memory");
    else asm volatile("s_waitcnt vmcnt(8)" ::: "memory");
    __builtin_amdgcn_sched_barrier(0);
    const LAS unsigned char* src = W + (U & 1) * U6_BUF + (li & 7) * U6_ROWP + 16 * lq;
    f32x4 acc = (f32x4){0.f, 0.f, 0.f, 0.f};
#pragma unroll
    for (int c = 0; c < 16; ++c) { const v4u a = *(const LAS v4u*)(src + 64 * c);
        acc = __builtin_amdgcn_mfma_f32_16x16x32_fp8_fp8((i64_t)(((unsigned long long)a[1] << 32) | a[0]), (i64_t)(((unsigned long long)hb[c][1] << 32) | hb[c][0]), acc, 0, 0, 0);
        acc = __builtin_amdgcn_mfma_f32_16x16x32_fp8_fp8((i64_t)(((unsigned long long)a[3] << 32) | a[2]), (i64_t)(((unsigned long long)hb[c][3] << 32) | hb[c][2]), acc, 0, 0, 0); }
    constexpr int base = (U & 7) * 8; const int r = li & 3;
    const float sel = r == 0 ? acc[0] : (r == 1 ? acc[1] : (r == 2 ? acc[2] : acc[3]));
    const float dmine = __shfl(sel, ((lane & 7) >> 2) * 16 + (lane & 3));
    const float gsel = U < 8 ? C.glo : C.ghi, susel = U < 8 ? C.su_lo : C.su_hi, svsel = U < 8 ? C.sv_lo : C.sv_hi;
    const float wv = gsel * gelu_erf(dmine * susel * C.hinv) * svsel;
    const bool mine = (lane >= base) && (lane < base + 8);
    if (U < 8) w_lo = mine ? wv : w_lo; else w_hi = mine ? wv : w_hi;
    if (U == 4) { nelo = *(const LAS int*)(W + U11_IDS + (l16 >> 2)); nehi = *(const LAS int*)(W + U11_IDS + 256 + (l16 >> 2)); }
    asm volatile("s_waitcnt lgkmcnt(0)" ::: "memory");
    __builtin_amdgcn_sched_barrier(0);
    if (U == 2) { u11_stage1(ws, tn, l16, W); __builtin_amdgcn_sched_barrier(0); }
    if (U == 4) { u11_stage2(ws, nelo, nehi, W); __builtin_amdgcn_sched_barrier(0); }
}
__device__ __forceinline__ void p8_peer_up11(Frame& F) {
    const int f_tid = threadIdx.x, lane = f_tid & 63, f_wave = __builtin_amdgcn_readfirstlane(f_tid >> 6);
    const int lq = lane >> 4;
    const unsigned char* EU = F.ws + WS_EU;
    LAS unsigned char* W = F.lds + f_wave * U11_WAVE;
    for (int wq = F.vcu * NWAVES + f_wave; wq < MTOK / 16; wq += F.G * NWAVES) {
        unsigned l16 = 16u * (unsigned)lane; asm volatile("" : "+v"(l16));
        const size_t t0 = (size_t)wq * 16;
        u11_stage1(F.ws, t0, l16, W);
        asm volatile("s_waitcnt vmcnt(0)" ::: "memory");
        int nelo = *(const LAS int*)(W + U11_IDS + (l16 >> 2)), nehi = *(const LAS int*)(W + U11_IDS + 256 + (l16 >> 2));
        LDS_WAIT(); asm volatile("" ::: "memory");
        u11_stage2(F.ws, nelo, nehi, W);
        u11_unit_dma<0>(nelo, nehi, EU, l16, W);
        asm volatile("s_waitcnt vmcnt(0)" ::: "memory");
        U11Tok C; v4u hb[16];
        u11_switch(C, nelo, nehi, W, l16, lq, hb);
#pragma unroll 1
        for (int tt = 0; tt < 16; ++tt) {
            float w_lo = 0.f, w_hi = 0.f;
            const size_t tn = t0 + (tt < 15 ? tt + 1 : tt);
            const bool ft = (tt == 0);
#define U11_U(U) u11_unit<U>(C, nelo, nehi, EU, F.ws, l16, W, hb, w_lo, w_hi, tn, ft, lane);
            U11_U(0) U11_U(1) U11_U(2) U11_U(3) U11_U(4) U11_U(5) U11_U(6) U11_U(7) U11_U(8) U11_U(9) U11_U(10) U11_U(11) U11_U(12) U11_U(13) U11_U(14) U11_U(15)
#undef U11_U
            WSP(float, WS_GATE)[(t0 + tt) * 128 + lane] = w_lo; WSP(float, WS_GATE)[(t0 + tt) * 128 + 64 + lane] = w_hi;
            __builtin_amdgcn_sched_barrier(0);
            u11_switch(C, nelo, nehi, W, l16, lq, hb);
        }
        asm volatile("s_waitcnt vmcnt(0)" ::: "memory");
    }
}
typedef unsigned v3u __attribute__((ext_vector_type(3)));
typedef unsigned v6u __attribute__((ext_vector_type(6)));
typedef float f32x32 __attribute__((ext_vector_type(32)));
struct __attribute__((packed, aligned(4))) U3 { unsigned a, b, c; };
__device__ __forceinline__ v3u ld_row6(const unsigned char* p) { const U3 u = *(const U3*)p; return (v3u){u.a, u.b, u.c}; }
__device__ __forceinline__ void p9_peer_down3(Frame& F) {
    const int f_tid = threadIdx.x, lane = f_tid & 63, f_wave = __builtin_amdgcn_readfirstlane(f_tid >> 6);
    const unsigned char* EV = F.ws + WS_EV;
    for (int wq = F.vcu * NWAVES + f_wave; wq < MTOK / 16; wq += F.G * NWAVES) {
        const int b = wq >> 7; const float* mb = WSP(float, WS_MOD) + (size_t)b * 6144;
        int ne_lo = WSP(int, WS_EID)[(size_t)wq * 16 * 128 + lane], ne_hi = WSP(int, WS_EID)[(size_t)wq * 16 * 128 + 64 + lane];
        float nw_lo = WSP(float, WS_GATE)[(size_t)wq * 16 * 128 + lane], nw_hi = WSP(float, WS_GATE)[(size_t)wq * 16 * 128 + 64 + lane];
        for (int tt = 0; tt < 16; ++tt) {
            const size_t t = (size_t)wq * 16 + tt;
            unsigned l16 = 16u * (unsigned)lane; asm volatile("" : "+v"(l16));
            const unsigned l12 = (l16 >> 2) * 3u;
            float* xr = (float*)((char*)(F.out + t * 1024) + 4u * l16);
            const int e_lo = ne_lo, e_hi = ne_hi; const float w_lo = nw_lo, w_hi = nw_hi;
            f32x2 o[8];
#pragma unroll
            for (int i = 0; i < 8; ++i) o[i] = (f32x2){0.f, 0.f};
#ifdef DN3_G16
            v3u qa[16], qb[16];
#pragma unroll
            for (int j = 0; j < 16; ++j) { const int e = __builtin_amdgcn_readlane(e_lo, j); qa[j] = ld_row6(EV + ((unsigned)e * 768u + l12)); }
#define DN3_STEP(GRP, CUR, NXT) { \
                const int grp = (GRP); const int nb = ((grp + 1) & 3) * 16; const int ensel = ((grp + 1) & 7) < 4 ? e_lo : e_hi; \
                { _Pragma("unroll") for (int j = 0; j < 16; ++j) { const int e = __builtin_amdgcn_readlane(ensel, nb + j); NXT[j] = ld_row6(EV + ((unsigned)e * 768u + l12)); } } \
                __builtin_amdgcn_sched_barrier(0); \
                const int base = (grp & 3) * 16; const float wsel = grp < 4 ? w_lo : w_hi; \
                _Pragma("unroll") for (int j = 0; j < 16; j += 2) { \
                    const float wa = __builtin_bit_cast(float, __builtin_amdgcn_readlane(__builtin_bit_cast(int, wsel), base + j)), wb = __builtin_bit_cast(float, __builtin_amdgcn_readlane(__builtin_bit_cast(int, wsel), base + j + 1)); \
                    const f32x2 wa2 = (f32x2){wa, wa}, wb2 = (f32x2){wb, wb}; \
                    const v6u pr = (v6u){CUR[j][0], CUR[j][1], CUR[j][2], CUR[j + 1][0], CUR[j + 1][1], CUR[j + 1][2]}; \
                    const f32x32 r = __builtin_amdgcn_cvt_scalef32_pk32_f32_fp6(pr, 1.0f); \
                    _Pragma("unroll") for (int i = 0; i < 8; ++i) { o[i] += wa2 * (f32x2){r[2 * i], r[2 * i + 1]}; o[i] += wb2 * (f32x2){r[16 + 2 * i], r[17 + 2 * i]}; } } }
#pragma unroll 1
            for (int g2 = 0; g2 < 8; g2 += 2) { DN3_STEP(g2, qa, qb) DN3_STEP(g2 + 1, qb, qa) }
#else
            v3u qa[8], qb[8];
#pragma unroll
            for (int j = 0; j < 8; ++j) { const int e = __builtin_amdgcn_readlane(e_lo, j); qa[j] = ld_row6(EV + ((unsigned)e * 768u + l12)); }
#define DN3_STEP(GRP, CUR, NXT) { \
                const int grp = (GRP); const int nb = ((grp + 1) & 7) * 8; const int ensel = (grp + 1) < 8 ? e_lo : e_hi; \
                { _Pragma("unroll") for (int j = 0; j < 8; ++j) { const int e = __builtin_amdgcn_readlane(ensel, nb + j); NXT[j] = ld_row6(EV + ((unsigned)e * 768u + l12)); } } \
                __builtin_amdgcn_sched_barrier(0); \
                const int base = (grp & 7) * 8; const float wsel = grp < 8 ? w_lo : w_hi; \
                _Pragma("unroll") for (int j = 0; j < 8; j += 2) { \
                    const float wa = __builtin_bit_cast(float, __builtin_amdgcn_readlane(__builtin_bit_cast(int, wsel), base + j)), wb = __builtin_bit_cast(float, __builtin_amdgcn_readlane(__builtin_bit_cast(int, wsel), base + j + 1)); \
                    const f32x2 wa2 = (f32x2){wa, wa}, wb2 = (f32x2){wb, wb}; \
                    const v6u pr = (v6u){CUR[j][0], CUR[j][1], CUR[j][2], CUR[j + 1][0], CUR[j + 1][1], CUR[j + 1][2]}; \
                    const f32x32 r = __builtin_amdgcn_cvt_scalef32_pk32_f32_fp6(pr, 1.0f); \
                    _Pragma("unroll") for (int i = 0; i < 8; ++i) { o[i] += wa2 * (f32x2){r[2 * i], r[2 * i + 1]}; o[i] += wb2 * (f32x2){r[16 + 2 * i], r[17 + 2 * i]}; } } }
#pragma unroll 1
            for (int g2 = 0; g2 < 16; g2 += 2) { DN3_STEP(g2, qa, qb) DN3_STEP(g2 + 1, qb, qa) }
#endif
#undef DN3_STEP
            { const size_t tn = t + (tt < 15 ? 1 : 0); ne_lo = WSP(int, WS_EID)[tn * 128 + lane]; ne_hi = WSP(int, WS_EID)[tn * 128 + 64 + lane]; nw_lo = WSP(float, WS_GATE)[tn * 128 + lane]; nw_hi = WSP(float, WS_GATE)[tn * 128 + 64 + lane]; }
            float x1[16]; float ss = 0.f;
#pragma unroll
            for (int q4 = 0; q4 < 4; ++q4) { const f32x4 v = *(const f32x4*)(xr + 4 * q4); x1[4 * q4] = v[0]; x1[4 * q4 + 1] = v[1]; x1[4 * q4 + 2] = v[2]; x1[4 * q4 + 3] = v[3]; }
#pragma unroll
            for (int q4 = 0; q4 < 4; ++q4) { const f32x4 gt = *(const f32x4*)((const char*)(mb + 5120) + 4u * l16 + 16 * q4);
#pragma unroll
                for (int e = 0; e < 4; ++e) { const int i = 4 * q4 + e; x1[i] += gt[e] * o[i >> 1][i & 1]; ss += x1[i] * x1[i]; } }
            const float rf = rsqrt_f(wave_sum(ss) * (1.0f / 1024.0f) + EPSF);
#pragma unroll
            for (int q4 = 0; q4 < 4; ++q4) { const f32x4 nf = *(const f32x4*)((const char*)(F.a->in[29]) + 4u * l16 + 16 * q4); f32x4 v;
#pragma unroll
                for (int e = 0; e < 4; ++e) v[e] = x1[4 * q4 + e] * rf * nf[e];
                *(f32x4*)(xr + 4 * q4) = v; }
        }
    }
}
constexpr int U12_ROWP = 784, U12_NBUF = 3, U12_BUF = 8 * U12_ROWP, U12_WAVE = U12_NBUF * U12_BUF + 1024;
static_assert(8 * U12_WAVE <= LDS_MAIN, "U12 LDS map");
typedef int i32x8 __attribute__((ext_vector_type(8)));
typedef unsigned v2u __attribute__((ext_vector_type(2)));
__device__ __forceinline__ void p8_peer_up12(Frame& F) {
    const int f_tid = threadIdx.x, lane = f_tid & 63, f_wave = __builtin_amdgcn_readfirstlane(f_tid >> 6);
    const int li = lane & 15, lq = lane >> 4;
    const unsigned char* EU = F.ws + WS_EU; const float* EUS = WSP(float, WS_EUS); const float* EVS = WSP(float, WS_EVS);
    LAS unsigned char* ring = F.lds + f_wave * U12_WAVE; LAS unsigned char* hq = ring + U12_NBUF * U12_BUF;
#ifdef PROBE_MFMA
    if (blockIdx.x == 0 && f_wave == 0) {
        i32x8 A = (i32x8){0, 0, 0, 0, 0, 0, 0, 0}; if (lane == PROBE_ALANE) A[PROBE_AREG] = PROBE_AVAL;
        i32x8 B;
        if (PROBE_BPAT == 0) B = (i32x8){0x48444038, 0x504E4C4A, 0x54535251, 0x58575655, 0x48444038, 0x504E4C4A, 0x54535251, 0x58575655};
        else { const unsigned c0 = (const unsigned[]){0x38u, 0x40u, 0x44u, 0x48u, 0x4Au, 0x4Cu, 0x4Eu, 0x50u}[0]; (void)c0;
               const int k = lane >> 4; const unsigned lo = k == 0 ? 0x38u : (k == 1 ? 0x44u : (k == 2 ? 0x4Au : 0x4Eu)), hi = k == 0 ? 0x40u : (k == 1 ? 0x48u : (k == 2 ? 0x4Cu : 0x50u));
               const int wl = (int)(lo * 0x01010101u), wh = (int)(hi * 0x01010101u); B = (i32x8){wl, wl, wl, wl, wh, wh, wh, wh}; }
        f32x4 acc = (f32x4){0.f, 0.f, 0.f, 0.f};
        acc = __builtin_amdgcn_mfma_scale_f32_16x16x128_f8f6f4(A, B, acc, 2, 0, 0, 0, 0, 0);
        if (lane == 0) *(volatile float*)(F.ws + WS_CTL + 40000) = acc[0] * 100.0f;
    }
#endif
    for (int wq = F.vcu * NWAVES + f_wave; wq < MTOK / 16; wq += F.G * NWAVES) {
        const int b = wq >> 7; const float* mb = WSP(float, WS_MOD) + (size_t)b * 6144;
        for (int tt = 0; tt < 16; ++tt) {
            const size_t t = (size_t)wq * 16 + tt;
            unsigned l16 = 16u * (unsigned)lane; asm volatile("" : "+v"(l16));
            const int e_lo = WSP(int, WS_EID)[t * 128 + lane], e_hi = WSP(int, WS_EID)[t * 128 + 64 + lane];
            const float g_lo = WSP(float, WS_GATE)[t * 128 + lane], g_hi = WSP(float, WS_GATE)[t * 128 + 64 + lane];
            const float rs = rsqrt_f(WSP(float, WS_ROWSTAT)[t] * (1.0f / 1024.0f) + EPSF);
            const char* xs = (const char*)(WSP(bf16, WS_X1S) + t * 1024) + 2u * l16; const v4u xa = *(const v4u*)xs, xb = *(const v4u*)(xs + 16);
            asm volatile("s_waitcnt vmcnt(0)" ::: "memory");
            if (lane < 48) {
#pragma unroll
            for (int j = 0; j < 16; ++j) { const int e = __builtin_amdgcn_readlane(e_lo, j);
                __builtin_amdgcn_global_load_lds((const unsigned*)(EU + ((unsigned)e * 768u + l16)), (LAS unsigned*)(ring + j * U12_ROWP), 16, 0, 0); } }
            const float su_lo = EUS[e_lo], su_hi = EUS[e_hi], sv_lo = EVS[e_lo], sv_hi = EVS[e_hi];
            float h2[16]; unpack8(xa, h2); unpack8(xb, h2 + 8); float mx = 0.f;
#pragma unroll
            for (int qd = 0; qd < 4; ++qd) { const f32x4 sh = *(const f32x4*)((const char*)(mb + 3072) + 4u * l16 + 16 * qd);
#pragma unroll
                for (int e = 0; e < 4; ++e) { h2[4 * qd + e] = h2[4 * qd + e] * rs + sh[e]; mx = fmaxf(mx, fabsf(h2[4 * qd + e])); } }
#pragma unroll
            for (int o = 1; o < 64; o <<= 1) mx = fmaxf(mx, __shfl_xor(mx, o));
            mx = fmaxf(mx, 1e-30f); const float hs = 224.0f / mx, hinv = mx * (1.0f / 224.0f);
            { v4u w;
#pragma unroll
              for (int qd = 0; qd < 4; ++qd) { int pk = 0; pk = __builtin_amdgcn_cvt_pk_fp8_f32(h2[4 * qd] * hs, h2[4 * qd + 1] * hs, pk, false); pk = __builtin_amdgcn_cvt_pk_fp8_f32(h2[4 * qd + 2] * hs, h2[4 * qd + 3] * hs, pk, true); w[qd] = (unsigned)pk; }
              *(LAS v4u*)(hq + l16) = w; }
            LDS_WAIT(); asm volatile("" ::: "memory");
            v4u hb[8];
#pragma unroll
            for (int c = 0; c < 4; ++c) { hb[2 * c] = *(const LAS v4u*)(hq + (li & 1) * 512 + 128 * c + 16 * lq); hb[2 * c + 1] = *(const LAS v4u*)(hq + (li & 1) * 512 + 128 * c + 64 + 16 * lq); }
            asm volatile("s_waitcnt vmcnt(0)" ::: "memory");
            float w_lo = 0.f, w_hi = 0.f;
            int cur = 0, nx2 = 2 * U12_BUF;
#pragma unroll 1
            for (int u = 0; u < 16; ++u) {
                if (u < 14) { const int un = u + 2; int ensel = un < 8 ? e_lo : e_hi; asm volatile("" : "+v"(ensel));     const int nb = (un & 7) * 8; LAS unsigned char* dst = ring + nx2;
                  if (lane < 48) {
#pragma unroll
                  for (int j = 0; j < 8; ++j) { const int e = __builtin_amdgcn_readlane(ensel, nb + j);
                      __builtin_amdgcn_global_load_lds((const unsigned*)(EU + ((unsigned)e * 768u + l16)), (LAS unsigned*)(dst + j * U12_ROWP), 16, 0, 0); } }
                  asm volatile("s_waitcnt vmcnt(16)" ::: "memory"); }
                else if (u == 14) asm volatile("s_waitcnt vmcnt(8)" ::: "memory");
                else asm volatile("s_waitcnt vmcnt(0)" ::: "memory");
                const LAS unsigned char* src = ring + cur + (li & 7) * U12_ROWP + (li >> 3) * 384 + 24 * lq;
                f32x4 acc = (f32x4){0.f, 0.f, 0.f, 0.f};
#pragma unroll
                for (int c = 0; c < 4; ++c) { const v2u a0 = *(const LAS v2u*)(src + 96 * c), a1 = *(const LAS v2u*)(src + 96 * c + 8), a2 = *(const LAS v2u*)(src + 96 * c + 16);
                    const i32x8 A = (i32x8){(int)a0[0], (int)a0[1], (int)a1[0], (int)a1[1], (int)a2[0], (int)a2[1], 0, 0};
                    const i32x8 B = (i32x8){(int)hb[2 * c][0], (int)hb[2 * c][1], (int)hb[2 * c][2], (int)hb[2 * c][3], (int)hb[2 * c + 1][0], (int)hb[2 * c + 1][1], (int)hb[2 * c + 1][2], (int)hb[2 * c + 1][3]};
                    acc = __builtin_amdgcn_mfma_scale_f32_16x16x128_f8f6f4(A, B, acc, 2, 0, 0, 0, 0, 0); }
                const int base = (u & 7) * 8; const int r = (li >> 1) & 3;
                const float sel = r == 0 ? acc[0] : (r == 1 ? acc[1] : (r == 2 ? acc[2] : acc[3]));
                const int sl = ((lane & 7) >> 2) * 16 + 2 * (lane & 3);
                const float dmine = __shfl(sel, sl) + __shfl(sel, sl + 33);
                const float gsel = u < 8 ? g_lo : g_hi, susel = u < 8 ? su_lo : su_hi, svsel = u < 8 ? sv_lo : sv_hi;
                const float wv = gsel * gelu_erf(dmine * susel * hinv) * svsel;
                const bool mine = (lane >= base) && (lane < base + 8);
                if (u < 8) w_lo = mine ? wv : w_lo; else w_hi = mine ? wv : w_hi;
                asm volatile("s_waitcnt lgkmcnt(0)" ::: "memory");
                cur = cur == 2 * U12_BUF ? 0 : cur + U12_BUF; nx2 = nx2 == 2 * U12_BUF ? 0 : nx2 + U12_BUF;
            }
            WSP(float, WS_GATE)[t * 128 + lane] = w_lo; WSP(float, WS_GATE)[t * 128 + 64 + lane] = w_hi;
        }
    }
}
constexpr int U14_ROWP = 1040, U14_BUF = 8 * U14_ROWP, U14_WAVE = 2 * U14_BUF + 1024;
static_assert(8 * U14_WAVE <= LDS_MAIN, "U14 LDS map");
struct U14Meta { int elo, ehi; float glo, ghi; v4u xa, xb; float rst; };
__device__ __forceinline__ void u14_meta_load(U14Meta& M, const unsigned char* ws, size_t t, unsigned l16) {
    const unsigned l = l16 >> 4; const int* ep = (const int*)(ws + WS_EID) + t * 128; const float* gp = (const float*)(ws + WS_GATE) + t * 128;
    M.elo = ep[l]; M.ehi = ep[64 + l]; M.glo = gp[l]; M.ghi = gp[64 + l];
    const char* xs = (const char*)(ws + WS_X1S) + t * 2048 + 2u * l16; M.xa = *(const v4u*)xs; M.xb = *(const v4u*)(xs + 16);
    M.rst = ((const float*)(ws + WS_ROWSTAT))[t];
}
__device__ __forceinline__ void u14_h2(const U14Meta& M, const float* S2, LAS unsigned char* hq, unsigned l16, int li, int lq, v4u* hb, float& hinv) {
    float h2[16]; unpack8(M.xa, h2); unpack8(M.xb, h2 + 8); float mx = 0.f;
    const float rs = rsqrt_f(M.rst * (1.0f / 1024.0f) + EPSF);
#pragma unroll
    for (int i = 0; i < 16; ++i) { h2[i] = h2[i] * rs + S2[i]; mx = fmaxf(mx, fabsf(h2[i])); }
#pragma unroll
    for (int o = 1; o < 64; o <<= 1) mx = fmaxf(mx, __shfl_xor(mx, o));
    mx = fmaxf(mx, 1e-30f); const float hs = 224.0f / mx; hinv = mx * (1.0f / 224.0f);
    v4u w;
#pragma unroll
    for (int qd = 0; qd < 4; ++qd) { int pk = 0; pk = __builtin_amdgcn_cvt_pk_fp8_f32(h2[4 * qd] * hs, h2[4 * qd + 1] * hs, pk, false); pk = __builtin_amdgcn_cvt_pk_fp8_f32(h2[4 * qd + 2] * hs, h2[4 * qd + 3] * hs, pk, true); w[qd] = (unsigned)pk; }
    *(LAS v4u*)(hq + l16) = w;
    LDS_WAIT(); asm volatile("" ::: "memory");
#pragma unroll
    for (int c = 0; c < 4; ++c) { hb[2 * c] = *(const LAS v4u*)(hq + (li & 1) * 512 + 128 * c + 16 * lq); hb[2 * c + 1] = *(const LAS v4u*)(hq + (li & 1) * 512 + 128 * c + 64 + 16 * lq); }
    LDS_WAIT(); asm volatile("" ::: "memory");
}
__device__ __forceinline__ void p8_peer_up14(Frame& F) {
    const int f_tid = threadIdx.x, lane = f_tid & 63, f_wave = __builtin_amdgcn_readfirstlane(f_tid >> 6);
    const int li = lane & 15, lq = lane >> 4;
    const unsigned char* EU = F.ws + WS_EU; const float* EUS = WSP(float, WS_EUS); const float* EVS = WSP(float, WS_EVS);
    LAS unsigned char* tile = F.lds + f_wave * U14_WAVE; LAS unsigned char* hq = tile + 2 * U14_BUF;
    for (int wq = F.vcu * NWAVES + f_wave; wq < MTOK / 16; wq += F.G * NWAVES) {
        const int b = wq >> 7; const float* mb = WSP(float, WS_MOD) + (size_t)b * 6144;
        unsigned l16 = 16u * (unsigned)lane; asm volatile("" : "+v"(l16));
        const unsigned rof = l16 < 768u ? l16 : l16 - 768u;
        float S2[16];
#pragma unroll
        for (int q = 0; q < 4; ++q) { const f32x4 sh = *(const f32x4*)((const char*)(mb + 3072) + 4u * l16 + 16 * q); S2[4 * q] = sh[0]; S2[4 * q + 1] = sh[1]; S2[4 * q + 2] = sh[2]; S2[4 * q + 3] = sh[3]; }
        const size_t t0 = (size_t)wq * 16;
        U14Meta N; u14_meta_load(N, F.ws, t0, l16);
        float nsu_lo = EUS[N.elo], nsu_hi = EUS[N.ehi], nsv_lo = EVS[N.elo], nsv_hi = EVS[N.ehi];
        v4u qa[8], qb[8];
#pragma unroll
        for (int j = 0; j < 8; ++j) { const int e = __builtin_amdgcn_readlane(N.elo, j); qa[j] = *(const v4u*)(EU + ((unsigned)e * 768u + rof)); }
#pragma unroll 1
        for (int tt = 0; tt < 16; ++tt) {
            const size_t t = t0 + tt;
            const int e_lo = N.elo, e_hi = N.ehi; const float g_lo = N.glo, g_hi = N.ghi, su_lo = nsu_lo, su_hi = nsu_hi, sv_lo = nsv_lo, sv_hi = nsv_hi;
            v4u hb[8]; float hinv;
            u14_h2(N, S2, hq, l16, li, lq, hb, hinv);
            u14_meta_load(N, F.ws, t + (tt < 15 ? 1 : 0), l16);
            float w_lo = 0.f, w_hi = 0.f;
#define U14_STEP(UU, CUR, NXT, NLO, NHI) { \
            const int u = (UU); const int un = (u + 1) & 15; const int nb = (un & 7) * 8; const int ensel = un < 8 ? (NLO) : (NHI); \
            { _Pragma("unroll") for (int j = 0; j < 8; ++j) { const int e = __builtin_amdgcn_readlane(ensel, nb + j); NXT[j] = *(const v4u*)(EU + ((unsigned)e * 768u + rof)); } } \
            __builtin_amdgcn_sched_barrier(0); \
            LAS unsigned char* tb = tile + (u & 1) * U14_BUF; \
            { _Pragma("unroll") for (int j = 0; j < 8; ++j) *(LAS v4u*)(tb + j * U14_ROWP + l16) = CUR[j]; } \
            LDS_WAIT(); asm volatile("" ::: "memory"); \
            const LAS unsigned char* src = tb + (li & 7) * U14_ROWP + (li >> 3) * 384 + 24 * lq; \
            f32x4 acc = (f32x4){0.f, 0.f, 0.f, 0.f}; \
            _Pragma("unroll") for (int c = 0; c < 4; ++c) { const v2u a0 = *(const LAS v2u*)(src + 96 * c), a1 = *(const LAS v2u*)(src + 96 * c + 8), a2 = *(const LAS v2u*)(src + 96 * c + 16); \
                const i32x8 A = (i32x8){(int)a0[0], (int)a0[1], (int)a1[0], (int)a1[1], (int)a2[0], (int)a2[1], 0, 0}; \
                const i32x8 B = (i32x8){(int)hb[2 * c][0], (int)hb[2 * c][1], (int)hb[2 * c][2], (int)hb[2 * c][3], (int)hb[2 * c + 1][0], (int)hb[2 * c + 1][1], (int)hb[2 * c + 1][2], (int)hb[2 * c + 1][3]}; \
                acc = __builtin_amdgcn_mfma_scale_f32_16x16x128_f8f6f4(A, B, acc, 2, 0, 0, 0, 0, 0); }        \
            const int base = (u & 7) * 8; const int r = (li >> 1) & 3; \
            const float sel = r == 0 ? acc[0] : (r == 1 ? acc[1] : (r == 2 ? acc[2] : acc[3])); \
            const int sl = ((lane & 7) >> 2) * 16 + 2 * (lane & 3);                          \
            const float dmine = __shfl(sel, sl) + __shfl(sel, sl + 33); \
            const float gsel = u < 8 ? g_lo : g_hi, susel = u < 8 ? su_lo : su_hi, svsel = u < 8 ? sv_lo : sv_hi; \
            const float wv = gsel * gelu_erf(dmine * susel * hinv) * svsel; \
            const bool mine = (lane >= base) && (lane < base + 8); \
            if (u < 8) w_lo = mine ? wv : w_lo; else w_hi = mine ? wv : w_hi; }
#pragma unroll 1
            for (int u2 = 0; u2 < 14; u2 += 2) { U14_STEP(u2, qa, qb, e_lo, e_hi) U14_STEP(u2 + 1, qb, qa, e_lo, e_hi) }
            U14_STEP(14, qa, qb, e_lo, e_hi)
            U14_STEP(15, qb, qa, N.elo, N.ehi)
#undef U14_STEP
            nsu_lo = EUS[N.elo]; nsu_hi = EUS[N.ehi]; nsv_lo = EVS[N.elo]; nsv_hi = EVS[N.ehi];
            __builtin_amdgcn_sched_barrier(0);
            WSP(float, WS_GATE)[t * 128 + lane] = w_lo; WSP(float, WS_GATE)[t * 128 + 64 + lane] = w_hi;
        }
    }
}
#ifdef TOPK2
#define P7FN p5b_topk2
#else
#define P7FN p5b_topk
#endif
constexpr int U16_ROWP = 1040, U16_BUF = 8 * U16_ROWP, U16_WAVE = 2 * U16_BUF + 1024;
static_assert(8 * U16_WAVE <= LDS_MAIN, "U16 LDS map");
struct U16A { v2u p[12]; };
__device__ __forceinline__ void u16_rows(v4u* R, int ids, int nb, const unsigned char* EU, unsigned rof) {
#pragma unroll
    for (int j = 0; j < 8; ++j) { const int e = __builtin_amdgcn_readlane(ids, nb + j); R[j] = *(const v4u*)(EU + ((unsigned)e * 768u + rof)); }
}
__device__ __forceinline__ void u16_write(const v4u* R, LAS unsigned char* tb, unsigned l16) {
#pragma unroll
    for (int j = 0; j < 8; ++j) *(LAS v4u*)(tb + j * U16_ROWP + l16) = R[j];
}
__device__ __forceinline__ void u16_read(U16A& A, const LAS unsigned char* tb, int li, int lq) {
    const LAS unsigned char* src = tb + (li & 7) * U16_ROWP + (li >> 3) * 384 + 24 * lq;
#pragma unroll
    for (int c = 0; c < 4; ++c) { A.p[3 * c] = *(const LAS v2u*)(src + 96 * c); A.p[3 * c + 1] = *(const LAS v2u*)(src + 96 * c + 8); A.p[3 * c + 2] = *(const LAS v2u*)(src + 96 * c + 16); }
}
__device__ __forceinline__ f32x4 u16_mma(const U16A& A, const v4u* hb) {
    f32x4 acc = (f32x4){0.f, 0.f, 0.f, 0.f};
#pragma unroll
    for (int c = 0; c < 4; ++c) {
        const i32x8 a = (i32x8){(int)A.p[3 * c][0], (int)A.p[3 * c][1], (int)A.p[3 * c + 1][0], (int)A.p[3 * c + 1][1], (int)A.p[3 * c + 2][0], (int)A.p[3 * c + 2][1], 0, 0};
        const i32x8 bb = (i32x8){(int)hb[2 * c][0], (int)hb[2 * c][1], (int)hb[2 * c][2], (int)hb[2 * c][3], (int)hb[2 * c + 1][0], (int)hb[2 * c + 1][1], (int)hb[2 * c + 1][2], (int)hb[2 * c + 1][3]};
        acc = __builtin_amdgcn_mfma_scale_f32_16x16x128_f8f6f4(a, bb, acc, 2, 0, 0, 0, 0, 0); }
    return acc;
}
__device__ __forceinline__ void p8_peer_up16(Frame& F) {
    const int f_tid = threadIdx.x, lane = f_tid & 63, f_wave = __builtin_amdgcn_readfirstlane(f_tid >> 6);
    const int li = lane & 15, lq = lane >> 4;
    const unsigned char* EU = F.ws + WS_EU; const float* EUS = WSP(float, WS_EUS); const float* EVS = WSP(float, WS_EVS);
    LAS unsigned char* tile = F.lds + f_wave * U16_WAVE; LAS unsigned char* hq = tile + 2 * U16_BUF;
    for (int wq = F.vcu * NWAVES + f_wave; wq < MTOK / 16; wq += F.G * NWAVES) {
        const int b = wq >> 7; const float* mb = WSP(float, WS_MOD) + (size_t)b * 6144;
        unsigned l16 = 16u * (unsigned)lane; asm volatile("" : "+v"(l16));
        const unsigned rof = l16 < 768u ? l16 : l16 - 768u;
        float S2[16];
#pragma unroll
        for (int q = 0; q < 4; ++q) { const f32x4 sh = *(const f32x4*)((const char*)(mb + 3072) + 4u * l16 + 16 * q); S2[4 * q] = sh[0]; S2[4 * q + 1] = sh[1]; S2[4 * q + 2] = sh[2]; S2[4 * q + 3] = sh[3]; }
        const size_t t0 = (size_t)wq * 16;
        U14Meta N; u14_meta_load(N, F.ws, t0, l16);
        float nsu_lo = EUS[N.elo], nsu_hi = EUS[N.ehi], nsv_lo = EVS[N.elo], nsv_hi = EVS[N.ehi];
        v4u r0[8], r1[8];
        U16A A;
        u16_rows(r0, N.elo, 0, EU, rof); u16_rows(r1, N.elo, 8, EU, rof);
        u16_write(r0, tile, l16);
        LDS_WAIT(); asm volatile("" ::: "memory");
        u16_read(A, tile, li, lq);
#pragma unroll 1
        for (int tt = 0; tt < 16; ++tt) {
            const size_t t = t0 + tt;
            const int e_lo = N.elo, e_hi = N.ehi; const float g_lo = N.glo, g_hi = N.ghi, su_lo = nsu_lo, su_hi = nsu_hi, sv_lo = nsv_lo, sv_hi = nsv_hi;
            v4u hb[8]; float hinv;
            u14_h2(N, S2, hq, l16, li, lq, hb, hinv);
            u14_meta_load(N, F.ws, t + (tt < 15 ? 1 : 0), l16);
            float w_lo = 0.f, w_hi = 0.f;
#define U16_STEP(UU, RL, RW, IDS, NB) { \
            const int u = (UU); \
            u16_rows(RL, (IDS), (NB), EU, rof); \
            __builtin_amdgcn_sched_barrier(0); \
            LAS unsigned char* tn = tile + ((u + 1) & 1) * U16_BUF; \
            u16_write(RW, tn, l16); \
            const f32x4 acc = u16_mma(A, hb); \
            LDS_WAIT(); asm volatile("" ::: "memory"); \
            u16_read(A, tn, li, lq); \
            const int base = (u & 7) * 8; const int r = (li >> 1) & 3; \
            const float sel = r == 0 ? acc[0] : (r == 1 ? acc[1] : (r == 2 ? acc[2] : acc[3])); \
            const int sl = ((lane & 7) >> 2) * 16 + 2 * (lane & 3);                          \
            const float dmine = __shfl(sel, sl) + __shfl(sel, sl + 33); \
            const float gsel = u < 8 ? g_lo : g_hi, susel = u < 8 ? su_lo : su_hi, svsel = u < 8 ? sv_lo : sv_hi; \
            const float wv = gsel * gelu_erf(dmine * susel * hinv) * svsel; \
            const bool mine = (lane >= base) && (lane < base + 8); \
            if (u < 8) w_lo = mine ? wv : w_lo; else w_hi = mine ? wv : w_hi; }
#pragma unroll 1
            for (int u2 = 0; u2 < 14; u2 += 2) { const int ua = u2 + 2, ub = u2 + 3;
                U16_STEP(u2, r0, r1, ua < 8 ? e_lo : e_hi, (ua & 7) * 8)
                U16_STEP(u2 + 1, r1, r0, ub < 8 ? e_lo : e_hi, (ub & 7) * 8) }
            U16_STEP(14, r0, r1, N.elo, 0)
            U16_STEP(15, r1, r0, N.elo, 8)
#undef U16_STEP
            nsu_lo = EUS[N.elo]; nsu_hi = EUS[N.ehi]; nsv_lo = EVS[N.elo]; nsv_hi = EVS[N.ehi];
            __builtin_amdgcn_sched_barrier(0);
            WSP(float, WS_GATE)[t * 128 + lane] = w_lo; WSP(float, WS_GATE)[t * 128 + 64 + lane] = w_hi;
        }
    }
}
typedef int i32x8 __attribute__((ext_vector_type(8)));
struct U15Meta { int elo, ehi; float glo, ghi; v4u xa, xb; float rst; };
__device__ __forceinline__ void u15_meta_load(U15Meta& M, const unsigned char* ws, size_t t, unsigned l16) {
    const unsigned l = l16 >> 4; const int* ep = (const int*)(ws + WS_EID) + t * 128; const float* gp = (const float*)(ws + WS_GATE) + t * 128;
    M.elo = ep[l]; M.ehi = ep[64 + l]; M.glo = gp[l]; M.ghi = gp[64 + l];
    const char* xs = (const char*)(ws + WS_X1S) + t * 2048 + 2u * l16; M.xa = *(const v4u*)xs; M.xb = *(const v4u*)(xs + 16);
    M.rst = ((const float*)(ws + WS_ROWSTAT))[t];
}
__device__ __forceinline__ void u15_h2(const U15Meta& M, const float* S2, LAS unsigned char* hq, unsigned l16, int li, int lq, v4u* hb, float& hinv) {
    float h2[16]; unpack8(M.xa, h2); unpack8(M.xb, h2 + 8); float mx = 0.f;
    const float rs = rsqrt_f(M.rst * (1.0f / 1024.0f) + EPSF);
#pragma unroll
    for (int i = 0; i < 16; ++i) { h2[i] = h2[i] * rs + S2[i]; mx = fmaxf(mx, fabsf(h2[i])); }
#pragma unroll
    for (int o = 1; o < 64; o <<= 1) mx = fmaxf(mx, __shfl_xor(mx, o));
    mx = fmaxf(mx, 1e-30f); const float hs = 224.0f / mx; hinv = mx * (1.0f / 224.0f);
    v4u w;
#pragma unroll
    for (int qd = 0; qd < 4; ++qd) { int pk = 0; pk = __builtin_amdgcn_cvt_pk_fp8_f32(h2[4 * qd] * hs, h2[4 * qd + 1] * hs, pk, false); pk = __builtin_amdgcn_cvt_pk_fp8_f32(h2[4 * qd + 2] * hs, h2[4 * qd + 3] * hs, pk, true); w[qd] = (unsigned)pk; }
    *(LAS v4u*)(hq + l16) = w;
    LDS_WAIT(); asm volatile("" ::: "memory");
#pragma unroll
    for (int c = 0; c < 4; ++c) { const int o = (li & 1) * 512 + 128 * (lq >> 1) + 32 * c + 16 * (lq & 1); hb[2 * c] = *(const LAS v4u*)(hq + o); hb[2 * c + 1] = *(const LAS v4u*)(hq + o + 256); }
    LDS_WAIT(); asm volatile("" ::: "memory");
}
__device__ __forceinline__ void p8_peer_up15(Frame& F) {
    const int f_tid = threadIdx.x, lane = f_tid & 63, f_wave = __builtin_amdgcn_readfirstlane(f_tid >> 6);
    const int li = lane & 15, lq = lane >> 4;
    const unsigned char* EU = F.ws + WS_EU; const float* EUS = WSP(float, WS_EUS); const float* EVS = WSP(float, WS_EVS);
    LAS unsigned char* hq = F.lds + f_wave * 1024;
    for (int wq = F.vcu * NWAVES + f_wave; wq < MTOK / 16; wq += F.G * NWAVES) {
        const int b = wq >> 7; const float* mb = WSP(float, WS_MOD) + (size_t)b * 6144;
        unsigned l16 = 16u * (unsigned)lane; asm volatile("" : "+v"(l16));
        unsigned qof = 16u * (unsigned)(4 * (li >> 3) + lq); asm volatile("" : "+v"(qof));
        const int rsel = li & 7;
        float S2[16];
#pragma unroll
        for (int q = 0; q < 4; ++q) { const f32x4 sh = *(const f32x4*)((const char*)(mb + 3072) + 4u * l16 + 16 * q); S2[4 * q] = sh[0]; S2[4 * q + 1] = sh[1]; S2[4 * q + 2] = sh[2]; S2[4 * q + 3] = sh[3]; }
        const size_t t0 = (size_t)wq * 16;
        U15Meta N; u15_meta_load(N, F.ws, t0, l16);
        float nsu_lo = EUS[N.elo], nsu_hi = EUS[N.ehi], nsv_lo = EVS[N.elo], nsv_hi = EVS[N.ehi];
        v4u qa[6], qb[6];
        { const int e = __shfl(N.elo, rsel); const unsigned char* rp = EU + ((unsigned)e * 768u + qof);
#pragma unroll
          for (int i = 0; i < 6; ++i) qa[i] = *(const v4u*)(rp + 128 * i); }
#pragma unroll 1
        for (int tt = 0; tt < 16; ++tt) {
            const size_t t = t0 + tt;
            const int e_lo = N.elo, e_hi = N.ehi; const float g_lo = N.glo, g_hi = N.ghi, su_lo = nsu_lo, su_hi = nsu_hi, sv_lo = nsv_lo, sv_hi = nsv_hi;
            v4u hb[8]; float hinv;
            u15_h2(N, S2, hq, l16, li, lq, hb, hinv);
            u15_meta_load(N, F.ws, t + (tt < 15 ? 1 : 0), l16);
            float w_lo = 0.f, w_hi = 0.f;
#define U15_STEP(UU, CUR, NXT, NLO, NHI) { \
            const int u = (UU); const int un = (u + 1) & 15; const int nb = (un & 7) * 8; const int ensel = un < 8 ? (NLO) : (NHI); \
            { const int e = __shfl(ensel, nb + rsel); const unsigned char* rp = EU + ((unsigned)e * 768u + qof); \
              _Pragma("unroll") for (int i = 0; i < 6; ++i) NXT[i] = *(const v4u*)(rp + 128 * i); } \
            __builtin_amdgcn_sched_barrier(0); \
            f32x4 acc = (f32x4){0.f, 0.f, 0.f, 0.f}; \
            { const i32x8 B0 = (i32x8){(int)hb[0][0], (int)hb[0][1], (int)hb[0][2], (int)hb[0][3], (int)hb[1][0], (int)hb[1][1], (int)hb[1][2], (int)hb[1][3]}; \
              const i32x8 B1 = (i32x8){(int)hb[2][0], (int)hb[2][1], (int)hb[2][2], (int)hb[2][3], (int)hb[3][0], (int)hb[3][1], (int)hb[3][2], (int)hb[3][3]}; \
              const i32x8 B2 = (i32x8){(int)hb[4][0], (int)hb[4][1], (int)hb[4][2], (int)hb[4][3], (int)hb[5][0], (int)hb[5][1], (int)hb[5][2], (int)hb[5][3]}; \
              const i32x8 B3 = (i32x8){(int)hb[6][0], (int)hb[6][1], (int)hb[6][2], (int)hb[6][3], (int)hb[7][0], (int)hb[7][1], (int)hb[7][2], (int)hb[7][3]}; \
              const i32x8 A0 = (i32x8){(int)CUR[0][0], (int)CUR[0][1], (int)CUR[0][2], (int)CUR[0][3], (int)CUR[1][0], (int)CUR[1][1], 0, 0}; \
              const i32x8 A1 = (i32x8){(int)CUR[1][2], (int)CUR[1][3], (int)CUR[2][0], (int)CUR[2][1], (int)CUR[2][2], (int)CUR[2][3], 0, 0}; \
              const i32x8 A2 = (i32x8){(int)CUR[3][0], (int)CUR[3][1], (int)CUR[3][2], (int)CUR[3][3], (int)CUR[4][0], (int)CUR[4][1], 0, 0}; \
              const i32x8 A3 = (i32x8){(int)CUR[4][2], (int)CUR[4][3], (int)CUR[5][0], (int)CUR[5][1], (int)CUR[5][2], (int)CUR[5][3], 0, 0}; \
              acc = __builtin_amdgcn_mfma_scale_f32_16x16x128_f8f6f4(A0, B0, acc, 2, 0, 0, 0, 0, 0);        \
              acc = __builtin_amdgcn_mfma_scale_f32_16x16x128_f8f6f4(A1, B1, acc, 2, 0, 0, 0, 0, 0); \
              acc = __builtin_amdgcn_mfma_scale_f32_16x16x128_f8f6f4(A2, B2, acc, 2, 0, 0, 0, 0, 0); \
              acc = __builtin_amdgcn_mfma_scale_f32_16x16x128_f8f6f4(A3, B3, acc, 2, 0, 0, 0, 0, 0); } \
            const int base = (u & 7) * 8; const int r = (li >> 1) & 3; \
            const float sel = r == 0 ? acc[0] : (r == 1 ? acc[1] : (r == 2 ? acc[2] : acc[3])); \
            const int sl = ((lane & 7) >> 2) * 16 + 2 * (lane & 3);                          \
            const float dmine = __shfl(sel, sl) + __shfl(sel, sl + 33); \
            const float gsel = u < 8 ? g_lo : g_hi, susel = u < 8 ? su_lo : su_hi, svsel = u < 8 ? sv_lo : sv_hi; \
            const float wv = gsel * gelu_erf(dmine * susel * hinv) * svsel; \
            const bool mine = (lane >= base) && (lane < base + 8); \
            if (u < 8) w_lo = mine ? wv : w_lo; else w_hi = mine ? wv : w_hi; }
#pragma unroll 1
            for (int u2 = 0; u2 < 14; u2 += 2) { U15_STEP(u2, qa, qb, e_lo, e_hi) U15_STEP(u2 + 1, qb, qa, e_lo, e_hi) }
            U15_STEP(14, qa, qb, e_lo, e_hi)
            U15_STEP(15, qb, qa, N.elo, N.ehi)
#undef U15_STEP
            nsu_lo = EUS[N.elo]; nsu_hi = EUS[N.ehi]; nsv_lo = EVS[N.elo]; nsv_hi = EVS[N.ehi];
            __builtin_amdgcn_sched_barrier(0);
            WSP(float, WS_GATE)[t * 128 + lane] = w_lo; WSP(float, WS_GATE)[t * 128 + 64 + lane] = w_hi;
        }
    }
}
#ifdef TOPK2
#define P7FN p5b_topk2
#else
#define P7FN p5b_topk
#endif
constexpr int NPHASE = 10;
__global__ void __launch_bounds__(NTHR, 2) fwd_mega(Args args) {
    extern __shared__ __attribute__((aligned(16))) unsigned char lds[];
    Frame F;
    F.lds = (LAS unsigned char*)lds;
    F.MISC = (volatile LAS unsigned*)(F.lds + MISC_OFF);
    F.G = gridDim.x; { const int bx = blockIdx.x; F.vcu = (F.G % 8 == 0) ? (bx % 8) * (F.G / 8) + bx / 8 : bx; }
    F.ws = args.ws; F.out = args.out;
    F.a = &args;
    for (int u = threadIdx.x; u < 32; u += NTHR) F.MISC[u] = 0u;
    __syncthreads();
    const int lo = args.ph_lo, hi = args.ph_hi;
#ifdef PROBE_PHASE_T
    unsigned long long pt0 = 0ull;
#endif
    const bool use_bar = (hi - lo) > 1;
    XcdBarrier bar; bar.bar = (unsigned*)(F.ws + WS_CTL); bar.x = 0; bar.st = nullptr;
    if (use_bar) bar = xcd_barrier_post((unsigned*)(F.ws + WS_CTL), F.MISC + 8);
#define IN(k) (lo <= (k) && (k) < hi)
#ifdef PROBE_PHASE_T
#define SEAM(k) do { if (IN(k) && IN((k) + 1)) xcd_barrier(bar); if ((k) + 1 == PROBE_PHASE_T) pt0 = __builtin_amdgcn_s_memrealtime(); if ((k) == PROBE_PHASE_T && blockIdx.x == 0 && threadIdx.x == 0) *(volatile float*)(F.ws + WS_CTL + 40000) = (float)(__builtin_amdgcn_s_memrealtime() - pt0) * 0.01f; } while (0)
#else
#define SEAM(k) do { if (IN(k) && IN((k) + 1)) xcd_barrier(bar); } while (0)
#endif
#ifndef REP_PHASE
#define REP_PHASE -1
#endif
#define REPEAT(k, body) do { if (REP_PHASE == (k)) { xcd_barrier(bar); body; } } while (0)
    if (IN(0)) {
#ifndef SKIP_P0
 p0_phase(F); REPEAT(0, p0_phase(F));
#endif
 } SEAM(0);
    if (IN(1)) {
#ifndef SKIP_P1
 p1_phase(F); REPEAT(1, p1_phase(F));
#endif
 } SEAM(1);
    if (IN(2)) {
        pg8::Gemm g{WSP(bf16, WS_H1), WSP(bf16, WS_WINT), MTOK, NPROJ, 1024}; pg8::StaticOrder S; S.init(MTOK, NPROJ, F.G, (int)blockIdx.x);
        pg8::EpiProj E{WSP(bf16, WS_PROJ), NPROJ};
        pg8::gemm_phase<pg8::EpiProj, pg8::StaticOrder, true, true>(F.lds, g, S, E);
        REPEAT(2, (pg8::gemm_phase<pg8::EpiProj, pg8::StaticOrder, true, true>(F.lds, g, S, E)));
    } SEAM(2);
    if (IN(3)) {
#ifndef SKIP_SSD
 p3pre_conv(F); xcd_barrier(bar); p3_ssd3(F); REPEAT(30, p3_ssd3(F)); REPEAT(32, p3pre_conv(F));
#endif
#ifndef SKIP_S5
 p3_s5v2(F); REPEAT(31, p3_s5v2(F));
#endif
 } SEAM(3);
    if (IN(5)) {
        pg8::Gemm g{WSP(bf16, WS_Y), WSP(bf16, WS_WOUTT), MTOK, 1024, 2048}; pg8::StaticOrder S; S.init(MTOK, 1024, F.G, (int)blockIdx.x);
        PG8_LAS float* tab = (PG8_LAS float*)(F.lds + pg8::STAGE_BYTES);
        { pg8::Unit u; for (int i = 0; S.next(i, u); ++i) pg8::SegScaleHook::build(F.lds + pg8::STAGE_BYTES, u, WSP(float, WS_STSSD), WSP(float, WS_STS5), (int)threadIdx.x); }
        __syncthreads();
        pg8::EpiX1 E{(F.a->in[0]), F.out, WSP(bf16, WS_X1S), WSP(float, WS_MOD), (F.a->in[24]), WSP(float, WS_ROWSTAT), tab};
        pg8::SegScaleHook H;
        pg8::gemm_phase<pg8::EpiX1, pg8::StaticOrder, true, true, pg8::SegScaleHook>(F.lds, g, S, E, H);
    } SEAM(5);
    if (IN(6)) {
        pg8::Gemm g{WSP(bf16, WS_X1S), WSP(bf16, WS_WQKT), MTOK, 2048, 1024}; pg8::StaticOrder S; S.init(MTOK, 2048, F.G, (int)blockIdx.x);
        pg8::EpiScores E{WSP(_Float16, WS_SCORES), WSP(float, WS_SB), WSP(float, WS_ROWSTAT)};
        pg8::gemm_phase<pg8::EpiScores, pg8::StaticOrder, true, true>(F.lds, g, S, E);
        REPEAT(6, (pg8::gemm_phase<pg8::EpiScores, pg8::StaticOrder, true, true>(F.lds, g, S, E)));
    } SEAM(6);
    if (IN(7)) {
#ifndef SKIP_TOPK
 P7FN(F); REPEAT(7, P7FN(F));
#endif
 } SEAM(7);
#ifdef UP16
    if (IN(8)) { p8_peer_up16(F); REPEAT(8, { P7FN(F); xcd_barrier(bar); p8_peer_up16(F); }); } SEAM(8);
#elif defined(UP15)
    if (IN(8)) { p8_peer_up15(F); REPEAT(8, { P7FN(F); xcd_barrier(bar); p8_peer_up15(F); }); } SEAM(8);
#elif defined(UP14)
    if (IN(8)) { p8_peer_up14(F); REPEAT(8, { P7FN(F); xcd_barrier(bar); p8_peer_up14(F); }); } SEAM(8);
#elif defined(UP12)
    if (IN(8)) { p8_peer_up12(F); REPEAT(8, { P7FN(F); xcd_barrier(bar); p8_peer_up12(F); }); } SEAM(8);
#elif defined(UP11)
    if (IN(8)) { p8_peer_up11(F); REPEAT(8, { P7FN(F); xcd_barrier(bar); p8_peer_up11(F); }); } SEAM(8);
#elif defined(UP10)
    if (IN(8)) { p8_peer_up10(F); } SEAM(8);
#else
    if (IN(8)) { p8_peer_up6(F); REPEAT(8, { P7FN(F); xcd_barrier(bar); p8_peer_up6(F); }); } SEAM(8);
#endif
#ifdef V6
    if (IN(9)) { p9_peer_down3(F); }
#else
    if (IN(9)) { p9_peer_down2(F); }
#endif
#ifdef PROBE_OUT
#if defined(PROBE_PHASE_T) && PROBE_PHASE_T == 9
    if (blockIdx.x == 0 && threadIdx.x == 0) *(volatile float*)(F.ws + WS_CTL + 40000) = (float)(__builtin_amdgcn_s_memrealtime() - pt0) * 0.01f;
#endif
    if (IN(9)) { __syncthreads(); if (blockIdx.x == 0 && threadIdx.x == 0) { asm volatile("s_waitcnt vmcnt(0)" ::: "memory"); F.out[0] = *(volatile float*)(F.ws + WS_CTL + 40000); } }
#endif
#undef IN
#undef SEAM
}

#ifndef N_LAUNCHES
#define N_LAUNCHES 1
#endif
extern "C" void kernel_launch(void* const* d_in, const int* in_sizes, int n_in, void* d_out, int out_size, void* d_ws, size_t ws_size, hipStream_t stream) {
    static int grid = 0;
    if (grid == 0) {
        if (n_in != 30 || in_sizes[0] != MTOK * DM || out_size != MTOK * DM || ws_size < WS_END) { fprintf(stderr, "kernel_launch: unexpected shapes (n_in %d, in0 %d, out %d, ws %zu)\n", n_in, n_in > 0 ? in_sizes[0] : -1, out_size, ws_size); grid = -1; return; }
        int dev = 0, cus = 0, per_cu = 0;
        if (hipGetDevice(&dev) != hipSuccess || hipDeviceGetAttribute(&cus, hipDeviceAttributeMultiprocessorCount, dev) != hipSuccess) { grid = -1; return; }
        if (hipFuncSetAttribute((const void*)fwd_mega, hipFuncAttributeMaxDynamicSharedMemorySize, LDS_BYTES) != hipSuccess) { fprintf(stderr, "kernel_launch: hipFuncSetAttribute failed\n"); grid = -1; return; }
        if (hipOccupancyMaxActiveBlocksPerMultiprocessor(&per_cu, (const void*)fwd_mega, NTHR, LDS_BYTES) != hipSuccess || per_cu < 1) { fprintf(stderr, "kernel_launch: occupancy query says %d\n", per_cu); (void)hipGetLastError(); grid = -1; return; }
        if (cus != 256) { fprintf(stderr, "kernel_launch: built for a 256-CU device (got %d CUs); nothing launched\n", cus); grid = -1; return; }
        grid = cus;
    }
    if (grid < 0) return;
    (void)hipMemsetAsync((char*)d_ws + WS_CTL, 0, CTL_ZERO_BYTES, stream);
    Args a{};
    for (int i = 0; i < 30; ++i) a.in[i] = (const float*)d_in[i];
    a.out = (float*)d_out; a.ws = (unsigned char*)d_ws;
    if (N_LAUNCHES == 1) {
        a.ph_lo = 0; a.ph_hi = NPHASE;
        void* kargs[] = {&a};
#ifdef PLAIN_LAUNCH
        (void)kargs; hipLaunchKernelGGL(fwd_mega, dim3(grid), dim3(NTHR), LDS_BYTES, stream, a);
#else
        hipError_t e = hipLaunchCooperativeKernel((const void*)fwd_mega, dim3(grid), dim3(NTHR), kargs, LDS_BYTES, stream);
        if (e != hipSuccess) fprintf(stderr, "kernel_launch: cooperative launch failed: %s (grid %d)\n", hipGetErrorString(e), grid);
#endif
    } else {
        for (int p = 0; p < NPHASE; ++p) { a.ph_lo = p; a.ph_hi = p + 1; hipLaunchKernelGGL(fwd_mega, dim3(grid), dim3(NTHR), LDS_BYTES, stream, a); }
    }
}
```

```cpp
#define V6
#define UP14
#define HWENC
#define DN3B
#include <hip/hip_runtime.h>
#include <cstdio>
#include <cstdint>
namespace pg8 {
#define PG8_LAS __attribute__((address_space(3)))
typedef unsigned short bf16_t;
typedef short bf16x8 __attribute__((ext_vector_type(8)));
typedef float f32x4 __attribute__((ext_vector_type(4)));
typedef unsigned u32x4 __attribute__((ext_vector_type(4)));
constexpr int BM = 256, BK = 64, HALF = 128, HTB = HALF * BK * 2  , STAGE_BYTES = 8 * HTB, NXCD = 8, WGM = 8;

__host__ __device__ __forceinline__ int lds_byte(int r, int c) { const int st = (r >> 4) * 2 + (c >> 5), rr = r & 15, cc = c & 31, ob = rr * 64 + cc * 2; return st * 1024 + (ob ^ (((ob >> 9) & 1) << 5)); }
__host__ __device__ __forceinline__ void stage_rc(int b, int& R, int& C) { const int st = b / 1024, sb = b % 1024, swz = sb ^ (((sb >> 9) & 1) << 5); R = (st >> 1) * 16 + swz / 64; C = (st & 1) * 32 + (swz % 64) / 2; }
__host__ __device__ __forceinline__ int perm32(int rho) { const int n = rho >> 4, i = rho & 15; return 8 * (i >> 2) + 4 * n + (i & 3); }

struct Unit { int pm, pn; };
struct Gemm { const bf16_t* A; const bf16_t* Bt; int M, N, K; };

struct StaticOrder {
    int nM, nN, nwg, G, c;
    __host__ __device__ void init(int M, int N, int G_, int c_) { nM = M / BM; nN = N / BM; nwg = nM * nN; G = G_; c = c_; }
    __host__ __device__ bool next(int i, Unit& u) const {
        const long L = (long)i * G + c; if (L >= nwg) return false;
        int wgid = (int)L; { const int q = nwg / NXCD, r = nwg % NXCD, xcd = wgid % NXCD, off = wgid / NXCD; wgid = (xcd < r ? xcd * (q + 1) : r * (q + 1) + (xcd - r) * q) + off; }
        const int nig = WGM * nN, gid = wgid / nig, fm = gid * WGM, gsz = (nM - fm) < WGM ? (nM - fm) : WGM;
        u.pm = fm + ((wgid % nig) % gsz); u.pn = (wgid % nig) / gsz; return true;
    }
    __device__ __forceinline__ void a_ready(const Unit&) const {}
    __device__ __forceinline__ void done(const Unit&) const {}
};

__device__ __forceinline__ unsigned cvt_pk_bf16(float lo, float hi) { unsigned r; asm volatile("v_cvt_pk_bf16_f32 %0, %1, %2" : "=v"(r) : "v"(lo), "v"(hi)); return r; }
typedef float f32x2 __attribute__((ext_vector_type(2)));
struct NoHook { __device__ __forceinline__ void at_tile(int, const Unit&, f32x4 (&)[2][2][4][2], PG8_LAS unsigned char*, int, int) const {} };
template <class Epi, class Sched, bool ALIGN_EPI = false, bool SP2 = false, class Hook = NoHook>
__device__ __forceinline__ void gemm_phase(PG8_LAS unsigned char* lds, const Gemm g, const Sched& S, const Epi& E, const Hook& H = Hook()) {
    const int tid = threadIdx.x, wid = __builtin_amdgcn_readfirstlane(tid >> 6), lane = tid & 63, wr = wid >> 2, wc = wid & 3, fr = lane & 15, fq = lane >> 4;
    const int K = g.K, nt = K / BK;
    unsigned voffA[2], voffB[2];
#pragma unroll
    for (int i = 0; i < 2; ++i) { int R, C; stage_rc(tid * 16 + i * 8192, R, C); const int Rb = Epi::PERM ? ((R & ~31) + perm32(R & 31)) : R;
        voffA[i] = (unsigned)(R * K + C) * 2u; voffB[i] = (unsigned)(Rb * K + C) * 2u; }
    const size_t kstep = (size_t)(BK * 2);
    const size_t hstep = (size_t)HALF * K * 2;
    const size_t tstep = 2 * hstep;
    const unsigned ldsw = (unsigned)wid * 1024u;
    const int aoff = lds_byte(wr * 64 + fr, fq * 8), boff = lds_byte(wc * 32 + fr, fq * 8);
#define PG8_SA(b, h) (((b) * 2 + (h)) * HTB)
#define PG8_SB(b, h) ((4 + (b) * 2 + (h)) * HTB)
#define PG8_STAGE(bufoff, gbase, voff) do { _Pragma("unroll") for (int _i = 0; _i < 2; ++_i) \
        __builtin_amdgcn_global_load_lds((const unsigned*)((const char*)(gbase) + (voff)[_i]), (PG8_LAS unsigned*)(lds + (bufoff) + ldsw + _i * 8192), 16, 0, 0); } while (0)
#define PG8_LDA(dst, b, h) do { _Pragma("unroll") for (int m = 0; m < 4; ++m) _Pragma("unroll") for (int k = 0; k < 2; ++k) dst[m][k] = *(const PG8_LAS bf16x8*)(lds + PG8_SA(b, h) + aoff + m * 2048 + k * 1024); } while (0)
#define PG8_LDB(dst, b, h) do { _Pragma("unroll") for (int n = 0; n < 2; ++n) _Pragma("unroll") for (int k = 0; k < 2; ++k) dst[n][k] = *(const PG8_LAS bf16x8*)(lds + PG8_SB(b, h) + boff + n * 2048 + k * 1024); } while (0)
#define PG8_MMA(ai, bj, At, Bt) do { __builtin_amdgcn_s_setprio(1); _Pragma("unroll") for (int m = 0; m < 4; ++m) _Pragma("unroll") for (int n = 0; n < 2; ++n) _Pragma("unroll") for (int k = 0; k < 2; ++k) \
        acc[ai][bj][m][n] = __builtin_amdgcn_mfma_f32_16x16x32_bf16(Bt[n][k], At[m][k], acc[ai][bj][m][n], 0, 0, 0); __builtin_amdgcn_s_setprio(0); } while (0)
#define PG8_WAIT_V(n) asm volatile("s_waitcnt vmcnt(" #n ")" ::: "memory")
#define PG8_WAIT_L(n) asm volatile("s_waitcnt lgkmcnt(" #n ")" ::: "memory")
#define PG8_BAR __builtin_amdgcn_s_barrier()
#define PG8_SCHED __builtin_amdgcn_sched_barrier(0)
    Unit cur, nxt; int ui = 0;
    if (!S.next(0, cur)) return;
    f32x4 acc[2][2][4][2];
#pragma unroll
    for (int a = 0; a < 2; ++a)
#pragma unroll
        for (int b = 0; b < 2; ++b)
#pragma unroll
            for (int m = 0; m < 4; ++m)
#pragma unroll
                for (int n = 0; n < 2; ++n) acc[a][b][m][n] = (f32x4){0.f, 0.f, 0.f, 0.f};
    bf16x8 At[4][2], B0[2][2], B1[2][2];
    const char* cA = (const char*)g.A + (size_t)cur.pm * tstep; const char* cB = (const char*)g.Bt + (size_t)cur.pn * tstep;
    S.a_ready(cur);
    if constexpr (SP2) {
        PG8_STAGE(PG8_SB(0, 0), cB, voffB); PG8_STAGE(PG8_SB(0, 1), cB + hstep, voffB); PG8_STAGE(PG8_SA(0, 0), cA, voffA); PG8_STAGE(PG8_SA(0, 1), cA + hstep, voffA);
        if (wr == 1) PG8_BAR;
        PG8_WAIT_V(2); PG8_BAR;
        PG8_STAGE(PG8_SB(1, 0), cB + kstep, voffB); PG8_STAGE(PG8_SA(1, 0), cA + kstep, voffA); PG8_STAGE(PG8_SB(1, 1), cB + hstep + kstep, voffB);
        PG8_WAIT_V(6); PG8_BAR;
    } else {
        PG8_STAGE(PG8_SB(0, 0), cB, voffB); PG8_STAGE(PG8_SA(0, 0), cA, voffA); PG8_STAGE(PG8_SB(0, 1), cB + hstep, voffB); PG8_STAGE(PG8_SA(0, 1), cA + hstep, voffA);
        if (wr == 1) PG8_BAR;
        PG8_WAIT_V(4); PG8_BAR;
        PG8_STAGE(PG8_SB(1, 0), cB + kstep, voffB); PG8_STAGE(PG8_SA(1, 0), cA + kstep, voffA); PG8_STAGE(PG8_SB(1, 1), cB + hstep + kstep, voffB);
        PG8_WAIT_V(6); PG8_BAR;
    }
    for (;;) {
        const bool has_next = S.next(ui + 1, nxt);
        const char* nA = has_next ? (const char*)g.A + (size_t)nxt.pm * tstep : cA; const char* nB = has_next ? (const char*)g.Bt + (size_t)nxt.pn * tstep : cB;
        for (int t = 0; t < nt; t += 2) {
            const bool last = (t == nt - 2);
            H.at_tile(t, cur, acc, lds + STAGE_BYTES, wr, fr);
            const char* a1 = cA + (size_t)(t + 1) * kstep;
            const char* a2 = last ? nA : cA + (size_t)(t + 2) * kstep; const char* b2 = last ? nB : cB + (size_t)(t + 2) * kstep;
            const char* a3 = a2 + kstep; const char* b3 = b2 + kstep;
            if (last && has_next) S.a_ready(nxt);
            if constexpr (SP2) {
            PG8_LDB(B0, 0, 0); PG8_LDB(B1, 0, 1); PG8_SCHED; PG8_LDA(At, 0, 0); PG8_STAGE(PG8_SA(1, 1), a1 + hstep, voffA);
            PG8_WAIT_V(8); PG8_WAIT_L(0); PG8_BAR; PG8_MMA(0, 0, At, B0); PG8_MMA(0, 1, At, B1); PG8_BAR; PG8_SCHED;
            PG8_LDA(At, 0, 1); PG8_STAGE(PG8_SB(0, 0), b2, voffB); PG8_STAGE(PG8_SB(0, 1), b2 + hstep, voffB); PG8_STAGE(PG8_SA(0, 0), a2, voffA);
            PG8_WAIT_V(8); PG8_WAIT_L(0); PG8_BAR; PG8_MMA(1, 0, At, B0); PG8_MMA(1, 1, At, B1); PG8_BAR; PG8_SCHED;
            PG8_LDB(B0, 1, 0); PG8_LDB(B1, 1, 1); PG8_SCHED; PG8_LDA(At, 1, 0); PG8_STAGE(PG8_SA(0, 1), a2 + hstep, voffA);
            PG8_WAIT_V(8); PG8_WAIT_L(0); PG8_BAR; PG8_MMA(0, 0, At, B0); PG8_MMA(0, 1, At, B1); PG8_BAR; PG8_SCHED;
            PG8_LDA(At, 1, 1); PG8_STAGE(PG8_SB(1, 0), b3, voffB); PG8_STAGE(PG8_SB(1, 1), b3 + hstep, voffB); PG8_STAGE(PG8_SA(1, 0), a3, voffA);
            PG8_WAIT_V(8); PG8_WAIT_L(0); PG8_BAR; PG8_MMA(1, 0, At, B0); PG8_MMA(1, 1, At, B1); PG8_BAR; PG8_SCHED;
            } else {
            PG8_LDB(B0, 0, 0); PG8_SCHED; PG8_LDA(At, 0, 0); PG8_STAGE(PG8_SA(1, 1), a1 + hstep, voffA);
            PG8_WAIT_L(8); PG8_BAR; PG8_WAIT_L(0); PG8_MMA(0, 0, At, B0); PG8_BAR; PG8_SCHED;
            PG8_LDB(B1, 0, 1); PG8_STAGE(PG8_SB(0, 0), b2, voffB);
            PG8_BAR; PG8_WAIT_L(0); PG8_MMA(0, 1, At, B1); PG8_BAR;
            PG8_LDA(At, 0, 1); PG8_STAGE(PG8_SA(0, 0), a2, voffA);
            PG8_BAR; PG8_WAIT_L(0); PG8_MMA(1, 0, At, B0); PG8_BAR; PG8_SCHED;
            PG8_STAGE(PG8_SB(0, 1), b2 + hstep, voffB);
            PG8_WAIT_V(6); PG8_BAR; PG8_MMA(1, 1, At, B1); PG8_BAR;
            PG8_LDB(B0, 1, 0); PG8_SCHED; PG8_LDA(At, 1, 0); PG8_STAGE(PG8_SA(0, 1), a2 + hstep, voffA);
            PG8_WAIT_L(8); PG8_BAR; PG8_WAIT_L(0); PG8_MMA(0, 0, At, B0); PG8_BAR; PG8_SCHED;
            PG8_LDB(B1, 1, 1); PG8_STAGE(PG8_SB(1, 0), b3, voffB);
            PG8_BAR; PG8_WAIT_L(0); PG8_MMA(0, 1, At, B1); PG8_BAR;
            PG8_LDA(At, 1, 1); PG8_STAGE(PG8_SA(1, 0), a3, voffA);
            PG8_BAR; PG8_WAIT_L(0); PG8_MMA(1, 0, At, B0); PG8_BAR; PG8_SCHED;
            PG8_STAGE(PG8_SB(1, 1), b3 + hstep, voffB);
            PG8_WAIT_V(6); PG8_BAR; PG8_MMA(1, 1, At, B1); PG8_BAR;
            }
        }
        if constexpr (ALIGN_EPI) { if (wr == 0) PG8_BAR; }
        if constexpr (!Epi::AFTER_DRAIN) { E(acc, cur, wr, wc, fr, fq);
#ifdef PROBE_EPI2
            if constexpr (Epi::PROBE_TWICE) { asm volatile("" ::: "memory"); E(acc, cur, wr, wc, fr, fq); }
#endif
            S.done(cur); }
        if (!has_next) break;
#pragma unroll
        for (int a = 0; a < 2; ++a)
#pragma unroll
            for (int b = 0; b < 2; ++b)
#pragma unroll
                for (int m = 0; m < 4; ++m)
#pragma unroll
                    for (int n = 0; n < 2; ++n) acc[a][b][m][n] = (f32x4){0.f, 0.f, 0.f, 0.f};
        cur = nxt; cA = nA; cB = nB; ++ui;
        if constexpr (ALIGN_EPI) { if (wr == 1) PG8_BAR; }
    }
    PG8_WAIT_V(0);
    if constexpr (!ALIGN_EPI) { if (wr == 0) PG8_BAR; }
    PG8_BAR;
    if constexpr (Epi::AFTER_DRAIN) { E.fused(acc, cur, wr, wc, fr, fq, lds, wid, lane); S.done(cur); }
#undef PG8_SA
#undef PG8_SB
#undef PG8_STAGE
#undef PG8_LDA
#undef PG8_LDB
#undef PG8_MMA
#undef PG8_WAIT_V
#undef PG8_WAIT_L
#undef PG8_BAR
#undef PG8_SCHED
}
}
namespace pg8 {
struct EpiProj {
    static constexpr bool PERM = true, AFTER_DRAIN = false, PROBE_TWICE = true;
    bf16_t* O; int ldc;
    __device__ __forceinline__ void operator()(const f32x4 (&acc)[2][2][4][2], const Unit& u, int wr, int wc, int fr, int fq) const {
        const int row0 = u.pm * BM + wr * 64 + fr; const int col0 = u.pn * BM + wc * 32 + 8 * fq;
#pragma unroll
        for (int ai = 0; ai < 2; ++ai)
#pragma unroll
            for (int m = 0; m < 4; ++m) { bf16_t* rowp = O + (size_t)(row0 + ai * HALF + m * 16) * ldc + col0;
#pragma unroll
                for (int bj = 0; bj < 2; ++bj) { const f32x4 v0 = acc[ai][bj][m][0], v1 = acc[ai][bj][m][1];
                    u32x4 w; w.x = cvt_pk_bf16(v0[0], v0[1]); w.y = cvt_pk_bf16(v0[2], v0[3]); w.z = cvt_pk_bf16(v1[0], v1[1]); w.w = cvt_pk_bf16(v1[2], v1[3]);
                    __builtin_nontemporal_store(w, (u32x4*)(rowp + bj * HALF)); } }
    }
};
struct EpiX1 {
    static constexpr bool PERM = true, AFTER_DRAIN = false, PROBE_TWICE = false;
    const float* x; float* x1; bf16_t* x1s; const float* mod; const float* norm2_g; float* rowstat; PG8_LAS float* tab;
    __device__ __forceinline__ void operator()(const f32x4 (&acc)[2][2][4][2], const Unit& u, int wr, int wc, int fr, int fq) const {
        const int row0 = u.pm * BM + wr * 64 + fr; const int col0 = u.pn * BM + wc * 32 + 8 * fq; const int b = (u.pm * BM) >> 11;
        const float* mb = mod + (size_t)b * 6144;
        f32x4 g1[2][2], g2[2][2];
#pragma unroll
        for (int bj = 0; bj < 2; ++bj)
#pragma unroll
            for (int n = 0; n < 2; ++n) { const int c = col0 + bj * HALF + 4 * n; g1[bj][n] = *(const f32x4*)(mb + 2048 + c);
                const f32x4 sc = *(const f32x4*)(mb + 4096 + c), ng = *(const f32x4*)(norm2_g + c); g2[bj][n] = ng * (sc + 1.0f); }
#pragma unroll
        for (int ai = 0; ai < 2; ++ai)
#pragma unroll
            for (int m = 0; m < 4; ++m) { const size_t row = (size_t)(row0 + ai * HALF + m * 16); const size_t off = row * 1024 + col0; float ss = 0.f;
                const float rfin = tab[((u.pm >> 3) & 1) * 1280 + 1024 + ai * HALF + wr * 64 + m * 16 + fr];
#pragma unroll
                for (int bj = 0; bj < 2; ++bj) {
                    const f32x4 xa = *(const f32x4*)(x + off + bj * HALF), xb = *(const f32x4*)(x + off + bj * HALF + 4);
                    const f32x4 v0 = xa + g1[bj][0] * (acc[ai][bj][m][0] * rfin), v1 = xb + g1[bj][1] * (acc[ai][bj][m][1] * rfin);
                    *(f32x4*)(x1 + off + bj * HALF) = v0; *(f32x4*)(x1 + off + bj * HALF + 4) = v1;
                    ss += (v0[0] * v0[0] + v0[1] * v0[1]) + (v0[2] * v0[2] + v0[3] * v0[3]) + (v1[0] * v1[0] + v1[1] * v1[1]) + (v1[2] * v1[2] + v1[3] * v1[3]);
                    const f32x4 s0 = v0 * g2[bj][0], s1 = v1 * g2[bj][1];
                    u32x4 w; w.x = cvt_pk_bf16(s0[0], s0[1]); w.y = cvt_pk_bf16(s0[2], s0[3]); w.z = cvt_pk_bf16(s1[0], s1[1]); w.w = cvt_pk_bf16(s1[2], s1[3]);
                    *(u32x4*)(x1s + off + bj * HALF) = w; }
                ss += __shfl_xor(ss, 16); ss += __shfl_xor(ss, 32);
                if (fq == 0) atomicAdd(rowstat + row, ss); }
    }
};
typedef _Float16 f16x8 __attribute__((ext_vector_type(8)));
struct EpiScores {
    static constexpr bool PERM = true, AFTER_DRAIN = false, PROBE_TWICE = false;
    _Float16* S; const float* sb; const float* rowstat;
    __device__ __forceinline__ void operator()(const f32x4 (&acc)[2][2][4][2], const Unit& u, int wr, int wc, int fr, int fq) const {
        const int row0 = u.pm * BM + wr * 64 + fr; const int col0 = u.pn * BM + wc * 32 + 8 * fq; const int b = (u.pm * BM) >> 11;
        f32x4 bv[2][2];
#pragma unroll
        for (int bj = 0; bj < 2; ++bj)
#pragma unroll
            for (int n = 0; n < 2; ++n) bv[bj][n] = *(const f32x4*)(sb + (size_t)b * 2048 + col0 + bj * HALF + 4 * n);
#pragma unroll
        for (int ai = 0; ai < 2; ++ai)
#pragma unroll
            for (int m = 0; m < 4; ++m) { const size_t row = (size_t)(row0 + ai * HALF + m * 16); const float rs = __builtin_amdgcn_rsqf(rowstat[row] * (1.0f / 1024.0f) + 1e-6f);
                _Float16* rowp = S + row * 2048 + col0;
#pragma unroll
                for (int bj = 0; bj < 2; ++bj) { const f32x4 v0 = acc[ai][bj][m][0] * rs + bv[bj][0], v1 = acc[ai][bj][m][1] * rs + bv[bj][1];
                    f16x8 h; h[0] = (_Float16)v0[0]; h[1] = (_Float16)v0[1]; h[2] = (_Float16)v0[2]; h[3] = (_Float16)v0[3]; h[4] = (_Float16)v1[0]; h[5] = (_Float16)v1[1]; h[6] = (_Float16)v1[2]; h[7] = (_Float16)v1[3];
                    *(f16x8*)(rowp + bj * HALF) = h; } }
    }
};
struct SegScaleHook {
    __device__ __forceinline__ static void build(PG8_LAS unsigned char* ldsx, const Unit& u, const float* st_ssd, const float* st_s5, int tid) {
        PG8_LAS float* tab = (PG8_LAS float*)ldsx + ((u.pm >> 3) & 1) * 1280;
        if (tid < 256) { const size_t row = (size_t)u.pm * BM + tid; const f32x4* sg = (const f32x4*)(st_ssd + row * 16); const f32x4* s5 = (const f32x4*)(st_s5 + row * 64);
            float r[5];
#pragma unroll
            for (int gI = 0; gI < 4; ++gI) { const f32x4 v = sg[gI]; r[gI] = __builtin_amdgcn_rsqf(((v[0] + v[1]) + (v[2] + v[3])) * (1.0f / 256.0f) + 1e-6f); }
            float a5 = 0.f;
#pragma unroll
            for (int q = 0; q < 16; ++q) { const f32x4 v = s5[q]; a5 += (v[0] + v[1]) + (v[2] + v[3]); }
            r[4] = __builtin_amdgcn_rsqf(a5 * (1.0f / 1024.0f) + 1e-6f);
#pragma unroll
            for (int k = 0; k < 4; ++k) tab[k * 256 + tid] = r[k] * __builtin_amdgcn_rcpf(r[k + 1]);
            tab[1024 + tid] = r[4]; }
    }
    __device__ __forceinline__ void at_tile(int t, const Unit& u, f32x4 (&acc)[2][2][4][2], PG8_LAS unsigned char* ldsx, int wr, int fr) const {
        if (t == 4 || t == 8 || t == 12 || t == 16) { const PG8_LAS float* rt = (const PG8_LAS float*)ldsx + ((u.pm >> 3) & 1) * 1280 + ((t >> 2) - 1) * 256 + wr * 64 + fr;
#pragma unroll
            for (int ai = 0; ai < 2; ++ai)
#pragma unroll
                for (int m = 0; m < 4; ++m) { const float r = rt[ai * HALF + m * 16];
#pragma unroll
                    for (int bj = 0; bj < 2; ++bj) { acc[ai][bj][m][0] = acc[ai][bj][m][0] * r; acc[ai][bj][m][1] = acc[ai][bj][m][1] * r; } } }
    }
};
}
constexpr int NWAVES = 8, NTHR = 512;
constexpr int DM = 1024, NB = 16, SEQ = 2048, MTOK = NB * SEQ;
constexpr int NPROJ = 4096;
constexpr int INW = 4112;
constexpr int NHEADS = 16, HDIM = 64, NGRP = 4, NST = 128, CHUNK = 128;
constexpr int S5G = 64, S5CH = 16, S5P = 64;
constexpr int PH = 8, PK = 16, PNK = 128;
constexpr float EPSF = 1e-6f;
constexpr int NS5PART = 64;

constexpr size_t MiB = 1u << 20;
constexpr size_t WS_CTL = 0, CTL_ZERO_BYTES = 64 * 1024;
constexpr size_t WS_MOD = 1 * MiB;
constexpr size_t WS_WDT = WS_MOD + 0x60000;
constexpr size_t WS_SB = WS_MOD + 0x70000;
constexpr size_t WS_ROWSTAT = WS_MOD + 0x90000;
constexpr size_t WS_S5LB = WS_MOD + 0xB0000;
constexpr size_t WS_S5BB = WS_MOD + 0xC0000;
constexpr size_t WS_DTRAW = 3 * MiB;
constexpr size_t WS_STSSD = 5 * MiB;
constexpr size_t WS_STS5 = 7 * MiB;
constexpr size_t WS_WINT = 15 * MiB;
constexpr size_t WS_WOUTT = 23 * MiB;
constexpr size_t WS_WQKT = 27 * MiB;
constexpr size_t WS_EU = 31 * MiB, WS_EV = 47 * MiB;
constexpr size_t WS_EUS = 63 * MiB, WS_EVS = 63 * MiB + 65536;
constexpr size_t WS_START = 64 * MiB;
constexpr size_t WS_A = 95 * MiB;
constexpr size_t WS_B = 223 * MiB;
constexpr size_t WS_H1 = WS_A, WS_Y = WS_A, WS_PROJ = WS_B, WS_SCORES = WS_A;
constexpr size_t WS_X1S = WS_B + 192 * MiB;
constexpr size_t WS_EID = 479 * MiB, WS_GATE = 495 * MiB;
constexpr size_t WS_H2Q = WS_B, WS_HINV = WS_B + 32 * MiB;
constexpr size_t WS_END = 511 * MiB;
static_assert(WS_SCORES + (size_t)MTOK * 2048 * 4 <= WS_X1S && WS_X1S + (size_t)MTOK * 1024 * 2 <= WS_EID && WS_GATE + (size_t)MTOK * 128 * 4 <= WS_END, "ws map");

constexpr int LDS_MAIN = 159744;
constexpr int MISC_OFF = LDS_MAIN;
constexpr int LDS_BYTES = LDS_MAIN + 128;

#define GAS __attribute__((address_space(1)))
#define LAS __attribute__((address_space(3)))
typedef unsigned short bf16;
typedef unsigned v4u __attribute__((ext_vector_type(4)));
typedef unsigned v2u __attribute__((ext_vector_type(2)));
typedef float f32x4 __attribute__((ext_vector_type(4)));
typedef float f32x2 __attribute__((ext_vector_type(2)));
typedef short bf16x8 __attribute__((ext_vector_type(8)));
#define LDS_WAIT() asm volatile("s_waitcnt lgkmcnt(0)" ::: "memory")
#define VM_WAIT() asm volatile("s_waitcnt vmcnt(0)" ::: "memory")
typedef __bf16 hwbf16x2 __attribute__((ext_vector_type(2)));
__device__ __forceinline__ unsigned pk2(float lo, float hi) { const f32x2 v = {lo, hi}; const hwbf16x2 b = __builtin_convertvector(v, hwbf16x2); return __builtin_bit_cast(unsigned, b); }
__device__ __forceinline__ unsigned f2bf(float f) { return pk2(f, 0.f) & 0xffffu; }
__device__ __forceinline__ float bflo(unsigned w) { return __builtin_bit_cast(float, w << 16); }
__device__ __forceinline__ float bfhi(unsigned w) { return __builtin_bit_cast(float, w & 0xffff0000u); }
__device__ __forceinline__ float bf2f(bf16 v) { return __builtin_bit_cast(float, (unsigned)v << 16); }
__device__ __forceinline__ float wave_sum(float v) {
#pragma unroll
    for (int o = 1; o < 64; o <<= 1) v += __shfl_xor(v, o);
    return v;
}
__device__ __forceinline__ float sigmoid_f(float v) { return __builtin_amdgcn_rcpf(1.0f + __builtin_amdgcn_exp2f(-1.4426950408889634f * v)); }
__device__ __forceinline__ float silu_f(float v) { return v * sigmoid_f(v); }
__device__ __forceinline__ float rsqrt_f(float v) { return __builtin_amdgcn_rsqf(v); }
__device__ __forceinline__ float gelu_erf(float v) {
    const float av = fabsf(v), t = __builtin_amdgcn_rcpf(av * 0.2316418882f + 1.0f);
    float q = t * 0.5307027145f + (-0.7265760135f); q = q * t + 0.7107068705f; q = q * t + (-0.142248368f); q = q * t + 0.127414796f; q = q * t;
    const float e = __builtin_amdgcn_exp2f((v * v) * (-0.72134752044f));
    const float m = v * (q * e);
    return v < 0.f ? m : v - m;
}
__device__ __forceinline__ float softplus_f(float v) { const float e = __builtin_amdgcn_exp2f(-1.4426950408889634f * fabsf(v));
    const float l = e < 1e-6f ? e : 0.6931471805599453f * __builtin_amdgcn_logf(1.0f + e); return fmaxf(v, 0.f) + l; }
__device__ __forceinline__ void unpack8(const v4u w, float* f) { f[0] = bflo(w.x); f[1] = bfhi(w.x); f[2] = bflo(w.y); f[3] = bfhi(w.y); f[4] = bflo(w.z); f[5] = bfhi(w.z); f[6] = bflo(w.w); f[7] = bfhi(w.w); }
#define LDS_BARRIER() do { asm volatile("s_waitcnt lgkmcnt(0)" ::: "memory"); __builtin_amdgcn_s_barrier(); asm volatile("" ::: "memory"); } while (0)
__device__ __forceinline__ float row16_sum_to15(float v) {
    v += __builtin_bit_cast(float, __builtin_amdgcn_update_dpp(0, __builtin_bit_cast(int, v), 0x118, 0xf, 0xf, true));
    v += __builtin_bit_cast(float, __builtin_amdgcn_update_dpp(0, __builtin_bit_cast(int, v), 0x114, 0xf, 0xf, true));
    v += __builtin_bit_cast(float, __builtin_amdgcn_update_dpp(0, __builtin_bit_cast(int, v), 0x112, 0xf, 0xf, true));
    v += __builtin_bit_cast(float, __builtin_amdgcn_update_dpp(0, __builtin_bit_cast(int, v), 0x111, 0xf, 0xf, true));
    return v;
}
__device__ __forceinline__ float wave_sum_to63(float v) {
    v = row16_sum_to15(v);
    v += __builtin_bit_cast(float, __builtin_amdgcn_update_dpp(0, __builtin_bit_cast(int, v), 0x142, 0xa, 0xf, false));
    v += __builtin_bit_cast(float, __builtin_amdgcn_update_dpp(0, __builtin_bit_cast(int, v), 0x143, 0xc, 0xf, false));
    return v;
}
__device__ __forceinline__ f32x2 gelu_pk2(f32x2 v) {
    const f32x2 av = __builtin_elementwise_abs(v), d = av * 0.2316418882f + 1.0f;
    f32x2 t; t[0] = __builtin_amdgcn_rcpf(d[0]); t[1] = __builtin_amdgcn_rcpf(d[1]);
    f32x2 q = t * 0.5307027145f + (-0.7265760135f); q = q * t + 0.7107068705f; q = q * t + (-0.142248368f); q = q * t + 0.127414796f; q = q * t;
    const f32x2 s = (v * v) * (-0.72134752044f);
    f32x2 e; e[0] = __builtin_amdgcn_exp2f(s[0]); e[1] = __builtin_amdgcn_exp2f(s[1]);
    const f32x2 m = v * (q * e), r = v - m;
    f32x2 o; o[0] = v[0] < 0.f ? m[0] : r[0]; o[1] = v[1] < 0.f ? m[1] : r[1]; return o;
}
#define XB_TMO      128
#define XB_XCNT(j)  (256  + 64 * (j))
#define XB_XSUB(j)  (1280 + 64 * (j))
#define XB_XGEN(j)  (2304 + 64 * (j))
#define XB_TOP      3328
#define XB_TOPGEN   3392
#define XCD_BAR_WORDS 3456
#define XB_SPIN_CAP (1u << 18)

__device__ __forceinline__ unsigned xb_ld(unsigned* p)              { return __hip_atomic_load(p, __ATOMIC_RELAXED, __HIP_MEMORY_SCOPE_AGENT); }
__device__ __forceinline__ unsigned xb_add(unsigned* p, unsigned v) { return __hip_atomic_fetch_add(p, v, __ATOMIC_RELAXED, __HIP_MEMORY_SCOPE_AGENT); }
__device__ __forceinline__ unsigned xb_xcc_id() { return (unsigned)__builtin_amdgcn_s_getreg((3 << 11) | 20) & 0xFu; }
#define XB_SPIN(cond, bar) do { unsigned _sp = 0; while (cond) { __builtin_amdgcn_s_sleep(1); \
    if ((++_sp & 255u) == 0u) { if (xb_ld(&(bar)[XB_TMO])) break; if (_sp > XB_SPIN_CAP) { atomicAdd(&(bar)[XB_TMO], 1u); break; } } } } while (0)

struct XcdBarrier {
    unsigned* bar; unsigned x;
    volatile LAS unsigned* st;
};

__device__ __forceinline__ XcdBarrier xcd_barrier_post(unsigned* bar, volatile LAS unsigned* st) {
    XcdBarrier b; b.bar = bar; b.x = xb_xcc_id(); b.st = st;
    if (threadIdx.x == 0) (void)xb_add(&bar[XB_XCNT(b.x)], 1u);
    return b;
}
__device__ __forceinline__ void xcd_barrier_complete(unsigned* bar, unsigned x, unsigned& nloc, unsigned& nx) {
    const unsigned G = gridDim.x * gridDim.y * gridDim.z;
    unsigned sum, cnt, mine, sp = 0u;
    for (;;) {
        sum = 0u; cnt = 0u; mine = 0u;
#pragma unroll
        for (unsigned j = 0; j < 16; ++j) { const unsigned c = xb_ld(&bar[XB_XCNT(j)]); sum += c; cnt += (c > 0u) ? 1u : 0u; mine = (j == x) ? c : mine; }
        if (sum == G) break;
        __builtin_amdgcn_s_sleep(1);
        if ((++sp & 255u) == 0u) { if (xb_ld(&bar[XB_TMO])) break; if (sp > XB_SPIN_CAP) { atomicAdd(&bar[XB_TMO], 1u); break; } }
    }
    nloc = mine > 0u ? mine : 1u; nx = cnt > 0u ? cnt : 1u;
}

__device__ __forceinline__ void xcd_barrier(const XcdBarrier& b) {
    asm volatile("s_waitcnt vmcnt(0)" ::: "memory");
    __syncthreads();
    if (threadIdx.x == 0) {
        unsigned* bar = b.bar;
        __builtin_amdgcn_s_waitcnt(0);
        unsigned nloc = b.st[0], nx = b.st[1];
        if (nloc == 0u) { xcd_barrier_complete(bar, b.x, nloc, nx); b.st[0] = nloc; b.st[1] = nx; }
        const unsigned old = xb_add(&bar[XB_XSUB(b.x)], 1u);
        const unsigned gen = old / nloc;
        if (old + 1u == (gen + 1u) * nloc) {
            __builtin_amdgcn_fence(__ATOMIC_RELEASE, "agent");
            asm volatile("s_waitcnt vmcnt(0)" ::: "memory");
            const unsigned og = xb_add(&bar[XB_TOP], 1u);
            const unsigned tg = og / nx;
            if (og + 1u == (tg + 1u) * nx) xb_add(&bar[XB_TOPGEN], 1u);
            else XB_SPIN(xb_ld(&bar[XB_TOPGEN]) == tg, bar);
            __builtin_amdgcn_fence(__ATOMIC_ACQUIRE, "agent");
            xb_add(&bar[XB_XGEN(b.x)], 1u);
            asm volatile("s_waitcnt vmcnt(0)" ::: "memory");
        } else {
            XB_SPIN(xb_ld(&bar[XB_XGEN(b.x)]) == gen, bar);
            __builtin_amdgcn_fence(__ATOMIC_ACQUIRE, "agent");
            asm volatile("s_waitcnt vmcnt(0)" ::: "memory");
        }
    }
    __syncthreads();
}
struct Args { const float* in[30]; float* out; unsigned char* ws; int ph_lo, ph_hi; };
struct Frame {
    LAS unsigned char* lds;
    volatile LAS unsigned* MISC;
    int vcu, G;
    unsigned char* ws;
    const Args* a;
    float* out;
};
#define WSP(T, off) ((T*)(F.ws + (off)))

__device__ __forceinline__ void transpose_tile(const float* W, int ldw, int k0, int src_n0, bf16* WT, int K, int dst_n0, LAS float* scr, int lane, const float* kscale) {
#pragma unroll 8
    for (int i = 0; i < 32; ++i) { const int kk = 2 * i + (lane >> 5); float v = W[(size_t)(k0 + kk) * ldw + src_n0 + (lane & 31)]; if (kscale) v *= kscale[k0 + kk]; scr[kk * 33 + (lane & 31)] = v; }
    LDS_WAIT(); asm volatile("" ::: "memory");
    const int c = lane & 7;
#pragma unroll
    for (int j = 0; j < 4; ++j) { const int n = (lane >> 3) + 8 * j; const LAS float* s = scr + (8 * c) * 33 + n;
        v4u o; o.x = pk2(s[0 * 33], s[1 * 33]); o.y = pk2(s[2 * 33], s[3 * 33]); o.z = pk2(s[4 * 33], s[5 * 33]); o.w = pk2(s[6 * 33], s[7 * 33]);
        *(v4u*)(WT + (size_t)(dst_n0 + n) * K + k0 + 8 * c) = o; }
    LDS_WAIT(); asm volatile("" ::: "memory");
}
__device__ __forceinline__ void p0_phase(Frame& F) {
    const int f_tid = threadIdx.x, f_lane = f_tid & 63, f_wave = __builtin_amdgcn_readfirstlane(f_tid >> 6);
    const int gw = F.vcu * NWAVES + f_wave, NGW = F.G * NWAVES, gt = F.vcu * NTHR + f_tid, NGT = F.G * NTHR;
    {
        LAS float* sc = (LAS float*)F.lds;
        LAS float* red = (LAS float*)(F.lds + 65536);
        for (int i = f_tid; i < 16 * 1024; i += NTHR) { const int b = i >> 10, k = i & 1023; sc[k * 16 + b] = silu_f((F.a->in[1])[i]); }
        __syncthreads();
        const int ks = f_tid / 24, col = f_tid - ks * 24, j = F.vcu * 24 + col;
        if (ks < 21) {
            float acc[16];
#pragma unroll
            for (int b = 0; b < 16; ++b) acc[b] = 0.f;
            const int k0 = ks * 49, kn = (k0 + 49 <= 1024) ? 49 : (1024 - k0);
            const float* wp = (F.a->in[2]) + (size_t)k0 * 6144 + j;
#pragma unroll 1
            for (int kb = 0; kb < 49; kb += 7) {
                asm volatile("" ::: "memory");
                float wv[7];
#pragma unroll
                for (int u = 0; u < 7; ++u) wv[u] = (kb + u < kn) ? wp[(size_t)(kb + u) * 6144] : 0.f;
#pragma unroll
                for (int u = 0; u < 7; ++u) { const int kk = (kb + u < kn) ? (k0 + kb + u) : k0; const LAS f32x4* s4 = (const LAS f32x4*)(sc + kk * 16);
#pragma unroll
                    for (int q = 0; q < 4; ++q) { const f32x4 sv = s4[q]; acc[4 * q] += sv[0] * wv[u]; acc[4 * q + 1] += sv[1] * wv[u]; acc[4 * q + 2] += sv[2] * wv[u]; acc[4 * q + 3] += sv[3] * wv[u]; } }
            }
#pragma unroll
            for (int b = 0; b < 16; ++b) red[(ks * 16 + b) * 24 + col] = acc[b];
        }
        __syncthreads();
        for (int i = f_tid; i < 16 * 24; i += NTHR) { const int b = i / 24, cc = i - b * 24; float sacc = 0.f;
            for (int q = 0; q < 21; ++q) sacc += red[(q * 16 + b) * 24 + cc];
            WSP(float, WS_MOD)[b * 6144 + F.vcu * 24 + cc] = sacc + (F.a->in[3])[F.vcu * 24 + cc]; }
        __syncthreads();
    }
    {
        LAS float* scr = (LAS float*)(F.lds + f_wave * 16384);
        constexpr int I_IN = (1024 / 64) * (NPROJ / 32), I_OUT = (2048 / 64) * (1024 / 32);
        for (int it = gw; it < I_IN + I_OUT; it += NGW) {
            if (it < I_IN) { const int kb = it / (NPROJ / 32), nb = it % (NPROJ / 32); const int dn = 32 * nb, sn = dn < 3072 ? dn : dn + 16;
                transpose_tile((F.a->in[5]), INW, 64 * kb, sn, WSP(bf16, WS_WINT), 1024, dn, scr, f_lane, nullptr); }
            else { const int r = it - I_IN, kb = r / 32, nb = r % 32; const int k0 = 64 * kb;
                transpose_tile((F.a->in[23]), 1024, k0, 32 * nb, WSP(bf16, WS_WOUTT), 2048, 32 * nb, scr, f_lane, k0 < 1024 ? (F.a->in[11]) : (F.a->in[22]) - 1024); }
        }
    }
    for (int i = gt; i < 16 * 1024; i += NGT) { const int h = i >> 10, k = i & 1023; WSP(float, WS_WDT)[i] = (F.a->in[5])[(size_t)k * INW + 3072 + h]; }
    for (int task = gw; task < 2048; task += NGW) {
        const int nt = task >> 4, ks = task & 15, n0 = 16 * nt, hc = n0 >> 7, k0 = 64 * ks;
        const int li = f_lane & 15, lq = f_lane >> 4;
        f32x4 acc[4];
#pragma unroll
        for (int s = 0; s < 4; ++s) acc[s] = (f32x4){0.f, 0.f, 0.f, 0.f};
        const float* ap = (F.a->in[26]) + (size_t)(n0 + li) * 128 + 4 * lq;
        const float* bp = (F.a->in[25]) + (size_t)(k0 + li) * 2048 + hc * 128 + 4 * lq;
#pragma unroll
        for (int q = 0; q < 8; ++q) { const f32x4 a = *(const f32x4*)(ap + 16 * q);
#pragma unroll
            for (int s = 0; s < 4; ++s) { const f32x4 b = *(const f32x4*)(bp + (size_t)(16 * s) * 2048 + 16 * q);
#pragma unroll
                for (int jj = 0; jj < 4; ++jj) acc[s] = __builtin_amdgcn_mfma_f32_16x16x4f32(a[jj], b[jj], acc[s], 0, 0, 0); } }
        bf16* o = WSP(bf16, WS_WQKT);
#pragma unroll
        for (int s = 0; s < 4; ++s)
#pragma unroll
            for (int r = 0; r < 4; ++r) o[(size_t)(n0 + 4 * lq + r) * 1024 + k0 + 16 * s + li] = (bf16)f2bf(acc[s][r]);
    }
    for (int i = gt; i < S5G * S5P; i += NGT) {
        const float lr = (F.a->in[12])[i], li = (F.a->in[13])[i], dt = expf((F.a->in[14])[i >> 6]);
        const float mag = expf(lr * dt); float sn, cs; sincosf(li * dt, &sn, &cs);
        const float lbr = mag * cs, lbi = mag * sn, den = lr * lr + li * li;
        const float cfr = ((lbr - 1.0f) * lr + lbi * li) / den, cfi = (lbi * lr - (lbr - 1.0f) * li) / den;
        WSP(float, WS_S5LB)[2 * i] = lbr; WSP(float, WS_S5LB)[2 * i + 1] = lbi;
        for (int hh = 0; hh < 16; ++hh) { const float br = (F.a->in[15])[i * 16 + hh], bi = (F.a->in[16])[i * 16 + hh];
            WSP(float, WS_S5BB)[i * 32 + hh] = cfr * br - cfi * bi; WSP(float, WS_S5BB)[i * 32 + 16 + hh] = cfr * bi + cfi * br; }
    }
    for (int i = gt; i < MTOK; i += NGT) WSP(float, WS_ROWSTAT)[i] = 0.f;
}

__device__ __forceinline__ void p1_phase(Frame& F) {
    const int f_tid = threadIdx.x, f_lane = f_tid & 63, f_wave = __builtin_amdgcn_readfirstlane(f_tid >> 6);
    const int gw = F.vcu * NWAVES + f_wave;
    LAS float* wdt = (LAS float*)F.lds;
    for (int i = f_tid; i < 16 * 1024 / 4; i += NTHR) ((LAS f32x4*)wdt)[i] = ((const f32x4*)WSP(float, WS_WDT))[i];
    __syncthreads();
    const int lane = f_lane;
    for (int wq = gw; wq < MTOK / 16; wq += F.G * NWAVES) {
        const int b = wq >> 7; const float* mb = WSP(float, WS_MOD) + (size_t)b * 6144;
        f32x4 Gv[4], Sv[4];
#pragma unroll
        for (int j = 0; j < 4; ++j) { const int k = 4 * lane + 256 * j; const f32x4 g = *(const f32x4*)((F.a->in[4]) + k), sc = *(const f32x4*)(mb + 1024 + k); Gv[j] = g * (sc + 1.0f); Sv[j] = *(const f32x4*)(mb + k); }
        f32x4 nx[4];
#pragma unroll
        for (int j = 0; j < 4; ++j) nx[j] = *(const f32x4*)((F.a->in[0]) + (size_t)wq * 16 * 1024 + 4 * lane + 256 * j);
        for (int tt = 0; tt < 16; ++tt) {
            asm volatile("" ::: "memory");
            const size_t t = (size_t)wq * 16 + tt; const float* xr = (F.a->in[0]) + t * 1024;
            f32x4 v[4]; float ss = 0.f;
#pragma unroll
            for (int j = 0; j < 4; ++j) { v[j] = nx[j]; ss += (v[j][0] * v[j][0] + v[j][1] * v[j][1]) + (v[j][2] * v[j][2] + v[j][3] * v[j][3]); }
            if (tt < 15) {
#pragma unroll
                for (int j = 0; j < 4; ++j) nx[j] = *(const f32x4*)(xr + 1024 + 4 * lane + 256 * j); }
            const float rstd = rsqrt_f(wave_sum(ss) * (1.0f / 1024.0f) + EPSF);
            bf16* hr = WSP(bf16, WS_H1) + t * 1024;
#pragma unroll
            for (int j = 0; j < 4; ++j) { v[j] = v[j] * rstd * Gv[j] + Sv[j]; v2u w; w.x = pk2(v[j][0], v[j][1]); w.y = pk2(v[j][2], v[j][3]); *(v2u*)(hr + 4 * lane + 256 * j) = w; }
            float d[16];
#pragma unroll
            for (int h = 0; h < 16; ++h) { float a = 0.f;
#pragma unroll
                for (int j = 0; j < 4; ++j) { const f32x4 w = *(const LAS f32x4*)(wdt + h * 1024 + 4 * lane + 256 * j); a += (v[j][0] * w[0] + v[j][1] * w[1]) + (v[j][2] * w[2] + v[j][3] * w[3]); }
                d[h] = a; }
            float e8[8], e4[4], e2[2], e1;
#pragma unroll
            for (int i = 0; i < 8; ++i) { const bool up = lane & 32; const float snd = up ? d[i] : d[i + 8]; const float rcv = __shfl_xor(snd, 32); e8[i] = (up ? d[i + 8] : d[i]) + rcv; }
#pragma unroll
            for (int i = 0; i < 4; ++i) { const bool up = lane & 16; const float snd = up ? e8[i] : e8[i + 4]; const float rcv = __shfl_xor(snd, 16); e4[i] = (up ? e8[i + 4] : e8[i]) + rcv; }
#pragma unroll
            for (int i = 0; i < 2; ++i) { const bool up = lane & 8; const float snd = up ? e4[i] : e4[i + 2]; const float rcv = __shfl_xor(snd, 8); e2[i] = (up ? e4[i + 2] : e4[i]) + rcv; }
            { const bool up = lane & 4; const float snd = up ? e2[0] : e2[1]; const float rcv = __shfl_xor(snd, 4); e1 = (up ? e2[1] : e2[0]) + rcv; }
            e1 += __shfl_xor(e1, 2); e1 += __shfl_xor(e1, 1);
            const int head = ((lane >> 5) & 1) * 8 + ((lane >> 4) & 1) * 4 + ((lane >> 3) & 1) * 2 + ((lane >> 2) & 1);
            if ((lane & 3) == 0) WSP(float, WS_DTRAW)[t * 16 + head] = e1;
        }
    }
    for (int n = gw; n < 2048; n += F.G * NWAVES) {
        const bf16* wr = WSP(bf16, WS_WQKT) + (size_t)n * 1024 + 16 * lane;
        const v4u w0 = *(const v4u*)wr, w1 = *(const v4u*)(wr + 8);
        float wv[16]; wv[0] = bflo(w0.x); wv[1] = bfhi(w0.x); wv[2] = bflo(w0.y); wv[3] = bfhi(w0.y); wv[4] = bflo(w0.z); wv[5] = bfhi(w0.z); wv[6] = bflo(w0.w); wv[7] = bfhi(w0.w);
        wv[8] = bflo(w1.x); wv[9] = bfhi(w1.x); wv[10] = bflo(w1.y); wv[11] = bfhi(w1.y); wv[12] = bflo(w1.z); wv[13] = bfhi(w1.z); wv[14] = bflo(w1.w); wv[15] = bfhi(w1.w);
        for (int b = 0; b < 16; ++b) { const float* sp = WSP(float, WS_MOD) + (size_t)b * 6144 + 3072 + 16 * lane; float a = 0.f;
#pragma unroll
            for (int q = 0; q < 4; ++q) { const f32x4 s = *(const f32x4*)(sp + 4 * q); a += (s[0] * wv[4 * q] + s[1] * wv[4 * q + 1]) + (s[2] * wv[4 * q + 2] + s[3] * wv[4 * q + 3]); }
            a = wave_sum(a); if (lane == 0) WSP(float, WS_SB)[b * 2048 + n] = a; }
    }
}
__device__ __forceinline__ void p3pre_conv(Frame& F) {
    const int tid = threadIdx.x;
    const bf16* proj = WSP(bf16, WS_PROJ); bf16* xo = (bf16*)F.out;
    for (int item = F.vcu * NTHR + tid; item < (MTOK / 16) * 256; item += F.G * NTHR) {
        const int oc = item & 255, run = item >> 8; const int t0 = run * 16, ch = 8 * oc;
        const bool halo = (t0 & (SEQ - 1)) != 0;
        v4u rw[19];
#pragma unroll
        for (int k = 0; k < 19; ++k) { rw[k] = (v4u){0u, 0u, 0u, 0u}; if (k >= 3 || halo) rw[k] = *(const v4u*)(proj + (size_t)(t0 - 3 + k) * NPROJ + 1024 + ch); }
        float cw[4][8], cbv[8];
#pragma unroll
        for (int k = 0; k < 4; ++k) { const f32x4 w0 = *(const f32x4*)((F.a->in[6]) + k * 2048 + ch), w1 = *(const f32x4*)((F.a->in[6]) + k * 2048 + ch + 4);
#pragma unroll
            for (int e = 0; e < 4; ++e) { cw[k][e] = w0[e]; cw[k][4 + e] = w1[e]; } }
        { const f32x4 b0 = *(const f32x4*)((F.a->in[7]) + ch), b1 = *(const f32x4*)((F.a->in[7]) + ch + 4);
#pragma unroll
            for (int e = 0; e < 4; ++e) { cbv[e] = b0[e]; cbv[4 + e] = b1[e]; } }
        float r0[8], r1[8], r2[8];
        unpack8(rw[0], r0); unpack8(rw[1], r1); unpack8(rw[2], r2);
#pragma unroll
        for (int tt = 0; tt < 16; ++tt) {
            float r3[8]; unpack8(rw[3 + tt], r3);
            float v[8];
#pragma unroll
            for (int i = 0; i < 8; ++i) { v[i] = silu_f(cbv[i] + r0[i] * cw[0][i] + r1[i] * cw[1][i] + r2[i] * cw[2][i] + r3[i] * cw[3][i]); r0[i] = r1[i]; r1[i] = r2[i]; r2[i] = r3[i]; }
            *(v4u*)(xo + (size_t)(t0 + tt) * 2048 + ch) = (v4u){pk2(v[0], v[1]), pk2(v[2], v[3]), pk2(v[4], v[5]), pk2(v[6], v[7])};
        }
    }
}
constexpr int SSD_PITCH = 272;
__device__ __forceinline__ bf16x8 lds_frag(LAS unsigned char* base, int row, int kbyte) { return *(const LAS bf16x8*)(base + row * SSD_PITCH + kbyte); }
#ifdef PROBE_SSD
#define SPR_T(v) const unsigned long long v = __builtin_amdgcn_s_memtime();
#define SPR_ACC(i, d) sacc[i] += (d);
#else
#define SPR_T(v)
#define SPR_ACC(i, d)
#endif
constexpr int S3_CS = 0, S3_BS = 34816, S3_GY = 69632, S3_XDT = 104448, S3_XP = 144, S3_PREV = 122880, S3_CSF = 140288, S3_DTF = 141312, S3_WTS = 142336, S3_END = 143360;
static_assert(S3_END <= LDS_MAIN, "SSD v3 LDS map");
typedef short v4i16_t __attribute__((ext_vector_type(4)));
__device__ __forceinline__ bf16x8 lds_frag_tr(LAS unsigned char* tile, int pitch, int k0, int col0, int li, int lq) {
    LAS unsigned char* p = tile + (k0 + 8 * lq + (li >> 2)) * pitch + (col0 + 4 * (li & 3)) * 2;
    const v4i16_t lo = __builtin_amdgcn_ds_read_tr16_b64_v4i16((LAS v4i16_t*)p), hi = __builtin_amdgcn_ds_read_tr16_b64_v4i16((LAS v4i16_t*)(p + 4 * pitch));
    return __builtin_shufflevector(lo, hi, 0, 1, 2, 3, 4, 5, 6, 7);
}
struct Ssd3Pre { v4u xr[4], br[4], cr[4]; float d0, d1; };
__device__ __forceinline__ void ssd3_prefetch(Ssd3Pre& P, const char* xcb, const float* dtr, unsigned voB, unsigned voX, int tid, int lane, int w) {
#pragma unroll
    for (int r = 0; r < 4; ++r) { P.br[r] = *(const v4u*)(xcb + (voB + r * 4096u)); P.cr[r] = *(const v4u*)(xcb + (voB + 1024u + r * 4096u)); }
#pragma unroll
    for (int r = 0; r < 4; ++r) P.xr[r] = *(const v4u*)(xcb + (voX + r * 4096u));
    P.d0 = dtr[lane * 32]; P.d1 = dtr[lane * 32 + 16];
}
__device__ __forceinline__ void ssd3_cumsum(LAS unsigned char* L, int par, float r0, float r1, float dtb, float A, int lane) {
    LAS float* csf = (LAS float*)(L + S3_CSF + par * 512); LAS float* dtf = (LAS float*)(L + S3_DTF + par * 512); LAS float* wts = (LAS float*)(L + S3_WTS + par * 512);
    const float d0 = softplus_f(r0 + dtb), d1 = softplus_f(r1 + dtb);
    const float a0 = d0 * A, a1 = d1 * A; float s = a0 + a1;
#pragma unroll
    for (int o = 1; o < 64; o <<= 1) { const float t = __shfl_up(s, o); if (lane >= o) s += t; }
    const float tot = __shfl(s, 63);
    dtf[2 * lane] = d0; dtf[2 * lane + 1] = d1; csf[2 * lane] = s - a1; csf[2 * lane + 1] = s;
    wts[2 * lane] = __expf(tot - (s - a1)); wts[2 * lane + 1] = __expf(tot - s);
}
__device__ __forceinline__ void p3_ssd3(Frame& F) {
    const int tid0 = threadIdx.x, w = __builtin_amdgcn_readfirstlane(tid0 >> 6);
    LAS unsigned char* L = F.lds;
    const bf16* proj = WSP(bf16, WS_PROJ); const bf16* xc = (const bf16*)F.out; const float* dtraw = WSP(float, WS_DTRAW);
    for (int item = F.vcu; item < NB * NHEADS; item += F.G) {
        const int b = item >> 4, h = item & 15, g = h >> 2;
        int tid = tid0; asm volatile("" : "+v"(tid)); int lane = tid & 63;
        const float A = -__expf((F.a->in[9])[h]), Dh = (F.a->in[10])[h], dtb = (F.a->in[8])[h];
        const int pbs = w >> 1, nb0 = 4 * (w & 1);
        f32x4 st[4];
#pragma unroll
        for (int j = 0; j < 4; ++j) st[j] = (f32x4){0.f, 0.f, 0.f, 0.f};
        __syncthreads();
        for (int i = tid; i < 17408 / 16; i += NTHR) ((LAS v4u*)(L + S3_PREV))[i] = (v4u){0u, 0u, 0u, 0u};
        Ssd3Pre P;
        { const unsigned voB0 = (unsigned)((4 * (tid >> 4)) * 2048 + 1024 + g * 128 + 8 * (tid & 15)) * 2u, voX0 = (unsigned)((4 * ((tid & 255) >> 3)) * 2048 + h * 64 + 8 * (tid & 7)) * 2u;
          ssd3_prefetch(P, (const char*)xc + (size_t)b * SEQ * 4096, dtraw + (size_t)b * SEQ * 16 + h, voB0, voX0, tid, lane, w); }
        if (w == 0) ssd3_cumsum(L, 0, P.d0, P.d1, dtb, A, lane);
        __syncthreads();
#ifdef PROBE_SSD
        unsigned long long sacc[8] = {0, 0, 0, 0, 0, 0, 0, 0};
#endif
        for (int c = 0; c < SEQ / CHUNK; ++c) {
            SPR_T(s0)
            const size_t row0 = (size_t)b * SEQ + (size_t)c * CHUNK; const int par = c & 1;
            asm volatile("" : "+v"(tid));
            lane = tid & 63; const int li = lane & 15, lq = lane >> 4;
            const unsigned voB = (unsigned)((4 * (tid >> 4)) * 2048 + 1024 + g * 128 + 8 * (tid & 15)) * 2u, voX = (unsigned)((4 * ((tid & 255) >> 3)) * 2048 + h * 64 + 8 * (tid & 7)) * 2u;
            const unsigned voZ0 = (unsigned)((tid >> 3) * NPROJ + h * 64 + 8 * (tid & 7)) * 2u, voZ1 = voZ0 + 64u * NPROJ * 2u;
            LAS float* csf = (LAS float*)(L + S3_CSF + par * 512); LAS float* dtf = (LAS float*)(L + S3_DTF + par * 512); LAS float* wts = (LAS float*)(L + S3_WTS + par * 512);
            { const int ob = tid & 15, lb = 4 * (tid >> 4), n0 = 8 * ob;
#pragma unroll
              for (int r = 0; r < 4; ++r) { *(LAS v4u*)(L + S3_BS + (lb + r) * SSD_PITCH + n0 * 2) = P.br[r]; *(LAS v4u*)(L + S3_CS + (lb + r) * SSD_PITCH + n0 * 2) = P.cr[r]; } }
            if (tid < 256) { const int ox = tid & 7, lx = 4 * (tid >> 3), p0 = 8 * ox;
#pragma unroll
              for (int r = 0; r < 4; ++r) { float xv[8]; unpack8(P.xr[r], xv); const float tw = dtf[lx + r];
                  *(LAS v4u*)(L + S3_XDT + (lx + r) * S3_XP + p0 * 2) = (v4u){pk2(xv[0] * tw, xv[1] * tw), pk2(xv[2] * tw, xv[3] * tw), pk2(xv[4] * tw, xv[5] * tw), pk2(xv[6] * tw, xv[7] * tw)}; } }
            const char* prb = (const char*)proj + row0 * (NPROJ * 2);
            const v4u zc0 = *(const v4u*)(prb + voZ0), zc1 = *(const v4u*)(prb + voZ1);
            SPR_T(s1) SPR_ACC(0, s1 - s0)
            LDS_BARRIER();
            SPR_T(s2) SPR_ACC(1, s2 - s1)
            const float cs_end = csf[127];
            bf16x8 ca[4];
#pragma unroll
            for (int ks = 0; ks < 4; ++ks) ca[ks] = lds_frag(L + S3_CS, 16 * w + li, 64 * ks + 16 * lq);
            float csl[4];
#pragma unroll
            for (int r = 0; r < 4; ++r) csl[r] = csf[16 * w + 4 * lq + r];
            { bf16x8 bq[2][4];
#pragma unroll
              for (int ks = 0; ks < 4; ++ks) bq[0][ks] = lds_frag(L + S3_BS, li, 64 * ks + 16 * lq);
#pragma unroll
              for (int sb = 0; sb < 8; ++sb) if (sb <= (w | 1)) {
                  f32x4 cbv = (f32x4){0.f, 0.f, 0.f, 0.f};
                  const int s = 16 * sb + li; const float css = csf[s];
                  if (sb <= w) {
                      if (sb + 1 <= w) {
#pragma unroll
                          for (int ks = 0; ks < 4; ++ks) bq[(sb + 1) & 1][ks] = lds_frag(L + S3_BS, 16 * (sb + 1) + li, 64 * ks + 16 * lq); }
                      __builtin_amdgcn_sched_barrier(0);
#pragma unroll
                      for (int ks = 0; ks < 4; ++ks) cbv = __builtin_amdgcn_mfma_f32_16x16x32_bf16(ca[ks], bq[sb & 1][ks], cbv, 0, 0, 0);
                      __builtin_amdgcn_sched_barrier(0); }
#pragma unroll
                  for (int r = 0; r < 4; ++r) { const int l = 16 * w + 4 * lq + r; const float gv = (s <= l) ? cbv[r] * __expf(csl[r] - css) : 0.f;
                      *(LAS unsigned short*)(L + S3_GY + l * SSD_PITCH + s * 2) = (unsigned short)f2bf(gv); } } }
            LDS_WAIT(); asm volatile("" ::: "memory");
            SPR_T(s3) SPR_ACC(2, s3 - s2)
            f32x4 yd[4], yo[4];
#pragma unroll
            for (int pb = 0; pb < 4; ++pb) { yd[pb] = (f32x4){0.f, 0.f, 0.f, 0.f}; yo[pb] = (f32x4){0.f, 0.f, 0.f, 0.f}; }
            { bf16x8 gq[2], xq[2][4];
              gq[0] = lds_frag(L + S3_GY, 16 * w + li, 16 * lq);
#pragma unroll
              for (int pb = 0; pb < 4; ++pb) xq[0][pb] = lds_frag_tr(L + S3_XDT, S3_XP, 0, 16 * pb, li, lq);
#pragma unroll
              for (int ks = 0; ks < 4; ++ks) if (ks <= (w >> 1)) {
                  if (ks + 1 <= (w >> 1)) { gq[(ks + 1) & 1] = lds_frag(L + S3_GY, 16 * w + li, 64 * (ks + 1) + 16 * lq);
#pragma unroll
                      for (int pb = 0; pb < 4; ++pb) xq[(ks + 1) & 1][pb] = lds_frag_tr(L + S3_XDT, S3_XP, 32 * (ks + 1), 16 * pb, li, lq); }
                  __builtin_amdgcn_sched_barrier(0);
#pragma unroll
                  for (int pb = 0; pb < 4; ++pb) yd[pb] = __builtin_amdgcn_mfma_f32_16x16x32_bf16(gq[ks & 1], xq[ks & 1][pb], yd[pb], 0, 0, 0);
                  __builtin_amdgcn_sched_barrier(0); } }
            { bf16x8 pq[2][4];
#pragma unroll
              for (int pb = 0; pb < 4; ++pb) pq[0][pb] = lds_frag(L + S3_PREV, 16 * pb + li, 16 * lq);
#pragma unroll
              for (int ks = 0; ks < 4; ++ks) {
                  if (ks < 3) {
#pragma unroll
                      for (int pb = 0; pb < 4; ++pb) pq[(ks + 1) & 1][pb] = lds_frag(L + S3_PREV, 16 * pb + li, 64 * (ks + 1) + 16 * lq); }
                  __builtin_amdgcn_sched_barrier(0);
#pragma unroll
                  for (int pb = 0; pb < 4; ++pb) yo[pb] = __builtin_amdgcn_mfma_f32_16x16x32_bf16(ca[ks], pq[ks & 1][pb], yo[pb], 0, 0, 0);
                  __builtin_amdgcn_sched_barrier(0); } }
#pragma unroll
            for (int r = 0; r < 4; ++r) { const float e = __expf(csl[r]);
#pragma unroll
                for (int pb = 0; pb < 4; ++pb) *(LAS float*)(L + S3_GY + (16 * w + 4 * lq + r) * SSD_PITCH + (16 * pb + li) * 4) = yd[pb][r] + e * yo[pb][r]; }
            { const size_t rown = row0 + (c + 1 < SEQ / CHUNK ? CHUNK : 0);
              ssd3_prefetch(P, (const char*)xc + rown * 4096, dtraw + rown * 16 + h, voB, voX, tid, lane, w); }
            SPR_T(s4) SPR_ACC(3, s4 - s3)
            LDS_BARRIER();
            SPR_T(s5) SPR_ACC(4, s5 - s4)
            { const float dec = __expf(cs_end);
#pragma unroll
              for (int j = 0; j < 4; ++j) st[j] = st[j] * dec;
              bf16x8 xq[2], bq2[2][4]; f32x4 wq[2][2];
              xq[0] = lds_frag_tr(L + S3_XDT, S3_XP, 0, 16 * pbs, li, lq); wq[0][0] = *(const LAS f32x4*)(wts + 8 * lq); wq[0][1] = *(const LAS f32x4*)(wts + 8 * lq + 4);
#pragma unroll
              for (int j = 0; j < 4; ++j) bq2[0][j] = lds_frag_tr(L + S3_BS, SSD_PITCH, 0, 16 * (nb0 + j), li, lq);
#pragma unroll
              for (int ks = 0; ks < 4; ++ks) {
                  if (ks < 3) { xq[(ks + 1) & 1] = lds_frag_tr(L + S3_XDT, S3_XP, 32 * (ks + 1), 16 * pbs, li, lq); wq[(ks + 1) & 1][0] = *(const LAS f32x4*)(wts + 32 * (ks + 1) + 8 * lq); wq[(ks + 1) & 1][1] = *(const LAS f32x4*)(wts + 32 * (ks + 1) + 8 * lq + 4);
#pragma unroll
                      for (int j = 0; j < 4; ++j) bq2[(ks + 1) & 1][j] = lds_frag_tr(L + S3_BS, SSD_PITCH, 32 * (ks + 1), 16 * (nb0 + j), li, lq); }
                  __builtin_amdgcn_sched_barrier(0);
                  const f32x4 w0 = wq[ks & 1][0], w1 = wq[ks & 1][1];
                  float xv[8]; unpack8(__builtin_bit_cast(v4u, xq[ks & 1]), xv);
                  const v4u xw = (v4u){pk2(xv[0] * w0[0], xv[1] * w0[1]), pk2(xv[2] * w0[2], xv[3] * w0[3]), pk2(xv[4] * w1[0], xv[5] * w1[1]), pk2(xv[6] * w1[2], xv[7] * w1[3])};
                  const bf16x8 xf = __builtin_bit_cast(bf16x8, xw);
#pragma unroll
                  for (int j = 0; j < 4; ++j) st[j] = __builtin_amdgcn_mfma_f32_16x16x32_bf16(xf, bq2[ks & 1][j], st[j], 0, 0, 0);
                  __builtin_amdgcn_sched_barrier(0); }
#pragma unroll
              for (int j = 0; j < 4; ++j)
#pragma unroll
                  for (int r = 0; r < 4; ++r) *(LAS unsigned short*)(L + S3_PREV + (16 * pbs + 4 * lq + r) * SSD_PITCH + (16 * (nb0 + j) + li) * 2) = (unsigned short)f2bf(st[j][r]); }
            SPR_T(s6) SPR_ACC(5, s6 - s5)
#pragma unroll
            for (int k = 0; k < 2; ++k) { const int it = tid + 512 * k, l = it >> 3, o = it & 7; const size_t row = row0 + l;
                const f32x4 y0 = *(const LAS f32x4*)(L + S3_GY + l * SSD_PITCH + 32 * o), y1 = *(const LAS f32x4*)(L + S3_GY + l * SSD_PITCH + 32 * o + 16);
                const v4u xw = *(const LAS v4u*)(L + S3_XDT + l * S3_XP + 16 * o); const v4u zw = k == 0 ? zc0 : zc1; const float dsk = Dh * __builtin_amdgcn_rcpf(fmaxf(dtf[l], 1e-30f));
                float xv[8], zv[8], yv[8]; unpack8(xw, xv); unpack8(zw, zv);
                float ss = 0.f;
#pragma unroll
                for (int e = 0; e < 8; ++e) { const float yy = (e < 4 ? y0[e] : y1[e - 4]) + dsk * xv[e]; yv[e] = yy * silu_f(zv[e]); ss += yv[e] * yv[e]; }
                ss += __shfl_xor(ss, 1); ss += __shfl_xor(ss, 2); ss += __shfl_xor(ss, 4);
                if (o == 0) WSP(float, WS_STSSD)[row * 16 + h] = ss;
                *(v4u*)(WSP(bf16, WS_Y) + row * 2048 + h * 64 + 8 * o) = (v4u){pk2(yv[0], yv[1]), pk2(yv[2], yv[3]), pk2(yv[4], yv[5]), pk2(yv[6], yv[7])}; }
            if (w == 0 && c + 1 < SEQ / CHUNK) ssd3_cumsum(L, par ^ 1, P.d0, P.d1, dtb, A, lane);
            SPR_T(s7) SPR_ACC(6, s7 - s6)
            LDS_BARRIER();
            SPR_T(s8) SPR_ACC(7, s8 - s7)
        }
#ifdef PROBE_SSD
        if (blockIdx.x == 0 && threadIdx.x == PROBE_TID) *(volatile float*)(F.ws + WS_CTL + 40000) = (float)sacc[PROBE_SSD] * 1e-3f;
#endif
    }
}
typedef float f32x16 __attribute__((ext_vector_type(16)));
#ifdef PROBE_SEL
#define PR_T(v) const unsigned long long v = __builtin_amdgcn_s_memtime();
#define PR_ACC(a, d) a += (d);
#define PR_OUT(i, a) if (PROBE_SEL == (i) && blockIdx.x == 0 && threadIdx.x == 0) *(volatile float*)(F.ws + WS_CTL + 40000) = (float)(a) * 1e-4f;
#define PR_OUT4(i, a) if (PROBE_SEL == (i) && blockIdx.x == 0 && threadIdx.x == 256) *(volatile float*)(F.ws + WS_CTL + 40000) = (float)(a) * 1e-4f;
#else
#define PR_T(v)
#define PR_ACC(a, d)
#define PR_OUT(i, a)
#define PR_OUT4(i, a)
#endif
constexpr int S5V_BU = 0, S5V_BUP = 2056, S5V_BUSZ = 16 * S5V_BUP, S5V_XT = 2 * S5V_BUSZ, S5V_XTP = 1040, S5V_XTSZ = 16 * S5V_XTP, S5V_VS = S5V_XT + 2 * S5V_XTSZ, S5V_OT = S5V_VS + 4 * 512, S5V_OTP = 144, S5V_OTSZ = 16 * S5V_OTP, S5V_END = S5V_OT + 2 * S5V_OTSZ;
static_assert(S5V_END <= LDS_MAIN, "S5 v2 LDS map");
__device__ __forceinline__ void p3_s5v2(Frame& F) {
    const int tid = threadIdx.x, lane = tid & 63, w = __builtin_amdgcn_readfirstlane(tid >> 6);
    const int li = lane & 15, lq = lane >> 4;
    LAS unsigned char* L = F.lds;
    const bf16* proj = WSP(bf16, WS_PROJ);
    constexpr int NT = SEQ / 16;
#ifdef PROBE_S5
    const unsigned long long pr_t0 = PROBE_CLOCK();
#endif
    for (int item = F.vcu; item < NB * 16; item += F.G) {
        const int b = item >> 4, gs = item & 15;
        const bool scanw = w < 4; const int gl = w & 3, g = gs * 4 + gl;
        const bf16* ubase = proj + (size_t)b * SEQ * NPROJ + 3072 + gs * 64 + gl * 16;
        __syncthreads();
        if (scanw) {
            __builtin_amdgcn_s_setprio(2);
            const float lbr = WSP(float, WS_S5LB)[(g * 64 + lane) * 2], lbi = WSP(float, WS_S5LB)[(g * 64 + lane) * 2 + 1], nlbi = -lbi;
            bf16x8 bfr[8];
#pragma unroll
            for (int cb = 0; cb < 8; ++cb) { v4u v = (v4u){0u, 0u, 0u, 0u};
                if (lq < 2) { const int col = 16 * cb + li; const float* src = WSP(float, WS_S5BB) + (g * 64 + (col >> 1)) * 32 + (col & 1) * 16 + 8 * lq; const f32x4 a0 = *(const f32x4*)src, a1 = *(const f32x4*)(src + 4);
                    v = (v4u){pk2(a0[0], a0[1]), pk2(a0[2], a0[3]), pk2(a1[0], a1[1]), pk2(a1[2], a1[3])}; }
                bfr[cb] = __builtin_bit_cast(bf16x8, v); }
            float xr = 0.f, xi = 0.f;
            const int lq2 = lq & 1;
            v4u ua = *(const v4u*)(ubase + (size_t)li * NPROJ + 8 * lq2);
            { const bf16x8 af = __builtin_bit_cast(bf16x8, lq < 2 ? ua : (v4u){0u, 0u, 0u, 0u});
              ua = *(const v4u*)(ubase + (size_t)(16 + li) * NPROJ + 8 * lq2);
#pragma unroll
              for (int cb = 0; cb < 8; ++cb) { f32x4 acc = (f32x4){0.f, 0.f, 0.f, 0.f}; acc = __builtin_amdgcn_mfma_f32_16x16x32_bf16(af, bfr[cb], acc, 0, 0, 0);
#pragma unroll
                  for (int r = 0; r < 4; ++r) *(LAS float*)(L + S5V_BU + (4 * lq + r) * S5V_BUP + (gl * 128 + 16 * cb + li) * 4) = acc[r]; } }
            LDS_BARRIER();
            unsigned long long pa0 = 0, pa1 = 0, pa2 = 0;
            for (int k = 0; k <= NT; ++k) {
                PR_T(pt0)
                if (k < NT) {
                    const LAS f32x2* bp = (const LAS f32x2*)(L + S5V_BU + (k & 1) * S5V_BUSZ + (gl * 128 + 2 * lane) * 4);
                    LAS unsigned* xp = (LAS unsigned*)(L + S5V_XT + (k & 1) * S5V_XTSZ + (gl * 128 + 2 * lane) * 2);
                    f32x2 bu[16];
#pragma unroll
                    for (int t = 0; t < 16; ++t) bu[t] = bp[t * (S5V_BUP / 8)];
                    unsigned xo[16];
#pragma unroll
                    for (int t = 0; t < 16; ++t) {
                        const float a = __builtin_fmaf(nlbi, xi, bu[t][0]), bq = __builtin_fmaf(lbi, xr, bu[t][1]);
                        const float nr = __builtin_fmaf(lbr, xr, a), ni = __builtin_fmaf(lbr, xi, bq); xr = nr; xi = ni; xo[t] = pk2(xr, xi); }
#pragma unroll
                    for (int t = 0; t < 16; ++t) xp[t * (S5V_XTP / 4)] = xo[t];
                    PR_T(pt1) PR_ACC(pa0, pt1 - pt0)
                    if (k + 1 < NT) {
                        const bf16x8 af = __builtin_bit_cast(bf16x8, lq < 2 ? ua : (v4u){0u, 0u, 0u, 0u});
                        { const int kn = k + 2 < NT ? k + 2 : NT - 1; ua = *(const v4u*)(ubase + (size_t)(16 * kn + li) * NPROJ + 8 * lq2); }
                        LAS unsigned char* bun = L + S5V_BU + ((k + 1) & 1) * S5V_BUSZ;
#pragma unroll
                        for (int cb = 0; cb < 8; ++cb) { f32x4 acc = (f32x4){0.f, 0.f, 0.f, 0.f}; acc = __builtin_amdgcn_mfma_f32_16x16x32_bf16(af, bfr[cb], acc, 0, 0, 0);
#pragma unroll
                            for (int r = 0; r < 4; ++r) *(LAS float*)(bun + (4 * lq + r) * S5V_BUP + (gl * 128 + 16 * cb + li) * 4) = acc[r]; }
                    }
                }
                PR_T(pt2) PR_ACC(pa1, pt2 - pt0)
                LDS_BARRIER();
                PR_T(pt3) PR_ACC(pa2, pt3 - pt2)
            }
            __builtin_amdgcn_s_setprio(0);
            PR_OUT(0, pa0) PR_OUT(1, pa1) PR_OUT(2, pa2)
        } else {
            bf16x8 cfr[4];
#pragma unroll
            for (int ks = 0; ks < 4; ++ks) { const float* cr = (F.a->in[17]) + (g * 16 + li) * 64 + 16 * ks + 4 * lq; const float* ci = (F.a->in[18]) + (g * 16 + li) * 64 + 16 * ks + 4 * lq;
                const f32x4 r0 = *(const f32x4*)cr, i0 = *(const f32x4*)ci;
                cfr[ks] = __builtin_bit_cast(bf16x8, ((v4u){pk2(r0[0], -i0[0]), pk2(r0[1], -i0[1]), pk2(r0[2], -i0[2]), pk2(r0[3], -i0[3])})); }
            v4u gwv = (v4u){0u, 0u, 0u, 0u};
            if (lq < 2) { float gwf[8];
#pragma unroll
                for (int j = 0; j < 8; ++j) gwf[j] = (F.a->in[20])[(g * 16 + 8 * lq + j) * 16 + li];
                gwv = (v4u){pk2(gwf[0], gwf[1]), pk2(gwf[2], gwf[3]), pk2(gwf[4], gwf[5]), pk2(gwf[6], gwf[7])}; }
            const bf16x8 gfr = __builtin_bit_cast(bf16x8, gwv);
            const float dsk = (F.a->in[19])[g * 16 + li], gbias = (F.a->in[21])[g * 16 + li];
            LAS unsigned char* vs = L + S5V_VS + gl * 512;
            float uo[4], un[4];
#pragma unroll
            for (int r = 0; r < 4; ++r) { uo[r] = bf2f(ubase[(size_t)(4 * lq + r) * NPROJ + li]); un[r] = bf2f(ubase[(size_t)(16 + 4 * lq + r) * NPROJ + li]); }
            LDS_BARRIER();
            unsigned long long pb0 = 0, pb1 = 0;
            for (int k = 0; k <= NT; ++k) {
                PR_T(qt0)
                float u2[4];
                { const int kn = k + 1 < NT ? k + 1 : NT - 1;
#pragma unroll
                  for (int r = 0; r < 4; ++r) u2[r] = bf2f(ubase[(size_t)(16 * kn + 4 * lq + r) * NPROJ + li]); }
                if (k >= 2) {
                    const int t = ((tid - 256) >> 3) & 15, oc = tid & 7; const v4u ov = *(const LAS v4u*)(L + S5V_OT + (k & 1) * S5V_OTSZ + t * S5V_OTP + 16 * oc);
                    if (tid < 384) *(v4u*)(WSP(bf16, WS_Y) + ((size_t)b * SEQ + 16 * (k - 2) + t) * 2048 + 1024 + gs * 64 + 8 * oc) = ov; }
                if (k >= 1) {
                    const int kt = k - 1; const LAS unsigned char* xt = L + S5V_XT + (kt & 1) * S5V_XTSZ;
                    f32x4 yacc = (f32x4){0.f, 0.f, 0.f, 0.f};
#pragma unroll
                    for (int ks = 0; ks < 4; ++ks) yacc = __builtin_amdgcn_mfma_f32_16x16x32_bf16(*(const LAS bf16x8*)(xt + li * S5V_XTP + (gl * 128 + 32 * ks + 8 * lq) * 2), cfr[ks], yacc, 0, 0, 0);
                    float v[4];
                    { const f32x2 g0 = gelu_pk2((f32x2){yacc[0] + dsk * uo[0], yacc[1] + dsk * uo[1]}), g1 = gelu_pk2((f32x2){yacc[2] + dsk * uo[2], yacc[3] + dsk * uo[3]}); v[0] = g0[0]; v[1] = g0[1]; v[2] = g1[0]; v[3] = g1[1]; }
#pragma unroll
                    for (int r = 0; r < 4; ++r) *(LAS unsigned short*)(vs + (4 * lq + r) * 32 + li * 2) = (unsigned short)f2bf(v[r]);
                    LDS_WAIT(); asm volatile("" ::: "memory");
                    v4u va = (v4u){0u, 0u, 0u, 0u};
                    if (lq < 2) va = *(const LAS v4u*)(vs + li * 32 + 16 * lq);
                    f32x4 gacc = (f32x4){0.f, 0.f, 0.f, 0.f};
                    gacc = __builtin_amdgcn_mfma_f32_16x16x32_bf16(__builtin_bit_cast(bf16x8, va), gfr, gacc, 0, 0, 0);
                    float o[4], ss[4];
#pragma unroll
                    for (int r = 0; r < 4; ++r) { o[r] = v[r] * sigmoid_f(gacc[r] + gbias); ss[r] = o[r] * o[r]; }
#pragma unroll
                    for (int r = 0; r < 4; ++r) ss[r] = row16_sum_to15(ss[r]);
                    if (li == 15) {
#pragma unroll
                        for (int r = 0; r < 4; ++r) WSP(float, WS_STS5)[((size_t)b * SEQ + 16 * kt + 4 * lq + r) * NS5PART + g] = ss[r]; }
                    LAS unsigned char* ot = L + S5V_OT + (kt & 1) * S5V_OTSZ;
#pragma unroll
                    for (int r = 0; r < 4; ++r) *(LAS unsigned short*)(ot + (4 * lq + r) * S5V_OTP + (gl * 16 + li) * 2) = (unsigned short)f2bf(o[r]);
#pragma unroll
                    for (int r = 0; r < 4; ++r) { uo[r] = un[r]; un[r] = u2[r]; }
                }
                PR_T(qt1) PR_ACC(pb0, qt1 - qt0)
                LDS_BARRIER();
                PR_T(qt2) PR_ACC(pb1, qt2 - qt1)
            }
            PR_OUT4(3, pb0) PR_OUT4(4, pb1)
            { const int t = ((tid - 256) >> 3) & 15, oc = tid & 7; const v4u ov = *(const LAS v4u*)(L + S5V_OT + ((NT - 1) & 1) * S5V_OTSZ + t * S5V_OTP + 16 * oc);
              if (tid < 384) *(v4u*)(WSP(bf16, WS_Y) + ((size_t)b * SEQ + 16 * (NT - 1) + t) * 2048 + 1024 + gs * 64 + 8 * oc) = ov; }
        }
    }
#ifdef PROBE_S5
    if (blockIdx.x == 0 && threadIdx.x == 0) *(volatile float*)(F.ws + WS_CTL + 40000) = (float)(PROBE_CLOCK() - pr_t0) * PROBE_SCALE;
#endif
}
__device__ __forceinline__ unsigned med3u(unsigned a, unsigned b, unsigned c) { unsigned r; asm("v_med3_u32 %0, %1, %2, %3" : "=v"(r) : "v"(a), "v"(b), "v"(c)); return r; }
__device__ __forceinline__ unsigned fkey(float v) { const unsigned u = __builtin_bit_cast(unsigned, v); return (u & 0x80000000u) ? ~u : (u | 0x80000000u); }
__device__ __forceinline__ float fkey_inv(unsigned k) { const unsigned u = (k & 0x80000000u) ? (k & 0x7fffffffu) : ~k; return __builtin_bit_cast(float, u); }
#define TOPK_INSERT(a, x) do { _Pragma("unroll") for (int _i = 15; _i >= 1; --_i) a[_i] = med3u(a[_i - 1], a[_i], (x)); a[0] = a[0] > (x) ? a[0] : (x); } while (0)
__device__ __forceinline__ unsigned fp6_code(float y) {
    const float a = fabsf(y);
    const float c = a < 2.0f ? __builtin_rintf(8.0f * a) : (a < 4.0f ? __builtin_rintf(4.0f * a) + 8.0f : fminf(__builtin_rintf(2.0f * a) + 16.0f, 31.0f));
    return (unsigned)c | (y < 0.f ? 32u : 0u);
}
__device__ __forceinline__ void fp6_pack16(const unsigned* c, unsigned& w0, unsigned& w1, unsigned& w2) {
    w0 = c[0] | (c[1] << 6) | (c[2] << 12) | (c[3] << 18) | (c[4] << 24) | (c[5] << 30);
    w1 = (c[5] >> 2) | (c[6] << 4) | (c[7] << 10) | (c[8] << 16) | (c[9] << 22) | (c[10] << 28);
    w2 = (c[10] >> 4) | (c[11] << 2) | (c[12] << 8) | (c[13] << 14) | (c[14] << 20) | (c[15] << 26);
}
__device__ __forceinline__ void h2_convert(Frame& F, int w0, int nw, int f_lane) {
    for (int tb = w0 * 16; tb < MTOK; tb += nw * 16) {
        const float* sh = WSP(float, WS_MOD) + (size_t)(tb >> 11) * 6144 + 3072 + 16 * f_lane;
        float S2[16];
#pragma unroll
        for (int q = 0; q < 4; ++q) { const f32x4 s4 = *(const f32x4*)(sh + 4 * q); S2[4 * q] = s4[0]; S2[4 * q + 1] = s4[1]; S2[4 * q + 2] = s4[2]; S2[4 * q + 3] = s4[3]; }
#pragma unroll 1
        for (int k = 0; k < 16; k += 4) {
            v4u xa[4], xb[4]; float rst[4];
#pragma unroll
            for (int u = 0; u < 4; ++u) { const int t = tb + k + u; const char* xs = (const char*)(WSP(bf16, WS_X1S) + (size_t)t * 1024) + 32 * f_lane; xa[u] = *(const v4u*)xs; xb[u] = *(const v4u*)(xs + 16); rst[u] = WSP(float, WS_ROWSTAT)[t]; }
#pragma unroll
            for (int u = 0; u < 4; ++u) { const int t = tb + k + u;
                const float rs = rsqrt_f(rst[u] * (1.0f / 1024.0f) + EPSF);
                float h2[16]; unpack8(xa[u], h2); unpack8(xb[u], h2 + 8); float mx = 0.f;
#pragma unroll
                for (int i = 0; i < 16; ++i) { h2[i] = h2[i] * rs + S2[i]; mx = fmaxf(mx, fabsf(h2[i])); }
#pragma unroll
                for (int o = 1; o < 64; o <<= 1) mx = fmaxf(mx, __shfl_xor(mx, o));
                mx = fmaxf(mx, 1e-30f); const float hs = 224.0f / mx;
                v4u w;
#pragma unroll
                for (int q = 0; q < 4; ++q) { int pk = 0; pk = __builtin_amdgcn_cvt_pk_fp8_f32(h2[4 * q] * hs, h2[4 * q + 1] * hs, pk, false); pk = __builtin_amdgcn_cvt_pk_fp8_f32(h2[4 * q + 2] * hs, h2[4 * q + 3] * hs, pk, true); w[q] = (unsigned)pk; }
                *(v4u*)(F.ws + WS_H2Q + (size_t)t * 1024 + 16 * f_lane) = w;
                if (f_lane == 0) WSP(float, WS_HINV)[t] = mx * (1.0f / 224.0f); }
        }
    }
}
__device__ __forceinline__ void expert_convert(Frame& F, int w0, int nw, int f_lane) {
    for (int rw = w0; rw < 2 * 16384; rw += 2 * nw) {
        f32x4 v[2][4]; float mx[2];
#pragma unroll
        for (int u = 0; u < 2; ++u) { const int r = rw + u * nw; const int tb = r >= 16384, e = tb ? r - 16384 : r; const float* src = (tb ? (F.a->in[28]) : (F.a->in[27])) + (size_t)e * 1024 + 16 * f_lane;
#pragma unroll
            for (int q = 0; q < 4; ++q) v[u][q] = *(const f32x4*)(src + 4 * q); }
#pragma unroll
        for (int u = 0; u < 2; ++u) { float m = 0.f;
#pragma unroll
            for (int q = 0; q < 4; ++q) m = fmaxf(m, fmaxf(fmaxf(fabsf(v[u][q][0]), fabsf(v[u][q][1])), fmaxf(fabsf(v[u][q][2]), fabsf(v[u][q][3]))));
#pragma unroll
            for (int o = 1; o < 64; o <<= 1) m = fmaxf(m, __shfl_xor(m, o));
            mx[u] = fmaxf(m, 1e-30f); }
#ifdef HWENC
        {
            typedef float f32x16 __attribute__((ext_vector_type(16))); typedef unsigned v6u_t __attribute__((ext_vector_type(6)));
            const float sa = 7.5f / mx[0], sb = 7.5f / mx[1]; f32x16 s0, s1;
#pragma unroll
            for (int i = 0; i < 8; ++i) {
#ifdef HWENC_SEQ
                s0[i] = v[0][i >> 2][i & 3] * sa; s0[8 + i] = v[0][2 + (i >> 2)][i & 3] * sa; s1[i] = v[1][i >> 2][i & 3] * sb; s1[8 + i] = v[1][2 + (i >> 2)][i & 3] * sb;
#else
                s0[i] = v[0][(2 * i) >> 2][(2 * i) & 3] * sa; s1[i] = v[0][(2 * i + 1) >> 2][(2 * i + 1) & 3] * sa; s0[8 + i] = v[1][(2 * i) >> 2][(2 * i) & 3] * sb; s1[8 + i] = v[1][(2 * i + 1) >> 2][(2 * i + 1) & 3] * sb;
#endif
            }
            const v6u_t enc = __builtin_amdgcn_cvt_scalef32_2xpk16_fp6_f32(s0, s1, 1.0f);
#pragma unroll
            for (int u = 0; u < 2; ++u) { const int r = rw + u * nw; const int tb = r >= 16384, e = tb ? r - 16384 : r;
                unsigned* dst = (unsigned*)(F.ws + (tb ? WS_EV : WS_EU) + (size_t)e * 768 + 12 * f_lane); dst[0] = enc[3 * u]; dst[1] = enc[3 * u + 1]; dst[2] = enc[3 * u + 2];
                if (f_lane == 0) WSP(float, tb ? WS_EVS : WS_EUS)[e] = mx[u] * (1.0f / 7.5f); }
            continue;
        }
#endif
#pragma unroll
        for (int u = 0; u < 2; ++u) { const int r = rw + u * nw; const int tb = r >= 16384, e = tb ? r - 16384 : r; const float sc = 224.0f / mx[u];
            v4u w;
#pragma unroll
            for (int q = 0; q < 4; ++q) { int pk = 0; pk = __builtin_amdgcn_cvt_pk_fp8_f32(v[u][q][0] * sc, v[u][q][1] * sc, pk, false); pk = __builtin_amdgcn_cvt_pk_fp8_f32(v[u][q][2] * sc, v[u][q][3] * sc, pk, true); w[q] = (unsigned)pk; }
#ifdef V6
#if defined(UP12) || defined(UP14) || defined(UP15) || defined(UP16)
            {
#else
            if (tb) {
#endif
                const float s6 = 7.5f / mx[u]; unsigned cd[16];
#pragma unroll
                for (int q = 0; q < 4; ++q)
#pragma unroll
                    for (int i = 0; i < 4; ++i) cd[4 * q + i] = fp6_code(v[u][q][i] * s6);
                unsigned w0, w1, w2; fp6_pack16(cd, w0, w1, w2);
#ifdef UP15
                if (!tb) {
                    unsigned char* rowp = F.ws + WS_EU + (size_t)e * 768 + 16 * (f_lane >> 3); const int d0 = 3 * (f_lane & 7);
                    *(unsigned*)(rowp + 128 * (d0 >> 2) + 4 * (d0 & 3)) = w0; *(unsigned*)(rowp + 128 * ((d0 + 1) >> 2) + 4 * ((d0 + 1) & 3)) = w1; *(unsigned*)(rowp + 128 * ((d0 + 2) >> 2) + 4 * ((d0 + 2) & 3)) = w2;
                    if (f_lane == 0) WSP(float, WS_EUS)[e] = mx[u] * (1.0f / 7.5f);
                    continue; }
#endif
                unsigned* dst = (unsigned*)(F.ws + (tb ? WS_EV : WS_EU) + (size_t)e * 768 + 12 * f_lane); dst[0] = w0; dst[1] = w1; dst[2] = w2;
                if (f_lane == 0) WSP(float, tb ? WS_EVS : WS_EUS)[e] = mx[u] * (1.0f / 7.5f);
                continue; }
#endif
            *(v4u*)(F.ws + (tb ? WS_EV : WS_EU) + (size_t)e * 1024 + 16 * f_lane) = w;
            if (f_lane == 0) WSP(float, tb ? WS_EVS : WS_EUS)[e] = mx[u] * (1.0f / 224.0f); }
    }
}
__device__ __forceinline__ void p5b_topk(Frame& F) {
    const int f_tid = threadIdx.x, f_lane = f_tid & 63, f_wave = __builtin_amdgcn_readfirstlane(f_tid >> 6);
    const _Float16* scores = WSP(_Float16, WS_SCORES);
    LAS unsigned char* ix = (LAS unsigned char*)F.lds + f_tid * 36;
#pragma unroll 1
    for (int half = 0; half < 2; ++half) {
#ifdef UP11
    if ((f_wave >> 2) != half) { expert_convert(F, (F.vcu * 4 + (f_wave & 3)) * 2 + half, F.G * 8, f_lane); h2_convert(F, (F.vcu * 4 + (f_wave & 3)) * 2 + half, F.G * 8, f_lane); continue; }
#else
    if ((f_wave >> 2) != half) { expert_convert(F, (F.vcu * 4 + (f_wave & 3)) * 2 + half, F.G * 8, f_lane); continue; }
#endif
    typedef _Float16 f16x8 __attribute__((ext_vector_type(8)));
    f16x8 sva[8], svb[8];
    { const int item0 = (F.vcu * 2 + half) * 256 + (f_tid & 255); const _Float16* sp0 = scores + (size_t)(item0 >> 3) * 2048 + (item0 & 7) * 256;
#pragma unroll
      for (int q = 0; q < 8; ++q) sva[q] = *(const f16x8*)(sp0 + 8 * q); }
#pragma unroll 1
    for (int item = (F.vcu * 2 + half) * 256 + (f_tid & 255); item < MTOK * PH; item += F.G * 512) {
        const int t = item >> 3, hd = item & 7;
        unsigned a1[16], a2[16];
#pragma unroll
        for (int i = 0; i < 16; ++i) { a1[i] = 0u; a2[i] = 0u; }
        const _Float16* sp = scores + (size_t)t * 2048 + hd * 256;
        const int itn = (item + F.G * 512 < MTOK * PH) ? item + F.G * 512 : item;
        const _Float16* spn = scores + (size_t)(itn >> 3) * 2048 + (itn & 7) * 256;
#define TK_BATCH(CUR, NXT, NP, A, M) { \
        { _Pragma("unroll") for (int q = 0; q < 8; ++q) NXT[q] = *(const f16x8*)((NP) + 8 * q); } \
        __builtin_amdgcn_sched_barrier(0); \
        _Pragma("unroll") for (int q = 0; q < 8; ++q) { _Pragma("unroll") for (int e = 0; e < 8; ++e) { const unsigned k = (fkey((float)CUR[q][e]) & ~127u) | (unsigned)(127 - (64 * (M) + 8 * q + e)); TOPK_INSERT(A, k); } } }
        TK_BATCH(sva, svb, sp + 64, a1, 0)
        TK_BATCH(svb, sva, sp + 128, a1, 1)
        TK_BATCH(sva, svb, sp + 192, a2, 0)
        TK_BATCH(svb, sva, spn, a2, 1)
#undef TK_BATCH
        float v1[16], v2[16];
#pragma unroll
        for (int i = 0; i < 16; ++i) { ix[i] = (unsigned char)(127u - (a1[i] & 127u)); ix[16 + i] = (unsigned char)(127u - (a2[i] & 127u)); v1[i] = fkey_inv(a1[i] & ~127u); v2[i] = fkey_inv(a2[i] & ~127u); }
        unsigned cb[16];
#pragma unroll
        for (int i = 0; i < 16; ++i) cb[i] = 0u;
#pragma unroll
        for (int i = 0; i < 16; ++i)
#pragma unroll
            for (int j = 0; j < 16; ++j) if ((i + 1) * (j + 1) <= 16) { const unsigned k = (fkey(v1[i] + v2[j]) & ~255u) | (unsigned)(255 - (i * 16 + j)); TOPK_INSERT(cb, k); }
        float tv[16]; float mx = -3.0e38f;
#pragma unroll
        for (int k = 0; k < 16; ++k) { tv[k] = fkey_inv(cb[k] & ~255u); mx = fmaxf(mx, tv[k]); }
        float sum = 0.f;
#pragma unroll
        for (int k = 0; k < 16; ++k) { tv[k] = __expf(tv[k] - mx); sum += tv[k]; }
        const float inv = 1.0f / sum;
        LDS_WAIT(); asm volatile("" ::: "memory");
        int ev[16]; unsigned long long c64 = 0ull;
#pragma unroll
        for (int k = 0; k < 16; ++k) { const unsigned code = 255u - (cb[k] & 255u); const int i = code >> 4, j = code & 15; ev[k] = (int)ix[i] * 128 + (int)ix[16 + j]; c64 += 1ull << (8 * (ev[k] >> 11)); }
        unsigned long long s64 = c64;
#pragma unroll
        for (int o = 1; o < 8; o <<= 1) { const unsigned lo = __shfl_up((unsigned)s64, o, 8), hi = __shfl_up((unsigned)(s64 >> 32), o, 8); if ((f_lane & 7) >= o) s64 += ((unsigned long long)hi << 32) | lo; }
        const unsigned long long e64 = s64 - c64;
        const unsigned long long t64 = ((unsigned long long)__shfl((unsigned)(s64 >> 32), 7, 8) << 32) | __shfl((unsigned)s64, 7, 8);
        const unsigned long long st64 = (t64 * 0x0101010101010101ull) << 8;
        unsigned long long base64 = st64 + e64;
        int* eo = WSP(int, WS_EID) + (size_t)t * 128; float* go = WSP(float, WS_GATE) + (size_t)t * 128;
#pragma unroll
        for (int k = 0; k < 16; ++k) { const int r8 = 8 * (ev[k] >> 11); const int slot = (int)((base64 >> r8) & 255ull); base64 += 1ull << r8; eo[slot] = ev[k]; go[slot] = tv[k] * inv; }
        if (hd == 0) WSP(unsigned long long, WS_START)[t] = st64;
        LDS_WAIT(); asm volatile("" ::: "memory");
    }
    }
}
__device__ __forceinline__ void dec16(const v4u q, float* f) {
#pragma unroll
    for (int i = 0; i < 4; ++i) { const f32x2 lo = __builtin_amdgcn_cvt_pk_f32_fp8((int)q[i], false), hi = __builtin_amdgcn_cvt_pk_f32_fp8((int)q[i], true); f[4 * i] = lo[0]; f[4 * i + 1] = lo[1]; f[4 * i + 2] = hi[0]; f[4 * i + 3] = hi[1]; }
}
struct CvE { f32x4 v[4]; };
struct CvH { v4u xa, xb; float rst; };
__device__ __forceinline__ void cve_load(CvE& c, Frame& F, int r, int f_lane) {
    const int tb = r >= 16384, e = tb ? r - 16384 : r; const float* src = (tb ? (F.a->in[28]) : (F.a->in[27])) + (size_t)e * 1024 + 16 * f_lane;
#pragma unroll
    for (int q = 0; q < 4; ++q) c.v[q] = *(const f32x4*)(src + 4 * q);
}
__device__ __forceinline__ void cve_finish(const CvE& c, Frame& F, int r, int f_lane) {
    const int tb = r >= 16384, e = tb ? r - 16384 : r; float m = 0.f;
#pragma unroll
    for (int q = 0; q < 4; ++q) m = fmaxf(m, fmaxf(fmaxf(fabsf(c.v[q][0]), fabsf(c.v[q][1])), fmaxf(fabsf(c.v[q][2]), fabsf(c.v[q][3]))));
#pragma unroll
    for (int o = 1; o < 64; o <<= 1) m = fmaxf(m, __shfl_xor(m, o));
    m = fmaxf(m, 1e-30f); const float sc = 224.0f / m;
    v4u w;
#pragma unroll
    for (int q = 0; q < 4; ++q) { int pk = 0; pk = __builtin_amdgcn_cvt_pk_fp8_f32(c.v[q][0] * sc, c.v[q][1] * sc, pk, false); pk = __builtin_amdgcn_cvt_pk_fp8_f32(c.v[q][2] * sc, c.v[q][3] * sc, pk, true); w[q] = (unsigned)pk; }
    *(v4u*)(F.ws + (tb ? WS_EV : WS_EU) + (size_t)e * 1024 + 16 * f_lane) = w;
    if (f_lane == 0) WSP(float, tb ? WS_EVS : WS_EUS)[e] = m * (1.0f / 224.0f);
}
__device__ __forceinline__ void cvh_load(CvH& c, Frame& F, int t, int f_lane) {
    const char* xs = (const char*)(WSP(bf16, WS_X1S) + (size_t)t * 1024) + 32 * f_lane; c.xa = *(const v4u*)xs; c.xb = *(const v4u*)(xs + 16); c.rst = WSP(float, WS_ROWSTAT)[t];
}
__device__ __forceinline__ void cvh_finish(const CvH& c, Frame& F, int t, int f_lane, const float* S2) {
    const float rs = rsqrt_f(c.rst * (1.0f / 1024.0f) + EPSF);
    float h2[16]; unpack8(c.xa, h2); unpack8(c.xb, h2 + 8); float mx = 0.f;
#pragma unroll
    for (int i = 0; i < 16; ++i) { h2[i] = h2[i] * rs + S2[i]; mx = fmaxf(mx, fabsf(h2[i])); }
#pragma unroll
    for (int o = 1; o < 64; o <<= 1) mx = fmaxf(mx, __shfl_xor(mx, o));
    mx = fmaxf(mx, 1e-30f); const float hs = 224.0f / mx;
    v4u w;
#pragma unroll
    for (int q = 0; q < 4; ++q) { int pk = 0; pk = __builtin_amdgcn_cvt_pk_fp8_f32(h2[4 * q] * hs, h2[4 * q + 1] * hs, pk, false); pk = __builtin_amdgcn_cvt_pk_fp8_f32(h2[4 * q + 2] * hs, h2[4 * q + 3] * hs, pk, true); w[q] = (unsigned)pk; }
    *(v4u*)(F.ws + WS_H2Q + (size_t)t * 1024 + 16 * f_lane) = w;
    if (f_lane == 0) WSP(float, WS_HINV)[t] = mx * (1.0f / 224.0f);
}
__device__ __forceinline__ void p5b_topk2(Frame& F) {
    const int f_tid = threadIdx.x, f_lane = f_tid & 63, f_wave = __builtin_amdgcn_readfirstlane(f_tid >> 6);
    const _Float16* scores = WSP(_Float16, WS_SCORES);
    LAS unsigned char* ix = (LAS unsigned char*)F.lds + f_tid * 36;
    const int gw = F.vcu * NWAVES + f_wave;
    static_assert(MTOK * PH == 2 * 256 * NTHR && MTOK == 16 * 256 * NWAVES, "P7 v2 work split");
    float S2[16];
    { const float* sh = WSP(float, WS_MOD) + (size_t)((gw * 16) >> 11) * 6144 + 3072 + 16 * f_lane;
#pragma unroll
      for (int q = 0; q < 4; ++q) { const f32x4 s4 = *(const f32x4*)(sh + 4 * q); S2[4 * q] = s4[0]; S2[4 * q + 1] = s4[1]; S2[4 * q + 2] = s4[2]; S2[4 * q + 3] = s4[3]; } }
    typedef _Float16 f16x8 __attribute__((ext_vector_type(8)));
    const int item_base = F.vcu * NTHR + f_tid, item_step = F.G * NTHR;
    f16x8 sva[8], svb[8];
    { const _Float16* sp0 = scores + (size_t)(item_base >> 3) * 2048 + (item_base & 7) * 256;
#pragma unroll
      for (int q = 0; q < 8; ++q) sva[q] = *(const f16x8*)(sp0 + 8 * q); }
    unsigned a1[16];
#pragma unroll
    for (int i = 0; i < 16; ++i) a1[i] = 0u;
#pragma unroll 1
    for (int hi = 0; hi < 4; ++hi) {
        const int item = item_base + (hi >> 1) * item_step; const int t = item >> 3, hd = item & 7, kh = hi & 1;
        const _Float16* sp = scores + (size_t)t * 2048 + hd * 256 + kh * 128;
        const int hn = hi < 3 ? hi + 1 : hi; const int itn = item_base + (hn >> 1) * item_step;
        const _Float16* spn = scores + (size_t)(itn >> 3) * 2048 + (itn & 7) * 256 + (hn & 1) * 128;
        unsigned a2[16];
#pragma unroll
        for (int i = 0; i < 16; ++i) a2[i] = 0u;
#define TK2_BATCH(CUR, NXT, NP, M) { \
        const int ku = 2 * (2 * hi + (M)); CvE e0, e1; CvH h0, h1; \
        { _Pragma("unroll") for (int q = 0; q < 8; ++q) NXT[q] = *(const f16x8*)((NP) + 8 * q); } \
        cve_load(e0, F, gw + ku * 2048, f_lane); cve_load(e1, F, gw + (ku + 1) * 2048, f_lane); cvh_load(h0, F, gw * 16 + ku, f_lane); cvh_load(h1, F, gw * 16 + ku + 1, f_lane); \
        __builtin_amdgcn_sched_barrier(0); \
        _Pragma("unroll") for (int q = 0; q < 8; ++q) { _Pragma("unroll") for (int e = 0; e < 8; ++e) { const unsigned k = (fkey((float)CUR[q][e]) & ~127u) | (unsigned)(127 - (64 * (M) + 8 * q + e)); TOPK_INSERT(a2, k); } } \
        __builtin_amdgcn_sched_barrier(0); \
        cve_finish(e0, F, gw + ku * 2048, f_lane); cve_finish(e1, F, gw + (ku + 1) * 2048, f_lane); cvh_finish(h0, F, gw * 16 + ku, f_lane, S2); cvh_finish(h1, F, gw * 16 + ku + 1, f_lane, S2); \
        __builtin_amdgcn_sched_barrier(0); }
        TK2_BATCH(sva, svb, sp + 64, 0)
        TK2_BATCH(svb, sva, spn, 1)
#undef TK2_BATCH
        if (kh == 0) {
#pragma unroll
            for (int i = 0; i < 16; ++i) a1[i] = a2[i];
            continue;
        }
        float v1[16], v2[16];
#pragma unroll
        for (int i = 0; i < 16; ++i) { ix[i] = (unsigned char)(127u - (a1[i] & 127u)); ix[16 + i] = (unsigned char)(127u - (a2[i] & 127u)); v1[i] = fkey_inv(a1[i] & ~127u); v2[i] = fkey_inv(a2[i] & ~127u); }
        unsigned cb[16];
#pragma unroll
        for (int i = 0; i < 16; ++i) cb[i] = 0u;
#pragma unroll
        for (int i = 0; i < 16; ++i)
#pragma unroll
            for (int j = 0; j < 16; ++j) if ((i + 1) * (j + 1) <= 16) { const unsigned k = (fkey(v1[i] + v2[j]) & ~255u) | (unsigned)(255 - (i * 16 + j)); TOPK_INSERT(cb, k); }
        float tv[16]; float mx = -3.0e38f;
#pragma unroll
        for (int k = 0; k < 16; ++k) { tv[k] = fkey_inv(cb[k] & ~255u); mx = fmaxf(mx, tv[k]); }
        float sum = 0.f;
#pragma unroll
        for (int k = 0; k < 16; ++k) { tv[k] = __expf(tv[k] - mx); sum += tv[k]; }
        const float inv = 1.0f / sum;
        LDS_WAIT(); asm volatile("" ::: "memory");
        int ev[16]; unsigned long long c64 = 0ull;
#pragma unroll
        for (int k = 0; k < 16; ++k) { const unsigned code = 255u - (cb[k] & 255u); const int i = code >> 4, j = code & 15; ev[k] = (int)ix[i] * 128 + (int)ix[16 + j]; c64 += 1ull << (8 * (ev[k] >> 11)); }
        unsigned long long s64 = c64;
#pragma unroll
        for (int o = 1; o < 8; o <<= 1) { const unsigned lo = __shfl_up((unsigned)s64, o, 8), hi2 = __shfl_up((unsigned)(s64 >> 32), o, 8); if ((f_lane & 7) >= o) s64 += ((unsigned long long)hi2 << 32) | lo; }
        const unsigned long long e64 = s64 - c64;
        const unsigned long long t64 = ((unsigned long long)__shfl((unsigned)(s64 >> 32), 7, 8) << 32) | __shfl((unsigned)s64, 7, 8);
        const unsigned long long st64 = (t64 * 0x0101010101010101ull) << 8;
        unsigned long long base64 = st64 + e64;
        int* eo = WSP(int, WS_EID) + (size_t)t * 128; float* go = WSP(float, WS_GATE) + (size_t)t * 128;
#pragma unroll
        for (int k = 0; k < 16; ++k) { const int r8 = 8 * (ev[k] >> 11); const int slot = (int)((base64 >> r8) & 255ull); base64 += 1ull << r8; eo[slot] = ev[k]; go[slot] = tv[k] * inv; }
        if (hd == 0) WSP(unsigned long long, WS_START)[t] = st64;
        LDS_WAIT(); asm volatile("" ::: "memory");
    }
}
__device__ __forceinline__ void p9_peer_down2(Frame& F) {
    const int f_tid = threadIdx.x, lane = f_tid & 63, f_wave = __builtin_amdgcn_readfirstlane(f_tid >> 6);
    const unsigned char* EV = F.ws + WS_EV;
    for (int wq = F.vcu * NWAVES + f_wave; wq < MTOK / 16; wq += F.G * NWAVES) {
        const int b = wq >> 7; const float* mb = WSP(float, WS_MOD) + (size_t)b * 6144;
        int ne_lo = WSP(int, WS_EID)[(size_t)wq * 16 * 128 + lane], ne_hi = WSP(int, WS_EID)[(size_t)wq * 16 * 128 + 64 + lane];
        float nw_lo = WSP(float, WS_GATE)[(size_t)wq * 16 * 128 + lane], nw_hi = WSP(float, WS_GATE)[(size_t)wq * 16 * 128 + 64 + lane];
        for (int tt = 0; tt < 16; ++tt) {
            const size_t t = (size_t)wq * 16 + tt;
            unsigned l16 = 16u * (unsigned)lane; asm volatile("" : "+v"(l16));
            float* xr = (float*)((char*)(F.out + t * 1024) + 4u * l16);
            const int e_lo = ne_lo, e_hi = ne_hi; const float w_lo = nw_lo, w_hi = nw_hi;
            f32x2 o[8];
#pragma unroll
            for (int i = 0; i < 8; ++i) o[i] = (f32x2){0.f, 0.f};
            v4u qa[8], qb[8];
#pragma unroll
            for (int j = 0; j < 8; ++j) { const int e = __builtin_amdgcn_readlane(e_lo, j); qa[j] = *(const v4u*)(EV + ((unsigned)e * 1024u + l16)); }
#define DN2_STEP(GRP, CUR, NXT) { \
                const int grp = (GRP); const int nb = ((grp + 1) & 7) * 8; const int ensel = (grp + 1) < 8 ? e_lo : e_hi; \
                { _Pragma("unroll") for (int j = 0; j < 8; ++j) { const int e = __builtin_amdgcn_readlane(ensel, nb + j); NXT[j] = *(const v4u*)(EV + ((unsigned)e * 1024u + l16)); } } \
                __builtin_amdgcn_sched_barrier(0); \
                const int base = (grp & 7) * 8; const float wsel = grp < 8 ? w_lo : w_hi; \
                _Pragma("unroll") for (int j = 0; j < 8; ++j) { const float wj = __builtin_bit_cast(float, __builtin_amdgcn_readlane(__builtin_bit_cast(int, wsel), base + j)); const f32x2 w2 = (f32x2){wj, wj}; \
                    _Pragma("unroll") for (int i = 0; i < 4; ++i) { const f32x2 lo = __builtin_amdgcn_cvt_pk_f32_fp8((int)CUR[j][i], false), hi = __builtin_amdgcn_cvt_pk_f32_fp8((int)CUR[j][i], true); o[2 * i] += w2 * lo; o[2 * i + 1] += w2 * hi; } } }
#pragma unroll 1
            for (int g2 = 0; g2 < 16; g2 += 2) { DN2_STEP(g2, qa, qb) DN2_STEP(g2 + 1, qb, qa) }
#undef DN2_STEP
            { const size_t tn = t + (tt < 15 ? 1 : 0); ne_lo = WSP(int, WS_EID)[tn * 128 + lane]; ne_hi = WSP(int, WS_EID)[tn * 128 + 64 + lane]; nw_lo = WSP(float, WS_GATE)[tn * 128 + lane]; nw_hi = WSP(float, WS_GATE)[tn * 128 + 64 + lane]; }
            float x1[16]; float ss = 0.f;
#pragma unroll
            for (int q4 = 0; q4 < 4; ++q4) { const f32x4 v = *(const f32x4*)(xr + 4 * q4); x1[4 * q4] = v[0]; x1[4 * q4 + 1] = v[1]; x1[4 * q4 + 2] = v[2]; x1[4 * q4 + 3] = v[3]; }
#pragma unroll
            for (int q4 = 0; q4 < 4; ++q4) { const f32x4 gt = *(const f32x4*)((const char*)(mb + 5120) + 4u * l16 + 16 * q4);
#pragma unroll
                for (int e = 0; e < 4; ++e) { const int i = 4 * q4 + e; x1[i] += gt[e] * o[i >> 1][i & 1]; ss += x1[i] * x1[i]; } }
            const float rf = rsqrt_f(wave_sum(ss) * (1.0f / 1024.0f) + EPSF);
#pragma unroll
            for (int q4 = 0; q4 < 4; ++q4) { const f32x4 nf = *(const f32x4*)((const char*)(F.a->in[29]) + 4u * l16 + 16 * q4); f32x4 v;
#pragma unroll
                for (int e = 0; e < 4; ++e) v[e] = x1[4 * q4 + e] * rf * nf[e];
                *(f32x4*)(xr + 4 * q4) = v; }
        }
    }
}
typedef long i64_t;
constexpr int U6_ROWP = 1040, U6_BUF = 8 * U6_ROWP, U6_WAVE = 2 * U6_BUF + 1024;
static_assert(8 * U6_WAVE <= LDS_MAIN, "U6 LDS map");
__device__ __forceinline__ void p8_peer_up6(Frame& F) {
    const int f_tid = threadIdx.x, lane = f_tid & 63, f_wave = __builtin_amdgcn_readfirstlane(f_tid >> 6);
    const int li = lane & 15, lq = lane >> 4;
    const unsigned char* EU = F.ws + WS_EU; const float* EUS = WSP(float, WS_EUS); const float* EVS = WSP(float, WS_EVS);
    LAS unsigned char* ring = F.lds + f_wave * U6_WAVE; LAS unsigned char* hq = ring + 2 * U6_BUF;
    for (int wq = F.vcu * NWAVES + f_wave; wq < MTOK / 16; wq += F.G * NWAVES) {
        const int b = wq >> 7; const float* mb = WSP(float, WS_MOD) + (size_t)b * 6144;
        for (int tt = 0; tt < 16; ++tt) {
            const size_t t = (size_t)wq * 16 + tt;
            unsigned l16 = 16u * (unsigned)lane; asm volatile("" : "+v"(l16));
            const int e_lo = WSP(int, WS_EID)[t * 128 + lane], e_hi = WSP(int, WS_EID)[t * 128 + 64 + lane];
            const float g_lo = WSP(float, WS_GATE)[t * 128 + lane], g_hi = WSP(float, WS_GATE)[t * 128 + 64 + lane];
            const float rs = rsqrt_f(WSP(float, WS_ROWSTAT)[t] * (1.0f / 1024.0f) + EPSF);
            const char* xs = (const char*)(WSP(bf16, WS_X1S) + t * 1024) + 2u * l16; const v4u xa = *(const v4u*)xs, xb = *(const v4u*)(xs + 16);
            asm volatile("s_waitcnt vmcnt(0)" ::: "memory");
#pragma unroll
            for (int j = 0; j < 8; ++j) { const int e = __builtin_amdgcn_readlane(e_lo, j);
                __builtin_amdgcn_global_load_lds((const unsigned*)(EU + ((unsigned)e * 1024u + l16)), (LAS unsigned*)(ring + j * U6_ROWP), 16, 0, 0); }
            const float su_lo = EUS[e_lo], su_hi = EUS[e_hi], sv_lo = EVS[e_lo], sv_hi = EVS[e_hi];
            float h2[16]; unpack8(xa, h2); unpack8(xb, h2 + 8); float mx = 0.f;
#pragma unroll
            for (int qd = 0; qd < 4; ++qd) { const f32x4 sh = *(const f32x4*)((const char*)(mb + 3072) + 4u * l16 + 16 * qd);
#pragma unroll
                for (int e = 0; e < 4; ++e) { h2[4 * qd + e] = h2[4 * qd + e] * rs + sh[e]; mx = fmaxf(mx, fabsf(h2[4 * qd + e])); } }
#pragma unroll
            for (int o = 1; o < 64; o <<= 1) mx = fmaxf(mx, __shfl_xor(mx, o));
            mx = fmaxf(mx, 1e-30f); const float hs = 224.0f / mx, hinv = mx * (1.0f / 224.0f);
            { v4u w;
#pragma unroll
              for (int qd = 0; qd < 4; ++qd) { int pk = 0; pk = __builtin_amdgcn_cvt_pk_fp8_f32(h2[4 * qd] * hs, h2[4 * qd + 1] * hs, pk, false); pk = __builtin_amdgcn_cvt_pk_fp8_f32(h2[4 * qd + 2] * hs, h2[4 * qd + 3] * hs, pk, true); w[qd] = (unsigned)pk; }
              *(LAS v4u*)(hq + l16) = w; }
            LDS_WAIT(); asm volatile("" ::: "memory");
            v4u hb[16];
#pragma unroll
            for (int c = 0; c < 16; ++c) hb[c] = *(const LAS v4u*)(hq + 64 * c + 16 * lq);
            asm volatile("s_waitcnt vmcnt(0)" ::: "memory");
            float w_lo = 0.f, w_hi = 0.f;
#pragma unroll 1
            for (int u = 0; u < 16; ++u) {
                { const int un = (u + 1) & 15; const int ensel = un < 8 ? e_lo : e_hi; const int nb = (un & 7) * 8; LAS unsigned char* dst = ring + ((u + 1) & 1) * U6_BUF;
#pragma unroll
                  for (int j = 0; j < 8; ++j) { const int e = __builtin_amdgcn_readlane(ensel, nb + j);
                      __builtin_amdgcn_global_load_lds((const unsigned*)(EU + ((unsigned)e * 1024u + l16)), (LAS unsigned*)(dst + j * U6_ROWP), 16, 0, 0); } }
                asm volatile("s_waitcnt vmcnt(8)" ::: "memory");
                const LAS unsigned char* src = ring + (u & 1) * U6_BUF + (li & 7) * U6_ROWP + 16 * lq;
                f32x4 acc = (f32x4){0.f, 0.f, 0.f, 0.f};
#ifdef HALF_READ
                v4u av[16];
#pragma unroll
                for (int c = 0; c < 16; ++c) asm volatile("" : "=v"(av[c]));
                if (li < 8) {
#pragma unroll
                    for (int c = 0; c < 16; ++c) av[c] = *(const LAS v4u*)(src + 64 * c); }
#pragma unroll
                for (int c = 0; c < 16; ++c) { const v4u a = av[c];
#else
#pragma unroll
                for (int c = 0; c < 16; ++c) { const v4u a = *(const LAS v4u*)(src + 64 * c);
#endif
                    acc = __builtin_amdgcn_mfma_f32_16x16x32_fp8_fp8((i64_t)(((unsigned long long)a[1] << 32) | a[0]), (i64_t)(((unsigned long long)hb[c][1] << 32) | hb[c][0]), acc, 0, 0, 0);
                    acc = __builtin_amdgcn_mfma_f32_16x16x32_fp8_fp8((i64_t)(((unsigned long long)a[3] << 32) | a[2]), (i64_t)(((unsigned long long)hb[c][3] << 32) | hb[c][2]), acc, 0, 0, 0); }
                const int base = (u & 7) * 8; const int r = li & 3;
                const float sel = r == 0 ? acc[0] : (r == 1 ? acc[1] : (r == 2 ? acc[2] : acc[3]));
                const float dmine = __shfl(sel, ((lane & 7) >> 2) * 16 + (lane & 3));
                const float gsel = u < 8 ? g_lo : g_hi, susel = u < 8 ? su_lo : su_hi, svsel = u < 8 ? sv_lo : sv_hi;
                const float wv = gsel * gelu_erf(dmine * susel * hinv) * svsel;
                const bool mine = (lane >= base) && (lane < base + 8);
                if (u < 8) w_lo = mine ? wv : w_lo; else w_hi = mine ? wv : w_hi;
                asm volatile("s_waitcnt lgkmcnt(0)" ::: "memory");
            }
            WSP(float, WS_GATE)[t * 128 + lane] = w_lo; WSP(float, WS_GATE)[t * 128 + 64 + lane] = w_hi;
        }
    }
}
struct U10Meta { int elo, ehi; float glo, ghi; v4u xa, xb; float rst; };
__device__ __forceinline__ void u10_meta_load(U10Meta& M, const unsigned char* ws, size_t t, unsigned l16) {
    const unsigned l = l16 >> 4; const int* ep = (const int*)(ws + WS_EID) + t * 128; const float* gp = (const float*)(ws + WS_GATE) + t * 128;
    M.elo = ep[l]; M.ehi = ep[64 + l]; M.glo = gp[l]; M.ghi = gp[64 + l];
    const char* xs = (const char*)(ws + WS_X1S) + t * 2048 + 2u * l16; M.xa = *(const v4u*)xs; M.xb = *(const v4u*)(xs + 16);
    M.rst = ((const float*)(ws + WS_ROWSTAT))[t + (l16 >> 30)];
}
__device__ __forceinline__ void u10_meta_touch(U10Meta& M) { asm volatile("" : "+v"(M.elo), "+v"(M.ehi), "+v"(M.glo), "+v"(M.ghi), "+v"(M.xa), "+v"(M.xb), "+v"(M.rst)); }
template <int UN> __device__ __forceinline__ void u10_unit_dma(int elo, int ehi, const unsigned char* EU, unsigned l16, LAS unsigned char* dst) {
    const int ensel = UN < 8 ? elo : ehi; constexpr int nb = (UN & 7) * 8;
#pragma unroll
    for (int j = 0; j < 8; ++j) { const int e = __builtin_amdgcn_readlane(ensel, nb + j);
        __builtin_amdgcn_global_load_lds((const unsigned*)(EU + ((unsigned)e * 1024u + l16)), (LAS unsigned*)(dst + j * U6_ROWP), 16, 0, 0); }
}
__device__ __forceinline__ void u10_h2(const U10Meta& M, const float* S2, LAS unsigned char* hq, unsigned l16, int lq, v4u* hb, float& hinv) {
    float h2[16]; unpack8(M.xa, h2); unpack8(M.xb, h2 + 8); float mx = 0.f;
    const float rs = rsqrt_f(M.rst * (1.0f / 1024.0f) + EPSF);
#pragma unroll
    for (int i = 0; i < 16; ++i) { h2[i] = h2[i] * rs + S2[i]; mx = fmaxf(mx, fabsf(h2[i])); }
#pragma unroll
    for (int o = 1; o < 64; o <<= 1) mx = fmaxf(mx, __shfl_xor(mx, o));
    mx = fmaxf(mx, 1e-30f); const float hs = 224.0f / mx; hinv = mx * (1.0f / 224.0f);
    v4u w;
#pragma unroll
    for (int qd = 0; qd < 4; ++qd) { int pk = 0; pk = __builtin_amdgcn_cvt_pk_fp8_f32(h2[4 * qd] * hs, h2[4 * qd + 1] * hs, pk, false); pk = __builtin_amdgcn_cvt_pk_fp8_f32(h2[4 * qd + 2] * hs, h2[4 * qd + 3] * hs, pk, true); w[qd] = (unsigned)pk; }
    *(LAS v4u*)(hq + l16) = w;
    LDS_WAIT(); asm volatile("" ::: "memory");
#pragma unroll
    for (int c = 0; c < 16; ++c) hb[c] = *(const LAS v4u*)(hq + 64 * c + 16 * lq);
    LDS_WAIT(); asm volatile("" ::: "memory");
}
template <int U> __device__ __forceinline__ void u10_unit(const U10Meta& C, U10Meta& N, const unsigned char* EU, const unsigned char* ws, unsigned l16, LAS unsigned char* ring, const v4u* hb, float hinv,
                                                          float su_lo, float su_hi, float sv_lo, float sv_hi, float& nsu_lo, float& nsu_hi, float& nsv_lo, float& nsv_hi,
                                                          float& w_lo, float& w_hi, size_t tn, bool first_token, int lane) {
    const int li = lane & 15, lq = lane >> 4;
    if (U == 15) u10_unit_dma<0>(N.elo, N.ehi, EU, l16, ring); else u10_unit_dma<(U + 1) & 15>(C.elo, C.ehi, EU, l16, ring + ((U + 1) & 1) * U6_BUF);
    __builtin_amdgcn_sched_barrier(0);
    if (U == 0) { if (first_token) asm volatile("s_waitcnt vmcnt(8)" ::: "memory"); else asm volatile("s_waitcnt vmcnt(10)" ::: "memory"); }
    else if (U == 3) asm volatile("s_waitcnt vmcnt(15)" ::: "memory");
    else if (U == 11) asm volatile("s_waitcnt vmcnt(12)" ::: "memory");
    else asm volatile("s_waitcnt vmcnt(8)" ::: "memory");
    if (U == 4) u10_meta_touch(N);
    if (U == 12) asm volatile("" : "+v"(nsu_lo), "+v"(nsu_hi), "+v"(nsv_lo), "+v"(nsv_hi));
    __builtin_amdgcn_sched_barrier(0);
    const LAS unsigned char* src = ring + (U & 1) * U6_BUF + (li & 7) * U6_ROWP + 16 * lq;
    f32x4 acc = (f32x4){0.f, 0.f, 0.f, 0.f};
#pragma unroll
    for (int c = 0; c < 16; ++c) { const v4u a = *(const LAS v4u*)(src + 64 * c);
        acc = __builtin_amdgcn_mfma_f32_16x16x32_fp8_fp8((i64_t)(((unsigned long long)a[1] << 32) | a[0]), (i64_t)(((unsigned long long)hb[c][1] << 32) | hb[c][0]), acc, 0, 0, 0);
        acc = __builtin_amdgcn_mfma_f32_16x16x32_fp8_fp8((i64_t)(((unsigned long long)a[3] << 32) | a[2]), (i64_t)(((unsigned long long)hb[c][3] << 32) | hb[c][2]), acc, 0, 0, 0); }
    constexpr int base = (U & 7) * 8; const int r = li & 3;
    const float sel = r == 0 ? acc[0] : (r == 1 ? acc[1] : (r == 2 ? acc[2] : acc[3]));
    const float dmine = __shfl(sel, ((lane & 7) >> 2) * 16 + (lane & 3));
    const float gsel = U < 8 ? C.glo : C.ghi, susel = U < 8 ? su_lo : su_hi, svsel = U < 8 ? sv_lo : sv_hi;
    const float wv = gsel * gelu_erf(dmine * susel * hinv) * svsel;
    const bool mine = (lane >= base) && (lane < base + 8);
    if (U < 8) w_lo = mine ? wv : w_lo; else w_hi = mine ? wv : w_hi;
    asm volatile("s_waitcnt lgkmcnt(0)" ::: "memory");
    __builtin_amdgcn_sched_barrier(0);
    if (U == 2) { u10_meta_load(N, ws, tn, l16); __builtin_amdgcn_sched_barrier(0); }
    if (U == 10) { const float* EUS = (const float*)(ws + WS_EUS); const float* EVS = (const float*)(ws + WS_EVS); nsu_lo = EUS[N.elo]; nsu_hi = EUS[N.ehi]; nsv_lo = EVS[N.elo]; nsv_hi = EVS[N.ehi]; __builtin_amdgcn_sched_barrier(0); }
}
__device__ __forceinline__ void p8_peer_up10(Frame& F) {
    const int f_tid = threadIdx.x, lane = f_tid & 63, f_wave = __builtin_amdgcn_readfirstlane(f_tid >> 6);
    const int lq = lane >> 4;
    const unsigned char* EU = F.ws + WS_EU; const float* EUS = WSP(float, WS_EUS); const float* EVS = WSP(float, WS_EVS);
    LAS unsigned char* ring = F.lds + f_wave * U6_WAVE; LAS unsigned char* hq = ring + 2 * U6_BUF;
    for (int wq = F.vcu * NWAVES + f_wave; wq < MTOK / 16; wq += F.G * NWAVES) {
        const int b = wq >> 7; const float* mb = WSP(float, WS_MOD) + (size_t)b * 6144;
        unsigned l16 = 16u * (unsigned)lane; asm volatile("" : "+v"(l16));
        float S2[16];
#pragma unroll
        for (int q = 0; q < 4; ++q) { const f32x4 sh = *(const f32x4*)((const char*)(mb + 3072) + 4u * l16 + 16 * q); S2[4 * q] = sh[0]; S2[4 * q + 1] = sh[1]; S2[4 * q + 2] = sh[2]; S2[4 * q + 3] = sh[3]; }
        const size_t t0 = (size_t)wq * 16;
        U10Meta C, N;
        u10_meta_load(C, F.ws, t0, l16);
        asm volatile("s_waitcnt vmcnt(0)" ::: "memory");
        u10_meta_touch(C);
        u10_unit_dma<0>(C.elo, C.ehi, EU, l16, ring);
        float su_lo = EUS[C.elo], su_hi = EUS[C.ehi], sv_lo = EVS[C.elo], sv_hi = EVS[C.ehi];
        float nsu_lo = 0.f, nsu_hi = 0.f, nsv_lo = 0.f, nsv_hi = 0.f;
        v4u hb[16]; float hinv;
        u10_h2(C, S2, hq, l16, lq, hb, hinv);
        N = C;
        asm volatile("s_waitcnt vmcnt(0)" ::: "memory");
        asm volatile("" : "+v"(su_lo), "+v"(su_hi), "+v"(sv_lo), "+v"(sv_hi));
#pragma unroll 1
        for (int tt = 0; tt < 16; ++tt) {
            float w_lo = 0.f, w_hi = 0.f;
            const size_t tn = t0 + (tt < 15 ? tt + 1 : tt);
            const bool ft = (tt == 0);
#define U10_U(U) u10_unit<U>(C, N, EU, F.ws, l16, ring, hb, hinv, su_lo, su_hi, sv_lo, sv_hi, nsu_lo, nsu_hi, nsv_lo, nsv_hi, w_lo, w_hi, tn, ft, lane);
            U10_U(0) U10_U(1) U10_U(2) U10_U(3) U10_U(4) U10_U(5) U10_U(6) U10_U(7) U10_U(8) U10_U(9) U10_U(10) U10_U(11) U10_U(12) U10_U(13) U10_U(14) U10_U(15)
#undef U10_U
            WSP(float, WS_GATE)[(t0 + tt) * 128 + lane] = w_lo; WSP(float, WS_GATE)[(t0 + tt) * 128 + 64 + lane] = w_hi;
            __builtin_amdgcn_sched_barrier(0);
            C = N; su_lo = nsu_lo; su_hi = nsu_hi; sv_lo = nsv_lo; sv_hi = nsv_hi;
            u10_h2(C, S2, hq, l16, lq, hb, hinv);
        }
        asm volatile("s_waitcnt vmcnt(0)" ::: "memory");
    }
}
#ifndef U11_AUX
#define U11_AUX 0
#endif
constexpr int U11_HQ = 2 * U6_BUF, U11_IDS = U11_HQ + 1024, U11_GATES = U11_IDS + 512, U11_SC = U11_GATES + 512, U11_HINV = U11_SC + 1024, U11_WAVE = U11_HINV + 256;
static_assert(8 * U11_WAVE <= LDS_MAIN, "U11 LDS map");
__device__ __forceinline__ void u11_dma4(const void* g, LAS unsigned char* l) { __builtin_amdgcn_global_load_lds((const unsigned*)g, (LAS unsigned*)l, 4, 0, 0); }
__device__ __forceinline__ void u11_stage1(const unsigned char* ws, size_t t, unsigned l16, LAS unsigned char* W) {
    const unsigned l4 = l16 >> 2;
    const unsigned char* ep = ws + WS_EID + t * 512; const unsigned char* gp = ws + WS_GATE + t * 512;
    u11_dma4(ep + l4, W + U11_IDS); u11_dma4(ep + 256 + l4, W + U11_IDS + 256);
    u11_dma4(gp + l4, W + U11_GATES); u11_dma4(gp + 256 + l4, W + U11_GATES + 256);
    __builtin_amdgcn_global_load_lds((const unsigned*)(ws + WS_H2Q + t * 1024 + l16), (LAS unsigned*)(W + U11_HQ), 16, 0, 0);
    u11_dma4(ws + WS_HINV + t * 4 + (l16 >> 30), W + U11_HINV);
}
__device__ __forceinline__ void u11_stage2(const unsigned char* ws, int elo, int ehi, LAS unsigned char* W) {
    u11_dma4(ws + WS_EUS + 4u * (unsigned)elo, W + U11_SC); u11_dma4(ws + WS_EUS + 4u * (unsigned)ehi, W + U11_SC + 256);
    u11_dma4(ws + WS_EVS + 4u * (unsigned)elo, W + U11_SC + 512); u11_dma4(ws + WS_EVS + 4u * (unsigned)ehi, W + U11_SC + 768);
}
template <int UN> __device__ __forceinline__ void u11_unit_dma(int elo, int ehi, const unsigned char* EU, unsigned l16, LAS unsigned char* dst) {
    const int ensel = UN < 8 ? elo : ehi; constexpr int nb = (UN & 7) * 8;
#pragma unroll
    for (int j = 0; j < 8; ++j) { const int e = __builtin_amdgcn_readlane(ensel, nb + j);
        __builtin_amdgcn_global_load_lds((const unsigned*)(EU + ((unsigned)e * 1024u + l16)), (LAS unsigned*)(dst + j * U6_ROWP), 16, 0, U11_AUX); }
}
struct U11Tok { int elo, ehi; float glo, ghi, su_lo, su_hi, sv_lo, sv_hi, hinv; };
__device__ __forceinline__ void u11_switch(U11Tok& C, int nelo, int nehi, LAS unsigned char* W, unsigned l16, int lq, v4u* hb) {
    const unsigned l4 = l16 >> 2;
    C.elo = nelo; C.ehi = nehi;
    C.glo = *(const LAS float*)(W + U11_GATES + l4); C.ghi = *(const LAS float*)(W + U11_GATES + 256 + l4);
    C.su_lo = *(const LAS float*)(W + U11_SC + l4); C.su_hi = *(const LAS float*)(W + U11_SC + 256 + l4); C.sv_lo = *(const LAS float*)(W + U11_SC + 512 + l4); C.sv_hi = *(const LAS float*)(W + U11_SC + 768 + l4);
    C.hinv = *(const LAS float*)(W + U11_HINV + l4);
#pragma unroll
    for (int c = 0; c < 16; ++c) hb[c] = *(const LAS v4u*)(W + U11_HQ + 64 * c + 16 * lq);
    LDS_WAIT(); asm volatile("" ::: "memory");
}
template <int U> __device__ __forceinline__ void u11_unit(const U11Tok& C, int& nelo, int& nehi, const unsigned char* EU, const unsigned char* ws, unsigned l16, LAS unsigned char* W, const v4u* hb,
                                                          float& w_lo, float& w_hi, size_t tn, bool first_token, int lane) {
    const int li = lane & 15, lq = lane >> 4;
    if (U == 15) u11_unit_dma<0>(nelo, nehi, EU, l16, W); else u11_unit_dma<(U + 1) & 15>(C.elo, C.ehi, EU, l16, W + ((U + 1) & 1) * U6_BUF);
    __builtin_amdgcn_sched_barrier(0);
    if (U == 0) { if (first_token) asm volatile("s_waitcnt vmcnt(8)" ::: "memory"); else asm volatile("s_waitcnt vmcnt(10)" ::: "memory"); }
    else if (U == 3) asm volatile("s_waitcnt vmcnt(14)" ::: "memory");
    else if (U == 5) asm volatile("s_waitcnt vmcnt(12)" ::: "memory");
    else asm volatile("s_waitcnt vmcnt(8)" ::: "memory");
    __builtin_amdgcn_sched_barrier(0);
    const LAS unsigned char* src = W + (U & 1) * U6_BUF + (li & 7) * U6_ROWP + 16 * lq;
    f32x4 acc = (f32x4){0.f, 0.f, 0.f, 0.f};
#pragma unroll
    for (int c = 0; c < 16; ++c) { const v4u a = *(const LAS v4u*)(src + 64 * c);
        acc = __builtin_amdgcn_mfma_f32_16x16x32_fp8_fp8((i64_t)(((unsigned long long)a[1] << 32) | a[0]), (i64_t)(((unsigned long long)hb[c][1] << 32) | hb[c][0]), acc, 0, 0, 0);
        acc = __builtin_amdgcn_mfma_f32_16x16x32_fp8_fp8((i64_t)(((unsigned long long)a[3] << 32) | a[2]), (i64_t)(((unsigned long long)hb[c][3] << 32) | hb[c][2]), acc, 0, 0, 0); }
    constexpr int base = (U & 7) * 8; const int r = li & 3;
    const float sel = r == 0 ? acc[0] : (r == 1 ? acc[1] : (r == 2 ? acc[2] : acc[3]));
    const float dmine = __shfl(sel, ((lane & 7) >> 2) * 16 + (lane & 3));
    const float gsel = U < 8 ? C.glo : C.ghi, susel = U < 8 ? C.su_lo : C.su_hi, svsel = U < 8 ? C.sv_lo : C.sv_hi;
    const float wv = gsel * gelu_erf(dmine * susel * C.hinv) * svsel;
    const bool mine = (lane >= base) && (lane < base + 8);
    if (U < 8) w_lo = mine ? wv : w_lo; else w_hi = mine ? wv : w_hi;
    if (U == 4) { nelo = *(const LAS int*)(W + U11_IDS + (l16 >> 2)); nehi = *(const LAS int*)(W + U11_IDS + 256 + (l16 >> 2)); }
    asm volatile("s_waitcnt lgkmcnt(0)" ::: "memory");
    __builtin_amdgcn_sched_barrier(0);
    if (U == 2) { u11_stage1(ws, tn, l16, W); __builtin_amdgcn_sched_barrier(0); }
    if (U == 4) { u11_stage2(ws, nelo, nehi, W); __builtin_amdgcn_sched_barrier(0); }
}
__device__ __forceinline__ void p8_peer_up11(Frame& F) {
    const int f_tid = threadIdx.x, lane = f_tid & 63, f_wave = __builtin_amdgcn_readfirstlane(f_tid >> 6);
    const int lq = lane >> 4;
    const unsigned char* EU = F.ws + WS_EU;
    LAS unsigned char* W = F.lds + f_wave * U11_WAVE;
    for (int wq = F.vcu * NWAVES + f_wave; wq < MTOK / 16; wq += F.G * NWAVES) {
        unsigned l16 = 16u * (unsigned)lane; asm volatile("" : "+v"(l16));
        const size_t t0 = (size_t)wq * 16;
        u11_stage1(F.ws, t0, l16, W);
        asm volatile("s_waitcnt vmcnt(0)" ::: "memory");
        int nelo = *(const LAS int*)(W + U11_IDS + (l16 >> 2)), nehi = *(const LAS int*)(W + U11_IDS + 256 + (l16 >> 2));
        LDS_WAIT(); asm volatile("" ::: "memory");
        u11_stage2(F.ws, nelo, nehi, W);
        u11_unit_dma<0>(nelo, nehi, EU, l16, W);
        asm volatile("s_waitcnt vmcnt(0)" ::: "memory");
        U11Tok C; v4u hb[16];
        u11_switch(C, nelo, nehi, W, l16, lq, hb);
#pragma unroll 1
        for (int tt = 0; tt < 16; ++tt) {
            float w_lo = 0.f, w_hi = 0.f;
            const size_t tn = t0 + (tt < 15 ? tt + 1 : tt);
            const bool ft = (tt == 0);
#define U11_U(U) u11_unit<U>(C, nelo, nehi, EU, F.ws, l16, W, hb, w_lo, w_hi, tn, ft, lane);
            U11_U(0) U11_U(1) U11_U(2) U11_U(3) U11_U(4) U11_U(5) U11_U(6) U11_U(7) U11_U(8) U11_U(9) U11_U(10) U11_U(11) U11_U(12) U11_U(13) U11_U(14) U11_U(15)
#undef U11_U
            WSP(float, WS_GATE)[(t0 + tt) * 128 + lane] = w_lo; WSP(float, WS_GATE)[(t0 + tt) * 128 + 64 + lane] = w_hi;
            __builtin_amdgcn_sched_barrier(0);
            u11_switch(C, nelo, nehi, W, l16, lq, hb);
        }
        asm volatile("s_waitcnt vmcnt(0)" ::: "memory");
    }
}
typedef unsigned v3u __attribute__((ext_vector_type(3)));
typedef unsigned v6u __attribute__((ext_vector_type(6)));
typedef float f32x32 __attribute__((ext_vector_type(32)));
struct __attribute__((packed, aligned(4))) U3 { unsigned a, b, c; };
__device__ __forceinline__ v3u ld_row6(const unsigned char* p) { const U3 u = *(const U3*)p; return (v3u){u.a, u.b, u.c}; }
__device__ __forceinline__ void p9_peer_down3(Frame& F) {
    const int f_tid = threadIdx.x, lane = f_tid & 63, f_wave = __builtin_amdgcn_readfirstlane(f_tid >> 6);
    const unsigned char* EV = F.ws + WS_EV;
    for (int wq = F.vcu * NWAVES + f_wave; wq < MTOK / 16; wq += F.G * NWAVES) {
        const int b = wq >> 7; const float* mb = WSP(float, WS_MOD) + (size_t)b * 6144;
        unsigned l16 = 16u * (unsigned)lane; asm volatile("" : "+v"(l16));
        const unsigned l12 = (l16 >> 2) * 3u;
        int ne_lo = WSP(int, WS_EID)[(size_t)wq * 16 * 128 + lane], ne_hi = WSP(int, WS_EID)[(size_t)wq * 16 * 128 + 64 + lane];
        float nw_lo = WSP(float, WS_GATE)[(size_t)wq * 16 * 128 + lane], nw_hi = WSP(float, WS_GATE)[(size_t)wq * 16 * 128 + 64 + lane];
        v3u qa[8], qb[8];
#pragma unroll
        for (int j = 0; j < 8; ++j) { const int e = __builtin_amdgcn_readlane(ne_lo, j); qa[j] = ld_row6(EV + ((unsigned)e * 768u + l12)); }
#pragma unroll 1
        for (int tt = 0; tt < 16; ++tt) {
            const size_t t = (size_t)wq * 16 + tt;
            float* xr = (float*)((char*)(F.out + t * 1024) + 4u * l16);
            const int e_lo = ne_lo, e_hi = ne_hi; const float w_lo = nw_lo, w_hi = nw_hi;
            { const size_t tn = t + (tt < 15 ? 1 : 0); ne_lo = WSP(int, WS_EID)[tn * 128 + lane]; ne_hi = WSP(int, WS_EID)[tn * 128 + 64 + lane]; nw_lo = WSP(float, WS_GATE)[tn * 128 + lane]; nw_hi = WSP(float, WS_GATE)[tn * 128 + 64 + lane]; }
            f32x2 o[8];
#pragma unroll
            for (int i = 0; i < 8; ++i) o[i] = (f32x2){0.f, 0.f};
#define DN3_STEP(GRP, CUR, NXT, NIDS, NB) { \
                const int grp = (GRP); \
                { const int nids = (NIDS); _Pragma("unroll") for (int j = 0; j < 8; ++j) { const int e = __builtin_amdgcn_readlane(nids, (NB) + j); NXT[j] = ld_row6(EV + ((unsigned)e * 768u + l12)); } } \
                __builtin_amdgcn_sched_barrier(0); \
                const int base = (grp & 7) * 8; const float wsel = grp < 8 ? w_lo : w_hi; \
                _Pragma("unroll") for (int j = 0; j < 8; j += 2) { \
                    const float wa = __builtin_bit_cast(float, __builtin_amdgcn_readlane(__builtin_bit_cast(int, wsel), base + j)), wb = __builtin_bit_cast(float, __builtin_amdgcn_readlane(__builtin_bit_cast(int, wsel), base + j + 1)); \
                    const f32x2 wa2 = (f32x2){wa, wa}, wb2 = (f32x2){wb, wb}; \
                    const v6u pr = (v6u){CUR[j][0], CUR[j][1], CUR[j][2], CUR[j + 1][0], CUR[j + 1][1], CUR[j + 1][2]}; \
                    const f32x32 r = __builtin_amdgcn_cvt_scalef32_pk32_f32_fp6(pr, 1.0f); \
                    _Pragma("unroll") for (int i = 0; i < 8; ++i) { o[i] += wa2 * (f32x2){r[2 * i], r[2 * i + 1]}; o[i] += wb2 * (f32x2){r[16 + 2 * i], r[17 + 2 * i]}; } } }
#pragma unroll 1
            for (int g2 = 0; g2 < 14; g2 += 2) { const int ga = g2 + 1, gb = g2 + 2;
                DN3_STEP(g2, qa, qb, ga < 8 ? e_lo : e_hi, (ga & 7) * 8)
                DN3_STEP(g2 + 1, qb, qa, gb < 8 ? e_lo : e_hi, (gb & 7) * 8) }
            DN3_STEP(14, qa, qb, e_hi, 56)
            DN3_STEP(15, qb, qa, ne_lo, 0)
#undef DN3_STEP
            float x1[16]; float ss = 0.f;
#pragma unroll
            for (int q4 = 0; q4 < 4; ++q4) { const f32x4 v = *(const f32x4*)(xr + 4 * q4); x1[4 * q4] = v[0]; x1[4 * q4 + 1] = v[1]; x1[4 * q4 + 2] = v[2]; x1[4 * q4 + 3] = v[3]; }
#pragma unroll
            for (int q4 = 0; q4 < 4; ++q4) { const f32x4 gt = *(const f32x4*)((const char*)(mb + 5120) + 4u * l16 + 16 * q4);
#pragma unroll
                for (int e = 0; e < 4; ++e) { const int i = 4 * q4 + e; x1[i] += gt[e] * o[i >> 1][i & 1]; ss += x1[i] * x1[i]; } }
            const float rf = rsqrt_f(wave_sum(ss) * (1.0f / 1024.0f) + EPSF);
#pragma unroll
            for (int q4 = 0; q4 < 4; ++q4) { const f32x4 nf = *(const f32x4*)((const char*)(F.a->in[29]) + 4u * l16 + 16 * q4); f32x4 v;
#pragma unroll
                for (int e = 0; e < 4; ++e) v[e] = x1[4 * q4 + e] * rf * nf[e];
                *(f32x4*)(xr + 4 * q4) = v; }
        }
    }
}
constexpr int U12_ROWP = 784, U12_NBUF = 3, U12_BUF = 8 * U12_ROWP, U12_WAVE = U12_NBUF * U12_BUF + 1024;
static_assert(8 * U12_WAVE <= LDS_MAIN, "U12 LDS map");
typedef int i32x8 __attribute__((ext_vector_type(8)));
typedef unsigned v2u __attribute__((ext_vector_type(2)));
__device__ __forceinline__ void p8_peer_up12(Frame& F) {
    const int f_tid = threadIdx.x, lane = f_tid & 63, f_wave = __builtin_amdgcn_readfirstlane(f_tid >> 6);
    const int li = lane & 15, lq = lane >> 4;
    const unsigned char* EU = F.ws + WS_EU; const float* EUS = WSP(float, WS_EUS); const float* EVS = WSP(float, WS_EVS);
    LAS unsigned char* ring = F.lds + f_wave * U12_WAVE; LAS unsigned char* hq = ring + U12_NBUF * U12_BUF;
#ifdef PROBE_MFMA
    if (blockIdx.x == 0 && f_wave == 0) {
        i32x8 A = (i32x8){0, 0, 0, 0, 0, 0, 0, 0}; if (lane == PROBE_ALANE) A[PROBE_AREG] = PROBE_AVAL;
        i32x8 B;
        if (PROBE_BPAT == 0) B = (i32x8){0x48444038, 0x504E4C4A, 0x54535251, 0x58575655, 0x48444038, 0x504E4C4A, 0x54535251, 0x58575655};
        else { const unsigned c0 = (const unsigned[]){0x38u, 0x40u, 0x44u, 0x48u, 0x4Au, 0x4Cu, 0x4Eu, 0x50u}[0]; (void)c0;
               const int k = lane >> 4; const unsigned lo = k == 0 ? 0x38u : (k == 1 ? 0x44u : (k == 2 ? 0x4Au : 0x4Eu)), hi = k == 0 ? 0x40u : (k == 1 ? 0x48u : (k == 2 ? 0x4Cu : 0x50u));
               const int wl = (int)(lo * 0x01010101u), wh = (int)(hi * 0x01010101u); B = (i32x8){wl, wl, wl, wl, wh, wh, wh, wh}; }
        f32x4 acc = (f32x4){0.f, 0.f, 0.f, 0.f};
        acc = __builtin_amdgcn_mfma_scale_f32_16x16x128_f8f6f4(A, B, acc, 2, 0, 0, 0, 0, 0);
        if (lane == 0) *(volatile float*)(F.ws + WS_CTL + 40000) = acc[0] * 100.0f;
    }
#endif
    for (int wq = F.vcu * NWAVES + f_wave; wq < MTOK / 16; wq += F.G * NWAVES) {
        const int b = wq >> 7; const float* mb = WSP(float, WS_MOD) + (size_t)b * 6144;
        for (int tt = 0; tt < 16; ++tt) {
            const size_t t = (size_t)wq * 16 + tt;
            unsigned l16 = 16u * (unsigned)lane; asm volatile("" : "+v"(l16));
            const int e_lo = WSP(int, WS_EID)[t * 128 + lane], e_hi = WSP(int, WS_EID)[t * 128 + 64 + lane];
            const float g_lo = WSP(float, WS_GATE)[t * 128 + lane], g_hi = WSP(float, WS_GATE)[t * 128 + 64 + lane];
            const float rs = rsqrt_f(WSP(float, WS_ROWSTAT)[t] * (1.0f / 1024.0f) + EPSF);
            const char* xs = (const char*)(WSP(bf16, WS_X1S) + t * 1024) + 2u * l16; const v4u xa = *(const v4u*)xs, xb = *(const v4u*)(xs + 16);
            asm volatile("s_waitcnt vmcnt(0)" ::: "memory");
            if (lane < 48) {
#pragma unroll
            for (int j = 0; j < 16; ++j) { const int e = __builtin_amdgcn_readlane(e_lo, j);
                __builtin_amdgcn_global_load_lds((const unsigned*)(EU + ((unsigned)e * 768u + l16)), (LAS unsigned*)(ring + j * U12_ROWP), 16, 0, 0); } }
            const float su_lo = EUS[e_lo], su_hi = EUS[e_hi], sv_lo = EVS[e_lo], sv_hi = EVS[e_hi];
            float h2[16]; unpack8(xa, h2); unpack8(xb, h2 + 8); float mx = 0.f;
#pragma unroll
            for (int qd = 0; qd < 4; ++qd) { const f32x4 sh = *(const f32x4*)((const char*)(mb + 3072) + 4u * l16 + 16 * qd);
#pragma unroll
                for (int e = 0; e < 4; ++e) { h2[4 * qd + e] = h2[4 * qd + e] * rs + sh[e]; mx = fmaxf(mx, fabsf(h2[4 * qd + e])); } }
#pragma unroll
            for (int o = 1; o < 64; o <<= 1) mx = fmaxf(mx, __shfl_xor(mx, o));
            mx = fmaxf(mx, 1e-30f); const float hs = 224.0f / mx, hinv = mx * (1.0f / 224.0f);
            { v4u w;
#pragma unroll
              for (int qd = 0; qd < 4; ++qd) { int pk = 0; pk = __builtin_amdgcn_cvt_pk_fp8_f32(h2[4 * qd] * hs, h2[4 * qd + 1] * hs, pk, false); pk = __builtin_amdgcn_cvt_pk_fp8_f32(h2[4 * qd + 2] * hs, h2[4 * qd + 3] * hs, pk, true); w[qd] = (unsigned)pk; }
              *(LAS v4u*)(hq + l16) = w; }
            LDS_WAIT(); asm volatile("" ::: "memory");
            v4u hb[8];
#pragma unroll
            for (int c = 0; c < 4; ++c) { hb[2 * c] = *(const LAS v4u*)(hq + (li & 1) * 512 + 128 * c + 16 * lq); hb[2 * c + 1] = *(const LAS v4u*)(hq + (li & 1) * 512 + 128 * c + 64 + 16 * lq); }
            asm volatile("s_waitcnt vmcnt(0)" ::: "memory");
            float w_lo = 0.f, w_hi = 0.f;
            int cur = 0, nx2 = 2 * U12_BUF;
#pragma unroll 1
            for (int u = 0; u < 16; ++u) {
                if (u < 14) { const int un = u + 2; int ensel = un < 8 ? e_lo : e_hi; asm volatile("" : "+v"(ensel));     const int nb = (un & 7) * 8; LAS unsigned char* dst = ring + nx2;
                  if (lane < 48) {
#pragma unroll
                  for (int j = 0; j < 8; ++j) { const int e = __builtin_amdgcn_readlane(ensel, nb + j);
                      __builtin_amdgcn_global_load_lds((const unsigned*)(EU + ((unsigned)e * 768u + l16)), (LAS unsigned*)(dst + j * U12_ROWP), 16, 0, 0); } }
                  asm volatile("s_waitcnt vmcnt(16)" ::: "memory"); }
                else if (u == 14) asm volatile("s_waitcnt vmcnt(8)" ::: "memory");
                else asm volatile("s_waitcnt vmcnt(0)" ::: "memory");
                const LAS unsigned char* src = ring + cur + (li & 7) * U12_ROWP + (li >> 3) * 384 + 24 * lq;
                f32x4 acc = (f32x4){0.f, 0.f, 0.f, 0.f};
#pragma unroll
                for (int c = 0; c < 4; ++c) { const v2u a0 = *(const LAS v2u*)(src + 96 * c), a1 = *(const LAS v2u*)(src + 96 * c + 8), a2 = *(const LAS v2u*)(src + 96 * c + 16);
                    const i32x8 A = (i32x8){(int)a0[0], (int)a0[1], (int)a1[0], (int)a1[1], (int)a2[0], (int)a2[1], 0, 0};
                    const i32x8 B = (i32x8){(int)hb[2 * c][0], (int)hb[2 * c][1], (int)hb[2 * c][2], (int)hb[2 * c][3], (int)hb[2 * c + 1][0], (int)hb[2 * c + 1][1], (int)hb[2 * c + 1][2], (int)hb[2 * c + 1][3]};
                    acc = __builtin_amdgcn_mfma_scale_f32_16x16x128_f8f6f4(A, B, acc, 2, 0, 0, 0, 0, 0); }
                const int base = (u & 7) * 8; const int r = (li >> 1) & 3;
                const float sel = r == 0 ? acc[0] : (r == 1 ? acc[1] : (r == 2 ? acc[2] : acc[3]));
                const int sl = ((lane & 7) >> 2) * 16 + 2 * (lane & 3);
                const float dmine = __shfl(sel, sl) + __shfl(sel, sl + 33);
                const float gsel = u < 8 ? g_lo : g_hi, susel = u < 8 ? su_lo : su_hi, svsel = u < 8 ? sv_lo : sv_hi;
                const float wv = gsel * gelu_erf(dmine * susel * hinv) * svsel;
                const bool mine = (lane >= base) && (lane < base + 8);
                if (u < 8) w_lo = mine ? wv : w_lo; else w_hi = mine ? wv : w_hi;
                asm volatile("s_waitcnt lgkmcnt(0)" ::: "memory");
                cur = cur == 2 * U12_BUF ? 0 : cur + U12_BUF; nx2 = nx2 == 2 * U12_BUF ? 0 : nx2 + U12_BUF;
            }
            WSP(float, WS_GATE)[t * 128 + lane] = w_lo; WSP(float, WS_GATE)[t * 128 + 64 + lane] = w_hi;
        }
    }
}
constexpr int U14_ROWP = 1040, U14_BUF = 8 * U14_ROWP, U14_WAVE = 2 * U14_BUF + 1024;
static_assert(8 * U14_WAVE <= LDS_MAIN, "U14 LDS map");
struct U14Meta { int elo, ehi; float glo, ghi; v4u xa, xb; float rst; };
__device__ __forceinline__ void u14_meta_load(U14Meta& M, const unsigned char* ws, size_t t, unsigned l16) {
    const unsigned l = l16 >> 4; const int* ep = (const int*)(ws + WS_EID) + t * 128; const float* gp = (const float*)(ws + WS_GATE) + t * 128;
    M.elo = ep[l]; M.ehi = ep[64 + l]; M.glo = gp[l]; M.ghi = gp[64 + l];
    const char* xs = (const char*)(ws + WS_X1S) + t * 2048 + 2u * l16; M.xa = *(const v4u*)xs; M.xb = *(const v4u*)(xs + 16);
    M.rst = ((const float*)(ws + WS_ROWSTAT))[t];
}
__device__ __forceinline__ void u14_h2(const U14Meta& M, const float* S2, LAS unsigned char* hq, unsigned l16, int li, int lq, v4u* hb, float& hinv) {
    float h2[16]; unpack8(M.xa, h2); unpack8(M.xb, h2 + 8); float mx = 0.f;
    const float rs = rsqrt_f(M.rst * (1.0f / 1024.0f) + EPSF);
#pragma unroll
    for (int i = 0; i < 16; ++i) { h2[i] = h2[i] * rs + S2[i]; mx = fmaxf(mx, fabsf(h2[i])); }
#pragma unroll
    for (int o = 1; o < 64; o <<= 1) mx = fmaxf(mx, __shfl_xor(mx, o));
    mx = fmaxf(mx, 1e-30f); const float hs = 224.0f / mx; hinv = mx * (1.0f / 224.0f);
    v4u w;
#pragma unroll
    for (int qd = 0; qd < 4; ++qd) { int pk = 0; pk = __builtin_amdgcn_cvt_pk_fp8_f32(h2[4 * qd] * hs, h2[4 * qd + 1] * hs, pk, false); pk = __builtin_amdgcn_cvt_pk_fp8_f32(h2[4 * qd + 2] * hs, h2[4 * qd + 3] * hs, pk, true); w[qd] = (unsigned)pk; }
    *(LAS v4u*)(hq + l16) = w;
    LDS_WAIT(); asm volatile("" ::: "memory");
#pragma unroll
    for (int c = 0; c < 4; ++c) { hb[2 * c] = *(const LAS v4u*)(hq + (li & 1) * 512 + 128 * c + 16 * lq); hb[2 * c + 1] = *(const LAS v4u*)(hq + (li & 1) * 512 + 128 * c + 64 + 16 * lq); }
    LDS_WAIT(); asm volatile("" ::: "memory");
}
__device__ __forceinline__ void p8_peer_up14(Frame& F) {
    const int f_tid = threadIdx.x, lane = f_tid & 63, f_wave = __builtin_amdgcn_readfirstlane(f_tid >> 6);
    const int li = lane & 15, lq = lane >> 4;
    const unsigned char* EU = F.ws + WS_EU; const float* EUS = WSP(float, WS_EUS); const float* EVS = WSP(float, WS_EVS);
    LAS unsigned char* tile = F.lds + f_wave * U14_WAVE; LAS unsigned char* hq = tile + 2 * U14_BUF;
    for (int wq = F.vcu * NWAVES + f_wave; wq < MTOK / 16; wq += F.G * NWAVES) {
        const int b = wq >> 7; const float* mb = WSP(float, WS_MOD) + (size_t)b * 6144;
        unsigned l16 = 16u * (unsigned)lane; asm volatile("" : "+v"(l16));
        const unsigned rof = l16 < 768u ? l16 : l16 - 768u;
        float S2[16];
#pragma unroll
        for (int q = 0; q < 4; ++q) { const f32x4 sh = *(const f32x4*)((const char*)(mb + 3072) + 4u * l16 + 16 * q); S2[4 * q] = sh[0]; S2[4 * q + 1] = sh[1]; S2[4 * q + 2] = sh[2]; S2[4 * q + 3] = sh[3]; }
        const size_t t0 = (size_t)wq * 16;
        U14Meta N; u14_meta_load(N, F.ws, t0, l16);
        float nsu_lo = EUS[N.elo], nsu_hi = EUS[N.ehi], nsv_lo = EVS[N.elo], nsv_hi = EVS[N.ehi];
        v4u qa[8], qb[8];
#pragma unroll
        for (int j = 0; j < 8; ++j) { const int e = __builtin_amdgcn_readlane(N.elo, j); qa[j] = *(const v4u*)(EU + ((unsigned)e * 768u + rof)); }
#pragma unroll 1
        for (int tt = 0; tt < 16; ++tt) {
            const size_t t = t0 + tt;
            const int e_lo = N.elo, e_hi = N.ehi; const float g_lo = N.glo, g_hi = N.ghi, su_lo = nsu_lo, su_hi = nsu_hi, sv_lo = nsv_lo, sv_hi = nsv_hi;
            v4u hb[8]; float hinv;
            u14_h2(N, S2, hq, l16, li, lq, hb, hinv);
            u14_meta_load(N, F.ws, t + (tt < 15 ? 1 : 0), l16);
            float w_lo = 0.f, w_hi = 0.f;
#define U14_STEP(UU, CUR, NXT, NLO, NHI) { \
            const int u = (UU); const int un = (u + 1) & 15; const int nb = (un & 7) * 8; const int ensel = un < 8 ? (NLO) : (NHI); \
            { _Pragma("unroll") for (int j = 0; j < 8; ++j) { const int e = __builtin_amdgcn_readlane(ensel, nb + j); NXT[j] = *(const v4u*)(EU + ((unsigned)e * 768u + rof)); } } \
            __builtin_amdgcn_sched_barrier(0); \
            LAS unsigned char* tb = tile + (u & 1) * U14_BUF; \
            { _Pragma("unroll") for (int j = 0; j < 8; ++j) *(LAS v4u*)(tb + j * U14_ROWP + l16) = CUR[j]; } \
            LDS_WAIT(); asm volatile("" ::: "memory"); \
            const LAS unsigned char* src = tb + (li & 7) * U14_ROWP + (li >> 3) * 384 + 24 * lq; \
            f32x4 acc = (f32x4){0.f, 0.f, 0.f, 0.f}; \
            _Pragma("unroll") for (int c = 0; c < 4; ++c) { const v2u a0 = *(const LAS v2u*)(src + 96 * c), a1 = *(const LAS v2u*)(src + 96 * c + 8), a2 = *(const LAS v2u*)(src + 96 * c + 16); \
                const i32x8 A = (i32x8){(int)a0[0], (int)a0[1], (int)a1[0], (int)a1[1], (int)a2[0], (int)a2[1], 0, 0}; \
                const i32x8 B = (i32x8){(int)hb[2 * c][0], (int)hb[2 * c][1], (int)hb[2 * c][2], (int)hb[2 * c][3], (int)hb[2 * c + 1][0], (int)hb[2 * c + 1][1], (int)hb[2 * c + 1][2], (int)hb[2 * c + 1][3]}; \
                acc = __builtin_amdgcn_mfma_scale_f32_16x16x128_f8f6f4(A, B, acc, 2, 0, 0, 0, 0, 0); }        \
            const int base = (u & 7) * 8; const int r = (li >> 1) & 3; \
            const float sel = r == 0 ? acc[0] : (r == 1 ? acc[1] : (r == 2 ? acc[2] : acc[3])); \
            const int sl = ((lane & 7) >> 2) * 16 + 2 * (lane & 3);                          \
            const float dmine = __shfl(sel, sl) + __shfl(sel, sl + 33); \
            const float gsel = u < 8 ? g_lo : g_hi, susel = u < 8 ? su_lo : su_hi, svsel = u < 8 ? sv_lo : sv_hi; \
            const float wv = gsel * gelu_erf(dmine * susel * hinv) * svsel; \
            const bool mine = (lane >= base) && (lane < base + 8); \
            if (u < 8) w_lo = mine ? wv : w_lo; else w_hi = mine ? wv : w_hi; }
#pragma unroll 1
            for (int u2 = 0; u2 < 14; u2 += 2) { U14_STEP(u2, qa, qb, e_lo, e_hi) U14_STEP(u2 + 1, qb, qa, e_lo, e_hi) }
            U14_STEP(14, qa, qb, e_lo, e_hi)
            U14_STEP(15, qb, qa, N.elo, N.ehi)
#undef U14_STEP
            nsu_lo = EUS[N.elo]; nsu_hi = EUS[N.ehi]; nsv_lo = EVS[N.elo]; nsv_hi = EVS[N.ehi];
            __builtin_amdgcn_sched_barrier(0);
            WSP(float, WS_GATE)[t * 128 + lane] = w_lo; WSP(float, WS_GATE)[t * 128 + 64 + lane] = w_hi;
        }
    }
}
#ifdef TOPK2
#define P7FN p5b_topk2
#else
#define P7FN p5b_topk
#endif
constexpr int U16_ROWP = 1040, U16_BUF = 8 * U16_ROWP, U16_WAVE = 2 * U16_BUF + 1024;
static_assert(8 * U16_WAVE <= LDS_MAIN, "U16 LDS map");
struct U16A { v2u p[12]; };
__device__ __forceinline__ void u16_rows(v4u* R, int ids, int nb, const unsigned char* EU, unsigned rof) {
#pragma unroll
    for (int j = 0; j < 8; ++j) { const int e = __builtin_amdgcn_readlane(ids, nb + j); R[j] = *(const v4u*)(EU + ((unsigned)e * 768u + rof)); }
}
__device__ __forceinline__ void u16_write(const v4u* R, LAS unsigned char* tb, unsigned l16) {
#pragma unroll
    for (int j = 0; j < 8; ++j) *(LAS v4u*)(tb + j * U16_ROWP + l16) = R[j];
}
__device__ __forceinline__ void u16_read(U16A& A, const LAS unsigned char* tb, int li, int lq) {
    const LAS unsigned char* src = tb + (li & 7) * U16_ROWP + (li >> 3) * 384 + 24 * lq;
#pragma unroll
    for (int c = 0; c < 4; ++c) { A.p[3 * c] = *(const LAS v2u*)(src + 96 * c); A.p[3 * c + 1] = *(const LAS v2u*)(src + 96 * c + 8); A.p[3 * c + 2] = *(const LAS v2u*)(src + 96 * c + 16); }
}
__device__ __forceinline__ f32x4 u16_mma(const U16A& A, const v4u* hb) {
    f32x4 acc = (f32x4){0.f, 0.f, 0.f, 0.f};
#pragma unroll
    for (int c = 0; c < 4; ++c) {
        const i32x8 a = (i32x8){(int)A.p[3 * c][0], (int)A.p[3 * c][1], (int)A.p[3 * c + 1][0], (int)A.p[3 * c + 1][1], (int)A.p[3 * c + 2][0], (int)A.p[3 * c + 2][1], 0, 0};
        const i32x8 bb = (i32x8){(int)hb[2 * c][0], (int)hb[2 * c][1], (int)hb[2 * c][2], (int)hb[2 * c][3], (int)hb[2 * c + 1][0], (int)hb[2 * c + 1][1], (int)hb[2 * c + 1][2], (int)hb[2 * c + 1][3]};
        acc = __builtin_amdgcn_mfma_scale_f32_16x16x128_f8f6f4(a, bb, acc, 2, 0, 0, 0, 0, 0); }
    return acc;
}
__device__ __forceinline__ void p8_peer_up16(Frame& F) {
    const int f_tid = threadIdx.x, lane = f_tid & 63, f_wave = __builtin_amdgcn_readfirstlane(f_tid >> 6);
    const int li = lane & 15, lq = lane >> 4;
    const unsigned char* EU = F.ws + WS_EU; const float* EUS = WSP(float, WS_EUS); const float* EVS = WSP(float, WS_EVS);
    LAS unsigned char* tile = F.lds + f_wave * U16_WAVE; LAS unsigned char* hq = tile + 2 * U16_BUF;
    for (int wq = F.vcu * NWAVES + f_wave; wq < MTOK / 16; wq += F.G * NWAVES) {
        const int b = wq >> 7; const float* mb = WSP(float, WS_MOD) + (size_t)b * 6144;
        unsigned l16 = 16u * (unsigned)lane; asm volatile("" : "+v"(l16));
        const unsigned rof = l16 < 768u ? l16 : l16 - 768u;
        float S2[16];
#pragma unroll
        for (int q = 0; q < 4; ++q) { const f32x4 sh = *(const f32x4*)((const char*)(mb + 3072) + 4u * l16 + 16 * q); S2[4 * q] = sh[0]; S2[4 * q + 1] = sh[1]; S2[4 * q + 2] = sh[2]; S2[4 * q + 3] = sh[3]; }
        const size_t t0 = (size_t)wq * 16;
        U14Meta N; u14_meta_load(N, F.ws, t0, l16);
        float nsu_lo = EUS[N.elo], nsu_hi = EUS[N.ehi], nsv_lo = EVS[N.elo], nsv_hi = EVS[N.ehi];
        v4u r0[8], r1[8];
        U16A A;
        u16_rows(r0, N.elo, 0, EU, rof); u16_rows(r1, N.elo, 8, EU, rof);
        u16_write(r0, tile, l16);
        LDS_WAIT(); asm volatile("" ::: "memory");
        u16_read(A, tile, li, lq);
#pragma unroll 1
        for (int tt = 0; tt < 16; ++tt) {
            const size_t t = t0 + tt;
            const int e_lo = N.elo, e_hi = N.ehi; const float g_lo = N.glo, g_hi = N.ghi, su_lo = nsu_lo, su_hi = nsu_hi, sv_lo = nsv_lo, sv_hi = nsv_hi;
            v4u hb[8]; float hinv;
            u14_h2(N, S2, hq, l16, li, lq, hb, hinv);
            u14_meta_load(N, F.ws, t + (tt < 15 ? 1 : 0), l16);
            float w_lo = 0.f, w_hi = 0.f;
#define U16_STEP(UU, RL, RW, IDS, NB) { \
            const int u = (UU); \
            u16_rows(RL, (IDS), (NB), EU, rof); \
            __builtin_amdgcn_sched_barrier(0); \
            LAS unsigned char* tn = tile + ((u + 1) & 1) * U16_BUF; \
            u16_write(RW, tn, l16); \
            const f32x4 acc = u16_mma(A, hb); \
            LDS_WAIT(); asm volatile("" ::: "memory"); \
            u16_read(A, tn, li, lq); \
            const int base = (u & 7) * 8; const int r = (li >> 1) & 3; \
            const float sel = r == 0 ? acc[0] : (r == 1 ? acc[1] : (r == 2 ? acc[2] : acc[3])); \
            const int sl = ((lane & 7) >> 2) * 16 + 2 * (lane & 3);                          \
            const float dmine = __shfl(sel, sl) + __shfl(sel, sl + 33); \
            const float gsel = u < 8 ? g_lo : g_hi, susel = u < 8 ? su_lo : su_hi, svsel = u < 8 ? sv_lo : sv_hi; \
            const float wv = gsel * gelu_erf(dmine * susel * hinv) * svsel; \
            const bool mine = (lane >= base) && (lane < base + 8); \
            if (u < 8) w_lo = mine ? wv : w_lo; else w_hi = mine ? wv : w_hi; }
#pragma unroll 1
            for (int u2 = 0; u2 < 14; u2 += 2) { const int ua = u2 + 2, ub = u2 + 3;
                U16_STEP(u2, r0, r1, ua < 8 ? e_lo : e_hi, (ua & 7) * 8)
                U16_STEP(u2 + 1, r1, r0, ub < 8 ? e_lo : e_hi, (ub & 7) * 8) }
            U16_STEP(14, r0, r1, N.elo, 0)
            U16_STEP(15, r1, r0, N.elo, 8)
#undef U16_STEP
            nsu_lo = EUS[N.elo]; nsu_hi = EUS[N.ehi]; nsv_lo = EVS[N.elo]; nsv_hi = EVS[N.ehi];
            __builtin_amdgcn_sched_barrier(0);
            WSP(float, WS_GATE)[t * 128 + lane] = w_lo; WSP(float, WS_GATE)[t * 128 + 64 + lane] = w_hi;
        }
    }
}
typedef int i32x8 __attribute__((ext_vector_type(8)));
struct U15Meta { int elo, ehi; float glo, ghi; v4u xa, xb; float rst; };
__device__ __forceinline__ void u15_meta_load(U15Meta& M, const unsigned char* ws, size_t t, unsigned l16) {
    const unsigned l = l16 >> 4; const int* ep = (const int*)(ws + WS_EID) + t * 128; const float* gp = (const float*)(ws + WS_GATE) + t * 128;
    M.elo = ep[l]; M.ehi = ep[64 + l]; M.glo = gp[l]; M.ghi = gp[64 + l];
    const char* xs = (const char*)(ws + WS_X1S) + t * 2048 + 2u * l16; M.xa = *(const v4u*)xs; M.xb = *(const v4u*)(xs + 16);
    M.rst = ((const float*)(ws + WS_ROWSTAT))[t];
}
__device__ __forceinline__ void u15_h2(const U15Meta& M, const float* S2, LAS unsigned char* hq, unsigned l16, int li, int lq, v4u* hb, float& hinv) {
    float h2[16]; unpack8(M.xa, h2); unpack8(M.xb, h2 + 8); float mx = 0.f;
    const float rs = rsqrt_f(M.rst * (1.0f / 1024.0f) + EPSF);
#pragma unroll
    for (int i = 0; i < 16; ++i) { h2[i] = h2[i] * rs + S2[i]; mx = fmaxf(mx, fabsf(h2[i])); }
#pragma unroll
    for (int o = 1; o < 64; o <<= 1) mx = fmaxf(mx, __shfl_xor(mx, o));
    mx = fmaxf(mx, 1e-30f); const float hs = 224.0f / mx; hinv = mx * (1.0f / 224.0f);
    v4u w;
#pragma unroll
    for (int qd = 0; qd < 4; ++qd) { int pk = 0; pk = __builtin_amdgcn_cvt_pk_fp8_f32(h2[4 * qd] * hs, h2[4 * qd + 1] * hs, pk, false); pk = __builtin_amdgcn_cvt_pk_fp8_f32(h2[4 * qd + 2] * hs, h2[4 * qd + 3] * hs, pk, true); w[qd] = (unsigned)pk; }
    *(LAS v4u*)(hq + l16) = w;
    LDS_WAIT(); asm volatile("" ::: "memory");
#pragma unroll
    for (int c = 0; c < 4; ++c) { const int o = (li & 1) * 512 + 128 * (lq >> 1) + 32 * c + 16 * (lq & 1); hb[2 * c] = *(const LAS v4u*)(hq + o); hb[2 * c + 1] = *(const LAS v4u*)(hq + o + 256); }
    LDS_WAIT(); asm volatile("" ::: "memory");
}
__device__ __forceinline__ void p8_peer_up15(Frame& F) {
    const int f_tid = threadIdx.x, lane = f_tid & 63, f_wave = __builtin_amdgcn_readfirstlane(f_tid >> 6);
    const int li = lane & 15, lq = lane >> 4;
    const unsigned char* EU = F.ws + WS_EU; const float* EUS = WSP(float, WS_EUS); const float* EVS = WSP(float, WS_EVS);
    LAS unsigned char* hq = F.lds + f_wave * 1024;
    for (int wq = F.vcu * NWAVES + f_wave; wq < MTOK / 16; wq += F.G * NWAVES) {
        const int b = wq >> 7; const float* mb = WSP(float, WS_MOD) + (size_t)b * 6144;
        unsigned l16 = 16u * (unsigned)lane; asm volatile("" : "+v"(l16));
        unsigned qof = 16u * (unsigned)(4 * (li >> 3) + lq); asm volatile("" : "+v"(qof));
        const int rsel = li & 7;
        float S2[16];
#pragma unroll
        for (int q = 0; q < 4; ++q) { const f32x4 sh = *(const f32x4*)((const char*)(mb + 3072) + 4u * l16 + 16 * q); S2[4 * q] = sh[0]; S2[4 * q + 1] = sh[1]; S2[4 * q + 2] = sh[2]; S2[4 * q + 3] = sh[3]; }
        const size_t t0 = (size_t)wq * 16;
        U15Meta N; u15_meta_load(N, F.ws, t0, l16);
        float nsu_lo = EUS[N.elo], nsu_hi = EUS[N.ehi], nsv_lo = EVS[N.elo], nsv_hi = EVS[N.ehi];
        v4u qa[6], qb[6];
        { const int e = __shfl(N.elo, rsel); const unsigned char* rp = EU + ((unsigned)e * 768u + qof);
#pragma unroll
          for (int i = 0; i < 6; ++i) qa[i] = *(const v4u*)(rp + 128 * i); }
#pragma unroll 1
        for (int tt = 0; tt < 16; ++tt) {
            const size_t t = t0 + tt;
            const int e_lo = N.elo, e_hi = N.ehi; const float g_lo = N.glo, g_hi = N.ghi, su_lo = nsu_lo, su_hi = nsu_hi, sv_lo = nsv_lo, sv_hi = nsv_hi;
            v4u hb[8]; float hinv;
            u15_h2(N, S2, hq, l16, li, lq, hb, hinv);
            u15_meta_load(N, F.ws, t + (tt < 15 ? 1 : 0), l16);
            float w_lo = 0.f, w_hi = 0.f;
#define U15_STEP(UU, CUR, NXT, NLO, NHI) { \
            const int u = (UU); const int un = (u + 1) & 15; const int nb = (un & 7) * 8; const int ensel = un < 8 ? (NLO) : (NHI); \
            { const int e = __shfl(ensel, nb + rsel); const unsigned char* rp = EU + ((unsigned)e * 768u + qof); \
              _Pragma("unroll") for (int i = 0; i < 6; ++i) NXT[i] = *(const v4u*)(rp + 128 * i); } \
            __builtin_amdgcn_sched_barrier(0); \
            f32x4 acc = (f32x4){0.f, 0.f, 0.f, 0.f}; \
            { const i32x8 B0 = (i32x8){(int)hb[0][0], (int)hb[0][1], (int)hb[0][2], (int)hb[0][3], (int)hb[1][0], (int)hb[1][1], (int)hb[1][2], (int)hb[1][3]}; \
              const i32x8 B1 = (i32x8){(int)hb[2][0], (int)hb[2][1], (int)hb[2][2], (int)hb[2][3], (int)hb[3][0], (int)hb[3][1], (int)hb[3][2], (int)hb[3][3]}; \
              const i32x8 B2 = (i32x8){(int)hb[4][0], (int)hb[4][1], (int)hb[4][2], (int)hb[4][3], (int)hb[5][0], (int)hb[5][1], (int)hb[5][2], (int)hb[5][3]}; \
              const i32x8 B3 = (i32x8){(int)hb[6][0], (int)hb[6][1], (int)hb[6][2], (int)hb[6][3], (int)hb[7][0], (int)hb[7][1], (int)hb[7][2], (int)hb[7][3]}; \
              const i32x8 A0 = (i32x8){(int)CUR[0][0], (int)CUR[0][1], (int)CUR[0][2], (int)CUR[0][3], (int)CUR[1][0], (int)CUR[1][1], 0, 0}; \
              const i32x8 A1 = (i32x8){(int)CUR[1][2], (int)CUR[1][3], (int)CUR[2][0], (int)CUR[2][1], (int)CUR[2][2], (int)CUR[2][3], 0, 0}; \
              const i32x8 A2 = (i32x8){(int)CUR[3][0], (int)CUR[3][1], (int)CUR[3][2], (int)CUR[3][3], (int)CUR[4][0], (int)CUR[4][1], 0, 0}; \
              const i32x8 A3 = (i32x8){(int)CUR[4][2], (int)CUR[4][3], (int)CUR[5][0], (int)CUR[5][1], (int)CUR[5][2], (int)CUR[5][3], 0, 0}; \
              acc = __builtin_amdgcn_mfma_scale_f32_16x16x128_f8f6f4(A0, B0, acc, 2, 0, 0, 0, 0, 0);        \
              acc = __builtin_amdgcn_mfma_scale_f32_16x16x128_f8f6f4(A1, B1, acc, 2, 0, 0, 0, 0, 0); \
              acc = __builtin_amdgcn_mfma_scale_f32_16x16x128_f8f6f4(A2, B2, acc, 2, 0, 0, 0, 0, 0); \
              acc = __builtin_amdgcn_mfma_scale_f32_16x16x128_f8f6f4(A3, B3, acc, 2, 0, 0, 0, 0, 0); } \
            const int base = (u & 7) * 8; const int r = (li >> 1) & 3; \
            const float sel = r == 0 ? acc[0] : (r == 1 ? acc[1] : (r == 2 ? acc[2] : acc[3])); \
            const int sl = ((lane & 7) >> 2) * 16 + 2 * (lane & 3);                          \
            const float dmine = __shfl(sel, sl) + __shfl(sel, sl + 33); \
            const float gsel = u < 8 ? g_lo : g_hi, susel = u < 8 ? su_lo : su_hi, svsel = u < 8 ? sv_lo : sv_hi; \
            const float wv = gsel * gelu_erf(dmine * susel * hinv) * svsel; \
            const bool mine = (lane >= base) && (lane < base + 8); \
            if (u < 8) w_lo = mine ? wv : w_lo; else w_hi = mine ? wv : w_hi; }
#pragma unroll 1
            for (int u2 = 0; u2 < 14; u2 += 2) { U15_STEP(u2, qa, qb, e_lo, e_hi) U15_STEP(u2 + 1, qb, qa, e_lo, e_hi) }
            U15_STEP(14, qa, qb, e_lo, e_hi)
            U15_STEP(15, qb, qa, N.elo, N.ehi)
#undef U15_STEP
            nsu_lo = EUS[N.elo]; nsu_hi = EUS[N.ehi]; nsv_lo = EVS[N.elo]; nsv_hi = EVS[N.ehi];
            __builtin_amdgcn_sched_barrier(0);
            WSP(float, WS_GATE)[t * 128 + lane] = w_lo; WSP(float, WS_GATE)[t * 128 + 64 + lane] = w_hi;
        }
    }
}
#ifdef TOPK2
#define P7FN p5b_topk2
#else
#define P7FN p5b_topk
#endif
constexpr int NPHASE = 10;
__global__ void __launch_bounds__(NTHR, 2) fwd_mega(Args args) {
    extern __shared__ __attribute__((aligned(16))) unsigned char lds[];
    Frame F;
    F.lds = (LAS unsigned char*)lds;
    F.MISC = (volatile LAS unsigned*)(F.lds + MISC_OFF);
    F.G = gridDim.x; { const int bx = blockIdx.x; F.vcu = (F.G % 8 == 0) ? (bx % 8) * (F.G / 8) + bx / 8 : bx; }
    F.ws = args.ws; F.out = args.out;
    F.a = &args;
    for (int u = threadIdx.x; u < 32; u += NTHR) F.MISC[u] = 0u;
    __syncthreads();
    const int lo = args.ph_lo, hi = args.ph_hi;
#ifdef PROBE_PHASE_T
    unsigned long long pt0 = 0ull;
#endif
    const bool use_bar = (hi - lo) > 1;
    XcdBarrier bar; bar.bar = (unsigned*)(F.ws + WS_CTL); bar.x = 0; bar.st = nullptr;
    if (use_bar) bar = xcd_barrier_post((unsigned*)(F.ws + WS_CTL), F.MISC + 8);
#define IN(k) (lo <= (k) && (k) < hi)
#ifdef PROBE_PHASE_T
#define SEAM(k) do { if (IN(k) && IN((k) + 1)) xcd_barrier(bar); if ((k) + 1 == PROBE_PHASE_T) pt0 = __builtin_amdgcn_s_memrealtime(); if ((k) == PROBE_PHASE_T && blockIdx.x == 0 && threadIdx.x == 0) *(volatile float*)(F.ws + WS_CTL + 40000) = (float)(__builtin_amdgcn_s_memrealtime() - pt0) * 0.01f; } while (0)
#else
#define SEAM(k) do { if (IN(k) && IN((k) + 1)) xcd_barrier(bar); } while (0)
#endif
#ifndef REP_PHASE
#define REP_PHASE -1
#endif
#define REPEAT(k, body) do { if (REP_PHASE == (k)) { xcd_barrier(bar); body; } } while (0)
    if (IN(0)) {
#ifndef SKIP_P0
 p0_phase(F); REPEAT(0, p0_phase(F));
#endif
 } SEAM(0);
    if (IN(1)) {
#ifndef SKIP_P1
 p1_phase(F); REPEAT(1, p1_phase(F));
#endif
 } SEAM(1);
    if (IN(2)) {
        pg8::Gemm g{WSP(bf16, WS_H1), WSP(bf16, WS_WINT), MTOK, NPROJ, 1024}; pg8::StaticOrder S; S.init(MTOK, NPROJ, F.G, (int)blockIdx.x);
        pg8::EpiProj E{WSP(bf16, WS_PROJ), NPROJ};
        pg8::gemm_phase<pg8::EpiProj, pg8::StaticOrder, true, true>(F.lds, g, S, E);
        REPEAT(2, (pg8::gemm_phase<pg8::EpiProj, pg8::StaticOrder, true, true>(F.lds, g, S, E)));
    } SEAM(2);
    if (IN(3)) {
#ifndef SKIP_SSD
 p3pre_conv(F); xcd_barrier(bar); p3_ssd3(F); REPEAT(30, p3_ssd3(F)); REPEAT(32, p3pre_conv(F));
#endif
#ifndef SKIP_S5
 p3_s5v2(F); REPEAT(31, p3_s5v2(F));
#endif
 } SEAM(3);
    if (IN(5)) {
        pg8::Gemm g{WSP(bf16, WS_Y), WSP(bf16, WS_WOUTT), MTOK, 1024, 2048}; pg8::StaticOrder S; S.init(MTOK, 1024, F.G, (int)blockIdx.x);
        PG8_LAS float* tab = (PG8_LAS float*)(F.lds + pg8::STAGE_BYTES);
        { pg8::Unit u; for (int i = 0; S.next(i, u); ++i) pg8::SegScaleHook::build(F.lds + pg8::STAGE_BYTES, u, WSP(float, WS_STSSD), WSP(float, WS_STS5), (int)threadIdx.x); }
        __syncthreads();
        pg8::EpiX1 E{(F.a->in[0]), F.out, WSP(bf16, WS_X1S), WSP(float, WS_MOD), (F.a->in[24]), WSP(float, WS_ROWSTAT), tab};
        pg8::SegScaleHook H;
        pg8::gemm_phase<pg8::EpiX1, pg8::StaticOrder, true, true, pg8::SegScaleHook>(F.lds, g, S, E, H);
    } SEAM(5);
    if (IN(6)) {
        pg8::Gemm g{WSP(bf16, WS_X1S), WSP(bf16, WS_WQKT), MTOK, 2048, 1024}; pg8::StaticOrder S; S.init(MTOK, 2048, F.G, (int)blockIdx.x);
        pg8::EpiScores E{WSP(_Float16, WS_SCORES), WSP(float, WS_SB), WSP(float, WS_ROWSTAT)};
        pg8::gemm_phase<pg8::EpiScores, pg8::StaticOrder, true, true>(F.lds, g, S, E);
        REPEAT(6, (pg8::gemm_phase<pg8::EpiScores, pg8::StaticOrder, true, true>(F.lds, g, S, E)));
    } SEAM(6);
    if (IN(7)) {
#ifndef SKIP_TOPK
 P7FN(F); REPEAT(7, P7FN(F));
#endif
 } SEAM(7);
#ifdef UP16
    if (IN(8)) { p8_peer_up16(F); REPEAT(8, { P7FN(F); xcd_barrier(bar); p8_peer_up16(F); }); } SEAM(8);
#elif defined(UP15)
    if (IN(8)) { p8_peer_up15(F); REPEAT(8, { P7FN(F); xcd_barrier(bar); p8_peer_up15(F); }); } SEAM(8);
#elif defined(UP14)
    if (IN(8)) { p8_peer_up14(F); REPEAT(8, { P7FN(F); xcd_barrier(bar); p8_peer_up14(F); }); } SEAM(8);
#elif defined(UP12)
    if (IN(8)) { p8_peer_up12(F); REPEAT(8, { P7FN(F); xcd_barrier(bar); p8_peer_up12(F); }); } SEAM(8);
#elif defined(UP11)
    if (IN(8)) { p8_peer_up11(F); REPEAT(8, { P7FN(F); xcd_barrier(bar); p8_peer_up11(F); }); } SEAM(8);
#elif defined(UP10)
    if (IN(8)) { p8_peer_up10(F); } SEAM(8);
#else
    if (IN(8)) { p8_peer_up6(F); REPEAT(8, { P7FN(F); xcd_barrier(bar); p8_peer_up6(F); }); } SEAM(8);
#endif
#ifdef V6
    if (IN(9)) { p9_peer_down3(F); }
#else
    if (IN(9)) { p9_peer_down2(F); }
#endif
#ifdef PROBE_OUT
#if defined(PROBE_PHASE_T) && PROBE_PHASE_T == 9
    if (blockIdx.x == 0 && threadIdx.x == 0) *(volatile float*)(F.ws + WS_CTL + 40000) = (float)(__builtin_amdgcn_s_memrealtime() - pt0) * 0.01f;
#endif
    if (IN(9)) { __syncthreads(); if (blockIdx.x == 0 && threadIdx.x == 0) { asm volatile("s_waitcnt vmcnt(0)" ::: "memory"); F.out[0] = *(volatile float*)(F.ws + WS_CTL + 40000); } }
#endif
#undef IN
#undef SEAM
}

#ifndef N_LAUNCHES
#define N_LAUNCHES 1
#endif
extern "C" void kernel_launch(void* const* d_in, const int* in_sizes, int n_in, void* d_out, int out_size, void* d_ws, size_t ws_size, hipStream_t stream) {
    static int grid = 0;
    if (grid == 0) {
        if (n_in != 30 || in_sizes[0] != MTOK * DM || out_size != MTOK * DM || ws_size < WS_END) { fprintf(stderr, "kernel_launch: unexpected shapes (n_in %d, in0 %d, out %d, ws %zu)\n", n_in, n_in > 0 ? in_sizes[0] : -1, out_size, ws_size); grid = -1; return; }
        int dev = 0, cus = 0, per_cu = 0;
        if (hipGetDevice(&dev) != hipSuccess || hipDeviceGetAttribute(&cus, hipDeviceAttributeMultiprocessorCount, dev) != hipSuccess) { grid = -1; return; }
        if (hipFuncSetAttribute((const void*)fwd_mega, hipFuncAttributeMaxDynamicSharedMemorySize, LDS_BYTES) != hipSuccess) { fprintf(stderr, "kernel_launch: hipFuncSetAttribute failed\n"); grid = -1; return; }
        if (hipOccupancyMaxActiveBlocksPerMultiprocessor(&per_cu, (const void*)fwd_mega, NTHR, LDS_BYTES) != hipSuccess || per_cu < 1) { fprintf(stderr, "kernel_launch: occupancy query says %d\n", per_cu); (void)hipGetLastError(); grid = -1; return; }
        if (cus != 256) { fprintf(stderr, "kernel_launch: built for a 256-CU device (got %d CUs); nothing launched\n", cus); grid = -1; return; }
        grid = cus;
    }
    if (grid < 0) return;
    (void)hipMemsetAsync((char*)d_ws + WS_CTL, 0, CTL_ZERO_BYTES, stream);
    Args a{};
    for (int i = 0; i < 30; ++i) a.in[i] = (const float*)d_in[i];
    a.out = (float*)d_out; a.ws = (unsigned char*)d_ws;
    if (N_LAUNCHES == 1) {
        a.ph_lo = 0; a.ph_hi = NPHASE;
        void* kargs[] = {&a};
#ifdef PLAIN_LAUNCH
        (void)kargs; hipLaunchKernelGGL(fwd_mega, dim3(grid), dim3(NTHR), LDS_BYTES, stream, a);
#else
        hipError_t e = hipLaunchCooperativeKernel((const void*)fwd_mega, dim3(grid), dim3(NTHR), kargs, LDS_BYTES, stream);
        if (e != hipSuccess) fprintf(stderr, "kernel_launch: cooperative launch failed: %s (grid %d)\n", hipGetErrorString(e), grid);
#endif
    } else {
        for (int p = 0; p < NPHASE; ++p) { a.ph_lo = p; a.ph_hi = p + 1; hipLaunchKernelGGL(fwd_mega, dim3(grid), dim3(NTHR), LDS_BYTES, stream, a); }
    }
}
```

```cpp
#define V6
#define UP14
#define HWENC
#define DN3B
#define X1B
#include <hip/hip_runtime.h>
#include <cstdio>
#include <cstdint>
namespace pg8 {
#define PG8_LAS __attribute__((address_space(3)))
typedef unsigned short bf16_t;
typedef short bf16x8 __attribute__((ext_vector_type(8)));
typedef float f32x4 __attribute__((ext_vector_type(4)));
typedef unsigned u32x4 __attribute__((ext_vector_type(4)));
constexpr int BM = 256, BK = 64, HALF = 128, HTB = HALF * BK * 2  , STAGE_BYTES = 8 * HTB, NXCD = 8, WGM = 8;

__host__ __device__ __forceinline__ int lds_byte(int r, int c) { const int st = (r >> 4) * 2 + (c >> 5), rr = r & 15, cc = c & 31, ob = rr * 64 + cc * 2; return st * 1024 + (ob ^ (((ob >> 9) & 1) << 5)); }
__host__ __device__ __forceinline__ void stage_rc(int b, int& R, int& C) { const int st = b / 1024, sb = b % 1024, swz = sb ^ (((sb >> 9) & 1) << 5); R = (st >> 1) * 16 + swz / 64; C = (st & 1) * 32 + (swz % 64) / 2; }
__host__ __device__ __forceinline__ int perm32(int rho) { const int n = rho >> 4, i = rho & 15; return 8 * (i >> 2) + 4 * n + (i & 3); }

struct Unit { int pm, pn; };
struct Gemm { const bf16_t* A; const bf16_t* Bt; int M, N, K; };

struct StaticOrder {
    int nM, nN, nwg, G, c;
    __host__ __device__ void init(int M, int N, int G_, int c_) { nM = M / BM; nN = N / BM; nwg = nM * nN; G = G_; c = c_; }
    __host__ __device__ bool next(int i, Unit& u) const {
        const long L = (long)i * G + c; if (L >= nwg) return false;
        int wgid = (int)L; { const int q = nwg / NXCD, r = nwg % NXCD, xcd = wgid % NXCD, off = wgid / NXCD; wgid = (xcd < r ? xcd * (q + 1) : r * (q + 1) + (xcd - r) * q) + off; }
        const int nig = WGM * nN, gid = wgid / nig, fm = gid * WGM, gsz = (nM - fm) < WGM ? (nM - fm) : WGM;
        u.pm = fm + ((wgid % nig) % gsz); u.pn = (wgid % nig) / gsz; return true;
    }
    __device__ __forceinline__ void a_ready(const Unit&) const {}
    __device__ __forceinline__ void done(const Unit&) const {}
};

__device__ __forceinline__ unsigned cvt_pk_bf16(float lo, float hi) { unsigned r; asm volatile("v_cvt_pk_bf16_f32 %0, %1, %2" : "=v"(r) : "v"(lo), "v"(hi)); return r; }
typedef float f32x2 __attribute__((ext_vector_type(2)));
struct NoHook { __device__ __forceinline__ void at_tile(int, const Unit&, f32x4 (&)[2][2][4][2], PG8_LAS unsigned char*, int, int) const {} };
template <class Epi, class Sched, bool ALIGN_EPI = false, bool SP2 = false, class Hook = NoHook>
__device__ __forceinline__ void gemm_phase(PG8_LAS unsigned char* lds, const Gemm g, const Sched& S, const Epi& E, const Hook& H = Hook()) {
    const int tid = threadIdx.x, wid = __builtin_amdgcn_readfirstlane(tid >> 6), lane = tid & 63, wr = wid >> 2, wc = wid & 3, fr = lane & 15, fq = lane >> 4;
    const int K = g.K, nt = K / BK;
    unsigned voffA[2], voffB[2];
#pragma unroll
    for (int i = 0; i < 2; ++i) { int R, C; stage_rc(tid * 16 + i * 8192, R, C); const int Rb = Epi::PERM ? ((R & ~31) + perm32(R & 31)) : R;
        voffA[i] = (unsigned)(R * K + C) * 2u; voffB[i] = (unsigned)(Rb * K + C) * 2u; }
    const size_t kstep = (size_t)(BK * 2);
    const size_t hstep = (size_t)HALF * K * 2;
    const size_t tstep = 2 * hstep;
    const unsigned ldsw = (unsigned)wid * 1024u;
    const int aoff = lds_byte(wr * 64 + fr, fq * 8), boff = lds_byte(wc * 32 + fr, fq * 8);
#define PG8_SA(b, h) (((b) * 2 + (h)) * HTB)
#define PG8_SB(b, h) ((4 + (b) * 2 + (h)) * HTB)
#define PG8_STAGE(bufoff, gbase, voff) do { _Pragma("unroll") for (int _i = 0; _i < 2; ++_i) \
        __builtin_amdgcn_global_load_lds((const unsigned*)((const char*)(gbase) + (voff)[_i]), (PG8_LAS unsigned*)(lds + (bufoff) + ldsw + _i * 8192), 16, 0, 0); } while (0)
#define PG8_LDA(dst, b, h) do { _Pragma("unroll") for (int m = 0; m < 4; ++m) _Pragma("unroll") for (int k = 0; k < 2; ++k) dst[m][k] = *(const PG8_LAS bf16x8*)(lds + PG8_SA(b, h) + aoff + m * 2048 + k * 1024); } while (0)
#define PG8_LDB(dst, b, h) do { _Pragma("unroll") for (int n = 0; n < 2; ++n) _Pragma("unroll") for (int k = 0; k < 2; ++k) dst[n][k] = *(const PG8_LAS bf16x8*)(lds + PG8_SB(b, h) + boff + n * 2048 + k * 1024); } while (0)
#define PG8_MMA(ai, bj, At, Bt) do { __builtin_amdgcn_s_setprio(1); _Pragma("unroll") for (int m = 0; m < 4; ++m) _Pragma("unroll") for (int n = 0; n < 2; ++n) _Pragma("unroll") for (int k = 0; k < 2; ++k) \
        acc[ai][bj][m][n] = __builtin_amdgcn_mfma_f32_16x16x32_bf16(Bt[n][k], At[m][k], acc[ai][bj][m][n], 0, 0, 0); __builtin_amdgcn_s_setprio(0); } while (0)
#define PG8_WAIT_V(n) asm volatile("s_waitcnt vmcnt(" #n ")" ::: "memory")
#define PG8_WAIT_L(n) asm volatile("s_waitcnt lgkmcnt(" #n ")" ::: "memory")
#define PG8_BAR __builtin_amdgcn_s_barrier()
#define PG8_SCHED __builtin_amdgcn_sched_barrier(0)
    Unit cur, nxt; int ui = 0;
    if (!S.next(0, cur)) return;
    f32x4 acc[2][2][4][2];
#pragma unroll
    for (int a = 0; a < 2; ++a)
#pragma unroll
        for (int b = 0; b < 2; ++b)
#pragma unroll
            for (int m = 0; m < 4; ++m)
#pragma unroll
                for (int n = 0; n < 2; ++n) acc[a][b][m][n] = (f32x4){0.f, 0.f, 0.f, 0.f};
    bf16x8 At[4][2], B0[2][2], B1[2][2];
    const char* cA = (const char*)g.A + (size_t)cur.pm * tstep; const char* cB = (const char*)g.Bt + (size_t)cur.pn * tstep;
    S.a_ready(cur);
    if constexpr (SP2) {
        PG8_STAGE(PG8_SB(0, 0), cB, voffB); PG8_STAGE(PG8_SB(0, 1), cB + hstep, voffB); PG8_STAGE(PG8_SA(0, 0), cA, voffA); PG8_STAGE(PG8_SA(0, 1), cA + hstep, voffA);
        if (wr == 1) PG8_BAR;
        PG8_WAIT_V(2); PG8_BAR;
        PG8_STAGE(PG8_SB(1, 0), cB + kstep, voffB); PG8_STAGE(PG8_SA(1, 0), cA + kstep, voffA); PG8_STAGE(PG8_SB(1, 1), cB + hstep + kstep, voffB);
        PG8_WAIT_V(6); PG8_BAR;
    } else {
        PG8_STAGE(PG8_SB(0, 0), cB, voffB); PG8_STAGE(PG8_SA(0, 0), cA, voffA); PG8_STAGE(PG8_SB(0, 1), cB + hstep, voffB); PG8_STAGE(PG8_SA(0, 1), cA + hstep, voffA);
        if (wr == 1) PG8_BAR;
        PG8_WAIT_V(4); PG8_BAR;
        PG8_STAGE(PG8_SB(1, 0), cB + kstep, voffB); PG8_STAGE(PG8_SA(1, 0), cA + kstep, voffA); PG8_STAGE(PG8_SB(1, 1), cB + hstep + kstep, voffB);
        PG8_WAIT_V(6); PG8_BAR;
    }
    for (;;) {
        const bool has_next = S.next(ui + 1, nxt);
        const char* nA = has_next ? (const char*)g.A + (size_t)nxt.pm * tstep : cA; const char* nB = has_next ? (const char*)g.Bt + (size_t)nxt.pn * tstep : cB;
        for (int t = 0; t < nt; t += 2) {
            const bool last = (t == nt - 2);
            H.at_tile(t, cur, acc, lds + STAGE_BYTES, wr, fr);
            const char* a1 = cA + (size_t)(t + 1) * kstep;
            const char* a2 = last ? nA : cA + (size_t)(t + 2) * kstep; const char* b2 = last ? nB : cB + (size_t)(t + 2) * kstep;
            const char* a3 = a2 + kstep; const char* b3 = b2 + kstep;
            if (last && has_next) S.a_ready(nxt);
            if constexpr (SP2) {
            PG8_LDB(B0, 0, 0); PG8_LDB(B1, 0, 1); PG8_SCHED; PG8_LDA(At, 0, 0); PG8_STAGE(PG8_SA(1, 1), a1 + hstep, voffA);
            PG8_WAIT_V(8); PG8_WAIT_L(0); PG8_BAR; PG8_MMA(0, 0, At, B0); PG8_MMA(0, 1, At, B1); PG8_BAR; PG8_SCHED;
            PG8_LDA(At, 0, 1); PG8_STAGE(PG8_SB(0, 0), b2, voffB); PG8_STAGE(PG8_SB(0, 1), b2 + hstep, voffB); PG8_STAGE(PG8_SA(0, 0), a2, voffA);
            PG8_WAIT_V(8); PG8_WAIT_L(0); PG8_BAR; PG8_MMA(1, 0, At, B0); PG8_MMA(1, 1, At, B1); PG8_BAR; PG8_SCHED;
            PG8_LDB(B0, 1, 0); PG8_LDB(B1, 1, 1); PG8_SCHED; PG8_LDA(At, 1, 0); PG8_STAGE(PG8_SA(0, 1), a2 + hstep, voffA);
            PG8_WAIT_V(8); PG8_WAIT_L(0); PG8_BAR; PG8_MMA(0, 0, At, B0); PG8_MMA(0, 1, At, B1); PG8_BAR; PG8_SCHED;
            PG8_LDA(At, 1, 1); PG8_STAGE(PG8_SB(1, 0), b3, voffB); PG8_STAGE(PG8_SB(1, 1), b3 + hstep, voffB); PG8_STAGE(PG8_SA(1, 0), a3, voffA);
            PG8_WAIT_V(8); PG8_WAIT_L(0); PG8_BAR; PG8_MMA(1, 0, At, B0); PG8_MMA(1, 1, At, B1); PG8_BAR; PG8_SCHED;
            } else {
            PG8_LDB(B0, 0, 0); PG8_SCHED; PG8_LDA(At, 0, 0); PG8_STAGE(PG8_SA(1, 1), a1 + hstep, voffA);
            PG8_WAIT_L(8); PG8_BAR; PG8_WAIT_L(0); PG8_MMA(0, 0, At, B0); PG8_BAR; PG8_SCHED;
            PG8_LDB(B1, 0, 1); PG8_STAGE(PG8_SB(0, 0), b2, voffB);
            PG8_BAR; PG8_WAIT_L(0); PG8_MMA(0, 1, At, B1); PG8_BAR;
            PG8_LDA(At, 0, 1); PG8_STAGE(PG8_SA(0, 0), a2, voffA);
            PG8_BAR; PG8_WAIT_L(0); PG8_MMA(1, 0, At, B0); PG8_BAR; PG8_SCHED;
            PG8_STAGE(PG8_SB(0, 1), b2 + hstep, voffB);
            PG8_WAIT_V(6); PG8_BAR; PG8_MMA(1, 1, At, B1); PG8_BAR;
            PG8_LDB(B0, 1, 0); PG8_SCHED; PG8_LDA(At, 1, 0); PG8_STAGE(PG8_SA(0, 1), a2 + hstep, voffA);
            PG8_WAIT_L(8); PG8_BAR; PG8_WAIT_L(0); PG8_MMA(0, 0, At, B0); PG8_BAR; PG8_SCHED;
            PG8_LDB(B1, 1, 1); PG8_STAGE(PG8_SB(1, 0), b3, voffB);
            PG8_BAR; PG8_WAIT_L(0); PG8_MMA(0, 1, At, B1); PG8_BAR;
            PG8_LDA(At, 1, 1); PG8_STAGE(PG8_SA(1, 0), a3, voffA);
            PG8_BAR; PG8_WAIT_L(0); PG8_MMA(1, 0, At, B0); PG8_BAR; PG8_SCHED;
            PG8_STAGE(PG8_SB(1, 1), b3 + hstep, voffB);
            PG8_WAIT_V(6); PG8_BAR; PG8_MMA(1, 1, At, B1); PG8_BAR;
            }
        }
        if constexpr (ALIGN_EPI) { if (wr == 0) PG8_BAR; }
        if constexpr (!Epi::AFTER_DRAIN) { E(acc, cur, wr, wc, fr, fq);
#ifdef PROBE_EPI2
            if constexpr (Epi::PROBE_TWICE) { asm volatile("" ::: "memory"); E(acc, cur, wr, wc, fr, fq); }
#endif
            S.done(cur); }
        if (!has_next) break;
#pragma unroll
        for (int a = 0; a < 2; ++a)
#pragma unroll
            for (int b = 0; b < 2; ++b)
#pragma unroll
                for (int m = 0; m < 4; ++m)
#pragma unroll
                    for (int n = 0; n < 2; ++n) acc[a][b][m][n] = (f32x4){0.f, 0.f, 0.f, 0.f};
        cur = nxt; cA = nA; cB = nB; ++ui;
        if constexpr (ALIGN_EPI) { if (wr == 1) PG8_BAR; }
    }
    PG8_WAIT_V(0);
    if constexpr (!ALIGN_EPI) { if (wr == 0) PG8_BAR; }
    PG8_BAR;
    if constexpr (Epi::AFTER_DRAIN) { E.fused(acc, cur, wr, wc, fr, fq, lds, wid, lane); S.done(cur); }
#undef PG8_SA
#undef PG8_SB
#undef PG8_STAGE
#undef PG8_LDA
#undef PG8_LDB
#undef PG8_MMA
#undef PG8_WAIT_V
#undef PG8_WAIT_L
#undef PG8_BAR
#undef PG8_SCHED
}
}
namespace pg8 {
struct EpiProj {
    static constexpr bool PERM = true, AFTER_DRAIN = false, PROBE_TWICE = true;
    bf16_t* O; int ldc;
    __device__ __forceinline__ void operator()(const f32x4 (&acc)[2][2][4][2], const Unit& u, int wr, int wc, int fr, int fq) const {
        const int row0 = u.pm * BM + wr * 64 + fr; const int col0 = u.pn * BM + wc * 32 + 8 * fq;
#pragma unroll
        for (int ai = 0; ai < 2; ++ai)
#pragma unroll
            for (int m = 0; m < 4; ++m) { bf16_t* rowp = O + (size_t)(row0 + ai * HALF + m * 16) * ldc + col0;
#pragma unroll
                for (int bj = 0; bj < 2; ++bj) { const f32x4 v0 = acc[ai][bj][m][0], v1 = acc[ai][bj][m][1];
                    u32x4 w; w.x = cvt_pk_bf16(v0[0], v0[1]); w.y = cvt_pk_bf16(v0[2], v0[3]); w.z = cvt_pk_bf16(v1[0], v1[1]); w.w = cvt_pk_bf16(v1[2], v1[3]);
                    __builtin_nontemporal_store(w, (u32x4*)(rowp + bj * HALF)); } }
    }
};
struct EpiX1 {
    static constexpr bool PERM = true, AFTER_DRAIN = false, PROBE_TWICE = false;
    const float* x; float* x1; bf16_t* x1s; const float* mod; const float* norm2_g; float* rowstat; PG8_LAS float* tab;
    __device__ __forceinline__ void operator()(const f32x4 (&acc)[2][2][4][2], const Unit& u, int wr, int wc, int fr, int fq) const {
        const int row0 = u.pm * BM + wr * 64 + fr; const int col0 = u.pn * BM + wc * 32 + 8 * fq; const int b = (u.pm * BM) >> 11;
        const float* mb = mod + (size_t)b * 6144;
        f32x4 g1[2][2], g2[2][2];
#pragma unroll
        for (int bj = 0; bj < 2; ++bj)
#pragma unroll
            for (int n = 0; n < 2; ++n) { const int c = col0 + bj * HALF + 4 * n; g1[bj][n] = *(const f32x4*)(mb + 2048 + c);
                const f32x4 sc = *(const f32x4*)(mb + 4096 + c), ng = *(const f32x4*)(norm2_g + c); g2[bj][n] = ng * (sc + 1.0f); }
#pragma unroll
        for (int ai = 0; ai < 2; ++ai)
#pragma unroll
            for (int m = 0; m < 4; ++m) { const size_t row = (size_t)(row0 + ai * HALF + m * 16); const size_t off = row * 1024 + col0; float ss = 0.f;
                const float rfin = tab[((u.pm >> 3) & 1) * 1280 + 1024 + ai * HALF + wr * 64 + m * 16 + fr];
#pragma unroll
                for (int bj = 0; bj < 2; ++bj) {
                    const f32x4 xa = *(const f32x4*)(x + off + bj * HALF), xb = *(const f32x4*)(x + off + bj * HALF + 4);
                    const f32x4 v0 = xa + g1[bj][0] * (acc[ai][bj][m][0] * rfin), v1 = xb + g1[bj][1] * (acc[ai][bj][m][1] * rfin);
#ifdef X1B
                    { u32x4 wx; wx.x = cvt_pk_bf16(v0[0], v0[1]); wx.y = cvt_pk_bf16(v0[2], v0[3]); wx.z = cvt_pk_bf16(v1[0], v1[1]); wx.w = cvt_pk_bf16(v1[2], v1[3]); *(u32x4*)((bf16_t*)x1 + off + bj * HALF) = wx; }
#else
                    *(f32x4*)(x1 + off + bj * HALF) = v0; *(f32x4*)(x1 + off + bj * HALF + 4) = v1;
#endif
                    ss += (v0[0] * v0[0] + v0[1] * v0[1]) + (v0[2] * v0[2] + v0[3] * v0[3]) + (v1[0] * v1[0] + v1[1] * v1[1]) + (v1[2] * v1[2] + v1[3] * v1[3]);
                    const f32x4 s0 = v0 * g2[bj][0], s1 = v1 * g2[bj][1];
                    u32x4 w; w.x = cvt_pk_bf16(s0[0], s0[1]); w.y = cvt_pk_bf16(s0[2], s0[3]); w.z = cvt_pk_bf16(s1[0], s1[1]); w.w = cvt_pk_bf16(s1[2], s1[3]);
                    *(u32x4*)(x1s + off + bj * HALF) = w; }
                ss += __shfl_xor(ss, 16); ss += __shfl_xor(ss, 32);
                if (fq == 0) atomicAdd(rowstat + row, ss); }
    }
};
typedef _Float16 f16x8 __attribute__((ext_vector_type(8)));
struct EpiScores {
    static constexpr bool PERM = true, AFTER_DRAIN = false, PROBE_TWICE = false;
    _Float16* S; const float* sb; const float* rowstat;
    __device__ __forceinline__ void operator()(const f32x4 (&acc)[2][2][4][2], const Unit& u, int wr, int wc, int fr, int fq) const {
        const int row0 = u.pm * BM + wr * 64 + fr; const int col0 = u.pn * BM + wc * 32 + 8 * fq; const int b = (u.pm * BM) >> 11;
        f32x4 bv[2][2];
#pragma unroll
        for (int bj = 0; bj < 2; ++bj)
#pragma unroll
            for (int n = 0; n < 2; ++n) bv[bj][n] = *(const f32x4*)(sb + (size_t)b * 2048 + col0 + bj * HALF + 4 * n);
#pragma unroll
        for (int ai = 0; ai < 2; ++ai)
#pragma unroll
            for (int m = 0; m < 4; ++m) { const size_t row = (size_t)(row0 + ai * HALF + m * 16); const float rs = __builtin_amdgcn_rsqf(rowstat[row] * (1.0f / 1024.0f) + 1e-6f);
                _Float16* rowp = S + row * 2048 + col0;
#pragma unroll
                for (int bj = 0; bj < 2; ++bj) { const f32x4 v0 = acc[ai][bj][m][0] * rs + bv[bj][0], v1 = acc[ai][bj][m][1] * rs + bv[bj][1];
                    f16x8 h; h[0] = (_Float16)v0[0]; h[1] = (_Float16)v0[1]; h[2] = (_Float16)v0[2]; h[3] = (_Float16)v0[3]; h[4] = (_Float16)v1[0]; h[5] = (_Float16)v1[1]; h[6] = (_Float16)v1[2]; h[7] = (_Float16)v1[3];
                    *(f16x8*)(rowp + bj * HALF) = h; } }
    }
};
struct SegScaleHook {
    __device__ __forceinline__ static void build(PG8_LAS unsigned char* ldsx, const Unit& u, const float* st_ssd, const float* st_s5, int tid) {
        PG8_LAS float* tab = (PG8_LAS float*)ldsx + ((u.pm >> 3) & 1) * 1280;
        if (tid < 256) { const size_t row = (size_t)u.pm * BM + tid; const f32x4* sg = (const f32x4*)(st_ssd + row * 16); const f32x4* s5 = (const f32x4*)(st_s5 + row * 64);
            float r[5];
#pragma unroll
            for (int gI = 0; gI < 4; ++gI) { const f32x4 v = sg[gI]; r[gI] = __builtin_amdgcn_rsqf(((v[0] + v[1]) + (v[2] + v[3])) * (1.0f / 256.0f) + 1e-6f); }
            float a5 = 0.f;
#pragma unroll
            for (int q = 0; q < 16; ++q) { const f32x4 v = s5[q]; a5 += (v[0] + v[1]) + (v[2] + v[3]); }
            r[4] = __builtin_amdgcn_rsqf(a5 * (1.0f / 1024.0f) + 1e-6f);
#pragma unroll
            for (int k = 0; k < 4; ++k) tab[k * 256 + tid] = r[k] * __builtin_amdgcn_rcpf(r[k + 1]);
            tab[1024 + tid] = r[4]; }
    }
    __device__ __forceinline__ void at_tile(int t, const Unit& u, f32x4 (&acc)[2][2][4][2], PG8_LAS unsigned char* ldsx, int wr, int fr) const {
        if (t == 4 || t == 8 || t == 12 || t == 16) { const PG8_LAS float* rt = (const PG8_LAS float*)ldsx + ((u.pm >> 3) & 1) * 1280 + ((t >> 2) - 1) * 256 + wr * 64 + fr;
#pragma unroll
            for (int ai = 0; ai < 2; ++ai)
#pragma unroll
                for (int m = 0; m < 4; ++m) { const float r = rt[ai * HALF + m * 16];
#pragma unroll
                    for (int bj = 0; bj < 2; ++bj) { acc[ai][bj][m][0] = acc[ai][bj][m][0] * r; acc[ai][bj][m][1] = acc[ai][bj][m][1] * r; } } }
    }
};
}
constexpr int NWAVES = 8, NTHR = 512;
constexpr int DM = 1024, NB = 16, SEQ = 2048, MTOK = NB * SEQ;
constexpr int NPROJ = 4096;
constexpr int INW = 4112;
constexpr int NHEADS = 16, HDIM = 64, NGRP = 4, NST = 128, CHUNK = 128;
constexpr int S5G = 64, S5CH = 16, S5P = 64;
constexpr int PH = 8, PK = 16, PNK = 128;
constexpr float EPSF = 1e-6f;
constexpr int NS5PART = 64;

constexpr size_t MiB = 1u << 20;
constexpr size_t WS_CTL = 0, CTL_ZERO_BYTES = 64 * 1024;
constexpr size_t WS_MOD = 1 * MiB;
constexpr size_t WS_WDT = WS_MOD + 0x60000;
constexpr size_t WS_SB = WS_MOD + 0x70000;
constexpr size_t WS_ROWSTAT = WS_MOD + 0x90000;
constexpr size_t WS_S5LB = WS_MOD + 0xB0000;
constexpr size_t WS_S5BB = WS_MOD + 0xC0000;
constexpr size_t WS_DTRAW = 3 * MiB;
constexpr size_t WS_STSSD = 5 * MiB;
constexpr size_t WS_STS5 = 7 * MiB;
constexpr size_t WS_WINT = 15 * MiB;
constexpr size_t WS_WOUTT = 23 * MiB;
constexpr size_t WS_WQKT = 27 * MiB;
constexpr size_t WS_EU = 31 * MiB, WS_EV = 47 * MiB;
constexpr size_t WS_EUS = 63 * MiB, WS_EVS = 63 * MiB + 65536;
constexpr size_t WS_START = 64 * MiB;
constexpr size_t WS_A = 95 * MiB;
constexpr size_t WS_B = 223 * MiB;
constexpr size_t WS_H1 = WS_A, WS_Y = WS_A, WS_PROJ = WS_B, WS_SCORES = WS_A;
constexpr size_t WS_X1S = WS_B + 192 * MiB;
constexpr size_t WS_EID = 479 * MiB, WS_GATE = 495 * MiB;
constexpr size_t WS_H2Q = WS_B, WS_HINV = WS_B + 32 * MiB;
constexpr size_t WS_X1B = WS_B + 64 * MiB;
constexpr size_t WS_END = 511 * MiB;
static_assert(WS_SCORES + (size_t)MTOK * 2048 * 4 <= WS_X1S && WS_X1S + (size_t)MTOK * 1024 * 2 <= WS_EID && WS_GATE + (size_t)MTOK * 128 * 4 <= WS_END, "ws map");

constexpr int LDS_MAIN = 159744;
constexpr int MISC_OFF = LDS_MAIN;
constexpr int LDS_BYTES = LDS_MAIN + 128;

#define GAS __attribute__((address_space(1)))
#define LAS __attribute__((address_space(3)))
typedef unsigned short bf16;
typedef unsigned v4u __attribute__((ext_vector_type(4)));
typedef unsigned v2u __attribute__((ext_vector_type(2)));
typedef float f32x4 __attribute__((ext_vector_type(4)));
typedef float f32x2 __attribute__((ext_vector_type(2)));
typedef short bf16x8 __attribute__((ext_vector_type(8)));
#define LDS_WAIT() asm volatile("s_waitcnt lgkmcnt(0)" ::: "memory")
#define VM_WAIT() asm volatile("s_waitcnt vmcnt(0)" ::: "memory")
typedef __bf16 hwbf16x2 __attribute__((ext_vector_type(2)));
__device__ __forceinline__ unsigned pk2(float lo, float hi) { const f32x2 v = {lo, hi}; const hwbf16x2 b = __builtin_convertvector(v, hwbf16x2); return __builtin_bit_cast(unsigned, b); }
__device__ __forceinline__ unsigned f2bf(float f) { return pk2(f, 0.f) & 0xffffu; }
__device__ __forceinline__ float bflo(unsigned w) { return __builtin_bit_cast(float, w << 16); }
__device__ __forceinline__ float bfhi(unsigned w) { return __builtin_bit_cast(float, w & 0xffff0000u); }
__device__ __forceinline__ float bf2f(bf16 v) { return __builtin_bit_cast(float, (unsigned)v << 16); }
__device__ __forceinline__ float wave_sum(float v) {
#pragma unroll
    for (int o = 1; o < 64; o <<= 1) v += __shfl_xor(v, o);
    return v;
}
__device__ __forceinline__ float sigmoid_f(float v) { return __builtin_amdgcn_rcpf(1.0f + __builtin_amdgcn_exp2f(-1.4426950408889634f * v)); }
__device__ __forceinline__ float silu_f(float v) { return v * sigmoid_f(v); }
__device__ __forceinline__ float rsqrt_f(float v) { return __builtin_amdgcn_rsqf(v); }
__device__ __forceinline__ float gelu_erf(float v) {
    const float av = fabsf(v), t = __builtin_amdgcn_rcpf(av * 0.2316418882f + 1.0f);
    float q = t * 0.5307027145f + (-0.7265760135f); q = q * t + 0.7107068705f; q = q * t + (-0.142248368f); q = q * t + 0.127414796f; q = q * t;
    const float e = __builtin_amdgcn_exp2f((v * v) * (-0.72134752044f));
    const float m = v * (q * e);
    return v < 0.f ? m : v - m;
}
__device__ __forceinline__ float softplus_f(float v) { const float e = __builtin_amdgcn_exp2f(-1.4426950408889634f * fabsf(v));
    const float l = e < 1e-6f ? e : 0.6931471805599453f * __builtin_amdgcn_logf(1.0f + e); return fmaxf(v, 0.f) + l; }
__device__ __forceinline__ void unpack8(const v4u w, float* f) { f[0] = bflo(w.x); f[1] = bfhi(w.x); f[2] = bflo(w.y); f[3] = bfhi(w.y); f[4] = bflo(w.z); f[5] = bfhi(w.z); f[6] = bflo(w.w); f[7] = bfhi(w.w); }
#define LDS_BARRIER() do { asm volatile("s_waitcnt lgkmcnt(0)" ::: "memory"); __builtin_amdgcn_s_barrier(); asm volatile("" ::: "memory"); } while (0)
__device__ __forceinline__ float row16_sum_to15(float v) {
    v += __builtin_bit_cast(float, __builtin_amdgcn_update_dpp(0, __builtin_bit_cast(int, v), 0x118, 0xf, 0xf, true));
    v += __builtin_bit_cast(float, __builtin_amdgcn_update_dpp(0, __builtin_bit_cast(int, v), 0x114, 0xf, 0xf, true));
    v += __builtin_bit_cast(float, __builtin_amdgcn_update_dpp(0, __builtin_bit_cast(int, v), 0x112, 0xf, 0xf, true));
    v += __builtin_bit_cast(float, __builtin_amdgcn_update_dpp(0, __builtin_bit_cast(int, v), 0x111, 0xf, 0xf, true));
    return v;
}
__device__ __forceinline__ float wave_sum_to63(float v) {
    v = row16_sum_to15(v);
    v += __builtin_bit_cast(float, __builtin_amdgcn_update_dpp(0, __builtin_bit_cast(int, v), 0x142, 0xa, 0xf, false));
    v += __builtin_bit_cast(float, __builtin_amdgcn_update_dpp(0, __builtin_bit_cast(int, v), 0x143, 0xc, 0xf, false));
    return v;
}
__device__ __forceinline__ f32x2 gelu_pk2(f32x2 v) {
    const f32x2 av = __builtin_elementwise_abs(v), d = av * 0.2316418882f + 1.0f;
    f32x2 t; t[0] = __builtin_amdgcn_rcpf(d[0]); t[1] = __builtin_amdgcn_rcpf(d[1]);
    f32x2 q = t * 0.5307027145f + (-0.7265760135f); q = q * t + 0.7107068705f; q = q * t + (-0.142248368f); q = q * t + 0.127414796f; q = q * t;
    const f32x2 s = (v * v) * (-0.72134752044f);
    f32x2 e; e[0] = __builtin_amdgcn_exp2f(s[0]); e[1] = __builtin_amdgcn_exp2f(s[1]);
    const f32x2 m = v * (q * e), r = v - m;
    f32x2 o; o[0] = v[0] < 0.f ? m[0] : r[0]; o[1] = v[1] < 0.f ? m[1] : r[1]; return o;
}
#define XB_TMO      128
#define XB_XCNT(j)  (256  + 64 * (j))
#define XB_XSUB(j)  (1280 + 64 * (j))
#define XB_XGEN(j)  (2304 + 64 * (j))
#define XB_TOP      3328
#define XB_TOPGEN   3392
#define XCD_BAR_WORDS 3456
#define XB_SPIN_CAP (1u << 18)

__device__ __forceinline__ unsigned xb_ld(unsigned* p)              { return __hip_atomic_load(p, __ATOMIC_RELAXED, __HIP_MEMORY_SCOPE_AGENT); }
__device__ __forceinline__ unsigned xb_add(unsigned* p, unsigned v) { return __hip_atomic_fetch_add(p, v, __ATOMIC_RELAXED, __HIP_MEMORY_SCOPE_AGENT); }
__device__ __forceinline__ unsigned xb_xcc_id() { return (unsigned)__builtin_amdgcn_s_getreg((3 << 11) | 20) & 0xFu; }
#define XB_SPIN(cond, bar) do { unsigned _sp = 0; while (cond) { __builtin_amdgcn_s_sleep(1); \
    if ((++_sp & 255u) == 0u) { if (xb_ld(&(bar)[XB_TMO])) break; if (_sp > XB_SPIN_CAP) { atomicAdd(&(bar)[XB_TMO], 1u); break; } } } } while (0)

struct XcdBarrier {
    unsigned* bar; unsigned x;
    volatile LAS unsigned* st;
};

__device__ __forceinline__ XcdBarrier xcd_barrier_post(unsigned* bar, volatile LAS unsigned* st) {
    XcdBarrier b; b.bar = bar; b.x = xb_xcc_id(); b.st = st;
    if (threadIdx.x == 0) (void)xb_add(&bar[XB_XCNT(b.x)], 1u);
    return b;
}
__device__ __forceinline__ void xcd_barrier_complete(unsigned* bar, unsigned x, unsigned& nloc, unsigned& nx) {
    const unsigned G = gridDim.x * gridDim.y * gridDim.z;
    unsigned sum, cnt, mine, sp = 0u;
    for (;;) {
        sum = 0u; cnt = 0u; mine = 0u;
#pragma unroll
        for (unsigned j = 0; j < 16; ++j) { const unsigned c = xb_ld(&bar[XB_XCNT(j)]); sum += c; cnt += (c > 0u) ? 1u : 0u; mine = (j == x) ? c : mine; }
        if (sum == G) break;
        __builtin_amdgcn_s_sleep(1);
        if ((++sp & 255u) == 0u) { if (xb_ld(&bar[XB_TMO])) break; if (sp > XB_SPIN_CAP) { atomicAdd(&bar[XB_TMO], 1u); break; } }
    }
    nloc = mine > 0u ? mine : 1u; nx = cnt > 0u ? cnt : 1u;
}

__device__ __forceinline__ void xcd_barrier(const XcdBarrier& b) {
    asm volatile("s_waitcnt vmcnt(0)" ::: "memory");
    __syncthreads();
    if (threadIdx.x == 0) {
        unsigned* bar = b.bar;
        __builtin_amdgcn_s_waitcnt(0);
        unsigned nloc = b.st[0], nx = b.st[1];
        if (nloc == 0u) { xcd_barrier_complete(bar, b.x, nloc, nx); b.st[0] = nloc; b.st[1] = nx; }
        const unsigned old = xb_add(&bar[XB_XSUB(b.x)], 1u);
        const unsigned gen = old / nloc;
        if (old + 1u == (gen + 1u) * nloc) {
            __builtin_amdgcn_fence(__ATOMIC_RELEASE, "agent");
            asm volatile("s_waitcnt vmcnt(0)" ::: "memory");
            const unsigned og = xb_add(&bar[XB_TOP], 1u);
            const unsigned tg = og / nx;
            if (og + 1u == (tg + 1u) * nx) xb_add(&bar[XB_TOPGEN], 1u);
            else XB_SPIN(xb_ld(&bar[XB_TOPGEN]) == tg, bar);
            __builtin_amdgcn_fence(__ATOMIC_ACQUIRE, "agent");
            xb_add(&bar[XB_XGEN(b.x)], 1u);
            asm volatile("s_waitcnt vmcnt(0)" ::: "memory");
        } else {
            XB_SPIN(xb_ld(&bar[XB_XGEN(b.x)]) == gen, bar);
            __builtin_amdgcn_fence(__ATOMIC_ACQUIRE, "agent");
            asm volatile("s_waitcnt vmcnt(0)" ::: "memory");
        }
    }
    __syncthreads();
}
struct Args { const float* in[30]; float* out; unsigned char* ws; int ph_lo, ph_hi; };
struct Frame {
    LAS unsigned char* lds;
    volatile LAS unsigned* MISC;
    int vcu, G;
    unsigned char* ws;
    const Args* a;
    float* out;
};
#define WSP(T, off) ((T*)(F.ws + (off)))

__device__ __forceinline__ void transpose_tile(const float* W, int ldw, int k0, int src_n0, bf16* WT, int K, int dst_n0, LAS float* scr, int lane, const float* kscale) {
#pragma unroll 8
    for (int i = 0; i < 32; ++i) { const int kk = 2 * i + (lane >> 5); float v = W[(size_t)(k0 + kk) * ldw + src_n0 + (lane & 31)]; if (kscale) v *= kscale[k0 + kk]; scr[kk * 33 + (lane & 31)] = v; }
    LDS_WAIT(); asm volatile("" ::: "memory");
    const int c = lane & 7;
#pragma unroll
    for (int j = 0; j < 4; ++j) { const int n = (lane >> 3) + 8 * j; const LAS float* s = scr + (8 * c) * 33 + n;
        v4u o; o.x = pk2(s[0 * 33], s[1 * 33]); o.y = pk2(s[2 * 33], s[3 * 33]); o.z = pk2(s[4 * 33], s[5 * 33]); o.w = pk2(s[6 * 33], s[7 * 33]);
        *(v4u*)(WT + (size_t)(dst_n0 + n) * K + k0 + 8 * c) = o; }
    LDS_WAIT(); asm volatile("" ::: "memory");
}
__device__ __forceinline__ void p0_phase(Frame& F) {
    const int f_tid = threadIdx.x, f_lane = f_tid & 63, f_wave = __builtin_amdgcn_readfirstlane(f_tid >> 6);
    const int gw = F.vcu * NWAVES + f_wave, NGW = F.G * NWAVES, gt = F.vcu * NTHR + f_tid, NGT = F.G * NTHR;
    {
        LAS float* sc = (LAS float*)F.lds;
        LAS float* red = (LAS float*)(F.lds + 65536);
        for (int i = f_tid; i < 16 * 1024; i += NTHR) { const int b = i >> 10, k = i & 1023; sc[k * 16 + b] = silu_f((F.a->in[1])[i]); }
        __syncthreads();
        const int ks = f_tid / 24, col = f_tid - ks * 24, j = F.vcu * 24 + col;
        if (ks < 21) {
            float acc[16];
#pragma unroll
            for (int b = 0; b < 16; ++b) acc[b] = 0.f;
            const int k0 = ks * 49, kn = (k0 + 49 <= 1024) ? 49 : (1024 - k0);
            const float* wp = (F.a->in[2]) + (size_t)k0 * 6144 + j;
#pragma unroll 1
            for (int kb = 0; kb < 49; kb += 7) {
                asm volatile("" ::: "memory");
                float wv[7];
#pragma unroll
                for (int u = 0; u < 7; ++u) wv[u] = (kb + u < kn) ? wp[(size_t)(kb + u) * 6144] : 0.f;
#pragma unroll
                for (int u = 0; u < 7; ++u) { const int kk = (kb + u < kn) ? (k0 + kb + u) : k0; const LAS f32x4* s4 = (const LAS f32x4*)(sc + kk * 16);
#pragma unroll
                    for (int q = 0; q < 4; ++q) { const f32x4 sv = s4[q]; acc[4 * q] += sv[0] * wv[u]; acc[4 * q + 1] += sv[1] * wv[u]; acc[4 * q + 2] += sv[2] * wv[u]; acc[4 * q + 3] += sv[3] * wv[u]; } }
            }
#pragma unroll
            for (int b = 0; b < 16; ++b) red[(ks * 16 + b) * 24 + col] = acc[b];
        }
        __syncthreads();
        for (int i = f_tid; i < 16 * 24; i += NTHR) { const int b = i / 24, cc = i - b * 24; float sacc = 0.f;
            for (int q = 0; q < 21; ++q) sacc += red[(q * 16 + b) * 24 + cc];
            WSP(float, WS_MOD)[b * 6144 + F.vcu * 24 + cc] = sacc + (F.a->in[3])[F.vcu * 24 + cc]; }
        __syncthreads();
    }
    {
        LAS float* scr = (LAS float*)(F.lds + f_wave * 16384);
        constexpr int I_IN = (1024 / 64) * (NPROJ / 32), I_OUT = (2048 / 64) * (1024 / 32);
        for (int it = gw; it < I_IN + I_OUT; it += NGW) {
            if (it < I_IN) { const int kb = it / (NPROJ / 32), nb = it % (NPROJ / 32); const int dn = 32 * nb, sn = dn < 3072 ? dn : dn + 16;
                transpose_tile((F.a->in[5]), INW, 64 * kb, sn, WSP(bf16, WS_WINT), 1024, dn, scr, f_lane, nullptr); }
            else { const int r = it - I_IN, kb = r / 32, nb = r % 32; const int k0 = 64 * kb;
                transpose_tile((F.a->in[23]), 1024, k0, 32 * nb, WSP(bf16, WS_WOUTT), 2048, 32 * nb, scr, f_lane, k0 < 1024 ? (F.a->in[11]) : (F.a->in[22]) - 1024); }
        }
    }
    for (int i = gt; i < 16 * 1024; i += NGT) { const int h = i >> 10, k = i & 1023; WSP(float, WS_WDT)[i] = (F.a->in[5])[(size_t)k * INW + 3072 + h]; }
    for (int task = gw; task < 2048; task += NGW) {
        const int nt = task >> 4, ks = task & 15, n0 = 16 * nt, hc = n0 >> 7, k0 = 64 * ks;
        const int li = f_lane & 15, lq = f_lane >> 4;
        f32x4 acc[4];
#pragma unroll
        for (int s = 0; s < 4; ++s) acc[s] = (f32x4){0.f, 0.f, 0.f, 0.f};
        const float* ap = (F.a->in[26]) + (size_t)(n0 + li) * 128 + 4 * lq;
        const float* bp = (F.a->in[25]) + (size_t)(k0 + li) * 2048 + hc * 128 + 4 * lq;
#pragma unroll
        for (int q = 0; q < 8; ++q) { const f32x4 a = *(const f32x4*)(ap + 16 * q);
#pragma unroll
            for (int s = 0; s < 4; ++s) { const f32x4 b = *(const f32x4*)(bp + (size_t)(16 * s) * 2048 + 16 * q);
#pragma unroll
                for (int jj = 0; jj < 4; ++jj) acc[s] = __builtin_amdgcn_mfma_f32_16x16x4f32(a[jj], b[jj], acc[s], 0, 0, 0); } }
        bf16* o = WSP(bf16, WS_WQKT);
#pragma unroll
        for (int s = 0; s < 4; ++s)
#pragma unroll
            for (int r = 0; r < 4; ++r) o[(size_t)(n0 + 4 * lq + r) * 1024 + k0 + 16 * s + li] = (bf16)f2bf(acc[s][r]);
    }
    for (int i = gt; i < S5G * S5P; i += NGT) {
        const float lr = (F.a->in[12])[i], li = (F.a->in[13])[i], dt = expf((F.a->in[14])[i >> 6]);
        const float mag = expf(lr * dt); float sn, cs; sincosf(li * dt, &sn, &cs);
        const float lbr = mag * cs, lbi = mag * sn, den = lr * lr + li * li;
        const float cfr = ((lbr - 1.0f) * lr + lbi * li) / den, cfi = (lbi * lr - (lbr - 1.0f) * li) / den;
        WSP(float, WS_S5LB)[2 * i] = lbr; WSP(float, WS_S5LB)[2 * i + 1] = lbi;
        for (int hh = 0; hh < 16; ++hh) { const float br = (F.a->in[15])[i * 16 + hh], bi = (F.a->in[16])[i * 16 + hh];
            WSP(float, WS_S5BB)[i * 32 + hh] = cfr * br - cfi * bi; WSP(float, WS_S5BB)[i * 32 + 16 + hh] = cfr * bi + cfi * br; }
    }
    for (int i = gt; i < MTOK; i += NGT) WSP(float, WS_ROWSTAT)[i] = 0.f;
}

__device__ __forceinline__ void p1_phase(Frame& F) {
    const int f_tid = threadIdx.x, f_lane = f_tid & 63, f_wave = __builtin_amdgcn_readfirstlane(f_tid >> 6);
    const int gw = F.vcu * NWAVES + f_wave;
    LAS float* wdt = (LAS float*)F.lds;
    for (int i = f_tid; i < 16 * 1024 / 4; i += NTHR) ((LAS f32x4*)wdt)[i] = ((const f32x4*)WSP(float, WS_WDT))[i];
    __syncthreads();
    const int lane = f_lane;
    for (int wq = gw; wq < MTOK / 16; wq += F.G * NWAVES) {
        const int b = wq >> 7; const float* mb = WSP(float, WS_MOD) + (size_t)b * 6144;
        f32x4 Gv[4], Sv[4];
#pragma unroll
        for (int j = 0; j < 4; ++j) { const int k = 4 * lane + 256 * j; const f32x4 g = *(const f32x4*)((F.a->in[4]) + k), sc = *(const f32x4*)(mb + 1024 + k); Gv[j] = g * (sc + 1.0f); Sv[j] = *(const f32x4*)(mb + k); }
        f32x4 nx[4];
#pragma unroll
        for (int j = 0; j < 4; ++j) nx[j] = *(const f32x4*)((F.a->in[0]) + (size_t)wq * 16 * 1024 + 4 * lane + 256 * j);
        for (int tt = 0; tt < 16; ++tt) {
            asm volatile("" ::: "memory");
            const size_t t = (size_t)wq * 16 + tt; const float* xr = (F.a->in[0]) + t * 1024;
            f32x4 v[4]; float ss = 0.f;
#pragma unroll
            for (int j = 0; j < 4; ++j) { v[j] = nx[j]; ss += (v[j][0] * v[j][0] + v[j][1] * v[j][1]) + (v[j][2] * v[j][2] + v[j][3] * v[j][3]); }
            if (tt < 15) {
#pragma unroll
                for (int j = 0; j < 4; ++j) nx[j] = *(const f32x4*)(xr + 1024 + 4 * lane + 256 * j); }
            const float rstd = rsqrt_f(wave_sum(ss) * (1.0f / 1024.0f) + EPSF);
            bf16* hr = WSP(bf16, WS_H1) + t * 1024;
#pragma unroll
            for (int j = 0; j < 4; ++j) { v[j] = v[j] * rstd * Gv[j] + Sv[j]; v2u w; w.x = pk2(v[j][0], v[j][1]); w.y = pk2(v[j][2], v[j][3]); *(v2u*)(hr + 4 * lane + 256 * j) = w; }
            float d[16];
#pragma unroll
            for (int h = 0; h < 16; ++h) { float a = 0.f;
#pragma unroll
                for (int j = 0; j < 4; ++j) { const f32x4 w = *(const LAS f32x4*)(wdt + h * 1024 + 4 * lane + 256 * j); a += (v[j][0] * w[0] + v[j][1] * w[1]) + (v[j][2] * w[2] + v[j][3] * w[3]); }
                d[h] = a; }
            float e8[8], e4[4], e2[2], e1;
#pragma unroll
            for (int i = 0; i < 8; ++i) { const bool up = lane & 32; const float snd = up ? d[i] : d[i + 8]; const float rcv = __shfl_xor(snd, 32); e8[i] = (up ? d[i + 8] : d[i]) + rcv; }
#pragma unroll
            for (int i = 0; i < 4; ++i) { const bool up = lane & 16; const float snd = up ? e8[i] : e8[i + 4]; const float rcv = __shfl_xor(snd, 16); e4[i] = (up ? e8[i + 4] : e8[i]) + rcv; }
#pragma unroll
            for (int i = 0; i < 2; ++i) { const bool up = lane & 8; const float snd = up ? e4[i] : e4[i + 2]; const float rcv = __shfl_xor(snd, 8); e2[i] = (up ? e4[i + 2] : e4[i]) + rcv; }
            { const bool up = lane & 4; const float snd = up ? e2[0] : e2[1]; const float rcv = __shfl_xor(snd, 4); e1 = (up ? e2[1] : e2[0]) + rcv; }
            e1 += __shfl_xor(e1, 2); e1 += __shfl_xor(e1, 1);
            const int head = ((lane >> 5) & 1) * 8 + ((lane >> 4) & 1) * 4 + ((lane >> 3) & 1) * 2 + ((lane >> 2) & 1);
            if ((lane & 3) == 0) WSP(float, WS_DTRAW)[t * 16 + head] = e1;
        }
    }
    for (int n = gw; n < 2048; n += F.G * NWAVES) {
        const bf16* wr = WSP(bf16, WS_WQKT) + (size_t)n * 1024 + 16 * lane;
        const v4u w0 = *(const v4u*)wr, w1 = *(const v4u*)(wr + 8);
        float wv[16]; wv[0] = bflo(w0.x); wv[1] = bfhi(w0.x); wv[2] = bflo(w0.y); wv[3] = bfhi(w0.y); wv[4] = bflo(w0.z); wv[5] = bfhi(w0.z); wv[6] = bflo(w0.w); wv[7] = bfhi(w0.w);
        wv[8] = bflo(w1.x); wv[9] = bfhi(w1.x); wv[10] = bflo(w1.y); wv[11] = bfhi(w1.y); wv[12] = bflo(w1.z); wv[13] = bfhi(w1.z); wv[14] = bflo(w1.w); wv[15] = bfhi(w1.w);
        for (int b = 0; b < 16; ++b) { const float* sp = WSP(float, WS_MOD) + (size_t)b * 6144 + 3072 + 16 * lane; float a = 0.f;
#pragma unroll
            for (int q = 0; q < 4; ++q) { const f32x4 s = *(const f32x4*)(sp + 4 * q); a += (s[0] * wv[4 * q] + s[1] * wv[4 * q + 1]) + (s[2] * wv[4 * q + 2] + s[3] * wv[4 * q + 3]); }
            a = wave_sum(a); if (lane == 0) WSP(float, WS_SB)[b * 2048 + n] = a; }
    }
}
__device__ __forceinline__ void p3pre_conv(Frame& F) {
    const int tid = threadIdx.x;
    const bf16* proj = WSP(bf16, WS_PROJ); bf16* xo = (bf16*)F.out;
    for (int item = F.vcu * NTHR + tid; item < (MTOK / 16) * 256; item += F.G * NTHR) {
        const int oc = item & 255, run = item >> 8; const int t0 = run * 16, ch = 8 * oc;
        const bool halo = (t0 & (SEQ - 1)) != 0;
        v4u rw[19];
#pragma unroll
        for (int k = 0; k < 19; ++k) { rw[k] = (v4u){0u, 0u, 0u, 0u}; if (k >= 3 || halo) rw[k] = *(const v4u*)(proj + (size_t)(t0 - 3 + k) * NPROJ + 1024 + ch); }
        float cw[4][8], cbv[8];
#pragma unroll
        for (int k = 0; k < 4; ++k) { const f32x4 w0 = *(const f32x4*)((F.a->in[6]) + k * 2048 + ch), w1 = *(const f32x4*)((F.a->in[6]) + k * 2048 + ch + 4);
#pragma unroll
            for (int e = 0; e < 4; ++e) { cw[k][e] = w0[e]; cw[k][4 + e] = w1[e]; } }
        { const f32x4 b0 = *(const f32x4*)((F.a->in[7]) + ch), b1 = *(const f32x4*)((F.a->in[7]) + ch + 4);
#pragma unroll
            for (int e = 0; e < 4; ++e) { cbv[e] = b0[e]; cbv[4 + e] = b1[e]; } }
        float r0[8], r1[8], r2[8];
        unpack8(rw[0], r0); unpack8(rw[1], r1); unpack8(rw[2], r2);
#pragma unroll
        for (int tt = 0; tt < 16; ++tt) {
            float r3[8]; unpack8(rw[3 + tt], r3);
            float v[8];
#pragma unroll
            for (int i = 0; i < 8; ++i) { v[i] = silu_f(cbv[i] + r0[i] * cw[0][i] + r1[i] * cw[1][i] + r2[i] * cw[2][i] + r3[i] * cw[3][i]); r0[i] = r1[i]; r1[i] = r2[i]; r2[i] = r3[i]; }
            *(v4u*)(xo + (size_t)(t0 + tt) * 2048 + ch) = (v4u){pk2(v[0], v[1]), pk2(v[2], v[3]), pk2(v[4], v[5]), pk2(v[6], v[7])};
        }
    }
}
constexpr int SSD_PITCH = 272;
__device__ __forceinline__ bf16x8 lds_frag(LAS unsigned char* base, int row, int kbyte) { return *(const LAS bf16x8*)(base + row * SSD_PITCH + kbyte); }
#ifdef PROBE_SSD
#define SPR_T(v) const unsigned long long v = __builtin_amdgcn_s_memtime();
#define SPR_ACC(i, d) sacc[i] += (d);
#else
#define SPR_T(v)
#define SPR_ACC(i, d)
#endif
constexpr int S3_CS = 0, S3_BS = 34816, S3_GY = 69632, S3_XDT = 104448, S3_XP = 144, S3_PREV = 122880, S3_CSF = 140288, S3_DTF = 141312, S3_WTS = 142336, S3_END = 143360;
static_assert(S3_END <= LDS_MAIN, "SSD v3 LDS map");
typedef short v4i16_t __attribute__((ext_vector_type(4)));
__device__ __forceinline__ bf16x8 lds_frag_tr(LAS unsigned char* tile, int pitch, int k0, int col0, int li, int lq) {
    LAS unsigned char* p = tile + (k0 + 8 * lq + (li >> 2)) * pitch + (col0 + 4 * (li & 3)) * 2;
    const v4i16_t lo = __builtin_amdgcn_ds_read_tr16_b64_v4i16((LAS v4i16_t*)p), hi = __builtin_amdgcn_ds_read_tr16_b64_v4i16((LAS v4i16_t*)(p + 4 * pitch));
    return __builtin_shufflevector(lo, hi, 0, 1, 2, 3, 4, 5, 6, 7);
}
struct Ssd3Pre { v4u xr[4], br[4], cr[4]; float d0, d1; };
__device__ __forceinline__ void ssd3_prefetch(Ssd3Pre& P, const char* xcb, const float* dtr, unsigned voB, unsigned voX, int tid, int lane, int w) {
#pragma unroll
    for (int r = 0; r < 4; ++r) { P.br[r] = *(const v4u*)(xcb + (voB + r * 4096u)); P.cr[r] = *(const v4u*)(xcb + (voB + 1024u + r * 4096u)); }
#pragma unroll
    for (int r = 0; r < 4; ++r) P.xr[r] = *(const v4u*)(xcb + (voX + r * 4096u));
    P.d0 = dtr[lane * 32]; P.d1 = dtr[lane * 32 + 16];
}
__device__ __forceinline__ void ssd3_cumsum(LAS unsigned char* L, int par, float r0, float r1, float dtb, float A, int lane) {
    LAS float* csf = (LAS float*)(L + S3_CSF + par * 512); LAS float* dtf = (LAS float*)(L + S3_DTF + par * 512); LAS float* wts = (LAS float*)(L + S3_WTS + par * 512);
    const float d0 = softplus_f(r0 + dtb), d1 = softplus_f(r1 + dtb);
    const float a0 = d0 * A, a1 = d1 * A; float s = a0 + a1;
#pragma unroll
    for (int o = 1; o < 64; o <<= 1) { const float t = __shfl_up(s, o); if (lane >= o) s += t; }
    const float tot = __shfl(s, 63);
    dtf[2 * lane] = d0; dtf[2 * lane + 1] = d1; csf[2 * lane] = s - a1; csf[2 * lane + 1] = s;
    wts[2 * lane] = __expf(tot - (s - a1)); wts[2 * lane + 1] = __expf(tot - s);
}
__device__ __forceinline__ void p3_ssd3(Frame& F) {
    const int tid0 = threadIdx.x, w = __builtin_amdgcn_readfirstlane(tid0 >> 6);
    LAS unsigned char* L = F.lds;
    const bf16* proj = WSP(bf16, WS_PROJ); const bf16* xc = (const bf16*)F.out; const float* dtraw = WSP(float, WS_DTRAW);
    for (int item = F.vcu; item < NB * NHEADS; item += F.G) {
        const int b = item >> 4, h = item & 15, g = h >> 2;
        int tid = tid0; asm volatile("" : "+v"(tid)); int lane = tid & 63;
        const float A = -__expf((F.a->in[9])[h]), Dh = (F.a->in[10])[h], dtb = (F.a->in[8])[h];
        const int pbs = w >> 1, nb0 = 4 * (w & 1);
        f32x4 st[4];
#pragma unroll
        for (int j = 0; j < 4; ++j) st[j] = (f32x4){0.f, 0.f, 0.f, 0.f};
        __syncthreads();
        for (int i = tid; i < 17408 / 16; i += NTHR) ((LAS v4u*)(L + S3_PREV))[i] = (v4u){0u, 0u, 0u, 0u};
        Ssd3Pre P;
        { const unsigned voB0 = (unsigned)((4 * (tid >> 4)) * 2048 + 1024 + g * 128 + 8 * (tid & 15)) * 2u, voX0 = (unsigned)((4 * ((tid & 255) >> 3)) * 2048 + h * 64 + 8 * (tid & 7)) * 2u;
          ssd3_prefetch(P, (const char*)xc + (size_t)b * SEQ * 4096, dtraw + (size_t)b * SEQ * 16 + h, voB0, voX0, tid, lane, w); }
        if (w == 0) ssd3_cumsum(L, 0, P.d0, P.d1, dtb, A, lane);
        __syncthreads();
#ifdef PROBE_SSD
        unsigned long long sacc[8] = {0, 0, 0, 0, 0, 0, 0, 0};
#endif
        for (int c = 0; c < SEQ / CHUNK; ++c) {
            SPR_T(s0)
            const size_t row0 = (size_t)b * SEQ + (size_t)c * CHUNK; const int par = c & 1;
            asm volatile("" : "+v"(tid));
            lane = tid & 63; const int li = lane & 15, lq = lane >> 4;
            const unsigned voB = (unsigned)((4 * (tid >> 4)) * 2048 + 1024 + g * 128 + 8 * (tid & 15)) * 2u, voX = (unsigned)((4 * ((tid & 255) >> 3)) * 2048 + h * 64 + 8 * (tid & 7)) * 2u;
            const unsigned voZ0 = (unsigned)((tid >> 3) * NPROJ + h * 64 + 8 * (tid & 7)) * 2u, voZ1 = voZ0 + 64u * NPROJ * 2u;
            LAS float* csf = (LAS float*)(L + S3_CSF + par * 512); LAS float* dtf = (LAS float*)(L + S3_DTF + par * 512); LAS float* wts = (LAS float*)(L + S3_WTS + par * 512);
            { const int ob = tid & 15, lb = 4 * (tid >> 4), n0 = 8 * ob;
#pragma unroll
              for (int r = 0; r < 4; ++r) { *(LAS v4u*)(L + S3_BS + (lb + r) * SSD_PITCH + n0 * 2) = P.br[r]; *(LAS v4u*)(L + S3_CS + (lb + r) * SSD_PITCH + n0 * 2) = P.cr[r]; } }
            if (tid < 256) { const int ox = tid & 7, lx = 4 * (tid >> 3), p0 = 8 * ox;
#pragma unroll
              for (int r = 0; r < 4; ++r) { float xv[8]; unpack8(P.xr[r], xv); const float tw = dtf[lx + r];
                  *(LAS v4u*)(L + S3_XDT + (lx + r) * S3_XP + p0 * 2) = (v4u){pk2(xv[0] * tw, xv[1] * tw), pk2(xv[2] * tw, xv[3] * tw), pk2(xv[4] * tw, xv[5] * tw), pk2(xv[6] * tw, xv[7] * tw)}; } }
            const char* prb = (const char*)proj + row0 * (NPROJ * 2);
            const v4u zc0 = *(const v4u*)(prb + voZ0), zc1 = *(const v4u*)(prb + voZ1);
            SPR_T(s1) SPR_ACC(0, s1 - s0)
            LDS_BARRIER();
            SPR_T(s2) SPR_ACC(1, s2 - s1)
            const float cs_end = csf[127];
            bf16x8 ca[4];
#pragma unroll
            for (int ks = 0; ks < 4; ++ks) ca[ks] = lds_frag(L + S3_CS, 16 * w + li, 64 * ks + 16 * lq);
            float csl[4];
#pragma unroll
            for (int r = 0; r < 4; ++r) csl[r] = csf[16 * w + 4 * lq + r];
            { bf16x8 bq[2][4];
#pragma unroll
              for (int ks = 0; ks < 4; ++ks) bq[0][ks] = lds_frag(L + S3_BS, li, 64 * ks + 16 * lq);
#pragma unroll
              for (int sb = 0; sb < 8; ++sb) if (sb <= (w | 1)) {
                  f32x4 cbv = (f32x4){0.f, 0.f, 0.f, 0.f};
                  const int s = 16 * sb + li; const float css = csf[s];
                  if (sb <= w) {
                      if (sb + 1 <= w) {
#pragma unroll
                          for (int ks = 0; ks < 4; ++ks) bq[(sb + 1) & 1][ks] = lds_frag(L + S3_BS, 16 * (sb + 1) + li, 64 * ks + 16 * lq); }
                      __builtin_amdgcn_sched_barrier(0);
#pragma unroll
                      for (int ks = 0; ks < 4; ++ks) cbv = __builtin_amdgcn_mfma_f32_16x16x32_bf16(ca[ks], bq[sb & 1][ks], cbv, 0, 0, 0);
                      __builtin_amdgcn_sched_barrier(0); }
#pragma unroll
                  for (int r = 0; r < 4; ++r) { const int l = 16 * w + 4 * lq + r; const float gv = (s <= l) ? cbv[r] * __expf(csl[r] - css) : 0.f;
                      *(LAS unsigned short*)(L + S3_GY + l * SSD_PITCH + s * 2) = (unsigned short)f2bf(gv); } } }
            LDS_WAIT(); asm volatile("" ::: "memory");
            SPR_T(s3) SPR_ACC(2, s3 - s2)
            f32x4 yd[4], yo[4];
#pragma unroll
            for (int pb = 0; pb < 4; ++pb) { yd[pb] = (f32x4){0.f, 0.f, 0.f, 0.f}; yo[pb] = (f32x4){0.f, 0.f, 0.f, 0.f}; }
            { bf16x8 gq[2], xq[2][4];
              gq[0] = lds_frag(L + S3_GY, 16 * w + li, 16 * lq);
#pragma unroll
              for (int pb = 0; pb < 4; ++pb) xq[0][pb] = lds_frag_tr(L + S3_XDT, S3_XP, 0, 16 * pb, li, lq);
#pragma unroll
              for (int ks = 0; ks < 4; ++ks) if (ks <= (w >> 1)) {
                  if (ks + 1 <= (w >> 1)) { gq[(ks + 1) & 1] = lds_frag(L + S3_GY, 16 * w + li, 64 * (ks + 1) + 16 * lq);
#pragma unroll
                      for (int pb = 0; pb < 4; ++pb) xq[(ks + 1) & 1][pb] = lds_frag_tr(L + S3_XDT, S3_XP, 32 * (ks + 1), 16 * pb, li, lq); }
                  __builtin_amdgcn_sched_barrier(0);
#pragma unroll
                  for (int pb = 0; pb < 4; ++pb) yd[pb] = __builtin_amdgcn_mfma_f32_16x16x32_bf16(gq[ks & 1], xq[ks & 1][pb], yd[pb], 0, 0, 0);
                  __builtin_amdgcn_sched_barrier(0); } }
            { bf16x8 pq[2][4];
#pragma unroll
              for (int pb = 0; pb < 4; ++pb) pq[0][pb] = lds_frag(L + S3_PREV, 16 * pb + li, 16 * lq);
#pragma unroll
              for (int ks = 0; ks < 4; ++ks) {
                  if (ks < 3) {
#pragma unroll
                      for (int pb = 0; pb < 4; ++pb) pq[(ks + 1) & 1][pb] = lds_frag(L + S3_PREV, 16 * pb + li, 64 * (ks + 1) + 16 * lq); }
                  __builtin_amdgcn_sched_barrier(0);
#pragma unroll
                  for (int pb = 0; pb < 4; ++pb) yo[pb] = __builtin_amdgcn_mfma_f32_16x16x32_bf16(ca[ks], pq[ks & 1][pb], yo[pb], 0, 0, 0);
                  __builtin_amdgcn_sched_barrier(0); } }
#pragma unroll
            for (int r = 0; r < 4; ++r) { const float e = __expf(csl[r]);
#pragma unroll
                for (int pb = 0; pb < 4; ++pb) *(LAS float*)(L + S3_GY + (16 * w + 4 * lq + r) * SSD_PITCH + (16 * pb + li) * 4) = yd[pb][r] + e * yo[pb][r]; }
            { const size_t rown = row0 + (c + 1 < SEQ / CHUNK ? CHUNK : 0);
              ssd3_prefetch(P, (const char*)xc + rown * 4096, dtraw + rown * 16 + h, voB, voX, tid, lane, w); }
            SPR_T(s4) SPR_ACC(3, s4 - s3)
            LDS_BARRIER();
            SPR_T(s5) SPR_ACC(4, s5 - s4)
            { const float dec = __expf(cs_end);
#pragma unroll
              for (int j = 0; j < 4; ++j) st[j] = st[j] * dec;
              bf16x8 xq[2], bq2[2][4]; f32x4 wq[2][2];
              xq[0] = lds_frag_tr(L + S3_XDT, S3_XP, 0, 16 * pbs, li, lq); wq[0][0] = *(const LAS f32x4*)(wts + 8 * lq); wq[0][1] = *(const LAS f32x4*)(wts + 8 * lq + 4);
#pragma unroll
              for (int j = 0; j < 4; ++j) bq2[0][j] = lds_frag_tr(L + S3_BS, SSD_PITCH, 0, 16 * (nb0 + j), li, lq);
#pragma unroll
              for (int ks = 0; ks < 4; ++ks) {
                  if (ks < 3) { xq[(ks + 1) & 1] = lds_frag_tr(L + S3_XDT, S3_XP, 32 * (ks + 1), 16 * pbs, li, lq); wq[(ks + 1) & 1][0] = *(const LAS f32x4*)(wts + 32 * (ks + 1) + 8 * lq); wq[(ks + 1) & 1][1] = *(const LAS f32x4*)(wts + 32 * (ks + 1) + 8 * lq + 4);
#pragma unroll
                      for (int j = 0; j < 4; ++j) bq2[(ks + 1) & 1][j] = lds_frag_tr(L + S3_BS, SSD_PITCH, 32 * (ks + 1), 16 * (nb0 + j), li, lq); }
                  __builtin_amdgcn_sched_barrier(0);
                  const f32x4 w0 = wq[ks & 1][0], w1 = wq[ks & 1][1];
                  float xv[8]; unpack8(__builtin_bit_cast(v4u, xq[ks & 1]), xv);
                  const v4u xw = (v4u){pk2(xv[0] * w0[0], xv[1] * w0[1]), pk2(xv[2] * w0[2], xv[3] * w0[3]), pk2(xv[4] * w1[0], xv[5] * w1[1]), pk2(xv[6] * w1[2], xv[7] * w1[3])};
                  const bf16x8 xf = __builtin_bit_cast(bf16x8, xw);
#pragma unroll
                  for (int j = 0; j < 4; ++j) st[j] = __builtin_amdgcn_mfma_f32_16x16x32_bf16(xf, bq2[ks & 1][j], st[j], 0, 0, 0);
                  __builtin_amdgcn_sched_barrier(0); }
#pragma unroll
              for (int j = 0; j < 4; ++j)
#pragma unroll
                  for (int r = 0; r < 4; ++r) *(LAS unsigned short*)(L + S3_PREV + (16 * pbs + 4 * lq + r) * SSD_PITCH + (16 * (nb0 + j) + li) * 2) = (unsigned short)f2bf(st[j][r]); }
            SPR_T(s6) SPR_ACC(5, s6 - s5)
#pragma unroll
            for (int k = 0; k < 2; ++k) { const int it = tid + 512 * k, l = it >> 3, o = it & 7; const size_t row = row0 + l;
                const f32x4 y0 = *(const LAS f32x4*)(L + S3_GY + l * SSD_PITCH + 32 * o), y1 = *(const LAS f32x4*)(L + S3_GY + l * SSD_PITCH + 32 * o + 16);
                const v4u xw = *(const LAS v4u*)(L + S3_XDT + l * S3_XP + 16 * o); const v4u zw = k == 0 ? zc0 : zc1; const float dsk = Dh * __builtin_amdgcn_rcpf(fmaxf(dtf[l], 1e-30f));
                float xv[8], zv[8], yv[8]; unpack8(xw, xv); unpack8(zw, zv);
                float ss = 0.f;
#pragma unroll
                for (int e = 0; e < 8; ++e) { const float yy = (e < 4 ? y0[e] : y1[e - 4]) + dsk * xv[e]; yv[e] = yy * silu_f(zv[e]); ss += yv[e] * yv[e]; }
                ss += __shfl_xor(ss, 1); ss += __shfl_xor(ss, 2); ss += __shfl_xor(ss, 4);
                if (o == 0) WSP(float, WS_STSSD)[row * 16 + h] = ss;
                *(v4u*)(WSP(bf16, WS_Y) + row * 2048 + h * 64 + 8 * o) = (v4u){pk2(yv[0], yv[1]), pk2(yv[2], yv[3]), pk2(yv[4], yv[5]), pk2(yv[6], yv[7])}; }
            if (w == 0 && c + 1 < SEQ / CHUNK) ssd3_cumsum(L, par ^ 1, P.d0, P.d1, dtb, A, lane);
            SPR_T(s7) SPR_ACC(6, s7 - s6)
            LDS_BARRIER();
            SPR_T(s8) SPR_ACC(7, s8 - s7)
        }
#ifdef PROBE_SSD
        if (blockIdx.x == 0 && threadIdx.x == PROBE_TID) *(volatile float*)(F.ws + WS_CTL + 40000) = (float)sacc[PROBE_SSD] * 1e-3f;
#endif
    }
}
typedef float f32x16 __attribute__((ext_vector_type(16)));
#ifdef PROBE_SEL
#define PR_T(v) const unsigned long long v = __builtin_amdgcn_s_memtime();
#define PR_ACC(a, d) a += (d);
#define PR_OUT(i, a) if (PROBE_SEL == (i) && blockIdx.x == 0 && threadIdx.x == 0) *(volatile float*)(F.ws + WS_CTL + 40000) = (float)(a) * 1e-4f;
#define PR_OUT4(i, a) if (PROBE_SEL == (i) && blockIdx.x == 0 && threadIdx.x == 256) *(volatile float*)(F.ws + WS_CTL + 40000) = (float)(a) * 1e-4f;
#else
#define PR_T(v)
#define PR_ACC(a, d)
#define PR_OUT(i, a)
#define PR_OUT4(i, a)
#endif
constexpr int S5V_BU = 0, S5V_BUP = 2056, S5V_BUSZ = 16 * S5V_BUP, S5V_XT = 2 * S5V_BUSZ, S5V_XTP = 1040, S5V_XTSZ = 16 * S5V_XTP, S5V_VS = S5V_XT + 2 * S5V_XTSZ, S5V_OT = S5V_VS + 4 * 512, S5V_OTP = 144, S5V_OTSZ = 16 * S5V_OTP, S5V_END = S5V_OT + 2 * S5V_OTSZ;
static_assert(S5V_END <= LDS_MAIN, "S5 v2 LDS map");
__device__ __forceinline__ void p3_s5v2(Frame& F) {
    const int tid = threadIdx.x, lane = tid & 63, w = __builtin_amdgcn_readfirstlane(tid >> 6);
    const int li = lane & 15, lq = lane >> 4;
    LAS unsigned char* L = F.lds;
    const bf16* proj = WSP(bf16, WS_PROJ);
    constexpr int NT = SEQ / 16;
#ifdef PROBE_S5
    const unsigned long long pr_t0 = PROBE_CLOCK();
#endif
    for (int item = F.vcu; item < NB * 16; item += F.G) {
        const int b = item >> 4, gs = item & 15;
        const bool scanw = w < 4; const int gl = w & 3, g = gs * 4 + gl;
        const bf16* ubase = proj + (size_t)b * SEQ * NPROJ + 3072 + gs * 64 + gl * 16;
        __syncthreads();
        if (scanw) {
            __builtin_amdgcn_s_setprio(2);
            const float lbr = WSP(float, WS_S5LB)[(g * 64 + lane) * 2], lbi = WSP(float, WS_S5LB)[(g * 64 + lane) * 2 + 1], nlbi = -lbi;
            bf16x8 bfr[8];
#pragma unroll
            for (int cb = 0; cb < 8; ++cb) { v4u v = (v4u){0u, 0u, 0u, 0u};
                if (lq < 2) { const int col = 16 * cb + li; const float* src = WSP(float, WS_S5BB) + (g * 64 + (col >> 1)) * 32 + (col & 1) * 16 + 8 * lq; const f32x4 a0 = *(const f32x4*)src, a1 = *(const f32x4*)(src + 4);
                    v = (v4u){pk2(a0[0], a0[1]), pk2(a0[2], a0[3]), pk2(a1[0], a1[1]), pk2(a1[2], a1[3])}; }
                bfr[cb] = __builtin_bit_cast(bf16x8, v); }
            float xr = 0.f, xi = 0.f;
            const int lq2 = lq & 1;
            v4u ua = *(const v4u*)(ubase + (size_t)li * NPROJ + 8 * lq2);
            { const bf16x8 af = __builtin_bit_cast(bf16x8, lq < 2 ? ua : (v4u){0u, 0u, 0u, 0u});
              ua = *(const v4u*)(ubase + (size_t)(16 + li) * NPROJ + 8 * lq2);
#pragma unroll
              for (int cb = 0; cb < 8; ++cb) { f32x4 acc = (f32x4){0.f, 0.f, 0.f, 0.f}; acc = __builtin_amdgcn_mfma_f32_16x16x32_bf16(af, bfr[cb], acc, 0, 0, 0);
#pragma unroll
                  for (int r = 0; r < 4; ++r) *(LAS float*)(L + S5V_BU + (4 * lq + r) * S5V_BUP + (gl * 128 + 16 * cb + li) * 4) = acc[r]; } }
            LDS_BARRIER();
            unsigned long long pa0 = 0, pa1 = 0, pa2 = 0;
            for (int k = 0; k <= NT; ++k) {
                PR_T(pt0)
                if (k < NT) {
                    const LAS f32x2* bp = (const LAS f32x2*)(L + S5V_BU + (k & 1) * S5V_BUSZ + (gl * 128 + 2 * lane) * 4);
                    LAS unsigned* xp = (LAS unsigned*)(L + S5V_XT + (k & 1) * S5V_XTSZ + (gl * 128 + 2 * lane) * 2);
                    f32x2 bu[16];
#pragma unroll
                    for (int t = 0; t < 16; ++t) bu[t] = bp[t * (S5V_BUP / 8)];
                    unsigned xo[16];
#pragma unroll
                    for (int t = 0; t < 16; ++t) {
                        const float a = __builtin_fmaf(nlbi, xi, bu[t][0]), bq = __builtin_fmaf(lbi, xr, bu[t][1]);
                        const float nr = __builtin_fmaf(lbr, xr, a), ni = __builtin_fmaf(lbr, xi, bq); xr = nr; xi = ni; xo[t] = pk2(xr, xi); }
#pragma unroll
                    for (int t = 0; t < 16; ++t) xp[t * (S5V_XTP / 4)] = xo[t];
                    PR_T(pt1) PR_ACC(pa0, pt1 - pt0)
                    if (k + 1 < NT) {
                        const bf16x8 af = __builtin_bit_cast(bf16x8, lq < 2 ? ua : (v4u){0u, 0u, 0u, 0u});
                        { const int kn = k + 2 < NT ? k + 2 : NT - 1; ua = *(const v4u*)(ubase + (size_t)(16 * kn + li) * NPROJ + 8 * lq2); }
                        LAS unsigned char* bun = L + S5V_BU + ((k + 1) & 1) * S5V_BUSZ;
#pragma unroll
                        for (int cb = 0; cb < 8; ++cb) { f32x4 acc = (f32x4){0.f, 0.f, 0.f, 0.f}; acc = __builtin_amdgcn_mfma_f32_16x16x32_bf16(af, bfr[cb], acc, 0, 0, 0);
#pragma unroll
                            for (int r = 0; r < 4; ++r) *(LAS float*)(bun + (4 * lq + r) * S5V_BUP + (gl * 128 + 16 * cb + li) * 4) = acc[r]; }
                    }
                }
                PR_T(pt2) PR_ACC(pa1, pt2 - pt0)
                LDS_BARRIER();
                PR_T(pt3) PR_ACC(pa2, pt3 - pt2)
            }
            __builtin_amdgcn_s_setprio(0);
            PR_OUT(0, pa0) PR_OUT(1, pa1) PR_OUT(2, pa2)
        } else {
            bf16x8 cfr[4];
#pragma unroll
            for (int ks = 0; ks < 4; ++ks) { const float* cr = (F.a->in[17]) + (g * 16 + li) * 64 + 16 * ks + 4 * lq; const float* ci = (F.a->in[18]) + (g * 16 + li) * 64 + 16 * ks + 4 * lq;
                const f32x4 r0 = *(const f32x4*)cr, i0 = *(const f32x4*)ci;
                cfr[ks] = __builtin_bit_cast(bf16x8, ((v4u){pk2(r0[0], -i0[0]), pk2(r0[1], -i0[1]), pk2(r0[2], -i0[2]), pk2(r0[3], -i0[3])})); }
            v4u gwv = (v4u){0u, 0u, 0u, 0u};
            if (lq < 2) { float gwf[8];
#pragma unroll
                for (int j = 0; j < 8; ++j) gwf[j] = (F.a->in[20])[(g * 16 + 8 * lq + j) * 16 + li];
                gwv = (v4u){pk2(gwf[0], gwf[1]), pk2(gwf[2], gwf[3]), pk2(gwf[4], gwf[5]), pk2(gwf[6], gwf[7])}; }
            const bf16x8 gfr = __builtin_bit_cast(bf16x8, gwv);
            const float dsk = (F.a->in[19])[g * 16 + li], gbias = (F.a->in[21])[g * 16 + li];
            LAS unsigned char* vs = L + S5V_VS + gl * 512;
            float uo[4], un[4];
#pragma unroll
            for (int r = 0; r < 4; ++r) { uo[r] = bf2f(ubase[(size_t)(4 * lq + r) * NPROJ + li]); un[r] = bf2f(ubase[(size_t)(16 + 4 * lq + r) * NPROJ + li]); }
            LDS_BARRIER();
            unsigned long long pb0 = 0, pb1 = 0;
            for (int k = 0; k <= NT; ++k) {
                PR_T(qt0)
                float u2[4];
                { const int kn = k + 1 < NT ? k + 1 : NT - 1;
#pragma unroll
                  for (int r = 0; r < 4; ++r) u2[r] = bf2f(ubase[(size_t)(16 * kn + 4 * lq + r) * NPROJ + li]); }
                if (k >= 2) {
                    const int t = ((tid - 256) >> 3) & 15, oc = tid & 7; const v4u ov = *(const LAS v4u*)(L + S5V_OT + (k & 1) * S5V_OTSZ + t * S5V_OTP + 16 * oc);
                    if (tid < 384) *(v4u*)(WSP(bf16, WS_Y) + ((size_t)b * SEQ + 16 * (k - 2) + t) * 2048 + 1024 + gs * 64 + 8 * oc) = ov; }
                if (k >= 1) {
                    const int kt = k - 1; const LAS unsigned char* xt = L + S5V_XT + (kt & 1) * S5V_XTSZ;
                    f32x4 yacc = (f32x4){0.f, 0.f, 0.f, 0.f};
#pragma unroll
                    for (int ks = 0; ks < 4; ++ks) yacc = __builtin_amdgcn_mfma_f32_16x16x32_bf16(*(const LAS bf16x8*)(xt + li * S5V_XTP + (gl * 128 + 32 * ks + 8 * lq) * 2), cfr[ks], yacc, 0, 0, 0);
                    float v[4];
                    { const f32x2 g0 = gelu_pk2((f32x2){yacc[0] + dsk * uo[0], yacc[1] + dsk * uo[1]}), g1 = gelu_pk2((f32x2){yacc[2] + dsk * uo[2], yacc[3] + dsk * uo[3]}); v[0] = g0[0]; v[1] = g0[1]; v[2] = g1[0]; v[3] = g1[1]; }
#pragma unroll
                    for (int r = 0; r < 4; ++r) *(LAS unsigned short*)(vs + (4 * lq + r) * 32 + li * 2) = (unsigned short)f2bf(v[r]);
                    LDS_WAIT(); asm volatile("" ::: "memory");
                    v4u va = (v4u){0u, 0u, 0u, 0u};
                    if (lq < 2) va = *(const LAS v4u*)(vs + li * 32 + 16 * lq);
                    f32x4 gacc = (f32x4){0.f, 0.f, 0.f, 0.f};
                    gacc = __builtin_amdgcn_mfma_f32_16x16x32_bf16(__builtin_bit_cast(bf16x8, va), gfr, gacc, 0, 0, 0);
                    float o[4], ss[4];
#pragma unroll
                    for (int r = 0; r < 4; ++r) { o[r] = v[r] * sigmoid_f(gacc[r] + gbias); ss[r] = o[r] * o[r]; }
#pragma unroll
                    for (int r = 0; r < 4; ++r) ss[r] = row16_sum_to15(ss[r]);
                    if (li == 15) {
#pragma unroll
                        for (int r = 0; r < 4; ++r) WSP(float, WS_STS5)[((size_t)b * SEQ + 16 * kt + 4 * lq + r) * NS5PART + g] = ss[r]; }
                    LAS unsigned char* ot = L + S5V_OT + (kt & 1) * S5V_OTSZ;
#pragma unroll
                    for (int r = 0; r < 4; ++r) *(LAS unsigned short*)(ot + (4 * lq + r) * S5V_OTP + (gl * 16 + li) * 2) = (unsigned short)f2bf(o[r]);
#pragma unroll
                    for (int r = 0; r < 4; ++r) { uo[r] = un[r]; un[r] = u2[r]; }
                }
                PR_T(qt1) PR_ACC(pb0, qt1 - qt0)
                LDS_BARRIER();
                PR_T(qt2) PR_ACC(pb1, qt2 - qt1)
            }
            PR_OUT4(3, pb0) PR_OUT4(4, pb1)
            { const int t = ((tid - 256) >> 3) & 15, oc = tid & 7; const v4u ov = *(const LAS v4u*)(L + S5V_OT + ((NT - 1) & 1) * S5V_OTSZ + t * S5V_OTP + 16 * oc);
              if (tid < 384) *(v4u*)(WSP(bf16, WS_Y) + ((size_t)b * SEQ + 16 * (NT - 1) + t) * 2048 + 1024 + gs * 64 + 8 * oc) = ov; }
        }
    }
#ifdef PROBE_S5
    if (blockIdx.x == 0 && threadIdx.x == 0) *(volatile float*)(F.ws + WS_CTL + 40000) = (float)(PROBE_CLOCK() - pr_t0) * PROBE_SCALE;
#endif
}
__device__ __forceinline__ unsigned med3u(unsigned a, unsigned b, unsigned c) { unsigned r; asm("v_med3_u32 %0, %1, %2, %3" : "=v"(r) : "v"(a), "v"(b), "v"(c)); return r; }
__device__ __forceinline__ unsigned fkey(float v) { const unsigned u = __builtin_bit_cast(unsigned, v); return (u & 0x80000000u) ? ~u : (u | 0x80000000u); }
__device__ __forceinline__ float fkey_inv(unsigned k) { const unsigned u = (k & 0x80000000u) ? (k & 0x7fffffffu) : ~k; return __builtin_bit_cast(float, u); }
#define TOPK_INSERT(a, x) do { _Pragma("unroll") for (int _i = 15; _i >= 1; --_i) a[_i] = med3u(a[_i - 1], a[_i], (x)); a[0] = a[0] > (x) ? a[0] : (x); } while (0)
__device__ __forceinline__ unsigned fp6_code(float y) {
    const float a = fabsf(y);
    const float c = a < 2.0f ? __builtin_rintf(8.0f * a) : (a < 4.0f ? __builtin_rintf(4.0f * a) + 8.0f : fminf(__builtin_rintf(2.0f * a) + 16.0f, 31.0f));
    return (unsigned)c | (y < 0.f ? 32u : 0u);
}
__device__ __forceinline__ void fp6_pack16(const unsigned* c, unsigned& w0, unsigned& w1, unsigned& w2) {
    w0 = c[0] | (c[1] << 6) | (c[2] << 12) | (c[3] << 18) | (c[4] << 24) | (c[5] << 30);
    w1 = (c[5] >> 2) | (c[6] << 4) | (c[7] << 10) | (c[8] << 16) | (c[9] << 22) | (c[10] << 28);
    w2 = (c[10] >> 4) | (c[11] << 2) | (c[12] << 8) | (c[13] << 14) | (c[14] << 20) | (c[15] << 26);
}
__device__ __forceinline__ void h2_convert(Frame& F, int w0, int nw, int f_lane) {
    for (int tb = w0 * 16; tb < MTOK; tb += nw * 16) {
        const float* sh = WSP(float, WS_MOD) + (size_t)(tb >> 11) * 6144 + 3072 + 16 * f_lane;
        float S2[16];
#pragma unroll
        for (int q = 0; q < 4; ++q) { const f32x4 s4 = *(const f32x4*)(sh + 4 * q); S2[4 * q] = s4[0]; S2[4 * q + 1] = s4[1]; S2[4 * q + 2] = s4[2]; S2[4 * q + 3] = s4[3]; }
#pragma unroll 1
        for (int k = 0; k < 16; k += 4) {
            v4u xa[4], xb[4]; float rst[4];
#pragma unroll
            for (int u = 0; u < 4; ++u) { const int t = tb + k + u; const char* xs = (const char*)(WSP(bf16, WS_X1S) + (size_t)t * 1024) + 32 * f_lane; xa[u] = *(const v4u*)xs; xb[u] = *(const v4u*)(xs + 16); rst[u] = WSP(float, WS_ROWSTAT)[t]; }
#pragma unroll
            for (int u = 0; u < 4; ++u) { const int t = tb + k + u;
                const float rs = rsqrt_f(rst[u] * (1.0f / 1024.0f) + EPSF);
                float h2[16]; unpack8(xa[u], h2); unpack8(xb[u], h2 + 8); float mx = 0.f;
#pragma unroll
                for (int i = 0; i < 16; ++i) { h2[i] = h2[i] * rs + S2[i]; mx = fmaxf(mx, fabsf(h2[i])); }
#pragma unroll
                for (int o = 1; o < 64; o <<= 1) mx = fmaxf(mx, __shfl_xor(mx, o));
                mx = fmaxf(mx, 1e-30f); const float hs = 224.0f / mx;
                v4u w;
#pragma unroll
                for (int q = 0; q < 4; ++q) { int pk = 0; pk = __builtin_amdgcn_cvt_pk_fp8_f32(h2[4 * q] * hs, h2[4 * q + 1] * hs, pk, false); pk = __builtin_amdgcn_cvt_pk_fp8_f32(h2[4 * q + 2] * hs, h2[4 * q + 3] * hs, pk, true); w[q] = (unsigned)pk; }
                *(v4u*)(F.ws + WS_H2Q + (size_t)t * 1024 + 16 * f_lane) = w;
                if (f_lane == 0) WSP(float, WS_HINV)[t] = mx * (1.0f / 224.0f); }
        }
    }
}
__device__ __forceinline__ void expert_convert(Frame& F, int w0, int nw, int f_lane) {
    for (int rw = w0; rw < 2 * 16384; rw += 2 * nw) {
        f32x4 v[2][4]; float mx[2];
#pragma unroll
        for (int u = 0; u < 2; ++u) { const int r = rw + u * nw; const int tb = r >= 16384, e = tb ? r - 16384 : r; const float* src = (tb ? (F.a->in[28]) : (F.a->in[27])) + (size_t)e * 1024 + 16 * f_lane;
#pragma unroll
            for (int q = 0; q < 4; ++q) v[u][q] = *(const f32x4*)(src + 4 * q); }
#pragma unroll
        for (int u = 0; u < 2; ++u) { float m = 0.f;
#pragma unroll
            for (int q = 0; q < 4; ++q) m = fmaxf(m, fmaxf(fmaxf(fabsf(v[u][q][0]), fabsf(v[u][q][1])), fmaxf(fabsf(v[u][q][2]), fabsf(v[u][q][3]))));
#pragma unroll
            for (int o = 1; o < 64; o <<= 1) m = fmaxf(m, __shfl_xor(m, o));
            mx[u] = fmaxf(m, 1e-30f); }
#ifdef HWENC
        {
            typedef float f32x16 __attribute__((ext_vector_type(16))); typedef unsigned v6u_t __attribute__((ext_vector_type(6)));
            const float sa = 7.5f / mx[0], sb = 7.5f / mx[1]; f32x16 s0, s1;
#pragma unroll
            for (int i = 0; i < 8; ++i) {
#ifdef HWENC_SEQ
                s0[i] = v[0][i >> 2][i & 3] * sa; s0[8 + i] = v[0][2 + (i >> 2)][i & 3] * sa; s1[i] = v[1][i >> 2][i & 3] * sb; s1[8 + i] = v[1][2 + (i >> 2)][i & 3] * sb;
#else
                s0[i] = v[0][(2 * i) >> 2][(2 * i) & 3] * sa; s1[i] = v[0][(2 * i + 1) >> 2][(2 * i + 1) & 3] * sa; s0[8 + i] = v[1][(2 * i) >> 2][(2 * i) & 3] * sb; s1[8 + i] = v[1][(2 * i + 1) >> 2][(2 * i + 1) & 3] * sb;
#endif
            }
            const v6u_t enc = __builtin_amdgcn_cvt_scalef32_2xpk16_fp6_f32(s0, s1, 1.0f);
#pragma unroll
            for (int u = 0; u < 2; ++u) { const int r = rw + u * nw; const int tb = r >= 16384, e = tb ? r - 16384 : r;
                unsigned* dst = (unsigned*)(F.ws + (tb ? WS_EV : WS_EU) + (size_t)e * 768 + 12 * f_lane); dst[0] = enc[3 * u]; dst[1] = enc[3 * u + 1]; dst[2] = enc[3 * u + 2];
                if (f_lane == 0) WSP(float, tb ? WS_EVS : WS_EUS)[e] = mx[u] * (1.0f / 7.5f); }
            continue;
        }
#endif
#pragma unroll
        for (int u = 0; u < 2; ++u) { const int r = rw + u * nw; const int tb = r >= 16384, e = tb ? r - 16384 : r; const float sc = 224.0f / mx[u];
            v4u w;
#pragma unroll
            for (int q = 0; q < 4; ++q) { int pk = 0; pk = __builtin_amdgcn_cvt_pk_fp8_f32(v[u][q][0] * sc, v[u][q][1] * sc, pk, false); pk = __builtin_amdgcn_cvt_pk_fp8_f32(v[u][q][2] * sc, v[u][q][3] * sc, pk, true); w[q] = (unsigned)pk; }
#ifdef V6
#if defined(UP12) || defined(UP14) || defined(UP15) || defined(UP16)
            {
#else
            if (tb) {
#endif
                const float s6 = 7.5f / mx[u]; unsigned cd[16];
#pragma unroll
                for (int q = 0; q < 4; ++q)
#pragma unroll
                    for (int i = 0; i < 4; ++i) cd[4 * q + i] = fp6_code(v[u][q][i] * s6);
                unsigned w0, w1, w2; fp6_pack16(cd, w0, w1, w2);
#ifdef UP15
                if (!tb) {
                    unsigned char* rowp = F.ws + WS_EU + (size_t)e * 768 + 16 * (f_lane >> 3); const int d0 = 3 * (f_lane & 7);
                    *(unsigned*)(rowp + 128 * (d0 >> 2) + 4 * (d0 & 3)) = w0; *(unsigned*)(rowp + 128 * ((d0 + 1) >> 2) + 4 * ((d0 + 1) & 3)) = w1; *(unsigned*)(rowp + 128 * ((d0 + 2) >> 2) + 4 * ((d0 + 2) & 3)) = w2;
                    if (f_lane == 0) WSP(float, WS_EUS)[e] = mx[u] * (1.0f / 7.5f);
                    continue; }
#endif
                unsigned* dst = (unsigned*)(F.ws + (tb ? WS_EV : WS_EU) + (size_t)e * 768 + 12 * f_lane); dst[0] = w0; dst[1] = w1; dst[2] = w2;
                if (f_lane == 0) WSP(float, tb ? WS_EVS : WS_EUS)[e] = mx[u] * (1.0f / 7.5f);
                continue; }
#endif
            *(v4u*)(F.ws + (tb ? WS_EV : WS_EU) + (size_t)e * 1024 + 16 * f_lane) = w;
            if (f_lane == 0) WSP(float, tb ? WS_EVS : WS_EUS)[e] = mx[u] * (1.0f / 224.0f); }
    }
}
__device__ __forceinline__ void p5b_topk(Frame& F) {
    const int f_tid = threadIdx.x, f_lane = f_tid & 63, f_wave = __builtin_amdgcn_readfirstlane(f_tid >> 6);
    const _Float16* scores = WSP(_Float16, WS_SCORES);
    LAS unsigned char* ix = (LAS unsigned char*)F.lds + f_tid * 36;
#pragma unroll 1
    for (int half = 0; half < 2; ++half) {
#ifdef UP11
    if ((f_wave >> 2) != half) { expert_convert(F, (F.vcu * 4 + (f_wave & 3)) * 2 + half, F.G * 8, f_lane); h2_convert(F, (F.vcu * 4 + (f_wave & 3)) * 2 + half, F.G * 8, f_lane); continue; }
#else
    if ((f_wave >> 2) != half) { expert_convert(F, (F.vcu * 4 + (f_wave & 3)) * 2 + half, F.G * 8, f_lane); continue; }
#endif
    typedef _Float16 f16x8 __attribute__((ext_vector_type(8)));
    f16x8 sva[8], svb[8];
    { const int item0 = (F.vcu * 2 + half) * 256 + (f_tid & 255); const _Float16* sp0 = scores + (size_t)(item0 >> 3) * 2048 + (item0 & 7) * 256;
#pragma unroll
      for (int q = 0; q < 8; ++q) sva[q] = *(const f16x8*)(sp0 + 8 * q); }
#pragma unroll 1
    for (int item = (F.vcu * 2 + half) * 256 + (f_tid & 255); item < MTOK * PH; item += F.G * 512) {
        const int t = item >> 3, hd = item & 7;
        unsigned a1[16], a2[16];
#pragma unroll
        for (int i = 0; i < 16; ++i) { a1[i] = 0u; a2[i] = 0u; }
        const _Float16* sp = scores + (size_t)t * 2048 + hd * 256;
        const int itn = (item + F.G * 512 < MTOK * PH) ? item + F.G * 512 : item;
        const _Float16* spn = scores + (size_t)(itn >> 3) * 2048 + (itn & 7) * 256;
#define TK_BATCH(CUR, NXT, NP, A, M) { \
        { _Pragma("unroll") for (int q = 0; q < 8; ++q) NXT[q] = *(const f16x8*)((NP) + 8 * q); } \
        __builtin_amdgcn_sched_barrier(0); \
        _Pragma("unroll") for (int q = 0; q < 8; ++q) { _Pragma("unroll") for (int e = 0; e < 8; ++e) { const unsigned k = (fkey((float)CUR[q][e]) & ~127u) | (unsigned)(127 - (64 * (M) + 8 * q + e)); TOPK_INSERT(A, k); } } }
        TK_BATCH(sva, svb, sp + 64, a1, 0)
        TK_BATCH(svb, sva, sp + 128, a1, 1)
        TK_BATCH(sva, svb, sp + 192, a2, 0)
        TK_BATCH(svb, sva, spn, a2, 1)
#undef TK_BATCH
        float v1[16], v2[16];
#pragma unroll
        for (int i = 0; i < 16; ++i) { ix[i] = (unsigned char)(127u - (a1[i] & 127u)); ix[16 + i] = (unsigned char)(127u - (a2[i] & 127u)); v1[i] = fkey_inv(a1[i] & ~127u); v2[i] = fkey_inv(a2[i] & ~127u); }
        unsigned cb[16];
#pragma unroll
        for (int i = 0; i < 16; ++i) cb[i] = 0u;
#pragma unroll
        for (int i = 0; i < 16; ++i)
#pragma unroll
            for (int j = 0; j < 16; ++j) if ((i + 1) * (j + 1) <= 16) { const unsigned k = (fkey(v1[i] + v2[j]) & ~255u) | (unsigned)(255 - (i * 16 + j)); TOPK_INSERT(cb, k); }
        float tv[16]; float mx = -3.0e38f;
#pragma unroll
        for (int k = 0; k < 16; ++k) { tv[k] = fkey_inv(cb[k] & ~255u); mx = fmaxf(mx, tv[k]); }
        float sum = 0.f;
#pragma unroll
        for (int k = 0; k < 16; ++k) { tv[k] = __expf(tv[k] - mx); sum += tv[k]; }
        const float inv = 1.0f / sum;
        LDS_WAIT(); asm volatile("" ::: "memory");
        int ev[16]; unsigned long long c64 = 0ull;
#pragma unroll
        for (int k = 0; k < 16; ++k) { const unsigned code = 255u - (cb[k] & 255u); const int i = code >> 4, j = code & 15; ev[k] = (int)ix[i] * 128 + (int)ix[16 + j]; c64 += 1ull << (8 * (ev[k] >> 11)); }
        unsigned long long s64 = c64;
#pragma unroll
        for (int o = 1; o < 8; o <<= 1) { const unsigned lo = __shfl_up((unsigned)s64, o, 8), hi = __shfl_up((unsigned)(s64 >> 32), o, 8); if ((f_lane & 7) >= o) s64 += ((unsigned long long)hi << 32) | lo; }
        const unsigned long long e64 = s64 - c64;
        const unsigned long long t64 = ((unsigned long long)__shfl((unsigned)(s64 >> 32), 7, 8) << 32) | __shfl((unsigned)s64, 7, 8);
        const unsigned long long st64 = (t64 * 0x0101010101010101ull) << 8;
        unsigned long long base64 = st64 + e64;
        int* eo = WSP(int, WS_EID) + (size_t)t * 128; float* go = WSP(float, WS_GATE) + (size_t)t * 128;
#pragma unroll
        for (int k = 0; k < 16; ++k) { const int r8 = 8 * (ev[k] >> 11); const int slot = (int)((base64 >> r8) & 255ull); base64 += 1ull << r8; eo[slot] = ev[k]; go[slot] = tv[k] * inv; }
        if (hd == 0) WSP(unsigned long long, WS_START)[t] = st64;
        LDS_WAIT(); asm volatile("" ::: "memory");
    }
    }
}
__device__ __forceinline__ void dec16(const v4u q, float* f) {
#pragma unroll
    for (int i = 0; i < 4; ++i) { const f32x2 lo = __builtin_amdgcn_cvt_pk_f32_fp8((int)q[i], false), hi = __builtin_amdgcn_cvt_pk_f32_fp8((int)q[i], true); f[4 * i] = lo[0]; f[4 * i + 1] = lo[1]; f[4 * i + 2] = hi[0]; f[4 * i + 3] = hi[1]; }
}
struct CvE { f32x4 v[4]; };
struct CvH { v4u xa, xb; float rst; };
__device__ __forceinline__ void cve_load(CvE& c, Frame& F, int r, int f_lane) {
    const int tb = r >= 16384, e = tb ? r - 16384 : r; const float* src = (tb ? (F.a->in[28]) : (F.a->in[27])) + (size_t)e * 1024 + 16 * f_lane;
#pragma unroll
    for (int q = 0; q < 4; ++q) c.v[q] = *(const f32x4*)(src + 4 * q);
}
__device__ __forceinline__ void cve_finish(const CvE& c, Frame& F, int r, int f_lane) {
    const int tb = r >= 16384, e = tb ? r - 16384 : r; float m = 0.f;
#pragma unroll
    for (int q = 0; q < 4; ++q) m = fmaxf(m, fmaxf(fmaxf(fabsf(c.v[q][0]), fabsf(c.v[q][1])), fmaxf(fabsf(c.v[q][2]), fabsf(c.v[q][3]))));
#pragma unroll
    for (int o = 1; o < 64; o <<= 1) m = fmaxf(m, __shfl_xor(m, o));
    m = fmaxf(m, 1e-30f); const float sc = 224.0f / m;
    v4u w;
#pragma unroll
    for (int q = 0; q < 4; ++q) { int pk = 0; pk = __builtin_amdgcn_cvt_pk_fp8_f32(c.v[q][0] * sc, c.v[q][1] * sc, pk, false); pk = __builtin_amdgcn_cvt_pk_fp8_f32(c.v[q][2] * sc, c.v[q][3] * sc, pk, true); w[q] = (unsigned)pk; }
    *(v4u*)(F.ws + (tb ? WS_EV : WS_EU) + (size_t)e * 1024 + 16 * f_lane) = w;
    if (f_lane == 0) WSP(float, tb ? WS_EVS : WS_EUS)[e] = m * (1.0f / 224.0f);
}
__device__ __forceinline__ void cvh_load(CvH& c, Frame& F, int t, int f_lane) {
    const char* xs = (const char*)(WSP(bf16, WS_X1S) + (size_t)t * 1024) + 32 * f_lane; c.xa = *(const v4u*)xs; c.xb = *(const v4u*)(xs + 16); c.rst = WSP(float, WS_ROWSTAT)[t];
}
__device__ __forceinline__ void cvh_finish(const CvH& c, Frame& F, int t, int f_lane, const float* S2) {
    const float rs = rsqrt_f(c.rst * (1.0f / 1024.0f) + EPSF);
    float h2[16]; unpack8(c.xa, h2); unpack8(c.xb, h2 + 8); float mx = 0.f;
#pragma unroll
    for (int i = 0; i < 16; ++i) { h2[i] = h2[i] * rs + S2[i]; mx = fmaxf(mx, fabsf(h2[i])); }
#pragma unroll
    for (int o = 1; o < 64; o <<= 1) mx = fmaxf(mx, __shfl_xor(mx, o));
    mx = fmaxf(mx, 1e-30f); const float hs = 224.0f / mx;
    v4u w;
#pragma unroll
    for (int q = 0; q < 4; ++q) { int pk = 0; pk = __builtin_amdgcn_cvt_pk_fp8_f32(h2[4 * q] * hs, h2[4 * q + 1] * hs, pk, false); pk = __builtin_amdgcn_cvt_pk_fp8_f32(h2[4 * q + 2] * hs, h2[4 * q + 3] * hs, pk, true); w[q] = (unsigned)pk; }
    *(v4u*)(F.ws + WS_H2Q + (size_t)t * 1024 + 16 * f_lane) = w;
    if (f_lane == 0) WSP(float, WS_HINV)[t] = mx * (1.0f / 224.0f);
}
__device__ __forceinline__ void p5b_topk2(Frame& F) {
    const int f_tid = threadIdx.x, f_lane = f_tid & 63, f_wave = __builtin_amdgcn_readfirstlane(f_tid >> 6);
    const _Float16* scores = WSP(_Float16, WS_SCORES);
    LAS unsigned char* ix = (LAS unsigned char*)F.lds + f_tid * 36;
    const int gw = F.vcu * NWAVES + f_wave;
    static_assert(MTOK * PH == 2 * 256 * NTHR && MTOK == 16 * 256 * NWAVES, "P7 v2 work split");
    float S2[16];
    { const float* sh = WSP(float, WS_MOD) + (size_t)((gw * 16) >> 11) * 6144 + 3072 + 16 * f_lane;
#pragma unroll
      for (int q = 0; q < 4; ++q) { const f32x4 s4 = *(const f32x4*)(sh + 4 * q); S2[4 * q] = s4[0]; S2[4 * q + 1] = s4[1]; S2[4 * q + 2] = s4[2]; S2[4 * q + 3] = s4[3]; } }
    typedef _Float16 f16x8 __attribute__((ext_vector_type(8)));
    const int item_base = F.vcu * NTHR + f_tid, item_step = F.G * NTHR;
    f16x8 sva[8], svb[8];
    { const _Float16* sp0 = scores + (size_t)(item_base >> 3) * 2048 + (item_base & 7) * 256;
#pragma unroll
      for (int q = 0; q < 8; ++q) sva[q] = *(const f16x8*)(sp0 + 8 * q); }
    unsigned a1[16];
#pragma unroll
    for (int i = 0; i < 16; ++i) a1[i] = 0u;
#pragma unroll 1
    for (int hi = 0; hi < 4; ++hi) {
        const int item = item_base + (hi >> 1) * item_step; const int t = item >> 3, hd = item & 7, kh = hi & 1;
        const _Float16* sp = scores + (size_t)t * 2048 + hd * 256 + kh * 128;
        const int hn = hi < 3 ? hi + 1 : hi; const int itn = item_base + (hn >> 1) * item_step;
        const _Float16* spn = scores + (size_t)(itn >> 3) * 2048 + (itn & 7) * 256 + (hn & 1) * 128;
        unsigned a2[16];
#pragma unroll
        for (int i = 0; i < 16; ++i) a2[i] = 0u;
#define TK2_BATCH(CUR, NXT, NP, M) { \
        const int ku = 2 * (2 * hi + (M)); CvE e0, e1; CvH h0, h1; \
        { _Pragma("unroll") for (int q = 0; q < 8; ++q) NXT[q] = *(const f16x8*)((NP) + 8 * q); } \
        cve_load(e0, F, gw + ku * 2048, f_lane); cve_load(e1, F, gw + (ku + 1) * 2048, f_lane); cvh_load(h0, F, gw * 16 + ku, f_lane); cvh_load(h1, F, gw * 16 + ku + 1, f_lane); \
        __builtin_amdgcn_sched_barrier(0); \
        _Pragma("unroll") for (int q = 0; q < 8; ++q) { _Pragma("unroll") for (int e = 0; e < 8; ++e) { const unsigned k = (fkey((float)CUR[q][e]) & ~127u) | (unsigned)(127 - (64 * (M) + 8 * q + e)); TOPK_INSERT(a2, k); } } \
        __builtin_amdgcn_sched_barrier(0); \
        cve_finish(e0, F, gw + ku * 2048, f_lane); cve_finish(e1, F, gw + (ku + 1) * 2048, f_lane); cvh_finish(h0, F, gw * 16 + ku, f_lane, S2); cvh_finish(h1, F, gw * 16 + ku + 1, f_lane, S2); \
        __builtin_amdgcn_sched_barrier(0); }
        TK2_BATCH(sva, svb, sp + 64, 0)
        TK2_BATCH(svb, sva, spn, 1)
#undef TK2_BATCH
        if (kh == 0) {
#pragma unroll
            for (int i = 0; i < 16; ++i) a1[i] = a2[i];
            continue;
        }
        float v1[16], v2[16];
#pragma unroll
        for (int i = 0; i < 16; ++i) { ix[i] = (unsigned char)(127u - (a1[i] & 127u)); ix[16 + i] = (unsigned char)(127u - (a2[i] & 127u)); v1[i] = fkey_inv(a1[i] & ~127u); v2[i] = fkey_inv(a2[i] & ~127u); }
        unsigned cb[16];
#pragma unroll
        for (int i = 0; i < 16; ++i) cb[i] = 0u;
#pragma unroll
        for (int i = 0; i < 16; ++i)
#pragma unroll
            for (int j = 0; j < 16; ++j) if ((i + 1) * (j + 1) <= 16) { const unsigned k = (fkey(v1[i] + v2[j]) & ~255u) | (unsigned)(255 - (i * 16 + j)); TOPK_INSERT(cb, k); }
        float tv[16]; float mx = -3.0e38f;
#pragma unroll
        for (int k = 0; k < 16; ++k) { tv[k] = fkey_inv(cb[k] & ~255u); mx = fmaxf(mx, tv[k]); }
        float sum = 0.f;
#pragma unroll
        for (int k = 0; k < 16; ++k) { tv[k] = __expf(tv[k] - mx); sum += tv[k]; }
        const float inv = 1.0f / sum;
        LDS_WAIT(); asm volatile("" ::: "memory");
        int ev[16]; unsigned long long c64 = 0ull;
#pragma unroll
        for (int k = 0; k < 16; ++k) { const unsigned code = 255u - (cb[k] & 255u); const int i = code >> 4, j = code & 15; ev[k] = (int)ix[i] * 128 + (int)ix[16 + j]; c64 += 1ull << (8 * (ev[k] >> 11)); }
        unsigned long long s64 = c64;
#pragma unroll
        for (int o = 1; o < 8; o <<= 1) { const unsigned lo = __shfl_up((unsigned)s64, o, 8), hi2 = __shfl_up((unsigned)(s64 >> 32), o, 8); if ((f_lane & 7) >= o) s64 += ((unsigned long long)hi2 << 32) | lo; }
        const unsigned long long e64 = s64 - c64;
        const unsigned long long t64 = ((unsigned long long)__shfl((unsigned)(s64 >> 32), 7, 8) << 32) | __shfl((unsigned)s64, 7, 8);
        const unsigned long long st64 = (t64 * 0x0101010101010101ull) << 8;
        unsigned long long base64 = st64 + e64;
        int* eo = WSP(int, WS_EID) + (size_t)t * 128; float* go = WSP(float, WS_GATE) + (size_t)t * 128;
#pragma unroll
        for (int k = 0; k < 16; ++k) { const int r8 = 8 * (ev[k] >> 11); const int slot = (int)((base64 >> r8) & 255ull); base64 += 1ull << r8; eo[slot] = ev[k]; go[slot] = tv[k] * inv; }
        if (hd == 0) WSP(unsigned long long, WS_START)[t] = st64;
        LDS_WAIT(); asm volatile("" ::: "memory");
    }
}
__device__ __forceinline__ void p9_peer_down2(Frame& F) {
    const int f_tid = threadIdx.x, lane = f_tid & 63, f_wave = __builtin_amdgcn_readfirstlane(f_tid >> 6);
    const unsigned char* EV = F.ws + WS_EV;
    for (int wq = F.vcu * NWAVES + f_wave; wq < MTOK / 16; wq += F.G * NWAVES) {
        const int b = wq >> 7; const float* mb = WSP(float, WS_MOD) + (size_t)b * 6144;
        int ne_lo = WSP(int, WS_EID)[(size_t)wq * 16 * 128 + lane], ne_hi = WSP(int, WS_EID)[(size_t)wq * 16 * 128 + 64 + lane];
        float nw_lo = WSP(float, WS_GATE)[(size_t)wq * 16 * 128 + lane], nw_hi = WSP(float, WS_GATE)[(size_t)wq * 16 * 128 + 64 + lane];
        for (int tt = 0; tt < 16; ++tt) {
            const size_t t = (size_t)wq * 16 + tt;
            unsigned l16 = 16u * (unsigned)lane; asm volatile("" : "+v"(l16));
            float* xr = (float*)((char*)(F.out + t * 1024) + 4u * l16);
            const int e_lo = ne_lo, e_hi = ne_hi; const float w_lo = nw_lo, w_hi = nw_hi;
            f32x2 o[8];
#pragma unroll
            for (int i = 0; i < 8; ++i) o[i] = (f32x2){0.f, 0.f};
            v4u qa[8], qb[8];
#pragma unroll
            for (int j = 0; j < 8; ++j) { const int e = __builtin_amdgcn_readlane(e_lo, j); qa[j] = *(const v4u*)(EV + ((unsigned)e * 1024u + l16)); }
#define DN2_STEP(GRP, CUR, NXT) { \
                const int grp = (GRP); const int nb = ((grp + 1) & 7) * 8; const int ensel = (grp + 1) < 8 ? e_lo : e_hi; \
                { _Pragma("unroll") for (int j = 0; j < 8; ++j) { const int e = __builtin_amdgcn_readlane(ensel, nb + j); NXT[j] = *(const v4u*)(EV + ((unsigned)e * 1024u + l16)); } } \
                __builtin_amdgcn_sched_barrier(0); \
                const int base = (grp & 7) * 8; const float wsel = grp < 8 ? w_lo : w_hi; \
                _Pragma("unroll") for (int j = 0; j < 8; ++j) { const float wj = __builtin_bit_cast(float, __builtin_amdgcn_readlane(__builtin_bit_cast(int, wsel), base + j)); const f32x2 w2 = (f32x2){wj, wj}; \
                    _Pragma("unroll") for (int i = 0; i < 4; ++i) { const f32x2 lo = __builtin_amdgcn_cvt_pk_f32_fp8((int)CUR[j][i], false), hi = __builtin_amdgcn_cvt_pk_f32_fp8((int)CUR[j][i], true); o[2 * i] += w2 * lo; o[2 * i + 1] += w2 * hi; } } }
#pragma unroll 1
            for (int g2 = 0; g2 < 16; g2 += 2) { DN2_STEP(g2, qa, qb) DN2_STEP(g2 + 1, qb, qa) }
#undef DN2_STEP
            { const size_t tn = t + (tt < 15 ? 1 : 0); ne_lo = WSP(int, WS_EID)[tn * 128 + lane]; ne_hi = WSP(int, WS_EID)[tn * 128 + 64 + lane]; nw_lo = WSP(float, WS_GATE)[tn * 128 + lane]; nw_hi = WSP(float, WS_GATE)[tn * 128 + 64 + lane]; }
            float x1[16]; float ss = 0.f;
#pragma unroll
            for (int q4 = 0; q4 < 4; ++q4) { const f32x4 v = *(const f32x4*)(xr + 4 * q4); x1[4 * q4] = v[0]; x1[4 * q4 + 1] = v[1]; x1[4 * q4 + 2] = v[2]; x1[4 * q4 + 3] = v[3]; }
#pragma unroll
            for (int q4 = 0; q4 < 4; ++q4) { const f32x4 gt = *(const f32x4*)((const char*)(mb + 5120) + 4u * l16 + 16 * q4);
#pragma unroll
                for (int e = 0; e < 4; ++e) { const int i = 4 * q4 + e; x1[i] += gt[e] * o[i >> 1][i & 1]; ss += x1[i] * x1[i]; } }
            const float rf = rsqrt_f(wave_sum(ss) * (1.0f / 1024.0f) + EPSF);
#pragma unroll
            for (int q4 = 0; q4 < 4; ++q4) { const f32x4 nf = *(const f32x4*)((const char*)(F.a->in[29]) + 4u * l16 + 16 * q4); f32x4 v;
#pragma unroll
                for (int e = 0; e < 4; ++e) v[e] = x1[4 * q4 + e] * rf * nf[e];
                *(f32x4*)(xr + 4 * q4) = v; }
        }
    }
}
typedef long i64_t;
constexpr int U6_ROWP = 1040, U6_BUF = 8 * U6_ROWP, U6_WAVE = 2 * U6_BUF + 1024;
static_assert(8 * U6_WAVE <= LDS_MAIN, "U6 LDS map");
__device__ __forceinline__ void p8_peer_up6(Frame& F) {
    const int f_tid = threadIdx.x, lane = f_tid & 63, f_wave = __builtin_amdgcn_readfirstlane(f_tid >> 6);
    const int li = lane & 15, lq = lane >> 4;
    const unsigned char* EU = F.ws + WS_EU; const float* EUS = WSP(float, WS_EUS); const float* EVS = WSP(float, WS_EVS);
    LAS unsigned char* ring = F.lds + f_wave * U6_WAVE; LAS unsigned char* hq = ring + 2 * U6_BUF;
    for (int wq = F.vcu * NWAVES + f_wave; wq < MTOK / 16; wq += F.G * NWAVES) {
        const int b = wq >> 7; const float* mb = WSP(float, WS_MOD) + (size_t)b * 6144;
        for (int tt = 0; tt < 16; ++tt) {
            const size_t t = (size_t)wq * 16 + tt;
            unsigned l16 = 16u * (unsigned)lane; asm volatile("" : "+v"(l16));
            const int e_lo = WSP(int, WS_EID)[t * 128 + lane], e_hi = WSP(int, WS_EID)[t * 128 + 64 + lane];
            const float g_lo = WSP(float, WS_GATE)[t * 128 + lane], g_hi = WSP(float, WS_GATE)[t * 128 + 64 + lane];
            const float rs = rsqrt_f(WSP(float, WS_ROWSTAT)[t] * (1.0f / 1024.0f) + EPSF);
            const char* xs = (const char*)(WSP(bf16, WS_X1S) + t * 1024) + 2u * l16; const v4u xa = *(const v4u*)xs, xb = *(const v4u*)(xs + 16);
            asm volatile("s_waitcnt vmcnt(0)" ::: "memory");
#pragma unroll
            for (int j = 0; j < 8; ++j) { const int e = __builtin_amdgcn_readlane(e_lo, j);
                __builtin_amdgcn_global_load_lds((const unsigned*)(EU + ((unsigned)e * 1024u + l16)), (LAS unsigned*)(ring + j * U6_ROWP), 16, 0, 0); }
            const float su_lo = EUS[e_lo], su_hi = EUS[e_hi], sv_lo = EVS[e_lo], sv_hi = EVS[e_hi];
            float h2[16]; unpack8(xa, h2); unpack8(xb, h2 + 8); float mx = 0.f;
#pragma unroll
            for (int qd = 0; qd < 4; ++qd) { const f32x4 sh = *(const f32x4*)((const char*)(mb + 3072) + 4u * l16 + 16 * qd);
#pragma unroll
                for (int e = 0; e < 4; ++e) { h2[4 * qd + e] = h2[4 * qd + e] * rs + sh[e]; mx = fmaxf(mx, fabsf(h2[4 * qd + e])); } }
#pragma unroll
            for (int o = 1; o < 64; o <<= 1) mx = fmaxf(mx, __shfl_xor(mx, o));
            mx = fmaxf(mx, 1e-30f); const float hs = 224.0f / mx, hinv = mx * (1.0f / 224.0f);
            { v4u w;
#pragma unroll
              for (int qd = 0; qd < 4; ++qd) { int pk = 0; pk = __builtin_amdgcn_cvt_pk_fp8_f32(h2[4 * qd] * hs, h2[4 * qd + 1] * hs, pk, false); pk = __builtin_amdgcn_cvt_pk_fp8_f32(h2[4 * qd + 2] * hs, h2[4 * qd + 3] * hs, pk, true); w[qd] = (unsigned)pk; }
              *(LAS v4u*)(hq + l16) = w; }
            LDS_WAIT(); asm volatile("" ::: "memory");
            v4u hb[16];
#pragma unroll
            for (int c = 0; c < 16; ++c) hb[c] = *(const LAS v4u*)(hq + 64 * c + 16 * lq);
            asm volatile("s_waitcnt vmcnt(0)" ::: "memory");
            float w_lo = 0.f, w_hi = 0.f;
#pragma unroll 1
            for (int u = 0; u < 16; ++u) {
                { const int un = (u + 1) & 15; const int ensel = un < 8 ? e_lo : e_hi; const int nb = (un & 7) * 8; LAS unsigned char* dst = ring + ((u + 1) & 1) * U6_BUF;
#pragma unroll
                  for (int j = 0; j < 8; ++j) { const int e = __builtin_amdgcn_readlane(ensel, nb + j);
                      __builtin_amdgcn_global_load_lds((const unsigned*)(EU + ((unsigned)e * 1024u + l16)), (LAS unsigned*)(dst + j * U6_ROWP), 16, 0, 0); } }
                asm volatile("s_waitcnt vmcnt(8)" ::: "memory");
                const LAS unsigned char* src = ring + (u & 1) * U6_BUF + (li & 7) * U6_ROWP + 16 * lq;
                f32x4 acc = (f32x4){0.f, 0.f, 0.f, 0.f};
#ifdef HALF_READ
                v4u av[16];
#pragma unroll
                for (int c = 0; c < 16; ++c) asm volatile("" : "=v"(av[c]));
                if (li < 8) {
#pragma unroll
                    for (int c = 0; c < 16; ++c) av[c] = *(const LAS v4u*)(src + 64 * c); }
#pragma unroll
                for (int c = 0; c < 16; ++c) { const v4u a = av[c];
#else
#pragma unroll
                for (int c = 0; c < 16; ++c) { const v4u a = *(const LAS v4u*)(src + 64 * c);
#endif
                    acc = __builtin_amdgcn_mfma_f32_16x16x32_fp8_fp8((i64_t)(((unsigned long long)a[1] << 32) | a[0]), (i64_t)(((unsigned long long)hb[c][1] << 32) | hb[c][0]), acc, 0, 0, 0);
                    acc = __builtin_amdgcn_mfma_f32_16x16x32_fp8_fp8((i64_t)(((unsigned long long)a[3] << 32) | a[2]), (i64_t)(((unsigned long long)hb[c][3] << 32) | hb[c][2]), acc, 0, 0, 0); }
                const int base = (u & 7) * 8; const int r = li & 3;
                const float sel = r == 0 ? acc[0] : (r == 1 ? acc[1] : (r == 2 ? acc[2] : acc[3]));
                const float dmine = __shfl(sel, ((lane & 7) >> 2) * 16 + (lane & 3));
                const float gsel = u < 8 ? g_lo : g_hi, susel = u < 8 ? su_lo : su_hi, svsel = u < 8 ? sv_lo : sv_hi;
                const float wv = gsel * gelu_erf(dmine * susel * hinv) * svsel;
                const bool mine = (lane >= base) && (lane < base + 8);
                if (u < 8) w_lo = mine ? wv : w_lo; else w_hi = mine ? wv : w_hi;
                asm volatile("s_waitcnt lgkmcnt(0)" ::: "memory");
            }
            WSP(float, WS_GATE)[t * 128 + lane] = w_lo; WSP(float, WS_GATE)[t * 128 + 64 + lane] = w_hi;
        }
    }
}
struct U10Meta { int elo, ehi; float glo, ghi; v4u xa, xb; float rst; };
__device__ __forceinline__ void u10_meta_load(U10Meta& M, const unsigned char* ws, size_t t, unsigned l16) {
    const unsigned l = l16 >> 4; const int* ep = (const int*)(ws + WS_EID) + t * 128; const float* gp = (const float*)(ws + WS_GATE) + t * 128;
    M.elo = ep[l]; M.ehi = ep[64 + l]; M.glo = gp[l]; M.ghi = gp[64 + l];
    const char* xs = (const char*)(ws + WS_X1S) + t * 2048 + 2u * l16; M.xa = *(const v4u*)xs; M.xb = *(const v4u*)(xs + 16);
    M.rst = ((const float*)(ws + WS_ROWSTAT))[t + (l16 >> 30)];
}
__device__ __forceinline__ void u10_meta_touch(U10Meta& M) { asm volatile("" : "+v"(M.elo), "+v"(M.ehi), "+v"(M.glo), "+v"(M.ghi), "+v"(M.xa), "+v"(M.xb), "+v"(M.rst)); }
template <int UN> __device__ __forceinline__ void u10_unit_dma(int elo, int ehi, const unsigned char* EU, unsigned l16, LAS unsigned char* dst) {
    const int ensel = UN < 8 ? elo : ehi; constexpr int nb = (UN & 7) * 8;
#pragma unroll
    for (int j = 0; j < 8; ++j) { const int e = __builtin_amdgcn_readlane(ensel, nb + j);
        __builtin_amdgcn_global_load_lds((const unsigned*)(EU + ((unsigned)e * 1024u + l16)), (LAS unsigned*)(dst + j * U6_ROWP), 16, 0, 0); }
}
__device__ __forceinline__ void u10_h2(const U10Meta& M, const float* S2, LAS unsigned char* hq, unsigned l16, int lq, v4u* hb, float& hinv) {
    float h2[16]; unpack8(M.xa, h2); unpack8(M.xb, h2 + 8); float mx = 0.f;
    const float rs = rsqrt_f(M.rst * (1.0f / 1024.0f) + EPSF);
#pragma unroll
    for (int i = 0; i < 16; ++i) { h2[i] = h2[i] * rs + S2[i]; mx = fmaxf(mx, fabsf(h2[i])); }
#pragma unroll
    for (int o = 1; o < 64; o <<= 1) mx = fmaxf(mx, __shfl_xor(mx, o));
    mx = fmaxf(mx, 1e-30f); const float hs = 224.0f / mx; hinv = mx * (1.0f / 224.0f);
    v4u w;
#pragma unroll
    for (int qd = 0; qd < 4; ++qd) { int pk = 0; pk = __builtin_amdgcn_cvt_pk_fp8_f32(h2[4 * qd] * hs, h2[4 * qd + 1] * hs, pk, false); pk = __builtin_amdgcn_cvt_pk_fp8_f32(h2[4 * qd + 2] * hs, h2[4 * qd + 3] * hs, pk, true); w[qd] = (unsigned)pk; }
    *(LAS v4u*)(hq + l16) = w;
    LDS_WAIT(); asm volatile("" ::: "memory");
#pragma unroll
    for (int c = 0; c < 16; ++c) hb[c] = *(const LAS v4u*)(hq + 64 * c + 16 * lq);
    LDS_WAIT(); asm volatile("" ::: "memory");
}
template <int U> __device__ __forceinline__ void u10_unit(const U10Meta& C, U10Meta& N, const unsigned char* EU, const unsigned char* ws, unsigned l16, LAS unsigned char* ring, const v4u* hb, float hinv,
                                                          float su_lo, float su_hi, float sv_lo, float sv_hi, float& nsu_lo, float& nsu_hi, float& nsv_lo, float& nsv_hi,
                                                          float& w_lo, float& w_hi, size_t tn, bool first_token, int lane) {
    const int li = lane & 15, lq = lane >> 4;
    if (U == 15) u10_unit_dma<0>(N.elo, N.ehi, EU, l16, ring); else u10_unit_dma<(U + 1) & 15>(C.elo, C.ehi, EU, l16, ring + ((U + 1) & 1) * U6_BUF);
    __builtin_amdgcn_sched_barrier(0);
    if (U == 0) { if (first_token) asm volatile("s_waitcnt vmcnt(8)" ::: "memory"); else asm volatile("s_waitcnt vmcnt(10)" ::: "memory"); }
    else if (U == 3) asm volatile("s_waitcnt vmcnt(15)" ::: "memory");
    else if (U == 11) asm volatile("s_waitcnt vmcnt(12)" ::: "memory");
    else asm volatile("s_waitcnt vmcnt(8)" ::: "memory");
    if (U == 4) u10_meta_touch(N);
    if (U == 12) asm volatile("" : "+v"(nsu_lo), "+v"(nsu_hi), "+v"(nsv_lo), "+v"(nsv_hi));
    __builtin_amdgcn_sched_barrier(0);
    const LAS unsigned char* src = ring + (U & 1) * U6_BUF + (li & 7) * U6_ROWP + 16 * lq;
    f32x4 acc = (f32x4){0.f, 0.f, 0.f, 0.f};
#pragma unroll
    for (int c = 0; c < 16; ++c) { const v4u a = *(const LAS v4u*)(src + 64 * c);
        acc = __builtin_amdgcn_mfma_f32_16x16x32_fp8_fp8((i64_t)(((unsigned long long)a[1] << 32) | a[0]), (i64_t)(((unsigned long long)hb[c][1] << 32) | hb[c][0]), acc, 0, 0, 0);
        acc = __builtin_amdgcn_mfma_f32_16x16x32_fp8_fp8((i64_t)(((unsigned long long)a[3] << 32) | a[2]), (i64_t)(((unsigned long long)hb[c][3] << 32) | hb[c][2]), acc, 0, 0, 0); }
    constexpr int base = (U & 7) * 8; const int r = li & 3;
    const float sel = r == 0 ? acc[0] : (r == 1 ? acc[1] : (r == 2 ? acc[2] : acc[3]));
    const float dmine = __shfl(sel, ((lane & 7) >> 2) * 16 + (lane & 3));
    const float gsel = U < 8 ? C.glo : C.ghi, susel = U < 8 ? su_lo : su_hi, svsel = U < 8 ? sv_lo : sv_hi;
    const float wv = gsel * gelu_erf(dmine * susel * hinv) * svsel;
    const bool mine = (lane >= base) && (lane < base + 8);
    if (U < 8) w_lo = mine ? wv : w_lo; else w_hi = mine ? wv : w_hi;
    asm volatile("s_waitcnt lgkmcnt(0)" ::: "memory");
    __builtin_amdgcn_sched_barrier(0);
    if (U == 2) { u10_meta_load(N, ws, tn, l16); __builtin_amdgcn_sched_barrier(0); }
    if (U == 10) { const float* EUS = (const float*)(ws + WS_EUS); const float* EVS = (const float*)(ws + WS_EVS); nsu_lo = EUS[N.elo]; nsu_hi = EUS[N.ehi]; nsv_lo = EVS[N.elo]; nsv_hi = EVS[N.ehi]; __builtin_amdgcn_sched_barrier(0); }
}
__device__ __forceinline__ void p8_peer_up10(Frame& F) {
    const int f_tid = threadIdx.x, lane = f_tid & 63, f_wave = __builtin_amdgcn_readfirstlane(f_tid >> 6);
    const int lq = lane >> 4;
    const unsigned char* EU = F.ws + WS_EU; const float* EUS = WSP(float, WS_EUS); const float* EVS = WSP(float, WS_EVS);
    LAS unsigned char* ring = F.lds + f_wave * U6_WAVE; LAS unsigned char* hq = ring + 2 * U6_BUF;
    for (int wq = F.vcu * NWAVES + f_wave; wq < MTOK / 16; wq += F.G * NWAVES) {
        const int b = wq >> 7; const float* mb = WSP(float, WS_MOD) + (size_t)b * 6144;
        unsigned l16 = 16u * (unsigned)lane; asm volatile("" : "+v"(l16));
        float S2[16];
#pragma unroll
        for (int q = 0; q < 4; ++q) { const f32x4 sh = *(const f32x4*)((const char*)(mb + 3072) + 4u * l16 + 16 * q); S2[4 * q] = sh[0]; S2[4 * q + 1] = sh[1]; S2[4 * q + 2] = sh[2]; S2[4 * q + 3] = sh[3]; }
        const size_t t0 = (size_t)wq * 16;
        U10Meta C, N;
        u10_meta_load(C, F.ws, t0, l16);
        asm volatile("s_waitcnt vmcnt(0)" ::: "memory");
        u10_meta_touch(C);
        u10_unit_dma<0>(C.elo, C.ehi, EU, l16, ring);
        float su_lo = EUS[C.elo], su_hi = EUS[C.ehi], sv_lo = EVS[C.elo], sv_hi = EVS[C.ehi];
        float nsu_lo = 0.f, nsu_hi = 0.f, nsv_lo = 0.f, nsv_hi = 0.f;
        v4u hb[16]; float hinv;
        u10_h2(C, S2, hq, l16, lq, hb, hinv);
        N = C;
        asm volatile("s_waitcnt vmcnt(0)" ::: "memory");
        asm volatile("" : "+v"(su_lo), "+v"(su_hi), "+v"(sv_lo), "+v"(sv_hi));
#pragma unroll 1
        for (int tt = 0; tt < 16; ++tt) {
            float w_lo = 0.f, w_hi = 0.f;
            const size_t tn = t0 + (tt < 15 ? tt + 1 : tt);
            const bool ft = (tt == 0);
#define U10_U(U) u10_unit<U>(C, N, EU, F.ws, l16, ring, hb, hinv, su_lo, su_hi, sv_lo, sv_hi, nsu_lo, nsu_hi, nsv_lo, nsv_hi, w_lo, w_hi, tn, ft, lane);
            U10_U(0) U10_U(1) U10_U(2) U10_U(3) U10_U(4) U10_U(5) U10_U(6) U10_U(7) U10_U(8) U10_U(9) U10_U(10) U10_U(11) U10_U(12) U10_U(13) U10_U(14) U10_U(15)
#undef U10_U
            WSP(float, WS_GATE)[(t0 + tt) * 128 + lane] = w_lo; WSP(float, WS_GATE)[(t0 + tt) * 128 + 64 + lane] = w_hi;
            __builtin_amdgcn_sched_barrier(0);
            C = N; su_lo = nsu_lo; su_hi = nsu_hi; sv_lo = nsv_lo; sv_hi = nsv_hi;
            u10_h2(C, S2, hq, l16, lq, hb, hinv);
        }
        asm volatile("s_waitcnt vmcnt(0)" ::: "memory");
    }
}
#ifndef U11_AUX
#define U11_AUX 0
#endif
constexpr int U11_HQ = 2 * U6_BUF, U11_IDS = U11_HQ + 1024, U11_GATES = U11_IDS + 512, U11_SC = U11_GATES + 512, U11_HINV = U11_SC + 1024, U11_WAVE = U11_HINV + 256;
static_assert(8 * U11_WAVE <= LDS_MAIN, "U11 LDS map");
__device__ __forceinline__ void u11_dma4(const void* g, LAS unsigned char* l) { __builtin_amdgcn_global_load_lds((const unsigned*)g, (LAS unsigned*)l, 4, 0, 0); }
__device__ __forceinline__ void u11_stage1(const unsigned char* ws, size_t t, unsigned l16, LAS unsigned char* W) {
    const unsigned l4 = l16 >> 2;
    const unsigned char* ep = ws + WS_EID + t * 512; const unsigned char* gp = ws + WS_GATE + t * 512;
    u11_dma4(ep + l4, W + U11_IDS); u11_dma4(ep + 256 + l4, W + U11_IDS + 256);
    u11_dma4(gp + l4, W + U11_GATES); u11_dma4(gp + 256 + l4, W + U11_GATES + 256);
    __builtin_amdgcn_global_load_lds((const unsigned*)(ws + WS_H2Q + t * 1024 + l16), (LAS unsigned*)(W + U11_HQ), 16, 0, 0);
    u11_dma4(ws + WS_HINV + t * 4 + (l16 >> 30), W + U11_HINV);
}
__device__ __forceinline__ void u11_stage2(const unsigned char* ws, int elo, int ehi, LAS unsigned char* W) {
    u11_dma4(ws + WS_EUS + 4u * (unsigned)elo, W + U11_SC); u11_dma4(ws + WS_EUS + 4u * (unsigned)ehi, W + U11_SC + 256);
    u11_dma4(ws + WS_EVS + 4u * (unsigned)elo, W + U11_SC + 512); u11_dma4(ws + WS_EVS + 4u * (unsigned)ehi, W + U11_SC + 768);
}
template <int UN> __device__ __forceinline__ void u11_unit_dma(int elo, int ehi, const unsigned char* EU, unsigned l16, LAS unsigned char* dst) {
    const int ensel = UN < 8 ? elo : ehi; constexpr int nb = (UN & 7) * 8;
#pragma unroll
    for (int j = 0; j < 8; ++j) { const int e = __builtin_amdgcn_readlane(ensel, nb + j);
        __builtin_amdgcn_global_load_lds((const unsigned*)(EU + ((unsigned)e * 1024u + l16)), (LAS unsigned*)(dst + j * U6_ROWP), 16, 0, U11_AUX); }
}
struct U11Tok { int elo, ehi; float glo, ghi, su_lo, su_hi, sv_lo, sv_hi, hinv; };
__device__ __forceinline__ void u11_switch(U11Tok& C, int nelo, int nehi, LAS unsigned char* W, unsigned l16, int lq, v4u* hb) {
    const unsigned l4 = l16 >> 2;
    C.elo = nelo; C.ehi = nehi;
    C.glo = *(const LAS float*)(W + U11_GATES + l4); C.ghi = *(const LAS float*)(W + U11_GATES + 256 + l4);
    C.su_lo = *(const LAS float*)(W + U11_SC + l4); C.su_hi = *(const LAS float*)(W + U11_SC + 256 + l4); C.sv_lo = *(const LAS float*)(W + U11_SC + 512 + l4); C.sv_hi = *(const LAS float*)(W + U11_SC + 768 + l4);
    C.hinv = *(const LAS float*)(W + U11_HINV + l4);
#pragma unroll
    for (int c = 0; c < 16; ++c) hb[c] = *(const LAS v4u*)(W + U11_HQ + 64 * c + 16 * lq);
    LDS_WAIT(); asm volatile("" ::: "memory");
}
template <int U> __device__ __forceinline__ void u11_unit(const U11Tok& C, int& nelo, int& nehi, const unsigned char* EU, const unsigned char* ws, unsigned l16, LAS unsigned char* W, const v4u* hb,
                                                          float& w_lo, float& w_hi, size_t tn, bool first_token, int lane) {
    const int li = lane & 15, lq = lane >> 4;
    if (U == 15) u11_unit_dma<0>(nelo, nehi, EU, l16, W); else u11_unit_dma<(U + 1) & 15>(C.elo, C.ehi, EU, l16, W + ((U + 1) & 1) * U6_BUF);
    __builtin_amdgcn_sched_barrier(0);
    if (U == 0) { if (first_token) asm volatile("s_waitcnt vmcnt(8)" ::: "memory"); else asm volatile("s_waitcnt vmcnt(10)" ::: "memory"); }
    else if (U == 3) asm volatile("s_waitcnt vmcnt(14)" ::: "memory");
    else if (U == 5) asm volatile("s_waitcnt vmcnt(12)" ::: "memory");
    else asm volatile("s_waitcnt vmcnt(8)" ::: "memory");
    __builtin_amdgcn_sched_barrier(0);
    const LAS unsigned char* src = W + (U & 1) * U6_BUF + (li & 7) * U6_ROWP + 16 * lq;
    f32x4 acc = (f32x4){0.f, 0.f, 0.f, 0.f};
#pragma unroll
    for (int c = 0; c < 16; ++c) { const v4u a = *(const LAS v4u*)(src + 64 * c);
        acc = __builtin_amdgcn_mfma_f32_16x16x32_fp8_fp8((i64_t)(((unsigned long long)a[1] << 32) | a[0]), (i64_t)(((unsigned long long)hb[c][1] << 32) | hb[c][0]), acc, 0, 0, 0);
        acc = __builtin_amdgcn_mfma_f32_16x16x32_fp8_fp8((i64_t)(((unsigned long long)a[3] << 32) | a[2]), (i64_t)(((unsigned long long)hb[c][3] << 32) | hb[c][2]), acc, 0, 0, 0); }
    constexpr int base = (U & 7) * 8; const int r = li & 3;
    const float sel = r == 0 ? acc[0] : (r == 1 ? acc[1] : (r == 2 ? acc[2] : acc[3]));
    const float dmine = __shfl(sel, ((lane & 7) >> 2) * 16 + (lane & 3));
    const float gsel = U < 8 ? C.glo : C.ghi, susel = U < 8 ? C.su_lo : C.su_hi, svsel = U < 8 ? C.sv_lo : C.sv_hi;
    const float wv = gsel * gelu_erf(dmine * susel * C.hinv) * svsel;
    const bool mine = (lane >= base) && (lane < base + 8);
    if (U < 8) w_lo = mine ? wv : w_lo; else w_hi = mine ? wv : w_hi;
    if (U == 4) { nelo = *(const LAS int*)(W + U11_IDS + (l16 >> 2)); nehi = *(const LAS int*)(W + U11_IDS + 256 + (l16 >> 2)); }
    asm volatile("s_waitcnt lgkmcnt(0)" ::: "memory");
    __builtin_amdgcn_sched_barrier(0);
    if (U == 2) { u11_stage1(ws, tn, l16, W); __builtin_amdgcn_sched_barrier(0); }
    if (U == 4) { u11_stage2(ws, nelo, nehi, W); __builtin_amdgcn_sched_barrier(0); }
}
__device__ __forceinline__ void p8_peer_up11(Frame& F) {
    const int f_tid = threadIdx.x, lane = f_tid & 63, f_wave = __builtin_amdgcn_readfirstlane(f_tid >> 6);
    const int lq = lane >> 4;
    const unsigned char* EU = F.ws + WS_EU;
    LAS unsigned char* W = F.lds + f_wave * U11_WAVE;
    for (int wq = F.vcu * NWAVES + f_wave; wq < MTOK / 16; wq += F.G * NWAVES) {
        unsigned l16 = 16u * (unsigned)lane; asm volatile("" : "+v"(l16));
        const size_t t0 = (size_t)wq * 16;
        u11_stage1(F.ws, t0, l16, W);
        asm volatile("s_waitcnt vmcnt(0)" ::: "memory");
        int nelo = *(const LAS int*)(W + U11_IDS + (l16 >> 2)), nehi = *(const LAS int*)(W + U11_IDS + 256 + (l16 >> 2));
        LDS_WAIT(); asm volatile("" ::: "memory");
        u11_stage2(F.ws, nelo, nehi, W);
        u11_unit_dma<0>(nelo, nehi, EU, l16, W);
        asm volatile("s_waitcnt vmcnt(0)" ::: "memory");
        U11Tok C; v4u hb[16];
        u11_switch(C, nelo, nehi, W, l16, lq, hb);
#pragma unroll 1
        for (int tt = 0; tt < 16; ++tt) {
            float w_lo = 0.f, w_hi = 0.f;
            const size_t tn = t0 + (tt < 15 ? tt + 1 : tt);
            const bool ft = (tt == 0);
#define U11_U(U) u11_unit<U>(C, nelo, nehi, EU, F.ws, l16, W, hb, w_lo, w_hi, tn, ft, lane);
            U11_U(0) U11_U(1) U11_U(2) U11_U(3) U11_U(4) U11_U(5) U11_U(6) U11_U(7) U11_U(8) U11_U(9) U11_U(10) U11_U(11) U11_U(12) U11_U(13) U11_U(14) U11_U(15)
#undef U11_U
            WSP(float, WS_GATE)[(t0 + tt) * 128 + lane] = w_lo; WSP(float, WS_GATE)[(t0 + tt) * 128 + 64 + lane] = w_hi;
            __builtin_amdgcn_sched_barrier(0);
            u11_switch(C, nelo, nehi, W, l16, lq, hb);
        }
        asm volatile("s_waitcnt vmcnt(0)" ::: "memory");
    }
}
typedef unsigned v3u __attribute__((ext_vector_type(3)));
typedef unsigned v6u __attribute__((ext_vector_type(6)));
typedef float f32x32 __attribute__((ext_vector_type(32)));
struct __attribute__((packed, aligned(4))) U3 { unsigned a, b, c; };
__device__ __forceinline__ v3u ld_row6(const unsigned char* p) { const U3 u = *(const U3*)p; return (v3u){u.a, u.b, u.c}; }
__device__ __forceinline__ void p9_peer_down3(Frame& F) {
    const int f_tid = threadIdx.x, lane = f_tid & 63, f_wave = __builtin_amdgcn_readfirstlane(f_tid >> 6);
    const unsigned char* EV = F.ws + WS_EV;
    for (int wq = F.vcu * NWAVES + f_wave; wq < MTOK / 16; wq += F.G * NWAVES) {
        const int b = wq >> 7; const float* mb = WSP(float, WS_MOD) + (size_t)b * 6144;
        unsigned l16 = 16u * (unsigned)lane; asm volatile("" : "+v"(l16));
        const unsigned l12 = (l16 >> 2) * 3u;
        int ne_lo = WSP(int, WS_EID)[(size_t)wq * 16 * 128 + lane], ne_hi = WSP(int, WS_EID)[(size_t)wq * 16 * 128 + 64 + lane];
        float nw_lo = WSP(float, WS_GATE)[(size_t)wq * 16 * 128 + lane], nw_hi = WSP(float, WS_GATE)[(size_t)wq * 16 * 128 + 64 + lane];
        v3u qa[8], qb[8];
#pragma unroll
        for (int j = 0; j < 8; ++j) { const int e = __builtin_amdgcn_readlane(ne_lo, j); qa[j] = ld_row6(EV + ((unsigned)e * 768u + l12)); }
#pragma unroll 1
        for (int tt = 0; tt < 16; ++tt) {
            const size_t t = (size_t)wq * 16 + tt;
            float* xr = (float*)((char*)(F.out + t * 1024) + 4u * l16);
            const int e_lo = ne_lo, e_hi = ne_hi; const float w_lo = nw_lo, w_hi = nw_hi;
            { const size_t tn = t + (tt < 15 ? 1 : 0); ne_lo = WSP(int, WS_EID)[tn * 128 + lane]; ne_hi = WSP(int, WS_EID)[tn * 128 + 64 + lane]; nw_lo = WSP(float, WS_GATE)[tn * 128 + lane]; nw_hi = WSP(float, WS_GATE)[tn * 128 + 64 + lane]; }
            f32x2 o[8];
#pragma unroll
            for (int i = 0; i < 8; ++i) o[i] = (f32x2){0.f, 0.f};
#define DN3_STEP(GRP, CUR, NXT, NIDS, NB) { \
                const int grp = (GRP); \
                { const int nids = (NIDS); _Pragma("unroll") for (int j = 0; j < 8; ++j) { const int e = __builtin_amdgcn_readlane(nids, (NB) + j); NXT[j] = ld_row6(EV + ((unsigned)e * 768u + l12)); } } \
                __builtin_amdgcn_sched_barrier(0); \
                const int base = (grp & 7) * 8; const float wsel = grp < 8 ? w_lo : w_hi; \
                _Pragma("unroll") for (int j = 0; j < 8; j += 2) { \
                    const float wa = __builtin_bit_cast(float, __builtin_amdgcn_readlane(__builtin_bit_cast(int, wsel), base + j)), wb = __builtin_bit_cast(float, __builtin_amdgcn_readlane(__builtin_bit_cast(int, wsel), base + j + 1)); \
                    const f32x2 wa2 = (f32x2){wa, wa}, wb2 = (f32x2){wb, wb}; \
                    const v6u pr = (v6u){CUR[j][0], CUR[j][1], CUR[j][2], CUR[j + 1][0], CUR[j + 1][1], CUR[j + 1][2]}; \
                    const f32x32 r = __builtin_amdgcn_cvt_scalef32_pk32_f32_fp6(pr, 1.0f); \
                    _Pragma("unroll") for (int i = 0; i < 8; ++i) { o[i] += wa2 * (f32x2){r[2 * i], r[2 * i + 1]}; o[i] += wb2 * (f32x2){r[16 + 2 * i], r[17 + 2 * i]}; } } }
#pragma unroll 1
            for (int g2 = 0; g2 < 14; g2 += 2) { const int ga = g2 + 1, gb = g2 + 2;
                DN3_STEP(g2, qa, qb, ga < 8 ? e_lo : e_hi, (ga & 7) * 8)
                DN3_STEP(g2 + 1, qb, qa, gb < 8 ? e_lo : e_hi, (gb & 7) * 8) }
            DN3_STEP(14, qa, qb, e_hi, 56)
            DN3_STEP(15, qb, qa, ne_lo, 0)
#undef DN3_STEP
            float x1[16]; float ss = 0.f;
#ifdef X1B
            { const char* xb = (const char*)(F.ws + WS_X1B + t * 2048) + 2u * l16; const v4u xa = *(const v4u*)xb, xc = *(const v4u*)(xb + 16); unpack8(xa, x1); unpack8(xc, x1 + 8); }
#else
#pragma unroll
            for (int q4 = 0; q4 < 4; ++q4) { const f32x4 v = *(const f32x4*)(xr + 4 * q4); x1[4 * q4] = v[0]; x1[4 * q4 + 1] = v[1]; x1[4 * q4 + 2] = v[2]; x1[4 * q4 + 3] = v[3]; }
#endif
#pragma unroll
            for (int q4 = 0; q4 < 4; ++q4) { const f32x4 gt = *(const f32x4*)((const char*)(mb + 5120) + 4u * l16 + 16 * q4);
#pragma unroll
                for (int e = 0; e < 4; ++e) { const int i = 4 * q4 + e; x1[i] += gt[e] * o[i >> 1][i & 1]; ss += x1[i] * x1[i]; } }
            const float rf = rsqrt_f(wave_sum(ss) * (1.0f / 1024.0f) + EPSF);
#pragma unroll
            for (int q4 = 0; q4 < 4; ++q4) { const f32x4 nf = *(const f32x4*)((const char*)(F.a->in[29]) + 4u * l16 + 16 * q4); f32x4 v;
#pragma unroll
                for (int e = 0; e < 4; ++e) v[e] = x1[4 * q4 + e] * rf * nf[e];
                *(f32x4*)(xr + 4 * q4) = v; }
        }
    }
}
constexpr int U12_ROWP = 784, U12_NBUF = 3, U12_BUF = 8 * U12_ROWP, U12_WAVE = U12_NBUF * U12_BUF + 1024;
static_assert(8 * U12_WAVE <= LDS_MAIN, "U12 LDS map");
typedef int i32x8 __attribute__((ext_vector_type(8)));
typedef unsigned v2u __attribute__((ext_vector_type(2)));
__device__ __forceinline__ void p8_peer_up12(Frame& F) {
    const int f_tid = threadIdx.x, lane = f_tid & 63, f_wave = __builtin_amdgcn_readfirstlane(f_tid >> 6);
    const int li = lane & 15, lq = lane >> 4;
    const unsigned char* EU = F.ws + WS_EU; const float* EUS = WSP(float, WS_EUS); const float* EVS = WSP(float, WS_EVS);
    LAS unsigned char* ring = F.lds + f_wave * U12_WAVE; LAS unsigned char* hq = ring + U12_NBUF * U12_BUF;
#ifdef PROBE_MFMA
    if (blockIdx.x == 0 && f_wave == 0) {
        i32x8 A = (i32x8){0, 0, 0, 0, 0, 0, 0, 0}; if (lane == PROBE_ALANE) A[PROBE_AREG] = PROBE_AVAL;
        i32x8 B;
        if (PROBE_BPAT == 0) B = (i32x8){0x48444038, 0x504E4C4A, 0x54535251, 0x58575655, 0x48444038, 0x504E4C4A, 0x54535251, 0x58575655};
        else { const unsigned c0 = (const unsigned[]){0x38u, 0x40u, 0x44u, 0x48u, 0x4Au, 0x4Cu, 0x4Eu, 0x50u}[0]; (void)c0;
               const int k = lane >> 4; const unsigned lo = k == 0 ? 0x38u : (k == 1 ? 0x44u : (k == 2 ? 0x4Au : 0x4Eu)), hi = k == 0 ? 0x40u : (k == 1 ? 0x48u : (k == 2 ? 0x4Cu : 0x50u));
               const int wl = (int)(lo * 0x01010101u), wh = (int)(hi * 0x01010101u); B = (i32x8){wl, wl, wl, wl, wh, wh, wh, wh}; }
        f32x4 acc = (f32x4){0.f, 0.f, 0.f, 0.f};
        acc = __builtin_amdgcn_mfma_scale_f32_16x16x128_f8f6f4(A, B, acc, 2, 0, 0, 0, 0, 0);
        if (lane == 0) *(volatile float*)(F.ws + WS_CTL + 40000) = acc[0] * 100.0f;
    }
#endif
    for (int wq = F.vcu * NWAVES + f_wave; wq < MTOK / 16; wq += F.G * NWAVES) {
        const int b = wq >> 7; const float* mb = WSP(float, WS_MOD) + (size_t)b * 6144;
        for (int tt = 0; tt < 16; ++tt) {
            const size_t t = (size_t)wq * 16 + tt;
            unsigned l16 = 16u * (unsigned)lane; asm volatile("" : "+v"(l16));
            const int e_lo = WSP(int, WS_EID)[t * 128 + lane], e_hi = WSP(int, WS_EID)[t * 128 + 64 + lane];
            const float g_lo = WSP(float, WS_GATE)[t * 128 + lane], g_hi = WSP(float, WS_GATE)[t * 128 + 64 + lane];
            const float rs = rsqrt_f(WSP(float, WS_ROWSTAT)[t] * (1.0f / 1024.0f) + EPSF);
            const char* xs = (const char*)(WSP(bf16, WS_X1S) + t * 1024) + 2u * l16; const v4u xa = *(const v4u*)xs, xb = *(const v4u*)(xs + 16);
            asm volatile("s_waitcnt vmcnt(0)" ::: "memory");
            if (lane < 48) {
#pragma unroll
            for (int j = 0; j < 16; ++j) { const int e = __builtin_amdgcn_readlane(e_lo, j);
                __builtin_amdgcn_global_load_lds((const unsigned*)(EU + ((unsigned)e * 768u + l16)), (LAS unsigned*)(ring + j * U12_ROWP), 16, 0, 0); } }
            const float su_lo = EUS[e_lo], su_hi = EUS[e_hi], sv_lo = EVS[e_lo], sv_hi = EVS[e_hi];
            float h2[16]; unpack8(xa, h2); unpack8(xb, h2 + 8); float mx = 0.f;
#pragma unroll
            for (int qd = 0; qd < 4; ++qd) { const f32x4 sh = *(const f32x4*)((const char*)(mb + 3072) + 4u * l16 + 16 * qd);
#pragma unroll
                for (int e = 0; e < 4; ++e) { h2[4 * qd + e] = h2[4 * qd + e] * rs + sh[e]; mx = fmaxf(mx, fabsf(h2[4 * qd + e])); } }
#pragma unroll
            for (int o = 1; o < 64; o <<= 1) mx = fmaxf(mx, __shfl_xor(mx, o));
            mx = fmaxf(mx, 1e-30f); const float hs = 224.0f / mx, hinv = mx * (1.0f / 224.0f);
            { v4u w;
#pragma unroll
              for (int qd = 0; qd < 4; ++qd) { int pk = 0; pk = __builtin_amdgcn_cvt_pk_fp8_f32(h2[4 * qd] * hs, h2[4 * qd + 1] * hs, pk, false); pk = __builtin_amdgcn_cvt_pk_fp8_f32(h2[4 * qd + 2] * hs, h2[4 * qd + 3] * hs, pk, true); w[qd] = (unsigned)pk; }
              *(LAS v4u*)(hq + l16) = w; }
            LDS_WAIT(); asm volatile("" ::: "memory");
            v4u hb[8];
#pragma unroll
            for (int c = 0; c < 4; ++c) { hb[2 * c] = *(const LAS v4u*)(hq + (li & 1) * 512 + 128 * c + 16 * lq); hb[2 * c + 1] = *(const LAS v4u*)(hq + (li & 1) * 512 + 128 * c + 64 + 16 * lq); }
            asm volatile("s_waitcnt vmcnt(0)" ::: "memory");
            float w_lo = 0.f, w_hi = 0.f;
            int cur = 0, nx2 = 2 * U12_BUF;
#pragma unroll 1
            for (int u = 0; u < 16; ++u) {
                if (u < 14) { const int un = u + 2; int ensel = un < 8 ? e_lo : e_hi; asm volatile("" : "+v"(ensel));     const int nb = (un & 7) * 8; LAS unsigned char* dst = ring + nx2;
                  if (lane < 48) {
#pragma unroll
                  for (int j = 0; j < 8; ++j) { const int e = __builtin_amdgcn_readlane(ensel, nb + j);
                      __builtin_amdgcn_global_load_lds((const unsigned*)(EU + ((unsigned)e * 768u + l16)), (LAS unsigned*)(dst + j * U12_ROWP), 16, 0, 0); } }
                  asm volatile("s_waitcnt vmcnt(16)" ::: "memory"); }
                else if (u == 14) asm volatile("s_waitcnt vmcnt(8)" ::: "memory");
                else asm volatile("s_waitcnt vmcnt(0)" ::: "memory");
                const LAS unsigned char* src = ring + cur + (li & 7) * U12_ROWP + (li >> 3) * 384 + 24 * lq;
                f32x4 acc = (f32x4){0.f, 0.f, 0.f, 0.f};
#pragma unroll
                for (int c = 0; c < 4; ++c) { const v2u a0 = *(const LAS v2u*)(src + 96 * c), a1 = *(const LAS v2u*)(src + 96 * c + 8), a2 = *(const LAS v2u*)(src + 96 * c + 16);
                    const i32x8 A = (i32x8){(int)a0[0], (int)a0[1], (int)a1[0], (int)a1[1], (int)a2[0], (int)a2[1], 0, 0};
                    const i32x8 B = (i32x8){(int)hb[2 * c][0], (int)hb[2 * c][1], (int)hb[2 * c][2], (int)hb[2 * c][3], (int)hb[2 * c + 1][0], (int)hb[2 * c + 1][1], (int)hb[2 * c + 1][2], (int)hb[2 * c + 1][3]};
                    acc = __builtin_amdgcn_mfma_scale_f32_16x16x128_f8f6f4(A, B, acc, 2, 0, 0, 0, 0, 0); }
                const int base = (u & 7) * 8; const int r = (li >> 1) & 3;
                const float sel = r == 0 ? acc[0] : (r == 1 ? acc[1] : (r == 2 ? acc[2] : acc[3]));
                const int sl = ((lane & 7) >> 2) * 16 + 2 * (lane & 3);
                const float dmine = __shfl(sel, sl) + __shfl(sel, sl + 33);
                const float gsel = u < 8 ? g_lo : g_hi, susel = u < 8 ? su_lo : su_hi, svsel = u < 8 ? sv_lo : sv_hi;
                const float wv = gsel * gelu_erf(dmine * susel * hinv) * svsel;
                const bool mine = (lane >= base) && (lane < base + 8);
                if (u < 8) w_lo = mine ? wv : w_lo; else w_hi = mine ? wv : w_hi;
                asm volatile("s_waitcnt lgkmcnt(0)" ::: "memory");
                cur = cur == 2 * U12_BUF ? 0 : cur + U12_BUF; nx2 = nx2 == 2 * U12_BUF ? 0 : nx2 + U12_BUF;
            }
            WSP(float, WS_GATE)[t * 128 + lane] = w_lo; WSP(float, WS_GATE)[t * 128 + 64 + lane] = w_hi;
        }
    }
}
constexpr int U14_ROWP = 1040, U14_BUF = 8 * U14_ROWP, U14_WAVE = 2 * U14_BUF + 1024;
static_assert(8 * U14_WAVE <= LDS_MAIN, "U14 LDS map");
struct U14Meta { int elo, ehi; float glo, ghi; v4u xa, xb; float rst; };
__device__ __forceinline__ void u14_meta_load(U14Meta& M, const unsigned char* ws, size_t t, unsigned l16) {
    const unsigned l = l16 >> 4; const int* ep = (const int*)(ws + WS_EID) + t * 128; const float* gp = (const float*)(ws + WS_GATE) + t * 128;
    M.elo = ep[l]; M.ehi = ep[64 + l]; M.glo = gp[l]; M.ghi = gp[64 + l];
    const char* xs = (const char*)(ws + WS_X1S) + t * 2048 + 2u * l16; M.xa = *(const v4u*)xs; M.xb = *(const v4u*)(xs + 16);
    M.rst = ((const float*)(ws + WS_ROWSTAT))[t];
}
__device__ __forceinline__ void u14_h2(const U14Meta& M, const float* S2, LAS unsigned char* hq, unsigned l16, int li, int lq, v4u* hb, float& hinv) {
    float h2[16]; unpack8(M.xa, h2); unpack8(M.xb, h2 + 8); float mx = 0.f;
    const float rs = rsqrt_f(M.rst * (1.0f / 1024.0f) + EPSF);
#pragma unroll
    for (int i = 0; i < 16; ++i) { h2[i] = h2[i] * rs + S2[i]; mx = fmaxf(mx, fabsf(h2[i])); }
#pragma unroll
    for (int o = 1; o < 64; o <<= 1) mx = fmaxf(mx, __shfl_xor(mx, o));
    mx = fmaxf(mx, 1e-30f); const float hs = 224.0f / mx; hinv = mx * (1.0f / 224.0f);
    v4u w;
#pragma unroll
    for (int qd = 0; qd < 4; ++qd) { int pk = 0; pk = __builtin_amdgcn_cvt_pk_fp8_f32(h2[4 * qd] * hs, h2[4 * qd + 1] * hs, pk, false); pk = __builtin_amdgcn_cvt_pk_fp8_f32(h2[4 * qd + 2] * hs, h2[4 * qd + 3] * hs, pk, true); w[qd] = (unsigned)pk; }
    *(LAS v4u*)(hq + l16) = w;
    LDS_WAIT(); asm volatile("" ::: "memory");
#pragma unroll
    for (int c = 0; c < 4; ++c) { hb[2 * c] = *(const LAS v4u*)(hq + (li & 1) * 512 + 128 * c + 16 * lq); hb[2 * c + 1] = *(const LAS v4u*)(hq + (li & 1) * 512 + 128 * c + 64 + 16 * lq); }
    LDS_WAIT(); asm volatile("" ::: "memory");
}
__device__ __forceinline__ void p8_peer_up14(Frame& F) {
    const int f_tid = threadIdx.x, lane = f_tid & 63, f_wave = __builtin_amdgcn_readfirstlane(f_tid >> 6);
    const int li = lane & 15, lq = lane >> 4;
    const unsigned char* EU = F.ws + WS_EU; const float* EUS = WSP(float, WS_EUS); const float* EVS = WSP(float, WS_EVS);
    LAS unsigned char* tile = F.lds + f_wave * U14_WAVE; LAS unsigned char* hq = tile + 2 * U14_BUF;
    for (int wq = F.vcu * NWAVES + f_wave; wq < MTOK / 16; wq += F.G * NWAVES) {
        const int b = wq >> 7; const float* mb = WSP(float, WS_MOD) + (size_t)b * 6144;
        unsigned l16 = 16u * (unsigned)lane; asm volatile("" : "+v"(l16));
        const unsigned rof = l16 < 768u ? l16 : l16 - 768u;
        float S2[16];
#pragma unroll
        for (int q = 0; q < 4; ++q) { const f32x4 sh = *(const f32x4*)((const char*)(mb + 3072) + 4u * l16 + 16 * q); S2[4 * q] = sh[0]; S2[4 * q + 1] = sh[1]; S2[4 * q + 2] = sh[2]; S2[4 * q + 3] = sh[3]; }
        const size_t t0 = (size_t)wq * 16;
        U14Meta N; u14_meta_load(N, F.ws, t0, l16);
        float nsu_lo = EUS[N.elo], nsu_hi = EUS[N.ehi], nsv_lo = EVS[N.elo], nsv_hi = EVS[N.ehi];
        v4u qa[8], qb[8];
#pragma unroll
        for (int j = 0; j < 8; ++j) { const int e = __builtin_amdgcn_readlane(N.elo, j); qa[j] = *(const v4u*)(EU + ((unsigned)e * 768u + rof)); }
#pragma unroll 1
        for (int tt = 0; tt < 16; ++tt) {
            const size_t t = t0 + tt;
            const int e_lo = N.elo, e_hi = N.ehi; const float g_lo = N.glo, g_hi = N.ghi, su_lo = nsu_lo, su_hi = nsu_hi, sv_lo = nsv_lo, sv_hi = nsv_hi;
            v4u hb[8]; float hinv;
            u14_h2(N, S2, hq, l16, li, lq, hb, hinv);
            u14_meta_load(N, F.ws, t + (tt < 15 ? 1 : 0), l16);
            float w_lo = 0.f, w_hi = 0.f;
#define U14_STEP(UU, CUR, NXT, NLO, NHI) { \
            const int u = (UU); const int un = (u + 1) & 15; const int nb = (un & 7) * 8; const int ensel = un < 8 ? (NLO) : (NHI); \
            { _Pragma("unroll") for (int j = 0; j < 8; ++j) { const int e = __builtin_amdgcn_readlane(ensel, nb + j); NXT[j] = *(const v4u*)(EU + ((unsigned)e * 768u + rof)); } } \
            __builtin_amdgcn_sched_barrier(0); \
            LAS unsigned char* tb = tile + (u & 1) * U14_BUF; \
            { _Pragma("unroll") for (int j = 0; j < 8; ++j) *(LAS v4u*)(tb + j * U14_ROWP + l16) = CUR[j]; } \
            LDS_WAIT(); asm volatile("" ::: "memory"); \
            const LAS unsigned char* src = tb + (li & 7) * U14_ROWP + (li >> 3) * 384 + 24 * lq; \
            f32x4 acc = (f32x4){0.f, 0.f, 0.f, 0.f}; \
            _Pragma("unroll") for (int c = 0; c < 4; ++c) { const v2u a0 = *(const LAS v2u*)(src + 96 * c), a1 = *(const LAS v2u*)(src + 96 * c + 8), a2 = *(const LAS v2u*)(src + 96 * c + 16); \
                const i32x8 A = (i32x8){(int)a0[0], (int)a0[1], (int)a1[0], (int)a1[1], (int)a2[0], (int)a2[1], 0, 0}; \
                const i32x8 B = (i32x8){(int)hb[2 * c][0], (int)hb[2 * c][1], (int)hb[2 * c][2], (int)hb[2 * c][3], (int)hb[2 * c + 1][0], (int)hb[2 * c + 1][1], (int)hb[2 * c + 1][2], (int)hb[2 * c + 1][3]}; \
                acc = __builtin_amdgcn_mfma_scale_f32_16x16x128_f8f6f4(A, B, acc, 2, 0, 0, 0, 0, 0); }        \
            const int base = (u & 7) * 8; const int r = (li >> 1) & 3; \
            const float sel = r == 0 ? acc[0] : (r == 1 ? acc[1] : (r == 2 ? acc[2] : acc[3])); \
            const int sl = ((lane & 7) >> 2) * 16 + 2 * (lane & 3);                          \
            const float dmine = __shfl(sel, sl) + __shfl(sel, sl + 33); \
            const float gsel = u < 8 ? g_lo : g_hi, susel = u < 8 ? su_lo : su_hi, svsel = u < 8 ? sv_lo : sv_hi; \
            const float wv = gsel * gelu_erf(dmine * susel * hinv) * svsel; \
            const bool mine = (lane >= base) && (lane < base + 8); \
            if (u < 8) w_lo = mine ? wv : w_lo; else w_hi = mine ? wv : w_hi; }
#pragma unroll 1
            for (int u2 = 0; u2 < 14; u2 += 2) { U14_STEP(u2, qa, qb, e_lo, e_hi) U14_STEP(u2 + 1, qb, qa, e_lo, e_hi) }
            U14_STEP(14, qa, qb, e_lo, e_hi)
            U14_STEP(15, qb, qa, N.elo, N.ehi)
#undef U14_STEP
            nsu_lo = EUS[N.elo]; nsu_hi = EUS[N.ehi]; nsv_lo = EVS[N.elo]; nsv_hi = EVS[N.ehi];
            __builtin_amdgcn_sched_barrier(0);
            WSP(float, WS_GATE)[t * 128 + lane] = w_lo; WSP(float, WS_GATE)[t * 128 + 64 + lane] = w_hi;
        }
    }
}
#ifdef TOPK2
#define P7FN p5b_topk2
#else
#define P7FN p5b_topk
#endif
constexpr int U16_ROWP = 1040, U16_BUF = 8 * U16_ROWP, U16_WAVE = 2 * U16_BUF + 1024;
static_assert(8 * U16_WAVE <= LDS_MAIN, "U16 LDS map");
struct U16A { v2u p[12]; };
__device__ __forceinline__ void u16_rows(v4u* R, int ids, int nb, const unsigned char* EU, unsigned rof) {
#pragma unroll
    for (int j = 0; j < 8; ++j) { const int e = __builtin_amdgcn_readlane(ids, nb + j); R[j] = *(const v4u*)(EU + ((unsigned)e * 768u + rof)); }
}
__device__ __forceinline__ void u16_write(const v4u* R, LAS unsigned char* tb, unsigned l16) {
#pragma unroll
    for (int j = 0; j < 8; ++j) *(LAS v4u*)(tb + j * U16_ROWP + l16) = R[j];
}
__device__ __forceinline__ void u16_read(U16A& A, const LAS unsigned char* tb, int li, int lq) {
    const LAS unsigned char* src = tb + (li & 7) * U16_ROWP + (li >> 3) * 384 + 24 * lq;
#pragma unroll
    for (int c = 0; c < 4; ++c) { A.p[3 * c] = *(const LAS v2u*)(src + 96 * c); A.p[3 * c + 1] = *(const LAS v2u*)(src + 96 * c + 8); A.p[3 * c + 2] = *(const LAS v2u*)(src + 96 * c + 16); }
}
__device__ __forceinline__ f32x4 u16_mma(const U16A& A, const v4u* hb) {
    f32x4 acc = (f32x4){0.f, 0.f, 0.f, 0.f};
#pragma unroll
    for (int c = 0; c < 4; ++c) {
        const i32x8 a = (i32x8){(int)A.p[3 * c][0], (int)A.p[3 * c][1], (int)A.p[3 * c + 1][0], (int)A.p[3 * c + 1][1], (int)A.p[3 * c + 2][0], (int)A.p[3 * c + 2][1], 0, 0};
        const i32x8 bb = (i32x8){(int)hb[2 * c][0], (int)hb[2 * c][1], (int)hb[2 * c][2], (int)hb[2 * c][3], (int)hb[2 * c + 1][0], (int)hb[2 * c + 1][1], (int)hb[2 * c + 1][2], (int)hb[2 * c + 1][3]};
        acc = __builtin_amdgcn_mfma_scale_f32_16x16x128_f8f6f4(a, bb, acc, 2, 0, 0, 0, 0, 0); }
    return acc;
}
__device__ __forceinline__ void p8_peer_up16(Frame& F) {
    const int f_tid = threadIdx.x, lane = f_tid & 63, f_wave = __builtin_amdgcn_readfirstlane(f_tid >> 6);
    const int li = lane & 15, lq = lane >> 4;
    const unsigned char* EU = F.ws + WS_EU; const float* EUS = WSP(float, WS_EUS); const float* EVS = WSP(float, WS_EVS);
    LAS unsigned char* tile = F.lds + f_wave * U16_WAVE; LAS unsigned char* hq = tile + 2 * U16_BUF;
    for (int wq = F.vcu * NWAVES + f_wave; wq < MTOK / 16; wq += F.G * NWAVES) {
        const int b = wq >> 7; const float* mb = WSP(float, WS_MOD) + (size_t)b * 6144;
        unsigned l16 = 16u * (unsigned)lane; asm volatile("" : "+v"(l16));
        const unsigned rof = l16 < 768u ? l16 : l16 - 768u;
        float S2[16];
#pragma unroll
        for (int q = 0; q < 4; ++q) { const f32x4 sh = *(const f32x4*)((const char*)(mb + 3072) + 4u * l16 + 16 * q); S2[4 * q] = sh[0]; S2[4 * q + 1] = sh[1]; S2[4 * q + 2] = sh[2]; S2[4 * q + 3] = sh[3]; }
        const size_t t0 = (size_t)wq * 16;
        U14Meta N; u14_meta_load(N, F.ws, t0, l16);
        float nsu_lo = EUS[N.elo], nsu_hi = EUS[N.ehi], nsv_lo = EVS[N.elo], nsv_hi = EVS[N.ehi];
        v4u r0[8], r1[8];
        U16A A;
        u16_rows(r0, N.elo, 0, EU, rof); u16_rows(r1, N.elo, 8, EU, rof);
        u16_write(r0, tile, l16);
        LDS_WAIT(); asm volatile("" ::: "memory");
        u16_read(A, tile, li, lq);
#pragma unroll 1
        for (int tt = 0; tt < 16; ++tt) {
            const size_t t = t0 + tt;
            const int e_lo = N.elo, e_hi = N.ehi; const float g_lo = N.glo, g_hi = N.ghi, su_lo = nsu_lo, su_hi = nsu_hi, sv_lo = nsv_lo, sv_hi = nsv_hi;
            v4u hb[8]; float hinv;
            u14_h2(N, S2, hq, l16, li, lq, hb, hinv);
            u14_meta_load(N, F.ws, t + (tt < 15 ? 1 : 0), l16);
            float w_lo = 0.f, w_hi = 0.f;
#define U16_STEP(UU, RL, RW, IDS, NB) { \
            const int u = (UU); \
            u16_rows(RL, (IDS), (NB), EU, rof); \
            __builtin_amdgcn_sched_barrier(0); \
            LAS unsigned char* tn = tile + ((u + 1) & 1) * U16_BUF; \
            u16_write(RW, tn, l16); \
            const f32x4 acc = u16_mma(A, hb); \
            LDS_WAIT(); asm volatile("" ::: "memory"); \
            u16_read(A, tn, li, lq); \
            const int base = (u & 7) * 8; const int r = (li >> 1) & 3; \
            const float sel = r == 0 ? acc[0] : (r == 1 ? acc[1] : (r == 2 ? acc[2] : acc[3])); \
            const int sl = ((lane & 7) >> 2) * 16 + 2 * (lane & 3);                          \
            const float dmine = __shfl(sel, sl) + __shfl(sel, sl + 33); \
            const float gsel = u < 8 ? g_lo : g_hi, susel = u < 8 ? su_lo : su_hi, svsel = u < 8 ? sv_lo : sv_hi; \
            const float wv = gsel * gelu_erf(dmine * susel * hinv) * svsel; \
            const bool mine = (lane >= base) && (lane < base + 8); \
            if (u < 8) w_lo = mine ? wv : w_lo; else w_hi = mine ? wv : w_hi; }
#pragma unroll 1
            for (int u2 = 0; u2 < 14; u2 += 2) { const int ua = u2 + 2, ub = u2 + 3;
                U16_STEP(u2, r0, r1, ua < 8 ? e_lo : e_hi, (ua & 7) * 8)
                U16_STEP(u2 + 1, r1, r0, ub < 8 ? e_lo : e_hi, (ub & 7) * 8) }
            U16_STEP(14, r0, r1, N.elo, 0)
            U16_STEP(15, r1, r0, N.elo, 8)
#undef U16_STEP
            nsu_lo = EUS[N.elo]; nsu_hi = EUS[N.ehi]; nsv_lo = EVS[N.elo]; nsv_hi = EVS[N.ehi];
            __builtin_amdgcn_sched_barrier(0);
            WSP(float, WS_GATE)[t * 128 + lane] = w_lo; WSP(float, WS_GATE)[t * 128 + 64 + lane] = w_hi;
        }
    }
}
typedef int i32x8 __attribute__((ext_vector_type(8)));
struct U15Meta { int elo, ehi; float glo, ghi; v4u xa, xb; float rst; };
__device__ __forceinline__ void u15_meta_load(U15Meta& M, const unsigned char* ws, size_t t, unsigned l16) {
    const unsigned l = l16 >> 4; const int* ep = (const int*)(ws + WS_EID) + t * 128; const float* gp = (const float*)(ws + WS_GATE) + t * 128;
    M.elo = ep[l]; M.ehi = ep[64 + l]; M.glo = gp[l]; M.ghi = gp[64 + l];
    const char* xs = (const char*)(ws + WS_X1S) + t * 2048 + 2u * l16; M.xa = *(const v4u*)xs; M.xb = *(const v4u*)(xs + 16);
    M.rst = ((const float*)(ws + WS_ROWSTAT))[t];
}
__device__ __forceinline__ void u15_h2(const U15Meta& M, const float* S2, LAS unsigned char* hq, unsigned l16, int li, int lq, v4u* hb, float& hinv) {
    float h2[16]; unpack8(M.xa, h2); unpack8(M.xb, h2 + 8); float mx = 0.f;
    const float rs = rsqrt_f(M.rst * (1.0f / 1024.0f) + EPSF);
#pragma unroll
    for (int i = 0; i < 16; ++i) { h2[i] = h2[i] * rs + S2[i]; mx = fmaxf(mx, fabsf(h2[i])); }
#pragma unroll
    for (int o = 1; o < 64; o <<= 1) mx = fmaxf(mx, __shfl_xor(mx, o));
    mx = fmaxf(mx, 1e-30f); const float hs = 224.0f / mx; hinv = mx * (1.0f / 224.0f);
    v4u w;
#pragma unroll
    for (int qd = 0; qd < 4; ++qd) { int pk = 0; pk = __builtin_amdgcn_cvt_pk_fp8_f32(h2[4 * qd] * hs, h2[4 * qd + 1] * hs, pk, false); pk = __builtin_amdgcn_cvt_pk_fp8_f32(h2[4 * qd + 2] * hs, h2[4 * qd + 3] * hs, pk, true); w[qd] = (unsigned)pk; }
    *(LAS v4u*)(hq + l16) = w;
    LDS_WAIT(); asm volatile("" ::: "memory");
#pragma unroll
    for (int c = 0; c < 4; ++c) { const int o = (li & 1) * 512 + 128 * (lq >> 1) + 32 * c + 16 * (lq & 1); hb[2 * c] = *(const LAS v4u*)(hq + o); hb[2 * c + 1] = *(const LAS v4u*)(hq + o + 256); }
    LDS_WAIT(); asm volatile("" ::: "memory");
}
__device__ __forceinline__ void p8_peer_up15(Frame& F) {
    const int f_tid = threadIdx.x, lane = f_tid & 63, f_wave = __builtin_amdgcn_readfirstlane(f_tid >> 6);
    const int li = lane & 15, lq = lane >> 4;
    const unsigned char* EU = F.ws + WS_EU; const float* EUS = WSP(float, WS_EUS); const float* EVS = WSP(float, WS_EVS);
    LAS unsigned char* hq = F.lds + f_wave * 1024;
    for (int wq = F.vcu * NWAVES + f_wave; wq < MTOK / 16; wq += F.G * NWAVES) {
        const int b = wq >> 7; const float* mb = WSP(float, WS_MOD) + (size_t)b * 6144;
        unsigned l16 = 16u * (unsigned)lane; asm volatile("" : "+v"(l16));
        unsigned qof = 16u * (unsigned)(4 * (li >> 3) + lq); asm volatile("" : "+v"(qof));
        const int rsel = li & 7;
        float S2[16];
#pragma unroll
        for (int q = 0; q < 4; ++q) { const f32x4 sh = *(const f32x4*)((const char*)(mb + 3072) + 4u * l16 + 16 * q); S2[4 * q] = sh[0]; S2[4 * q + 1] = sh[1]; S2[4 * q + 2] = sh[2]; S2[4 * q + 3] = sh[3]; }
        const size_t t0 = (size_t)wq * 16;
        U15Meta N; u15_meta_load(N, F.ws, t0, l16);
        float nsu_lo = EUS[N.elo], nsu_hi = EUS[N.ehi], nsv_lo = EVS[N.elo], nsv_hi = EVS[N.ehi];
        v4u qa[6], qb[6];
        { const int e = __shfl(N.elo, rsel); const unsigned char* rp = EU + ((unsigned)e * 768u + qof);
#pragma unroll
          for (int i = 0; i < 6; ++i) qa[i] = *(const v4u*)(rp + 128 * i); }
#pragma unroll 1
        for (int tt = 0; tt < 16; ++tt) {
            const size_t t = t0 + tt;
            const int e_lo = N.elo, e_hi = N.ehi; const float g_lo = N.glo, g_hi = N.ghi, su_lo = nsu_lo, su_hi = nsu_hi, sv_lo = nsv_lo, sv_hi = nsv_hi;
            v4u hb[8]; float hinv;
            u15_h2(N, S2, hq, l16, li, lq, hb, hinv);
            u15_meta_load(N, F.ws, t + (tt < 15 ? 1 : 0), l16);
            float w_lo = 0.f, w_hi = 0.f;
#define U15_STEP(UU, CUR, NXT, NLO, NHI) { \
            const int u = (UU); const int un = (u + 1) & 15; const int nb = (un & 7) * 8; const int ensel = un < 8 ? (NLO) : (NHI); \
            { const int e = __shfl(ensel, nb + rsel); const unsigned char* rp = EU + ((unsigned)e * 768u + qof); \
              _Pragma("unroll") for (int i = 0; i < 6; ++i) NXT[i] = *(const v4u*)(rp + 128 * i); } \
            __builtin_amdgcn_sched_barrier(0); \
            f32x4 acc = (f32x4){0.f, 0.f, 0.f, 0.f}; \
            { const i32x8 B0 = (i32x8){(int)hb[0][0], (int)hb[0][1], (int)hb[0][2], (int)hb[0][3], (int)hb[1][0], (int)hb[1][1], (int)hb[1][2], (int)hb[1][3]}; \
              const i32x8 B1 = (i32x8){(int)hb[2][0], (int)hb[2][1], (int)hb[2][2], (int)hb[2][3], (int)hb[3][0], (int)hb[3][1], (int)hb[3][2], (int)hb[3][3]}; \
              const i32x8 B2 = (i32x8){(int)hb[4][0], (int)hb[4][1], (int)hb[4][2], (int)hb[4][3], (int)hb[5][0], (int)hb[5][1], (int)hb[5][2], (int)hb[5][3]}; \
              const i32x8 B3 = (i32x8){(int)hb[6][0], (int)hb[6][1], (int)hb[6][2], (int)hb[6][3], (int)hb[7][0], (int)hb[7][1], (int)hb[7][2], (int)hb[7][3]}; \
              const i32x8 A0 = (i32x8){(int)CUR[0][0], (int)CUR[0][1], (int)CUR[0][2], (int)CUR[0][3], (int)CUR[1][0], (int)CUR[1][1], 0, 0}; \
              const i32x8 A1 = (i32x8){(int)CUR[1][2], (int)CUR[1][3], (int)CUR[2][0], (int)CUR[2][1], (int)CUR[2][2], (int)CUR[2][3], 0, 0}; \
              const i32x8 A2 = (i32x8){(int)CUR[3][0], (int)CUR[3][1], (int)CUR[3][2], (int)CUR[3][3], (int)CUR[4][0], (int)CUR[4][1], 0, 0}; \
              const i32x8 A3 = (i32x8){(int)CUR[4][2], (int)CUR[4][3], (int)CUR[5][0], (int)CUR[5][1], (int)CUR[5][2], (int)CUR[5][3], 0, 0}; \
              acc = __builtin_amdgcn_mfma_scale_f32_16x16x128_f8f6f4(A0, B0, acc, 2, 0, 0, 0, 0, 0);        \
              acc = __builtin_amdgcn_mfma_scale_f32_16x16x128_f8f6f4(A1, B1, acc, 2, 0, 0, 0, 0, 0); \
              acc = __builtin_amdgcn_mfma_scale_f32_16x16x128_f8f6f4(A2, B2, acc, 2, 0, 0, 0, 0, 0); \
              acc = __builtin_amdgcn_mfma_scale_f32_16x16x128_f8f6f4(A3, B3, acc, 2, 0, 0, 0, 0, 0); } \
            const int base = (u & 7) * 8; const int r = (li >> 1) & 3; \
            const float sel = r == 0 ? acc[0] : (r == 1 ? acc[1] : (r == 2 ? acc[2] : acc[3])); \
            const int sl = ((lane & 7) >> 2) * 16 + 2 * (lane & 3);                          \
            const float dmine = __shfl(sel, sl) + __shfl(sel, sl + 33); \
            const float gsel = u < 8 ? g_lo : g_hi, susel = u < 8 ? su_lo : su_hi, svsel = u < 8 ? sv_lo : sv_hi; \
            const float wv = gsel * gelu_erf(dmine * susel * hinv) * svsel; \
            const bool mine = (lane >= base) && (lane < base + 8); \
            if (u < 8) w_lo = mine ? wv : w_lo; else w_hi = mine ? wv : w_hi; }
#pragma unroll 1
            for (int u2 = 0; u2 < 14; u2 += 2) { U15_STEP(u2, qa, qb, e_lo, e_hi) U15_STEP(u2 + 1, qb, qa, e_lo, e_hi) }
            U15_STEP(14, qa, qb, e_lo, e_hi)
            U15_STEP(15, qb, qa, N.elo, N.ehi)
#undef U15_STEP
            nsu_lo = EUS[N.elo]; nsu_hi = EUS[N.ehi]; nsv_lo = EVS[N.elo]; nsv_hi = EVS[N.ehi];
            __builtin_amdgcn_sched_barrier(0);
            WSP(float, WS_GATE)[t * 128 + lane] = w_lo; WSP(float, WS_GATE)[t * 128 + 64 + lane] = w_hi;
        }
    }
}
#ifdef TOPK2
#define P7FN p5b_topk2
#else
#define P7FN p5b_topk
#endif
constexpr int NPHASE = 10;
__global__ void __launch_bounds__(NTHR, 2) fwd_mega(Args args) {
    extern __shared__ __attribute__((aligned(16))) unsigned char lds[];
    Frame F;
    F.lds = (LAS unsigned char*)lds;
    F.MISC = (volatile LAS unsigned*)(F.lds + MISC_OFF);
    F.G = gridDim.x; { const int bx = blockIdx.x; F.vcu = (F.G % 8 == 0) ? (bx % 8) * (F.G / 8) + bx / 8 : bx; }
    F.ws = args.ws; F.out = args.out;
    F.a = &args;
    for (int u = threadIdx.x; u < 32; u += NTHR) F.MISC[u] = 0u;
    __syncthreads();
    const int lo = args.ph_lo, hi = args.ph_hi;
#ifdef PROBE_PHASE_T
    unsigned long long pt0 = 0ull;
#endif
    const bool use_bar = (hi - lo) > 1;
    XcdBarrier bar; bar.bar = (unsigned*)(F.ws + WS_CTL); bar.x = 0; bar.st = nullptr;
    if (use_bar) bar = xcd_barrier_post((unsigned*)(F.ws + WS_CTL), F.MISC + 8);
#ifdef X1B
#define X1PTR ((float*)(F.ws + WS_X1B))
#else
#define X1PTR F.out
#endif
#define IN(k) (lo <= (k) && (k) < hi)
#ifdef PROBE_PHASE_T
#define SEAM(k) do { if (IN(k) && IN((k) + 1)) xcd_barrier(bar); if ((k) + 1 == PROBE_PHASE_T) pt0 = __builtin_amdgcn_s_memrealtime(); if ((k) == PROBE_PHASE_T && blockIdx.x == 0 && threadIdx.x == 0) *(volatile float*)(F.ws + WS_CTL + 40000) = (float)(__builtin_amdgcn_s_memrealtime() - pt0) * 0.01f; } while (0)
#else
#define SEAM(k) do { if (IN(k) && IN((k) + 1)) xcd_barrier(bar); } while (0)
#endif
#ifndef REP_PHASE
#define REP_PHASE -1
#endif
#define REPEAT(k, body) do { if (REP_PHASE == (k)) { xcd_barrier(bar); body; } } while (0)
    if (IN(0)) {
#ifndef SKIP_P0
 p0_phase(F); REPEAT(0, p0_phase(F));
#endif
 } SEAM(0);
    if (IN(1)) {
#ifndef SKIP_P1
 p1_phase(F); REPEAT(1, p1_phase(F));
#endif
 } SEAM(1);
    if (IN(2)) {
        pg8::Gemm g{WSP(bf16, WS_H1), WSP(bf16, WS_WINT), MTOK, NPROJ, 1024}; pg8::StaticOrder S; S.init(MTOK, NPROJ, F.G, (int)blockIdx.x);
        pg8::EpiProj E{WSP(bf16, WS_PROJ), NPROJ};
        pg8::gemm_phase<pg8::EpiProj, pg8::StaticOrder, true, true>(F.lds, g, S, E);
        REPEAT(2, (pg8::gemm_phase<pg8::EpiProj, pg8::StaticOrder, true, true>(F.lds, g, S, E)));
    } SEAM(2);
    if (IN(3)) {
#ifndef SKIP_SSD
 p3pre_conv(F); xcd_barrier(bar); p3_ssd3(F); REPEAT(30, p3_ssd3(F)); REPEAT(32, p3pre_conv(F));
#endif
#ifndef SKIP_S5
 p3_s5v2(F); REPEAT(31, p3_s5v2(F));
#endif
 } SEAM(3);
    if (IN(5)) {
        pg8::Gemm g{WSP(bf16, WS_Y), WSP(bf16, WS_WOUTT), MTOK, 1024, 2048}; pg8::StaticOrder S; S.init(MTOK, 1024, F.G, (int)blockIdx.x);
        PG8_LAS float* tab = (PG8_LAS float*)(F.lds + pg8::STAGE_BYTES);
        { pg8::Unit u; for (int i = 0; S.next(i, u); ++i) pg8::SegScaleHook::build(F.lds + pg8::STAGE_BYTES, u, WSP(float, WS_STSSD), WSP(float, WS_STS5), (int)threadIdx.x); }
        __syncthreads();
        pg8::EpiX1 E{(F.a->in[0]), X1PTR, WSP(bf16, WS_X1S), WSP(float, WS_MOD), (F.a->in[24]), WSP(float, WS_ROWSTAT), tab};
        pg8::SegScaleHook H;
        pg8::gemm_phase<pg8::EpiX1, pg8::StaticOrder, true, true, pg8::SegScaleHook>(F.lds, g, S, E, H);
    } SEAM(5);
    if (IN(6)) {
        pg8::Gemm g{WSP(bf16, WS_X1S), WSP(bf16, WS_WQKT), MTOK, 2048, 1024}; pg8::StaticOrder S; S.init(MTOK, 2048, F.G, (int)blockIdx.x);
        pg8::EpiScores E{WSP(_Float16, WS_SCORES), WSP(float, WS_SB), WSP(float, WS_ROWSTAT)};
        pg8::gemm_phase<pg8::EpiScores, pg8::StaticOrder, true, true>(F.lds, g, S, E);
        REPEAT(6, (pg8::gemm_phase<pg8::EpiScores, pg8::StaticOrder, true, true>(F.lds, g, S, E)));
    } SEAM(6);
    if (IN(7)) {
#ifndef SKIP_TOPK
 P7FN(F); REPEAT(7, P7FN(F));
#endif
 } SEAM(7);
#ifdef UP16
    if (IN(8)) { p8_peer_up16(F); REPEAT(8, { P7FN(F); xcd_barrier(bar); p8_peer_up16(F); }); } SEAM(8);
#elif defined(UP15)
    if (IN(8)) { p8_peer_up15(F); REPEAT(8, { P7FN(F); xcd_barrier(bar); p8_peer_up15(F); }); } SEAM(8);
#elif defined(UP14)
    if (IN(8)) { p8_peer_up14(F); REPEAT(8, { P7FN(F); xcd_barrier(bar); p8_peer_up14(F); }); } SEAM(8);
#elif defined(UP12)
    if (IN(8)) { p8_peer_up12(F); REPEAT(8, { P7FN(F); xcd_barrier(bar); p8_peer_up12(F); }); } SEAM(8);
#elif defined(UP11)
    if (IN(8)) { p8_peer_up11(F); REPEAT(8, { P7FN(F); xcd_barrier(bar); p8_peer_up11(F); }); } SEAM(8);
#elif defined(UP10)
    if (IN(8)) { p8_peer_up10(F); } SEAM(8);
#else
    if (IN(8)) { p8_peer_up6(F); REPEAT(8, { P7FN(F); xcd_barrier(bar); p8_peer_up6(F); }); } SEAM(8);
#endif
#ifdef V6
    if (IN(9)) { p9_peer_down3(F); }
#else
    if (IN(9)) { p9_peer_down2(F); }
#endif
#ifdef PROBE_OUT
#if defined(PROBE_PHASE_T) && PROBE_PHASE_T == 9
    if (blockIdx.x == 0 && threadIdx.x == 0) *(volatile float*)(F.ws + WS_CTL + 40000) = (float)(__builtin_amdgcn_s_memrealtime() - pt0) * 0.01f;
#endif
    if (IN(9)) { __syncthreads(); if (blockIdx.x == 0 && threadIdx.x == 0) { asm volatile("s_waitcnt vmcnt(0)" ::: "memory"); F.out[0] = *(volatile float*)(F.ws + WS_CTL + 40000); } }
#endif
#undef IN
#undef SEAM
}

#ifndef N_LAUNCHES
#define N_LAUNCHES 1
#endif
extern "C" void kernel_launch(void* const* d_in, const int* in_sizes, int n_in, void* d_out, int out_size, void* d_ws, size_t ws_size, hipStream_t stream) {
    static int grid = 0;
    if (grid == 0) {
        if (n_in != 30 || in_sizes[0] != MTOK * DM || out_size != MTOK * DM || ws_size < WS_END) { fprintf(stderr, "kernel_launch: unexpected shapes (n_in %d, in0 %d, out %d, ws %zu)\n", n_in, n_in > 0 ? in_sizes[0] : -1, out_size, ws_size); grid = -1; return; }
        int dev = 0, cus = 0, per_cu = 0;
        if (hipGetDevice(&dev) != hipSuccess || hipDeviceGetAttribute(&cus, hipDeviceAttributeMultiprocessorCount, dev) != hipSuccess) { grid = -1; return; }
        if (hipFuncSetAttribute((const void*)fwd_mega, hipFuncAttributeMaxDynamicSharedMemorySize, LDS_BYTES) != hipSuccess) { fprintf(stderr, "kernel_launch: hipFuncSetAttribute failed\n"); grid = -1; return; }
        if (hipOccupancyMaxActiveBlocksPerMultiprocessor(&per_cu, (const void*)fwd_mega, NTHR, LDS_BYTES) != hipSuccess || per_cu < 1) { fprintf(stderr, "kernel_launch: occupancy query says %d\n", per_cu); (void)hipGetLastError(); grid = -1; return; }
        if (cus != 256) { fprintf(stderr, "kernel_launch: built for a 256-CU device (got %d CUs); nothing launched\n", cus); grid = -1; return; }
        grid = cus;
    }
    if (grid < 0) return;
    (void)hipMemsetAsync((char*)d_ws + WS_CTL, 0, CTL_ZERO_BYTES, stream);
    Args a{};
    for (int i = 0; i < 30; ++i) a.in[i] = (const float*)d_in[i];
    a.out = (float*)d_out; a.ws = (unsigned char*)d_ws;
    if (N_LAUNCHES == 1) {
        a.ph_lo = 0; a.ph_hi = NPHASE;
        void* kargs[] = {&a};
#ifdef PLAIN_LAUNCH
        (void)kargs; hipLaunchKernelGGL(fwd_mega, dim3(grid), dim3(NTHR), LDS_BYTES, stream, a);
#else
        hipError_t e = hipLaunchCooperativeKernel((const void*)fwd_mega, dim3(grid), dim3(NTHR), kargs, LDS_BYTES, stream);
        if (e != hipSuccess) fprintf(stderr, "kernel_launch: cooperative launch failed: %s (grid %d)\n", hipGetErrorString(e), grid);
#endif
    } else {
        for (int p = 0; p < NPHASE; ++p) { a.ph_lo = p; a.ph_hi = p + 1; hipLaunchKernelGGL(fwd_mega, dim3(grid), dim3(NTHR), LDS_BYTES, stream, a); }
    }
}
```

```cpp
#define V6
#define UP14
#define HWENC
#define DN3B
#define X1B
#define RANGE16
#include <hip/hip_runtime.h>
#include <cstdio>
#include <cstdint>
namespace pg8 {
#define PG8_LAS __attribute__((address_space(3)))
typedef unsigned short bf16_t;
typedef short bf16x8 __attribute__((ext_vector_type(8)));
typedef float f32x4 __attribute__((ext_vector_type(4)));
typedef unsigned u32x4 __attribute__((ext_vector_type(4)));
constexpr int BM = 256, BK = 64, HALF = 128, HTB = HALF * BK * 2  , STAGE_BYTES = 8 * HTB, NXCD = 8, WGM = 8;

__host__ __device__ __forceinline__ int lds_byte(int r, int c) { const int st = (r >> 4) * 2 + (c >> 5), rr = r & 15, cc = c & 31, ob = rr * 64 + cc * 2; return st * 1024 + (ob ^ (((ob >> 9) & 1) << 5)); }
__host__ __device__ __forceinline__ void stage_rc(int b, int& R, int& C) { const int st = b / 1024, sb = b % 1024, swz = sb ^ (((sb >> 9) & 1) << 5); R = (st >> 1) * 16 + swz / 64; C = (st & 1) * 32 + (swz % 64) / 2; }
__host__ __device__ __forceinline__ int perm32(int rho) { const int n = rho >> 4, i = rho & 15; return 8 * (i >> 2) + 4 * n + (i & 3); }

struct Unit { int pm, pn; };
struct Gemm { const bf16_t* A; const bf16_t* Bt; int M, N, K; };

struct StaticOrder {
    int nM, nN, nwg, G, c;
    __host__ __device__ void init(int M, int N, int G_, int c_) { nM = M / BM; nN = N / BM; nwg = nM * nN; G = G_; c = c_; }
    __host__ __device__ bool next(int i, Unit& u) const {
        const long L = (long)i * G + c; if (L >= nwg) return false;
        int wgid = (int)L; { const int q = nwg / NXCD, r = nwg % NXCD, xcd = wgid % NXCD, off = wgid / NXCD; wgid = (xcd < r ? xcd * (q + 1) : r * (q + 1) + (xcd - r) * q) + off; }
        const int nig = WGM * nN, gid = wgid / nig, fm = gid * WGM, gsz = (nM - fm) < WGM ? (nM - fm) : WGM;
        u.pm = fm + ((wgid % nig) % gsz); u.pn = (wgid % nig) / gsz; return true;
    }
    __device__ __forceinline__ void a_ready(const Unit&) const {}
    __device__ __forceinline__ void done(const Unit&) const {}
};

__device__ __forceinline__ unsigned cvt_pk_bf16(float lo, float hi) { unsigned r; asm volatile("v_cvt_pk_bf16_f32 %0, %1, %2" : "=v"(r) : "v"(lo), "v"(hi)); return r; }
typedef float f32x2 __attribute__((ext_vector_type(2)));
struct NoHook { __device__ __forceinline__ void at_tile(int, const Unit&, f32x4 (&)[2][2][4][2], PG8_LAS unsigned char*, int, int) const {} };
template <class Epi, class Sched, bool ALIGN_EPI = false, bool SP2 = false, class Hook = NoHook>
__device__ __forceinline__ void gemm_phase(PG8_LAS unsigned char* lds, const Gemm g, const Sched& S, const Epi& E, const Hook& H = Hook()) {
    const int tid = threadIdx.x, wid = __builtin_amdgcn_readfirstlane(tid >> 6), lane = tid & 63, wr = wid >> 2, wc = wid & 3, fr = lane & 15, fq = lane >> 4;
    const int K = g.K, nt = K / BK;
    unsigned voffA[2], voffB[2];
#pragma unroll
    for (int i = 0; i < 2; ++i) { int R, C; stage_rc(tid * 16 + i * 8192, R, C); const int Rb = Epi::PERM ? ((R & ~31) + perm32(R & 31)) : R;
        voffA[i] = (unsigned)(R * K + C) * 2u; voffB[i] = (unsigned)(Rb * K + C) * 2u; }
    const size_t kstep = (size_t)(BK * 2);
    const size_t hstep = (size_t)HALF * K * 2;
    const size_t tstep = 2 * hstep;
    const unsigned ldsw = (unsigned)wid * 1024u;
    const int aoff = lds_byte(wr * 64 + fr, fq * 8), boff = lds_byte(wc * 32 + fr, fq * 8);
#define PG8_SA(b, h) (((b) * 2 + (h)) * HTB)
#define PG8_SB(b, h) ((4 + (b) * 2 + (h)) * HTB)
#define PG8_STAGE(bufoff, gbase, voff) do { _Pragma("unroll") for (int _i = 0; _i < 2; ++_i) \
        __builtin_amdgcn_global_load_lds((const unsigned*)((const char*)(gbase) + (voff)[_i]), (PG8_LAS unsigned*)(lds + (bufoff) + ldsw + _i * 8192), 16, 0, 0); } while (0)
#define PG8_LDA(dst, b, h) do { _Pragma("unroll") for (int m = 0; m < 4; ++m) _Pragma("unroll") for (int k = 0; k < 2; ++k) dst[m][k] = *(const PG8_LAS bf16x8*)(lds + PG8_SA(b, h) + aoff + m * 2048 + k * 1024); } while (0)
#define PG8_LDB(dst, b, h) do { _Pragma("unroll") for (int n = 0; n < 2; ++n) _Pragma("unroll") for (int k = 0; k < 2; ++k) dst[n][k] = *(const PG8_LAS bf16x8*)(lds + PG8_SB(b, h) + boff + n * 2048 + k * 1024); } while (0)
#define PG8_MMA(ai, bj, At, Bt) do { __builtin_amdgcn_s_setprio(1); _Pragma("unroll") for (int m = 0; m < 4; ++m) _Pragma("unroll") for (int n = 0; n < 2; ++n) _Pragma("unroll") for (int k = 0; k < 2; ++k) \
        acc[ai][bj][m][n] = __builtin_amdgcn_mfma_f32_16x16x32_bf16(Bt[n][k], At[m][k], acc[ai][bj][m][n], 0, 0, 0); __builtin_amdgcn_s_setprio(0); } while (0)
#define PG8_WAIT_V(n) asm volatile("s_waitcnt vmcnt(" #n ")" ::: "memory")
#define PG8_WAIT_L(n) asm volatile("s_waitcnt lgkmcnt(" #n ")" ::: "memory")
#define PG8_BAR __builtin_amdgcn_s_barrier()
#define PG8_SCHED __builtin_amdgcn_sched_barrier(0)
    Unit cur, nxt; int ui = 0;
    if (!S.next(0, cur)) return;
    f32x4 acc[2][2][4][2];
#pragma unroll
    for (int a = 0; a < 2; ++a)
#pragma unroll
        for (int b = 0; b < 2; ++b)
#pragma unroll
            for (int m = 0; m < 4; ++m)
#pragma unroll
                for (int n = 0; n < 2; ++n) acc[a][b][m][n] = (f32x4){0.f, 0.f, 0.f, 0.f};
    bf16x8 At[4][2], B0[2][2], B1[2][2];
    const char* cA = (const char*)g.A + (size_t)cur.pm * tstep; const char* cB = (const char*)g.Bt + (size_t)cur.pn * tstep;
    S.a_ready(cur);
    if constexpr (SP2) {
        PG8_STAGE(PG8_SB(0, 0), cB, voffB); PG8_STAGE(PG8_SB(0, 1), cB + hstep, voffB); PG8_STAGE(PG8_SA(0, 0), cA, voffA); PG8_STAGE(PG8_SA(0, 1), cA + hstep, voffA);
        if (wr == 1) PG8_BAR;
        PG8_WAIT_V(2); PG8_BAR;
        PG8_STAGE(PG8_SB(1, 0), cB + kstep, voffB); PG8_STAGE(PG8_SA(1, 0), cA + kstep, voffA); PG8_STAGE(PG8_SB(1, 1), cB + hstep + kstep, voffB);
        PG8_WAIT_V(6); PG8_BAR;
    } else {
        PG8_STAGE(PG8_SB(0, 0), cB, voffB); PG8_STAGE(PG8_SA(0, 0), cA, voffA); PG8_STAGE(PG8_SB(0, 1), cB + hstep, voffB); PG8_STAGE(PG8_SA(0, 1), cA + hstep, voffA);
        if (wr == 1) PG8_BAR;
        PG8_WAIT_V(4); PG8_BAR;
        PG8_STAGE(PG8_SB(1, 0), cB + kstep, voffB); PG8_STAGE(PG8_SA(1, 0), cA + kstep, voffA); PG8_STAGE(PG8_SB(1, 1), cB + hstep + kstep, voffB);
        PG8_WAIT_V(6); PG8_BAR;
    }
    for (;;) {
        const bool has_next = S.next(ui + 1, nxt);
        const char* nA = has_next ? (const char*)g.A + (size_t)nxt.pm * tstep : cA; const char* nB = has_next ? (const char*)g.Bt + (size_t)nxt.pn * tstep : cB;
        for (int t = 0; t < nt; t += 2) {
            const bool last = (t == nt - 2);
            H.at_tile(t, cur, acc, lds + STAGE_BYTES, wr, fr);
            const char* a1 = cA + (size_t)(t + 1) * kstep;
            const char* a2 = last ? nA : cA + (size_t)(t + 2) * kstep; const char* b2 = last ? nB : cB + (size_t)(t + 2) * kstep;
            const char* a3 = a2 + kstep; const char* b3 = b2 + kstep;
            if (last && has_next) S.a_ready(nxt);
            if constexpr (SP2) {
            PG8_LDB(B0, 0, 0); PG8_LDB(B1, 0, 1); PG8_SCHED; PG8_LDA(At, 0, 0); PG8_STAGE(PG8_SA(1, 1), a1 + hstep, voffA);
            PG8_WAIT_V(8); PG8_WAIT_L(0); PG8_BAR; PG8_MMA(0, 0, At, B0); PG8_MMA(0, 1, At, B1); PG8_BAR; PG8_SCHED;
            PG8_LDA(At, 0, 1); PG8_STAGE(PG8_SB(0, 0), b2, voffB); PG8_STAGE(PG8_SB(0, 1), b2 + hstep, voffB); PG8_STAGE(PG8_SA(0, 0), a2, voffA);
            PG8_WAIT_V(8); PG8_WAIT_L(0); PG8_BAR; PG8_MMA(1, 0, At, B0); PG8_MMA(1, 1, At, B1); PG8_BAR; PG8_SCHED;
            PG8_LDB(B0, 1, 0); PG8_LDB(B1, 1, 1); PG8_SCHED; PG8_LDA(At, 1, 0); PG8_STAGE(PG8_SA(0, 1), a2 + hstep, voffA);
            PG8_WAIT_V(8); PG8_WAIT_L(0); PG8_BAR; PG8_MMA(0, 0, At, B0); PG8_MMA(0, 1, At, B1); PG8_BAR; PG8_SCHED;
            PG8_LDA(At, 1, 1); PG8_STAGE(PG8_SB(1, 0), b3, voffB); PG8_STAGE(PG8_SB(1, 1), b3 + hstep, voffB); PG8_STAGE(PG8_SA(1, 0), a3, voffA);
            PG8_WAIT_V(8); PG8_WAIT_L(0); PG8_BAR; PG8_MMA(1, 0, At, B0); PG8_MMA(1, 1, At, B1); PG8_BAR; PG8_SCHED;
            } else {
            PG8_LDB(B0, 0, 0); PG8_SCHED; PG8_LDA(At, 0, 0); PG8_STAGE(PG8_SA(1, 1), a1 + hstep, voffA);
            PG8_WAIT_L(8); PG8_BAR; PG8_WAIT_L(0); PG8_MMA(0, 0, At, B0); PG8_BAR; PG8_SCHED;
            PG8_LDB(B1, 0, 1); PG8_STAGE(PG8_SB(0, 0), b2, voffB);
            PG8_BAR; PG8_WAIT_L(0); PG8_MMA(0, 1, At, B1); PG8_BAR;
            PG8_LDA(At, 0, 1); PG8_STAGE(PG8_SA(0, 0), a2, voffA);
            PG8_BAR; PG8_WAIT_L(0); PG8_MMA(1, 0, At, B0); PG8_BAR; PG8_SCHED;
            PG8_STAGE(PG8_SB(0, 1), b2 + hstep, voffB);
            PG8_WAIT_V(6); PG8_BAR; PG8_MMA(1, 1, At, B1); PG8_BAR;
            PG8_LDB(B0, 1, 0); PG8_SCHED; PG8_LDA(At, 1, 0); PG8_STAGE(PG8_SA(0, 1), a2 + hstep, voffA);
            PG8_WAIT_L(8); PG8_BAR; PG8_WAIT_L(0); PG8_MMA(0, 0, At, B0); PG8_BAR; PG8_SCHED;
            PG8_LDB(B1, 1, 1); PG8_STAGE(PG8_SB(1, 0), b3, voffB);
            PG8_BAR; PG8_WAIT_L(0); PG8_MMA(0, 1, At, B1); PG8_BAR;
            PG8_LDA(At, 1, 1); PG8_STAGE(PG8_SA(1, 0), a3, voffA);
            PG8_BAR; PG8_WAIT_L(0); PG8_MMA(1, 0, At, B0); PG8_BAR; PG8_SCHED;
            PG8_STAGE(PG8_SB(1, 1), b3 + hstep, voffB);
            PG8_WAIT_V(6); PG8_BAR; PG8_MMA(1, 1, At, B1); PG8_BAR;
            }
        }
        if constexpr (ALIGN_EPI) { if (wr == 0) PG8_BAR; }
        if constexpr (!Epi::AFTER_DRAIN) { E(acc, cur, wr, wc, fr, fq);
#ifdef PROBE_EPI2
            if constexpr (Epi::PROBE_TWICE) { asm volatile("" ::: "memory"); E(acc, cur, wr, wc, fr, fq); }
#endif
            S.done(cur); }
        if (!has_next) break;
#pragma unroll
        for (int a = 0; a < 2; ++a)
#pragma unroll
            for (int b = 0; b < 2; ++b)
#pragma unroll
                for (int m = 0; m < 4; ++m)
#pragma unroll
                    for (int n = 0; n < 2; ++n) acc[a][b][m][n] = (f32x4){0.f, 0.f, 0.f, 0.f};
        cur = nxt; cA = nA; cB = nB; ++ui;
        if constexpr (ALIGN_EPI) { if (wr == 1) PG8_BAR; }
    }
    PG8_WAIT_V(0);
    if constexpr (!ALIGN_EPI) { if (wr == 0) PG8_BAR; }
    PG8_BAR;
    if constexpr (Epi::AFTER_DRAIN) { E.fused(acc, cur, wr, wc, fr, fq, lds, wid, lane); S.done(cur); }
#undef PG8_SA
#undef PG8_SB
#undef PG8_STAGE
#undef PG8_LDA
#undef PG8_LDB
#undef PG8_MMA
#undef PG8_WAIT_V
#undef PG8_WAIT_L
#undef PG8_BAR
#undef PG8_SCHED
}
}
namespace pg8 {
struct EpiProj {
    static constexpr bool PERM = true, AFTER_DRAIN = false, PROBE_TWICE = true;
    bf16_t* O; int ldc;
    __device__ __forceinline__ void operator()(const f32x4 (&acc)[2][2][4][2], const Unit& u, int wr, int wc, int fr, int fq) const {
        const int row0 = u.pm * BM + wr * 64 + fr; const int col0 = u.pn * BM + wc * 32 + 8 * fq;
#pragma unroll
        for (int ai = 0; ai < 2; ++ai)
#pragma unroll
            for (int m = 0; m < 4; ++m) { bf16_t* rowp = O + (size_t)(row0 + ai * HALF + m * 16) * ldc + col0;
#pragma unroll
                for (int bj = 0; bj < 2; ++bj) { const f32x4 v0 = acc[ai][bj][m][0], v1 = acc[ai][bj][m][1];
                    u32x4 w; w.x = cvt_pk_bf16(v0[0], v0[1]); w.y = cvt_pk_bf16(v0[2], v0[3]); w.z = cvt_pk_bf16(v1[0], v1[1]); w.w = cvt_pk_bf16(v1[2], v1[3]);
                    __builtin_nontemporal_store(w, (u32x4*)(rowp + bj * HALF)); } }
    }
};
struct EpiX1 {
    static constexpr bool PERM = true, AFTER_DRAIN = false, PROBE_TWICE = false;
    const float* x; float* x1; bf16_t* x1s; const float* mod; const float* norm2_g; float* rowstat; PG8_LAS float* tab;
    __device__ __forceinline__ void operator()(const f32x4 (&acc)[2][2][4][2], const Unit& u, int wr, int wc, int fr, int fq) const {
        const int row0 = u.pm * BM + wr * 64 + fr; const int col0 = u.pn * BM + wc * 32 + 8 * fq; const int b = (u.pm * BM) >> 11;
        const float* mb = mod + (size_t)b * 6144;
        f32x4 g1[2][2], g2[2][2];
#pragma unroll
        for (int bj = 0; bj < 2; ++bj)
#pragma unroll
            for (int n = 0; n < 2; ++n) { const int c = col0 + bj * HALF + 4 * n; g1[bj][n] = *(const f32x4*)(mb + 2048 + c);
                const f32x4 sc = *(const f32x4*)(mb + 4096 + c), ng = *(const f32x4*)(norm2_g + c); g2[bj][n] = ng * (sc + 1.0f); }
#pragma unroll
        for (int ai = 0; ai < 2; ++ai)
#pragma unroll
            for (int m = 0; m < 4; ++m) { const size_t row = (size_t)(row0 + ai * HALF + m * 16); const size_t off = row * 1024 + col0; float ss = 0.f;
                const float rfin = tab[((u.pm >> 3) & 1) * 1280 + 1024 + ai * HALF + wr * 64 + m * 16 + fr];
#pragma unroll
                for (int bj = 0; bj < 2; ++bj) {
                    const f32x4 xa = *(const f32x4*)(x + off + bj * HALF), xb = *(const f32x4*)(x + off + bj * HALF + 4);
                    const f32x4 v0 = xa + g1[bj][0] * (acc[ai][bj][m][0] * rfin), v1 = xb + g1[bj][1] * (acc[ai][bj][m][1] * rfin);
#ifdef X1B
                    { u32x4 wx; wx.x = cvt_pk_bf16(v0[0], v0[1]); wx.y = cvt_pk_bf16(v0[2], v0[3]); wx.z = cvt_pk_bf16(v1[0], v1[1]); wx.w = cvt_pk_bf16(v1[2], v1[3]); *(u32x4*)((bf16_t*)x1 + off + bj * HALF) = wx; }
#else
                    *(f32x4*)(x1 + off + bj * HALF) = v0; *(f32x4*)(x1 + off + bj * HALF + 4) = v1;
#endif
                    ss += (v0[0] * v0[0] + v0[1] * v0[1]) + (v0[2] * v0[2] + v0[3] * v0[3]) + (v1[0] * v1[0] + v1[1] * v1[1]) + (v1[2] * v1[2] + v1[3] * v1[3]);
                    const f32x4 s0 = v0 * g2[bj][0], s1 = v1 * g2[bj][1];
                    u32x4 w; w.x = cvt_pk_bf16(s0[0], s0[1]); w.y = cvt_pk_bf16(s0[2], s0[3]); w.z = cvt_pk_bf16(s1[0], s1[1]); w.w = cvt_pk_bf16(s1[2], s1[3]);
                    *(u32x4*)(x1s + off + bj * HALF) = w; }
                ss += __shfl_xor(ss, 16); ss += __shfl_xor(ss, 32);
                if (fq == 0) atomicAdd(rowstat + row, ss); }
    }
};
typedef _Float16 f16x8 __attribute__((ext_vector_type(8)));
struct EpiScores {
    static constexpr bool PERM = true, AFTER_DRAIN = false, PROBE_TWICE = false;
    _Float16* S; const float* sb; const float* rowstat;
    __device__ __forceinline__ void operator()(const f32x4 (&acc)[2][2][4][2], const Unit& u, int wr, int wc, int fr, int fq) const {
        const int row0 = u.pm * BM + wr * 64 + fr; const int col0 = u.pn * BM + wc * 32 + 8 * fq; const int b = (u.pm * BM) >> 11;
        f32x4 bv[2][2];
#pragma unroll
        for (int bj = 0; bj < 2; ++bj)
#pragma unroll
            for (int n = 0; n < 2; ++n) bv[bj][n] = *(const f32x4*)(sb + (size_t)b * 2048 + col0 + bj * HALF + 4 * n);
#pragma unroll
        for (int ai = 0; ai < 2; ++ai)
#pragma unroll
            for (int m = 0; m < 4; ++m) { const size_t row = (size_t)(row0 + ai * HALF + m * 16); const float rs = __builtin_amdgcn_rsqf(rowstat[row] * (1.0f / 1024.0f) + 1e-6f);
                _Float16* rowp = S + row * 2048 + col0;
#pragma unroll
                for (int bj = 0; bj < 2; ++bj) { const f32x4 v0 = acc[ai][bj][m][0] * rs + bv[bj][0], v1 = acc[ai][bj][m][1] * rs + bv[bj][1];
                    f16x8 h; h[0] = (_Float16)v0[0]; h[1] = (_Float16)v0[1]; h[2] = (_Float16)v0[2]; h[3] = (_Float16)v0[3]; h[4] = (_Float16)v1[0]; h[5] = (_Float16)v1[1]; h[6] = (_Float16)v1[2]; h[7] = (_Float16)v1[3];
                    *(f16x8*)(rowp + bj * HALF) = h; } }
    }
};
struct SegScaleHook {
    __device__ __forceinline__ static void build(PG8_LAS unsigned char* ldsx, const Unit& u, const float* st_ssd, const float* st_s5, int tid) {
        PG8_LAS float* tab = (PG8_LAS float*)ldsx + ((u.pm >> 3) & 1) * 1280;
        if (tid < 256) { const size_t row = (size_t)u.pm * BM + tid; const f32x4* sg = (const f32x4*)(st_ssd + row * 16); const f32x4* s5 = (const f32x4*)(st_s5 + row * 64);
            float r[5];
#pragma unroll
            for (int gI = 0; gI < 4; ++gI) { const f32x4 v = sg[gI]; r[gI] = __builtin_amdgcn_rsqf(((v[0] + v[1]) + (v[2] + v[3])) * (1.0f / 256.0f) + 1e-6f); }
            float a5 = 0.f;
#pragma unroll
            for (int q = 0; q < 16; ++q) { const f32x4 v = s5[q]; a5 += (v[0] + v[1]) + (v[2] + v[3]); }
            r[4] = __builtin_amdgcn_rsqf(a5 * (1.0f / 1024.0f) + 1e-6f);
#pragma unroll
            for (int k = 0; k < 4; ++k) tab[k * 256 + tid] = r[k] * __builtin_amdgcn_rcpf(r[k + 1]);
            tab[1024 + tid] = r[4]; }
    }
    __device__ __forceinline__ void at_tile(int t, const Unit& u, f32x4 (&acc)[2][2][4][2], PG8_LAS unsigned char* ldsx, int wr, int fr) const {
        if (t == 4 || t == 8 || t == 12 || t == 16) { const PG8_LAS float* rt = (const PG8_LAS float*)ldsx + ((u.pm >> 3) & 1) * 1280 + ((t >> 2) - 1) * 256 + wr * 64 + fr;
#pragma unroll
            for (int ai = 0; ai < 2; ++ai)
#pragma unroll
                for (int m = 0; m < 4; ++m) { const float r = rt[ai * HALF + m * 16];
#pragma unroll
                    for (int bj = 0; bj < 2; ++bj) { acc[ai][bj][m][0] = acc[ai][bj][m][0] * r; acc[ai][bj][m][1] = acc[ai][bj][m][1] * r; } } }
    }
};
}
constexpr int NWAVES = 8, NTHR = 512;
constexpr int DM = 1024, NB = 16, SEQ = 2048, MTOK = NB * SEQ;
constexpr int NPROJ = 4096;
constexpr int INW = 4112;
constexpr int NHEADS = 16, HDIM = 64, NGRP = 4, NST = 128, CHUNK = 128;
constexpr int S5G = 64, S5CH = 16, S5P = 64;
constexpr int PH = 8, PK = 16, PNK = 128;
constexpr float EPSF = 1e-6f;
constexpr int NS5PART = 64;

constexpr size_t MiB = 1u << 20;
constexpr size_t WS_CTL = 0, CTL_ZERO_BYTES = 64 * 1024;
constexpr size_t WS_MOD = 1 * MiB;
constexpr size_t WS_WDT = WS_MOD + 0x60000;
constexpr size_t WS_SB = WS_MOD + 0x70000;
constexpr size_t WS_ROWSTAT = WS_MOD + 0x90000;
constexpr size_t WS_S5LB = WS_MOD + 0xB0000;
constexpr size_t WS_S5BB = WS_MOD + 0xC0000;
constexpr size_t WS_DTRAW = 3 * MiB;
constexpr size_t WS_STSSD = 5 * MiB;
constexpr size_t WS_STS5 = 7 * MiB;
constexpr size_t WS_WINT = 15 * MiB;
constexpr size_t WS_WOUTT = 23 * MiB;
constexpr size_t WS_WQKT = 27 * MiB;
constexpr size_t WS_EU = 31 * MiB, WS_EV = 47 * MiB;
constexpr size_t WS_EUS = 63 * MiB, WS_EVS = 63 * MiB + 65536;
constexpr size_t WS_START = 64 * MiB;
constexpr size_t WS_A = 95 * MiB;
constexpr size_t WS_B = 223 * MiB;
constexpr size_t WS_H1 = WS_A, WS_Y = WS_A, WS_PROJ = WS_B, WS_SCORES = WS_A;
constexpr size_t WS_X1S = WS_B + 192 * MiB;
constexpr size_t WS_EID = 479 * MiB, WS_GATE = 495 * MiB;
constexpr size_t WS_H2Q = WS_B, WS_HINV = WS_B + 32 * MiB;
constexpr size_t WS_X1B = WS_B + 64 * MiB;
constexpr size_t WS_END = 511 * MiB;
static_assert(WS_SCORES + (size_t)MTOK * 2048 * 4 <= WS_X1S && WS_X1S + (size_t)MTOK * 1024 * 2 <= WS_EID && WS_GATE + (size_t)MTOK * 128 * 4 <= WS_END, "ws map");

constexpr int LDS_MAIN = 159744;
constexpr int MISC_OFF = LDS_MAIN;
constexpr int LDS_BYTES = LDS_MAIN + 128;

#define GAS __attribute__((address_space(1)))
#define LAS __attribute__((address_space(3)))
typedef unsigned short bf16;
typedef unsigned v4u __attribute__((ext_vector_type(4)));
typedef unsigned v2u __attribute__((ext_vector_type(2)));
typedef float f32x4 __attribute__((ext_vector_type(4)));
typedef float f32x2 __attribute__((ext_vector_type(2)));
typedef short bf16x8 __attribute__((ext_vector_type(8)));
#define LDS_WAIT() asm volatile("s_waitcnt lgkmcnt(0)" ::: "memory")
#define VM_WAIT() asm volatile("s_waitcnt vmcnt(0)" ::: "memory")
typedef __bf16 hwbf16x2 __attribute__((ext_vector_type(2)));
__device__ __forceinline__ unsigned pk2(float lo, float hi) { const f32x2 v = {lo, hi}; const hwbf16x2 b = __builtin_convertvector(v, hwbf16x2); return __builtin_bit_cast(unsigned, b); }
__device__ __forceinline__ unsigned f2bf(float f) { return pk2(f, 0.f) & 0xffffu; }
__device__ __forceinline__ float bflo(unsigned w) { return __builtin_bit_cast(float, w << 16); }
__device__ __forceinline__ float bfhi(unsigned w) { return __builtin_bit_cast(float, w & 0xffff0000u); }
__device__ __forceinline__ float bf2f(bf16 v) { return __builtin_bit_cast(float, (unsigned)v << 16); }
__device__ __forceinline__ float wave_sum(float v) {
#pragma unroll
    for (int o = 1; o < 64; o <<= 1) v += __shfl_xor(v, o);
    return v;
}
__device__ __forceinline__ float sigmoid_f(float v) { return __builtin_amdgcn_rcpf(1.0f + __builtin_amdgcn_exp2f(-1.4426950408889634f * v)); }
__device__ __forceinline__ float silu_f(float v) { return v * sigmoid_f(v); }
__device__ __forceinline__ float rsqrt_f(float v) { return __builtin_amdgcn_rsqf(v); }
__device__ __forceinline__ float gelu_erf(float v) {
    const float av = fabsf(v), t = __builtin_amdgcn_rcpf(av * 0.2316418882f + 1.0f);
    float q = t * 0.5307027145f + (-0.7265760135f); q = q * t + 0.7107068705f; q = q * t + (-0.142248368f); q = q * t + 0.127414796f; q = q * t;
    const float e = __builtin_amdgcn_exp2f((v * v) * (-0.72134752044f));
    const float m = v * (q * e);
    return v < 0.f ? m : v - m;
}
__device__ __forceinline__ float softplus_f(float v) { const float e = __builtin_amdgcn_exp2f(-1.4426950408889634f * fabsf(v));
    const float l = e < 1e-6f ? e : 0.6931471805599453f * __builtin_amdgcn_logf(1.0f + e); return fmaxf(v, 0.f) + l; }
__device__ __forceinline__ void unpack8(const v4u w, float* f) { f[0] = bflo(w.x); f[1] = bfhi(w.x); f[2] = bflo(w.y); f[3] = bfhi(w.y); f[4] = bflo(w.z); f[5] = bfhi(w.z); f[6] = bflo(w.w); f[7] = bfhi(w.w); }
#define LDS_BARRIER() do { asm volatile("s_waitcnt lgkmcnt(0)" ::: "memory"); __builtin_amdgcn_s_barrier(); asm volatile("" ::: "memory"); } while (0)
__device__ __forceinline__ float row16_sum_to15(float v) {
    v += __builtin_bit_cast(float, __builtin_amdgcn_update_dpp(0, __builtin_bit_cast(int, v), 0x118, 0xf, 0xf, true));
    v += __builtin_bit_cast(float, __builtin_amdgcn_update_dpp(0, __builtin_bit_cast(int, v), 0x114, 0xf, 0xf, true));
    v += __builtin_bit_cast(float, __builtin_amdgcn_update_dpp(0, __builtin_bit_cast(int, v), 0x112, 0xf, 0xf, true));
    v += __builtin_bit_cast(float, __builtin_amdgcn_update_dpp(0, __builtin_bit_cast(int, v), 0x111, 0xf, 0xf, true));
    return v;
}
__device__ __forceinline__ float wave_sum_to63(float v) {
    v = row16_sum_to15(v);
    v += __builtin_bit_cast(float, __builtin_amdgcn_update_dpp(0, __builtin_bit_cast(int, v), 0x142, 0xa, 0xf, false));
    v += __builtin_bit_cast(float, __builtin_amdgcn_update_dpp(0, __builtin_bit_cast(int, v), 0x143, 0xc, 0xf, false));
    return v;
}
__device__ __forceinline__ f32x2 gelu_pk2(f32x2 v) {
    const f32x2 av = __builtin_elementwise_abs(v), d = av * 0.2316418882f + 1.0f;
    f32x2 t; t[0] = __builtin_amdgcn_rcpf(d[0]); t[1] = __builtin_amdgcn_rcpf(d[1]);
    f32x2 q = t * 0.5307027145f + (-0.7265760135f); q = q * t + 0.7107068705f; q = q * t + (-0.142248368f); q = q * t + 0.127414796f; q = q * t;
    const f32x2 s = (v * v) * (-0.72134752044f);
    f32x2 e; e[0] = __builtin_amdgcn_exp2f(s[0]); e[1] = __builtin_amdgcn_exp2f(s[1]);
    const f32x2 m = v * (q * e), r = v - m;
    f32x2 o; o[0] = v[0] < 0.f ? m[0] : r[0]; o[1] = v[1] < 0.f ? m[1] : r[1]; return o;
}
#define XB_TMO      128
#define XB_XCNT(j)  (256  + 64 * (j))
#define XB_XSUB(j)  (1280 + 64 * (j))
#define XB_XGEN(j)  (2304 + 64 * (j))
#define XB_TOP      3328
#define XB_TOPGEN   3392
#define XCD_BAR_WORDS 3456
#define XB_SPIN_CAP (1u << 18)

__device__ __forceinline__ unsigned xb_ld(unsigned* p)              { return __hip_atomic_load(p, __ATOMIC_RELAXED, __HIP_MEMORY_SCOPE_AGENT); }
__device__ __forceinline__ unsigned xb_add(unsigned* p, unsigned v) { return __hip_atomic_fetch_add(p, v, __ATOMIC_RELAXED, __HIP_MEMORY_SCOPE_AGENT); }
__device__ __forceinline__ unsigned xb_xcc_id() { return (unsigned)__builtin_amdgcn_s_getreg((3 << 11) | 20) & 0xFu; }
#define XB_SPIN(cond, bar) do { unsigned _sp = 0; while (cond) { __builtin_amdgcn_s_sleep(1); \
    if ((++_sp & 255u) == 0u) { if (xb_ld(&(bar)[XB_TMO])) break; if (_sp > XB_SPIN_CAP) { atomicAdd(&(bar)[XB_TMO], 1u); break; } } } } while (0)

struct XcdBarrier {
    unsigned* bar; unsigned x;
    volatile LAS unsigned* st;
};

__device__ __forceinline__ XcdBarrier xcd_barrier_post(unsigned* bar, volatile LAS unsigned* st) {
    XcdBarrier b; b.bar = bar; b.x = xb_xcc_id(); b.st = st;
    if (threadIdx.x == 0) (void)xb_add(&bar[XB_XCNT(b.x)], 1u);
    return b;
}
__device__ __forceinline__ void xcd_barrier_complete(unsigned* bar, unsigned x, unsigned& nloc, unsigned& nx) {
    const unsigned G = gridDim.x * gridDim.y * gridDim.z;
    unsigned sum, cnt, mine, sp = 0u;
    for (;;) {
        sum = 0u; cnt = 0u; mine = 0u;
#pragma unroll
        for (unsigned j = 0; j < 16; ++j) { const unsigned c = xb_ld(&bar[XB_XCNT(j)]); sum += c; cnt += (c > 0u) ? 1u : 0u; mine = (j == x) ? c : mine; }
        if (sum == G) break;
        __builtin_amdgcn_s_sleep(1);
        if ((++sp & 255u) == 0u) { if (xb_ld(&bar[XB_TMO])) break; if (sp > XB_SPIN_CAP) { atomicAdd(&bar[XB_TMO], 1u); break; } }
    }
    nloc = mine > 0u ? mine : 1u; nx = cnt > 0u ? cnt : 1u;
}

__device__ __forceinline__ void xcd_barrier(const XcdBarrier& b) {
    asm volatile("s_waitcnt vmcnt(0)" ::: "memory");
    __syncthreads();
    if (threadIdx.x == 0) {
        unsigned* bar = b.bar;
        __builtin_amdgcn_s_waitcnt(0);
        unsigned nloc = b.st[0], nx = b.st[1];
        if (nloc == 0u) { xcd_barrier_complete(bar, b.x, nloc, nx); b.st[0] = nloc; b.st[1] = nx; }
        const unsigned old = xb_add(&bar[XB_XSUB(b.x)], 1u);
        const unsigned gen = old / nloc;
        if (old + 1u == (gen + 1u) * nloc) {
            __builtin_amdgcn_fence(__ATOMIC_RELEASE, "agent");
            asm volatile("s_waitcnt vmcnt(0)" ::: "memory");
            const unsigned og = xb_add(&bar[XB_TOP], 1u);
            const unsigned tg = og / nx;
            if (og + 1u == (tg + 1u) * nx) xb_add(&bar[XB_TOPGEN], 1u);
            else XB_SPIN(xb_ld(&bar[XB_TOPGEN]) == tg, bar);
            __builtin_amdgcn_fence(__ATOMIC_ACQUIRE, "agent");
            xb_add(&bar[XB_XGEN(b.x)], 1u);
            asm volatile("s_waitcnt vmcnt(0)" ::: "memory");
        } else {
            XB_SPIN(xb_ld(&bar[XB_XGEN(b.x)]) == gen, bar);
            __builtin_amdgcn_fence(__ATOMIC_ACQUIRE, "agent");
            asm volatile("s_waitcnt vmcnt(0)" ::: "memory");
        }
    }
    __syncthreads();
}
struct Args { const float* in[30]; float* out; unsigned char* ws; int ph_lo, ph_hi; };
struct Frame {
    LAS unsigned char* lds;
    volatile LAS unsigned* MISC;
    int vcu, G;
    unsigned char* ws;
    const Args* a;
    float* out;
};
#define WSP(T, off) ((T*)(F.ws + (off)))

__device__ __forceinline__ void transpose_tile(const float* W, int ldw, int k0, int src_n0, bf16* WT, int K, int dst_n0, LAS float* scr, int lane, const float* kscale) {
#pragma unroll 8
    for (int i = 0; i < 32; ++i) { const int kk = 2 * i + (lane >> 5); float v = W[(size_t)(k0 + kk) * ldw + src_n0 + (lane & 31)]; if (kscale) v *= kscale[k0 + kk]; scr[kk * 33 + (lane & 31)] = v; }
    LDS_WAIT(); asm volatile("" ::: "memory");
    const int c = lane & 7;
#pragma unroll
    for (int j = 0; j < 4; ++j) { const int n = (lane >> 3) + 8 * j; const LAS float* s = scr + (8 * c) * 33 + n;
        v4u o; o.x = pk2(s[0 * 33], s[1 * 33]); o.y = pk2(s[2 * 33], s[3 * 33]); o.z = pk2(s[4 * 33], s[5 * 33]); o.w = pk2(s[6 * 33], s[7 * 33]);
        *(v4u*)(WT + (size_t)(dst_n0 + n) * K + k0 + 8 * c) = o; }
    LDS_WAIT(); asm volatile("" ::: "memory");
}
__device__ __forceinline__ void p0_phase(Frame& F) {
    const int f_tid = threadIdx.x, f_lane = f_tid & 63, f_wave = __builtin_amdgcn_readfirstlane(f_tid >> 6);
    const int gw = F.vcu * NWAVES + f_wave, NGW = F.G * NWAVES, gt = F.vcu * NTHR + f_tid, NGT = F.G * NTHR;
    {
        LAS float* sc = (LAS float*)F.lds;
        LAS float* red = (LAS float*)(F.lds + 65536);
        for (int i = f_tid; i < 16 * 1024; i += NTHR) { const int b = i >> 10, k = i & 1023; sc[k * 16 + b] = silu_f((F.a->in[1])[i]); }
        __syncthreads();
        const int ks = f_tid / 24, col = f_tid - ks * 24, j = F.vcu * 24 + col;
        if (ks < 21) {
            float acc[16];
#pragma unroll
            for (int b = 0; b < 16; ++b) acc[b] = 0.f;
            const int k0 = ks * 49, kn = (k0 + 49 <= 1024) ? 49 : (1024 - k0);
            const float* wp = (F.a->in[2]) + (size_t)k0 * 6144 + j;
#pragma unroll 1
            for (int kb = 0; kb < 49; kb += 7) {
                asm volatile("" ::: "memory");
                float wv[7];
#pragma unroll
                for (int u = 0; u < 7; ++u) wv[u] = (kb + u < kn) ? wp[(size_t)(kb + u) * 6144] : 0.f;
#pragma unroll
                for (int u = 0; u < 7; ++u) { const int kk = (kb + u < kn) ? (k0 + kb + u) : k0; const LAS f32x4* s4 = (const LAS f32x4*)(sc + kk * 16);
#pragma unroll
                    for (int q = 0; q < 4; ++q) { const f32x4 sv = s4[q]; acc[4 * q] += sv[0] * wv[u]; acc[4 * q + 1] += sv[1] * wv[u]; acc[4 * q + 2] += sv[2] * wv[u]; acc[4 * q + 3] += sv[3] * wv[u]; } }
            }
#pragma unroll
            for (int b = 0; b < 16; ++b) red[(ks * 16 + b) * 24 + col] = acc[b];
        }
        __syncthreads();
        for (int i = f_tid; i < 16 * 24; i += NTHR) { const int b = i / 24, cc = i - b * 24; float sacc = 0.f;
            for (int q = 0; q < 21; ++q) sacc += red[(q * 16 + b) * 24 + cc];
            WSP(float, WS_MOD)[b * 6144 + F.vcu * 24 + cc] = sacc + (F.a->in[3])[F.vcu * 24 + cc]; }
        __syncthreads();
    }
    {
        LAS float* scr = (LAS float*)(F.lds + f_wave * 16384);
        constexpr int I_IN = (1024 / 64) * (NPROJ / 32), I_OUT = (2048 / 64) * (1024 / 32);
        for (int it = gw; it < I_IN + I_OUT; it += NGW) {
            if (it < I_IN) { const int kb = it / (NPROJ / 32), nb = it % (NPROJ / 32); const int dn = 32 * nb, sn = dn < 3072 ? dn : dn + 16;
                transpose_tile((F.a->in[5]), INW, 64 * kb, sn, WSP(bf16, WS_WINT), 1024, dn, scr, f_lane, nullptr); }
            else { const int r = it - I_IN, kb = r / 32, nb = r % 32; const int k0 = 64 * kb;
                transpose_tile((F.a->in[23]), 1024, k0, 32 * nb, WSP(bf16, WS_WOUTT), 2048, 32 * nb, scr, f_lane, k0 < 1024 ? (F.a->in[11]) : (F.a->in[22]) - 1024); }
        }
    }
    for (int i = gt; i < 16 * 1024; i += NGT) { const int h = i >> 10, k = i & 1023; WSP(float, WS_WDT)[i] = (F.a->in[5])[(size_t)k * INW + 3072 + h]; }
    for (int task = gw; task < 2048; task += NGW) {
        const int nt = task >> 4, ks = task & 15, n0 = 16 * nt, hc = n0 >> 7, k0 = 64 * ks;
        const int li = f_lane & 15, lq = f_lane >> 4;
        f32x4 acc[4];
#pragma unroll
        for (int s = 0; s < 4; ++s) acc[s] = (f32x4){0.f, 0.f, 0.f, 0.f};
        const float* ap = (F.a->in[26]) + (size_t)(n0 + li) * 128 + 4 * lq;
        const float* bp = (F.a->in[25]) + (size_t)(k0 + li) * 2048 + hc * 128 + 4 * lq;
#pragma unroll
        for (int q = 0; q < 8; ++q) { const f32x4 a = *(const f32x4*)(ap + 16 * q);
#pragma unroll
            for (int s = 0; s < 4; ++s) { const f32x4 b = *(const f32x4*)(bp + (size_t)(16 * s) * 2048 + 16 * q);
#pragma unroll
                for (int jj = 0; jj < 4; ++jj) acc[s] = __builtin_amdgcn_mfma_f32_16x16x4f32(a[jj], b[jj], acc[s], 0, 0, 0); } }
        bf16* o = WSP(bf16, WS_WQKT);
#pragma unroll
        for (int s = 0; s < 4; ++s)
#pragma unroll
            for (int r = 0; r < 4; ++r) o[(size_t)(n0 + 4 * lq + r) * 1024 + k0 + 16 * s + li] = (bf16)f2bf(acc[s][r]);
    }
    for (int i = gt; i < S5G * S5P; i += NGT) {
        const float lr = (F.a->in[12])[i], li = (F.a->in[13])[i], dt = expf((F.a->in[14])[i >> 6]);
        const float mag = expf(lr * dt); float sn, cs; sincosf(li * dt, &sn, &cs);
        const float lbr = mag * cs, lbi = mag * sn, den = lr * lr + li * li;
        const float cfr = ((lbr - 1.0f) * lr + lbi * li) / den, cfi = (lbi * lr - (lbr - 1.0f) * li) / den;
        WSP(float, WS_S5LB)[2 * i] = lbr; WSP(float, WS_S5LB)[2 * i + 1] = lbi;
        for (int hh = 0; hh < 16; ++hh) { const float br = (F.a->in[15])[i * 16 + hh], bi = (F.a->in[16])[i * 16 + hh];
            WSP(float, WS_S5BB)[i * 32 + hh] = cfr * br - cfi * bi; WSP(float, WS_S5BB)[i * 32 + 16 + hh] = cfr * bi + cfi * br; }
    }
    for (int i = gt; i < MTOK; i += NGT) WSP(float, WS_ROWSTAT)[i] = 0.f;
}

__device__ __forceinline__ void p1_phase(Frame& F) {
    const int f_tid = threadIdx.x, f_lane = f_tid & 63, f_wave = __builtin_amdgcn_readfirstlane(f_tid >> 6);
    const int gw = F.vcu * NWAVES + f_wave;
    LAS float* wdt = (LAS float*)F.lds;
    for (int i = f_tid; i < 16 * 1024 / 4; i += NTHR) ((LAS f32x4*)wdt)[i] = ((const f32x4*)WSP(float, WS_WDT))[i];
    __syncthreads();
    const int lane = f_lane;
    for (int wq = gw; wq < MTOK / 16; wq += F.G * NWAVES) {
        const int b = wq >> 7; const float* mb = WSP(float, WS_MOD) + (size_t)b * 6144;
        f32x4 Gv[4], Sv[4];
#pragma unroll
        for (int j = 0; j < 4; ++j) { const int k = 4 * lane + 256 * j; const f32x4 g = *(const f32x4*)((F.a->in[4]) + k), sc = *(const f32x4*)(mb + 1024 + k); Gv[j] = g * (sc + 1.0f); Sv[j] = *(const f32x4*)(mb + k); }
        f32x4 nx[4];
#pragma unroll
        for (int j = 0; j < 4; ++j) nx[j] = *(const f32x4*)((F.a->in[0]) + (size_t)wq * 16 * 1024 + 4 * lane + 256 * j);
        for (int tt = 0; tt < 16; ++tt) {
            asm volatile("" ::: "memory");
            const size_t t = (size_t)wq * 16 + tt; const float* xr = (F.a->in[0]) + t * 1024;
            f32x4 v[4]; float ss = 0.f;
#pragma unroll
            for (int j = 0; j < 4; ++j) { v[j] = nx[j]; ss += (v[j][0] * v[j][0] + v[j][1] * v[j][1]) + (v[j][2] * v[j][2] + v[j][3] * v[j][3]); }
            if (tt < 15) {
#pragma unroll
                for (int j = 0; j < 4; ++j) nx[j] = *(const f32x4*)(xr + 1024 + 4 * lane + 256 * j); }
            const float rstd = rsqrt_f(wave_sum(ss) * (1.0f / 1024.0f) + EPSF);
            bf16* hr = WSP(bf16, WS_H1) + t * 1024;
#pragma unroll
            for (int j = 0; j < 4; ++j) { v[j] = v[j] * rstd * Gv[j] + Sv[j]; v2u w; w.x = pk2(v[j][0], v[j][1]); w.y = pk2(v[j][2], v[j][3]); *(v2u*)(hr + 4 * lane + 256 * j) = w; }
            float d[16];
#pragma unroll
            for (int h = 0; h < 16; ++h) { float a = 0.f;
#pragma unroll
                for (int j = 0; j < 4; ++j) { const f32x4 w = *(const LAS f32x4*)(wdt + h * 1024 + 4 * lane + 256 * j); a += (v[j][0] * w[0] + v[j][1] * w[1]) + (v[j][2] * w[2] + v[j][3] * w[3]); }
                d[h] = a; }
            float e8[8], e4[4], e2[2], e1;
#pragma unroll
            for (int i = 0; i < 8; ++i) { const bool up = lane & 32; const float snd = up ? d[i] : d[i + 8]; const float rcv = __shfl_xor(snd, 32); e8[i] = (up ? d[i + 8] : d[i]) + rcv; }
#pragma unroll
            for (int i = 0; i < 4; ++i) { const bool up = lane & 16; const float snd = up ? e8[i] : e8[i + 4]; const float rcv = __shfl_xor(snd, 16); e4[i] = (up ? e8[i + 4] : e8[i]) + rcv; }
#pragma unroll
            for (int i = 0; i < 2; ++i) { const bool up = lane & 8; const float snd = up ? e4[i] : e4[i + 2]; const float rcv = __shfl_xor(snd, 8); e2[i] = (up ? e4[i + 2] : e4[i]) + rcv; }
            { const bool up = lane & 4; const float snd = up ? e2[0] : e2[1]; const float rcv = __shfl_xor(snd, 4); e1 = (up ? e2[1] : e2[0]) + rcv; }
            e1 += __shfl_xor(e1, 2); e1 += __shfl_xor(e1, 1);
            const int head = ((lane >> 5) & 1) * 8 + ((lane >> 4) & 1) * 4 + ((lane >> 3) & 1) * 2 + ((lane >> 2) & 1);
            if ((lane & 3) == 0) WSP(float, WS_DTRAW)[t * 16 + head] = e1;
        }
    }
    for (int n = gw; n < 2048; n += F.G * NWAVES) {
        const bf16* wr = WSP(bf16, WS_WQKT) + (size_t)n * 1024 + 16 * lane;
        const v4u w0 = *(const v4u*)wr, w1 = *(const v4u*)(wr + 8);
        float wv[16]; wv[0] = bflo(w0.x); wv[1] = bfhi(w0.x); wv[2] = bflo(w0.y); wv[3] = bfhi(w0.y); wv[4] = bflo(w0.z); wv[5] = bfhi(w0.z); wv[6] = bflo(w0.w); wv[7] = bfhi(w0.w);
        wv[8] = bflo(w1.x); wv[9] = bfhi(w1.x); wv[10] = bflo(w1.y); wv[11] = bfhi(w1.y); wv[12] = bflo(w1.z); wv[13] = bfhi(w1.z); wv[14] = bflo(w1.w); wv[15] = bfhi(w1.w);
        for (int b = 0; b < 16; ++b) { const float* sp = WSP(float, WS_MOD) + (size_t)b * 6144 + 3072 + 16 * lane; float a = 0.f;
#pragma unroll
            for (int q = 0; q < 4; ++q) { const f32x4 s = *(const f32x4*)(sp + 4 * q); a += (s[0] * wv[4 * q] + s[1] * wv[4 * q + 1]) + (s[2] * wv[4 * q + 2] + s[3] * wv[4 * q + 3]); }
            a = wave_sum(a); if (lane == 0) WSP(float, WS_SB)[b * 2048 + n] = a; }
    }
}
__device__ __forceinline__ void p3pre_conv(Frame& F) {
    const int tid = threadIdx.x;
    const bf16* proj = WSP(bf16, WS_PROJ); bf16* xo = (bf16*)F.out;
    for (int item = F.vcu * NTHR + tid; item < (MTOK / 16) * 256; item += F.G * NTHR) {
        const int oc = item & 255, run = item >> 8; const int t0 = run * 16, ch = 8 * oc;
        const bool halo = (t0 & (SEQ - 1)) != 0;
        v4u rw[19];
#pragma unroll
        for (int k = 0; k < 19; ++k) { rw[k] = (v4u){0u, 0u, 0u, 0u}; if (k >= 3 || halo) rw[k] = *(const v4u*)(proj + (size_t)(t0 - 3 + k) * NPROJ + 1024 + ch); }
        float cw[4][8], cbv[8];
#pragma unroll
        for (int k = 0; k < 4; ++k) { const f32x4 w0 = *(const f32x4*)((F.a->in[6]) + k * 2048 + ch), w1 = *(const f32x4*)((F.a->in[6]) + k * 2048 + ch + 4);
#pragma unroll
            for (int e = 0; e < 4; ++e) { cw[k][e] = w0[e]; cw[k][4 + e] = w1[e]; } }
        { const f32x4 b0 = *(const f32x4*)((F.a->in[7]) + ch), b1 = *(const f32x4*)((F.a->in[7]) + ch + 4);
#pragma unroll
            for (int e = 0; e < 4; ++e) { cbv[e] = b0[e]; cbv[4 + e] = b1[e]; } }
        float r0[8], r1[8], r2[8];
        unpack8(rw[0], r0); unpack8(rw[1], r1); unpack8(rw[2], r2);
#pragma unroll
        for (int tt = 0; tt < 16; ++tt) {
            float r3[8]; unpack8(rw[3 + tt], r3);
            float v[8];
#pragma unroll
            for (int i = 0; i < 8; ++i) { v[i] = silu_f(cbv[i] + r0[i] * cw[0][i] + r1[i] * cw[1][i] + r2[i] * cw[2][i] + r3[i] * cw[3][i]); r0[i] = r1[i]; r1[i] = r2[i]; r2[i] = r3[i]; }
            *(v4u*)(xo + (size_t)(t0 + tt) * 2048 + ch) = (v4u){pk2(v[0], v[1]), pk2(v[2], v[3]), pk2(v[4], v[5]), pk2(v[6], v[7])};
        }
    }
}
constexpr int SSD_PITCH = 272;
__device__ __forceinline__ bf16x8 lds_frag(LAS unsigned char* base, int row, int kbyte) { return *(const LAS bf16x8*)(base + row * SSD_PITCH + kbyte); }
#ifdef PROBE_SSD
#define SPR_T(v) const unsigned long long v = __builtin_amdgcn_s_memtime();
#define SPR_ACC(i, d) sacc[i] += (d);
#else
#define SPR_T(v)
#define SPR_ACC(i, d)
#endif
constexpr int S3_CS = 0, S3_BS = 34816, S3_GY = 69632, S3_XDT = 104448, S3_XP = 144, S3_PREV = 122880, S3_CSF = 140288, S3_DTF = 141312, S3_WTS = 142336, S3_END = 143360;
static_assert(S3_END <= LDS_MAIN, "SSD v3 LDS map");
typedef short v4i16_t __attribute__((ext_vector_type(4)));
__device__ __forceinline__ bf16x8 lds_frag_tr(LAS unsigned char* tile, int pitch, int k0, int col0, int li, int lq) {
    LAS unsigned char* p = tile + (k0 + 8 * lq + (li >> 2)) * pitch + (col0 + 4 * (li & 3)) * 2;
    const v4i16_t lo = __builtin_amdgcn_ds_read_tr16_b64_v4i16((LAS v4i16_t*)p), hi = __builtin_amdgcn_ds_read_tr16_b64_v4i16((LAS v4i16_t*)(p + 4 * pitch));
    return __builtin_shufflevector(lo, hi, 0, 1, 2, 3, 4, 5, 6, 7);
}
struct Ssd3Pre { v4u xr[4], br[4], cr[4]; float d0, d1; };
__device__ __forceinline__ void ssd3_prefetch(Ssd3Pre& P, const char* xcb, const float* dtr, unsigned voB, unsigned voX, int tid, int lane, int w) {
#pragma unroll
    for (int r = 0; r < 4; ++r) { P.br[r] = *(const v4u*)(xcb + (voB + r * 4096u)); P.cr[r] = *(const v4u*)(xcb + (voB + 1024u + r * 4096u)); }
#pragma unroll
    for (int r = 0; r < 4; ++r) P.xr[r] = *(const v4u*)(xcb + (voX + r * 4096u));
    P.d0 = dtr[lane * 32]; P.d1 = dtr[lane * 32 + 16];
}
__device__ __forceinline__ void ssd3_cumsum(LAS unsigned char* L, int par, float r0, float r1, float dtb, float A, int lane) {
    LAS float* csf = (LAS float*)(L + S3_CSF + par * 512); LAS float* dtf = (LAS float*)(L + S3_DTF + par * 512); LAS float* wts = (LAS float*)(L + S3_WTS + par * 512);
    const float d0 = softplus_f(r0 + dtb), d1 = softplus_f(r1 + dtb);
    const float a0 = d0 * A, a1 = d1 * A; float s = a0 + a1;
#pragma unroll
    for (int o = 1; o < 64; o <<= 1) { const float t = __shfl_up(s, o); if (lane >= o) s += t; }
    const float tot = __shfl(s, 63);
    dtf[2 * lane] = d0; dtf[2 * lane + 1] = d1; csf[2 * lane] = s - a1; csf[2 * lane + 1] = s;
    wts[2 * lane] = __expf(tot - (s - a1)); wts[2 * lane + 1] = __expf(tot - s);
}
__device__ __forceinline__ void p3_ssd3(Frame& F) {
    const int tid0 = threadIdx.x, w = __builtin_amdgcn_readfirstlane(tid0 >> 6);
    LAS unsigned char* L = F.lds;
    const bf16* proj = WSP(bf16, WS_PROJ); const bf16* xc = (const bf16*)F.out; const float* dtraw = WSP(float, WS_DTRAW);
    for (int item = F.vcu; item < NB * NHEADS; item += F.G) {
        const int b = item >> 4, h = item & 15, g = h >> 2;
        int tid = tid0; asm volatile("" : "+v"(tid)); int lane = tid & 63;
        const float A = -__expf((F.a->in[9])[h]), Dh = (F.a->in[10])[h], dtb = (F.a->in[8])[h];
        const int pbs = w >> 1, nb0 = 4 * (w & 1);
        f32x4 st[4];
#pragma unroll
        for (int j = 0; j < 4; ++j) st[j] = (f32x4){0.f, 0.f, 0.f, 0.f};
        __syncthreads();
        for (int i = tid; i < 17408 / 16; i += NTHR) ((LAS v4u*)(L + S3_PREV))[i] = (v4u){0u, 0u, 0u, 0u};
        Ssd3Pre P;
        { const unsigned voB0 = (unsigned)((4 * (tid >> 4)) * 2048 + 1024 + g * 128 + 8 * (tid & 15)) * 2u, voX0 = (unsigned)((4 * ((tid & 255) >> 3)) * 2048 + h * 64 + 8 * (tid & 7)) * 2u;
          ssd3_prefetch(P, (const char*)xc + (size_t)b * SEQ * 4096, dtraw + (size_t)b * SEQ * 16 + h, voB0, voX0, tid, lane, w); }
        if (w == 0) ssd3_cumsum(L, 0, P.d0, P.d1, dtb, A, lane);
        __syncthreads();
#ifdef PROBE_SSD
        unsigned long long sacc[8] = {0, 0, 0, 0, 0, 0, 0, 0};
#endif
        for (int c = 0; c < SEQ / CHUNK; ++c) {
            SPR_T(s0)
            const size_t row0 = (size_t)b * SEQ + (size_t)c * CHUNK; const int par = c & 1;
            asm volatile("" : "+v"(tid));
            lane = tid & 63; const int li = lane & 15, lq = lane >> 4;
            const unsigned voB = (unsigned)((4 * (tid >> 4)) * 2048 + 1024 + g * 128 + 8 * (tid & 15)) * 2u, voX = (unsigned)((4 * ((tid & 255) >> 3)) * 2048 + h * 64 + 8 * (tid & 7)) * 2u;
            const unsigned voZ0 = (unsigned)((tid >> 3) * NPROJ + h * 64 + 8 * (tid & 7)) * 2u, voZ1 = voZ0 + 64u * NPROJ * 2u;
            LAS float* csf = (LAS float*)(L + S3_CSF + par * 512); LAS float* dtf = (LAS float*)(L + S3_DTF + par * 512); LAS float* wts = (LAS float*)(L + S3_WTS + par * 512);
            { const int ob = tid & 15, lb = 4 * (tid >> 4), n0 = 8 * ob;
#pragma unroll
              for (int r = 0; r < 4; ++r) { *(LAS v4u*)(L + S3_BS + (lb + r) * SSD_PITCH + n0 * 2) = P.br[r]; *(LAS v4u*)(L + S3_CS + (lb + r) * SSD_PITCH + n0 * 2) = P.cr[r]; } }
            if (tid < 256) { const int ox = tid & 7, lx = 4 * (tid >> 3), p0 = 8 * ox;
#pragma unroll
              for (int r = 0; r < 4; ++r) { float xv[8]; unpack8(P.xr[r], xv); const float tw = dtf[lx + r];
                  *(LAS v4u*)(L + S3_XDT + (lx + r) * S3_XP + p0 * 2) = (v4u){pk2(xv[0] * tw, xv[1] * tw), pk2(xv[2] * tw, xv[3] * tw), pk2(xv[4] * tw, xv[5] * tw), pk2(xv[6] * tw, xv[7] * tw)}; } }
            const char* prb = (const char*)proj + row0 * (NPROJ * 2);
            const v4u zc0 = *(const v4u*)(prb + voZ0), zc1 = *(const v4u*)(prb + voZ1);
            SPR_T(s1) SPR_ACC(0, s1 - s0)
            LDS_BARRIER();
            SPR_T(s2) SPR_ACC(1, s2 - s1)
            const float cs_end = csf[127];
            bf16x8 ca[4];
#pragma unroll
            for (int ks = 0; ks < 4; ++ks) ca[ks] = lds_frag(L + S3_CS, 16 * w + li, 64 * ks + 16 * lq);
            float csl[4];
#pragma unroll
            for (int r = 0; r < 4; ++r) csl[r] = csf[16 * w + 4 * lq + r];
            { bf16x8 bq[2][4];
#pragma unroll
              for (int ks = 0; ks < 4; ++ks) bq[0][ks] = lds_frag(L + S3_BS, li, 64 * ks + 16 * lq);
#pragma unroll
              for (int sb = 0; sb < 8; ++sb) if (sb <= (w | 1)) {
                  f32x4 cbv = (f32x4){0.f, 0.f, 0.f, 0.f};
                  const int s = 16 * sb + li; const float css = csf[s];
                  if (sb <= w) {
                      if (sb + 1 <= w) {
#pragma unroll
                          for (int ks = 0; ks < 4; ++ks) bq[(sb + 1) & 1][ks] = lds_frag(L + S3_BS, 16 * (sb + 1) + li, 64 * ks + 16 * lq); }
                      __builtin_amdgcn_sched_barrier(0);
#pragma unroll
                      for (int ks = 0; ks < 4; ++ks) cbv = __builtin_amdgcn_mfma_f32_16x16x32_bf16(ca[ks], bq[sb & 1][ks], cbv, 0, 0, 0);
                      __builtin_amdgcn_sched_barrier(0); }
#pragma unroll
                  for (int r = 0; r < 4; ++r) { const int l = 16 * w + 4 * lq + r; const float gv = (s <= l) ? cbv[r] * __expf(csl[r] - css) : 0.f;
                      *(LAS unsigned short*)(L + S3_GY + l * SSD_PITCH + s * 2) = (unsigned short)f2bf(gv); } } }
            LDS_WAIT(); asm volatile("" ::: "memory");
            SPR_T(s3) SPR_ACC(2, s3 - s2)
            f32x4 yd[4], yo[4];
#pragma unroll
            for (int pb = 0; pb < 4; ++pb) { yd[pb] = (f32x4){0.f, 0.f, 0.f, 0.f}; yo[pb] = (f32x4){0.f, 0.f, 0.f, 0.f}; }
            { bf16x8 gq[2], xq[2][4];
              gq[0] = lds_frag(L + S3_GY, 16 * w + li, 16 * lq);
#pragma unroll
              for (int pb = 0; pb < 4; ++pb) xq[0][pb] = lds_frag_tr(L + S3_XDT, S3_XP, 0, 16 * pb, li, lq);
#pragma unroll
              for (int ks = 0; ks < 4; ++ks) if (ks <= (w >> 1)) {
                  if (ks + 1 <= (w >> 1)) { gq[(ks + 1) & 1] = lds_frag(L + S3_GY, 16 * w + li, 64 * (ks + 1) + 16 * lq);
#pragma unroll
                      for (int pb = 0; pb < 4; ++pb) xq[(ks + 1) & 1][pb] = lds_frag_tr(L + S3_XDT, S3_XP, 32 * (ks + 1), 16 * pb, li, lq); }
                  __builtin_amdgcn_sched_barrier(0);
#pragma unroll
                  for (int pb = 0; pb < 4; ++pb) yd[pb] = __builtin_amdgcn_mfma_f32_16x16x32_bf16(gq[ks & 1], xq[ks & 1][pb], yd[pb], 0, 0, 0);
                  __builtin_amdgcn_sched_barrier(0); } }
            { bf16x8 pq[2][4];
#pragma unroll
              for (int pb = 0; pb < 4; ++pb) pq[0][pb] = lds_frag(L + S3_PREV, 16 * pb + li, 16 * lq);
#pragma unroll
              for (int ks = 0; ks < 4; ++ks) {
                  if (ks < 3) {
#pragma unroll
                      for (int pb = 0; pb < 4; ++pb) pq[(ks + 1) & 1][pb] = lds_frag(L + S3_PREV, 16 * pb + li, 64 * (ks + 1) + 16 * lq); }
                  __builtin_amdgcn_sched_barrier(0);
#pragma unroll
                  for (int pb = 0; pb < 4; ++pb) yo[pb] = __builtin_amdgcn_mfma_f32_16x16x32_bf16(ca[ks], pq[ks & 1][pb], yo[pb], 0, 0, 0);
                  __builtin_amdgcn_sched_barrier(0); } }
#pragma unroll
            for (int r = 0; r < 4; ++r) { const float e = __expf(csl[r]);
#pragma unroll
                for (int pb = 0; pb < 4; ++pb) *(LAS float*)(L + S3_GY + (16 * w + 4 * lq + r) * SSD_PITCH + (16 * pb + li) * 4) = yd[pb][r] + e * yo[pb][r]; }
            { const size_t rown = row0 + (c + 1 < SEQ / CHUNK ? CHUNK : 0);
              ssd3_prefetch(P, (const char*)xc + rown * 4096, dtraw + rown * 16 + h, voB, voX, tid, lane, w); }
            SPR_T(s4) SPR_ACC(3, s4 - s3)
            LDS_BARRIER();
            SPR_T(s5) SPR_ACC(4, s5 - s4)
            { const float dec = __expf(cs_end);
#pragma unroll
              for (int j = 0; j < 4; ++j) st[j] = st[j] * dec;
              bf16x8 xq[2], bq2[2][4]; f32x4 wq[2][2];
              xq[0] = lds_frag_tr(L + S3_XDT, S3_XP, 0, 16 * pbs, li, lq); wq[0][0] = *(const LAS f32x4*)(wts + 8 * lq); wq[0][1] = *(const LAS f32x4*)(wts + 8 * lq + 4);
#pragma unroll
              for (int j = 0; j < 4; ++j) bq2[0][j] = lds_frag_tr(L + S3_BS, SSD_PITCH, 0, 16 * (nb0 + j), li, lq);
#pragma unroll
              for (int ks = 0; ks < 4; ++ks) {
                  if (ks < 3) { xq[(ks + 1) & 1] = lds_frag_tr(L + S3_XDT, S3_XP, 32 * (ks + 1), 16 * pbs, li, lq); wq[(ks + 1) & 1][0] = *(const LAS f32x4*)(wts + 32 * (ks + 1) + 8 * lq); wq[(ks + 1) & 1][1] = *(const LAS f32x4*)(wts + 32 * (ks + 1) + 8 * lq + 4);
#pragma unroll
                      for (int j = 0; j < 4; ++j) bq2[(ks + 1) & 1][j] = lds_frag_tr(L + S3_BS, SSD_PITCH, 32 * (ks + 1), 16 * (nb0 + j), li, lq); }
                  __builtin_amdgcn_sched_barrier(0);
                  const f32x4 w0 = wq[ks & 1][0], w1 = wq[ks & 1][1];
                  float xv[8]; unpack8(__builtin_bit_cast(v4u, xq[ks & 1]), xv);
                  const v4u xw = (v4u){pk2(xv[0] * w0[0], xv[1] * w0[1]), pk2(xv[2] * w0[2], xv[3] * w0[3]), pk2(xv[4] * w1[0], xv[5] * w1[1]), pk2(xv[6] * w1[2], xv[7] * w1[3])};
                  const bf16x8 xf = __builtin_bit_cast(bf16x8, xw);
#pragma unroll
                  for (int j = 0; j < 4; ++j) st[j] = __builtin_amdgcn_mfma_f32_16x16x32_bf16(xf, bq2[ks & 1][j], st[j], 0, 0, 0);
                  __builtin_amdgcn_sched_barrier(0); }
#pragma unroll
              for (int j = 0; j < 4; ++j)
#pragma unroll
                  for (int r = 0; r < 4; ++r) *(LAS unsigned short*)(L + S3_PREV + (16 * pbs + 4 * lq + r) * SSD_PITCH + (16 * (nb0 + j) + li) * 2) = (unsigned short)f2bf(st[j][r]); }
            SPR_T(s6) SPR_ACC(5, s6 - s5)
#pragma unroll
            for (int k = 0; k < 2; ++k) { const int it = tid + 512 * k, l = it >> 3, o = it & 7; const size_t row = row0 + l;
                const f32x4 y0 = *(const LAS f32x4*)(L + S3_GY + l * SSD_PITCH + 32 * o), y1 = *(const LAS f32x4*)(L + S3_GY + l * SSD_PITCH + 32 * o + 16);
                const v4u xw = *(const LAS v4u*)(L + S3_XDT + l * S3_XP + 16 * o); const v4u zw = k == 0 ? zc0 : zc1; const float dsk = Dh * __builtin_amdgcn_rcpf(fmaxf(dtf[l], 1e-30f));
                float xv[8], zv[8], yv[8]; unpack8(xw, xv); unpack8(zw, zv);
                float ss = 0.f;
#pragma unroll
                for (int e = 0; e < 8; ++e) { const float yy = (e < 4 ? y0[e] : y1[e - 4]) + dsk * xv[e]; yv[e] = yy * silu_f(zv[e]); ss += yv[e] * yv[e]; }
                ss += __shfl_xor(ss, 1); ss += __shfl_xor(ss, 2); ss += __shfl_xor(ss, 4);
                if (o == 0) WSP(float, WS_STSSD)[row * 16 + h] = ss;
                *(v4u*)(WSP(bf16, WS_Y) + row * 2048 + h * 64 + 8 * o) = (v4u){pk2(yv[0], yv[1]), pk2(yv[2], yv[3]), pk2(yv[4], yv[5]), pk2(yv[6], yv[7])}; }
            if (w == 0 && c + 1 < SEQ / CHUNK) ssd3_cumsum(L, par ^ 1, P.d0, P.d1, dtb, A, lane);
            SPR_T(s7) SPR_ACC(6, s7 - s6)
            LDS_BARRIER();
            SPR_T(s8) SPR_ACC(7, s8 - s7)
        }
#ifdef PROBE_SSD
        if (blockIdx.x == 0 && threadIdx.x == PROBE_TID) *(volatile float*)(F.ws + WS_CTL + 40000) = (float)sacc[PROBE_SSD] * 1e-3f;
#endif
    }
}
typedef float f32x16 __attribute__((ext_vector_type(16)));
#ifdef PROBE_SEL
#define PR_T(v) const unsigned long long v = __builtin_amdgcn_s_memtime();
#define PR_ACC(a, d) a += (d);
#define PR_OUT(i, a) if (PROBE_SEL == (i) && blockIdx.x == 0 && threadIdx.x == 0) *(volatile float*)(F.ws + WS_CTL + 40000) = (float)(a) * 1e-4f;
#define PR_OUT4(i, a) if (PROBE_SEL == (i) && blockIdx.x == 0 && threadIdx.x == 256) *(volatile float*)(F.ws + WS_CTL + 40000) = (float)(a) * 1e-4f;
#else
#define PR_T(v)
#define PR_ACC(a, d)
#define PR_OUT(i, a)
#define PR_OUT4(i, a)
#endif
constexpr int S5V_BU = 0, S5V_BUP = 2056, S5V_BUSZ = 16 * S5V_BUP, S5V_XT = 2 * S5V_BUSZ, S5V_XTP = 1040, S5V_XTSZ = 16 * S5V_XTP, S5V_VS = S5V_XT + 2 * S5V_XTSZ, S5V_OT = S5V_VS + 4 * 512, S5V_OTP = 144, S5V_OTSZ = 16 * S5V_OTP, S5V_END = S5V_OT + 2 * S5V_OTSZ;
static_assert(S5V_END <= LDS_MAIN, "S5 v2 LDS map");
__device__ __forceinline__ void p3_s5v2(Frame& F) {
    const int tid = threadIdx.x, lane = tid & 63, w = __builtin_amdgcn_readfirstlane(tid >> 6);
    const int li = lane & 15, lq = lane >> 4;
    LAS unsigned char* L = F.lds;
    const bf16* proj = WSP(bf16, WS_PROJ);
    constexpr int NT = SEQ / 16;
#ifdef PROBE_S5
    const unsigned long long pr_t0 = PROBE_CLOCK();
#endif
    for (int item = F.vcu; item < NB * 16; item += F.G) {
        const int b = item >> 4, gs = item & 15;
        const bool scanw = w < 4; const int gl = w & 3, g = gs * 4 + gl;
        const bf16* ubase = proj + (size_t)b * SEQ * NPROJ + 3072 + gs * 64 + gl * 16;
        __syncthreads();
        if (scanw) {
            __builtin_amdgcn_s_setprio(2);
            const float lbr = WSP(float, WS_S5LB)[(g * 64 + lane) * 2], lbi = WSP(float, WS_S5LB)[(g * 64 + lane) * 2 + 1], nlbi = -lbi;
            bf16x8 bfr[8];
#pragma unroll
            for (int cb = 0; cb < 8; ++cb) { v4u v = (v4u){0u, 0u, 0u, 0u};
                if (lq < 2) { const int col = 16 * cb + li; const float* src = WSP(float, WS_S5BB) + (g * 64 + (col >> 1)) * 32 + (col & 1) * 16 + 8 * lq; const f32x4 a0 = *(const f32x4*)src, a1 = *(const f32x4*)(src + 4);
                    v = (v4u){pk2(a0[0], a0[1]), pk2(a0[2], a0[3]), pk2(a1[0], a1[1]), pk2(a1[2], a1[3])}; }
                bfr[cb] = __builtin_bit_cast(bf16x8, v); }
            float xr = 0.f, xi = 0.f;
            const int lq2 = lq & 1;
            v4u ua = *(const v4u*)(ubase + (size_t)li * NPROJ + 8 * lq2);
            { const bf16x8 af = __builtin_bit_cast(bf16x8, lq < 2 ? ua : (v4u){0u, 0u, 0u, 0u});
              ua = *(const v4u*)(ubase + (size_t)(16 + li) * NPROJ + 8 * lq2);
#pragma unroll
              for (int cb = 0; cb < 8; ++cb) { f32x4 acc = (f32x4){0.f, 0.f, 0.f, 0.f}; acc = __builtin_amdgcn_mfma_f32_16x16x32_bf16(af, bfr[cb], acc, 0, 0, 0);
#pragma unroll
                  for (int r = 0; r < 4; ++r) *(LAS float*)(L + S5V_BU + (4 * lq + r) * S5V_BUP + (gl * 128 + 16 * cb + li) * 4) = acc[r]; } }
            LDS_BARRIER();
            unsigned long long pa0 = 0, pa1 = 0, pa2 = 0;
            for (int k = 0; k <= NT; ++k) {
                PR_T(pt0)
                if (k < NT) {
                    const LAS f32x2* bp = (const LAS f32x2*)(L + S5V_BU + (k & 1) * S5V_BUSZ + (gl * 128 + 2 * lane) * 4);
                    LAS unsigned* xp = (LAS unsigned*)(L + S5V_XT + (k & 1) * S5V_XTSZ + (gl * 128 + 2 * lane) * 2);
                    f32x2 bu[16];
#pragma unroll
                    for (int t = 0; t < 16; ++t) bu[t] = bp[t * (S5V_BUP / 8)];
                    unsigned xo[16];
#pragma unroll
                    for (int t = 0; t < 16; ++t) {
                        const float a = __builtin_fmaf(nlbi, xi, bu[t][0]), bq = __builtin_fmaf(lbi, xr, bu[t][1]);
                        const float nr = __builtin_fmaf(lbr, xr, a), ni = __builtin_fmaf(lbr, xi, bq); xr = nr; xi = ni; xo[t] = pk2(xr, xi); }
#pragma unroll
                    for (int t = 0; t < 16; ++t) xp[t * (S5V_XTP / 4)] = xo[t];
                    PR_T(pt1) PR_ACC(pa0, pt1 - pt0)
                    if (k + 1 < NT) {
                        const bf16x8 af = __builtin_bit_cast(bf16x8, lq < 2 ? ua : (v4u){0u, 0u, 0u, 0u});
                        { const int kn = k + 2 < NT ? k + 2 : NT - 1; ua = *(const v4u*)(ubase + (size_t)(16 * kn + li) * NPROJ + 8 * lq2); }
                        LAS unsigned char* bun = L + S5V_BU + ((k + 1) & 1) * S5V_BUSZ;
#pragma unroll
                        for (int cb = 0; cb < 8; ++cb) { f32x4 acc = (f32x4){0.f, 0.f, 0.f, 0.f}; acc = __builtin_amdgcn_mfma_f32_16x16x32_bf16(af, bfr[cb], acc, 0, 0, 0);
#pragma unroll
                            for (int r = 0; r < 4; ++r) *(LAS float*)(bun + (4 * lq + r) * S5V_BUP + (gl * 128 + 16 * cb + li) * 4) = acc[r]; }
                    }
                }
                PR_T(pt2) PR_ACC(pa1, pt2 - pt0)
                LDS_BARRIER();
                PR_T(pt3) PR_ACC(pa2, pt3 - pt2)
            }
            __builtin_amdgcn_s_setprio(0);
            PR_OUT(0, pa0) PR_OUT(1, pa1) PR_OUT(2, pa2)
        } else {
            bf16x8 cfr[4];
#pragma unroll
            for (int ks = 0; ks < 4; ++ks) { const float* cr = (F.a->in[17]) + (g * 16 + li) * 64 + 16 * ks + 4 * lq; const float* ci = (F.a->in[18]) + (g * 16 + li) * 64 + 16 * ks + 4 * lq;
                const f32x4 r0 = *(const f32x4*)cr, i0 = *(const f32x4*)ci;
                cfr[ks] = __builtin_bit_cast(bf16x8, ((v4u){pk2(r0[0], -i0[0]), pk2(r0[1], -i0[1]), pk2(r0[2], -i0[2]), pk2(r0[3], -i0[3])})); }
            v4u gwv = (v4u){0u, 0u, 0u, 0u};
            if (lq < 2) { float gwf[8];
#pragma unroll
                for (int j = 0; j < 8; ++j) gwf[j] = (F.a->in[20])[(g * 16 + 8 * lq + j) * 16 + li];
                gwv = (v4u){pk2(gwf[0], gwf[1]), pk2(gwf[2], gwf[3]), pk2(gwf[4], gwf[5]), pk2(gwf[6], gwf[7])}; }
            const bf16x8 gfr = __builtin_bit_cast(bf16x8, gwv);
            const float dsk = (F.a->in[19])[g * 16 + li], gbias = (F.a->in[21])[g * 16 + li];
            LAS unsigned char* vs = L + S5V_VS + gl * 512;
            float uo[4], un[4];
#pragma unroll
            for (int r = 0; r < 4; ++r) { uo[r] = bf2f(ubase[(size_t)(4 * lq + r) * NPROJ + li]); un[r] = bf2f(ubase[(size_t)(16 + 4 * lq + r) * NPROJ + li]); }
            LDS_BARRIER();
            unsigned long long pb0 = 0, pb1 = 0;
            for (int k = 0; k <= NT; ++k) {
                PR_T(qt0)
                float u2[4];
                { const int kn = k + 1 < NT ? k + 1 : NT - 1;
#pragma unroll
                  for (int r = 0; r < 4; ++r) u2[r] = bf2f(ubase[(size_t)(16 * kn + 4 * lq + r) * NPROJ + li]); }
                if (k >= 2) {
                    const int t = ((tid - 256) >> 3) & 15, oc = tid & 7; const v4u ov = *(const LAS v4u*)(L + S5V_OT + (k & 1) * S5V_OTSZ + t * S5V_OTP + 16 * oc);
                    if (tid < 384) *(v4u*)(WSP(bf16, WS_Y) + ((size_t)b * SEQ + 16 * (k - 2) + t) * 2048 + 1024 + gs * 64 + 8 * oc) = ov; }
                if (k >= 1) {
                    const int kt = k - 1; const LAS unsigned char* xt = L + S5V_XT + (kt & 1) * S5V_XTSZ;
                    f32x4 yacc = (f32x4){0.f, 0.f, 0.f, 0.f};
#pragma unroll
                    for (int ks = 0; ks < 4; ++ks) yacc = __builtin_amdgcn_mfma_f32_16x16x32_bf16(*(const LAS bf16x8*)(xt + li * S5V_XTP + (gl * 128 + 32 * ks + 8 * lq) * 2), cfr[ks], yacc, 0, 0, 0);
                    float v[4];
                    { const f32x2 g0 = gelu_pk2((f32x2){yacc[0] + dsk * uo[0], yacc[1] + dsk * uo[1]}), g1 = gelu_pk2((f32x2){yacc[2] + dsk * uo[2], yacc[3] + dsk * uo[3]}); v[0] = g0[0]; v[1] = g0[1]; v[2] = g1[0]; v[3] = g1[1]; }
#pragma unroll
                    for (int r = 0; r < 4; ++r) *(LAS unsigned short*)(vs + (4 * lq + r) * 32 + li * 2) = (unsigned short)f2bf(v[r]);
                    LDS_WAIT(); asm volatile("" ::: "memory");
                    v4u va = (v4u){0u, 0u, 0u, 0u};
                    if (lq < 2) va = *(const LAS v4u*)(vs + li * 32 + 16 * lq);
                    f32x4 gacc = (f32x4){0.f, 0.f, 0.f, 0.f};
                    gacc = __builtin_amdgcn_mfma_f32_16x16x32_bf16(__builtin_bit_cast(bf16x8, va), gfr, gacc, 0, 0, 0);
                    float o[4], ss[4];
#pragma unroll
                    for (int r = 0; r < 4; ++r) { o[r] = v[r] * sigmoid_f(gacc[r] + gbias); ss[r] = o[r] * o[r]; }
#pragma unroll
                    for (int r = 0; r < 4; ++r) ss[r] = row16_sum_to15(ss[r]);
                    if (li == 15) {
#pragma unroll
                        for (int r = 0; r < 4; ++r) WSP(float, WS_STS5)[((size_t)b * SEQ + 16 * kt + 4 * lq + r) * NS5PART + g] = ss[r]; }
                    LAS unsigned char* ot = L + S5V_OT + (kt & 1) * S5V_OTSZ;
#pragma unroll
                    for (int r = 0; r < 4; ++r) *(LAS unsigned short*)(ot + (4 * lq + r) * S5V_OTP + (gl * 16 + li) * 2) = (unsigned short)f2bf(o[r]);
#pragma unroll
                    for (int r = 0; r < 4; ++r) { uo[r] = un[r]; un[r] = u2[r]; }
                }
                PR_T(qt1) PR_ACC(pb0, qt1 - qt0)
                LDS_BARRIER();
                PR_T(qt2) PR_ACC(pb1, qt2 - qt1)
            }
            PR_OUT4(3, pb0) PR_OUT4(4, pb1)
            { const int t = ((tid - 256) >> 3) & 15, oc = tid & 7; const v4u ov = *(const LAS v4u*)(L + S5V_OT + ((NT - 1) & 1) * S5V_OTSZ + t * S5V_OTP + 16 * oc);
              if (tid < 384) *(v4u*)(WSP(bf16, WS_Y) + ((size_t)b * SEQ + 16 * (NT - 1) + t) * 2048 + 1024 + gs * 64 + 8 * oc) = ov; }
        }
    }
#ifdef PROBE_S5
    if (blockIdx.x == 0 && threadIdx.x == 0) *(volatile float*)(F.ws + WS_CTL + 40000) = (float)(PROBE_CLOCK() - pr_t0) * PROBE_SCALE;
#endif
}
__device__ __forceinline__ unsigned med3u(unsigned a, unsigned b, unsigned c) { unsigned r; asm("v_med3_u32 %0, %1, %2, %3" : "=v"(r) : "v"(a), "v"(b), "v"(c)); return r; }
__device__ __forceinline__ unsigned fkey(float v) { const unsigned u = __builtin_bit_cast(unsigned, v); return (u & 0x80000000u) ? ~u : (u | 0x80000000u); }
__device__ __forceinline__ float fkey_inv(unsigned k) { const unsigned u = (k & 0x80000000u) ? (k & 0x7fffffffu) : ~k; return __builtin_bit_cast(float, u); }
#define TOPK_INSERT(a, x) do { _Pragma("unroll") for (int _i = 15; _i >= 1; --_i) a[_i] = med3u(a[_i - 1], a[_i], (x)); a[0] = a[0] > (x) ? a[0] : (x); } while (0)
__device__ __forceinline__ unsigned fp6_code(float y) {
    const float a = fabsf(y);
    const float c = a < 2.0f ? __builtin_rintf(8.0f * a) : (a < 4.0f ? __builtin_rintf(4.0f * a) + 8.0f : fminf(__builtin_rintf(2.0f * a) + 16.0f, 31.0f));
    return (unsigned)c | (y < 0.f ? 32u : 0u);
}
__device__ __forceinline__ void fp6_pack16(const unsigned* c, unsigned& w0, unsigned& w1, unsigned& w2) {
    w0 = c[0] | (c[1] << 6) | (c[2] << 12) | (c[3] << 18) | (c[4] << 24) | (c[5] << 30);
    w1 = (c[5] >> 2) | (c[6] << 4) | (c[7] << 10) | (c[8] << 16) | (c[9] << 22) | (c[10] << 28);
    w2 = (c[10] >> 4) | (c[11] << 2) | (c[12] << 8) | (c[13] << 14) | (c[14] << 20) | (c[15] << 26);
}
__device__ __forceinline__ void h2_convert(Frame& F, int w0, int nw, int f_lane) {
    for (int tb = w0 * 16; tb < MTOK; tb += nw * 16) {
        const float* sh = WSP(float, WS_MOD) + (size_t)(tb >> 11) * 6144 + 3072 + 16 * f_lane;
        float S2[16];
#pragma unroll
        for (int q = 0; q < 4; ++q) { const f32x4 s4 = *(const f32x4*)(sh + 4 * q); S2[4 * q] = s4[0]; S2[4 * q + 1] = s4[1]; S2[4 * q + 2] = s4[2]; S2[4 * q + 3] = s4[3]; }
#pragma unroll 1
        for (int k = 0; k < 16; k += 4) {
            v4u xa[4], xb[4]; float rst[4];
#pragma unroll
            for (int u = 0; u < 4; ++u) { const int t = tb + k + u; const char* xs = (const char*)(WSP(bf16, WS_X1S) + (size_t)t * 1024) + 32 * f_lane; xa[u] = *(const v4u*)xs; xb[u] = *(const v4u*)(xs + 16); rst[u] = WSP(float, WS_ROWSTAT)[t]; }
#pragma unroll
            for (int u = 0; u < 4; ++u) { const int t = tb + k + u;
                const float rs = rsqrt_f(rst[u] * (1.0f / 1024.0f) + EPSF);
                float h2[16]; unpack8(xa[u], h2); unpack8(xb[u], h2 + 8); float mx = 0.f;
#pragma unroll
                for (int i = 0; i < 16; ++i) { h2[i] = h2[i] * rs + S2[i]; mx = fmaxf(mx, fabsf(h2[i])); }
#pragma unroll
                for (int o = 1; o < 64; o <<= 1) mx = fmaxf(mx, __shfl_xor(mx, o));
                mx = fmaxf(mx, 1e-30f); const float hs = 224.0f / mx;
                v4u w;
#pragma unroll
                for (int q = 0; q < 4; ++q) { int pk = 0; pk = __builtin_amdgcn_cvt_pk_fp8_f32(h2[4 * q] * hs, h2[4 * q + 1] * hs, pk, false); pk = __builtin_amdgcn_cvt_pk_fp8_f32(h2[4 * q + 2] * hs, h2[4 * q + 3] * hs, pk, true); w[q] = (unsigned)pk; }
                *(v4u*)(F.ws + WS_H2Q + (size_t)t * 1024 + 16 * f_lane) = w;
                if (f_lane == 0) WSP(float, WS_HINV)[t] = mx * (1.0f / 224.0f); }
        }
    }
}
__device__ __forceinline__ void expert_convert(Frame& F, int w0, int nw, int f_lane) {
    for (int rw = w0; rw < 2 * 16384; rw += 2 * nw) {
        f32x4 v[2][4]; float mx[2];
#pragma unroll
        for (int u = 0; u < 2; ++u) { const int r = rw + u * nw; const int tb = r >= 16384, e = tb ? r - 16384 : r; const float* src = (tb ? (F.a->in[28]) : (F.a->in[27])) + (size_t)e * 1024 + 16 * f_lane;
#pragma unroll
            for (int q = 0; q < 4; ++q) v[u][q] = *(const f32x4*)(src + 4 * q); }
#pragma unroll
        for (int u = 0; u < 2; ++u) { float m = 0.f;
#pragma unroll
            for (int q = 0; q < 4; ++q) m = fmaxf(m, fmaxf(fmaxf(fabsf(v[u][q][0]), fabsf(v[u][q][1])), fmaxf(fabsf(v[u][q][2]), fabsf(v[u][q][3]))));
#pragma unroll
            for (int o = 1; o < 64; o <<= 1) m = fmaxf(m, __shfl_xor(m, o));
            mx[u] = fmaxf(m, 1e-30f); }
#ifdef HWENC
        {
            typedef float f32x16 __attribute__((ext_vector_type(16))); typedef unsigned v6u_t __attribute__((ext_vector_type(6)));
            const float sa = 7.5f / mx[0], sb = 7.5f / mx[1]; f32x16 s0, s1;
#pragma unroll
            for (int i = 0; i < 8; ++i) {
#ifdef HWENC_SEQ
                s0[i] = v[0][i >> 2][i & 3] * sa; s0[8 + i] = v[0][2 + (i >> 2)][i & 3] * sa; s1[i] = v[1][i >> 2][i & 3] * sb; s1[8 + i] = v[1][2 + (i >> 2)][i & 3] * sb;
#else
                s0[i] = v[0][(2 * i) >> 2][(2 * i) & 3] * sa; s1[i] = v[0][(2 * i + 1) >> 2][(2 * i + 1) & 3] * sa; s0[8 + i] = v[1][(2 * i) >> 2][(2 * i) & 3] * sb; s1[8 + i] = v[1][(2 * i + 1) >> 2][(2 * i + 1) & 3] * sb;
#endif
            }
            const v6u_t enc = __builtin_amdgcn_cvt_scalef32_2xpk16_fp6_f32(s0, s1, 1.0f);
#pragma unroll
            for (int u = 0; u < 2; ++u) { const int r = rw + u * nw; const int tb = r >= 16384, e = tb ? r - 16384 : r;
                unsigned* dst = (unsigned*)(F.ws + (tb ? WS_EV : WS_EU) + (size_t)e * 768 + 12 * f_lane); dst[0] = enc[3 * u]; dst[1] = enc[3 * u + 1]; dst[2] = enc[3 * u + 2];
                if (f_lane == 0) WSP(float, tb ? WS_EVS : WS_EUS)[e] = mx[u] * (1.0f / 7.5f); }
            continue;
        }
#endif
#pragma unroll
        for (int u = 0; u < 2; ++u) { const int r = rw + u * nw; const int tb = r >= 16384, e = tb ? r - 16384 : r; const float sc = 224.0f / mx[u];
            v4u w;
#pragma unroll
            for (int q = 0; q < 4; ++q) { int pk = 0; pk = __builtin_amdgcn_cvt_pk_fp8_f32(v[u][q][0] * sc, v[u][q][1] * sc, pk, false); pk = __builtin_amdgcn_cvt_pk_fp8_f32(v[u][q][2] * sc, v[u][q][3] * sc, pk, true); w[q] = (unsigned)pk; }
#ifdef V6
#if defined(UP12) || defined(UP14) || defined(UP15) || defined(UP16)
            {
#else
            if (tb) {
#endif
                const float s6 = 7.5f / mx[u]; unsigned cd[16];
#pragma unroll
                for (int q = 0; q < 4; ++q)
#pragma unroll
                    for (int i = 0; i < 4; ++i) cd[4 * q + i] = fp6_code(v[u][q][i] * s6);
                unsigned w0, w1, w2; fp6_pack16(cd, w0, w1, w2);
#ifdef UP15
                if (!tb) {
                    unsigned char* rowp = F.ws + WS_EU + (size_t)e * 768 + 16 * (f_lane >> 3); const int d0 = 3 * (f_lane & 7);
                    *(unsigned*)(rowp + 128 * (d0 >> 2) + 4 * (d0 & 3)) = w0; *(unsigned*)(rowp + 128 * ((d0 + 1) >> 2) + 4 * ((d0 + 1) & 3)) = w1; *(unsigned*)(rowp + 128 * ((d0 + 2) >> 2) + 4 * ((d0 + 2) & 3)) = w2;
                    if (f_lane == 0) WSP(float, WS_EUS)[e] = mx[u] * (1.0f / 7.5f);
                    continue; }
#endif
                unsigned* dst = (unsigned*)(F.ws + (tb ? WS_EV : WS_EU) + (size_t)e * 768 + 12 * f_lane); dst[0] = w0; dst[1] = w1; dst[2] = w2;
                if (f_lane == 0) WSP(float, tb ? WS_EVS : WS_EUS)[e] = mx[u] * (1.0f / 7.5f);
                continue; }
#endif
            *(v4u*)(F.ws + (tb ? WS_EV : WS_EU) + (size_t)e * 1024 + 16 * f_lane) = w;
            if (f_lane == 0) WSP(float, tb ? WS_EVS : WS_EUS)[e] = mx[u] * (1.0f / 224.0f); }
    }
}
__device__ __forceinline__ void p5b_topk(Frame& F) {
    const int f_tid = threadIdx.x, f_lane = f_tid & 63, f_wave = __builtin_amdgcn_readfirstlane(f_tid >> 6);
    const _Float16* scores = WSP(_Float16, WS_SCORES);
    LAS unsigned char* ix = (LAS unsigned char*)F.lds + f_tid * 36;
#pragma unroll 1
    for (int half = 0; half < 2; ++half) {
#ifdef UP11
    if ((f_wave >> 2) != half) { expert_convert(F, (F.vcu * 4 + (f_wave & 3)) * 2 + half, F.G * 8, f_lane); h2_convert(F, (F.vcu * 4 + (f_wave & 3)) * 2 + half, F.G * 8, f_lane); continue; }
#else
    if ((f_wave >> 2) != half) { expert_convert(F, (F.vcu * 4 + (f_wave & 3)) * 2 + half, F.G * 8, f_lane); continue; }
#endif
    typedef _Float16 f16x8 __attribute__((ext_vector_type(8)));
    f16x8 sva[8], svb[8];
    { const int item0 = (F.vcu * 2 + half) * 256 + (f_tid & 255); const _Float16* sp0 = scores + (size_t)(item0 >> 3) * 2048 + (item0 & 7) * 256;
#pragma unroll
      for (int q = 0; q < 8; ++q) sva[q] = *(const f16x8*)(sp0 + 8 * q); }
#pragma unroll 1
    for (int item = (F.vcu * 2 + half) * 256 + (f_tid & 255); item < MTOK * PH; item += F.G * 512) {
        const int t = item >> 3, hd = item & 7;
        unsigned a1[16], a2[16];
#pragma unroll
        for (int i = 0; i < 16; ++i) { a1[i] = 0u; a2[i] = 0u; }
        const _Float16* sp = scores + (size_t)t * 2048 + hd * 256;
        const int itn = (item + F.G * 512 < MTOK * PH) ? item + F.G * 512 : item;
        const _Float16* spn = scores + (size_t)(itn >> 3) * 2048 + (itn & 7) * 256;
#define TK_BATCH(CUR, NXT, NP, A, M) { \
        { _Pragma("unroll") for (int q = 0; q < 8; ++q) NXT[q] = *(const f16x8*)((NP) + 8 * q); } \
        __builtin_amdgcn_sched_barrier(0); \
        _Pragma("unroll") for (int q = 0; q < 8; ++q) { _Pragma("unroll") for (int e = 0; e < 8; ++e) { const unsigned k = (fkey((float)CUR[q][e]) & ~127u) | (unsigned)(127 - (64 * (M) + 8 * q + e)); TOPK_INSERT(A, k); } } }
        TK_BATCH(sva, svb, sp + 64, a1, 0)
        TK_BATCH(svb, sva, sp + 128, a1, 1)
        TK_BATCH(sva, svb, sp + 192, a2, 0)
        TK_BATCH(svb, sva, spn, a2, 1)
#undef TK_BATCH
        float v1[16], v2[16];
#pragma unroll
        for (int i = 0; i < 16; ++i) { ix[i] = (unsigned char)(127u - (a1[i] & 127u)); ix[16 + i] = (unsigned char)(127u - (a2[i] & 127u)); v1[i] = fkey_inv(a1[i] & ~127u); v2[i] = fkey_inv(a2[i] & ~127u); }
        unsigned cb[16];
#pragma unroll
        for (int i = 0; i < 16; ++i) cb[i] = 0u;
#pragma unroll
        for (int i = 0; i < 16; ++i)
#pragma unroll
            for (int j = 0; j < 16; ++j) if ((i + 1) * (j + 1) <= 16) { const unsigned k = (fkey(v1[i] + v2[j]) & ~255u) | (unsigned)(255 - (i * 16 + j)); TOPK_INSERT(cb, k); }
        float tv[16]; float mx = -3.0e38f;
#pragma unroll
        for (int k = 0; k < 16; ++k) { tv[k] = fkey_inv(cb[k] & ~255u); mx = fmaxf(mx, tv[k]); }
        float sum = 0.f;
#pragma unroll
        for (int k = 0; k < 16; ++k) { tv[k] = __expf(tv[k] - mx); sum += tv[k]; }
        const float inv = 1.0f / sum;
        LDS_WAIT(); asm volatile("" ::: "memory");
#ifdef RANGE16
        int ev[16]; unsigned long long cA = 0ull, cB = 0ull;
#pragma unroll
        for (int k = 0; k < 16; ++k) { const unsigned code = 255u - (cb[k] & 255u); const int i = code >> 4, j = code & 15; ev[k] = (int)ix[i] * 128 + (int)ix[16 + j];
            const int r = ev[k] >> 10; const unsigned long long one = 1ull << (8 * (r & 7)); if (r < 8) cA += one; else cB += one; }
        unsigned long long sA = cA, sB = cB;
#pragma unroll
        for (int o = 1; o < 8; o <<= 1) {
            const unsigned alo = __shfl_up((unsigned)sA, o, 8), ahi = __shfl_up((unsigned)(sA >> 32), o, 8), blo = __shfl_up((unsigned)sB, o, 8), bhi = __shfl_up((unsigned)(sB >> 32), o, 8);
            if ((f_lane & 7) >= o) { sA += ((unsigned long long)ahi << 32) | alo; sB += ((unsigned long long)bhi << 32) | blo; } }
        const unsigned long long eA = sA - cA, eB = sB - cB;
        const unsigned long long tA = ((unsigned long long)__shfl((unsigned)(sA >> 32), 7, 8) << 32) | __shfl((unsigned)sA, 7, 8), tB = ((unsigned long long)__shfl((unsigned)(sB >> 32), 7, 8) << 32) | __shfl((unsigned)sB, 7, 8);
        const unsigned long long pA = tA * 0x0101010101010101ull, pB = tB * 0x0101010101010101ull;
        const unsigned long long st64 = pA << 8, stB = (pB << 8) + (pA >> 56) * 0x0101010101010101ull;
        unsigned long long baseA = st64 + eA, baseB = stB + eB;
        int* eo = WSP(int, WS_EID) + (size_t)t * 128; float* go = WSP(float, WS_GATE) + (size_t)t * 128;
#pragma unroll
        for (int k = 0; k < 16; ++k) { const int r = ev[k] >> 10; const int r8 = 8 * (r & 7); const unsigned long long one = 1ull << r8;
            const int slot = (int)(((r < 8 ? baseA : baseB) >> r8) & 255ull); if (r < 8) baseA += one; else baseB += one; eo[slot] = ev[k]; go[slot] = tv[k] * inv; }
        if (hd == 0) WSP(unsigned long long, WS_START)[t] = st64;
#else
        int ev[16]; unsigned long long c64 = 0ull;
#pragma unroll
        for (int k = 0; k < 16; ++k) { const unsigned code = 255u - (cb[k] & 255u); const int i = code >> 4, j = code & 15; ev[k] = (int)ix[i] * 128 + (int)ix[16 + j]; c64 += 1ull << (8 * (ev[k] >> RANGE_SHIFT)); }
        unsigned long long s64 = c64;
#pragma unroll
        for (int o = 1; o < 8; o <<= 1) { const unsigned lo = __shfl_up((unsigned)s64, o, 8), hi = __shfl_up((unsigned)(s64 >> 32), o, 8); if ((f_lane & 7) >= o) s64 += ((unsigned long long)hi << 32) | lo; }
        const unsigned long long e64 = s64 - c64;
        const unsigned long long t64 = ((unsigned long long)__shfl((unsigned)(s64 >> 32), 7, 8) << 32) | __shfl((unsigned)s64, 7, 8);
        const unsigned long long st64 = (t64 * 0x0101010101010101ull) << 8;
        unsigned long long base64 = st64 + e64;
        int* eo = WSP(int, WS_EID) + (size_t)t * 128; float* go = WSP(float, WS_GATE) + (size_t)t * 128;
#pragma unroll
        for (int k = 0; k < 16; ++k) { const int r8 = 8 * (ev[k] >> RANGE_SHIFT); const int slot = (int)((base64 >> r8) & 255ull); base64 += 1ull << r8; eo[slot] = ev[k]; go[slot] = tv[k] * inv; }
        if (hd == 0) WSP(unsigned long long, WS_START)[t] = st64;
#endif
        LDS_WAIT(); asm volatile("" ::: "memory");
    }
    }
}
__device__ __forceinline__ void dec16(const v4u q, float* f) {
#pragma unroll
    for (int i = 0; i < 4; ++i) { const f32x2 lo = __builtin_amdgcn_cvt_pk_f32_fp8((int)q[i], false), hi = __builtin_amdgcn_cvt_pk_f32_fp8((int)q[i], true); f[4 * i] = lo[0]; f[4 * i + 1] = lo[1]; f[4 * i + 2] = hi[0]; f[4 * i + 3] = hi[1]; }
}
struct CvE { f32x4 v[4]; };
struct CvH { v4u xa, xb; float rst; };
__device__ __forceinline__ void cve_load(CvE& c, Frame& F, int r, int f_lane) {
    const int tb = r >= 16384, e = tb ? r - 16384 : r; const float* src = (tb ? (F.a->in[28]) : (F.a->in[27])) + (size_t)e * 1024 + 16 * f_lane;
#pragma unroll
    for (int q = 0; q < 4; ++q) c.v[q] = *(const f32x4*)(src + 4 * q);
}
__device__ __forceinline__ void cve_finish(const CvE& c, Frame& F, int r, int f_lane) {
    const int tb = r >= 16384, e = tb ? r - 16384 : r; float m = 0.f;
#pragma unroll
    for (int q = 0; q < 4; ++q) m = fmaxf(m, fmaxf(fmaxf(fabsf(c.v[q][0]), fabsf(c.v[q][1])), fmaxf(fabsf(c.v[q][2]), fabsf(c.v[q][3]))));
#pragma unroll
    for (int o = 1; o < 64; o <<= 1) m = fmaxf(m, __shfl_xor(m, o));
    m = fmaxf(m, 1e-30f); const float sc = 224.0f / m;
    v4u w;
#pragma unroll
    for (int q = 0; q < 4; ++q) { int pk = 0; pk = __builtin_amdgcn_cvt_pk_fp8_f32(c.v[q][0] * sc, c.v[q][1] * sc, pk, false); pk = __builtin_amdgcn_cvt_pk_fp8_f32(c.v[q][2] * sc, c.v[q][3] * sc, pk, true); w[q] = (unsigned)pk; }
    *(v4u*)(F.ws + (tb ? WS_EV : WS_EU) + (size_t)e * 1024 + 16 * f_lane) = w;
    if (f_lane == 0) WSP(float, tb ? WS_EVS : WS_EUS)[e] = m * (1.0f / 224.0f);
}
__device__ __forceinline__ void cvh_load(CvH& c, Frame& F, int t, int f_lane) {
    const char* xs = (const char*)(WSP(bf16, WS_X1S) + (size_t)t * 1024) + 32 * f_lane; c.xa = *(const v4u*)xs; c.xb = *(const v4u*)(xs + 16); c.rst = WSP(float, WS_ROWSTAT)[t];
}
__device__ __forceinline__ void cvh_finish(const CvH& c, Frame& F, int t, int f_lane, const float* S2) {
    const float rs = rsqrt_f(c.rst * (1.0f / 1024.0f) + EPSF);
    float h2[16]; unpack8(c.xa, h2); unpack8(c.xb, h2 + 8); float mx = 0.f;
#pragma unroll
    for (int i = 0; i < 16; ++i) { h2[i] = h2[i] * rs + S2[i]; mx = fmaxf(mx, fabsf(h2[i])); }
#pragma unroll
    for (int o = 1; o < 64; o <<= 1) mx = fmaxf(mx, __shfl_xor(mx, o));
    mx = fmaxf(mx, 1e-30f); const float hs = 224.0f / mx;
    v4u w;
#pragma unroll
    for (int q = 0; q < 4; ++q) { int pk = 0; pk = __builtin_amdgcn_cvt_pk_fp8_f32(h2[4 * q] * hs, h2[4 * q + 1] * hs, pk, false); pk = __builtin_amdgcn_cvt_pk_fp8_f32(h2[4 * q + 2] * hs, h2[4 * q + 3] * hs, pk, true); w[q] = (unsigned)pk; }
    *(v4u*)(F.ws + WS_H2Q + (size_t)t * 1024 + 16 * f_lane) = w;
    if (f_lane == 0) WSP(float, WS_HINV)[t] = mx * (1.0f / 224.0f);
}
__device__ __forceinline__ void p5b_topk2(Frame& F) {
    const int f_tid = threadIdx.x, f_lane = f_tid & 63, f_wave = __builtin_amdgcn_readfirstlane(f_tid >> 6);
    const _Float16* scores = WSP(_Float16, WS_SCORES);
    LAS unsigned char* ix = (LAS unsigned char*)F.lds + f_tid * 36;
    const int gw = F.vcu * NWAVES + f_wave;
    static_assert(MTOK * PH == 2 * 256 * NTHR && MTOK == 16 * 256 * NWAVES, "P7 v2 work split");
    float S2[16];
    { const float* sh = WSP(float, WS_MOD) + (size_t)((gw * 16) >> 11) * 6144 + 3072 + 16 * f_lane;
#pragma unroll
      for (int q = 0; q < 4; ++q) { const f32x4 s4 = *(const f32x4*)(sh + 4 * q); S2[4 * q] = s4[0]; S2[4 * q + 1] = s4[1]; S2[4 * q + 2] = s4[2]; S2[4 * q + 3] = s4[3]; } }
    typedef _Float16 f16x8 __attribute__((ext_vector_type(8)));
    const int item_base = F.vcu * NTHR + f_tid, item_step = F.G * NTHR;
    f16x8 sva[8], svb[8];
    { const _Float16* sp0 = scores + (size_t)(item_base >> 3) * 2048 + (item_base & 7) * 256;
#pragma unroll
      for (int q = 0; q < 8; ++q) sva[q] = *(const f16x8*)(sp0 + 8 * q); }
    unsigned a1[16];
#pragma unroll
    for (int i = 0; i < 16; ++i) a1[i] = 0u;
#pragma unroll 1
    for (int hi = 0; hi < 4; ++hi) {
        const int item = item_base + (hi >> 1) * item_step; const int t = item >> 3, hd = item & 7, kh = hi & 1;
        const _Float16* sp = scores + (size_t)t * 2048 + hd * 256 + kh * 128;
        const int hn = hi < 3 ? hi + 1 : hi; const int itn = item_base + (hn >> 1) * item_step;
        const _Float16* spn = scores + (size_t)(itn >> 3) * 2048 + (itn & 7) * 256 + (hn & 1) * 128;
        unsigned a2[16];
#pragma unroll
        for (int i = 0; i < 16; ++i) a2[i] = 0u;
#define TK2_BATCH(CUR, NXT, NP, M) { \
        const int ku = 2 * (2 * hi + (M)); CvE e0, e1; CvH h0, h1; \
        { _Pragma("unroll") for (int q = 0; q < 8; ++q) NXT[q] = *(const f16x8*)((NP) + 8 * q); } \
        cve_load(e0, F, gw + ku * 2048, f_lane); cve_load(e1, F, gw + (ku + 1) * 2048, f_lane); cvh_load(h0, F, gw * 16 + ku, f_lane); cvh_load(h1, F, gw * 16 + ku + 1, f_lane); \
        __builtin_amdgcn_sched_barrier(0); \
        _Pragma("unroll") for (int q = 0; q < 8; ++q) { _Pragma("unroll") for (int e = 0; e < 8; ++e) { const unsigned k = (fkey((float)CUR[q][e]) & ~127u) | (unsigned)(127 - (64 * (M) + 8 * q + e)); TOPK_INSERT(a2, k); } } \
        __builtin_amdgcn_sched_barrier(0); \
        cve_finish(e0, F, gw + ku * 2048, f_lane); cve_finish(e1, F, gw + (ku + 1) * 2048, f_lane); cvh_finish(h0, F, gw * 16 + ku, f_lane, S2); cvh_finish(h1, F, gw * 16 + ku + 1, f_lane, S2); \
        __builtin_amdgcn_sched_barrier(0); }
        TK2_BATCH(sva, svb, sp + 64, 0)
        TK2_BATCH(svb, sva, spn, 1)
#undef TK2_BATCH
        if (kh == 0) {
#pragma unroll
            for (int i = 0; i < 16; ++i) a1[i] = a2[i];
            continue;
        }
        float v1[16], v2[16];
#pragma unroll
        for (int i = 0; i < 16; ++i) { ix[i] = (unsigned char)(127u - (a1[i] & 127u)); ix[16 + i] = (unsigned char)(127u - (a2[i] & 127u)); v1[i] = fkey_inv(a1[i] & ~127u); v2[i] = fkey_inv(a2[i] & ~127u); }
        unsigned cb[16];
#pragma unroll
        for (int i = 0; i < 16; ++i) cb[i] = 0u;
#pragma unroll
        for (int i = 0; i < 16; ++i)
#pragma unroll
            for (int j = 0; j < 16; ++j) if ((i + 1) * (j + 1) <= 16) { const unsigned k = (fkey(v1[i] + v2[j]) & ~255u) | (unsigned)(255 - (i * 16 + j)); TOPK_INSERT(cb, k); }
        float tv[16]; float mx = -3.0e38f;
#pragma unroll
        for (int k = 0; k < 16; ++k) { tv[k] = fkey_inv(cb[k] & ~255u); mx = fmaxf(mx, tv[k]); }
        float sum = 0.f;
#pragma unroll
        for (int k = 0; k < 16; ++k) { tv[k] = __expf(tv[k] - mx); sum += tv[k]; }
        const float inv = 1.0f / sum;
        LDS_WAIT(); asm volatile("" ::: "memory");
        int ev[16]; unsigned long long c64 = 0ull;
#pragma unroll
        for (int k = 0; k < 16; ++k) { const unsigned code = 255u - (cb[k] & 255u); const int i = code >> 4, j = code & 15; ev[k] = (int)ix[i] * 128 + (int)ix[16 + j]; c64 += 1ull << (8 * (ev[k] >> 11)); }
        unsigned long long s64 = c64;
#pragma unroll
        for (int o = 1; o < 8; o <<= 1) { const unsigned lo = __shfl_up((unsigned)s64, o, 8), hi2 = __shfl_up((unsigned)(s64 >> 32), o, 8); if ((f_lane & 7) >= o) s64 += ((unsigned long long)hi2 << 32) | lo; }
        const unsigned long long e64 = s64 - c64;
        const unsigned long long t64 = ((unsigned long long)__shfl((unsigned)(s64 >> 32), 7, 8) << 32) | __shfl((unsigned)s64, 7, 8);
        const unsigned long long st64 = (t64 * 0x0101010101010101ull) << 8;
        unsigned long long base64 = st64 + e64;
        int* eo = WSP(int, WS_EID) + (size_t)t * 128; float* go = WSP(float, WS_GATE) + (size_t)t * 128;
#pragma unroll
        for (int k = 0; k < 16; ++k) { const int r8 = 8 * (ev[k] >> 11); const int slot = (int)((base64 >> r8) & 255ull); base64 += 1ull << r8; eo[slot] = ev[k]; go[slot] = tv[k] * inv; }
        if (hd == 0) WSP(unsigned long long, WS_START)[t] = st64;
        LDS_WAIT(); asm volatile("" ::: "memory");
    }
}
__device__ __forceinline__ void p9_peer_down2(Frame& F) {
    const int f_tid = threadIdx.x, lane = f_tid & 63, f_wave = __builtin_amdgcn_readfirstlane(f_tid >> 6);
    const unsigned char* EV = F.ws + WS_EV;
    for (int wq = F.vcu * NWAVES + f_wave; wq < MTOK / 16; wq += F.G * NWAVES) {
        const int b = wq >> 7; const float* mb = WSP(float, WS_MOD) + (size_t)b * 6144;
        int ne_lo = WSP(int, WS_EID)[(size_t)wq * 16 * 128 + lane], ne_hi = WSP(int, WS_EID)[(size_t)wq * 16 * 128 + 64 + lane];
        float nw_lo = WSP(float, WS_GATE)[(size_t)wq * 16 * 128 + lane], nw_hi = WSP(float, WS_GATE)[(size_t)wq * 16 * 128 + 64 + lane];
        for (int tt = 0; tt < 16; ++tt) {
            const size_t t = (size_t)wq * 16 + tt;
            unsigned l16 = 16u * (unsigned)lane; asm volatile("" : "+v"(l16));
            float* xr = (float*)((char*)(F.out + t * 1024) + 4u * l16);
            const int e_lo = ne_lo, e_hi = ne_hi; const float w_lo = nw_lo, w_hi = nw_hi;
            f32x2 o[8];
#pragma unroll
            for (int i = 0; i < 8; ++i) o[i] = (f32x2){0.f, 0.f};
            v4u qa[8], qb[8];
#pragma unroll
            for (int j = 0; j < 8; ++j) { const int e = __builtin_amdgcn_readlane(e_lo, j); qa[j] = *(const v4u*)(EV + ((unsigned)e * 1024u + l16)); }
#define DN2_STEP(GRP, CUR, NXT) { \
                const int grp = (GRP); const int nb = ((grp + 1) & 7) * 8; const int ensel = (grp + 1) < 8 ? e_lo : e_hi; \
                { _Pragma("unroll") for (int j = 0; j < 8; ++j) { const int e = __builtin_amdgcn_readlane(ensel, nb + j); NXT[j] = *(const v4u*)(EV + ((unsigned)e * 1024u + l16)); } } \
                __builtin_amdgcn_sched_barrier(0); \
                const int base = (grp & 7) * 8; const float wsel = grp < 8 ? w_lo : w_hi; \
                _Pragma("unroll") for (int j = 0; j < 8; ++j) { const float wj = __builtin_bit_cast(float, __builtin_amdgcn_readlane(__builtin_bit_cast(int, wsel), base + j)); const f32x2 w2 = (f32x2){wj, wj}; \
                    _Pragma("unroll") for (int i = 0; i < 4; ++i) { const f32x2 lo = __builtin_amdgcn_cvt_pk_f32_fp8((int)CUR[j][i], false), hi = __builtin_amdgcn_cvt_pk_f32_fp8((int)CUR[j][i], true); o[2 * i] += w2 * lo; o[2 * i + 1] += w2 * hi; } } }
#pragma unroll 1
            for (int g2 = 0; g2 < 16; g2 += 2) { DN2_STEP(g2, qa, qb) DN2_STEP(g2 + 1, qb, qa) }
#undef DN2_STEP
            { const size_t tn = t + (tt < 15 ? 1 : 0); ne_lo = WSP(int, WS_EID)[tn * 128 + lane]; ne_hi = WSP(int, WS_EID)[tn * 128 + 64 + lane]; nw_lo = WSP(float, WS_GATE)[tn * 128 + lane]; nw_hi = WSP(float, WS_GATE)[tn * 128 + 64 + lane]; }
            float x1[16]; float ss = 0.f;
#pragma unroll
            for (int q4 = 0; q4 < 4; ++q4) { const f32x4 v = *(const f32x4*)(xr + 4 * q4); x1[4 * q4] = v[0]; x1[4 * q4 + 1] = v[1]; x1[4 * q4 + 2] = v[2]; x1[4 * q4 + 3] = v[3]; }
#pragma unroll
            for (int q4 = 0; q4 < 4; ++q4) { const f32x4 gt = *(const f32x4*)((const char*)(mb + 5120) + 4u * l16 + 16 * q4);
#pragma unroll
                for (int e = 0; e < 4; ++e) { const int i = 4 * q4 + e; x1[i] += gt[e] * o[i >> 1][i & 1]; ss += x1[i] * x1[i]; } }
            const float rf = rsqrt_f(wave_sum(ss) * (1.0f / 1024.0f) + EPSF);
#pragma unroll
            for (int q4 = 0; q4 < 4; ++q4) { const f32x4 nf = *(const f32x4*)((const char*)(F.a->in[29]) + 4u * l16 + 16 * q4); f32x4 v;
#pragma unroll
                for (int e = 0; e < 4; ++e) v[e] = x1[4 * q4 + e] * rf * nf[e];
                *(f32x4*)(xr + 4 * q4) = v; }
        }
    }
}
typedef long i64_t;
constexpr int U6_ROWP = 1040, U6_BUF = 8 * U6_ROWP, U6_WAVE = 2 * U6_BUF + 1024;
static_assert(8 * U6_WAVE <= LDS_MAIN, "U6 LDS map");
__device__ __forceinline__ void p8_peer_up6(Frame& F) {
    const int f_tid = threadIdx.x, lane = f_tid & 63, f_wave = __builtin_amdgcn_readfirstlane(f_tid >> 6);
    const int li = lane & 15, lq = lane >> 4;
    const unsigned char* EU = F.ws + WS_EU; const float* EUS = WSP(float, WS_EUS); const float* EVS = WSP(float, WS_EVS);
    LAS unsigned char* ring = F.lds + f_wave * U6_WAVE; LAS unsigned char* hq = ring + 2 * U6_BUF;
    for (int wq = F.vcu * NWAVES + f_wave; wq < MTOK / 16; wq += F.G * NWAVES) {
        const int b = wq >> 7; const float* mb = WSP(float, WS_MOD) + (size_t)b * 6144;
        for (int tt = 0; tt < 16; ++tt) {
            const size_t t = (size_t)wq * 16 + tt;
            unsigned l16 = 16u * (unsigned)lane; asm volatile("" : "+v"(l16));
            const int e_lo = WSP(int, WS_EID)[t * 128 + lane], e_hi = WSP(int, WS_EID)[t * 128 + 64 + lane];
            const float g_lo = WSP(float, WS_GATE)[t * 128 + lane], g_hi = WSP(float, WS_GATE)[t * 128 + 64 + lane];
            const float rs = rsqrt_f(WSP(float, WS_ROWSTAT)[t] * (1.0f / 1024.0f) + EPSF);
            const char* xs = (const char*)(WSP(bf16, WS_X1S) + t * 1024) + 2u * l16; const v4u xa = *(const v4u*)xs, xb = *(const v4u*)(xs + 16);
            asm volatile("s_waitcnt vmcnt(0)" ::: "memory");
#pragma unroll
            for (int j = 0; j < 8; ++j) { const int e = __builtin_amdgcn_readlane(e_lo, j);
                __builtin_amdgcn_global_load_lds((const unsigned*)(EU + ((unsigned)e * 1024u + l16)), (LAS unsigned*)(ring + j * U6_ROWP), 16, 0, 0); }
            const float su_lo = EUS[e_lo], su_hi = EUS[e_hi], sv_lo = EVS[e_lo], sv_hi = EVS[e_hi];
            float h2[16]; unpack8(xa, h2); unpack8(xb, h2 + 8); float mx = 0.f;
#pragma unroll
            for (int qd = 0; qd < 4; ++qd) { const f32x4 sh = *(const f32x4*)((const char*)(mb + 3072) + 4u * l16 + 16 * qd);
#pragma unroll
                for (int e = 0; e < 4; ++e) { h2[4 * qd + e] = h2[4 * qd + e] * rs + sh[e]; mx = fmaxf(mx, fabsf(h2[4 * qd + e])); } }
#pragma unroll
            for (int o = 1; o < 64; o <<= 1) mx = fmaxf(mx, __shfl_xor(mx, o));
            mx = fmaxf(mx, 1e-30f); const float hs = 224.0f / mx, hinv = mx * (1.0f / 224.0f);
            { v4u w;
#pragma unroll
              for (int qd = 0; qd < 4; ++qd) { int pk = 0; pk = __builtin_amdgcn_cvt_pk_fp8_f32(h2[4 * qd] * hs, h2[4 * qd + 1] * hs, pk, false); pk = __builtin_amdgcn_cvt_pk_fp8_f32(h2[4 * qd + 2] * hs, h2[4 * qd + 3] * hs, pk, true); w[qd] = (unsigned)pk; }
              *(LAS v4u*)(hq + l16) = w; }
            LDS_WAIT(); asm volatile("" ::: "memory");
            v4u hb[16];
#pragma unroll
            for (int c = 0; c < 16; ++c) hb[c] = *(const LAS v4u*)(hq + 64 * c + 16 * lq);
            asm volatile("s_waitcnt vmcnt(0)" ::: "memory");
            float w_lo = 0.f, w_hi = 0.f;
#pragma unroll 1
            for (int u = 0; u < 16; ++u) {
                { const int un = (u + 1) & 15; const int ensel = un < 8 ? e_lo : e_hi; const int nb = (un & 7) * 8; LAS unsigned char* dst = ring + ((u + 1) & 1) * U6_BUF;
#pragma unroll
                  for (int j = 0; j < 8; ++j) { const int e = __builtin_amdgcn_readlane(ensel, nb + j);
                      __builtin_amdgcn_global_load_lds((const unsigned*)(EU + ((unsigned)e * 1024u + l16)), (LAS unsigned*)(dst + j * U6_ROWP), 16, 0, 0); } }
                asm volatile("s_waitcnt vmcnt(8)" ::: "memory");
                const LAS unsigned char* src = ring + (u & 1) * U6_BUF + (li & 7) * U6_ROWP + 16 * lq;
                f32x4 acc = (f32x4){0.f, 0.f, 0.f, 0.f};
#ifdef HALF_READ
                v4u av[16];
#pragma unroll
                for (int c = 0; c < 16; ++c) asm volatile("" : "=v"(av[c]));
                if (li < 8) {
#pragma unroll
                    for (int c = 0; c < 16; ++c) av[c] = *(const LAS v4u*)(src + 64 * c); }
#pragma unroll
                for (int c = 0; c < 16; ++c) { const v4u a = av[c];
#else
#pragma unroll
                for (int c = 0; c < 16; ++c) { const v4u a = *(const LAS v4u*)(src + 64 * c);
#endif
                    acc = __builtin_amdgcn_mfma_f32_16x16x32_fp8_fp8((i64_t)(((unsigned long long)a[1] << 32) | a[0]), (i64_t)(((unsigned long long)hb[c][1] << 32) | hb[c][0]), acc, 0, 0, 0);
                    acc = __builtin_amdgcn_mfma_f32_16x16x32_fp8_fp8((i64_t)(((unsigned long long)a[3] << 32) | a[2]), (i64_t)(((unsigned long long)hb[c][3] << 32) | hb[c][2]), acc, 0, 0, 0); }
                const int base = (u & 7) * 8; const int r = li & 3;
                const float sel = r == 0 ? acc[0] : (r == 1 ? acc[1] : (r == 2 ? acc[2] : acc[3]));
                const float dmine = __shfl(sel, ((lane & 7) >> 2) * 16 + (lane & 3));
                const float gsel = u < 8 ? g_lo : g_hi, susel = u < 8 ? su_lo : su_hi, svsel = u < 8 ? sv_lo : sv_hi;
                const float wv = gsel * gelu_erf(dmine * susel * hinv) * svsel;
                const bool mine = (lane >= base) && (lane < base + 8);
                if (u < 8) w_lo = mine ? wv : w_lo; else w_hi = mine ? wv : w_hi;
                asm volatile("s_waitcnt lgkmcnt(0)" ::: "memory");
            }
            WSP(float, WS_GATE)[t * 128 + lane] = w_lo; WSP(float, WS_GATE)[t * 128 + 64 + lane] = w_hi;
        }
    }
}
struct U10Meta { int elo, ehi; float glo, ghi; v4u xa, xb; float rst; };
__device__ __forceinline__ void u10_meta_load(U10Meta& M, const unsigned char* ws, size_t t, unsigned l16) {
    const unsigned l = l16 >> 4; const int* ep = (const int*)(ws + WS_EID) + t * 128; const float* gp = (const float*)(ws + WS_GATE) + t * 128;
    M.elo = ep[l]; M.ehi = ep[64 + l]; M.glo = gp[l]; M.ghi = gp[64 + l];
    const char* xs = (const char*)(ws + WS_X1S) + t * 2048 + 2u * l16; M.xa = *(const v4u*)xs; M.xb = *(const v4u*)(xs + 16);
    M.rst = ((const float*)(ws + WS_ROWSTAT))[t + (l16 >> 30)];
}
__device__ __forceinline__ void u10_meta_touch(U10Meta& M) { asm volatile("" : "+v"(M.elo), "+v"(M.ehi), "+v"(M.glo), "+v"(M.ghi), "+v"(M.xa), "+v"(M.xb), "+v"(M.rst)); }
template <int UN> __device__ __forceinline__ void u10_unit_dma(int elo, int ehi, const unsigned char* EU, unsigned l16, LAS unsigned char* dst) {
    const int ensel = UN < 8 ? elo : ehi; constexpr int nb = (UN & 7) * 8;
#pragma unroll
    for (int j = 0; j < 8; ++j) { const int e = __builtin_amdgcn_readlane(ensel, nb + j);
        __builtin_amdgcn_global_load_lds((const unsigned*)(EU + ((unsigned)e * 1024u + l16)), (LAS unsigned*)(dst + j * U6_ROWP), 16, 0, 0); }
}
__device__ __forceinline__ void u10_h2(const U10Meta& M, const float* S2, LAS unsigned char* hq, unsigned l16, int lq, v4u* hb, float& hinv) {
    float h2[16]; unpack8(M.xa, h2); unpack8(M.xb, h2 + 8); float mx = 0.f;
    const float rs = rsqrt_f(M.rst * (1.0f / 1024.0f) + EPSF);
#pragma unroll
    for (int i = 0; i < 16; ++i) { h2[i] = h2[i] * rs + S2[i]; mx = fmaxf(mx, fabsf(h2[i])); }
#pragma unroll
    for (int o = 1; o < 64; o <<= 1) mx = fmaxf(mx, __shfl_xor(mx, o));
    mx = fmaxf(mx, 1e-30f); const float hs = 224.0f / mx; hinv = mx * (1.0f / 224.0f);
    v4u w;
#pragma unroll
    for (int qd = 0; qd < 4; ++qd) { int pk = 0; pk = __builtin_amdgcn_cvt_pk_fp8_f32(h2[4 * qd] * hs, h2[4 * qd + 1] * hs, pk, false); pk = __builtin_amdgcn_cvt_pk_fp8_f32(h2[4 * qd + 2] * hs, h2[4 * qd + 3] * hs, pk, true); w[qd] = (unsigned)pk; }
    *(LAS v4u*)(hq + l16) = w;
    LDS_WAIT(); asm volatile("" ::: "memory");
#pragma unroll
    for (int c = 0; c < 16; ++c) hb[c] = *(const LAS v4u*)(hq + 64 * c + 16 * lq);
    LDS_WAIT(); asm volatile("" ::: "memory");
}
template <int U> __device__ __forceinline__ void u10_unit(const U10Meta& C, U10Meta& N, const unsigned char* EU, const unsigned char* ws, unsigned l16, LAS unsigned char* ring, const v4u* hb, float hinv,
                                                          float su_lo, float su_hi, float sv_lo, float sv_hi, float& nsu_lo, float& nsu_hi, float& nsv_lo, float& nsv_hi,
                                                          float& w_lo, float& w_hi, size_t tn, bool first_token, int lane) {
    const int li = lane & 15, lq = lane >> 4;
    if (U == 15) u10_unit_dma<0>(N.elo, N.ehi, EU, l16, ring); else u10_unit_dma<(U + 1) & 15>(C.elo, C.ehi, EU, l16, ring + ((U + 1) & 1) * U6_BUF);
    __builtin_amdgcn_sched_barrier(0);
    if (U == 0) { if (first_token) asm volatile("s_waitcnt vmcnt(8)" ::: "memory"); else asm volatile("s_waitcnt vmcnt(10)" ::: "memory"); }
    else if (U == 3) asm volatile("s_waitcnt vmcnt(15)" ::: "memory");
    else if (U == 11) asm volatile("s_waitcnt vmcnt(12)" ::: "memory");
    else asm volatile("s_waitcnt vmcnt(8)" ::: "memory");
    if (U == 4) u10_meta_touch(N);
    if (U == 12) asm volatile("" : "+v"(nsu_lo), "+v"(nsu_hi), "+v"(nsv_lo), "+v"(nsv_hi));
    __builtin_amdgcn_sched_barrier(0);
    const LAS unsigned char* src = ring + (U & 1) * U6_BUF + (li & 7) * U6_ROWP + 16 * lq;
    f32x4 acc = (f32x4){0.f, 0.f, 0.f, 0.f};
#pragma unroll
    for (int c = 0; c < 16; ++c) { const v4u a = *(const LAS v4u*)(src + 64 * c);
        acc = __builtin_amdgcn_mfma_f32_16x16x32_fp8_fp8((i64_t)(((unsigned long long)a[1] << 32) | a[0]), (i64_t)(((unsigned long long)hb[c][1] << 32) | hb[c][0]), acc, 0, 0, 0);
        acc = __builtin_amdgcn_mfma_f32_16x16x32_fp8_fp8((i64_t)(((unsigned long long)a[3] << 32) | a[2]), (i64_t)(((unsigned long long)hb[c][3] << 32) | hb[c][2]), acc, 0, 0, 0); }
    constexpr int base = (U & 7) * 8; const int r = li & 3;
    const float sel = r == 0 ? acc[0] : (r == 1 ? acc[1] : (r == 2 ? acc[2] : acc[3]));
    const float dmine = __shfl(sel, ((lane & 7) >> 2) * 16 + (lane & 3));
    const float gsel = U < 8 ? C.glo : C.ghi, susel = U < 8 ? su_lo : su_hi, svsel = U < 8 ? sv_lo : sv_hi;
    const float wv = gsel * gelu_erf(dmine * susel * hinv) * svsel;
    const bool mine = (lane >= base) && (lane < base + 8);
    if (U < 8) w_lo = mine ? wv : w_lo; else w_hi = mine ? wv : w_hi;
    asm volatile("s_waitcnt lgkmcnt(0)" ::: "memory");
    __builtin_amdgcn_sched_barrier(0);
    if (U == 2) { u10_meta_load(N, ws, tn, l16); __builtin_amdgcn_sched_barrier(0); }
    if (U == 10) { const float* EUS = (const float*)(ws + WS_EUS); const float* EVS = (const float*)(ws + WS_EVS); nsu_lo = EUS[N.elo]; nsu_hi = EUS[N.ehi]; nsv_lo = EVS[N.elo]; nsv_hi = EVS[N.ehi]; __builtin_amdgcn_sched_barrier(0); }
}
__device__ __forceinline__ void p8_peer_up10(Frame& F) {
    const int f_tid = threadIdx.x, lane = f_tid & 63, f_wave = __builtin_amdgcn_readfirstlane(f_tid >> 6);
    const int lq = lane >> 4;
    const unsigned char* EU = F.ws + WS_EU; const float* EUS = WSP(float, WS_EUS); const float* EVS = WSP(float, WS_EVS);
    LAS unsigned char* ring = F.lds + f_wave * U6_WAVE; LAS unsigned char* hq = ring + 2 * U6_BUF;
    for (int wq = F.vcu * NWAVES + f_wave; wq < MTOK / 16; wq += F.G * NWAVES) {
        const int b = wq >> 7; const float* mb = WSP(float, WS_MOD) + (size_t)b * 6144;
        unsigned l16 = 16u * (unsigned)lane; asm volatile("" : "+v"(l16));
        float S2[16];
#pragma unroll
        for (int q = 0; q < 4; ++q) { const f32x4 sh = *(const f32x4*)((const char*)(mb + 3072) + 4u * l16 + 16 * q); S2[4 * q] = sh[0]; S2[4 * q + 1] = sh[1]; S2[4 * q + 2] = sh[2]; S2[4 * q + 3] = sh[3]; }
        const size_t t0 = (size_t)wq * 16;
        U10Meta C, N;
        u10_meta_load(C, F.ws, t0, l16);
        asm volatile("s_waitcnt vmcnt(0)" ::: "memory");
        u10_meta_touch(C);
        u10_unit_dma<0>(C.elo, C.ehi, EU, l16, ring);
        float su_lo = EUS[C.elo], su_hi = EUS[C.ehi], sv_lo = EVS[C.elo], sv_hi = EVS[C.ehi];
        float nsu_lo = 0.f, nsu_hi = 0.f, nsv_lo = 0.f, nsv_hi = 0.f;
        v4u hb[16]; float hinv;
        u10_h2(C, S2, hq, l16, lq, hb, hinv);
        N = C;
        asm volatile("s_waitcnt vmcnt(0)" ::: "memory");
        asm volatile("" : "+v"(su_lo), "+v"(su_hi), "+v"(sv_lo), "+v"(sv_hi));
#pragma unroll 1
        for (int tt = 0; tt < 16; ++tt) {
            float w_lo = 0.f, w_hi = 0.f;
            const size_t tn = t0 + (tt < 15 ? tt + 1 : tt);
            const bool ft = (tt == 0);
#define U10_U(U) u10_unit<U>(C, N, EU, F.ws, l16, ring, hb, hinv, su_lo, su_hi, sv_lo, sv_hi, nsu_lo, nsu_hi, nsv_lo, nsv_hi, w_lo, w_hi, tn, ft, lane);
            U10_U(0) U10_U(1) U10_U(2) U10_U(3) U10_U(4) U10_U(5) U10_U(6) U10_U(7) U10_U(8) U10_U(9) U10_U(10) U10_U(11) U10_U(12) U10_U(13) U10_U(14) U10_U(15)
#undef U10_U
            WSP(float, WS_GATE)[(t0 + tt) * 128 + lane] = w_lo; WSP(float, WS_GATE)[(t0 + tt) * 128 + 64 + lane] = w_hi;
            __builtin_amdgcn_sched_barrier(0);
            C = N; su_lo = nsu_lo; su_hi = nsu_hi; sv_lo = nsv_lo; sv_hi = nsv_hi;
            u10_h2(C, S2, hq, l16, lq, hb, hinv);
        }
        asm volatile("s_waitcnt vmcnt(0)" ::: "memory");
    }
}
#ifndef U11_AUX
#define U11_AUX 0
#endif
constexpr int U11_HQ = 2 * U6_BUF, U11_IDS = U11_HQ + 1024, U11_GATES = U11_IDS + 512, U11_SC = U11_GATES + 512, U11_HINV = U11_SC + 1024, U11_WAVE = U11_HINV + 256;
static_assert(8 * U11_WAVE <= LDS_MAIN, "U11 LDS map");
__device__ __forceinline__ void u11_dma4(const void* g, LAS unsigned char* l) { __builtin_amdgcn_global_load_lds((const unsigned*)g, (LAS unsigned*)l, 4, 0, 0); }
__device__ __forceinline__ void u11_stage1(const unsigned char* ws, size_t t, unsigned l16, LAS unsigned char* W) {
    const unsigned l4 = l16 >> 2;
    const unsigned char* ep = ws + WS_EID + t * 512; const unsigned char* gp = ws + WS_GATE + t * 512;
    u11_dma4(ep + l4, W + U11_IDS); u11_dma4(ep + 256 + l4, W + U11_IDS + 256);
    u11_dma4(gp + l4, W + U11_GATES); u11_dma4(gp + 256 + l4, W + U11_GATES + 256);
    __builtin_amdgcn_global_load_lds((const unsigned*)(ws + WS_H2Q + t * 1024 + l16), (LAS unsigned*)(W + U11_HQ), 16, 0, 0);
    u11_dma4(ws + WS_HINV + t * 4 + (l16 >> 30), W + U11_HINV);
}
__device__ __forceinline__ void u11_stage2(const unsigned char* ws, int elo, int ehi, LAS unsigned char* W) {
    u11_dma4(ws + WS_EUS + 4u * (unsigned)elo, W + U11_SC); u11_dma4(ws + WS_EUS + 4u * (unsigned)ehi, W + U11_SC + 256);
    u11_dma4(ws + WS_EVS + 4u * (unsigned)elo, W + U11_SC + 512); u11_dma4(ws + WS_EVS + 4u * (unsigned)ehi, W + U11_SC + 768);
}
template <int UN> __device__ __forceinline__ void u11_unit_dma(int elo, int ehi, const unsigned char* EU, unsigned l16, LAS unsigned char* dst) {
    const int ensel = UN < 8 ? elo : ehi; constexpr int nb = (UN & 7) * 8;
#pragma unroll
    for (int j = 0; j < 8; ++j) { const int e = __builtin_amdgcn_readlane(ensel, nb + j);
        __builtin_amdgcn_global_load_lds((const unsigned*)(EU + ((unsigned)e * 1024u + l16)), (LAS unsigned*)(dst + j * U6_ROWP), 16, 0, U11_AUX); }
}
struct U11Tok { int elo, ehi; float glo, ghi, su_lo, su_hi, sv_lo, sv_hi, hinv; };
__device__ __forceinline__ void u11_switch(U11Tok& C, int nelo, int nehi, LAS unsigned char* W, unsigned l16, int lq, v4u* hb) {
    const unsigned l4 = l16 >> 2;
    C.elo = nelo; C.ehi = nehi;
    C.glo = *(const LAS float*)(W + U11_GATES + l4); C.ghi = *(const LAS float*)(W + U11_GATES + 256 + l4);
    C.su_lo = *(const LAS float*)(W + U11_SC + l4); C.su_hi = *(const LAS float*)(W + U11_SC + 256 + l4); C.sv_lo = *(const LAS float*)(W + U11_SC + 512 + l4); C.sv_hi = *(const LAS float*)(W + U11_SC + 768 + l4);
    C.hinv = *(const LAS float*)(W + U11_HINV + l4);
#pragma unroll
    for (int c = 0; c < 16; ++c) hb[c] = *(const LAS v4u*)(W + U11_HQ + 64 * c + 16 * lq);
    LDS_WAIT(); asm volatile("" ::: "memory");
}
template <int U> __device__ __forceinline__ void u11_unit(const U11Tok& C, int& nelo, int& nehi, const unsigned char* EU, const unsigned char* ws, unsigned l16, LAS unsigned char* W, const v4u* hb,
                                                          float& w_lo, float& w_hi, size_t tn, bool first_token, int lane) {
    const int li = lane & 15, lq = lane >> 4;
    if (U == 15) u11_unit_dma<0>(nelo, nehi, EU, l16, W); else u11_unit_dma<(U + 1) & 15>(C.elo, C.ehi, EU, l16, W + ((U + 1) & 1) * U6_BUF);
    __builtin_amdgcn_sched_barrier(0);
    if (U == 0) { if (first_token) asm volatile("s_waitcnt vmcnt(8)" ::: "memory"); else asm volatile("s_waitcnt vmcnt(10)" ::: "memory"); }
    else if (U == 3) asm volatile("s_waitcnt vmcnt(14)" ::: "memory");
    else if (U == 5) asm volatile("s_waitcnt vmcnt(12)" ::: "memory");
    else asm volatile("s_waitcnt vmcnt(8)" ::: "memory");
    __builtin_amdgcn_sched_barrier(0);
    const LAS unsigned char* src = W + (U & 1) * U6_BUF + (li & 7) * U6_ROWP + 16 * lq;
    f32x4 acc = (f32x4){0.f, 0.f, 0.f, 0.f};
#pragma unroll
    for (int c = 0; c < 16; ++c) { const v4u a = *(const LAS v4u*)(src + 64 * c);
        acc = __builtin_amdgcn_mfma_f32_16x16x32_fp8_fp8((i64_t)(((unsigned long long)a[1] << 32) | a[0]), (i64_t)(((unsigned long long)hb[c][1] << 32) | hb[c][0]), acc, 0, 0, 0);
        acc = __builtin_amdgcn_mfma_f32_16x16x32_fp8_fp8((i64_t)(((unsigned long long)a[3] << 32) | a[2]), (i64_t)(((unsigned long long)hb[c][3] << 32) | hb[c][2]), acc, 0, 0, 0); }
    constexpr int base = (U & 7) * 8; const int r = li & 3;
    const float sel = r == 0 ? acc[0] : (r == 1 ? acc[1] : (r == 2 ? acc[2] : acc[3]));
    const float dmine = __shfl(sel, ((lane & 7) >> 2) * 16 + (lane & 3));
    const float gsel = U < 8 ? C.glo : C.ghi, susel = U < 8 ? C.su_lo : C.su_hi, svsel = U < 8 ? C.sv_lo : C.sv_hi;
    const float wv = gsel * gelu_erf(dmine * susel * C.hinv) * svsel;
    const bool mine = (lane >= base) && (lane < base + 8);
    if (U < 8) w_lo = mine ? wv : w_lo; else w_hi = mine ? wv : w_hi;
    if (U == 4) { nelo = *(const LAS int*)(W + U11_IDS + (l16 >> 2)); nehi = *(const LAS int*)(W + U11_IDS + 256 + (l16 >> 2)); }
    asm volatile("s_waitcnt lgkmcnt(0)" ::: "memory");
    __builtin_amdgcn_sched_barrier(0);
    if (U == 2) { u11_stage1(ws, tn, l16, W); __builtin_amdgcn_sched_barrier(0); }
    if (U == 4) { u11_stage2(ws, nelo, nehi, W); __builtin_amdgcn_sched_barrier(0); }
}
__device__ __forceinline__ void p8_peer_up11(Frame& F) {
    const int f_tid = threadIdx.x, lane = f_tid & 63, f_wave = __builtin_amdgcn_readfirstlane(f_tid >> 6);
    const int lq = lane >> 4;
    const unsigned char* EU = F.ws + WS_EU;
    LAS unsigned char* W = F.lds + f_wave * U11_WAVE;
    for (int wq = F.vcu * NWAVES + f_wave; wq < MTOK / 16; wq += F.G * NWAVES) {
        unsigned l16 = 16u * (unsigned)lane; asm volatile("" : "+v"(l16));
        const size_t t0 = (size_t)wq * 16;
        u11_stage1(F.ws, t0, l16, W);
        asm volatile("s_waitcnt vmcnt(0)" ::: "memory");
        int nelo = *(const LAS int*)(W + U11_IDS + (l16 >> 2)), nehi = *(const LAS int*)(W + U11_IDS + 256 + (l16 >> 2));
        LDS_WAIT(); asm volatile("" ::: "memory");
        u11_stage2(F.ws, nelo, nehi, W);
        u11_unit_dma<0>(nelo, nehi, EU, l16, W);
        asm volatile("s_waitcnt vmcnt(0)" ::: "memory");
        U11Tok C; v4u hb[16];
        u11_switch(C, nelo, nehi, W, l16, lq, hb);
#pragma unroll 1
        for (int tt = 0; tt < 16; ++tt) {
            float w_lo = 0.f, w_hi = 0.f;
            const size_t tn = t0 + (tt < 15 ? tt + 1 : tt);
            const bool ft = (tt == 0);
#define U11_U(U) u11_unit<U>(C, nelo, nehi, EU, F.ws, l16, W, hb, w_lo, w_hi, tn, ft, lane);
            U11_U(0) U11_U(1) U11_U(2) U11_U(3) U11_U(4) U11_U(5) U11_U(6) U11_U(7) U11_U(8) U11_U(9) U11_U(10) U11_U(11) U11_U(12) U11_U(13) U11_U(14) U11_U(15)
#undef U11_U
            WSP(float, WS_GATE)[(t0 + tt) * 128 + lane] = w_lo; WSP(float, WS_GATE)[(t0 + tt) * 128 + 64 + lane] = w_hi;
            __builtin_amdgcn_sched_barrier(0);
            u11_switch(C, nelo, nehi, W, l16, lq, hb);
        }
        asm volatile("s_waitcnt vmcnt(0)" ::: "memory");
    }
}
typedef unsigned v3u __attribute__((ext_vector_type(3)));
typedef unsigned v6u __attribute__((ext_vector_type(6)));
typedef float f32x32 __attribute__((ext_vector_type(32)));
struct __attribute__((packed, aligned(4))) U3 { unsigned a, b, c; };
__device__ __forceinline__ v3u ld_row6(const unsigned char* p) { const U3 u = *(const U3*)p; return (v3u){u.a, u.b, u.c}; }
__device__ __forceinline__ void p9_peer_down3(Frame& F) {
    const int f_tid = threadIdx.x, lane = f_tid & 63, f_wave = __builtin_amdgcn_readfirstlane(f_tid >> 6);
    const unsigned char* EV = F.ws + WS_EV;
    for (int wq = F.vcu * NWAVES + f_wave; wq < MTOK / 16; wq += F.G * NWAVES) {
        const int b = wq >> 7; const float* mb = WSP(float, WS_MOD) + (size_t)b * 6144;
        unsigned l16 = 16u * (unsigned)lane; asm volatile("" : "+v"(l16));
        const unsigned l12 = (l16 >> 2) * 3u;
        int ne_lo = WSP(int, WS_EID)[(size_t)wq * 16 * 128 + lane], ne_hi = WSP(int, WS_EID)[(size_t)wq * 16 * 128 + 64 + lane];
        float nw_lo = WSP(float, WS_GATE)[(size_t)wq * 16 * 128 + lane], nw_hi = WSP(float, WS_GATE)[(size_t)wq * 16 * 128 + 64 + lane];
        v3u qa[8], qb[8];
#pragma unroll
        for (int j = 0; j < 8; ++j) { const int e = __builtin_amdgcn_readlane(ne_lo, j); qa[j] = ld_row6(EV + ((unsigned)e * 768u + l12)); }
#pragma unroll 1
        for (int tt = 0; tt < 16; ++tt) {
            const size_t t = (size_t)wq * 16 + tt;
            float* xr = (float*)((char*)(F.out + t * 1024) + 4u * l16);
            const int e_lo = ne_lo, e_hi = ne_hi; const float w_lo = nw_lo, w_hi = nw_hi;
            { const size_t tn = t + (tt < 15 ? 1 : 0); ne_lo = WSP(int, WS_EID)[tn * 128 + lane]; ne_hi = WSP(int, WS_EID)[tn * 128 + 64 + lane]; nw_lo = WSP(float, WS_GATE)[tn * 128 + lane]; nw_hi = WSP(float, WS_GATE)[tn * 128 + 64 + lane]; }
            f32x2 o[8];
#pragma unroll
            for (int i = 0; i < 8; ++i) o[i] = (f32x2){0.f, 0.f};
#define DN3_STEP(GRP, CUR, NXT, NIDS, NB) { \
                const int grp = (GRP); \
                { const int nids = (NIDS); _Pragma("unroll") for (int j = 0; j < 8; ++j) { const int e = __builtin_amdgcn_readlane(nids, (NB) + j); NXT[j] = ld_row6(EV + ((unsigned)e * 768u + l12)); } } \
                __builtin_amdgcn_sched_barrier(0); \
                const int base = (grp & 7) * 8; const float wsel = grp < 8 ? w_lo : w_hi; \
                _Pragma("unroll") for (int j = 0; j < 8; j += 2) { \
                    const float wa = __builtin_bit_cast(float, __builtin_amdgcn_readlane(__builtin_bit_cast(int, wsel), base + j)), wb = __builtin_bit_cast(float, __builtin_amdgcn_readlane(__builtin_bit_cast(int, wsel), base + j + 1)); \
                    const f32x2 wa2 = (f32x2){wa, wa}, wb2 = (f32x2){wb, wb}; \
                    const v6u pr = (v6u){CUR[j][0], CUR[j][1], CUR[j][2], CUR[j + 1][0], CUR[j + 1][1], CUR[j + 1][2]}; \
                    const f32x32 r = __builtin_amdgcn_cvt_scalef32_pk32_f32_fp6(pr, 1.0f); \
                    _Pragma("unroll") for (int i = 0; i < 8; ++i) { o[i] += wa2 * (f32x2){r[2 * i], r[2 * i + 1]}; o[i] += wb2 * (f32x2){r[16 + 2 * i], r[17 + 2 * i]}; } } }
#pragma unroll 1
            for (int g2 = 0; g2 < 14; g2 += 2) { const int ga = g2 + 1, gb = g2 + 2;
                DN3_STEP(g2, qa, qb, ga < 8 ? e_lo : e_hi, (ga & 7) * 8)
                DN3_STEP(g2 + 1, qb, qa, gb < 8 ? e_lo : e_hi, (gb & 7) * 8) }
            DN3_STEP(14, qa, qb, e_hi, 56)
            DN3_STEP(15, qb, qa, ne_lo, 0)
#undef DN3_STEP
            float x1[16]; float ss = 0.f;
#ifdef X1B
            { const char* xb = (const char*)(F.ws + WS_X1B + t * 2048) + 2u * l16; const v4u xa = *(const v4u*)xb, xc = *(const v4u*)(xb + 16); unpack8(xa, x1); unpack8(xc, x1 + 8); }
#else
#pragma unroll
            for (int q4 = 0; q4 < 4; ++q4) { const f32x4 v = *(const f32x4*)(xr + 4 * q4); x1[4 * q4] = v[0]; x1[4 * q4 + 1] = v[1]; x1[4 * q4 + 2] = v[2]; x1[4 * q4 + 3] = v[3]; }
#endif
#pragma unroll
            for (int q4 = 0; q4 < 4; ++q4) { const f32x4 gt = *(const f32x4*)((const char*)(mb + 5120) + 4u * l16 + 16 * q4);
#pragma unroll
                for (int e = 0; e < 4; ++e) { const int i = 4 * q4 + e; x1[i] += gt[e] * o[i >> 1][i & 1]; ss += x1[i] * x1[i]; } }
            const float rf = rsqrt_f(wave_sum(ss) * (1.0f / 1024.0f) + EPSF);
#pragma unroll
            for (int q4 = 0; q4 < 4; ++q4) { const f32x4 nf = *(const f32x4*)((const char*)(F.a->in[29]) + 4u * l16 + 16 * q4); f32x4 v;
#pragma unroll
                for (int e = 0; e < 4; ++e) v[e] = x1[4 * q4 + e] * rf * nf[e];
                *(f32x4*)(xr + 4 * q4) = v; }
        }
    }
}
constexpr int U12_ROWP = 784, U12_NBUF = 3, U12_BUF = 8 * U12_ROWP, U12_WAVE = U12_NBUF * U12_BUF + 1024;
static_assert(8 * U12_WAVE <= LDS_MAIN, "U12 LDS map");
typedef int i32x8 __attribute__((ext_vector_type(8)));
typedef unsigned v2u __attribute__((ext_vector_type(2)));
__device__ __forceinline__ void p8_peer_up12(Frame& F) {
    const int f_tid = threadIdx.x, lane = f_tid & 63, f_wave = __builtin_amdgcn_readfirstlane(f_tid >> 6);
    const int li = lane & 15, lq = lane >> 4;
    const unsigned char* EU = F.ws + WS_EU; const float* EUS = WSP(float, WS_EUS); const float* EVS = WSP(float, WS_EVS);
    LAS unsigned char* ring = F.lds + f_wave * U12_WAVE; LAS unsigned char* hq = ring + U12_NBUF * U12_BUF;
#ifdef PROBE_MFMA
    if (blockIdx.x == 0 && f_wave == 0) {
        i32x8 A = (i32x8){0, 0, 0, 0, 0, 0, 0, 0}; if (lane == PROBE_ALANE) A[PROBE_AREG] = PROBE_AVAL;
        i32x8 B;
        if (PROBE_BPAT == 0) B = (i32x8){0x48444038, 0x504E4C4A, 0x54535251, 0x58575655, 0x48444038, 0x504E4C4A, 0x54535251, 0x58575655};
        else { const unsigned c0 = (const unsigned[]){0x38u, 0x40u, 0x44u, 0x48u, 0x4Au, 0x4Cu, 0x4Eu, 0x50u}[0]; (void)c0;
               const int k = lane >> 4; const unsigned lo = k == 0 ? 0x38u : (k == 1 ? 0x44u : (k == 2 ? 0x4Au : 0x4Eu)), hi = k == 0 ? 0x40u : (k == 1 ? 0x48u : (k == 2 ? 0x4Cu : 0x50u));
               const int wl = (int)(lo * 0x01010101u), wh = (int)(hi * 0x01010101u); B = (i32x8){wl, wl, wl, wl, wh, wh, wh, wh}; }
        f32x4 acc = (f32x4){0.f, 0.f, 0.f, 0.f};
        acc = __builtin_amdgcn_mfma_scale_f32_16x16x128_f8f6f4(A, B, acc, 2, 0, 0, 0, 0, 0);
        if (lane == 0) *(volatile float*)(F.ws + WS_CTL + 40000) = acc[0] * 100.0f;
    }
#endif
    for (int wq = F.vcu * NWAVES + f_wave; wq < MTOK / 16; wq += F.G * NWAVES) {
        const int b = wq >> 7; const float* mb = WSP(float, WS_MOD) + (size_t)b * 6144;
        for (int tt = 0; tt < 16; ++tt) {
            const size_t t = (size_t)wq * 16 + tt;
            unsigned l16 = 16u * (unsigned)lane; asm volatile("" : "+v"(l16));
            const int e_lo = WSP(int, WS_EID)[t * 128 + lane], e_hi = WSP(int, WS_EID)[t * 128 + 64 + lane];
            const float g_lo = WSP(float, WS_GATE)[t * 128 + lane], g_hi = WSP(float, WS_GATE)[t * 128 + 64 + lane];
            const float rs = rsqrt_f(WSP(float, WS_ROWSTAT)[t] * (1.0f / 1024.0f) + EPSF);
            const char* xs = (const char*)(WSP(bf16, WS_X1S) + t * 1024) + 2u * l16; const v4u xa = *(const v4u*)xs, xb = *(const v4u*)(xs + 16);
            asm volatile("s_waitcnt vmcnt(0)" ::: "memory");
            if (lane < 48) {
#pragma unroll
            for (int j = 0; j < 16; ++j) { const int e = __builtin_amdgcn_readlane(e_lo, j);
                __builtin_amdgcn_global_load_lds((const unsigned*)(EU + ((unsigned)e * 768u + l16)), (LAS unsigned*)(ring + j * U12_ROWP), 16, 0, 0); } }
            const float su_lo = EUS[e_lo], su_hi = EUS[e_hi], sv_lo = EVS[e_lo], sv_hi = EVS[e_hi];
            float h2[16]; unpack8(xa, h2); unpack8(xb, h2 + 8); float mx = 0.f;
#pragma unroll
            for (int qd = 0; qd < 4; ++qd) { const f32x4 sh = *(const f32x4*)((const char*)(mb + 3072) + 4u * l16 + 16 * qd);
#pragma unroll
                for (int e = 0; e < 4; ++e) { h2[4 * qd + e] = h2[4 * qd + e] * rs + sh[e]; mx = fmaxf(mx, fabsf(h2[4 * qd + e])); } }
#pragma unroll
            for (int o = 1; o < 64; o <<= 1) mx = fmaxf(mx, __shfl_xor(mx, o));
            mx = fmaxf(mx, 1e-30f); const float hs = 224.0f / mx, hinv = mx * (1.0f / 224.0f);
            { v4u w;
#pragma unroll
              for (int qd = 0; qd < 4; ++qd) { int pk = 0; pk = __builtin_amdgcn_cvt_pk_fp8_f32(h2[4 * qd] * hs, h2[4 * qd + 1] * hs, pk, false); pk = __builtin_amdgcn_cvt_pk_fp8_f32(h2[4 * qd + 2] * hs, h2[4 * qd + 3] * hs, pk, true); w[qd] = (unsigned)pk; }
              *(LAS v4u*)(hq + l16) = w; }
            LDS_WAIT(); asm volatile("" ::: "memory");
            v4u hb[8];
#pragma unroll
            for (int c = 0; c < 4; ++c) { hb[2 * c] = *(const LAS v4u*)(hq + (li & 1) * 512 + 128 * c + 16 * lq); hb[2 * c + 1] = *(const LAS v4u*)(hq + (li & 1) * 512 + 128 * c + 64 + 16 * lq); }
            asm volatile("s_waitcnt vmcnt(0)" ::: "memory");
            float w_lo = 0.f, w_hi = 0.f;
            int cur = 0, nx2 = 2 * U12_BUF;
#pragma unroll 1
            for (int u = 0; u < 16; ++u) {
                if (u < 14) { const int un = u + 2; int ensel = un < 8 ? e_lo : e_hi; asm volatile("" : "+v"(ensel));     const int nb = (un & 7) * 8; LAS unsigned char* dst = ring + nx2;
                  if (lane < 48) {
#pragma unroll
                  for (int j = 0; j < 8; ++j) { const int e = __builtin_amdgcn_readlane(ensel, nb + j);
                      __builtin_amdgcn_global_load_lds((const unsigned*)(EU + ((unsigned)e * 768u + l16)), (LAS unsigned*)(dst + j * U12_ROWP), 16, 0, 0); } }
                  asm volatile("s_waitcnt vmcnt(16)" ::: "memory"); }
                else if (u == 14) asm volatile("s_waitcnt vmcnt(8)" ::: "memory");
                else asm volatile("s_waitcnt vmcnt(0)" ::: "memory");
                const LAS unsigned char* src = ring + cur + (li & 7) * U12_ROWP + (li >> 3) * 384 + 24 * lq;
                f32x4 acc = (f32x4){0.f, 0.f, 0.f, 0.f};
#pragma unroll
                for (int c = 0; c < 4; ++c) { const v2u a0 = *(const LAS v2u*)(src + 96 * c), a1 = *(const LAS v2u*)(src + 96 * c + 8), a2 = *(const LAS v2u*)(src + 96 * c + 16);
                    const i32x8 A = (i32x8){(int)a0[0], (int)a0[1], (int)a1[0], (int)a1[1], (int)a2[0], (int)a2[1], 0, 0};
                    const i32x8 B = (i32x8){(int)hb[2 * c][0], (int)hb[2 * c][1], (int)hb[2 * c][2], (int)hb[2 * c][3], (int)hb[2 * c + 1][0], (int)hb[2 * c + 1][1], (int)hb[2 * c + 1][2], (int)hb[2 * c + 1][3]};
                    acc = __builtin_amdgcn_mfma_scale_f32_16x16x128_f8f6f4(A, B, acc, 2, 0, 0, 0, 0, 0); }
                const int base = (u & 7) * 8; const int r = (li >> 1) & 3;
                const float sel = r == 0 ? acc[0] : (r == 1 ? acc[1] : (r == 2 ? acc[2] : acc[3]));
                const int sl = ((lane & 7) >> 2) * 16 + 2 * (lane & 3);
                const float dmine = __shfl(sel, sl) + __shfl(sel, sl + 33);
                const float gsel = u < 8 ? g_lo : g_hi, susel = u < 8 ? su_lo : su_hi, svsel = u < 8 ? sv_lo : sv_hi;
                const float wv = gsel * gelu_erf(dmine * susel * hinv) * svsel;
                const bool mine = (lane >= base) && (lane < base + 8);
                if (u < 8) w_lo = mine ? wv : w_lo; else w_hi = mine ? wv : w_hi;
                asm volatile("s_waitcnt lgkmcnt(0)" ::: "memory");
                cur = cur == 2 * U12_BUF ? 0 : cur + U12_BUF; nx2 = nx2 == 2 * U12_BUF ? 0 : nx2 + U12_BUF;
            }
            WSP(float, WS_GATE)[t * 128 + lane] = w_lo; WSP(float, WS_GATE)[t * 128 + 64 + lane] = w_hi;
        }
    }
}
constexpr int U14_ROWP = 1040, U14_BUF = 8 * U14_ROWP, U14_WAVE = 2 * U14_BUF + 1024;
static_assert(8 * U14_WAVE <= LDS_MAIN, "U14 LDS map");
struct U14Meta { int elo, ehi; float glo, ghi; v4u xa, xb; float rst; };
__device__ __forceinline__ void u14_meta_load(U14Meta& M, const unsigned char* ws, size_t t, unsigned l16) {
    const unsigned l = l16 >> 4; const int* ep = (const int*)(ws + WS_EID) + t * 128; const float* gp = (const float*)(ws + WS_GATE) + t * 128;
    M.elo = ep[l]; M.ehi = ep[64 + l]; M.glo = gp[l]; M.ghi = gp[64 + l];
    const char* xs = (const char*)(ws + WS_X1S) + t * 2048 + 2u * l16; M.xa = *(const v4u*)xs; M.xb = *(const v4u*)(xs + 16);
    M.rst = ((const float*)(ws + WS_ROWSTAT))[t];
}
__device__ __forceinline__ void u14_h2(const U14Meta& M, const float* S2, LAS unsigned char* hq, unsigned l16, int li, int lq, v4u* hb, float& hinv) {
    float h2[16]; unpack8(M.xa, h2); unpack8(M.xb, h2 + 8); float mx = 0.f;
    const float rs = rsqrt_f(M.rst * (1.0f / 1024.0f) + EPSF);
#pragma unroll
    for (int i = 0; i < 16; ++i) { h2[i] = h2[i] * rs + S2[i]; mx = fmaxf(mx, fabsf(h2[i])); }
#pragma unroll
    for (int o = 1; o < 64; o <<= 1) mx = fmaxf(mx, __shfl_xor(mx, o));
    mx = fmaxf(mx, 1e-30f); const float hs = 224.0f / mx; hinv = mx * (1.0f / 224.0f);
    v4u w;
#pragma unroll
    for (int qd = 0; qd < 4; ++qd) { int pk = 0; pk = __builtin_amdgcn_cvt_pk_fp8_f32(h2[4 * qd] * hs, h2[4 * qd + 1] * hs, pk, false); pk = __builtin_amdgcn_cvt_pk_fp8_f32(h2[4 * qd + 2] * hs, h2[4 * qd + 3] * hs, pk, true); w[qd] = (unsigned)pk; }
    *(LAS v4u*)(hq + l16) = w;
    LDS_WAIT(); asm volatile("" ::: "memory");
#pragma unroll
    for (int c = 0; c < 4; ++c) { hb[2 * c] = *(const LAS v4u*)(hq + (li & 1) * 512 + 128 * c + 16 * lq); hb[2 * c + 1] = *(const LAS v4u*)(hq + (li & 1) * 512 + 128 * c + 64 + 16 * lq); }
    LDS_WAIT(); asm volatile("" ::: "memory");
}
__device__ __forceinline__ void p8_peer_up14(Frame& F) {
    const int f_tid = threadIdx.x, lane = f_tid & 63, f_wave = __builtin_amdgcn_readfirstlane(f_tid >> 6);
    const int li = lane & 15, lq = lane >> 4;
    const unsigned char* EU = F.ws + WS_EU; const float* EUS = WSP(float, WS_EUS); const float* EVS = WSP(float, WS_EVS);
    LAS unsigned char* tile = F.lds + f_wave * U14_WAVE; LAS unsigned char* hq = tile + 2 * U14_BUF;
    for (int wq = F.vcu * NWAVES + f_wave; wq < MTOK / 16; wq += F.G * NWAVES) {
        const int b = wq >> 7; const float* mb = WSP(float, WS_MOD) + (size_t)b * 6144;
        unsigned l16 = 16u * (unsigned)lane; asm volatile("" : "+v"(l16));
        const unsigned rof = l16 < 768u ? l16 : l16 - 768u;
        float S2[16];
#pragma unroll
        for (int q = 0; q < 4; ++q) { const f32x4 sh = *(const f32x4*)((const char*)(mb + 3072) + 4u * l16 + 16 * q); S2[4 * q] = sh[0]; S2[4 * q + 1] = sh[1]; S2[4 * q + 2] = sh[2]; S2[4 * q + 3] = sh[3]; }
        const size_t t0 = (size_t)wq * 16;
        U14Meta N; u14_meta_load(N, F.ws, t0, l16);
        float nsu_lo = EUS[N.elo], nsu_hi = EUS[N.ehi], nsv_lo = EVS[N.elo], nsv_hi = EVS[N.ehi];
        v4u qa[8], qb[8];
#pragma unroll
        for (int j = 0; j < 8; ++j) { const int e = __builtin_amdgcn_readlane(N.elo, j); qa[j] = *(const v4u*)(EU + ((unsigned)e * 768u + rof)); }
#pragma unroll 1
        for (int tt = 0; tt < 16; ++tt) {
            const size_t t = t0 + tt;
            const int e_lo = N.elo, e_hi = N.ehi; const float g_lo = N.glo, g_hi = N.ghi, su_lo = nsu_lo, su_hi = nsu_hi, sv_lo = nsv_lo, sv_hi = nsv_hi;
            v4u hb[8]; float hinv;
            u14_h2(N, S2, hq, l16, li, lq, hb, hinv);
            u14_meta_load(N, F.ws, t + (tt < 15 ? 1 : 0), l16);
            float w_lo = 0.f, w_hi = 0.f;
#define U14_STEP(UU, CUR, NXT, NLO, NHI) { \
            const int u = (UU); const int un = (u + 1) & 15; const int nb = (un & 7) * 8; const int ensel = un < 8 ? (NLO) : (NHI); \
            { _Pragma("unroll") for (int j = 0; j < 8; ++j) { const int e = __builtin_amdgcn_readlane(ensel, nb + j); NXT[j] = *(const v4u*)(EU + ((unsigned)e * 768u + rof)); } } \
            __builtin_amdgcn_sched_barrier(0); \
            LAS unsigned char* tb = tile + (u & 1) * U14_BUF; \
            { _Pragma("unroll") for (int j = 0; j < 8; ++j) *(LAS v4u*)(tb + j * U14_ROWP + l16) = CUR[j]; } \
            LDS_WAIT(); asm volatile("" ::: "memory"); \
            const LAS unsigned char* src = tb + (li & 7) * U14_ROWP + (li >> 3) * 384 + 24 * lq; \
            f32x4 acc = (f32x4){0.f, 0.f, 0.f, 0.f}; \
            _Pragma("unroll") for (int c = 0; c < 4; ++c) { const v2u a0 = *(const LAS v2u*)(src + 96 * c), a1 = *(const LAS v2u*)(src + 96 * c + 8), a2 = *(const LAS v2u*)(src + 96 * c + 16); \
                const i32x8 A = (i32x8){(int)a0[0], (int)a0[1], (int)a1[0], (int)a1[1], (int)a2[0], (int)a2[1], 0, 0}; \
                const i32x8 B = (i32x8){(int)hb[2 * c][0], (int)hb[2 * c][1], (int)hb[2 * c][2], (int)hb[2 * c][3], (int)hb[2 * c + 1][0], (int)hb[2 * c + 1][1], (int)hb[2 * c + 1][2], (int)hb[2 * c + 1][3]}; \
                acc = __builtin_amdgcn_mfma_scale_f32_16x16x128_f8f6f4(A, B, acc, 2, 0, 0, 0, 0, 0); }        \
            const int base = (u & 7) * 8; const int r = (li >> 1) & 3; \
            const float sel = r == 0 ? acc[0] : (r == 1 ? acc[1] : (r == 2 ? acc[2] : acc[3])); \
            const int sl = ((lane & 7) >> 2) * 16 + 2 * (lane & 3);                          \
            const float dmine = __shfl(sel, sl) + __shfl(sel, sl + 33); \
            const float gsel = u < 8 ? g_lo : g_hi, susel = u < 8 ? su_lo : su_hi, svsel = u < 8 ? sv_lo : sv_hi; \
            const float wv = gsel * gelu_erf(dmine * susel * hinv) * svsel; \
            const bool mine = (lane >= base) && (lane < base + 8); \
            if (u < 8) w_lo = mine ? wv : w_lo; else w_hi = mine ? wv : w_hi; }
#pragma unroll 1
            for (int u2 = 0; u2 < 14; u2 += 2) { U14_STEP(u2, qa, qb, e_lo, e_hi) U14_STEP(u2 + 1, qb, qa, e_lo, e_hi) }
            U14_STEP(14, qa, qb, e_lo, e_hi)
            U14_STEP(15, qb, qa, N.elo, N.ehi)
#undef U14_STEP
            nsu_lo = EUS[N.elo]; nsu_hi = EUS[N.ehi]; nsv_lo = EVS[N.elo]; nsv_hi = EVS[N.ehi];
            __builtin_amdgcn_sched_barrier(0);
            WSP(float, WS_GATE)[t * 128 + lane] = w_lo; WSP(float, WS_GATE)[t * 128 + 64 + lane] = w_hi;
        }
    }
}
#ifdef TOPK2
#define P7FN p5b_topk2
#else
#define P7FN p5b_topk
#endif
constexpr int U16_ROWP = 1040, U16_BUF = 8 * U16_ROWP, U16_WAVE = 2 * U16_BUF + 1024;
static_assert(8 * U16_WAVE <= LDS_MAIN, "U16 LDS map");
struct U16A { v2u p[12]; };
__device__ __forceinline__ void u16_rows(v4u* R, int ids, int nb, const unsigned char* EU, unsigned rof) {
#pragma unroll
    for (int j = 0; j < 8; ++j) { const int e = __builtin_amdgcn_readlane(ids, nb + j); R[j] = *(const v4u*)(EU + ((unsigned)e * 768u + rof)); }
}
__device__ __forceinline__ void u16_write(const v4u* R, LAS unsigned char* tb, unsigned l16) {
#pragma unroll
    for (int j = 0; j < 8; ++j) *(LAS v4u*)(tb + j * U16_ROWP + l16) = R[j];
}
__device__ __forceinline__ void u16_read(U16A& A, const LAS unsigned char* tb, int li, int lq) {
    const LAS unsigned char* src = tb + (li & 7) * U16_ROWP + (li >> 3) * 384 + 24 * lq;
#pragma unroll
    for (int c = 0; c < 4; ++c) { A.p[3 * c] = *(const LAS v2u*)(src + 96 * c); A.p[3 * c + 1] = *(const LAS v2u*)(src + 96 * c + 8); A.p[3 * c + 2] = *(const LAS v2u*)(src + 96 * c + 16); }
}
__device__ __forceinline__ f32x4 u16_mma(const U16A& A, const v4u* hb) {
    f32x4 acc = (f32x4){0.f, 0.f, 0.f, 0.f};
#pragma unroll
    for (int c = 0; c < 4; ++c) {
        const i32x8 a = (i32x8){(int)A.p[3 * c][0], (int)A.p[3 * c][1], (int)A.p[3 * c + 1][0], (int)A.p[3 * c + 1][1], (int)A.p[3 * c + 2][0], (int)A.p[3 * c + 2][1], 0, 0};
        const i32x8 bb = (i32x8){(int)hb[2 * c][0], (int)hb[2 * c][1], (int)hb[2 * c][2], (int)hb[2 * c][3], (int)hb[2 * c + 1][0], (int)hb[2 * c + 1][1], (int)hb[2 * c + 1][2], (int)hb[2 * c + 1][3]};
        acc = __builtin_amdgcn_mfma_scale_f32_16x16x128_f8f6f4(a, bb, acc, 2, 0, 0, 0, 0, 0); }
    return acc;
}
__device__ __forceinline__ void p8_peer_up16(Frame& F) {
    const int f_tid = threadIdx.x, lane = f_tid & 63, f_wave = __builtin_amdgcn_readfirstlane(f_tid >> 6);
    const int li = lane & 15, lq = lane >> 4;
    const unsigned char* EU = F.ws + WS_EU; const float* EUS = WSP(float, WS_EUS); const float* EVS = WSP(float, WS_EVS);
    LAS unsigned char* tile = F.lds + f_wave * U16_WAVE; LAS unsigned char* hq = tile + 2 * U16_BUF;
    for (int wq = F.vcu * NWAVES + f_wave; wq < MTOK / 16; wq += F.G * NWAVES) {
        const int b = wq >> 7; const float* mb = WSP(float, WS_MOD) + (size_t)b * 6144;
        unsigned l16 = 16u * (unsigned)lane; asm volatile("" : "+v"(l16));
        const unsigned rof = l16 < 768u ? l16 : l16 - 768u;
        float S2[16];
#pragma unroll
        for (int q = 0; q < 4; ++q) { const f32x4 sh = *(const f32x4*)((const char*)(mb + 3072) + 4u * l16 + 16 * q); S2[4 * q] = sh[0]; S2[4 * q + 1] = sh[1]; S2[4 * q + 2] = sh[2]; S2[4 * q + 3] = sh[3]; }
        const size_t t0 = (size_t)wq * 16;
        U14Meta N; u14_meta_load(N, F.ws, t0, l16);
        float nsu_lo = EUS[N.elo], nsu_hi = EUS[N.ehi], nsv_lo = EVS[N.elo], nsv_hi = EVS[N.ehi];
        v4u r0[8], r1[8];
        U16A A;
        u16_rows(r0, N.elo, 0, EU, rof); u16_rows(r1, N.elo, 8, EU, rof);
        u16_write(r0, tile, l16);
        LDS_WAIT(); asm volatile("" ::: "memory");
        u16_read(A, tile, li, lq);
#pragma unroll 1
        for (int tt = 0; tt < 16; ++tt) {
            const size_t t = t0 + tt;
            const int e_lo = N.elo, e_hi = N.ehi; const float g_lo = N.glo, g_hi = N.ghi, su_lo = nsu_lo, su_hi = nsu_hi, sv_lo = nsv_lo, sv_hi = nsv_hi;
            v4u hb[8]; float hinv;
            u14_h2(N, S2, hq, l16, li, lq, hb, hinv);
            u14_meta_load(N, F.ws, t + (tt < 15 ? 1 : 0), l16);
            float w_lo = 0.f, w_hi = 0.f;
#define U16_STEP(UU, RL, RW, IDS, NB) { \
            const int u = (UU); \
            u16_rows(RL, (IDS), (NB), EU, rof); \
            __builtin_amdgcn_sched_barrier(0); \
            LAS unsigned char* tn = tile + ((u + 1) & 1) * U16_BUF; \
            u16_write(RW, tn, l16); \
            const f32x4 acc = u16_mma(A, hb); \
            LDS_WAIT(); asm volatile("" ::: "memory"); \
            u16_read(A, tn, li, lq); \
            const int base = (u & 7) * 8; const int r = (li >> 1) & 3; \
            const float sel = r == 0 ? acc[0] : (r == 1 ? acc[1] : (r == 2 ? acc[2] : acc[3])); \
            const int sl = ((lane & 7) >> 2) * 16 + 2 * (lane & 3);                          \
            const float dmine = __shfl(sel, sl) + __shfl(sel, sl + 33); \
            const float gsel = u < 8 ? g_lo : g_hi, susel = u < 8 ? su_lo : su_hi, svsel = u < 8 ? sv_lo : sv_hi; \
            const float wv = gsel * gelu_erf(dmine * susel * hinv) * svsel; \
            const bool mine = (lane >= base) && (lane < base + 8); \
            if (u < 8) w_lo = mine ? wv : w_lo; else w_hi = mine ? wv : w_hi; }
#pragma unroll 1
            for (int u2 = 0; u2 < 14; u2 += 2) { const int ua = u2 + 2, ub = u2 + 3;
                U16_STEP(u2, r0, r1, ua < 8 ? e_lo : e_hi, (ua & 7) * 8)
                U16_STEP(u2 + 1, r1, r0, ub < 8 ? e_lo : e_hi, (ub & 7) * 8) }
            U16_STEP(14, r0, r1, N.elo, 0)
            U16_STEP(15, r1, r0, N.elo, 8)
#undef U16_STEP
            nsu_lo = EUS[N.elo]; nsu_hi = EUS[N.ehi]; nsv_lo = EVS[N.elo]; nsv_hi = EVS[N.ehi];
            __builtin_amdgcn_sched_barrier(0);
            WSP(float, WS_GATE)[t * 128 + lane] = w_lo; WSP(float, WS_GATE)[t * 128 + 64 + lane] = w_hi;
        }
    }
}
typedef int i32x8 __attribute__((ext_vector_type(8)));
struct U15Meta { int elo, ehi; float glo, ghi; v4u xa, xb; float rst; };
__device__ __forceinline__ void u15_meta_load(U15Meta& M, const unsigned char* ws, size_t t, unsigned l16) {
    const unsigned l = l16 >> 4; const int* ep = (const int*)(ws + WS_EID) + t * 128; const float* gp = (const float*)(ws + WS_GATE) + t * 128;
    M.elo = ep[l]; M.ehi = ep[64 + l]; M.glo = gp[l]; M.ghi = gp[64 + l];
    const char* xs = (const char*)(ws + WS_X1S) + t * 2048 + 2u * l16; M.xa = *(const v4u*)xs; M.xb = *(const v4u*)(xs + 16);
    M.rst = ((const float*)(ws + WS_ROWSTAT))[t];
}
__device__ __forceinline__ void u15_h2(const U15Meta& M, const float* S2, LAS unsigned char* hq, unsigned l16, int li, int lq, v4u* hb, float& hinv) {
    float h2[16]; unpack8(M.xa, h2); unpack8(M.xb, h2 + 8); float mx = 0.f;
    const float rs = rsqrt_f(M.rst * (1.0f / 1024.0f) + EPSF);
#pragma unroll
    for (int i = 0; i < 16; ++i) { h2[i] = h2[i] * rs + S2[i]; mx = fmaxf(mx, fabsf(h2[i])); }
#pragma unroll
    for (int o = 1; o < 64; o <<= 1) mx = fmaxf(mx, __shfl_xor(mx, o));
    mx = fmaxf(mx, 1e-30f); const float hs = 224.0f / mx; hinv = mx * (1.0f / 224.0f);
    v4u w;
#pragma unroll
    for (int qd = 0; qd < 4; ++qd) { int pk = 0; pk = __builtin_amdgcn_cvt_pk_fp8_f32(h2[4 * qd] * hs, h2[4 * qd + 1] * hs, pk, false); pk = __builtin_amdgcn_cvt_pk_fp8_f32(h2[4 * qd + 2] * hs, h2[4 * qd + 3] * hs, pk, true); w[qd] = (unsigned)pk; }
    *(LAS v4u*)(hq + l16) = w;
    LDS_WAIT(); asm volatile("" ::: "memory");
#pragma unroll
    for (int c = 0; c < 4; ++c) { const int o = (li & 1) * 512 + 128 * (lq >> 1) + 32 * c + 16 * (lq & 1); hb[2 * c] = *(const LAS v4u*)(hq + o); hb[2 * c + 1] = *(const LAS v4u*)(hq + o + 256); }
    LDS_WAIT(); asm volatile("" ::: "memory");
}
__device__ __forceinline__ void p8_peer_up15(Frame& F) {
    const int f_tid = threadIdx.x, lane = f_tid & 63, f_wave = __builtin_amdgcn_readfirstlane(f_tid >> 6);
    const int li = lane & 15, lq = lane >> 4;
    const unsigned char* EU = F.ws + WS_EU; const float* EUS = WSP(float, WS_EUS); const float* EVS = WSP(float, WS_EVS);
    LAS unsigned char* hq = F.lds + f_wave * 1024;
    for (int wq = F.vcu * NWAVES + f_wave; wq < MTOK / 16; wq += F.G * NWAVES) {
        const int b = wq >> 7; const float* mb = WSP(float, WS_MOD) + (size_t)b * 6144;
        unsigned l16 = 16u * (unsigned)lane; asm volatile("" : "+v"(l16));
        unsigned qof = 16u * (unsigned)(4 * (li >> 3) + lq); asm volatile("" : "+v"(qof));
        const int rsel = li & 7;
        float S2[16];
#pragma unroll
        for (int q = 0; q < 4; ++q) { const f32x4 sh = *(const f32x4*)((const char*)(mb + 3072) + 4u * l16 + 16 * q); S2[4 * q] = sh[0]; S2[4 * q + 1] = sh[1]; S2[4 * q + 2] = sh[2]; S2[4 * q + 3] = sh[3]; }
        const size_t t0 = (size_t)wq * 16;
        U15Meta N; u15_meta_load(N, F.ws, t0, l16);
        float nsu_lo = EUS[N.elo], nsu_hi = EUS[N.ehi], nsv_lo = EVS[N.elo], nsv_hi = EVS[N.ehi];
        v4u qa[6], qb[6];
        { const int e = __shfl(N.elo, rsel); const unsigned char* rp = EU + ((unsigned)e * 768u + qof);
#pragma unroll
          for (int i = 0; i < 6; ++i) qa[i] = *(const v4u*)(rp + 128 * i); }
#pragma unroll 1
        for (int tt = 0; tt < 16; ++tt) {
            const size_t t = t0 + tt;
            const int e_lo = N.elo, e_hi = N.ehi; const float g_lo = N.glo, g_hi = N.ghi, su_lo = nsu_lo, su_hi = nsu_hi, sv_lo = nsv_lo, sv_hi = nsv_hi;
            v4u hb[8]; float hinv;
            u15_h2(N, S2, hq, l16, li, lq, hb, hinv);
            u15_meta_load(N, F.ws, t + (tt < 15 ? 1 : 0), l16);
            float w_lo = 0.f, w_hi = 0.f;
#define U15_STEP(UU, CUR, NXT, NLO, NHI) { \
            const int u = (UU); const int un = (u + 1) & 15; const int nb = (un & 7) * 8; const int ensel = un < 8 ? (NLO) : (NHI); \
            { const int e = __shfl(ensel, nb + rsel); const unsigned char* rp = EU + ((unsigned)e * 768u + qof); \
              _Pragma("unroll") for (int i = 0; i < 6; ++i) NXT[i] = *(const v4u*)(rp + 128 * i); } \
            __builtin_amdgcn_sched_barrier(0); \
            f32x4 acc = (f32x4){0.f, 0.f, 0.f, 0.f}; \
            { const i32x8 B0 = (i32x8){(int)hb[0][0], (int)hb[0][1], (int)hb[0][2], (int)hb[0][3], (int)hb[1][0], (int)hb[1][1], (int)hb[1][2], (int)hb[1][3]}; \
              const i32x8 B1 = (i32x8){(int)hb[2][0], (int)hb[2][1], (int)hb[2][2], (int)hb[2][3], (int)hb[3][0], (int)hb[3][1], (int)hb[3][2], (int)hb[3][3]}; \
              const i32x8 B2 = (i32x8){(int)hb[4][0], (int)hb[4][1], (int)hb[4][2], (int)hb[4][3], (int)hb[5][0], (int)hb[5][1], (int)hb[5][2], (int)hb[5][3]}; \
              const i32x8 B3 = (i32x8){(int)hb[6][0], (int)hb[6][1], (int)hb[6][2], (int)hb[6][3], (int)hb[7][0], (int)hb[7][1], (int)hb[7][2], (int)hb[7][3]}; \
              const i32x8 A0 = (i32x8){(int)CUR[0][0], (int)CUR[0][1], (int)CUR[0][2], (int)CUR[0][3], (int)CUR[1][0], (int)CUR[1][1], 0, 0}; \
              const i32x8 A1 = (i32x8){(int)CUR[1][2], (int)CUR[1][3], (int)CUR[2][0], (int)CUR[2][1], (int)CUR[2][2], (int)CUR[2][3], 0, 0}; \
              const i32x8 A2 = (i32x8){(int)CUR[3][0], (int)CUR[3][1], (int)CUR[3][2], (int)CUR[3][3], (int)CUR[4][0], (int)CUR[4][1], 0, 0}; \
              const i32x8 A3 = (i32x8){(int)CUR[4][2], (int)CUR[4][3], (int)CUR[5][0], (int)CUR[5][1], (int)CUR[5][2], (int)CUR[5][3], 0, 0}; \
              acc = __builtin_amdgcn_mfma_scale_f32_16x16x128_f8f6f4(A0, B0, acc, 2, 0, 0, 0, 0, 0);        \
              acc = __builtin_amdgcn_mfma_scale_f32_16x16x128_f8f6f4(A1, B1, acc, 2, 0, 0, 0, 0, 0); \
              acc = __builtin_amdgcn_mfma_scale_f32_16x16x128_f8f6f4(A2, B2, acc, 2, 0, 0, 0, 0, 0); \
              acc = __builtin_amdgcn_mfma_scale_f32_16x16x128_f8f6f4(A3, B3, acc, 2, 0, 0, 0, 0, 0); } \
            const int base = (u & 7) * 8; const int r = (li >> 1) & 3; \
            const float sel = r == 0 ? acc[0] : (r == 1 ? acc[1] : (r == 2 ? acc[2] : acc[3])); \
            const int sl = ((lane & 7) >> 2) * 16 + 2 * (lane & 3);                          \
            const float dmine = __shfl(sel, sl) + __shfl(sel, sl + 33); \
            const float gsel = u < 8 ? g_lo : g_hi, susel = u < 8 ? su_lo : su_hi, svsel = u < 8 ? sv_lo : sv_hi; \
            const float wv = gsel * gelu_erf(dmine * susel * hinv) * svsel; \
            const bool mine = (lane >= base) && (lane < base + 8); \
            if (u < 8) w_lo = mine ? wv : w_lo; else w_hi = mine ? wv : w_hi; }
#pragma unroll 1
            for (int u2 = 0; u2 < 14; u2 += 2) { U15_STEP(u2, qa, qb, e_lo, e_hi) U15_STEP(u2 + 1, qb, qa, e_lo, e_hi) }
            U15_STEP(14, qa, qb, e_lo, e_hi)
            U15_STEP(15, qb, qa, N.elo, N.ehi)
#undef U15_STEP
            nsu_lo = EUS[N.elo]; nsu_hi = EUS[N.ehi]; nsv_lo = EVS[N.elo]; nsv_hi = EVS[N.ehi];
            __builtin_amdgcn_sched_barrier(0);
            WSP(float, WS_GATE)[t * 128 + lane] = w_lo; WSP(float, WS_GATE)[t * 128 + 64 + lane] = w_hi;
        }
    }
}
#ifdef TOPK2
#define P7FN p5b_topk2
#else
#define P7FN p5b_topk
#endif
#ifdef NO_SEAM8
#define SEAM8
#else
#define SEAM8 SEAM(8)
#endif
constexpr int NPHASE = 10;
__global__ void __launch_bounds__(NTHR, 2) fwd_mega(Args args) {
    extern __shared__ __attribute__((aligned(16))) unsigned char lds[];
    Frame F;
    F.lds = (LAS unsigned char*)lds;
    F.MISC = (volatile LAS unsigned*)(F.lds + MISC_OFF);
    F.G = gridDim.x; { const int bx = blockIdx.x; F.vcu = (F.G % 8 == 0) ? (bx % 8) * (F.G / 8) + bx / 8 : bx; }
    F.ws = args.ws; F.out = args.out;
    F.a = &args;
    for (int u = threadIdx.x; u < 32; u += NTHR) F.MISC[u] = 0u;
    __syncthreads();
    const int lo = args.ph_lo, hi = args.ph_hi;
#ifdef PROBE_PHASE_T
    unsigned long long pt0 = 0ull;
#endif
    const bool use_bar = (hi - lo) > 1;
    XcdBarrier bar; bar.bar = (unsigned*)(F.ws + WS_CTL); bar.x = 0; bar.st = nullptr;
    if (use_bar) bar = xcd_barrier_post((unsigned*)(F.ws + WS_CTL), F.MISC + 8);
#ifdef X1B
#define X1PTR ((float*)(F.ws + WS_X1B))
#else
#define X1PTR F.out
#endif
#define IN(k) (lo <= (k) && (k) < hi)
#ifdef PROBE_PHASE_T
#define SEAM(k) do { if (IN(k) && IN((k) + 1)) xcd_barrier(bar); if ((k) + 1 == PROBE_PHASE_T) pt0 = __builtin_amdgcn_s_memrealtime(); if ((k) == PROBE_PHASE_T && blockIdx.x == 0 && threadIdx.x == 0) *(volatile float*)(F.ws + WS_CTL + 40000) = (float)(__builtin_amdgcn_s_memrealtime() - pt0) * 0.01f; } while (0)
#else
#define SEAM(k) do { if (IN(k) && IN((k) + 1)) xcd_barrier(bar); } while (0)
#endif
#ifndef REP_PHASE
#define REP_PHASE -1
#endif
#define REPEAT(k, body) do { if (REP_PHASE == (k)) { xcd_barrier(bar); body; } } while (0)
    if (IN(0)) {
#ifndef SKIP_P0
 p0_phase(F); REPEAT(0, p0_phase(F));
#endif
 } SEAM(0);
    if (IN(1)) {
#ifndef SKIP_P1
 p1_phase(F); REPEAT(1, p1_phase(F));
#endif
 } SEAM(1);
    if (IN(2)) {
        pg8::Gemm g{WSP(bf16, WS_H1), WSP(bf16, WS_WINT), MTOK, NPROJ, 1024}; pg8::StaticOrder S; S.init(MTOK, NPROJ, F.G, (int)blockIdx.x);
        pg8::EpiProj E{WSP(bf16, WS_PROJ), NPROJ};
        pg8::gemm_phase<pg8::EpiProj, pg8::StaticOrder, true, true>(F.lds, g, S, E);
        REPEAT(2, (pg8::gemm_phase<pg8::EpiProj, pg8::StaticOrder, true, true>(F.lds, g, S, E)));
    } SEAM(2);
    if (IN(3)) {
#ifndef SKIP_SSD
 p3pre_conv(F); xcd_barrier(bar); p3_ssd3(F); REPEAT(30, p3_ssd3(F)); REPEAT(32, p3pre_conv(F));
#endif
#ifndef SKIP_S5
 p3_s5v2(F); REPEAT(31, p3_s5v2(F));
#endif
 } SEAM(3);
    if (IN(5)) {
        pg8::Gemm g{WSP(bf16, WS_Y), WSP(bf16, WS_WOUTT), MTOK, 1024, 2048}; pg8::StaticOrder S; S.init(MTOK, 1024, F.G, (int)blockIdx.x);
        PG8_LAS float* tab = (PG8_LAS float*)(F.lds + pg8::STAGE_BYTES);
        { pg8::Unit u; for (int i = 0; S.next(i, u); ++i) pg8::SegScaleHook::build(F.lds + pg8::STAGE_BYTES, u, WSP(float, WS_STSSD), WSP(float, WS_STS5), (int)threadIdx.x); }
        __syncthreads();
        pg8::EpiX1 E{(F.a->in[0]), X1PTR, WSP(bf16, WS_X1S), WSP(float, WS_MOD), (F.a->in[24]), WSP(float, WS_ROWSTAT), tab};
        pg8::SegScaleHook H;
        pg8::gemm_phase<pg8::EpiX1, pg8::StaticOrder, true, true, pg8::SegScaleHook>(F.lds, g, S, E, H);
    } SEAM(5);
    if (IN(6)) {
        pg8::Gemm g{WSP(bf16, WS_X1S), WSP(bf16, WS_WQKT), MTOK, 2048, 1024}; pg8::StaticOrder S; S.init(MTOK, 2048, F.G, (int)blockIdx.x);
        pg8::EpiScores E{WSP(_Float16, WS_SCORES), WSP(float, WS_SB), WSP(float, WS_ROWSTAT)};
        pg8::gemm_phase<pg8::EpiScores, pg8::StaticOrder, true, true>(F.lds, g, S, E);
        REPEAT(6, (pg8::gemm_phase<pg8::EpiScores, pg8::StaticOrder, true, true>(F.lds, g, S, E)));
    } SEAM(6);
    if (IN(7)) {
#ifndef SKIP_TOPK
 P7FN(F); REPEAT(7, P7FN(F));
#endif
 } SEAM(7);
#ifdef UP16
    if (IN(8)) { p8_peer_up16(F); REPEAT(8, { P7FN(F); xcd_barrier(bar); p8_peer_up16(F); }); } SEAM8;
#elif defined(UP15)
    if (IN(8)) { p8_peer_up15(F); REPEAT(8, { P7FN(F); xcd_barrier(bar); p8_peer_up15(F); }); } SEAM8;
#elif defined(UP14)
    if (IN(8)) { p8_peer_up14(F); REPEAT(8, { P7FN(F); xcd_barrier(bar); p8_peer_up14(F); }); } SEAM8;
#elif defined(UP12)
    if (IN(8)) { p8_peer_up12(F); REPEAT(8, { P7FN(F); xcd_barrier(bar); p8_peer_up12(F); }); } SEAM8;
#elif defined(UP11)
    if (IN(8)) { p8_peer_up11(F); REPEAT(8, { P7FN(F); xcd_barrier(bar); p8_peer_up11(F); }); } SEAM8;
#elif defined(UP10)
    if (IN(8)) { p8_peer_up10(F); } SEAM8;
#else
    if (IN(8)) { p8_peer_up6(F); REPEAT(8, { P7FN(F); xcd_barrier(bar); p8_peer_up6(F); }); } SEAM8;
#endif
#ifdef V6
    if (IN(9)) { p9_peer_down3(F); }
#else
    if (IN(9)) { p9_peer_down2(F); }
#endif
#ifdef PROBE_OUT
#if defined(PROBE_PHASE_T) && PROBE_PHASE_T == 9
    if (blockIdx.x == 0 && threadIdx.x == 0) *(volatile float*)(F.ws + WS_CTL + 40000) = (float)(__builtin_amdgcn_s_memrealtime() - pt0) * 0.01f;
#endif
    if (IN(9)) { __syncthreads(); if (blockIdx.x == 0 && threadIdx.x == 0) { asm volatile("s_waitcnt vmcnt(0)" ::: "memory"); F.out[0] = *(volatile float*)(F.ws + WS_CTL + 40000); } }
#endif
#undef IN
#undef SEAM
}

#ifndef N_LAUNCHES
#define N_LAUNCHES 1
#endif
extern "C" void kernel_launch(void* const* d_in, const int* in_sizes, int n_in, void* d_out, int out_size, void* d_ws, size_t ws_size, hipStream_t stream) {
    static int grid = 0;
    if (grid == 0) {
        if (n_in != 30 || in_sizes[0] != MTOK * DM || out_size != MTOK * DM || ws_size < WS_END) { fprintf(stderr, "kernel_launch: unexpected shapes (n_in %d, in0 %d, out %d, ws %zu)\n", n_in, n_in > 0 ? in_sizes[0] : -1, out_size, ws_size); grid = -1; return; }
        int dev = 0, cus = 0, per_cu = 0;
        if (hipGetDevice(&dev) != hipSuccess || hipDeviceGetAttribute(&cus, hipDeviceAttributeMultiprocessorCount, dev) != hipSuccess) { grid = -1; return; }
        if (hipFuncSetAttribute((const void*)fwd_mega, hipFuncAttributeMaxDynamicSharedMemorySize, LDS_BYTES) != hipSuccess) { fprintf(stderr, "kernel_launch: hipFuncSetAttribute failed\n"); grid = -1; return; }
        if (hipOccupancyMaxActiveBlocksPerMultiprocessor(&per_cu, (const void*)fwd_mega, NTHR, LDS_BYTES) != hipSuccess || per_cu < 1) { fprintf(stderr, "kernel_launch: occupancy query says %d\n", per_cu); (void)hipGetLastError(); grid = -1; return; }
        if (cus != 256) { fprintf(stderr, "kernel_launch: built for a 256-CU device (got %d CUs); nothing launched\n", cus); grid = -1; return; }
        grid = cus;
    }
    if (grid < 0) return;
    (void)hipMemsetAsync((char*)d_ws + WS_CTL, 0, CTL_ZERO_BYTES, stream);
    Args a{};
    for (int i = 0; i < 30; ++i) a.in[i] = (const float*)d_in[i];
    a.out = (float*)d_out; a.ws = (unsigned char*)d_ws;
    if (N_LAUNCHES == 1) {
        a.ph_lo = 0; a.ph_hi = NPHASE;
        void* kargs[] = {&a};
#ifdef PLAIN_LAUNCH
        (void)kargs; hipLaunchKernelGGL(fwd_mega, dim3(grid), dim3(NTHR), LDS_BYTES, stream, a);
#else
        hipError_t e = hipLaunchCooperativeKernel((const void*)fwd_mega, dim3(grid), dim3(NTHR), kargs, LDS_BYTES, stream);
        if (e != hipSuccess) fprintf(stderr, "kernel_launch: cooperative launch failed: %s (grid %d)\n", hipGetErrorString(e), grid);
#endif
    } else {
        for (int p = 0; p < NPHASE; ++p) { a.ph_lo = p; a.ph_hi = p + 1; hipLaunchKernelGGL(fwd_mega, dim3(grid), dim3(NTHR), LDS_BYTES, stream, a); }
    }
}
```

```cpp
#include <hip/hip_runtime.h>
#include <cstdio>
#include <cstdint>
namespace pg8 {
#define PG8_LAS __attribute__((address_space(3)))
typedef unsigned short bf16_t;
typedef short bf16x8 __attribute__((ext_vector_type(8)));
typedef float f32x4 __attribute__((ext_vector_type(4)));
typedef unsigned u32x4 __attribute__((ext_vector_type(4)));
constexpr int BM = 256, BK = 64, HALF = 128, HTB = HALF * BK * 2  , STAGE_BYTES = 8 * HTB, NXCD = 8, WGM = 8;

__host__ __device__ __forceinline__ int lds_byte(int r, int c) { const int st = (r >> 4) * 2 + (c >> 5), rr = r & 15, cc = c & 31, ob = rr * 64 + cc * 2; return st * 1024 + (ob ^ (((ob >> 9) & 1) << 5)); }
__host__ __device__ __forceinline__ void stage_rc(int b, int& R, int& C) { const int st = b / 1024, sb = b % 1024, swz = sb ^ (((sb >> 9) & 1) << 5); R = (st >> 1) * 16 + swz / 64; C = (st & 1) * 32 + (swz % 64) / 2; }
__host__ __device__ __forceinline__ int perm32(int rho) { const int n = rho >> 4, i = rho & 15; return 8 * (i >> 2) + 4 * n + (i & 3); }

struct Unit { int pm, pn; };
struct Gemm { const bf16_t* A; const bf16_t* Bt; int M, N, K; };

struct StaticOrder {
    int nM, nN, nwg, G, c;
    __host__ __device__ void init(int M, int N, int G_, int c_) { nM = M / BM; nN = N / BM; nwg = nM * nN; G = G_; c = c_; }
    __host__ __device__ bool next(int i, Unit& u) const {
        const long L = (long)i * G + c; if (L >= nwg) return false;
        int wgid = (int)L; { const int q = nwg / NXCD, r = nwg % NXCD, xcd = wgid % NXCD, off = wgid / NXCD; wgid = (xcd < r ? xcd * (q + 1) : r * (q + 1) + (xcd - r) * q) + off; }
        const int nig = WGM * nN, gid = wgid / nig, fm = gid * WGM, gsz = (nM - fm) < WGM ? (nM - fm) : WGM;
        u.pm = fm + ((wgid % nig) % gsz); u.pn = (wgid % nig) / gsz; return true;
    }
    __device__ __forceinline__ void a_ready(const Unit&) const {}
    __device__ __forceinline__ void done(const Unit&) const {}
};

__device__ __forceinline__ unsigned cvt_pk_bf16(float lo, float hi) { unsigned r; asm volatile("v_cvt_pk_bf16_f32 %0, %1, %2" : "=v"(r) : "v"(lo), "v"(hi)); return r; }
typedef float f32x2 __attribute__((ext_vector_type(2)));
struct NoHook { __device__ __forceinline__ void at_tile(int, const Unit&, f32x4 (&)[2][2][4][2], PG8_LAS unsigned char*, int, int) const {} };
template <class Epi, class Sched, bool ALIGN_EPI = false, bool SP2 = false, class Hook = NoHook>
__device__ __forceinline__ void gemm_phase(PG8_LAS unsigned char* lds, const Gemm g, const Sched& S, const Epi& E, const Hook& H = Hook()) {
    const int tid = threadIdx.x, wid = __builtin_amdgcn_readfirstlane(tid >> 6), lane = tid & 63, wr = wid >> 2, wc = wid & 3, fr = lane & 15, fq = lane >> 4;
    const int K = g.K, nt = K / BK;
    unsigned voffA[2], voffB[2];
#pragma unroll
    for (int i = 0; i < 2; ++i) { int R, C; stage_rc(tid * 16 + i * 8192, R, C); const int Rb = Epi::PERM ? ((R & ~31) + perm32(R & 31)) : R;
        voffA[i] = (unsigned)(R * K + C) * 2u; voffB[i] = (unsigned)(Rb * K + C) * 2u; }
    const size_t kstep = (size_t)(BK * 2);
    const size_t hstep = (size_t)HALF * K * 2;
    const size_t tstep = 2 * hstep;
    const unsigned ldsw = (unsigned)wid * 1024u;
    const int aoff = lds_byte(wr * 64 + fr, fq * 8), boff = lds_byte(wc * 32 + fr, fq * 8);
#define PG8_SA(b, h) (((b) * 2 + (h)) * HTB)
#define PG8_SB(b, h) ((4 + (b) * 2 + (h)) * HTB)
#define PG8_STAGE(bufoff, gbase, voff) do { _Pragma("unroll") for (int _i = 0; _i < 2; ++_i) \
        __builtin_amdgcn_global_load_lds((const unsigned*)((const char*)(gbase) + (voff)[_i]), (PG8_LAS unsigned*)(lds + (bufoff) + ldsw + _i * 8192), 16, 0, 0); } while (0)
#define PG8_LDA(dst, b, h) do { _Pragma("unroll") for (int m = 0; m < 4; ++m) _Pragma("unroll") for (int k = 0; k < 2; ++k) dst[m][k] = *(const PG8_LAS bf16x8*)(lds + PG8_SA(b, h) + aoff + m * 2048 + k * 1024); } while (0)
#define PG8_LDB(dst, b, h) do { _Pragma("unroll") for (int n = 0; n < 2; ++n) _Pragma("unroll") for (int k = 0; k < 2; ++k) dst[n][k] = *(const PG8_LAS bf16x8*)(lds + PG8_SB(b, h) + boff + n * 2048 + k * 1024); } while (0)
#define PG8_MMA(ai, bj, At, Bt) do { __builtin_amdgcn_s_setprio(1); _Pragma("unroll") for (int m = 0; m < 4; ++m) _Pragma("unroll") for (int n = 0; n < 2; ++n) _Pragma("unroll") for (int k = 0; k < 2; ++k) \
        acc[ai][bj][m][n] = __builtin_amdgcn_mfma_f32_16x16x32_bf16(Bt[n][k], At[m][k], acc[ai][bj][m][n], 0, 0, 0); __builtin_amdgcn_s_setprio(0); } while (0)
#define PG8_WAIT_V(n) asm volatile("s_waitcnt vmcnt(" #n ")" ::: "memory")
#define PG8_WAIT_L(n) asm volatile("s_waitcnt lgkmcnt(" #n ")" ::: "memory")
#define PG8_BAR __builtin_amdgcn_s_barrier()
#define PG8_SCHED __builtin_amdgcn_sched_barrier(0)
    Unit cur, nxt; int ui = 0;
    if (!S.next(0, cur)) return;
    f32x4 acc[2][2][4][2];
#pragma unroll
    for (int a = 0; a < 2; ++a)
#pragma unroll
        for (int b = 0; b < 2; ++b)
#pragma unroll
            for (int m = 0; m < 4; ++m)
#pragma unroll
                for (int n = 0; n < 2; ++n) acc[a][b][m][n] = (f32x4){0.f, 0.f, 0.f, 0.f};
    bf16x8 At[4][2], B0[2][2], B1[2][2];
    const char* cA = (const char*)g.A + (size_t)cur.pm * tstep; const char* cB = (const char*)g.Bt + (size_t)cur.pn * tstep;
    S.a_ready(cur);
    if constexpr (SP2) {
        PG8_STAGE(PG8_SB(0, 0), cB, voffB); PG8_STAGE(PG8_SB(0, 1), cB + hstep, voffB); PG8_STAGE(PG8_SA(0, 0), cA, voffA); PG8_STAGE(PG8_SA(0, 1), cA + hstep, voffA);
        if (wr == 1) PG8_BAR;
        PG8_WAIT_V(2); PG8_BAR;
        PG8_STAGE(PG8_SB(1, 0), cB + kstep, voffB); PG8_STAGE(PG8_SA(1, 0), cA + kstep, voffA); PG8_STAGE(PG8_SB(1, 1), cB + hstep + kstep, voffB);
        PG8_WAIT_V(6); PG8_BAR;
    } else {
        PG8_STAGE(PG8_SB(0, 0), cB, voffB); PG8_STAGE(PG8_SA(0, 0), cA, voffA); PG8_STAGE(PG8_SB(0, 1), cB + hstep, voffB); PG8_STAGE(PG8_SA(0, 1), cA + hstep, voffA);
        if (wr == 1) PG8_BAR;
        PG8_WAIT_V(4); PG8_BAR;
        PG8_STAGE(PG8_SB(1, 0), cB + kstep, voffB); PG8_STAGE(PG8_SA(1, 0), cA + kstep, voffA); PG8_STAGE(PG8_SB(1, 1), cB + hstep + kstep, voffB);
        PG8_WAIT_V(6); PG8_BAR;
    }
    for (;;) {
        const bool has_next = S.next(ui + 1, nxt);
        const char* nA = has_next ? (const char*)g.A + (size_t)nxt.pm * tstep : cA; const char* nB = has_next ? (const char*)g.Bt + (size_t)nxt.pn * tstep : cB;
        for (int t = 0; t < nt; t += 2) {
            const bool last = (t == nt - 2);
            H.at_tile(t, cur, acc, lds + STAGE_BYTES, wr, fr);
            const char* a1 = cA + (size_t)(t + 1) * kstep;
            const char* a2 = last ? nA : cA + (size_t)(t + 2) * kstep; const char* b2 = last ? nB : cB + (size_t)(t + 2) * kstep;
            const char* a3 = a2 + kstep; const char* b3 = b2 + kstep;
            if (last && has_next) S.a_ready(nxt);
            if constexpr (SP2) {
            PG8_LDB(B0, 0, 0); PG8_LDB(B1, 0, 1); PG8_SCHED; PG8_LDA(At, 0, 0); PG8_STAGE(PG8_SA(1, 1), a1 + hstep, voffA);
            PG8_WAIT_V(8); PG8_WAIT_L(0); PG8_BAR; PG8_MMA(0, 0, At, B0); PG8_MMA(0, 1, At, B1); PG8_BAR; PG8_SCHED;
            PG8_LDA(At, 0, 1); PG8_STAGE(PG8_SB(0, 0), b2, voffB); PG8_STAGE(PG8_SB(0, 1), b2 + hstep, voffB); PG8_STAGE(PG8_SA(0, 0), a2, voffA);
            PG8_WAIT_V(8); PG8_WAIT_L(0); PG8_BAR; PG8_MMA(1, 0, At, B0); PG8_MMA(1, 1, At, B1); PG8_BAR; PG8_SCHED;
            PG8_LDB(B0, 1, 0); PG8_LDB(B1, 1, 1); PG8_SCHED; PG8_LDA(At, 1, 0); PG8_STAGE(PG8_SA(0, 1), a2 + hstep, voffA);
            PG8_WAIT_V(8); PG8_WAIT_L(0); PG8_BAR; PG8_MMA(0, 0, At, B0); PG8_MMA(0, 1, At, B1); PG8_BAR; PG8_SCHED;
            PG8_LDA(At, 1, 1); PG8_STAGE(PG8_SB(1, 0), b3, voffB); PG8_STAGE(PG8_SB(1, 1), b3 + hstep, voffB); PG8_STAGE(PG8_SA(1, 0), a3, voffA);
            PG8_WAIT_V(8); PG8_WAIT_L(0); PG8_BAR; PG8_MMA(1, 0, At, B0); PG8_MMA(1, 1, At, B1); PG8_BAR; PG8_SCHED;
            } else {
            PG8_LDB(B0, 0, 0); PG8_SCHED; PG8_LDA(At, 0, 0); PG8_STAGE(PG8_SA(1, 1), a1 + hstep, voffA);
            PG8_WAIT_L(8); PG8_BAR; PG8_WAIT_L(0); PG8_MMA(0, 0, At, B0); PG8_BAR; PG8_SCHED;
            PG8_LDB(B1, 0, 1); PG8_STAGE(PG8_SB(0, 0), b2, voffB);
            PG8_BAR; PG8_WAIT_L(0); PG8_MMA(0, 1, At, B1); PG8_BAR;
            PG8_LDA(At, 0, 1); PG8_STAGE(PG8_SA(0, 0), a2, voffA);
            PG8_BAR; PG8_WAIT_L(0); PG8_MMA(1, 0, At, B0); PG8_BAR; PG8_SCHED;
            PG8_STAGE(PG8_SB(0, 1), b2 + hstep, voffB);
            PG8_WAIT_V(6); PG8_BAR; PG8_MMA(1, 1, At, B1); PG8_BAR;
            PG8_LDB(B0, 1, 0); PG8_SCHED; PG8_LDA(At, 1, 0); PG8_STAGE(PG8_SA(0, 1), a2 + hstep, voffA);
            PG8_WAIT_L(8); PG8_BAR; PG8_WAIT_L(0); PG8_MMA(0, 0, At, B0); PG8_BAR; PG8_SCHED;
            PG8_LDB(B1, 1, 1); PG8_STAGE(PG8_SB(1, 0), b3, voffB);
            PG8_BAR; PG8_WAIT_L(0); PG8_MMA(0, 1, At, B1); PG8_BAR;
            PG8_LDA(At, 1, 1); PG8_STAGE(PG8_SA(1, 0), a3, voffA);
            PG8_BAR; PG8_WAIT_L(0); PG8_MMA(1, 0, At, B0); PG8_BAR; PG8_SCHED;
            PG8_STAGE(PG8_SB(1, 1), b3 + hstep, voffB);
            PG8_WAIT_V(6); PG8_BAR; PG8_MMA(1, 1, At, B1); PG8_BAR;
            }
        }
        if constexpr (ALIGN_EPI) { if (wr == 0) PG8_BAR; }
        if constexpr (!Epi::AFTER_DRAIN) { E(acc, cur, wr, wc, fr, fq);
            S.done(cur); }
        if (!has_next) break;
#pragma unroll
        for (int a = 0; a < 2; ++a)
#pragma unroll
            for (int b = 0; b < 2; ++b)
#pragma unroll
                for (int m = 0; m < 4; ++m)
#pragma unroll
                    for (int n = 0; n < 2; ++n) acc[a][b][m][n] = (f32x4){0.f, 0.f, 0.f, 0.f};
        cur = nxt; cA = nA; cB = nB; ++ui;
        if constexpr (ALIGN_EPI) { if (wr == 1) PG8_BAR; }
    }
    PG8_WAIT_V(0);
    if constexpr (!ALIGN_EPI) { if (wr == 0) PG8_BAR; }
    PG8_BAR;
    if constexpr (Epi::AFTER_DRAIN) { E.fused(acc, cur, wr, wc, fr, fq, lds, wid, lane); S.done(cur); }
#undef PG8_SA
#undef PG8_SB
#undef PG8_STAGE
#undef PG8_LDA
#undef PG8_LDB
#undef PG8_MMA
#undef PG8_WAIT_V
#undef PG8_WAIT_L
#undef PG8_BAR
#undef PG8_SCHED
}
}
namespace pg8 {
struct EpiProj {
    static constexpr bool PERM = true, AFTER_DRAIN = false, PROBE_TWICE = true;
    bf16_t* O; int ldc;
    __device__ __forceinline__ void operator()(const f32x4 (&acc)[2][2][4][2], const Unit& u, int wr, int wc, int fr, int fq) const {
        const int row0 = u.pm * BM + wr * 64 + fr; const int col0 = u.pn * BM + wc * 32 + 8 * fq;
#pragma unroll
        for (int ai = 0; ai < 2; ++ai)
#pragma unroll
            for (int m = 0; m < 4; ++m) { bf16_t* rowp = O + (size_t)(row0 + ai * HALF + m * 16) * ldc + col0;
#pragma unroll
                for (int bj = 0; bj < 2; ++bj) { const f32x4 v0 = acc[ai][bj][m][0], v1 = acc[ai][bj][m][1];
                    u32x4 w; w.x = cvt_pk_bf16(v0[0], v0[1]); w.y = cvt_pk_bf16(v0[2], v0[3]); w.z = cvt_pk_bf16(v1[0], v1[1]); w.w = cvt_pk_bf16(v1[2], v1[3]);
                    __builtin_nontemporal_store(w, (u32x4*)(rowp + bj * HALF)); } }
    }
};
struct EpiX1 {
    static constexpr bool PERM = true, AFTER_DRAIN = false, PROBE_TWICE = false;
    const float* x; float* x1; bf16_t* x1s; const float* mod; const float* norm2_g; float* rowstat; PG8_LAS float* tab;
    __device__ __forceinline__ void operator()(const f32x4 (&acc)[2][2][4][2], const Unit& u, int wr, int wc, int fr, int fq) const {
        const int row0 = u.pm * BM + wr * 64 + fr; const int col0 = u.pn * BM + wc * 32 + 8 * fq; const int b = (u.pm * BM) >> 11;
        const float* mb = mod + (size_t)b * 6144;
        f32x4 g1[2][2], g2[2][2];
#pragma unroll
        for (int bj = 0; bj < 2; ++bj)
#pragma unroll
            for (int n = 0; n < 2; ++n) { const int c = col0 + bj * HALF + 4 * n; g1[bj][n] = *(const f32x4*)(mb + 2048 + c);
                const f32x4 sc = *(const f32x4*)(mb + 4096 + c), ng = *(const f32x4*)(norm2_g + c); g2[bj][n] = ng * (sc + 1.0f); }
#pragma unroll
        for (int ai = 0; ai < 2; ++ai)
#pragma unroll
            for (int m = 0; m < 4; ++m) { const size_t row = (size_t)(row0 + ai * HALF + m * 16); const size_t off = row * 1024 + col0; float ss = 0.f;
                const float rfin = tab[((u.pm >> 3) & 1) * 1280 + 1024 + ai * HALF + wr * 64 + m * 16 + fr];
#pragma unroll
                for (int bj = 0; bj < 2; ++bj) {
                    const f32x4 xa = *(const f32x4*)(x + off + bj * HALF), xb = *(const f32x4*)(x + off + bj * HALF + 4);
                    const f32x4 v0 = xa + g1[bj][0] * (acc[ai][bj][m][0] * rfin), v1 = xb + g1[bj][1] * (acc[ai][bj][m][1] * rfin);
                    { u32x4 wx; wx.x = cvt_pk_bf16(v0[0], v0[1]); wx.y = cvt_pk_bf16(v0[2], v0[3]); wx.z = cvt_pk_bf16(v1[0], v1[1]); wx.w = cvt_pk_bf16(v1[2], v1[3]); *(u32x4*)((bf16_t*)x1 + off + bj * HALF) = wx; }
                    ss += (v0[0] * v0[0] + v0[1] * v0[1]) + (v0[2] * v0[2] + v0[3] * v0[3]) + (v1[0] * v1[0] + v1[1] * v1[1]) + (v1[2] * v1[2] + v1[3] * v1[3]);
                    const f32x4 s0 = v0 * g2[bj][0], s1 = v1 * g2[bj][1];
                    u32x4 w; w.x = cvt_pk_bf16(s0[0], s0[1]); w.y = cvt_pk_bf16(s0[2], s0[3]); w.z = cvt_pk_bf16(s1[0], s1[1]); w.w = cvt_pk_bf16(s1[2], s1[3]);
                    *(u32x4*)(x1s + off + bj * HALF) = w; }
                ss += __shfl_xor(ss, 16); ss += __shfl_xor(ss, 32);
                if (fq == 0) atomicAdd(rowstat + row, ss); }
    }
};
typedef _Float16 f16x8 __attribute__((ext_vector_type(8)));
struct EpiScores {
    static constexpr bool PERM = true, AFTER_DRAIN = false, PROBE_TWICE = false;
    _Float16* S; const float* sb; const float* rowstat;
    __device__ __forceinline__ void operator()(const f32x4 (&acc)[2][2][4][2], const Unit& u, int wr, int wc, int fr, int fq) const {
        const int row0 = u.pm * BM + wr * 64 + fr; const int col0 = u.pn * BM + wc * 32 + 8 * fq; const int b = (u.pm * BM) >> 11;
        f32x4 bv[2][2];
#pragma unroll
        for (int bj = 0; bj < 2; ++bj)
#pragma unroll
            for (int n = 0; n < 2; ++n) bv[bj][n] = *(const f32x4*)(sb + (size_t)b * 2048 + col0 + bj * HALF + 4 * n);
#pragma unroll
        for (int ai = 0; ai < 2; ++ai)
#pragma unroll
            for (int m = 0; m < 4; ++m) { const size_t row = (size_t)(row0 + ai * HALF + m * 16); const float rs = __builtin_amdgcn_rsqf(rowstat[row] * (1.0f / 1024.0f) + 1e-6f);
                _Float16* rowp = S + row * 2048 + col0;
#pragma unroll
                for (int bj = 0; bj < 2; ++bj) { const f32x4 v0 = acc[ai][bj][m][0] * rs + bv[bj][0], v1 = acc[ai][bj][m][1] * rs + bv[bj][1];
                    f16x8 h; h[0] = (_Float16)v0[0]; h[1] = (_Float16)v0[1]; h[2] = (_Float16)v0[2]; h[3] = (_Float16)v0[3]; h[4] = (_Float16)v1[0]; h[5] = (_Float16)v1[1]; h[6] = (_Float16)v1[2]; h[7] = (_Float16)v1[3];
                    *(f16x8*)(rowp + bj * HALF) = h; } }
    }
};
struct SegScaleHook {
    __device__ __forceinline__ static void build(PG8_LAS unsigned char* ldsx, const Unit& u, const float* st_ssd, const float* st_s5, int tid) {
        PG8_LAS float* tab = (PG8_LAS float*)ldsx + ((u.pm >> 3) & 1) * 1280;
        if (tid < 256) { const size_t row = (size_t)u.pm * BM + tid; const f32x4* sg = (const f32x4*)(st_ssd + row * 16); const f32x4* s5 = (const f32x4*)(st_s5 + row * 64);
            float r[5];
#pragma unroll
            for (int gI = 0; gI < 4; ++gI) { const f32x4 v = sg[gI]; r[gI] = __builtin_amdgcn_rsqf(((v[0] + v[1]) + (v[2] + v[3])) * (1.0f / 256.0f) + 1e-6f); }
            float a5 = 0.f;
#pragma unroll
            for (int q = 0; q < 16; ++q) { const f32x4 v = s5[q]; a5 += (v[0] + v[1]) + (v[2] + v[3]); }
            r[4] = __builtin_amdgcn_rsqf(a5 * (1.0f / 1024.0f) + 1e-6f);
#pragma unroll
            for (int k = 0; k < 4; ++k) tab[k * 256 + tid] = r[k] * __builtin_amdgcn_rcpf(r[k + 1]);
            tab[1024 + tid] = r[4]; }
    }
    __device__ __forceinline__ void at_tile(int t, const Unit& u, f32x4 (&acc)[2][2][4][2], PG8_LAS unsigned char* ldsx, int wr, int fr) const {
        if (t == 4 || t == 8 || t == 12 || t == 16) { const PG8_LAS float* rt = (const PG8_LAS float*)ldsx + ((u.pm >> 3) & 1) * 1280 + ((t >> 2) - 1) * 256 + wr * 64 + fr;
#pragma unroll
            for (int ai = 0; ai < 2; ++ai)
#pragma unroll
                for (int m = 0; m < 4; ++m) { const float r = rt[ai * HALF + m * 16];
#pragma unroll
                    for (int bj = 0; bj < 2; ++bj) { acc[ai][bj][m][0] = acc[ai][bj][m][0] * r; acc[ai][bj][m][1] = acc[ai][bj][m][1] * r; } } }
    }
};
}
constexpr int NWAVES = 8, NTHR = 512;
constexpr int DM = 1024, NB = 16, SEQ = 2048, MTOK = NB * SEQ;
constexpr int NPROJ = 4096;
constexpr int INW = 4112;
constexpr int NHEADS = 16, HDIM = 64, NGRP = 4, NST = 128, CHUNK = 128;
constexpr int S5G = 64, S5CH = 16, S5P = 64;
constexpr int PH = 8, PK = 16, PNK = 128;
constexpr float EPSF = 1e-6f;
constexpr int NS5PART = 64;

constexpr size_t MiB = 1u << 20;
constexpr size_t WS_CTL = 0, CTL_ZERO_BYTES = 64 * 1024;
constexpr size_t WS_MOD = 1 * MiB;
constexpr size_t WS_WDT = WS_MOD + 0x60000;
constexpr size_t WS_SB = WS_MOD + 0x70000;
constexpr size_t WS_ROWSTAT = WS_MOD + 0x90000;
constexpr size_t WS_S5LB = WS_MOD + 0xB0000;
constexpr size_t WS_S5BB = WS_MOD + 0xC0000;
constexpr size_t WS_DTRAW = 3 * MiB;
constexpr size_t WS_STSSD = 5 * MiB;
constexpr size_t WS_STS5 = 7 * MiB;
constexpr size_t WS_WINT = 15 * MiB;
constexpr size_t WS_WOUTT = 23 * MiB;
constexpr size_t WS_WQKT = 27 * MiB;
constexpr size_t WS_EU = 31 * MiB, WS_EV = 47 * MiB;
constexpr size_t WS_EUS = 63 * MiB, WS_EVS = 63 * MiB + 65536;
constexpr size_t WS_START = 64 * MiB;
constexpr size_t WS_A = 95 * MiB;
constexpr size_t WS_B = 223 * MiB;
constexpr size_t WS_H1 = WS_A, WS_Y = WS_A, WS_PROJ = WS_B, WS_SCORES = WS_A;
constexpr size_t WS_X1S = WS_B + 192 * MiB;
constexpr size_t WS_EID = 479 * MiB, WS_GATE = 495 * MiB;
constexpr size_t WS_H2Q = WS_B, WS_HINV = WS_B + 32 * MiB;
constexpr size_t WS_X1B = WS_B + 64 * MiB;
constexpr size_t WS_END = 511 * MiB;
static_assert(WS_SCORES + (size_t)MTOK * 2048 * 4 <= WS_X1S && WS_X1S + (size_t)MTOK * 1024 * 2 <= WS_EID && WS_GATE + (size_t)MTOK * 128 * 4 <= WS_END, "ws map");

constexpr int LDS_MAIN = 159744;
constexpr int MISC_OFF = LDS_MAIN;
constexpr int LDS_BYTES = LDS_MAIN + 128;

#define GAS __attribute__((address_space(1)))
#define LAS __attribute__((address_space(3)))
typedef unsigned short bf16;
typedef unsigned v4u __attribute__((ext_vector_type(4)));
typedef unsigned v2u __attribute__((ext_vector_type(2)));
typedef float f32x4 __attribute__((ext_vector_type(4)));
typedef float f32x2 __attribute__((ext_vector_type(2)));
typedef short bf16x8 __attribute__((ext_vector_type(8)));
#define LDS_WAIT() asm volatile("s_waitcnt lgkmcnt(0)" ::: "memory")
#define VM_WAIT() asm volatile("s_waitcnt vmcnt(0)" ::: "memory")
typedef __bf16 hwbf16x2 __attribute__((ext_vector_type(2)));
__device__ __forceinline__ unsigned pk2(float lo, float hi) { const f32x2 v = {lo, hi}; const hwbf16x2 b = __builtin_convertvector(v, hwbf16x2); return __builtin_bit_cast(unsigned, b); }
__device__ __forceinline__ unsigned f2bf(float f) { return pk2(f, 0.f) & 0xffffu; }
__device__ __forceinline__ float bflo(unsigned w) { return __builtin_bit_cast(float, w << 16); }
__device__ __forceinline__ float bfhi(unsigned w) { return __builtin_bit_cast(float, w & 0xffff0000u); }
__device__ __forceinline__ float bf2f(bf16 v) { return __builtin_bit_cast(float, (unsigned)v << 16); }
__device__ __forceinline__ float wave_sum(float v) {
#pragma unroll
    for (int o = 1; o < 64; o <<= 1) v += __shfl_xor(v, o);
    return v;
}
__device__ __forceinline__ float sigmoid_f(float v) { return __builtin_amdgcn_rcpf(1.0f + __builtin_amdgcn_exp2f(-1.4426950408889634f * v)); }
__device__ __forceinline__ float silu_f(float v) { return v * sigmoid_f(v); }
__device__ __forceinline__ float rsqrt_f(float v) { return __builtin_amdgcn_rsqf(v); }
__device__ __forceinline__ float gelu_erf(float v) {
    const float av = fabsf(v), t = __builtin_amdgcn_rcpf(av * 0.2316418882f + 1.0f);
    float q = t * 0.5307027145f + (-0.7265760135f); q = q * t + 0.7107068705f; q = q * t + (-0.142248368f); q = q * t + 0.127414796f; q = q * t;
    const float e = __builtin_amdgcn_exp2f((v * v) * (-0.72134752044f));
    const float m = v * (q * e);
    return v < 0.f ? m : v - m;
}
__device__ __forceinline__ float softplus_f(float v) { const float e = __builtin_amdgcn_exp2f(-1.4426950408889634f * fabsf(v));
    const float l = e < 1e-6f ? e : 0.6931471805599453f * __builtin_amdgcn_logf(1.0f + e); return fmaxf(v, 0.f) + l; }
__device__ __forceinline__ void unpack8(const v4u w, float* f) { f[0] = bflo(w.x); f[1] = bfhi(w.x); f[2] = bflo(w.y); f[3] = bfhi(w.y); f[4] = bflo(w.z); f[5] = bfhi(w.z); f[6] = bflo(w.w); f[7] = bfhi(w.w); }
#define LDS_BARRIER() do { asm volatile("s_waitcnt lgkmcnt(0)" ::: "memory"); __builtin_amdgcn_s_barrier(); asm volatile("" ::: "memory"); } while (0)
__device__ __forceinline__ float row16_sum_to15(float v) {
    v += __builtin_bit_cast(float, __builtin_amdgcn_update_dpp(0, __builtin_bit_cast(int, v), 0x118, 0xf, 0xf, true));
    v += __builtin_bit_cast(float, __builtin_amdgcn_update_dpp(0, __builtin_bit_cast(int, v), 0x114, 0xf, 0xf, true));
    v += __builtin_bit_cast(float, __builtin_amdgcn_update_dpp(0, __builtin_bit_cast(int, v), 0x112, 0xf, 0xf, true));
    v += __builtin_bit_cast(float, __builtin_amdgcn_update_dpp(0, __builtin_bit_cast(int, v), 0x111, 0xf, 0xf, true));
    return v;
}
__device__ __forceinline__ float wave_sum_to63(float v) {
    v = row16_sum_to15(v);
    v += __builtin_bit_cast(float, __builtin_amdgcn_update_dpp(0, __builtin_bit_cast(int, v), 0x142, 0xa, 0xf, false));
    v += __builtin_bit_cast(float, __builtin_amdgcn_update_dpp(0, __builtin_bit_cast(int, v), 0x143, 0xc, 0xf, false));
    return v;
}
__device__ __forceinline__ f32x2 gelu_pk2(f32x2 v) {
    const f32x2 av = __builtin_elementwise_abs(v), d = av * 0.2316418882f + 1.0f;
    f32x2 t; t[0] = __builtin_amdgcn_rcpf(d[0]); t[1] = __builtin_amdgcn_rcpf(d[1]);
    f32x2 q = t * 0.5307027145f + (-0.7265760135f); q = q * t + 0.7107068705f; q = q * t + (-0.142248368f); q = q * t + 0.127414796f; q = q * t;
    const f32x2 s = (v * v) * (-0.72134752044f);
    f32x2 e; e[0] = __builtin_amdgcn_exp2f(s[0]); e[1] = __builtin_amdgcn_exp2f(s[1]);
    const f32x2 m = v * (q * e), r = v - m;
    f32x2 o; o[0] = v[0] < 0.f ? m[0] : r[0]; o[1] = v[1] < 0.f ? m[1] : r[1]; return o;
}
#define XB_TMO      128
#define XB_XCNT(j)  (256  + 64 * (j))
#define XB_XSUB(j)  (1280 + 64 * (j))
#define XB_XGEN(j)  (2304 + 64 * (j))
#define XB_TOP      3328
#define XB_TOPGEN   3392
#define XCD_BAR_WORDS 3456
#define XB_SPIN_CAP (1u << 18)

__device__ __forceinline__ unsigned xb_ld(unsigned* p)              { return __hip_atomic_load(p, __ATOMIC_RELAXED, __HIP_MEMORY_SCOPE_AGENT); }
__device__ __forceinline__ unsigned xb_add(unsigned* p, unsigned v) { return __hip_atomic_fetch_add(p, v, __ATOMIC_RELAXED, __HIP_MEMORY_SCOPE_AGENT); }
__device__ __forceinline__ unsigned xb_xcc_id() { return (unsigned)__builtin_amdgcn_s_getreg((3 << 11) | 20) & 0xFu; }
#define XB_SPIN(cond, bar) do { unsigned _sp = 0; while (cond) { __builtin_amdgcn_s_sleep(1); \
    if ((++_sp & 255u) == 0u) { if (xb_ld(&(bar)[XB_TMO])) break; if (_sp > XB_SPIN_CAP) { atomicAdd(&(bar)[XB_TMO], 1u); break; } } } } while (0)

struct XcdBarrier {
    unsigned* bar; unsigned x;
    volatile LAS unsigned* st;
};

__device__ __forceinline__ XcdBarrier xcd_barrier_post(unsigned* bar, volatile LAS unsigned* st) {
    XcdBarrier b; b.bar = bar; b.x = xb_xcc_id(); b.st = st;
    if (threadIdx.x == 0) (void)xb_add(&bar[XB_XCNT(b.x)], 1u);
    return b;
}
__device__ __forceinline__ void xcd_barrier_complete(unsigned* bar, unsigned x, unsigned& nloc, unsigned& nx) {
    const unsigned G = gridDim.x * gridDim.y * gridDim.z;
    unsigned sum, cnt, mine, sp = 0u;
    for (;;) {
        sum = 0u; cnt = 0u; mine = 0u;
#pragma unroll
        for (unsigned j = 0; j < 16; ++j) { const unsigned c = xb_ld(&bar[XB_XCNT(j)]); sum += c; cnt += (c > 0u) ? 1u : 0u; mine = (j == x) ? c : mine; }
        if (sum == G) break;
        __builtin_amdgcn_s_sleep(1);
        if ((++sp & 255u) == 0u) { if (xb_ld(&bar[XB_TMO])) break; if (sp > XB_SPIN_CAP) { atomicAdd(&bar[XB_TMO], 1u); break; } }
    }
    nloc = mine > 0u ? mine : 1u; nx = cnt > 0u ? cnt : 1u;
}

__device__ __forceinline__ void xcd_barrier(const XcdBarrier& b) {
    asm volatile("s_waitcnt vmcnt(0)" ::: "memory");
    __syncthreads();
    if (threadIdx.x == 0) {
        unsigned* bar = b.bar;
        __builtin_amdgcn_s_waitcnt(0);
        unsigned nloc = b.st[0], nx = b.st[1];
        if (nloc == 0u) { xcd_barrier_complete(bar, b.x, nloc, nx); b.st[0] = nloc; b.st[1] = nx; }
        const unsigned old = xb_add(&bar[XB_XSUB(b.x)], 1u);
        const unsigned gen = old / nloc;
        if (old + 1u == (gen + 1u) * nloc) {
            __builtin_amdgcn_fence(__ATOMIC_RELEASE, "agent");
            asm volatile("s_waitcnt vmcnt(0)" ::: "memory");
            const unsigned og = xb_add(&bar[XB_TOP], 1u);
            const unsigned tg = og / nx;
            if (og + 1u == (tg + 1u) * nx) xb_add(&bar[XB_TOPGEN], 1u);
            else XB_SPIN(xb_ld(&bar[XB_TOPGEN]) == tg, bar);
            __builtin_amdgcn_fence(__ATOMIC_ACQUIRE, "agent");
            xb_add(&bar[XB_XGEN(b.x)], 1u);
            asm volatile("s_waitcnt vmcnt(0)" ::: "memory");
        } else {
            XB_SPIN(xb_ld(&bar[XB_XGEN(b.x)]) == gen, bar);
            __builtin_amdgcn_fence(__ATOMIC_ACQUIRE, "agent");
            asm volatile("s_waitcnt vmcnt(0)" ::: "memory");
        }
    }
    __syncthreads();
}
struct Args { const float* in[30]; float* out; unsigned char* ws; int ph_lo, ph_hi; };
struct Frame {
    LAS unsigned char* lds;
    volatile LAS unsigned* MISC;
    int vcu, G;
    unsigned char* ws;
    const Args* a;
    float* out;
};
#define WSP(T, off) ((T*)(F.ws + (off)))

__device__ __forceinline__ void transpose_tile(const float* W, int ldw, int k0, int src_n0, bf16* WT, int K, int dst_n0, LAS float* scr, int lane, const float* kscale) {
#pragma unroll 8
    for (int i = 0; i < 32; ++i) { const int kk = 2 * i + (lane >> 5); float v = W[(size_t)(k0 + kk) * ldw + src_n0 + (lane & 31)]; if (kscale) v *= kscale[k0 + kk]; scr[kk * 33 + (lane & 31)] = v; }
    LDS_WAIT(); asm volatile("" ::: "memory");
    const int c = lane & 7;
#pragma unroll
    for (int j = 0; j < 4; ++j) { const int n = (lane >> 3) + 8 * j; const LAS float* s = scr + (8 * c) * 33 + n;
        v4u o; o.x = pk2(s[0 * 33], s[1 * 33]); o.y = pk2(s[2 * 33], s[3 * 33]); o.z = pk2(s[4 * 33], s[5 * 33]); o.w = pk2(s[6 * 33], s[7 * 33]);
        *(v4u*)(WT + (size_t)(dst_n0 + n) * K + k0 + 8 * c) = o; }
    LDS_WAIT(); asm volatile("" ::: "memory");
}
__device__ __forceinline__ void p0_phase(Frame& F) {
    const int f_tid = threadIdx.x, f_lane = f_tid & 63, f_wave = __builtin_amdgcn_readfirstlane(f_tid >> 6);
    const int gw = F.vcu * NWAVES + f_wave, NGW = F.G * NWAVES, gt = F.vcu * NTHR + f_tid, NGT = F.G * NTHR;
    {
        LAS float* sc = (LAS float*)F.lds;
        LAS float* red = (LAS float*)(F.lds + 65536);
        for (int i = f_tid; i < 16 * 1024; i += NTHR) { const int b = i >> 10, k = i & 1023; sc[k * 16 + b] = silu_f((F.a->in[1])[i]); }
        __syncthreads();
        const int ks = f_tid / 24, col = f_tid - ks * 24, j = F.vcu * 24 + col;
        if (ks < 21) {
            float acc[16];
#pragma unroll
            for (int b = 0; b < 16; ++b) acc[b] = 0.f;
            const int k0 = ks * 49, kn = (k0 + 49 <= 1024) ? 49 : (1024 - k0);
            const float* wp = (F.a->in[2]) + (size_t)k0 * 6144 + j;
#pragma unroll 1
            for (int kb = 0; kb < 49; kb += 7) {
                asm volatile("" ::: "memory");
                float wv[7];
#pragma unroll
                for (int u = 0; u < 7; ++u) wv[u] = (kb + u < kn) ? wp[(size_t)(kb + u) * 6144] : 0.f;
#pragma unroll
                for (int u = 0; u < 7; ++u) { const int kk = (kb + u < kn) ? (k0 + kb + u) : k0; const LAS f32x4* s4 = (const LAS f32x4*)(sc + kk * 16);
#pragma unroll
                    for (int q = 0; q < 4; ++q) { const f32x4 sv = s4[q]; acc[4 * q] += sv[0] * wv[u]; acc[4 * q + 1] += sv[1] * wv[u]; acc[4 * q + 2] += sv[2] * wv[u]; acc[4 * q + 3] += sv[3] * wv[u]; } }
            }
#pragma unroll
            for (int b = 0; b < 16; ++b) red[(ks * 16 + b) * 24 + col] = acc[b];
        }
        __syncthreads();
        for (int i = f_tid; i < 16 * 24; i += NTHR) { const int b = i / 24, cc = i - b * 24; float sacc = 0.f;
            for (int q = 0; q < 21; ++q) sacc += red[(q * 16 + b) * 24 + cc];
            WSP(float, WS_MOD)[b * 6144 + F.vcu * 24 + cc] = sacc + (F.a->in[3])[F.vcu * 24 + cc]; }
        __syncthreads();
    }
    {
        LAS float* scr = (LAS float*)(F.lds + f_wave * 16384);
        constexpr int I_IN = (1024 / 64) * (NPROJ / 32), I_OUT = (2048 / 64) * (1024 / 32);
        for (int it = gw; it < I_IN + I_OUT; it += NGW) {
            if (it < I_IN) { const int kb = it / (NPROJ / 32), nb = it % (NPROJ / 32); const int dn = 32 * nb, sn = dn < 3072 ? dn : dn + 16;
                transpose_tile((F.a->in[5]), INW, 64 * kb, sn, WSP(bf16, WS_WINT), 1024, dn, scr, f_lane, nullptr); }
            else { const int r = it - I_IN, kb = r / 32, nb = r % 32; const int k0 = 64 * kb;
                transpose_tile((F.a->in[23]), 1024, k0, 32 * nb, WSP(bf16, WS_WOUTT), 2048, 32 * nb, scr, f_lane, k0 < 1024 ? (F.a->in[11]) : (F.a->in[22]) - 1024); }
        }
    }
    for (int i = gt; i < 16 * 1024; i += NGT) { const int h = i >> 10, k = i & 1023; WSP(float, WS_WDT)[i] = (F.a->in[5])[(size_t)k * INW + 3072 + h]; }
    for (int task = gw; task < 2048; task += NGW) {
        const int nt = task >> 4, ks = task & 15, n0 = 16 * nt, hc = n0 >> 7, k0 = 64 * ks;
        const int li = f_lane & 15, lq = f_lane >> 4;
        f32x4 acc[4];
#pragma unroll
        for (int s = 0; s < 4; ++s) acc[s] = (f32x4){0.f, 0.f, 0.f, 0.f};
        const float* ap = (F.a->in[26]) + (size_t)(n0 + li) * 128 + 4 * lq;
        const float* bp = (F.a->in[25]) + (size_t)(k0 + li) * 2048 + hc * 128 + 4 * lq;
#pragma unroll
        for (int q = 0; q < 8; ++q) { const f32x4 a = *(const f32x4*)(ap + 16 * q);
#pragma unroll
            for (int s = 0; s < 4; ++s) { const f32x4 b = *(const f32x4*)(bp + (size_t)(16 * s) * 2048 + 16 * q);
#pragma unroll
                for (int jj = 0; jj < 4; ++jj) acc[s] = __builtin_amdgcn_mfma_f32_16x16x4f32(a[jj], b[jj], acc[s], 0, 0, 0); } }
        bf16* o = WSP(bf16, WS_WQKT);
#pragma unroll
        for (int s = 0; s < 4; ++s)
#pragma unroll
            for (int r = 0; r < 4; ++r) o[(size_t)(n0 + 4 * lq + r) * 1024 + k0 + 16 * s + li] = (bf16)f2bf(acc[s][r]);
    }
    for (int i = gt; i < S5G * S5P; i += NGT) {
        const float lr = (F.a->in[12])[i], li = (F.a->in[13])[i], dt = expf((F.a->in[14])[i >> 6]);
        const float mag = expf(lr * dt); float sn, cs; sincosf(li * dt, &sn, &cs);
        const float lbr = mag * cs, lbi = mag * sn, den = lr * lr + li * li;
        const float cfr = ((lbr - 1.0f) * lr + lbi * li) / den, cfi = (lbi * lr - (lbr - 1.0f) * li) / den;
        WSP(float, WS_S5LB)[2 * i] = lbr; WSP(float, WS_S5LB)[2 * i + 1] = lbi;
        for (int hh = 0; hh < 16; ++hh) { const float br = (F.a->in[15])[i * 16 + hh], bi = (F.a->in[16])[i * 16 + hh];
            WSP(float, WS_S5BB)[i * 32 + hh] = cfr * br - cfi * bi; WSP(float, WS_S5BB)[i * 32 + 16 + hh] = cfr * bi + cfi * br; }
    }
    for (int i = gt; i < MTOK; i += NGT) WSP(float, WS_ROWSTAT)[i] = 0.f;
}

__device__ __forceinline__ void p1_phase(Frame& F) {
    const int f_tid = threadIdx.x, f_lane = f_tid & 63, f_wave = __builtin_amdgcn_readfirstlane(f_tid >> 6);
    const int gw = F.vcu * NWAVES + f_wave;
    LAS float* wdt = (LAS float*)F.lds;
    for (int i = f_tid; i < 16 * 1024 / 4; i += NTHR) ((LAS f32x4*)wdt)[i] = ((const f32x4*)WSP(float, WS_WDT))[i];
    __syncthreads();
    const int lane = f_lane;
    for (int wq = gw; wq < MTOK / 16; wq += F.G * NWAVES) {
        const int b = wq >> 7; const float* mb = WSP(float, WS_MOD) + (size_t)b * 6144;
        f32x4 Gv[4], Sv[4];
#pragma unroll
        for (int j = 0; j < 4; ++j) { const int k = 4 * lane + 256 * j; const f32x4 g = *(const f32x4*)((F.a->in[4]) + k), sc = *(const f32x4*)(mb + 1024 + k); Gv[j] = g * (sc + 1.0f); Sv[j] = *(const f32x4*)(mb + k); }
        f32x4 nx[4];
#pragma unroll
        for (int j = 0; j < 4; ++j) nx[j] = *(const f32x4*)((F.a->in[0]) + (size_t)wq * 16 * 1024 + 4 * lane + 256 * j);
        for (int tt = 0; tt < 16; ++tt) {
            asm volatile("" ::: "memory");
            const size_t t = (size_t)wq * 16 + tt; const float* xr = (F.a->in[0]) + t * 1024;
            f32x4 v[4]; float ss = 0.f;
#pragma unroll
            for (int j = 0; j < 4; ++j) { v[j] = nx[j]; ss += (v[j][0] * v[j][0] + v[j][1] * v[j][1]) + (v[j][2] * v[j][2] + v[j][3] * v[j][3]); }
            if (tt < 15) {
#pragma unroll
                for (int j = 0; j < 4; ++j) nx[j] = *(const f32x4*)(xr + 1024 + 4 * lane + 256 * j); }
            const float rstd = rsqrt_f(wave_sum(ss) * (1.0f / 1024.0f) + EPSF);
            bf16* hr = WSP(bf16, WS_H1) + t * 1024;
#pragma unroll
            for (int j = 0; j < 4; ++j) { v[j] = v[j] * rstd * Gv[j] + Sv[j]; v2u w; w.x = pk2(v[j][0], v[j][1]); w.y = pk2(v[j][2], v[j][3]); *(v2u*)(hr + 4 * lane + 256 * j) = w; }
            float d[16];
#pragma unroll
            for (int h = 0; h < 16; ++h) { float a = 0.f;
#pragma unroll
                for (int j = 0; j < 4; ++j) { const f32x4 w = *(const LAS f32x4*)(wdt + h * 1024 + 4 * lane + 256 * j); a += (v[j][0] * w[0] + v[j][1] * w[1]) + (v[j][2] * w[2] + v[j][3] * w[3]); }
                d[h] = a; }
            float e8[8], e4[4], e2[2], e1;
#pragma unroll
            for (int i = 0; i < 8; ++i) { const bool up = lane & 32; const float snd = up ? d[i] : d[i + 8]; const float rcv = __shfl_xor(snd, 32); e8[i] = (up ? d[i + 8] : d[i]) + rcv; }
#pragma unroll
            for (int i = 0; i < 4; ++i) { const bool up = lane & 16; const float snd = up ? e8[i] : e8[i + 4]; const float rcv = __shfl_xor(snd, 16); e4[i] = (up ? e8[i + 4] : e8[i]) + rcv; }
#pragma unroll
            for (int i = 0; i < 2; ++i) { const bool up = lane & 8; const float snd = up ? e4[i] : e4[i + 2]; const float rcv = __shfl_xor(snd, 8); e2[i] = (up ? e4[i + 2] : e4[i]) + rcv; }
            { const bool up = lane & 4; const float snd = up ? e2[0] : e2[1]; const float rcv = __shfl_xor(snd, 4); e1 = (up ? e2[1] : e2[0]) + rcv; }
            e1 += __shfl_xor(e1, 2); e1 += __shfl_xor(e1, 1);
            const int head = ((lane >> 5) & 1) * 8 + ((lane >> 4) & 1) * 4 + ((lane >> 3) & 1) * 2 + ((lane >> 2) & 1);
            if ((lane & 3) == 0) WSP(float, WS_DTRAW)[t * 16 + head] = e1;
        }
    }
    for (int n = gw; n < 2048; n += F.G * NWAVES) {
        const bf16* wr = WSP(bf16, WS_WQKT) + (size_t)n * 1024 + 16 * lane;
        const v4u w0 = *(const v4u*)wr, w1 = *(const v4u*)(wr + 8);
        float wv[16]; wv[0] = bflo(w0.x); wv[1] = bfhi(w0.x); wv[2] = bflo(w0.y); wv[3] = bfhi(w0.y); wv[4] = bflo(w0.z); wv[5] = bfhi(w0.z); wv[6] = bflo(w0.w); wv[7] = bfhi(w0.w);
        wv[8] = bflo(w1.x); wv[9] = bfhi(w1.x); wv[10] = bflo(w1.y); wv[11] = bfhi(w1.y); wv[12] = bflo(w1.z); wv[13] = bfhi(w1.z); wv[14] = bflo(w1.w); wv[15] = bfhi(w1.w);
        for (int b = 0; b < 16; ++b) { const float* sp = WSP(float, WS_MOD) + (size_t)b * 6144 + 3072 + 16 * lane; float a = 0.f;
#pragma unroll
            for (int q = 0; q < 4; ++q) { const f32x4 s = *(const f32x4*)(sp + 4 * q); a += (s[0] * wv[4 * q] + s[1] * wv[4 * q + 1]) + (s[2] * wv[4 * q + 2] + s[3] * wv[4 * q + 3]); }
            a = wave_sum(a); if (lane == 0) WSP(float, WS_SB)[b * 2048 + n] = a; }
    }
}
__device__ __forceinline__ void p3pre_conv(Frame& F) {
    const int tid = threadIdx.x;
    const bf16* proj = WSP(bf16, WS_PROJ); bf16* xo = (bf16*)F.out;
    for (int item = F.vcu * NTHR + tid; item < (MTOK / 16) * 256; item += F.G * NTHR) {
        const int oc = item & 255, run = item >> 8; const int t0 = run * 16, ch = 8 * oc;
        const bool halo = (t0 & (SEQ - 1)) != 0;
        v4u rw[19];
#pragma unroll
        for (int k = 0; k < 19; ++k) { rw[k] = (v4u){0u, 0u, 0u, 0u}; if (k >= 3 || halo) rw[k] = *(const v4u*)(proj + (size_t)(t0 - 3 + k) * NPROJ + 1024 + ch); }
        float cw[4][8], cbv[8];
#pragma unroll
        for (int k = 0; k < 4; ++k) { const f32x4 w0 = *(const f32x4*)((F.a->in[6]) + k * 2048 + ch), w1 = *(const f32x4*)((F.a->in[6]) + k * 2048 + ch + 4);
#pragma unroll
            for (int e = 0; e < 4; ++e) { cw[k][e] = w0[e]; cw[k][4 + e] = w1[e]; } }
        { const f32x4 b0 = *(const f32x4*)((F.a->in[7]) + ch), b1 = *(const f32x4*)((F.a->in[7]) + ch + 4);
#pragma unroll
            for (int e = 0; e < 4; ++e) { cbv[e] = b0[e]; cbv[4 + e] = b1[e]; } }
        float r0[8], r1[8], r2[8];
        unpack8(rw[0], r0); unpack8(rw[1], r1); unpack8(rw[2], r2);
#pragma unroll
        for (int tt = 0; tt < 16; ++tt) {
            float r3[8]; unpack8(rw[3 + tt], r3);
            float v[8];
#pragma unroll
            for (int i = 0; i < 8; ++i) { v[i] = silu_f(cbv[i] + r0[i] * cw[0][i] + r1[i] * cw[1][i] + r2[i] * cw[2][i] + r3[i] * cw[3][i]); r0[i] = r1[i]; r1[i] = r2[i]; r2[i] = r3[i]; }
            *(v4u*)(xo + (size_t)(t0 + tt) * 2048 + ch) = (v4u){pk2(v[0], v[1]), pk2(v[2], v[3]), pk2(v[4], v[5]), pk2(v[6], v[7])};
        }
    }
}
constexpr int SSD_PITCH = 272;
__device__ __forceinline__ bf16x8 lds_frag(LAS unsigned char* base, int row, int kbyte) { return *(const LAS bf16x8*)(base + row * SSD_PITCH + kbyte); }
#ifdef PROBE_SSD
#define SPR_T(v) const unsigned long long v = __builtin_amdgcn_s_memtime();
#define SPR_ACC(i, d) sacc[i] += (d);
#else
#define SPR_T(v)
#define SPR_ACC(i, d)
#endif
constexpr int S3_CS = 0, S3_BS = 34816, S3_GY = 69632, S3_XDT = 104448, S3_XP = 144, S3_PREV = 122880, S3_CSF = 140288, S3_DTF = 141312, S3_WTS = 142336, S3_END = 143360;
static_assert(S3_END <= LDS_MAIN, "SSD v3 LDS map");
typedef short v4i16_t __attribute__((ext_vector_type(4)));
__device__ __forceinline__ bf16x8 lds_frag_tr(LAS unsigned char* tile, int pitch, int k0, int col0, int li, int lq) {
    LAS unsigned char* p = tile + (k0 + 8 * lq + (li >> 2)) * pitch + (col0 + 4 * (li & 3)) * 2;
    const v4i16_t lo = __builtin_amdgcn_ds_read_tr16_b64_v4i16((LAS v4i16_t*)p), hi = __builtin_amdgcn_ds_read_tr16_b64_v4i16((LAS v4i16_t*)(p + 4 * pitch));
    return __builtin_shufflevector(lo, hi, 0, 1, 2, 3, 4, 5, 6, 7);
}
struct Ssd3Pre { v4u xr[4], br[4], cr[4]; float d0, d1; };
__device__ __forceinline__ void ssd3_prefetch(Ssd3Pre& P, const char* xcb, const float* dtr, unsigned voB, unsigned voX, int tid, int lane, int w) {
#pragma unroll
    for (int r = 0; r < 4; ++r) { P.br[r] = *(const v4u*)(xcb + (voB + r * 4096u)); P.cr[r] = *(const v4u*)(xcb + (voB + 1024u + r * 4096u)); }
#pragma unroll
    for (int r = 0; r < 4; ++r) P.xr[r] = *(const v4u*)(xcb + (voX + r * 4096u));
    P.d0 = dtr[lane * 32]; P.d1 = dtr[lane * 32 + 16];
}
__device__ __forceinline__ void ssd3_cumsum(LAS unsigned char* L, int par, float r0, float r1, float dtb, float A, int lane) {
    LAS float* csf = (LAS float*)(L + S3_CSF + par * 512); LAS float* dtf = (LAS float*)(L + S3_DTF + par * 512); LAS float* wts = (LAS float*)(L + S3_WTS + par * 512);
    const float d0 = softplus_f(r0 + dtb), d1 = softplus_f(r1 + dtb);
    const float a0 = d0 * A, a1 = d1 * A; float s = a0 + a1;
#pragma unroll
    for (int o = 1; o < 64; o <<= 1) { const float t = __shfl_up(s, o); if (lane >= o) s += t; }
    const float tot = __shfl(s, 63);
    dtf[2 * lane] = d0; dtf[2 * lane + 1] = d1; csf[2 * lane] = s - a1; csf[2 * lane + 1] = s;
    wts[2 * lane] = __expf(tot - (s - a1)); wts[2 * lane + 1] = __expf(tot - s);
}
__device__ __forceinline__ void p3_ssd3(Frame& F) {
    const int tid0 = threadIdx.x, w = __builtin_amdgcn_readfirstlane(tid0 >> 6);
    LAS unsigned char* L = F.lds;
    const bf16* proj = WSP(bf16, WS_PROJ); const bf16* xc = (const bf16*)F.out; const float* dtraw = WSP(float, WS_DTRAW);
    for (int item = F.vcu; item < NB * NHEADS; item += F.G) {
        const int b = item >> 4, h = item & 15, g = h >> 2;
        int tid = tid0; asm volatile("" : "+v"(tid)); int lane = tid & 63;
        const float A = -__expf((F.a->in[9])[h]), Dh = (F.a->in[10])[h], dtb = (F.a->in[8])[h];
        const int pbs = w >> 1, nb0 = 4 * (w & 1);
        f32x4 st[4];
#pragma unroll
        for (int j = 0; j < 4; ++j) st[j] = (f32x4){0.f, 0.f, 0.f, 0.f};
        __syncthreads();
        for (int i = tid; i < 17408 / 16; i += NTHR) ((LAS v4u*)(L + S3_PREV))[i] = (v4u){0u, 0u, 0u, 0u};
        Ssd3Pre P;
        { const unsigned voB0 = (unsigned)((4 * (tid >> 4)) * 2048 + 1024 + g * 128 + 8 * (tid & 15)) * 2u, voX0 = (unsigned)((4 * ((tid & 255) >> 3)) * 2048 + h * 64 + 8 * (tid & 7)) * 2u;
          ssd3_prefetch(P, (const char*)xc + (size_t)b * SEQ * 4096, dtraw + (size_t)b * SEQ * 16 + h, voB0, voX0, tid, lane, w); }
        if (w == 0) ssd3_cumsum(L, 0, P.d0, P.d1, dtb, A, lane);
        __syncthreads();
#ifdef PROBE_SSD
        unsigned long long sacc[8] = {0, 0, 0, 0, 0, 0, 0, 0};
#endif
        for (int c = 0; c < SEQ / CHUNK; ++c) {
            SPR_T(s0)
            const size_t row0 = (size_t)b * SEQ + (size_t)c * CHUNK; const int par = c & 1;
            asm volatile("" : "+v"(tid));
            lane = tid & 63; const int li = lane & 15, lq = lane >> 4;
            const unsigned voB = (unsigned)((4 * (tid >> 4)) * 2048 + 1024 + g * 128 + 8 * (tid & 15)) * 2u, voX = (unsigned)((4 * ((tid & 255) >> 3)) * 2048 + h * 64 + 8 * (tid & 7)) * 2u;
            const unsigned voZ0 = (unsigned)((tid >> 3) * NPROJ + h * 64 + 8 * (tid & 7)) * 2u, voZ1 = voZ0 + 64u * NPROJ * 2u;
            LAS float* csf = (LAS float*)(L + S3_CSF + par * 512); LAS float* dtf = (LAS float*)(L + S3_DTF + par * 512); LAS float* wts = (LAS float*)(L + S3_WTS + par * 512);
            { const int ob = tid & 15, lb = 4 * (tid >> 4), n0 = 8 * ob;
#pragma unroll
              for (int r = 0; r < 4; ++r) { *(LAS v4u*)(L + S3_BS + (lb + r) * SSD_PITCH + n0 * 2) = P.br[r]; *(LAS v4u*)(L + S3_CS + (lb + r) * SSD_PITCH + n0 * 2) = P.cr[r]; } }
            if (tid < 256) { const int ox = tid & 7, lx = 4 * (tid >> 3), p0 = 8 * ox;
#pragma unroll
              for (int r = 0; r < 4; ++r) { float xv[8]; unpack8(P.xr[r], xv); const float tw = dtf[lx + r];
                  *(LAS v4u*)(L + S3_XDT + (lx + r) * S3_XP + p0 * 2) = (v4u){pk2(xv[0] * tw, xv[1] * tw), pk2(xv[2] * tw, xv[3] * tw), pk2(xv[4] * tw, xv[5] * tw), pk2(xv[6] * tw, xv[7] * tw)}; } }
            const char* prb = (const char*)proj + row0 * (NPROJ * 2);
            const v4u zc0 = *(const v4u*)(prb + voZ0), zc1 = *(const v4u*)(prb + voZ1);
            SPR_T(s1) SPR_ACC(0, s1 - s0)
            LDS_BARRIER();
            SPR_T(s2) SPR_ACC(1, s2 - s1)
            const float cs_end = csf[127];
            bf16x8 ca[4];
#pragma unroll
            for (int ks = 0; ks < 4; ++ks) ca[ks] = lds_frag(L + S3_CS, 16 * w + li, 64 * ks + 16 * lq);
            float csl[4];
#pragma unroll
            for (int r = 0; r < 4; ++r) csl[r] = csf[16 * w + 4 * lq + r];
            { bf16x8 bq[2][4];
#pragma unroll
              for (int ks = 0; ks < 4; ++ks) bq[0][ks] = lds_frag(L + S3_BS, li, 64 * ks + 16 * lq);
#pragma unroll
              for (int sb = 0; sb < 8; ++sb) if (sb <= (w | 1)) {
                  f32x4 cbv = (f32x4){0.f, 0.f, 0.f, 0.f};
                  const int s = 16 * sb + li; const float css = csf[s];
                  if (sb <= w) {
                      if (sb + 1 <= w) {
#pragma unroll
                          for (int ks = 0; ks < 4; ++ks) bq[(sb + 1) & 1][ks] = lds_frag(L + S3_BS, 16 * (sb + 1) + li, 64 * ks + 16 * lq); }
                      __builtin_amdgcn_sched_barrier(0);
#pragma unroll
                      for (int ks = 0; ks < 4; ++ks) cbv = __builtin_amdgcn_mfma_f32_16x16x32_bf16(ca[ks], bq[sb & 1][ks], cbv, 0, 0, 0);
                      __builtin_amdgcn_sched_barrier(0); }
#pragma unroll
                  for (int r = 0; r < 4; ++r) { const int l = 16 * w + 4 * lq + r; const float gv = (s <= l) ? cbv[r] * __expf(csl[r] - css) : 0.f;
                      *(LAS unsigned short*)(L + S3_GY + l * SSD_PITCH + s * 2) = (unsigned short)f2bf(gv); } } }
            LDS_WAIT(); asm volatile("" ::: "memory");
            SPR_T(s3) SPR_ACC(2, s3 - s2)
            f32x4 yd[4], yo[4];
#pragma unroll
            for (int pb = 0; pb < 4; ++pb) { yd[pb] = (f32x4){0.f, 0.f, 0.f, 0.f}; yo[pb] = (f32x4){0.f, 0.f, 0.f, 0.f}; }
            { bf16x8 gq[2], xq[2][4];
              gq[0] = lds_frag(L + S3_GY, 16 * w + li, 16 * lq);
#pragma unroll
              for (int pb = 0; pb < 4; ++pb) xq[0][pb] = lds_frag_tr(L + S3_XDT, S3_XP, 0, 16 * pb, li, lq);
#pragma unroll
              for (int ks = 0; ks < 4; ++ks) if (ks <= (w >> 1)) {
                  if (ks + 1 <= (w >> 1)) { gq[(ks + 1) & 1] = lds_frag(L + S3_GY, 16 * w + li, 64 * (ks + 1) + 16 * lq);
#pragma unroll
                      for (int pb = 0; pb < 4; ++pb) xq[(ks + 1) & 1][pb] = lds_frag_tr(L + S3_XDT, S3_XP, 32 * (ks + 1), 16 * pb, li, lq); }
                  __builtin_amdgcn_sched_barrier(0);
#pragma unroll
                  for (int pb = 0; pb < 4; ++pb) yd[pb] = __builtin_amdgcn_mfma_f32_16x16x32_bf16(gq[ks & 1], xq[ks & 1][pb], yd[pb], 0, 0, 0);
                  __builtin_amdgcn_sched_barrier(0); } }
            { bf16x8 pq[2][4];
#pragma unroll
              for (int pb = 0; pb < 4; ++pb) pq[0][pb] = lds_frag(L + S3_PREV, 16 * pb + li, 16 * lq);
#pragma unroll
              for (int ks = 0; ks < 4; ++ks) {
                  if (ks < 3) {
#pragma unroll
                      for (int pb = 0; pb < 4; ++pb) pq[(ks + 1) & 1][pb] = lds_frag(L + S3_PREV, 16 * pb + li, 64 * (ks + 1) + 16 * lq); }
                  __builtin_amdgcn_sched_barrier(0);
#pragma unroll
                  for (int pb = 0; pb < 4; ++pb) yo[pb] = __builtin_amdgcn_mfma_f32_16x16x32_bf16(ca[ks], pq[ks & 1][pb], yo[pb], 0, 0, 0);
                  __builtin_amdgcn_sched_barrier(0); } }
#pragma unroll
            for (int r = 0; r < 4; ++r) { const float e = __expf(csl[r]);
#pragma unroll
                for (int pb = 0; pb < 4; ++pb) *(LAS float*)(L + S3_GY + (16 * w + 4 * lq + r) * SSD_PITCH + (16 * pb + li) * 4) = yd[pb][r] + e * yo[pb][r]; }
            { const size_t rown = row0 + (c + 1 < SEQ / CHUNK ? CHUNK : 0);
              ssd3_prefetch(P, (const char*)xc + rown * 4096, dtraw + rown * 16 + h, voB, voX, tid, lane, w); }
            SPR_T(s4) SPR_ACC(3, s4 - s3)
            LDS_BARRIER();
            SPR_T(s5) SPR_ACC(4, s5 - s4)
            { const float dec = __expf(cs_end);
#pragma unroll
              for (int j = 0; j < 4; ++j) st[j] = st[j] * dec;
              bf16x8 xq[2], bq2[2][4]; f32x4 wq[2][2];
              xq[0] = lds_frag_tr(L + S3_XDT, S3_XP, 0, 16 * pbs, li, lq); wq[0][0] = *(const LAS f32x4*)(wts + 8 * lq); wq[0][1] = *(const LAS f32x4*)(wts + 8 * lq + 4);
#pragma unroll
              for (int j = 0; j < 4; ++j) bq2[0][j] = lds_frag_tr(L + S3_BS, SSD_PITCH, 0, 16 * (nb0 + j), li, lq);
#pragma unroll
              for (int ks = 0; ks < 4; ++ks) {
                  if (ks < 3) { xq[(ks + 1) & 1] = lds_frag_tr(L + S3_XDT, S3_XP, 32 * (ks + 1), 16 * pbs, li, lq); wq[(ks + 1) & 1][0] = *(const LAS f32x4*)(wts + 32 * (ks + 1) + 8 * lq); wq[(ks + 1) & 1][1] = *(const LAS f32x4*)(wts + 32 * (ks + 1) + 8 * lq + 4);
#pragma unroll
                      for (int j = 0; j < 4; ++j) bq2[(ks + 1) & 1][j] = lds_frag_tr(L + S3_BS, SSD_PITCH, 32 * (ks + 1), 16 * (nb0 + j), li, lq); }
                  __builtin_amdgcn_sched_barrier(0);
                  const f32x4 w0 = wq[ks & 1][0], w1 = wq[ks & 1][1];
                  float xv[8]; unpack8(__builtin_bit_cast(v4u, xq[ks & 1]), xv);
                  const v4u xw = (v4u){pk2(xv[0] * w0[0], xv[1] * w0[1]), pk2(xv[2] * w0[2], xv[3] * w0[3]), pk2(xv[4] * w1[0], xv[5] * w1[1]), pk2(xv[6] * w1[2], xv[7] * w1[3])};
                  const bf16x8 xf = __builtin_bit_cast(bf16x8, xw);
#pragma unroll
                  for (int j = 0; j < 4; ++j) st[j] = __builtin_amdgcn_mfma_f32_16x16x32_bf16(xf, bq2[ks & 1][j], st[j], 0, 0, 0);
                  __builtin_amdgcn_sched_barrier(0); }
#pragma unroll
              for (int j = 0; j < 4; ++j)
#pragma unroll
                  for (int r = 0; r < 4; ++r) *(LAS unsigned short*)(L + S3_PREV + (16 * pbs + 4 * lq + r) * SSD_PITCH + (16 * (nb0 + j) + li) * 2) = (unsigned short)f2bf(st[j][r]); }
            SPR_T(s6) SPR_ACC(5, s6 - s5)
#pragma unroll
            for (int k = 0; k < 2; ++k) { const int it = tid + 512 * k, l = it >> 3, o = it & 7; const size_t row = row0 + l;
                const f32x4 y0 = *(const LAS f32x4*)(L + S3_GY + l * SSD_PITCH + 32 * o), y1 = *(const LAS f32x4*)(L + S3_GY + l * SSD_PITCH + 32 * o + 16);
                const v4u xw = *(const LAS v4u*)(L + S3_XDT + l * S3_XP + 16 * o); const v4u zw = k == 0 ? zc0 : zc1; const float dsk = Dh * __builtin_amdgcn_rcpf(fmaxf(dtf[l], 1e-30f));
                float xv[8], zv[8], yv[8]; unpack8(xw, xv); unpack8(zw, zv);
                float ss = 0.f;
#pragma unroll
                for (int e = 0; e < 8; ++e) { const float yy = (e < 4 ? y0[e] : y1[e - 4]) + dsk * xv[e]; yv[e] = yy * silu_f(zv[e]); ss += yv[e] * yv[e]; }
                ss += __shfl_xor(ss, 1); ss += __shfl_xor(ss, 2); ss += __shfl_xor(ss, 4);
                if (o == 0) WSP(float, WS_STSSD)[row * 16 + h] = ss;
                *(v4u*)(WSP(bf16, WS_Y) + row * 2048 + h * 64 + 8 * o) = (v4u){pk2(yv[0], yv[1]), pk2(yv[2], yv[3]), pk2(yv[4], yv[5]), pk2(yv[6], yv[7])}; }
            if (w == 0 && c + 1 < SEQ / CHUNK) ssd3_cumsum(L, par ^ 1, P.d0, P.d1, dtb, A, lane);
            SPR_T(s7) SPR_ACC(6, s7 - s6)
            LDS_BARRIER();
            SPR_T(s8) SPR_ACC(7, s8 - s7)
        }
#ifdef PROBE_SSD
        if (blockIdx.x == 0 && threadIdx.x == PROBE_TID) *(volatile float*)(F.ws + WS_CTL + 40000) = (float)sacc[PROBE_SSD] * 1e-3f;
#endif
    }
}
typedef float f32x16 __attribute__((ext_vector_type(16)));
#ifdef PROBE_SEL
#define PR_T(v) const unsigned long long v = __builtin_amdgcn_s_memtime();
#define PR_ACC(a, d) a += (d);
#define PR_OUT(i, a) if (PROBE_SEL == (i) && blockIdx.x == 0 && threadIdx.x == 0) *(volatile float*)(F.ws + WS_CTL + 40000) = (float)(a) * 1e-4f;
#define PR_OUT4(i, a) if (PROBE_SEL == (i) && blockIdx.x == 0 && threadIdx.x == 256) *(volatile float*)(F.ws + WS_CTL + 40000) = (float)(a) * 1e-4f;
#else
#define PR_T(v)
#define PR_ACC(a, d)
#define PR_OUT(i, a)
#define PR_OUT4(i, a)
#endif
constexpr int S5V_BU = 0, S5V_BUP = 2056, S5V_BUSZ = 16 * S5V_BUP, S5V_XT = 2 * S5V_BUSZ, S5V_XTP = 1040, S5V_XTSZ = 16 * S5V_XTP, S5V_VS = S5V_XT + 2 * S5V_XTSZ, S5V_OT = S5V_VS + 4 * 512, S5V_OTP = 144, S5V_OTSZ = 16 * S5V_OTP, S5V_END = S5V_OT + 2 * S5V_OTSZ;
static_assert(S5V_END <= LDS_MAIN, "S5 v2 LDS map");
__device__ __forceinline__ void p3_s5v2(Frame& F) {
    const int tid = threadIdx.x, lane = tid & 63, w = __builtin_amdgcn_readfirstlane(tid >> 6);
    const int li = lane & 15, lq = lane >> 4;
    LAS unsigned char* L = F.lds;
    const bf16* proj = WSP(bf16, WS_PROJ);
    constexpr int NT = SEQ / 16;
#ifdef PROBE_S5
    const unsigned long long pr_t0 = PROBE_CLOCK();
#endif
    for (int item = F.vcu; item < NB * 16; item += F.G) {
        const int b = item >> 4, gs = item & 15;
        const bool scanw = w < 4; const int gl = w & 3, g = gs * 4 + gl;
        const bf16* ubase = proj + (size_t)b * SEQ * NPROJ + 3072 + gs * 64 + gl * 16;
        __syncthreads();
        if (scanw) {
            __builtin_amdgcn_s_setprio(2);
            const float lbr = WSP(float, WS_S5LB)[(g * 64 + lane) * 2], lbi = WSP(float, WS_S5LB)[(g * 64 + lane) * 2 + 1], nlbi = -lbi;
            bf16x8 bfr[8];
#pragma unroll
            for (int cb = 0; cb < 8; ++cb) { v4u v = (v4u){0u, 0u, 0u, 0u};
                if (lq < 2) { const int col = 16 * cb + li; const float* src = WSP(float, WS_S5BB) + (g * 64 + (col >> 1)) * 32 + (col & 1) * 16 + 8 * lq; const f32x4 a0 = *(const f32x4*)src, a1 = *(const f32x4*)(src + 4);
                    v = (v4u){pk2(a0[0], a0[1]), pk2(a0[2], a0[3]), pk2(a1[0], a1[1]), pk2(a1[2], a1[3])}; }
                bfr[cb] = __builtin_bit_cast(bf16x8, v); }
            float xr = 0.f, xi = 0.f;
            const int lq2 = lq & 1;
            v4u ua = *(const v4u*)(ubase + (size_t)li * NPROJ + 8 * lq2);
            { const bf16x8 af = __builtin_bit_cast(bf16x8, lq < 2 ? ua : (v4u){0u, 0u, 0u, 0u});
              ua = *(const v4u*)(ubase + (size_t)(16 + li) * NPROJ + 8 * lq2);
#pragma unroll
              for (int cb = 0; cb < 8; ++cb) { f32x4 acc = (f32x4){0.f, 0.f, 0.f, 0.f}; acc = __builtin_amdgcn_mfma_f32_16x16x32_bf16(af, bfr[cb], acc, 0, 0, 0);
#pragma unroll
                  for (int r = 0; r < 4; ++r) *(LAS float*)(L + S5V_BU + (4 * lq + r) * S5V_BUP + (gl * 128 + 16 * cb + li) * 4) = acc[r]; } }
            LDS_BARRIER();
            unsigned long long pa0 = 0, pa1 = 0, pa2 = 0;
            for (int k = 0; k <= NT; ++k) {
                PR_T(pt0)
                if (k < NT) {
                    const LAS f32x2* bp = (const LAS f32x2*)(L + S5V_BU + (k & 1) * S5V_BUSZ + (gl * 128 + 2 * lane) * 4);
                    LAS unsigned* xp = (LAS unsigned*)(L + S5V_XT + (k & 1) * S5V_XTSZ + (gl * 128 + 2 * lane) * 2);
                    f32x2 bu[16];
#pragma unroll
                    for (int t = 0; t < 16; ++t) bu[t] = bp[t * (S5V_BUP / 8)];
                    unsigned xo[16];
#pragma unroll
                    for (int t = 0; t < 16; ++t) {
                        const float a = __builtin_fmaf(nlbi, xi, bu[t][0]), bq = __builtin_fmaf(lbi, xr, bu[t][1]);
                        const float nr = __builtin_fmaf(lbr, xr, a), ni = __builtin_fmaf(lbr, xi, bq); xr = nr; xi = ni; xo[t] = pk2(xr, xi); }
#pragma unroll
                    for (int t = 0; t < 16; ++t) xp[t * (S5V_XTP / 4)] = xo[t];
                    PR_T(pt1) PR_ACC(pa0, pt1 - pt0)
                    if (k + 1 < NT) {
                        const bf16x8 af = __builtin_bit_cast(bf16x8, lq < 2 ? ua : (v4u){0u, 0u, 0u, 0u});
                        { const int kn = k + 2 < NT ? k + 2 : NT - 1; ua = *(const v4u*)(ubase + (size_t)(16 * kn + li) * NPROJ + 8 * lq2); }
                        LAS unsigned char* bun = L + S5V_BU + ((k + 1) & 1) * S5V_BUSZ;
#pragma unroll
                        for (int cb = 0; cb < 8; ++cb) { f32x4 acc = (f32x4){0.f, 0.f, 0.f, 0.f}; acc = __builtin_amdgcn_mfma_f32_16x16x32_bf16(af, bfr[cb], acc, 0, 0, 0);
#pragma unroll
                            for (int r = 0; r < 4; ++r) *(LAS float*)(bun + (4 * lq + r) * S5V_BUP + (gl * 128 + 16 * cb + li) * 4) = acc[r]; }
                    }
                }
                PR_T(pt2) PR_ACC(pa1, pt2 - pt0)
                LDS_BARRIER();
                PR_T(pt3) PR_ACC(pa2, pt3 - pt2)
            }
            __builtin_amdgcn_s_setprio(0);
            PR_OUT(0, pa0) PR_OUT(1, pa1) PR_OUT(2, pa2)
        } else {
            bf16x8 cfr[4];
#pragma unroll
            for (int ks = 0; ks < 4; ++ks) { const float* cr = (F.a->in[17]) + (g * 16 + li) * 64 + 16 * ks + 4 * lq; const float* ci = (F.a->in[18]) + (g * 16 + li) * 64 + 16 * ks + 4 * lq;
                const f32x4 r0 = *(const f32x4*)cr, i0 = *(const f32x4*)ci;
                cfr[ks] = __builtin_bit_cast(bf16x8, ((v4u){pk2(r0[0], -i0[0]), pk2(r0[1], -i0[1]), pk2(r0[2], -i0[2]), pk2(r0[3], -i0[3])})); }
            v4u gwv = (v4u){0u, 0u, 0u, 0u};
            if (lq < 2) { float gwf[8];
#pragma unroll
                for (int j = 0; j < 8; ++j) gwf[j] = (F.a->in[20])[(g * 16 + 8 * lq + j) * 16 + li];
                gwv = (v4u){pk2(gwf[0], gwf[1]), pk2(gwf[2], gwf[3]), pk2(gwf[4], gwf[5]), pk2(gwf[6], gwf[7])}; }
            const bf16x8 gfr = __builtin_bit_cast(bf16x8, gwv);
            const float dsk = (F.a->in[19])[g * 16 + li], gbias = (F.a->in[21])[g * 16 + li];
            LAS unsigned char* vs = L + S5V_VS + gl * 512;
            float uo[4], un[4];
#pragma unroll
            for (int r = 0; r < 4; ++r) { uo[r] = bf2f(ubase[(size_t)(4 * lq + r) * NPROJ + li]); un[r] = bf2f(ubase[(size_t)(16 + 4 * lq + r) * NPROJ + li]); }
            LDS_BARRIER();
            unsigned long long pb0 = 0, pb1 = 0;
            for (int k = 0; k <= NT; ++k) {
                PR_T(qt0)
                float u2[4];
                { const int kn = k + 1 < NT ? k + 1 : NT - 1;
#pragma unroll
                  for (int r = 0; r < 4; ++r) u2[r] = bf2f(ubase[(size_t)(16 * kn + 4 * lq + r) * NPROJ + li]); }
                if (k >= 2) {
                    const int t = ((tid - 256) >> 3) & 15, oc = tid & 7; const v4u ov = *(const LAS v4u*)(L + S5V_OT + (k & 1) * S5V_OTSZ + t * S5V_OTP + 16 * oc);
                    if (tid < 384) *(v4u*)(WSP(bf16, WS_Y) + ((size_t)b * SEQ + 16 * (k - 2) + t) * 2048 + 1024 + gs * 64 + 8 * oc) = ov; }
                if (k >= 1) {
                    const int kt = k - 1; const LAS unsigned char* xt = L + S5V_XT + (kt & 1) * S5V_XTSZ;
                    f32x4 yacc = (f32x4){0.f, 0.f, 0.f, 0.f};
#pragma unroll
                    for (int ks = 0; ks < 4; ++ks) yacc = __builtin_amdgcn_mfma_f32_16x16x32_bf16(*(const LAS bf16x8*)(xt + li * S5V_XTP + (gl * 128 + 32 * ks + 8 * lq) * 2), cfr[ks], yacc, 0, 0, 0);
                    float v[4];
                    { const f32x2 g0 = gelu_pk2((f32x2){yacc[0] + dsk * uo[0], yacc[1] + dsk * uo[1]}), g1 = gelu_pk2((f32x2){yacc[2] + dsk * uo[2], yacc[3] + dsk * uo[3]}); v[0] = g0[0]; v[1] = g0[1]; v[2] = g1[0]; v[3] = g1[1]; }
#pragma unroll
                    for (int r = 0; r < 4; ++r) *(LAS unsigned short*)(vs + (4 * lq + r) * 32 + li * 2) = (unsigned short)f2bf(v[r]);
                    LDS_WAIT(); asm volatile("" ::: "memory");
                    v4u va = (v4u){0u, 0u, 0u, 0u};
                    if (lq < 2) va = *(const LAS v4u*)(vs + li * 32 + 16 * lq);
                    f32x4 gacc = (f32x4){0.f, 0.f, 0.f, 0.f};
                    gacc = __builtin_amdgcn_mfma_f32_16x16x32_bf16(__builtin_bit_cast(bf16x8, va), gfr, gacc, 0, 0, 0);
                    float o[4], ss[4];
#pragma unroll
                    for (int r = 0; r < 4; ++r) { o[r] = v[r] * sigmoid_f(gacc[r] + gbias); ss[r] = o[r] * o[r]; }
#pragma unroll
                    for (int r = 0; r < 4; ++r) ss[r] = row16_sum_to15(ss[r]);
                    if (li == 15) {
#pragma unroll
                        for (int r = 0; r < 4; ++r) WSP(float, WS_STS5)[((size_t)b * SEQ + 16 * kt + 4 * lq + r) * NS5PART + g] = ss[r]; }
                    LAS unsigned char* ot = L + S5V_OT + (kt & 1) * S5V_OTSZ;
#pragma unroll
                    for (int r = 0; r < 4; ++r) *(LAS unsigned short*)(ot + (4 * lq + r) * S5V_OTP + (gl * 16 + li) * 2) = (unsigned short)f2bf(o[r]);
#pragma unroll
                    for (int r = 0; r < 4; ++r) { uo[r] = un[r]; un[r] = u2[r]; }
                }
                PR_T(qt1) PR_ACC(pb0, qt1 - qt0)
                LDS_BARRIER();
                PR_T(qt2) PR_ACC(pb1, qt2 - qt1)
            }
            PR_OUT4(3, pb0) PR_OUT4(4, pb1)
            { const int t = ((tid - 256) >> 3) & 15, oc = tid & 7; const v4u ov = *(const LAS v4u*)(L + S5V_OT + ((NT - 1) & 1) * S5V_OTSZ + t * S5V_OTP + 16 * oc);
              if (tid < 384) *(v4u*)(WSP(bf16, WS_Y) + ((size_t)b * SEQ + 16 * (NT - 1) + t) * 2048 + 1024 + gs * 64 + 8 * oc) = ov; }
        }
    }
#ifdef PROBE_S5
    if (blockIdx.x == 0 && threadIdx.x == 0) *(volatile float*)(F.ws + WS_CTL + 40000) = (float)(PROBE_CLOCK() - pr_t0) * PROBE_SCALE;
#endif
}
__device__ __forceinline__ unsigned med3u(unsigned a, unsigned b, unsigned c) { unsigned r; asm("v_med3_u32 %0, %1, %2, %3" : "=v"(r) : "v"(a), "v"(b), "v"(c)); return r; }
__device__ __forceinline__ unsigned fkey(float v) { const unsigned u = __builtin_bit_cast(unsigned, v); return (u & 0x80000000u) ? ~u : (u | 0x80000000u); }
__device__ __forceinline__ float fkey_inv(unsigned k) { const unsigned u = (k & 0x80000000u) ? (k & 0x7fffffffu) : ~k; return __builtin_bit_cast(float, u); }
#define TOPK_INSERT(a, x) do { _Pragma("unroll") for (int _i = 15; _i >= 1; --_i) a[_i] = med3u(a[_i - 1], a[_i], (x)); a[0] = a[0] > (x) ? a[0] : (x); } while (0)
__device__ __forceinline__ unsigned fp6_code(float y) {
    const float a = fabsf(y);
    const float c = a < 2.0f ? __builtin_rintf(8.0f * a) : (a < 4.0f ? __builtin_rintf(4.0f * a) + 8.0f : fminf(__builtin_rintf(2.0f * a) + 16.0f, 31.0f));
    return (unsigned)c | (y < 0.f ? 32u : 0u);
}
__device__ __forceinline__ void fp6_pack16(const unsigned* c, unsigned& w0, unsigned& w1, unsigned& w2) {
    w0 = c[0] | (c[1] << 6) | (c[2] << 12) | (c[3] << 18) | (c[4] << 24) | (c[5] << 30);
    w1 = (c[5] >> 2) | (c[6] << 4) | (c[7] << 10) | (c[8] << 16) | (c[9] << 22) | (c[10] << 28);
    w2 = (c[10] >> 4) | (c[11] << 2) | (c[12] << 8) | (c[13] << 14) | (c[14] << 20) | (c[15] << 26);
}
__device__ __forceinline__ void h2_convert(Frame& F, int w0, int nw, int f_lane) {
    for (int tb = w0 * 16; tb < MTOK; tb += nw * 16) {
        const float* sh = WSP(float, WS_MOD) + (size_t)(tb >> 11) * 6144 + 3072 + 16 * f_lane;
        float S2[16];
#pragma unroll
        for (int q = 0; q < 4; ++q) { const f32x4 s4 = *(const f32x4*)(sh + 4 * q); S2[4 * q] = s4[0]; S2[4 * q + 1] = s4[1]; S2[4 * q + 2] = s4[2]; S2[4 * q + 3] = s4[3]; }
#pragma unroll 1
        for (int k = 0; k < 16; k += 4) {
            v4u xa[4], xb[4]; float rst[4];
#pragma unroll
            for (int u = 0; u < 4; ++u) { const int t = tb + k + u; const char* xs = (const char*)(WSP(bf16, WS_X1S) + (size_t)t * 1024) + 32 * f_lane; xa[u] = *(const v4u*)xs; xb[u] = *(const v4u*)(xs + 16); rst[u] = WSP(float, WS_ROWSTAT)[t]; }
#pragma unroll
            for (int u = 0; u < 4; ++u) { const int t = tb + k + u;
                const float rs = rsqrt_f(rst[u] * (1.0f / 1024.0f) + EPSF);
                float h2[16]; unpack8(xa[u], h2); unpack8(xb[u], h2 + 8); float mx = 0.f;
#pragma unroll
                for (int i = 0; i < 16; ++i) { h2[i] = h2[i] * rs + S2[i]; mx = fmaxf(mx, fabsf(h2[i])); }
#pragma unroll
                for (int o = 1; o < 64; o <<= 1) mx = fmaxf(mx, __shfl_xor(mx, o));
                mx = fmaxf(mx, 1e-30f); const float hs = 224.0f / mx;
                v4u w;
#pragma unroll
                for (int q = 0; q < 4; ++q) { int pk = 0; pk = __builtin_amdgcn_cvt_pk_fp8_f32(h2[4 * q] * hs, h2[4 * q + 1] * hs, pk, false); pk = __builtin_amdgcn_cvt_pk_fp8_f32(h2[4 * q + 2] * hs, h2[4 * q + 3] * hs, pk, true); w[q] = (unsigned)pk; }
                *(v4u*)(F.ws + WS_H2Q + (size_t)t * 1024 + 16 * f_lane) = w;
                if (f_lane == 0) WSP(float, WS_HINV)[t] = mx * (1.0f / 224.0f); }
        }
    }
}
__device__ __forceinline__ void expert_convert(Frame& F, int w0, int nw, int f_lane) {
    for (int rw = w0; rw < 2 * 16384; rw += 2 * nw) {
        f32x4 v[2][4]; float mx[2];
#pragma unroll
        for (int u = 0; u < 2; ++u) { const int r = rw + u * nw; const int tb = r >= 16384, e = tb ? r - 16384 : r; const float* src = (tb ? (F.a->in[28]) : (F.a->in[27])) + (size_t)e * 1024 + 16 * f_lane;
#pragma unroll
            for (int q = 0; q < 4; ++q) v[u][q] = *(const f32x4*)(src + 4 * q); }
#pragma unroll
        for (int u = 0; u < 2; ++u) { float m = 0.f;
#pragma unroll
            for (int q = 0; q < 4; ++q) m = fmaxf(m, fmaxf(fmaxf(fabsf(v[u][q][0]), fabsf(v[u][q][1])), fmaxf(fabsf(v[u][q][2]), fabsf(v[u][q][3]))));
#pragma unroll
            for (int o = 1; o < 64; o <<= 1) m = fmaxf(m, __shfl_xor(m, o));
            mx[u] = fmaxf(m, 1e-30f); }
        {
            typedef float f32x16 __attribute__((ext_vector_type(16))); typedef unsigned v6u_t __attribute__((ext_vector_type(6)));
            const float sa = 7.5f / mx[0], sb = 7.5f / mx[1]; f32x16 s0, s1;
#pragma unroll
            for (int i = 0; i < 8; ++i) {
                s0[i] = v[0][(2 * i) >> 2][(2 * i) & 3] * sa; s1[i] = v[0][(2 * i + 1) >> 2][(2 * i + 1) & 3] * sa; s0[8 + i] = v[1][(2 * i) >> 2][(2 * i) & 3] * sb; s1[8 + i] = v[1][(2 * i + 1) >> 2][(2 * i + 1) & 3] * sb;
            }
            const v6u_t enc = __builtin_amdgcn_cvt_scalef32_2xpk16_fp6_f32(s0, s1, 1.0f);
#pragma unroll
            for (int u = 0; u < 2; ++u) { const int r = rw + u * nw; const int tb = r >= 16384, e = tb ? r - 16384 : r;
                unsigned* dst = (unsigned*)(F.ws + (tb ? WS_EV : WS_EU) + (size_t)e * 768 + 12 * f_lane); dst[0] = enc[3 * u]; dst[1] = enc[3 * u + 1]; dst[2] = enc[3 * u + 2];
                if (f_lane == 0) WSP(float, tb ? WS_EVS : WS_EUS)[e] = mx[u] * (1.0f / 7.5f); }
            continue;
        }
#pragma unroll
        for (int u = 0; u < 2; ++u) { const int r = rw + u * nw; const int tb = r >= 16384, e = tb ? r - 16384 : r; const float sc = 224.0f / mx[u];
            v4u w;
#pragma unroll
            for (int q = 0; q < 4; ++q) { int pk = 0; pk = __builtin_amdgcn_cvt_pk_fp8_f32(v[u][q][0] * sc, v[u][q][1] * sc, pk, false); pk = __builtin_amdgcn_cvt_pk_fp8_f32(v[u][q][2] * sc, v[u][q][3] * sc, pk, true); w[q] = (unsigned)pk; }
            {
                const float s6 = 7.5f / mx[u]; unsigned cd[16];
#pragma unroll
                for (int q = 0; q < 4; ++q)
#pragma unroll
                    for (int i = 0; i < 4; ++i) cd[4 * q + i] = fp6_code(v[u][q][i] * s6);
                unsigned w0, w1, w2; fp6_pack16(cd, w0, w1, w2);
                unsigned* dst = (unsigned*)(F.ws + (tb ? WS_EV : WS_EU) + (size_t)e * 768 + 12 * f_lane); dst[0] = w0; dst[1] = w1; dst[2] = w2;
                if (f_lane == 0) WSP(float, tb ? WS_EVS : WS_EUS)[e] = mx[u] * (1.0f / 7.5f);
                continue; }
            *(v4u*)(F.ws + (tb ? WS_EV : WS_EU) + (size_t)e * 1024 + 16 * f_lane) = w;
            if (f_lane == 0) WSP(float, tb ? WS_EVS : WS_EUS)[e] = mx[u] * (1.0f / 224.0f); }
    }
}
__device__ __forceinline__ void p5b_topk(Frame& F) {
    const int f_tid = threadIdx.x, f_lane = f_tid & 63, f_wave = __builtin_amdgcn_readfirstlane(f_tid >> 6);
    const _Float16* scores = WSP(_Float16, WS_SCORES);
    LAS unsigned char* ix = (LAS unsigned char*)F.lds + f_tid * 36;
#pragma unroll 1
    for (int half = 0; half < 2; ++half) {
    if ((f_wave >> 2) != half) { expert_convert(F, (F.vcu * 4 + (f_wave & 3)) * 2 + half, F.G * 8, f_lane); continue; }
    typedef _Float16 f16x8 __attribute__((ext_vector_type(8)));
    f16x8 sva[8], svb[8];
    { const int item0 = (F.vcu * 2 + half) * 256 + (f_tid & 255); const _Float16* sp0 = scores + (size_t)(item0 >> 3) * 2048 + (item0 & 7) * 256;
#pragma unroll
      for (int q = 0; q < 8; ++q) sva[q] = *(const f16x8*)(sp0 + 8 * q); }
#pragma unroll 1
    for (int item = (F.vcu * 2 + half) * 256 + (f_tid & 255); item < MTOK * PH; item += F.G * 512) {
        const int t = item >> 3, hd = item & 7;
        unsigned a1[16], a2[16];
#pragma unroll
        for (int i = 0; i < 16; ++i) { a1[i] = 0u; a2[i] = 0u; }
        const _Float16* sp = scores + (size_t)t * 2048 + hd * 256;
        const int itn = (item + F.G * 512 < MTOK * PH) ? item + F.G * 512 : item;
        const _Float16* spn = scores + (size_t)(itn >> 3) * 2048 + (itn & 7) * 256;
#define TK_BATCH(CUR, NXT, NP, A, M) { \
        { _Pragma("unroll") for (int q = 0; q < 8; ++q) NXT[q] = *(const f16x8*)((NP) + 8 * q); } \
        __builtin_amdgcn_sched_barrier(0); \
        _Pragma("unroll") for (int q = 0; q < 8; ++q) { _Pragma("unroll") for (int e = 0; e < 8; ++e) { const unsigned k = (fkey((float)CUR[q][e]) & ~127u) | (unsigned)(127 - (64 * (M) + 8 * q + e)); TOPK_INSERT(A, k); } } }
        TK_BATCH(sva, svb, sp + 64, a1, 0)
        TK_BATCH(svb, sva, sp + 128, a1, 1)
        TK_BATCH(sva, svb, sp + 192, a2, 0)
        TK_BATCH(svb, sva, spn, a2, 1)
#undef TK_BATCH
        float v1[16], v2[16];
#pragma unroll
        for (int i = 0; i < 16; ++i) { ix[i] = (unsigned char)(127u - (a1[i] & 127u)); ix[16 + i] = (unsigned char)(127u - (a2[i] & 127u)); v1[i] = fkey_inv(a1[i] & ~127u); v2[i] = fkey_inv(a2[i] & ~127u); }
        unsigned cb[16];
#pragma unroll
        for (int i = 0; i < 16; ++i) cb[i] = 0u;
#pragma unroll
        for (int i = 0; i < 16; ++i)
#pragma unroll
            for (int j = 0; j < 16; ++j) if ((i + 1) * (j + 1) <= 16) { const unsigned k = (fkey(v1[i] + v2[j]) & ~255u) | (unsigned)(255 - (i * 16 + j)); TOPK_INSERT(cb, k); }
        float tv[16]; float mx = -3.0e38f;
#pragma unroll
        for (int k = 0; k < 16; ++k) { tv[k] = fkey_inv(cb[k] & ~255u); mx = fmaxf(mx, tv[k]); }
        float sum = 0.f;
#pragma unroll
        for (int k = 0; k < 16; ++k) { tv[k] = __expf(tv[k] - mx); sum += tv[k]; }
        const float inv = 1.0f / sum;
        LDS_WAIT(); asm volatile("" ::: "memory");
        int ev[16]; unsigned long long cA = 0ull, cB = 0ull;
#pragma unroll
        for (int k = 0; k < 16; ++k) { const unsigned code = 255u - (cb[k] & 255u); const int i = code >> 4, j = code & 15; ev[k] = (int)ix[i] * 128 + (int)ix[16 + j];
            const int r = ev[k] >> 10; const unsigned long long one = 1ull << (8 * (r & 7)); if (r < 8) cA += one; else cB += one; }
        unsigned long long sA = cA, sB = cB;
#pragma unroll
        for (int o = 1; o < 8; o <<= 1) {
            const unsigned alo = __shfl_up((unsigned)sA, o, 8), ahi = __shfl_up((unsigned)(sA >> 32), o, 8), blo = __shfl_up((unsigned)sB, o, 8), bhi = __shfl_up((unsigned)(sB >> 32), o, 8);
            if ((f_lane & 7) >= o) { sA += ((unsigned long long)ahi << 32) | alo; sB += ((unsigned long long)bhi << 32) | blo; } }
        const unsigned long long eA = sA - cA, eB = sB - cB;
        const unsigned long long tA = ((unsigned long long)__shfl((unsigned)(sA >> 32), 7, 8) << 32) | __shfl((unsigned)sA, 7, 8), tB = ((unsigned long long)__shfl((unsigned)(sB >> 32), 7, 8) << 32) | __shfl((unsigned)sB, 7, 8);
        const unsigned long long pA = tA * 0x0101010101010101ull, pB = tB * 0x0101010101010101ull;
        const unsigned long long st64 = pA << 8, stB = (pB << 8) + (pA >> 56) * 0x0101010101010101ull;
        unsigned long long baseA = st64 + eA, baseB = stB + eB;
        int* eo = WSP(int, WS_EID) + (size_t)t * 128; float* go = WSP(float, WS_GATE) + (size_t)t * 128;
#pragma unroll
        for (int k = 0; k < 16; ++k) { const int r = ev[k] >> 10; const int r8 = 8 * (r & 7); const unsigned long long one = 1ull << r8;
            const int slot = (int)(((r < 8 ? baseA : baseB) >> r8) & 255ull); if (r < 8) baseA += one; else baseB += one; eo[slot] = ev[k]; go[slot] = tv[k] * inv; }
        if (hd == 0) WSP(unsigned long long, WS_START)[t] = st64;
        LDS_WAIT(); asm volatile("" ::: "memory");
    }
    }
}
typedef long i64_t;
typedef unsigned v3u __attribute__((ext_vector_type(3)));
typedef unsigned v6u __attribute__((ext_vector_type(6)));
typedef float f32x32 __attribute__((ext_vector_type(32)));
struct __attribute__((packed, aligned(4))) U3 { unsigned a, b, c; };
__device__ __forceinline__ v3u ld_row6(const unsigned char* p) { const U3 u = *(const U3*)p; return (v3u){u.a, u.b, u.c}; }
__device__ __forceinline__ void p9_peer_down3(Frame& F) {
    const int f_tid = threadIdx.x, lane = f_tid & 63, f_wave = __builtin_amdgcn_readfirstlane(f_tid >> 6);
    const unsigned char* EV = F.ws + WS_EV;
    for (int wq = F.vcu * NWAVES + f_wave; wq < MTOK / 16; wq += F.G * NWAVES) {
        const int b = wq >> 7; const float* mb = WSP(float, WS_MOD) + (size_t)b * 6144;
        unsigned l16 = 16u * (unsigned)lane; asm volatile("" : "+v"(l16));
        const unsigned l12 = (l16 >> 2) * 3u;
        int ne_lo = WSP(int, WS_EID)[(size_t)wq * 16 * 128 + lane], ne_hi = WSP(int, WS_EID)[(size_t)wq * 16 * 128 + 64 + lane];
        float nw_lo = WSP(float, WS_GATE)[(size_t)wq * 16 * 128 + lane], nw_hi = WSP(float, WS_GATE)[(size_t)wq * 16 * 128 + 64 + lane];
        v3u qa[8], qb[8];
#pragma unroll
        for (int j = 0; j < 8; ++j) { const int e = __builtin_amdgcn_readlane(ne_lo, j); qa[j] = ld_row6(EV + ((unsigned)e * 768u + l12)); }
#pragma unroll 1
        for (int tt = 0; tt < 16; ++tt) {
            const size_t t = (size_t)wq * 16 + tt;
            float* xr = (float*)((char*)(F.out + t * 1024) + 4u * l16);
            const int e_lo = ne_lo, e_hi = ne_hi; const float w_lo = nw_lo, w_hi = nw_hi;
            { const size_t tn = t + (tt < 15 ? 1 : 0); ne_lo = WSP(int, WS_EID)[tn * 128 + lane]; ne_hi = WSP(int, WS_EID)[tn * 128 + 64 + lane]; nw_lo = WSP(float, WS_GATE)[tn * 128 + lane]; nw_hi = WSP(float, WS_GATE)[tn * 128 + 64 + lane]; }
            f32x2 o[8];
#pragma unroll
            for (int i = 0; i < 8; ++i) o[i] = (f32x2){0.f, 0.f};
#define DN3_STEP(GRP, CUR, NXT, NIDS, NB) { \
                const int grp = (GRP); \
                { const int nids = (NIDS); _Pragma("unroll") for (int j = 0; j < 8; ++j) { const int e = __builtin_amdgcn_readlane(nids, (NB) + j); NXT[j] = ld_row6(EV + ((unsigned)e * 768u + l12)); } } \
                __builtin_amdgcn_sched_barrier(0); \
                const int base = (grp & 7) * 8; const float wsel = grp < 8 ? w_lo : w_hi; \
                _Pragma("unroll") for (int j = 0; j < 8; j += 2) { \
                    const float wa = __builtin_bit_cast(float, __builtin_amdgcn_readlane(__builtin_bit_cast(int, wsel), base + j)), wb = __builtin_bit_cast(float, __builtin_amdgcn_readlane(__builtin_bit_cast(int, wsel), base + j + 1)); \
                    const f32x2 wa2 = (f32x2){wa, wa}, wb2 = (f32x2){wb, wb}; \
                    const v6u pr = (v6u){CUR[j][0], CUR[j][1], CUR[j][2], CUR[j + 1][0], CUR[j + 1][1], CUR[j + 1][2]}; \
                    const f32x32 r = __builtin_amdgcn_cvt_scalef32_pk32_f32_fp6(pr, 1.0f); \
                    _Pragma("unroll") for (int i = 0; i < 8; ++i) { o[i] += wa2 * (f32x2){r[2 * i], r[2 * i + 1]}; o[i] += wb2 * (f32x2){r[16 + 2 * i], r[17 + 2 * i]}; } } }
#pragma unroll 1
            for (int g2 = 0; g2 < 14; g2 += 2) { const int ga = g2 + 1, gb = g2 + 2;
                DN3_STEP(g2, qa, qb, ga < 8 ? e_lo : e_hi, (ga & 7) * 8)
                DN3_STEP(g2 + 1, qb, qa, gb < 8 ? e_lo : e_hi, (gb & 7) * 8) }
            DN3_STEP(14, qa, qb, e_hi, 56)
            DN3_STEP(15, qb, qa, ne_lo, 0)
#undef DN3_STEP
            float x1[16]; float ss = 0.f;
            { const char* xb = (const char*)(F.ws + WS_X1B + t * 2048) + 2u * l16; const v4u xa = *(const v4u*)xb, xc = *(const v4u*)(xb + 16); unpack8(xa, x1); unpack8(xc, x1 + 8); }
#pragma unroll
            for (int q4 = 0; q4 < 4; ++q4) { const f32x4 gt = *(const f32x4*)((const char*)(mb + 5120) + 4u * l16 + 16 * q4);
#pragma unroll
                for (int e = 0; e < 4; ++e) { const int i = 4 * q4 + e; x1[i] += gt[e] * o[i >> 1][i & 1]; ss += x1[i] * x1[i]; } }
            const float rf = rsqrt_f(wave_sum(ss) * (1.0f / 1024.0f) + EPSF);
#pragma unroll
            for (int q4 = 0; q4 < 4; ++q4) { const f32x4 nf = *(const f32x4*)((const char*)(F.a->in[29]) + 4u * l16 + 16 * q4); f32x4 v;
#pragma unroll
                for (int e = 0; e < 4; ++e) v[e] = x1[4 * q4 + e] * rf * nf[e];
                *(f32x4*)(xr + 4 * q4) = v; }
        }
    }
}
typedef int i32x8 __attribute__((ext_vector_type(8)));
typedef unsigned v2u __attribute__((ext_vector_type(2)));
#define U14_WRMASK true
constexpr int U14_ROWP = 1040, U14_BUF = 8 * U14_ROWP, U14_WAVE = 2 * U14_BUF + 1024;
static_assert(8 * U14_WAVE <= LDS_MAIN, "U14 LDS map");
struct U14Meta { int elo, ehi; float glo, ghi; v4u xa, xb; float rst; };
__device__ __forceinline__ void u14_meta_load(U14Meta& M, const unsigned char* ws, size_t t, unsigned l16) {
    const unsigned l = l16 >> 4; const int* ep = (const int*)(ws + WS_EID) + t * 128; const float* gp = (const float*)(ws + WS_GATE) + t * 128;
    M.elo = ep[l]; M.ehi = ep[64 + l]; M.glo = gp[l]; M.ghi = gp[64 + l];
    const char* xs = (const char*)(ws + WS_X1S) + t * 2048 + 2u * l16; M.xa = *(const v4u*)xs; M.xb = *(const v4u*)(xs + 16);
    M.rst = ((const float*)(ws + WS_ROWSTAT))[t];
}
__device__ __forceinline__ void u14_h2(const U14Meta& M, const float* S2, LAS unsigned char* hq, unsigned l16, int li, int lq, v4u* hb, float& hinv) {
    float h2[16]; unpack8(M.xa, h2); unpack8(M.xb, h2 + 8); float mx = 0.f;
    const float rs = rsqrt_f(M.rst * (1.0f / 1024.0f) + EPSF);
#pragma unroll
    for (int i = 0; i < 16; ++i) { h2[i] = h2[i] * rs + S2[i]; mx = fmaxf(mx, fabsf(h2[i])); }
#pragma unroll
    for (int o = 1; o < 64; o <<= 1) mx = fmaxf(mx, __shfl_xor(mx, o));
    mx = fmaxf(mx, 1e-30f); const float hs = 224.0f / mx; hinv = mx * (1.0f / 224.0f);
    v4u w;
#pragma unroll
    for (int qd = 0; qd < 4; ++qd) { int pk = 0; pk = __builtin_amdgcn_cvt_pk_fp8_f32(h2[4 * qd] * hs, h2[4 * qd + 1] * hs, pk, false); pk = __builtin_amdgcn_cvt_pk_fp8_f32(h2[4 * qd + 2] * hs, h2[4 * qd + 3] * hs, pk, true); w[qd] = (unsigned)pk; }
    *(LAS v4u*)(hq + l16) = w;
    LDS_WAIT(); asm volatile("" ::: "memory");
#pragma unroll
    for (int c = 0; c < 4; ++c) { hb[2 * c] = *(const LAS v4u*)(hq + (li & 1) * 512 + 128 * c + 16 * lq); hb[2 * c + 1] = *(const LAS v4u*)(hq + (li & 1) * 512 + 128 * c + 64 + 16 * lq); }
    LDS_WAIT(); asm volatile("" ::: "memory");
}
__device__ __forceinline__ void p8_peer_up14(Frame& F) {
    const int f_tid = threadIdx.x, lane = f_tid & 63, f_wave = __builtin_amdgcn_readfirstlane(f_tid >> 6);
    const int li = lane & 15, lq = lane >> 4;
    const unsigned char* EU = F.ws + WS_EU; const float* EUS = WSP(float, WS_EUS); const float* EVS = WSP(float, WS_EVS);
    LAS unsigned char* tile = F.lds + f_wave * U14_WAVE; LAS unsigned char* hq = tile + 2 * U14_BUF;
    for (int wq = F.vcu * NWAVES + f_wave; wq < MTOK / 16; wq += F.G * NWAVES) {
        const int b = wq >> 7; const float* mb = WSP(float, WS_MOD) + (size_t)b * 6144;
        unsigned l16 = 16u * (unsigned)lane; asm volatile("" : "+v"(l16));
        const unsigned rof = l16 < 768u ? l16 : l16 - 768u;
        float S2[16];
#pragma unroll
        for (int q = 0; q < 4; ++q) { const f32x4 sh = *(const f32x4*)((const char*)(mb + 3072) + 4u * l16 + 16 * q); S2[4 * q] = sh[0]; S2[4 * q + 1] = sh[1]; S2[4 * q + 2] = sh[2]; S2[4 * q + 3] = sh[3]; }
        const size_t t0 = (size_t)wq * 16;
        U14Meta N; u14_meta_load(N, F.ws, t0, l16);
        float nsu_lo = EUS[N.elo], nsu_hi = EUS[N.ehi], nsv_lo = EVS[N.elo], nsv_hi = EVS[N.ehi];
        v4u qa[8], qb[8];
#pragma unroll
        for (int j = 0; j < 8; ++j) { const int e = __builtin_amdgcn_readlane(N.elo, j); qa[j] = *(const v4u*)(EU + ((unsigned)e * 768u + rof)); }
#pragma unroll 1
        for (int tt = 0; tt < 16; ++tt) {
            const size_t t = t0 + tt;
            const int e_lo = N.elo, e_hi = N.ehi; const float g_lo = N.glo, g_hi = N.ghi, su_lo = nsu_lo, su_hi = nsu_hi, sv_lo = nsv_lo, sv_hi = nsv_hi;
            v4u hb[8]; float hinv;
            u14_h2(N, S2, hq, l16, li, lq, hb, hinv);
            u14_meta_load(N, F.ws, t + (tt < 15 ? 1 : 0), l16);
            float w_lo = 0.f, w_hi = 0.f;
#define U14_STEP(UU, CUR, NXT, NLO, NHI) { \
            const int u = (UU); const int un = (u + 1) & 15; const int nb = (un & 7) * 8; const int ensel = un < 8 ? (NLO) : (NHI); \
            { _Pragma("unroll") for (int j = 0; j < 8; ++j) { const int e = __builtin_amdgcn_readlane(ensel, nb + j); NXT[j] = *(const v4u*)(EU + ((unsigned)e * 768u + rof)); } } \
            __builtin_amdgcn_sched_barrier(0); \
            LAS unsigned char* tb = tile + (u & 1) * U14_BUF; \
            if (U14_WRMASK) { _Pragma("unroll") for (int j = 0; j < 8; ++j) *(LAS v4u*)(tb + j * U14_ROWP + l16) = CUR[j]; } \
            LDS_WAIT(); asm volatile("" ::: "memory"); \
            const LAS unsigned char* src = tb + (li & 7) * U14_ROWP + (li >> 3) * 384 + 24 * lq; \
            f32x4 acc = (f32x4){0.f, 0.f, 0.f, 0.f}; \
            _Pragma("unroll") for (int c = 0; c < 4; ++c) { const v2u a0 = *(const LAS v2u*)(src + 96 * c), a1 = *(const LAS v2u*)(src + 96 * c + 8), a2 = *(const LAS v2u*)(src + 96 * c + 16); \
                const i32x8 A = (i32x8){(int)a0[0], (int)a0[1], (int)a1[0], (int)a1[1], (int)a2[0], (int)a2[1], 0, 0}; \
                const i32x8 B = (i32x8){(int)hb[2 * c][0], (int)hb[2 * c][1], (int)hb[2 * c][2], (int)hb[2 * c][3], (int)hb[2 * c + 1][0], (int)hb[2 * c + 1][1], (int)hb[2 * c + 1][2], (int)hb[2 * c + 1][3]}; \
                acc = __builtin_amdgcn_mfma_scale_f32_16x16x128_f8f6f4(A, B, acc, 2, 0, 0, 0, 0, 0); }        \
            const int base = (u & 7) * 8; const int r = (li >> 1) & 3; \
            const float sel = r == 0 ? acc[0] : (r == 1 ? acc[1] : (r == 2 ? acc[2] : acc[3])); \
            const int sl = ((lane & 7) >> 2) * 16 + 2 * (lane & 3);                          \
            const float dmine = __shfl(sel, sl) + __shfl(sel, sl + 33); \
            const float gsel = u < 8 ? g_lo : g_hi, susel = u < 8 ? su_lo : su_hi, svsel = u < 8 ? sv_lo : sv_hi; \
            const float wv = gsel * gelu_erf(dmine * susel * hinv) * svsel; \
            const bool mine = (lane >= base) && (lane < base + 8); \
            if (u < 8) w_lo = mine ? wv : w_lo; else w_hi = mine ? wv : w_hi; }
#pragma unroll 1
            for (int u2 = 0; u2 < 14; u2 += 2) { U14_STEP(u2, qa, qb, e_lo, e_hi) U14_STEP(u2 + 1, qb, qa, e_lo, e_hi) }
            U14_STEP(14, qa, qb, e_lo, e_hi)
            U14_STEP(15, qb, qa, N.elo, N.ehi)
#undef U14_STEP
            nsu_lo = EUS[N.elo]; nsu_hi = EUS[N.ehi]; nsv_lo = EVS[N.elo]; nsv_hi = EVS[N.ehi];
            __builtin_amdgcn_sched_barrier(0);
            WSP(float, WS_GATE)[t * 128 + lane] = w_lo; WSP(float, WS_GATE)[t * 128 + 64 + lane] = w_hi;
        }
    }
}
#define SEAM8 SEAM(8)
constexpr int NPHASE = 10;
__global__ void __launch_bounds__(NTHR, 2) fwd_mega(Args args) {
    extern __shared__ __attribute__((aligned(16))) unsigned char lds[];
    Frame F;
    F.lds = (LAS unsigned char*)lds;
    F.MISC = (volatile LAS unsigned*)(F.lds + MISC_OFF);
    F.G = gridDim.x; { const int bx = blockIdx.x; F.vcu = (F.G % 8 == 0) ? (bx % 8) * (F.G / 8) + bx / 8 : bx; }
    F.ws = args.ws; F.out = args.out;
    F.a = &args;
    for (int u = threadIdx.x; u < 32; u += NTHR) F.MISC[u] = 0u;
    __syncthreads();
    const int lo = args.ph_lo, hi = args.ph_hi;
    const bool use_bar = (hi - lo) > 1;
    XcdBarrier bar; bar.bar = (unsigned*)(F.ws + WS_CTL); bar.x = 0; bar.st = nullptr;
    if (use_bar) bar = xcd_barrier_post((unsigned*)(F.ws + WS_CTL), F.MISC + 8);
#define X1PTR ((float*)(F.ws + WS_X1B))
#define IN(k) (lo <= (k) && (k) < hi)
#define SEAM(k) do { if (IN(k) && IN((k) + 1)) xcd_barrier(bar); } while (0)
#ifndef REP_PHASE
#define REP_PHASE -1
#endif
#define REPEAT(k, body) do { if (REP_PHASE == (k)) { xcd_barrier(bar); body; } } while (0)
    if (IN(0)) {
#ifndef SKIP_P0
 p0_phase(F); REPEAT(0, p0_phase(F));
#endif
 } SEAM(0);
    if (IN(1)) {
#ifndef SKIP_P1
 p1_phase(F); REPEAT(1, p1_phase(F));
#endif
 } SEAM(1);
    if (IN(2)) {
        pg8::Gemm g{WSP(bf16, WS_H1), WSP(bf16, WS_WINT), MTOK, NPROJ, 1024}; pg8::StaticOrder S; S.init(MTOK, NPROJ, F.G, (int)blockIdx.x);
        pg8::EpiProj E{WSP(bf16, WS_PROJ), NPROJ};
        pg8::gemm_phase<pg8::EpiProj, pg8::StaticOrder, true, true>(F.lds, g, S, E);
        REPEAT(2, (pg8::gemm_phase<pg8::EpiProj, pg8::StaticOrder, true, true>(F.lds, g, S, E)));
    } SEAM(2);
    if (IN(3)) {
#ifndef SKIP_SSD
 p3pre_conv(F); xcd_barrier(bar); p3_ssd3(F); REPEAT(30, p3_ssd3(F)); REPEAT(32, p3pre_conv(F));
#endif
#ifndef SKIP_S5
 p3_s5v2(F); REPEAT(31, p3_s5v2(F));
#endif
 } SEAM(3);
    if (IN(5)) {
        pg8::Gemm g{WSP(bf16, WS_Y), WSP(bf16, WS_WOUTT), MTOK, 1024, 2048}; pg8::StaticOrder S; S.init(MTOK, 1024, F.G, (int)blockIdx.x);
        PG8_LAS float* tab = (PG8_LAS float*)(F.lds + pg8::STAGE_BYTES);
        { pg8::Unit u; for (int i = 0; S.next(i, u); ++i) pg8::SegScaleHook::build(F.lds + pg8::STAGE_BYTES, u, WSP(float, WS_STSSD), WSP(float, WS_STS5), (int)threadIdx.x); }
        __syncthreads();
        pg8::EpiX1 E{(F.a->in[0]), X1PTR, WSP(bf16, WS_X1S), WSP(float, WS_MOD), (F.a->in[24]), WSP(float, WS_ROWSTAT), tab};
        pg8::SegScaleHook H;
        pg8::gemm_phase<pg8::EpiX1, pg8::StaticOrder, true, true, pg8::SegScaleHook>(F.lds, g, S, E, H);
    } SEAM(5);
    if (IN(6)) {
        pg8::Gemm g{WSP(bf16, WS_X1S), WSP(bf16, WS_WQKT), MTOK, 2048, 1024}; pg8::StaticOrder S; S.init(MTOK, 2048, F.G, (int)blockIdx.x);
        pg8::EpiScores E{WSP(_Float16, WS_SCORES), WSP(float, WS_SB), WSP(float, WS_ROWSTAT)};
        pg8::gemm_phase<pg8::EpiScores, pg8::StaticOrder, true, true>(F.lds, g, S, E);
        REPEAT(6, (pg8::gemm_phase<pg8::EpiScores, pg8::StaticOrder, true, true>(F.lds, g, S, E)));
    } SEAM(6);
    if (IN(7)) {
#ifndef SKIP_TOPK
 p5b_topk(F); REPEAT(7, p5b_topk(F));
#endif
 } SEAM(7);
    if (IN(8)) { p8_peer_up14(F); REPEAT(8, { p5b_topk(F); xcd_barrier(bar); p8_peer_up14(F); }); } SEAM8;
    if (IN(9)) { p9_peer_down3(F); }
#undef IN
#undef SEAM
}

#ifndef N_LAUNCHES
#define N_LAUNCHES 1
#endif
extern "C" void kernel_launch(void* const* d_in, const int* in_sizes, int n_in, void* d_out, int out_size, void* d_ws, size_t ws_size, hipStream_t stream) {
    static int grid = 0;
    if (grid == 0) {
        if (n_in != 30 || in_sizes[0] != MTOK * DM || out_size != MTOK * DM || ws_size < WS_END) { fprintf(stderr, "kernel_launch: unexpected shapes (n_in %d, in0 %d, out %d, ws %zu)\n", n_in, n_in > 0 ? in_sizes[0] : -1, out_size, ws_size); grid = -1; return; }
        int dev = 0, cus = 0, per_cu = 0;
        if (hipGetDevice(&dev) != hipSuccess || hipDeviceGetAttribute(&cus, hipDeviceAttributeMultiprocessorCount, dev) != hipSuccess) { grid = -1; return; }
        if (hipFuncSetAttribute((const void*)fwd_mega, hipFuncAttributeMaxDynamicSharedMemorySize, LDS_BYTES) != hipSuccess) { fprintf(stderr, "kernel_launch: hipFuncSetAttribute failed\n"); grid = -1; return; }
        if (hipOccupancyMaxActiveBlocksPerMultiprocessor(&per_cu, (const void*)fwd_mega, NTHR, LDS_BYTES) != hipSuccess || per_cu < 1) { fprintf(stderr, "kernel_launch: occupancy query says %d\n", per_cu); (void)hipGetLastError(); grid = -1; return; }
        if (cus != 256) { fprintf(stderr, "kernel_launch: built for a 256-CU device (got %d CUs); nothing launched\n", cus); grid = -1; return; }
        grid = cus;
    }
    if (grid < 0) return;
    (void)hipMemsetAsync((char*)d_ws + WS_CTL, 0, CTL_ZERO_BYTES, stream);
    Args a{};
    for (int i = 0; i < 30; ++i) a.in[i] = (const float*)d_in[i];
    a.out = (float*)d_out; a.ws = (unsigned char*)d_ws;
    if (N_LAUNCHES == 1) {
        a.ph_lo = 0; a.ph_hi = NPHASE;
        void* kargs[] = {&a};
        hipError_t e = hipLaunchCooperativeKernel((const void*)fwd_mega, dim3(grid), dim3(NTHR), kargs, LDS_BYTES, stream);
        if (e != hipSuccess) fprintf(stderr, "kernel_launch: cooperative launch failed: %s (grid %d)\n", hipGetErrorString(e), grid);
    } else {
        for (int p = 0; p < NPHASE; ++p) { a.ph_lo = p; a.ph_hi = p + 1; hipLaunchKernelGGL(fwd_mega, dim3(grid), dim3(NTHR), LDS_BYTES, stream, a); }
    }
}
```
